# Optimizing an MI355X kernel written in HIP

```python
import math
import functools
import numpy as np
import jax
import jax.numpy as jnp
from jax import lax

D_MODEL = 1024
BATCH = 4
SEQ = 4096
DEPTH = 2

GRID_W = 64
CTX_LEN = 256
EPS = 1e-6
F32 = jnp.float32

ATT_HEADS = 4
ATT_DH = 64
ATT_VD = 2 * ATT_DH
ATT_W = ATT_HEADS * ATT_VD
Q_BLOCK = 128
ROPE_BASE = 10000.0

DN_HEADS = 4
DN_DH = 64
DN_W = DN_HEADS * DN_DH
DN_CONV = 5
DN_CHUNK = 64

POOL_WINDOWS = (2, 4, 8, 16)
POOL_GD = 64
POOL_W = len(POOL_WINDOWS) * POOL_GD

N_BRANCH = 3
MIX_W = ATT_W + DN_W + POOL_W

IN_SPLITS = (ATT_HEADS * 2 * ATT_DH, ATT_HEADS * 2 * ATT_DH, ATT_W,
             DN_W, DN_W, DN_W, DN_W, 2 * DN_HEADS, 2 * DN_HEADS,
             POOL_W, N_BRANCH * D_MODEL)
IN_W = sum(IN_SPLITS)

FFN_DENSE = ((8 * D_MODEL // 3 + 255) // 256) * 256
N_EXPERTS = 8
TOP_K = 2
FFN_EXPERT = 7 * D_MODEL // 2
N_DENSE = (DEPTH + 1) // 2
N_MOE = DEPTH // 2

kernel_name = 'hybrid_diffattn_gdn_pool_moe_dit'


def _rmsnorm(x, g):
    xf = x.astype(F32)
    y = xf * lax.rsqrt(jnp.mean(xf * xf, axis=-1, keepdims=True) + EPS)
    return (y * g.astype(F32)).astype(x.dtype)


def _modulate(x, shift, scale):
    return x * (1 + scale) + shift


def _split(x, sizes):
    return jnp.split(x, np.cumsum(sizes)[:-1].tolist(), axis=-1)


def _l2norm(x):
    return x * lax.rsqrt(jnp.sum(x * x, axis=-1, keepdims=True) + EPS)


def _conv_centred(x, w):
    k = w.shape[0]
    return lax.conv_general_dilated(
        x, w[:, None, :].astype(x.dtype), window_strides=(1,),
        padding=[(k // 2, k // 2)], dimension_numbers=('NWC', 'WIO', 'NWC'),
        feature_group_count=x.shape[-1])


def _axial_rope_tables(rows):
    row = jnp.repeat(jnp.arange(rows), GRID_W).astype(F32)
    col = jnp.tile(jnp.arange(GRID_W), rows).astype(F32)
    n_freq = ATT_DH // 4
    inv = ROPE_BASE ** (-jnp.arange(n_freq, dtype=F32) / n_freq)
    ar = row[:, None] * inv
    ac = col[:, None] * inv
    return (jnp.cos(ar), jnp.sin(ar), jnp.cos(ac), jnp.sin(ac))


def _rotate(x, cos, sin):
    x1, x2 = jnp.split(x, 2, axis=-1)
    c = cos[:, None, None, :]
    s = sin[:, None, None, :]
    return jnp.concatenate([x1 * c - x2 * s, x2 * c + x1 * s], axis=-1)


def _apply_axial_rope(x, rope):
    cr, sr, cc, sc = rope
    xf = x.astype(F32)
    half = ATT_DH // 2
    out = jnp.concatenate([_rotate(xf[..., :half], cr, sr), _rotate(xf[..., half:], cc, sc)], axis=-1)
    return out.astype(x.dtype)


def _diff_softmax_attend(q, k, v, lam):
    s = jnp.einsum('bqhmd,bkhmd->bhmqk', q, k).astype(F32) * (ATT_DH ** -0.5)
    p = jax.nn.softmax(s, axis=-1)
    a = p[:, :, 0] - lam * p[:, :, 1]
    return jnp.einsum('bhqk,bkhe->bqhe', a.astype(v.dtype), v)


def _diff_attention(q_l, k_l, v_l, q_c, k_c, v_c, lam_params, subln_g, lambda_init, rope, ctx_out):
    B, S, _ = q_l.shape
    C = q_c.shape[1]
    ql = _apply_axial_rope(q_l.reshape(B, S, ATT_HEADS, 2, ATT_DH), rope)
    kl = _apply_axial_rope(k_l.reshape(B, S, ATT_HEADS, 2, ATT_DH), rope)
    vl = v_l.reshape(B, S, ATT_HEADS, ATT_VD)
    kc = k_c.reshape(B, C, ATT_HEADS, 2, ATT_DH)
    vc = v_c.reshape(B, C, ATT_HEADS, ATT_VD)
    lp = lam_params.astype(F32)
    lam = jnp.exp(jnp.sum(lp[0] * lp[1])) - jnp.exp(jnp.sum(lp[2] * lp[3])) + lambda_init
    k_all = jnp.concatenate([kc, kl], axis=1)
    v_all = jnp.concatenate([vc, vl], axis=1)
    nb = S // Q_BLOCK
    qb = jnp.moveaxis(ql.reshape(B, nb, Q_BLOCK, ATT_HEADS, 2, ATT_DH), 1, 0)
    ob = lax.map(lambda blk: _diff_softmax_attend(blk, k_all, v_all, lam), qb)
    o_l = jnp.moveaxis(ob, 0, 1).reshape(B, S, ATT_HEADS, ATT_VD)
    y_l = (_rmsnorm(o_l, subln_g) * (1 - lambda_init)).reshape(B, S, ATT_W)
    y_c = None
    if ctx_out:
        qc = q_c.reshape(B, C, ATT_HEADS, 2, ATT_DH)
        o_c = _diff_softmax_attend(qc, kc, vc, lam)
        y_c = (_rmsnorm(o_c, subln_g) * (1 - lambda_init)).reshape(B, C, ATT_W)
    return y_l, y_c


def _dn_inputs(q, k, v, a, b, conv_w, a_log, dt_bias):
    B, L, _ = q.shape
    qkv = jax.nn.silu(_conv_centred(jnp.concatenate([q, k, v], axis=-1), conv_w)).astype(F32)
    q, k, v = [t.reshape(B, L, DN_HEADS, DN_DH) for t in jnp.split(qkv, 3, axis=-1)]
    q = _l2norm(q) * (DN_DH ** -0.5)
    k = _l2norm(k)
    a = a.astype(F32).reshape(B, L, 2, DN_HEADS)
    b = b.astype(F32).reshape(B, L, 2, DN_HEADS)
    g = -jnp.exp(a_log.astype(F32)) * jax.nn.softplus(a + dt_bias.astype(F32))
    beta = jax.nn.sigmoid(b)
    return q, k, v, g, beta


def _chunk_gated_delta(q, k, v, beta, g, s0, with_output):
    B, L, H, Dk = q.shape
    Dv = v.shape[-1]
    n = L // DN_CHUNK
    cn = DN_CHUNK

    def blocks(t):
        t = jnp.moveaxis(t, 2, 1)
        t = t.reshape(B, H, n, cn, *t.shape[3:])
        return jnp.moveaxis(t, 2, 0)

    q, k, v, beta, g = (blocks(t) for t in (q, k, v, beta, g))
    G = jnp.cumsum(g, axis=-1)
    incl = jnp.tril(jnp.ones((cn, cn), dtype=bool))
    strict = jnp.tril(jnp.ones((cn, cn), dtype=bool), -1)
    decay = jnp.exp(jnp.where(incl, G[..., :, None] - G[..., None, :], -jnp.inf))
    kb = k * beta[..., None]
    m = jnp.where(strict, jnp.einsum('nbhid,nbhjd->nbhij', kb, k) * decay, 0.0)
    a = m + jnp.eye(cn, dtype=m.dtype)
    rhs = jnp.concatenate([v * beta[..., None], kb * jnp.exp(G)[..., None]], axis=-1)
    sol = lax.linalg.triangular_solve(a, rhs, left_side=True, lower=True, unit_diagonal=True)
    u, w = sol[..., :Dv], sol[..., Dv:]
    kt = k * jnp.exp(G[..., -1:] - G)[..., None]
    g_last = jnp.exp(G[..., -1])

    if with_output:
        qk = jnp.einsum('nbhid,nbhjd->nbhij', q, k) * decay
        qg = q * jnp.exp(G)[..., None]

        def step(s, xs):
            qg_i, qk_i, kt_i, u_i, w_i, gl_i = xs
            v_new = u_i - jnp.einsum('bhcd,bhde->bhce', w_i, s)
            o_i = jnp.einsum('bhcd,bhde->bhce', qg_i, s) + jnp.einsum('bhij,bhje->bhie', qk_i, v_new)
            s = s * gl_i[..., None, None] + jnp.einsum('bhcd,bhce->bhde', kt_i, v_new)
            return s, o_i

        s_fin, o = lax.scan(step, s0, (qg, qk, kt, u, w, g_last))
        o = jnp.moveaxis(o, 0, 2).reshape(B, H, L, Dv)
        return jnp.moveaxis(o, 1, 2), s_fin

    def step_state(s, xs):
        kt_i, u_i, w_i, gl_i = xs
        v_new = u_i - jnp.einsum('bhcd,bhde->bhce', w_i, s)
        return s * gl_i[..., None, None] + jnp.einsum('bhcd,bhce->bhde', kt_i, v_new), None

    s_fin, _ = lax.scan(step_state, s0, (kt, u, w, g_last))
    return None, s_fin


def _gated_deltanet(lat_parts, ctx_parts, conv_w, a_log, dt_bias, norm_g, ctx_out):
    ql, kl, vl, zl, al, bl = lat_parts
    qc, kc, vc, zc, ac, bc = ctx_parts
    lat = _dn_inputs(ql, kl, vl, al, bl, conv_w, a_log, dt_bias)
    ctx = _dn_inputs(qc, kc, vc, ac, bc, conv_w, a_log, dt_bias)
    B = ql.shape[0]
    s0 = jnp.zeros((B, DN_HEADS, DN_DH, DN_DH), F32)
    outs_l, outs_c = [], []
    for d in range(2):
        def orient(t):
            return jnp.flip(t, axis=1) if d == 1 else t
        c_in = [orient(t) for t in ctx[:3]] + [orient(ctx[4][:, :, d]), orient(ctx[3][:, :, d])]
        o_c, s_c = _chunk_gated_delta(*c_in, s0, ctx_out)
        l_in = [orient(t) for t in lat[:3]] + [orient(lat[4][:, :, d]), orient(lat[3][:, :, d])]
        o_l, _ = _chunk_gated_delta(*l_in, s_c, True)
        outs_l.append(orient(o_l))
        if ctx_out:
            outs_c.append(orient(o_c))

    def out_gate(o, z):
        Bz, L, _ = z.shape
        y = _rmsnorm(o, norm_g) * jax.nn.silu(z.astype(F32).reshape(Bz, L, DN_HEADS, DN_DH))
        return y.reshape(Bz, L, DN_W).astype(z.dtype)

    y_l = out_gate(outs_l[0] + outs_l[1], zl)
    y_c = out_gate(outs_c[0] + outs_c[1], zc) if ctx_out else None
    return y_l, y_c


def _multiscale_pool(u, pool_w, pool_scale):
    B, L, _ = u.shape
    uf = u.astype(F32)
    cs = jnp.concatenate([jnp.zeros((B, 1, POOL_W), F32), jnp.cumsum(uf, axis=1)], axis=1)
    t = jnp.arange(L)
    groups = []
    for gi, win in enumerate(POOL_WINDOWS):
        lo = jnp.clip(t - win // 2, 0, L)
        hi = jnp.clip(t - win // 2 + win, 0, L)
        sl = slice(gi * POOL_GD, (gi + 1) * POOL_GD)
        cs_g = cs[..., sl]
        mean = (cs_g[:, hi] - cs_g[:, lo]) / (hi - lo).astype(F32)[None, :, None]
        groups.append(mean - uf[..., sl])
    m = jnp.stack(groups, axis=2)
    y = jnp.einsum('blgi,gio->blgo', m, pool_w.astype(F32)).reshape(B, L, POOL_W)
    return (y * pool_scale.astype(F32)).astype(u.dtype)


def _token_mixer(u_lat, u_ctx, w_in, attn_lambda, attn_subln_g, lambda_init, dn_conv_w, dn_a_log,
                 dn_dt_bias, dn_norm_g, pool_w, pool_scale, w_branch, w_out, rope, ctx_out):
    pl = _split(u_lat @ w_in, IN_SPLITS)
    pc = _split(u_ctx @ w_in, IN_SPLITS)
    att_l, att_c = _diff_attention(pl[0], pl[1], pl[2], pc[0], pc[1], pc[2], attn_lambda,
                                   attn_subln_g, lambda_init, rope, ctx_out)
    dn_l, dn_c = _gated_deltanet(pl[3:9], pc[3:9], dn_conv_w, dn_a_log, dn_dt_bias, dn_norm_g, ctx_out)
    wb_att = w_branch[:ATT_W]
    wb_dn = w_branch[ATT_W:ATT_W + DN_W]
    wb_pool = w_branch[ATT_W + DN_W:]

    def merge(att, dn, pool, gates):
        ga, gd, gp = jnp.split(jax.nn.sigmoid(gates), N_BRANCH, axis=-1)
        return (ga * (att @ wb_att) + gd * (dn @ wb_dn) + gp * (pool @ wb_pool)) @ w_out

    y_lat = merge(att_l, dn_l, _multiscale_pool(pl[9], pool_w, pool_scale), pl[10])
    y_ctx = None
    if ctx_out:
        y_ctx = merge(att_c, dn_c, _multiscale_pool(pc[9], pool_w, pool_scale), pc[10])
    return y_lat, y_ctx


def _swiglu(u, w1, w3, w2):
    return (jax.nn.silu(u @ w1) * (u @ w3)) @ w2


def _moe_swiglu(u, router_w, w1, w3, w2):
    logits = (u @ router_w).astype(F32)
    top_v, top_i = lax.top_k(logits, TOP_K)
    top_w = jax.nn.softmax(top_v, axis=-1)
    comb = jnp.sum(jax.nn.one_hot(top_i, N_EXPERTS, dtype=F32) * top_w[..., None], axis=-2)
    out = jnp.zeros(u.shape, F32)
    for e in range(N_EXPERTS):
        out = out + comb[..., e:e + 1] * _swiglu(u, w1[e], w3[e], w2[e]).astype(F32)
    return out.astype(u.dtype)


def setup_inputs(seed: int = 0) -> dict:
    key = jax.random.key(seed)
    ks = iter(jax.random.split(key, 32))
    D = D_MODEL

    def nrm(shape, scale):
        return jax.random.normal(next(ks), shape, F32) * scale

    x = nrm((BATCH, SEQ, D), 1.0)
    c = nrm((BATCH, D), 1.0)
    ctx = nrm((BATCH, CTX_LEN, D), 1.0)
    c_ctx = nrm((D,), 1.0)
    ada_w = nrm((DEPTH, D, 6 * D), 0.5 * D ** -0.5)
    ada_b = nrm((DEPTH, 6 * D), 0.01)
    norm1_g = 1.0 + nrm((DEPTH, D), 0.05)
    norm2_g = 1.0 + nrm((DEPTH, D), 0.05)
    w_in = nrm((DEPTH, D, IN_W), D ** -0.5)
    attn_lambda = nrm((DEPTH, 4, ATT_DH), 0.1)
    attn_subln_g = 1.0 + nrm((DEPTH, ATT_VD), 0.05)
    dn_conv_w = nrm((DEPTH, DN_CONV, 3 * DN_W), DN_CONV ** -0.5)
    dn_a_log = jnp.log(jax.random.uniform(next(ks), (DEPTH, 2, DN_HEADS), F32, minval=1.0, maxval=16.0))
    dt = jnp.exp(jax.random.uniform(next(ks), (DEPTH, 2, DN_HEADS), F32,
                                    minval=math.log(1e-3), maxval=math.log(1e-1)))
    dn_dt_bias = dt + jnp.log(-jnp.expm1(-dt))
    dn_norm_g = 1.0 + nrm((DEPTH, DN_DH), 0.05)
    pool_w = nrm((DEPTH, len(POOL_WINDOWS), POOL_GD, POOL_GD), POOL_GD ** -0.5)
    pool_scale = 1.0 + nrm((DEPTH, POOL_W), 0.05)
    w_branch = jnp.concatenate([nrm((DEPTH, ATT_W, D), ATT_W ** -0.5),
                                nrm((DEPTH, DN_W, D), DN_W ** -0.5),
                                nrm((DEPTH, POOL_W, D), POOL_W ** -0.5)], axis=1)
    w_out = nrm((DEPTH, D, D), D ** -0.5)
    ffn_w1 = nrm((N_DENSE, D, FFN_DENSE), D ** -0.5)
    ffn_w3 = nrm((N_DENSE, D, FFN_DENSE), D ** -0.5)
    ffn_w2 = nrm((N_DENSE, FFN_DENSE, D), FFN_DENSE ** -0.5)
    router_w = nrm((N_MOE, D, N_EXPERTS), D ** -0.5)
    moe_w1 = nrm((N_MOE, N_EXPERTS, D, FFN_EXPERT), D ** -0.5)
    moe_w3 = nrm((N_MOE, N_EXPERTS, D, FFN_EXPERT), D ** -0.5)
    moe_w2 = nrm((N_MOE, N_EXPERTS, FFN_EXPERT, D), FFN_EXPERT ** -0.5)
    final_norm_g = 1.0 + nrm((D,), 0.05)
    return {'x': x, 'c': c, 'ctx': ctx, 'c_ctx': c_ctx, 'ada_w': ada_w, 'ada_b': ada_b,
            'norm1_g': norm1_g, 'norm2_g': norm2_g, 'w_in': w_in, 'attn_lambda': attn_lambda,
            'attn_subln_g': attn_subln_g, 'dn_conv_w': dn_conv_w, 'dn_a_log': dn_a_log,
            'dn_dt_bias': dn_dt_bias, 'dn_norm_g': dn_norm_g, 'pool_w': pool_w, 'pool_scale': pool_scale,
            'w_branch': w_branch, 'w_out': w_out, 'ffn_w1': ffn_w1, 'ffn_w3': ffn_w3, 'ffn_w2': ffn_w2,
            'router_w': router_w, 'moe_w1': moe_w1, 'moe_w3': moe_w3, 'moe_w2': moe_w2,
            'final_norm_g': final_norm_g}


def reference(x, c, ctx, c_ctx, ada_w, ada_b, norm1_g, norm2_g, w_in, attn_lambda, attn_subln_g,
              dn_conv_w, dn_a_log, dn_dt_bias, dn_norm_g, pool_w, pool_scale, w_branch, w_out,
              ffn_w1, ffn_w3, ffn_w2, router_w, moe_w1, moe_w3, moe_w2, final_norm_g):
    rows = x.shape[1] // GRID_W
    rope = _axial_rope_tables(rows)
    h_lat, h_ctx = x, ctx
    for l in range(DEPTH):
        ctx_out = l < DEPTH - 1
        lambda_init = 0.8 - 0.6 * math.exp(-0.3 * l)
        mod_lat = [m[:, None, :] for m in jnp.split(jax.nn.silu(c) @ ada_w[l] + ada_b[l], 6, axis=-1)]
        mod_ctx = jnp.split(jax.nn.silu(c_ctx) @ ada_w[l] + ada_b[l], 6, axis=-1)
        u_lat = _modulate(_rmsnorm(h_lat, norm1_g[l]), mod_lat[0], mod_lat[1])
        u_ctx = _modulate(_rmsnorm(h_ctx, norm1_g[l]), mod_ctx[0], mod_ctx[1])
        y_lat, y_ctx = _token_mixer(u_lat, u_ctx, w_in[l], attn_lambda[l], attn_subln_g[l], lambda_init,
                                    dn_conv_w[l], dn_a_log[l], dn_dt_bias[l], dn_norm_g[l], pool_w[l],
                                    pool_scale[l], w_branch[l], w_out[l], rope, ctx_out)
        h_lat = h_lat + mod_lat[2] * y_lat
        if ctx_out:
            h_ctx = h_ctx + mod_ctx[2] * y_ctx
        if l % 2 == 0:
            ffn = functools.partial(_swiglu, w1=ffn_w1[l // 2], w3=ffn_w3[l // 2], w2=ffn_w2[l // 2])
        else:
            ffn = functools.partial(_moe_swiglu, router_w=router_w[l // 2], w1=moe_w1[l // 2],
                                    w3=moe_w3[l // 2], w2=moe_w2[l // 2])
        h_lat = h_lat + mod_lat[5] * ffn(_modulate(_rmsnorm(h_lat, norm2_g[l]), mod_lat[3], mod_lat[4]))
        if ctx_out:
            h_ctx = h_ctx + mod_ctx[5] * ffn(_modulate(_rmsnorm(h_ctx, norm2_g[l]), mod_ctx[3], mod_ctx[4]))
    return _rmsnorm(h_lat, final_norm_g)
```

```cpp
#include <hip/hip_runtime.h>
#include <cstdio>
#include <cstdint>
#include <cmath>

namespace pg8 {
#define PG8_LAS __attribute__((address_space(3)))
typedef unsigned short bf16_t;
typedef short bf16x8 __attribute__((ext_vector_type(8)));
typedef float f32x4 __attribute__((ext_vector_type(4)));
typedef unsigned u32x4 __attribute__((ext_vector_type(4)));
typedef unsigned u32x2 __attribute__((ext_vector_type(2)));
constexpr int BM = 256, BK = 64, HALF = 128, HTB = HALF * BK * 2  , STAGE_BYTES = 8 * HTB;

__host__ __device__ __forceinline__ int lds_byte(int r, int c) { const int st = (r >> 4) * 2 + (c >> 5), rr = r & 15, cc = c & 31, ob = rr * 64 + cc * 2; return st * 1024 + (ob ^ (((ob >> 9) & 1) << 5)); }
__host__ __device__ __forceinline__ void stage_rc(int b, int& R, int& C) { const int st = b / 1024, sb = b % 1024, swz = sb ^ (((sb >> 9) & 1) << 5); R = (st >> 1) * 16 + swz / 64; C = (st & 1) * 32 + (swz % 64) / 2; }
__host__ __device__ __forceinline__ int perm32(int rho) { const int n = rho >> 4, i = rho & 15; return 8 * (i >> 2) + 4 * n + (i & 3); }

struct Unit { int pm, pn, pb; };
struct Gemm { const bf16_t* A; const bf16_t* Bt; int K, lda, ldb; };

__device__ __forceinline__ unsigned cvt_pk_bf16(float lo, float hi) { unsigned r; asm volatile("v_cvt_pk_bf16_f32 %0, %1, %2" : "=v"(r) : "v"(lo), "v"(hi)); return r; }
template <class Epi, class Sched, bool ALIGN_EPI = false, bool SP2 = false>
__device__ __forceinline__ void gemm_phase(PG8_LAS unsigned char* lds, const Gemm g, const Sched& S, const Epi& E) {
    int tid = threadIdx.x; asm volatile("" : "+v"(tid)); const int wid = __builtin_amdgcn_readfirstlane(tid >> 6), lane = tid & 63, wr = wid >> 2, wc = wid & 3, fr = lane & 15, fq = lane >> 4;
    const int K = g.K, nt = K / BK;
    unsigned voffA[2], voffB[2];
#pragma unroll
    for (int i = 0; i < 2; ++i) { int R, C; stage_rc(tid * 16 + i * 8192, R, C); const int Rb = Epi::PERM ? ((R & ~31) + perm32(R & 31)) : R;
        voffA[i] = (unsigned)(R * g.lda + C) * 2u; voffB[i] = (unsigned)(Rb * g.ldb + C) * 2u; }
    const size_t kstep = (size_t)(BK * 2);
    const size_t hstepA = (size_t)HALF * g.lda * 2, hstepB = (size_t)HALF * g.ldb * 2;
    const size_t tstepA = 2 * hstepA, tstepB = 2 * hstepB;
    const unsigned ldsw = (unsigned)wid * 1024u;
    const int aoff = lds_byte(wr * 64 + fr, fq * 8), boff = lds_byte(wc * 32 + fr, fq * 8);
#define PG8_SA(b, h) (((b) * 2 + (h)) * HTB)
#define PG8_SB(b, h) ((4 + (b) * 2 + (h)) * HTB)
#define PG8_STAGE(bufoff, gbase, voff) do { _Pragma("unroll") for (int _i = 0; _i < 2; ++_i) \
        __builtin_amdgcn_global_load_lds((const unsigned*)((const char*)(gbase) + (voff)[_i]), (PG8_LAS unsigned*)(lds + (bufoff) + ldsw + _i * 8192), 16, 0, 0); } while (0)
#define PG8_LDA(dst, b, h) do { _Pragma("unroll") for (int m = 0; m < 4; ++m) _Pragma("unroll") for (int k = 0; k < 2; ++k) dst[m][k] = *(const PG8_LAS bf16x8*)(lds + PG8_SA(b, h) + aoff + m * 2048 + k * 1024); } while (0)
#define PG8_LDB(dst, b, h) do { _Pragma("unroll") for (int n = 0; n < 2; ++n) _Pragma("unroll") for (int k = 0; k < 2; ++k) dst[n][k] = *(const PG8_LAS bf16x8*)(lds + PG8_SB(b, h) + boff + n * 2048 + k * 1024); } while (0)
#define PG8_MMA(ai, bj, At, Bt) do { __builtin_amdgcn_s_setprio(1); _Pragma("unroll") for (int m = 0; m < 4; ++m) _Pragma("unroll") for (int n = 0; n < 2; ++n) _Pragma("unroll") for (int k = 0; k < 2; ++k) \
        acc[ai][bj][m][n] = __builtin_amdgcn_mfma_f32_16x16x32_bf16(Bt[n][k], At[m][k], acc[ai][bj][m][n], 0, 0, 0); __builtin_amdgcn_s_setprio(0); } while (0)
#define PG8_WAIT_V(n) asm volatile("s_waitcnt vmcnt(" #n ")" ::: "memory")
#define PG8_WAIT_L(n) asm volatile("s_waitcnt lgkmcnt(" #n ")" ::: "memory")
#define PG8_BAR __builtin_amdgcn_s_barrier()
#define PG8_SCHED __builtin_amdgcn_sched_barrier(0)
    Unit cur, nxt; int ui = 0;
    if (!S.next(0, cur)) return;
    f32x4 acc[2][2][4][2];
#pragma unroll
    for (int a = 0; a < 2; ++a)
#pragma unroll
        for (int b = 0; b < 2; ++b)
#pragma unroll
            for (int m = 0; m < 4; ++m)
#pragma unroll
                for (int n = 0; n < 2; ++n) acc[a][b][m][n] = (f32x4){0.f, 0.f, 0.f, 0.f};
    bf16x8 At[4][2], B0[2][2], B1[2][2];
    const char* cA = (const char*)g.A + (size_t)cur.pm * tstepA; const char* cB = (const char*)g.Bt + (size_t)cur.pb * tstepB;
    S.a_ready(cur);
    if constexpr (SP2) {
        PG8_STAGE(PG8_SB(0, 0), cB, voffB); PG8_STAGE(PG8_SB(0, 1), cB + hstepB, voffB); PG8_STAGE(PG8_SA(0, 0), cA, voffA); PG8_STAGE(PG8_SA(0, 1), cA + hstepA, voffA);
        if (wr == 1) PG8_BAR;
        PG8_WAIT_V(2); PG8_BAR;
        PG8_STAGE(PG8_SB(1, 0), cB + kstep, voffB); PG8_STAGE(PG8_SA(1, 0), cA + kstep, voffA); PG8_STAGE(PG8_SB(1, 1), cB + hstepB + kstep, voffB);
        PG8_WAIT_V(6); PG8_BAR;
    } else {
        PG8_STAGE(PG8_SB(0, 0), cB, voffB); PG8_STAGE(PG8_SA(0, 0), cA, voffA); PG8_STAGE(PG8_SB(0, 1), cB + hstepB, voffB); PG8_STAGE(PG8_SA(0, 1), cA + hstepA, voffA);
        if (wr == 1) PG8_BAR;
        PG8_WAIT_V(4); PG8_BAR;
        PG8_STAGE(PG8_SB(1, 0), cB + kstep, voffB); PG8_STAGE(PG8_SA(1, 0), cA + kstep, voffA); PG8_STAGE(PG8_SB(1, 1), cB + hstepB + kstep, voffB);
        PG8_WAIT_V(6); PG8_BAR;
    }
    for (;;) {
        const bool has_next = S.next(ui + 1, nxt);
        const char* nA = has_next ? (const char*)g.A + (size_t)nxt.pm * tstepA : cA; const char* nB = has_next ? (const char*)g.Bt + (size_t)nxt.pb * tstepB : cB;
        for (int t = 0; t < nt; t += 2) {
            const bool last = (t == nt - 2);
            const char* a1 = cA + (size_t)(t + 1) * kstep;
            const char* a2 = last ? nA : cA + (size_t)(t + 2) * kstep; const char* b2 = last ? nB : cB + (size_t)(t + 2) * kstep;
            const char* a3 = a2 + kstep; const char* b3 = b2 + kstep;
            if (last && has_next) S.a_ready(nxt);
            if constexpr (SP2) {
            PG8_LDB(B0, 0, 0); PG8_LDB(B1, 0, 1); PG8_SCHED; PG8_LDA(At, 0, 0); PG8_STAGE(PG8_SA(1, 1), a1 + hstepA, voffA);
            PG8_WAIT_V(8); PG8_WAIT_L(0); PG8_BAR; PG8_MMA(0, 0, At, B0); PG8_MMA(0, 1, At, B1); PG8_BAR; PG8_SCHED;
            PG8_LDA(At, 0, 1); PG8_STAGE(PG8_SB(0, 0), b2, voffB); PG8_STAGE(PG8_SB(0, 1), b2 + hstepB, voffB); PG8_STAGE(PG8_SA(0, 0), a2, voffA);
            PG8_WAIT_V(8); PG8_WAIT_L(0); PG8_BAR; PG8_MMA(1, 0, At, B0); PG8_MMA(1, 1, At, B1); PG8_BAR; PG8_SCHED;
            PG8_LDB(B0, 1, 0); PG8_LDB(B1, 1, 1); PG8_SCHED; PG8_LDA(At, 1, 0); PG8_STAGE(PG8_SA(0, 1), a2 + hstepA, voffA);
            PG8_WAIT_V(8); PG8_WAIT_L(0); PG8_BAR; PG8_MMA(0, 0, At, B0); PG8_MMA(0, 1, At, B1); PG8_BAR; PG8_SCHED;
            PG8_LDA(At, 1, 1); PG8_STAGE(PG8_SB(1, 0), b3, voffB); PG8_STAGE(PG8_SB(1, 1), b3 + hstepB, voffB); PG8_STAGE(PG8_SA(1, 0), a3, voffA);
            PG8_WAIT_V(8); PG8_WAIT_L(0); PG8_BAR; PG8_MMA(1, 0, At, B0); PG8_MMA(1, 1, At, B1); PG8_BAR; PG8_SCHED;
            } else {
            PG8_LDB(B0, 0, 0); PG8_SCHED; PG8_LDA(At, 0, 0); PG8_STAGE(PG8_SA(1, 1), a1 + hstepA, voffA);
            PG8_WAIT_L(8); PG8_BAR; PG8_WAIT_L(0); PG8_MMA(0, 0, At, B0); PG8_BAR; PG8_SCHED;
            PG8_LDB(B1, 0, 1); PG8_STAGE(PG8_SB(0, 0), b2, voffB);
            PG8_BAR; PG8_WAIT_L(0); PG8_MMA(0, 1, At, B1); PG8_BAR;
            PG8_LDA(At, 0, 1); PG8_STAGE(PG8_SA(0, 0), a2, voffA);
            PG8_BAR; PG8_WAIT_L(0); PG8_MMA(1, 0, At, B0); PG8_BAR; PG8_SCHED;
            PG8_STAGE(PG8_SB(0, 1), b2 + hstepB, voffB);
            PG8_WAIT_V(6); PG8_BAR; PG8_MMA(1, 1, At, B1); PG8_BAR;
            PG8_LDB(B0, 1, 0); PG8_SCHED; PG8_LDA(At, 1, 0); PG8_STAGE(PG8_SA(0, 1), a2 + hstepA, voffA);
            PG8_WAIT_L(8); PG8_BAR; PG8_WAIT_L(0); PG8_MMA(0, 0, At, B0); PG8_BAR; PG8_SCHED;
            PG8_LDB(B1, 1, 1); PG8_STAGE(PG8_SB(1, 0), b3, voffB);
            PG8_BAR; PG8_WAIT_L(0); PG8_MMA(0, 1, At, B1); PG8_BAR;
            PG8_LDA(At, 1, 1); PG8_STAGE(PG8_SA(1, 0), a3, voffA);
            PG8_BAR; PG8_WAIT_L(0); PG8_MMA(1, 0, At, B0); PG8_BAR; PG8_SCHED;
            PG8_STAGE(PG8_SB(1, 1), b3 + hstepB, voffB);
            PG8_WAIT_V(6); PG8_BAR; PG8_MMA(1, 1, At, B1); PG8_BAR;
            }
        }
        if constexpr (ALIGN_EPI) { if (wr == 0) PG8_BAR; }
        if constexpr (!Epi::AFTER_DRAIN) { E(acc, cur, wr, wc, fr, fq); S.done(cur); }
        if (!has_next) break;
#pragma unroll
        for (int a = 0; a < 2; ++a)
#pragma unroll
            for (int b = 0; b < 2; ++b)
#pragma unroll
                for (int m = 0; m < 4; ++m)
#pragma unroll
                    for (int n = 0; n < 2; ++n) acc[a][b][m][n] = (f32x4){0.f, 0.f, 0.f, 0.f};
        cur = nxt; cA = nA; cB = nB; ++ui;
        if constexpr (ALIGN_EPI) { if (wr == 1) PG8_BAR; }
    }
    PG8_WAIT_V(0);
    if constexpr (!ALIGN_EPI) { if (wr == 0) PG8_BAR; }
    PG8_BAR;
    if constexpr (Epi::AFTER_DRAIN) { E.fused(acc, cur, wr, wc, fr, fq, lds, wid, lane); S.done(cur); }
#undef PG8_SA
#undef PG8_SB
#undef PG8_STAGE
#undef PG8_LDA
#undef PG8_LDB
#undef PG8_MMA
#undef PG8_WAIT_V
#undef PG8_WAIT_L
#undef PG8_BAR
#undef PG8_SCHED
}
}

namespace attn {
using bf16x8 = __attribute__((ext_vector_type(8))) short;
using s16x4  = __attribute__((ext_vector_type(4))) short;
using f32x16 = __attribute__((ext_vector_type(16))) float;
using u32x4  = __attribute__((ext_vector_type(4))) unsigned;
constexpr int DV = 128, DK = 64, NW = 8, QBLK = 32, KVBLK = 64;
constexpr float SCALE = 0.125f;
constexpr float THR = 4.f;
constexpr size_t SHM_V = KVBLK * DV * 2, SHM_K = KVBLK * DK * 2, SHM_ATTN = 2 * SHM_V + 2 * SHM_K + NW * 64 * 4;
#define AKSWZ(row, colB) ((row) * 128 + ((colB) ^ ((((row) >> 1) & 7) << 4)))
#define ASBAR() __builtin_amdgcn_sched_barrier(0)
__device__ __forceinline__ int crow(int r, int hi) { return (r & 3) + 8 * (r >> 2) + 4 * hi; }
__device__ __forceinline__ unsigned cvtpk(float lo, float hi) { unsigned r; asm volatile("v_cvt_pk_bf16_f32 %0, %1, %2" : "=v"(r) : "v"(lo), "v"(hi)); return r; }

__device__ __forceinline__ void partialSM(f32x16& p0, f32x16& p1, float& m_reg, float& mn, float& alpha) {
  constexpr float C = SCALE * 1.4426950408889634f;
  float pmax = p0[0];
#pragma unroll
  for (int r = 1; r < 16; ++r) pmax = fmaxf(pmax, p0[r]);
#pragma unroll
  for (int r = 0; r < 16; ++r) pmax = fmaxf(pmax, p1[r]);
  { auto rr = __builtin_amdgcn_permlane32_swap(__float_as_uint(pmax), __float_as_uint(pmax), false, false);
    pmax = fmaxf(__uint_as_float(rr[0]), __uint_as_float(rr[1])); }
  if (__builtin_expect(__all(pmax - m_reg <= THR / SCALE), 1)) { mn = m_reg; alpha = 1.f; }
  else { mn = fmaxf(m_reg, pmax); alpha = __builtin_amdgcn_exp2f((m_reg - mn) * C); m_reg = mn; }
  const float mnC = -mn * C;
#pragma unroll
  for (int r = 0; r < 16; ++r) p0[r] = fmaf(p0[r], C, mnC);
#pragma unroll
  for (int r = 0; r < 16; ++r) p1[r] = fmaf(p1[r], C, mnC);
#pragma unroll
  for (int r = 0; r < 16; ++r) p0[r] = __builtin_amdgcn_exp2f(p0[r]);
}
__device__ __forceinline__ void finishSM(f32x16& p0, f32x16& p1, float alpha, float& l_reg, bf16x8& pa0, bf16x8& pa1, bf16x8& pa2, bf16x8& pa3) {
#pragma unroll
  for (int r = 0; r < 16; ++r) p1[r] = __builtin_amdgcn_exp2f(p1[r]);
  float ps = 0;
#pragma unroll
  for (int r = 0; r < 16; ++r) ps += p0[r];
#pragma unroll
  for (int r = 0; r < 16; ++r) ps += p1[r];
  { auto rr = __builtin_amdgcn_permlane32_swap(__float_as_uint(ps), __float_as_uint(ps), false, false);
    ps = __uint_as_float(rr[0]) + __uint_as_float(rr[1]); }
  l_reg = l_reg * alpha + ps;
#define APK4(P, BASE, OUT) do { unsigned a0 = cvtpk(P[BASE + 0], P[BASE + 1]), a1 = cvtpk(P[BASE + 2], P[BASE + 3]);   \
    unsigned b0 = cvtpk(P[BASE + 4], P[BASE + 5]), b1 = cvtpk(P[BASE + 6], P[BASE + 7]);                              \
    auto r0 = __builtin_amdgcn_permlane32_swap(a0, b0, false, false); auto r1 = __builtin_amdgcn_permlane32_swap(a1, b1, false, false); \
    u32x4 w = {r0[0], r1[0], r0[1], r1[1]}; OUT = *reinterpret_cast<bf16x8*>(&w); } while (0)
  APK4(p0, 0, pa0); APK4(p0, 8, pa1); APK4(p1, 0, pa2); APK4(p1, 8, pa3);
#undef APK4
}
__device__ __forceinline__ void qkt(f32x16& p0, f32x16& p1, const char* Ks, const bf16x8* qr, int r32, int hi) {
  p0 = f32x16{}; p1 = f32x16{};
#pragma unroll
  for (int d0 = 0; d0 < 4; ++d0) { const int cb = (d0 * 16 + hi * 8) * 2;
    bf16x8 b0 = *reinterpret_cast<const bf16x8*>(Ks + AKSWZ(r32, cb));
    bf16x8 b1 = *reinterpret_cast<const bf16x8*>(Ks + AKSWZ(32 + r32, cb));
    p0 = __builtin_amdgcn_mfma_f32_32x32x16_bf16(b0, qr[d0], p0, 0, 0, 0);
    p1 = __builtin_amdgcn_mfma_f32_32x32x16_bf16(b1, qr[d0], p1, 0, 0, 0); }
}
__device__ __forceinline__ int v_st(int k, int c) { const int kk = (k & ~0xC) | ((k & 4) << 1) | ((k & 8) >> 1); return ((kk >> 3) * 4 + (c >> 5)) * 512 + ((kk & 7) * 32 + (c & 31)) * 2; }
__device__ __forceinline__ int v_rd_base(int lane) { return ((lane & 3) << 3) | (((lane >> 2) & 3) << 6) | (((lane >> 4) & 1) << 5) | (((lane >> 5) & 1) << 8); }
constexpr int v_rd_off(int d0, int ks, int half) { return d0 * 512 + ks * 4096 + half * 2048; }
template <int OFF> __device__ __forceinline__ s16x4 tr_read(int vb) {
  s16x4 r; asm volatile("ds_read_b64_tr_b16 %0, %1 offset:%2" : "=&v"(r) : "v"(vb), "i"(OFF) : "memory"); return r;
}
template <int D0> __device__ __forceinline__ void pv_one(f32x16& od, int vb, bf16x8 pa0, bf16x8 pa1, bf16x8 pa2, bf16x8 pa3) {
  const s16x4 l0 = tr_read<v_rd_off(D0, 0, 0)>(vb), h0 = tr_read<v_rd_off(D0, 0, 1)>(vb), l1 = tr_read<v_rd_off(D0, 1, 0)>(vb), h1 = tr_read<v_rd_off(D0, 1, 1)>(vb);
  const s16x4 l2 = tr_read<v_rd_off(D0, 2, 0)>(vb), h2 = tr_read<v_rd_off(D0, 2, 1)>(vb), l3 = tr_read<v_rd_off(D0, 3, 0)>(vb), h3 = tr_read<v_rd_off(D0, 3, 1)>(vb);
  asm volatile("s_waitcnt lgkmcnt(0)" ::: "memory"); ASBAR();
#define APK(L, H) (bf16x8){L[0], L[1], L[2], L[3], H[0], H[1], H[2], H[3]}
  od = __builtin_amdgcn_mfma_f32_32x32x16_bf16(pa0, APK(l0, h0), od, 0, 0, 0);
  od = __builtin_amdgcn_mfma_f32_32x32x16_bf16(pa1, APK(l1, h1), od, 0, 0, 0);
  od = __builtin_amdgcn_mfma_f32_32x32x16_bf16(pa2, APK(l2, h2), od, 0, 0, 0);
  od = __builtin_amdgcn_mfma_f32_32x32x16_bf16(pa3, APK(l3, h3), od, 0, 0, 0);
#undef APK
}
__device__ __forceinline__ void pv_d0(f32x16* o, int vb, bf16x8 pa0, bf16x8 pa1, bf16x8 pa2, bf16x8 pa3) {
  pv_one<0>(o[0], vb, pa0, pa1, pa2, pa3); pv_one<1>(o[1], vb, pa0, pa1, pa2, pa3); pv_one<2>(o[2], vb, pa0, pa1, pa2, pa3); pv_one<3>(o[3], vb, pa0, pa1, pa2, pa3);
}
template <int LDQ, int LDO>
__device__ __forceinline__ void attn_unit(const unsigned short* __restrict__ Qb, const unsigned short* __restrict__ Kh, const unsigned short* __restrict__ Vh,
                                          unsigned short* __restrict__ Ob, int seq, char* lds) {
  int tid = threadIdx.x; asm volatile("" : "+v"(tid)); const int wid = tid >> 6, lane = tid & 63, r32 = lane & 31, hi = lane >> 5;
  char* V_lds = lds; char* K_lds = lds + 2 * SHM_V;
  float* ws = (float*)(lds + 2 * SHM_V + 2 * SHM_K) + wid * 64; float* li_l = ws; float* al_l = ws + 32;
  float m_reg = -1e30f, l_reg = 0; f32x16 o[4] = {}; bf16x8 qr[4];
  const unsigned short* Qw = Qb + (long)(wid * QBLK + r32) * LDQ + hi * 8;
#pragma unroll
  for (int d0 = 0; d0 < 4; ++d0) qr[d0] = *reinterpret_cast<const bf16x8*>(Qw + d0 * 16);
  const int sr = tid >> 4, sc = (tid & 15) * 8, vst0 = v_st(sr, sc), vst1 = v_st(32 + sr, sc);
  const int kr = tid >> 3, kc = (tid & 7) * 8, kst = AKSWZ(kr, kc * 2);
  const int vb0 = (int)(uintptr_t)V_lds + v_rd_base(lane);
  bf16x8 sv0[2], sv1[2], sk0[2];
#define ASLOAD(i, k0) do { sv0[i] = *reinterpret_cast<const bf16x8*>(&Vh[(long)((k0) + sr) * LDQ + sc]); sv1[i] = *reinterpret_cast<const bf16x8*>(&Vh[(long)((k0) + 32 + sr) * LDQ + sc]); \
    sk0[i] = *reinterpret_cast<const bf16x8*>(&Kh[(long)((k0) + kr) * LDQ + kc]); } while (0)
#define ASWRITE(b, i) do { *(bf16x8*)(V_lds + (b) * SHM_V + vst0) = sv0[i]; *(bf16x8*)(V_lds + (b) * SHM_V + vst1) = sv1[i]; \
    *(bf16x8*)(K_lds + (b) * SHM_K + kst) = sk0[i]; } while (0)
#define ASWAIT() asm volatile("s_waitcnt vmcnt(3)" ::: "memory")
#define ARESC(a) do { if (__any((a) < 1.f)) { if (hi == 0) al_l[r32] = (a); asm volatile("s_waitcnt lgkmcnt(0)" ::: "memory"); \
    _Pragma("unroll") for (int d = 0; d < 4; ++d) _Pragma("unroll") for (int r = 0; r < 16; ++r) o[d][r] *= al_l[crow(r, hi)]; } } while (0)
  f32x16 pA0, pA1, pB0, pB1; float mnA, mnB, alA, alB; bf16x8 pa0, pa1, pa2, pa3; const int NT = seq / KVBLK;
  ASLOAD(0, 0); asm volatile("s_waitcnt vmcnt(0)" ::: "memory"); ASWRITE(0, 0); __syncthreads();
  qkt(pA0, pA1, K_lds, qr, r32, hi); partialSM(pA0, pA1, m_reg, mnA, alA);
  ASLOAD(1, KVBLK); if (2 < NT) ASLOAD(0, 2 * KVBLK);
  if (2 < NT) ASWAIT(); else asm volatile("s_waitcnt vmcnt(0)" ::: "memory");
  ASWRITE(1, 1); __syncthreads();
  for (int j = 1; j + 1 < NT; j += 2) {
    ASBAR(); qkt(pB0, pB1, K_lds + SHM_K, qr, r32, hi);
    finishSM(pA0, pA1, alA, l_reg, pa0, pa1, pa2, pa3); ASBAR();
    ASLOAD(1, (j + 2) * KVBLK); ASBAR();
    pv_d0(o, vb0, pa0, pa1, pa2, pa3); partialSM(pB0, pB1, m_reg, mnB, alB);
    __syncthreads(); ASWAIT(); ASWRITE(0, 0);
    ARESC(alB); __syncthreads();
    ASBAR(); qkt(pA0, pA1, K_lds, qr, r32, hi);
    finishSM(pB0, pB1, alB, l_reg, pa0, pa1, pa2, pa3); ASBAR();
    if (j + 3 < NT) ASLOAD(0, (j + 3) * KVBLK); ASBAR();
    pv_d0(o, vb0 + (int)SHM_V, pa0, pa1, pa2, pa3); partialSM(pA0, pA1, m_reg, mnA, alA);
    __syncthreads(); if (j + 3 < NT) ASWAIT(); else asm volatile("s_waitcnt vmcnt(0)" ::: "memory");
    ASWRITE(1, 1);
    ARESC(alA); __syncthreads();
  }
  ASBAR(); qkt(pB0, pB1, K_lds + SHM_K, qr, r32, hi);
  finishSM(pA0, pA1, alA, l_reg, pa0, pa1, pa2, pa3); ASBAR();
  pv_d0(o, vb0, pa0, pa1, pa2, pa3); partialSM(pB0, pB1, m_reg, mnB, alB);
  __syncthreads(); ARESC(alB);
  finishSM(pB0, pB1, alB, l_reg, pa0, pa1, pa2, pa3); ASBAR();
  pv_d0(o, vb0 + (int)SHM_V, pa0, pa1, pa2, pa3);
  if (hi == 0) li_l[r32] = l_reg; asm volatile("s_waitcnt lgkmcnt(0)" ::: "memory");
  float rli[16];
#pragma unroll
  for (int r = 0; r < 16; ++r) rli[r] = __builtin_amdgcn_rcpf(li_l[crow(r, hi)]);
  unsigned short* Ow = Ob + (long)(wid * QBLK) * LDO;
#pragma unroll
  for (int r = 0; r < 16; ++r) { const int orow = crow(r, hi);
#pragma unroll
    for (int d0 = 0; d0 < 4; ++d0) { const float v = o[d0][r] * rli[r]; Ow[(long)orow * LDO + d0 * 32 + r32] = (unsigned short)(cvtpk(v, v) & 0xffffu); } }
  __syncthreads();
#undef ASLOAD
#undef ASWRITE
#undef ASWAIT
#undef ARESC
}
}

constexpr int NWAVES = 8, NTHR = NWAVES * 64;
constexpr int DM = 1024, NB = 4, SEQ = 4096, CTXL = 256, RPB = CTXL + SEQ  , MROWS = NB * RPB  ;
constexpr int INW = 5904, NPROJ = 6144;
constexpr int FFD = 2816, FFE = 3584, NEXP = 8, FFEH = FFE / 2;
constexpr int NCHUNK = RPB / 64;
constexpr float EPSN = 1e-6f;
constexpr int PC_AQ = 0, PC_AK = 512, PC_AV = 1024, PC_DQ = 1536, PC_DK = 1792, PC_DV = 2048, PC_DZ = 2304, PC_POOL = 2560, PC_GATE = 2816, PC_AB = 5888;

constexpr size_t MiB = 1u << 20;
constexpr size_t WS_CTL = 0, CTL_ZERO_BYTES = 2 * MiB;
constexpr size_t WS_MOD = 1 * MiB;
constexpr size_t WS_ROPE = 2 * MiB;
constexpr size_t WS_LAM = 2 * MiB + 65536;
constexpr size_t WS_ROUTE = 3 * MiB;
constexpr size_t WS_GB = 4 * MiB;
constexpr size_t WS_WIN = 8 * MiB;
constexpr size_t WS_WBR = 32 * MiB;
constexpr size_t WS_WOUT = 36 * MiB;
constexpr size_t WS_W13 = 40 * MiB;
constexpr size_t WS_W2 = 51 * MiB;
constexpr size_t WS_H = 58 * MiB;
constexpr size_t WS_U = 126 * MiB;
constexpr size_t WS_ATTO = WS_U;
constexpr size_t WS_PROJ = 160 * MiB;
constexpr size_t WS_MIX = 364 * MiB;
constexpr size_t WS_DNP = 398 * MiB;
constexpr size_t WS_MG = WS_DNP;
constexpr size_t WS_DNG = 466 * MiB;
constexpr size_t WS_DNO = 467 * MiB;
constexpr size_t WS_HID = WS_PROJ;
constexpr int MOE_MAXT = 136;
constexpr size_t WS_XG = 160 * MiB;
constexpr size_t WS_Y = 228 * MiB;
constexpr size_t WS_W13M = 296 * MiB;
constexpr size_t WS_W2M = 352 * MiB;
constexpr size_t WS_HIDM = 380 * MiB;
constexpr size_t WS_END = 500 * MiB;
static_assert(WS_HIDM + (size_t)MOE_MAXT * 256 * FFEH * 2 <= WS_END && WS_DNO + (size_t)2 * MROWS * 256 * 2 <= WS_END, "ws map");
static_assert(WS_WIN + (size_t)2 * NPROJ * 1024 * 2 <= WS_WBR && WS_W13 + (size_t)2 * FFD * 1024 * 2 <= WS_W2 && WS_W2 + (size_t)1024 * FFD * 2 <= WS_H, "ws map (weights)");
static_assert(WS_H + (size_t)MROWS * 1024 * 4 <= WS_U && WS_U + (size_t)MROWS * 1024 * 2 <= WS_PROJ && WS_PROJ + (size_t)MROWS * NPROJ * 2 <= WS_MIX, "ws map (acts)");
static_assert(WS_MIX + (size_t)MROWS * 1024 * 2 <= WS_DNP && WS_DNP + (size_t)NB * NCHUNK * 4 * 2 * 32768 <= WS_DNG, "ws map (dn)");
static_assert(WS_XG + (size_t)MOE_MAXT * 256 * 1024 * 2 <= WS_Y && WS_Y + (size_t)MOE_MAXT * 256 * 1024 * 2 <= WS_W13M && WS_W13M + (size_t)8 * FFE * 1024 * 2 <= WS_W2M && WS_W2M + (size_t)8 * 1024 * FFEH * 2 <= WS_HIDM, "ws map (moe)");
constexpr int CW_TMO = 0, CW_CODE = 1;
constexpr int CW_BAR = 4096;
constexpr int CW_ECNT = 8192;

constexpr int RING_BYTES = 155648;
constexpr int MISC_OFF = RING_BYTES;
constexpr int LDS_BYTES = RING_BYTES + 1024;

enum { PH_PRO = 0, PH_L0 = 1, PH_N1 = 0, PH_PROJ = 1, PH_ATT = 2, PH_SCAN = 3, PH_MIXB = 4, PH_MRG0 = 5, PH_MRG1 = 6, PH_MRG2 = 7, PH_OUT = 8, PH_N2 = 9, PH_LAYER = 10,
       PH_FUP = 11, PH_FDN = 12, PH_L1 = 13, PH_GATH = 23, PH_CV0 = 24, PH_UP0 = 25, PH_DN0 = 26, PH_CV1 = 27, PH_UP1 = 28, PH_DN1 = 29, PH_FIN = 30, PH_COUNT = 31 };

#define GAS __attribute__((address_space(1)))
#define LAS __attribute__((address_space(3)))
typedef unsigned short bf16;
typedef unsigned v4u __attribute__((ext_vector_type(4)));
typedef unsigned v2u __attribute__((ext_vector_type(2)));
typedef float f32x4 __attribute__((ext_vector_type(4)));
typedef GAS unsigned gu32;
#define RLX_AGENT __ATOMIC_RELAXED, __HIP_MEMORY_SCOPE_AGENT
#define LDS_WAIT() asm volatile("s_waitcnt lgkmcnt(0)" ::: "memory")
#define VM_WAIT() asm volatile("s_waitcnt vmcnt(0)" ::: "memory")
__device__ __forceinline__ unsigned f2bf(float f) { unsigned u = __builtin_bit_cast(unsigned, f); return (u + 0x7fffu + ((u >> 16) & 1u)) >> 16; }
__device__ __forceinline__ unsigned pk2(float lo, float hi) { return f2bf(lo) | (f2bf(hi) << 16); }
__device__ __forceinline__ float bf_lo(unsigned w) { return __builtin_bit_cast(float, w << 16); }
__device__ __forceinline__ float bf_hi(unsigned w) { return __builtin_bit_cast(float, w & 0xffff0000u); }
__device__ __forceinline__ float bf2f(bf16 v) { return __builtin_bit_cast(float, (unsigned)v << 16); }
__device__ __forceinline__ float sigmoidf_(float x) { return 1.f / (1.f + __expf(-x)); }
__device__ __forceinline__ float siluf_(float x) { return x / (1.f + __expf(-x)); }
__device__ __forceinline__ float wave_sum(float v) {
#pragma unroll
    for (int o = 1; o < 64; o <<= 1) v += __shfl_xor(v, o);
    return v;
}
#define XB_TMO      128
#define XB_XCNT(j)  (256  + 64 * (j))
#define XB_XSUB(j)  (1280 + 64 * (j))
#define XB_XGEN(j)  (2304 + 64 * (j))
#define XB_TOP      3328
#define XB_TOPGEN   3392
#define XCD_BAR_WORDS 3456
#define XB_SPIN_CAP (1u << 18)

__device__ __forceinline__ unsigned xb_ld(unsigned* p)              { return __hip_atomic_load(p, __ATOMIC_RELAXED, __HIP_MEMORY_SCOPE_AGENT); }
__device__ __forceinline__ unsigned xb_add(unsigned* p, unsigned v) { return __hip_atomic_fetch_add(p, v, __ATOMIC_RELAXED, __HIP_MEMORY_SCOPE_AGENT); }
__device__ __forceinline__ unsigned xb_xcc_id() { return (unsigned)__builtin_amdgcn_s_getreg((3 << 11) | 20) & 0xFu; }
#define XB_SPIN(cond, bar) do { unsigned _sp = 0; while (cond) { __builtin_amdgcn_s_sleep(1); \
    if ((++_sp & 255u) == 0u) { if (xb_ld(&(bar)[XB_TMO])) break; if (_sp > XB_SPIN_CAP) { atomicAdd(&(bar)[XB_TMO], 1u); break; } } } } while (0)

struct XcdBarrier {
    unsigned* bar; unsigned x;
    volatile LAS unsigned* st;
};

__device__ __forceinline__ XcdBarrier xcd_barrier_post(unsigned* bar, volatile LAS unsigned* st) {
    XcdBarrier b; b.bar = bar; b.x = xb_xcc_id(); b.st = st;
    if (threadIdx.x == 0) (void)xb_add(&bar[XB_XCNT(b.x)], 1u);
    return b;
}
__device__ __forceinline__ void xcd_barrier_complete(unsigned* bar, unsigned x, unsigned& nloc, unsigned& nx) {
    const unsigned G = gridDim.x * gridDim.y * gridDim.z;
    unsigned sum, cnt, mine, sp = 0u;
    for (;;) {
        sum = 0u; cnt = 0u; mine = 0u;
#pragma unroll
        for (unsigned j = 0; j < 16; ++j) { const unsigned c = xb_ld(&bar[XB_XCNT(j)]); sum += c; cnt += (c > 0u) ? 1u : 0u; mine = (j == x) ? c : mine; }
        if (sum == G) break;
        __builtin_amdgcn_s_sleep(1);
        if ((++sp & 255u) == 0u) { if (xb_ld(&bar[XB_TMO])) break; if (sp > XB_SPIN_CAP) { atomicAdd(&bar[XB_TMO], 1u); break; } }
    }
    nloc = mine > 0u ? mine : 1u; nx = cnt > 0u ? cnt : 1u;
}

__device__ __forceinline__ void xcd_barrier(const XcdBarrier& b) {
    asm volatile("s_waitcnt vmcnt(0)" ::: "memory");
    __syncthreads();
    if (threadIdx.x == 0) {
        unsigned* bar = b.bar;
        __builtin_amdgcn_s_waitcnt(0);
        unsigned nloc = b.st[0], nx = b.st[1];
        if (nloc == 0u) { xcd_barrier_complete(bar, b.x, nloc, nx); b.st[0] = nloc; b.st[1] = nx; }
        const unsigned old = xb_add(&bar[XB_XSUB(b.x)], 1u);
        const unsigned gen = old / nloc;
        if (old + 1u == (gen + 1u) * nloc) {
            __builtin_amdgcn_fence(__ATOMIC_RELEASE, "agent");
            asm volatile("s_waitcnt vmcnt(0)" ::: "memory");
            const unsigned og = xb_add(&bar[XB_TOP], 1u);
            const unsigned tg = og / nx;
            if (og + 1u == (tg + 1u) * nx) xb_add(&bar[XB_TOPGEN], 1u);
            else XB_SPIN(xb_ld(&bar[XB_TOPGEN]) == tg, bar);
            __builtin_amdgcn_fence(__ATOMIC_ACQUIRE, "agent");
            xb_add(&bar[XB_XGEN(b.x)], 1u);
            asm volatile("s_waitcnt vmcnt(0)" ::: "memory");
        } else {
            XB_SPIN(xb_ld(&bar[XB_XGEN(b.x)]) == gen, bar);
            __builtin_amdgcn_fence(__ATOMIC_ACQUIRE, "agent");
            asm volatile("s_waitcnt vmcnt(0)" ::: "memory");
        }
    }
    __syncthreads();
}

struct Frame {
    LAS unsigned char* lds;
    volatile LAS unsigned* MISC;
    gu32* ctl;
    int tid, lane, wave, vcu, G, zz;
    unsigned char* ws;
    float* out;
};
struct Args { const float* in[27]; float* out; unsigned char* ws; int ph_lo, ph_hi; };

struct TileOrder {
    int nM, nN, nwg, G, c, skip;
    __device__ __forceinline__ void init(int nM_, int nN_, int G_, int c_, int skip_) { nM = nM_; nN = nN_; nwg = nM * nN; G = G_; c = c_; skip = skip_; }
    __device__ __forceinline__ bool next(int i, pg8::Unit& u) const {
        const long L = (long)i * G + c; if (L >= nwg) return false;
        int wgid = (int)L; { const int q = nwg / 8, r = nwg % 8, xcd = wgid % 8, off = wgid / 8; wgid = (xcd < r ? xcd * (q + 1) : r * (q + 1) + (xcd - r) * q) + off; }
        const int nig = 8 * nN, gid = wgid / nig, fm = gid * 8, gsz = (nM - fm) < 8 ? (nM - fm) : 8;
        int pm = fm + ((wgid % nig) % gsz); const int pn = (wgid % nig) / gsz;
        if (skip) pm = (pm >> 4) * 17 + 1 + (pm & 15);
        u.pm = pm; u.pn = pn; u.pb = pn; return true;
    }
    __device__ __forceinline__ void a_ready(const pg8::Unit&) const {}
    __device__ __forceinline__ void done(const pg8::Unit&) const {}
};
struct MoeOrder {
    int t1, t2, t3, t4, t5, t6, t7, t8, nN, G, c;
    __device__ __forceinline__ void init(const gu32* cnt, int nN_, int G_, int c_) {
        int t = 0;
        t += ((int)__hip_atomic_load(cnt + 0 * 64, RLX_AGENT) + 255) >> 8; t1 = t; t += ((int)__hip_atomic_load(cnt + 1 * 64, RLX_AGENT) + 255) >> 8; t2 = t;
        t += ((int)__hip_atomic_load(cnt + 2 * 64, RLX_AGENT) + 255) >> 8; t3 = t; t += ((int)__hip_atomic_load(cnt + 3 * 64, RLX_AGENT) + 255) >> 8; t4 = t;
        t += ((int)__hip_atomic_load(cnt + 4 * 64, RLX_AGENT) + 255) >> 8; t5 = t; t += ((int)__hip_atomic_load(cnt + 5 * 64, RLX_AGENT) + 255) >> 8; t6 = t;
        t += ((int)__hip_atomic_load(cnt + 6 * 64, RLX_AGENT) + 255) >> 8; t7 = t; t += ((int)__hip_atomic_load(cnt + 7 * 64, RLX_AGENT) + 255) >> 8; t8 = t;
        nN = nN_; G = G_; c = c_;
    }
    __device__ __forceinline__ int tile_off(int e) const { return e == 0 ? 0 : e == 1 ? t1 : e == 2 ? t2 : e == 3 ? t3 : e == 4 ? t4 : e == 5 ? t5 : e == 6 ? t6 : t7; }
    __device__ __forceinline__ bool next(int i, pg8::Unit& u) const {
        const long L = (long)i * G + c; if (L >= (long)t8 * nN) return false;
        const int pm = (int)(L / nN), pn = (int)(L % nN);
        const int e = (pm >= t1) + (pm >= t2) + (pm >= t3) + (pm >= t4) + (pm >= t5) + (pm >= t6) + (pm >= t7);
        u.pm = pm; u.pn = pn; u.pb = e * nN + pn; return true;
    }
    __device__ __forceinline__ void a_ready(const pg8::Unit&) const {}
    __device__ __forceinline__ void done(const pg8::Unit&) const {}
};

#define EPI_LOOP(...) _Pragma("unroll") for (int ai = 0; ai < 2; ++ai) _Pragma("unroll") for (int m = 0; m < 4; ++m) { const int row = u.pm * 256 + ai * 128 + wr * 64 + m * 16 + fr; \
    _Pragma("unroll") for (int bj = 0; bj < 2; ++bj) { const int col = bj * 128 + wc * 32 + 4 * fq; f32x4 v0 = acc[ai][bj][m][0], v1 = acc[ai][bj][m][1]; __VA_ARGS__ } if (m & 1) asm volatile("" ::: "memory"); }
__device__ __forceinline__ v2u pack4(f32x4 v) { v2u w; w.x = pg8::cvt_pk_bf16(v[0], v[1]); w.y = pg8::cvt_pk_bf16(v[2], v[3]); return w; }
__device__ __forceinline__ f32x4 unpack4(v2u w) { return (f32x4){bf_lo(w.x), bf_hi(w.x), bf_lo(w.y), bf_hi(w.y)}; }

struct EpiProj {
    static constexpr bool PERM = false, AFTER_DRAIN = false;
    bf16* P; float* GB; const float* rope; const float* a_log; const float* dt_bias;
    __device__ __forceinline__ void operator()(const pg8::f32x4 (&acc)[2][2][4][2], const pg8::Unit& u, int wr, int wc, int fr, int fq) const {
        const int pn = u.pn;
        if (pn < 4) {
            EPI_LOOP({ const int j = row % RPB;
                if (j >= CTXL) { const int t = j - CTXL; const int pos = (wc & 1) ? (t & 63) : (t >> 6);
                    const f32x4 cs0 = *(const f32x4*)(rope + (pos * 16 + 4 * fq) * 2), cs1 = *(const f32x4*)(rope + (pos * 16 + 4 * fq) * 2 + 4);
                    const float c0 = cs0[0], s0 = cs0[1], c1 = cs0[2], s1 = cs0[3], c2 = cs1[0], s2 = cs1[1], c3 = cs1[2], s3 = cs1[3];
                    const f32x4 a = v0, b = v1;
                    v0[0] = a[0] * c0 - b[0] * s0; v1[0] = b[0] * c0 + a[0] * s0; v0[1] = a[1] * c1 - b[1] * s1; v1[1] = b[1] * c1 + a[1] * s1;
                    v0[2] = a[2] * c2 - b[2] * s2; v1[2] = b[2] * c2 + a[2] * s2; v0[3] = a[3] * c3 - b[3] * s3; v1[3] = b[3] * c3 + a[3] * s3; }
                bf16* o = P + (size_t)row * NPROJ + pn * 256 + col; *(v2u*)o = pack4(v0); *(v2u*)(o + 16) = pack4(v1); })
        } else if (pn >= 11 && pn < 23) {
            EPI_LOOP({ for (int q = 0; q < 4; ++q) { v0[q] = sigmoidf_(v0[q]); v1[q] = sigmoidf_(v1[q]); }
                bf16* o = P + (size_t)row * NPROJ + pn * 256 + col; *(v2u*)o = pack4(v0); *(v2u*)(o + 16) = pack4(v1); })
        } else if (pn == 23) {
            if (wc == 0) {
                EPI_LOOP({ if (bj == 0) { f32x4 r;
                    for (int q = 0; q < 4; ++q) { const int c = 4 * fq + q; const float x = v0[q];
                        if (c < 8) { const float z = x + dt_bias[c]; const float ez = __expf(z); const float sp = z > 15.f ? z : (ez < 0.03f ? ez * (1.f - ez * (0.5f - ez * (1.f / 3.f))) : __logf(1.f + ez)); r[q] = -__expf(a_log[c]) * sp; }
                        else r[q] = sigmoidf_(x); }
                    *(f32x4*)(GB + (size_t)row * 16 + 4 * fq) = r; } (void)v1; })
            }
        } else {
            EPI_LOOP({ bf16* o = P + (size_t)row * NPROJ + pn * 256 + col; *(v2u*)o = pack4(v0); *(v2u*)(o + 16) = pack4(v1); })
        }
    }
};
struct EpiMerge {
    static constexpr bool PERM = false, AFTER_DRAIN = false;
    bf16* MG; const bf16* P; int gcol0; int first;
    __device__ __forceinline__ void operator()(const pg8::f32x4 (&acc)[2][2][4][2], const pg8::Unit& u, int wr, int wc, int fr, int fq) const {
        EPI_LOOP({ const int c = u.pn * 256 + col; const bf16* gp = P + (size_t)row * NPROJ + gcol0 + c; bf16* o = MG + (size_t)row * DM + c;
            const f32x4 g0 = unpack4(*(const v2u*)gp), g1 = unpack4(*(const v2u*)(gp + 16));
            f32x4 r0 = g0 * v0, r1 = g1 * v1;
            if (!first) { unsigned long long w0 = __hip_atomic_load((unsigned long long*)o, RLX_AGENT), w1 = __hip_atomic_load((unsigned long long*)(o + 16), RLX_AGENT);
                r0 += unpack4((v2u){(unsigned)w0, (unsigned)(w0 >> 32)}); r1 += unpack4((v2u){(unsigned)w1, (unsigned)(w1 >> 32)}); }
            *(v2u*)o = pack4(r0); *(v2u*)(o + 16) = pack4(r1); })
    }
};
struct EpiResid {
    static constexpr bool PERM = false, AFTER_DRAIN = false;
    float* H; const float* modl; int gidx;
    __device__ __forceinline__ void operator()(const pg8::f32x4 (&acc)[2][2][4][2], const pg8::Unit& u, int wr, int wc, int fr, int fq) const {
        EPI_LOOP({ const int c = u.pn * 256 + col; const int b = row / RPB, j = row - b * RPB; const int mr = j < CTXL ? 4 : b;
            const float* gp = modl + mr * 6144 + gidx * 1024 + c; float* hp = H + (size_t)row * DM + c;
            const f32x4 g0 = *(const f32x4*)gp, g1 = *(const f32x4*)(gp + 16);
            *(f32x4*)hp = *(const f32x4*)hp + g0 * v0; *(f32x4*)(hp + 16) = *(const f32x4*)(hp + 16) + g1 * v1; })
    }
};
struct EpiSwiglu {
    static constexpr bool PERM = false, AFTER_DRAIN = false;
    bf16* HID; int ldh;
    __device__ __forceinline__ void operator()(const pg8::f32x4 (&acc)[2][2][4][2], const pg8::Unit& u, int wr, int wc, int fr, int fq) const {
        EPI_LOOP({ (void)col; f32x4 r; for (int q = 0; q < 4; ++q) r[q] = siluf_(v0[q]) * v1[q];
            *(v2u*)(HID + (size_t)row * ldh + u.pn * 128 + bj * 64 + wc * 16 + 4 * fq) = pack4(r); })
    }
};
struct EpiY {
    static constexpr bool PERM = false, AFTER_DRAIN = false;
    bf16* Y; int first;
    __device__ __forceinline__ void operator()(const pg8::f32x4 (&acc)[2][2][4][2], const pg8::Unit& u, int wr, int wc, int fr, int fq) const {
        EPI_LOOP({ bf16* o = Y + (size_t)row * DM + u.pn * 256 + col; f32x4 r0 = v0, r1 = v1;
            if (!first) { unsigned long long w0 = __hip_atomic_load((unsigned long long*)o, RLX_AGENT), w1 = __hip_atomic_load((unsigned long long*)(o + 16), RLX_AGENT);
                r0 += unpack4((v2u){(unsigned)w0, (unsigned)(w0 >> 32)}); r1 += unpack4((v2u){(unsigned)w1, (unsigned)(w1 >> 32)}); }
            *(v2u*)o = pack4(r0); *(v2u*)(o + 16) = pack4(r1); })
    }
};

template <int MAP> __device__ __forceinline__ int map_col(int c) {
    if (MAP == 0) return c;
    if (MAP == 1) return c < 2560 ? c : (c < 2576 ? PC_AB + (c - 2560) : (c < 2832 ? PC_POOL + (c - 2576) : PC_GATE + (c - 2832)));
    if (MAP == 2) return (c >> 4) * 32 + (c & 15);
    return (c >> 4) * 32 + 16 + (c & 15);
}
template <int MAP> __device__ __forceinline__ void tr_item(const float* W, int ldw, int N, bf16* WT, int ldd, int item, LAS float* scr, int lane) {
    const int nblk = (N + 31) / 32, kb = item / nblk, nb = item % nblk, k0 = 64 * kb, n0 = 32 * nb;
    const int cl = n0 + (lane & 31);
#pragma unroll 8
    for (int i = 0; i < 32; ++i) { const int kk = 2 * i + (lane >> 5); scr[kk * 33 + (lane & 31)] = cl < N ? W[(size_t)(k0 + kk) * ldw + cl] : 0.f; }
    LDS_WAIT(); asm volatile("" ::: "memory");
    const int c = lane & 7;
#pragma unroll
    for (int j = 0; j < 4; ++j) { const int n = (lane >> 3) + 8 * j; const LAS float* s = scr + (8 * c) * 33 + n;
        if (n0 + n < N) { v4u o; o.x = pk2(s[0 * 33], s[1 * 33]); o.y = pk2(s[2 * 33], s[3 * 33]); o.z = pk2(s[4 * 33], s[5 * 33]); o.w = pk2(s[6 * 33], s[7 * 33]);
            *(GAS v4u*)(WT + (size_t)map_col<MAP>(n0 + n) * ldd + k0 + 8 * c) = o; } }
    LDS_WAIT(); asm volatile("" ::: "memory");
}
#define TR_RUN(MAP, W, ldw, K, N, WT, ldd) { const int cnt_ = ((K) / 64) * (((N) + 31) / 32); if (r < cnt_) { tr_item<MAP>(W, ldw, N, WT, ldd, r, scr, F.lane); continue; } r -= cnt_; }

__device__ __forceinline__ void p0_prologue(Frame& F, const Args& A) {
    LAS float* scr = (LAS float*)(F.lds + F.wave * 16384);
    const int gw = F.vcu * NWAVES + F.wave, NGW = F.G * NWAVES;
    bf16* WIN = (bf16*)(F.ws + WS_WIN); bf16* WBR = (bf16*)(F.ws + WS_WBR); bf16* WOUT = (bf16*)(F.ws + WS_WOUT); bf16* W13 = (bf16*)(F.ws + WS_W13); bf16* W2 = (bf16*)(F.ws + WS_W2);
    constexpr int PER_LAYER = 16 * 185 + 8 * 32 + 4 * 32 + 4 * 32 + 16 * 32, TOTAL = 2 * PER_LAYER + 16 * 88 * 2 + 44 * 32;
    for (int it = gw; it < TOTAL; it += NGW) {
        int r = it;
        for (int l = 0; l < 2; ++l) {
            bool hit = false;
            if (r < PER_LAYER) { hit = true;
                const float* win = A.in[F.zz + 8] + (size_t)l * 1024 * INW; const float* wbr = A.in[F.zz + 17] + (size_t)l * 1024 * 1024; const float* wo = A.in[F.zz + 18] + (size_t)l * 1024 * 1024;
                bf16* dbr = WBR + (size_t)l * 1024 * 1024;
                do {
                    { const int cnt_ = 16 * 185; if (r < cnt_) { tr_item<1>(win, INW, INW, WIN + (size_t)l * NPROJ * 1024, 1024, r, scr, F.lane); break; } r -= cnt_; }
                    { const int cnt_ = 8 * 32; if (r < cnt_) { tr_item<0>(wbr, 1024, 1024, dbr, 512, r, scr, F.lane); break; } r -= cnt_; }
                    { const int cnt_ = 4 * 32; if (r < cnt_) { tr_item<0>(wbr + 512 * 1024, 1024, 1024, dbr + 1024 * 512, 256, r, scr, F.lane); break; } r -= cnt_; }
                    { const int cnt_ = 4 * 32; if (r < cnt_) { tr_item<0>(wbr + 768 * 1024, 1024, 1024, dbr + 1024 * 768, 256, r, scr, F.lane); break; } r -= cnt_; }
                    tr_item<0>(wo, 1024, 1024, WOUT + (size_t)l * 1024 * 1024, 1024, r, scr, F.lane);
                } while (0);
            }
            if (hit) { r = -1; break; }
            r -= PER_LAYER;
        }
        if (r < 0) continue;
        { const int cnt_ = 16 * 88; if (r < cnt_) { tr_item<2>(A.in[F.zz + 19], FFD, FFD, W13, 1024, r, scr, F.lane); continue; } r -= cnt_; }
        { const int cnt_ = 16 * 88; if (r < cnt_) { tr_item<3>(A.in[F.zz + 20], FFD, FFD, W13, 1024, r, scr, F.lane); continue; } r -= cnt_; }
        tr_item<0>(A.in[F.zz + 21], 1024, 1024, W2, FFD, r, scr, F.lane);
    }
    float* H = (float*)(F.ws + WS_H);
    for (int R = gw; R < MROWS; R += NGW) { const int b = R / RPB, j = R - b * RPB;
        const float* src = j < CTXL ? A.in[F.zz + 2] + ((size_t)b * CTXL + j) * DM : A.in[F.zz + 0] + ((size_t)b * SEQ + (j - CTXL)) * DM;
        const GAS f32x4* s4 = (const GAS f32x4*)src + F.lane; GAS f32x4* d4 = (GAS f32x4*)(H + (size_t)R * DM) + F.lane;
#pragma unroll
        for (int q = 0; q < 4; ++q) d4[64 * q] = s4[64 * q]; }
    if (F.vcu == 0) {
        float* rope = (float*)(F.ws + WS_ROPE);
        for (int e = F.tid; e < 1024; e += NTHR) { const int pos = e >> 4, i = e & 15; const float inv = powf(10000.f, -(float)i / 16.f); const float a = (float)pos * inv;
            rope[2 * e] = cosf(a); rope[2 * e + 1] = sinf(a); }
        if (F.tid < 2) { const int l = F.tid; const float* lp = A.in[F.zz + 9] + l * 256; float s1 = 0.f, s2 = 0.f;
            for (int i = 0; i < 64; ++i) { s1 += lp[i] * lp[64 + i]; s2 += lp[128 + i] * lp[192 + i]; }
            const float li = 0.8f - 0.6f * expf(-0.3f * (float)l);
            ((float*)(F.ws + WS_LAM))[l] = expf(s1) - expf(s2) + li; }
    }
    __syncthreads();
    float* MOD = (float*)(F.ws + WS_MOD);
    LAS float* red = (LAS float*)F.lds;
    for (int task = F.vcu; task < 2 * 96; task += F.G) {
        const int l = task / 96, cc = task % 96;
        const float* aw = A.in[F.zz + 4] + (size_t)l * 1024 * 6144 + cc * 64 + F.lane;
        const float* c0 = A.in[F.zz + 1]; const float* cx = A.in[F.zz + 3];
        float a0 = 0.f, a1 = 0.f, a2 = 0.f, a3 = 0.f, a4 = 0.f;
#pragma unroll 8
        for (int i = 0; i < 128; ++i) { const int k = F.wave * 128 + i; const float w = aw[(size_t)k * 6144];
            a0 += siluf_(c0[k]) * w; a1 += siluf_(c0[1024 + k]) * w; a2 += siluf_(c0[2048 + k]) * w; a3 += siluf_(c0[3072 + k]) * w; a4 += siluf_(cx[k]) * w; }
        LAS float* rw = red + F.wave * 320 + F.lane;
        rw[0] = a0; rw[64] = a1; rw[128] = a2; rw[192] = a3; rw[256] = a4;
        __syncthreads();
        if (F.tid < 320) { float s = 0.f;
#pragma unroll
            for (int w = 0; w < 8; ++w) s += red[w * 320 + F.tid];
            const int rr = F.tid >> 6, jj = cc * 64 + (F.tid & 63);
            MOD[(l * 5 + rr) * 6144 + jj] = s + A.in[F.zz + 5][l * 6144 + jj]; }
        __syncthreads();
    }
}

__device__ __forceinline__ void moe_convert(Frame& F, const Args& A, int hh) {
    LAS float* scr = (LAS float*)(F.lds + F.wave * 16384);
    const int gw = F.vcu * NWAVES + F.wave, NGW = F.G * NWAVES;
    bf16* W13M = (bf16*)(F.ws + WS_W13M); bf16* W2M = (bf16*)(F.ws + WS_W2M);
    constexpr int I13 = 16 * 56, I2 = 28 * 32, PER_E = 2 * I13 + I2;
    for (int it = gw; it < 8 * PER_E; it += NGW) {
        const int e = it / PER_E; int r = it - e * PER_E;
        if (r < I13) { tr_item<2>(A.in[F.zz + 23] + (size_t)e * 1024 * FFE + hh * FFEH, FFE, FFEH, W13M + (size_t)e * FFE * 1024, 1024, r, scr, F.lane); continue; } r -= I13;
        if (r < I13) { tr_item<3>(A.in[F.zz + 24] + (size_t)e * 1024 * FFE + hh * FFEH, FFE, FFEH, W13M + (size_t)e * FFE * 1024, 1024, r, scr, F.lane); continue; } r -= I13;
        tr_item<0>(A.in[F.zz + 25] + (size_t)e * FFE * 1024 + (size_t)hh * FFEH * 1024, 1024, 1024, W2M + (size_t)e * 1024 * FFEH, FFEH, r, scr, F.lane);
    }
}

__device__ __forceinline__ void norm_mod_phase(Frame& F, const Args& A, int l, int which, bool latent_only, bool route) {
    const int gw = F.vcu * NWAVES + F.wave, NGW = F.G * NWAVES;
    const float* H = (const float*)(F.ws + WS_H); bf16* U = (bf16*)(F.ws + WS_U); const float* MOD = (const float*)(F.ws + WS_MOD) + l * 5 * 6144;
    const float* g = (which ? A.in[F.zz + 7] : A.in[F.zz + 6]) + l * 1024;
    for (int R = gw; R < MROWS; R += NGW) {
        const int b = R / RPB, j = R - b * RPB; const bool isctx = j < CTXL; if (latent_only && isctx) continue;
        const float* mod = MOD + (isctx ? 4 : b) * 6144; const float* shift = mod + (which ? 3 : 0) * 1024; const float* scale = mod + (which ? 4 : 1) * 1024;
        const GAS f32x4* xr = (const GAS f32x4*)(H + (size_t)R * DM) + F.lane;
        f32x4 v[4]; float ss = 0.f;
#pragma unroll
        for (int q = 0; q < 4; ++q) { v[q] = xr[64 * q]; ss += (v[q].x * v[q].x + v[q].y * v[q].y) + (v[q].z * v[q].z + v[q].w * v[q].w); }
        const float rstd = 1.f / sqrtf(wave_sum(ss) * (1.f / DM) + EPSN);
        GAS v2u* o8 = (GAS v2u*)(U + (size_t)R * DM) + F.lane;
#pragma unroll
        for (int q = 0; q < 4; ++q) { const int c = 4 * F.lane + 256 * q; const f32x4 gg = *(const f32x4*)(g + c), sh = *(const f32x4*)(shift + c), sc = *(const f32x4*)(scale + c);
            v[q] = (v[q] * rstd) * gg * (sc + 1.f) + sh; v2u w; w.x = pk2(v[q].x, v[q].y); w.y = pk2(v[q].z, v[q].w); o8[64 * q] = w; }
        if (route) {
            const float* rw = A.in[F.zz + 22];
            float lg[8] = {0, 0, 0, 0, 0, 0, 0, 0};
#pragma unroll
            for (int q = 0; q < 4; ++q)
#pragma unroll
                for (int i = 0; i < 4; ++i) { const int k = 4 * F.lane + 256 * q + i; const f32x4 w0 = *(const f32x4*)(rw + k * 8), w1 = *(const f32x4*)(rw + k * 8 + 4); const float x = v[q][i];
                    lg[0] += x * w0[0]; lg[1] += x * w0[1]; lg[2] += x * w0[2]; lg[3] += x * w0[3]; lg[4] += x * w1[0]; lg[5] += x * w1[1]; lg[6] += x * w1[2]; lg[7] += x * w1[3]; }
#pragma unroll
            for (int e = 0; e < 8; ++e) lg[e] = wave_sum(lg[e]);
            if (F.lane == 0) {
                int e0 = 0; float v0 = lg[0];
#pragma unroll
                for (int e = 1; e < 8; ++e) if (lg[e] > v0) { v0 = lg[e]; e0 = e; }
                int e1 = -1; float v1 = -3.0e38f;
#pragma unroll
                for (int e = 0; e < 8; ++e) if (e != e0 && lg[e] > v1) { v1 = lg[e]; e1 = e; }
                const float ex = __expf(v1 - v0); const float w0 = 1.f / (1.f + ex), w1 = ex / (1.f + ex);
                gu32* cnt = F.ctl + CW_ECNT;
#ifdef DBG_DETPOS
                const unsigned p0 = 0, p1 = 0; (void)cnt;
#else
                const unsigned p0 = __hip_atomic_fetch_add(cnt + 64 * e0, 1u, RLX_AGENT), p1 = __hip_atomic_fetch_add(cnt + 64 * e1, 1u, RLX_AGENT);
#endif
                const int tk = b * SEQ + (j - CTXL);
                v4u* rt = (v4u*)(F.ws + WS_ROUTE) + 2 * tk;
                rt[0] = (v4u){(unsigned)e0, (unsigned)e1, p0, p1}; rt[1] = (v4u){__float_as_uint(w0), __float_as_uint(w1), 0u, 0u};
            }
        }
    }
}

__device__ __forceinline__ void moe_gather(Frame& F) {
#ifdef DBG_DETPOS
    if (F.vcu == 0 && F.tid == 0) { unsigned c[8] = {0,0,0,0,0,0,0,0};
        for (int tk = 0; tk < NB * SEQ; ++tk) { v4u* rt = (v4u*)(F.ws + WS_ROUTE) + 2 * tk; v4u r = rt[0];
            for (int e = 0; e < 8; ++e) { if ((int)r.x == e) r.z = c[e]++; } for (int e = 0; e < 8; ++e) { if ((int)r.y == e) r.w = c[e]++; } rt[0] = r; }
        for (int e = 0; e < 8; ++e) __hip_atomic_store(F.ctl + CW_ECNT + 64 * e, c[e], RLX_AGENT); }
    return;
#endif
    const int gw = F.vcu * NWAVES + F.wave, NGW = F.G * NWAVES;
    MoeOrder mo; mo.init(F.ctl + CW_ECNT, 1, 1, 0);
    const bf16* U = (const bf16*)(F.ws + WS_U); bf16* XG = (bf16*)(F.ws + WS_XG);
    for (int tk = gw; tk < NB * SEQ; tk += NGW) {
        const int b = tk / SEQ, t = tk - b * SEQ; const size_t R = (size_t)b * RPB + CTXL + t;
        const v4u rt = ((const v4u*)(F.ws + WS_ROUTE))[2 * tk];
        const size_t r0 = (size_t)mo.tile_off((int)rt.x) * 256 + rt.z, r1 = (size_t)mo.tile_off((int)rt.y) * 256 + rt.w;
        const GAS v4u* s = (const GAS v4u*)(U + R * DM) + F.lane; const v4u a = s[0], c = s[64];
        GAS v4u* d0 = (GAS v4u*)(XG + r0 * DM) + F.lane; GAS v4u* d1 = (GAS v4u*)(XG + r1 * DM) + F.lane;
        d0[0] = a; d0[64] = c; d1[0] = a; d1[64] = c;
    }
}

__device__ __forceinline__ void moe_gather2(Frame& F) {
    const int gw = F.vcu * NWAVES + F.wave, NGW = F.G * NWAVES;
    MoeOrder mo; mo.init(F.ctl + CW_ECNT, 1, 1, 0);
    const bf16* U = (const bf16*)(F.ws + WS_U); bf16* XG = (bf16*)(F.ws + WS_XG);
    for (int tk = gw; tk < NB * SEQ; tk += NGW) {
        const int b = tk / SEQ, t = tk - b * SEQ; const size_t R = (size_t)b * RPB + CTXL + t;
        const v4u rt = ((const v4u*)(F.ws + WS_ROUTE))[2 * tk];
        const size_t r0 = (size_t)mo.tile_off((int)rt.x) * 256 + rt.z, r1 = (size_t)mo.tile_off((int)rt.y) * 256 + rt.w;
        const GAS v4u* s = (const GAS v4u*)(U + R * DM) + F.lane; const v4u a = s[0], c = s[64];
        GAS v4u* d0 = (GAS v4u*)(XG + r0 * DM) + F.lane; GAS v4u* d1 = (GAS v4u*)(XG + r1 * DM) + F.lane;
        d0[0] = a; d0[64] = c; d1[0] = a; d1[64] = c;
    }
}

__device__ __forceinline__ void final_phase(Frame& F, const Args& A) {
    const int gw = F.vcu * NWAVES + F.wave, NGW = F.G * NWAVES;
    MoeOrder mo; mo.init(F.ctl + CW_ECNT, 1, 1, 0);
    const float* H = (const float*)(F.ws + WS_H); const bf16* Y = (const bf16*)(F.ws + WS_Y); const float* MOD = (const float*)(F.ws + WS_MOD) + 1 * 5 * 6144;
    for (int tk = gw; tk < NB * SEQ; tk += NGW) {
        const int b = tk / SEQ, t = tk - b * SEQ; const size_t R = (size_t)b * RPB + CTXL + t;
        const v4u rt = ((const v4u*)(F.ws + WS_ROUTE))[2 * tk], rw = ((const v4u*)(F.ws + WS_ROUTE))[2 * tk + 1];
        const size_t r0 = (size_t)mo.tile_off((int)rt.x) * 256 + rt.z, r1 = (size_t)mo.tile_off((int)rt.y) * 256 + rt.w;
        const float w0 = __uint_as_float(rw.x), w1 = __uint_as_float(rw.y);
        const float* gate = MOD + b * 6144 + 5 * 1024;
        f32x4 v[4]; float ss = 0.f;
#pragma unroll
        for (int q = 0; q < 4; ++q) { const int c = 4 * F.lane + 256 * q;
            const f32x4 h = *(const f32x4*)(H + R * DM + c), gg = *(const f32x4*)(gate + c);
            const f32x4 y0 = unpack4(*(const v2u*)(Y + r0 * DM + c)), y1 = unpack4(*(const v2u*)(Y + r1 * DM + c));
            v[q] = h + gg * (y0 * w0 + y1 * w1); ss += (v[q].x * v[q].x + v[q].y * v[q].y) + (v[q].z * v[q].z + v[q].w * v[q].w); }
        const float rstd = 1.f / sqrtf(wave_sum(ss) * (1.f / DM) + EPSN);
#pragma unroll
        for (int q = 0; q < 4; ++q) { const int c = 4 * F.lane + 256 * q; *(f32x4*)(F.out + (size_t)tk * DM + c) = v[q] * rstd * *(const f32x4*)(A.in[F.zz + 26] + c); }
    }
}

constexpr int DP = 65;
constexpr int DN_ARR = 64 * DP * 4;
__device__ __forceinline__ void dn_pre_unit(Frame& F, const Args& A, int l, int b, int n, int h) {
    LAS float* Qc = (LAS float*)(F.lds + 0 * DN_ARR); LAS float* Kc = (LAS float*)(F.lds + 1 * DN_ARR); LAS float* Vc = (LAS float*)(F.lds + 2 * DN_ARR);
    LAS float* KK = (LAS float*)(F.lds + 3 * DN_ARR);
    LAS float* QK = (LAS float*)(F.lds + 4 * DN_ARR); LAS float* A0 = (LAS float*)(F.lds + 5 * DN_ARR);
    LAS float* U1 = (LAS float*)(F.lds + 6 * DN_ARR); LAS float* W0 = (LAS float*)(F.lds + 7 * DN_ARR); LAS float* W1 = (LAS float*)(F.lds + 8 * DN_ARR);
    LAS float* Gs = (LAS float*)(F.lds + 9 * DN_ARR);
    LAS float* Bs = Gs + 128;
    LAS float* gr = Gs + 256;
    const bf16* P = (const bf16*)(F.ws + WS_PROJ); const float* GB = (const float*)(F.ws + WS_GB);
    int tid = threadIdx.x; asm volatile("" : "+v"(tid));
    const int row0 = b * RPB + n * 64; const int seq_lo = (n < 4) ? b * RPB : b * RPB + CTXL, seq_hi = (n < 4) ? b * RPB + CTXL : (b + 1) * RPB;
    {
        const int t = tid >> 3, cg = tid & 7;
        const float* cw = A.in[F.zz + 11] + (size_t)l * 5 * 768;
#pragma unroll
        for (int p = 0; p < 3; ++p) {
            const int ch = p * 256 + h * 64 + cg * 8;
            float acc[8] = {0, 0, 0, 0, 0, 0, 0, 0};
#pragma unroll
            for (int tap = 0; tap < 5; ++tap) { const int r = row0 + t + tap - 2;
                if (r >= seq_lo && r < seq_hi) { const v4u x = *(const v4u*)(P + (size_t)r * NPROJ + PC_DQ + ch);
                    const f32x4 w0 = *(const f32x4*)(cw + tap * 768 + ch), w1 = *(const f32x4*)(cw + tap * 768 + ch + 4);
                    acc[0] += bf_lo(x.x) * w0[0]; acc[1] += bf_hi(x.x) * w0[1]; acc[2] += bf_lo(x.y) * w0[2]; acc[3] += bf_hi(x.y) * w0[3];
                    acc[4] += bf_lo(x.z) * w1[0]; acc[5] += bf_hi(x.z) * w1[1]; acc[6] += bf_lo(x.w) * w1[2]; acc[7] += bf_hi(x.w) * w1[3]; } }
            float ss = 0.f;
#pragma unroll
            for (int i = 0; i < 8; ++i) { acc[i] = siluf_(acc[i]); ss += acc[i] * acc[i]; }
            float sc = 1.f;
            if (p < 2) { ss += __shfl_xor(ss, 1); ss += __shfl_xor(ss, 2); ss += __shfl_xor(ss, 4); sc = (1.f / sqrtf(ss + EPSN)) * (p == 0 ? 0.125f : 1.f); }
            LAS float* dst = (p == 0 ? Qc : p == 1 ? Kc : Vc) + t * DP + cg * 8;
#pragma unroll
            for (int i = 0; i < 8; ++i) dst[i] = acc[i] * sc;
        }
        if (tid < 128) { const int d = tid >> 6, tt = tid & 63; const float* gb = GB + (size_t)(row0 + tt) * 16; gr[d * 64 + tt] = gb[d * 4 + h]; Bs[d * 64 + tt] = gb[8 + d * 4 + h]; }
    }
    __syncthreads();
    {
#pragma unroll 1
        for (int k = 0; k < 8; ++k) { const int e = tid + 512 * k, t = e >> 6, s = e & 63; float a = 0.f, c = 0.f;
#pragma unroll 8
            for (int i = 0; i < 64; ++i) { const float ks = Kc[s * DP + i]; a += Kc[t * DP + i] * ks; c += Qc[t * DP + i] * ks; }
            KK[t * DP + s] = a; QK[t * DP + s] = c; }
        if (tid < 128) { const int d = tid >> 6, tt = tid & 63; float g = 0.f;
            if (d == 0) { for (int s = 0; s <= tt; ++s) g += gr[s]; } else { for (int s = 63; s >= tt; --s) g += gr[64 + s]; }
            Gs[d * 64 + tt] = g; }
    }
    __syncthreads();
    {
#pragma unroll 1
        for (int k = 0; k < 8; ++k) { const int e = tid + 512 * k, t = e >> 6, s = e & 63; const float kk = KK[t * DP + s];
            const float a0 = (s < t) ? Bs[t] * kk * __expf(Gs[t] - Gs[s]) : 0.f;
            const float a1 = (s > t) ? Bs[64 + t] * kk * __expf(Gs[64 + t] - Gs[64 + s]) : 0.f;
            A0[t * DP + s] = a0; KK[t * DP + s] = a1;
            const float v = Vc[t * DP + s], kc = Kc[t * DP + s];
            Vc[t * DP + s] = Bs[t] * v; U1[t * DP + s] = Bs[64 + t] * v;
            W0[t * DP + s] = Bs[t] * __expf(Gs[t]) * kc; W1[t * DP + s] = Bs[64 + t] * __expf(Gs[64 + t]) * kc; }
    }
    __syncthreads();
    if (tid < 256) {
        const int d = tid >> 7, c = tid & 127; LAS float* X = (c < 64) ? (d == 0 ? Vc : U1) + c : (d == 0 ? W0 : W1) + (c - 64);
        const LAS float* Am = d == 0 ? A0 : KK;
        if (d == 0) {
#pragma unroll 1
            for (int i = 1; i < 64; ++i) { float a = X[i * DP];
#pragma unroll 4
                for (int j = 0; j < i; ++j) a -= Am[i * DP + j] * X[j * DP];
                X[i * DP] = a; }
        } else {
#pragma unroll 1
            for (int i = 62; i >= 0; --i) { float a = X[i * DP];
#pragma unroll 4
                for (int j = i + 1; j < 64; ++j) a -= Am[i * DP + j] * X[j * DP];
                X[i * DP] = a; }
        }
    }
    __syncthreads();
    {
#pragma unroll 1
        for (int k = 0; k < 8; ++k) { const int e = tid + 512 * k, t = e >> 6, s = e & 63; const float qk = QK[t * DP + s];
            A0[t * DP + s] = (s <= t) ? qk * __expf(Gs[t] - Gs[s]) : 0.f;
            KK[t * DP + s] = (s >= t) ? qk * __expf(Gs[64 + t] - Gs[64 + s]) : 0.f; }
    }
    __syncthreads();
    {
        const int d = tid >> 8, tt = tid & 255;
        const LAS float* Aq = d == 0 ? A0 : KK; const LAS float* Ud = d == 0 ? Vc : U1; const LAS float* Wd = d == 0 ? W0 : W1; const LAS float* Gd = Gs + d * 64;
        const float glast = d == 0 ? Gd[63] : Gd[0];
        const size_t prob = (((size_t)b * NCHUNK + n) * 4 + h) * 2 + d;
        bf16* out = (bf16*)(F.ws + WS_DNP) + prob * 16384;
        if (tt == 0) ((float*)(F.ws + WS_DNG))[prob] = __expf(glast);
#pragma unroll 1
        for (int k = 0; k < 16; ++k) { const int e = tt + 256 * k, r = e >> 6, c = e & 63;
            float rr = 0.f, yy = 0.f, bb = 0.f, cc = 0.f;
#pragma unroll 4
            for (int s = 0; s < 64; ++s) { const float aq = Aq[r * DP + s], us = Ud[s * DP + c], ws = Wd[s * DP + c];
                rr += aq * us; yy += aq * ws;
                const float kt = __expf(glast - Gd[s]) * Kc[s * DP + r]; bb += kt * us; cc += kt * ws; }
            const float pp = __expf(Gd[r]) * Qc[r * DP + c] - yy;
            out[e] = (bf16)f2bf(pp); out[4096 + e] = (bf16)f2bf(rr); out[8192 + e] = (bf16)f2bf(bb); out[12288 + e] = (bf16)f2bf(cc); }
    }
    __syncthreads();
}

__device__ __forceinline__ void pool_unit(Frame& F, const Args& A, int l, int blk, int g) {
    LAS float* Uw = (LAS float*)F.lds;
    LAS float* Mm = Uw + 80 * DP;
    LAS float* PW = Mm + 64 * DP;
    const bf16* P = (const bf16*)(F.ws + WS_PROJ); bf16* MIX = (bf16*)(F.ws + WS_MIX);
    int tid = threadIdx.x; asm volatile("" : "+v"(tid));
    const int row0 = blk * 64, b = row0 / RPB, j0 = row0 - b * RPB; const bool isctx = j0 < CTXL;
    const int seq_lo = isctx ? b * RPB : b * RPB + CTXL, L = isctx ? CTXL : SEQ; const int pos0 = row0 - seq_lo;
    for (int idx = tid; idx < 640; idx += NTHR) { const int rr = idx >> 3, c8 = (idx & 7) * 8; const int pos = pos0 - 8 + rr;
        float v[8] = {0, 0, 0, 0, 0, 0, 0, 0};
        if (pos >= 0 && pos < L) { const v4u x = *(const v4u*)(P + (size_t)(seq_lo + pos) * NPROJ + PC_POOL + g * 64 + c8);
            v[0] = bf_lo(x.x); v[1] = bf_hi(x.x); v[2] = bf_lo(x.y); v[3] = bf_hi(x.y); v[4] = bf_lo(x.z); v[5] = bf_hi(x.z); v[6] = bf_lo(x.w); v[7] = bf_hi(x.w); }
#pragma unroll
        for (int i = 0; i < 8; ++i) Uw[rr * DP + c8 + i] = v[i]; }
    { const float* pw = A.in[F.zz + 15] + ((size_t)l * 4 + g) * 4096;
#pragma unroll
      for (int k = 0; k < 8; ++k) { const int e = tid + 512 * k; PW[(e >> 6) * DP + (e & 63)] = pw[e]; } }
    __syncthreads();
    const int win = 2 << g;
#pragma unroll 1
    for (int k = 0; k < 8; ++k) { const int e = tid + 512 * k, t = e >> 6, i = e & 63; const int pos = pos0 + t;
        int lo = pos - win / 2, hi = lo + win; lo = lo < 0 ? 0 : lo; hi = hi > L ? L : hi;
        float s = 0.f; for (int p = lo; p < hi; ++p) s += Uw[(p - pos0 + 8) * DP + i];
        Mm[t * DP + i] = s / (float)(hi - lo) - Uw[(t + 8) * DP + i]; }
    __syncthreads();
    const float* psc = A.in[F.zz + 16] + l * 256 + g * 64;
#pragma unroll 1
    for (int k = 0; k < 8; ++k) { const int e = tid + 512 * k, t = e >> 6, o = e & 63; float a = 0.f;
#pragma unroll 8
        for (int i = 0; i < 64; ++i) a += Mm[t * DP + i] * PW[i * DP + o];
        MIX[(size_t)(row0 + t) * DM + 768 + g * 64 + o] = (bf16)f2bf(a * psc[o]); }
    __syncthreads();
}

__device__ __forceinline__ void dn_scan_item(Frame& F, int item) {
    const int es = item & 3, d = (item >> 2) & 1, h = (item >> 3) & 3, b = item >> 5;
    LAS float* Pm = (LAS float*)F.lds; LAS float* Cm = Pm + 64 * DP; LAS float* Rm = Cm + 64 * DP; LAS float* Bm = Rm + 64 * 17; LAS float* S0 = Bm + 64 * 17; LAS float* S1 = S0 + 64 * 17;
    int tid = threadIdx.x; asm volatile("" : "+v"(tid));
    for (int e = tid; e < 64 * 17; e += NTHR) { S0[e] = 0.f; S1[e] = 0.f; }
    bf16* DNO = (bf16*)(F.ws + WS_DNO) + (size_t)d * MROWS * 256;
    LAS float* Sc = S0; LAS float* Sn = S1;
#pragma unroll 1
    for (int st = 0; st < NCHUNK; ++st) {
        const int n = d == 0 ? st : (st < 4 ? 3 - st : 71 - st);
        const size_t prob = (((size_t)b * NCHUNK + n) * 4 + h) * 2 + d;
        const bf16* src = (const bf16*)(F.ws + WS_DNP) + prob * 16384;
        const float gl = ((const float*)(F.ws + WS_DNG))[prob];
        { const v4u x = *(const v4u*)(src + tid * 8), y = *(const v4u*)(src + 12288 + tid * 8); const int r = tid >> 3, c = (tid & 7) * 8;
          LAS float* p = Pm + r * DP + c; LAS float* q = Cm + r * DP + c;
          p[0] = bf_lo(x.x); p[1] = bf_hi(x.x); p[2] = bf_lo(x.y); p[3] = bf_hi(x.y); p[4] = bf_lo(x.z); p[5] = bf_hi(x.z); p[6] = bf_lo(x.w); p[7] = bf_hi(x.w);
          q[0] = bf_lo(y.x); q[1] = bf_hi(y.x); q[2] = bf_lo(y.y); q[3] = bf_hi(y.y); q[4] = bf_lo(y.z); q[5] = bf_hi(y.z); q[6] = bf_lo(y.w); q[7] = bf_hi(y.w); }
#pragma unroll
        for (int k = 0; k < 2; ++k) { const int e = tid + 512 * k, r = e >> 4, c = e & 15;
            Rm[r * 17 + c] = bf2f(src[4096 + r * 64 + es * 16 + c]); Bm[r * 17 + c] = bf2f(src[8192 + r * 64 + es * 16 + c]); }
        __syncthreads();
#pragma unroll
        for (int k = 0; k < 2; ++k) { const int e = tid + 512 * k, r = e >> 4, c = e & 15; float o = Rm[r * 17 + c], sn = gl * Sc[r * 17 + c] + Bm[r * 17 + c];
#pragma unroll 8
            for (int i = 0; i < 64; ++i) { const float sv = Sc[i * 17 + c]; o += Pm[r * DP + i] * sv; sn -= Cm[r * DP + i] * sv; }
            Sn[r * 17 + c] = sn;
            DNO[(size_t)(b * RPB + n * 64 + r) * 256 + h * 64 + es * 16 + c] = (bf16)f2bf(o); }
        __syncthreads();
        LAS float* tmp = Sc; Sc = Sn; Sn = tmp;
    }
}

__device__ __forceinline__ void mix_build(Frame& F, const Args& A, int l) {
    int lane = threadIdx.x & 63; asm volatile("" : "+v"(lane)); const int gw = F.vcu * NWAVES + F.wave, NGW = F.G * NWAVES;
    const bf16* ATTO = (const bf16*)(F.ws + WS_ATTO); const bf16* P = (const bf16*)(F.ws + WS_PROJ); const bf16* DNO = (const bf16*)(F.ws + WS_DNO); bf16* MIX = (bf16*)(F.ws + WS_MIX);
    const float lam = ((const float*)(F.ws + WS_LAM))[l]; const float li = 0.8f - 0.6f * expf(-0.3f * (float)l);
    const float* sg = A.in[F.zz + 10] + l * 128; const float* ng = A.in[F.zz + 14] + l * 64;
    for (int R = gw; R < MROWS; R += NGW) {
        const int j = R % RPB; if (l == 1 && j < CTXL) continue;
        { const int hh = lane >> 4, e0 = (lane & 15) * 8;
          const v4u a = *(const v4u*)(ATTO + (size_t)R * DM + (hh * 2) * 128 + e0), c = *(const v4u*)(ATTO + (size_t)R * DM + (hh * 2 + 1) * 128 + e0);
          float x[8] = {bf_lo(a.x) - lam * bf_lo(c.x), bf_hi(a.x) - lam * bf_hi(c.x), bf_lo(a.y) - lam * bf_lo(c.y), bf_hi(a.y) - lam * bf_hi(c.y),
                        bf_lo(a.z) - lam * bf_lo(c.z), bf_hi(a.z) - lam * bf_hi(c.z), bf_lo(a.w) - lam * bf_lo(c.w), bf_hi(a.w) - lam * bf_hi(c.w)};
          float ss = 0.f;
#pragma unroll
          for (int i = 0; i < 8; ++i) ss += x[i] * x[i];
          ss += __shfl_xor(ss, 1); ss += __shfl_xor(ss, 2); ss += __shfl_xor(ss, 4); ss += __shfl_xor(ss, 8);
          const float sc = (1.f / sqrtf(ss * (1.f / 128.f) + EPSN)) * (1.f - li);
          const f32x4 g0 = *(const f32x4*)(sg + e0), g1 = *(const f32x4*)(sg + e0 + 4);
          v4u o; o.x = pk2(x[0] * sc * g0[0], x[1] * sc * g0[1]); o.y = pk2(x[2] * sc * g0[2], x[3] * sc * g0[3]); o.z = pk2(x[4] * sc * g1[0], x[5] * sc * g1[1]); o.w = pk2(x[6] * sc * g1[2], x[7] * sc * g1[3]);
          *(v4u*)(MIX + (size_t)R * DM + hh * 128 + e0) = o; }
        { const int c0 = lane * 4;
          const v2u a = *(const v2u*)(DNO + (size_t)R * 256 + c0), c = *(const v2u*)(DNO + ((size_t)MROWS + R) * 256 + c0), z = *(const v2u*)(P + (size_t)R * NPROJ + PC_DZ + c0);
          float x[4] = {bf_lo(a.x) + bf_lo(c.x), bf_hi(a.x) + bf_hi(c.x), bf_lo(a.y) + bf_lo(c.y), bf_hi(a.y) + bf_hi(c.y)};
          float ss = x[0] * x[0] + x[1] * x[1] + x[2] * x[2] + x[3] * x[3];
          ss += __shfl_xor(ss, 1); ss += __shfl_xor(ss, 2); ss += __shfl_xor(ss, 4); ss += __shfl_xor(ss, 8);
          const float sc = 1.f / sqrtf(ss * (1.f / 64.f) + EPSN);
          const f32x4 gg = *(const f32x4*)(ng + (c0 & 63));
          v2u o; o.x = pk2(x[0] * sc * gg[0] * siluf_(bf_lo(z.x)), x[1] * sc * gg[1] * siluf_(bf_hi(z.x))); o.y = pk2(x[2] * sc * gg[2] * siluf_(bf_lo(z.y)), x[3] * sc * gg[3] * siluf_(bf_hi(z.y)));
          *(v2u*)(MIX + (size_t)R * DM + 512 + c0) = o; }
    }
}

#ifndef MK_N_LAUNCHES
#define MK_N_LAUNCHES 31
#endif
__global__ void __launch_bounds__(NTHR, 2) mk_fwd(Args args) {
    extern __shared__ __attribute__((aligned(16))) unsigned char lds[];
    Frame F;
    F.lds = (LAS unsigned char*)lds;
    F.MISC = (volatile LAS unsigned*)(F.lds + MISC_OFF);
    F.tid = threadIdx.x; F.lane = F.tid & 63; F.wave = __builtin_amdgcn_readfirstlane(F.tid >> 6);
    F.G = gridDim.x; { const int bx = blockIdx.x; F.vcu = (F.G % 8 == 0) ? (bx % 8) * (F.G / 8) + bx / 8 : bx; }
    F.ws = args.ws; F.out = args.out; F.zz = 0;
    F.ctl = (gu32*)(args.ws + WS_CTL);
    for (int u = F.tid; u < (LDS_BYTES - MISC_OFF) / 4; u += NTHR) ((LAS unsigned*)(F.lds + MISC_OFF))[u] = 0u;
    __syncthreads();
    const int lo = args.ph_lo, hi = args.ph_hi;
    const bool use_bar = (hi - lo) > 1;
    XcdBarrier bar; bar.bar = (unsigned*)(F.ctl + CW_BAR); bar.x = 0; bar.st = nullptr;
    if (use_bar) bar = xcd_barrier_post((unsigned*)(F.ctl + CW_BAR), F.MISC + 8);
#ifndef EN_MASK
#define EN_MASK 0xFFFFFFFFu
#endif
#define IN(k) (((EN_MASK >> ((k) > 12 ? (k) - 12 : (k))) & 1u) && lo <= (k) && (k) < hi)
#define PB() do { int z_ = 0; asm volatile("" : "+s"(z_)); F.ws = args.ws + z_; F.ctl = (gu32*)(args.ws + z_); F.zz = z_; int t_ = threadIdx.x; asm volatile("" : "+v"(t_)); F.tid = t_; F.lane = t_ & 63; F.wave = __builtin_amdgcn_readfirstlane(t_ >> 6); } while (0)
#define SEAM(k) do { if (IN(k) && IN((k) + 1)) { XcdBarrier bl_ = bar; { int z_ = 0; unsigned x_ = bar.x; asm volatile("" : "+s"(z_), "+s"(x_)); bl_.bar = (unsigned*)(args.ws + WS_CTL) + CW_BAR + z_; bl_.x = x_; } xcd_barrier(bl_); } } while (0)
    char* ldsg = (char*)lds;

    if (IN(PH_PRO)) { PB(); p0_prologue(F, args); } SEAM(PH_PRO);

#pragma unroll 1
    for (int l = 0; l < 2; ++l) {
        const int pb = 1 + 12 * l;
        const float* modl = (const float*)(F.ws + WS_MOD) + l * 5 * 6144;
        if (IN(pb + PH_N1)) { PB(); norm_mod_phase(F, args, l, 0, false, false); } SEAM(pb + PH_N1);
        if (IN(pb + PH_PROJ)) { PB();
            pg8::Gemm g{(const bf16*)(F.ws + WS_U), (const bf16*)(F.ws + WS_WIN) + (size_t)l * NPROJ * 1024, 1024, 1024, 1024};
            TileOrder S; S.init(MROWS / 256, NPROJ / 256, F.G, (int)blockIdx.x, 0);
            EpiProj E{(bf16*)(F.ws + WS_PROJ), (float*)(F.ws + WS_GB), (const float*)(F.ws + WS_ROPE), args.in[F.zz + 12] + l * 8, args.in[F.zz + 13] + l * 8};
            pg8::gemm_phase<EpiProj, TileOrder, true, true>(F.lds, g, S, E);
        } SEAM(pb + PH_PROJ);
        if (IN(pb + PH_ATT)) { PB();
            const bf16* P = (const bf16*)(F.ws + WS_PROJ); bf16* AO = (bf16*)(F.ws + WS_ATTO);
            const int nunits = 512 + (l == 0 ? 32 : 0);
#ifndef DIS_ATTN
#pragma unroll 1
            for (int u = F.vcu; u < nunits; u += F.G) {
                int b, hm, qrow, seq;
                if (u < 512) { b = u >> 7; hm = (u >> 4) & 7; qrow = CTXL + (u & 15) * 256; seq = RPB; }
                else { const int v = u - 512; b = v >> 3; hm = v & 7; qrow = 0; seq = CTXL; }
                const size_t r0 = (size_t)b * RPB;
                attn::attn_unit<NPROJ, DM>(P + (r0 + qrow) * NPROJ + PC_AQ + hm * 64, P + r0 * NPROJ + PC_AK + hm * 64, P + r0 * NPROJ + PC_AV + (hm >> 1) * 128,
                                           AO + (r0 + qrow) * DM + hm * 128, seq, ldsg);
            }
#endif
#ifndef DIS_DNPRE
#pragma unroll 1
            for (int u = F.vcu; u < NB * NCHUNK * 4; u += F.G) { const int h = u & 3, n = (u >> 2) % NCHUNK, b = (u >> 2) / NCHUNK; dn_pre_unit(F, args, l, b, n, h); }
#endif
#ifndef DIS_POOL
#pragma unroll 1
            for (int u = F.vcu; u < (MROWS / 64) * 4; u += F.G) pool_unit(F, args, l, u >> 2, u & 3);
#endif
        } SEAM(pb + PH_ATT);
        if (IN(pb + PH_SCAN)) { PB();
#pragma unroll 1
            for (int it = F.vcu; it < 128; it += F.G) dn_scan_item(F, it);
        } SEAM(pb + PH_SCAN);
        if (IN(pb + PH_MIXB)) { PB(); mix_build(F, args, l); } SEAM(pb + PH_MIXB);
#pragma unroll 1
        for (int s = 0; s < 3; ++s) {
            if (IN(pb + PH_MRG0 + s)) { PB();
                const int koff = s == 0 ? 0 : (s == 1 ? 512 : 768), ks = s == 0 ? 512 : 256;
                pg8::Gemm g{(const bf16*)(F.ws + WS_MIX) + koff, (const bf16*)(F.ws + WS_WBR) + (size_t)l * 1024 * 1024 + (size_t)1024 * koff, ks, 1024, ks};
                TileOrder S; S.init(l == 0 ? 68 : 64, 4, F.G, (int)blockIdx.x, l);
                EpiMerge E{(bf16*)(F.ws + WS_MG), (const bf16*)(F.ws + WS_PROJ), PC_GATE + s * 1024, s == 0};
                pg8::gemm_phase<EpiMerge, TileOrder, true, true>(F.lds, g, S, E);
            }
            if (s < 2) { if (IN(pb + PH_MRG0 + s)) { PB(); VM_WAIT(); __syncthreads(); } } else SEAM(pb + PH_MRG2);
        }
        if (IN(pb + PH_OUT)) { PB();
            pg8::Gemm g{(const bf16*)(F.ws + WS_MG), (const bf16*)(F.ws + WS_WOUT) + (size_t)l * 1024 * 1024, 1024, 1024, 1024};
            TileOrder S; S.init(l == 0 ? 68 : 64, 4, F.G, (int)blockIdx.x, l);
            EpiResid E{(float*)(F.ws + WS_H), modl, 2};
            pg8::gemm_phase<EpiResid, TileOrder, true, true>(F.lds, g, S, E);
        } SEAM(pb + PH_OUT);
        if (IN(pb + PH_N2)) { PB(); norm_mod_phase(F, args, l, 1, l == 1, l == 1); } SEAM(pb + PH_N2);
        if (l == 0) {
            if (IN(PH_FUP)) { PB();
                pg8::Gemm g{(const bf16*)(F.ws + WS_U), (const bf16*)(F.ws + WS_W13), 1024, 1024, 1024};
                TileOrder S; S.init(68, 2 * FFD / 256, F.G, (int)blockIdx.x, 0);
                EpiSwiglu E{(bf16*)(F.ws + WS_HID), FFD};
                pg8::gemm_phase<EpiSwiglu, TileOrder, true, true>(F.lds, g, S, E);
            } SEAM(PH_FUP);
            if (IN(PH_FDN)) { PB();
                pg8::Gemm g{(const bf16*)(F.ws + WS_HID), (const bf16*)(F.ws + WS_W2), FFD, FFD, FFD};
                TileOrder S; S.init(68, 4, F.G, (int)blockIdx.x, 0);
                EpiResid E{(float*)(F.ws + WS_H), modl, 5};
                pg8::gemm_phase<EpiResid, TileOrder, true, true>(F.lds, g, S, E);
            } SEAM(PH_FDN);
        }
    }
    if (IN(PH_GATH)) { PB(); moe_gather(F); } SEAM(PH_GATH);
#pragma unroll 1
    for (int hh = 0; hh < 2; ++hh) {
        const int p0 = PH_CV0 + 3 * hh;
        if (IN(p0)) { PB();
#ifdef DBG_DETPOS
            if (hh == 0) moe_gather2(F);
#endif
            moe_convert(F, args, hh); } SEAM(p0);
        if (IN(p0 + 1)) { PB();
            pg8::Gemm g{(const bf16*)(F.ws + WS_XG), (const bf16*)(F.ws + WS_W13M), 1024, 1024, 1024};
            MoeOrder S; S.init(F.ctl + CW_ECNT, FFE / 256, F.G, F.vcu);
            EpiSwiglu E{(bf16*)(F.ws + WS_HIDM), FFEH};
            pg8::gemm_phase<EpiSwiglu, MoeOrder, true, true>(F.lds, g, S, E);
        } SEAM(p0 + 1);
        if (IN(p0 + 2)) { PB();
            pg8::Gemm g{(const bf16*)(F.ws + WS_HIDM), (const bf16*)(F.ws + WS_W2M), FFEH, FFEH, FFEH};
            MoeOrder S; S.init(F.ctl + CW_ECNT, 4, F.G, F.vcu);
            EpiY E{(bf16*)(F.ws + WS_Y), hh == 0};
            pg8::gemm_phase<EpiY, MoeOrder, true, true>(F.lds, g, S, E);
        } SEAM(p0 + 2);
    }
    if (IN(PH_FIN)) { PB(); final_phase(F, args); }
#ifdef DBG_STOP
    if (lo == 100) {
        const int gw = F.vcu * NWAVES + F.wave, NGW = F.G * NWAVES;
        for (int tk = gw; tk < NB * SEQ; tk += NGW) { const int b = tk / SEQ, t = tk - b * SEQ; const size_t R = (size_t)b * RPB + CTXL + t;
#if DBG_SRC == 0
            const f32x4* s = (const f32x4*)((const float*)(args.ws + WS_H) + R * DM) + F.lane; f32x4* d = (f32x4*)(args.out + (size_t)tk * DM) + F.lane;
            for (int q = 0; q < 4; ++q) d[64 * q] = s[64 * q];
#elif DBG_SRC == 2
            MoeOrder mo; mo.init((gu32*)args.ws + CW_ECNT, 1, 1, 0); const v4u rt = ((const v4u*)(args.ws + WS_ROUTE))[2 * tk];
            const size_t rr = (size_t)mo.tile_off((int)rt.x) * 256 + rt.z; (void)R;
            const bf16* s = (const bf16*)(args.ws + DBG_OFF) + rr * DBG_LD + DBG_COL; float* d = args.out + (size_t)tk * DM;
            for (int q = 0; q < 16; ++q) d[F.lane + 64 * q] = bf2f(s[F.lane + 64 * q]);
#else
            const bf16* s = (const bf16*)(args.ws + DBG_OFF) + R * DBG_LD + DBG_COL; float* d = args.out + (size_t)tk * DM;
            for (int q = 0; q < 16; ++q) d[F.lane + 64 * q] = bf2f(s[F.lane + 64 * q]);
#endif
        }
    }
#endif
#undef IN
#undef SEAM
}

extern "C" void kernel_launch(void* const* d_in, const int* in_sizes, int n_in, void* d_out, int out_size, void* d_ws, size_t ws_size, hipStream_t stream) {
    static int grid = 0;
    if (grid == 0) {
        if (n_in != 27 || in_sizes[0] != NB * SEQ * DM || out_size != NB * SEQ * DM || ws_size < WS_END) {
            fprintf(stderr, "kernel_launch: shape / workspace mismatch (n_in %d, in0 %d, out %d, ws %zu, need %zu); nothing launched\n", n_in, n_in > 0 ? in_sizes[0] : -1, out_size, ws_size, (size_t)WS_END); grid = -1; return; }
        int dev = 0, cus = 0, per_cu = 0;
        if (hipGetDevice(&dev) != hipSuccess || hipDeviceGetAttribute(&cus, hipDeviceAttributeMultiprocessorCount, dev) != hipSuccess) { grid = -1; return; }
        if (hipFuncSetAttribute((const void*)mk_fwd, hipFuncAttributeMaxDynamicSharedMemorySize, LDS_BYTES) != hipSuccess) { fprintf(stderr, "kernel_launch: hipFuncSetAttribute failed\n"); grid = -1; return; }
        if (hipOccupancyMaxActiveBlocksPerMultiprocessor(&per_cu, (const void*)mk_fwd, NTHR, LDS_BYTES) != hipSuccess || per_cu < 1)
            fprintf(stderr, "kernel_launch: note: occupancy query reports %d workgroups per CU\n", per_cu);
        (void)hipGetLastError();
        grid = cus;
    }
    if (grid < 0) return;
    if (hipMemsetAsync((char*)d_ws + WS_CTL, 0, CTL_ZERO_BYTES, stream) != hipSuccess) return;
    Args a{};
    for (int i = 0; i < 27; ++i) a.in[i] = (const float*)d_in[i];
    a.out = (float*)d_out; a.ws = (unsigned char*)d_ws;
    constexpr int NL = MK_N_LAUNCHES;
#ifdef DBG_STOP
    constexpr int NLL = DBG_STOP + 2;
#else
    constexpr int NLL = NL;
#endif
    for (int li = 0; li < NLL; ++li) {
#ifdef DBG_SKIP_LO
        if (li >= DBG_SKIP_LO && li <= DBG_SKIP_HI) continue;
#endif
        a.ph_lo = (NL == 1) ? 0 : li; a.ph_hi = (NL == 1) ? PH_COUNT : li + 1;
#ifdef DBG_STOP
        if (li == NLL - 1) { a.ph_lo = 100; a.ph_hi = 101; }
#endif
        hipLaunchKernelGGL(mk_fwd, dim3(grid), dim3(NTHR), LDS_BYTES, stream, a);
        const hipError_t le = hipPeekAtLastError();
        if (le != hipSuccess) { fprintf(stderr, "kernel_launch: launch %d failed: %s\n", li, hipGetErrorName(le)); break; }
    }
}
```

```cpp
#include <hip/hip_runtime.h>
#include <cstdio>
#include <cstdint>
#include <cmath>

namespace pg8 {
#define PG8_LAS __attribute__((address_space(3)))
typedef unsigned short bf16_t;
typedef short bf16x8 __attribute__((ext_vector_type(8)));
typedef float f32x4 __attribute__((ext_vector_type(4)));
typedef unsigned u32x4 __attribute__((ext_vector_type(4)));
typedef unsigned u32x2 __attribute__((ext_vector_type(2)));
constexpr int BM = 256, BK = 64, HALF = 128, HTB = HALF * BK * 2  , STAGE_BYTES = 8 * HTB;

__host__ __device__ __forceinline__ int lds_byte(int r, int c) { const int st = (r >> 4) * 2 + (c >> 5), rr = r & 15, cc = c & 31, ob = rr * 64 + cc * 2; return st * 1024 + (ob ^ (((ob >> 9) & 1) << 5)); }
__host__ __device__ __forceinline__ void stage_rc(int b, int& R, int& C) { const int st = b / 1024, sb = b % 1024, swz = sb ^ (((sb >> 9) & 1) << 5); R = (st >> 1) * 16 + swz / 64; C = (st & 1) * 32 + (swz % 64) / 2; }
__host__ __device__ __forceinline__ int perm32(int rho) { const int n = rho >> 4, i = rho & 15; return 8 * (i >> 2) + 4 * n + (i & 3); }

struct Unit { int pm, pn, pb; };
struct Gemm { const bf16_t* A; const bf16_t* Bt; int K, lda, ldb; };

__device__ __forceinline__ unsigned cvt_pk_bf16(float lo, float hi) { unsigned r; asm volatile("v_cvt_pk_bf16_f32 %0, %1, %2" : "=v"(r) : "v"(lo), "v"(hi)); return r; }
template <class Epi, class Sched, bool ALIGN_EPI = false, bool SP2 = false>
__device__ __forceinline__ void gemm_phase(PG8_LAS unsigned char* lds, const Gemm g, const Sched& S, const Epi& E) {
    int tid = threadIdx.x; asm volatile("" : "+v"(tid)); const int wid = __builtin_amdgcn_readfirstlane(tid >> 6), lane = tid & 63, wr = wid >> 2, wc = wid & 3, fr = lane & 15, fq = lane >> 4;
    const int K = g.K, nt = K / BK;
    unsigned voffA[2], voffB[2];
#pragma unroll
    for (int i = 0; i < 2; ++i) { int R, C; stage_rc(tid * 16 + i * 8192, R, C); const int Rb = Epi::PERM ? ((R & ~31) + perm32(R & 31)) : R;
        voffA[i] = (unsigned)(R * g.lda + C) * 2u; voffB[i] = (unsigned)(Rb * g.ldb + C) * 2u; }
    const size_t kstep = (size_t)(BK * 2);
    const size_t hstepA = (size_t)HALF * g.lda * 2, hstepB = (size_t)HALF * g.ldb * 2;
    const size_t tstepA = 2 * hstepA, tstepB = 2 * hstepB;
    const unsigned ldsw = (unsigned)wid * 1024u;
    const int aoff = lds_byte(wr * 64 + fr, fq * 8), boff = lds_byte(wc * 32 + fr, fq * 8);
#define PG8_SA(b, h) (((b) * 2 + (h)) * HTB)
#define PG8_SB(b, h) ((4 + (b) * 2 + (h)) * HTB)
#define PG8_STAGE(bufoff, gbase, voff) do { _Pragma("unroll") for (int _i = 0; _i < 2; ++_i) \
        __builtin_amdgcn_global_load_lds((const unsigned*)((const char*)(gbase) + (voff)[_i]), (PG8_LAS unsigned*)(lds + (bufoff) + ldsw + _i * 8192), 16, 0, 0); } while (0)
#define PG8_LDA(dst, b, h) do { _Pragma("unroll") for (int m = 0; m < 4; ++m) _Pragma("unroll") for (int k = 0; k < 2; ++k) dst[m][k] = *(const PG8_LAS bf16x8*)(lds + PG8_SA(b, h) + aoff + m * 2048 + k * 1024); } while (0)
#define PG8_LDB(dst, b, h) do { _Pragma("unroll") for (int n = 0; n < 2; ++n) _Pragma("unroll") for (int k = 0; k < 2; ++k) dst[n][k] = *(const PG8_LAS bf16x8*)(lds + PG8_SB(b, h) + boff + n * 2048 + k * 1024); } while (0)
#define PG8_MMA(ai, bj, At, Bt) do { __builtin_amdgcn_s_setprio(1); _Pragma("unroll") for (int m = 0; m < 4; ++m) _Pragma("unroll") for (int n = 0; n < 2; ++n) _Pragma("unroll") for (int k = 0; k < 2; ++k) \
        acc[ai][bj][m][n] = __builtin_amdgcn_mfma_f32_16x16x32_bf16(Bt[n][k], At[m][k], acc[ai][bj][m][n], 0, 0, 0); __builtin_amdgcn_s_setprio(0); } while (0)
#define PG8_WAIT_V(n) asm volatile("s_waitcnt vmcnt(" #n ")" ::: "memory")
#define PG8_WAIT_L(n) asm volatile("s_waitcnt lgkmcnt(" #n ")" ::: "memory")
#define PG8_BAR __builtin_amdgcn_s_barrier()
#define PG8_SCHED __builtin_amdgcn_sched_barrier(0)
    Unit cur, nxt; int ui = 0;
    if (!S.next(0, cur)) return;
    f32x4 acc[2][2][4][2];
#pragma unroll
    for (int a = 0; a < 2; ++a)
#pragma unroll
        for (int b = 0; b < 2; ++b)
#pragma unroll
            for (int m = 0; m < 4; ++m)
#pragma unroll
                for (int n = 0; n < 2; ++n) acc[a][b][m][n] = (f32x4){0.f, 0.f, 0.f, 0.f};
    bf16x8 At[4][2], B0[2][2], B1[2][2];
    const char* cA = (const char*)g.A + (size_t)cur.pm * tstepA; const char* cB = (const char*)g.Bt + (size_t)cur.pb * tstepB;
    S.a_ready(cur);
    if constexpr (SP2) {
        PG8_STAGE(PG8_SB(0, 0), cB, voffB); PG8_STAGE(PG8_SB(0, 1), cB + hstepB, voffB); PG8_STAGE(PG8_SA(0, 0), cA, voffA); PG8_STAGE(PG8_SA(0, 1), cA + hstepA, voffA);
        if (wr == 1) PG8_BAR;
        PG8_WAIT_V(2); PG8_BAR;
        PG8_STAGE(PG8_SB(1, 0), cB + kstep, voffB); PG8_STAGE(PG8_SA(1, 0), cA + kstep, voffA); PG8_STAGE(PG8_SB(1, 1), cB + hstepB + kstep, voffB);
        PG8_WAIT_V(6); PG8_BAR;
    } else {
        PG8_STAGE(PG8_SB(0, 0), cB, voffB); PG8_STAGE(PG8_SA(0, 0), cA, voffA); PG8_STAGE(PG8_SB(0, 1), cB + hstepB, voffB); PG8_STAGE(PG8_SA(0, 1), cA + hstepA, voffA);
        if (wr == 1) PG8_BAR;
        PG8_WAIT_V(4); PG8_BAR;
        PG8_STAGE(PG8_SB(1, 0), cB + kstep, voffB); PG8_STAGE(PG8_SA(1, 0), cA + kstep, voffA); PG8_STAGE(PG8_SB(1, 1), cB + hstepB + kstep, voffB);
        PG8_WAIT_V(6); PG8_BAR;
    }
    for (;;) {
        const bool has_next = S.next(ui + 1, nxt);
        const char* nA = has_next ? (const char*)g.A + (size_t)nxt.pm * tstepA : cA; const char* nB = has_next ? (const char*)g.Bt + (size_t)nxt.pb * tstepB : cB;
        for (int t = 0; t < nt; t += 2) {
            const bool last = (t == nt - 2);
            const char* a1 = cA + (size_t)(t + 1) * kstep;
            const char* a2 = last ? nA : cA + (size_t)(t + 2) * kstep; const char* b2 = last ? nB : cB + (size_t)(t + 2) * kstep;
            const char* a3 = a2 + kstep; const char* b3 = b2 + kstep;
            if (last && has_next) S.a_ready(nxt);
            if constexpr (SP2) {
            PG8_LDB(B0, 0, 0); PG8_LDB(B1, 0, 1); PG8_SCHED; PG8_LDA(At, 0, 0); PG8_STAGE(PG8_SA(1, 1), a1 + hstepA, voffA);
            PG8_WAIT_V(8); PG8_WAIT_L(0); PG8_BAR; PG8_MMA(0, 0, At, B0); PG8_MMA(0, 1, At, B1); PG8_BAR; PG8_SCHED;
            PG8_LDA(At, 0, 1); PG8_STAGE(PG8_SB(0, 0), b2, voffB); PG8_STAGE(PG8_SB(0, 1), b2 + hstepB, voffB); PG8_STAGE(PG8_SA(0, 0), a2, voffA);
            PG8_WAIT_V(8); PG8_WAIT_L(0); PG8_BAR; PG8_MMA(1, 0, At, B0); PG8_MMA(1, 1, At, B1); PG8_BAR; PG8_SCHED;
            PG8_LDB(B0, 1, 0); PG8_LDB(B1, 1, 1); PG8_SCHED; PG8_LDA(At, 1, 0); PG8_STAGE(PG8_SA(0, 1), a2 + hstepA, voffA);
            PG8_WAIT_V(8); PG8_WAIT_L(0); PG8_BAR; PG8_MMA(0, 0, At, B0); PG8_MMA(0, 1, At, B1); PG8_BAR; PG8_SCHED;
            PG8_LDA(At, 1, 1); PG8_STAGE(PG8_SB(1, 0), b3, voffB); PG8_STAGE(PG8_SB(1, 1), b3 + hstepB, voffB); PG8_STAGE(PG8_SA(1, 0), a3, voffA);
            PG8_WAIT_V(8); PG8_WAIT_L(0); PG8_BAR; PG8_MMA(1, 0, At, B0); PG8_MMA(1, 1, At, B1); PG8_BAR; PG8_SCHED;
            } else {
            PG8_LDB(B0, 0, 0); PG8_SCHED; PG8_LDA(At, 0, 0); PG8_STAGE(PG8_SA(1, 1), a1 + hstepA, voffA);
            PG8_WAIT_L(8); PG8_BAR; PG8_WAIT_L(0); PG8_MMA(0, 0, At, B0); PG8_BAR; PG8_SCHED;
            PG8_LDB(B1, 0, 1); PG8_STAGE(PG8_SB(0, 0), b2, voffB);
            PG8_BAR; PG8_WAIT_L(0); PG8_MMA(0, 1, At, B1); PG8_BAR;
            PG8_LDA(At, 0, 1); PG8_STAGE(PG8_SA(0, 0), a2, voffA);
            PG8_BAR; PG8_WAIT_L(0); PG8_MMA(1, 0, At, B0); PG8_BAR; PG8_SCHED;
            PG8_STAGE(PG8_SB(0, 1), b2 + hstepB, voffB);
            PG8_WAIT_V(6); PG8_BAR; PG8_MMA(1, 1, At, B1); PG8_BAR;
            PG8_LDB(B0, 1, 0); PG8_SCHED; PG8_LDA(At, 1, 0); PG8_STAGE(PG8_SA(0, 1), a2 + hstepA, voffA);
            PG8_WAIT_L(8); PG8_BAR; PG8_WAIT_L(0); PG8_MMA(0, 0, At, B0); PG8_BAR; PG8_SCHED;
            PG8_LDB(B1, 1, 1); PG8_STAGE(PG8_SB(1, 0), b3, voffB);
            PG8_BAR; PG8_WAIT_L(0); PG8_MMA(0, 1, At, B1); PG8_BAR;
            PG8_LDA(At, 1, 1); PG8_STAGE(PG8_SA(1, 0), a3, voffA);
            PG8_BAR; PG8_WAIT_L(0); PG8_MMA(1, 0, At, B0); PG8_BAR; PG8_SCHED;
            PG8_STAGE(PG8_SB(1, 1), b3 + hstepB, voffB);
            PG8_WAIT_V(6); PG8_BAR; PG8_MMA(1, 1, At, B1); PG8_BAR;
            }
        }
        if constexpr (ALIGN_EPI) { if (wr == 0) PG8_BAR; }
        if constexpr (!Epi::AFTER_DRAIN) { E(acc, cur, wr, wc, fr, fq); S.done(cur); }
        if (!has_next) break;
#pragma unroll
        for (int a = 0; a < 2; ++a)
#pragma unroll
            for (int b = 0; b < 2; ++b)
#pragma unroll
                for (int m = 0; m < 4; ++m)
#pragma unroll
                    for (int n = 0; n < 2; ++n) acc[a][b][m][n] = (f32x4){0.f, 0.f, 0.f, 0.f};
        cur = nxt; cA = nA; cB = nB; ++ui;
        if constexpr (ALIGN_EPI) { if (wr == 1) PG8_BAR; }
    }
    PG8_WAIT_V(0);
    if constexpr (!ALIGN_EPI) { if (wr == 0) PG8_BAR; }
    PG8_BAR;
    if constexpr (Epi::AFTER_DRAIN) { E.fused(acc, cur, wr, wc, fr, fq, lds, wid, lane); S.done(cur); }
#undef PG8_SA
#undef PG8_SB
#undef PG8_STAGE
#undef PG8_LDA
#undef PG8_LDB
#undef PG8_MMA
#undef PG8_WAIT_V
#undef PG8_WAIT_L
#undef PG8_BAR
#undef PG8_SCHED
}
}

namespace attn {
using bf16x8 = __attribute__((ext_vector_type(8))) short;
using s16x4  = __attribute__((ext_vector_type(4))) short;
using f32x16 = __attribute__((ext_vector_type(16))) float;
using u32x4  = __attribute__((ext_vector_type(4))) unsigned;
constexpr int DV = 128, DK = 64, NW = 8, QBLK = 32, KVBLK = 64;
constexpr float SCALE = 0.125f;
constexpr float THR = 4.f;
constexpr size_t SHM_V = KVBLK * DV * 2, SHM_K = KVBLK * DK * 2, SHM_ATTN = 2 * SHM_V + 2 * SHM_K + NW * 64 * 4;
#define AKSWZ(row, colB) ((row) * 128 + ((colB) ^ ((((row) >> 1) & 7) << 4)))
#define ASBAR() __builtin_amdgcn_sched_barrier(0)
__device__ __forceinline__ int crow(int r, int hi) { return (r & 3) + 8 * (r >> 2) + 4 * hi; }
__device__ __forceinline__ unsigned cvtpk(float lo, float hi) { unsigned r; asm volatile("v_cvt_pk_bf16_f32 %0, %1, %2" : "=v"(r) : "v"(lo), "v"(hi)); return r; }

__device__ __forceinline__ void partialSM(f32x16& p0, f32x16& p1, float& m_reg, float& mn, float& alpha) {
  constexpr float C = SCALE * 1.4426950408889634f;
  float pmax = p0[0];
#pragma unroll
  for (int r = 1; r < 16; ++r) pmax = fmaxf(pmax, p0[r]);
#pragma unroll
  for (int r = 0; r < 16; ++r) pmax = fmaxf(pmax, p1[r]);
  { auto rr = __builtin_amdgcn_permlane32_swap(__float_as_uint(pmax), __float_as_uint(pmax), false, false);
    pmax = fmaxf(__uint_as_float(rr[0]), __uint_as_float(rr[1])); }
  if (__builtin_expect(__all(pmax - m_reg <= THR / SCALE), 1)) { mn = m_reg; alpha = 1.f; }
  else { mn = fmaxf(m_reg, pmax); alpha = __builtin_amdgcn_exp2f((m_reg - mn) * C); m_reg = mn; }
  const float mnC = -mn * C;
#pragma unroll
  for (int r = 0; r < 16; ++r) p0[r] = fmaf(p0[r], C, mnC);
#pragma unroll
  for (int r = 0; r < 16; ++r) p1[r] = fmaf(p1[r], C, mnC);
#pragma unroll
  for (int r = 0; r < 16; ++r) p0[r] = __builtin_amdgcn_exp2f(p0[r]);
}
__device__ __forceinline__ void finishSM(f32x16& p0, f32x16& p1, float alpha, float& l_reg, bf16x8& pa0, bf16x8& pa1, bf16x8& pa2, bf16x8& pa3) {
#pragma unroll
  for (int r = 0; r < 16; ++r) p1[r] = __builtin_amdgcn_exp2f(p1[r]);
  float ps = 0;
#pragma unroll
  for (int r = 0; r < 16; ++r) ps += p0[r];
#pragma unroll
  for (int r = 0; r < 16; ++r) ps += p1[r];
  { auto rr = __builtin_amdgcn_permlane32_swap(__float_as_uint(ps), __float_as_uint(ps), false, false);
    ps = __uint_as_float(rr[0]) + __uint_as_float(rr[1]); }
  l_reg = l_reg * alpha + ps;
#define APK4(P, BASE, OUT) do { unsigned a0 = cvtpk(P[BASE + 0], P[BASE + 1]), a1 = cvtpk(P[BASE + 2], P[BASE + 3]);   \
    unsigned b0 = cvtpk(P[BASE + 4], P[BASE + 5]), b1 = cvtpk(P[BASE + 6], P[BASE + 7]);                              \
    auto r0 = __builtin_amdgcn_permlane32_swap(a0, b0, false, false); auto r1 = __builtin_amdgcn_permlane32_swap(a1, b1, false, false); \
    u32x4 w = {r0[0], r1[0], r0[1], r1[1]}; OUT = *reinterpret_cast<bf16x8*>(&w); } while (0)
  APK4(p0, 0, pa0); APK4(p0, 8, pa1); APK4(p1, 0, pa2); APK4(p1, 8, pa3);
#undef APK4
}
__device__ __forceinline__ void qkt(f32x16& p0, f32x16& p1, const char* Ks, const bf16x8* qr, int r32, int hi) {
  p0 = f32x16{}; p1 = f32x16{};
#pragma unroll
  for (int d0 = 0; d0 < 4; ++d0) { const int cb = (d0 * 16 + hi * 8) * 2;
    bf16x8 b0 = *reinterpret_cast<const bf16x8*>(Ks + AKSWZ(r32, cb));
    bf16x8 b1 = *reinterpret_cast<const bf16x8*>(Ks + AKSWZ(32 + r32, cb));
    p0 = __builtin_amdgcn_mfma_f32_32x32x16_bf16(b0, qr[d0], p0, 0, 0, 0);
    p1 = __builtin_amdgcn_mfma_f32_32x32x16_bf16(b1, qr[d0], p1, 0, 0, 0); }
}
__device__ __forceinline__ int v_st(int k, int c) { const int kk = (k & ~0xC) | ((k & 4) << 1) | ((k & 8) >> 1); return ((kk >> 3) * 4 + (c >> 5)) * 512 + ((kk & 7) * 32 + (c & 31)) * 2; }
__device__ __forceinline__ int v_rd_base(int lane) { return ((lane & 3) << 3) | (((lane >> 2) & 3) << 6) | (((lane >> 4) & 1) << 5) | (((lane >> 5) & 1) << 8); }
constexpr int v_rd_off(int d0, int ks, int half) { return d0 * 512 + ks * 4096 + half * 2048; }
template <int OFF> __device__ __forceinline__ s16x4 tr_read(int vb) {
  s16x4 r; asm volatile("ds_read_b64_tr_b16 %0, %1 offset:%2" : "=&v"(r) : "v"(vb), "i"(OFF) : "memory"); return r;
}
template <int D0> __device__ __forceinline__ void pv_one(f32x16& od, int vb, bf16x8 pa0, bf16x8 pa1, bf16x8 pa2, bf16x8 pa3) {
  const s16x4 l0 = tr_read<v_rd_off(D0, 0, 0)>(vb), h0 = tr_read<v_rd_off(D0, 0, 1)>(vb), l1 = tr_read<v_rd_off(D0, 1, 0)>(vb), h1 = tr_read<v_rd_off(D0, 1, 1)>(vb);
  const s16x4 l2 = tr_read<v_rd_off(D0, 2, 0)>(vb), h2 = tr_read<v_rd_off(D0, 2, 1)>(vb), l3 = tr_read<v_rd_off(D0, 3, 0)>(vb), h3 = tr_read<v_rd_off(D0, 3, 1)>(vb);
  asm volatile("s_waitcnt lgkmcnt(0)" ::: "memory"); ASBAR();
#define APK(L, H) (bf16x8){L[0], L[1], L[2], L[3], H[0], H[1], H[2], H[3]}
  od = __builtin_amdgcn_mfma_f32_32x32x16_bf16(pa0, APK(l0, h0), od, 0, 0, 0);
  od = __builtin_amdgcn_mfma_f32_32x32x16_bf16(pa1, APK(l1, h1), od, 0, 0, 0);
  od = __builtin_amdgcn_mfma_f32_32x32x16_bf16(pa2, APK(l2, h2), od, 0, 0, 0);
  od = __builtin_amdgcn_mfma_f32_32x32x16_bf16(pa3, APK(l3, h3), od, 0, 0, 0);
#undef APK
}
__device__ __forceinline__ void pv_d0(f32x16* o, int vb, bf16x8 pa0, bf16x8 pa1, bf16x8 pa2, bf16x8 pa3) {
  pv_one<0>(o[0], vb, pa0, pa1, pa2, pa3); pv_one<1>(o[1], vb, pa0, pa1, pa2, pa3); pv_one<2>(o[2], vb, pa0, pa1, pa2, pa3); pv_one<3>(o[3], vb, pa0, pa1, pa2, pa3);
}
template <int LDQ, int LDO>
__device__ __forceinline__ void attn_unit(const unsigned short* __restrict__ Qb, const unsigned short* __restrict__ Kh, const unsigned short* __restrict__ Vh,
                                          unsigned short* __restrict__ Ob, int seq, char* lds) {
  int tid = threadIdx.x; asm volatile("" : "+v"(tid)); const int wid = tid >> 6, lane = tid & 63, r32 = lane & 31, hi = lane >> 5;
  char* V_lds = lds; char* K_lds = lds + 2 * SHM_V;
  float* ws = (float*)(lds + 2 * SHM_V + 2 * SHM_K) + wid * 64; float* li_l = ws; float* al_l = ws + 32;
  float m_reg = -1e30f, l_reg = 0; f32x16 o[4] = {}; bf16x8 qr[4];
  const unsigned short* Qw = Qb + (long)(wid * QBLK + r32) * LDQ + hi * 8;
#pragma unroll
  for (int d0 = 0; d0 < 4; ++d0) qr[d0] = *reinterpret_cast<const bf16x8*>(Qw + d0 * 16);
  const int sr = tid >> 4, sc = (tid & 15) * 8, vst0 = v_st(sr, sc), vst1 = v_st(32 + sr, sc);
  const int kr = tid >> 3, kc = (tid & 7) * 8, kst = AKSWZ(kr, kc * 2);
  const int vb0 = (int)(uintptr_t)V_lds + v_rd_base(lane);
  bf16x8 sv0[2], sv1[2], sk0[2];
#define ASLOAD(i, k0) do { sv0[i] = *reinterpret_cast<const bf16x8*>(&Vh[(long)((k0) + sr) * LDQ + sc]); sv1[i] = *reinterpret_cast<const bf16x8*>(&Vh[(long)((k0) + 32 + sr) * LDQ + sc]); \
    sk0[i] = *reinterpret_cast<const bf16x8*>(&Kh[(long)((k0) + kr) * LDQ + kc]); } while (0)
#define ASWRITE(b, i) do { *(bf16x8*)(V_lds + (b) * SHM_V + vst0) = sv0[i]; *(bf16x8*)(V_lds + (b) * SHM_V + vst1) = sv1[i]; \
    *(bf16x8*)(K_lds + (b) * SHM_K + kst) = sk0[i]; } while (0)
#define ASWAIT() asm volatile("s_waitcnt vmcnt(3)" ::: "memory")
#define ARESC(a) do { if (__any((a) < 1.f)) { if (hi == 0) al_l[r32] = (a); asm volatile("s_waitcnt lgkmcnt(0)" ::: "memory"); \
    _Pragma("unroll") for (int d = 0; d < 4; ++d) _Pragma("unroll") for (int r = 0; r < 16; ++r) o[d][r] *= al_l[crow(r, hi)]; } } while (0)
  f32x16 pA0, pA1, pB0, pB1; float mnA, mnB, alA, alB; bf16x8 pa0, pa1, pa2, pa3; const int NT = seq / KVBLK;
  ASLOAD(0, 0); asm volatile("s_waitcnt vmcnt(0)" ::: "memory"); ASWRITE(0, 0); __syncthreads();
  qkt(pA0, pA1, K_lds, qr, r32, hi); partialSM(pA0, pA1, m_reg, mnA, alA);
  ASLOAD(1, KVBLK); if (2 < NT) ASLOAD(0, 2 * KVBLK);
  if (2 < NT) ASWAIT(); else asm volatile("s_waitcnt vmcnt(0)" ::: "memory");
  ASWRITE(1, 1); __syncthreads();
  for (int j = 1; j + 1 < NT; j += 2) {
    ASBAR(); qkt(pB0, pB1, K_lds + SHM_K, qr, r32, hi);
    finishSM(pA0, pA1, alA, l_reg, pa0, pa1, pa2, pa3); ASBAR();
    ASLOAD(1, (j + 2) * KVBLK); ASBAR();
    pv_d0(o, vb0, pa0, pa1, pa2, pa3); partialSM(pB0, pB1, m_reg, mnB, alB);
    __syncthreads(); ASWAIT(); ASWRITE(0, 0);
    ARESC(alB); __syncthreads();
    ASBAR(); qkt(pA0, pA1, K_lds, qr, r32, hi);
    finishSM(pB0, pB1, alB, l_reg, pa0, pa1, pa2, pa3); ASBAR();
    if (j + 3 < NT) ASLOAD(0, (j + 3) * KVBLK); ASBAR();
    pv_d0(o, vb0 + (int)SHM_V, pa0, pa1, pa2, pa3); partialSM(pA0, pA1, m_reg, mnA, alA);
    __syncthreads(); if (j + 3 < NT) ASWAIT(); else asm volatile("s_waitcnt vmcnt(0)" ::: "memory");
    ASWRITE(1, 1);
    ARESC(alA); __syncthreads();
  }
  ASBAR(); qkt(pB0, pB1, K_lds + SHM_K, qr, r32, hi);
  finishSM(pA0, pA1, alA, l_reg, pa0, pa1, pa2, pa3); ASBAR();
  pv_d0(o, vb0, pa0, pa1, pa2, pa3); partialSM(pB0, pB1, m_reg, mnB, alB);
  __syncthreads(); ARESC(alB);
  finishSM(pB0, pB1, alB, l_reg, pa0, pa1, pa2, pa3); ASBAR();
  pv_d0(o, vb0 + (int)SHM_V, pa0, pa1, pa2, pa3);
  if (hi == 0) li_l[r32] = l_reg; asm volatile("s_waitcnt lgkmcnt(0)" ::: "memory");
  float rli[16];
#pragma unroll
  for (int r = 0; r < 16; ++r) rli[r] = __builtin_amdgcn_rcpf(li_l[crow(r, hi)]);
  unsigned short* Ow = Ob + (long)(wid * QBLK) * LDO;
#pragma unroll
  for (int r = 0; r < 16; ++r) { const int orow = crow(r, hi);
#pragma unroll
    for (int d0 = 0; d0 < 4; ++d0) { const float v = o[d0][r] * rli[r]; Ow[(long)orow * LDO + d0 * 32 + r32] = (unsigned short)(cvtpk(v, v) & 0xffffu); } }
  __syncthreads();
#undef ASLOAD
#undef ASWRITE
#undef ASWAIT
#undef ARESC
}
}

constexpr int NWAVES = 8, NTHR = NWAVES * 64;
constexpr int DM = 1024, NB = 4, SEQ = 4096, CTXL = 256, RPB = CTXL + SEQ  , MROWS = NB * RPB  ;
constexpr int INW = 5904, NPROJ = 6144;
constexpr int FFD = 2816, FFE = 3584, NEXP = 8, FFEH = FFE / 2;
constexpr int NCHUNK = RPB / 64;
constexpr float EPSN = 1e-6f;
constexpr int PC_AQ = 0, PC_AK = 512, PC_AV = 1024, PC_DQ = 1536, PC_DK = 1792, PC_DV = 2048, PC_DZ = 2304, PC_POOL = 2560, PC_GATE = 2816, PC_AB = 5888;

constexpr size_t MiB = 1u << 20;
constexpr size_t WS_CTL = 0, CTL_ZERO_BYTES = 2 * MiB;
constexpr size_t WS_MOD = 1 * MiB;
constexpr size_t WS_ROPE = 2 * MiB;
constexpr size_t WS_LAM = 2 * MiB + 65536;
constexpr size_t WS_ROUTE = 3 * MiB;
constexpr size_t WS_GB = 4 * MiB;
constexpr size_t WS_WIN = 8 * MiB;
constexpr size_t WS_WBR = 32 * MiB;
constexpr size_t WS_WOUT = 36 * MiB;
constexpr size_t WS_W13 = 40 * MiB;
constexpr size_t WS_W2 = 51 * MiB;
constexpr size_t WS_H = 58 * MiB;
constexpr size_t WS_U = 126 * MiB;
constexpr size_t WS_ATTO = WS_U;
constexpr size_t WS_PROJ = 160 * MiB;
constexpr size_t WS_MIX = 364 * MiB;
constexpr size_t WS_DNP = 398 * MiB;
constexpr size_t WS_MG = WS_DNP;
constexpr size_t WS_DNG = 466 * MiB;
constexpr size_t WS_DNO = 467 * MiB;
constexpr size_t WS_HID = WS_PROJ;
constexpr int MOE_MAXT = 136;
constexpr size_t WS_XG = 160 * MiB;
constexpr size_t WS_Y = 228 * MiB;
constexpr size_t WS_W13M = 296 * MiB;
constexpr size_t WS_W2M = 352 * MiB;
constexpr size_t WS_HIDM = 380 * MiB;
constexpr size_t WS_END = 500 * MiB;
static_assert(WS_HIDM + (size_t)MOE_MAXT * 256 * FFEH * 2 <= WS_END && WS_DNO + (size_t)2 * MROWS * 256 * 2 <= WS_END, "ws map");
static_assert(WS_WIN + (size_t)2 * NPROJ * 1024 * 2 <= WS_WBR && WS_W13 + (size_t)2 * FFD * 1024 * 2 <= WS_W2 && WS_W2 + (size_t)1024 * FFD * 2 <= WS_H, "ws map (weights)");
static_assert(WS_H + (size_t)MROWS * 1024 * 4 <= WS_U && WS_U + (size_t)MROWS * 1024 * 2 <= WS_PROJ && WS_PROJ + (size_t)MROWS * NPROJ * 2 <= WS_MIX, "ws map (acts)");
static_assert(WS_MIX + (size_t)MROWS * 1024 * 2 <= WS_DNP && WS_DNP + (size_t)NB * NCHUNK * 4 * 2 * 32768 <= WS_DNG, "ws map (dn)");
static_assert(WS_XG + (size_t)MOE_MAXT * 256 * 1024 * 2 <= WS_Y && WS_Y + (size_t)MOE_MAXT * 256 * 1024 * 2 <= WS_W13M && WS_W13M + (size_t)8 * FFE * 1024 * 2 <= WS_W2M && WS_W2M + (size_t)8 * 1024 * FFEH * 2 <= WS_HIDM, "ws map (moe)");
constexpr int CW_TMO = 0, CW_CODE = 1;
constexpr int CW_BAR = 4096;
constexpr int CW_ECNT = 8192;

constexpr int RING_BYTES = 155648;
constexpr int MISC_OFF = RING_BYTES;
constexpr int LDS_BYTES = RING_BYTES + 1024;

enum { PH_PRO = 0, PH_L0 = 1, PH_N1 = 0, PH_PROJ = 1, PH_ATT = 2, PH_SCAN = 3, PH_MIXB = 4, PH_MRG0 = 5, PH_MRG1 = 6, PH_MRG2 = 7, PH_OUT = 8, PH_N2 = 9, PH_LAYER = 10,
       PH_FUP = 11, PH_FDN = 12, PH_L1 = 13, PH_GATH = 23, PH_CV0 = 24, PH_UP0 = 25, PH_DN0 = 26, PH_CV1 = 27, PH_UP1 = 28, PH_DN1 = 29, PH_FIN = 30, PH_COUNT = 31 };

#define GAS __attribute__((address_space(1)))
#define LAS __attribute__((address_space(3)))
typedef unsigned short bf16;
typedef unsigned v4u __attribute__((ext_vector_type(4)));
typedef unsigned v2u __attribute__((ext_vector_type(2)));
typedef float f32x4 __attribute__((ext_vector_type(4)));
typedef GAS unsigned gu32;
#define RLX_AGENT __ATOMIC_RELAXED, __HIP_MEMORY_SCOPE_AGENT
#define LDS_WAIT() asm volatile("s_waitcnt lgkmcnt(0)" ::: "memory")
#define VM_WAIT() asm volatile("s_waitcnt vmcnt(0)" ::: "memory")
__device__ __forceinline__ unsigned f2bf(float f) { unsigned u = __builtin_bit_cast(unsigned, f); return (u + 0x7fffu + ((u >> 16) & 1u)) >> 16; }
__device__ __forceinline__ unsigned pk2(float lo, float hi) { return f2bf(lo) | (f2bf(hi) << 16); }
__device__ __forceinline__ float bf_lo(unsigned w) { return __builtin_bit_cast(float, w << 16); }
__device__ __forceinline__ float bf_hi(unsigned w) { return __builtin_bit_cast(float, w & 0xffff0000u); }
__device__ __forceinline__ float bf2f(bf16 v) { return __builtin_bit_cast(float, (unsigned)v << 16); }
__device__ __forceinline__ float sigmoidf_(float x) { return 1.f / (1.f + __expf(-x)); }
__device__ __forceinline__ float siluf_(float x) { return x / (1.f + __expf(-x)); }
__device__ __forceinline__ float wave_sum(float v) {
#pragma unroll
    for (int o = 1; o < 64; o <<= 1) v += __shfl_xor(v, o);
    return v;
}
#define XB_TMO      128
#define XB_XCNT(j)  (256  + 64 * (j))
#define XB_XSUB(j)  (1280 + 64 * (j))
#define XB_XGEN(j)  (2304 + 64 * (j))
#define XB_TOP      3328
#define XB_TOPGEN   3392
#define XCD_BAR_WORDS 3456
#define XB_SPIN_CAP (1u << 18)

__device__ __forceinline__ unsigned xb_ld(unsigned* p)              { return __hip_atomic_load(p, __ATOMIC_RELAXED, __HIP_MEMORY_SCOPE_AGENT); }
__device__ __forceinline__ unsigned xb_add(unsigned* p, unsigned v) { return __hip_atomic_fetch_add(p, v, __ATOMIC_RELAXED, __HIP_MEMORY_SCOPE_AGENT); }
__device__ __forceinline__ unsigned xb_xcc_id() { return (unsigned)__builtin_amdgcn_s_getreg((3 << 11) | 20) & 0xFu; }
#define XB_SPIN(cond, bar) do { unsigned _sp = 0; while (cond) { __builtin_amdgcn_s_sleep(1); \
    if ((++_sp & 255u) == 0u) { if (xb_ld(&(bar)[XB_TMO])) break; if (_sp > XB_SPIN_CAP) { atomicAdd(&(bar)[XB_TMO], 1u); break; } } } } while (0)

struct XcdBarrier {
    unsigned* bar; unsigned x;
    volatile LAS unsigned* st;
};

__device__ __forceinline__ XcdBarrier xcd_barrier_post(unsigned* bar, volatile LAS unsigned* st) {
    XcdBarrier b; b.bar = bar; b.x = xb_xcc_id(); b.st = st;
    if (threadIdx.x == 0) (void)xb_add(&bar[XB_XCNT(b.x)], 1u);
    return b;
}
__device__ __forceinline__ void xcd_barrier_complete(unsigned* bar, unsigned x, unsigned& nloc, unsigned& nx) {
    const unsigned G = gridDim.x * gridDim.y * gridDim.z;
    unsigned sum, cnt, mine, sp = 0u;
    for (;;) {
        sum = 0u; cnt = 0u; mine = 0u;
#pragma unroll
        for (unsigned j = 0; j < 16; ++j) { const unsigned c = xb_ld(&bar[XB_XCNT(j)]); sum += c; cnt += (c > 0u) ? 1u : 0u; mine = (j == x) ? c : mine; }
        if (sum == G) break;
        __builtin_amdgcn_s_sleep(1);
        if ((++sp & 255u) == 0u) { if (xb_ld(&bar[XB_TMO])) break; if (sp > XB_SPIN_CAP) { atomicAdd(&bar[XB_TMO], 1u); break; } }
    }
    nloc = mine > 0u ? mine : 1u; nx = cnt > 0u ? cnt : 1u;
}

__device__ __forceinline__ void xcd_barrier(const XcdBarrier& b) {
    asm volatile("s_waitcnt vmcnt(0)" ::: "memory");
    __syncthreads();
    if (threadIdx.x == 0) {
        unsigned* bar = b.bar;
        __builtin_amdgcn_s_waitcnt(0);
        unsigned nloc = b.st[0], nx = b.st[1];
        if (nloc == 0u) { xcd_barrier_complete(bar, b.x, nloc, nx); b.st[0] = nloc; b.st[1] = nx; }
        const unsigned old = xb_add(&bar[XB_XSUB(b.x)], 1u);
        const unsigned gen = old / nloc;
        if (old + 1u == (gen + 1u) * nloc) {
            __builtin_amdgcn_fence(__ATOMIC_RELEASE, "agent");
            asm volatile("s_waitcnt vmcnt(0)" ::: "memory");
            const unsigned og = xb_add(&bar[XB_TOP], 1u);
            const unsigned tg = og / nx;
            if (og + 1u == (tg + 1u) * nx) xb_add(&bar[XB_TOPGEN], 1u);
            else XB_SPIN(xb_ld(&bar[XB_TOPGEN]) == tg, bar);
            __builtin_amdgcn_fence(__ATOMIC_ACQUIRE, "agent");
            xb_add(&bar[XB_XGEN(b.x)], 1u);
            asm volatile("s_waitcnt vmcnt(0)" ::: "memory");
        } else {
            XB_SPIN(xb_ld(&bar[XB_XGEN(b.x)]) == gen, bar);
            __builtin_amdgcn_fence(__ATOMIC_ACQUIRE, "agent");
            asm volatile("s_waitcnt vmcnt(0)" ::: "memory");
        }
    }
    __syncthreads();
}

struct Frame {
    LAS unsigned char* lds;
    volatile LAS unsigned* MISC;
    gu32* ctl;
    int tid, lane, wave, vcu, G, zz;
    unsigned char* ws;
    float* out;
};
struct Args { const float* in[27]; float* out; unsigned char* ws; int ph_lo, ph_hi; };

struct TileOrder {
    int nM, nN, nwg, G, c, skip;
    __device__ __forceinline__ void init(int nM_, int nN_, int G_, int c_, int skip_) { nM = nM_; nN = nN_; nwg = nM * nN; G = G_; c = c_; skip = skip_; }
    __device__ __forceinline__ bool next(int i, pg8::Unit& u) const {
        const long L = (long)i * G + c; if (L >= nwg) return false;
        int wgid = (int)L; { const int q = nwg / 8, r = nwg % 8, xcd = wgid % 8, off = wgid / 8; wgid = (xcd < r ? xcd * (q + 1) : r * (q + 1) + (xcd - r) * q) + off; }
        const int nig = 8 * nN, gid = wgid / nig, fm = gid * 8, gsz = (nM - fm) < 8 ? (nM - fm) : 8;
        int pm = fm + ((wgid % nig) % gsz); const int pn = (wgid % nig) / gsz;
        if (skip) pm = (pm >> 4) * 17 + 1 + (pm & 15);
        u.pm = pm; u.pn = pn; u.pb = pn; return true;
    }
    __device__ __forceinline__ void a_ready(const pg8::Unit&) const {}
    __device__ __forceinline__ void done(const pg8::Unit&) const {}
};
struct MoeOrder {
    int t1, t2, t3, t4, t5, t6, t7, t8, nN, G, c;
    __device__ __forceinline__ void init(const gu32* cnt, int nN_, int G_, int c_) {
        int t = 0;
        t += ((int)__hip_atomic_load(cnt + 0 * 64, RLX_AGENT) + 255) >> 8; t1 = t; t += ((int)__hip_atomic_load(cnt + 1 * 64, RLX_AGENT) + 255) >> 8; t2 = t;
        t += ((int)__hip_atomic_load(cnt + 2 * 64, RLX_AGENT) + 255) >> 8; t3 = t; t += ((int)__hip_atomic_load(cnt + 3 * 64, RLX_AGENT) + 255) >> 8; t4 = t;
        t += ((int)__hip_atomic_load(cnt + 4 * 64, RLX_AGENT) + 255) >> 8; t5 = t; t += ((int)__hip_atomic_load(cnt + 5 * 64, RLX_AGENT) + 255) >> 8; t6 = t;
        t += ((int)__hip_atomic_load(cnt + 6 * 64, RLX_AGENT) + 255) >> 8; t7 = t; t += ((int)__hip_atomic_load(cnt + 7 * 64, RLX_AGENT) + 255) >> 8; t8 = t;
        nN = nN_; G = G_; c = c_;
    }
    __device__ __forceinline__ int tile_off(int e) const { return e == 0 ? 0 : e == 1 ? t1 : e == 2 ? t2 : e == 3 ? t3 : e == 4 ? t4 : e == 5 ? t5 : e == 6 ? t6 : t7; }
    __device__ __forceinline__ bool next(int i, pg8::Unit& u) const {
        const long L = (long)i * G + c; if (L >= (long)t8 * nN) return false;
        const int pm = (int)(L / nN), pn = (int)(L % nN);
        const int e = (pm >= t1) + (pm >= t2) + (pm >= t3) + (pm >= t4) + (pm >= t5) + (pm >= t6) + (pm >= t7);
        u.pm = pm; u.pn = pn; u.pb = e * nN + pn; return true;
    }
    __device__ __forceinline__ void a_ready(const pg8::Unit&) const {}
    __device__ __forceinline__ void done(const pg8::Unit&) const {}
};

#define EPI_LOOP(...) _Pragma("unroll") for (int ai = 0; ai < 2; ++ai) _Pragma("unroll") for (int m = 0; m < 4; ++m) { const int row = u.pm * 256 + ai * 128 + wr * 64 + m * 16 + fr; \
    _Pragma("unroll") for (int bj = 0; bj < 2; ++bj) { const int col = bj * 128 + wc * 32 + 4 * fq; f32x4 v0 = acc[ai][bj][m][0], v1 = acc[ai][bj][m][1]; __VA_ARGS__ } if (m & 1) asm volatile("" ::: "memory"); }
__device__ __forceinline__ v2u pack4(f32x4 v) { v2u w; w.x = pg8::cvt_pk_bf16(v[0], v[1]); w.y = pg8::cvt_pk_bf16(v[2], v[3]); return w; }
__device__ __forceinline__ f32x4 unpack4(v2u w) { return (f32x4){bf_lo(w.x), bf_hi(w.x), bf_lo(w.y), bf_hi(w.y)}; }

struct EpiProj {
    static constexpr bool PERM = false, AFTER_DRAIN = false;
    bf16* P; float* GB; const float* rope; const float* a_log; const float* dt_bias;
    __device__ __forceinline__ void operator()(const pg8::f32x4 (&acc)[2][2][4][2], const pg8::Unit& u, int wr, int wc, int fr, int fq) const {
        const int pn = u.pn;
        if (pn < 4) {
            EPI_LOOP({ const int j = row % RPB;
                if (j >= CTXL) { const int t = j - CTXL; const int pos = (wc & 1) ? (t & 63) : (t >> 6);
                    const f32x4 cs0 = *(const f32x4*)(rope + (pos * 16 + 4 * fq) * 2), cs1 = *(const f32x4*)(rope + (pos * 16 + 4 * fq) * 2 + 4);
                    const float c0 = cs0[0], s0 = cs0[1], c1 = cs0[2], s1 = cs0[3], c2 = cs1[0], s2 = cs1[1], c3 = cs1[2], s3 = cs1[3];
                    const f32x4 a = v0, b = v1;
                    v0[0] = a[0] * c0 - b[0] * s0; v1[0] = b[0] * c0 + a[0] * s0; v0[1] = a[1] * c1 - b[1] * s1; v1[1] = b[1] * c1 + a[1] * s1;
                    v0[2] = a[2] * c2 - b[2] * s2; v1[2] = b[2] * c2 + a[2] * s2; v0[3] = a[3] * c3 - b[3] * s3; v1[3] = b[3] * c3 + a[3] * s3; }
                bf16* o = P + (size_t)row * NPROJ + pn * 256 + col; *(v2u*)o = pack4(v0); *(v2u*)(o + 16) = pack4(v1); })
        } else if (pn >= 11 && pn < 23) {
            EPI_LOOP({ for (int q = 0; q < 4; ++q) { v0[q] = sigmoidf_(v0[q]); v1[q] = sigmoidf_(v1[q]); }
                bf16* o = P + (size_t)row * NPROJ + pn * 256 + col; *(v2u*)o = pack4(v0); *(v2u*)(o + 16) = pack4(v1); })
        } else if (pn == 23) {
            if (wc == 0) {
                EPI_LOOP({ if (bj == 0) { f32x4 r;
                    for (int q = 0; q < 4; ++q) { const int c = 4 * fq + q; const float x = v0[q];
                        if (c < 8) { const float z = x + dt_bias[c]; const float ez = __expf(z); const float sp = z > 15.f ? z : (ez < 0.03f ? ez * (1.f - ez * (0.5f - ez * (1.f / 3.f))) : __logf(1.f + ez)); r[q] = -__expf(a_log[c]) * sp; }
                        else r[q] = sigmoidf_(x); }
                    *(f32x4*)(GB + (size_t)row * 16 + 4 * fq) = r; } (void)v1; })
            }
        } else {
            EPI_LOOP({ bf16* o = P + (size_t)row * NPROJ + pn * 256 + col; *(v2u*)o = pack4(v0); *(v2u*)(o + 16) = pack4(v1); })
        }
    }
};
struct EpiMerge {
    static constexpr bool PERM = false, AFTER_DRAIN = false;
    bf16* MG; const bf16* P; int gcol0; int first;
    __device__ __forceinline__ void operator()(const pg8::f32x4 (&acc)[2][2][4][2], const pg8::Unit& u, int wr, int wc, int fr, int fq) const {
        EPI_LOOP({ const int c = u.pn * 256 + col; const bf16* gp = P + (size_t)row * NPROJ + gcol0 + c; bf16* o = MG + (size_t)row * DM + c;
            const f32x4 g0 = unpack4(*(const v2u*)gp), g1 = unpack4(*(const v2u*)(gp + 16));
            f32x4 r0 = g0 * v0, r1 = g1 * v1;
            if (!first) { unsigned long long w0 = __hip_atomic_load((unsigned long long*)o, RLX_AGENT), w1 = __hip_atomic_load((unsigned long long*)(o + 16), RLX_AGENT);
                r0 += unpack4((v2u){(unsigned)w0, (unsigned)(w0 >> 32)}); r1 += unpack4((v2u){(unsigned)w1, (unsigned)(w1 >> 32)}); }
            *(v2u*)o = pack4(r0); *(v2u*)(o + 16) = pack4(r1); })
    }
};
struct EpiResid {
    static constexpr bool PERM = false, AFTER_DRAIN = false;
    float* H; const float* modl; int gidx;
    __device__ __forceinline__ void operator()(const pg8::f32x4 (&acc)[2][2][4][2], const pg8::Unit& u, int wr, int wc, int fr, int fq) const {
        EPI_LOOP({ const int c = u.pn * 256 + col; const int b = row / RPB, j = row - b * RPB; const int mr = j < CTXL ? 4 : b;
            const float* gp = modl + mr * 6144 + gidx * 1024 + c; float* hp = H + (size_t)row * DM + c;
            const f32x4 g0 = *(const f32x4*)gp, g1 = *(const f32x4*)(gp + 16);
            *(f32x4*)hp = *(const f32x4*)hp + g0 * v0; *(f32x4*)(hp + 16) = *(const f32x4*)(hp + 16) + g1 * v1; })
    }
};
struct EpiSwiglu {
    static constexpr bool PERM = false, AFTER_DRAIN = false;
    bf16* HID; int ldh;
    __device__ __forceinline__ void operator()(const pg8::f32x4 (&acc)[2][2][4][2], const pg8::Unit& u, int wr, int wc, int fr, int fq) const {
        EPI_LOOP({ (void)col; f32x4 r; for (int q = 0; q < 4; ++q) r[q] = siluf_(v0[q]) * v1[q];
            *(v2u*)(HID + (size_t)row * ldh + u.pn * 128 + bj * 64 + wc * 16 + 4 * fq) = pack4(r); })
    }
};
struct EpiY {
    static constexpr bool PERM = false, AFTER_DRAIN = false;
    bf16* Y; int first;
    __device__ __forceinline__ void operator()(const pg8::f32x4 (&acc)[2][2][4][2], const pg8::Unit& u, int wr, int wc, int fr, int fq) const {
        EPI_LOOP({ bf16* o = Y + (size_t)row * DM + u.pn * 256 + col; f32x4 r0 = v0, r1 = v1;
            if (!first) { unsigned long long w0 = __hip_atomic_load((unsigned long long*)o, RLX_AGENT), w1 = __hip_atomic_load((unsigned long long*)(o + 16), RLX_AGENT);
                r0 += unpack4((v2u){(unsigned)w0, (unsigned)(w0 >> 32)}); r1 += unpack4((v2u){(unsigned)w1, (unsigned)(w1 >> 32)}); }
            *(v2u*)o = pack4(r0); *(v2u*)(o + 16) = pack4(r1); })
    }
};

template <int MAP> __device__ __forceinline__ int map_col(int c) {
    if (MAP == 0) return c;
    if (MAP == 1) return c < 2560 ? c : (c < 2576 ? PC_AB + (c - 2560) : (c < 2832 ? PC_POOL + (c - 2576) : PC_GATE + (c - 2832)));
    if (MAP == 2) return (c >> 4) * 32 + (c & 15);
    return (c >> 4) * 32 + 16 + (c & 15);
}
template <int MAP> __device__ __forceinline__ void tr_item(const float* W, int ldw, int N, bf16* WT, int ldd, int item, LAS float* scr, int lane) {
    const int nblk = (N + 31) / 32, kb = item / nblk, nb = item % nblk, k0 = 64 * kb, n0 = 32 * nb;
    const int cl = n0 + (lane & 31);
#pragma unroll 8
    for (int i = 0; i < 32; ++i) { const int kk = 2 * i + (lane >> 5); scr[kk * 33 + (lane & 31)] = cl < N ? W[(size_t)(k0 + kk) * ldw + cl] : 0.f; }
    LDS_WAIT(); asm volatile("" ::: "memory");
    const int c = lane & 7;
#pragma unroll
    for (int j = 0; j < 4; ++j) { const int n = (lane >> 3) + 8 * j; const LAS float* s = scr + (8 * c) * 33 + n;
        if (n0 + n < N) { v4u o; o.x = pk2(s[0 * 33], s[1 * 33]); o.y = pk2(s[2 * 33], s[3 * 33]); o.z = pk2(s[4 * 33], s[5 * 33]); o.w = pk2(s[6 * 33], s[7 * 33]);
            *(GAS v4u*)(WT + (size_t)map_col<MAP>(n0 + n) * ldd + k0 + 8 * c) = o; } }
    LDS_WAIT(); asm volatile("" ::: "memory");
}
#define TR_RUN(MAP, W, ldw, K, N, WT, ldd) { const int cnt_ = ((K) / 64) * (((N) + 31) / 32); if (r < cnt_) { tr_item<MAP>(W, ldw, N, WT, ldd, r, scr, F.lane); continue; } r -= cnt_; }

__device__ __forceinline__ void p0_prologue(Frame& F, const Args& A) {
    LAS float* scr = (LAS float*)(F.lds + F.wave * 16384);
    const int gw = F.vcu * NWAVES + F.wave, NGW = F.G * NWAVES;
    bf16* WIN = (bf16*)(F.ws + WS_WIN); bf16* WBR = (bf16*)(F.ws + WS_WBR); bf16* WOUT = (bf16*)(F.ws + WS_WOUT); bf16* W13 = (bf16*)(F.ws + WS_W13); bf16* W2 = (bf16*)(F.ws + WS_W2);
    constexpr int PER_LAYER = 16 * 185 + 8 * 32 + 4 * 32 + 4 * 32 + 16 * 32, TOTAL = 2 * PER_LAYER + 16 * 88 * 2 + 44 * 32;
    for (int it = gw; it < TOTAL; it += NGW) {
        int r = it;
        for (int l = 0; l < 2; ++l) {
            bool hit = false;
            if (r < PER_LAYER) { hit = true;
                const float* win = A.in[F.zz + 8] + (size_t)l * 1024 * INW; const float* wbr = A.in[F.zz + 17] + (size_t)l * 1024 * 1024; const float* wo = A.in[F.zz + 18] + (size_t)l * 1024 * 1024;
                bf16* dbr = WBR + (size_t)l * 1024 * 1024;
                do {
                    { const int cnt_ = 16 * 185; if (r < cnt_) { tr_item<1>(win, INW, INW, WIN + (size_t)l * NPROJ * 1024, 1024, r, scr, F.lane); break; } r -= cnt_; }
                    { const int cnt_ = 8 * 32; if (r < cnt_) { tr_item<0>(wbr, 1024, 1024, dbr, 512, r, scr, F.lane); break; } r -= cnt_; }
                    { const int cnt_ = 4 * 32; if (r < cnt_) { tr_item<0>(wbr + 512 * 1024, 1024, 1024, dbr + 1024 * 512, 256, r, scr, F.lane); break; } r -= cnt_; }
                    { const int cnt_ = 4 * 32; if (r < cnt_) { tr_item<0>(wbr + 768 * 1024, 1024, 1024, dbr + 1024 * 768, 256, r, scr, F.lane); break; } r -= cnt_; }
                    tr_item<0>(wo, 1024, 1024, WOUT + (size_t)l * 1024 * 1024, 1024, r, scr, F.lane);
                } while (0);
            }
            if (hit) { r = -1; break; }
            r -= PER_LAYER;
        }
        if (r < 0) continue;
        { const int cnt_ = 16 * 88; if (r < cnt_) { tr_item<2>(A.in[F.zz + 19], FFD, FFD, W13, 1024, r, scr, F.lane); continue; } r -= cnt_; }
        { const int cnt_ = 16 * 88; if (r < cnt_) { tr_item<3>(A.in[F.zz + 20], FFD, FFD, W13, 1024, r, scr, F.lane); continue; } r -= cnt_; }
        tr_item<0>(A.in[F.zz + 21], 1024, 1024, W2, FFD, r, scr, F.lane);
    }
    float* H = (float*)(F.ws + WS_H);
    for (int R = gw; R < MROWS; R += NGW) { const int b = R / RPB, j = R - b * RPB;
        const float* src = j < CTXL ? A.in[F.zz + 2] + ((size_t)b * CTXL + j) * DM : A.in[F.zz + 0] + ((size_t)b * SEQ + (j - CTXL)) * DM;
        const GAS f32x4* s4 = (const GAS f32x4*)src + F.lane; GAS f32x4* d4 = (GAS f32x4*)(H + (size_t)R * DM) + F.lane;
#pragma unroll
        for (int q = 0; q < 4; ++q) d4[64 * q] = s4[64 * q]; }
    if (F.vcu == 0) {
        float* rope = (float*)(F.ws + WS_ROPE);
        for (int e = F.tid; e < 1024; e += NTHR) { const int pos = e >> 4, i = e & 15; const float inv = powf(10000.f, -(float)i / 16.f); const float a = (float)pos * inv;
            rope[2 * e] = cosf(a); rope[2 * e + 1] = sinf(a); }
        if (F.tid < 2) { const int l = F.tid; const float* lp = A.in[F.zz + 9] + l * 256; float s1 = 0.f, s2 = 0.f;
            for (int i = 0; i < 64; ++i) { s1 += lp[i] * lp[64 + i]; s2 += lp[128 + i] * lp[192 + i]; }
            const float li = 0.8f - 0.6f * expf(-0.3f * (float)l);
            ((float*)(F.ws + WS_LAM))[l] = expf(s1) - expf(s2) + li; }
    }
    __syncthreads();
    float* MOD = (float*)(F.ws + WS_MOD);
    LAS float* red = (LAS float*)F.lds;
    for (int task = F.vcu; task < 2 * 96; task += F.G) {
        const int l = task / 96, cc = task % 96;
        const float* aw = A.in[F.zz + 4] + (size_t)l * 1024 * 6144 + cc * 64 + F.lane;
        const float* c0 = A.in[F.zz + 1]; const float* cx = A.in[F.zz + 3];
        float a0 = 0.f, a1 = 0.f, a2 = 0.f, a3 = 0.f, a4 = 0.f;
#pragma unroll 8
        for (int i = 0; i < 128; ++i) { const int k = F.wave * 128 + i; const float w = aw[(size_t)k * 6144];
            a0 += siluf_(c0[k]) * w; a1 += siluf_(c0[1024 + k]) * w; a2 += siluf_(c0[2048 + k]) * w; a3 += siluf_(c0[3072 + k]) * w; a4 += siluf_(cx[k]) * w; }
        LAS float* rw = red + F.wave * 320 + F.lane;
        rw[0] = a0; rw[64] = a1; rw[128] = a2; rw[192] = a3; rw[256] = a4;
        __syncthreads();
        if (F.tid < 320) { float s = 0.f;
#pragma unroll
            for (int w = 0; w < 8; ++w) s += red[w * 320 + F.tid];
            const int rr = F.tid >> 6, jj = cc * 64 + (F.tid & 63);
            MOD[(l * 5 + rr) * 6144 + jj] = s + A.in[F.zz + 5][l * 6144 + jj]; }
        __syncthreads();
    }
}

__device__ __forceinline__ void moe_convert(Frame& F, const Args& A, int hh) {
    LAS float* scr = (LAS float*)(F.lds + F.wave * 16384);
    const int gw = F.vcu * NWAVES + F.wave, NGW = F.G * NWAVES;
    bf16* W13M = (bf16*)(F.ws + WS_W13M); bf16* W2M = (bf16*)(F.ws + WS_W2M);
    constexpr int I13 = 16 * 56, I2 = 28 * 32, PER_E = 2 * I13 + I2;
    for (int it = gw; it < 8 * PER_E; it += NGW) {
        const int e = it / PER_E; int r = it - e * PER_E;
        if (r < I13) { tr_item<2>(A.in[F.zz + 23] + (size_t)e * 1024 * FFE + hh * FFEH, FFE, FFEH, W13M + (size_t)e * FFE * 1024, 1024, r, scr, F.lane); continue; } r -= I13;
        if (r < I13) { tr_item<3>(A.in[F.zz + 24] + (size_t)e * 1024 * FFE + hh * FFEH, FFE, FFEH, W13M + (size_t)e * FFE * 1024, 1024, r, scr, F.lane); continue; } r -= I13;
        tr_item<0>(A.in[F.zz + 25] + (size_t)e * FFE * 1024 + (size_t)hh * FFEH * 1024, 1024, 1024, W2M + (size_t)e * 1024 * FFEH, FFEH, r, scr, F.lane);
    }
}

__device__ __forceinline__ void norm_mod_phase(Frame& F, const Args& A, int l, int which, bool latent_only, bool route) {
    const int gw = F.vcu * NWAVES + F.wave, NGW = F.G * NWAVES;
    const float* H = (const float*)(F.ws + WS_H); bf16* U = (bf16*)(F.ws + WS_U); const float* MOD = (const float*)(F.ws + WS_MOD) + l * 5 * 6144;
    const float* g = (which ? A.in[F.zz + 7] : A.in[F.zz + 6]) + l * 1024;
    for (int R = gw; R < MROWS; R += NGW) {
        const int b = R / RPB, j = R - b * RPB; const bool isctx = j < CTXL; if (latent_only && isctx) continue;
        const float* mod = MOD + (isctx ? 4 : b) * 6144; const float* shift = mod + (which ? 3 : 0) * 1024; const float* scale = mod + (which ? 4 : 1) * 1024;
        const GAS f32x4* xr = (const GAS f32x4*)(H + (size_t)R * DM) + F.lane;
        f32x4 v[4]; float ss = 0.f;
#pragma unroll
        for (int q = 0; q < 4; ++q) { v[q] = xr[64 * q]; ss += (v[q].x * v[q].x + v[q].y * v[q].y) + (v[q].z * v[q].z + v[q].w * v[q].w); }
        const float rstd = 1.f / sqrtf(wave_sum(ss) * (1.f / DM) + EPSN);
        GAS v2u* o8 = (GAS v2u*)(U + (size_t)R * DM) + F.lane;
#pragma unroll
        for (int q = 0; q < 4; ++q) { const int c = 4 * F.lane + 256 * q; const f32x4 gg = *(const f32x4*)(g + c), sh = *(const f32x4*)(shift + c), sc = *(const f32x4*)(scale + c);
            v[q] = (v[q] * rstd) * gg * (sc + 1.f) + sh; v2u w; w.x = pk2(v[q].x, v[q].y); w.y = pk2(v[q].z, v[q].w); o8[64 * q] = w; }
        if (route) {
            const float* rw = A.in[F.zz + 22];
            float lg[8] = {0, 0, 0, 0, 0, 0, 0, 0};
#pragma unroll
            for (int q = 0; q < 4; ++q)
#pragma unroll
                for (int i = 0; i < 4; ++i) { const int k = 4 * F.lane + 256 * q + i; const f32x4 w0 = *(const f32x4*)(rw + k * 8), w1 = *(const f32x4*)(rw + k * 8 + 4); const float x = v[q][i];
                    lg[0] += x * w0[0]; lg[1] += x * w0[1]; lg[2] += x * w0[2]; lg[3] += x * w0[3]; lg[4] += x * w1[0]; lg[5] += x * w1[1]; lg[6] += x * w1[2]; lg[7] += x * w1[3]; }
#pragma unroll
            for (int e = 0; e < 8; ++e) lg[e] = wave_sum(lg[e]);
            if (F.lane == 0) {
                int e0 = 0; float v0 = lg[0];
#pragma unroll
                for (int e = 1; e < 8; ++e) if (lg[e] > v0) { v0 = lg[e]; e0 = e; }
                int e1 = -1; float v1 = -3.0e38f;
#pragma unroll
                for (int e = 0; e < 8; ++e) if (e != e0 && lg[e] > v1) { v1 = lg[e]; e1 = e; }
                const float ex = __expf(v1 - v0); const float w0 = 1.f / (1.f + ex), w1 = ex / (1.f + ex);
                gu32* cnt = F.ctl + CW_ECNT;
#ifdef DBG_DETPOS
                const unsigned p0 = 0, p1 = 0; (void)cnt;
#else
                const unsigned p0 = __hip_atomic_fetch_add(cnt + 64 * e0, 1u, RLX_AGENT), p1 = __hip_atomic_fetch_add(cnt + 64 * e1, 1u, RLX_AGENT);
#endif
                const int tk = b * SEQ + (j - CTXL);
                v4u* rt = (v4u*)(F.ws + WS_ROUTE) + 2 * tk;
                rt[0] = (v4u){(unsigned)e0, (unsigned)e1, p0, p1}; rt[1] = (v4u){__float_as_uint(w0), __float_as_uint(w1), 0u, 0u};
            }
        }
    }
}

__device__ __forceinline__ void moe_gather(Frame& F) {
#ifdef DBG_DETPOS
    if (F.vcu == 0 && F.tid == 0) { unsigned c[8] = {0,0,0,0,0,0,0,0};
        for (int tk = 0; tk < NB * SEQ; ++tk) { v4u* rt = (v4u*)(F.ws + WS_ROUTE) + 2 * tk; v4u r = rt[0];
            for (int e = 0; e < 8; ++e) { if ((int)r.x == e) r.z = c[e]++; } for (int e = 0; e < 8; ++e) { if ((int)r.y == e) r.w = c[e]++; } rt[0] = r; }
        for (int e = 0; e < 8; ++e) __hip_atomic_store(F.ctl + CW_ECNT + 64 * e, c[e], RLX_AGENT); }
    return;
#endif
    const int gw = F.vcu * NWAVES + F.wave, NGW = F.G * NWAVES;
    MoeOrder mo; mo.init(F.ctl + CW_ECNT, 1, 1, 0);
    const bf16* U = (const bf16*)(F.ws + WS_U); bf16* XG = (bf16*)(F.ws + WS_XG);
    for (int tk = gw; tk < NB * SEQ; tk += NGW) {
        const int b = tk / SEQ, t = tk - b * SEQ; const size_t R = (size_t)b * RPB + CTXL + t;
        const v4u rt = ((const v4u*)(F.ws + WS_ROUTE))[2 * tk];
        const size_t r0 = (size_t)mo.tile_off((int)rt.x) * 256 + rt.z, r1 = (size_t)mo.tile_off((int)rt.y) * 256 + rt.w;
        const GAS v4u* s = (const GAS v4u*)(U + R * DM) + F.lane; const v4u a = s[0], c = s[64];
        GAS v4u* d0 = (GAS v4u*)(XG + r0 * DM) + F.lane; GAS v4u* d1 = (GAS v4u*)(XG + r1 * DM) + F.lane;
        d0[0] = a; d0[64] = c; d1[0] = a; d1[64] = c;
    }
}

__device__ __forceinline__ void moe_gather2(Frame& F) {
    const int gw = F.vcu * NWAVES + F.wave, NGW = F.G * NWAVES;
    MoeOrder mo; mo.init(F.ctl + CW_ECNT, 1, 1, 0);
    const bf16* U = (const bf16*)(F.ws + WS_U); bf16* XG = (bf16*)(F.ws + WS_XG);
    for (int tk = gw; tk < NB * SEQ; tk += NGW) {
        const int b = tk / SEQ, t = tk - b * SEQ; const size_t R = (size_t)b * RPB + CTXL + t;
        const v4u rt = ((const v4u*)(F.ws + WS_ROUTE))[2 * tk];
        const size_t r0 = (size_t)mo.tile_off((int)rt.x) * 256 + rt.z, r1 = (size_t)mo.tile_off((int)rt.y) * 256 + rt.w;
        const GAS v4u* s = (const GAS v4u*)(U + R * DM) + F.lane; const v4u a = s[0], c = s[64];
        GAS v4u* d0 = (GAS v4u*)(XG + r0 * DM) + F.lane; GAS v4u* d1 = (GAS v4u*)(XG + r1 * DM) + F.lane;
        d0[0] = a; d0[64] = c; d1[0] = a; d1[64] = c;
    }
}

__device__ __forceinline__ void final_phase(Frame& F, const Args& A) {
    const int gw = F.vcu * NWAVES + F.wave, NGW = F.G * NWAVES;
    MoeOrder mo; mo.init(F.ctl + CW_ECNT, 1, 1, 0);
    const float* H = (const float*)(F.ws + WS_H); const bf16* Y = (const bf16*)(F.ws + WS_Y); const float* MOD = (const float*)(F.ws + WS_MOD) + 1 * 5 * 6144;
    for (int tk = gw; tk < NB * SEQ; tk += NGW) {
        const int b = tk / SEQ, t = tk - b * SEQ; const size_t R = (size_t)b * RPB + CTXL + t;
        const v4u rt = ((const v4u*)(F.ws + WS_ROUTE))[2 * tk], rw = ((const v4u*)(F.ws + WS_ROUTE))[2 * tk + 1];
        const size_t r0 = (size_t)mo.tile_off((int)rt.x) * 256 + rt.z, r1 = (size_t)mo.tile_off((int)rt.y) * 256 + rt.w;
        const float w0 = __uint_as_float(rw.x), w1 = __uint_as_float(rw.y);
        const float* gate = MOD + b * 6144 + 5 * 1024;
        f32x4 v[4]; float ss = 0.f;
#pragma unroll
        for (int q = 0; q < 4; ++q) { const int c = 4 * F.lane + 256 * q;
            const f32x4 h = *(const f32x4*)(H + R * DM + c), gg = *(const f32x4*)(gate + c);
            const f32x4 y0 = unpack4(*(const v2u*)(Y + r0 * DM + c)), y1 = unpack4(*(const v2u*)(Y + r1 * DM + c));
            v[q] = h + gg * (y0 * w0 + y1 * w1); ss += (v[q].x * v[q].x + v[q].y * v[q].y) + (v[q].z * v[q].z + v[q].w * v[q].w); }
        const float rstd = 1.f / sqrtf(wave_sum(ss) * (1.f / DM) + EPSN);
#pragma unroll
        for (int q = 0; q < 4; ++q) { const int c = 4 * F.lane + 256 * q; *(f32x4*)(F.out + (size_t)tk * DM + c) = v[q] * rstd * *(const f32x4*)(A.in[F.zz + 26] + c); }
    }
}

constexpr int DP = 65;
constexpr int DN_ARR = 64 * DP * 4;
__device__ __forceinline__ void dn_pre_unit(Frame& F, const Args& A, int l, int b, int n, int h) {
    LAS float* Qc = (LAS float*)(F.lds + 0 * DN_ARR); LAS float* Kc = (LAS float*)(F.lds + 1 * DN_ARR); LAS float* Vc = (LAS float*)(F.lds + 2 * DN_ARR);
    LAS float* KK = (LAS float*)(F.lds + 3 * DN_ARR);
    LAS float* QK = (LAS float*)(F.lds + 4 * DN_ARR); LAS float* A0 = (LAS float*)(F.lds + 5 * DN_ARR);
    LAS float* U1 = (LAS float*)(F.lds + 6 * DN_ARR); LAS float* W0 = (LAS float*)(F.lds + 7 * DN_ARR); LAS float* W1 = (LAS float*)(F.lds + 8 * DN_ARR);
    LAS float* Gs = (LAS float*)(F.lds + 9 * DN_ARR);
    LAS float* Bs = Gs + 128;
    LAS float* gr = Gs + 256;
    const bf16* P = (const bf16*)(F.ws + WS_PROJ); const float* GB = (const float*)(F.ws + WS_GB);
    int tid = threadIdx.x; asm volatile("" : "+v"(tid));
    const int row0 = b * RPB + n * 64; const int seq_lo = (n < 4) ? b * RPB : b * RPB + CTXL, seq_hi = (n < 4) ? b * RPB + CTXL : (b + 1) * RPB;
    {
        const int t = tid >> 3, cg = tid & 7;
        const float* cw = A.in[F.zz + 11] + (size_t)l * 5 * 768;
#pragma unroll
        for (int p = 0; p < 3; ++p) {
            const int ch = p * 256 + h * 64 + cg * 8;
            float acc[8] = {0, 0, 0, 0, 0, 0, 0, 0};
#pragma unroll
            for (int tap = 0; tap < 5; ++tap) { const int r = row0 + t + tap - 2;
                if (r >= seq_lo && r < seq_hi) { const v4u x = *(const v4u*)(P + (size_t)r * NPROJ + PC_DQ + ch);
                    const f32x4 w0 = *(const f32x4*)(cw + tap * 768 + ch), w1 = *(const f32x4*)(cw + tap * 768 + ch + 4);
                    acc[0] += bf_lo(x.x) * w0[0]; acc[1] += bf_hi(x.x) * w0[1]; acc[2] += bf_lo(x.y) * w0[2]; acc[3] += bf_hi(x.y) * w0[3];
                    acc[4] += bf_lo(x.z) * w1[0]; acc[5] += bf_hi(x.z) * w1[1]; acc[6] += bf_lo(x.w) * w1[2]; acc[7] += bf_hi(x.w) * w1[3]; } }
            float ss = 0.f;
#pragma unroll
            for (int i = 0; i < 8; ++i) { acc[i] = siluf_(acc[i]); ss += acc[i] * acc[i]; }
            float sc = 1.f;
            if (p < 2) { ss += __shfl_xor(ss, 1); ss += __shfl_xor(ss, 2); ss += __shfl_xor(ss, 4); sc = (1.f / sqrtf(ss + EPSN)) * (p == 0 ? 0.125f : 1.f); }
            LAS float* dst = (p == 0 ? Qc : p == 1 ? Kc : Vc) + t * DP + cg * 8;
#pragma unroll
            for (int i = 0; i < 8; ++i) dst[i] = acc[i] * sc;
        }
        if (tid < 128) { const int d = tid >> 6, tt = tid & 63; const float* gb = GB + (size_t)(row0 + tt) * 16; gr[d * 64 + tt] = gb[d * 4 + h]; Bs[d * 64 + tt] = gb[8 + d * 4 + h]; }
    }
    __syncthreads();
    {
#pragma unroll 1
        for (int k = 0; k < 8; ++k) { const int e = tid + 512 * k, t = e >> 6, s = e & 63; float a = 0.f, c = 0.f;
#pragma unroll 8
            for (int i = 0; i < 64; ++i) { const float ks = Kc[s * DP + i]; a += Kc[t * DP + i] * ks; c += Qc[t * DP + i] * ks; }
            KK[t * DP + s] = a; QK[t * DP + s] = c; }
        if (tid < 128) { const int d = tid >> 6, tt = tid & 63; float g = 0.f;
            if (d == 0) { for (int s = 0; s <= tt; ++s) g += gr[s]; } else { for (int s = 63; s >= tt; --s) g += gr[64 + s]; }
            Gs[d * 64 + tt] = g; }
    }
    __syncthreads();
    {
#pragma unroll 1
        for (int k = 0; k < 8; ++k) { const int e = tid + 512 * k, t = e >> 6, s = e & 63; const float kk = KK[t * DP + s];
            const float a0 = (s < t) ? Bs[t] * kk * __expf(Gs[t] - Gs[s]) : 0.f;
            const float a1 = (s > t) ? Bs[64 + t] * kk * __expf(Gs[64 + t] - Gs[64 + s]) : 0.f;
            A0[t * DP + s] = a0; KK[t * DP + s] = a1;
            const float v = Vc[t * DP + s], kc = Kc[t * DP + s];
            Vc[t * DP + s] = Bs[t] * v; U1[t * DP + s] = Bs[64 + t] * v;
            W0[t * DP + s] = Bs[t] * __expf(Gs[t]) * kc; W1[t * DP + s] = Bs[64 + t] * __expf(Gs[64 + t]) * kc; }
    }
    __syncthreads();
    if (tid < 256) {
        const int d = tid >> 7, c = tid & 127; LAS float* X = (c < 64) ? (d == 0 ? Vc : U1) + c : (d == 0 ? W0 : W1) + (c - 64);
        const LAS float* Am = d == 0 ? A0 : KK;
        if (d == 0) {
#pragma unroll 1
            for (int i = 1; i < 64; ++i) { float a = X[i * DP];
#pragma unroll 4
                for (int j = 0; j < i; ++j) a -= Am[i * DP + j] * X[j * DP];
                X[i * DP] = a; }
        } else {
#pragma unroll 1
            for (int i = 62; i >= 0; --i) { float a = X[i * DP];
#pragma unroll 4
                for (int j = i + 1; j < 64; ++j) a -= Am[i * DP + j] * X[j * DP];
                X[i * DP] = a; }
        }
    }
    __syncthreads();
    {
#pragma unroll 1
        for (int k = 0; k < 8; ++k) { const int e = tid + 512 * k, t = e >> 6, s = e & 63; const float qk = QK[t * DP + s];
            A0[t * DP + s] = (s <= t) ? qk * __expf(Gs[t] - Gs[s]) : 0.f;
            KK[t * DP + s] = (s >= t) ? qk * __expf(Gs[64 + t] - Gs[64 + s]) : 0.f; }
    }
    __syncthreads();
    {
        const int d = tid >> 8, tt = tid & 255;
        const LAS float* Aq = d == 0 ? A0 : KK; const LAS float* Ud = d == 0 ? Vc : U1; const LAS float* Wd = d == 0 ? W0 : W1; const LAS float* Gd = Gs + d * 64;
        const float glast = d == 0 ? Gd[63] : Gd[0];
        const size_t prob = (((size_t)b * NCHUNK + n) * 4 + h) * 2 + d;
        bf16* out = (bf16*)(F.ws + WS_DNP) + prob * 16384;
        if (tt == 0) ((float*)(F.ws + WS_DNG))[prob] = __expf(glast);
#pragma unroll 1
        for (int k = 0; k < 16; ++k) { const int e = tt + 256 * k, r = e >> 6, c = e & 63;
            float rr = 0.f, yy = 0.f, bb = 0.f, cc = 0.f;
#pragma unroll 4
            for (int s = 0; s < 64; ++s) { const float aq = Aq[r * DP + s], us = Ud[s * DP + c], ws = Wd[s * DP + c];
                rr += aq * us; yy += aq * ws;
                const float kt = __expf(glast - Gd[s]) * Kc[s * DP + r]; bb += kt * us; cc += kt * ws; }
            const float pp = __expf(Gd[r]) * Qc[r * DP + c] - yy;
            out[e] = (bf16)f2bf(pp); out[4096 + e] = (bf16)f2bf(rr); out[8192 + e] = (bf16)f2bf(bb); out[12288 + e] = (bf16)f2bf(cc); }
    }
    __syncthreads();
}

__device__ __forceinline__ void pool_unit(Frame& F, const Args& A, int l, int blk, int g) {
    LAS float* Uw = (LAS float*)F.lds;
    LAS float* Mm = Uw + 80 * DP;
    LAS float* PW = Mm + 64 * DP;
    const bf16* P = (const bf16*)(F.ws + WS_PROJ); bf16* MIX = (bf16*)(F.ws + WS_MIX);
    int tid = threadIdx.x; asm volatile("" : "+v"(tid));
    const int row0 = blk * 64, b = row0 / RPB, j0 = row0 - b * RPB; const bool isctx = j0 < CTXL;
    const int seq_lo = isctx ? b * RPB : b * RPB + CTXL, L = isctx ? CTXL : SEQ; const int pos0 = row0 - seq_lo;
    for (int idx = tid; idx < 640; idx += NTHR) { const int rr = idx >> 3, c8 = (idx & 7) * 8; const int pos = pos0 - 8 + rr;
        float v[8] = {0, 0, 0, 0, 0, 0, 0, 0};
        if (pos >= 0 && pos < L) { const v4u x = *(const v4u*)(P + (size_t)(seq_lo + pos) * NPROJ + PC_POOL + g * 64 + c8);
            v[0] = bf_lo(x.x); v[1] = bf_hi(x.x); v[2] = bf_lo(x.y); v[3] = bf_hi(x.y); v[4] = bf_lo(x.z); v[5] = bf_hi(x.z); v[6] = bf_lo(x.w); v[7] = bf_hi(x.w); }
#pragma unroll
        for (int i = 0; i < 8; ++i) Uw[rr * DP + c8 + i] = v[i]; }
    { const float* pw = A.in[F.zz + 15] + ((size_t)l * 4 + g) * 4096;
#pragma unroll
      for (int k = 0; k < 8; ++k) { const int e = tid + 512 * k; PW[(e >> 6) * DP + (e & 63)] = pw[e]; } }
    __syncthreads();
    const int win = 2 << g;
#pragma unroll 1
    for (int k = 0; k < 8; ++k) { const int e = tid + 512 * k, t = e >> 6, i = e & 63; const int pos = pos0 + t;
        int lo = pos - win / 2, hi = lo + win; lo = lo < 0 ? 0 : lo; hi = hi > L ? L : hi;
        float s = 0.f; for (int p = lo; p < hi; ++p) s += Uw[(p - pos0 + 8) * DP + i];
        Mm[t * DP + i] = s / (float)(hi - lo) - Uw[(t + 8) * DP + i]; }
    __syncthreads();
    const float* psc = A.in[F.zz + 16] + l * 256 + g * 64;
#pragma unroll 1
    for (int k = 0; k < 8; ++k) { const int e = tid + 512 * k, t = e >> 6, o = e & 63; float a = 0.f;
#pragma unroll 8
        for (int i = 0; i < 64; ++i) a += Mm[t * DP + i] * PW[i * DP + o];
        MIX[(size_t)(row0 + t) * DM + 768 + g * 64 + o] = (bf16)f2bf(a * psc[o]); }
    __syncthreads();
}

__device__ __forceinline__ void dn_scan_item(Frame& F, int item) {
    const int es = item & 3, d = (item >> 2) & 1, h = (item >> 3) & 3, b = item >> 5;
    LAS float* Pm = (LAS float*)F.lds; LAS float* Cm = Pm + 64 * DP; LAS float* Rm = Cm + 64 * DP; LAS float* Bm = Rm + 64 * 17; LAS float* S0 = Bm + 64 * 17; LAS float* S1 = S0 + 64 * 17;
    int tid = threadIdx.x; asm volatile("" : "+v"(tid));
    for (int e = tid; e < 64 * 17; e += NTHR) { S0[e] = 0.f; S1[e] = 0.f; }
    bf16* DNO = (bf16*)(F.ws + WS_DNO) + (size_t)d * MROWS * 256;
    LAS float* Sc = S0; LAS float* Sn = S1;
#pragma unroll 1
    for (int st = 0; st < NCHUNK; ++st) {
        const int n = d == 0 ? st : (st < 4 ? 3 - st : 71 - st);
        const size_t prob = (((size_t)b * NCHUNK + n) * 4 + h) * 2 + d;
        const bf16* src = (const bf16*)(F.ws + WS_DNP) + prob * 16384;
        const float gl = ((const float*)(F.ws + WS_DNG))[prob];
        { const v4u x = *(const v4u*)(src + tid * 8), y = *(const v4u*)(src + 12288 + tid * 8); const int r = tid >> 3, c = (tid & 7) * 8;
          LAS float* p = Pm + r * DP + c; LAS float* q = Cm + r * DP + c;
          p[0] = bf_lo(x.x); p[1] = bf_hi(x.x); p[2] = bf_lo(x.y); p[3] = bf_hi(x.y); p[4] = bf_lo(x.z); p[5] = bf_hi(x.z); p[6] = bf_lo(x.w); p[7] = bf_hi(x.w);
          q[0] = bf_lo(y.x); q[1] = bf_hi(y.x); q[2] = bf_lo(y.y); q[3] = bf_hi(y.y); q[4] = bf_lo(y.z); q[5] = bf_hi(y.z); q[6] = bf_lo(y.w); q[7] = bf_hi(y.w); }
#pragma unroll
        for (int k = 0; k < 2; ++k) { const int e = tid + 512 * k, r = e >> 4, c = e & 15;
            Rm[r * 17 + c] = bf2f(src[4096 + r * 64 + es * 16 + c]); Bm[r * 17 + c] = bf2f(src[8192 + r * 64 + es * 16 + c]); }
        __syncthreads();
#pragma unroll
        for (int k = 0; k < 2; ++k) { const int e = tid + 512 * k, r = e >> 4, c = e & 15; float o = Rm[r * 17 + c], sn = gl * Sc[r * 17 + c] + Bm[r * 17 + c];
#pragma unroll 8
            for (int i = 0; i < 64; ++i) { const float sv = Sc[i * 17 + c]; o += Pm[r * DP + i] * sv; sn -= Cm[r * DP + i] * sv; }
            Sn[r * 17 + c] = sn;
            DNO[(size_t)(b * RPB + n * 64 + r) * 256 + h * 64 + es * 16 + c] = (bf16)f2bf(o); }
        __syncthreads();
        LAS float* tmp = Sc; Sc = Sn; Sn = tmp;
    }
}

__device__ __forceinline__ void mix_build(Frame& F, const Args& A, int l) {
    int lane = threadIdx.x & 63; asm volatile("" : "+v"(lane)); const int gw = F.vcu * NWAVES + F.wave, NGW = F.G * NWAVES;
    const bf16* ATTO = (const bf16*)(F.ws + WS_ATTO); const bf16* P = (const bf16*)(F.ws + WS_PROJ); const bf16* DNO = (const bf16*)(F.ws + WS_DNO); bf16* MIX = (bf16*)(F.ws + WS_MIX);
    const float lam = ((const float*)(F.ws + WS_LAM))[l]; const float li = 0.8f - 0.6f * expf(-0.3f * (float)l);
    const float* sg = A.in[F.zz + 10] + l * 128; const float* ng = A.in[F.zz + 14] + l * 64;
    for (int R = gw; R < MROWS; R += NGW) {
        const int j = R % RPB; if (l == 1 && j < CTXL) continue;
        { const int hh = lane >> 4, e0 = (lane & 15) * 8;
          const v4u a = *(const v4u*)(ATTO + (size_t)R * DM + (hh * 2) * 128 + e0), c = *(const v4u*)(ATTO + (size_t)R * DM + (hh * 2 + 1) * 128 + e0);
          float x[8] = {bf_lo(a.x) - lam * bf_lo(c.x), bf_hi(a.x) - lam * bf_hi(c.x), bf_lo(a.y) - lam * bf_lo(c.y), bf_hi(a.y) - lam * bf_hi(c.y),
                        bf_lo(a.z) - lam * bf_lo(c.z), bf_hi(a.z) - lam * bf_hi(c.z), bf_lo(a.w) - lam * bf_lo(c.w), bf_hi(a.w) - lam * bf_hi(c.w)};
          float ss = 0.f;
#pragma unroll
          for (int i = 0; i < 8; ++i) ss += x[i] * x[i];
          ss += __shfl_xor(ss, 1); ss += __shfl_xor(ss, 2); ss += __shfl_xor(ss, 4); ss += __shfl_xor(ss, 8);
          const float sc = (1.f / sqrtf(ss * (1.f / 128.f) + EPSN)) * (1.f - li);
          const f32x4 g0 = *(const f32x4*)(sg + e0), g1 = *(const f32x4*)(sg + e0 + 4);
          v4u o; o.x = pk2(x[0] * sc * g0[0], x[1] * sc * g0[1]); o.y = pk2(x[2] * sc * g0[2], x[3] * sc * g0[3]); o.z = pk2(x[4] * sc * g1[0], x[5] * sc * g1[1]); o.w = pk2(x[6] * sc * g1[2], x[7] * sc * g1[3]);
          *(v4u*)(MIX + (size_t)R * DM + hh * 128 + e0) = o; }
        { const int c0 = lane * 4;
          const v2u a = *(const v2u*)(DNO + (size_t)R * 256 + c0), c = *(const v2u*)(DNO + ((size_t)MROWS + R) * 256 + c0), z = *(const v2u*)(P + (size_t)R * NPROJ + PC_DZ + c0);
          float x[4] = {bf_lo(a.x) + bf_lo(c.x), bf_hi(a.x) + bf_hi(c.x), bf_lo(a.y) + bf_lo(c.y), bf_hi(a.y) + bf_hi(c.y)};
          float ss = x[0] * x[0] + x[1] * x[1] + x[2] * x[2] + x[3] * x[3];
          ss += __shfl_xor(ss, 1); ss += __shfl_xor(ss, 2); ss += __shfl_xor(ss, 4); ss += __shfl_xor(ss, 8);
          const float sc = 1.f / sqrtf(ss * (1.f / 64.f) + EPSN);
          const f32x4 gg = *(const f32x4*)(ng + (c0 & 63));
          v2u o; o.x = pk2(x[0] * sc * gg[0] * siluf_(bf_lo(z.x)), x[1] * sc * gg[1] * siluf_(bf_hi(z.x))); o.y = pk2(x[2] * sc * gg[2] * siluf_(bf_lo(z.y)), x[3] * sc * gg[3] * siluf_(bf_hi(z.y)));
          *(v2u*)(MIX + (size_t)R * DM + 512 + c0) = o; }
    }
}

#ifndef MK_N_LAUNCHES
#define MK_N_LAUNCHES 1
#endif
__global__ void __launch_bounds__(NTHR, 2) mk_fwd(Args args) {
    extern __shared__ __attribute__((aligned(16))) unsigned char lds[];
    Frame F;
    F.lds = (LAS unsigned char*)lds;
    F.MISC = (volatile LAS unsigned*)(F.lds + MISC_OFF);
    F.tid = threadIdx.x; F.lane = F.tid & 63; F.wave = __builtin_amdgcn_readfirstlane(F.tid >> 6);
    F.G = gridDim.x; { const int bx = blockIdx.x; F.vcu = (F.G % 8 == 0) ? (bx % 8) * (F.G / 8) + bx / 8 : bx; }
    F.ws = args.ws; F.out = args.out; F.zz = 0;
    F.ctl = (gu32*)(args.ws + WS_CTL);
    for (int u = F.tid; u < (LDS_BYTES - MISC_OFF) / 4; u += NTHR) ((LAS unsigned*)(F.lds + MISC_OFF))[u] = 0u;
    __syncthreads();
    const int lo = args.ph_lo, hi = args.ph_hi;
    const bool use_bar = (hi - lo) > 1;
    XcdBarrier bar; bar.bar = (unsigned*)(F.ctl + CW_BAR); bar.x = 0; bar.st = nullptr;
    if (use_bar) bar = xcd_barrier_post((unsigned*)(F.ctl + CW_BAR), F.MISC + 8);
#ifndef EN_MASK
#define EN_MASK 0xFFFFFFFFu
#endif
#define IN(k) (((EN_MASK >> ((k) > 12 ? (k) - 12 : (k))) & 1u) && lo <= (k) && (k) < hi)
#define PB() do { int z_ = 0; asm volatile("" : "+s"(z_)); F.ws = args.ws + z_; F.ctl = (gu32*)(args.ws + z_); F.zz = z_; int t_ = threadIdx.x; asm volatile("" : "+v"(t_)); F.tid = t_; F.lane = t_ & 63; F.wave = __builtin_amdgcn_readfirstlane(t_ >> 6); } while (0)
#define SEAM(k) do { if (IN(k) && IN((k) + 1)) { XcdBarrier bl_ = bar; { int z_ = 0; unsigned x_ = bar.x; asm volatile("" : "+s"(z_), "+s"(x_)); bl_.bar = (unsigned*)(args.ws + WS_CTL) + CW_BAR + z_; bl_.x = x_; } xcd_barrier(bl_); } } while (0)
    char* ldsg = (char*)lds;

    if (IN(PH_PRO)) { PB(); p0_prologue(F, args); } SEAM(PH_PRO);

#pragma unroll 1
    for (int l = 0; l < 2; ++l) {
        const int pb = 1 + 12 * l;
        const float* modl = (const float*)(F.ws + WS_MOD) + l * 5 * 6144;
        if (IN(pb + PH_N1)) { PB(); norm_mod_phase(F, args, l, 0, false, false); } SEAM(pb + PH_N1);
        if (IN(pb + PH_PROJ)) { PB();
            pg8::Gemm g{(const bf16*)(F.ws + WS_U), (const bf16*)(F.ws + WS_WIN) + (size_t)l * NPROJ * 1024, 1024, 1024, 1024};
            TileOrder S; S.init(MROWS / 256, NPROJ / 256, F.G, (int)blockIdx.x, 0);
            EpiProj E{(bf16*)(F.ws + WS_PROJ), (float*)(F.ws + WS_GB), (const float*)(F.ws + WS_ROPE), args.in[F.zz + 12] + l * 8, args.in[F.zz + 13] + l * 8};
            pg8::gemm_phase<EpiProj, TileOrder, true, true>(F.lds, g, S, E);
        } SEAM(pb + PH_PROJ);
        if (IN(pb + PH_ATT)) { PB();
            const bf16* P = (const bf16*)(F.ws + WS_PROJ); bf16* AO = (bf16*)(F.ws + WS_ATTO);
            const int nunits = 512 + (l == 0 ? 32 : 0);
#ifndef DIS_ATTN
#pragma unroll 1
            for (int u = F.vcu; u < nunits; u += F.G) {
                int b, hm, qrow, seq;
                if (u < 512) { b = u >> 7; hm = (u >> 4) & 7; qrow = CTXL + (u & 15) * 256; seq = RPB; }
                else { const int v = u - 512; b = v >> 3; hm = v & 7; qrow = 0; seq = CTXL; }
                const size_t r0 = (size_t)b * RPB;
                attn::attn_unit<NPROJ, DM>(P + (r0 + qrow) * NPROJ + PC_AQ + hm * 64, P + r0 * NPROJ + PC_AK + hm * 64, P + r0 * NPROJ + PC_AV + (hm >> 1) * 128,
                                           AO + (r0 + qrow) * DM + hm * 128, seq, ldsg);
            }
#endif
#ifndef DIS_DNPRE
#pragma unroll 1
            for (int u = F.vcu; u < NB * NCHUNK * 4; u += F.G) { const int h = u & 3, n = (u >> 2) % NCHUNK, b = (u >> 2) / NCHUNK; dn_pre_unit(F, args, l, b, n, h); }
#endif
#ifndef DIS_POOL
#pragma unroll 1
            for (int u = F.vcu; u < (MROWS / 64) * 4; u += F.G) pool_unit(F, args, l, u >> 2, u & 3);
#endif
        } SEAM(pb + PH_ATT);
        if (IN(pb + PH_SCAN)) { PB();
#pragma unroll 1
            for (int it = F.vcu; it < 128; it += F.G) dn_scan_item(F, it);
        } SEAM(pb + PH_SCAN);
        if (IN(pb + PH_MIXB)) { PB(); mix_build(F, args, l); } SEAM(pb + PH_MIXB);
#pragma unroll 1
        for (int s = 0; s < 3; ++s) {
            if (IN(pb + PH_MRG0 + s)) { PB();
                const int koff = s == 0 ? 0 : (s == 1 ? 512 : 768), ks = s == 0 ? 512 : 256;
                pg8::Gemm g{(const bf16*)(F.ws + WS_MIX) + koff, (const bf16*)(F.ws + WS_WBR) + (size_t)l * 1024 * 1024 + (size_t)1024 * koff, ks, 1024, ks};
                TileOrder S; S.init(l == 0 ? 68 : 64, 4, F.G, (int)blockIdx.x, l);
                EpiMerge E{(bf16*)(F.ws + WS_MG), (const bf16*)(F.ws + WS_PROJ), PC_GATE + s * 1024, s == 0};
                pg8::gemm_phase<EpiMerge, TileOrder, true, true>(F.lds, g, S, E);
            }
            if (s < 2) { if (IN(pb + PH_MRG0 + s)) { PB(); VM_WAIT(); __syncthreads(); } } else SEAM(pb + PH_MRG2);
        }
        if (IN(pb + PH_OUT)) { PB();
            pg8::Gemm g{(const bf16*)(F.ws + WS_MG), (const bf16*)(F.ws + WS_WOUT) + (size_t)l * 1024 * 1024, 1024, 1024, 1024};
            TileOrder S; S.init(l == 0 ? 68 : 64, 4, F.G, (int)blockIdx.x, l);
            EpiResid E{(float*)(F.ws + WS_H), modl, 2};
            pg8::gemm_phase<EpiResid, TileOrder, true, true>(F.lds, g, S, E);
        } SEAM(pb + PH_OUT);
        if (IN(pb + PH_N2)) { PB(); norm_mod_phase(F, args, l, 1, l == 1, l == 1); } SEAM(pb + PH_N2);
        if (l == 0) {
            if (IN(PH_FUP)) { PB();
                pg8::Gemm g{(const bf16*)(F.ws + WS_U), (const bf16*)(F.ws + WS_W13), 1024, 1024, 1024};
                TileOrder S; S.init(68, 2 * FFD / 256, F.G, (int)blockIdx.x, 0);
                EpiSwiglu E{(bf16*)(F.ws + WS_HID), FFD};
                pg8::gemm_phase<EpiSwiglu, TileOrder, true, true>(F.lds, g, S, E);
            } SEAM(PH_FUP);
            if (IN(PH_FDN)) { PB();
                pg8::Gemm g{(const bf16*)(F.ws + WS_HID), (const bf16*)(F.ws + WS_W2), FFD, FFD, FFD};
                TileOrder S; S.init(68, 4, F.G, (int)blockIdx.x, 0);
                EpiResid E{(float*)(F.ws + WS_H), modl, 5};
                pg8::gemm_phase<EpiResid, TileOrder, true, true>(F.lds, g, S, E);
            } SEAM(PH_FDN);
        }
    }
    if (IN(PH_GATH)) { PB(); moe_gather(F); } SEAM(PH_GATH);
#pragma unroll 1
    for (int hh = 0; hh < 2; ++hh) {
        const int p0 = PH_CV0 + 3 * hh;
        if (IN(p0)) { PB();
#ifdef DBG_DETPOS
            if (hh == 0) moe_gather2(F);
#endif
            moe_convert(F, args, hh); } SEAM(p0);
        if (IN(p0 + 1)) { PB();
            pg8::Gemm g{(const bf16*)(F.ws + WS_XG), (const bf16*)(F.ws + WS_W13M), 1024, 1024, 1024};
            MoeOrder S; S.init(F.ctl + CW_ECNT, FFE / 256, F.G, F.vcu);
            EpiSwiglu E{(bf16*)(F.ws + WS_HIDM), FFEH};
            pg8::gemm_phase<EpiSwiglu, MoeOrder, true, true>(F.lds, g, S, E);
        } SEAM(p0 + 1);
        if (IN(p0 + 2)) { PB();
            pg8::Gemm g{(const bf16*)(F.ws + WS_HIDM), (const bf16*)(F.ws + WS_W2M), FFEH, FFEH, FFEH};
            MoeOrder S; S.init(F.ctl + CW_ECNT, 4, F.G, F.vcu);
            EpiY E{(bf16*)(F.ws + WS_Y), hh == 0};
            pg8::gemm_phase<EpiY, MoeOrder, true, true>(F.lds, g, S, E);
        } SEAM(p0 + 2);
    }
    if (IN(PH_FIN)) { PB(); final_phase(F, args); }
#ifdef DBG_STOP
    if (lo == 100) {
        const int gw = F.vcu * NWAVES + F.wave, NGW = F.G * NWAVES;
        for (int tk = gw; tk < NB * SEQ; tk += NGW) { const int b = tk / SEQ, t = tk - b * SEQ; const size_t R = (size_t)b * RPB + CTXL + t;
#if DBG_SRC == 0
            const f32x4* s = (const f32x4*)((const float*)(args.ws + WS_H) + R * DM) + F.lane; f32x4* d = (f32x4*)(args.out + (size_t)tk * DM) + F.lane;
            for (int q = 0; q < 4; ++q) d[64 * q] = s[64 * q];
#elif DBG_SRC == 2
            MoeOrder mo; mo.init((gu32*)args.ws + CW_ECNT, 1, 1, 0); const v4u rt = ((const v4u*)(args.ws + WS_ROUTE))[2 * tk];
            const size_t rr = (size_t)mo.tile_off((int)rt.x) * 256 + rt.z; (void)R;
            const bf16* s = (const bf16*)(args.ws + DBG_OFF) + rr * DBG_LD + DBG_COL; float* d = args.out + (size_t)tk * DM;
            for (int q = 0; q < 16; ++q) d[F.lane + 64 * q] = bf2f(s[F.lane + 64 * q]);
#else
            const bf16* s = (const bf16*)(args.ws + DBG_OFF) + R * DBG_LD + DBG_COL; float* d = args.out + (size_t)tk * DM;
            for (int q = 0; q < 16; ++q) d[F.lane + 64 * q] = bf2f(s[F.lane + 64 * q]);
#endif
        }
    }
#endif
#undef IN
#undef SEAM
}

extern "C" void kernel_launch(void* const* d_in, const int* in_sizes, int n_in, void* d_out, int out_size, void* d_ws, size_t ws_size, hipStream_t stream) {
    static int grid = 0;
    if (grid == 0) {
        if (n_in != 27 || in_sizes[0] != NB * SEQ * DM || out_size != NB * SEQ * DM || ws_size < WS_END) {
            fprintf(stderr, "kernel_launch: shape / workspace mismatch (n_in %d, in0 %d, out %d, ws %zu, need %zu); nothing launched\n", n_in, n_in > 0 ? in_sizes[0] : -1, out_size, ws_size, (size_t)WS_END); grid = -1; return; }
        int dev = 0, cus = 0, per_cu = 0;
        if (hipGetDevice(&dev) != hipSuccess || hipDeviceGetAttribute(&cus, hipDeviceAttributeMultiprocessorCount, dev) != hipSuccess) { grid = -1; return; }
        if (hipFuncSetAttribute((const void*)mk_fwd, hipFuncAttributeMaxDynamicSharedMemorySize, LDS_BYTES) != hipSuccess) { fprintf(stderr, "kernel_launch: hipFuncSetAttribute failed\n"); grid = -1; return; }
        if (hipOccupancyMaxActiveBlocksPerMultiprocessor(&per_cu, (const void*)mk_fwd, NTHR, LDS_BYTES) != hipSuccess || per_cu < 1)
            fprintf(stderr, "kernel_launch: note: occupancy query reports %d workgroups per CU\n", per_cu);
        (void)hipGetLastError();
        grid = cus;
    }
    if (grid < 0) return;
    if (hipMemsetAsync((char*)d_ws + WS_CTL, 0, CTL_ZERO_BYTES, stream) != hipSuccess) return;
    Args a{};
    for (int i = 0; i < 27; ++i) a.in[i] = (const float*)d_in[i];
    a.out = (float*)d_out; a.ws = (unsigned char*)d_ws;
    constexpr int NL = MK_N_LAUNCHES;
#ifdef DBG_STOP
    constexpr int NLL = DBG_STOP + 2;
#else
    constexpr int NLL = NL;
#endif
    for (int li = 0; li < NLL; ++li) {
#ifdef DBG_SKIP_LO
        if (li >= DBG_SKIP_LO && li <= DBG_SKIP_HI) continue;
#endif
        a.ph_lo = (NL == 1) ? 0 : li; a.ph_hi = (NL == 1) ? PH_COUNT : li + 1;
#ifdef DBG_STOP
        if (li == NLL - 1) { a.ph_lo = 100; a.ph_hi = 101; }
#endif
        hipLaunchKernelGGL(mk_fwd, dim3(grid), dim3(NTHR), LDS_BYTES, stream, a);
        const hipError_t le = hipPeekAtLastError();
        if (le != hipSuccess) { fprintf(stderr, "kernel_launch: launch %d failed: %s\n", li, hipGetErrorName(le)); break; }
    }
}
```

```cpp
#include <hip/hip_runtime.h>
#include <cstdio>
#include <cstdint>
#include <cmath>

namespace pg8 {
#define PG8_LAS __attribute__((address_space(3)))
typedef unsigned short bf16_t;
typedef short bf16x8 __attribute__((ext_vector_type(8)));
typedef float f32x4 __attribute__((ext_vector_type(4)));
typedef unsigned u32x4 __attribute__((ext_vector_type(4)));
typedef unsigned u32x2 __attribute__((ext_vector_type(2)));
constexpr int BM = 256, BK = 64, HALF = 128, HTB = HALF * BK * 2  , STAGE_BYTES = 8 * HTB;

__host__ __device__ __forceinline__ int lds_byte(int r, int c) { const int st = (r >> 4) * 2 + (c >> 5), rr = r & 15, cc = c & 31, ob = rr * 64 + cc * 2; return st * 1024 + (ob ^ (((ob >> 9) & 1) << 5)); }
__host__ __device__ __forceinline__ void stage_rc(int b, int& R, int& C) { const int st = b / 1024, sb = b % 1024, swz = sb ^ (((sb >> 9) & 1) << 5); R = (st >> 1) * 16 + swz / 64; C = (st & 1) * 32 + (swz % 64) / 2; }
__host__ __device__ __forceinline__ int perm32(int rho) { const int n = rho >> 4, i = rho & 15; return 8 * (i >> 2) + 4 * n + (i & 3); }

struct Unit { int pm, pn, pb; };
struct Gemm { const bf16_t* A; const bf16_t* Bt; int K, lda, ldb; };

__device__ __forceinline__ unsigned cvt_pk_bf16(float lo, float hi) { unsigned r; asm volatile("v_cvt_pk_bf16_f32 %0, %1, %2" : "=v"(r) : "v"(lo), "v"(hi)); return r; }
template <class Epi, class Sched, bool ALIGN_EPI = false, bool SP2 = false>
__device__ __forceinline__ void gemm_phase(PG8_LAS unsigned char* lds, const Gemm g, const Sched& S, const Epi& E) {
    int tid = threadIdx.x; asm volatile("" : "+v"(tid)); const int wid = __builtin_amdgcn_readfirstlane(tid >> 6), lane = tid & 63, wr = wid >> 2, wc = wid & 3, fr = lane & 15, fq = lane >> 4;
    const int K = g.K, nt = K / BK;
    unsigned voffA[2], voffB[2];
#pragma unroll
    for (int i = 0; i < 2; ++i) { int R, C; stage_rc(tid * 16 + i * 8192, R, C); const int Rb = Epi::PERM ? ((R & ~31) + perm32(R & 31)) : R;
        voffA[i] = (unsigned)(R * g.lda + C) * 2u; voffB[i] = (unsigned)(Rb * g.ldb + C) * 2u; }
    const size_t kstep = (size_t)(BK * 2);
    const size_t hstepA = (size_t)HALF * g.lda * 2, hstepB = (size_t)HALF * g.ldb * 2;
    const size_t tstepA = 2 * hstepA, tstepB = 2 * hstepB;
    const unsigned ldsw = (unsigned)wid * 1024u;
    const int aoff = lds_byte(wr * 64 + fr, fq * 8), boff = lds_byte(wc * 32 + fr, fq * 8);
#define PG8_SA(b, h) (((b) * 2 + (h)) * HTB)
#define PG8_SB(b, h) ((4 + (b) * 2 + (h)) * HTB)
#define PG8_STAGE(bufoff, gbase, voff) do { _Pragma("unroll") for (int _i = 0; _i < 2; ++_i) \
        __builtin_amdgcn_global_load_lds((const unsigned*)((const char*)(gbase) + (voff)[_i]), (PG8_LAS unsigned*)(lds + (bufoff) + ldsw + _i * 8192), 16, 0, 0); } while (0)
#define PG8_LDA(dst, b, h) do { _Pragma("unroll") for (int m = 0; m < 4; ++m) _Pragma("unroll") for (int k = 0; k < 2; ++k) dst[m][k] = *(const PG8_LAS bf16x8*)(lds + PG8_SA(b, h) + aoff + m * 2048 + k * 1024); } while (0)
#define PG8_LDB(dst, b, h) do { _Pragma("unroll") for (int n = 0; n < 2; ++n) _Pragma("unroll") for (int k = 0; k < 2; ++k) dst[n][k] = *(const PG8_LAS bf16x8*)(lds + PG8_SB(b, h) + boff + n * 2048 + k * 1024); } while (0)
#define PG8_MMA(ai, bj, At, Bt) do { __builtin_amdgcn_s_setprio(1); _Pragma("unroll") for (int m = 0; m < 4; ++m) _Pragma("unroll") for (int n = 0; n < 2; ++n) _Pragma("unroll") for (int k = 0; k < 2; ++k) \
        acc[ai][bj][m][n] = __builtin_amdgcn_mfma_f32_16x16x32_bf16(Bt[n][k], At[m][k], acc[ai][bj][m][n], 0, 0, 0); __builtin_amdgcn_s_setprio(0); } while (0)
#define PG8_WAIT_V(n) asm volatile("s_waitcnt vmcnt(" #n ")" ::: "memory")
#define PG8_WAIT_L(n) asm volatile("s_waitcnt lgkmcnt(" #n ")" ::: "memory")
#define PG8_BAR __builtin_amdgcn_s_barrier()
#define PG8_SCHED __builtin_amdgcn_sched_barrier(0)
    Unit cur, nxt; int ui = 0;
    if (!S.next(0, cur)) return;
    f32x4 acc[2][2][4][2];
#pragma unroll
    for (int a = 0; a < 2; ++a)
#pragma unroll
        for (int b = 0; b < 2; ++b)
#pragma unroll
            for (int m = 0; m < 4; ++m)
#pragma unroll
                for (int n = 0; n < 2; ++n) acc[a][b][m][n] = (f32x4){0.f, 0.f, 0.f, 0.f};
    bf16x8 At[4][2], B0[2][2], B1[2][2];
    const char* cA = (const char*)g.A + (size_t)cur.pm * tstepA; const char* cB = (const char*)g.Bt + (size_t)cur.pb * tstepB;
    S.a_ready(cur);
    if constexpr (SP2) {
        PG8_STAGE(PG8_SB(0, 0), cB, voffB); PG8_STAGE(PG8_SB(0, 1), cB + hstepB, voffB); PG8_STAGE(PG8_SA(0, 0), cA, voffA); PG8_STAGE(PG8_SA(0, 1), cA + hstepA, voffA);
        if (wr == 1) PG8_BAR;
        PG8_WAIT_V(2); PG8_BAR;
        PG8_STAGE(PG8_SB(1, 0), cB + kstep, voffB); PG8_STAGE(PG8_SA(1, 0), cA + kstep, voffA); PG8_STAGE(PG8_SB(1, 1), cB + hstepB + kstep, voffB);
        PG8_WAIT_V(6); PG8_BAR;
    } else {
        PG8_STAGE(PG8_SB(0, 0), cB, voffB); PG8_STAGE(PG8_SA(0, 0), cA, voffA); PG8_STAGE(PG8_SB(0, 1), cB + hstepB, voffB); PG8_STAGE(PG8_SA(0, 1), cA + hstepA, voffA);
        if (wr == 1) PG8_BAR;
        PG8_WAIT_V(4); PG8_BAR;
        PG8_STAGE(PG8_SB(1, 0), cB + kstep, voffB); PG8_STAGE(PG8_SA(1, 0), cA + kstep, voffA); PG8_STAGE(PG8_SB(1, 1), cB + hstepB + kstep, voffB);
        PG8_WAIT_V(6); PG8_BAR;
    }
    for (;;) {
        const bool has_next = S.next(ui + 1, nxt);
        const char* nA = has_next ? (const char*)g.A + (size_t)nxt.pm * tstepA : cA; const char* nB = has_next ? (const char*)g.Bt + (size_t)nxt.pb * tstepB : cB;
        for (int t = 0; t < nt; t += 2) {
            const bool last = (t == nt - 2);
            const char* a1 = cA + (size_t)(t + 1) * kstep;
            const char* a2 = last ? nA : cA + (size_t)(t + 2) * kstep; const char* b2 = last ? nB : cB + (size_t)(t + 2) * kstep;
            const char* a3 = a2 + kstep; const char* b3 = b2 + kstep;
            if (last && has_next) S.a_ready(nxt);
            if constexpr (SP2) {
            PG8_LDB(B0, 0, 0); PG8_LDB(B1, 0, 1); PG8_SCHED; PG8_LDA(At, 0, 0); PG8_STAGE(PG8_SA(1, 1), a1 + hstepA, voffA);
            PG8_WAIT_V(8); PG8_WAIT_L(0); PG8_BAR; PG8_MMA(0, 0, At, B0); PG8_MMA(0, 1, At, B1); PG8_BAR; PG8_SCHED;
            PG8_LDA(At, 0, 1); PG8_STAGE(PG8_SB(0, 0), b2, voffB); PG8_STAGE(PG8_SB(0, 1), b2 + hstepB, voffB); PG8_STAGE(PG8_SA(0, 0), a2, voffA);
            PG8_WAIT_V(8); PG8_WAIT_L(0); PG8_BAR; PG8_MMA(1, 0, At, B0); PG8_MMA(1, 1, At, B1); PG8_BAR; PG8_SCHED;
            PG8_LDB(B0, 1, 0); PG8_LDB(B1, 1, 1); PG8_SCHED; PG8_LDA(At, 1, 0); PG8_STAGE(PG8_SA(0, 1), a2 + hstepA, voffA);
            PG8_WAIT_V(8); PG8_WAIT_L(0); PG8_BAR; PG8_MMA(0, 0, At, B0); PG8_MMA(0, 1, At, B1); PG8_BAR; PG8_SCHED;
            PG8_LDA(At, 1, 1); PG8_STAGE(PG8_SB(1, 0), b3, voffB); PG8_STAGE(PG8_SB(1, 1), b3 + hstepB, voffB); PG8_STAGE(PG8_SA(1, 0), a3, voffA);
            PG8_WAIT_V(8); PG8_WAIT_L(0); PG8_BAR; PG8_MMA(1, 0, At, B0); PG8_MMA(1, 1, At, B1); PG8_BAR; PG8_SCHED;
            } else {
            PG8_LDB(B0, 0, 0); PG8_SCHED; PG8_LDA(At, 0, 0); PG8_STAGE(PG8_SA(1, 1), a1 + hstepA, voffA);
            PG8_WAIT_L(8); PG8_BAR; PG8_WAIT_L(0); PG8_MMA(0, 0, At, B0); PG8_BAR; PG8_SCHED;
            PG8_LDB(B1, 0, 1); PG8_STAGE(PG8_SB(0, 0), b2, voffB);
            PG8_BAR; PG8_WAIT_L(0); PG8_MMA(0, 1, At, B1); PG8_BAR;
            PG8_LDA(At, 0, 1); PG8_STAGE(PG8_SA(0, 0), a2, voffA);
            PG8_BAR; PG8_WAIT_L(0); PG8_MMA(1, 0, At, B0); PG8_BAR; PG8_SCHED;
            PG8_STAGE(PG8_SB(0, 1), b2 + hstepB, voffB);
            PG8_WAIT_V(6); PG8_BAR; PG8_MMA(1, 1, At, B1); PG8_BAR;
            PG8_LDB(B0, 1, 0); PG8_SCHED; PG8_LDA(At, 1, 0); PG8_STAGE(PG8_SA(0, 1), a2 + hstepA, voffA);
            PG8_WAIT_L(8); PG8_BAR; PG8_WAIT_L(0); PG8_MMA(0, 0, At, B0); PG8_BAR; PG8_SCHED;
            PG8_LDB(B1, 1, 1); PG8_STAGE(PG8_SB(1, 0), b3, voffB);
            PG8_BAR; PG8_WAIT_L(0); PG8_MMA(0, 1, At, B1); PG8_BAR;
            PG8_LDA(At, 1, 1); PG8_STAGE(PG8_SA(1, 0), a3, voffA);
            PG8_BAR; PG8_WAIT_L(0); PG8_MMA(1, 0, At, B0); PG8_BAR; PG8_SCHED;
            PG8_STAGE(PG8_SB(1, 1), b3 + hstepB, voffB);
            PG8_WAIT_V(6); PG8_BAR; PG8_MMA(1, 1, At, B1); PG8_BAR;
            }
        }
        if constexpr (ALIGN_EPI) { if (wr == 0) PG8_BAR; }
        if constexpr (!Epi::AFTER_DRAIN) { E(acc, cur, wr, wc, fr, fq); S.done(cur); }
        if (!has_next) break;
#pragma unroll
        for (int a = 0; a < 2; ++a)
#pragma unroll
            for (int b = 0; b < 2; ++b)
#pragma unroll
                for (int m = 0; m < 4; ++m)
#pragma unroll
                    for (int n = 0; n < 2; ++n) acc[a][b][m][n] = (f32x4){0.f, 0.f, 0.f, 0.f};
        cur = nxt; cA = nA; cB = nB; ++ui;
        if constexpr (ALIGN_EPI) { if (wr == 1) PG8_BAR; }
    }
    PG8_WAIT_V(0);
    if constexpr (!ALIGN_EPI) { if (wr == 0) PG8_BAR; }
    PG8_BAR;
    if constexpr (Epi::AFTER_DRAIN) { E.fused(acc, cur, wr, wc, fr, fq, lds, wid, lane); S.done(cur); }
#undef PG8_SA
#undef PG8_SB
#undef PG8_STAGE
#undef PG8_LDA
#undef PG8_LDB
#undef PG8_MMA
#undef PG8_WAIT_V
#undef PG8_WAIT_L
#undef PG8_BAR
#undef PG8_SCHED
}
}

namespace attn {
using bf16x8 = __attribute__((ext_vector_type(8))) short;
using s16x4  = __attribute__((ext_vector_type(4))) short;
using f32x16 = __attribute__((ext_vector_type(16))) float;
using u32x4  = __attribute__((ext_vector_type(4))) unsigned;
constexpr int DV = 128, DK = 64, NW = 8, QBLK = 32, KVBLK = 64;
constexpr float SCALE = 0.125f;
constexpr float THR = 4.f;
constexpr size_t SHM_V = KVBLK * DV * 2, SHM_K = KVBLK * DK * 2, SHM_ATTN = 2 * SHM_V + 2 * SHM_K + NW * 64 * 4;
#define AKSWZ(row, colB) ((row) * 128 + ((colB) ^ ((((row) >> 1) & 7) << 4)))
#define ASBAR() __builtin_amdgcn_sched_barrier(0)
__device__ __forceinline__ int crow(int r, int hi) { return (r & 3) + 8 * (r >> 2) + 4 * hi; }
__device__ __forceinline__ unsigned cvtpk(float lo, float hi) { unsigned r; asm volatile("v_cvt_pk_bf16_f32 %0, %1, %2" : "=v"(r) : "v"(lo), "v"(hi)); return r; }

__device__ __forceinline__ void partialSM(f32x16& p0, f32x16& p1, float& m_reg, float& mn, float& alpha) {
  constexpr float C = SCALE * 1.4426950408889634f;
  float pmax = p0[0];
#pragma unroll
  for (int r = 1; r < 16; ++r) pmax = fmaxf(pmax, p0[r]);
#pragma unroll
  for (int r = 0; r < 16; ++r) pmax = fmaxf(pmax, p1[r]);
  { auto rr = __builtin_amdgcn_permlane32_swap(__float_as_uint(pmax), __float_as_uint(pmax), false, false);
    pmax = fmaxf(__uint_as_float(rr[0]), __uint_as_float(rr[1])); }
  if (__builtin_expect(__all(pmax - m_reg <= THR / SCALE), 1)) { mn = m_reg; alpha = 1.f; }
  else { mn = fmaxf(m_reg, pmax); alpha = __builtin_amdgcn_exp2f((m_reg - mn) * C); m_reg = mn; }
  const float mnC = -mn * C;
#pragma unroll
  for (int r = 0; r < 16; ++r) p0[r] = fmaf(p0[r], C, mnC);
#pragma unroll
  for (int r = 0; r < 16; ++r) p1[r] = fmaf(p1[r], C, mnC);
#pragma unroll
  for (int r = 0; r < 16; ++r) p0[r] = __builtin_amdgcn_exp2f(p0[r]);
}
__device__ __forceinline__ void finishSM(f32x16& p0, f32x16& p1, float alpha, float& l_reg, bf16x8& pa0, bf16x8& pa1, bf16x8& pa2, bf16x8& pa3) {
#pragma unroll
  for (int r = 0; r < 16; ++r) p1[r] = __builtin_amdgcn_exp2f(p1[r]);
  float ps = 0;
#pragma unroll
  for (int r = 0; r < 16; ++r) ps += p0[r];
#pragma unroll
  for (int r = 0; r < 16; ++r) ps += p1[r];
  { auto rr = __builtin_amdgcn_permlane32_swap(__float_as_uint(ps), __float_as_uint(ps), false, false);
    ps = __uint_as_float(rr[0]) + __uint_as_float(rr[1]); }
  l_reg = l_reg * alpha + ps;
#define APK4(P, BASE, OUT) do { unsigned a0 = cvtpk(P[BASE + 0], P[BASE + 1]), a1 = cvtpk(P[BASE + 2], P[BASE + 3]);   \
    unsigned b0 = cvtpk(P[BASE + 4], P[BASE + 5]), b1 = cvtpk(P[BASE + 6], P[BASE + 7]);                              \
    auto r0 = __builtin_amdgcn_permlane32_swap(a0, b0, false, false); auto r1 = __builtin_amdgcn_permlane32_swap(a1, b1, false, false); \
    u32x4 w = {r0[0], r1[0], r0[1], r1[1]}; OUT = *reinterpret_cast<bf16x8*>(&w); } while (0)
  APK4(p0, 0, pa0); APK4(p0, 8, pa1); APK4(p1, 0, pa2); APK4(p1, 8, pa3);
#undef APK4
}
__device__ __forceinline__ void qkt(f32x16& p0, f32x16& p1, const char* Ks, const bf16x8* qr, int r32, int hi) {
  p0 = f32x16{}; p1 = f32x16{};
#pragma unroll
  for (int d0 = 0; d0 < 4; ++d0) { const int cb = (d0 * 16 + hi * 8) * 2;
    bf16x8 b0 = *reinterpret_cast<const bf16x8*>(Ks + AKSWZ(r32, cb));
    bf16x8 b1 = *reinterpret_cast<const bf16x8*>(Ks + AKSWZ(32 + r32, cb));
    p0 = __builtin_amdgcn_mfma_f32_32x32x16_bf16(b0, qr[d0], p0, 0, 0, 0);
    p1 = __builtin_amdgcn_mfma_f32_32x32x16_bf16(b1, qr[d0], p1, 0, 0, 0); }
}
__device__ __forceinline__ int v_st(int k, int c) { const int kk = (k & ~0xC) | ((k & 4) << 1) | ((k & 8) >> 1); return ((kk >> 3) * 4 + (c >> 5)) * 512 + ((kk & 7) * 32 + (c & 31)) * 2; }
__device__ __forceinline__ int v_rd_base(int lane) { return ((lane & 3) << 3) | (((lane >> 2) & 3) << 6) | (((lane >> 4) & 1) << 5) | (((lane >> 5) & 1) << 8); }
constexpr int v_rd_off(int d0, int ks, int half) { return d0 * 512 + ks * 4096 + half * 2048; }
template <int OFF> __device__ __forceinline__ s16x4 tr_read(int vb) {
  s16x4 r; asm volatile("ds_read_b64_tr_b16 %0, %1 offset:%2" : "=&v"(r) : "v"(vb), "i"(OFF) : "memory"); return r;
}
template <int D0> __device__ __forceinline__ void pv_one(f32x16& od, int vb, bf16x8 pa0, bf16x8 pa1, bf16x8 pa2, bf16x8 pa3) {
  const s16x4 l0 = tr_read<v_rd_off(D0, 0, 0)>(vb), h0 = tr_read<v_rd_off(D0, 0, 1)>(vb), l1 = tr_read<v_rd_off(D0, 1, 0)>(vb), h1 = tr_read<v_rd_off(D0, 1, 1)>(vb);
  const s16x4 l2 = tr_read<v_rd_off(D0, 2, 0)>(vb), h2 = tr_read<v_rd_off(D0, 2, 1)>(vb), l3 = tr_read<v_rd_off(D0, 3, 0)>(vb), h3 = tr_read<v_rd_off(D0, 3, 1)>(vb);
  asm volatile("s_waitcnt lgkmcnt(0)" ::: "memory"); ASBAR();
#define APK(L, H) (bf16x8){L[0], L[1], L[2], L[3], H[0], H[1], H[2], H[3]}
  od = __builtin_amdgcn_mfma_f32_32x32x16_bf16(pa0, APK(l0, h0), od, 0, 0, 0);
  od = __builtin_amdgcn_mfma_f32_32x32x16_bf16(pa1, APK(l1, h1), od, 0, 0, 0);
  od = __builtin_amdgcn_mfma_f32_32x32x16_bf16(pa2, APK(l2, h2), od, 0, 0, 0);
  od = __builtin_amdgcn_mfma_f32_32x32x16_bf16(pa3, APK(l3, h3), od, 0, 0, 0);
#undef APK
}
__device__ __forceinline__ void pv_d0(f32x16* o, int vb, bf16x8 pa0, bf16x8 pa1, bf16x8 pa2, bf16x8 pa3) {
  pv_one<0>(o[0], vb, pa0, pa1, pa2, pa3); pv_one<1>(o[1], vb, pa0, pa1, pa2, pa3); pv_one<2>(o[2], vb, pa0, pa1, pa2, pa3); pv_one<3>(o[3], vb, pa0, pa1, pa2, pa3);
}
template <int LDQ, int LDO>
__device__ __forceinline__ void attn_unit(const unsigned short* __restrict__ Qb, const unsigned short* __restrict__ Kh, const unsigned short* __restrict__ Vh,
                                          unsigned short* __restrict__ Ob, int seq, char* lds) {
  int tid = threadIdx.x; asm volatile("" : "+v"(tid)); const int wid = tid >> 6, lane = tid & 63, r32 = lane & 31, hi = lane >> 5;
  char* V_lds = lds; char* K_lds = lds + 2 * SHM_V;
  float* ws = (float*)(lds + 2 * SHM_V + 2 * SHM_K) + wid * 64; float* li_l = ws; float* al_l = ws + 32;
  float m_reg = -1e30f, l_reg = 0; f32x16 o[4] = {}; bf16x8 qr[4];
  const unsigned short* Qw = Qb + (long)(wid * QBLK + r32) * LDQ + hi * 8;
#pragma unroll
  for (int d0 = 0; d0 < 4; ++d0) qr[d0] = *reinterpret_cast<const bf16x8*>(Qw + d0 * 16);
  const int sr = tid >> 4, sc = (tid & 15) * 8, vst0 = v_st(sr, sc), vst1 = v_st(32 + sr, sc);
  const int kr = tid >> 3, kc = (tid & 7) * 8, kst = AKSWZ(kr, kc * 2);
  const int vb0 = (int)(uintptr_t)V_lds + v_rd_base(lane);
  bf16x8 sv0[2], sv1[2], sk0[2];
#define ASLOAD(i, k0) do { sv0[i] = *reinterpret_cast<const bf16x8*>(&Vh[(long)((k0) + sr) * LDQ + sc]); sv1[i] = *reinterpret_cast<const bf16x8*>(&Vh[(long)((k0) + 32 + sr) * LDQ + sc]); \
    sk0[i] = *reinterpret_cast<const bf16x8*>(&Kh[(long)((k0) + kr) * LDQ + kc]); } while (0)
#define ASWRITE(b, i) do { *(bf16x8*)(V_lds + (b) * SHM_V + vst0) = sv0[i]; *(bf16x8*)(V_lds + (b) * SHM_V + vst1) = sv1[i]; \
    *(bf16x8*)(K_lds + (b) * SHM_K + kst) = sk0[i]; } while (0)
#define ASWAIT() asm volatile("s_waitcnt vmcnt(3)" ::: "memory")
#define ARESC(a) do { if (__any((a) < 1.f)) { if (hi == 0) al_l[r32] = (a); asm volatile("s_waitcnt lgkmcnt(0)" ::: "memory"); \
    _Pragma("unroll") for (int d = 0; d < 4; ++d) _Pragma("unroll") for (int r = 0; r < 16; ++r) o[d][r] *= al_l[crow(r, hi)]; } } while (0)
  f32x16 pA0, pA1, pB0, pB1; float mnA, mnB, alA, alB; bf16x8 pa0, pa1, pa2, pa3; const int NT = seq / KVBLK;
  ASLOAD(0, 0); asm volatile("s_waitcnt vmcnt(0)" ::: "memory"); ASWRITE(0, 0); __syncthreads();
  qkt(pA0, pA1, K_lds, qr, r32, hi); partialSM(pA0, pA1, m_reg, mnA, alA);
  ASLOAD(1, KVBLK); if (2 < NT) ASLOAD(0, 2 * KVBLK);
  if (2 < NT) ASWAIT(); else asm volatile("s_waitcnt vmcnt(0)" ::: "memory");
  ASWRITE(1, 1); __syncthreads();
  for (int j = 1; j + 1 < NT; j += 2) {
    ASBAR(); qkt(pB0, pB1, K_lds + SHM_K, qr, r32, hi);
    finishSM(pA0, pA1, alA, l_reg, pa0, pa1, pa2, pa3); ASBAR();
    ASLOAD(1, (j + 2) * KVBLK); ASBAR();
    pv_d0(o, vb0, pa0, pa1, pa2, pa3); partialSM(pB0, pB1, m_reg, mnB, alB);
    __syncthreads(); ASWAIT(); ASWRITE(0, 0);
    ARESC(alB); __syncthreads();
    ASBAR(); qkt(pA0, pA1, K_lds, qr, r32, hi);
    finishSM(pB0, pB1, alB, l_reg, pa0, pa1, pa2, pa3); ASBAR();
    if (j + 3 < NT) ASLOAD(0, (j + 3) * KVBLK); ASBAR();
    pv_d0(o, vb0 + (int)SHM_V, pa0, pa1, pa2, pa3); partialSM(pA0, pA1, m_reg, mnA, alA);
    __syncthreads(); if (j + 3 < NT) ASWAIT(); else asm volatile("s_waitcnt vmcnt(0)" ::: "memory");
    ASWRITE(1, 1);
    ARESC(alA); __syncthreads();
  }
  ASBAR(); qkt(pB0, pB1, K_lds + SHM_K, qr, r32, hi);
  finishSM(pA0, pA1, alA, l_reg, pa0, pa1, pa2, pa3); ASBAR();
  pv_d0(o, vb0, pa0, pa1, pa2, pa3); partialSM(pB0, pB1, m_reg, mnB, alB);
  __syncthreads(); ARESC(alB);
  finishSM(pB0, pB1, alB, l_reg, pa0, pa1, pa2, pa3); ASBAR();
  pv_d0(o, vb0 + (int)SHM_V, pa0, pa1, pa2, pa3);
  if (hi == 0) li_l[r32] = l_reg; asm volatile("s_waitcnt lgkmcnt(0)" ::: "memory");
  float rli[16];
#pragma unroll
  for (int r = 0; r < 16; ++r) rli[r] = __builtin_amdgcn_rcpf(li_l[crow(r, hi)]);
  unsigned short* Ow = Ob + (long)(wid * QBLK) * LDO;
#pragma unroll
  for (int r = 0; r < 16; ++r) { const int orow = crow(r, hi);
#pragma unroll
    for (int d0 = 0; d0 < 4; ++d0) { const float v = o[d0][r] * rli[r]; Ow[(long)orow * LDO + d0 * 32 + r32] = (unsigned short)(cvtpk(v, v) & 0xffffu); } }
  __syncthreads();
#undef ASLOAD
#undef ASWRITE
#undef ASWAIT
#undef ARESC
}
}

constexpr int NWAVES = 8, NTHR = NWAVES * 64;
constexpr int DM = 1024, NB = 4, SEQ = 4096, CTXL = 256, RPB = CTXL + SEQ  , MROWS = NB * RPB  ;
constexpr int INW = 5904, NPROJ = 6144;
constexpr int FFD = 2816, FFE = 3584, NEXP = 8, FFEH = FFE / 2;
constexpr int NCHUNK = RPB / 64;
constexpr float EPSN = 1e-6f;
constexpr int PC_AQ = 0, PC_AK = 512, PC_AV = 1024, PC_DQ = 1536, PC_DK = 1792, PC_DV = 2048, PC_DZ = 2304, PC_POOL = 2560, PC_GATE = 2816, PC_AB = 5888;

constexpr size_t MiB = 1u << 20;
constexpr size_t WS_CTL = 0, CTL_ZERO_BYTES = 2 * MiB;
constexpr size_t WS_MOD = 1 * MiB;
constexpr size_t WS_ROPE = 2 * MiB;
constexpr size_t WS_LAM = 2 * MiB + 65536;
constexpr size_t WS_ROUTE = 3 * MiB;
constexpr size_t WS_GB = 4 * MiB;
constexpr size_t WS_WIN = 8 * MiB;
constexpr size_t WS_WBR = 32 * MiB;
constexpr size_t WS_WOUT = 36 * MiB;
constexpr size_t WS_W13 = 40 * MiB;
constexpr size_t WS_W2 = 51 * MiB;
constexpr size_t WS_H = 58 * MiB;
constexpr size_t WS_U = 126 * MiB;
constexpr size_t WS_ATTO = WS_U;
constexpr size_t WS_PROJ = 160 * MiB;
constexpr size_t WS_MIX = 364 * MiB;
constexpr size_t WS_DNP = 398 * MiB;
constexpr size_t WS_MG = WS_DNP;
constexpr size_t WS_DNG = 466 * MiB;
constexpr size_t WS_DNO = 467 * MiB;
constexpr size_t WS_HID = WS_PROJ;
constexpr int MOE_MAXT = 136;
constexpr size_t WS_XG = 160 * MiB;
constexpr size_t WS_Y = 228 * MiB;
constexpr size_t WS_W13M = 296 * MiB;
constexpr size_t WS_W2M = 352 * MiB;
constexpr size_t WS_HIDM = 380 * MiB;
constexpr size_t WS_END = 500 * MiB;
static_assert(WS_HIDM + (size_t)MOE_MAXT * 256 * FFEH * 2 <= WS_END && WS_DNO + (size_t)2 * MROWS * 256 * 2 <= WS_END, "ws map");
static_assert(WS_WIN + (size_t)2 * NPROJ * 1024 * 2 <= WS_WBR && WS_W13 + (size_t)2 * FFD * 1024 * 2 <= WS_W2 && WS_W2 + (size_t)1024 * FFD * 2 <= WS_H, "ws map (weights)");
static_assert(WS_H + (size_t)MROWS * 1024 * 4 <= WS_U && WS_U + (size_t)MROWS * 1024 * 2 <= WS_PROJ && WS_PROJ + (size_t)MROWS * NPROJ * 2 <= WS_MIX, "ws map (acts)");
static_assert(WS_MIX + (size_t)MROWS * 1024 * 2 <= WS_DNP && WS_DNP + (size_t)NB * NCHUNK * 4 * 2 * 32768 <= WS_DNG, "ws map (dn)");
static_assert(WS_XG + (size_t)MOE_MAXT * 256 * 1024 * 2 <= WS_Y && WS_Y + (size_t)MOE_MAXT * 256 * 1024 * 2 <= WS_W13M && WS_W13M + (size_t)8 * FFE * 1024 * 2 <= WS_W2M && WS_W2M + (size_t)8 * 1024 * FFEH * 2 <= WS_HIDM, "ws map (moe)");
constexpr int CW_TMO = 0, CW_CODE = 1;
constexpr int CW_BAR = 4096;
constexpr int CW_ECNT = 8192;

constexpr int RING_BYTES = 155648;
constexpr int MISC_OFF = RING_BYTES;
constexpr int LDS_BYTES = RING_BYTES + 1024;

enum { PH_PRO = 0, PH_L0 = 1, PH_N1 = 0, PH_PROJ = 1, PH_ATT = 2, PH_SCAN = 3, PH_MIXB = 4, PH_MRG0 = 5, PH_MRG1 = 6, PH_MRG2 = 7, PH_OUT = 8, PH_N2 = 9, PH_LAYER = 10,
       PH_FUP = 11, PH_FDN = 12, PH_L1 = 13, PH_GATH = 23, PH_CV0 = 24, PH_UP0 = 25, PH_DN0 = 26, PH_CV1 = 27, PH_UP1 = 28, PH_DN1 = 29, PH_FIN = 30, PH_COUNT = 31 };

#define GAS __attribute__((address_space(1)))
#define LAS __attribute__((address_space(3)))
typedef unsigned short bf16;
typedef unsigned v4u __attribute__((ext_vector_type(4)));
typedef unsigned v2u __attribute__((ext_vector_type(2)));
typedef float f32x4 __attribute__((ext_vector_type(4)));
typedef GAS unsigned gu32;
#define RLX_AGENT __ATOMIC_RELAXED, __HIP_MEMORY_SCOPE_AGENT
#define LDS_WAIT() asm volatile("s_waitcnt lgkmcnt(0)" ::: "memory")
#define VM_WAIT() asm volatile("s_waitcnt vmcnt(0)" ::: "memory")
__device__ __forceinline__ unsigned f2bf(float f) { unsigned u = __builtin_bit_cast(unsigned, f); return (u + 0x7fffu + ((u >> 16) & 1u)) >> 16; }
__device__ __forceinline__ unsigned pk2(float lo, float hi) { return f2bf(lo) | (f2bf(hi) << 16); }
__device__ __forceinline__ float bf_lo(unsigned w) { return __builtin_bit_cast(float, w << 16); }
__device__ __forceinline__ float bf_hi(unsigned w) { return __builtin_bit_cast(float, w & 0xffff0000u); }
__device__ __forceinline__ float bf2f(bf16 v) { return __builtin_bit_cast(float, (unsigned)v << 16); }
__device__ __forceinline__ float sigmoidf_(float x) { return 1.f / (1.f + __expf(-x)); }
__device__ __forceinline__ float siluf_(float x) { return x / (1.f + __expf(-x)); }
__device__ __forceinline__ float wave_sum(float v) {
#pragma unroll
    for (int o = 1; o < 64; o <<= 1) v += __shfl_xor(v, o);
    return v;
}
#define XB_TMO      128
#define XB_XCNT(j)  (256  + 64 * (j))
#define XB_XSUB(j)  (1280 + 64 * (j))
#define XB_XGEN(j)  (2304 + 64 * (j))
#define XB_TOP      3328
#define XB_TOPGEN   3392
#define XCD_BAR_WORDS 3456
#define XB_SPIN_CAP (1u << 18)

__device__ __forceinline__ unsigned xb_ld(unsigned* p)              { return __hip_atomic_load(p, __ATOMIC_RELAXED, __HIP_MEMORY_SCOPE_AGENT); }
__device__ __forceinline__ unsigned xb_add(unsigned* p, unsigned v) { return __hip_atomic_fetch_add(p, v, __ATOMIC_RELAXED, __HIP_MEMORY_SCOPE_AGENT); }
__device__ __forceinline__ unsigned xb_xcc_id() { return (unsigned)__builtin_amdgcn_s_getreg((3 << 11) | 20) & 0xFu; }
#define XB_SPIN(cond, bar) do { unsigned _sp = 0; while (cond) { __builtin_amdgcn_s_sleep(1); \
    if ((++_sp & 255u) == 0u) { if (xb_ld(&(bar)[XB_TMO])) break; if (_sp > XB_SPIN_CAP) { atomicAdd(&(bar)[XB_TMO], 1u); break; } } } } while (0)

struct XcdBarrier {
    unsigned* bar; unsigned x;
    volatile LAS unsigned* st;
};

__device__ __forceinline__ XcdBarrier xcd_barrier_post(unsigned* bar, volatile LAS unsigned* st) {
    XcdBarrier b; b.bar = bar; b.x = xb_xcc_id(); b.st = st;
    if (threadIdx.x == 0) (void)xb_add(&bar[XB_XCNT(b.x)], 1u);
    return b;
}
__device__ __forceinline__ void xcd_barrier_complete(unsigned* bar, unsigned x, unsigned& nloc, unsigned& nx) {
    const unsigned G = gridDim.x * gridDim.y * gridDim.z;
    unsigned sum, cnt, mine, sp = 0u;
    for (;;) {
        sum = 0u; cnt = 0u; mine = 0u;
#pragma unroll
        for (unsigned j = 0; j < 16; ++j) { const unsigned c = xb_ld(&bar[XB_XCNT(j)]); sum += c; cnt += (c > 0u) ? 1u : 0u; mine = (j == x) ? c : mine; }
        if (sum == G) break;
        __builtin_amdgcn_s_sleep(1);
        if ((++sp & 255u) == 0u) { if (xb_ld(&bar[XB_TMO])) break; if (sp > XB_SPIN_CAP) { atomicAdd(&bar[XB_TMO], 1u); break; } }
    }
    nloc = mine > 0u ? mine : 1u; nx = cnt > 0u ? cnt : 1u;
}

__device__ __forceinline__ void xcd_barrier(const XcdBarrier& b) {
    asm volatile("s_waitcnt vmcnt(0)" ::: "memory");
    __syncthreads();
    if (threadIdx.x == 0) {
        unsigned* bar = b.bar;
        __builtin_amdgcn_s_waitcnt(0);
        unsigned nloc = b.st[0], nx = b.st[1];
        if (nloc == 0u) { xcd_barrier_complete(bar, b.x, nloc, nx); b.st[0] = nloc; b.st[1] = nx; }
        const unsigned old = xb_add(&bar[XB_XSUB(b.x)], 1u);
        const unsigned gen = old / nloc;
        if (old + 1u == (gen + 1u) * nloc) {
            __builtin_amdgcn_fence(__ATOMIC_RELEASE, "agent");
            asm volatile("s_waitcnt vmcnt(0)" ::: "memory");
            const unsigned og = xb_add(&bar[XB_TOP], 1u);
            const unsigned tg = og / nx;
            if (og + 1u == (tg + 1u) * nx) xb_add(&bar[XB_TOPGEN], 1u);
            else XB_SPIN(xb_ld(&bar[XB_TOPGEN]) == tg, bar);
            __builtin_amdgcn_fence(__ATOMIC_ACQUIRE, "agent");
            xb_add(&bar[XB_XGEN(b.x)], 1u);
            asm volatile("s_waitcnt vmcnt(0)" ::: "memory");
        } else {
            XB_SPIN(xb_ld(&bar[XB_XGEN(b.x)]) == gen, bar);
            __builtin_amdgcn_fence(__ATOMIC_ACQUIRE, "agent");
            asm volatile("s_waitcnt vmcnt(0)" ::: "memory");
        }
    }
    __syncthreads();
}

struct Frame {
    LAS unsigned char* lds;
    volatile LAS unsigned* MISC;
    gu32* ctl;
    int tid, lane, wave, vcu, G, zz;
    unsigned char* ws;
    float* out;
};
struct Args { const float* in[27]; float* out; unsigned char* ws; int ph_lo, ph_hi; };

struct TileOrder {
    int nM, nN, nwg, G, c, skip;
    __device__ __forceinline__ void init(int nM_, int nN_, int G_, int c_, int skip_) { nM = nM_; nN = nN_; nwg = nM * nN; G = G_; c = c_; skip = skip_; }
    __device__ __forceinline__ bool next(int i, pg8::Unit& u) const {
        const long L = (long)i * G + c; if (L >= nwg) return false;
        int wgid = (int)L; { const int q = nwg / 8, r = nwg % 8, xcd = wgid % 8, off = wgid / 8; wgid = (xcd < r ? xcd * (q + 1) : r * (q + 1) + (xcd - r) * q) + off; }
        const int nig = 8 * nN, gid = wgid / nig, fm = gid * 8, gsz = (nM - fm) < 8 ? (nM - fm) : 8;
        int pm = fm + ((wgid % nig) % gsz); const int pn = (wgid % nig) / gsz;
        if (skip) pm = (pm >> 4) * 17 + 1 + (pm & 15);
        u.pm = pm; u.pn = pn; u.pb = pn; return true;
    }
    __device__ __forceinline__ void a_ready(const pg8::Unit&) const {}
    __device__ __forceinline__ void done(const pg8::Unit&) const {}
};
struct MoeOrder {
    int t1, t2, t3, t4, t5, t6, t7, t8, nN, G, c;
    __device__ __forceinline__ void init(const gu32* cnt, int nN_, int G_, int c_) {
        int t = 0;
        t += ((int)__hip_atomic_load(cnt + 0 * 64, RLX_AGENT) + 255) >> 8; t1 = t; t += ((int)__hip_atomic_load(cnt + 1 * 64, RLX_AGENT) + 255) >> 8; t2 = t;
        t += ((int)__hip_atomic_load(cnt + 2 * 64, RLX_AGENT) + 255) >> 8; t3 = t; t += ((int)__hip_atomic_load(cnt + 3 * 64, RLX_AGENT) + 255) >> 8; t4 = t;
        t += ((int)__hip_atomic_load(cnt + 4 * 64, RLX_AGENT) + 255) >> 8; t5 = t; t += ((int)__hip_atomic_load(cnt + 5 * 64, RLX_AGENT) + 255) >> 8; t6 = t;
        t += ((int)__hip_atomic_load(cnt + 6 * 64, RLX_AGENT) + 255) >> 8; t7 = t; t += ((int)__hip_atomic_load(cnt + 7 * 64, RLX_AGENT) + 255) >> 8; t8 = t;
        nN = nN_; G = G_; c = c_;
    }
    __device__ __forceinline__ int tile_off(int e) const { return e == 0 ? 0 : e == 1 ? t1 : e == 2 ? t2 : e == 3 ? t3 : e == 4 ? t4 : e == 5 ? t5 : e == 6 ? t6 : t7; }
    __device__ __forceinline__ bool next(int i, pg8::Unit& u) const {
        const long L = (long)i * G + c; if (L >= (long)t8 * nN) return false;
        const int pm = (int)(L / nN), pn = (int)(L % nN);
        const int e = (pm >= t1) + (pm >= t2) + (pm >= t3) + (pm >= t4) + (pm >= t5) + (pm >= t6) + (pm >= t7);
        u.pm = pm; u.pn = pn; u.pb = e * nN + pn; return true;
    }
    __device__ __forceinline__ void a_ready(const pg8::Unit&) const {}
    __device__ __forceinline__ void done(const pg8::Unit&) const {}
};

#define EPI_LOOP(...) _Pragma("unroll") for (int ai = 0; ai < 2; ++ai) _Pragma("unroll") for (int m = 0; m < 4; ++m) { const int row = u.pm * 256 + ai * 128 + wr * 64 + m * 16 + fr; \
    _Pragma("unroll") for (int bj = 0; bj < 2; ++bj) { const int col = bj * 128 + wc * 32 + 4 * fq; f32x4 v0 = acc[ai][bj][m][0], v1 = acc[ai][bj][m][1]; __VA_ARGS__ } if (m & 1) asm volatile("" ::: "memory"); }
__device__ __forceinline__ v2u pack4(f32x4 v) { v2u w; w.x = pg8::cvt_pk_bf16(v[0], v[1]); w.y = pg8::cvt_pk_bf16(v[2], v[3]); return w; }
__device__ __forceinline__ f32x4 unpack4(v2u w) { return (f32x4){bf_lo(w.x), bf_hi(w.x), bf_lo(w.y), bf_hi(w.y)}; }

struct EpiProj {
    static constexpr bool PERM = false, AFTER_DRAIN = false;
    bf16* P; float* GB; const float* rope; const float* a_log; const float* dt_bias;
    __device__ __forceinline__ void operator()(const pg8::f32x4 (&acc)[2][2][4][2], const pg8::Unit& u, int wr, int wc, int fr, int fq) const {
        const int pn = u.pn;
        if (pn < 4) {
            EPI_LOOP({ const int j = row % RPB;
                if (j >= CTXL) { const int t = j - CTXL; const int pos = (wc & 1) ? (t & 63) : (t >> 6);
                    const f32x4 cs0 = *(const f32x4*)(rope + (pos * 16 + 4 * fq) * 2), cs1 = *(const f32x4*)(rope + (pos * 16 + 4 * fq) * 2 + 4);
                    const float c0 = cs0[0], s0 = cs0[1], c1 = cs0[2], s1 = cs0[3], c2 = cs1[0], s2 = cs1[1], c3 = cs1[2], s3 = cs1[3];
                    const f32x4 a = v0, b = v1;
                    v0[0] = a[0] * c0 - b[0] * s0; v1[0] = b[0] * c0 + a[0] * s0; v0[1] = a[1] * c1 - b[1] * s1; v1[1] = b[1] * c1 + a[1] * s1;
                    v0[2] = a[2] * c2 - b[2] * s2; v1[2] = b[2] * c2 + a[2] * s2; v0[3] = a[3] * c3 - b[3] * s3; v1[3] = b[3] * c3 + a[3] * s3; }
                bf16* o = P + (size_t)row * NPROJ + pn * 256 + col; *(v2u*)o = pack4(v0); *(v2u*)(o + 16) = pack4(v1); })
        } else if (pn >= 11 && pn < 23) {
            EPI_LOOP({ for (int q = 0; q < 4; ++q) { v0[q] = sigmoidf_(v0[q]); v1[q] = sigmoidf_(v1[q]); }
                bf16* o = P + (size_t)row * NPROJ + pn * 256 + col; *(v2u*)o = pack4(v0); *(v2u*)(o + 16) = pack4(v1); })
        } else if (pn == 23) {
            if (wc == 0) {
                EPI_LOOP({ if (bj == 0) { f32x4 r;
                    for (int q = 0; q < 4; ++q) { const int c = 4 * fq + q; const float x = v0[q];
                        if (c < 8) { const float z = x + dt_bias[c]; const float ez = __expf(z); const float sp = z > 15.f ? z : (ez < 0.03f ? ez * (1.f - ez * (0.5f - ez * (1.f / 3.f))) : __logf(1.f + ez)); r[q] = -__expf(a_log[c]) * sp; }
                        else r[q] = sigmoidf_(x); }
                    *(f32x4*)(GB + (size_t)row * 16 + 4 * fq) = r; } (void)v1; })
            }
        } else {
            EPI_LOOP({ bf16* o = P + (size_t)row * NPROJ + pn * 256 + col; *(v2u*)o = pack4(v0); *(v2u*)(o + 16) = pack4(v1); })
        }
    }
};
struct EpiMerge {
    static constexpr bool PERM = false, AFTER_DRAIN = false;
    bf16* MG; const bf16* P; int gcol0; int first;
    __device__ __forceinline__ void operator()(const pg8::f32x4 (&acc)[2][2][4][2], const pg8::Unit& u, int wr, int wc, int fr, int fq) const {
        EPI_LOOP({ const int c = u.pn * 256 + col; const bf16* gp = P + (size_t)row * NPROJ + gcol0 + c; bf16* o = MG + (size_t)row * DM + c;
            const f32x4 g0 = unpack4(*(const v2u*)gp), g1 = unpack4(*(const v2u*)(gp + 16));
            f32x4 r0 = g0 * v0, r1 = g1 * v1;
            if (!first) { unsigned long long w0 = __hip_atomic_load((unsigned long long*)o, RLX_AGENT), w1 = __hip_atomic_load((unsigned long long*)(o + 16), RLX_AGENT);
                r0 += unpack4((v2u){(unsigned)w0, (unsigned)(w0 >> 32)}); r1 += unpack4((v2u){(unsigned)w1, (unsigned)(w1 >> 32)}); }
            *(v2u*)o = pack4(r0); *(v2u*)(o + 16) = pack4(r1); })
    }
};
struct EpiResid {
    static constexpr bool PERM = false, AFTER_DRAIN = false;
    float* H; const float* modl; int gidx;
    __device__ __forceinline__ void operator()(const pg8::f32x4 (&acc)[2][2][4][2], const pg8::Unit& u, int wr, int wc, int fr, int fq) const {
        EPI_LOOP({ const int c = u.pn * 256 + col; const int b = row / RPB, j = row - b * RPB; const int mr = j < CTXL ? 4 : b;
            const float* gp = modl + mr * 6144 + gidx * 1024 + c; float* hp = H + (size_t)row * DM + c;
            const f32x4 g0 = *(const f32x4*)gp, g1 = *(const f32x4*)(gp + 16);
            *(f32x4*)hp = *(const f32x4*)hp + g0 * v0; *(f32x4*)(hp + 16) = *(const f32x4*)(hp + 16) + g1 * v1; })
    }
};
struct EpiSwiglu {
    static constexpr bool PERM = false, AFTER_DRAIN = false;
    bf16* HID; int ldh;
    __device__ __forceinline__ void operator()(const pg8::f32x4 (&acc)[2][2][4][2], const pg8::Unit& u, int wr, int wc, int fr, int fq) const {
        EPI_LOOP({ (void)col; f32x4 r; for (int q = 0; q < 4; ++q) r[q] = siluf_(v0[q]) * v1[q];
            *(v2u*)(HID + (size_t)row * ldh + u.pn * 128 + bj * 64 + wc * 16 + 4 * fq) = pack4(r); })
    }
};
struct EpiY {
    static constexpr bool PERM = false, AFTER_DRAIN = false;
    bf16* Y; int first;
    __device__ __forceinline__ void operator()(const pg8::f32x4 (&acc)[2][2][4][2], const pg8::Unit& u, int wr, int wc, int fr, int fq) const {
        EPI_LOOP({ bf16* o = Y + (size_t)row * DM + u.pn * 256 + col; f32x4 r0 = v0, r1 = v1;
            if (!first) { unsigned long long w0 = __hip_atomic_load((unsigned long long*)o, RLX_AGENT), w1 = __hip_atomic_load((unsigned long long*)(o + 16), RLX_AGENT);
                r0 += unpack4((v2u){(unsigned)w0, (unsigned)(w0 >> 32)}); r1 += unpack4((v2u){(unsigned)w1, (unsigned)(w1 >> 32)}); }
            *(v2u*)o = pack4(r0); *(v2u*)(o + 16) = pack4(r1); })
    }
};

template <int MAP> __device__ __forceinline__ int map_col(int c) {
    if (MAP == 0) return c;
    if (MAP == 1) return c < 2560 ? c : (c < 2576 ? PC_AB + (c - 2560) : (c < 2832 ? PC_POOL + (c - 2576) : PC_GATE + (c - 2832)));
    if (MAP == 2) return (c >> 4) * 32 + (c & 15);
    return (c >> 4) * 32 + 16 + (c & 15);
}
template <int MAP> __device__ __forceinline__ void tr_item(const float* W, int ldw, int N, bf16* WT, int ldd, int item, LAS float* scr, int lane) {
    const int nblk = (N + 31) / 32, kb = item / nblk, nb = item % nblk, k0 = 64 * kb, n0 = 32 * nb;
    const int cl = n0 + (lane & 31);
#pragma unroll 8
    for (int i = 0; i < 32; ++i) { const int kk = 2 * i + (lane >> 5); scr[kk * 33 + (lane & 31)] = cl < N ? W[(size_t)(k0 + kk) * ldw + cl] : 0.f; }
    LDS_WAIT(); asm volatile("" ::: "memory");
    const int c = lane & 7;
#pragma unroll
    for (int j = 0; j < 4; ++j) { const int n = (lane >> 3) + 8 * j; const LAS float* s = scr + (8 * c) * 33 + n;
        if (n0 + n < N) { v4u o; o.x = pk2(s[0 * 33], s[1 * 33]); o.y = pk2(s[2 * 33], s[3 * 33]); o.z = pk2(s[4 * 33], s[5 * 33]); o.w = pk2(s[6 * 33], s[7 * 33]);
            *(GAS v4u*)(WT + (size_t)map_col<MAP>(n0 + n) * ldd + k0 + 8 * c) = o; } }
    LDS_WAIT(); asm volatile("" ::: "memory");
}
#define TR_RUN(MAP, W, ldw, K, N, WT, ldd) { const int cnt_ = ((K) / 64) * (((N) + 31) / 32); if (r < cnt_) { tr_item<MAP>(W, ldw, N, WT, ldd, r, scr, F.lane); continue; } r -= cnt_; }

__device__ __forceinline__ void p0_prologue(Frame& F, const Args& A) {
    LAS float* scr = (LAS float*)(F.lds + F.wave * 16384);
    const int gw = F.vcu * NWAVES + F.wave, NGW = F.G * NWAVES;
    bf16* WIN = (bf16*)(F.ws + WS_WIN); bf16* WBR = (bf16*)(F.ws + WS_WBR); bf16* WOUT = (bf16*)(F.ws + WS_WOUT); bf16* W13 = (bf16*)(F.ws + WS_W13); bf16* W2 = (bf16*)(F.ws + WS_W2);
    constexpr int PER_LAYER = 16 * 185 + 8 * 32 + 4 * 32 + 4 * 32 + 16 * 32, TOTAL = 2 * PER_LAYER + 16 * 88 * 2 + 44 * 32;
    for (int it = gw; it < TOTAL; it += NGW) {
        int r = it;
        for (int l = 0; l < 2; ++l) {
            bool hit = false;
            if (r < PER_LAYER) { hit = true;
                const float* win = A.in[F.zz + 8] + (size_t)l * 1024 * INW; const float* wbr = A.in[F.zz + 17] + (size_t)l * 1024 * 1024; const float* wo = A.in[F.zz + 18] + (size_t)l * 1024 * 1024;
                bf16* dbr = WBR + (size_t)l * 1024 * 1024;
                do {
                    { const int cnt_ = 16 * 185; if (r < cnt_) { tr_item<1>(win, INW, INW, WIN + (size_t)l * NPROJ * 1024, 1024, r, scr, F.lane); break; } r -= cnt_; }
                    { const int cnt_ = 8 * 32; if (r < cnt_) { tr_item<0>(wbr, 1024, 1024, dbr, 512, r, scr, F.lane); break; } r -= cnt_; }
                    { const int cnt_ = 4 * 32; if (r < cnt_) { tr_item<0>(wbr + 512 * 1024, 1024, 1024, dbr + 1024 * 512, 256, r, scr, F.lane); break; } r -= cnt_; }
                    { const int cnt_ = 4 * 32; if (r < cnt_) { tr_item<0>(wbr + 768 * 1024, 1024, 1024, dbr + 1024 * 768, 256, r, scr, F.lane); break; } r -= cnt_; }
                    tr_item<0>(wo, 1024, 1024, WOUT + (size_t)l * 1024 * 1024, 1024, r, scr, F.lane);
                } while (0);
            }
            if (hit) { r = -1; break; }
            r -= PER_LAYER;
        }
        if (r < 0) continue;
        { const int cnt_ = 16 * 88; if (r < cnt_) { tr_item<2>(A.in[F.zz + 19], FFD, FFD, W13, 1024, r, scr, F.lane); continue; } r -= cnt_; }
        { const int cnt_ = 16 * 88; if (r < cnt_) { tr_item<3>(A.in[F.zz + 20], FFD, FFD, W13, 1024, r, scr, F.lane); continue; } r -= cnt_; }
        tr_item<0>(A.in[F.zz + 21], 1024, 1024, W2, FFD, r, scr, F.lane);
    }
    float* H = (float*)(F.ws + WS_H);
    for (int R = gw; R < MROWS; R += NGW) { const int b = R / RPB, j = R - b * RPB;
        const float* src = j < CTXL ? A.in[F.zz + 2] + ((size_t)b * CTXL + j) * DM : A.in[F.zz + 0] + ((size_t)b * SEQ + (j - CTXL)) * DM;
        const GAS f32x4* s4 = (const GAS f32x4*)src + F.lane; GAS f32x4* d4 = (GAS f32x4*)(H + (size_t)R * DM) + F.lane;
#pragma unroll
        for (int q = 0; q < 4; ++q) d4[64 * q] = s4[64 * q]; }
    if (F.vcu == 0) {
        float* rope = (float*)(F.ws + WS_ROPE);
        for (int e = F.tid; e < 1024; e += NTHR) { const int pos = e >> 4, i = e & 15; const float inv = powf(10000.f, -(float)i / 16.f); const float a = (float)pos * inv;
            rope[2 * e] = cosf(a); rope[2 * e + 1] = sinf(a); }
        if (F.tid < 2) { const int l = F.tid; const float* lp = A.in[F.zz + 9] + l * 256; float s1 = 0.f, s2 = 0.f;
            for (int i = 0; i < 64; ++i) { s1 += lp[i] * lp[64 + i]; s2 += lp[128 + i] * lp[192 + i]; }
            const float li = 0.8f - 0.6f * expf(-0.3f * (float)l);
            ((float*)(F.ws + WS_LAM))[l] = expf(s1) - expf(s2) + li; }
    }
    __syncthreads();
    float* MOD = (float*)(F.ws + WS_MOD);
    LAS float* red = (LAS float*)F.lds;
    for (int task = F.vcu; task < 2 * 96; task += F.G) {
        const int l = task / 96, cc = task % 96;
        const float* aw = A.in[F.zz + 4] + (size_t)l * 1024 * 6144 + cc * 64 + F.lane;
        const float* c0 = A.in[F.zz + 1]; const float* cx = A.in[F.zz + 3];
        float a0 = 0.f, a1 = 0.f, a2 = 0.f, a3 = 0.f, a4 = 0.f;
#pragma unroll 8
        for (int i = 0; i < 128; ++i) { const int k = F.wave * 128 + i; const float w = aw[(size_t)k * 6144];
            a0 += siluf_(c0[k]) * w; a1 += siluf_(c0[1024 + k]) * w; a2 += siluf_(c0[2048 + k]) * w; a3 += siluf_(c0[3072 + k]) * w; a4 += siluf_(cx[k]) * w; }
        LAS float* rw = red + F.wave * 320 + F.lane;
        rw[0] = a0; rw[64] = a1; rw[128] = a2; rw[192] = a3; rw[256] = a4;
        __syncthreads();
        if (F.tid < 320) { float s = 0.f;
#pragma unroll
            for (int w = 0; w < 8; ++w) s += red[w * 320 + F.tid];
            const int rr = F.tid >> 6, jj = cc * 64 + (F.tid & 63);
            MOD[(l * 5 + rr) * 6144 + jj] = s + A.in[F.zz + 5][l * 6144 + jj]; }
        __syncthreads();
    }
}

__device__ __forceinline__ void moe_convert(Frame& F, const Args& A, int hh) {
    LAS float* scr = (LAS float*)(F.lds + F.wave * 16384);
    const int gw = F.vcu * NWAVES + F.wave, NGW = F.G * NWAVES;
    bf16* W13M = (bf16*)(F.ws + WS_W13M); bf16* W2M = (bf16*)(F.ws + WS_W2M);
    constexpr int I13 = 16 * 56, I2 = 28 * 32, PER_E = 2 * I13 + I2;
    for (int it = gw; it < 8 * PER_E; it += NGW) {
        const int e = it / PER_E; int r = it - e * PER_E;
        if (r < I13) { tr_item<2>(A.in[F.zz + 23] + (size_t)e * 1024 * FFE + hh * FFEH, FFE, FFEH, W13M + (size_t)e * FFE * 1024, 1024, r, scr, F.lane); continue; } r -= I13;
        if (r < I13) { tr_item<3>(A.in[F.zz + 24] + (size_t)e * 1024 * FFE + hh * FFEH, FFE, FFEH, W13M + (size_t)e * FFE * 1024, 1024, r, scr, F.lane); continue; } r -= I13;
        tr_item<0>(A.in[F.zz + 25] + (size_t)e * FFE * 1024 + (size_t)hh * FFEH * 1024, 1024, 1024, W2M + (size_t)e * 1024 * FFEH, FFEH, r, scr, F.lane);
    }
}

__device__ __forceinline__ void norm_mod_phase(Frame& F, const Args& A, int l, int which, bool latent_only, bool route) {
    const int gw = F.vcu * NWAVES + F.wave, NGW = F.G * NWAVES;
    const float* H = (const float*)(F.ws + WS_H); bf16* U = (bf16*)(F.ws + WS_U); const float* MOD = (const float*)(F.ws + WS_MOD) + l * 5 * 6144;
    const float* g = (which ? A.in[F.zz + 7] : A.in[F.zz + 6]) + l * 1024;
    for (int R = gw; R < MROWS; R += NGW) {
        const int b = R / RPB, j = R - b * RPB; const bool isctx = j < CTXL; if (latent_only && isctx) continue;
        const float* mod = MOD + (isctx ? 4 : b) * 6144; const float* shift = mod + (which ? 3 : 0) * 1024; const float* scale = mod + (which ? 4 : 1) * 1024;
        const GAS f32x4* xr = (const GAS f32x4*)(H + (size_t)R * DM) + F.lane;
        f32x4 v[4]; float ss = 0.f;
#pragma unroll
        for (int q = 0; q < 4; ++q) { v[q] = xr[64 * q]; ss += (v[q].x * v[q].x + v[q].y * v[q].y) + (v[q].z * v[q].z + v[q].w * v[q].w); }
        const float rstd = 1.f / sqrtf(wave_sum(ss) * (1.f / DM) + EPSN);
        GAS v2u* o8 = (GAS v2u*)(U + (size_t)R * DM) + F.lane;
#pragma unroll
        for (int q = 0; q < 4; ++q) { const int c = 4 * F.lane + 256 * q; const f32x4 gg = *(const f32x4*)(g + c), sh = *(const f32x4*)(shift + c), sc = *(const f32x4*)(scale + c);
            v[q] = (v[q] * rstd) * gg * (sc + 1.f) + sh; v2u w; w.x = pk2(v[q].x, v[q].y); w.y = pk2(v[q].z, v[q].w); o8[64 * q] = w; }
        if (route) {
            const float* rw = A.in[F.zz + 22];
            float lg[8] = {0, 0, 0, 0, 0, 0, 0, 0};
#pragma unroll
            for (int q = 0; q < 4; ++q)
#pragma unroll
                for (int i = 0; i < 4; ++i) { const int k = 4 * F.lane + 256 * q + i; const f32x4 w0 = *(const f32x4*)(rw + k * 8), w1 = *(const f32x4*)(rw + k * 8 + 4); const float x = v[q][i];
                    lg[0] += x * w0[0]; lg[1] += x * w0[1]; lg[2] += x * w0[2]; lg[3] += x * w0[3]; lg[4] += x * w1[0]; lg[5] += x * w1[1]; lg[6] += x * w1[2]; lg[7] += x * w1[3]; }
#pragma unroll
            for (int e = 0; e < 8; ++e) lg[e] = wave_sum(lg[e]);
            if (F.lane == 0) {
                int e0 = 0; float v0 = lg[0];
#pragma unroll
                for (int e = 1; e < 8; ++e) if (lg[e] > v0) { v0 = lg[e]; e0 = e; }
                int e1 = -1; float v1 = -3.0e38f;
#pragma unroll
                for (int e = 0; e < 8; ++e) if (e != e0 && lg[e] > v1) { v1 = lg[e]; e1 = e; }
                const float ex = __expf(v1 - v0); const float w0 = 1.f / (1.f + ex), w1 = ex / (1.f + ex);
                gu32* cnt = F.ctl + CW_ECNT;
#ifdef DBG_DETPOS
                const unsigned p0 = 0, p1 = 0; (void)cnt;
#else
                const unsigned p0 = __hip_atomic_fetch_add(cnt + 64 * e0, 1u, RLX_AGENT), p1 = __hip_atomic_fetch_add(cnt + 64 * e1, 1u, RLX_AGENT);
#endif
                const int tk = b * SEQ + (j - CTXL);
                v4u* rt = (v4u*)(F.ws + WS_ROUTE) + 2 * tk;
                rt[0] = (v4u){(unsigned)e0, (unsigned)e1, p0, p1}; rt[1] = (v4u){__float_as_uint(w0), __float_as_uint(w1), 0u, 0u};
            }
        }
    }
}

__device__ __forceinline__ void moe_gather(Frame& F) {
#ifdef DBG_DETPOS
    if (F.vcu == 0 && F.tid == 0) { unsigned c[8] = {0,0,0,0,0,0,0,0};
        for (int tk = 0; tk < NB * SEQ; ++tk) { v4u* rt = (v4u*)(F.ws + WS_ROUTE) + 2 * tk; v4u r = rt[0];
            for (int e = 0; e < 8; ++e) { if ((int)r.x == e) r.z = c[e]++; } for (int e = 0; e < 8; ++e) { if ((int)r.y == e) r.w = c[e]++; } rt[0] = r; }
        for (int e = 0; e < 8; ++e) __hip_atomic_store(F.ctl + CW_ECNT + 64 * e, c[e], RLX_AGENT); }
    return;
#endif
    const int gw = F.vcu * NWAVES + F.wave, NGW = F.G * NWAVES;
    MoeOrder mo; mo.init(F.ctl + CW_ECNT, 1, 1, 0);
    const bf16* U = (const bf16*)(F.ws + WS_U); bf16* XG = (bf16*)(F.ws + WS_XG);
    for (int tk = gw; tk < NB * SEQ; tk += NGW) {
        const int b = tk / SEQ, t = tk - b * SEQ; const size_t R = (size_t)b * RPB + CTXL + t;
        const v4u rt = ((const v4u*)(F.ws + WS_ROUTE))[2 * tk];
        const size_t r0 = (size_t)mo.tile_off((int)rt.x) * 256 + rt.z, r1 = (size_t)mo.tile_off((int)rt.y) * 256 + rt.w;
        const GAS v4u* s = (const GAS v4u*)(U + R * DM) + F.lane; const v4u a = s[0], c = s[64];
        GAS v4u* d0 = (GAS v4u*)(XG + r0 * DM) + F.lane; GAS v4u* d1 = (GAS v4u*)(XG + r1 * DM) + F.lane;
        d0[0] = a; d0[64] = c; d1[0] = a; d1[64] = c;
    }
}

__device__ __forceinline__ void moe_gather2(Frame& F) {
    const int gw = F.vcu * NWAVES + F.wave, NGW = F.G * NWAVES;
    MoeOrder mo; mo.init(F.ctl + CW_ECNT, 1, 1, 0);
    const bf16* U = (const bf16*)(F.ws + WS_U); bf16* XG = (bf16*)(F.ws + WS_XG);
    for (int tk = gw; tk < NB * SEQ; tk += NGW) {
        const int b = tk / SEQ, t = tk - b * SEQ; const size_t R = (size_t)b * RPB + CTXL + t;
        const v4u rt = ((const v4u*)(F.ws + WS_ROUTE))[2 * tk];
        const size_t r0 = (size_t)mo.tile_off((int)rt.x) * 256 + rt.z, r1 = (size_t)mo.tile_off((int)rt.y) * 256 + rt.w;
        const GAS v4u* s = (const GAS v4u*)(U + R * DM) + F.lane; const v4u a = s[0], c = s[64];
        GAS v4u* d0 = (GAS v4u*)(XG + r0 * DM) + F.lane; GAS v4u* d1 = (GAS v4u*)(XG + r1 * DM) + F.lane;
        d0[0] = a; d0[64] = c; d1[0] = a; d1[64] = c;
    }
}

__device__ __forceinline__ void final_phase(Frame& F, const Args& A) {
    const int gw = F.vcu * NWAVES + F.wave, NGW = F.G * NWAVES;
    MoeOrder mo; mo.init(F.ctl + CW_ECNT, 1, 1, 0);
    const float* H = (const float*)(F.ws + WS_H); const bf16* Y = (const bf16*)(F.ws + WS_Y); const float* MOD = (const float*)(F.ws + WS_MOD) + 1 * 5 * 6144;
    for (int tk = gw; tk < NB * SEQ; tk += NGW) {
        const int b = tk / SEQ, t = tk - b * SEQ; const size_t R = (size_t)b * RPB + CTXL + t;
        const v4u rt = ((const v4u*)(F.ws + WS_ROUTE))[2 * tk], rw = ((const v4u*)(F.ws + WS_ROUTE))[2 * tk + 1];
        const size_t r0 = (size_t)mo.tile_off((int)rt.x) * 256 + rt.z, r1 = (size_t)mo.tile_off((int)rt.y) * 256 + rt.w;
        const float w0 = __uint_as_float(rw.x), w1 = __uint_as_float(rw.y);
        const float* gate = MOD + b * 6144 + 5 * 1024;
        f32x4 v[4]; float ss = 0.f;
#pragma unroll
        for (int q = 0; q < 4; ++q) { const int c = 4 * F.lane + 256 * q;
            const f32x4 h = *(const f32x4*)(H + R * DM + c), gg = *(const f32x4*)(gate + c);
            const f32x4 y0 = unpack4(*(const v2u*)(Y + r0 * DM + c)), y1 = unpack4(*(const v2u*)(Y + r1 * DM + c));
            v[q] = h + gg * (y0 * w0 + y1 * w1); ss += (v[q].x * v[q].x + v[q].y * v[q].y) + (v[q].z * v[q].z + v[q].w * v[q].w); }
        const float rstd = 1.f / sqrtf(wave_sum(ss) * (1.f / DM) + EPSN);
#pragma unroll
        for (int q = 0; q < 4; ++q) { const int c = 4 * F.lane + 256 * q; *(f32x4*)(F.out + (size_t)tk * DM + c) = v[q] * rstd * *(const f32x4*)(A.in[F.zz + 26] + c); }
    }
}

typedef short dn_bf16x8 __attribute__((ext_vector_type(8)));
__device__ __forceinline__ f32x4 mm_tile(const LAS float* Am, int a_sm, int a_sk, const LAS float* Bm, int b_sk, int b_sn, int m0, int n0, int lane) {
    const int r = lane & 15, q = lane >> 4; f32x4 acc = {0.f, 0.f, 0.f, 0.f};
#pragma unroll
    for (int ks = 0; ks < 2; ++ks) {
        const LAS float* ap = Am + (m0 + r) * a_sm + (32 * ks + 8 * q) * a_sk; const LAS float* bp = Bm + (32 * ks + 8 * q) * b_sk + (n0 + r) * b_sn;
        v4u a, b;
        a.x = pk2(ap[0], ap[a_sk]); a.y = pk2(ap[2 * a_sk], ap[3 * a_sk]); a.z = pk2(ap[4 * a_sk], ap[5 * a_sk]); a.w = pk2(ap[6 * a_sk], ap[7 * a_sk]);
        b.x = pk2(bp[0], bp[b_sk]); b.y = pk2(bp[2 * b_sk], bp[3 * b_sk]); b.z = pk2(bp[4 * b_sk], bp[5 * b_sk]); b.w = pk2(bp[6 * b_sk], bp[7 * b_sk]);
        acc = __builtin_amdgcn_mfma_f32_16x16x32_bf16(__builtin_bit_cast(dn_bf16x8, a), __builtin_bit_cast(dn_bf16x8, b), acc, 0, 0, 0);
    }
    return acc;
}
template <int D> __device__ __forceinline__ void dn_diag_inv(LAS float* Am, int ln) {
    const int blk = ln >> 4, r = ln & 15;
    LAS float* Ab = Am + (16 * blk) * 65 + 16 * blk;
    float t[16];
#pragma unroll
    for (int c = 0; c < 16; ++c) t[c] = (c == r) ? 1.f : 0.f;
#pragma unroll
    for (int c = 14; c >= 0; --c) { float s = 0.f;
#pragma unroll
        for (int j = c + 1; j < 16; ++j) { const float a = D == 0 ? Ab[j * 65 + c] : Ab[(15 - j) * 65 + (15 - c)]; s -= t[j] * a; }
        t[c] = (c < r) ? s : t[c]; }
    asm volatile("s_waitcnt lgkmcnt(0)" ::: "memory");
#pragma unroll
    for (int c = 0; c < 16; ++c) { if (D == 0) Ab[r * 65 + c] = t[c]; else Ab[(15 - r) * 65 + (15 - c)] = t[c]; }
}
template <int D> __device__ __forceinline__ void dn_solve_tiles(const LAS float* Md, LAS float* Ud, LAS float* Wd, int w4, int ln) {
    typedef short s16x4v __attribute__((ext_vector_type(4)));
    const int r = ln & 15, q = ln >> 4;
#pragma unroll 1
    for (int i = 0; i < 2; ++i) { const int nt = w4 * 2 + i; LAS float* X = (nt < 4 ? Ud : Wd) + (nt & 3) * 16 + r;
        f32x4 acc[4]; s16x4v xb[4];
#pragma unroll
        for (int bi = 0; bi < 4; ++bi)
#pragma unroll
            for (int g = 0; g < 4; ++g) acc[bi][g] = X[(16 * bi + 4 * q + g) * 65];
#pragma unroll
        for (int st = 0; st < 4; ++st) { constexpr int dummy = 0; (void)dummy; const int bi = D == 0 ? st : 3 - st;
#pragma unroll
            for (int s2 = 0; s2 < st; ++s2) { const int bj = D == 0 ? s2 : 3 - s2;
                const LAS float* ap = Md + (16 * bi + r) * 65 + 16 * bj + 4 * q; v2u a; a.x = pk2(-ap[0], -ap[1]); a.y = pk2(-ap[2], -ap[3]);
                acc[bi] = __builtin_amdgcn_mfma_f32_16x16x16bf16_1k(__builtin_bit_cast(s16x4v, a), xb[bj], acc[bi], 0, 0, 0); }
            { const LAS float* ap = Md + (16 * bi + r) * 65 + 16 * bi + 4 * q; v2u a; a.x = pk2(ap[0], ap[1]); a.y = pk2(ap[2], ap[3]);
              v2u xr; xr.x = pk2(acc[bi][0], acc[bi][1]); xr.y = pk2(acc[bi][2], acc[bi][3]);
              acc[bi] = __builtin_amdgcn_mfma_f32_16x16x16bf16_1k(__builtin_bit_cast(s16x4v, a), __builtin_bit_cast(s16x4v, xr), (f32x4){0.f, 0.f, 0.f, 0.f}, 0, 0, 0);
              v2u xo; xo.x = pk2(acc[bi][0], acc[bi][1]); xo.y = pk2(acc[bi][2], acc[bi][3]); xb[bi] = __builtin_bit_cast(s16x4v, xo); }
        }
#pragma unroll
        for (int bi = 0; bi < 4; ++bi)
#pragma unroll
            for (int g = 0; g < 4; ++g) X[(16 * bi + 4 * q + g) * 65] = acc[bi][g];
    }
}
constexpr int DP = 65;
constexpr int DN_ARR = 64 * DP * 4;
__device__ __forceinline__ void dn_pre_unit(Frame& F, const Args& A, int l, int b, int n, int h) {
    LAS float* Qc = (LAS float*)(F.lds + 0 * DN_ARR); LAS float* Kc = (LAS float*)(F.lds + 1 * DN_ARR); LAS float* Vc = (LAS float*)(F.lds + 2 * DN_ARR);
    LAS float* KK = (LAS float*)(F.lds + 3 * DN_ARR);
    LAS float* QK = (LAS float*)(F.lds + 4 * DN_ARR); LAS float* A0 = (LAS float*)(F.lds + 5 * DN_ARR);
    LAS float* U1 = (LAS float*)(F.lds + 6 * DN_ARR); LAS float* W0 = (LAS float*)(F.lds + 7 * DN_ARR); LAS float* W1 = (LAS float*)(F.lds + 8 * DN_ARR);
    LAS float* Gs = (LAS float*)(F.lds + 9 * DN_ARR);
    LAS float* Bs = Gs + 128;
    LAS float* gr = Gs + 256;
    const bf16* P = (const bf16*)(F.ws + WS_PROJ); const float* GB = (const float*)(F.ws + WS_GB);
    int tid = threadIdx.x; asm volatile("" : "+v"(tid));
    const int row0 = b * RPB + n * 64; const int seq_lo = (n < 4) ? b * RPB : b * RPB + CTXL, seq_hi = (n < 4) ? b * RPB + CTXL : (b + 1) * RPB;
    {
        const int t = tid >> 3, cg = tid & 7;
        const float* cw = A.in[F.zz + 11] + (size_t)l * 5 * 768;
#pragma unroll
        for (int p = 0; p < 3; ++p) {
            const int ch = p * 256 + h * 64 + cg * 8;
            float acc[8] = {0, 0, 0, 0, 0, 0, 0, 0};
#pragma unroll
            for (int tap = 0; tap < 5; ++tap) { const int r = row0 + t + tap - 2;
                if (r >= seq_lo && r < seq_hi) { const v4u x = *(const v4u*)(P + (size_t)r * NPROJ + PC_DQ + ch);
                    const f32x4 w0 = *(const f32x4*)(cw + tap * 768 + ch), w1 = *(const f32x4*)(cw + tap * 768 + ch + 4);
                    acc[0] += bf_lo(x.x) * w0[0]; acc[1] += bf_hi(x.x) * w0[1]; acc[2] += bf_lo(x.y) * w0[2]; acc[3] += bf_hi(x.y) * w0[3];
                    acc[4] += bf_lo(x.z) * w1[0]; acc[5] += bf_hi(x.z) * w1[1]; acc[6] += bf_lo(x.w) * w1[2]; acc[7] += bf_hi(x.w) * w1[3]; } }
            float ss = 0.f;
#pragma unroll
            for (int i = 0; i < 8; ++i) { acc[i] = siluf_(acc[i]); ss += acc[i] * acc[i]; }
            float sc = 1.f;
            if (p < 2) { ss += __shfl_xor(ss, 1); ss += __shfl_xor(ss, 2); ss += __shfl_xor(ss, 4); sc = (1.f / sqrtf(ss + EPSN)) * (p == 0 ? 0.125f : 1.f); }
            LAS float* dst = (p == 0 ? Qc : p == 1 ? Kc : Vc) + t * DP + cg * 8;
#pragma unroll
            for (int i = 0; i < 8; ++i) dst[i] = acc[i] * sc;
        }
        if (tid < 128) { const int d = tid >> 6, tt = tid & 63; const float* gb = GB + (size_t)(row0 + tt) * 16; gr[d * 64 + tt] = gb[d * 4 + h]; Bs[d * 64 + tt] = gb[8 + d * 4 + h]; }
    }
    __syncthreads();
    {
        { const int wv = tid >> 6, ln = tid & 63, r = ln & 15, q = ln >> 4;
#pragma unroll
          for (int i = 0; i < 2; ++i) { const int tile = wv * 2 + i, m0 = (tile >> 2) * 16, n0 = (tile & 3) * 16;
              const f32x4 kk = mm_tile(Kc, DP, 1, Kc, 1, DP, m0, n0, ln), qk = mm_tile(Qc, DP, 1, Kc, 1, DP, m0, n0, ln);
#pragma unroll
              for (int g = 0; g < 4; ++g) { KK[(m0 + 4 * q + g) * DP + n0 + r] = kk[g]; QK[(m0 + 4 * q + g) * DP + n0 + r] = qk[g]; } } }
        if (tid < 128) { const int d = tid >> 6, tt = tid & 63; float g = 0.f;
            if (d == 0) { for (int s = 0; s <= tt; ++s) g += gr[s]; } else { for (int s = 63; s >= tt; --s) g += gr[64 + s]; }
            Gs[d * 64 + tt] = g; }
    }
    __syncthreads();
    {
#pragma unroll 1
        for (int k = 0; k < 8; ++k) { const int e = tid + 512 * k, t = e >> 6, s = e & 63; const float kk = KK[t * DP + s];
            const float a0 = (s < t) ? Bs[t] * kk * __expf(Gs[t] - Gs[s]) : 0.f;
            const float a1 = (s > t) ? Bs[64 + t] * kk * __expf(Gs[64 + t] - Gs[64 + s]) : 0.f;
            A0[t * DP + s] = a0; KK[t * DP + s] = a1;
            const float v = Vc[t * DP + s], kc = Kc[t * DP + s];
            Vc[t * DP + s] = Bs[t] * v; U1[t * DP + s] = Bs[64 + t] * v;
            W0[t * DP + s] = Bs[t] * __expf(Gs[t]) * kc; W1[t * DP + s] = Bs[64 + t] * __expf(Gs[64 + t]) * kc; }
    }
    __syncthreads();
    {
        const int wv = tid >> 6, ln = tid & 63;
        if (wv == 0) dn_diag_inv<0>(A0, ln); else if (wv == 4) dn_diag_inv<1>(KK, ln);
    }
    __syncthreads();
    {
        const int wv = tid >> 6, ln = tid & 63;
        if (wv < 4) dn_solve_tiles<0>(A0, Vc, W0, wv & 3, ln); else dn_solve_tiles<1>(KK, U1, W1, wv & 3, ln);
    }
    __syncthreads();
    {
#pragma unroll 1
        for (int k = 0; k < 8; ++k) { const int e = tid + 512 * k, t = e >> 6, s = e & 63; const float qk = QK[t * DP + s];
            A0[t * DP + s] = (s <= t) ? qk * __expf(Gs[t] - Gs[s]) : 0.f;
            KK[t * DP + s] = (s >= t) ? qk * __expf(Gs[64 + t] - Gs[64 + s]) : 0.f; }
    }
    __syncthreads();
    {
        const int wv = tid >> 6, ln = tid & 63, r = ln & 15, q = ln >> 4, d = wv >> 2, mt = wv & 3;
        const LAS float* Aq = d == 0 ? A0 : KK; LAS float* Ud = d == 0 ? Vc : U1; LAS float* Wd = d == 0 ? W0 : W1; const LAS float* Gd = Gs + d * 64;
        const float glast = d == 0 ? Gd[63] : Gd[0];
        const size_t prob = (((size_t)b * NCHUNK + n) * 4 + h) * 2 + d;
        unsigned char* out = F.ws + WS_DNP + prob * 32768;
        if ((tid & 255) == 0) ((float*)(F.ws + WS_DNG))[prob] = __expf(glast);
        const float gq = __expf(Gd[16 * mt + r]);
#pragma unroll 1
        for (int ks = 0; ks < 2; ++ks) {
            const f32x4 y0 = mm_tile(Wd, 1, DP, Aq, 1, DP, 32 * ks, 16 * mt, ln), y1 = mm_tile(Wd, 1, DP, Aq, 1, DP, 32 * ks + 16, 16 * mt, ln);
            const LAS float* qp = Qc + (16 * mt + r) * DP + 32 * ks + 4 * q;
            v4u o; o.x = pk2(gq * qp[0] - y0[0], gq * qp[1] - y0[1]); o.y = pk2(gq * qp[2] - y0[2], gq * qp[3] - y0[3]);
            o.z = pk2(gq * qp[16] - y1[0], gq * qp[17] - y1[1]); o.w = pk2(gq * qp[18] - y1[2], gq * qp[19] - y1[3]);
            *(v4u*)(out + (mt * 2 + ks) * 1024 + ln * 16) = o; }
#pragma unroll 1
        for (int nt = 0; nt < 4; ++nt) { const f32x4 rr = mm_tile(Aq, DP, 1, Ud, DP, 1, 16 * mt, 16 * nt, ln);
            v2u o; o.x = pk2(rr[0], rr[1]); o.y = pk2(rr[2], rr[3]); *(v2u*)(out + 16384 + (mt * 4 + nt) * 512 + ln * 8) = o; }
        __syncthreads();
        { const int tt = tid & 255;
#pragma unroll 1
          for (int k = 0; k < 16; ++k) { const int e = tt + 256 * k, t = e >> 6, c = e & 63; const float sc = __expf(glast - Gd[t]); Ud[t * DP + c] *= sc; Wd[t * DP + c] *= sc; } }
        __syncthreads();
#pragma unroll 1
        for (int ks = 0; ks < 2; ++ks) {
            const f32x4 c0 = mm_tile(Wd, 1, DP, Kc, DP, 1, 32 * ks, 16 * mt, ln), c1 = mm_tile(Wd, 1, DP, Kc, DP, 1, 32 * ks + 16, 16 * mt, ln);
            v4u o; o.x = pk2(-c0[0], -c0[1]); o.y = pk2(-c0[2], -c0[3]); o.z = pk2(-c1[0], -c1[1]); o.w = pk2(-c1[2], -c1[3]);
            *(v4u*)(out + 8192 + (mt * 2 + ks) * 1024 + ln * 16) = o; }
#pragma unroll 1
        for (int nt = 0; nt < 4; ++nt) { const f32x4 bb = mm_tile(Kc, 1, DP, Ud, DP, 1, 16 * mt, 16 * nt, ln);
            v2u o; o.x = pk2(bb[0], bb[1]); o.y = pk2(bb[2], bb[3]); *(v2u*)(out + 24576 + (mt * 4 + nt) * 512 + ln * 8) = o; }
    }
    __syncthreads();
}

__device__ __forceinline__ void pool_unit(Frame& F, const Args& A, int l, int blk, int g) {
    LAS float* Uw = (LAS float*)F.lds;
    LAS float* Mm = Uw + 80 * DP;
    LAS float* PW = Mm + 64 * DP;
    const bf16* P = (const bf16*)(F.ws + WS_PROJ); bf16* MIX = (bf16*)(F.ws + WS_MIX);
    int tid = threadIdx.x; asm volatile("" : "+v"(tid));
    const int row0 = blk * 64, b = row0 / RPB, j0 = row0 - b * RPB; const bool isctx = j0 < CTXL;
    const int seq_lo = isctx ? b * RPB : b * RPB + CTXL, L = isctx ? CTXL : SEQ; const int pos0 = row0 - seq_lo;
    for (int idx = tid; idx < 640; idx += NTHR) { const int rr = idx >> 3, c8 = (idx & 7) * 8; const int pos = pos0 - 8 + rr;
        float v[8] = {0, 0, 0, 0, 0, 0, 0, 0};
        if (pos >= 0 && pos < L) { const v4u x = *(const v4u*)(P + (size_t)(seq_lo + pos) * NPROJ + PC_POOL + g * 64 + c8);
            v[0] = bf_lo(x.x); v[1] = bf_hi(x.x); v[2] = bf_lo(x.y); v[3] = bf_hi(x.y); v[4] = bf_lo(x.z); v[5] = bf_hi(x.z); v[6] = bf_lo(x.w); v[7] = bf_hi(x.w); }
#pragma unroll
        for (int i = 0; i < 8; ++i) Uw[rr * DP + c8 + i] = v[i]; }
    { const float* pw = A.in[F.zz + 15] + ((size_t)l * 4 + g) * 4096;
#pragma unroll
      for (int k = 0; k < 8; ++k) { const int e = tid + 512 * k; PW[(e >> 6) * DP + (e & 63)] = pw[e]; } }
    __syncthreads();
    const int win = 2 << g;
#pragma unroll 1
    for (int k = 0; k < 8; ++k) { const int e = tid + 512 * k, t = e >> 6, i = e & 63; const int pos = pos0 + t;
        int lo = pos - win / 2, hi = lo + win; lo = lo < 0 ? 0 : lo; hi = hi > L ? L : hi;
        float s = 0.f; for (int p = lo; p < hi; ++p) s += Uw[(p - pos0 + 8) * DP + i];
        Mm[t * DP + i] = s / (float)(hi - lo) - Uw[(t + 8) * DP + i]; }
    __syncthreads();
    const float* psc = A.in[F.zz + 16] + l * 256 + g * 64;
#pragma unroll 1
    for (int k = 0; k < 8; ++k) { const int e = tid + 512 * k, t = e >> 6, o = e & 63; float a = 0.f;
#pragma unroll 8
        for (int i = 0; i < 64; ++i) a += Mm[t * DP + i] * PW[i * DP + o];
        MIX[(size_t)(row0 + t) * DM + 768 + g * 64 + o] = (bf16)f2bf(a * psc[o]); }
    __syncthreads();
}

constexpr int SC_SLOT = 32768, SC_NSLOT = 4, SC_ST = SC_SLOT * SC_NSLOT, SC_GL = SC_ST + 2 * 8192;
__device__ __forceinline__ void dn_scan_item(Frame& F, int item) {
    typedef short s16x8v __attribute__((ext_vector_type(8)));
    const int d = item & 1, h = (item >> 1) & 3, b = item >> 3;
    int tid = threadIdx.x; asm volatile("" : "+v"(tid));
    const int wv = __builtin_amdgcn_readfirstlane(tid >> 6), ln = tid & 63, r = ln & 15, q = ln >> 4;
    LAS unsigned char* L = F.lds;
    LAS float* glv = (LAS float*)(L + SC_GL);
    const unsigned char* dnp = F.ws + WS_DNP;
#define SC_N(st) (d == 0 ? (st) : ((st) < 4 ? 3 - (st) : 71 - (st)))
#define SC_PROB(st) ((((size_t)b * NCHUNK + SC_N(st)) * 4 + h) * 2 + d)
    if (tid < NCHUNK) glv[tid] = ((const float*)(F.ws + WS_DNG))[SC_PROB(tid)];
    for (int e = tid; e < 2 * 8192 / 16; e += NTHR) ((LAS v4u*)(L + SC_ST))[e] = (v4u){0u, 0u, 0u, 0u};
    asm volatile("s_waitcnt vmcnt(0) lgkmcnt(0)" ::: "memory"); __builtin_amdgcn_s_barrier();
#define SC_DMA(st, slot) do { const unsigned char* src_ = dnp + SC_PROB(st) * 32768 + wv * 8192 + ln * 16; \
        _Pragma("unroll") for (int i_ = 0; i_ < 8; ++i_) __builtin_amdgcn_global_load_lds((const unsigned*)(src_ + i_ * 1024), (LAS unsigned*)(L + (slot) * SC_SLOT + wv * 8192 + i_ * 1024), 16, 0, 0); } while (0)
    if (wv < 4) { SC_DMA(0, 0); SC_DMA(1, 1); SC_DMA(2, 2); }
    f32x4 s0 = {0.f, 0.f, 0.f, 0.f}, s1 = s0, s2 = s0, s3 = s0;
    bf16* DNO = (bf16*)(F.ws + WS_DNO) + (size_t)d * MROWS * 256;
#pragma unroll 1
    for (int st = 0; st < NCHUNK; ++st) {
        if (wv < 4) asm volatile("s_waitcnt vmcnt(16)" ::: "memory");
        asm volatile("s_waitcnt lgkmcnt(0)" ::: "memory"); __builtin_amdgcn_s_barrier();
        if (wv < 4) { const int nx = st + 3 < NCHUNK ? st + 3 : NCHUNK - 1; SC_DMA(nx, (st + 3) & 3); }
        const LAS unsigned char* slot = L + (st & 3) * SC_SLOT;
        const LAS unsigned char* stc = L + SC_ST + (st & 1) * 8192; LAS unsigned char* stn = L + SC_ST + ((st + 1) & 1) * 8192;
        const int nt = wv & 3;
        const s16x8v bf0 = *(const LAS s16x8v*)(stc + (nt * 2 + 0) * 1024 + ln * 16), bf1 = *(const LAS s16x8v*)(stc + (nt * 2 + 1) * 1024 + ln * 16);
        if (wv < 4) {
            const float gl = glv[st];
            const LAS unsigned char* cf = slot + 8192; const LAS unsigned char* bi = slot + 24576;
#define SC_ST_TILE(S, mt) do { const v2u bw_ = *(const LAS v2u*)(bi + ((mt) * 4 + nt) * 512 + ln * 8); \
            f32x4 a_ = {gl * S[0] + bf_lo(bw_.x), gl * S[1] + bf_hi(bw_.x), gl * S[2] + bf_lo(bw_.y), gl * S[3] + bf_hi(bw_.y)}; \
            a_ = __builtin_amdgcn_mfma_f32_16x16x32_bf16(*(const LAS s16x8v*)(cf + ((mt) * 2 + 0) * 1024 + ln * 16), bf0, a_, 0, 0, 0); \
            a_ = __builtin_amdgcn_mfma_f32_16x16x32_bf16(*(const LAS s16x8v*)(cf + ((mt) * 2 + 1) * 1024 + ln * 16), bf1, a_, 0, 0, 0); S = a_; } while (0)
            SC_ST_TILE(s0, 0); SC_ST_TILE(s1, 1); SC_ST_TILE(s2, 2); SC_ST_TILE(s3, 3);
#undef SC_ST_TILE
            v4u w0, w1; w0.x = pk2(s0[0], s0[1]); w0.y = pk2(s0[2], s0[3]); w0.z = pk2(s1[0], s1[1]); w0.w = pk2(s1[2], s1[3]);
            w1.x = pk2(s2[0], s2[1]); w1.y = pk2(s2[2], s2[3]); w1.z = pk2(s3[0], s3[1]); w1.w = pk2(s3[2], s3[3]);
            *(LAS v4u*)(stn + (nt * 2 + 0) * 1024 + ln * 16) = w0; *(LAS v4u*)(stn + (nt * 2 + 1) * 1024 + ln * 16) = w1;
        } else {
            const LAS unsigned char* pf = slot; const LAS unsigned char* ri = slot + 16384;
            const int n = SC_N(st);
            bf16* orow = DNO + (size_t)(b * RPB + n * 64 + 4 * q) * 256 + h * 64 + nt * 16 + r;
#pragma unroll
            for (int mt = 0; mt < 4; ++mt) { const v2u rw_ = *(const LAS v2u*)(ri + (mt * 4 + nt) * 512 + ln * 8);
                f32x4 a_ = {bf_lo(rw_.x), bf_hi(rw_.x), bf_lo(rw_.y), bf_hi(rw_.y)};
                a_ = __builtin_amdgcn_mfma_f32_16x16x32_bf16(*(const LAS s16x8v*)(pf + (mt * 2 + 0) * 1024 + ln * 16), bf0, a_, 0, 0, 0);
                a_ = __builtin_amdgcn_mfma_f32_16x16x32_bf16(*(const LAS s16x8v*)(pf + (mt * 2 + 1) * 1024 + ln * 16), bf1, a_, 0, 0, 0);
#pragma unroll
                for (int g = 0; g < 4; ++g) orow[(size_t)(16 * mt + g) * 256] = (bf16)f2bf(a_[g]); }
        }
    }
    asm volatile("s_waitcnt vmcnt(0) lgkmcnt(0)" ::: "memory"); __builtin_amdgcn_s_barrier();
#undef SC_DMA
#undef SC_N
#undef SC_PROB
}

__device__ __forceinline__ void mix_build(Frame& F, const Args& A, int l) {
    int lane = threadIdx.x & 63; asm volatile("" : "+v"(lane)); const int gw = F.vcu * NWAVES + F.wave, NGW = F.G * NWAVES;
    const bf16* ATTO = (const bf16*)(F.ws + WS_ATTO); const bf16* P = (const bf16*)(F.ws + WS_PROJ); const bf16* DNO = (const bf16*)(F.ws + WS_DNO); bf16* MIX = (bf16*)(F.ws + WS_MIX);
    const float lam = ((const float*)(F.ws + WS_LAM))[l]; const float li = 0.8f - 0.6f * expf(-0.3f * (float)l);
    const float* sg = A.in[F.zz + 10] + l * 128; const float* ng = A.in[F.zz + 14] + l * 64;
    for (int R = gw; R < MROWS; R += NGW) {
        const int j = R % RPB; if (l == 1 && j < CTXL) continue;
        { const int hh = lane >> 4, e0 = (lane & 15) * 8;
          const v4u a = *(const v4u*)(ATTO + (size_t)R * DM + (hh * 2) * 128 + e0), c = *(const v4u*)(ATTO + (size_t)R * DM + (hh * 2 + 1) * 128 + e0);
          float x[8] = {bf_lo(a.x) - lam * bf_lo(c.x), bf_hi(a.x) - lam * bf_hi(c.x), bf_lo(a.y) - lam * bf_lo(c.y), bf_hi(a.y) - lam * bf_hi(c.y),
                        bf_lo(a.z) - lam * bf_lo(c.z), bf_hi(a.z) - lam * bf_hi(c.z), bf_lo(a.w) - lam * bf_lo(c.w), bf_hi(a.w) - lam * bf_hi(c.w)};
          float ss = 0.f;
#pragma unroll
          for (int i = 0; i < 8; ++i) ss += x[i] * x[i];
          ss += __shfl_xor(ss, 1); ss += __shfl_xor(ss, 2); ss += __shfl_xor(ss, 4); ss += __shfl_xor(ss, 8);
          const float sc = (1.f / sqrtf(ss * (1.f / 128.f) + EPSN)) * (1.f - li);
          const f32x4 g0 = *(const f32x4*)(sg + e0), g1 = *(const f32x4*)(sg + e0 + 4);
          v4u o; o.x = pk2(x[0] * sc * g0[0], x[1] * sc * g0[1]); o.y = pk2(x[2] * sc * g0[2], x[3] * sc * g0[3]); o.z = pk2(x[4] * sc * g1[0], x[5] * sc * g1[1]); o.w = pk2(x[6] * sc * g1[2], x[7] * sc * g1[3]);
          *(v4u*)(MIX + (size_t)R * DM + hh * 128 + e0) = o; }
        { const int c0 = lane * 4;
          const v2u a = *(const v2u*)(DNO + (size_t)R * 256 + c0), c = *(const v2u*)(DNO + ((size_t)MROWS + R) * 256 + c0), z = *(const v2u*)(P + (size_t)R * NPROJ + PC_DZ + c0);
          float x[4] = {bf_lo(a.x) + bf_lo(c.x), bf_hi(a.x) + bf_hi(c.x), bf_lo(a.y) + bf_lo(c.y), bf_hi(a.y) + bf_hi(c.y)};
          float ss = x[0] * x[0] + x[1] * x[1] + x[2] * x[2] + x[3] * x[3];
          ss += __shfl_xor(ss, 1); ss += __shfl_xor(ss, 2); ss += __shfl_xor(ss, 4); ss += __shfl_xor(ss, 8);
          const float sc = 1.f / sqrtf(ss * (1.f / 64.f) + EPSN);
          const f32x4 gg = *(const f32x4*)(ng + (c0 & 63));
          v2u o; o.x = pk2(x[0] * sc * gg[0] * siluf_(bf_lo(z.x)), x[1] * sc * gg[1] * siluf_(bf_hi(z.x))); o.y = pk2(x[2] * sc * gg[2] * siluf_(bf_lo(z.y)), x[3] * sc * gg[3] * siluf_(bf_hi(z.y)));
          *(v2u*)(MIX + (size_t)R * DM + 512 + c0) = o; }
    }
}

#ifndef MK_N_LAUNCHES
#define MK_N_LAUNCHES 1
#endif
__global__ void __launch_bounds__(NTHR, 2) mk_fwd(Args args) {
    extern __shared__ __attribute__((aligned(16))) unsigned char lds[];
    Frame F;
    F.lds = (LAS unsigned char*)lds;
    F.MISC = (volatile LAS unsigned*)(F.lds + MISC_OFF);
    F.tid = threadIdx.x; F.lane = F.tid & 63; F.wave = __builtin_amdgcn_readfirstlane(F.tid >> 6);
    F.G = gridDim.x; { const int bx = blockIdx.x; F.vcu = (F.G % 8 == 0) ? (bx % 8) * (F.G / 8) + bx / 8 : bx; }
    F.ws = args.ws; F.out = args.out; F.zz = 0;
    F.ctl = (gu32*)(args.ws + WS_CTL);
    for (int u = F.tid; u < (LDS_BYTES - MISC_OFF) / 4; u += NTHR) ((LAS unsigned*)(F.lds + MISC_OFF))[u] = 0u;
    __syncthreads();
    const int lo = args.ph_lo, hi = args.ph_hi;
    const bool use_bar = (hi - lo) > 1;
    XcdBarrier bar; bar.bar = (unsigned*)(F.ctl + CW_BAR); bar.x = 0; bar.st = nullptr;
    if (use_bar) bar = xcd_barrier_post((unsigned*)(F.ctl + CW_BAR), F.MISC + 8);
#ifndef EN_MASK
#define EN_MASK 0xFFFFFFFFu
#endif
#define IN(k) (((EN_MASK >> ((k) > 12 ? (k) - 12 : (k))) & 1u) && lo <= (k) && (k) < hi)
#define PB() do { int z_ = 0; asm volatile("" : "+s"(z_)); F.ws = args.ws + z_; F.ctl = (gu32*)(args.ws + z_); F.zz = z_; int t_ = threadIdx.x; asm volatile("" : "+v"(t_)); F.tid = t_; F.lane = t_ & 63; F.wave = __builtin_amdgcn_readfirstlane(t_ >> 6); } while (0)
#ifdef DBG_DUP
#define NREP(k) ((((k) > 12 && (k) < 23) ? (k) - 12 : (k)) == DBG_DUP ? 2 : 1)
#else
#define NREP(k) 1
#endif
#define SEAMX() do { XcdBarrier bl_ = bar; { int z_ = 0; unsigned x_ = bar.x; asm volatile("" : "+s"(z_), "+s"(x_)); bl_.bar = (unsigned*)(args.ws + WS_CTL) + CW_BAR + z_; bl_.x = x_; } xcd_barrier(bl_); } while (0)
#define PH_BEGIN(k) if (IN(k)) { for (int rep_ = 0; rep_ < NREP(k); ++rep_) { if (rep_) SEAMX(); PB();
#define PH_END(k) } } SEAM(k);
#define SEAM(k) do { if (IN(k) && IN((k) + 1)) { XcdBarrier bl_ = bar; { int z_ = 0; unsigned x_ = bar.x; asm volatile("" : "+s"(z_), "+s"(x_)); bl_.bar = (unsigned*)(args.ws + WS_CTL) + CW_BAR + z_; bl_.x = x_; } xcd_barrier(bl_); } } while (0)
    char* ldsg = (char*)lds;

    PH_BEGIN(PH_PRO) p0_prologue(F, args); PH_END(PH_PRO)

#pragma unroll 1
    for (int l = 0; l < 2; ++l) {
        const int pb = 1 + 12 * l;
        const float* modl = (const float*)(F.ws + WS_MOD) + l * 5 * 6144;
        PH_BEGIN(pb + PH_N1) norm_mod_phase(F, args, l, 0, false, false); PH_END(pb + PH_N1)
        PH_BEGIN(pb + PH_PROJ)
            pg8::Gemm g{(const bf16*)(F.ws + WS_U), (const bf16*)(F.ws + WS_WIN) + (size_t)l * NPROJ * 1024, 1024, 1024, 1024};
            TileOrder S; S.init(MROWS / 256, NPROJ / 256, F.G, (int)blockIdx.x, 0);
            EpiProj E{(bf16*)(F.ws + WS_PROJ), (float*)(F.ws + WS_GB), (const float*)(F.ws + WS_ROPE), args.in[F.zz + 12] + l * 8, args.in[F.zz + 13] + l * 8};
            pg8::gemm_phase<EpiProj, TileOrder, true, true>(F.lds, g, S, E);
        PH_END(pb + PH_PROJ)
        PH_BEGIN(pb + PH_ATT)
            const bf16* P = (const bf16*)(F.ws + WS_PROJ); bf16* AO = (bf16*)(F.ws + WS_ATTO);
            const int nunits = 512 + (l == 0 ? 32 : 0);
#ifndef DIS_ATTN
#ifdef DBG_DUP
            for (int r2_ = 0; r2_ < (DBG_DUP == 31 ? 2 : 1); ++r2_)
#endif
#pragma unroll 1
            for (int u = F.vcu; u < nunits; u += F.G) {
                int b, hm, qrow, seq;
                if (u < 512) { b = u >> 7; hm = (u >> 4) & 7; qrow = CTXL + (u & 15) * 256; seq = RPB; }
                else { const int v = u - 512; b = v >> 3; hm = v & 7; qrow = 0; seq = CTXL; }
                const size_t r0 = (size_t)b * RPB;
                attn::attn_unit<NPROJ, DM>(P + (r0 + qrow) * NPROJ + PC_AQ + hm * 64, P + r0 * NPROJ + PC_AK + hm * 64, P + r0 * NPROJ + PC_AV + (hm >> 1) * 128,
                                           AO + (r0 + qrow) * DM + hm * 128, seq, ldsg);
            }
#endif
#ifndef DIS_DNPRE
#ifdef DBG_DUP
            for (int r2_ = 0; r2_ < (DBG_DUP == 32 ? 2 : 1); ++r2_)
#endif
#pragma unroll 1
            for (int u = F.vcu; u < NB * NCHUNK * 4; u += F.G) { const int h = u & 3, n = (u >> 2) % NCHUNK, b = (u >> 2) / NCHUNK; dn_pre_unit(F, args, l, b, n, h); }
#endif
#ifndef DIS_POOL
#ifdef DBG_DUP
            for (int r2_ = 0; r2_ < (DBG_DUP == 33 ? 2 : 1); ++r2_)
#endif
#pragma unroll 1
            for (int u = F.vcu; u < (MROWS / 64) * 4; u += F.G) pool_unit(F, args, l, u >> 2, u & 3);
#endif
        PH_END(pb + PH_ATT)
        PH_BEGIN(pb + PH_SCAN)
#pragma unroll 1
            for (int it = F.vcu; it < 32; it += F.G) dn_scan_item(F, it);
        PH_END(pb + PH_SCAN)
        PH_BEGIN(pb + PH_MIXB) mix_build(F, args, l); PH_END(pb + PH_MIXB)
#pragma unroll 1
        for (int s = 0; s < 3; ++s) {
            if (IN(pb + PH_MRG0 + s)) { PB();
                const int koff = s == 0 ? 0 : (s == 1 ? 512 : 768), ks = s == 0 ? 512 : 256;
                pg8::Gemm g{(const bf16*)(F.ws + WS_MIX) + koff, (const bf16*)(F.ws + WS_WBR) + (size_t)l * 1024 * 1024 + (size_t)1024 * koff, ks, 1024, ks};
                TileOrder S; S.init(l == 0 ? 68 : 64, 4, F.G, (int)blockIdx.x, l);
                EpiMerge E{(bf16*)(F.ws + WS_MG), (const bf16*)(F.ws + WS_PROJ), PC_GATE + s * 1024, s == 0};
                pg8::gemm_phase<EpiMerge, TileOrder, true, true>(F.lds, g, S, E);
            }
            if (s < 2) { if (IN(pb + PH_MRG0 + s)) { PB(); VM_WAIT(); __syncthreads(); } } else SEAM(pb + PH_MRG2);
        }
        if (IN(pb + PH_OUT)) { PB();
            pg8::Gemm g{(const bf16*)(F.ws + WS_MG), (const bf16*)(F.ws + WS_WOUT) + (size_t)l * 1024 * 1024, 1024, 1024, 1024};
            TileOrder S; S.init(l == 0 ? 68 : 64, 4, F.G, (int)blockIdx.x, l);
            EpiResid E{(float*)(F.ws + WS_H), modl, 2};
            pg8::gemm_phase<EpiResid, TileOrder, true, true>(F.lds, g, S, E);
        } SEAM(pb + PH_OUT);
        PH_BEGIN(pb + PH_N2) norm_mod_phase(F, args, l, 1, l == 1, l == 1); PH_END(pb + PH_N2)
        if (l == 0) {
            PH_BEGIN(PH_FUP)
                pg8::Gemm g{(const bf16*)(F.ws + WS_U), (const bf16*)(F.ws + WS_W13), 1024, 1024, 1024};
                TileOrder S; S.init(68, 2 * FFD / 256, F.G, (int)blockIdx.x, 0);
                EpiSwiglu E{(bf16*)(F.ws + WS_HID), FFD};
                pg8::gemm_phase<EpiSwiglu, TileOrder, true, true>(F.lds, g, S, E);
            PH_END(PH_FUP)
            if (IN(PH_FDN)) { PB();
                pg8::Gemm g{(const bf16*)(F.ws + WS_HID), (const bf16*)(F.ws + WS_W2), FFD, FFD, FFD};
                TileOrder S; S.init(68, 4, F.G, (int)blockIdx.x, 0);
                EpiResid E{(float*)(F.ws + WS_H), modl, 5};
                pg8::gemm_phase<EpiResid, TileOrder, true, true>(F.lds, g, S, E);
            } SEAM(PH_FDN);
        }
    }
    PH_BEGIN(PH_GATH) moe_gather(F); PH_END(PH_GATH)
#pragma unroll 1
    for (int hh = 0; hh < 2; ++hh) {
        const int p0 = PH_CV0 + 3 * hh;
        PH_BEGIN(p0)
#ifdef DBG_DETPOS
            if (hh == 0) moe_gather2(F);
#endif
            moe_convert(F, args, hh); PH_END(p0)
        PH_BEGIN(p0 + 1)
            pg8::Gemm g{(const bf16*)(F.ws + WS_XG), (const bf16*)(F.ws + WS_W13M), 1024, 1024, 1024};
            MoeOrder S; S.init(F.ctl + CW_ECNT, FFE / 256, F.G, F.vcu);
            EpiSwiglu E{(bf16*)(F.ws + WS_HIDM), FFEH};
            pg8::gemm_phase<EpiSwiglu, MoeOrder, true, true>(F.lds, g, S, E);
        PH_END(p0 + 1)
        if (IN(p0 + 2)) { PB();
            pg8::Gemm g{(const bf16*)(F.ws + WS_HIDM), (const bf16*)(F.ws + WS_W2M), FFEH, FFEH, FFEH};
            MoeOrder S; S.init(F.ctl + CW_ECNT, 4, F.G, F.vcu);
            EpiY E{(bf16*)(F.ws + WS_Y), hh == 0};
            pg8::gemm_phase<EpiY, MoeOrder, true, true>(F.lds, g, S, E);
        } SEAM(p0 + 2);
    }
    PH_BEGIN(PH_FIN) final_phase(F, args); } }
#ifdef DBG_STOP
    if (lo == 100) {
        const int gw = F.vcu * NWAVES + F.wave, NGW = F.G * NWAVES;
        for (int tk = gw; tk < NB * SEQ; tk += NGW) { const int b = tk / SEQ, t = tk - b * SEQ; const size_t R = (size_t)b * RPB + CTXL + t;
#if DBG_SRC == 0
            const f32x4* s = (const f32x4*)((const float*)(args.ws + WS_H) + R * DM) + F.lane; f32x4* d = (f32x4*)(args.out + (size_t)tk * DM) + F.lane;
            for (int q = 0; q < 4; ++q) d[64 * q] = s[64 * q];
#elif DBG_SRC == 2
            MoeOrder mo; mo.init((gu32*)args.ws + CW_ECNT, 1, 1, 0); const v4u rt = ((const v4u*)(args.ws + WS_ROUTE))[2 * tk];
            const size_t rr = (size_t)mo.tile_off((int)rt.x) * 256 + rt.z; (void)R;
            const bf16* s = (const bf16*)(args.ws + DBG_OFF) + rr * DBG_LD + DBG_COL; float* d = args.out + (size_t)tk * DM;
            for (int q = 0; q < 16; ++q) d[F.lane + 64 * q] = bf2f(s[F.lane + 64 * q]);
#else
            const bf16* s = (const bf16*)(args.ws + DBG_OFF) + R * DBG_LD + DBG_COL; float* d = args.out + (size_t)tk * DM;
            for (int q = 0; q < 16; ++q) d[F.lane + 64 * q] = bf2f(s[F.lane + 64 * q]);
#endif
        }
    }
#endif
#undef IN
#undef SEAM
}

extern "C" void kernel_launch(void* const* d_in, const int* in_sizes, int n_in, void* d_out, int out_size, void* d_ws, size_t ws_size, hipStream_t stream) {
    static int grid = 0;
    if (grid == 0) {
        if (n_in != 27 || in_sizes[0] != NB * SEQ * DM || out_size != NB * SEQ * DM || ws_size < WS_END) {
            fprintf(stderr, "kernel_launch: shape / workspace mismatch (n_in %d, in0 %d, out %d, ws %zu, need %zu); nothing launched\n", n_in, n_in > 0 ? in_sizes[0] : -1, out_size, ws_size, (size_t)WS_END); grid = -1; return; }
        int dev = 0, cus = 0, per_cu = 0;
        if (hipGetDevice(&dev) != hipSuccess || hipDeviceGetAttribute(&cus, hipDeviceAttributeMultiprocessorCount, dev) != hipSuccess) { grid = -1; return; }
        if (hipFuncSetAttribute((const void*)mk_fwd, hipFuncAttributeMaxDynamicSharedMemorySize, LDS_BYTES) != hipSuccess) { fprintf(stderr, "kernel_launch: hipFuncSetAttribute failed\n"); grid = -1; return; }
        if (hipOccupancyMaxActiveBlocksPerMultiprocessor(&per_cu, (const void*)mk_fwd, NTHR, LDS_BYTES) != hipSuccess || per_cu < 1)
            fprintf(stderr, "kernel_launch: note: occupancy query reports %d workgroups per CU\n", per_cu);
        (void)hipGetLastError();
        grid = cus;
    }
    if (grid < 0) return;
    if (hipMemsetAsync((char*)d_ws + WS_CTL, 0, CTL_ZERO_BYTES, stream) != hipSuccess) return;
    Args a{};
    for (int i = 0; i < 27; ++i) a.in[i] = (const float*)d_in[i];
    a.out = (float*)d_out; a.ws = (unsigned char*)d_ws;
    constexpr int NL = MK_N_LAUNCHES;
#ifdef DBG_STOP
    constexpr int NLL = DBG_STOP + 2;
#else
    constexpr int NLL = NL;
#endif
    for (int li = 0; li < NLL; ++li) {
#ifdef DBG_SKIP_LO
        if (li >= DBG_SKIP_LO && li <= DBG_SKIP_HI) continue;
#endif
        a.ph_lo = (NL == 1) ? 0 : li; a.ph_hi = (NL == 1) ? PH_COUNT : li + 1;
#ifdef DBG_STOP
        if (li == NLL - 1) { a.ph_lo = 100; a.ph_hi = 101; }
#endif
        hipLaunchKernelGGL(mk_fwd, dim3(grid), dim3(NTHR), LDS_BYTES, stream, a);
        const hipError_t le = hipPeekAtLastError();
        if (le != hipSuccess) { fprintf(stderr, "kernel_launch: launch %d failed: %s\n", li, hipGetErrorName(le)); break; }
    }
}
```

```cpp
#include <hip/hip_runtime.h>
#include <cstdio>
#include <cstdint>
#include <cmath>

namespace pg8 {
#define PG8_LAS __attribute__((address_space(3)))
typedef unsigned short bf16_t;
typedef short bf16x8 __attribute__((ext_vector_type(8)));
typedef float f32x4 __attribute__((ext_vector_type(4)));
typedef unsigned u32x4 __attribute__((ext_vector_type(4)));
typedef unsigned u32x2 __attribute__((ext_vector_type(2)));
constexpr int BM = 256, BK = 64, HALF = 128, HTB = HALF * BK * 2  , STAGE_BYTES = 8 * HTB;

__host__ __device__ __forceinline__ int lds_byte(int r, int c) { const int st = (r >> 4) * 2 + (c >> 5), rr = r & 15, cc = c & 31, ob = rr * 64 + cc * 2; return st * 1024 + (ob ^ (((ob >> 9) & 1) << 5)); }
__host__ __device__ __forceinline__ void stage_rc(int b, int& R, int& C) { const int st = b / 1024, sb = b % 1024, swz = sb ^ (((sb >> 9) & 1) << 5); R = (st >> 1) * 16 + swz / 64; C = (st & 1) * 32 + (swz % 64) / 2; }
__host__ __device__ __forceinline__ int perm32(int rho) { const int n = rho >> 4, i = rho & 15; return 8 * (i >> 2) + 4 * n + (i & 3); }

struct Unit { int pm, pn, pb; };
struct Gemm { const bf16_t* A; const bf16_t* Bt; int K, lda, ldb; };

__device__ __forceinline__ unsigned cvt_pk_bf16(float lo, float hi) { unsigned r; asm volatile("v_cvt_pk_bf16_f32 %0, %1, %2" : "=v"(r) : "v"(lo), "v"(hi)); return r; }
template <class Epi, class Sched, bool ALIGN_EPI = false, bool SP2 = false>
__device__ __forceinline__ void gemm_phase(PG8_LAS unsigned char* lds, const Gemm g, const Sched& S, const Epi& E) {
    int tid = threadIdx.x; asm volatile("" : "+v"(tid)); const int wid = __builtin_amdgcn_readfirstlane(tid >> 6), lane = tid & 63, wr = wid >> 2, wc = wid & 3, fr = lane & 15, fq = lane >> 4;
    const int K = g.K, nt = K / BK;
    unsigned voffA[2], voffB[2];
#pragma unroll
    for (int i = 0; i < 2; ++i) { int R, C; stage_rc(tid * 16 + i * 8192, R, C); const int Rb = Epi::PERM ? ((R & ~31) + perm32(R & 31)) : R;
        voffA[i] = (unsigned)(R * g.lda + C) * 2u; voffB[i] = (unsigned)(Rb * g.ldb + C) * 2u; }
    const size_t kstep = (size_t)(BK * 2);
    const size_t hstepA = (size_t)HALF * g.lda * 2, hstepB = (size_t)HALF * g.ldb * 2;
    const size_t tstepA = 2 * hstepA, tstepB = 2 * hstepB;
    const unsigned ldsw = (unsigned)wid * 1024u;
    const int aoff = lds_byte(wr * 64 + fr, fq * 8), boff = lds_byte(wc * 32 + fr, fq * 8);
#define PG8_SA(b, h) (((b) * 2 + (h)) * HTB)
#define PG8_SB(b, h) ((4 + (b) * 2 + (h)) * HTB)
#define PG8_STAGE(bufoff, gbase, voff) do { _Pragma("unroll") for (int _i = 0; _i < 2; ++_i) \
        __builtin_amdgcn_global_load_lds((const unsigned*)((const char*)(gbase) + (voff)[_i]), (PG8_LAS unsigned*)(lds + (bufoff) + ldsw + _i * 8192), 16, 0, 0); } while (0)
#define PG8_LDA(dst, b, h) do { _Pragma("unroll") for (int m = 0; m < 4; ++m) _Pragma("unroll") for (int k = 0; k < 2; ++k) dst[m][k] = *(const PG8_LAS bf16x8*)(lds + PG8_SA(b, h) + aoff + m * 2048 + k * 1024); } while (0)
#define PG8_LDB(dst, b, h) do { _Pragma("unroll") for (int n = 0; n < 2; ++n) _Pragma("unroll") for (int k = 0; k < 2; ++k) dst[n][k] = *(const PG8_LAS bf16x8*)(lds + PG8_SB(b, h) + boff + n * 2048 + k * 1024); } while (0)
#define PG8_MMA(ai, bj, At, Bt) do { __builtin_amdgcn_s_setprio(1); _Pragma("unroll") for (int m = 0; m < 4; ++m) _Pragma("unroll") for (int n = 0; n < 2; ++n) _Pragma("unroll") for (int k = 0; k < 2; ++k) \
        acc[ai][bj][m][n] = __builtin_amdgcn_mfma_f32_16x16x32_bf16(Bt[n][k], At[m][k], acc[ai][bj][m][n], 0, 0, 0); __builtin_amdgcn_s_setprio(0); } while (0)
#define PG8_WAIT_V(n) asm volatile("s_waitcnt vmcnt(" #n ")" ::: "memory")
#define PG8_WAIT_L(n) asm volatile("s_waitcnt lgkmcnt(" #n ")" ::: "memory")
#define PG8_BAR __builtin_amdgcn_s_barrier()
#define PG8_SCHED __builtin_amdgcn_sched_barrier(0)
    Unit cur, nxt; int ui = 0;
    if (!S.next(0, cur)) return;
    f32x4 acc[2][2][4][2];
#pragma unroll
    for (int a = 0; a < 2; ++a)
#pragma unroll
        for (int b = 0; b < 2; ++b)
#pragma unroll
            for (int m = 0; m < 4; ++m)
#pragma unroll
                for (int n = 0; n < 2; ++n) acc[a][b][m][n] = (f32x4){0.f, 0.f, 0.f, 0.f};
    bf16x8 At[4][2], B0[2][2], B1[2][2];
    const char* cA = (const char*)g.A + (size_t)cur.pm * tstepA; const char* cB = (const char*)g.Bt + (size_t)cur.pb * tstepB;
    S.a_ready(cur);
    if constexpr (SP2) {
        PG8_STAGE(PG8_SB(0, 0), cB, voffB); PG8_STAGE(PG8_SB(0, 1), cB + hstepB, voffB); PG8_STAGE(PG8_SA(0, 0), cA, voffA); PG8_STAGE(PG8_SA(0, 1), cA + hstepA, voffA);
        if (wr == 1) PG8_BAR;
        PG8_WAIT_V(2); PG8_BAR;
        PG8_STAGE(PG8_SB(1, 0), cB + kstep, voffB); PG8_STAGE(PG8_SA(1, 0), cA + kstep, voffA); PG8_STAGE(PG8_SB(1, 1), cB + hstepB + kstep, voffB);
        PG8_WAIT_V(6); PG8_BAR;
    } else {
        PG8_STAGE(PG8_SB(0, 0), cB, voffB); PG8_STAGE(PG8_SA(0, 0), cA, voffA); PG8_STAGE(PG8_SB(0, 1), cB + hstepB, voffB); PG8_STAGE(PG8_SA(0, 1), cA + hstepA, voffA);
        if (wr == 1) PG8_BAR;
        PG8_WAIT_V(4); PG8_BAR;
        PG8_STAGE(PG8_SB(1, 0), cB + kstep, voffB); PG8_STAGE(PG8_SA(1, 0), cA + kstep, voffA); PG8_STAGE(PG8_SB(1, 1), cB + hstepB + kstep, voffB);
        PG8_WAIT_V(6); PG8_BAR;
    }
    for (;;) {
        const bool has_next = S.next(ui + 1, nxt);
        const char* nA = has_next ? (const char*)g.A + (size_t)nxt.pm * tstepA : cA; const char* nB = has_next ? (const char*)g.Bt + (size_t)nxt.pb * tstepB : cB;
        for (int t = 0; t < nt; t += 2) {
            const bool last = (t == nt - 2);
            const char* a1 = cA + (size_t)(t + 1) * kstep;
            const char* a2 = last ? nA : cA + (size_t)(t + 2) * kstep; const char* b2 = last ? nB : cB + (size_t)(t + 2) * kstep;
            const char* a3 = a2 + kstep; const char* b3 = b2 + kstep;
            if (last && has_next) S.a_ready(nxt);
            if constexpr (SP2) {
            PG8_LDB(B0, 0, 0); PG8_LDB(B1, 0, 1); PG8_SCHED; PG8_LDA(At, 0, 0); PG8_STAGE(PG8_SA(1, 1), a1 + hstepA, voffA);
            PG8_WAIT_V(8); PG8_WAIT_L(0); PG8_BAR; PG8_MMA(0, 0, At, B0); PG8_MMA(0, 1, At, B1); PG8_BAR; PG8_SCHED;
            PG8_LDA(At, 0, 1); PG8_STAGE(PG8_SB(0, 0), b2, voffB); PG8_STAGE(PG8_SB(0, 1), b2 + hstepB, voffB); PG8_STAGE(PG8_SA(0, 0), a2, voffA);
            PG8_WAIT_V(8); PG8_WAIT_L(0); PG8_BAR; PG8_MMA(1, 0, At, B0); PG8_MMA(1, 1, At, B1); PG8_BAR; PG8_SCHED;
            PG8_LDB(B0, 1, 0); PG8_LDB(B1, 1, 1); PG8_SCHED; PG8_LDA(At, 1, 0); PG8_STAGE(PG8_SA(0, 1), a2 + hstepA, voffA);
            PG8_WAIT_V(8); PG8_WAIT_L(0); PG8_BAR; PG8_MMA(0, 0, At, B0); PG8_MMA(0, 1, At, B1); PG8_BAR; PG8_SCHED;
            PG8_LDA(At, 1, 1); PG8_STAGE(PG8_SB(1, 0), b3, voffB); PG8_STAGE(PG8_SB(1, 1), b3 + hstepB, voffB); PG8_STAGE(PG8_SA(1, 0), a3, voffA);
            PG8_WAIT_V(8); PG8_WAIT_L(0); PG8_BAR; PG8_MMA(1, 0, At, B0); PG8_MMA(1, 1, At, B1); PG8_BAR; PG8_SCHED;
            } else {
            PG8_LDB(B0, 0, 0); PG8_SCHED; PG8_LDA(At, 0, 0); PG8_STAGE(PG8_SA(1, 1), a1 + hstepA, voffA);
            PG8_WAIT_L(8); PG8_BAR; PG8_WAIT_L(0); PG8_MMA(0, 0, At, B0); PG8_BAR; PG8_SCHED;
            PG8_LDB(B1, 0, 1); PG8_STAGE(PG8_SB(0, 0), b2, voffB);
            PG8_BAR; PG8_WAIT_L(0); PG8_MMA(0, 1, At, B1); PG8_BAR;
            PG8_LDA(At, 0, 1); PG8_STAGE(PG8_SA(0, 0), a2, voffA);
            PG8_BAR; PG8_WAIT_L(0); PG8_MMA(1, 0, At, B0); PG8_BAR; PG8_SCHED;
            PG8_STAGE(PG8_SB(0, 1), b2 + hstepB, voffB);
            PG8_WAIT_V(6); PG8_BAR; PG8_MMA(1, 1, At, B1); PG8_BAR;
            PG8_LDB(B0, 1, 0); PG8_SCHED; PG8_LDA(At, 1, 0); PG8_STAGE(PG8_SA(0, 1), a2 + hstepA, voffA);
            PG8_WAIT_L(8); PG8_BAR; PG8_WAIT_L(0); PG8_MMA(0, 0, At, B0); PG8_BAR; PG8_SCHED;
            PG8_LDB(B1, 1, 1); PG8_STAGE(PG8_SB(1, 0), b3, voffB);
            PG8_BAR; PG8_WAIT_L(0); PG8_MMA(0, 1, At, B1); PG8_BAR;
            PG8_LDA(At, 1, 1); PG8_STAGE(PG8_SA(1, 0), a3, voffA);
            PG8_BAR; PG8_WAIT_L(0); PG8_MMA(1, 0, At, B0); PG8_BAR; PG8_SCHED;
            PG8_STAGE(PG8_SB(1, 1), b3 + hstepB, voffB);
            PG8_WAIT_V(6); PG8_BAR; PG8_MMA(1, 1, At, B1); PG8_BAR;
            }
        }
        if constexpr (ALIGN_EPI) { if (wr == 0) PG8_BAR; }
        if constexpr (!Epi::AFTER_DRAIN) { E(acc, cur, wr, wc, fr, fq); S.done(cur); }
        if (!has_next) break;
#pragma unroll
        for (int a = 0; a < 2; ++a)
#pragma unroll
            for (int b = 0; b < 2; ++b)
#pragma unroll
                for (int m = 0; m < 4; ++m)
#pragma unroll
                    for (int n = 0; n < 2; ++n) acc[a][b][m][n] = (f32x4){0.f, 0.f, 0.f, 0.f};
        cur = nxt; cA = nA; cB = nB; ++ui;
        if constexpr (ALIGN_EPI) { if (wr == 1) PG8_BAR; }
    }
    PG8_WAIT_V(0);
    if constexpr (!ALIGN_EPI) { if (wr == 0) PG8_BAR; }
    PG8_BAR;
    if constexpr (Epi::AFTER_DRAIN) { E.fused(acc, cur, wr, wc, fr, fq, lds, wid, lane); S.done(cur); }
#undef PG8_SA
#undef PG8_SB
#undef PG8_STAGE
#undef PG8_LDA
#undef PG8_LDB
#undef PG8_MMA
#undef PG8_WAIT_V
#undef PG8_WAIT_L
#undef PG8_BAR
#undef PG8_SCHED
}
}

namespace attn {
using bf16x8 = __attribute__((ext_vector_type(8))) short;
using s16x4  = __attribute__((ext_vector_type(4))) short;
using f32x16 = __attribute__((ext_vector_type(16))) float;
using u32x4  = __attribute__((ext_vector_type(4))) unsigned;
constexpr int DV = 128, DK = 64, NW = 8, QBLK = 32, KVBLK = 64;
constexpr float SCALE = 0.125f;
constexpr float THR = 4.f;
constexpr size_t SHM_V = KVBLK * DV * 2, SHM_K = KVBLK * DK * 2, SHM_ATTN = 2 * SHM_V + 2 * SHM_K + NW * 64 * 4;
#define AKSWZ(row, colB) ((row) * 128 + ((colB) ^ ((((row) >> 1) & 7) << 4)))
#define ASBAR() __builtin_amdgcn_sched_barrier(0)
__device__ __forceinline__ int crow(int r, int hi) { return (r & 3) + 8 * (r >> 2) + 4 * hi; }
__device__ __forceinline__ unsigned cvtpk(float lo, float hi) { unsigned r; asm volatile("v_cvt_pk_bf16_f32 %0, %1, %2" : "=v"(r) : "v"(lo), "v"(hi)); return r; }

__device__ __forceinline__ void partialSM(f32x16& p0, f32x16& p1, float& m_reg, float& mn, float& alpha) {
  constexpr float C = SCALE * 1.4426950408889634f;
  float pmax = p0[0];
#pragma unroll
  for (int r = 1; r < 16; ++r) pmax = fmaxf(pmax, p0[r]);
#pragma unroll
  for (int r = 0; r < 16; ++r) pmax = fmaxf(pmax, p1[r]);
  { auto rr = __builtin_amdgcn_permlane32_swap(__float_as_uint(pmax), __float_as_uint(pmax), false, false);
    pmax = fmaxf(__uint_as_float(rr[0]), __uint_as_float(rr[1])); }
  if (__builtin_expect(__all(pmax - m_reg <= THR / SCALE), 1)) { mn = m_reg; alpha = 1.f; }
  else { mn = fmaxf(m_reg, pmax); alpha = __builtin_amdgcn_exp2f((m_reg - mn) * C); m_reg = mn; }
  const float mnC = -mn * C;
#pragma unroll
  for (int r = 0; r < 16; ++r) p0[r] = fmaf(p0[r], C, mnC);
#pragma unroll
  for (int r = 0; r < 16; ++r) p1[r] = fmaf(p1[r], C, mnC);
#pragma unroll
  for (int r = 0; r < 16; ++r) p0[r] = __builtin_amdgcn_exp2f(p0[r]);
}
__device__ __forceinline__ void finishSM(f32x16& p0, f32x16& p1, float alpha, float& l_reg, bf16x8& pa0, bf16x8& pa1, bf16x8& pa2, bf16x8& pa3) {
#pragma unroll
  for (int r = 0; r < 16; ++r) p1[r] = __builtin_amdgcn_exp2f(p1[r]);
  float ps = 0;
#pragma unroll
  for (int r = 0; r < 16; ++r) ps += p0[r];
#pragma unroll
  for (int r = 0; r < 16; ++r) ps += p1[r];
  { auto rr = __builtin_amdgcn_permlane32_swap(__float_as_uint(ps), __float_as_uint(ps), false, false);
    ps = __uint_as_float(rr[0]) + __uint_as_float(rr[1]); }
  l_reg = l_reg * alpha + ps;
#define APK4(P, BASE, OUT) do { unsigned a0 = cvtpk(P[BASE + 0], P[BASE + 1]), a1 = cvtpk(P[BASE + 2], P[BASE + 3]);   \
    unsigned b0 = cvtpk(P[BASE + 4], P[BASE + 5]), b1 = cvtpk(P[BASE + 6], P[BASE + 7]);                              \
    auto r0 = __builtin_amdgcn_permlane32_swap(a0, b0, false, false); auto r1 = __builtin_amdgcn_permlane32_swap(a1, b1, false, false); \
    u32x4 w = {r0[0], r1[0], r0[1], r1[1]}; OUT = *reinterpret_cast<bf16x8*>(&w); } while (0)
  APK4(p0, 0, pa0); APK4(p0, 8, pa1); APK4(p1, 0, pa2); APK4(p1, 8, pa3);
#undef APK4
}
__device__ __forceinline__ void qkt(f32x16& p0, f32x16& p1, const char* Ks, const bf16x8* qr, int r32, int hi) {
  p0 = f32x16{}; p1 = f32x16{};
#pragma unroll
  for (int d0 = 0; d0 < 4; ++d0) { const int cb = (d0 * 16 + hi * 8) * 2;
    bf16x8 b0 = *reinterpret_cast<const bf16x8*>(Ks + AKSWZ(r32, cb));
    bf16x8 b1 = *reinterpret_cast<const bf16x8*>(Ks + AKSWZ(32 + r32, cb));
    p0 = __builtin_amdgcn_mfma_f32_32x32x16_bf16(b0, qr[d0], p0, 0, 0, 0);
    p1 = __builtin_amdgcn_mfma_f32_32x32x16_bf16(b1, qr[d0], p1, 0, 0, 0); }
}
__device__ __forceinline__ int v_st(int k, int c) { const int kk = (k & ~0xC) | ((k & 4) << 1) | ((k & 8) >> 1); return ((kk >> 3) * 4 + (c >> 5)) * 512 + ((kk & 7) * 32 + (c & 31)) * 2; }
__device__ __forceinline__ int v_rd_base(int lane) { return ((lane & 3) << 3) | (((lane >> 2) & 3) << 6) | (((lane >> 4) & 1) << 5) | (((lane >> 5) & 1) << 8); }
constexpr int v_rd_off(int d0, int ks, int half) { return d0 * 512 + ks * 4096 + half * 2048; }
template <int OFF> __device__ __forceinline__ s16x4 tr_read(int vb) {
  s16x4 r; asm volatile("ds_read_b64_tr_b16 %0, %1 offset:%2" : "=&v"(r) : "v"(vb), "i"(OFF) : "memory"); return r;
}
template <int D0> __device__ __forceinline__ void pv_one(f32x16& od, int vb, bf16x8 pa0, bf16x8 pa1, bf16x8 pa2, bf16x8 pa3) {
  const s16x4 l0 = tr_read<v_rd_off(D0, 0, 0)>(vb), h0 = tr_read<v_rd_off(D0, 0, 1)>(vb), l1 = tr_read<v_rd_off(D0, 1, 0)>(vb), h1 = tr_read<v_rd_off(D0, 1, 1)>(vb);
  const s16x4 l2 = tr_read<v_rd_off(D0, 2, 0)>(vb), h2 = tr_read<v_rd_off(D0, 2, 1)>(vb), l3 = tr_read<v_rd_off(D0, 3, 0)>(vb), h3 = tr_read<v_rd_off(D0, 3, 1)>(vb);
  asm volatile("s_waitcnt lgkmcnt(0)" ::: "memory"); ASBAR();
#define APK(L, H) (bf16x8){L[0], L[1], L[2], L[3], H[0], H[1], H[2], H[3]}
  od = __builtin_amdgcn_mfma_f32_32x32x16_bf16(pa0, APK(l0, h0), od, 0, 0, 0);
  od = __builtin_amdgcn_mfma_f32_32x32x16_bf16(pa1, APK(l1, h1), od, 0, 0, 0);
  od = __builtin_amdgcn_mfma_f32_32x32x16_bf16(pa2, APK(l2, h2), od, 0, 0, 0);
  od = __builtin_amdgcn_mfma_f32_32x32x16_bf16(pa3, APK(l3, h3), od, 0, 0, 0);
#undef APK
}
__device__ __forceinline__ void pv_d0(f32x16* o, int vb, bf16x8 pa0, bf16x8 pa1, bf16x8 pa2, bf16x8 pa3) {
  pv_one<0>(o[0], vb, pa0, pa1, pa2, pa3); pv_one<1>(o[1], vb, pa0, pa1, pa2, pa3); pv_one<2>(o[2], vb, pa0, pa1, pa2, pa3); pv_one<3>(o[3], vb, pa0, pa1, pa2, pa3);
}
template <int LDQ, int LDO>
__device__ __forceinline__ void attn_unit(const unsigned short* __restrict__ Qb, const unsigned short* __restrict__ Kh, const unsigned short* __restrict__ Vh,
                                          unsigned short* __restrict__ Ob, int seq, char* lds) {
  int tid = threadIdx.x; asm volatile("" : "+v"(tid)); const int wid = tid >> 6, lane = tid & 63, r32 = lane & 31, hi = lane >> 5;
  char* V_lds = lds; char* K_lds = lds + 2 * SHM_V;
  float* ws = (float*)(lds + 2 * SHM_V + 2 * SHM_K) + wid * 64; float* li_l = ws; float* al_l = ws + 32;
  float m_reg = -1e30f, l_reg = 0; f32x16 o[4] = {}; bf16x8 qr[4];
  const unsigned short* Qw = Qb + (long)(wid * QBLK + r32) * LDQ + hi * 8;
#pragma unroll
  for (int d0 = 0; d0 < 4; ++d0) qr[d0] = *reinterpret_cast<const bf16x8*>(Qw + d0 * 16);
  const int sr = tid >> 4, sc = (tid & 15) * 8, vst0 = v_st(sr, sc), vst1 = v_st(32 + sr, sc);
  const int kr = tid >> 3, kc = (tid & 7) * 8, kst = AKSWZ(kr, kc * 2);
  const int vb0 = (int)(uintptr_t)V_lds + v_rd_base(lane);
  bf16x8 sv0[2], sv1[2], sk0[2];
#define ASLOAD(i, k0) do { sv0[i] = *reinterpret_cast<const bf16x8*>(&Vh[(long)((k0) + sr) * LDQ + sc]); sv1[i] = *reinterpret_cast<const bf16x8*>(&Vh[(long)((k0) + 32 + sr) * LDQ + sc]); \
    sk0[i] = *reinterpret_cast<const bf16x8*>(&Kh[(long)((k0) + kr) * LDQ + kc]); } while (0)
#define ASWRITE(b, i) do { *(bf16x8*)(V_lds + (b) * SHM_V + vst0) = sv0[i]; *(bf16x8*)(V_lds + (b) * SHM_V + vst1) = sv1[i]; \
    *(bf16x8*)(K_lds + (b) * SHM_K + kst) = sk0[i]; } while (0)
#define ASWAIT() asm volatile("s_waitcnt vmcnt(3)" ::: "memory")
#define ARESC(a) do { if (__any((a) < 1.f)) { if (hi == 0) al_l[r32] = (a); asm volatile("s_waitcnt lgkmcnt(0)" ::: "memory"); \
    _Pragma("unroll") for (int d = 0; d < 4; ++d) _Pragma("unroll") for (int r = 0; r < 16; ++r) o[d][r] *= al_l[crow(r, hi)]; } } while (0)
  f32x16 pA0, pA1, pB0, pB1; float mnA, mnB, alA, alB; bf16x8 pa0, pa1, pa2, pa3; const int NT = seq / KVBLK;
  ASLOAD(0, 0); asm volatile("s_waitcnt vmcnt(0)" ::: "memory"); ASWRITE(0, 0); __syncthreads();
  qkt(pA0, pA1, K_lds, qr, r32, hi); partialSM(pA0, pA1, m_reg, mnA, alA);
  ASLOAD(1, KVBLK); if (2 < NT) ASLOAD(0, 2 * KVBLK);
  if (2 < NT) ASWAIT(); else asm volatile("s_waitcnt vmcnt(0)" ::: "memory");
  ASWRITE(1, 1); __syncthreads();
  for (int j = 1; j + 1 < NT; j += 2) {
    ASBAR(); qkt(pB0, pB1, K_lds + SHM_K, qr, r32, hi);
    finishSM(pA0, pA1, alA, l_reg, pa0, pa1, pa2, pa3); ASBAR();
    ASLOAD(1, (j + 2) * KVBLK); ASBAR();
    pv_d0(o, vb0, pa0, pa1, pa2, pa3); partialSM(pB0, pB1, m_reg, mnB, alB);
    __syncthreads(); ASWAIT(); ASWRITE(0, 0);
    ARESC(alB); __syncthreads();
    ASBAR(); qkt(pA0, pA1, K_lds, qr, r32, hi);
    finishSM(pB0, pB1, alB, l_reg, pa0, pa1, pa2, pa3); ASBAR();
    if (j + 3 < NT) ASLOAD(0, (j + 3) * KVBLK); ASBAR();
    pv_d0(o, vb0 + (int)SHM_V, pa0, pa1, pa2, pa3); partialSM(pA0, pA1, m_reg, mnA, alA);
    __syncthreads(); if (j + 3 < NT) ASWAIT(); else asm volatile("s_waitcnt vmcnt(0)" ::: "memory");
    ASWRITE(1, 1);
    ARESC(alA); __syncthreads();
  }
  ASBAR(); qkt(pB0, pB1, K_lds + SHM_K, qr, r32, hi);
  finishSM(pA0, pA1, alA, l_reg, pa0, pa1, pa2, pa3); ASBAR();
  pv_d0(o, vb0, pa0, pa1, pa2, pa3); partialSM(pB0, pB1, m_reg, mnB, alB);
  __syncthreads(); ARESC(alB);
  finishSM(pB0, pB1, alB, l_reg, pa0, pa1, pa2, pa3); ASBAR();
  pv_d0(o, vb0 + (int)SHM_V, pa0, pa1, pa2, pa3);
  if (hi == 0) li_l[r32] = l_reg; asm volatile("s_waitcnt lgkmcnt(0)" ::: "memory");
  float rli[16];
#pragma unroll
  for (int r = 0; r < 16; ++r) rli[r] = __builtin_amdgcn_rcpf(li_l[crow(r, hi)]);
  unsigned short* Ow = Ob + (long)(wid * QBLK) * LDO;
#pragma unroll
  for (int r = 0; r < 16; ++r) { const int orow = crow(r, hi);
#pragma unroll
    for (int d0 = 0; d0 < 4; ++d0) { const float v = o[d0][r] * rli[r]; Ow[(long)orow * LDO + d0 * 32 + r32] = (unsigned short)(cvtpk(v, v) & 0xffffu); } }
  __syncthreads();
#undef ASLOAD
#undef ASWRITE
#undef ASWAIT
#undef ARESC
}
}

constexpr int NWAVES = 8, NTHR = NWAVES * 64;
constexpr int DM = 1024, NB = 4, SEQ = 4096, CTXL = 256, RPB = CTXL + SEQ  , MROWS = NB * RPB  ;
constexpr int INW = 5904, NPROJ = 6144;
constexpr int FFD = 2816, FFE = 3584, NEXP = 8, FFEH = FFE / 2;
constexpr int NCHUNK = RPB / 64;
constexpr float EPSN = 1e-6f;
constexpr int PC_AQ = 0, PC_AK = 512, PC_AV = 1024, PC_DQ = 1536, PC_DK = 1792, PC_DV = 2048, PC_DZ = 2304, PC_POOL = 2560, PC_GATE = 2816, PC_AB = 5888;

constexpr size_t MiB = 1u << 20;
constexpr size_t WS_CTL = 0, CTL_ZERO_BYTES = 2 * MiB;
constexpr size_t WS_MOD = 1 * MiB;
constexpr size_t WS_ROPE = 2 * MiB;
constexpr size_t WS_LAM = 2 * MiB + 65536;
constexpr size_t WS_ROUTE = 3 * MiB;
constexpr size_t WS_GB = 4 * MiB;
constexpr size_t WS_WIN = 8 * MiB;
constexpr size_t WS_WBR = 32 * MiB;
constexpr size_t WS_WOUT = 36 * MiB;
constexpr size_t WS_W13 = 40 * MiB;
constexpr size_t WS_W2 = 51 * MiB;
constexpr size_t WS_H = 58 * MiB;
constexpr size_t WS_U = 126 * MiB;
constexpr size_t WS_ATTO = WS_U;
constexpr size_t WS_PROJ = 160 * MiB;
constexpr size_t WS_MIX = 364 * MiB;
constexpr size_t WS_DNP = 398 * MiB;
constexpr size_t WS_MG = WS_DNP;
constexpr size_t WS_DNG = 466 * MiB;
constexpr size_t WS_DNO = 467 * MiB;
constexpr size_t WS_HID = WS_PROJ;
constexpr int MOE_MAXT = 136;
constexpr size_t WS_XG = 160 * MiB;
constexpr size_t WS_Y = 228 * MiB;
constexpr size_t WS_W13M = 296 * MiB;
constexpr size_t WS_W2M = 352 * MiB;
constexpr size_t WS_HIDM = 380 * MiB;
constexpr size_t WS_END = 500 * MiB;
static_assert(WS_HIDM + (size_t)MOE_MAXT * 256 * FFEH * 2 <= WS_END && WS_DNO + (size_t)2 * MROWS * 256 * 2 <= WS_END, "ws map");
static_assert(WS_WIN + (size_t)2 * NPROJ * 1024 * 2 <= WS_WBR && WS_W13 + (size_t)2 * FFD * 1024 * 2 <= WS_W2 && WS_W2 + (size_t)1024 * FFD * 2 <= WS_H, "ws map (weights)");
static_assert(WS_H + (size_t)MROWS * 1024 * 4 <= WS_U && WS_U + (size_t)MROWS * 1024 * 2 <= WS_PROJ && WS_PROJ + (size_t)MROWS * NPROJ * 2 <= WS_MIX, "ws map (acts)");
static_assert(WS_MIX + (size_t)MROWS * 1024 * 2 <= WS_DNP && WS_DNP + (size_t)NB * NCHUNK * 4 * 2 * 32768 <= WS_DNG, "ws map (dn)");
static_assert(WS_XG + (size_t)MOE_MAXT * 256 * 1024 * 2 <= WS_Y && WS_Y + (size_t)MOE_MAXT * 256 * 1024 * 2 <= WS_W13M && WS_W13M + (size_t)8 * FFE * 1024 * 2 <= WS_W2M && WS_W2M + (size_t)8 * 1024 * FFEH * 2 <= WS_HIDM, "ws map (moe)");
constexpr int CW_TMO = 0, CW_CODE = 1;
constexpr int CW_BAR = 4096;
constexpr int CW_ECNT = 8192;

constexpr int RING_BYTES = 155648;
constexpr int MISC_OFF = RING_BYTES;
constexpr int LDS_BYTES = RING_BYTES + 1024;

enum { PH_PRO = 0, PH_L0 = 1, PH_N1 = 0, PH_PROJ = 1, PH_ATT = 2, PH_SCAN = 3, PH_MIXB = 4, PH_MRG0 = 5, PH_MRG1 = 6, PH_MRG2 = 7, PH_OUT = 8, PH_N2 = 9, PH_LAYER = 10,
       PH_FUP = 11, PH_FDN = 12, PH_L1 = 13, PH_GATH = 23, PH_CV0 = 24, PH_UP0 = 25, PH_DN0 = 26, PH_CV1 = 27, PH_UP1 = 28, PH_DN1 = 29, PH_FIN = 30, PH_COUNT = 31 };

#define GAS __attribute__((address_space(1)))
#define LAS __attribute__((address_space(3)))
typedef unsigned short bf16;
typedef unsigned v4u __attribute__((ext_vector_type(4)));
typedef unsigned v2u __attribute__((ext_vector_type(2)));
typedef float f32x4 __attribute__((ext_vector_type(4)));
typedef GAS unsigned gu32;
#define RLX_AGENT __ATOMIC_RELAXED, __HIP_MEMORY_SCOPE_AGENT
#define LDS_WAIT() asm volatile("s_waitcnt lgkmcnt(0)" ::: "memory")
#define VM_WAIT() asm volatile("s_waitcnt vmcnt(0)" ::: "memory")
__device__ __forceinline__ unsigned f2bf(float f) { unsigned u = __builtin_bit_cast(unsigned, f); return (u + 0x7fffu + ((u >> 16) & 1u)) >> 16; }
typedef float f32x2_c __attribute__((ext_vector_type(2))); typedef __bf16 bf16x2_c __attribute__((ext_vector_type(2)));
__device__ __forceinline__ unsigned cvtpk_c(float lo, float hi) { f32x2_c v = {lo, hi}; bf16x2_c b = __builtin_convertvector(v, bf16x2_c); return __builtin_bit_cast(unsigned, b); }
__device__ __forceinline__ unsigned pk2(float lo, float hi) { return cvtpk_c(lo, hi); }
__device__ __forceinline__ float bf_lo(unsigned w) { return __builtin_bit_cast(float, w << 16); }
__device__ __forceinline__ float bf_hi(unsigned w) { return __builtin_bit_cast(float, w & 0xffff0000u); }
__device__ __forceinline__ float bf2f(bf16 v) { return __builtin_bit_cast(float, (unsigned)v << 16); }
__device__ __forceinline__ float sigmoidf_(float x) { return 1.f / (1.f + __expf(-x)); }
__device__ __forceinline__ float siluf_(float x) { return x / (1.f + __expf(-x)); }
__device__ __forceinline__ float wave_sum(float v) {
#pragma unroll
    for (int o = 1; o < 64; o <<= 1) v += __shfl_xor(v, o);
    return v;
}
#define XB_TMO      128
#define XB_XCNT(j)  (256  + 64 * (j))
#define XB_XSUB(j)  (1280 + 64 * (j))
#define XB_XGEN(j)  (2304 + 64 * (j))
#define XB_TOP      3328
#define XB_TOPGEN   3392
#define XCD_BAR_WORDS 3456
#define XB_SPIN_CAP (1u << 18)

__device__ __forceinline__ unsigned xb_ld(unsigned* p)              { return __hip_atomic_load(p, __ATOMIC_RELAXED, __HIP_MEMORY_SCOPE_AGENT); }
__device__ __forceinline__ unsigned xb_add(unsigned* p, unsigned v) { return __hip_atomic_fetch_add(p, v, __ATOMIC_RELAXED, __HIP_MEMORY_SCOPE_AGENT); }
__device__ __forceinline__ unsigned xb_xcc_id() { return (unsigned)__builtin_amdgcn_s_getreg((3 << 11) | 20) & 0xFu; }
#define XB_SPIN(cond, bar) do { unsigned _sp = 0; while (cond) { __builtin_amdgcn_s_sleep(1); \
    if ((++_sp & 255u) == 0u) { if (xb_ld(&(bar)[XB_TMO])) break; if (_sp > XB_SPIN_CAP) { atomicAdd(&(bar)[XB_TMO], 1u); break; } } } } while (0)

struct XcdBarrier {
    unsigned* bar; unsigned x;
    volatile LAS unsigned* st;
};

__device__ __forceinline__ XcdBarrier xcd_barrier_post(unsigned* bar, volatile LAS unsigned* st) {
    XcdBarrier b; b.bar = bar; b.x = xb_xcc_id(); b.st = st;
    if (threadIdx.x == 0) (void)xb_add(&bar[XB_XCNT(b.x)], 1u);
    return b;
}
__device__ __forceinline__ void xcd_barrier_complete(unsigned* bar, unsigned x, unsigned& nloc, unsigned& nx) {
    const unsigned G = gridDim.x * gridDim.y * gridDim.z;
    unsigned sum, cnt, mine, sp = 0u;
    for (;;) {
        sum = 0u; cnt = 0u; mine = 0u;
#pragma unroll
        for (unsigned j = 0; j < 16; ++j) { const unsigned c = xb_ld(&bar[XB_XCNT(j)]); sum += c; cnt += (c > 0u) ? 1u : 0u; mine = (j == x) ? c : mine; }
        if (sum == G) break;
        __builtin_amdgcn_s_sleep(1);
        if ((++sp & 255u) == 0u) { if (xb_ld(&bar[XB_TMO])) break; if (sp > XB_SPIN_CAP) { atomicAdd(&bar[XB_TMO], 1u); break; } }
    }
    nloc = mine > 0u ? mine : 1u; nx = cnt > 0u ? cnt : 1u;
}

__device__ __forceinline__ void xcd_barrier(const XcdBarrier& b) {
    asm volatile("s_waitcnt vmcnt(0)" ::: "memory");
    __syncthreads();
    if (threadIdx.x == 0) {
        unsigned* bar = b.bar;
        __builtin_amdgcn_s_waitcnt(0);
        unsigned nloc = b.st[0], nx = b.st[1];
        if (nloc == 0u) { xcd_barrier_complete(bar, b.x, nloc, nx); b.st[0] = nloc; b.st[1] = nx; }
        const unsigned old = xb_add(&bar[XB_XSUB(b.x)], 1u);
        const unsigned gen = old / nloc;
        if (old + 1u == (gen + 1u) * nloc) {
            __builtin_amdgcn_fence(__ATOMIC_RELEASE, "agent");
            asm volatile("s_waitcnt vmcnt(0)" ::: "memory");
            const unsigned og = xb_add(&bar[XB_TOP], 1u);
            const unsigned tg = og / nx;
            if (og + 1u == (tg + 1u) * nx) xb_add(&bar[XB_TOPGEN], 1u);
            else XB_SPIN(xb_ld(&bar[XB_TOPGEN]) == tg, bar);
            __builtin_amdgcn_fence(__ATOMIC_ACQUIRE, "agent");
            xb_add(&bar[XB_XGEN(b.x)], 1u);
            asm volatile("s_waitcnt vmcnt(0)" ::: "memory");
        } else {
            XB_SPIN(xb_ld(&bar[XB_XGEN(b.x)]) == gen, bar);
            __builtin_amdgcn_fence(__ATOMIC_ACQUIRE, "agent");
            asm volatile("s_waitcnt vmcnt(0)" ::: "memory");
        }
    }
    __syncthreads();
}

struct Frame {
    LAS unsigned char* lds;
    volatile LAS unsigned* MISC;
    gu32* ctl;
    int tid, lane, wave, vcu, G, zz;
    unsigned char* ws;
    float* out;
};
struct Args { const float* in[27]; float* out; unsigned char* ws; int ph_lo, ph_hi; };

struct TileOrder {
    int nM, nN, nwg, G, c, skip;
    __device__ __forceinline__ void init(int nM_, int nN_, int G_, int c_, int skip_) { nM = nM_; nN = nN_; nwg = nM * nN; G = G_; c = c_; skip = skip_; }
    __device__ __forceinline__ bool next(int i, pg8::Unit& u) const {
        const long L = (long)i * G + c; if (L >= nwg) return false;
        int wgid = (int)L; { const int q = nwg / 8, r = nwg % 8, xcd = wgid % 8, off = wgid / 8; wgid = (xcd < r ? xcd * (q + 1) : r * (q + 1) + (xcd - r) * q) + off; }
        const int nig = 8 * nN, gid = wgid / nig, fm = gid * 8, gsz = (nM - fm) < 8 ? (nM - fm) : 8;
        int pm = fm + ((wgid % nig) % gsz); const int pn = (wgid % nig) / gsz;
        if (skip) pm = (pm >> 4) * 17 + 1 + (pm & 15);
        u.pm = pm; u.pn = pn; u.pb = pn; return true;
    }
    __device__ __forceinline__ void a_ready(const pg8::Unit&) const {}
    __device__ __forceinline__ void done(const pg8::Unit&) const {}
};
struct MoeOrder {
    int t1, t2, t3, t4, t5, t6, t7, t8, nN, G, c;
    __device__ __forceinline__ void init(const gu32* cnt, int nN_, int G_, int c_) {
        int t = 0;
        t += ((int)__hip_atomic_load(cnt + 0 * 64, RLX_AGENT) + 255) >> 8; t1 = t; t += ((int)__hip_atomic_load(cnt + 1 * 64, RLX_AGENT) + 255) >> 8; t2 = t;
        t += ((int)__hip_atomic_load(cnt + 2 * 64, RLX_AGENT) + 255) >> 8; t3 = t; t += ((int)__hip_atomic_load(cnt + 3 * 64, RLX_AGENT) + 255) >> 8; t4 = t;
        t += ((int)__hip_atomic_load(cnt + 4 * 64, RLX_AGENT) + 255) >> 8; t5 = t; t += ((int)__hip_atomic_load(cnt + 5 * 64, RLX_AGENT) + 255) >> 8; t6 = t;
        t += ((int)__hip_atomic_load(cnt + 6 * 64, RLX_AGENT) + 255) >> 8; t7 = t; t += ((int)__hip_atomic_load(cnt + 7 * 64, RLX_AGENT) + 255) >> 8; t8 = t;
        nN = nN_; G = G_; c = c_;
    }
    __device__ __forceinline__ int tile_off(int e) const { return e == 0 ? 0 : e == 1 ? t1 : e == 2 ? t2 : e == 3 ? t3 : e == 4 ? t4 : e == 5 ? t5 : e == 6 ? t6 : t7; }
    __device__ __forceinline__ bool next(int i, pg8::Unit& u) const {
        const long L = (long)i * G + c; if (L >= (long)t8 * nN) return false;
        const int pm = (int)(L / nN), pn = (int)(L % nN);
        const int e = (pm >= t1) + (pm >= t2) + (pm >= t3) + (pm >= t4) + (pm >= t5) + (pm >= t6) + (pm >= t7);
        u.pm = pm; u.pn = pn; u.pb = e * nN + pn; return true;
    }
    __device__ __forceinline__ void a_ready(const pg8::Unit&) const {}
    __device__ __forceinline__ void done(const pg8::Unit&) const {}
};

#define EPI_LOOP(...) _Pragma("unroll") for (int ai = 0; ai < 2; ++ai) _Pragma("unroll") for (int m = 0; m < 4; ++m) { const int row = u.pm * 256 + ai * 128 + wr * 64 + m * 16 + fr; \
    _Pragma("unroll") for (int bj = 0; bj < 2; ++bj) { const int col = bj * 128 + wc * 32 + 4 * fq; f32x4 v0 = acc[ai][bj][m][0], v1 = acc[ai][bj][m][1]; __VA_ARGS__ } if (m & 1) asm volatile("" ::: "memory"); }
__device__ __forceinline__ v2u pack4(f32x4 v) { v2u w; w.x = pg8::cvt_pk_bf16(v[0], v[1]); w.y = pg8::cvt_pk_bf16(v[2], v[3]); return w; }
__device__ __forceinline__ f32x4 unpack4(v2u w) { return (f32x4){bf_lo(w.x), bf_hi(w.x), bf_lo(w.y), bf_hi(w.y)}; }

struct EpiProj {
    static constexpr bool PERM = false, AFTER_DRAIN = false;
    bf16* P; float* GB; const float* rope; const float* a_log; const float* dt_bias;
    __device__ __forceinline__ void operator()(const pg8::f32x4 (&acc)[2][2][4][2], const pg8::Unit& u, int wr, int wc, int fr, int fq) const {
        const int pn = u.pn;
        if (pn < 4) {
            EPI_LOOP({ const int j = row % RPB;
                if (j >= CTXL) { const int t = j - CTXL; const int pos = (wc & 1) ? (t & 63) : (t >> 6);
                    const f32x4 cs0 = *(const f32x4*)(rope + (pos * 16 + 4 * fq) * 2), cs1 = *(const f32x4*)(rope + (pos * 16 + 4 * fq) * 2 + 4);
                    const float c0 = cs0[0], s0 = cs0[1], c1 = cs0[2], s1 = cs0[3], c2 = cs1[0], s2 = cs1[1], c3 = cs1[2], s3 = cs1[3];
                    const f32x4 a = v0, b = v1;
                    v0[0] = a[0] * c0 - b[0] * s0; v1[0] = b[0] * c0 + a[0] * s0; v0[1] = a[1] * c1 - b[1] * s1; v1[1] = b[1] * c1 + a[1] * s1;
                    v0[2] = a[2] * c2 - b[2] * s2; v1[2] = b[2] * c2 + a[2] * s2; v0[3] = a[3] * c3 - b[3] * s3; v1[3] = b[3] * c3 + a[3] * s3; }
                bf16* o = P + (size_t)row * NPROJ + pn * 256 + col; *(v2u*)o = pack4(v0); *(v2u*)(o + 16) = pack4(v1); })
        } else if (pn >= 11 && pn < 23) {
            EPI_LOOP({ for (int q = 0; q < 4; ++q) { v0[q] = sigmoidf_(v0[q]); v1[q] = sigmoidf_(v1[q]); }
                bf16* o = P + (size_t)row * NPROJ + pn * 256 + col; *(v2u*)o = pack4(v0); *(v2u*)(o + 16) = pack4(v1); })
        } else if (pn == 23) {
            if (wc == 0) {
                EPI_LOOP({ if (bj == 0) { f32x4 r;
                    for (int q = 0; q < 4; ++q) { const int c = 4 * fq + q; const float x = v0[q];
                        if (c < 8) { const float z = x + dt_bias[c]; const float ez = __expf(z); const float sp = z > 15.f ? z : (ez < 0.03f ? ez * (1.f - ez * (0.5f - ez * (1.f / 3.f))) : __logf(1.f + ez)); r[q] = -__expf(a_log[c]) * sp; }
                        else r[q] = sigmoidf_(x); }
                    *(f32x4*)(GB + (size_t)row * 16 + 4 * fq) = r; } (void)v1; })
            }
        } else {
            EPI_LOOP({ bf16* o = P + (size_t)row * NPROJ + pn * 256 + col; *(v2u*)o = pack4(v0); *(v2u*)(o + 16) = pack4(v1); })
        }
    }
};
struct EpiMerge {
    static constexpr bool PERM = false, AFTER_DRAIN = false;
    bf16* MG; const bf16* P; int gcol0; int first;
    __device__ __forceinline__ void operator()(const pg8::f32x4 (&acc)[2][2][4][2], const pg8::Unit& u, int wr, int wc, int fr, int fq) const {
        EPI_LOOP({ const int c = u.pn * 256 + col; const bf16* gp = P + (size_t)row * NPROJ + gcol0 + c; bf16* o = MG + (size_t)row * DM + c;
            const f32x4 g0 = unpack4(*(const v2u*)gp), g1 = unpack4(*(const v2u*)(gp + 16));
            f32x4 r0 = g0 * v0, r1 = g1 * v1;
            if (!first) { unsigned long long w0 = __hip_atomic_load((unsigned long long*)o, RLX_AGENT), w1 = __hip_atomic_load((unsigned long long*)(o + 16), RLX_AGENT);
                r0 += unpack4((v2u){(unsigned)w0, (unsigned)(w0 >> 32)}); r1 += unpack4((v2u){(unsigned)w1, (unsigned)(w1 >> 32)}); }
            *(v2u*)o = pack4(r0); *(v2u*)(o + 16) = pack4(r1); })
    }
};
struct EpiResid {
    static constexpr bool PERM = false, AFTER_DRAIN = false;
    float* H; const float* modl; int gidx;
    __device__ __forceinline__ void operator()(const pg8::f32x4 (&acc)[2][2][4][2], const pg8::Unit& u, int wr, int wc, int fr, int fq) const {
        EPI_LOOP({ const int c = u.pn * 256 + col; const int b = row / RPB, j = row - b * RPB; const int mr = j < CTXL ? 4 : b;
            const float* gp = modl + mr * 6144 + gidx * 1024 + c; float* hp = H + (size_t)row * DM + c;
            const f32x4 g0 = *(const f32x4*)gp, g1 = *(const f32x4*)(gp + 16);
            *(f32x4*)hp = *(const f32x4*)hp + g0 * v0; *(f32x4*)(hp + 16) = *(const f32x4*)(hp + 16) + g1 * v1; })
    }
};
struct EpiSwiglu {
    static constexpr bool PERM = false, AFTER_DRAIN = false;
    bf16* HID; int ldh;
    __device__ __forceinline__ void operator()(const pg8::f32x4 (&acc)[2][2][4][2], const pg8::Unit& u, int wr, int wc, int fr, int fq) const {
        EPI_LOOP({ (void)col; f32x4 r; for (int q = 0; q < 4; ++q) r[q] = siluf_(v0[q]) * v1[q];
            *(v2u*)(HID + (size_t)row * ldh + u.pn * 128 + bj * 64 + wc * 16 + 4 * fq) = pack4(r); })
    }
};
struct EpiY {
    static constexpr bool PERM = false, AFTER_DRAIN = false;
    bf16* Y; int first;
    __device__ __forceinline__ void operator()(const pg8::f32x4 (&acc)[2][2][4][2], const pg8::Unit& u, int wr, int wc, int fr, int fq) const {
        EPI_LOOP({ bf16* o = Y + (size_t)row * DM + u.pn * 256 + col; f32x4 r0 = v0, r1 = v1;
            if (!first) { unsigned long long w0 = __hip_atomic_load((unsigned long long*)o, RLX_AGENT), w1 = __hip_atomic_load((unsigned long long*)(o + 16), RLX_AGENT);
                r0 += unpack4((v2u){(unsigned)w0, (unsigned)(w0 >> 32)}); r1 += unpack4((v2u){(unsigned)w1, (unsigned)(w1 >> 32)}); }
            *(v2u*)o = pack4(r0); *(v2u*)(o + 16) = pack4(r1); })
    }
};

template <int MAP> __device__ __forceinline__ int map_col(int c) {
    if (MAP == 0) return c;
    if (MAP == 1) return c < 2560 ? c : (c < 2576 ? PC_AB + (c - 2560) : (c < 2832 ? PC_POOL + (c - 2576) : PC_GATE + (c - 2832)));
    if (MAP == 2) return (c >> 4) * 32 + (c & 15);
    return (c >> 4) * 32 + 16 + (c & 15);
}
template <int MAP> __device__ __forceinline__ void tr_item(const float* W, int ldw, int N, bf16* WT, int ldd, int item, LAS float* scr, int lane) {
    const int nblk = (N + 31) / 32, kb = item / nblk, nb = item % nblk, k0 = 64 * kb, n0 = 32 * nb;
    const int cl = n0 + (lane & 31);
    float tv[32];
#pragma unroll
    for (int i = 0; i < 32; ++i) { const int kk = 2 * i + (lane >> 5); tv[i] = cl < N ? W[(size_t)(k0 + kk) * ldw + cl] : 0.f; }
#pragma unroll
    for (int i = 0; i < 32; ++i) { const int kk = 2 * i + (lane >> 5); scr[kk * 33 + (lane & 31)] = tv[i]; }
    LDS_WAIT(); asm volatile("" ::: "memory");
    const int c = lane & 7;
#pragma unroll
    for (int j = 0; j < 4; ++j) { const int n = (lane >> 3) + 8 * j; const LAS float* s = scr + (8 * c) * 33 + n;
        if (n0 + n < N) { v4u o; o.x = pk2(s[0 * 33], s[1 * 33]); o.y = pk2(s[2 * 33], s[3 * 33]); o.z = pk2(s[4 * 33], s[5 * 33]); o.w = pk2(s[6 * 33], s[7 * 33]);
            *(GAS v4u*)(WT + (size_t)map_col<MAP>(n0 + n) * ldd + k0 + 8 * c) = o; } }
    LDS_WAIT(); asm volatile("" ::: "memory");
}
#define TR_RUN(MAP, W, ldw, K, N, WT, ldd) { const int cnt_ = ((K) / 64) * (((N) + 31) / 32); if (r < cnt_) { tr_item<MAP>(W, ldw, N, WT, ldd, r, scr, F.lane); continue; } r -= cnt_; }

__device__ __forceinline__ void p0_prologue(Frame& F, const Args& A) {
    LAS float* scr = (LAS float*)(F.lds + F.wave * 16384);
    const int gw = F.vcu * NWAVES + F.wave, NGW = F.G * NWAVES;
    bf16* WIN = (bf16*)(F.ws + WS_WIN); bf16* WBR = (bf16*)(F.ws + WS_WBR); bf16* WOUT = (bf16*)(F.ws + WS_WOUT); bf16* W13 = (bf16*)(F.ws + WS_W13); bf16* W2 = (bf16*)(F.ws + WS_W2);
    constexpr int PER_LAYER = 16 * 185 + 8 * 32 + 4 * 32 + 4 * 32 + 16 * 32, TOTAL = 2 * PER_LAYER + 16 * 88 * 2 + 44 * 32;
    for (int it = gw; it < TOTAL; it += NGW) {
        int r = it;
        for (int l = 0; l < 2; ++l) {
            bool hit = false;
            if (r < PER_LAYER) { hit = true;
                const float* win = A.in[F.zz + 8] + (size_t)l * 1024 * INW; const float* wbr = A.in[F.zz + 17] + (size_t)l * 1024 * 1024; const float* wo = A.in[F.zz + 18] + (size_t)l * 1024 * 1024;
                bf16* dbr = WBR + (size_t)l * 1024 * 1024;
                do {
                    { const int cnt_ = 16 * 185; if (r < cnt_) { tr_item<1>(win, INW, INW, WIN + (size_t)l * NPROJ * 1024, 1024, r, scr, F.lane); break; } r -= cnt_; }
                    { const int cnt_ = 8 * 32; if (r < cnt_) { tr_item<0>(wbr, 1024, 1024, dbr, 512, r, scr, F.lane); break; } r -= cnt_; }
                    { const int cnt_ = 4 * 32; if (r < cnt_) { tr_item<0>(wbr + 512 * 1024, 1024, 1024, dbr + 1024 * 512, 256, r, scr, F.lane); break; } r -= cnt_; }
                    { const int cnt_ = 4 * 32; if (r < cnt_) { tr_item<0>(wbr + 768 * 1024, 1024, 1024, dbr + 1024 * 768, 256, r, scr, F.lane); break; } r -= cnt_; }
                    tr_item<0>(wo, 1024, 1024, WOUT + (size_t)l * 1024 * 1024, 1024, r, scr, F.lane);
                } while (0);
            }
            if (hit) { r = -1; break; }
            r -= PER_LAYER;
        }
        if (r < 0) continue;
        { const int cnt_ = 16 * 88; if (r < cnt_) { tr_item<2>(A.in[F.zz + 19], FFD, FFD, W13, 1024, r, scr, F.lane); continue; } r -= cnt_; }
        { const int cnt_ = 16 * 88; if (r < cnt_) { tr_item<3>(A.in[F.zz + 20], FFD, FFD, W13, 1024, r, scr, F.lane); continue; } r -= cnt_; }
        tr_item<0>(A.in[F.zz + 21], 1024, 1024, W2, FFD, r, scr, F.lane);
    }
    float* H = (float*)(F.ws + WS_H);
    for (int R = gw; R < MROWS; R += NGW) { const int b = R / RPB, j = R - b * RPB;
        const float* src = j < CTXL ? A.in[F.zz + 2] + ((size_t)b * CTXL + j) * DM : A.in[F.zz + 0] + ((size_t)b * SEQ + (j - CTXL)) * DM;
        const GAS f32x4* s4 = (const GAS f32x4*)src + F.lane; GAS f32x4* d4 = (GAS f32x4*)(H + (size_t)R * DM) + F.lane;
#pragma unroll
        for (int q = 0; q < 4; ++q) d4[64 * q] = s4[64 * q]; }
    if (F.vcu == 0) {
        float* rope = (float*)(F.ws + WS_ROPE);
        for (int e = F.tid; e < 1024; e += NTHR) { const int pos = e >> 4, i = e & 15; const float inv = powf(10000.f, -(float)i / 16.f); const float a = (float)pos * inv;
            rope[2 * e] = cosf(a); rope[2 * e + 1] = sinf(a); }
        if (F.tid < 2) { const int l = F.tid; const float* lp = A.in[F.zz + 9] + l * 256; float s1 = 0.f, s2 = 0.f;
            for (int i = 0; i < 64; ++i) { s1 += lp[i] * lp[64 + i]; s2 += lp[128 + i] * lp[192 + i]; }
            const float li = 0.8f - 0.6f * expf(-0.3f * (float)l);
            ((float*)(F.ws + WS_LAM))[l] = expf(s1) - expf(s2) + li; }
    }
    __syncthreads();
    float* MOD = (float*)(F.ws + WS_MOD);
    LAS float* red = (LAS float*)F.lds;
    for (int task = F.vcu; task < 2 * 96; task += F.G) {
        const int l = task / 96, cc = task % 96;
        const float* aw = A.in[F.zz + 4] + (size_t)l * 1024 * 6144 + cc * 64 + F.lane;
        const float* c0 = A.in[F.zz + 1]; const float* cx = A.in[F.zz + 3];
        float a0 = 0.f, a1 = 0.f, a2 = 0.f, a3 = 0.f, a4 = 0.f;
#pragma unroll 8
        for (int i = 0; i < 128; ++i) { const int k = F.wave * 128 + i; const float w = aw[(size_t)k * 6144];
            a0 += siluf_(c0[k]) * w; a1 += siluf_(c0[1024 + k]) * w; a2 += siluf_(c0[2048 + k]) * w; a3 += siluf_(c0[3072 + k]) * w; a4 += siluf_(cx[k]) * w; }
        LAS float* rw = red + F.wave * 320 + F.lane;
        rw[0] = a0; rw[64] = a1; rw[128] = a2; rw[192] = a3; rw[256] = a4;
        __syncthreads();
        if (F.tid < 320) { float s = 0.f;
#pragma unroll
            for (int w = 0; w < 8; ++w) s += red[w * 320 + F.tid];
            const int rr = F.tid >> 6, jj = cc * 64 + (F.tid & 63);
            MOD[(l * 5 + rr) * 6144 + jj] = s + A.in[F.zz + 5][l * 6144 + jj]; }
        __syncthreads();
    }
}

__device__ __forceinline__ void moe_convert(Frame& F, const Args& A, int hh) {
    LAS float* scr = (LAS float*)(F.lds + F.wave * 16384);
    const int gw = F.vcu * NWAVES + F.wave, NGW = F.G * NWAVES;
    bf16* W13M = (bf16*)(F.ws + WS_W13M); bf16* W2M = (bf16*)(F.ws + WS_W2M);
    constexpr int I13 = 16 * 56, I2 = 28 * 32, PER_E = 2 * I13 + I2;
    for (int it = gw; it < 8 * PER_E; it += NGW) {
        const int e = it / PER_E; int r = it - e * PER_E;
        if (r < I13) { tr_item<2>(A.in[F.zz + 23] + (size_t)e * 1024 * FFE + hh * FFEH, FFE, FFEH, W13M + (size_t)e * FFE * 1024, 1024, r, scr, F.lane); continue; } r -= I13;
        if (r < I13) { tr_item<3>(A.in[F.zz + 24] + (size_t)e * 1024 * FFE + hh * FFEH, FFE, FFEH, W13M + (size_t)e * FFE * 1024, 1024, r, scr, F.lane); continue; } r -= I13;
        tr_item<0>(A.in[F.zz + 25] + (size_t)e * FFE * 1024 + (size_t)hh * FFEH * 1024, 1024, 1024, W2M + (size_t)e * 1024 * FFEH, FFEH, r, scr, F.lane);
    }
}

__device__ __forceinline__ void norm_mod_phase(Frame& F, const Args& A, int l, int which, bool latent_only, bool route) {
    const int gw = F.vcu * NWAVES + F.wave, NGW = F.G * NWAVES;
    const float* H = (const float*)(F.ws + WS_H); bf16* U = (bf16*)(F.ws + WS_U); const float* MOD = (const float*)(F.ws + WS_MOD) + l * 5 * 6144;
    const float* g = (which ? A.in[F.zz + 7] : A.in[F.zz + 6]) + l * 1024;
    for (int R = gw; R < MROWS; R += NGW) {
        const int b = R / RPB, j = R - b * RPB; const bool isctx = j < CTXL; if (latent_only && isctx) continue;
        const float* mod = MOD + (isctx ? 4 : b) * 6144; const float* shift = mod + (which ? 3 : 0) * 1024; const float* scale = mod + (which ? 4 : 1) * 1024;
        const GAS f32x4* xr = (const GAS f32x4*)(H + (size_t)R * DM) + F.lane;
        f32x4 v[4]; float ss = 0.f;
#pragma unroll
        for (int q = 0; q < 4; ++q) { v[q] = xr[64 * q]; ss += (v[q].x * v[q].x + v[q].y * v[q].y) + (v[q].z * v[q].z + v[q].w * v[q].w); }
        const float rstd = 1.f / sqrtf(wave_sum(ss) * (1.f / DM) + EPSN);
        GAS v2u* o8 = (GAS v2u*)(U + (size_t)R * DM) + F.lane;
#pragma unroll
        for (int q = 0; q < 4; ++q) { const int c = 4 * F.lane + 256 * q; const f32x4 gg = *(const f32x4*)(g + c), sh = *(const f32x4*)(shift + c), sc = *(const f32x4*)(scale + c);
            v[q] = (v[q] * rstd) * gg * (sc + 1.f) + sh; v2u w; w.x = pk2(v[q].x, v[q].y); w.y = pk2(v[q].z, v[q].w); o8[64 * q] = w; }
        if (route) {
            const float* rw = A.in[F.zz + 22];
            float lg[8] = {0, 0, 0, 0, 0, 0, 0, 0};
#pragma unroll
            for (int q = 0; q < 4; ++q)
#pragma unroll
                for (int i = 0; i < 4; ++i) { const int k = 4 * F.lane + 256 * q + i; const f32x4 w0 = *(const f32x4*)(rw + k * 8), w1 = *(const f32x4*)(rw + k * 8 + 4); const float x = v[q][i];
                    lg[0] += x * w0[0]; lg[1] += x * w0[1]; lg[2] += x * w0[2]; lg[3] += x * w0[3]; lg[4] += x * w1[0]; lg[5] += x * w1[1]; lg[6] += x * w1[2]; lg[7] += x * w1[3]; }
#pragma unroll
            for (int e = 0; e < 8; ++e) lg[e] = wave_sum(lg[e]);
            if (F.lane == 0) {
                int e0 = 0; float v0 = lg[0];
#pragma unroll
                for (int e = 1; e < 8; ++e) if (lg[e] > v0) { v0 = lg[e]; e0 = e; }
                int e1 = -1; float v1 = -3.0e38f;
#pragma unroll
                for (int e = 0; e < 8; ++e) if (e != e0 && lg[e] > v1) { v1 = lg[e]; e1 = e; }
                const float ex = __expf(v1 - v0); const float w0 = 1.f / (1.f + ex), w1 = ex / (1.f + ex);
                gu32* cnt = F.ctl + CW_ECNT;
#ifdef DBG_DETPOS
                const unsigned p0 = 0, p1 = 0; (void)cnt;
#else
                const unsigned p0 = __hip_atomic_fetch_add(cnt + 64 * e0, 1u, RLX_AGENT), p1 = __hip_atomic_fetch_add(cnt + 64 * e1, 1u, RLX_AGENT);
#endif
                const int tk = b * SEQ + (j - CTXL);
                v4u* rt = (v4u*)(F.ws + WS_ROUTE) + 2 * tk;
                rt[0] = (v4u){(unsigned)e0, (unsigned)e1, p0, p1}; rt[1] = (v4u){__float_as_uint(w0), __float_as_uint(w1), 0u, 0u};
            }
        }
    }
}

__device__ __forceinline__ void moe_gather(Frame& F) {
#ifdef DBG_DETPOS
    if (F.vcu == 0 && F.tid == 0) { unsigned c[8] = {0,0,0,0,0,0,0,0};
        for (int tk = 0; tk < NB * SEQ; ++tk) { v4u* rt = (v4u*)(F.ws + WS_ROUTE) + 2 * tk; v4u r = rt[0];
            for (int e = 0; e < 8; ++e) { if ((int)r.x == e) r.z = c[e]++; } for (int e = 0; e < 8; ++e) { if ((int)r.y == e) r.w = c[e]++; } rt[0] = r; }
        for (int e = 0; e < 8; ++e) __hip_atomic_store(F.ctl + CW_ECNT + 64 * e, c[e], RLX_AGENT); }
    return;
#endif
    const int gw = F.vcu * NWAVES + F.wave, NGW = F.G * NWAVES;
    MoeOrder mo; mo.init(F.ctl + CW_ECNT, 1, 1, 0);
    const bf16* U = (const bf16*)(F.ws + WS_U); bf16* XG = (bf16*)(F.ws + WS_XG);
    for (int tk = gw; tk < NB * SEQ; tk += NGW) {
        const int b = tk / SEQ, t = tk - b * SEQ; const size_t R = (size_t)b * RPB + CTXL + t;
        const v4u rt = ((const v4u*)(F.ws + WS_ROUTE))[2 * tk];
        const size_t r0 = (size_t)mo.tile_off((int)rt.x) * 256 + rt.z, r1 = (size_t)mo.tile_off((int)rt.y) * 256 + rt.w;
        const GAS v4u* s = (const GAS v4u*)(U + R * DM) + F.lane; const v4u a = s[0], c = s[64];
        GAS v4u* d0 = (GAS v4u*)(XG + r0 * DM) + F.lane; GAS v4u* d1 = (GAS v4u*)(XG + r1 * DM) + F.lane;
        d0[0] = a; d0[64] = c; d1[0] = a; d1[64] = c;
    }
}

__device__ __forceinline__ void moe_gather2(Frame& F) {
    const int gw = F.vcu * NWAVES + F.wave, NGW = F.G * NWAVES;
    MoeOrder mo; mo.init(F.ctl + CW_ECNT, 1, 1, 0);
    const bf16* U = (const bf16*)(F.ws + WS_U); bf16* XG = (bf16*)(F.ws + WS_XG);
    for (int tk = gw; tk < NB * SEQ; tk += NGW) {
        const int b = tk / SEQ, t = tk - b * SEQ; const size_t R = (size_t)b * RPB + CTXL + t;
        const v4u rt = ((const v4u*)(F.ws + WS_ROUTE))[2 * tk];
        const size_t r0 = (size_t)mo.tile_off((int)rt.x) * 256 + rt.z, r1 = (size_t)mo.tile_off((int)rt.y) * 256 + rt.w;
        const GAS v4u* s = (const GAS v4u*)(U + R * DM) + F.lane; const v4u a = s[0], c = s[64];
        GAS v4u* d0 = (GAS v4u*)(XG + r0 * DM) + F.lane; GAS v4u* d1 = (GAS v4u*)(XG + r1 * DM) + F.lane;
        d0[0] = a; d0[64] = c; d1[0] = a; d1[64] = c;
    }
}

__device__ __forceinline__ void final_phase(Frame& F, const Args& A) {
    const int gw = F.vcu * NWAVES + F.wave, NGW = F.G * NWAVES;
    MoeOrder mo; mo.init(F.ctl + CW_ECNT, 1, 1, 0);
    const float* H = (const float*)(F.ws + WS_H); const bf16* Y = (const bf16*)(F.ws + WS_Y); const float* MOD = (const float*)(F.ws + WS_MOD) + 1 * 5 * 6144;
    for (int tk = gw; tk < NB * SEQ; tk += NGW) {
        const int b = tk / SEQ, t = tk - b * SEQ; const size_t R = (size_t)b * RPB + CTXL + t;
        const v4u rt = ((const v4u*)(F.ws + WS_ROUTE))[2 * tk], rw = ((const v4u*)(F.ws + WS_ROUTE))[2 * tk + 1];
        const size_t r0 = (size_t)mo.tile_off((int)rt.x) * 256 + rt.z, r1 = (size_t)mo.tile_off((int)rt.y) * 256 + rt.w;
        const float w0 = __uint_as_float(rw.x), w1 = __uint_as_float(rw.y);
        const float* gate = MOD + b * 6144 + 5 * 1024;
        f32x4 v[4]; float ss = 0.f;
#pragma unroll
        for (int q = 0; q < 4; ++q) { const int c = 4 * F.lane + 256 * q;
            const f32x4 h = *(const f32x4*)(H + R * DM + c), gg = *(const f32x4*)(gate + c);
            const f32x4 y0 = unpack4(*(const v2u*)(Y + r0 * DM + c)), y1 = unpack4(*(const v2u*)(Y + r1 * DM + c));
            v[q] = h + gg * (y0 * w0 + y1 * w1); ss += (v[q].x * v[q].x + v[q].y * v[q].y) + (v[q].z * v[q].z + v[q].w * v[q].w); }
        const float rstd = 1.f / sqrtf(wave_sum(ss) * (1.f / DM) + EPSN);
#pragma unroll
        for (int q = 0; q < 4; ++q) { const int c = 4 * F.lane + 256 * q; *(f32x4*)(F.out + (size_t)tk * DM + c) = v[q] * rstd * *(const f32x4*)(A.in[F.zz + 26] + c); }
    }
}

constexpr int DP = 65;
typedef short dn_bf16x8 __attribute__((ext_vector_type(8)));
__device__ __forceinline__ f32x4 mm_tile(const LAS float* Am, int a_sm, int a_sk, const LAS float* Bm, int b_sk, int b_sn, int m0, int n0, int lane) {
    const int r = lane & 15, q = lane >> 4; f32x4 acc = {0.f, 0.f, 0.f, 0.f};
#pragma unroll
    for (int ks = 0; ks < 2; ++ks) {
        const LAS float* ap = Am + (m0 + r) * a_sm + (32 * ks + 8 * q) * a_sk; const LAS float* bp = Bm + (32 * ks + 8 * q) * b_sk + (n0 + r) * b_sn;
        v4u a, b;
        a.x = pk2(ap[0], ap[a_sk]); a.y = pk2(ap[2 * a_sk], ap[3 * a_sk]); a.z = pk2(ap[4 * a_sk], ap[5 * a_sk]); a.w = pk2(ap[6 * a_sk], ap[7 * a_sk]);
        b.x = pk2(bp[0], bp[b_sk]); b.y = pk2(bp[2 * b_sk], bp[3 * b_sk]); b.z = pk2(bp[4 * b_sk], bp[5 * b_sk]); b.w = pk2(bp[6 * b_sk], bp[7 * b_sk]);
        acc = __builtin_amdgcn_mfma_f32_16x16x32_bf16(__builtin_bit_cast(dn_bf16x8, a), __builtin_bit_cast(dn_bf16x8, b), acc, 0, 0, 0);
    }
    return acc;
}

constexpr int RS = 72;
constexpr int IMG = 64 * RS * 2;
typedef short dn_s16x4 __attribute__((ext_vector_type(4)));
__device__ __forceinline__ f32x4 mm_img(const LAS bf16* Ai, const LAS bf16* Bi, int m0, int n0, int r, int q) {
    f32x4 acc = {0.f, 0.f, 0.f, 0.f};
    const LAS bf16* ap = Ai + (m0 + r) * RS + 8 * q; const LAS bf16* bp = Bi + (n0 + r) * RS + 8 * q;
    acc = __builtin_amdgcn_mfma_f32_16x16x32_bf16(*(const LAS dn_bf16x8*)ap, *(const LAS dn_bf16x8*)bp, acc, 0, 0, 0);
    acc = __builtin_amdgcn_mfma_f32_16x16x32_bf16(*(const LAS dn_bf16x8*)(ap + 32), *(const LAS dn_bf16x8*)(bp + 32), acc, 0, 0, 0);
    return acc;
}
template <int D> __device__ __forceinline__ void dn_diag_inv(LAS float* Dg, int ln) {
    const int blk = ln >> 4, r = ln & 15;
    LAS float* Ab = Dg + blk * 256;
    float t[16];
#pragma unroll
    for (int c = 0; c < 16; ++c) t[c] = (c == r) ? 1.f : 0.f;
#pragma unroll
    for (int c = 14; c >= 0; --c) { float s = 0.f;
#pragma unroll
        for (int j = c + 1; j < 16; ++j) { const float a = D == 0 ? Ab[j * 16 + c] : Ab[(15 - j) * 16 + (15 - c)]; s -= t[j] * a; }
        t[c] = (c < r) ? s : t[c]; }
    asm volatile("s_waitcnt lgkmcnt(0)" ::: "memory");
#pragma unroll
    for (int c = 0; c < 16; ++c) { if (D == 0) Ab[r * 16 + c] = t[c]; else Ab[(15 - r) * 16 + (15 - c)] = t[c]; }
}
template <int D> __device__ __forceinline__ void dn_solve_tiles(const LAS bf16* Ad, const LAS float* Dg, const LAS bf16* VT, const LAS bf16* KT, LAS bf16* UT, LAS bf16* WT,
                                                               const LAS float* Bd, const LAS float* Gd, int w4, int ln) {
    const int r = ln & 15, q = ln >> 4;
#pragma unroll 1
    for (int i = 0; i < 2; ++i) { const int nt = w4 * 2 + i; const bool isw = nt >= 4; const int c0 = (nt & 3) * 16 + r;
        const LAS bf16* src = (isw ? KT : VT) + c0 * RS; LAS bf16* dst = (isw ? WT : UT) + c0 * RS;
        f32x4 acc[4]; dn_s16x4 xb[4];
#pragma unroll
        for (int bi = 0; bi < 4; ++bi) { const v2u x = *(const LAS v2u*)(src + 16 * bi + 4 * q); const f32x4 xv = {bf_lo(x.x), bf_hi(x.x), bf_lo(x.y), bf_hi(x.y)};
#pragma unroll
            for (int g = 0; g < 4; ++g) { const int t = 16 * bi + 4 * q + g; const float sc = isw ? Bd[t] * __expf(Gd[t]) : Bd[t]; acc[bi][g] = xv[g] * sc; } }
#pragma unroll
        for (int st = 0; st < 4; ++st) { const int bi = D == 0 ? st : 3 - st;
#pragma unroll
            for (int s2 = 0; s2 < st; ++s2) { const int bj = D == 0 ? s2 : 3 - s2;
                v2u a = *(const LAS v2u*)(Ad + (16 * bi + r) * RS + 16 * bj + 4 * q); a.x ^= 0x80008000u; a.y ^= 0x80008000u;
                acc[bi] = __builtin_amdgcn_mfma_f32_16x16x16bf16_1k(__builtin_bit_cast(dn_s16x4, a), xb[bj], acc[bi], 0, 0, 0); }
            { const LAS float* tp = Dg + bi * 256 + r * 16 + 4 * q; v2u a; a.x = cvtpk_c(tp[0], tp[1]); a.y = cvtpk_c(tp[2], tp[3]);
              v2u xr; xr.x = cvtpk_c(acc[bi][0], acc[bi][1]); xr.y = cvtpk_c(acc[bi][2], acc[bi][3]);
              acc[bi] = __builtin_amdgcn_mfma_f32_16x16x16bf16_1k(__builtin_bit_cast(dn_s16x4, a), __builtin_bit_cast(dn_s16x4, xr), (f32x4){0.f, 0.f, 0.f, 0.f}, 0, 0, 0);
              v2u xo; xo.x = cvtpk_c(acc[bi][0], acc[bi][1]); xo.y = cvtpk_c(acc[bi][2], acc[bi][3]); xb[bi] = __builtin_bit_cast(dn_s16x4, xo);
              *(LAS v2u*)(dst + 16 * bi + 4 * q) = xo; }
        }
    }
}
__device__ __forceinline__ void dn_pre_unit(Frame& F, const Args& A, int l, int b, int n, int h) {
    LAS bf16* KcB = (LAS bf16*)(F.lds + 0 * IMG); LAS bf16* QcB = (LAS bf16*)(F.lds + 1 * IMG); LAS bf16* KT = (LAS bf16*)(F.lds + 2 * IMG); LAS bf16* VT = (LAS bf16*)(F.lds + 3 * IMG);
#define DIMG(d, k) ((LAS bf16*)(F.lds + (4 + 5 * (d) + (k)) * IMG))
    LAS float* Gs = (LAS float*)(F.lds + 14 * IMG);
    LAS float* Bs = Gs + 128;
    LAS float* Dg = Gs + 256;
    const bf16* P = (const bf16*)(F.ws + WS_PROJ); const float* GB = (const float*)(F.ws + WS_GB);
    int tid = threadIdx.x; asm volatile("" : "+v"(tid));
    const int wv = tid >> 6, ln = tid & 63, r = ln & 15, q = ln >> 4;
    const int row0 = b * RPB + n * 64; const int seq_lo = (n < 4) ? b * RPB : b * RPB + CTXL, seq_hi = (n < 4) ? b * RPB + CTXL : (b + 1) * RPB;
    {
        const int t = tid >> 3, cg = tid & 7;
        const float* cw = A.in[F.zz + 11] + (size_t)l * 5 * 768;
#pragma unroll
        for (int p = 0; p < 3; ++p) {
            const int ch = p * 256 + h * 64 + cg * 8;
            float acc[8] = {0, 0, 0, 0, 0, 0, 0, 0};
#pragma unroll
            for (int tap = 0; tap < 5; ++tap) { const int rr = row0 + t + tap - 2;
                if (rr >= seq_lo && rr < seq_hi) { const v4u x = *(const v4u*)(P + (size_t)rr * NPROJ + PC_DQ + ch);
                    const f32x4 w0 = *(const f32x4*)(cw + tap * 768 + ch), w1 = *(const f32x4*)(cw + tap * 768 + ch + 4);
                    acc[0] += bf_lo(x.x) * w0[0]; acc[1] += bf_hi(x.x) * w0[1]; acc[2] += bf_lo(x.y) * w0[2]; acc[3] += bf_hi(x.y) * w0[3];
                    acc[4] += bf_lo(x.z) * w1[0]; acc[5] += bf_hi(x.z) * w1[1]; acc[6] += bf_lo(x.w) * w1[2]; acc[7] += bf_hi(x.w) * w1[3]; } }
            float ss = 0.f;
#pragma unroll
            for (int i = 0; i < 8; ++i) { acc[i] = siluf_(acc[i]); ss += acc[i] * acc[i]; }
            float sc = 1.f;
            if (p < 2) { ss += __shfl_xor(ss, 1); ss += __shfl_xor(ss, 2); ss += __shfl_xor(ss, 4); sc = (1.f / sqrtf(ss + EPSN)) * (p == 0 ? 0.125f : 1.f); }
            v4u o; o.x = cvtpk_c(acc[0] * sc, acc[1] * sc); o.y = cvtpk_c(acc[2] * sc, acc[3] * sc); o.z = cvtpk_c(acc[4] * sc, acc[5] * sc); o.w = cvtpk_c(acc[6] * sc, acc[7] * sc);
            if (p == 0) *(LAS v4u*)(QcB + t * RS + cg * 8) = o;
            else { if (p == 1) *(LAS v4u*)(KcB + t * RS + cg * 8) = o;
                LAS bf16* tp = (p == 1 ? KT : VT) + (cg * 8) * RS + t;
                tp[0 * RS] = (bf16)(o.x & 0xffffu); tp[1 * RS] = (bf16)(o.x >> 16); tp[2 * RS] = (bf16)(o.y & 0xffffu); tp[3 * RS] = (bf16)(o.y >> 16);
                tp[4 * RS] = (bf16)(o.z & 0xffffu); tp[5 * RS] = (bf16)(o.z >> 16); tp[6 * RS] = (bf16)(o.w & 0xffffu); tp[7 * RS] = (bf16)(o.w >> 16); }
        }
        if (wv < 2) { const int d = wv; const float* gb = GB + (size_t)(row0 + ln) * 16; const float g = gb[d * 4 + h]; Bs[d * 64 + ln] = gb[8 + d * 4 + h];
            float pf = g;
#pragma unroll
            for (int o = 1; o < 64; o <<= 1) { const float v = __shfl_up(pf, o); if (ln >= o) pf += v; }
            const float tot = __shfl(pf, 63);
            Gs[d * 64 + ln] = d == 0 ? pf : tot - pf + g; }
    }
    __syncthreads();
    {
#pragma unroll
        for (int i = 0; i < 2; ++i) { const int tile = wv * 2 + i, m0 = (tile >> 2) * 16, n0 = (tile & 3) * 16;
            const f32x4 kk = mm_img(KcB, KcB, m0, n0, r, q), qk = mm_img(QcB, KcB, m0, n0, r, q);
            const int s = n0 + r; const float g0s = Gs[s], g1s = Gs[64 + s];
#pragma unroll
            for (int g = 0; g < 4; ++g) { const int t = m0 + 4 * q + g; const float e0 = __expf(Gs[t] - g0s), e1 = __expf(Gs[64 + t] - g1s);
                const float a0 = (s < t) ? Bs[t] * kk[g] * e0 : 0.f, a1 = (s > t) ? Bs[64 + t] * kk[g] * e1 : 0.f;
                DIMG(0, 0)[t * RS + s] = (bf16)f2bf(a0); DIMG(1, 0)[t * RS + s] = (bf16)f2bf(a1);
                DIMG(0, 1)[t * RS + s] = (bf16)f2bf((s <= t) ? qk[g] * e0 : 0.f); DIMG(1, 1)[t * RS + s] = (bf16)f2bf((s >= t) ? qk[g] * e1 : 0.f);
                if (m0 == n0) { Dg[(m0 >> 4) * 256 + (t & 15) * 16 + r] = a0; Dg[1024 + (m0 >> 4) * 256 + (t & 15) * 16 + r] = a1; } } }
        { const int c = tid >> 3, t0 = (tid & 7) * 8; const v4u kx = *(const LAS v4u*)(KT + c * RS + t0); const float gl0 = Gs[63], gl1 = Gs[64];
          const float kf[8] = {bf_lo(kx.x), bf_hi(kx.x), bf_lo(kx.y), bf_hi(kx.y), bf_lo(kx.z), bf_hi(kx.z), bf_lo(kx.w), bf_hi(kx.w)};
          float s0[8], s1[8];
#pragma unroll
          for (int j = 0; j < 8; ++j) { s0[j] = kf[j] * __expf(gl0 - Gs[t0 + j]); s1[j] = kf[j] * __expf(gl1 - Gs[64 + t0 + j]); }
          v4u o0, o1; o0.x = cvtpk_c(s0[0], s0[1]); o0.y = cvtpk_c(s0[2], s0[3]); o0.z = cvtpk_c(s0[4], s0[5]); o0.w = cvtpk_c(s0[6], s0[7]);
          o1.x = cvtpk_c(s1[0], s1[1]); o1.y = cvtpk_c(s1[2], s1[3]); o1.z = cvtpk_c(s1[4], s1[5]); o1.w = cvtpk_c(s1[6], s1[7]);
          *(LAS v4u*)(DIMG(0, 4) + c * RS + t0) = o0; *(LAS v4u*)(DIMG(1, 4) + c * RS + t0) = o1; }
    }
    __syncthreads();
    if (wv == 0) dn_diag_inv<0>(Dg, ln); else if (wv == 4) dn_diag_inv<1>(Dg + 1024, ln);
    __syncthreads();
    if (wv < 4) dn_solve_tiles<0>(DIMG(0, 0), Dg, VT, KT, DIMG(0, 3), DIMG(0, 2), Bs, Gs, wv & 3, ln);
    else dn_solve_tiles<1>(DIMG(1, 0), Dg + 1024, VT, KT, DIMG(1, 3), DIMG(1, 2), Bs + 64, Gs + 64, wv & 3, ln);
    __syncthreads();
    {
        const int d = wv >> 2, mt = wv & 3;
        const LAS bf16* Aq = DIMG(d, 1); const LAS bf16* WT = DIMG(d, 2); const LAS bf16* UT = DIMG(d, 3); const LAS bf16* KsT = DIMG(d, 4); const LAS float* Gd = Gs + d * 64;
        const float glast = d == 0 ? Gd[63] : Gd[0];
        const size_t prob = (((size_t)b * NCHUNK + n) * 4 + h) * 2 + d;
        unsigned char* out = F.ws + WS_DNP + prob * 32768;
        if (ln == 0 && mt == 0) ((float*)(F.ws + WS_DNG))[prob] = __expf(glast);
        const float gq = __expf(Gd[16 * mt + r]);
#pragma unroll
        for (int ks = 0; ks < 2; ++ks) {
            const f32x4 y0 = mm_img(WT, Aq, 32 * ks, 16 * mt, r, q), y1 = mm_img(WT, Aq, 32 * ks + 16, 16 * mt, r, q);
            const LAS bf16* qp = QcB + (16 * mt + r) * RS + 32 * ks + 4 * q; const v2u qa = *(const LAS v2u*)qp, qb = *(const LAS v2u*)(qp + 16);
            v4u o; o.x = cvtpk_c(gq * bf_lo(qa.x) - y0[0], gq * bf_hi(qa.x) - y0[1]); o.y = cvtpk_c(gq * bf_lo(qa.y) - y0[2], gq * bf_hi(qa.y) - y0[3]);
            o.z = cvtpk_c(gq * bf_lo(qb.x) - y1[0], gq * bf_hi(qb.x) - y1[1]); o.w = cvtpk_c(gq * bf_lo(qb.y) - y1[2], gq * bf_hi(qb.y) - y1[3]);
            *(v4u*)(out + (mt * 2 + ks) * 1024 + ln * 16) = o;
            const f32x4 c0 = mm_img(WT, KsT, 32 * ks, 16 * mt, r, q), c1 = mm_img(WT, KsT, 32 * ks + 16, 16 * mt, r, q);
            v4u oc; oc.x = cvtpk_c(-c0[0], -c0[1]); oc.y = cvtpk_c(-c0[2], -c0[3]); oc.z = cvtpk_c(-c1[0], -c1[1]); oc.w = cvtpk_c(-c1[2], -c1[3]);
            *(v4u*)(out + 8192 + (mt * 2 + ks) * 1024 + ln * 16) = oc; }
#pragma unroll
        for (int nt = 0; nt < 4; ++nt) { const f32x4 rr = mm_img(Aq, UT, 16 * mt, 16 * nt, r, q), bb = mm_img(KsT, UT, 16 * mt, 16 * nt, r, q);
            v2u o; o.x = cvtpk_c(rr[0], rr[1]); o.y = cvtpk_c(rr[2], rr[3]); *(v2u*)(out + 16384 + (mt * 4 + nt) * 512 + ln * 8) = o;
            v2u ob; ob.x = cvtpk_c(bb[0], bb[1]); ob.y = cvtpk_c(bb[2], bb[3]); *(v2u*)(out + 24576 + (mt * 4 + nt) * 512 + ln * 8) = ob; }
    }
    __syncthreads();
#ifdef DBG_DN
    { unsigned char* out = F.ws + WS_DNP + ((((size_t)b * NCHUNK + n) * 4 + h) * 2) * 32768;
      if (DBG_DN < 14) { const LAS bf16* im = (const LAS bf16*)(F.lds + DBG_DN * IMG);
          for (int e = tid; e < 4096; e += NTHR) ((bf16*)out)[e] = im[(e >> 6) * RS + (e & 63)]; }
      else { for (int e = tid; e < 2304; e += NTHR) ((bf16*)out)[e] = (bf16)f2bf(Gs[e]); for (int e = 2304 + tid; e < 4096; e += NTHR) ((bf16*)out)[e] = 0; } }
    __syncthreads();
#endif
#undef DIMG
}

__device__ __forceinline__ void pool_unit(Frame& F, const Args& A, int l, int blk, int g) {
    LAS float* Uw = (LAS float*)F.lds;
    LAS float* Mm = Uw + 80 * DP;
    LAS float* PW = Mm + 64 * DP;
    const bf16* P = (const bf16*)(F.ws + WS_PROJ); bf16* MIX = (bf16*)(F.ws + WS_MIX);
    int tid = threadIdx.x; asm volatile("" : "+v"(tid));
    const int row0 = blk * 64, b = row0 / RPB, j0 = row0 - b * RPB; const bool isctx = j0 < CTXL;
    const int seq_lo = isctx ? b * RPB : b * RPB + CTXL, L = isctx ? CTXL : SEQ; const int pos0 = row0 - seq_lo;
    for (int idx = tid; idx < 640; idx += NTHR) { const int rr = idx >> 3, c8 = (idx & 7) * 8; const int pos = pos0 - 8 + rr;
        float v[8] = {0, 0, 0, 0, 0, 0, 0, 0};
        if (pos >= 0 && pos < L) { const v4u x = *(const v4u*)(P + (size_t)(seq_lo + pos) * NPROJ + PC_POOL + g * 64 + c8);
            v[0] = bf_lo(x.x); v[1] = bf_hi(x.x); v[2] = bf_lo(x.y); v[3] = bf_hi(x.y); v[4] = bf_lo(x.z); v[5] = bf_hi(x.z); v[6] = bf_lo(x.w); v[7] = bf_hi(x.w); }
#pragma unroll
        for (int i = 0; i < 8; ++i) Uw[rr * DP + c8 + i] = v[i]; }
    { const float* pw = A.in[F.zz + 15] + ((size_t)l * 4 + g) * 4096;
#pragma unroll
      for (int k = 0; k < 8; ++k) { const int e = tid + 512 * k; PW[(e >> 6) * DP + (e & 63)] = pw[e]; } }
    __syncthreads();
    const int win = 2 << g;
#pragma unroll 1
    for (int k = 0; k < 8; ++k) { const int e = tid + 512 * k, t = e >> 6, i = e & 63; const int pos = pos0 + t;
        int lo = pos - win / 2, hi = lo + win; lo = lo < 0 ? 0 : lo; hi = hi > L ? L : hi;
        float s = 0.f;
#pragma unroll 4
        for (int p = lo; p < hi; ++p) s += Uw[(p - pos0 + 8) * DP + i];
        Mm[t * DP + i] = s / (float)(hi - lo) - Uw[(t + 8) * DP + i]; }
    __syncthreads();
    const float* psc = A.in[F.zz + 16] + l * 256 + g * 64;
    { const int wv = tid >> 6, ln = tid & 63, r = ln & 15, q = ln >> 4;
#pragma unroll
      for (int i = 0; i < 2; ++i) { const int tile = wv * 2 + i, m0 = (tile >> 2) * 16, n0 = (tile & 3) * 16;
          const f32x4 y = mm_tile(Mm, DP, 1, PW, DP, 1, m0, n0, ln); const float sc = psc[n0 + r];
#pragma unroll
          for (int gg = 0; gg < 4; ++gg) MIX[(size_t)(row0 + m0 + 4 * q + gg) * DM + 768 + g * 64 + n0 + r] = (bf16)f2bf(y[gg] * sc); } }
    __syncthreads();
}

constexpr int SC_SLOT = 32768, SC_NSLOT = 4, SC_ST = SC_SLOT * SC_NSLOT, SC_GL = SC_ST + 2 * 8192;
__device__ __forceinline__ void dn_scan_item(Frame& F, int item) {
    typedef short s16x8v __attribute__((ext_vector_type(8)));
    const int d = item & 1, h = (item >> 1) & 3, b = item >> 3;
    int tid = threadIdx.x; asm volatile("" : "+v"(tid));
    const int wv = __builtin_amdgcn_readfirstlane(tid >> 6), ln = tid & 63, r = ln & 15, q = ln >> 4;
    LAS unsigned char* L = F.lds;
    LAS float* glv = (LAS float*)(L + SC_GL);
    const unsigned char* dnp = F.ws + WS_DNP;
#define SC_N(st) (d == 0 ? (st) : ((st) < 4 ? 3 - (st) : 71 - (st)))
#define SC_PROB(st) ((((size_t)b * NCHUNK + SC_N(st)) * 4 + h) * 2 + d)
    if (tid < NCHUNK) glv[tid] = ((const float*)(F.ws + WS_DNG))[SC_PROB(tid)];
    for (int e = tid; e < 2 * 8192 / 16; e += NTHR) ((LAS v4u*)(L + SC_ST))[e] = (v4u){0u, 0u, 0u, 0u};
    asm volatile("s_waitcnt vmcnt(0) lgkmcnt(0)" ::: "memory"); __builtin_amdgcn_s_barrier();
#define SC_DMA(st, slot) do { const unsigned char* src_ = dnp + SC_PROB(st) * 32768 + wv * 8192 + ln * 16; \
        _Pragma("unroll") for (int i_ = 0; i_ < 8; ++i_) __builtin_amdgcn_global_load_lds((const unsigned*)(src_ + i_ * 1024), (LAS unsigned*)(L + (slot) * SC_SLOT + wv * 8192 + i_ * 1024), 16, 0, 0); } while (0)
    if (wv < 4) { SC_DMA(0, 0); SC_DMA(1, 1); SC_DMA(2, 2); }
    f32x4 s0 = {0.f, 0.f, 0.f, 0.f}, s1 = s0, s2 = s0, s3 = s0;
    bf16* DNO = (bf16*)(F.ws + WS_DNO) + (size_t)d * MROWS * 256;
#pragma unroll 1
    for (int st = 0; st < NCHUNK; ++st) {
        if (wv < 4) asm volatile("s_waitcnt vmcnt(16)" ::: "memory");
        asm volatile("s_waitcnt lgkmcnt(0)" ::: "memory"); __builtin_amdgcn_s_barrier();
        if (wv < 4) { const int nx = st + 3 < NCHUNK ? st + 3 : NCHUNK - 1; SC_DMA(nx, (st + 3) & 3); }
        const LAS unsigned char* slot = L + (st & 3) * SC_SLOT;
        const LAS unsigned char* stc = L + SC_ST + (st & 1) * 8192; LAS unsigned char* stn = L + SC_ST + ((st + 1) & 1) * 8192;
        const int nt = wv & 3;
        const s16x8v bf0 = *(const LAS s16x8v*)(stc + (nt * 2 + 0) * 1024 + ln * 16), bf1 = *(const LAS s16x8v*)(stc + (nt * 2 + 1) * 1024 + ln * 16);
        if (wv < 4) {
            const float gl = glv[st];
            const LAS unsigned char* cf = slot + 8192; const LAS unsigned char* bi = slot + 24576;
#define SC_ST_TILE(S, mt) do { const v2u bw_ = *(const LAS v2u*)(bi + ((mt) * 4 + nt) * 512 + ln * 8); \
            f32x4 a_ = {gl * S[0] + bf_lo(bw_.x), gl * S[1] + bf_hi(bw_.x), gl * S[2] + bf_lo(bw_.y), gl * S[3] + bf_hi(bw_.y)}; \
            a_ = __builtin_amdgcn_mfma_f32_16x16x32_bf16(*(const LAS s16x8v*)(cf + ((mt) * 2 + 0) * 1024 + ln * 16), bf0, a_, 0, 0, 0); \
            a_ = __builtin_amdgcn_mfma_f32_16x16x32_bf16(*(const LAS s16x8v*)(cf + ((mt) * 2 + 1) * 1024 + ln * 16), bf1, a_, 0, 0, 0); S = a_; } while (0)
            SC_ST_TILE(s0, 0); SC_ST_TILE(s1, 1); SC_ST_TILE(s2, 2); SC_ST_TILE(s3, 3);
#undef SC_ST_TILE
            v4u w0, w1; w0.x = pk2(s0[0], s0[1]); w0.y = pk2(s0[2], s0[3]); w0.z = pk2(s1[0], s1[1]); w0.w = pk2(s1[2], s1[3]);
            w1.x = pk2(s2[0], s2[1]); w1.y = pk2(s2[2], s2[3]); w1.z = pk2(s3[0], s3[1]); w1.w = pk2(s3[2], s3[3]);
            *(LAS v4u*)(stn + (nt * 2 + 0) * 1024 + ln * 16) = w0; *(LAS v4u*)(stn + (nt * 2 + 1) * 1024 + ln * 16) = w1;
        } else {
            const LAS unsigned char* pf = slot; const LAS unsigned char* ri = slot + 16384;
            const int n = SC_N(st);
            bf16* orow = DNO + (size_t)(b * RPB + n * 64 + 4 * q) * 256 + h * 64 + nt * 16 + r;
#pragma unroll
            for (int mt = 0; mt < 4; ++mt) { const v2u rw_ = *(const LAS v2u*)(ri + (mt * 4 + nt) * 512 + ln * 8);
                f32x4 a_ = {bf_lo(rw_.x), bf_hi(rw_.x), bf_lo(rw_.y), bf_hi(rw_.y)};
                a_ = __builtin_amdgcn_mfma_f32_16x16x32_bf16(*(const LAS s16x8v*)(pf + (mt * 2 + 0) * 1024 + ln * 16), bf0, a_, 0, 0, 0);
                a_ = __builtin_amdgcn_mfma_f32_16x16x32_bf16(*(const LAS s16x8v*)(pf + (mt * 2 + 1) * 1024 + ln * 16), bf1, a_, 0, 0, 0);
#pragma unroll
                for (int g = 0; g < 4; ++g) orow[(size_t)(16 * mt + g) * 256] = (bf16)f2bf(a_[g]); }
        }
    }
    asm volatile("s_waitcnt vmcnt(0) lgkmcnt(0)" ::: "memory"); __builtin_amdgcn_s_barrier();
#undef SC_DMA
#undef SC_N
#undef SC_PROB
}

__device__ __forceinline__ void mix_build(Frame& F, const Args& A, int l) {
    int lane = threadIdx.x & 63; asm volatile("" : "+v"(lane)); const int gw = F.vcu * NWAVES + F.wave, NGW = F.G * NWAVES;
    const bf16* ATTO = (const bf16*)(F.ws + WS_ATTO); const bf16* P = (const bf16*)(F.ws + WS_PROJ); const bf16* DNO = (const bf16*)(F.ws + WS_DNO); bf16* MIX = (bf16*)(F.ws + WS_MIX);
    const float lam = ((const float*)(F.ws + WS_LAM))[l]; const float li = 0.8f - 0.6f * expf(-0.3f * (float)l);
    const float* sg = A.in[F.zz + 10] + l * 128; const float* ng = A.in[F.zz + 14] + l * 64;
    for (int R = gw; R < MROWS; R += NGW) {
        const int j = R % RPB; if (l == 1 && j < CTXL) continue;
        { const int hh = lane >> 4, e0 = (lane & 15) * 8;
          const v4u a = *(const v4u*)(ATTO + (size_t)R * DM + (hh * 2) * 128 + e0), c = *(const v4u*)(ATTO + (size_t)R * DM + (hh * 2 + 1) * 128 + e0);
          float x[8] = {bf_lo(a.x) - lam * bf_lo(c.x), bf_hi(a.x) - lam * bf_hi(c.x), bf_lo(a.y) - lam * bf_lo(c.y), bf_hi(a.y) - lam * bf_hi(c.y),
                        bf_lo(a.z) - lam * bf_lo(c.z), bf_hi(a.z) - lam * bf_hi(c.z), bf_lo(a.w) - lam * bf_lo(c.w), bf_hi(a.w) - lam * bf_hi(c.w)};
          float ss = 0.f;
#pragma unroll
          for (int i = 0; i < 8; ++i) ss += x[i] * x[i];
          ss += __shfl_xor(ss, 1); ss += __shfl_xor(ss, 2); ss += __shfl_xor(ss, 4); ss += __shfl_xor(ss, 8);
          const float sc = (1.f / sqrtf(ss * (1.f / 128.f) + EPSN)) * (1.f - li);
          const f32x4 g0 = *(const f32x4*)(sg + e0), g1 = *(const f32x4*)(sg + e0 + 4);
          v4u o; o.x = pk2(x[0] * sc * g0[0], x[1] * sc * g0[1]); o.y = pk2(x[2] * sc * g0[2], x[3] * sc * g0[3]); o.z = pk2(x[4] * sc * g1[0], x[5] * sc * g1[1]); o.w = pk2(x[6] * sc * g1[2], x[7] * sc * g1[3]);
          *(v4u*)(MIX + (size_t)R * DM + hh * 128 + e0) = o; }
        { const int c0 = lane * 4;
          const v2u a = *(const v2u*)(DNO + (size_t)R * 256 + c0), c = *(const v2u*)(DNO + ((size_t)MROWS + R) * 256 + c0), z = *(const v2u*)(P + (size_t)R * NPROJ + PC_DZ + c0);
          float x[4] = {bf_lo(a.x) + bf_lo(c.x), bf_hi(a.x) + bf_hi(c.x), bf_lo(a.y) + bf_lo(c.y), bf_hi(a.y) + bf_hi(c.y)};
          float ss = x[0] * x[0] + x[1] * x[1] + x[2] * x[2] + x[3] * x[3];
          ss += __shfl_xor(ss, 1); ss += __shfl_xor(ss, 2); ss += __shfl_xor(ss, 4); ss += __shfl_xor(ss, 8);
          const float sc = 1.f / sqrtf(ss * (1.f / 64.f) + EPSN);
          const f32x4 gg = *(const f32x4*)(ng + (c0 & 63));
          v2u o; o.x = pk2(x[0] * sc * gg[0] * siluf_(bf_lo(z.x)), x[1] * sc * gg[1] * siluf_(bf_hi(z.x))); o.y = pk2(x[2] * sc * gg[2] * siluf_(bf_lo(z.y)), x[3] * sc * gg[3] * siluf_(bf_hi(z.y)));
          *(v2u*)(MIX + (size_t)R * DM + 512 + c0) = o; }
    }
}

#ifndef MK_N_LAUNCHES
#define MK_N_LAUNCHES 1
#endif
__global__ void __launch_bounds__(NTHR, 2) mk_fwd(Args args) {
    extern __shared__ __attribute__((aligned(16))) unsigned char lds[];
    Frame F;
    F.lds = (LAS unsigned char*)lds;
    F.MISC = (volatile LAS unsigned*)(F.lds + MISC_OFF);
    F.tid = threadIdx.x; F.lane = F.tid & 63; F.wave = __builtin_amdgcn_readfirstlane(F.tid >> 6);
    F.G = gridDim.x; { const int bx = blockIdx.x; F.vcu = (F.G % 8 == 0) ? (bx % 8) * (F.G / 8) + bx / 8 : bx; }
    F.ws = args.ws; F.out = args.out; F.zz = 0;
    F.ctl = (gu32*)(args.ws + WS_CTL);
    for (int u = F.tid; u < (LDS_BYTES - MISC_OFF) / 4; u += NTHR) ((LAS unsigned*)(F.lds + MISC_OFF))[u] = 0u;
    __syncthreads();
    const int lo = args.ph_lo, hi = args.ph_hi;
    const bool use_bar = (hi - lo) > 1;
    XcdBarrier bar; bar.bar = (unsigned*)(F.ctl + CW_BAR); bar.x = 0; bar.st = nullptr;
    if (use_bar) bar = xcd_barrier_post((unsigned*)(F.ctl + CW_BAR), F.MISC + 8);
#ifndef EN_MASK
#define EN_MASK 0xFFFFFFFFu
#endif
#define IN(k) (((EN_MASK >> ((k) > 12 ? (k) - 12 : (k))) & 1u) && lo <= (k) && (k) < hi)
#define PB() do { int z_ = 0; asm volatile("" : "+s"(z_)); F.ws = args.ws + z_; F.ctl = (gu32*)(args.ws + z_); F.zz = z_; int t_ = threadIdx.x; asm volatile("" : "+v"(t_)); F.tid = t_; F.lane = t_ & 63; F.wave = __builtin_amdgcn_readfirstlane(t_ >> 6); } while (0)
#ifdef DBG_DUP
#define NREP(k) ((((k) > 12 && (k) < 23) ? (k) - 12 : (k)) == DBG_DUP ? 2 : 1)
#else
#define NREP(k) 1
#endif
#define SEAMX() do { XcdBarrier bl_ = bar; { int z_ = 0; unsigned x_ = bar.x; asm volatile("" : "+s"(z_), "+s"(x_)); bl_.bar = (unsigned*)(args.ws + WS_CTL) + CW_BAR + z_; bl_.x = x_; } xcd_barrier(bl_); } while (0)
#define PH_BEGIN(k) if (IN(k)) { for (int rep_ = 0; rep_ < NREP(k); ++rep_) { if (rep_) SEAMX(); PB();
#define PH_END(k) } } SEAM(k);
#define SEAM(k) do { if (IN(k) && IN((k) + 1)) { XcdBarrier bl_ = bar; { int z_ = 0; unsigned x_ = bar.x; asm volatile("" : "+s"(z_), "+s"(x_)); bl_.bar = (unsigned*)(args.ws + WS_CTL) + CW_BAR + z_; bl_.x = x_; } xcd_barrier(bl_); } } while (0)
    char* ldsg = (char*)lds;

    PH_BEGIN(PH_PRO) p0_prologue(F, args); PH_END(PH_PRO)

#pragma unroll 1
    for (int l = 0; l < 2; ++l) {
        const int pb = 1 + 12 * l;
        const float* modl = (const float*)(F.ws + WS_MOD) + l * 5 * 6144;
        PH_BEGIN(pb + PH_N1) norm_mod_phase(F, args, l, 0, false, false); PH_END(pb + PH_N1)
        PH_BEGIN(pb + PH_PROJ)
            pg8::Gemm g{(const bf16*)(F.ws + WS_U), (const bf16*)(F.ws + WS_WIN) + (size_t)l * NPROJ * 1024, 1024, 1024, 1024};
            TileOrder S; S.init(MROWS / 256, NPROJ / 256, F.G, (int)blockIdx.x, 0);
            EpiProj E{(bf16*)(F.ws + WS_PROJ), (float*)(F.ws + WS_GB), (const float*)(F.ws + WS_ROPE), args.in[F.zz + 12] + l * 8, args.in[F.zz + 13] + l * 8};
            pg8::gemm_phase<EpiProj, TileOrder, true, true>(F.lds, g, S, E);
        PH_END(pb + PH_PROJ)
        PH_BEGIN(pb + PH_ATT)
            const bf16* P = (const bf16*)(F.ws + WS_PROJ); bf16* AO = (bf16*)(F.ws + WS_ATTO);
            const int nunits = 512 + (l == 0 ? 32 : 0);
#ifndef DIS_ATTN
#ifdef DBG_DUP
            for (int r2_ = 0; r2_ < (DBG_DUP == 31 ? 2 : 1); ++r2_)
#endif
#pragma unroll 1
            for (int u = F.vcu; u < nunits; u += F.G) {
                int b, hm, qrow, seq;
                if (u < 512) { b = u >> 7; hm = (u >> 4) & 7; qrow = CTXL + (u & 15) * 256; seq = RPB; }
                else { const int v = u - 512; b = v >> 3; hm = v & 7; qrow = 0; seq = CTXL; }
                const size_t r0 = (size_t)b * RPB;
                attn::attn_unit<NPROJ, DM>(P + (r0 + qrow) * NPROJ + PC_AQ + hm * 64, P + r0 * NPROJ + PC_AK + hm * 64, P + r0 * NPROJ + PC_AV + (hm >> 1) * 128,
                                           AO + (r0 + qrow) * DM + hm * 128, seq, ldsg);
            }
#endif
#ifndef DIS_DNPRE
#ifdef DBG_DUP
            for (int r2_ = 0; r2_ < (DBG_DUP == 32 ? 2 : 1); ++r2_)
#endif
#pragma unroll 1
            for (int u = F.vcu; u < NB * NCHUNK * 4; u += F.G) { const int h = u & 3, n = (u >> 2) % NCHUNK, b = (u >> 2) / NCHUNK; dn_pre_unit(F, args, l, b, n, h); }
#endif
        PH_END(pb + PH_ATT)
        PH_BEGIN(pb + PH_SCAN)
#pragma unroll 1
            for (int it = F.vcu; it < 32; it += F.G) dn_scan_item(F, it);
            if (F.G > 32) { if (F.vcu >= 32) {
#pragma unroll 1
                for (int u = F.vcu - 32; u < (MROWS / 64) * 4; u += F.G - 32) pool_unit(F, args, l, u >> 2, u & 3); } }
            else {
#pragma unroll 1
                for (int u = F.vcu; u < (MROWS / 64) * 4; u += F.G) pool_unit(F, args, l, u >> 2, u & 3); }
        PH_END(pb + PH_SCAN)
        PH_BEGIN(pb + PH_MIXB) mix_build(F, args, l); PH_END(pb + PH_MIXB)
#pragma unroll 1
        for (int s = 0; s < 3; ++s) {
            if (IN(pb + PH_MRG0 + s)) { PB();
                const int koff = s == 0 ? 0 : (s == 1 ? 512 : 768), ks = s == 0 ? 512 : 256;
                pg8::Gemm g{(const bf16*)(F.ws + WS_MIX) + koff, (const bf16*)(F.ws + WS_WBR) + (size_t)l * 1024 * 1024 + (size_t)1024 * koff, ks, 1024, ks};
                TileOrder S; S.init(l == 0 ? 68 : 64, 4, F.G, (int)blockIdx.x, l);
                EpiMerge E{(bf16*)(F.ws + WS_MG), (const bf16*)(F.ws + WS_PROJ), PC_GATE + s * 1024, s == 0};
                pg8::gemm_phase<EpiMerge, TileOrder, true, true>(F.lds, g, S, E);
            }
            if (s < 2) { if (IN(pb + PH_MRG0 + s)) { PB(); VM_WAIT(); __syncthreads(); } } else SEAM(pb + PH_MRG2);
        }
        if (IN(pb + PH_OUT)) { PB();
            pg8::Gemm g{(const bf16*)(F.ws + WS_MG), (const bf16*)(F.ws + WS_WOUT) + (size_t)l * 1024 * 1024, 1024, 1024, 1024};
            TileOrder S; S.init(l == 0 ? 68 : 64, 4, F.G, (int)blockIdx.x, l);
            EpiResid E{(float*)(F.ws + WS_H), modl, 2};
            pg8::gemm_phase<EpiResid, TileOrder, true, true>(F.lds, g, S, E);
        } SEAM(pb + PH_OUT);
        PH_BEGIN(pb + PH_N2) norm_mod_phase(F, args, l, 1, l == 1, l == 1); PH_END(pb + PH_N2)
        if (l == 0) {
            PH_BEGIN(PH_FUP)
                pg8::Gemm g{(const bf16*)(F.ws + WS_U), (const bf16*)(F.ws + WS_W13), 1024, 1024, 1024};
                TileOrder S; S.init(68, 2 * FFD / 256, F.G, (int)blockIdx.x, 0);
                EpiSwiglu E{(bf16*)(F.ws + WS_HID), FFD};
                pg8::gemm_phase<EpiSwiglu, TileOrder, true, true>(F.lds, g, S, E);
            PH_END(PH_FUP)
            if (IN(PH_FDN)) { PB();
                pg8::Gemm g{(const bf16*)(F.ws + WS_HID), (const bf16*)(F.ws + WS_W2), FFD, FFD, FFD};
                TileOrder S; S.init(68, 4, F.G, (int)blockIdx.x, 0);
                EpiResid E{(float*)(F.ws + WS_H), modl, 5};
                pg8::gemm_phase<EpiResid, TileOrder, true, true>(F.lds, g, S, E);
            } SEAM(PH_FDN);
        }
    }
    PH_BEGIN(PH_GATH) moe_gather(F); PH_END(PH_GATH)
#pragma unroll 1
    for (int hh = 0; hh < 2; ++hh) {
        const int p0 = PH_CV0 + 3 * hh;
        PH_BEGIN(p0)
#ifdef DBG_DETPOS
            if (hh == 0) moe_gather2(F);
#endif
            moe_convert(F, args, hh); PH_END(p0)
        PH_BEGIN(p0 + 1)
            pg8::Gemm g{(const bf16*)(F.ws + WS_XG), (const bf16*)(F.ws + WS_W13M), 1024, 1024, 1024};
            MoeOrder S; S.init(F.ctl + CW_ECNT, FFE / 256, F.G, F.vcu);
            EpiSwiglu E{(bf16*)(F.ws + WS_HIDM), FFEH};
            pg8::gemm_phase<EpiSwiglu, MoeOrder, true, true>(F.lds, g, S, E);
        PH_END(p0 + 1)
        if (IN(p0 + 2)) { PB();
            pg8::Gemm g{(const bf16*)(F.ws + WS_HIDM), (const bf16*)(F.ws + WS_W2M), FFEH, FFEH, FFEH};
            MoeOrder S; S.init(F.ctl + CW_ECNT, 4, F.G, F.vcu);
            EpiY E{(bf16*)(F.ws + WS_Y), hh == 0};
            pg8::gemm_phase<EpiY, MoeOrder, true, true>(F.lds, g, S, E);
        } SEAM(p0 + 2);
    }
    PH_BEGIN(PH_FIN) final_phase(F, args); } }
#ifdef DBG_STOP
    if (lo == 100) {
        const int gw = F.vcu * NWAVES + F.wave, NGW = F.G * NWAVES;
        for (int tk = gw; tk < NB * SEQ; tk += NGW) { const int b = tk / SEQ, t = tk - b * SEQ; const size_t R = (size_t)b * RPB + CTXL + t;
#if DBG_SRC == 0
            const f32x4* s = (const f32x4*)((const float*)(args.ws + WS_H) + R * DM) + F.lane; f32x4* d = (f32x4*)(args.out + (size_t)tk * DM) + F.lane;
            for (int q = 0; q < 4; ++q) d[64 * q] = s[64 * q];
#elif DBG_SRC == 2
            MoeOrder mo; mo.init((gu32*)args.ws + CW_ECNT, 1, 1, 0); const v4u rt = ((const v4u*)(args.ws + WS_ROUTE))[2 * tk];
            const size_t rr = (size_t)mo.tile_off((int)rt.x) * 256 + rt.z; (void)R;
            const bf16* s = (const bf16*)(args.ws + DBG_OFF) + rr * DBG_LD + DBG_COL; float* d = args.out + (size_t)tk * DM;
            for (int q = 0; q < 16; ++q) d[F.lane + 64 * q] = bf2f(s[F.lane + 64 * q]);
#else
#ifdef DBG_MOD
            const bf16* s = (const bf16*)(args.ws + DBG_OFF) + (R % DBG_MOD) * DBG_LD + DBG_COL; float* d = args.out + (size_t)tk * DM;
#else
            const bf16* s = (const bf16*)(args.ws + DBG_OFF) + R * DBG_LD + DBG_COL; float* d = args.out + (size_t)tk * DM;
#endif
            for (int q = 0; q < 16; ++q) { float v = bf2f(s[F.lane + 64 * q]); d[F.lane + 64 * q] = (v == v && fabsf(v) < 1e30f) ? v : DBG_NANVAL; }
#endif
        }
    }
#endif
#undef IN
#undef SEAM
}

extern "C" void kernel_launch(void* const* d_in, const int* in_sizes, int n_in, void* d_out, int out_size, void* d_ws, size_t ws_size, hipStream_t stream) {
    static int grid = 0;
    if (grid == 0) {
        if (n_in != 27 || in_sizes[0] != NB * SEQ * DM || out_size != NB * SEQ * DM || ws_size < WS_END) {
            fprintf(stderr, "kernel_launch: shape / workspace mismatch (n_in %d, in0 %d, out %d, ws %zu, need %zu); nothing launched\n", n_in, n_in > 0 ? in_sizes[0] : -1, out_size, ws_size, (size_t)WS_END); grid = -1; return; }
        int dev = 0, cus = 0, per_cu = 0;
        if (hipGetDevice(&dev) != hipSuccess || hipDeviceGetAttribute(&cus, hipDeviceAttributeMultiprocessorCount, dev) != hipSuccess) { grid = -1; return; }
        if (hipFuncSetAttribute((const void*)mk_fwd, hipFuncAttributeMaxDynamicSharedMemorySize, LDS_BYTES) != hipSuccess) { fprintf(stderr, "kernel_launch: hipFuncSetAttribute failed\n"); grid = -1; return; }
        if (hipOccupancyMaxActiveBlocksPerMultiprocessor(&per_cu, (const void*)mk_fwd, NTHR, LDS_BYTES) != hipSuccess || per_cu < 1)
            fprintf(stderr, "kernel_launch: note: occupancy query reports %d workgroups per CU\n", per_cu);
        (void)hipGetLastError();
        grid = cus;
    }
    if (grid < 0) return;
    if (hipMemsetAsync((char*)d_ws + WS_CTL, 0, CTL_ZERO_BYTES, stream) != hipSuccess) return;
    Args a{};
    for (int i = 0; i < 27; ++i) a.in[i] = (const float*)d_in[i];
    a.out = (float*)d_out; a.ws = (unsigned char*)d_ws;
    constexpr int NL = MK_N_LAUNCHES;
#ifdef DBG_STOP
    constexpr int NLL = DBG_STOP + 2;
#else
    constexpr int NLL = NL;
#endif
    for (int li = 0; li < NLL; ++li) {
#ifdef DBG_SKIP_LO
        if (li >= DBG_SKIP_LO && li <= DBG_SKIP_HI) continue;
#endif
        a.ph_lo = (NL == 1) ? 0 : li; a.ph_hi = (NL == 1) ? PH_COUNT : li + 1;
#ifdef DBG_STOP
        a.ph_lo = li; a.ph_hi = li + 1;
        if (li == NLL - 1) { a.ph_lo = 100; a.ph_hi = 101; }
#endif
        hipLaunchKernelGGL(mk_fwd, dim3(grid), dim3(NTHR), LDS_BYTES, stream, a);
        const hipError_t le = hipPeekAtLastError();
        if (le != hipSuccess) { fprintf(stderr, "kernel_launch: launch %d failed: %s\n", li, hipGetErrorName(le)); break; }
    }
}
```

```cpp
#include <hip/hip_runtime.h>
#include <cstdio>
#include <cstdint>
#include <cmath>

namespace pg8 {
#define PG8_LAS __attribute__((address_space(3)))
typedef unsigned short bf16_t;
typedef short bf16x8 __attribute__((ext_vector_type(8)));
typedef float f32x4 __attribute__((ext_vector_type(4)));
typedef unsigned u32x4 __attribute__((ext_vector_type(4)));
typedef unsigned u32x2 __attribute__((ext_vector_type(2)));
constexpr int BM = 256, BK = 64, HALF = 128, HTB = HALF * BK * 2  , STAGE_BYTES = 8 * HTB;

__host__ __device__ __forceinline__ int lds_byte(int r, int c) { const int st = (r >> 4) * 2 + (c >> 5), rr = r & 15, cc = c & 31, ob = rr * 64 + cc * 2; return st * 1024 + (ob ^ (((ob >> 9) & 1) << 5)); }
__host__ __device__ __forceinline__ void stage_rc(int b, int& R, int& C) { const int st = b / 1024, sb = b % 1024, swz = sb ^ (((sb >> 9) & 1) << 5); R = (st >> 1) * 16 + swz / 64; C = (st & 1) * 32 + (swz % 64) / 2; }
__host__ __device__ __forceinline__ int perm32(int rho) { const int n = rho >> 4, i = rho & 15; return 8 * (i >> 2) + 4 * n + (i & 3); }

struct Unit { int pm, pn, pb; };
struct Gemm { const bf16_t* A; const bf16_t* Bt; int K, lda, ldb, sA, sB; };

__device__ __forceinline__ unsigned cvt_pk_bf16(float lo, float hi) { unsigned r; asm volatile("v_cvt_pk_bf16_f32 %0, %1, %2" : "=v"(r) : "v"(lo), "v"(hi)); return r; }
template <class Epi, class Sched, bool ALIGN_EPI = false, bool SP2 = false>
__device__ __forceinline__ void gemm_phase(PG8_LAS unsigned char* lds, const Gemm g, const Sched& S, const Epi& E) {
    int tid = threadIdx.x; asm volatile("" : "+v"(tid)); const int wid = __builtin_amdgcn_readfirstlane(tid >> 6), lane = tid & 63, wr = wid >> 2, wc = wid & 3, fr = lane & 15, fq = lane >> 4;
    const int K = g.K, nt = K / BK;
    unsigned voffA[2], voffB[2];
#pragma unroll
    for (int i = 0; i < 2; ++i) { int R, C; stage_rc(tid * 16 + i * 8192, R, C); const int Rb = Epi::PERM ? ((R & ~31) + perm32(R & 31)) : R;
        voffA[i] = (unsigned)(R * g.lda + C) * 2u; voffB[i] = (unsigned)(Rb * g.ldb + C) * 2u; }
    const size_t kstep = (size_t)(BK * 2);
    const size_t hstepA = (size_t)HALF * g.lda * 2, hstepB = (size_t)HALF * g.ldb * 2;
    const size_t tstepA = 2 * hstepA, tstepB = 2 * hstepB;
    const unsigned ldsw = (unsigned)wid * 1024u;
    const int aoff = lds_byte(wr * 64 + fr, fq * 8), boff = lds_byte(wc * 32 + fr, fq * 8);
#define PG8_SA(b, h) (((b) * 2 + (h)) * HTB)
#define PG8_SB(b, h) ((4 + (b) * 2 + (h)) * HTB)
#define PG8_STAGE(bufoff, gbase, voff) do { _Pragma("unroll") for (int _i = 0; _i < 2; ++_i) \
        __builtin_amdgcn_global_load_lds((const unsigned*)((const char*)(gbase) + (voff)[_i]), (PG8_LAS unsigned*)(lds + (bufoff) + ldsw + _i * 8192), 16, 0, 0); } while (0)
#define PG8_LDA(dst, b, h) do { _Pragma("unroll") for (int m = 0; m < 4; ++m) _Pragma("unroll") for (int k = 0; k < 2; ++k) dst[m][k] = *(const PG8_LAS bf16x8*)(lds + PG8_SA(b, h) + aoff + m * 2048 + k * 1024); } while (0)
#define PG8_LDB(dst, b, h) do { _Pragma("unroll") for (int n = 0; n < 2; ++n) _Pragma("unroll") for (int k = 0; k < 2; ++k) dst[n][k] = *(const PG8_LAS bf16x8*)(lds + PG8_SB(b, h) + boff + n * 2048 + k * 1024); } while (0)
#define PG8_MMA(ai, bj, At, Bt) do { __builtin_amdgcn_s_setprio(1); _Pragma("unroll") for (int m = 0; m < 4; ++m) _Pragma("unroll") for (int n = 0; n < 2; ++n) _Pragma("unroll") for (int k = 0; k < 2; ++k) \
        acc[ai][bj][m][n] = __builtin_amdgcn_mfma_f32_16x16x32_bf16(Bt[n][k], At[m][k], acc[ai][bj][m][n], 0, 0, 0); __builtin_amdgcn_s_setprio(0); } while (0)
#define PG8_WAIT_V(n) asm volatile("s_waitcnt vmcnt(" #n ")" ::: "memory")
#define PG8_WAIT_L(n) asm volatile("s_waitcnt lgkmcnt(" #n ")" ::: "memory")
#define PG8_BAR __builtin_amdgcn_s_barrier()
#define PG8_SCHED __builtin_amdgcn_sched_barrier(0)
    Unit cur, nxt; int ui = 0;
    if (!S.next(0, cur)) return;
    f32x4 acc[2][2][4][2];
#pragma unroll
    for (int a = 0; a < 2; ++a)
#pragma unroll
        for (int b = 0; b < 2; ++b)
#pragma unroll
            for (int m = 0; m < 4; ++m)
#pragma unroll
                for (int n = 0; n < 2; ++n) acc[a][b][m][n] = (f32x4){0.f, 0.f, 0.f, 0.f};
    bf16x8 At[4][2], B0[2][2], B1[2][2];
    const char* cA = (const char*)g.A + (size_t)cur.pm * tstepA; const char* cB = (const char*)g.Bt + (size_t)cur.pb * tstepB;
    S.a_ready(cur);
    if constexpr (SP2) {
        PG8_STAGE(PG8_SB(0, 0), cB, voffB); PG8_STAGE(PG8_SB(0, 1), cB + hstepB, voffB); PG8_STAGE(PG8_SA(0, 0), cA, voffA); PG8_STAGE(PG8_SA(0, 1), cA + hstepA, voffA);
        if (wr == 1) PG8_BAR;
        PG8_WAIT_V(2); PG8_BAR;
        PG8_STAGE(PG8_SB(1, 0), cB + kstep, voffB); PG8_STAGE(PG8_SA(1, 0), cA + kstep, voffA); PG8_STAGE(PG8_SB(1, 1), cB + hstepB + kstep, voffB);
        PG8_WAIT_V(6); PG8_BAR;
    } else {
        PG8_STAGE(PG8_SB(0, 0), cB, voffB); PG8_STAGE(PG8_SA(0, 0), cA, voffA); PG8_STAGE(PG8_SB(0, 1), cB + hstepB, voffB); PG8_STAGE(PG8_SA(0, 1), cA + hstepA, voffA);
        if (wr == 1) PG8_BAR;
        PG8_WAIT_V(4); PG8_BAR;
        PG8_STAGE(PG8_SB(1, 0), cB + kstep, voffB); PG8_STAGE(PG8_SA(1, 0), cA + kstep, voffA); PG8_STAGE(PG8_SB(1, 1), cB + hstepB + kstep, voffB);
        PG8_WAIT_V(6); PG8_BAR;
    }
    for (;;) {
        const bool has_next = S.next(ui + 1, nxt);
        const char* nA = has_next ? (const char*)g.A + (size_t)nxt.pm * tstepA : cA; const char* nB = has_next ? (const char*)g.Bt + (size_t)nxt.pb * tstepB : cB;
        for (int t = 0; t < nt; t += 2) {
            const bool last = (t == nt - 2);
            const char* a1 = cA + (size_t)(t + 1) * kstep;
            const char* a2 = last ? nA : cA + (size_t)(t + 2) * kstep; const char* b2 = last ? nB : cB + (size_t)(t + 2) * kstep;
            const char* a3 = a2 + kstep; const char* b3 = b2 + kstep;
            if (last && has_next) S.a_ready(nxt);
            if constexpr (SP2) {
            PG8_LDB(B0, 0, 0); PG8_LDB(B1, 0, 1); PG8_SCHED; PG8_LDA(At, 0, 0); PG8_STAGE(PG8_SA(1, 1), a1 + hstepA, voffA);
            PG8_WAIT_V(8); PG8_WAIT_L(0); PG8_BAR; PG8_MMA(0, 0, At, B0); PG8_MMA(0, 1, At, B1); PG8_BAR; PG8_SCHED;
            PG8_LDA(At, 0, 1); PG8_STAGE(PG8_SB(0, 0), b2, voffB); PG8_STAGE(PG8_SB(0, 1), b2 + hstepB, voffB); PG8_STAGE(PG8_SA(0, 0), a2, voffA);
            PG8_WAIT_V(8); PG8_WAIT_L(0); PG8_BAR; PG8_MMA(1, 0, At, B0); PG8_MMA(1, 1, At, B1); PG8_BAR; PG8_SCHED;
            PG8_LDB(B0, 1, 0); PG8_LDB(B1, 1, 1); PG8_SCHED; PG8_LDA(At, 1, 0); PG8_STAGE(PG8_SA(0, 1), a2 + hstepA, voffA);
            PG8_WAIT_V(8); PG8_WAIT_L(0); PG8_BAR; PG8_MMA(0, 0, At, B0); PG8_MMA(0, 1, At, B1); PG8_BAR; PG8_SCHED;
            PG8_LDA(At, 1, 1); PG8_STAGE(PG8_SB(1, 0), b3, voffB); PG8_STAGE(PG8_SB(1, 1), b3 + hstepB, voffB); PG8_STAGE(PG8_SA(1, 0), a3, voffA);
            PG8_WAIT_V(8); PG8_WAIT_L(0); PG8_BAR; PG8_MMA(1, 0, At, B0); PG8_MMA(1, 1, At, B1); PG8_BAR; PG8_SCHED;
            } else {
            PG8_LDB(B0, 0, 0); PG8_SCHED; PG8_LDA(At, 0, 0); PG8_STAGE(PG8_SA(1, 1), a1 + hstepA, voffA);
            PG8_WAIT_L(8); PG8_BAR; PG8_WAIT_L(0); PG8_MMA(0, 0, At, B0); PG8_BAR; PG8_SCHED;
            PG8_LDB(B1, 0, 1); PG8_STAGE(PG8_SB(0, 0), b2, voffB);
            PG8_BAR; PG8_WAIT_L(0); PG8_MMA(0, 1, At, B1); PG8_BAR;
            PG8_LDA(At, 0, 1); PG8_STAGE(PG8_SA(0, 0), a2, voffA);
            PG8_BAR; PG8_WAIT_L(0); PG8_MMA(1, 0, At, B0); PG8_BAR; PG8_SCHED;
            PG8_STAGE(PG8_SB(0, 1), b2 + hstepB, voffB);
            PG8_WAIT_V(6); PG8_BAR; PG8_MMA(1, 1, At, B1); PG8_BAR;
            PG8_LDB(B0, 1, 0); PG8_SCHED; PG8_LDA(At, 1, 0); PG8_STAGE(PG8_SA(0, 1), a2 + hstepA, voffA);
            PG8_WAIT_L(8); PG8_BAR; PG8_WAIT_L(0); PG8_MMA(0, 0, At, B0); PG8_BAR; PG8_SCHED;
            PG8_LDB(B1, 1, 1); PG8_STAGE(PG8_SB(1, 0), b3, voffB);
            PG8_BAR; PG8_WAIT_L(0); PG8_MMA(0, 1, At, B1); PG8_BAR;
            PG8_LDA(At, 1, 1); PG8_STAGE(PG8_SA(1, 0), a3, voffA);
            PG8_BAR; PG8_WAIT_L(0); PG8_MMA(1, 0, At, B0); PG8_BAR; PG8_SCHED;
            PG8_STAGE(PG8_SB(1, 1), b3 + hstepB, voffB);
            PG8_WAIT_V(6); PG8_BAR; PG8_MMA(1, 1, At, B1); PG8_BAR;
            }
        }
        if constexpr (ALIGN_EPI) { if (wr == 0) PG8_BAR; }
        if constexpr (!Epi::AFTER_DRAIN) { E(acc, cur, wr, wc, fr, fq); S.done(cur); }
        if (!has_next) break;
#pragma unroll
        for (int a = 0; a < 2; ++a)
#pragma unroll
            for (int b = 0; b < 2; ++b)
#pragma unroll
                for (int m = 0; m < 4; ++m)
#pragma unroll
                    for (int n = 0; n < 2; ++n) acc[a][b][m][n] = (f32x4){0.f, 0.f, 0.f, 0.f};
        cur = nxt; cA = nA; cB = nB; ++ui;
        if constexpr (ALIGN_EPI) { if (wr == 1) PG8_BAR; }
    }
    PG8_WAIT_V(0);
    if constexpr (!ALIGN_EPI) { if (wr == 0) PG8_BAR; }
    PG8_BAR;
    if constexpr (Epi::AFTER_DRAIN) { E.fused(acc, cur, wr, wc, fr, fq, lds, wid, lane); S.done(cur); }
#undef PG8_SA
#undef PG8_SB
#undef PG8_STAGE
#undef PG8_LDA
#undef PG8_LDB
#undef PG8_MMA
#undef PG8_WAIT_V
#undef PG8_WAIT_L
#undef PG8_BAR
#undef PG8_SCHED
}
template <class Epi, class Sched, bool ALIGN_EPI = false, bool SP2 = false>
__device__ __forceinline__ void gemm_phase8(PG8_LAS unsigned char* lds, const Gemm g, const Sched& S, const Epi& E) {
    int tid = threadIdx.x; asm volatile("" : "+v"(tid)); const int wid = __builtin_amdgcn_readfirstlane(tid >> 6), lane = tid & 63, wr = wid >> 2, wc = wid & 3, fr = lane & 15, fq = lane >> 4;
    const int K = g.K, nt = K / BK;
    unsigned voffA[2], voffB[2];
#pragma unroll
    for (int i = 0; i < 2; ++i) { int R, C; stage_rc(tid * 16 + i * 8192, R, C); const int Rb = Epi::PERM ? ((R & ~31) + perm32(R & 31)) : R;
        voffA[i] = (unsigned)(R * g.lda + C) * 2u; voffB[i] = (unsigned)(Rb * g.ldb + C) * 2u; }
    const size_t kstep = (size_t)(BK * 2);
    const size_t hstepA = (size_t)HALF * g.lda * 2, hstepB = (size_t)HALF * g.ldb * 2;
    const size_t tstepA = 2 * hstepA, tstepB = 2 * hstepB;
    const unsigned ldsw = (unsigned)wid * 1024u;
    const int c8 = (fq >> 1) * 32 + (fq & 1) * 16;
    const int aoff0 = lds_byte(wr * 64 + fr, c8), aoff1 = lds_byte(wr * 64 + fr, c8 + 8), boff0 = lds_byte(wc * 32 + fr, c8), boff1 = lds_byte(wc * 32 + fr, c8 + 8);
#define PG8_SA(b, h) (((b) * 2 + (h)) * HTB)
#define PG8_SB(b, h) ((4 + (b) * 2 + (h)) * HTB)
#define PG8_STAGE(bufoff, gbase, voff) do { _Pragma("unroll") for (int _i = 0; _i < 2; ++_i) \
        __builtin_amdgcn_global_load_lds((const unsigned*)((const char*)(gbase) + (voff)[_i]), (PG8_LAS unsigned*)(lds + (bufoff) + ldsw + _i * 8192), 16, 0, 0); } while (0)
#define PG8_LDA(dst, b, h) do { _Pragma("unroll") for (int m = 0; m < 4; ++m) { const u32x4 lo_ = *(const PG8_LAS u32x4*)(lds + PG8_SA(b, h) + aoff0 + m * 2048), hi_ = *(const PG8_LAS u32x4*)(lds + PG8_SA(b, h) + aoff1 + m * 2048); \
        dst[m] = (i32x8){(int)lo_.x, (int)lo_.y, (int)lo_.z, (int)lo_.w, (int)hi_.x, (int)hi_.y, (int)hi_.z, (int)hi_.w}; } } while (0)
#define PG8_LDB(dst, b, h) do { _Pragma("unroll") for (int n = 0; n < 2; ++n) { const u32x4 lo_ = *(const PG8_LAS u32x4*)(lds + PG8_SB(b, h) + boff0 + n * 2048), hi_ = *(const PG8_LAS u32x4*)(lds + PG8_SB(b, h) + boff1 + n * 2048); \
        dst[n] = (i32x8){(int)lo_.x, (int)lo_.y, (int)lo_.z, (int)lo_.w, (int)hi_.x, (int)hi_.y, (int)hi_.z, (int)hi_.w}; } } while (0)
#define PG8_MMA(ai, bj, At, Bt) do { __builtin_amdgcn_s_setprio(1); _Pragma("unroll") for (int m = 0; m < 4; ++m) _Pragma("unroll") for (int n = 0; n < 2; ++n) \
        asm volatile("v_mfma_scale_f32_16x16x128_f8f6f4 %0, %1, %2, %0, %3, %4 op_sel_hi:[0,0,0]" : "+v"(acc[ai][bj][m][n]) : "v"(Bt[n]), "v"(At[m]), "v"(vsB), "v"(vsA)); __builtin_amdgcn_s_setprio(0); } while (0)
#define PG8_WAIT_V(n) asm volatile("s_waitcnt vmcnt(" #n ")" ::: "memory")
#define PG8_WAIT_L(n) asm volatile("s_waitcnt lgkmcnt(" #n ")" ::: "memory")
#define PG8_BAR __builtin_amdgcn_s_barrier()
#define PG8_SCHED __builtin_amdgcn_sched_barrier(0)
    Unit cur, nxt; int ui = 0;
    if (!S.next(0, cur)) return;
    f32x4 acc[2][2][4][2];
#pragma unroll
    for (int a = 0; a < 2; ++a)
#pragma unroll
        for (int b = 0; b < 2; ++b)
#pragma unroll
            for (int m = 0; m < 4; ++m)
#pragma unroll
                for (int n = 0; n < 2; ++n) acc[a][b][m][n] = (f32x4){0.f, 0.f, 0.f, 0.f};
    typedef int i32x8 __attribute__((ext_vector_type(8)));
    i32x8 At[4], B0[2], B1[2];
    int vsA = g.sA, vsB = g.sB; asm volatile("" : "+v"(vsA), "+v"(vsB));
    const char* cA = (const char*)g.A + (size_t)cur.pm * tstepA; const char* cB = (const char*)g.Bt + (size_t)cur.pb * tstepB;
    S.a_ready(cur);
    if constexpr (SP2) {
        PG8_STAGE(PG8_SB(0, 0), cB, voffB); PG8_STAGE(PG8_SB(0, 1), cB + hstepB, voffB); PG8_STAGE(PG8_SA(0, 0), cA, voffA); PG8_STAGE(PG8_SA(0, 1), cA + hstepA, voffA);
        if (wr == 1) PG8_BAR;
        PG8_WAIT_V(2); PG8_BAR;
        PG8_STAGE(PG8_SB(1, 0), cB + kstep, voffB); PG8_STAGE(PG8_SA(1, 0), cA + kstep, voffA); PG8_STAGE(PG8_SB(1, 1), cB + hstepB + kstep, voffB);
        PG8_WAIT_V(6); PG8_BAR;
    } else {
        PG8_STAGE(PG8_SB(0, 0), cB, voffB); PG8_STAGE(PG8_SA(0, 0), cA, voffA); PG8_STAGE(PG8_SB(0, 1), cB + hstepB, voffB); PG8_STAGE(PG8_SA(0, 1), cA + hstepA, voffA);
        if (wr == 1) PG8_BAR;
        PG8_WAIT_V(4); PG8_BAR;
        PG8_STAGE(PG8_SB(1, 0), cB + kstep, voffB); PG8_STAGE(PG8_SA(1, 0), cA + kstep, voffA); PG8_STAGE(PG8_SB(1, 1), cB + hstepB + kstep, voffB);
        PG8_WAIT_V(6); PG8_BAR;
    }
    for (;;) {
        const bool has_next = S.next(ui + 1, nxt);
        const char* nA = has_next ? (const char*)g.A + (size_t)nxt.pm * tstepA : cA; const char* nB = has_next ? (const char*)g.Bt + (size_t)nxt.pb * tstepB : cB;
        for (int t = 0; t < nt; t += 2) {
            const bool last = (t == nt - 2);
            const char* a1 = cA + (size_t)(t + 1) * kstep;
            const char* a2 = last ? nA : cA + (size_t)(t + 2) * kstep; const char* b2 = last ? nB : cB + (size_t)(t + 2) * kstep;
            const char* a3 = a2 + kstep; const char* b3 = b2 + kstep;
            if (last && has_next) S.a_ready(nxt);
            if constexpr (SP2) {
            PG8_LDB(B0, 0, 0); PG8_LDB(B1, 0, 1); PG8_SCHED; PG8_LDA(At, 0, 0); PG8_STAGE(PG8_SA(1, 1), a1 + hstepA, voffA);
            PG8_WAIT_V(8); PG8_WAIT_L(0); PG8_BAR; PG8_MMA(0, 0, At, B0); PG8_MMA(0, 1, At, B1); PG8_BAR; PG8_SCHED;
            PG8_LDA(At, 0, 1); PG8_STAGE(PG8_SB(0, 0), b2, voffB); PG8_STAGE(PG8_SB(0, 1), b2 + hstepB, voffB); PG8_STAGE(PG8_SA(0, 0), a2, voffA);
            PG8_WAIT_V(8); PG8_WAIT_L(0); PG8_BAR; PG8_MMA(1, 0, At, B0); PG8_MMA(1, 1, At, B1); PG8_BAR; PG8_SCHED;
            PG8_LDB(B0, 1, 0); PG8_LDB(B1, 1, 1); PG8_SCHED; PG8_LDA(At, 1, 0); PG8_STAGE(PG8_SA(0, 1), a2 + hstepA, voffA);
            PG8_WAIT_V(8); PG8_WAIT_L(0); PG8_BAR; PG8_MMA(0, 0, At, B0); PG8_MMA(0, 1, At, B1); PG8_BAR; PG8_SCHED;
            PG8_LDA(At, 1, 1); PG8_STAGE(PG8_SB(1, 0), b3, voffB); PG8_STAGE(PG8_SB(1, 1), b3 + hstepB, voffB); PG8_STAGE(PG8_SA(1, 0), a3, voffA);
            PG8_WAIT_V(8); PG8_WAIT_L(0); PG8_BAR; PG8_MMA(1, 0, At, B0); PG8_MMA(1, 1, At, B1); PG8_BAR; PG8_SCHED;
            } else {
            PG8_LDB(B0, 0, 0); PG8_SCHED; PG8_LDA(At, 0, 0); PG8_STAGE(PG8_SA(1, 1), a1 + hstepA, voffA);
            PG8_WAIT_L(8); PG8_BAR; PG8_WAIT_L(0); PG8_MMA(0, 0, At, B0); PG8_BAR; PG8_SCHED;
            PG8_LDB(B1, 0, 1); PG8_STAGE(PG8_SB(0, 0), b2, voffB);
            PG8_BAR; PG8_WAIT_L(0); PG8_MMA(0, 1, At, B1); PG8_BAR;
            PG8_LDA(At, 0, 1); PG8_STAGE(PG8_SA(0, 0), a2, voffA);
            PG8_BAR; PG8_WAIT_L(0); PG8_MMA(1, 0, At, B0); PG8_BAR; PG8_SCHED;
            PG8_STAGE(PG8_SB(0, 1), b2 + hstepB, voffB);
            PG8_WAIT_V(6); PG8_BAR; PG8_MMA(1, 1, At, B1); PG8_BAR;
            PG8_LDB(B0, 1, 0); PG8_SCHED; PG8_LDA(At, 1, 0); PG8_STAGE(PG8_SA(0, 1), a2 + hstepA, voffA);
            PG8_WAIT_L(8); PG8_BAR; PG8_WAIT_L(0); PG8_MMA(0, 0, At, B0); PG8_BAR; PG8_SCHED;
            PG8_LDB(B1, 1, 1); PG8_STAGE(PG8_SB(1, 0), b3, voffB);
            PG8_BAR; PG8_WAIT_L(0); PG8_MMA(0, 1, At, B1); PG8_BAR;
            PG8_LDA(At, 1, 1); PG8_STAGE(PG8_SA(1, 0), a3, voffA);
            PG8_BAR; PG8_WAIT_L(0); PG8_MMA(1, 0, At, B0); PG8_BAR; PG8_SCHED;
            PG8_STAGE(PG8_SB(1, 1), b3 + hstepB, voffB);
            PG8_WAIT_V(6); PG8_BAR; PG8_MMA(1, 1, At, B1); PG8_BAR;
            }
        }
        if constexpr (ALIGN_EPI) { if (wr == 0) PG8_BAR; }
        asm volatile("s_nop 15\n\ts_nop 15" ::: "memory");
        if constexpr (!Epi::AFTER_DRAIN) { E(acc, cur, wr, wc, fr, fq); S.done(cur); }
        if (!has_next) break;
#pragma unroll
        for (int a = 0; a < 2; ++a)
#pragma unroll
            for (int b = 0; b < 2; ++b)
#pragma unroll
                for (int m = 0; m < 4; ++m)
#pragma unroll
                    for (int n = 0; n < 2; ++n) acc[a][b][m][n] = (f32x4){0.f, 0.f, 0.f, 0.f};
        cur = nxt; cA = nA; cB = nB; ++ui;
        if constexpr (ALIGN_EPI) { if (wr == 1) PG8_BAR; }
    }
    PG8_WAIT_V(0);
    if constexpr (!ALIGN_EPI) { if (wr == 0) PG8_BAR; }
    PG8_BAR;
    if constexpr (Epi::AFTER_DRAIN) { E.fused(acc, cur, wr, wc, fr, fq, lds, wid, lane); S.done(cur); }
#undef PG8_SA
#undef PG8_SB
#undef PG8_STAGE
#undef PG8_LDA
#undef PG8_LDB
#undef PG8_MMA
#undef PG8_WAIT_V
#undef PG8_WAIT_L
#undef PG8_BAR
#undef PG8_SCHED
}
}

namespace attn {
using bf16x8 = __attribute__((ext_vector_type(8))) short;
using s16x4  = __attribute__((ext_vector_type(4))) short;
using f32x16 = __attribute__((ext_vector_type(16))) float;
using u32x4  = __attribute__((ext_vector_type(4))) unsigned;
constexpr int DV = 128, DK = 64, NW = 8, QBLK = 32, KVBLK = 64;
constexpr float SCALE = 0.125f;
constexpr float THR = 4.f;
constexpr size_t SHM_V = KVBLK * DV * 2, SHM_K = KVBLK * DK * 2, SHM_ATTN = 2 * SHM_V + 2 * SHM_K + NW * 64 * 4;
#define AKSWZ(row, colB) ((row) * 128 + ((colB) ^ ((((row) >> 1) & 7) << 4)))
#define ASBAR() __builtin_amdgcn_sched_barrier(0)
__device__ __forceinline__ int crow(int r, int hi) { return (r & 3) + 8 * (r >> 2) + 4 * hi; }
__device__ __forceinline__ unsigned cvtpk(float lo, float hi) { unsigned r; asm volatile("v_cvt_pk_bf16_f32 %0, %1, %2" : "=v"(r) : "v"(lo), "v"(hi)); return r; }

__device__ __forceinline__ void partialSM(f32x16& p0, f32x16& p1, float& m_reg, float& mn, float& alpha) {
  constexpr float C = SCALE * 1.4426950408889634f;
  float pmax = p0[0];
#pragma unroll
  for (int r = 1; r < 16; ++r) pmax = fmaxf(pmax, p0[r]);
#pragma unroll
  for (int r = 0; r < 16; ++r) pmax = fmaxf(pmax, p1[r]);
  { auto rr = __builtin_amdgcn_permlane32_swap(__float_as_uint(pmax), __float_as_uint(pmax), false, false);
    pmax = fmaxf(__uint_as_float(rr[0]), __uint_as_float(rr[1])); }
  if (__builtin_expect(__all(pmax - m_reg <= THR / SCALE), 1)) { mn = m_reg; alpha = 1.f; }
  else { mn = fmaxf(m_reg, pmax); alpha = __builtin_amdgcn_exp2f((m_reg - mn) * C); m_reg = mn; }
  const float mnC = -mn * C;
#pragma unroll
  for (int r = 0; r < 16; ++r) p0[r] = fmaf(p0[r], C, mnC);
#pragma unroll
  for (int r = 0; r < 16; ++r) p1[r] = fmaf(p1[r], C, mnC);
#pragma unroll
  for (int r = 0; r < 16; ++r) p0[r] = __builtin_amdgcn_exp2f(p0[r]);
}
__device__ __forceinline__ void finishSM(f32x16& p0, f32x16& p1, float alpha, float& l_reg, bf16x8& pa0, bf16x8& pa1, bf16x8& pa2, bf16x8& pa3) {
#pragma unroll
  for (int r = 0; r < 16; ++r) p1[r] = __builtin_amdgcn_exp2f(p1[r]);
  float ps = 0;
#pragma unroll
  for (int r = 0; r < 16; ++r) ps += p0[r];
#pragma unroll
  for (int r = 0; r < 16; ++r) ps += p1[r];
  { auto rr = __builtin_amdgcn_permlane32_swap(__float_as_uint(ps), __float_as_uint(ps), false, false);
    ps = __uint_as_float(rr[0]) + __uint_as_float(rr[1]); }
  l_reg = l_reg * alpha + ps;
#define APK4(P, BASE, OUT) do { unsigned a0 = cvtpk(P[BASE + 0], P[BASE + 1]), a1 = cvtpk(P[BASE + 2], P[BASE + 3]);   \
    unsigned b0 = cvtpk(P[BASE + 4], P[BASE + 5]), b1 = cvtpk(P[BASE + 6], P[BASE + 7]);                              \
    auto r0 = __builtin_amdgcn_permlane32_swap(a0, b0, false, false); auto r1 = __builtin_amdgcn_permlane32_swap(a1, b1, false, false); \
    u32x4 w = {r0[0], r1[0], r0[1], r1[1]}; OUT = *reinterpret_cast<bf16x8*>(&w); } while (0)
  APK4(p0, 0, pa0); APK4(p0, 8, pa1); APK4(p1, 0, pa2); APK4(p1, 8, pa3);
#undef APK4
}
__device__ __forceinline__ void qkt(f32x16& p0, f32x16& p1, const char* Ks, const bf16x8* qr, int r32, int hi) {
  p0 = f32x16{}; p1 = f32x16{};
#pragma unroll
  for (int d0 = 0; d0 < 4; ++d0) { const int cb = (d0 * 16 + hi * 8) * 2;
    bf16x8 b0 = *reinterpret_cast<const bf16x8*>(Ks + AKSWZ(r32, cb));
    bf16x8 b1 = *reinterpret_cast<const bf16x8*>(Ks + AKSWZ(32 + r32, cb));
    p0 = __builtin_amdgcn_mfma_f32_32x32x16_bf16(b0, qr[d0], p0, 0, 0, 0);
    p1 = __builtin_amdgcn_mfma_f32_32x32x16_bf16(b1, qr[d0], p1, 0, 0, 0); }
}
__device__ __forceinline__ int v_st(int k, int c) { const int kk = (k & ~0xC) | ((k & 4) << 1) | ((k & 8) >> 1); return ((kk >> 3) * 4 + (c >> 5)) * 512 + ((kk & 7) * 32 + (c & 31)) * 2; }
__device__ __forceinline__ int v_rd_base(int lane) { return ((lane & 3) << 3) | (((lane >> 2) & 3) << 6) | (((lane >> 4) & 1) << 5) | (((lane >> 5) & 1) << 8); }
constexpr int v_rd_off(int d0, int ks, int half) { return d0 * 512 + ks * 4096 + half * 2048; }
template <int OFF> __device__ __forceinline__ s16x4 tr_read(int vb) {
  s16x4 r; asm volatile("ds_read_b64_tr_b16 %0, %1 offset:%2" : "=&v"(r) : "v"(vb), "i"(OFF) : "memory"); return r;
}
template <int D0> __device__ __forceinline__ void pv_one(f32x16& od, int vb, bf16x8 pa0, bf16x8 pa1, bf16x8 pa2, bf16x8 pa3) {
  const s16x4 l0 = tr_read<v_rd_off(D0, 0, 0)>(vb), h0 = tr_read<v_rd_off(D0, 0, 1)>(vb), l1 = tr_read<v_rd_off(D0, 1, 0)>(vb), h1 = tr_read<v_rd_off(D0, 1, 1)>(vb);
  const s16x4 l2 = tr_read<v_rd_off(D0, 2, 0)>(vb), h2 = tr_read<v_rd_off(D0, 2, 1)>(vb), l3 = tr_read<v_rd_off(D0, 3, 0)>(vb), h3 = tr_read<v_rd_off(D0, 3, 1)>(vb);
  asm volatile("s_waitcnt lgkmcnt(0)" ::: "memory"); ASBAR();
#define APK(L, H) (bf16x8){L[0], L[1], L[2], L[3], H[0], H[1], H[2], H[3]}
  od = __builtin_amdgcn_mfma_f32_32x32x16_bf16(pa0, APK(l0, h0), od, 0, 0, 0);
  od = __builtin_amdgcn_mfma_f32_32x32x16_bf16(pa1, APK(l1, h1), od, 0, 0, 0);
  od = __builtin_amdgcn_mfma_f32_32x32x16_bf16(pa2, APK(l2, h2), od, 0, 0, 0);
  od = __builtin_amdgcn_mfma_f32_32x32x16_bf16(pa3, APK(l3, h3), od, 0, 0, 0);
#undef APK
}
__device__ __forceinline__ void pv_d0(f32x16* o, int vb, bf16x8 pa0, bf16x8 pa1, bf16x8 pa2, bf16x8 pa3) {
  pv_one<0>(o[0], vb, pa0, pa1, pa2, pa3); pv_one<1>(o[1], vb, pa0, pa1, pa2, pa3); pv_one<2>(o[2], vb, pa0, pa1, pa2, pa3); pv_one<3>(o[3], vb, pa0, pa1, pa2, pa3);
}
template <int LDQ, int LDO>
__device__ __forceinline__ void attn_unit(const unsigned short* __restrict__ Qb, const unsigned short* __restrict__ Kh, const unsigned short* __restrict__ Vh,
                                          unsigned short* __restrict__ Ob, int seq, char* lds) {
  int tid = threadIdx.x; asm volatile("" : "+v"(tid)); const int wid = tid >> 6, lane = tid & 63, r32 = lane & 31, hi = lane >> 5;
  char* V_lds = lds; char* K_lds = lds + 2 * SHM_V;
  float* ws = (float*)(lds + 2 * SHM_V + 2 * SHM_K) + wid * 64; float* li_l = ws; float* al_l = ws + 32;
  float m_reg = -1e30f, l_reg = 0; f32x16 o[4] = {}; bf16x8 qr[4];
  const unsigned short* Qw = Qb + (long)(wid * QBLK + r32) * LDQ + hi * 8;
#pragma unroll
  for (int d0 = 0; d0 < 4; ++d0) qr[d0] = *reinterpret_cast<const bf16x8*>(Qw + d0 * 16);
  const int sr = tid >> 4, sc = (tid & 15) * 8, vst0 = v_st(sr, sc), vst1 = v_st(32 + sr, sc);
  const int kr = tid >> 3, kc = (tid & 7) * 8, kst = AKSWZ(kr, kc * 2);
  const int vb0 = (int)(uintptr_t)V_lds + v_rd_base(lane);
  bf16x8 sv0[2], sv1[2], sk0[2];
#define ASLOAD(i, k0) do { sv0[i] = *reinterpret_cast<const bf16x8*>(&Vh[(long)((k0) + sr) * LDQ + sc]); sv1[i] = *reinterpret_cast<const bf16x8*>(&Vh[(long)((k0) + 32 + sr) * LDQ + sc]); \
    sk0[i] = *reinterpret_cast<const bf16x8*>(&Kh[(long)((k0) + kr) * LDQ + kc]); } while (0)
#define ASWRITE(b, i) do { *(bf16x8*)(V_lds + (b) * SHM_V + vst0) = sv0[i]; *(bf16x8*)(V_lds + (b) * SHM_V + vst1) = sv1[i]; \
    *(bf16x8*)(K_lds + (b) * SHM_K + kst) = sk0[i]; } while (0)
#define ASWAIT() asm volatile("s_waitcnt vmcnt(3)" ::: "memory")
#define ARESC(a) do { if (__any((a) < 1.f)) { if (hi == 0) al_l[r32] = (a); asm volatile("s_waitcnt lgkmcnt(0)" ::: "memory"); \
    _Pragma("unroll") for (int d = 0; d < 4; ++d) _Pragma("unroll") for (int r = 0; r < 16; ++r) o[d][r] *= al_l[crow(r, hi)]; } } while (0)
  f32x16 pA0, pA1, pB0, pB1; float mnA, mnB, alA, alB; bf16x8 pa0, pa1, pa2, pa3; const int NT = seq / KVBLK;
  ASLOAD(0, 0); asm volatile("s_waitcnt vmcnt(0)" ::: "memory"); ASWRITE(0, 0); __syncthreads();
  qkt(pA0, pA1, K_lds, qr, r32, hi); partialSM(pA0, pA1, m_reg, mnA, alA);
  ASLOAD(1, KVBLK); if (2 < NT) ASLOAD(0, 2 * KVBLK);
  if (2 < NT) ASWAIT(); else asm volatile("s_waitcnt vmcnt(0)" ::: "memory");
  ASWRITE(1, 1); __syncthreads();
  for (int j = 1; j + 1 < NT; j += 2) {
    ASBAR(); qkt(pB0, pB1, K_lds + SHM_K, qr, r32, hi);
    finishSM(pA0, pA1, alA, l_reg, pa0, pa1, pa2, pa3); ASBAR();
    ASLOAD(1, (j + 2) * KVBLK); ASBAR();
    pv_d0(o, vb0, pa0, pa1, pa2, pa3); partialSM(pB0, pB1, m_reg, mnB, alB);
    __syncthreads(); ASWAIT(); ASWRITE(0, 0);
    ARESC(alB); __syncthreads();
    ASBAR(); qkt(pA0, pA1, K_lds, qr, r32, hi);
    finishSM(pB0, pB1, alB, l_reg, pa0, pa1, pa2, pa3); ASBAR();
    if (j + 3 < NT) ASLOAD(0, (j + 3) * KVBLK); ASBAR();
    pv_d0(o, vb0 + (int)SHM_V, pa0, pa1, pa2, pa3); partialSM(pA0, pA1, m_reg, mnA, alA);
    __syncthreads(); if (j + 3 < NT) ASWAIT(); else asm volatile("s_waitcnt vmcnt(0)" ::: "memory");
    ASWRITE(1, 1);
    ARESC(alA); __syncthreads();
  }
  ASBAR(); qkt(pB0, pB1, K_lds + SHM_K, qr, r32, hi);
  finishSM(pA0, pA1, alA, l_reg, pa0, pa1, pa2, pa3); ASBAR();
  pv_d0(o, vb0, pa0, pa1, pa2, pa3); partialSM(pB0, pB1, m_reg, mnB, alB);
  __syncthreads(); ARESC(alB);
  finishSM(pB0, pB1, alB, l_reg, pa0, pa1, pa2, pa3); ASBAR();
  pv_d0(o, vb0 + (int)SHM_V, pa0, pa1, pa2, pa3);
  if (hi == 0) li_l[r32] = l_reg; asm volatile("s_waitcnt lgkmcnt(0)" ::: "memory");
  float rli[16];
#pragma unroll
  for (int r = 0; r < 16; ++r) rli[r] = __builtin_amdgcn_rcpf(li_l[crow(r, hi)]);
  unsigned short* Ow = Ob + (long)(wid * QBLK) * LDO;
#pragma unroll
  for (int r = 0; r < 16; ++r) { const int orow = crow(r, hi);
#pragma unroll
    for (int d0 = 0; d0 < 4; ++d0) { const float v = o[d0][r] * rli[r]; Ow[(long)orow * LDO + d0 * 32 + r32] = (unsigned short)(cvtpk(v, v) & 0xffffu); } }
  __syncthreads();
#undef ASLOAD
#undef ASWRITE
#undef ASWAIT
#undef ARESC
}
}

constexpr int NWAVES = 8, NTHR = NWAVES * 64;
constexpr int DM = 1024, NB = 4, SEQ = 4096, CTXL = 256, RPB = CTXL + SEQ  , MROWS = NB * RPB  ;
constexpr int INW = 5904, NPROJ = 6144;
constexpr int FFD = 2816, FFE = 3584, NEXP = 8, FFEH = FFE / 2;
constexpr int NCHUNK = RPB / 64;
constexpr float EPSN = 1e-6f;
constexpr int PC_AQ = 0, PC_AK = 512, PC_AV = 1024, PC_DQ = 1536, PC_DK = 1792, PC_DV = 2048, PC_DZ = 2304, PC_POOL = 2560, PC_GATE = 2816, PC_AB = 5888;

constexpr size_t MiB = 1u << 20;
constexpr size_t WS_CTL = 0, CTL_ZERO_BYTES = 2 * MiB;
constexpr size_t WS_MOD = 1 * MiB;
constexpr size_t WS_ROPE = 2 * MiB;
constexpr size_t WS_LAM = 2 * MiB + 65536;
constexpr size_t WS_ROUTE = 3 * MiB;
constexpr size_t WS_GB = 4 * MiB;
constexpr size_t WS_WIN = 8 * MiB;
constexpr size_t WS_WBR = 32 * MiB;
constexpr size_t WS_WOUT = 36 * MiB;
constexpr size_t WS_W13 = 40 * MiB;
constexpr size_t WS_W2 = 51 * MiB;
constexpr size_t WS_H = 58 * MiB;
constexpr size_t WS_U = 126 * MiB;
constexpr size_t WS_ATTO = WS_U;
constexpr size_t WS_PROJ = 160 * MiB;
constexpr size_t WS_MIX = 364 * MiB;
constexpr size_t WS_DNP = 398 * MiB;
constexpr size_t WS_MG = WS_DNP;
constexpr size_t WS_DNG = 466 * MiB;
constexpr size_t WS_DNO = 467 * MiB;
constexpr size_t WS_HID = WS_PROJ;
constexpr int MOE_MAXT = 136;
constexpr size_t WS_XG = 160 * MiB;
constexpr size_t WS_Y = 194 * MiB;
constexpr size_t WS_W13M = 262 * MiB;
constexpr size_t WS_W2M = 318 * MiB;
constexpr size_t WS_HIDM = 346 * MiB;
constexpr size_t WS_END = 500 * MiB;
static_assert(WS_HIDM + (size_t)MOE_MAXT * 256 * FFE <= WS_END && WS_DNO + (size_t)2 * MROWS * 256 * 2 <= WS_END, "ws map");
static_assert(WS_WIN + (size_t)2 * NPROJ * 1024 * 2 <= WS_WBR && WS_W13 + (size_t)2 * FFD * 1024 * 2 <= WS_W2 && WS_W2 + (size_t)1024 * FFD * 2 <= WS_H, "ws map (weights)");
static_assert(WS_H + (size_t)MROWS * 1024 * 4 <= WS_U && WS_U + (size_t)MROWS * 1024 * 2 <= WS_PROJ && WS_PROJ + (size_t)MROWS * NPROJ * 2 <= WS_MIX, "ws map (acts)");
static_assert(WS_MIX + (size_t)MROWS * 1024 * 2 <= WS_DNP && WS_DNP + (size_t)NB * NCHUNK * 4 * 2 * 32768 <= WS_DNG, "ws map (dn)");
static_assert(WS_XG + (size_t)MOE_MAXT * 256 * 1024 <= WS_Y && WS_Y + (size_t)MOE_MAXT * 256 * 1024 * 2 <= WS_W13M && WS_W13M + (size_t)8 * 2 * FFE * 1024 <= WS_W2M && WS_W2M + (size_t)8 * 1024 * FFE <= WS_HIDM, "ws map (moe)");
constexpr int CW_TMO = 0, CW_CODE = 1;
constexpr int CW_BAR = 4096;
constexpr int CW_ECNT = 8192;

constexpr int RING_BYTES = 155648;
constexpr int MISC_OFF = RING_BYTES;
constexpr int LDS_BYTES = RING_BYTES + 1024;

enum { PH_PRO = 0, PH_L0 = 1, PH_N1 = 0, PH_PROJ = 1, PH_ATT = 2, PH_SCAN = 3, PH_MIXB = 4, PH_MRG0 = 5, PH_MRG1 = 6, PH_MRG2 = 7, PH_OUT = 8, PH_N2 = 9, PH_LAYER = 10,
       PH_FUP = 11, PH_FDN = 12, PH_L1 = 13, PH_GATH = 23, PH_CV0 = 24, PH_UP0 = 25, PH_DN0 = 26, PH_CV1 = 27, PH_UP1 = 28, PH_DN1 = 29, PH_FIN = 30, PH_COUNT = 31 };

#define GAS __attribute__((address_space(1)))
#define LAS __attribute__((address_space(3)))
typedef unsigned short bf16;
typedef unsigned v4u __attribute__((ext_vector_type(4)));
typedef unsigned v2u __attribute__((ext_vector_type(2)));
typedef float f32x4 __attribute__((ext_vector_type(4)));
typedef GAS unsigned gu32;
#define RLX_AGENT __ATOMIC_RELAXED, __HIP_MEMORY_SCOPE_AGENT
#define LDS_WAIT() asm volatile("s_waitcnt lgkmcnt(0)" ::: "memory")
#define VM_WAIT() asm volatile("s_waitcnt vmcnt(0)" ::: "memory")
__device__ __forceinline__ unsigned f2bf(float f) { unsigned u = __builtin_bit_cast(unsigned, f); return (u + 0x7fffu + ((u >> 16) & 1u)) >> 16; }
typedef float f32x2_c __attribute__((ext_vector_type(2))); typedef __bf16 bf16x2_c __attribute__((ext_vector_type(2)));
__device__ __forceinline__ unsigned cvtpk_c(float lo, float hi) { f32x2_c v = {lo, hi}; bf16x2_c b = __builtin_convertvector(v, bf16x2_c); return __builtin_bit_cast(unsigned, b); }
__device__ __forceinline__ unsigned pk2(float lo, float hi) { return cvtpk_c(lo, hi); }
__device__ __forceinline__ unsigned cvt4_fp8(float a, float b, float c, float d) {
    a = fminf(fmaxf(a, -448.f), 448.f); b = fminf(fmaxf(b, -448.f), 448.f); c = fminf(fmaxf(c, -448.f), 448.f); d = fminf(fmaxf(d, -448.f), 448.f);
    int r = 0; r = __builtin_amdgcn_cvt_pk_fp8_f32(a, b, r, false); r = __builtin_amdgcn_cvt_pk_fp8_f32(c, d, r, true); return (unsigned)r; }
constexpr int E8(int log2scale) { return (127 - log2scale) * 0x01010101; }
constexpr int F8_ACT_L2 = 3, F8_W13_L2 = 5, F8_W2_L2 = 6;
__device__ __forceinline__ float bf_lo(unsigned w) { return __builtin_bit_cast(float, w << 16); }
__device__ __forceinline__ float bf_hi(unsigned w) { return __builtin_bit_cast(float, w & 0xffff0000u); }
__device__ __forceinline__ float bf2f(bf16 v) { return __builtin_bit_cast(float, (unsigned)v << 16); }
__device__ __forceinline__ float sigmoidf_(float x) { return 1.f / (1.f + __expf(-x)); }
__device__ __forceinline__ float siluf_(float x) { return x / (1.f + __expf(-x)); }
__device__ __forceinline__ float wave_sum(float v) {
#pragma unroll
    for (int o = 1; o < 64; o <<= 1) v += __shfl_xor(v, o);
    return v;
}
#define XB_TMO      128
#define XB_XCNT(j)  (256  + 64 * (j))
#define XB_XSUB(j)  (1280 + 64 * (j))
#define XB_XGEN(j)  (2304 + 64 * (j))
#define XB_TOP      3328
#define XB_TOPGEN   3392
#define XCD_BAR_WORDS 3456
#define XB_SPIN_CAP (1u << 18)

__device__ __forceinline__ unsigned xb_ld(unsigned* p)              { return __hip_atomic_load(p, __ATOMIC_RELAXED, __HIP_MEMORY_SCOPE_AGENT); }
__device__ __forceinline__ unsigned xb_add(unsigned* p, unsigned v) { return __hip_atomic_fetch_add(p, v, __ATOMIC_RELAXED, __HIP_MEMORY_SCOPE_AGENT); }
__device__ __forceinline__ unsigned xb_xcc_id() { return (unsigned)__builtin_amdgcn_s_getreg((3 << 11) | 20) & 0xFu; }
#define XB_SPIN(cond, bar) do { unsigned _sp = 0; while (cond) { __builtin_amdgcn_s_sleep(1); \
    if ((++_sp & 255u) == 0u) { if (xb_ld(&(bar)[XB_TMO])) break; if (_sp > XB_SPIN_CAP) { atomicAdd(&(bar)[XB_TMO], 1u); break; } } } } while (0)

struct XcdBarrier {
    unsigned* bar; unsigned x;
    volatile LAS unsigned* st;
};

__device__ __forceinline__ XcdBarrier xcd_barrier_post(unsigned* bar, volatile LAS unsigned* st) {
    XcdBarrier b; b.bar = bar; b.x = xb_xcc_id(); b.st = st;
    if (threadIdx.x == 0) (void)xb_add(&bar[XB_XCNT(b.x)], 1u);
    return b;
}
__device__ __forceinline__ void xcd_barrier_complete(unsigned* bar, unsigned x, unsigned& nloc, unsigned& nx) {
    const unsigned G = gridDim.x * gridDim.y * gridDim.z;
    unsigned sum, cnt, mine, sp = 0u;
    for (;;) {
        sum = 0u; cnt = 0u; mine = 0u;
#pragma unroll
        for (unsigned j = 0; j < 16; ++j) { const unsigned c = xb_ld(&bar[XB_XCNT(j)]); sum += c; cnt += (c > 0u) ? 1u : 0u; mine = (j == x) ? c : mine; }
        if (sum == G) break;
        __builtin_amdgcn_s_sleep(1);
        if ((++sp & 255u) == 0u) { if (xb_ld(&bar[XB_TMO])) break; if (sp > XB_SPIN_CAP) { atomicAdd(&bar[XB_TMO], 1u); break; } }
    }
    nloc = mine > 0u ? mine : 1u; nx = cnt > 0u ? cnt : 1u;
}

__device__ __forceinline__ void xcd_barrier(const XcdBarrier& b) {
    asm volatile("s_waitcnt vmcnt(0)" ::: "memory");
    __syncthreads();
    if (threadIdx.x == 0) {
        unsigned* bar = b.bar;
        __builtin_amdgcn_s_waitcnt(0);
        unsigned nloc = b.st[0], nx = b.st[1];
        if (nloc == 0u) { xcd_barrier_complete(bar, b.x, nloc, nx); b.st[0] = nloc; b.st[1] = nx; }
        const unsigned old = xb_add(&bar[XB_XSUB(b.x)], 1u);
        const unsigned gen = old / nloc;
        if (old + 1u == (gen + 1u) * nloc) {
            __builtin_amdgcn_fence(__ATOMIC_RELEASE, "agent");
            asm volatile("s_waitcnt vmcnt(0)" ::: "memory");
            const unsigned og = xb_add(&bar[XB_TOP], 1u);
            const unsigned tg = og / nx;
            if (og + 1u == (tg + 1u) * nx) xb_add(&bar[XB_TOPGEN], 1u);
            else XB_SPIN(xb_ld(&bar[XB_TOPGEN]) == tg, bar);
            __builtin_amdgcn_fence(__ATOMIC_ACQUIRE, "agent");
            xb_add(&bar[XB_XGEN(b.x)], 1u);
            asm volatile("s_waitcnt vmcnt(0)" ::: "memory");
        } else {
            XB_SPIN(xb_ld(&bar[XB_XGEN(b.x)]) == gen, bar);
            __builtin_amdgcn_fence(__ATOMIC_ACQUIRE, "agent");
            asm volatile("s_waitcnt vmcnt(0)" ::: "memory");
        }
    }
    __syncthreads();
}

struct Frame {
    LAS unsigned char* lds;
    volatile LAS unsigned* MISC;
    gu32* ctl;
    int tid, lane, wave, vcu, G, zz;
    unsigned char* ws;
    float* out;
};
struct Args { const float* in[27]; float* out; unsigned char* ws; int ph_lo, ph_hi; };

struct TileOrder {
    int nM, nN, nwg, G, c, skip;
    __device__ __forceinline__ void init(int nM_, int nN_, int G_, int c_, int skip_) { nM = nM_; nN = nN_; nwg = nM * nN; G = G_; c = c_; skip = skip_; }
    __device__ __forceinline__ bool next(int i, pg8::Unit& u) const {
        const long L = (long)i * G + c; if (L >= nwg) return false;
        int wgid = (int)L; { const int q = nwg / 8, r = nwg % 8, xcd = wgid % 8, off = wgid / 8; wgid = (xcd < r ? xcd * (q + 1) : r * (q + 1) + (xcd - r) * q) + off; }
        const int nig = 8 * nN, gid = wgid / nig, fm = gid * 8, gsz = (nM - fm) < 8 ? (nM - fm) : 8;
        int pm = fm + ((wgid % nig) % gsz); const int pn = (wgid % nig) / gsz;
        if (skip) pm = (pm >> 4) * 17 + 1 + (pm & 15);
        u.pm = pm; u.pn = pn; u.pb = pn; return true;
    }
    __device__ __forceinline__ void a_ready(const pg8::Unit&) const {}
    __device__ __forceinline__ void done(const pg8::Unit&) const {}
};
struct MoeOrder {
    int t1, t2, t3, t4, t5, t6, t7, t8, nN, G, c;
    __device__ __forceinline__ void init(const gu32* cnt, int nN_, int G_, int c_) {
        int t = 0;
        t += ((int)__hip_atomic_load(cnt + 0 * 64, RLX_AGENT) + 255) >> 8; t1 = t; t += ((int)__hip_atomic_load(cnt + 1 * 64, RLX_AGENT) + 255) >> 8; t2 = t;
        t += ((int)__hip_atomic_load(cnt + 2 * 64, RLX_AGENT) + 255) >> 8; t3 = t; t += ((int)__hip_atomic_load(cnt + 3 * 64, RLX_AGENT) + 255) >> 8; t4 = t;
        t += ((int)__hip_atomic_load(cnt + 4 * 64, RLX_AGENT) + 255) >> 8; t5 = t; t += ((int)__hip_atomic_load(cnt + 5 * 64, RLX_AGENT) + 255) >> 8; t6 = t;
        t += ((int)__hip_atomic_load(cnt + 6 * 64, RLX_AGENT) + 255) >> 8; t7 = t; t += ((int)__hip_atomic_load(cnt + 7 * 64, RLX_AGENT) + 255) >> 8; t8 = t;
        nN = nN_; G = G_; c = c_;
    }
    __device__ __forceinline__ int tile_off(int e) const { return e == 0 ? 0 : e == 1 ? t1 : e == 2 ? t2 : e == 3 ? t3 : e == 4 ? t4 : e == 5 ? t5 : e == 6 ? t6 : t7; }
    __device__ __forceinline__ bool next(int i, pg8::Unit& u) const {
        const long L = (long)i * G + c; if (L >= (long)t8 * nN) return false;
        const int pm = (int)(L / nN), pn = (int)(L % nN);
        const int e = (pm >= t1) + (pm >= t2) + (pm >= t3) + (pm >= t4) + (pm >= t5) + (pm >= t6) + (pm >= t7);
        u.pm = pm; u.pn = pn; u.pb = e * nN + pn; return true;
    }
    __device__ __forceinline__ void a_ready(const pg8::Unit&) const {}
    __device__ __forceinline__ void done(const pg8::Unit&) const {}
};

#define EPI_LOOP(...) _Pragma("unroll") for (int ai = 0; ai < 2; ++ai) _Pragma("unroll") for (int m = 0; m < 4; ++m) { const int row = u.pm * 256 + ai * 128 + wr * 64 + m * 16 + fr; \
    _Pragma("unroll") for (int bj = 0; bj < 2; ++bj) { const int col = bj * 128 + wc * 32 + 4 * fq; f32x4 v0 = acc[ai][bj][m][0], v1 = acc[ai][bj][m][1]; __VA_ARGS__ } if (m & 1) asm volatile("" ::: "memory"); }
__device__ __forceinline__ v2u pack4(f32x4 v) { v2u w; w.x = pg8::cvt_pk_bf16(v[0], v[1]); w.y = pg8::cvt_pk_bf16(v[2], v[3]); return w; }
__device__ __forceinline__ f32x4 unpack4(v2u w) { return (f32x4){bf_lo(w.x), bf_hi(w.x), bf_lo(w.y), bf_hi(w.y)}; }

struct EpiProj {
    static constexpr bool PERM = false, AFTER_DRAIN = false;
    bf16* P; float* GB; const float* rope; const float* a_log; const float* dt_bias;
    __device__ __forceinline__ void operator()(const pg8::f32x4 (&acc)[2][2][4][2], const pg8::Unit& u, int wr, int wc, int fr, int fq) const {
        const int pn = u.pn;
        if (pn < 4) {
            EPI_LOOP({ const int j = row % RPB;
                if (j >= CTXL) { const int t = j - CTXL; const int pos = (wc & 1) ? (t & 63) : (t >> 6);
                    const f32x4 cs0 = *(const f32x4*)(rope + (pos * 16 + 4 * fq) * 2), cs1 = *(const f32x4*)(rope + (pos * 16 + 4 * fq) * 2 + 4);
                    const float c0 = cs0[0], s0 = cs0[1], c1 = cs0[2], s1 = cs0[3], c2 = cs1[0], s2 = cs1[1], c3 = cs1[2], s3 = cs1[3];
                    const f32x4 a = v0, b = v1;
                    v0[0] = a[0] * c0 - b[0] * s0; v1[0] = b[0] * c0 + a[0] * s0; v0[1] = a[1] * c1 - b[1] * s1; v1[1] = b[1] * c1 + a[1] * s1;
                    v0[2] = a[2] * c2 - b[2] * s2; v1[2] = b[2] * c2 + a[2] * s2; v0[3] = a[3] * c3 - b[3] * s3; v1[3] = b[3] * c3 + a[3] * s3; }
                bf16* o = P + (size_t)row * NPROJ + pn * 256 + col; *(v2u*)o = pack4(v0); *(v2u*)(o + 16) = pack4(v1); })
        } else if (pn >= 11 && pn < 23) {
            EPI_LOOP({ for (int q = 0; q < 4; ++q) { v0[q] = sigmoidf_(v0[q]); v1[q] = sigmoidf_(v1[q]); }
                bf16* o = P + (size_t)row * NPROJ + pn * 256 + col; *(v2u*)o = pack4(v0); *(v2u*)(o + 16) = pack4(v1); })
        } else if (pn == 23) {
            if (wc == 0) {
                EPI_LOOP({ if (bj == 0) { f32x4 r;
                    for (int q = 0; q < 4; ++q) { const int c = 4 * fq + q; const float x = v0[q];
                        if (c < 8) { const float z = x + dt_bias[c]; const float ez = __expf(z); const float sp = z > 15.f ? z : (ez < 0.03f ? ez * (1.f - ez * (0.5f - ez * (1.f / 3.f))) : __logf(1.f + ez)); r[q] = -__expf(a_log[c]) * sp; }
                        else r[q] = sigmoidf_(x); }
                    *(f32x4*)(GB + (size_t)row * 16 + 4 * fq) = r; } (void)v1; })
            }
        } else {
            EPI_LOOP({ bf16* o = P + (size_t)row * NPROJ + pn * 256 + col; *(v2u*)o = pack4(v0); *(v2u*)(o + 16) = pack4(v1); })
        }
    }
};
struct EpiMerge {
    static constexpr bool PERM = false, AFTER_DRAIN = false;
    bf16* MG; const bf16* P; int gcol0; int first;
    __device__ __forceinline__ void operator()(const pg8::f32x4 (&acc)[2][2][4][2], const pg8::Unit& u, int wr, int wc, int fr, int fq) const {
        EPI_LOOP({ const int c = u.pn * 256 + col; const bf16* gp = P + (size_t)row * NPROJ + gcol0 + c; bf16* o = MG + (size_t)row * DM + c;
            const f32x4 g0 = unpack4(*(const v2u*)gp), g1 = unpack4(*(const v2u*)(gp + 16));
            f32x4 r0 = g0 * v0, r1 = g1 * v1;
            if (!first) { unsigned long long w0 = __hip_atomic_load((unsigned long long*)o, RLX_AGENT), w1 = __hip_atomic_load((unsigned long long*)(o + 16), RLX_AGENT);
                r0 += unpack4((v2u){(unsigned)w0, (unsigned)(w0 >> 32)}); r1 += unpack4((v2u){(unsigned)w1, (unsigned)(w1 >> 32)}); }
            *(v2u*)o = pack4(r0); *(v2u*)(o + 16) = pack4(r1); })
    }
};
struct EpiResid {
    static constexpr bool PERM = false, AFTER_DRAIN = false;
    float* H; const float* modl; int gidx;
    __device__ __forceinline__ void operator()(const pg8::f32x4 (&acc)[2][2][4][2], const pg8::Unit& u, int wr, int wc, int fr, int fq) const {
        EPI_LOOP({ const int c = u.pn * 256 + col; const int b = row / RPB, j = row - b * RPB; const int mr = j < CTXL ? 4 : b;
            const float* gp = modl + mr * 6144 + gidx * 1024 + c; float* hp = H + (size_t)row * DM + c;
            const f32x4 g0 = *(const f32x4*)gp, g1 = *(const f32x4*)(gp + 16);
            *(f32x4*)hp = *(const f32x4*)hp + g0 * v0; *(f32x4*)(hp + 16) = *(const f32x4*)(hp + 16) + g1 * v1; })
    }
};
struct EpiSwiglu {
    static constexpr bool PERM = false, AFTER_DRAIN = false;
    bf16* HID; int ldh;
    __device__ __forceinline__ void operator()(const pg8::f32x4 (&acc)[2][2][4][2], const pg8::Unit& u, int wr, int wc, int fr, int fq) const {
        EPI_LOOP({ (void)col; f32x4 r; for (int q = 0; q < 4; ++q) r[q] = siluf_(v0[q]) * v1[q];
            *(v2u*)(HID + (size_t)row * ldh + u.pn * 128 + bj * 64 + wc * 16 + 4 * fq) = pack4(r); })
    }
};
struct EpiSwiglu8 {
    static constexpr bool PERM = false, AFTER_DRAIN = false;
    unsigned char* HID; int ldh;
    __device__ __forceinline__ void operator()(const pg8::f32x4 (&acc)[2][2][4][2], const pg8::Unit& u, int wr, int wc, int fr, int fq) const {
        EPI_LOOP({ (void)col; f32x4 r; for (int q = 0; q < 4; ++q) r[q] = siluf_(v0[q]) * v1[q] * (float)(1 << F8_ACT_L2);
            *(unsigned*)(HID + (size_t)row * ldh + u.pn * 128 + bj * 64 + wc * 16 + 4 * fq) = cvt4_fp8(r[0], r[1], r[2], r[3]); })
    }
};
struct EpiY {
    static constexpr bool PERM = false, AFTER_DRAIN = false;
    bf16* Y; int first;
    __device__ __forceinline__ void operator()(const pg8::f32x4 (&acc)[2][2][4][2], const pg8::Unit& u, int wr, int wc, int fr, int fq) const {
        EPI_LOOP({ bf16* o = Y + (size_t)row * DM + u.pn * 256 + col; f32x4 r0 = v0, r1 = v1;
            if (!first) { unsigned long long w0 = __hip_atomic_load((unsigned long long*)o, RLX_AGENT), w1 = __hip_atomic_load((unsigned long long*)(o + 16), RLX_AGENT);
                r0 += unpack4((v2u){(unsigned)w0, (unsigned)(w0 >> 32)}); r1 += unpack4((v2u){(unsigned)w1, (unsigned)(w1 >> 32)}); }
            *(v2u*)o = pack4(r0); *(v2u*)(o + 16) = pack4(r1); })
    }
};

template <int MAP> __device__ __forceinline__ int map_col(int c) {
    if (MAP == 0) return c;
    if (MAP == 1) return c < 2560 ? c : (c < 2576 ? PC_AB + (c - 2560) : (c < 2832 ? PC_POOL + (c - 2576) : PC_GATE + (c - 2832)));
    if (MAP == 2) return (c >> 4) * 32 + (c & 15);
    return (c >> 4) * 32 + 16 + (c & 15);
}
template <int MAP> __device__ __forceinline__ void tr_item(const float* W, int ldw, int N, bf16* WT, int ldd, int item, LAS float* scr, int lane) {
    const int nblk = (N + 31) / 32, kb = item / nblk, nb = item % nblk, k0 = 64 * kb, n0 = 32 * nb;
    const int cl = n0 + (lane & 31);
    float tv[32];
#pragma unroll
    for (int i = 0; i < 32; ++i) { const int kk = 2 * i + (lane >> 5); tv[i] = cl < N ? W[(size_t)(k0 + kk) * ldw + cl] : 0.f; }
#pragma unroll
    for (int i = 0; i < 32; ++i) { const int kk = 2 * i + (lane >> 5); scr[kk * 33 + (lane & 31)] = tv[i]; }
    LDS_WAIT(); asm volatile("" ::: "memory");
    const int c = lane & 7;
#pragma unroll
    for (int j = 0; j < 4; ++j) { const int n = (lane >> 3) + 8 * j; const LAS float* s = scr + (8 * c) * 33 + n;
        if (n0 + n < N) { v4u o; o.x = pk2(s[0 * 33], s[1 * 33]); o.y = pk2(s[2 * 33], s[3 * 33]); o.z = pk2(s[4 * 33], s[5 * 33]); o.w = pk2(s[6 * 33], s[7 * 33]);
            *(GAS v4u*)(WT + (size_t)map_col<MAP>(n0 + n) * ldd + k0 + 8 * c) = o; } }
    LDS_WAIT(); asm volatile("" ::: "memory");
}
template <int MAP> __device__ __forceinline__ void tr_item8(const float* W, int ldw, int N, unsigned char* WT, int ldd, int item, LAS float* scr, int lane, float scale) {
    const int nblk = (N + 31) / 32, kb = item / nblk, nb = item % nblk, k0 = 64 * kb, n0 = 32 * nb;
    const int cl = n0 + (lane & 31);
    float tv[32];
#pragma unroll
    for (int i = 0; i < 32; ++i) { const int kk = 2 * i + (lane >> 5); tv[i] = cl < N ? W[(size_t)(k0 + kk) * ldw + cl] : 0.f; }
#pragma unroll
    for (int i = 0; i < 32; ++i) { const int kk = 2 * i + (lane >> 5); scr[kk * 33 + (lane & 31)] = tv[i]; }
    LDS_WAIT(); asm volatile("" ::: "memory");
    const int c = lane & 7;
#pragma unroll
    for (int j = 0; j < 4; ++j) { const int n = (lane >> 3) + 8 * j; const LAS float* s = scr + (8 * c) * 33 + n;
        if (n0 + n < N) { v2u o; o.x = cvt4_fp8(s[0 * 33] * scale, s[1 * 33] * scale, s[2 * 33] * scale, s[3 * 33] * scale); o.y = cvt4_fp8(s[4 * 33] * scale, s[5 * 33] * scale, s[6 * 33] * scale, s[7 * 33] * scale);
            *(GAS v2u*)(WT + (size_t)map_col<MAP>(n0 + n) * ldd + k0 + 8 * c) = o; } }
    LDS_WAIT(); asm volatile("" ::: "memory");
}
#define TR_RUN(MAP, W, ldw, K, N, WT, ldd) { const int cnt_ = ((K) / 64) * (((N) + 31) / 32); if (r < cnt_) { tr_item<MAP>(W, ldw, N, WT, ldd, r, scr, F.lane); continue; } r -= cnt_; }

__device__ __forceinline__ void p0_prologue(Frame& F, const Args& A) {
    LAS float* scr = (LAS float*)(F.lds + F.wave * 16384);
    const int gw = F.vcu * NWAVES + F.wave, NGW = F.G * NWAVES;
    bf16* WIN = (bf16*)(F.ws + WS_WIN); bf16* WBR = (bf16*)(F.ws + WS_WBR); bf16* WOUT = (bf16*)(F.ws + WS_WOUT); bf16* W13 = (bf16*)(F.ws + WS_W13); bf16* W2 = (bf16*)(F.ws + WS_W2);
    constexpr int PER_LAYER = 16 * 185 + 8 * 32 + 4 * 32 + 4 * 32 + 16 * 32, TOTAL = 2 * PER_LAYER + 16 * 88 * 2 + 44 * 32;
    for (int it = gw; it < TOTAL; it += NGW) {
        int r = it;
        for (int l = 0; l < 2; ++l) {
            bool hit = false;
            if (r < PER_LAYER) { hit = true;
                const float* win = A.in[F.zz + 8] + (size_t)l * 1024 * INW; const float* wbr = A.in[F.zz + 17] + (size_t)l * 1024 * 1024; const float* wo = A.in[F.zz + 18] + (size_t)l * 1024 * 1024;
                bf16* dbr = WBR + (size_t)l * 1024 * 1024;
                do {
                    { const int cnt_ = 16 * 185; if (r < cnt_) { tr_item<1>(win, INW, INW, WIN + (size_t)l * NPROJ * 1024, 1024, r, scr, F.lane); break; } r -= cnt_; }
                    { const int cnt_ = 8 * 32; if (r < cnt_) { tr_item<0>(wbr, 1024, 1024, dbr, 512, r, scr, F.lane); break; } r -= cnt_; }
                    { const int cnt_ = 4 * 32; if (r < cnt_) { tr_item<0>(wbr + 512 * 1024, 1024, 1024, dbr + 1024 * 512, 256, r, scr, F.lane); break; } r -= cnt_; }
                    { const int cnt_ = 4 * 32; if (r < cnt_) { tr_item<0>(wbr + 768 * 1024, 1024, 1024, dbr + 1024 * 768, 256, r, scr, F.lane); break; } r -= cnt_; }
                    tr_item<0>(wo, 1024, 1024, WOUT + (size_t)l * 1024 * 1024, 1024, r, scr, F.lane);
                } while (0);
            }
            if (hit) { r = -1; break; }
            r -= PER_LAYER;
        }
        if (r < 0) continue;
        { const int cnt_ = 16 * 88; if (r < cnt_) { tr_item<2>(A.in[F.zz + 19], FFD, FFD, W13, 1024, r, scr, F.lane); continue; } r -= cnt_; }
        { const int cnt_ = 16 * 88; if (r < cnt_) { tr_item<3>(A.in[F.zz + 20], FFD, FFD, W13, 1024, r, scr, F.lane); continue; } r -= cnt_; }
        tr_item<0>(A.in[F.zz + 21], 1024, 1024, W2, FFD, r, scr, F.lane);
    }
    float* H = (float*)(F.ws + WS_H);
    for (int R = gw; R < MROWS; R += NGW) { const int b = R / RPB, j = R - b * RPB;
        const float* src = j < CTXL ? A.in[F.zz + 2] + ((size_t)b * CTXL + j) * DM : A.in[F.zz + 0] + ((size_t)b * SEQ + (j - CTXL)) * DM;
        const GAS f32x4* s4 = (const GAS f32x4*)src + F.lane; GAS f32x4* d4 = (GAS f32x4*)(H + (size_t)R * DM) + F.lane;
#pragma unroll
        for (int q = 0; q < 4; ++q) d4[64 * q] = s4[64 * q]; }
    if (F.vcu == 0) {
        float* rope = (float*)(F.ws + WS_ROPE);
        for (int e = F.tid; e < 1024; e += NTHR) { const int pos = e >> 4, i = e & 15; const float inv = powf(10000.f, -(float)i / 16.f); const float a = (float)pos * inv;
            rope[2 * e] = cosf(a); rope[2 * e + 1] = sinf(a); }
        if (F.tid < 2) { const int l = F.tid; const float* lp = A.in[F.zz + 9] + l * 256; float s1 = 0.f, s2 = 0.f;
            for (int i = 0; i < 64; ++i) { s1 += lp[i] * lp[64 + i]; s2 += lp[128 + i] * lp[192 + i]; }
            const float li = 0.8f - 0.6f * expf(-0.3f * (float)l);
            ((float*)(F.ws + WS_LAM))[l] = expf(s1) - expf(s2) + li; }
    }
    __syncthreads();
    float* MOD = (float*)(F.ws + WS_MOD);
    LAS float* red = (LAS float*)F.lds;
    for (int task = F.vcu; task < 2 * 96; task += F.G) {
        const int l = task / 96, cc = task % 96;
        const float* aw = A.in[F.zz + 4] + (size_t)l * 1024 * 6144 + cc * 64 + F.lane;
        const float* c0 = A.in[F.zz + 1]; const float* cx = A.in[F.zz + 3];
        float a0 = 0.f, a1 = 0.f, a2 = 0.f, a3 = 0.f, a4 = 0.f;
#pragma unroll 8
        for (int i = 0; i < 128; ++i) { const int k = F.wave * 128 + i; const float w = aw[(size_t)k * 6144];
            a0 += siluf_(c0[k]) * w; a1 += siluf_(c0[1024 + k]) * w; a2 += siluf_(c0[2048 + k]) * w; a3 += siluf_(c0[3072 + k]) * w; a4 += siluf_(cx[k]) * w; }
        LAS float* rw = red + F.wave * 320 + F.lane;
        rw[0] = a0; rw[64] = a1; rw[128] = a2; rw[192] = a3; rw[256] = a4;
        __syncthreads();
        if (F.tid < 320) { float s = 0.f;
#pragma unroll
            for (int w = 0; w < 8; ++w) s += red[w * 320 + F.tid];
            const int rr = F.tid >> 6, jj = cc * 64 + (F.tid & 63);
            MOD[(l * 5 + rr) * 6144 + jj] = s + A.in[F.zz + 5][l * 6144 + jj]; }
        __syncthreads();
    }
}

__device__ __forceinline__ void moe_convert(Frame& F, const Args& A, int hh) {
    (void)hh;
    LAS float* scr = (LAS float*)(F.lds + F.wave * 16384);
    const int gw = F.vcu * NWAVES + F.wave, NGW = F.G * NWAVES;
    unsigned char* W13M = F.ws + WS_W13M; unsigned char* W2M = F.ws + WS_W2M;
    constexpr int I13 = 16 * 112, I2 = 56 * 32, PER_E = 2 * I13 + I2;
    for (int it = gw; it < 8 * PER_E; it += NGW) {
        const int e = it / PER_E; int r = it - e * PER_E;
        if (r < I13) { tr_item8<2>(A.in[F.zz + 23] + (size_t)e * 1024 * FFE, FFE, FFE, W13M + (size_t)e * 2 * FFE * 1024, 1024, r, scr, F.lane, (float)(1 << F8_W13_L2)); continue; } r -= I13;
        if (r < I13) { tr_item8<3>(A.in[F.zz + 24] + (size_t)e * 1024 * FFE, FFE, FFE, W13M + (size_t)e * 2 * FFE * 1024, 1024, r, scr, F.lane, (float)(1 << F8_W13_L2)); continue; } r -= I13;
        tr_item8<0>(A.in[F.zz + 25] + (size_t)e * FFE * 1024, 1024, 1024, W2M + (size_t)e * 1024 * FFE, FFE, r, scr, F.lane, (float)(1 << F8_W2_L2));
    }
}

__device__ __forceinline__ void norm_mod_phase(Frame& F, const Args& A, int l, int which, bool latent_only, bool route) {
    const int gw = F.vcu * NWAVES + F.wave, NGW = F.G * NWAVES;
    const float* H = (const float*)(F.ws + WS_H); bf16* U = (bf16*)(F.ws + WS_U); const float* MOD = (const float*)(F.ws + WS_MOD) + l * 5 * 6144;
    const float* g = (which ? A.in[F.zz + 7] : A.in[F.zz + 6]) + l * 1024;
    for (int R = gw; R < MROWS; R += NGW) {
        const int b = R / RPB, j = R - b * RPB; const bool isctx = j < CTXL; if (latent_only && isctx) continue;
        const float* mod = MOD + (isctx ? 4 : b) * 6144; const float* shift = mod + (which ? 3 : 0) * 1024; const float* scale = mod + (which ? 4 : 1) * 1024;
        const GAS f32x4* xr = (const GAS f32x4*)(H + (size_t)R * DM) + F.lane;
        f32x4 v[4]; float ss = 0.f;
#pragma unroll
        for (int q = 0; q < 4; ++q) { v[q] = xr[64 * q]; ss += (v[q].x * v[q].x + v[q].y * v[q].y) + (v[q].z * v[q].z + v[q].w * v[q].w); }
        const float rstd = 1.f / sqrtf(wave_sum(ss) * (1.f / DM) + EPSN);
        GAS v2u* o8 = (GAS v2u*)(U + (size_t)R * DM) + F.lane;
#pragma unroll
        for (int q = 0; q < 4; ++q) { const int c = 4 * F.lane + 256 * q; const f32x4 gg = *(const f32x4*)(g + c), sh = *(const f32x4*)(shift + c), sc = *(const f32x4*)(scale + c);
            v[q] = (v[q] * rstd) * gg * (sc + 1.f) + sh; v2u w; w.x = pk2(v[q].x, v[q].y); w.y = pk2(v[q].z, v[q].w); o8[64 * q] = w; }
        if (route) {
            const float* rw = A.in[F.zz + 22];
            float lg[8] = {0, 0, 0, 0, 0, 0, 0, 0};
#pragma unroll
            for (int q = 0; q < 4; ++q)
#pragma unroll
                for (int i = 0; i < 4; ++i) { const int k = 4 * F.lane + 256 * q + i; const f32x4 w0 = *(const f32x4*)(rw + k * 8), w1 = *(const f32x4*)(rw + k * 8 + 4); const float x = v[q][i];
                    lg[0] += x * w0[0]; lg[1] += x * w0[1]; lg[2] += x * w0[2]; lg[3] += x * w0[3]; lg[4] += x * w1[0]; lg[5] += x * w1[1]; lg[6] += x * w1[2]; lg[7] += x * w1[3]; }
#pragma unroll
            for (int e = 0; e < 8; ++e) lg[e] = wave_sum(lg[e]);
            if (F.lane == 0) {
                int e0 = 0; float v0 = lg[0];
#pragma unroll
                for (int e = 1; e < 8; ++e) if (lg[e] > v0) { v0 = lg[e]; e0 = e; }
                int e1 = -1; float v1 = -3.0e38f;
#pragma unroll
                for (int e = 0; e < 8; ++e) if (e != e0 && lg[e] > v1) { v1 = lg[e]; e1 = e; }
                const float ex = __expf(v1 - v0); const float w0 = 1.f / (1.f + ex), w1 = ex / (1.f + ex);
                gu32* cnt = F.ctl + CW_ECNT;
#ifdef DBG_DETPOS
                const unsigned p0 = 0, p1 = 0; (void)cnt;
#else
                const unsigned p0 = __hip_atomic_fetch_add(cnt + 64 * e0, 1u, RLX_AGENT), p1 = __hip_atomic_fetch_add(cnt + 64 * e1, 1u, RLX_AGENT);
#endif
                const int tk = b * SEQ + (j - CTXL);
                v4u* rt = (v4u*)(F.ws + WS_ROUTE) + 2 * tk;
                rt[0] = (v4u){(unsigned)e0, (unsigned)e1, p0, p1}; rt[1] = (v4u){__float_as_uint(w0), __float_as_uint(w1), 0u, 0u};
            }
        }
    }
}

__device__ __forceinline__ void moe_gather2(Frame& F) {
    const int gw = F.vcu * NWAVES + F.wave, NGW = F.G * NWAVES;
    MoeOrder mo; mo.init(F.ctl + CW_ECNT, 1, 1, 0);
    const bf16* U = (const bf16*)(F.ws + WS_U); unsigned char* XG = F.ws + WS_XG; const float sc = (float)(1 << F8_ACT_L2);
    for (int tk = gw; tk < NB * SEQ; tk += NGW) {
        const int b = tk / SEQ, t = tk - b * SEQ; const size_t R = (size_t)b * RPB + CTXL + t;
        const v4u rt = ((const v4u*)(F.ws + WS_ROUTE))[2 * tk];
        const size_t r0 = (size_t)mo.tile_off((int)rt.x) * 256 + rt.z, r1 = (size_t)mo.tile_off((int)rt.y) * 256 + rt.w;
        const GAS v4u* s = (const GAS v4u*)(U + R * DM) + 2 * F.lane; const v4u a = s[0], c = s[1];
        v4u o; o.x = cvt4_fp8(bf_lo(a.x) * sc, bf_hi(a.x) * sc, bf_lo(a.y) * sc, bf_hi(a.y) * sc); o.y = cvt4_fp8(bf_lo(a.z) * sc, bf_hi(a.z) * sc, bf_lo(a.w) * sc, bf_hi(a.w) * sc);
        o.z = cvt4_fp8(bf_lo(c.x) * sc, bf_hi(c.x) * sc, bf_lo(c.y) * sc, bf_hi(c.y) * sc); o.w = cvt4_fp8(bf_lo(c.z) * sc, bf_hi(c.z) * sc, bf_lo(c.w) * sc, bf_hi(c.w) * sc);
        *((GAS v4u*)(XG + r0 * DM) + F.lane) = o; *((GAS v4u*)(XG + r1 * DM) + F.lane) = o;
    }
}
__device__ __forceinline__ void moe_gather(Frame& F) {
#ifdef DBG_DETPOS
    if (F.vcu == 0 && F.tid == 0) { unsigned c[8] = {0,0,0,0,0,0,0,0};
        for (int tk = 0; tk < NB * SEQ; ++tk) { v4u* rt = (v4u*)(F.ws + WS_ROUTE) + 2 * tk; v4u r = rt[0];
            for (int e = 0; e < 8; ++e) { if ((int)r.x == e) r.z = c[e]++; } for (int e = 0; e < 8; ++e) { if ((int)r.y == e) r.w = c[e]++; } rt[0] = r; }
        for (int e = 0; e < 8; ++e) __hip_atomic_store(F.ctl + CW_ECNT + 64 * e, c[e], RLX_AGENT); }
    return;
#endif
    moe_gather2(F);
}
__device__ __forceinline__ void final_phase(Frame& F, const Args& A) {
    const int gw = F.vcu * NWAVES + F.wave, NGW = F.G * NWAVES;
    MoeOrder mo; mo.init(F.ctl + CW_ECNT, 1, 1, 0);
    const float* H = (const float*)(F.ws + WS_H); const bf16* Y = (const bf16*)(F.ws + WS_Y); const float* MOD = (const float*)(F.ws + WS_MOD) + 1 * 5 * 6144;
    for (int tk = gw; tk < NB * SEQ; tk += NGW) {
        const int b = tk / SEQ, t = tk - b * SEQ; const size_t R = (size_t)b * RPB + CTXL + t;
        const v4u rt = ((const v4u*)(F.ws + WS_ROUTE))[2 * tk], rw = ((const v4u*)(F.ws + WS_ROUTE))[2 * tk + 1];
        const size_t r0 = (size_t)mo.tile_off((int)rt.x) * 256 + rt.z, r1 = (size_t)mo.tile_off((int)rt.y) * 256 + rt.w;
        const float w0 = __uint_as_float(rw.x), w1 = __uint_as_float(rw.y);
        const float* gate = MOD + b * 6144 + 5 * 1024;
        f32x4 v[4]; float ss = 0.f;
#pragma unroll
        for (int q = 0; q < 4; ++q) { const int c = 4 * F.lane + 256 * q;
            const f32x4 h = *(const f32x4*)(H + R * DM + c), gg = *(const f32x4*)(gate + c);
            const f32x4 y0 = unpack4(*(const v2u*)(Y + r0 * DM + c)), y1 = unpack4(*(const v2u*)(Y + r1 * DM + c));
            v[q] = h + gg * (y0 * w0 + y1 * w1); ss += (v[q].x * v[q].x + v[q].y * v[q].y) + (v[q].z * v[q].z + v[q].w * v[q].w); }
        const float rstd = 1.f / sqrtf(wave_sum(ss) * (1.f / DM) + EPSN);
#pragma unroll
        for (int q = 0; q < 4; ++q) { const int c = 4 * F.lane + 256 * q; *(f32x4*)(F.out + (size_t)tk * DM + c) = v[q] * rstd * *(const f32x4*)(A.in[F.zz + 26] + c); }
    }
}

constexpr int DP = 65;
typedef short dn_bf16x8 __attribute__((ext_vector_type(8)));
__device__ __forceinline__ f32x4 mm_tile(const LAS float* Am, int a_sm, int a_sk, const LAS float* Bm, int b_sk, int b_sn, int m0, int n0, int lane) {
    const int r = lane & 15, q = lane >> 4; f32x4 acc = {0.f, 0.f, 0.f, 0.f};
#pragma unroll
    for (int ks = 0; ks < 2; ++ks) {
        const LAS float* ap = Am + (m0 + r) * a_sm + (32 * ks + 8 * q) * a_sk; const LAS float* bp = Bm + (32 * ks + 8 * q) * b_sk + (n0 + r) * b_sn;
        v4u a, b;
        a.x = pk2(ap[0], ap[a_sk]); a.y = pk2(ap[2 * a_sk], ap[3 * a_sk]); a.z = pk2(ap[4 * a_sk], ap[5 * a_sk]); a.w = pk2(ap[6 * a_sk], ap[7 * a_sk]);
        b.x = pk2(bp[0], bp[b_sk]); b.y = pk2(bp[2 * b_sk], bp[3 * b_sk]); b.z = pk2(bp[4 * b_sk], bp[5 * b_sk]); b.w = pk2(bp[6 * b_sk], bp[7 * b_sk]);
        acc = __builtin_amdgcn_mfma_f32_16x16x32_bf16(__builtin_bit_cast(dn_bf16x8, a), __builtin_bit_cast(dn_bf16x8, b), acc, 0, 0, 0);
    }
    return acc;
}

constexpr int RS = 72;
constexpr int IMG = 64 * RS * 2;
typedef short dn_s16x4 __attribute__((ext_vector_type(4)));
__device__ __forceinline__ f32x4 mm_img(const LAS bf16* Ai, const LAS bf16* Bi, int m0, int n0, int r, int q) {
    f32x4 acc = {0.f, 0.f, 0.f, 0.f};
    const LAS bf16* ap = Ai + (m0 + r) * RS + 8 * q; const LAS bf16* bp = Bi + (n0 + r) * RS + 8 * q;
    acc = __builtin_amdgcn_mfma_f32_16x16x32_bf16(*(const LAS dn_bf16x8*)ap, *(const LAS dn_bf16x8*)bp, acc, 0, 0, 0);
    acc = __builtin_amdgcn_mfma_f32_16x16x32_bf16(*(const LAS dn_bf16x8*)(ap + 32), *(const LAS dn_bf16x8*)(bp + 32), acc, 0, 0, 0);
    return acc;
}
template <int D> __device__ __forceinline__ void dn_diag_inv(LAS float* Dg, int ln) {
    const int blk = ln >> 4, r = ln & 15;
    LAS float* Ab = Dg + blk * 256;
    float t[16];
#pragma unroll
    for (int c = 0; c < 16; ++c) t[c] = (c == r) ? 1.f : 0.f;
#pragma unroll
    for (int c = 14; c >= 0; --c) { float s = 0.f;
#pragma unroll
        for (int j = c + 1; j < 16; ++j) { const float a = D == 0 ? Ab[j * 16 + c] : Ab[(15 - j) * 16 + (15 - c)]; s -= t[j] * a; }
        t[c] = (c < r) ? s : t[c]; }
    asm volatile("s_waitcnt lgkmcnt(0)" ::: "memory");
#pragma unroll
    for (int c = 0; c < 16; ++c) { if (D == 0) Ab[r * 16 + c] = t[c]; else Ab[(15 - r) * 16 + (15 - c)] = t[c]; }
}
template <int D> __device__ __forceinline__ void dn_solve_tiles(const LAS bf16* Ad, const LAS float* Dg, const LAS bf16* VT, const LAS bf16* KT, LAS bf16* UT, LAS bf16* WT,
                                                               const LAS float* Bd, const LAS float* Gd, int w4, int ln) {
    const int r = ln & 15, q = ln >> 4;
#pragma unroll 1
    for (int i = 0; i < 2; ++i) { const int nt = w4 * 2 + i; const bool isw = nt >= 4; const int c0 = (nt & 3) * 16 + r;
        const LAS bf16* src = (isw ? KT : VT) + c0 * RS; LAS bf16* dst = (isw ? WT : UT) + c0 * RS;
        f32x4 acc[4]; dn_s16x4 xb[4];
#pragma unroll
        for (int bi = 0; bi < 4; ++bi) { const v2u x = *(const LAS v2u*)(src + 16 * bi + 4 * q); const f32x4 xv = {bf_lo(x.x), bf_hi(x.x), bf_lo(x.y), bf_hi(x.y)};
#pragma unroll
            for (int g = 0; g < 4; ++g) { const int t = 16 * bi + 4 * q + g; const float sc = isw ? Bd[t] * __expf(Gd[t]) : Bd[t]; acc[bi][g] = xv[g] * sc; } }
#pragma unroll
        for (int st = 0; st < 4; ++st) { const int bi = D == 0 ? st : 3 - st;
#pragma unroll
            for (int s2 = 0; s2 < st; ++s2) { const int bj = D == 0 ? s2 : 3 - s2;
                v2u a = *(const LAS v2u*)(Ad + (16 * bi + r) * RS + 16 * bj + 4 * q); a.x ^= 0x80008000u; a.y ^= 0x80008000u;
                acc[bi] = __builtin_amdgcn_mfma_f32_16x16x16bf16_1k(__builtin_bit_cast(dn_s16x4, a), xb[bj], acc[bi], 0, 0, 0); }
            { const LAS float* tp = Dg + bi * 256 + r * 16 + 4 * q; v2u a; a.x = cvtpk_c(tp[0], tp[1]); a.y = cvtpk_c(tp[2], tp[3]);
              v2u xr; xr.x = cvtpk_c(acc[bi][0], acc[bi][1]); xr.y = cvtpk_c(acc[bi][2], acc[bi][3]);
              acc[bi] = __builtin_amdgcn_mfma_f32_16x16x16bf16_1k(__builtin_bit_cast(dn_s16x4, a), __builtin_bit_cast(dn_s16x4, xr), (f32x4){0.f, 0.f, 0.f, 0.f}, 0, 0, 0);
              v2u xo; xo.x = cvtpk_c(acc[bi][0], acc[bi][1]); xo.y = cvtpk_c(acc[bi][2], acc[bi][3]); xb[bi] = __builtin_bit_cast(dn_s16x4, xo);
              *(LAS v2u*)(dst + 16 * bi + 4 * q) = xo; }
        }
    }
}
__device__ __forceinline__ void dn_pre_unit(Frame& F, const Args& A, int l, int b, int n, int h) {
    LAS bf16* KcB = (LAS bf16*)(F.lds + 0 * IMG); LAS bf16* QcB = (LAS bf16*)(F.lds + 1 * IMG); LAS bf16* KT = (LAS bf16*)(F.lds + 2 * IMG); LAS bf16* VT = (LAS bf16*)(F.lds + 3 * IMG);
#define DIMG(d, k) ((LAS bf16*)(F.lds + (4 + 5 * (d) + (k)) * IMG))
    LAS float* Gs = (LAS float*)(F.lds + 14 * IMG);
    LAS float* Bs = Gs + 128;
    LAS float* Dg = Gs + 256;
    const bf16* P = (const bf16*)(F.ws + WS_PROJ); const float* GB = (const float*)(F.ws + WS_GB);
    int tid = threadIdx.x; asm volatile("" : "+v"(tid));
    const int wv = tid >> 6, ln = tid & 63, r = ln & 15, q = ln >> 4;
    const int row0 = b * RPB + n * 64; const int seq_lo = (n < 4) ? b * RPB : b * RPB + CTXL, seq_hi = (n < 4) ? b * RPB + CTXL : (b + 1) * RPB;
    {
        const int t = tid >> 3, cg = tid & 7;
        const float* cw = A.in[F.zz + 11] + (size_t)l * 5 * 768;
#pragma unroll
        for (int p = 0; p < 3; ++p) {
            const int ch = p * 256 + h * 64 + cg * 8;
            float acc[8] = {0, 0, 0, 0, 0, 0, 0, 0};
#pragma unroll
            for (int tap = 0; tap < 5; ++tap) { const int rr = row0 + t + tap - 2;
                if (rr >= seq_lo && rr < seq_hi) { const v4u x = *(const v4u*)(P + (size_t)rr * NPROJ + PC_DQ + ch);
                    const f32x4 w0 = *(const f32x4*)(cw + tap * 768 + ch), w1 = *(const f32x4*)(cw + tap * 768 + ch + 4);
                    acc[0] += bf_lo(x.x) * w0[0]; acc[1] += bf_hi(x.x) * w0[1]; acc[2] += bf_lo(x.y) * w0[2]; acc[3] += bf_hi(x.y) * w0[3];
                    acc[4] += bf_lo(x.z) * w1[0]; acc[5] += bf_hi(x.z) * w1[1]; acc[6] += bf_lo(x.w) * w1[2]; acc[7] += bf_hi(x.w) * w1[3]; } }
            float ss = 0.f;
#pragma unroll
            for (int i = 0; i < 8; ++i) { acc[i] = siluf_(acc[i]); ss += acc[i] * acc[i]; }
            float sc = 1.f;
            if (p < 2) { ss += __shfl_xor(ss, 1); ss += __shfl_xor(ss, 2); ss += __shfl_xor(ss, 4); sc = (1.f / sqrtf(ss + EPSN)) * (p == 0 ? 0.125f : 1.f); }
            v4u o; o.x = cvtpk_c(acc[0] * sc, acc[1] * sc); o.y = cvtpk_c(acc[2] * sc, acc[3] * sc); o.z = cvtpk_c(acc[4] * sc, acc[5] * sc); o.w = cvtpk_c(acc[6] * sc, acc[7] * sc);
            if (p == 0) *(LAS v4u*)(QcB + t * RS + cg * 8) = o;
            else { if (p == 1) *(LAS v4u*)(KcB + t * RS + cg * 8) = o;
                LAS bf16* tp = (p == 1 ? KT : VT) + (cg * 8) * RS + t;
                tp[0 * RS] = (bf16)(o.x & 0xffffu); tp[1 * RS] = (bf16)(o.x >> 16); tp[2 * RS] = (bf16)(o.y & 0xffffu); tp[3 * RS] = (bf16)(o.y >> 16);
                tp[4 * RS] = (bf16)(o.z & 0xffffu); tp[5 * RS] = (bf16)(o.z >> 16); tp[6 * RS] = (bf16)(o.w & 0xffffu); tp[7 * RS] = (bf16)(o.w >> 16); }
        }
        if (wv < 2) { const int d = wv; const float* gb = GB + (size_t)(row0 + ln) * 16; const float g = gb[d * 4 + h]; Bs[d * 64 + ln] = gb[8 + d * 4 + h];
            float pf = g;
#pragma unroll
            for (int o = 1; o < 64; o <<= 1) { const float v = __shfl_up(pf, o); if (ln >= o) pf += v; }
            const float tot = __shfl(pf, 63);
            Gs[d * 64 + ln] = d == 0 ? pf : tot - pf + g; }
    }
    __syncthreads();
    {
#pragma unroll
        for (int i = 0; i < 2; ++i) { const int tile = wv * 2 + i, m0 = (tile >> 2) * 16, n0 = (tile & 3) * 16;
            const f32x4 kk = mm_img(KcB, KcB, m0, n0, r, q), qk = mm_img(QcB, KcB, m0, n0, r, q);
            const int s = n0 + r; const float g0s = Gs[s], g1s = Gs[64 + s];
#pragma unroll
            for (int g = 0; g < 4; ++g) { const int t = m0 + 4 * q + g; const float e0 = __expf(Gs[t] - g0s), e1 = __expf(Gs[64 + t] - g1s);
                const float a0 = (s < t) ? Bs[t] * kk[g] * e0 : 0.f, a1 = (s > t) ? Bs[64 + t] * kk[g] * e1 : 0.f;
                DIMG(0, 0)[t * RS + s] = (bf16)f2bf(a0); DIMG(1, 0)[t * RS + s] = (bf16)f2bf(a1);
                DIMG(0, 1)[t * RS + s] = (bf16)f2bf((s <= t) ? qk[g] * e0 : 0.f); DIMG(1, 1)[t * RS + s] = (bf16)f2bf((s >= t) ? qk[g] * e1 : 0.f);
                if (m0 == n0) { Dg[(m0 >> 4) * 256 + (t & 15) * 16 + r] = a0; Dg[1024 + (m0 >> 4) * 256 + (t & 15) * 16 + r] = a1; } } }
        { const int c = tid >> 3, t0 = (tid & 7) * 8; const v4u kx = *(const LAS v4u*)(KT + c * RS + t0); const float gl0 = Gs[63], gl1 = Gs[64];
          const float kf[8] = {bf_lo(kx.x), bf_hi(kx.x), bf_lo(kx.y), bf_hi(kx.y), bf_lo(kx.z), bf_hi(kx.z), bf_lo(kx.w), bf_hi(kx.w)};
          float s0[8], s1[8];
#pragma unroll
          for (int j = 0; j < 8; ++j) { s0[j] = kf[j] * __expf(gl0 - Gs[t0 + j]); s1[j] = kf[j] * __expf(gl1 - Gs[64 + t0 + j]); }
          v4u o0, o1; o0.x = cvtpk_c(s0[0], s0[1]); o0.y = cvtpk_c(s0[2], s0[3]); o0.z = cvtpk_c(s0[4], s0[5]); o0.w = cvtpk_c(s0[6], s0[7]);
          o1.x = cvtpk_c(s1[0], s1[1]); o1.y = cvtpk_c(s1[2], s1[3]); o1.z = cvtpk_c(s1[4], s1[5]); o1.w = cvtpk_c(s1[6], s1[7]);
          *(LAS v4u*)(DIMG(0, 4) + c * RS + t0) = o0; *(LAS v4u*)(DIMG(1, 4) + c * RS + t0) = o1; }
    }
    __syncthreads();
    if (wv == 0) dn_diag_inv<0>(Dg, ln); else if (wv == 4) dn_diag_inv<1>(Dg + 1024, ln);
    __syncthreads();
    if (wv < 4) dn_solve_tiles<0>(DIMG(0, 0), Dg, VT, KT, DIMG(0, 3), DIMG(0, 2), Bs, Gs, wv & 3, ln);
    else dn_solve_tiles<1>(DIMG(1, 0), Dg + 1024, VT, KT, DIMG(1, 3), DIMG(1, 2), Bs + 64, Gs + 64, wv & 3, ln);
    __syncthreads();
    {
        const int d = wv >> 2, mt = wv & 3;
        const LAS bf16* Aq = DIMG(d, 1); const LAS bf16* WT = DIMG(d, 2); const LAS bf16* UT = DIMG(d, 3); const LAS bf16* KsT = DIMG(d, 4); const LAS float* Gd = Gs + d * 64;
        const float glast = d == 0 ? Gd[63] : Gd[0];
        const size_t prob = (((size_t)b * NCHUNK + n) * 4 + h) * 2 + d;
        unsigned char* out = F.ws + WS_DNP + prob * 32768;
        if (ln == 0 && mt == 0) ((float*)(F.ws + WS_DNG))[prob] = __expf(glast);
        const float gq = __expf(Gd[16 * mt + r]);
#pragma unroll
        for (int ks = 0; ks < 2; ++ks) {
            const f32x4 y0 = mm_img(WT, Aq, 32 * ks, 16 * mt, r, q), y1 = mm_img(WT, Aq, 32 * ks + 16, 16 * mt, r, q);
            const LAS bf16* qp = QcB + (16 * mt + r) * RS + 32 * ks + 4 * q; const v2u qa = *(const LAS v2u*)qp, qb = *(const LAS v2u*)(qp + 16);
            v4u o; o.x = cvtpk_c(gq * bf_lo(qa.x) - y0[0], gq * bf_hi(qa.x) - y0[1]); o.y = cvtpk_c(gq * bf_lo(qa.y) - y0[2], gq * bf_hi(qa.y) - y0[3]);
            o.z = cvtpk_c(gq * bf_lo(qb.x) - y1[0], gq * bf_hi(qb.x) - y1[1]); o.w = cvtpk_c(gq * bf_lo(qb.y) - y1[2], gq * bf_hi(qb.y) - y1[3]);
            *(v4u*)(out + (mt * 2 + ks) * 1024 + ln * 16) = o;
            const f32x4 c0 = mm_img(WT, KsT, 32 * ks, 16 * mt, r, q), c1 = mm_img(WT, KsT, 32 * ks + 16, 16 * mt, r, q);
            v4u oc; oc.x = cvtpk_c(-c0[0], -c0[1]); oc.y = cvtpk_c(-c0[2], -c0[3]); oc.z = cvtpk_c(-c1[0], -c1[1]); oc.w = cvtpk_c(-c1[2], -c1[3]);
            *(v4u*)(out + 8192 + (mt * 2 + ks) * 1024 + ln * 16) = oc; }
#pragma unroll
        for (int nt = 0; nt < 4; ++nt) { const f32x4 rr = mm_img(Aq, UT, 16 * mt, 16 * nt, r, q), bb = mm_img(KsT, UT, 16 * mt, 16 * nt, r, q);
            v2u o; o.x = cvtpk_c(rr[0], rr[1]); o.y = cvtpk_c(rr[2], rr[3]); *(v2u*)(out + 16384 + (mt * 4 + nt) * 512 + ln * 8) = o;
            v2u ob; ob.x = cvtpk_c(bb[0], bb[1]); ob.y = cvtpk_c(bb[2], bb[3]); *(v2u*)(out + 24576 + (mt * 4 + nt) * 512 + ln * 8) = ob; }
    }
    __syncthreads();
#ifdef DBG_DN
    { unsigned char* out = F.ws + WS_DNP + ((((size_t)b * NCHUNK + n) * 4 + h) * 2) * 32768;
      if (DBG_DN < 14) { const LAS bf16* im = (const LAS bf16*)(F.lds + DBG_DN * IMG);
          for (int e = tid; e < 4096; e += NTHR) ((bf16*)out)[e] = im[(e >> 6) * RS + (e & 63)]; }
      else { for (int e = tid; e < 2304; e += NTHR) ((bf16*)out)[e] = (bf16)f2bf(Gs[e]); for (int e = 2304 + tid; e < 4096; e += NTHR) ((bf16*)out)[e] = 0; } }
    __syncthreads();
#endif
#undef DIMG
}

__device__ __forceinline__ void pool_unit(Frame& F, const Args& A, int l, int blk, int g) {
    LAS float* Uw = (LAS float*)F.lds;
    LAS float* Mm = Uw + 80 * DP;
    LAS float* PW = Mm + 64 * DP;
    const bf16* P = (const bf16*)(F.ws + WS_PROJ); bf16* MIX = (bf16*)(F.ws + WS_MIX);
    int tid = threadIdx.x; asm volatile("" : "+v"(tid));
    const int row0 = blk * 64, b = row0 / RPB, j0 = row0 - b * RPB; const bool isctx = j0 < CTXL;
    const int seq_lo = isctx ? b * RPB : b * RPB + CTXL, L = isctx ? CTXL : SEQ; const int pos0 = row0 - seq_lo;
    for (int idx = tid; idx < 640; idx += NTHR) { const int rr = idx >> 3, c8 = (idx & 7) * 8; const int pos = pos0 - 8 + rr;
        float v[8] = {0, 0, 0, 0, 0, 0, 0, 0};
        if (pos >= 0 && pos < L) { const v4u x = *(const v4u*)(P + (size_t)(seq_lo + pos) * NPROJ + PC_POOL + g * 64 + c8);
            v[0] = bf_lo(x.x); v[1] = bf_hi(x.x); v[2] = bf_lo(x.y); v[3] = bf_hi(x.y); v[4] = bf_lo(x.z); v[5] = bf_hi(x.z); v[6] = bf_lo(x.w); v[7] = bf_hi(x.w); }
#pragma unroll
        for (int i = 0; i < 8; ++i) Uw[rr * DP + c8 + i] = v[i]; }
    { const float* pw = A.in[F.zz + 15] + ((size_t)l * 4 + g) * 4096;
#pragma unroll
      for (int k = 0; k < 8; ++k) { const int e = tid + 512 * k; PW[(e >> 6) * DP + (e & 63)] = pw[e]; } }
    __syncthreads();
    const int win = 2 << g;
#pragma unroll 1
    for (int k = 0; k < 8; ++k) { const int e = tid + 512 * k, t = e >> 6, i = e & 63; const int pos = pos0 + t;
        int lo = pos - win / 2, hi = lo + win; lo = lo < 0 ? 0 : lo; hi = hi > L ? L : hi;
        float s = 0.f;
#pragma unroll 4
        for (int p = lo; p < hi; ++p) s += Uw[(p - pos0 + 8) * DP + i];
        Mm[t * DP + i] = s / (float)(hi - lo) - Uw[(t + 8) * DP + i]; }
    __syncthreads();
    const float* psc = A.in[F.zz + 16] + l * 256 + g * 64;
    { const int wv = tid >> 6, ln = tid & 63, r = ln & 15, q = ln >> 4;
#pragma unroll
      for (int i = 0; i < 2; ++i) { const int tile = wv * 2 + i, m0 = (tile >> 2) * 16, n0 = (tile & 3) * 16;
          const f32x4 y = mm_tile(Mm, DP, 1, PW, DP, 1, m0, n0, ln); const float sc = psc[n0 + r];
#pragma unroll
          for (int gg = 0; gg < 4; ++gg) MIX[(size_t)(row0 + m0 + 4 * q + gg) * DM + 768 + g * 64 + n0 + r] = (bf16)f2bf(y[gg] * sc); } }
    __syncthreads();
}

constexpr int SC_SLOT = 32768, SC_NSLOT = 4, SC_ST = SC_SLOT * SC_NSLOT, SC_GL = SC_ST + 2 * 8192;
__device__ __forceinline__ void dn_scan_item(Frame& F, int item) {
    typedef short s16x8v __attribute__((ext_vector_type(8)));
    const int d = item & 1, h = (item >> 1) & 3, b = item >> 3;
    int tid = threadIdx.x; asm volatile("" : "+v"(tid));
    const int wv = __builtin_amdgcn_readfirstlane(tid >> 6), ln = tid & 63, r = ln & 15, q = ln >> 4;
    LAS unsigned char* L = F.lds;
    LAS float* glv = (LAS float*)(L + SC_GL);
    const unsigned char* dnp = F.ws + WS_DNP;
#define SC_N(st) (d == 0 ? (st) : ((st) < 4 ? 3 - (st) : 71 - (st)))
#define SC_PROB(st) ((((size_t)b * NCHUNK + SC_N(st)) * 4 + h) * 2 + d)
    if (tid < NCHUNK) glv[tid] = ((const float*)(F.ws + WS_DNG))[SC_PROB(tid)];
    for (int e = tid; e < 2 * 8192 / 16; e += NTHR) ((LAS v4u*)(L + SC_ST))[e] = (v4u){0u, 0u, 0u, 0u};
    asm volatile("s_waitcnt vmcnt(0) lgkmcnt(0)" ::: "memory"); __builtin_amdgcn_s_barrier();
#define SC_DMA(st, slot) do { const unsigned char* src_ = dnp + SC_PROB(st) * 32768 + wv * 8192 + ln * 16; \
        _Pragma("unroll") for (int i_ = 0; i_ < 8; ++i_) __builtin_amdgcn_global_load_lds((const unsigned*)(src_ + i_ * 1024), (LAS unsigned*)(L + (slot) * SC_SLOT + wv * 8192 + i_ * 1024), 16, 0, 0); } while (0)
    if (wv < 4) { SC_DMA(0, 0); SC_DMA(1, 1); SC_DMA(2, 2); }
    f32x4 s0 = {0.f, 0.f, 0.f, 0.f}, s1 = s0, s2 = s0, s3 = s0;
    bf16* DNO = (bf16*)(F.ws + WS_DNO) + (size_t)d * MROWS * 256;
#pragma unroll 1
    for (int st = 0; st < NCHUNK; ++st) {
        if (wv < 4) asm volatile("s_waitcnt vmcnt(16)" ::: "memory");
        asm volatile("s_waitcnt lgkmcnt(0)" ::: "memory"); __builtin_amdgcn_s_barrier();
        if (wv < 4) { const int nx = st + 3 < NCHUNK ? st + 3 : NCHUNK - 1; SC_DMA(nx, (st + 3) & 3); }
        const LAS unsigned char* slot = L + (st & 3) * SC_SLOT;
        const LAS unsigned char* stc = L + SC_ST + (st & 1) * 8192; LAS unsigned char* stn = L + SC_ST + ((st + 1) & 1) * 8192;
        const int nt = wv & 3;
        const s16x8v bf0 = *(const LAS s16x8v*)(stc + (nt * 2 + 0) * 1024 + ln * 16), bf1 = *(const LAS s16x8v*)(stc + (nt * 2 + 1) * 1024 + ln * 16);
        if (wv < 4) {
            const float gl = glv[st];
            const LAS unsigned char* cf = slot + 8192; const LAS unsigned char* bi = slot + 24576;
#define SC_ST_TILE(S, mt) do { const v2u bw_ = *(const LAS v2u*)(bi + ((mt) * 4 + nt) * 512 + ln * 8); \
            f32x4 a_ = {gl * S[0] + bf_lo(bw_.x), gl * S[1] + bf_hi(bw_.x), gl * S[2] + bf_lo(bw_.y), gl * S[3] + bf_hi(bw_.y)}; \
            a_ = __builtin_amdgcn_mfma_f32_16x16x32_bf16(*(const LAS s16x8v*)(cf + ((mt) * 2 + 0) * 1024 + ln * 16), bf0, a_, 0, 0, 0); \
            a_ = __builtin_amdgcn_mfma_f32_16x16x32_bf16(*(const LAS s16x8v*)(cf + ((mt) * 2 + 1) * 1024 + ln * 16), bf1, a_, 0, 0, 0); S = a_; } while (0)
            SC_ST_TILE(s0, 0); SC_ST_TILE(s1, 1); SC_ST_TILE(s2, 2); SC_ST_TILE(s3, 3);
#undef SC_ST_TILE
            v4u w0, w1; w0.x = pk2(s0[0], s0[1]); w0.y = pk2(s0[2], s0[3]); w0.z = pk2(s1[0], s1[1]); w0.w = pk2(s1[2], s1[3]);
            w1.x = pk2(s2[0], s2[1]); w1.y = pk2(s2[2], s2[3]); w1.z = pk2(s3[0], s3[1]); w1.w = pk2(s3[2], s3[3]);
            *(LAS v4u*)(stn + (nt * 2 + 0) * 1024 + ln * 16) = w0; *(LAS v4u*)(stn + (nt * 2 + 1) * 1024 + ln * 16) = w1;
        } else {
            const LAS unsigned char* pf = slot; const LAS unsigned char* ri = slot + 16384;
            const int n = SC_N(st);
            bf16* orow = DNO + (size_t)(b * RPB + n * 64 + 4 * q) * 256 + h * 64 + nt * 16 + r;
#pragma unroll
            for (int mt = 0; mt < 4; ++mt) { const v2u rw_ = *(const LAS v2u*)(ri + (mt * 4 + nt) * 512 + ln * 8);
                f32x4 a_ = {bf_lo(rw_.x), bf_hi(rw_.x), bf_lo(rw_.y), bf_hi(rw_.y)};
                a_ = __builtin_amdgcn_mfma_f32_16x16x32_bf16(*(const LAS s16x8v*)(pf + (mt * 2 + 0) * 1024 + ln * 16), bf0, a_, 0, 0, 0);
                a_ = __builtin_amdgcn_mfma_f32_16x16x32_bf16(*(const LAS s16x8v*)(pf + (mt * 2 + 1) * 1024 + ln * 16), bf1, a_, 0, 0, 0);
#pragma unroll
                for (int g = 0; g < 4; ++g) orow[(size_t)(16 * mt + g) * 256] = (bf16)f2bf(a_[g]); }
        }
    }
    asm volatile("s_waitcnt vmcnt(0) lgkmcnt(0)" ::: "memory"); __builtin_amdgcn_s_barrier();
#undef SC_DMA
#undef SC_N
#undef SC_PROB
}

__device__ __forceinline__ void mix_build(Frame& F, const Args& A, int l) {
    int lane = threadIdx.x & 63; asm volatile("" : "+v"(lane)); const int gw = F.vcu * NWAVES + F.wave, NGW = F.G * NWAVES;
    const bf16* ATTO = (const bf16*)(F.ws + WS_ATTO); const bf16* P = (const bf16*)(F.ws + WS_PROJ); const bf16* DNO = (const bf16*)(F.ws + WS_DNO); bf16* MIX = (bf16*)(F.ws + WS_MIX);
    const float lam = ((const float*)(F.ws + WS_LAM))[l]; const float li = 0.8f - 0.6f * expf(-0.3f * (float)l);
    const float* sg = A.in[F.zz + 10] + l * 128; const float* ng = A.in[F.zz + 14] + l * 64;
    for (int R = gw; R < MROWS; R += NGW) {
        const int j = R % RPB; if (l == 1 && j < CTXL) continue;
        { const int hh = lane >> 4, e0 = (lane & 15) * 8;
          const v4u a = *(const v4u*)(ATTO + (size_t)R * DM + (hh * 2) * 128 + e0), c = *(const v4u*)(ATTO + (size_t)R * DM + (hh * 2 + 1) * 128 + e0);
          float x[8] = {bf_lo(a.x) - lam * bf_lo(c.x), bf_hi(a.x) - lam * bf_hi(c.x), bf_lo(a.y) - lam * bf_lo(c.y), bf_hi(a.y) - lam * bf_hi(c.y),
                        bf_lo(a.z) - lam * bf_lo(c.z), bf_hi(a.z) - lam * bf_hi(c.z), bf_lo(a.w) - lam * bf_lo(c.w), bf_hi(a.w) - lam * bf_hi(c.w)};
          float ss = 0.f;
#pragma unroll
          for (int i = 0; i < 8; ++i) ss += x[i] * x[i];
          ss += __shfl_xor(ss, 1); ss += __shfl_xor(ss, 2); ss += __shfl_xor(ss, 4); ss += __shfl_xor(ss, 8);
          const float sc = (1.f / sqrtf(ss * (1.f / 128.f) + EPSN)) * (1.f - li);
          const f32x4 g0 = *(const f32x4*)(sg + e0), g1 = *(const f32x4*)(sg + e0 + 4);
          v4u o; o.x = pk2(x[0] * sc * g0[0], x[1] * sc * g0[1]); o.y = pk2(x[2] * sc * g0[2], x[3] * sc * g0[3]); o.z = pk2(x[4] * sc * g1[0], x[5] * sc * g1[1]); o.w = pk2(x[6] * sc * g1[2], x[7] * sc * g1[3]);
          *(v4u*)(MIX + (size_t)R * DM + hh * 128 + e0) = o; }
        { const int c0 = lane * 4;
          const v2u a = *(const v2u*)(DNO + (size_t)R * 256 + c0), c = *(const v2u*)(DNO + ((size_t)MROWS + R) * 256 + c0), z = *(const v2u*)(P + (size_t)R * NPROJ + PC_DZ + c0);
          float x[4] = {bf_lo(a.x) + bf_lo(c.x), bf_hi(a.x) + bf_hi(c.x), bf_lo(a.y) + bf_lo(c.y), bf_hi(a.y) + bf_hi(c.y)};
          float ss = x[0] * x[0] + x[1] * x[1] + x[2] * x[2] + x[3] * x[3];
          ss += __shfl_xor(ss, 1); ss += __shfl_xor(ss, 2); ss += __shfl_xor(ss, 4); ss += __shfl_xor(ss, 8);
          const float sc = 1.f / sqrtf(ss * (1.f / 64.f) + EPSN);
          const f32x4 gg = *(const f32x4*)(ng + (c0 & 63));
          v2u o; o.x = pk2(x[0] * sc * gg[0] * siluf_(bf_lo(z.x)), x[1] * sc * gg[1] * siluf_(bf_hi(z.x))); o.y = pk2(x[2] * sc * gg[2] * siluf_(bf_lo(z.y)), x[3] * sc * gg[3] * siluf_(bf_hi(z.y)));
          *(v2u*)(MIX + (size_t)R * DM + 512 + c0) = o; }
    }
}

#ifndef MK_N_LAUNCHES
#define MK_N_LAUNCHES 1
#endif
__global__ void __launch_bounds__(NTHR, 2) mk_fwd(Args args) {
    extern __shared__ __attribute__((aligned(16))) unsigned char lds[];
    Frame F;
    F.lds = (LAS unsigned char*)lds;
    F.MISC = (volatile LAS unsigned*)(F.lds + MISC_OFF);
    F.tid = threadIdx.x; F.lane = F.tid & 63; F.wave = __builtin_amdgcn_readfirstlane(F.tid >> 6);
    F.G = gridDim.x; { const int bx = blockIdx.x; F.vcu = (F.G % 8 == 0) ? (bx % 8) * (F.G / 8) + bx / 8 : bx; }
    F.ws = args.ws; F.out = args.out; F.zz = 0;
    F.ctl = (gu32*)(args.ws + WS_CTL);
    for (int u = F.tid; u < (LDS_BYTES - MISC_OFF) / 4; u += NTHR) ((LAS unsigned*)(F.lds + MISC_OFF))[u] = 0u;
    __syncthreads();
    const int lo = args.ph_lo, hi = args.ph_hi;
    const bool use_bar = (hi - lo) > 1;
    XcdBarrier bar; bar.bar = (unsigned*)(F.ctl + CW_BAR); bar.x = 0; bar.st = nullptr;
    if (use_bar) bar = xcd_barrier_post((unsigned*)(F.ctl + CW_BAR), F.MISC + 8);
#ifndef EN_MASK
#define EN_MASK 0xFFFFFFFFu
#endif
#define IN(k) (((EN_MASK >> ((k) > 12 ? (k) - 12 : (k))) & 1u) && lo <= (k) && (k) < hi)
#define PB() do { int z_ = 0; asm volatile("" : "+s"(z_)); F.ws = args.ws + z_; F.ctl = (gu32*)(args.ws + z_); F.zz = z_; int t_ = threadIdx.x; asm volatile("" : "+v"(t_)); F.tid = t_; F.lane = t_ & 63; F.wave = __builtin_amdgcn_readfirstlane(t_ >> 6); } while (0)
#ifdef DBG_DUP
#define NREP(k) ((((k) > 12 && (k) < 23) ? (k) - 12 : (k)) == DBG_DUP ? 2 : 1)
#else
#define NREP(k) 1
#endif
#define SEAMX() do { XcdBarrier bl_ = bar; { int z_ = 0; unsigned x_ = bar.x; asm volatile("" : "+s"(z_), "+s"(x_)); bl_.bar = (unsigned*)(args.ws + WS_CTL) + CW_BAR + z_; bl_.x = x_; } xcd_barrier(bl_); } while (0)
#define PH_BEGIN(k) if (IN(k)) { for (int rep_ = 0; rep_ < NREP(k); ++rep_) { if (rep_) SEAMX(); PB();
#define PH_END(k) } } SEAM(k);
#define SEAM(k) do { if (IN(k) && IN((k) + 1)) { XcdBarrier bl_ = bar; { int z_ = 0; unsigned x_ = bar.x; asm volatile("" : "+s"(z_), "+s"(x_)); bl_.bar = (unsigned*)(args.ws + WS_CTL) + CW_BAR + z_; bl_.x = x_; } xcd_barrier(bl_); } } while (0)
    char* ldsg = (char*)lds;

    PH_BEGIN(PH_PRO) p0_prologue(F, args); PH_END(PH_PRO)

#pragma unroll 1
    for (int l = 0; l < 2; ++l) {
        const int pb = 1 + 12 * l;
        const float* modl = (const float*)(F.ws + WS_MOD) + l * 5 * 6144;
        PH_BEGIN(pb + PH_N1) norm_mod_phase(F, args, l, 0, false, false); PH_END(pb + PH_N1)
        PH_BEGIN(pb + PH_PROJ)
            pg8::Gemm g{(const bf16*)(F.ws + WS_U), (const bf16*)(F.ws + WS_WIN) + (size_t)l * NPROJ * 1024, 1024, 1024, 1024};
            TileOrder S; S.init(MROWS / 256, NPROJ / 256, F.G, (int)blockIdx.x, 0);
            EpiProj E{(bf16*)(F.ws + WS_PROJ), (float*)(F.ws + WS_GB), (const float*)(F.ws + WS_ROPE), args.in[F.zz + 12] + l * 8, args.in[F.zz + 13] + l * 8};
            pg8::gemm_phase<EpiProj, TileOrder, true, true>(F.lds, g, S, E);
        PH_END(pb + PH_PROJ)
        PH_BEGIN(pb + PH_ATT)
            const bf16* P = (const bf16*)(F.ws + WS_PROJ); bf16* AO = (bf16*)(F.ws + WS_ATTO);
            const int nunits = 512 + (l == 0 ? 32 : 0);
#ifndef DIS_ATTN
#ifdef DBG_DUP
            for (int r2_ = 0; r2_ < (DBG_DUP == 31 ? 2 : 1); ++r2_)
#endif
#pragma unroll 1
            for (int u = F.vcu; u < nunits; u += F.G) {
                int b, hm, qrow, seq;
                if (u < 512) { b = u >> 7; hm = (u >> 4) & 7; qrow = CTXL + (u & 15) * 256; seq = RPB; }
                else { const int v = u - 512; b = v >> 3; hm = v & 7; qrow = 0; seq = CTXL; }
                const size_t r0 = (size_t)b * RPB;
                attn::attn_unit<NPROJ, DM>(P + (r0 + qrow) * NPROJ + PC_AQ + hm * 64, P + r0 * NPROJ + PC_AK + hm * 64, P + r0 * NPROJ + PC_AV + (hm >> 1) * 128,
                                           AO + (r0 + qrow) * DM + hm * 128, seq, ldsg);
            }
#endif
#ifndef DIS_DNPRE
#ifdef DBG_DUP
            for (int r2_ = 0; r2_ < (DBG_DUP == 32 ? 2 : 1); ++r2_)
#endif
#pragma unroll 1
            for (int u = F.vcu; u < NB * NCHUNK * 4; u += F.G) { const int h = u & 3, n = (u >> 2) % NCHUNK, b = (u >> 2) / NCHUNK; dn_pre_unit(F, args, l, b, n, h); }
#endif
        PH_END(pb + PH_ATT)
        PH_BEGIN(pb + PH_SCAN)
#pragma unroll 1
            for (int it = F.vcu; it < 32; it += F.G) dn_scan_item(F, it);
            if (F.G > 32) { if (F.vcu >= 32) {
#pragma unroll 1
                for (int u = F.vcu - 32; u < (MROWS / 64) * 4; u += F.G - 32) pool_unit(F, args, l, u >> 2, u & 3); } }
            else {
#pragma unroll 1
                for (int u = F.vcu; u < (MROWS / 64) * 4; u += F.G) pool_unit(F, args, l, u >> 2, u & 3); }
        PH_END(pb + PH_SCAN)
        PH_BEGIN(pb + PH_MIXB) mix_build(F, args, l); PH_END(pb + PH_MIXB)
#pragma unroll 1
        for (int s = 0; s < 3; ++s) {
            if (IN(pb + PH_MRG0 + s)) { PB();
                const int koff = s == 0 ? 0 : (s == 1 ? 512 : 768), ks = s == 0 ? 512 : 256;
                pg8::Gemm g{(const bf16*)(F.ws + WS_MIX) + koff, (const bf16*)(F.ws + WS_WBR) + (size_t)l * 1024 * 1024 + (size_t)1024 * koff, ks, 1024, ks};
                TileOrder S; S.init(l == 0 ? 68 : 64, 4, F.G, (int)blockIdx.x, l);
                EpiMerge E{(bf16*)(F.ws + WS_MG), (const bf16*)(F.ws + WS_PROJ), PC_GATE + s * 1024, s == 0};
                pg8::gemm_phase<EpiMerge, TileOrder, true, true>(F.lds, g, S, E);
            }
            if (s < 2) { if (IN(pb + PH_MRG0 + s)) { PB(); VM_WAIT(); __syncthreads(); } } else SEAM(pb + PH_MRG2);
        }
        if (IN(pb + PH_OUT)) { PB();
            pg8::Gemm g{(const bf16*)(F.ws + WS_MG), (const bf16*)(F.ws + WS_WOUT) + (size_t)l * 1024 * 1024, 1024, 1024, 1024};
            TileOrder S; S.init(l == 0 ? 68 : 64, 4, F.G, (int)blockIdx.x, l);
            EpiResid E{(float*)(F.ws + WS_H), modl, 2};
            pg8::gemm_phase<EpiResid, TileOrder, true, true>(F.lds, g, S, E);
        } SEAM(pb + PH_OUT);
        PH_BEGIN(pb + PH_N2) norm_mod_phase(F, args, l, 1, l == 1, l == 1); PH_END(pb + PH_N2)
        if (l == 0) {
            PH_BEGIN(PH_FUP)
                pg8::Gemm g{(const bf16*)(F.ws + WS_U), (const bf16*)(F.ws + WS_W13), 1024, 1024, 1024};
                TileOrder S; S.init(68, 2 * FFD / 256, F.G, (int)blockIdx.x, 0);
                EpiSwiglu E{(bf16*)(F.ws + WS_HID), FFD};
                pg8::gemm_phase<EpiSwiglu, TileOrder, true, true>(F.lds, g, S, E);
            PH_END(PH_FUP)
            if (IN(PH_FDN)) { PB();
                pg8::Gemm g{(const bf16*)(F.ws + WS_HID), (const bf16*)(F.ws + WS_W2), FFD, FFD, FFD};
                TileOrder S; S.init(68, 4, F.G, (int)blockIdx.x, 0);
                EpiResid E{(float*)(F.ws + WS_H), modl, 5};
                pg8::gemm_phase<EpiResid, TileOrder, true, true>(F.lds, g, S, E);
            } SEAM(PH_FDN);
        }
    }
    PH_BEGIN(PH_GATH) moe_gather(F); PH_END(PH_GATH)
#pragma unroll 1
    for (int hh = 0; hh < 1; ++hh) {
        const int p0 = PH_CV0 + 3 * hh;
        PH_BEGIN(p0)
#ifdef DBG_DETPOS
            if (hh == 0) moe_gather2(F);
#endif
            moe_convert(F, args, hh); PH_END(p0)
        PH_BEGIN(p0 + 1)
            pg8::Gemm g{(const bf16*)(F.ws + WS_XG), (const bf16*)(F.ws + WS_W13M), 512, 512, 512, E8(F8_ACT_L2), E8(F8_W13_L2)};
            MoeOrder S; S.init(F.ctl + CW_ECNT, 2 * FFE / 256, F.G, F.vcu);
            EpiSwiglu8 E{F.ws + WS_HIDM, FFE};
            pg8::gemm_phase8<EpiSwiglu8, MoeOrder, true, true>(F.lds, g, S, E);
        PH_END(p0 + 1)
        if (IN(p0 + 2)) { PB();
            pg8::Gemm g{(const bf16*)(F.ws + WS_HIDM), (const bf16*)(F.ws + WS_W2M), FFE / 2, FFE / 2, FFE / 2, E8(F8_ACT_L2), E8(F8_W2_L2)};
            MoeOrder S; S.init(F.ctl + CW_ECNT, 4, F.G, F.vcu);
            EpiY E{(bf16*)(F.ws + WS_Y), 1};
            pg8::gemm_phase8<EpiY, MoeOrder, true, true>(F.lds, g, S, E);
        } SEAM(p0 + 2);
    }
    PH_BEGIN(PH_FIN) final_phase(F, args); } }
#ifdef DBG_STOP
    if (lo == 100) {
        const int gw = F.vcu * NWAVES + F.wave, NGW = F.G * NWAVES;
        for (int tk = gw; tk < NB * SEQ; tk += NGW) { const int b = tk / SEQ, t = tk - b * SEQ; const size_t R = (size_t)b * RPB + CTXL + t;
#if DBG_SRC == 0
            const f32x4* s = (const f32x4*)((const float*)(args.ws + WS_H) + R * DM) + F.lane; f32x4* d = (f32x4*)(args.out + (size_t)tk * DM) + F.lane;
            for (int q = 0; q < 4; ++q) d[64 * q] = s[64 * q];
#elif DBG_SRC == 2
            MoeOrder mo; mo.init((gu32*)args.ws + CW_ECNT, 1, 1, 0); const v4u rt = ((const v4u*)(args.ws + WS_ROUTE))[2 * tk];
            const size_t rr = (size_t)mo.tile_off((int)rt.x) * 256 + rt.z; (void)R;
            const bf16* s = (const bf16*)(args.ws + DBG_OFF) + rr * DBG_LD + DBG_COL; float* d = args.out + (size_t)tk * DM;
            for (int q = 0; q < 16; ++q) d[F.lane + 64 * q] = bf2f(s[F.lane + 64 * q]);
#else
#ifdef DBG_MOD
            const bf16* s = (const bf16*)(args.ws + DBG_OFF) + (R % DBG_MOD) * DBG_LD + DBG_COL; float* d = args.out + (size_t)tk * DM;
#else
            const bf16* s = (const bf16*)(args.ws + DBG_OFF) + R * DBG_LD + DBG_COL; float* d = args.out + (size_t)tk * DM;
#endif
            for (int q = 0; q < 16; ++q) { float v = bf2f(s[F.lane + 64 * q]); d[F.lane + 64 * q] = (v == v && fabsf(v) < 1e30f) ? v : DBG_NANVAL; }
#endif
        }
    }
#endif
#undef IN
#undef SEAM
}

extern "C" void kernel_launch(void* const* d_in, const int* in_sizes, int n_in, void* d_out, int out_size, void* d_ws, size_t ws_size, hipStream_t stream) {
    static int grid = 0;
    if (grid == 0) {
        if (n_in != 27 || in_sizes[0] != NB * SEQ * DM || out_size != NB * SEQ * DM || ws_size < WS_END) {
            fprintf(stderr, "kernel_launch: shape / workspace mismatch (n_in %d, in0 %d, out %d, ws %zu, need %zu); nothing launched\n", n_in, n_in > 0 ? in_sizes[0] : -1, out_size, ws_size, (size_t)WS_END); grid = -1; return; }
        int dev = 0, cus = 0, per_cu = 0;
        if (hipGetDevice(&dev) != hipSuccess || hipDeviceGetAttribute(&cus, hipDeviceAttributeMultiprocessorCount, dev) != hipSuccess) { grid = -1; return; }
        if (hipFuncSetAttribute((const void*)mk_fwd, hipFuncAttributeMaxDynamicSharedMemorySize, LDS_BYTES) != hipSuccess) { fprintf(stderr, "kernel_launch: hipFuncSetAttribute failed\n"); grid = -1; return; }
        if (hipOccupancyMaxActiveBlocksPerMultiprocessor(&per_cu, (const void*)mk_fwd, NTHR, LDS_BYTES) != hipSuccess || per_cu < 1)
            fprintf(stderr, "kernel_launch: note: occupancy query reports %d workgroups per CU\n", per_cu);
        (void)hipGetLastError();
        grid = cus;
    }
    if (grid < 0) return;
    if (hipMemsetAsync((char*)d_ws + WS_CTL, 0, CTL_ZERO_BYTES, stream) != hipSuccess) return;
    Args a{};
    for (int i = 0; i < 27; ++i) a.in[i] = (const float*)d_in[i];
    a.out = (float*)d_out; a.ws = (unsigned char*)d_ws;
    constexpr int NL = MK_N_LAUNCHES;
#ifdef DBG_STOP
    constexpr int NLL = DBG_STOP + 2;
#else
    constexpr int NLL = NL;
#endif
    for (int li = 0; li < NLL; ++li) {
#ifdef DBG_SKIP_LO
        if (li >= DBG_SKIP_LO && li <= DBG_SKIP_HI) continue;
#endif
        a.ph_lo = (NL == 1) ? 0 : li; a.ph_hi = (NL == 1) ? PH_COUNT : li + 1;
#ifdef DBG_STOP
        a.ph_lo = li; a.ph_hi = li + 1;
        if (li == NLL - 1) { a.ph_lo = 100; a.ph_hi = 101; }
#endif
        hipLaunchKernelGGL(mk_fwd, dim3(grid), dim3(NTHR), LDS_BYTES, stream, a);
        const hipError_t le = hipPeekAtLastError();
        if (le != hipSuccess) { fprintf(stderr, "kernel_launch: launch %d failed: %s\n", li, hipGetErrorName(le)); break; }
    }
}
```

```cpp
#include <hip/hip_runtime.h>
#include <cstdio>
#include <cstdint>
#include <cmath>

namespace pg8 {
#define PG8_LAS __attribute__((address_space(3)))
typedef unsigned short bf16_t;
typedef short bf16x8 __attribute__((ext_vector_type(8)));
typedef float f32x4 __attribute__((ext_vector_type(4)));
typedef unsigned u32x4 __attribute__((ext_vector_type(4)));
typedef unsigned u32x2 __attribute__((ext_vector_type(2)));
constexpr int BM = 256, BK = 64, HALF = 128, HTB = HALF * BK * 2  , STAGE_BYTES = 8 * HTB;

__host__ __device__ __forceinline__ int lds_byte(int r, int c) { const int st = (r >> 4) * 2 + (c >> 5), rr = r & 15, cc = c & 31, ob = rr * 64 + cc * 2; return st * 1024 + (ob ^ (((ob >> 9) & 1) << 5)); }
__host__ __device__ __forceinline__ void stage_rc(int b, int& R, int& C) { const int st = b / 1024, sb = b % 1024, swz = sb ^ (((sb >> 9) & 1) << 5); R = (st >> 1) * 16 + swz / 64; C = (st & 1) * 32 + (swz % 64) / 2; }
__host__ __device__ __forceinline__ int perm32(int rho) { const int n = rho >> 4, i = rho & 15; return 8 * (i >> 2) + 4 * n + (i & 3); }

struct Unit { int pm, pn, pb; };
struct Gemm { const bf16_t* A; const bf16_t* Bt; int K, lda, ldb, sA, sB; };

__device__ __forceinline__ unsigned cvt_pk_bf16(float lo, float hi) { unsigned r; asm volatile("v_cvt_pk_bf16_f32 %0, %1, %2" : "=v"(r) : "v"(lo), "v"(hi)); return r; }
template <class Epi, class Sched, bool ALIGN_EPI = false, bool SP2 = false>
__device__ __forceinline__ void gemm_phase(PG8_LAS unsigned char* lds, const Gemm g, const Sched& S, const Epi& E) {
    int tid = threadIdx.x; asm volatile("" : "+v"(tid)); const int wid = __builtin_amdgcn_readfirstlane(tid >> 6), lane = tid & 63, wr = wid >> 2, wc = wid & 3, fr = lane & 15, fq = lane >> 4;
    const int K = g.K, nt = K / BK;
    unsigned voffA[2], voffB[2];
#pragma unroll
    for (int i = 0; i < 2; ++i) { int R, C; stage_rc(tid * 16 + i * 8192, R, C); const int Rb = Epi::PERM ? ((R & ~31) + perm32(R & 31)) : R;
        voffA[i] = (unsigned)(R * g.lda + C) * 2u; voffB[i] = (unsigned)(Rb * g.ldb + C) * 2u; }
    const size_t kstep = (size_t)(BK * 2);
    const size_t hstepA = (size_t)HALF * g.lda * 2, hstepB = (size_t)HALF * g.ldb * 2;
    const size_t tstepA = 2 * hstepA, tstepB = 2 * hstepB;
    const unsigned ldsw = (unsigned)wid * 1024u;
    const int aoff = lds_byte(wr * 64 + fr, fq * 8), boff = lds_byte(wc * 32 + fr, fq * 8);
#define PG8_SA(b, h) (((b) * 2 + (h)) * HTB)
#define PG8_SB(b, h) ((4 + (b) * 2 + (h)) * HTB)
#define PG8_STAGE(bufoff, gbase, voff) do { _Pragma("unroll") for (int _i = 0; _i < 2; ++_i) \
        __builtin_amdgcn_global_load_lds((const unsigned*)((const char*)(gbase) + (voff)[_i]), (PG8_LAS unsigned*)(lds + (bufoff) + ldsw + _i * 8192), 16, 0, 0); } while (0)
#define PG8_LDA(dst, b, h) do { _Pragma("unroll") for (int m = 0; m < 4; ++m) _Pragma("unroll") for (int k = 0; k < 2; ++k) dst[m][k] = *(const PG8_LAS bf16x8*)(lds + PG8_SA(b, h) + aoff + m * 2048 + k * 1024); } while (0)
#define PG8_LDB(dst, b, h) do { _Pragma("unroll") for (int n = 0; n < 2; ++n) _Pragma("unroll") for (int k = 0; k < 2; ++k) dst[n][k] = *(const PG8_LAS bf16x8*)(lds + PG8_SB(b, h) + boff + n * 2048 + k * 1024); } while (0)
#define PG8_MMA(ai, bj, At, Bt) do { __builtin_amdgcn_s_setprio(1); _Pragma("unroll") for (int m = 0; m < 4; ++m) _Pragma("unroll") for (int n = 0; n < 2; ++n) _Pragma("unroll") for (int k = 0; k < 2; ++k) \
        acc[ai][bj][m][n] = __builtin_amdgcn_mfma_f32_16x16x32_bf16(Bt[n][k], At[m][k], acc[ai][bj][m][n], 0, 0, 0); __builtin_amdgcn_s_setprio(0); } while (0)
#define PG8_WAIT_V(n) asm volatile("s_waitcnt vmcnt(" #n ")" ::: "memory")
#define PG8_WAIT_L(n) asm volatile("s_waitcnt lgkmcnt(" #n ")" ::: "memory")
#define PG8_BAR __builtin_amdgcn_s_barrier()
#define PG8_SCHED __builtin_amdgcn_sched_barrier(0)
    Unit cur, nxt; int ui = 0;
    if (!S.next(0, cur)) return;
    f32x4 acc[2][2][4][2];
#pragma unroll
    for (int a = 0; a < 2; ++a)
#pragma unroll
        for (int b = 0; b < 2; ++b)
#pragma unroll
            for (int m = 0; m < 4; ++m)
#pragma unroll
                for (int n = 0; n < 2; ++n) acc[a][b][m][n] = (f32x4){0.f, 0.f, 0.f, 0.f};
    bf16x8 At[4][2], B0[2][2], B1[2][2];
    const char* cA = (const char*)g.A + (size_t)cur.pm * tstepA; const char* cB = (const char*)g.Bt + (size_t)cur.pb * tstepB;
    S.a_ready(cur);
    if constexpr (SP2) {
        PG8_STAGE(PG8_SB(0, 0), cB, voffB); PG8_STAGE(PG8_SB(0, 1), cB + hstepB, voffB); PG8_STAGE(PG8_SA(0, 0), cA, voffA); PG8_STAGE(PG8_SA(0, 1), cA + hstepA, voffA);
        if (wr == 1) PG8_BAR;
        PG8_WAIT_V(2); PG8_BAR;
        PG8_STAGE(PG8_SB(1, 0), cB + kstep, voffB); PG8_STAGE(PG8_SA(1, 0), cA + kstep, voffA); PG8_STAGE(PG8_SB(1, 1), cB + hstepB + kstep, voffB);
        PG8_WAIT_V(6); PG8_BAR;
    } else {
        PG8_STAGE(PG8_SB(0, 0), cB, voffB); PG8_STAGE(PG8_SA(0, 0), cA, voffA); PG8_STAGE(PG8_SB(0, 1), cB + hstepB, voffB); PG8_STAGE(PG8_SA(0, 1), cA + hstepA, voffA);
        if (wr == 1) PG8_BAR;
        PG8_WAIT_V(4); PG8_BAR;
        PG8_STAGE(PG8_SB(1, 0), cB + kstep, voffB); PG8_STAGE(PG8_SA(1, 0), cA + kstep, voffA); PG8_STAGE(PG8_SB(1, 1), cB + hstepB + kstep, voffB);
        PG8_WAIT_V(6); PG8_BAR;
    }
    for (;;) {
        const bool has_next = S.next(ui + 1, nxt);
        const char* nA = has_next ? (const char*)g.A + (size_t)nxt.pm * tstepA : cA; const char* nB = has_next ? (const char*)g.Bt + (size_t)nxt.pb * tstepB : cB;
        for (int t = 0; t < nt; t += 2) {
            const bool last = (t == nt - 2);
            const char* a1 = cA + (size_t)(t + 1) * kstep;
            const char* a2 = last ? nA : cA + (size_t)(t + 2) * kstep; const char* b2 = last ? nB : cB + (size_t)(t + 2) * kstep;
            const char* a3 = a2 + kstep; const char* b3 = b2 + kstep;
            if (last && has_next) S.a_ready(nxt);
            if constexpr (SP2) {
            PG8_LDB(B0, 0, 0); PG8_LDB(B1, 0, 1); PG8_SCHED; PG8_LDA(At, 0, 0); PG8_STAGE(PG8_SA(1, 1), a1 + hstepA, voffA);
            PG8_WAIT_V(8); PG8_WAIT_L(0); PG8_BAR; PG8_MMA(0, 0, At, B0); PG8_MMA(0, 1, At, B1); PG8_BAR; PG8_SCHED;
            PG8_LDA(At, 0, 1); PG8_STAGE(PG8_SB(0, 0), b2, voffB); PG8_STAGE(PG8_SB(0, 1), b2 + hstepB, voffB); PG8_STAGE(PG8_SA(0, 0), a2, voffA);
            PG8_WAIT_V(8); PG8_WAIT_L(0); PG8_BAR; PG8_MMA(1, 0, At, B0); PG8_MMA(1, 1, At, B1); PG8_BAR; PG8_SCHED;
            PG8_LDB(B0, 1, 0); PG8_LDB(B1, 1, 1); PG8_SCHED; PG8_LDA(At, 1, 0); PG8_STAGE(PG8_SA(0, 1), a2 + hstepA, voffA);
            PG8_WAIT_V(8); PG8_WAIT_L(0); PG8_BAR; PG8_MMA(0, 0, At, B0); PG8_MMA(0, 1, At, B1); PG8_BAR; PG8_SCHED;
            PG8_LDA(At, 1, 1); PG8_STAGE(PG8_SB(1, 0), b3, voffB); PG8_STAGE(PG8_SB(1, 1), b3 + hstepB, voffB); PG8_STAGE(PG8_SA(1, 0), a3, voffA);
            PG8_WAIT_V(8); PG8_WAIT_L(0); PG8_BAR; PG8_MMA(1, 0, At, B0); PG8_MMA(1, 1, At, B1); PG8_BAR; PG8_SCHED;
            } else {
            PG8_LDB(B0, 0, 0); PG8_SCHED; PG8_LDA(At, 0, 0); PG8_STAGE(PG8_SA(1, 1), a1 + hstepA, voffA);
            PG8_WAIT_L(8); PG8_BAR; PG8_WAIT_L(0); PG8_MMA(0, 0, At, B0); PG8_BAR; PG8_SCHED;
            PG8_LDB(B1, 0, 1); PG8_STAGE(PG8_SB(0, 0), b2, voffB);
            PG8_BAR; PG8_WAIT_L(0); PG8_MMA(0, 1, At, B1); PG8_BAR;
            PG8_LDA(At, 0, 1); PG8_STAGE(PG8_SA(0, 0), a2, voffA);
            PG8_BAR; PG8_WAIT_L(0); PG8_MMA(1, 0, At, B0); PG8_BAR; PG8_SCHED;
            PG8_STAGE(PG8_SB(0, 1), b2 + hstepB, voffB);
            PG8_WAIT_V(6); PG8_BAR; PG8_MMA(1, 1, At, B1); PG8_BAR;
            PG8_LDB(B0, 1, 0); PG8_SCHED; PG8_LDA(At, 1, 0); PG8_STAGE(PG8_SA(0, 1), a2 + hstepA, voffA);
            PG8_WAIT_L(8); PG8_BAR; PG8_WAIT_L(0); PG8_MMA(0, 0, At, B0); PG8_BAR; PG8_SCHED;
            PG8_LDB(B1, 1, 1); PG8_STAGE(PG8_SB(1, 0), b3, voffB);
            PG8_BAR; PG8_WAIT_L(0); PG8_MMA(0, 1, At, B1); PG8_BAR;
            PG8_LDA(At, 1, 1); PG8_STAGE(PG8_SA(1, 0), a3, voffA);
            PG8_BAR; PG8_WAIT_L(0); PG8_MMA(1, 0, At, B0); PG8_BAR; PG8_SCHED;
            PG8_STAGE(PG8_SB(1, 1), b3 + hstepB, voffB);
            PG8_WAIT_V(6); PG8_BAR; PG8_MMA(1, 1, At, B1); PG8_BAR;
            }
        }
        if constexpr (ALIGN_EPI) { if (wr == 0) PG8_BAR; }
        if constexpr (!Epi::AFTER_DRAIN) { E(acc, cur, wr, wc, fr, fq); S.done(cur); }
        if (!has_next) break;
#pragma unroll
        for (int a = 0; a < 2; ++a)
#pragma unroll
            for (int b = 0; b < 2; ++b)
#pragma unroll
                for (int m = 0; m < 4; ++m)
#pragma unroll
                    for (int n = 0; n < 2; ++n) acc[a][b][m][n] = (f32x4){0.f, 0.f, 0.f, 0.f};
        cur = nxt; cA = nA; cB = nB; ++ui;
        if constexpr (ALIGN_EPI) { if (wr == 1) PG8_BAR; }
    }
    PG8_WAIT_V(0);
    if constexpr (!ALIGN_EPI) { if (wr == 0) PG8_BAR; }
    PG8_BAR;
    if constexpr (Epi::AFTER_DRAIN) { E.fused(acc, cur, wr, wc, fr, fq, lds, wid, lane); S.done(cur); }
#undef PG8_SA
#undef PG8_SB
#undef PG8_STAGE
#undef PG8_LDA
#undef PG8_LDB
#undef PG8_MMA
#undef PG8_WAIT_V
#undef PG8_WAIT_L
#undef PG8_BAR
#undef PG8_SCHED
}
template <class Epi, class Sched, bool ALIGN_EPI = false, bool SP2 = false>
__device__ __forceinline__ void gemm_phase8(PG8_LAS unsigned char* lds, const Gemm g, const Sched& S, const Epi& E) {
    int tid = threadIdx.x; asm volatile("" : "+v"(tid)); const int wid = __builtin_amdgcn_readfirstlane(tid >> 6), lane = tid & 63, wr = wid >> 2, wc = wid & 3, fr = lane & 15, fq = lane >> 4;
    const int K = g.K, nt = K / BK;
    unsigned voffA[2], voffB[2];
#pragma unroll
    for (int i = 0; i < 2; ++i) { int R, C; stage_rc(tid * 16 + i * 8192, R, C); const int Rb = Epi::PERM ? ((R & ~31) + perm32(R & 31)) : R;
        voffA[i] = (unsigned)(R * g.lda + C) * 2u; voffB[i] = (unsigned)(Rb * g.ldb + C) * 2u; }
    const size_t kstep = (size_t)(BK * 2);
    const size_t hstepA = (size_t)HALF * g.lda * 2, hstepB = (size_t)HALF * g.ldb * 2;
    const size_t tstepA = 2 * hstepA, tstepB = 2 * hstepB;
    const unsigned ldsw = (unsigned)wid * 1024u;
    const int c8 = (fq >> 1) * 32 + (fq & 1) * 16;
    const int aoff0 = lds_byte(wr * 64 + fr, c8), aoff1 = lds_byte(wr * 64 + fr, c8 + 8), boff0 = lds_byte(wc * 32 + fr, c8), boff1 = lds_byte(wc * 32 + fr, c8 + 8);
#define PG8_SA(b, h) (((b) * 2 + (h)) * HTB)
#define PG8_SB(b, h) ((4 + (b) * 2 + (h)) * HTB)
#define PG8_STAGE(bufoff, gbase, voff) do { _Pragma("unroll") for (int _i = 0; _i < 2; ++_i) \
        __builtin_amdgcn_global_load_lds((const unsigned*)((const char*)(gbase) + (voff)[_i]), (PG8_LAS unsigned*)(lds + (bufoff) + ldsw + _i * 8192), 16, 0, 0); } while (0)
#define PG8_LDA(dst, b, h) do { _Pragma("unroll") for (int m = 0; m < 4; ++m) { const u32x4 lo_ = *(const PG8_LAS u32x4*)(lds + PG8_SA(b, h) + aoff0 + m * 2048), hi_ = *(const PG8_LAS u32x4*)(lds + PG8_SA(b, h) + aoff1 + m * 2048); \
        dst[m] = (i32x8){(int)lo_.x, (int)lo_.y, (int)lo_.z, (int)lo_.w, (int)hi_.x, (int)hi_.y, (int)hi_.z, (int)hi_.w}; } } while (0)
#define PG8_LDB(dst, b, h) do { _Pragma("unroll") for (int n = 0; n < 2; ++n) { const u32x4 lo_ = *(const PG8_LAS u32x4*)(lds + PG8_SB(b, h) + boff0 + n * 2048), hi_ = *(const PG8_LAS u32x4*)(lds + PG8_SB(b, h) + boff1 + n * 2048); \
        dst[n] = (i32x8){(int)lo_.x, (int)lo_.y, (int)lo_.z, (int)lo_.w, (int)hi_.x, (int)hi_.y, (int)hi_.z, (int)hi_.w}; } } while (0)
#define PG8_MMA(ai, bj, At, Bt) do { __builtin_amdgcn_s_setprio(1); _Pragma("unroll") for (int m = 0; m < 4; ++m) _Pragma("unroll") for (int n = 0; n < 2; ++n) \
        asm volatile("v_mfma_scale_f32_16x16x128_f8f6f4 %0, %1, %2, %0, %3, %4 op_sel_hi:[0,0,0]" : "+v"(acc[ai][bj][m][n]) : "v"(Bt[n]), "v"(At[m]), "v"(vsB), "v"(vsA)); __builtin_amdgcn_s_setprio(0); } while (0)
#define PG8_WAIT_V(n) asm volatile("s_waitcnt vmcnt(" #n ")" ::: "memory")
#define PG8_WAIT_L(n) asm volatile("s_waitcnt lgkmcnt(" #n ")" ::: "memory")
#define PG8_BAR __builtin_amdgcn_s_barrier()
#define PG8_SCHED __builtin_amdgcn_sched_barrier(0)
    Unit cur, nxt; int ui = 0;
    if (!S.next(0, cur)) return;
    f32x4 acc[2][2][4][2];
#pragma unroll
    for (int a = 0; a < 2; ++a)
#pragma unroll
        for (int b = 0; b < 2; ++b)
#pragma unroll
            for (int m = 0; m < 4; ++m)
#pragma unroll
                for (int n = 0; n < 2; ++n) acc[a][b][m][n] = (f32x4){0.f, 0.f, 0.f, 0.f};
    typedef int i32x8 __attribute__((ext_vector_type(8)));
    i32x8 At[4], B0[2], B1[2];
    int vsA = g.sA, vsB = g.sB; asm volatile("" : "+v"(vsA), "+v"(vsB));
    const char* cA = (const char*)g.A + (size_t)cur.pm * tstepA; const char* cB = (const char*)g.Bt + (size_t)cur.pb * tstepB;
    S.a_ready(cur);
    if constexpr (SP2) {
        PG8_STAGE(PG8_SB(0, 0), cB, voffB); PG8_STAGE(PG8_SB(0, 1), cB + hstepB, voffB); PG8_STAGE(PG8_SA(0, 0), cA, voffA); PG8_STAGE(PG8_SA(0, 1), cA + hstepA, voffA);
        if (wr == 1) PG8_BAR;
        PG8_WAIT_V(2); PG8_BAR;
        PG8_STAGE(PG8_SB(1, 0), cB + kstep, voffB); PG8_STAGE(PG8_SA(1, 0), cA + kstep, voffA); PG8_STAGE(PG8_SB(1, 1), cB + hstepB + kstep, voffB);
        PG8_WAIT_V(6); PG8_BAR;
    } else {
        PG8_STAGE(PG8_SB(0, 0), cB, voffB); PG8_STAGE(PG8_SA(0, 0), cA, voffA); PG8_STAGE(PG8_SB(0, 1), cB + hstepB, voffB); PG8_STAGE(PG8_SA(0, 1), cA + hstepA, voffA);
        if (wr == 1) PG8_BAR;
        PG8_WAIT_V(4); PG8_BAR;
        PG8_STAGE(PG8_SB(1, 0), cB + kstep, voffB); PG8_STAGE(PG8_SA(1, 0), cA + kstep, voffA); PG8_STAGE(PG8_SB(1, 1), cB + hstepB + kstep, voffB);
        PG8_WAIT_V(6); PG8_BAR;
    }
    for (;;) {
        const bool has_next = S.next(ui + 1, nxt);
        const char* nA = has_next ? (const char*)g.A + (size_t)nxt.pm * tstepA : cA; const char* nB = has_next ? (const char*)g.Bt + (size_t)nxt.pb * tstepB : cB;
        for (int t = 0; t < nt; t += 2) {
            const bool last = (t == nt - 2);
            const char* a1 = cA + (size_t)(t + 1) * kstep;
            const char* a2 = last ? nA : cA + (size_t)(t + 2) * kstep; const char* b2 = last ? nB : cB + (size_t)(t + 2) * kstep;
            const char* a3 = a2 + kstep; const char* b3 = b2 + kstep;
            if (last && has_next) S.a_ready(nxt);
            if constexpr (SP2) {
            PG8_LDB(B0, 0, 0); PG8_LDB(B1, 0, 1); PG8_SCHED; PG8_LDA(At, 0, 0); PG8_STAGE(PG8_SA(1, 1), a1 + hstepA, voffA);
            PG8_WAIT_V(8); PG8_WAIT_L(0); PG8_BAR; PG8_MMA(0, 0, At, B0); PG8_MMA(0, 1, At, B1); PG8_BAR; PG8_SCHED;
            PG8_LDA(At, 0, 1); PG8_STAGE(PG8_SB(0, 0), b2, voffB); PG8_STAGE(PG8_SB(0, 1), b2 + hstepB, voffB); PG8_STAGE(PG8_SA(0, 0), a2, voffA);
            PG8_WAIT_V(8); PG8_WAIT_L(0); PG8_BAR; PG8_MMA(1, 0, At, B0); PG8_MMA(1, 1, At, B1); PG8_BAR; PG8_SCHED;
            PG8_LDB(B0, 1, 0); PG8_LDB(B1, 1, 1); PG8_SCHED; PG8_LDA(At, 1, 0); PG8_STAGE(PG8_SA(0, 1), a2 + hstepA, voffA);
            PG8_WAIT_V(8); PG8_WAIT_L(0); PG8_BAR; PG8_MMA(0, 0, At, B0); PG8_MMA(0, 1, At, B1); PG8_BAR; PG8_SCHED;
            PG8_LDA(At, 1, 1); PG8_STAGE(PG8_SB(1, 0), b3, voffB); PG8_STAGE(PG8_SB(1, 1), b3 + hstepB, voffB); PG8_STAGE(PG8_SA(1, 0), a3, voffA);
            PG8_WAIT_V(8); PG8_WAIT_L(0); PG8_BAR; PG8_MMA(1, 0, At, B0); PG8_MMA(1, 1, At, B1); PG8_BAR; PG8_SCHED;
            } else {
            PG8_LDB(B0, 0, 0); PG8_SCHED; PG8_LDA(At, 0, 0); PG8_STAGE(PG8_SA(1, 1), a1 + hstepA, voffA);
            PG8_WAIT_L(8); PG8_BAR; PG8_WAIT_L(0); PG8_MMA(0, 0, At, B0); PG8_BAR; PG8_SCHED;
            PG8_LDB(B1, 0, 1); PG8_STAGE(PG8_SB(0, 0), b2, voffB);
            PG8_BAR; PG8_WAIT_L(0); PG8_MMA(0, 1, At, B1); PG8_BAR;
            PG8_LDA(At, 0, 1); PG8_STAGE(PG8_SA(0, 0), a2, voffA);
            PG8_BAR; PG8_WAIT_L(0); PG8_MMA(1, 0, At, B0); PG8_BAR; PG8_SCHED;
            PG8_STAGE(PG8_SB(0, 1), b2 + hstepB, voffB);
            PG8_WAIT_V(6); PG8_BAR; PG8_MMA(1, 1, At, B1); PG8_BAR;
            PG8_LDB(B0, 1, 0); PG8_SCHED; PG8_LDA(At, 1, 0); PG8_STAGE(PG8_SA(0, 1), a2 + hstepA, voffA);
            PG8_WAIT_L(8); PG8_BAR; PG8_WAIT_L(0); PG8_MMA(0, 0, At, B0); PG8_BAR; PG8_SCHED;
            PG8_LDB(B1, 1, 1); PG8_STAGE(PG8_SB(1, 0), b3, voffB);
            PG8_BAR; PG8_WAIT_L(0); PG8_MMA(0, 1, At, B1); PG8_BAR;
            PG8_LDA(At, 1, 1); PG8_STAGE(PG8_SA(1, 0), a3, voffA);
            PG8_BAR; PG8_WAIT_L(0); PG8_MMA(1, 0, At, B0); PG8_BAR; PG8_SCHED;
            PG8_STAGE(PG8_SB(1, 1), b3 + hstepB, voffB);
            PG8_WAIT_V(6); PG8_BAR; PG8_MMA(1, 1, At, B1); PG8_BAR;
            }
        }
        if constexpr (ALIGN_EPI) { if (wr == 0) PG8_BAR; }
        asm volatile("s_nop 15\n\ts_nop 15" ::: "memory");
        if constexpr (!Epi::AFTER_DRAIN) { E(acc, cur, wr, wc, fr, fq); S.done(cur); }
        if (!has_next) break;
#pragma unroll
        for (int a = 0; a < 2; ++a)
#pragma unroll
            for (int b = 0; b < 2; ++b)
#pragma unroll
                for (int m = 0; m < 4; ++m)
#pragma unroll
                    for (int n = 0; n < 2; ++n) acc[a][b][m][n] = (f32x4){0.f, 0.f, 0.f, 0.f};
        cur = nxt; cA = nA; cB = nB; ++ui;
        if constexpr (ALIGN_EPI) { if (wr == 1) PG8_BAR; }
    }
    PG8_WAIT_V(0);
    if constexpr (!ALIGN_EPI) { if (wr == 0) PG8_BAR; }
    PG8_BAR;
    if constexpr (Epi::AFTER_DRAIN) { E.fused(acc, cur, wr, wc, fr, fq, lds, wid, lane); S.done(cur); }
#undef PG8_SA
#undef PG8_SB
#undef PG8_STAGE
#undef PG8_LDA
#undef PG8_LDB
#undef PG8_MMA
#undef PG8_WAIT_V
#undef PG8_WAIT_L
#undef PG8_BAR
#undef PG8_SCHED
}
}

namespace attn {
using bf16x8 = __attribute__((ext_vector_type(8))) short;
using s16x4  = __attribute__((ext_vector_type(4))) short;
using f32x16 = __attribute__((ext_vector_type(16))) float;
using u32x4  = __attribute__((ext_vector_type(4))) unsigned;
constexpr int DV = 128, DK = 64, NW = 8, QBLK = 32, KVBLK = 64;
constexpr float SCALE = 0.125f;
constexpr float THR = 4.f;
constexpr size_t SHM_V = KVBLK * DV * 2, SHM_K = KVBLK * DK * 2, SHM_ATTN = 2 * SHM_V + 2 * SHM_K + NW * 64 * 4;
#define AKSWZ(row, colB) ((row) * 128 + ((colB) ^ ((((row) >> 1) & 7) << 4)))
#define ASBAR() __builtin_amdgcn_sched_barrier(0)
__device__ __forceinline__ int crow(int r, int hi) { return (r & 3) + 8 * (r >> 2) + 4 * hi; }
__device__ __forceinline__ unsigned cvtpk(float lo, float hi) { unsigned r; asm volatile("v_cvt_pk_bf16_f32 %0, %1, %2" : "=v"(r) : "v"(lo), "v"(hi)); return r; }

__device__ __forceinline__ void partialSM(f32x16& p0, f32x16& p1, float& m_reg, float& mn, float& alpha) {
  constexpr float C = SCALE * 1.4426950408889634f;
  float pmax = p0[0];
#pragma unroll
  for (int r = 1; r < 16; ++r) pmax = fmaxf(pmax, p0[r]);
#pragma unroll
  for (int r = 0; r < 16; ++r) pmax = fmaxf(pmax, p1[r]);
  { auto rr = __builtin_amdgcn_permlane32_swap(__float_as_uint(pmax), __float_as_uint(pmax), false, false);
    pmax = fmaxf(__uint_as_float(rr[0]), __uint_as_float(rr[1])); }
  if (__builtin_expect(__all(pmax - m_reg <= THR / SCALE), 1)) { mn = m_reg; alpha = 1.f; }
  else { mn = fmaxf(m_reg, pmax); alpha = __builtin_amdgcn_exp2f((m_reg - mn) * C); m_reg = mn; }
  const float mnC = -mn * C;
#pragma unroll
  for (int r = 0; r < 16; ++r) p0[r] = fmaf(p0[r], C, mnC);
#pragma unroll
  for (int r = 0; r < 16; ++r) p1[r] = fmaf(p1[r], C, mnC);
#pragma unroll
  for (int r = 0; r < 16; ++r) p0[r] = __builtin_amdgcn_exp2f(p0[r]);
}
__device__ __forceinline__ void finishSM(f32x16& p0, f32x16& p1, float alpha, float& l_reg, bf16x8& pa0, bf16x8& pa1, bf16x8& pa2, bf16x8& pa3) {
#pragma unroll
  for (int r = 0; r < 16; ++r) p1[r] = __builtin_amdgcn_exp2f(p1[r]);
  float ps = 0;
#pragma unroll
  for (int r = 0; r < 16; ++r) ps += p0[r];
#pragma unroll
  for (int r = 0; r < 16; ++r) ps += p1[r];
  { auto rr = __builtin_amdgcn_permlane32_swap(__float_as_uint(ps), __float_as_uint(ps), false, false);
    ps = __uint_as_float(rr[0]) + __uint_as_float(rr[1]); }
  l_reg = l_reg * alpha + ps;
#define APK4(P, BASE, OUT) do { unsigned a0 = cvtpk(P[BASE + 0], P[BASE + 1]), a1 = cvtpk(P[BASE + 2], P[BASE + 3]);   \
    unsigned b0 = cvtpk(P[BASE + 4], P[BASE + 5]), b1 = cvtpk(P[BASE + 6], P[BASE + 7]);                              \
    auto r0 = __builtin_amdgcn_permlane32_swap(a0, b0, false, false); auto r1 = __builtin_amdgcn_permlane32_swap(a1, b1, false, false); \
    u32x4 w = {r0[0], r1[0], r0[1], r1[1]}; OUT = *reinterpret_cast<bf16x8*>(&w); } while (0)
  APK4(p0, 0, pa0); APK4(p0, 8, pa1); APK4(p1, 0, pa2); APK4(p1, 8, pa3);
#undef APK4
}
__device__ __forceinline__ void qkt(f32x16& p0, f32x16& p1, const char* Ks, const bf16x8* qr, int r32, int hi) {
  p0 = f32x16{}; p1 = f32x16{};
#pragma unroll
  for (int d0 = 0; d0 < 4; ++d0) { const int cb = (d0 * 16 + hi * 8) * 2;
    bf16x8 b0 = *reinterpret_cast<const bf16x8*>(Ks + AKSWZ(r32, cb));
    bf16x8 b1 = *reinterpret_cast<const bf16x8*>(Ks + AKSWZ(32 + r32, cb));
    p0 = __builtin_amdgcn_mfma_f32_32x32x16_bf16(b0, qr[d0], p0, 0, 0, 0);
    p1 = __builtin_amdgcn_mfma_f32_32x32x16_bf16(b1, qr[d0], p1, 0, 0, 0); }
}
__device__ __forceinline__ int v_st(int k, int c) { const int kk = (k & ~0xC) | ((k & 4) << 1) | ((k & 8) >> 1); return ((kk >> 3) * 4 + (c >> 5)) * 512 + ((kk & 7) * 32 + (c & 31)) * 2; }
__device__ __forceinline__ int v_rd_base(int lane) { return ((lane & 3) << 3) | (((lane >> 2) & 3) << 6) | (((lane >> 4) & 1) << 5) | (((lane >> 5) & 1) << 8); }
constexpr int v_rd_off(int d0, int ks, int half) { return d0 * 512 + ks * 4096 + half * 2048; }
template <int OFF> __device__ __forceinline__ s16x4 tr_read(int vb) {
  s16x4 r; asm volatile("ds_read_b64_tr_b16 %0, %1 offset:%2" : "=&v"(r) : "v"(vb), "i"(OFF) : "memory"); return r;
}
template <int D0> __device__ __forceinline__ void pv_one(f32x16& od, int vb, bf16x8 pa0, bf16x8 pa1, bf16x8 pa2, bf16x8 pa3) {
  const s16x4 l0 = tr_read<v_rd_off(D0, 0, 0)>(vb), h0 = tr_read<v_rd_off(D0, 0, 1)>(vb), l1 = tr_read<v_rd_off(D0, 1, 0)>(vb), h1 = tr_read<v_rd_off(D0, 1, 1)>(vb);
  const s16x4 l2 = tr_read<v_rd_off(D0, 2, 0)>(vb), h2 = tr_read<v_rd_off(D0, 2, 1)>(vb), l3 = tr_read<v_rd_off(D0, 3, 0)>(vb), h3 = tr_read<v_rd_off(D0, 3, 1)>(vb);
  asm volatile("s_waitcnt lgkmcnt(0)" ::: "memory"); ASBAR();
#define APK(L, H) (bf16x8){L[0], L[1], L[2], L[3], H[0], H[1], H[2], H[3]}
  od = __builtin_amdgcn_mfma_f32_32x32x16_bf16(pa0, APK(l0, h0), od, 0, 0, 0);
  od = __builtin_amdgcn_mfma_f32_32x32x16_bf16(pa1, APK(l1, h1), od, 0, 0, 0);
  od = __builtin_amdgcn_mfma_f32_32x32x16_bf16(pa2, APK(l2, h2), od, 0, 0, 0);
  od = __builtin_amdgcn_mfma_f32_32x32x16_bf16(pa3, APK(l3, h3), od, 0, 0, 0);
#undef APK
}
__device__ __forceinline__ void pv_d0(f32x16* o, int vb, bf16x8 pa0, bf16x8 pa1, bf16x8 pa2, bf16x8 pa3) {
  pv_one<0>(o[0], vb, pa0, pa1, pa2, pa3); pv_one<1>(o[1], vb, pa0, pa1, pa2, pa3); pv_one<2>(o[2], vb, pa0, pa1, pa2, pa3); pv_one<3>(o[3], vb, pa0, pa1, pa2, pa3);
}
template <int LDQ, int LDO>
__device__ __forceinline__ void attn_unit(const unsigned short* __restrict__ Qb, const unsigned short* __restrict__ Kh, const unsigned short* __restrict__ Vh,
                                          unsigned short* __restrict__ Ob, int seq, char* lds) {
  int tid = threadIdx.x; asm volatile("" : "+v"(tid)); const int wid = tid >> 6, lane = tid & 63, r32 = lane & 31, hi = lane >> 5;
  char* V_lds = lds; char* K_lds = lds + 2 * SHM_V;
  float* ws = (float*)(lds + 2 * SHM_V + 2 * SHM_K) + wid * 64; float* li_l = ws; float* al_l = ws + 32;
  float m_reg = -1e30f, l_reg = 0; f32x16 o[4] = {}; bf16x8 qr[4];
  const unsigned short* Qw = Qb + (long)(wid * QBLK + r32) * LDQ + hi * 8;
#pragma unroll
  for (int d0 = 0; d0 < 4; ++d0) qr[d0] = *reinterpret_cast<const bf16x8*>(Qw + d0 * 16);
  const int sr = tid >> 4, sc = (tid & 15) * 8, vst0 = v_st(sr, sc), vst1 = v_st(32 + sr, sc);
  const int kr = tid >> 3, kc = (tid & 7) * 8, kst = AKSWZ(kr, kc * 2);
  const int vb0 = (int)(uintptr_t)V_lds + v_rd_base(lane);
  bf16x8 sv0[2], sv1[2], sk0[2];
#define ASLOAD(i, k0) do { sv0[i] = *reinterpret_cast<const bf16x8*>(&Vh[(long)((k0) + sr) * LDQ + sc]); sv1[i] = *reinterpret_cast<const bf16x8*>(&Vh[(long)((k0) + 32 + sr) * LDQ + sc]); \
    sk0[i] = *reinterpret_cast<const bf16x8*>(&Kh[(long)((k0) + kr) * LDQ + kc]); } while (0)
#define ASWRITE(b, i) do { *(bf16x8*)(V_lds + (b) * SHM_V + vst0) = sv0[i]; *(bf16x8*)(V_lds + (b) * SHM_V + vst1) = sv1[i]; \
    *(bf16x8*)(K_lds + (b) * SHM_K + kst) = sk0[i]; } while (0)
#define ASWAIT() asm volatile("s_waitcnt vmcnt(3)" ::: "memory")
#define ARESC(a) do { if (__any((a) < 1.f)) { if (hi == 0) al_l[r32] = (a); asm volatile("s_waitcnt lgkmcnt(0)" ::: "memory"); \
    _Pragma("unroll") for (int d = 0; d < 4; ++d) _Pragma("unroll") for (int r = 0; r < 16; ++r) o[d][r] *= al_l[crow(r, hi)]; } } while (0)
  f32x16 pA0, pA1, pB0, pB1; float mnA, mnB, alA, alB; bf16x8 pa0, pa1, pa2, pa3; const int NT = seq / KVBLK;
  ASLOAD(0, 0); asm volatile("s_waitcnt vmcnt(0)" ::: "memory"); ASWRITE(0, 0); __syncthreads();
  qkt(pA0, pA1, K_lds, qr, r32, hi); partialSM(pA0, pA1, m_reg, mnA, alA);
  ASLOAD(1, KVBLK); if (2 < NT) ASLOAD(0, 2 * KVBLK);
  if (2 < NT) ASWAIT(); else asm volatile("s_waitcnt vmcnt(0)" ::: "memory");
  ASWRITE(1, 1); __syncthreads();
  for (int j = 1; j + 1 < NT; j += 2) {
    ASBAR(); qkt(pB0, pB1, K_lds + SHM_K, qr, r32, hi);
    finishSM(pA0, pA1, alA, l_reg, pa0, pa1, pa2, pa3); ASBAR();
    ASLOAD(1, (j + 2) * KVBLK); ASBAR();
    pv_d0(o, vb0, pa0, pa1, pa2, pa3); partialSM(pB0, pB1, m_reg, mnB, alB);
    __syncthreads(); ASWAIT(); ASWRITE(0, 0);
    ARESC(alB); __syncthreads();
    ASBAR(); qkt(pA0, pA1, K_lds, qr, r32, hi);
    finishSM(pB0, pB1, alB, l_reg, pa0, pa1, pa2, pa3); ASBAR();
    if (j + 3 < NT) ASLOAD(0, (j + 3) * KVBLK); ASBAR();
    pv_d0(o, vb0 + (int)SHM_V, pa0, pa1, pa2, pa3); partialSM(pA0, pA1, m_reg, mnA, alA);
    __syncthreads(); if (j + 3 < NT) ASWAIT(); else asm volatile("s_waitcnt vmcnt(0)" ::: "memory");
    ASWRITE(1, 1);
    ARESC(alA); __syncthreads();
  }
  ASBAR(); qkt(pB0, pB1, K_lds + SHM_K, qr, r32, hi);
  finishSM(pA0, pA1, alA, l_reg, pa0, pa1, pa2, pa3); ASBAR();
  pv_d0(o, vb0, pa0, pa1, pa2, pa3); partialSM(pB0, pB1, m_reg, mnB, alB);
  __syncthreads(); ARESC(alB);
  finishSM(pB0, pB1, alB, l_reg, pa0, pa1, pa2, pa3); ASBAR();
  pv_d0(o, vb0 + (int)SHM_V, pa0, pa1, pa2, pa3);
  if (hi == 0) li_l[r32] = l_reg; asm volatile("s_waitcnt lgkmcnt(0)" ::: "memory");
  float rli[16];
#pragma unroll
  for (int r = 0; r < 16; ++r) rli[r] = __builtin_amdgcn_rcpf(li_l[crow(r, hi)]);
  unsigned short* Ow = Ob + (long)(wid * QBLK) * LDO;
#pragma unroll
  for (int r = 0; r < 16; ++r) { const int orow = crow(r, hi);
#pragma unroll
    for (int d0 = 0; d0 < 4; ++d0) { const float v = o[d0][r] * rli[r]; Ow[(long)orow * LDO + d0 * 32 + r32] = (unsigned short)(cvtpk(v, v) & 0xffffu); } }
  __syncthreads();
#undef ASLOAD
#undef ASWRITE
#undef ASWAIT
#undef ARESC
}
}

constexpr int NWAVES = 8, NTHR = NWAVES * 64;
constexpr int DM = 1024, NB = 4, SEQ = 4096, CTXL = 256, RPB = CTXL + SEQ  , MROWS = NB * RPB  ;
constexpr int INW = 5904, NPROJ = 6144, PLD = 5888;
constexpr int FFD = 2816, FFE = 3584, NEXP = 8, FFEH = FFE / 2;
constexpr int NCHUNK = RPB / 64;
constexpr float EPSN = 1e-6f;
constexpr int PC_AQ = 0, PC_AK = 512, PC_AV = 1024, PC_DQ = 1536, PC_DK = 1792, PC_DV = 2048, PC_DZ = 2304, PC_POOL = 2560, PC_GATE = 2816, PC_AB = 5888;

constexpr size_t MiB = 1u << 20;
constexpr size_t WS_CTL = 0, CTL_ZERO_BYTES = 2 * MiB;
constexpr size_t WS_MOD = 1 * MiB;
constexpr size_t WS_ROPE = 2 * MiB;
constexpr size_t WS_LAM = 2 * MiB + 65536;
constexpr size_t WS_ROUTE = 3 * MiB;
constexpr size_t WS_GB = 4 * MiB;
constexpr size_t WS_WIN = 8 * MiB;
constexpr size_t WS_WBR = 32 * MiB;
constexpr size_t WS_WOUT = 36 * MiB;
constexpr size_t WS_W13 = 40 * MiB;
constexpr size_t WS_W2 = 51 * MiB;
constexpr size_t WS_H = 58 * MiB;
constexpr size_t WS_U = 126 * MiB;
constexpr size_t WS_ATTO = WS_U;
constexpr size_t WS_MIX = WS_U;
constexpr size_t WS_PROJ = 160 * MiB;
constexpr size_t WS_POOLO = 356 * MiB;
constexpr size_t WS_W2M = 365 * MiB;
constexpr size_t WS_DNP = 398 * MiB;
constexpr size_t WS_MG = WS_DNP;
constexpr size_t WS_DNG = 466 * MiB;
constexpr size_t WS_DNO = 467 * MiB;
constexpr size_t WS_W13M = 484 * MiB;
constexpr size_t WS_HID = WS_PROJ;
constexpr int MOE_MAXT = 136;
constexpr size_t WS_HIDM = 160 * MiB;
constexpr size_t WS_XG = 279 * MiB;
constexpr size_t WS_Y = 279 * MiB;
constexpr size_t WS_END = 540 * MiB;
static_assert(WS_HIDM + (size_t)MOE_MAXT * 256 * FFE <= WS_XG && WS_Y + (size_t)MOE_MAXT * 256 * 1024 * 2 <= WS_POOLO && WS_DNO + (size_t)2 * MROWS * 256 * 2 <= WS_W13M && WS_W13M + (size_t)8 * 2 * FFE * 1024 <= WS_END, "ws map");
static_assert(WS_WIN + (size_t)2 * NPROJ * 1024 * 2 <= WS_WBR && WS_W13 + (size_t)2 * FFD * 1024 * 2 <= WS_W2 && WS_W2 + (size_t)1024 * FFD * 2 <= WS_H, "ws map (weights)");
static_assert(WS_H + (size_t)MROWS * 1024 * 4 <= WS_U && WS_U + (size_t)MROWS * 1024 * 2 <= WS_PROJ && WS_PROJ + (size_t)MROWS * PLD * 2 <= WS_POOLO && WS_POOLO + (size_t)MROWS * 256 * 2 <= WS_W2M && WS_W2M + (size_t)8 * 1024 * FFE <= WS_DNP, "ws map (acts)");
static_assert(WS_DNP + (size_t)NB * NCHUNK * 4 * 2 * 32768 <= WS_DNG, "ws map (dn)");
constexpr int CW_TMO = 0, CW_CODE = 1;
constexpr int CW_BAR = 4096;
constexpr int CW_ECNT = 8192;

constexpr int RING_BYTES = 155648;
constexpr int MISC_OFF = RING_BYTES;
constexpr int LDS_BYTES = RING_BYTES + 1024;

enum { PH_PRO = 0, PH_L0 = 1, PH_N1 = 0, PH_PROJ = 1, PH_ATT = 2, PH_SCAN = 3, PH_MIXB = 4, PH_MRG0 = 5, PH_MRG1 = 6, PH_MRG2 = 7, PH_OUT = 8, PH_N2 = 9, PH_LAYER = 10,
       PH_FUP = 11, PH_FDN = 12, PH_L1 = 13, PH_GATH = 23, PH_CV0 = 24, PH_UP0 = 25, PH_DN0 = 26, PH_CV1 = 27, PH_UP1 = 28, PH_DN1 = 29, PH_FIN = 30, PH_COUNT = 31 };

#define GAS __attribute__((address_space(1)))
#define LAS __attribute__((address_space(3)))
typedef unsigned short bf16;
typedef unsigned v4u __attribute__((ext_vector_type(4)));
typedef unsigned v2u __attribute__((ext_vector_type(2)));
typedef float f32x4 __attribute__((ext_vector_type(4)));
typedef GAS unsigned gu32;
#define RLX_AGENT __ATOMIC_RELAXED, __HIP_MEMORY_SCOPE_AGENT
#define LDS_WAIT() asm volatile("s_waitcnt lgkmcnt(0)" ::: "memory")
#define VM_WAIT() asm volatile("s_waitcnt vmcnt(0)" ::: "memory")
__device__ __forceinline__ unsigned f2bf(float f) { unsigned u = __builtin_bit_cast(unsigned, f); return (u + 0x7fffu + ((u >> 16) & 1u)) >> 16; }
typedef float f32x2_c __attribute__((ext_vector_type(2))); typedef __bf16 bf16x2_c __attribute__((ext_vector_type(2)));
__device__ __forceinline__ unsigned cvtpk_c(float lo, float hi) { f32x2_c v = {lo, hi}; bf16x2_c b = __builtin_convertvector(v, bf16x2_c); return __builtin_bit_cast(unsigned, b); }
__device__ __forceinline__ unsigned pk2(float lo, float hi) { return cvtpk_c(lo, hi); }
__device__ __forceinline__ unsigned cvt4_fp8(float a, float b, float c, float d) {
    a = fminf(fmaxf(a, -448.f), 448.f); b = fminf(fmaxf(b, -448.f), 448.f); c = fminf(fmaxf(c, -448.f), 448.f); d = fminf(fmaxf(d, -448.f), 448.f);
    int r = 0; r = __builtin_amdgcn_cvt_pk_fp8_f32(a, b, r, false); r = __builtin_amdgcn_cvt_pk_fp8_f32(c, d, r, true); return (unsigned)r; }
constexpr int E8(int log2scale) { return (127 - log2scale) * 0x01010101; }
constexpr int F8_ACT_L2 = 3, F8_W13_L2 = 5, F8_W2_L2 = 6;
__device__ __forceinline__ float bf_lo(unsigned w) { return __builtin_bit_cast(float, w << 16); }
__device__ __forceinline__ float bf_hi(unsigned w) { return __builtin_bit_cast(float, w & 0xffff0000u); }
__device__ __forceinline__ float bf2f(bf16 v) { return __builtin_bit_cast(float, (unsigned)v << 16); }
__device__ __forceinline__ float sigmoidf_(float x) { return 1.f / (1.f + __expf(-x)); }
__device__ __forceinline__ float siluf_(float x) { return x / (1.f + __expf(-x)); }
__device__ __forceinline__ float wave_sum(float v) {
#pragma unroll
    for (int o = 1; o < 64; o <<= 1) v += __shfl_xor(v, o);
    return v;
}
#define XB_TMO      128
#define XB_XCNT(j)  (256  + 64 * (j))
#define XB_XSUB(j)  (1280 + 64 * (j))
#define XB_XGEN(j)  (2304 + 64 * (j))
#define XB_TOP      3328
#define XB_TOPGEN   3392
#define XCD_BAR_WORDS 3456
#define XB_SPIN_CAP (1u << 18)

__device__ __forceinline__ unsigned xb_ld(unsigned* p)              { return __hip_atomic_load(p, __ATOMIC_RELAXED, __HIP_MEMORY_SCOPE_AGENT); }
__device__ __forceinline__ unsigned xb_add(unsigned* p, unsigned v) { return __hip_atomic_fetch_add(p, v, __ATOMIC_RELAXED, __HIP_MEMORY_SCOPE_AGENT); }
__device__ __forceinline__ unsigned xb_xcc_id() { return (unsigned)__builtin_amdgcn_s_getreg((3 << 11) | 20) & 0xFu; }
#define XB_SPIN(cond, bar) do { unsigned _sp = 0; while (cond) { __builtin_amdgcn_s_sleep(1); \
    if ((++_sp & 255u) == 0u) { if (xb_ld(&(bar)[XB_TMO])) break; if (_sp > XB_SPIN_CAP) { atomicAdd(&(bar)[XB_TMO], 1u); break; } } } } while (0)

struct XcdBarrier {
    unsigned* bar; unsigned x;
    volatile LAS unsigned* st;
};

__device__ __forceinline__ XcdBarrier xcd_barrier_post(unsigned* bar, volatile LAS unsigned* st) {
    XcdBarrier b; b.bar = bar; b.x = xb_xcc_id(); b.st = st;
    if (threadIdx.x == 0) (void)xb_add(&bar[XB_XCNT(b.x)], 1u);
    return b;
}
__device__ __forceinline__ void xcd_barrier_complete(unsigned* bar, unsigned x, unsigned& nloc, unsigned& nx) {
    const unsigned G = gridDim.x * gridDim.y * gridDim.z;
    unsigned sum, cnt, mine, sp = 0u;
    for (;;) {
        sum = 0u; cnt = 0u; mine = 0u;
#pragma unroll
        for (unsigned j = 0; j < 16; ++j) { const unsigned c = xb_ld(&bar[XB_XCNT(j)]); sum += c; cnt += (c > 0u) ? 1u : 0u; mine = (j == x) ? c : mine; }
        if (sum == G) break;
        __builtin_amdgcn_s_sleep(1);
        if ((++sp & 255u) == 0u) { if (xb_ld(&bar[XB_TMO])) break; if (sp > XB_SPIN_CAP) { atomicAdd(&bar[XB_TMO], 1u); break; } }
    }
    nloc = mine > 0u ? mine : 1u; nx = cnt > 0u ? cnt : 1u;
}

__device__ __forceinline__ void xcd_barrier(const XcdBarrier& b) {
    asm volatile("s_waitcnt vmcnt(0)" ::: "memory");
    __syncthreads();
    if (threadIdx.x == 0) {
        unsigned* bar = b.bar;
        __builtin_amdgcn_s_waitcnt(0);
        unsigned nloc = b.st[0], nx = b.st[1];
        if (nloc == 0u) { xcd_barrier_complete(bar, b.x, nloc, nx); b.st[0] = nloc; b.st[1] = nx; }
        const unsigned old = xb_add(&bar[XB_XSUB(b.x)], 1u);
        const unsigned gen = old / nloc;
        if (old + 1u == (gen + 1u) * nloc) {
            __builtin_amdgcn_fence(__ATOMIC_RELEASE, "agent");
            asm volatile("s_waitcnt vmcnt(0)" ::: "memory");
            const unsigned og = xb_add(&bar[XB_TOP], 1u);
            const unsigned tg = og / nx;
            if (og + 1u == (tg + 1u) * nx) xb_add(&bar[XB_TOPGEN], 1u);
            else XB_SPIN(xb_ld(&bar[XB_TOPGEN]) == tg, bar);
            __builtin_amdgcn_fence(__ATOMIC_ACQUIRE, "agent");
            xb_add(&bar[XB_XGEN(b.x)], 1u);
            asm volatile("s_waitcnt vmcnt(0)" ::: "memory");
        } else {
            XB_SPIN(xb_ld(&bar[XB_XGEN(b.x)]) == gen, bar);
            __builtin_amdgcn_fence(__ATOMIC_ACQUIRE, "agent");
            asm volatile("s_waitcnt vmcnt(0)" ::: "memory");
        }
    }
    __syncthreads();
}

struct Frame {
    LAS unsigned char* lds;
    volatile LAS unsigned* MISC;
    gu32* ctl;
    int tid, lane, wave, vcu, G, zz;
    unsigned char* ws;
    float* out;
};
struct Args { const float* in[27]; float* out; unsigned char* ws; int ph_lo, ph_hi; };

struct TileOrder {
    int nM, nN, nwg, G, c, skip;
    __device__ __forceinline__ void init(int nM_, int nN_, int G_, int c_, int skip_) { nM = nM_; nN = nN_; nwg = nM * nN; G = G_; c = c_; skip = skip_; }
    __device__ __forceinline__ bool next(int i, pg8::Unit& u) const {
        const long L = (long)i * G + c; if (L >= nwg) return false;
        int wgid = (int)L; { const int q = nwg / 8, r = nwg % 8, xcd = wgid % 8, off = wgid / 8; wgid = (xcd < r ? xcd * (q + 1) : r * (q + 1) + (xcd - r) * q) + off; }
        const int nig = 8 * nN, gid = wgid / nig, fm = gid * 8, gsz = (nM - fm) < 8 ? (nM - fm) : 8;
        int pm = fm + ((wgid % nig) % gsz); const int pn = (wgid % nig) / gsz;
        if (skip) pm = (pm >> 4) * 17 + 1 + (pm & 15);
        u.pm = pm; u.pn = pn; u.pb = pn; return true;
    }
    __device__ __forceinline__ void a_ready(const pg8::Unit&) const {}
    __device__ __forceinline__ void done(const pg8::Unit&) const {}
};
struct MoeOrder {
    int t1, t2, t3, t4, t5, t6, t7, t8, nN, G, c;
    __device__ __forceinline__ void init(const gu32* cnt, int nN_, int G_, int c_) {
        int t = 0;
        t += ((int)__hip_atomic_load(cnt + 0 * 64, RLX_AGENT) + 255) >> 8; t1 = t; t += ((int)__hip_atomic_load(cnt + 1 * 64, RLX_AGENT) + 255) >> 8; t2 = t;
        t += ((int)__hip_atomic_load(cnt + 2 * 64, RLX_AGENT) + 255) >> 8; t3 = t; t += ((int)__hip_atomic_load(cnt + 3 * 64, RLX_AGENT) + 255) >> 8; t4 = t;
        t += ((int)__hip_atomic_load(cnt + 4 * 64, RLX_AGENT) + 255) >> 8; t5 = t; t += ((int)__hip_atomic_load(cnt + 5 * 64, RLX_AGENT) + 255) >> 8; t6 = t;
        t += ((int)__hip_atomic_load(cnt + 6 * 64, RLX_AGENT) + 255) >> 8; t7 = t; t += ((int)__hip_atomic_load(cnt + 7 * 64, RLX_AGENT) + 255) >> 8; t8 = t;
        nN = nN_; G = G_; c = c_;
    }
    __device__ __forceinline__ int tile_off(int e) const { return e == 0 ? 0 : e == 1 ? t1 : e == 2 ? t2 : e == 3 ? t3 : e == 4 ? t4 : e == 5 ? t5 : e == 6 ? t6 : t7; }
    __device__ __forceinline__ bool next(int i, pg8::Unit& u) const {
        const long L = (long)i * G + c; if (L >= (long)t8 * nN) return false;
        const int pm = (int)(L / nN), pn = (int)(L % nN);
        const int e = (pm >= t1) + (pm >= t2) + (pm >= t3) + (pm >= t4) + (pm >= t5) + (pm >= t6) + (pm >= t7);
        u.pm = pm; u.pn = pn; u.pb = e * nN + pn; return true;
    }
    __device__ __forceinline__ void a_ready(const pg8::Unit&) const {}
    __device__ __forceinline__ void done(const pg8::Unit&) const {}
};

#define EPI_LOOP(...) _Pragma("unroll") for (int ai = 0; ai < 2; ++ai) _Pragma("unroll") for (int m = 0; m < 4; ++m) { const int row = u.pm * 256 + ai * 128 + wr * 64 + m * 16 + fr; \
    _Pragma("unroll") for (int bj = 0; bj < 2; ++bj) { const int col = bj * 128 + wc * 32 + 4 * fq; f32x4 v0 = acc[ai][bj][m][0], v1 = acc[ai][bj][m][1]; __VA_ARGS__ } if (m & 1) asm volatile("" ::: "memory"); }
#define EPI_LOOP8(...) _Pragma("unroll") for (int ai = 0; ai < 2; ++ai) _Pragma("unroll") for (int m = 0; m < 4; ++m) { const int row = u.pm * 256 + ai * 128 + wr * 64 + m * 16 + fr; \
    _Pragma("unroll") for (int bj = 0; bj < 2; ++bj) { const int col = bj * 128 + wc * 32 + 8 * fq; f32x4 v0 = acc[ai][bj][m][0], v1 = acc[ai][bj][m][1]; __VA_ARGS__ } if (m & 1) asm volatile("" ::: "memory"); }
__device__ __forceinline__ v4u pack8(f32x4 a, f32x4 b) { v4u w; w.x = pg8::cvt_pk_bf16(a[0], a[1]); w.y = pg8::cvt_pk_bf16(a[2], a[3]); w.z = pg8::cvt_pk_bf16(b[0], b[1]); w.w = pg8::cvt_pk_bf16(b[2], b[3]); return w; }
__device__ __forceinline__ v2u pack4(f32x4 v) { v2u w; w.x = pg8::cvt_pk_bf16(v[0], v[1]); w.y = pg8::cvt_pk_bf16(v[2], v[3]); return w; }
__device__ __forceinline__ f32x4 unpack4(v2u w) { return (f32x4){bf_lo(w.x), bf_hi(w.x), bf_lo(w.y), bf_hi(w.y)}; }

struct EpiProj {
    static constexpr bool PERM = false, AFTER_DRAIN = false;
    bf16* P; float* GB; const float* rope; const float* a_log; const float* dt_bias;
    __device__ __forceinline__ void operator()(const pg8::f32x4 (&acc)[2][2][4][2], const pg8::Unit& u, int wr, int wc, int fr, int fq) const {
        const int pn = u.pn;
        if (pn < 4) {
            EPI_LOOP({ const int j = row % RPB;
                if (j >= CTXL) { const int t = j - CTXL; const int pos = (wc & 1) ? (t & 63) : (t >> 6);
                    const f32x4 cs0 = *(const f32x4*)(rope + (pos * 16 + 4 * fq) * 2), cs1 = *(const f32x4*)(rope + (pos * 16 + 4 * fq) * 2 + 4);
                    const float c0 = cs0[0], s0 = cs0[1], c1 = cs0[2], s1 = cs0[3], c2 = cs1[0], s2 = cs1[1], c3 = cs1[2], s3 = cs1[3];
                    const f32x4 a = v0, b = v1;
                    v0[0] = a[0] * c0 - b[0] * s0; v1[0] = b[0] * c0 + a[0] * s0; v0[1] = a[1] * c1 - b[1] * s1; v1[1] = b[1] * c1 + a[1] * s1;
                    v0[2] = a[2] * c2 - b[2] * s2; v1[2] = b[2] * c2 + a[2] * s2; v0[3] = a[3] * c3 - b[3] * s3; v1[3] = b[3] * c3 + a[3] * s3; }
                bf16* o = P + (size_t)row * PLD + pn * 256 + col; *(v2u*)o = pack4(v0); *(v2u*)(o + 16) = pack4(v1); })
        } else if (pn >= 11 && pn < 23) {
            EPI_LOOP8({ for (int q = 0; q < 4; ++q) { v0[q] = sigmoidf_(v0[q]); v1[q] = sigmoidf_(v1[q]); }
                *(v4u*)(P + (size_t)row * PLD + pn * 256 + col) = pack8(v0, v1); })
        } else if (pn == 23) {
            if (wc == 0) {
                EPI_LOOP({ if (bj == 0) { f32x4 r;
                    for (int q = 0; q < 4; ++q) { const int c = 4 * fq + q; const float x = v0[q];
                        if (c < 8) { const float z = x + dt_bias[c]; const float ez = __expf(z); const float sp = z > 15.f ? z : (ez < 0.03f ? ez * (1.f - ez * (0.5f - ez * (1.f / 3.f))) : __logf(1.f + ez)); r[q] = -__expf(a_log[c]) * sp; }
                        else r[q] = sigmoidf_(x); }
                    *(f32x4*)(GB + (size_t)row * 16 + 4 * fq) = r; } (void)v1; })
            }
        } else {
            EPI_LOOP8({ *(v4u*)(P + (size_t)row * PLD + pn * 256 + col) = pack8(v0, v1); })
        }
    }
};
struct EpiMerge {
    static constexpr bool PERM = false, AFTER_DRAIN = false;
    bf16* MG; const bf16* P; int gcol0; int first;
    __device__ __forceinline__ void operator()(const pg8::f32x4 (&acc)[2][2][4][2], const pg8::Unit& u, int wr, int wc, int fr, int fq) const {
        EPI_LOOP8({ const int c = u.pn * 256 + col; const v4u gw = *(const v4u*)(P + (size_t)row * PLD + gcol0 + c); bf16* o = MG + (size_t)row * DM + c;
            f32x4 r0 = unpack4((v2u){gw.x, gw.y}) * v0, r1 = unpack4((v2u){gw.z, gw.w}) * v1;
            if (!first) { unsigned long long w0 = __hip_atomic_load((unsigned long long*)o, RLX_AGENT), w1 = __hip_atomic_load((unsigned long long*)(o + 4), RLX_AGENT);
                r0 += unpack4((v2u){(unsigned)w0, (unsigned)(w0 >> 32)}); r1 += unpack4((v2u){(unsigned)w1, (unsigned)(w1 >> 32)}); }
            *(v4u*)o = pack8(r0, r1); })
    }
};
struct EpiResid {
    static constexpr bool PERM = false, AFTER_DRAIN = false;
    float* H; const float* modl; int gidx;
    __device__ __forceinline__ void operator()(const pg8::f32x4 (&acc)[2][2][4][2], const pg8::Unit& u, int wr, int wc, int fr, int fq) const {
        EPI_LOOP8({ const int c = u.pn * 256 + col; const int b = row / RPB, j = row - b * RPB; const int mr = j < CTXL ? 4 : b;
            const float* gp = modl + mr * 6144 + gidx * 1024 + c; float* hp = H + (size_t)row * DM + c;
            const f32x4 g0 = *(const f32x4*)gp, g1 = *(const f32x4*)(gp + 4);
            *(f32x4*)hp = *(const f32x4*)hp + g0 * v0; *(f32x4*)(hp + 4) = *(const f32x4*)(hp + 4) + g1 * v1; })
    }
};
struct EpiSwiglu {
    static constexpr bool PERM = false, AFTER_DRAIN = false;
    bf16* HID; int ldh;
    __device__ __forceinline__ void operator()(const pg8::f32x4 (&acc)[2][2][4][2], const pg8::Unit& u, int wr, int wc, int fr, int fq) const {
#pragma unroll
        for (int ai = 0; ai < 2; ++ai)
#pragma unroll
            for (int m = 0; m < 4; ++m) { const int row = u.pm * 256 + ai * 128 + wr * 64 + m * 16 + fr; f32x4 r0, r1;
#pragma unroll
                for (int q = 0; q < 4; ++q) { r0[q] = siluf_(acc[ai][0][m][0][q]) * acc[ai][0][m][1][q]; r1[q] = siluf_(acc[ai][1][m][0][q]) * acc[ai][1][m][1][q]; }
                *(v4u*)(HID + (size_t)row * ldh + u.pn * 128 + wc * 32 + 8 * fq) = pack8(r0, r1);
                if (m & 1) asm volatile("" ::: "memory"); }
    }
};
struct EpiSwiglu8 {
    static constexpr bool PERM = false, AFTER_DRAIN = false;
    unsigned char* HID; int ldh;
    __device__ __forceinline__ void operator()(const pg8::f32x4 (&acc)[2][2][4][2], const pg8::Unit& u, int wr, int wc, int fr, int fq) const {
        const float s8 = (float)(1 << F8_ACT_L2);
#pragma unroll
        for (int ai = 0; ai < 2; ++ai)
#pragma unroll
            for (int m = 0; m < 4; ++m) { const int row = u.pm * 256 + ai * 128 + wr * 64 + m * 16 + fr; f32x4 r0, r1;
#pragma unroll
                for (int q = 0; q < 4; ++q) { r0[q] = siluf_(acc[ai][0][m][0][q]) * acc[ai][0][m][1][q] * s8; r1[q] = siluf_(acc[ai][1][m][0][q]) * acc[ai][1][m][1][q] * s8; }
                v2u o; o.x = cvt4_fp8(r0[0], r0[1], r0[2], r0[3]); o.y = cvt4_fp8(r1[0], r1[1], r1[2], r1[3]);
                *(v2u*)(HID + (size_t)row * ldh + u.pn * 128 + wc * 32 + 8 * fq) = o;
                if (m & 1) asm volatile("" ::: "memory"); }
    }
};
struct EpiY {
    static constexpr bool PERM = false, AFTER_DRAIN = false;
    bf16* Y; int first;
    __device__ __forceinline__ void operator()(const pg8::f32x4 (&acc)[2][2][4][2], const pg8::Unit& u, int wr, int wc, int fr, int fq) const {
        EPI_LOOP8({ (void)first; *(v4u*)(Y + (size_t)row * DM + u.pn * 256 + col) = pack8(v0, v1); })
    }
};

__device__ __forceinline__ int iperm32(int c) { return ((c >> 2) & 1) * 16 + (c >> 3) * 4 + (c & 3); }
template <int MAP> __device__ __forceinline__ int map_col(int c) {
    if (MAP == 0) return c;
    if (MAP == 1) { const int d = c < 2560 ? c : (c < 2576 ? PC_AB + (c - 2560) : (c < 2832 ? PC_POOL + (c - 2576) : PC_GATE + (c - 2832)));
        return (d < 1024 || d >= PC_AB) ? d : (d & ~31) + iperm32(d & 31); }
    if (MAP == 4) return (c & ~31) + iperm32(c & 31);
    { const int x = c & 31; return (c >> 7) * 256 + ((x >> 2) & 1) * 128 + ((c >> 5) & 3) * 32 + (MAP == 3 ? 16 : 0) + 4 * (x >> 3) + (x & 3); }
}
template <int MAP> __device__ __forceinline__ void tr_item(const float* W, int ldw, int N, bf16* WT, int ldd, int item, LAS float* scr, int lane) {
    const int nblk = (N + 31) / 32, kb = item / nblk, nb = item % nblk, k0 = 64 * kb, n0 = 32 * nb;
    const int cl = n0 + (lane & 31);
    float tv[32];
#pragma unroll
    for (int i = 0; i < 32; ++i) { const int kk = 2 * i + (lane >> 5); tv[i] = cl < N ? W[(size_t)(k0 + kk) * ldw + cl] : 0.f; }
#pragma unroll
    for (int i = 0; i < 32; ++i) { const int kk = 2 * i + (lane >> 5); scr[kk * 33 + (lane & 31)] = tv[i]; }
    LDS_WAIT(); asm volatile("" ::: "memory");
    const int c = lane & 7;
#pragma unroll
    for (int j = 0; j < 4; ++j) { const int n = (lane >> 3) + 8 * j; const LAS float* s = scr + (8 * c) * 33 + n;
        if (n0 + n < N) { v4u o; o.x = pk2(s[0 * 33], s[1 * 33]); o.y = pk2(s[2 * 33], s[3 * 33]); o.z = pk2(s[4 * 33], s[5 * 33]); o.w = pk2(s[6 * 33], s[7 * 33]);
            *(GAS v4u*)(WT + (size_t)map_col<MAP>(n0 + n) * ldd + k0 + 8 * c) = o; } }
    LDS_WAIT(); asm volatile("" ::: "memory");
}
template <int MAP> __device__ __forceinline__ void tr_item8(const float* W, int ldw, int N, unsigned char* WT, int ldd, int item, LAS float* scr, int lane, float scale) {
    const int nblk = (N + 31) / 32, kb = item / nblk, nb = item % nblk, k0 = 64 * kb, n0 = 32 * nb;
    const int cl = n0 + (lane & 31);
    float tv[32];
#pragma unroll
    for (int i = 0; i < 32; ++i) { const int kk = 2 * i + (lane >> 5); tv[i] = cl < N ? W[(size_t)(k0 + kk) * ldw + cl] : 0.f; }
#pragma unroll
    for (int i = 0; i < 32; ++i) { const int kk = 2 * i + (lane >> 5); scr[kk * 33 + (lane & 31)] = tv[i]; }
    LDS_WAIT(); asm volatile("" ::: "memory");
    const int c = lane & 7;
#pragma unroll
    for (int j = 0; j < 4; ++j) { const int n = (lane >> 3) + 8 * j; const LAS float* s = scr + (8 * c) * 33 + n;
        if (n0 + n < N) { v2u o; o.x = cvt4_fp8(s[0 * 33] * scale, s[1 * 33] * scale, s[2 * 33] * scale, s[3 * 33] * scale); o.y = cvt4_fp8(s[4 * 33] * scale, s[5 * 33] * scale, s[6 * 33] * scale, s[7 * 33] * scale);
            *(GAS v2u*)(WT + (size_t)map_col<MAP>(n0 + n) * ldd + k0 + 8 * c) = o; } }
    LDS_WAIT(); asm volatile("" ::: "memory");
}
#define TR_RUN(MAP, W, ldw, K, N, WT, ldd) { const int cnt_ = ((K) / 64) * (((N) + 31) / 32); if (r < cnt_) { tr_item<MAP>(W, ldw, N, WT, ldd, r, scr, F.lane); continue; } r -= cnt_; }

constexpr int LW_ITEMS = 16 * 185 + 8 * 32 + 4 * 32 + 4 * 32 + 16 * 32;
__device__ __forceinline__ void conv_layer_weights(Frame& F, const Args& A, int l, int rank, int nranks) {
    LAS float* scr = (LAS float*)(F.lds + F.wave * 16384);
    bf16* WIN = (bf16*)(F.ws + WS_WIN); bf16* WBR = (bf16*)(F.ws + WS_WBR); bf16* WOUT = (bf16*)(F.ws + WS_WOUT);
    const float* win = A.in[F.zz + 8] + (size_t)l * 1024 * INW; const float* wbr = A.in[F.zz + 17] + (size_t)l * 1024 * 1024; const float* wo = A.in[F.zz + 18] + (size_t)l * 1024 * 1024;
    bf16* dbr = WBR + (size_t)l * 1024 * 1024;
    for (int it = rank; it < LW_ITEMS; it += nranks) {
        int r = it;
        { const int cnt_ = 16 * 185; if (r < cnt_) { tr_item<1>(win, INW, INW, WIN + (size_t)l * NPROJ * 1024, 1024, r, scr, F.lane); continue; } r -= cnt_; }
        { const int cnt_ = 8 * 32; if (r < cnt_) { tr_item<4>(wbr, 1024, 1024, dbr, 512, r, scr, F.lane); continue; } r -= cnt_; }
        { const int cnt_ = 4 * 32; if (r < cnt_) { tr_item<4>(wbr + 512 * 1024, 1024, 1024, dbr + 1024 * 512, 256, r, scr, F.lane); continue; } r -= cnt_; }
        { const int cnt_ = 4 * 32; if (r < cnt_) { tr_item<4>(wbr + 768 * 1024, 1024, 1024, dbr + 1024 * 768, 256, r, scr, F.lane); continue; } r -= cnt_; }
        tr_item<4>(wo, 1024, 1024, WOUT + (size_t)l * 1024 * 1024, 1024, r, scr, F.lane);
    }
}
__device__ __forceinline__ void p0_prologue(Frame& F, const Args& A) {
    LAS float* scr = (LAS float*)(F.lds + F.wave * 16384);
    const int gw = F.vcu * NWAVES + F.wave, NGW = F.G * NWAVES;
    bf16* W13 = (bf16*)(F.ws + WS_W13); bf16* W2 = (bf16*)(F.ws + WS_W2);
    conv_layer_weights(F, A, 0, gw, NGW);
    constexpr int TOTAL = 16 * 88 * 2 + 44 * 32;
    for (int it = gw; it < TOTAL; it += NGW) {
        int r = it;
#ifdef DENSE_F8
        { const int cnt_ = 16 * 88; if (r < cnt_) { tr_item8<2>(A.in[F.zz + 19], FFD, FFD, (unsigned char*)W13, 1024, r, scr, F.lane, (float)(1 << F8_W13_L2)); continue; } r -= cnt_; }
        { const int cnt_ = 16 * 88; if (r < cnt_) { tr_item8<3>(A.in[F.zz + 20], FFD, FFD, (unsigned char*)W13, 1024, r, scr, F.lane, (float)(1 << F8_W13_L2)); continue; } r -= cnt_; }
        tr_item8<4>(A.in[F.zz + 21], 1024, 1024, (unsigned char*)W2, FFD, r, scr, F.lane, (float)(1 << F8_W2_L2));
#else
        { const int cnt_ = 16 * 88; if (r < cnt_) { tr_item<2>(A.in[F.zz + 19], FFD, FFD, W13, 1024, r, scr, F.lane); continue; } r -= cnt_; }
        { const int cnt_ = 16 * 88; if (r < cnt_) { tr_item<3>(A.in[F.zz + 20], FFD, FFD, W13, 1024, r, scr, F.lane); continue; } r -= cnt_; }
        tr_item<4>(A.in[F.zz + 21], 1024, 1024, W2, FFD, r, scr, F.lane);
#endif
    }
    float* H = (float*)(F.ws + WS_H);
    for (int R = gw; R < MROWS; R += NGW) { const int b = R / RPB, j = R - b * RPB;
        const float* src = j < CTXL ? A.in[F.zz + 2] + ((size_t)b * CTXL + j) * DM : A.in[F.zz + 0] + ((size_t)b * SEQ + (j - CTXL)) * DM;
        const GAS f32x4* s4 = (const GAS f32x4*)src + F.lane; GAS f32x4* d4 = (GAS f32x4*)(H + (size_t)R * DM) + F.lane;
#pragma unroll
        for (int q = 0; q < 4; ++q) d4[64 * q] = s4[64 * q]; }
    if (F.vcu == 0) {
        float* rope = (float*)(F.ws + WS_ROPE);
        for (int e = F.tid; e < 1024; e += NTHR) { const int pos = e >> 4, i = e & 15; const float inv = powf(10000.f, -(float)i / 16.f); const float a = (float)pos * inv;
            rope[2 * e] = cosf(a); rope[2 * e + 1] = sinf(a); }
        if (F.tid < 2) { const int l = F.tid; const float* lp = A.in[F.zz + 9] + l * 256; float s1 = 0.f, s2 = 0.f;
            for (int i = 0; i < 64; ++i) { s1 += lp[i] * lp[64 + i]; s2 += lp[128 + i] * lp[192 + i]; }
            const float li = 0.8f - 0.6f * expf(-0.3f * (float)l);
            ((float*)(F.ws + WS_LAM))[l] = expf(s1) - expf(s2) + li; }
    }
    __syncthreads();
    float* MOD = (float*)(F.ws + WS_MOD);
    LAS float* red = (LAS float*)F.lds;
    for (int task = F.vcu; task < 2 * 96; task += F.G) {
        const int l = task / 96, cc = task % 96;
        const float* aw = A.in[F.zz + 4] + (size_t)l * 1024 * 6144 + cc * 64 + F.lane;
        const float* c0 = A.in[F.zz + 1]; const float* cx = A.in[F.zz + 3];
        float a0 = 0.f, a1 = 0.f, a2 = 0.f, a3 = 0.f, a4 = 0.f;
#pragma unroll 8
        for (int i = 0; i < 128; ++i) { const int k = F.wave * 128 + i; const float w = aw[(size_t)k * 6144];
            a0 += siluf_(c0[k]) * w; a1 += siluf_(c0[1024 + k]) * w; a2 += siluf_(c0[2048 + k]) * w; a3 += siluf_(c0[3072 + k]) * w; a4 += siluf_(cx[k]) * w; }
        LAS float* rw = red + F.wave * 320 + F.lane;
        rw[0] = a0; rw[64] = a1; rw[128] = a2; rw[192] = a3; rw[256] = a4;
        __syncthreads();
        if (F.tid < 320) { float s = 0.f;
#pragma unroll
            for (int w = 0; w < 8; ++w) s += red[w * 320 + F.tid];
            const int rr = F.tid >> 6, jj = cc * 64 + (F.tid & 63);
            MOD[(l * 5 + rr) * 6144 + jj] = s + A.in[F.zz + 5][l * 6144 + jj]; }
        __syncthreads();
    }
}

__device__ __forceinline__ void moe_convert(Frame& F, const Args& A, int rank, int nranks) {
    LAS float* scr = (LAS float*)(F.lds + F.wave * 16384);
    const int gw = rank, NGW = nranks;
    unsigned char* W13M = F.ws + WS_W13M; unsigned char* W2M = F.ws + WS_W2M;
    constexpr int I13 = 16 * 112, I2 = 56 * 32, PER_E = 2 * I13 + I2;
    for (int it = gw; it < 8 * PER_E; it += NGW) {
        const int e = it / PER_E; int r = it - e * PER_E;
        if (r < I13) { tr_item8<2>(A.in[F.zz + 23] + (size_t)e * 1024 * FFE, FFE, FFE, W13M + (size_t)e * 2 * FFE * 1024, 1024, r, scr, F.lane, (float)(1 << F8_W13_L2)); continue; } r -= I13;
        if (r < I13) { tr_item8<3>(A.in[F.zz + 24] + (size_t)e * 1024 * FFE, FFE, FFE, W13M + (size_t)e * 2 * FFE * 1024, 1024, r, scr, F.lane, (float)(1 << F8_W13_L2)); continue; } r -= I13;
        tr_item8<4>(A.in[F.zz + 25] + (size_t)e * FFE * 1024, 1024, 1024, W2M + (size_t)e * 1024 * FFE, FFE, r, scr, F.lane, (float)(1 << F8_W2_L2));
    }
}

__device__ __forceinline__ void norm_mod_phase(Frame& F, const Args& A, int l, int which, bool latent_only, bool route, bool out8 = false) {
    const int gw = F.vcu * NWAVES + F.wave, NGW = F.G * NWAVES;
    const float* H = (const float*)(F.ws + WS_H); bf16* U = (bf16*)(F.ws + WS_U); const float* MOD = (const float*)(F.ws + WS_MOD) + l * 5 * 6144;
    const float* g = (which ? A.in[F.zz + 7] : A.in[F.zz + 6]) + l * 1024;
    for (int R = gw; R < MROWS; R += NGW) {
        const int b = R / RPB, j = R - b * RPB; const bool isctx = j < CTXL; if (latent_only && isctx) continue;
        const float* mod = MOD + (isctx ? 4 : b) * 6144; const float* shift = mod + (which ? 3 : 0) * 1024; const float* scale = mod + (which ? 4 : 1) * 1024;
        const GAS f32x4* xr = (const GAS f32x4*)(H + (size_t)R * DM) + F.lane;
        f32x4 v[4]; float ss = 0.f;
#pragma unroll
        for (int q = 0; q < 4; ++q) { v[q] = xr[64 * q]; ss += (v[q].x * v[q].x + v[q].y * v[q].y) + (v[q].z * v[q].z + v[q].w * v[q].w); }
        const float rstd = 1.f / sqrtf(wave_sum(ss) * (1.f / DM) + EPSN);
        GAS v2u* o8 = (GAS v2u*)(U + (size_t)R * DM) + F.lane;
#pragma unroll
        for (int q = 0; q < 4; ++q) { const int c = 4 * F.lane + 256 * q; const f32x4 gg = *(const f32x4*)(g + c), sh = *(const f32x4*)(shift + c), sc = *(const f32x4*)(scale + c);
            v[q] = (v[q] * rstd) * gg * (sc + 1.f) + sh;
            if (out8) { const float s8 = (float)(1 << F8_ACT_L2); ((GAS unsigned*)((unsigned char*)U + (size_t)R * DM))[F.lane + 64 * q] = cvt4_fp8(v[q].x * s8, v[q].y * s8, v[q].z * s8, v[q].w * s8); }
            else { v2u w; w.x = pk2(v[q].x, v[q].y); w.y = pk2(v[q].z, v[q].w); o8[64 * q] = w; } }
        if (route) {
            const float* rw = A.in[F.zz + 22];
            float lg[8] = {0, 0, 0, 0, 0, 0, 0, 0};
#pragma unroll
            for (int q = 0; q < 4; ++q)
#pragma unroll
                for (int i = 0; i < 4; ++i) { const int k = 4 * F.lane + 256 * q + i; const f32x4 w0 = *(const f32x4*)(rw + k * 8), w1 = *(const f32x4*)(rw + k * 8 + 4); const float x = v[q][i];
                    lg[0] += x * w0[0]; lg[1] += x * w0[1]; lg[2] += x * w0[2]; lg[3] += x * w0[3]; lg[4] += x * w1[0]; lg[5] += x * w1[1]; lg[6] += x * w1[2]; lg[7] += x * w1[3]; }
#pragma unroll
            for (int e = 0; e < 8; ++e) lg[e] = wave_sum(lg[e]);
            if (F.lane == 0) {
                int e0 = 0; float v0 = lg[0];
#pragma unroll
                for (int e = 1; e < 8; ++e) if (lg[e] > v0) { v0 = lg[e]; e0 = e; }
                int e1 = -1; float v1 = -3.0e38f;
#pragma unroll
                for (int e = 0; e < 8; ++e) if (e != e0 && lg[e] > v1) { v1 = lg[e]; e1 = e; }
                const float ex = __expf(v1 - v0); const float w0 = 1.f / (1.f + ex), w1 = ex / (1.f + ex);
                gu32* cnt = F.ctl + CW_ECNT;
#ifdef DBG_DETPOS
                const unsigned p0 = 0, p1 = 0; (void)cnt;
#else
                const unsigned p0 = __hip_atomic_fetch_add(cnt + 64 * e0, 1u, RLX_AGENT), p1 = __hip_atomic_fetch_add(cnt + 64 * e1, 1u, RLX_AGENT);
#endif
                const int tk = b * SEQ + (j - CTXL);
                v4u* rt = (v4u*)(F.ws + WS_ROUTE) + 2 * tk;
                rt[0] = (v4u){(unsigned)e0, (unsigned)e1, p0, p1}; rt[1] = (v4u){__float_as_uint(w0), __float_as_uint(w1), 0u, 0u};
            }
        }
    }
}

__device__ __forceinline__ void moe_gather2(Frame& F) {
    const int gw = F.vcu * NWAVES + F.wave, NGW = F.G * NWAVES;
    MoeOrder mo; mo.init(F.ctl + CW_ECNT, 1, 1, 0);
    const bf16* U = (const bf16*)(F.ws + WS_U); unsigned char* XG = F.ws + WS_XG; const float sc = (float)(1 << F8_ACT_L2);
    for (int tk = gw; tk < NB * SEQ; tk += NGW) {
        const int b = tk / SEQ, t = tk - b * SEQ; const size_t R = (size_t)b * RPB + CTXL + t;
        const v4u rt = ((const v4u*)(F.ws + WS_ROUTE))[2 * tk];
        const size_t r0 = (size_t)mo.tile_off((int)rt.x) * 256 + rt.z, r1 = (size_t)mo.tile_off((int)rt.y) * 256 + rt.w;
        const GAS v4u* s = (const GAS v4u*)(U + R * DM) + 2 * F.lane; const v4u a = s[0], c = s[1];
        v4u o; o.x = cvt4_fp8(bf_lo(a.x) * sc, bf_hi(a.x) * sc, bf_lo(a.y) * sc, bf_hi(a.y) * sc); o.y = cvt4_fp8(bf_lo(a.z) * sc, bf_hi(a.z) * sc, bf_lo(a.w) * sc, bf_hi(a.w) * sc);
        o.z = cvt4_fp8(bf_lo(c.x) * sc, bf_hi(c.x) * sc, bf_lo(c.y) * sc, bf_hi(c.y) * sc); o.w = cvt4_fp8(bf_lo(c.z) * sc, bf_hi(c.z) * sc, bf_lo(c.w) * sc, bf_hi(c.w) * sc);
        *((GAS v4u*)(XG + r0 * DM) + F.lane) = o; *((GAS v4u*)(XG + r1 * DM) + F.lane) = o;
    }
}
__device__ __forceinline__ void moe_gather(Frame& F) {
    moe_gather2(F);
}
__device__ __forceinline__ void final_phase(Frame& F, const Args& A) {
    const int gw = F.vcu * NWAVES + F.wave, NGW = F.G * NWAVES;
    MoeOrder mo; mo.init(F.ctl + CW_ECNT, 1, 1, 0);
    const float* H = (const float*)(F.ws + WS_H); const bf16* Y = (const bf16*)(F.ws + WS_Y); const float* MOD = (const float*)(F.ws + WS_MOD) + 1 * 5 * 6144;
    for (int tk = gw; tk < NB * SEQ; tk += NGW) {
        const int b = tk / SEQ, t = tk - b * SEQ; const size_t R = (size_t)b * RPB + CTXL + t;
        const v4u rt = ((const v4u*)(F.ws + WS_ROUTE))[2 * tk], rw = ((const v4u*)(F.ws + WS_ROUTE))[2 * tk + 1];
        const size_t r0 = (size_t)mo.tile_off((int)rt.x) * 256 + rt.z, r1 = (size_t)mo.tile_off((int)rt.y) * 256 + rt.w;
        const float w0 = __uint_as_float(rw.x), w1 = __uint_as_float(rw.y);
        const float* gate = MOD + b * 6144 + 5 * 1024;
        f32x4 v[4]; float ss = 0.f;
#pragma unroll
        for (int q = 0; q < 4; ++q) { const int c = 4 * F.lane + 256 * q;
            const f32x4 h = *(const f32x4*)(H + R * DM + c), gg = *(const f32x4*)(gate + c);
            const f32x4 y0 = unpack4(*(const v2u*)(Y + r0 * DM + c)), y1 = unpack4(*(const v2u*)(Y + r1 * DM + c));
            v[q] = h + gg * (y0 * w0 + y1 * w1); ss += (v[q].x * v[q].x + v[q].y * v[q].y) + (v[q].z * v[q].z + v[q].w * v[q].w); }
        const float rstd = 1.f / sqrtf(wave_sum(ss) * (1.f / DM) + EPSN);
#pragma unroll
        for (int q = 0; q < 4; ++q) { const int c = 4 * F.lane + 256 * q; *(f32x4*)(F.out + (size_t)tk * DM + c) = v[q] * rstd * *(const f32x4*)(A.in[F.zz + 26] + c); }
    }
}

constexpr int DP = 65;
typedef short dn_bf16x8 __attribute__((ext_vector_type(8)));
__device__ __forceinline__ f32x4 mm_tile(const LAS float* Am, int a_sm, int a_sk, const LAS float* Bm, int b_sk, int b_sn, int m0, int n0, int lane) {
    const int r = lane & 15, q = lane >> 4; f32x4 acc = {0.f, 0.f, 0.f, 0.f};
#pragma unroll
    for (int ks = 0; ks < 2; ++ks) {
        const LAS float* ap = Am + (m0 + r) * a_sm + (32 * ks + 8 * q) * a_sk; const LAS float* bp = Bm + (32 * ks + 8 * q) * b_sk + (n0 + r) * b_sn;
        v4u a, b;
        a.x = pk2(ap[0], ap[a_sk]); a.y = pk2(ap[2 * a_sk], ap[3 * a_sk]); a.z = pk2(ap[4 * a_sk], ap[5 * a_sk]); a.w = pk2(ap[6 * a_sk], ap[7 * a_sk]);
        b.x = pk2(bp[0], bp[b_sk]); b.y = pk2(bp[2 * b_sk], bp[3 * b_sk]); b.z = pk2(bp[4 * b_sk], bp[5 * b_sk]); b.w = pk2(bp[6 * b_sk], bp[7 * b_sk]);
        acc = __builtin_amdgcn_mfma_f32_16x16x32_bf16(__builtin_bit_cast(dn_bf16x8, a), __builtin_bit_cast(dn_bf16x8, b), acc, 0, 0, 0);
    }
    return acc;
}

constexpr int RS = 72;
constexpr int IMG = 64 * RS * 2;
typedef short dn_s16x4 __attribute__((ext_vector_type(4)));
__device__ __forceinline__ f32x4 mm_img(const LAS bf16* Ai, const LAS bf16* Bi, int m0, int n0, int r, int q) {
    f32x4 acc = {0.f, 0.f, 0.f, 0.f};
    const LAS bf16* ap = Ai + (m0 + r) * RS + 8 * q; const LAS bf16* bp = Bi + (n0 + r) * RS + 8 * q;
    acc = __builtin_amdgcn_mfma_f32_16x16x32_bf16(*(const LAS dn_bf16x8*)ap, *(const LAS dn_bf16x8*)bp, acc, 0, 0, 0);
    acc = __builtin_amdgcn_mfma_f32_16x16x32_bf16(*(const LAS dn_bf16x8*)(ap + 32), *(const LAS dn_bf16x8*)(bp + 32), acc, 0, 0, 0);
    return acc;
}
template <int D> __device__ __forceinline__ void dn_diag_inv(LAS float* Dg, int ln) {
    const int blk = ln >> 4, r = ln & 15;
    LAS float* Ab = Dg + blk * 256;
    float t[16];
#pragma unroll
    for (int c = 0; c < 16; ++c) t[c] = (c == r) ? 1.f : 0.f;
#pragma unroll
    for (int c = 14; c >= 0; --c) { float s = 0.f;
#pragma unroll
        for (int j = c + 1; j < 16; ++j) { const float a = D == 0 ? Ab[j * 16 + c] : Ab[(15 - j) * 16 + (15 - c)]; s -= t[j] * a; }
        t[c] = (c < r) ? s : t[c]; }
    asm volatile("s_waitcnt lgkmcnt(0)" ::: "memory");
#pragma unroll
    for (int c = 0; c < 16; ++c) { if (D == 0) Ab[r * 16 + c] = t[c]; else Ab[(15 - r) * 16 + (15 - c)] = t[c]; }
}
template <int D> __device__ __forceinline__ void dn_solve_tiles(const LAS bf16* Ad, const LAS float* Dg, const LAS bf16* VT, const LAS bf16* KT, LAS bf16* UT, LAS bf16* WT,
                                                               const LAS float* Bd, const LAS float* Gd, int w4, int ln) {
    const int r = ln & 15, q = ln >> 4;
#pragma unroll 1
    for (int i = 0; i < 2; ++i) { const int nt = w4 * 2 + i; const bool isw = nt >= 4; const int c0 = (nt & 3) * 16 + r;
        const LAS bf16* src = (isw ? KT : VT) + c0 * RS; LAS bf16* dst = (isw ? WT : UT) + c0 * RS;
        f32x4 acc[4]; dn_s16x4 xb[4];
#pragma unroll
        for (int bi = 0; bi < 4; ++bi) { const v2u x = *(const LAS v2u*)(src + 16 * bi + 4 * q); const f32x4 xv = {bf_lo(x.x), bf_hi(x.x), bf_lo(x.y), bf_hi(x.y)};
#pragma unroll
            for (int g = 0; g < 4; ++g) { const int t = 16 * bi + 4 * q + g; const float sc = isw ? Bd[t] * __expf(Gd[t]) : Bd[t]; acc[bi][g] = xv[g] * sc; } }
#pragma unroll
        for (int st = 0; st < 4; ++st) { const int bi = D == 0 ? st : 3 - st;
#pragma unroll
            for (int s2 = 0; s2 < st; ++s2) { const int bj = D == 0 ? s2 : 3 - s2;
                v2u a = *(const LAS v2u*)(Ad + (16 * bi + r) * RS + 16 * bj + 4 * q); a.x ^= 0x80008000u; a.y ^= 0x80008000u;
                acc[bi] = __builtin_amdgcn_mfma_f32_16x16x16bf16_1k(__builtin_bit_cast(dn_s16x4, a), xb[bj], acc[bi], 0, 0, 0); }
            { const LAS float* tp = Dg + bi * 256 + r * 16 + 4 * q; v2u a; a.x = cvtpk_c(tp[0], tp[1]); a.y = cvtpk_c(tp[2], tp[3]);
              v2u xr; xr.x = cvtpk_c(acc[bi][0], acc[bi][1]); xr.y = cvtpk_c(acc[bi][2], acc[bi][3]);
              acc[bi] = __builtin_amdgcn_mfma_f32_16x16x16bf16_1k(__builtin_bit_cast(dn_s16x4, a), __builtin_bit_cast(dn_s16x4, xr), (f32x4){0.f, 0.f, 0.f, 0.f}, 0, 0, 0);
              v2u xo; xo.x = cvtpk_c(acc[bi][0], acc[bi][1]); xo.y = cvtpk_c(acc[bi][2], acc[bi][3]); xb[bi] = __builtin_bit_cast(dn_s16x4, xo);
              *(LAS v2u*)(dst + 16 * bi + 4 * q) = xo; }
        }
    }
}
__device__ __forceinline__ void dn_pre_unit(Frame& F, const Args& A, int l, int b, int n, int h) {
    LAS bf16* KcB = (LAS bf16*)(F.lds + 0 * IMG); LAS bf16* QcB = (LAS bf16*)(F.lds + 1 * IMG); LAS bf16* KT = (LAS bf16*)(F.lds + 2 * IMG); LAS bf16* VT = (LAS bf16*)(F.lds + 3 * IMG);
#define DIMG(d, k) ((LAS bf16*)(F.lds + (4 + 5 * (d) + (k)) * IMG))
    LAS float* Gs = (LAS float*)(F.lds + 14 * IMG);
    LAS float* Bs = Gs + 128;
    LAS float* Dg = Gs + 256;
    const bf16* P = (const bf16*)(F.ws + WS_PROJ); const float* GB = (const float*)(F.ws + WS_GB);
    int tid = threadIdx.x; asm volatile("" : "+v"(tid));
    const int wv = tid >> 6, ln = tid & 63, r = ln & 15, q = ln >> 4;
    const int row0 = b * RPB + n * 64; const int seq_lo = (n < 4) ? b * RPB : b * RPB + CTXL, seq_hi = (n < 4) ? b * RPB + CTXL : (b + 1) * RPB;
    {
        const int t = tid >> 3, cg = tid & 7;
        const float* cw = A.in[F.zz + 11] + (size_t)l * 5 * 768;
#pragma unroll
        for (int p = 0; p < 3; ++p) {
            const int ch = p * 256 + h * 64 + cg * 8;
            float acc[8] = {0, 0, 0, 0, 0, 0, 0, 0};
#pragma unroll
            for (int tap = 0; tap < 5; ++tap) { const int rr = row0 + t + tap - 2;
                if (rr >= seq_lo && rr < seq_hi) { const v4u x = *(const v4u*)(P + (size_t)rr * PLD + PC_DQ + ch);
                    const f32x4 w0 = *(const f32x4*)(cw + tap * 768 + ch), w1 = *(const f32x4*)(cw + tap * 768 + ch + 4);
                    acc[0] += bf_lo(x.x) * w0[0]; acc[1] += bf_hi(x.x) * w0[1]; acc[2] += bf_lo(x.y) * w0[2]; acc[3] += bf_hi(x.y) * w0[3];
                    acc[4] += bf_lo(x.z) * w1[0]; acc[5] += bf_hi(x.z) * w1[1]; acc[6] += bf_lo(x.w) * w1[2]; acc[7] += bf_hi(x.w) * w1[3]; } }
            float ss = 0.f;
#pragma unroll
            for (int i = 0; i < 8; ++i) { acc[i] = siluf_(acc[i]); ss += acc[i] * acc[i]; }
            float sc = 1.f;
            if (p < 2) { ss += __shfl_xor(ss, 1); ss += __shfl_xor(ss, 2); ss += __shfl_xor(ss, 4); sc = (1.f / sqrtf(ss + EPSN)) * (p == 0 ? 0.125f : 1.f); }
            v4u o; o.x = cvtpk_c(acc[0] * sc, acc[1] * sc); o.y = cvtpk_c(acc[2] * sc, acc[3] * sc); o.z = cvtpk_c(acc[4] * sc, acc[5] * sc); o.w = cvtpk_c(acc[6] * sc, acc[7] * sc);
            if (p == 0) *(LAS v4u*)(QcB + t * RS + cg * 8) = o;
            else { if (p == 1) *(LAS v4u*)(KcB + t * RS + cg * 8) = o;
                LAS bf16* tp = (p == 1 ? KT : VT) + (cg * 8) * RS + t;
                tp[0 * RS] = (bf16)(o.x & 0xffffu); tp[1 * RS] = (bf16)(o.x >> 16); tp[2 * RS] = (bf16)(o.y & 0xffffu); tp[3 * RS] = (bf16)(o.y >> 16);
                tp[4 * RS] = (bf16)(o.z & 0xffffu); tp[5 * RS] = (bf16)(o.z >> 16); tp[6 * RS] = (bf16)(o.w & 0xffffu); tp[7 * RS] = (bf16)(o.w >> 16); }
        }
        if (wv < 2) { const int d = wv; const float* gb = GB + (size_t)(row0 + ln) * 16; const float g = gb[d * 4 + h]; Bs[d * 64 + ln] = gb[8 + d * 4 + h];
            float pf = g;
#pragma unroll
            for (int o = 1; o < 64; o <<= 1) { const float v = __shfl_up(pf, o); if (ln >= o) pf += v; }
            const float tot = __shfl(pf, 63);
            Gs[d * 64 + ln] = d == 0 ? pf : tot - pf + g; }
    }
    __syncthreads();
    {
#pragma unroll
        for (int i = 0; i < 2; ++i) { const int tile = wv * 2 + i, m0 = (tile >> 2) * 16, n0 = (tile & 3) * 16;
            const f32x4 kk = mm_img(KcB, KcB, m0, n0, r, q), qk = mm_img(QcB, KcB, m0, n0, r, q);
            const int s = n0 + r; const float g0s = Gs[s], g1s = Gs[64 + s];
#pragma unroll
            for (int g = 0; g < 4; ++g) { const int t = m0 + 4 * q + g; const float e0 = __expf(Gs[t] - g0s), e1 = __expf(Gs[64 + t] - g1s);
                const float a0 = (s < t) ? Bs[t] * kk[g] * e0 : 0.f, a1 = (s > t) ? Bs[64 + t] * kk[g] * e1 : 0.f;
                DIMG(0, 0)[t * RS + s] = (bf16)f2bf(a0); DIMG(1, 0)[t * RS + s] = (bf16)f2bf(a1);
                DIMG(0, 1)[t * RS + s] = (bf16)f2bf((s <= t) ? qk[g] * e0 : 0.f); DIMG(1, 1)[t * RS + s] = (bf16)f2bf((s >= t) ? qk[g] * e1 : 0.f);
                if (m0 == n0) { Dg[(m0 >> 4) * 256 + (t & 15) * 16 + r] = a0; Dg[1024 + (m0 >> 4) * 256 + (t & 15) * 16 + r] = a1; } } }
        { const int c = tid >> 3, t0 = (tid & 7) * 8; const v4u kx = *(const LAS v4u*)(KT + c * RS + t0); const float gl0 = Gs[63], gl1 = Gs[64];
          const float kf[8] = {bf_lo(kx.x), bf_hi(kx.x), bf_lo(kx.y), bf_hi(kx.y), bf_lo(kx.z), bf_hi(kx.z), bf_lo(kx.w), bf_hi(kx.w)};
          float s0[8], s1[8];
#pragma unroll
          for (int j = 0; j < 8; ++j) { s0[j] = kf[j] * __expf(gl0 - Gs[t0 + j]); s1[j] = kf[j] * __expf(gl1 - Gs[64 + t0 + j]); }
          v4u o0, o1; o0.x = cvtpk_c(s0[0], s0[1]); o0.y = cvtpk_c(s0[2], s0[3]); o0.z = cvtpk_c(s0[4], s0[5]); o0.w = cvtpk_c(s0[6], s0[7]);
          o1.x = cvtpk_c(s1[0], s1[1]); o1.y = cvtpk_c(s1[2], s1[3]); o1.z = cvtpk_c(s1[4], s1[5]); o1.w = cvtpk_c(s1[6], s1[7]);
          *(LAS v4u*)(DIMG(0, 4) + c * RS + t0) = o0; *(LAS v4u*)(DIMG(1, 4) + c * RS + t0) = o1; }
    }
    __syncthreads();
    if (wv == 0) dn_diag_inv<0>(Dg, ln); else if (wv == 4) dn_diag_inv<1>(Dg + 1024, ln);
    __syncthreads();
    if (wv < 4) dn_solve_tiles<0>(DIMG(0, 0), Dg, VT, KT, DIMG(0, 3), DIMG(0, 2), Bs, Gs, wv & 3, ln);
    else dn_solve_tiles<1>(DIMG(1, 0), Dg + 1024, VT, KT, DIMG(1, 3), DIMG(1, 2), Bs + 64, Gs + 64, wv & 3, ln);
    __syncthreads();
    {
        const int d = wv >> 2, mt = wv & 3;
        const LAS bf16* Aq = DIMG(d, 1); const LAS bf16* WT = DIMG(d, 2); const LAS bf16* UT = DIMG(d, 3); const LAS bf16* KsT = DIMG(d, 4); const LAS float* Gd = Gs + d * 64;
        const float glast = d == 0 ? Gd[63] : Gd[0];
        const size_t prob = (((size_t)b * NCHUNK + n) * 4 + h) * 2 + d;
        unsigned char* out = F.ws + WS_DNP + prob * 32768;
        if (ln == 0 && mt == 0) ((float*)(F.ws + WS_DNG))[prob] = __expf(glast);
        const float gq = __expf(Gd[16 * mt + r]);
#pragma unroll
        for (int ks = 0; ks < 2; ++ks) {
            const f32x4 y0 = mm_img(WT, Aq, 32 * ks, 16 * mt, r, q), y1 = mm_img(WT, Aq, 32 * ks + 16, 16 * mt, r, q);
            const LAS bf16* qp = QcB + (16 * mt + r) * RS + 32 * ks + 4 * q; const v2u qa = *(const LAS v2u*)qp, qb = *(const LAS v2u*)(qp + 16);
            v4u o; o.x = cvtpk_c(gq * bf_lo(qa.x) - y0[0], gq * bf_hi(qa.x) - y0[1]); o.y = cvtpk_c(gq * bf_lo(qa.y) - y0[2], gq * bf_hi(qa.y) - y0[3]);
            o.z = cvtpk_c(gq * bf_lo(qb.x) - y1[0], gq * bf_hi(qb.x) - y1[1]); o.w = cvtpk_c(gq * bf_lo(qb.y) - y1[2], gq * bf_hi(qb.y) - y1[3]);
            *(v4u*)(out + (mt * 2 + ks) * 1024 + ln * 16) = o;
            const f32x4 c0 = mm_img(WT, KsT, 32 * ks, 16 * mt, r, q), c1 = mm_img(WT, KsT, 32 * ks + 16, 16 * mt, r, q);
            v4u oc; oc.x = cvtpk_c(-c0[0], -c0[1]); oc.y = cvtpk_c(-c0[2], -c0[3]); oc.z = cvtpk_c(-c1[0], -c1[1]); oc.w = cvtpk_c(-c1[2], -c1[3]);
            *(v4u*)(out + 8192 + (mt * 2 + ks) * 1024 + ln * 16) = oc; }
#pragma unroll
        for (int nt = 0; nt < 4; ++nt) { const f32x4 rr = mm_img(Aq, UT, 16 * mt, 16 * nt, r, q), bb = mm_img(KsT, UT, 16 * mt, 16 * nt, r, q);
            v2u o; o.x = cvtpk_c(rr[0], rr[1]); o.y = cvtpk_c(rr[2], rr[3]); *(v2u*)(out + 16384 + (mt * 4 + nt) * 512 + ln * 8) = o;
            v2u ob; ob.x = cvtpk_c(bb[0], bb[1]); ob.y = cvtpk_c(bb[2], bb[3]); *(v2u*)(out + 24576 + (mt * 4 + nt) * 512 + ln * 8) = ob; }
    }
    __syncthreads();
#ifdef DBG_DN
    { unsigned char* out = F.ws + WS_DNP + ((((size_t)b * NCHUNK + n) * 4 + h) * 2) * 32768;
      if (DBG_DN < 14) { const LAS bf16* im = (const LAS bf16*)(F.lds + DBG_DN * IMG);
          for (int e = tid; e < 4096; e += NTHR) ((bf16*)out)[e] = im[(e >> 6) * RS + (e & 63)]; }
      else { for (int e = tid; e < 2304; e += NTHR) ((bf16*)out)[e] = (bf16)f2bf(Gs[e]); for (int e = 2304 + tid; e < 4096; e += NTHR) ((bf16*)out)[e] = 0; } }
    __syncthreads();
#endif
#undef DIMG
}

__device__ __forceinline__ void pool_unit(Frame& F, const Args& A, int l, int blk, int g) {
    LAS float* Uw = (LAS float*)F.lds;
    LAS float* Mm = Uw + 80 * DP;
    LAS float* PW = Mm + 64 * DP;
    const bf16* P = (const bf16*)(F.ws + WS_PROJ); bf16* PO = (bf16*)(F.ws + WS_POOLO);
    int tid = threadIdx.x; asm volatile("" : "+v"(tid));
    const int row0 = blk * 64, b = row0 / RPB, j0 = row0 - b * RPB; const bool isctx = j0 < CTXL;
    const int seq_lo = isctx ? b * RPB : b * RPB + CTXL, L = isctx ? CTXL : SEQ; const int pos0 = row0 - seq_lo;
    for (int idx = tid; idx < 640; idx += NTHR) { const int rr = idx >> 3, c8 = (idx & 7) * 8; const int pos = pos0 - 8 + rr;
        float v[8] = {0, 0, 0, 0, 0, 0, 0, 0};
        if (pos >= 0 && pos < L) { const v4u x = *(const v4u*)(P + (size_t)(seq_lo + pos) * PLD + PC_POOL + g * 64 + c8);
            v[0] = bf_lo(x.x); v[1] = bf_hi(x.x); v[2] = bf_lo(x.y); v[3] = bf_hi(x.y); v[4] = bf_lo(x.z); v[5] = bf_hi(x.z); v[6] = bf_lo(x.w); v[7] = bf_hi(x.w); }
#pragma unroll
        for (int i = 0; i < 8; ++i) Uw[rr * DP + c8 + i] = v[i]; }
    { const float* pw = A.in[F.zz + 15] + ((size_t)l * 4 + g) * 4096;
#pragma unroll
      for (int k = 0; k < 8; ++k) { const int e = tid + 512 * k; PW[(e >> 6) * DP + (e & 63)] = pw[e]; } }
    __syncthreads();
    const int win = 2 << g;
#pragma unroll 1
    for (int k = 0; k < 8; ++k) { const int e = tid + 512 * k, t = e >> 6, i = e & 63; const int pos = pos0 + t;
        int lo = pos - win / 2, hi = lo + win; lo = lo < 0 ? 0 : lo; hi = hi > L ? L : hi;
        float s = 0.f;
#pragma unroll 4
        for (int p = lo; p < hi; ++p) s += Uw[(p - pos0 + 8) * DP + i];
        Mm[t * DP + i] = s / (float)(hi - lo) - Uw[(t + 8) * DP + i]; }
    __syncthreads();
    const float* psc = A.in[F.zz + 16] + l * 256 + g * 64;
    { const int wv = tid >> 6, ln = tid & 63, r = ln & 15, q = ln >> 4;
#pragma unroll
      for (int i = 0; i < 2; ++i) { const int tile = wv * 2 + i, m0 = (tile >> 2) * 16, n0 = (tile & 3) * 16;
          const f32x4 y = mm_tile(Mm, DP, 1, PW, DP, 1, m0, n0, ln); const float sc = psc[n0 + r];
#pragma unroll
          for (int gg = 0; gg < 4; ++gg) PO[(size_t)(row0 + m0 + 4 * q + gg) * 256 + g * 64 + n0 + r] = (bf16)f2bf(y[gg] * sc); } }
    __syncthreads();
}

constexpr int SC_SLOT = 32768, SC_NSLOT = 4, SC_ST = SC_SLOT * SC_NSLOT, SC_GL = SC_ST + 2 * 8192;
__device__ __forceinline__ void dn_scan_item(Frame& F, int item) {
    typedef short s16x8v __attribute__((ext_vector_type(8)));
    const int d = item & 1, h = (item >> 1) & 3, b = item >> 3;
    int tid = threadIdx.x; asm volatile("" : "+v"(tid));
    const int wv = __builtin_amdgcn_readfirstlane(tid >> 6), ln = tid & 63, r = ln & 15, q = ln >> 4;
    LAS unsigned char* L = F.lds;
    LAS float* glv = (LAS float*)(L + SC_GL);
    const unsigned char* dnp = F.ws + WS_DNP;
#define SC_N(st) (d == 0 ? (st) : ((st) < 4 ? 3 - (st) : 71 - (st)))
#define SC_PROB(st) ((((size_t)b * NCHUNK + SC_N(st)) * 4 + h) * 2 + d)
    if (tid < NCHUNK) glv[tid] = ((const float*)(F.ws + WS_DNG))[SC_PROB(tid)];
    for (int e = tid; e < 2 * 8192 / 16; e += NTHR) ((LAS v4u*)(L + SC_ST))[e] = (v4u){0u, 0u, 0u, 0u};
    asm volatile("s_waitcnt vmcnt(0) lgkmcnt(0)" ::: "memory"); __builtin_amdgcn_s_barrier();
#define SC_DMA(st, slot) do { const unsigned char* src_ = dnp + SC_PROB(st) * 32768 + wv * 8192 + ln * 16; \
        _Pragma("unroll") for (int i_ = 0; i_ < 8; ++i_) __builtin_amdgcn_global_load_lds((const unsigned*)(src_ + i_ * 1024), (LAS unsigned*)(L + (slot) * SC_SLOT + wv * 8192 + i_ * 1024), 16, 0, 0); } while (0)
    if (wv < 4) { SC_DMA(0, 0); SC_DMA(1, 1); SC_DMA(2, 2); }
    f32x4 s0 = {0.f, 0.f, 0.f, 0.f}, s1 = s0, s2 = s0, s3 = s0;
    bf16* DNO = (bf16*)(F.ws + WS_DNO) + (size_t)d * MROWS * 256;
#pragma unroll 1
    for (int st = 0; st < NCHUNK; ++st) {
        if (wv < 4) asm volatile("s_waitcnt vmcnt(16)" ::: "memory");
        asm volatile("s_waitcnt lgkmcnt(0)" ::: "memory"); __builtin_amdgcn_s_barrier();
        if (wv < 4) { const int nx = st + 3 < NCHUNK ? st + 3 : NCHUNK - 1; SC_DMA(nx, (st + 3) & 3); }
        const LAS unsigned char* slot = L + (st & 3) * SC_SLOT;
        const LAS unsigned char* stc = L + SC_ST + (st & 1) * 8192; LAS unsigned char* stn = L + SC_ST + ((st + 1) & 1) * 8192;
        const int nt = wv & 3;
        const s16x8v bf0 = *(const LAS s16x8v*)(stc + (nt * 2 + 0) * 1024 + ln * 16), bf1 = *(const LAS s16x8v*)(stc + (nt * 2 + 1) * 1024 + ln * 16);
        if (wv < 4) {
            const float gl = glv[st];
            const LAS unsigned char* cf = slot + 8192; const LAS unsigned char* bi = slot + 24576;
#define SC_ST_TILE(S, mt) do { const v2u bw_ = *(const LAS v2u*)(bi + ((mt) * 4 + nt) * 512 + ln * 8); \
            f32x4 a_ = {gl * S[0] + bf_lo(bw_.x), gl * S[1] + bf_hi(bw_.x), gl * S[2] + bf_lo(bw_.y), gl * S[3] + bf_hi(bw_.y)}; \
            a_ = __builtin_amdgcn_mfma_f32_16x16x32_bf16(*(const LAS s16x8v*)(cf + ((mt) * 2 + 0) * 1024 + ln * 16), bf0, a_, 0, 0, 0); \
            a_ = __builtin_amdgcn_mfma_f32_16x16x32_bf16(*(const LAS s16x8v*)(cf + ((mt) * 2 + 1) * 1024 + ln * 16), bf1, a_, 0, 0, 0); S = a_; } while (0)
            SC_ST_TILE(s0, 0); SC_ST_TILE(s1, 1); SC_ST_TILE(s2, 2); SC_ST_TILE(s3, 3);
#undef SC_ST_TILE
            v4u w0, w1; w0.x = pk2(s0[0], s0[1]); w0.y = pk2(s0[2], s0[3]); w0.z = pk2(s1[0], s1[1]); w0.w = pk2(s1[2], s1[3]);
            w1.x = pk2(s2[0], s2[1]); w1.y = pk2(s2[2], s2[3]); w1.z = pk2(s3[0], s3[1]); w1.w = pk2(s3[2], s3[3]);
            *(LAS v4u*)(stn + (nt * 2 + 0) * 1024 + ln * 16) = w0; *(LAS v4u*)(stn + (nt * 2 + 1) * 1024 + ln * 16) = w1;
        } else {
            const LAS unsigned char* pf = slot; const LAS unsigned char* ri = slot + 16384;
            const int n = SC_N(st);
            bf16* orow = DNO + (size_t)(b * RPB + n * 64 + 4 * q) * 256 + h * 64 + nt * 16 + r;
#pragma unroll
            for (int mt = 0; mt < 4; ++mt) { const v2u rw_ = *(const LAS v2u*)(ri + (mt * 4 + nt) * 512 + ln * 8);
                f32x4 a_ = {bf_lo(rw_.x), bf_hi(rw_.x), bf_lo(rw_.y), bf_hi(rw_.y)};
                a_ = __builtin_amdgcn_mfma_f32_16x16x32_bf16(*(const LAS s16x8v*)(pf + (mt * 2 + 0) * 1024 + ln * 16), bf0, a_, 0, 0, 0);
                a_ = __builtin_amdgcn_mfma_f32_16x16x32_bf16(*(const LAS s16x8v*)(pf + (mt * 2 + 1) * 1024 + ln * 16), bf1, a_, 0, 0, 0);
#pragma unroll
                for (int g = 0; g < 4; ++g) orow[(size_t)(16 * mt + g) * 256] = (bf16)f2bf(a_[g]); }
        }
    }
    asm volatile("s_waitcnt vmcnt(0) lgkmcnt(0)" ::: "memory"); __builtin_amdgcn_s_barrier();
#undef SC_DMA
#undef SC_N
#undef SC_PROB
}

__device__ __forceinline__ void mix_build(Frame& F, const Args& A, int l) {
    int lane = threadIdx.x & 63; asm volatile("" : "+v"(lane)); const int gw = F.vcu * NWAVES + F.wave, NGW = F.G * NWAVES;
    const bf16* ATTO = (const bf16*)(F.ws + WS_ATTO); const bf16* P = (const bf16*)(F.ws + WS_PROJ); const bf16* DNO = (const bf16*)(F.ws + WS_DNO); bf16* MIX = (bf16*)(F.ws + WS_MIX);
    const float lam = ((const float*)(F.ws + WS_LAM))[l]; const float li = 0.8f - 0.6f * expf(-0.3f * (float)l);
    const float* sg = A.in[F.zz + 10] + l * 128; const float* ng = A.in[F.zz + 14] + l * 64;
    for (int R = gw; R < MROWS; R += NGW) {
        const int j = R % RPB; if (l == 1 && j < CTXL) continue;
        { const int hh = lane >> 4, e0 = (lane & 15) * 8;
          const v4u a = *(const v4u*)(ATTO + (size_t)R * DM + (hh * 2) * 128 + e0), c = *(const v4u*)(ATTO + (size_t)R * DM + (hh * 2 + 1) * 128 + e0);
          float x[8] = {bf_lo(a.x) - lam * bf_lo(c.x), bf_hi(a.x) - lam * bf_hi(c.x), bf_lo(a.y) - lam * bf_lo(c.y), bf_hi(a.y) - lam * bf_hi(c.y),
                        bf_lo(a.z) - lam * bf_lo(c.z), bf_hi(a.z) - lam * bf_hi(c.z), bf_lo(a.w) - lam * bf_lo(c.w), bf_hi(a.w) - lam * bf_hi(c.w)};
          float ss = 0.f;
#pragma unroll
          for (int i = 0; i < 8; ++i) ss += x[i] * x[i];
          ss += __shfl_xor(ss, 1); ss += __shfl_xor(ss, 2); ss += __shfl_xor(ss, 4); ss += __shfl_xor(ss, 8);
          const float sc = (1.f / sqrtf(ss * (1.f / 128.f) + EPSN)) * (1.f - li);
          const f32x4 g0 = *(const f32x4*)(sg + e0), g1 = *(const f32x4*)(sg + e0 + 4);
          v4u o; o.x = pk2(x[0] * sc * g0[0], x[1] * sc * g0[1]); o.y = pk2(x[2] * sc * g0[2], x[3] * sc * g0[3]); o.z = pk2(x[4] * sc * g1[0], x[5] * sc * g1[1]); o.w = pk2(x[6] * sc * g1[2], x[7] * sc * g1[3]);
          *(v4u*)(MIX + (size_t)R * DM + hh * 128 + e0) = o; }
        { const int c0 = lane * 4;
          const v2u a = *(const v2u*)(DNO + (size_t)R * 256 + c0), c = *(const v2u*)(DNO + ((size_t)MROWS + R) * 256 + c0), z = *(const v2u*)(P + (size_t)R * PLD + PC_DZ + c0);
          float x[4] = {bf_lo(a.x) + bf_lo(c.x), bf_hi(a.x) + bf_hi(c.x), bf_lo(a.y) + bf_lo(c.y), bf_hi(a.y) + bf_hi(c.y)};
          float ss = x[0] * x[0] + x[1] * x[1] + x[2] * x[2] + x[3] * x[3];
          ss += __shfl_xor(ss, 1); ss += __shfl_xor(ss, 2); ss += __shfl_xor(ss, 4); ss += __shfl_xor(ss, 8);
          const float sc = 1.f / sqrtf(ss * (1.f / 64.f) + EPSN);
          const f32x4 gg = *(const f32x4*)(ng + (c0 & 63));
          v2u o; o.x = pk2(x[0] * sc * gg[0] * siluf_(bf_lo(z.x)), x[1] * sc * gg[1] * siluf_(bf_hi(z.x))); o.y = pk2(x[2] * sc * gg[2] * siluf_(bf_lo(z.y)), x[3] * sc * gg[3] * siluf_(bf_hi(z.y)));
          *(v2u*)(MIX + (size_t)R * DM + 512 + c0) = o; }
    }
}

#ifndef MK_N_LAUNCHES
#define MK_N_LAUNCHES 1
#endif
__global__ void __launch_bounds__(NTHR, 2) mk_fwd(Args args) {
    extern __shared__ __attribute__((aligned(16))) unsigned char lds[];
    Frame F;
    F.lds = (LAS unsigned char*)lds;
    F.MISC = (volatile LAS unsigned*)(F.lds + MISC_OFF);
    F.tid = threadIdx.x; F.lane = F.tid & 63; F.wave = __builtin_amdgcn_readfirstlane(F.tid >> 6);
    F.G = gridDim.x; { const int bx = blockIdx.x; F.vcu = (F.G % 8 == 0) ? (bx % 8) * (F.G / 8) + bx / 8 : bx; }
    F.ws = args.ws; F.out = args.out; F.zz = 0;
    F.ctl = (gu32*)(args.ws + WS_CTL);
    for (int u = F.tid; u < (LDS_BYTES - MISC_OFF) / 4; u += NTHR) ((LAS unsigned*)(F.lds + MISC_OFF))[u] = 0u;
    __syncthreads();
    const int lo = args.ph_lo, hi = args.ph_hi;
    const bool use_bar = (hi - lo) > 1;
    XcdBarrier bar; bar.bar = (unsigned*)(F.ctl + CW_BAR); bar.x = 0; bar.st = nullptr;
    if (use_bar) bar = xcd_barrier_post((unsigned*)(F.ctl + CW_BAR), F.MISC + 8);
#ifndef EN_MASK
#define EN_MASK 0xFFFFFFFFu
#endif
#define IN(k) (((EN_MASK >> ((k) > 12 ? (k) - 12 : (k))) & 1u) && lo <= (k) && (k) < hi)
#define PB() do { int z_ = 0; asm volatile("" : "+s"(z_)); F.ws = args.ws + z_; F.ctl = (gu32*)(args.ws + z_); F.zz = z_; int t_ = threadIdx.x; asm volatile("" : "+v"(t_)); F.tid = t_; F.lane = t_ & 63; F.wave = __builtin_amdgcn_readfirstlane(t_ >> 6); } while (0)
#ifdef DBG_DUP
#define NREP(k) ((((k) > 12 && (k) < 23) ? (k) - 12 : (k)) == DBG_DUP ? 2 : 1)
#else
#define NREP(k) 1
#endif
#define SEAMX() do { XcdBarrier bl_ = bar; { int z_ = 0; unsigned x_ = bar.x; asm volatile("" : "+s"(z_), "+s"(x_)); bl_.bar = (unsigned*)(args.ws + WS_CTL) + CW_BAR + z_; bl_.x = x_; } xcd_barrier(bl_); } while (0)
#define PH_BEGIN(k) if (IN(k)) { for (int rep_ = 0; rep_ < NREP(k); ++rep_) { if (rep_) SEAMX(); PB();
#define PH_END(k) } } SEAM(k);
#define SEAM(k) do { if (IN(k) && IN((k) + 1)) { XcdBarrier bl_ = bar; { int z_ = 0; unsigned x_ = bar.x; asm volatile("" : "+s"(z_), "+s"(x_)); bl_.bar = (unsigned*)(args.ws + WS_CTL) + CW_BAR + z_; bl_.x = x_; } xcd_barrier(bl_); } } while (0)
    char* ldsg = (char*)lds;

    PH_BEGIN(PH_PRO) p0_prologue(F, args); PH_END(PH_PRO)

#pragma unroll 1
    for (int l = 0; l < 2; ++l) {
        const int pb = 1 + 12 * l;
        const float* modl = (const float*)(F.ws + WS_MOD) + l * 5 * 6144;
        PH_BEGIN(pb + PH_N1) norm_mod_phase(F, args, l, 0, false, false); PH_END(pb + PH_N1)
        PH_BEGIN(pb + PH_PROJ)
            pg8::Gemm g{(const bf16*)(F.ws + WS_U), (const bf16*)(F.ws + WS_WIN) + (size_t)l * NPROJ * 1024, 1024, 1024, 1024};
            TileOrder S; S.init(MROWS / 256, NPROJ / 256, F.G, (int)blockIdx.x, 0);
            EpiProj E{(bf16*)(F.ws + WS_PROJ), (float*)(F.ws + WS_GB), (const float*)(F.ws + WS_ROPE), args.in[F.zz + 12] + l * 8, args.in[F.zz + 13] + l * 8};
            pg8::gemm_phase<EpiProj, TileOrder, true, true>(F.lds, g, S, E);
        PH_END(pb + PH_PROJ)
        PH_BEGIN(pb + PH_ATT)
            const bf16* P = (const bf16*)(F.ws + WS_PROJ); bf16* AO = (bf16*)(F.ws + WS_ATTO);
            const int nunits = 512 + (l == 0 ? 32 : 0);
#ifndef DIS_ATTN
#ifdef DBG_DUP
            for (int r2_ = 0; r2_ < (DBG_DUP == 31 ? 2 : 1); ++r2_)
#endif
#pragma unroll 1
            for (int u = F.vcu; u < nunits; u += F.G) {
                int b, hm, qrow, seq;
                if (u < 512) { b = u >> 7; hm = (u >> 4) & 7; qrow = CTXL + (u & 15) * 256; seq = RPB; }
                else { const int v = u - 512; b = v >> 3; hm = v & 7; qrow = 0; seq = CTXL; }
                const size_t r0 = (size_t)b * RPB;
                attn::attn_unit<PLD, DM>(P + (r0 + qrow) * PLD + PC_AQ + hm * 64, P + r0 * PLD + PC_AK + hm * 64, P + r0 * PLD + PC_AV + (hm >> 1) * 128,
                                           AO + (r0 + qrow) * DM + hm * 128, seq, ldsg);
            }
#endif
#ifndef DIS_DNPRE
#ifdef DBG_DUP
            for (int r2_ = 0; r2_ < (DBG_DUP == 32 ? 2 : 1); ++r2_)
#endif
#pragma unroll 1
            for (int u = F.vcu; u < NB * NCHUNK * 4; u += F.G) { const int h = u & 3, n = (u >> 2) % NCHUNK, b = (u >> 2) / NCHUNK; dn_pre_unit(F, args, l, b, n, h); }
#endif
        PH_END(pb + PH_ATT)
        PH_BEGIN(pb + PH_SCAN)
#pragma unroll 1
            for (int it = F.vcu; it < 32; it += F.G) dn_scan_item(F, it);
            { const bool many = F.G > 32; const int rk = many ? F.vcu - 32 : F.vcu, nr = many ? F.G - 32 : F.G;
              if (rk >= 0) {
#pragma unroll 1
                for (int u = rk; u < (MROWS / 64) * 4; u += nr) pool_unit(F, args, l, u >> 2, u & 3);
                if (l == 0) conv_layer_weights(F, args, 1, rk * NWAVES + F.wave, nr * NWAVES);
                else moe_convert(F, args, rk * NWAVES + F.wave, nr * NWAVES); } }
        PH_END(pb + PH_SCAN)
        PH_BEGIN(pb + PH_MIXB) mix_build(F, args, l); PH_END(pb + PH_MIXB)
#pragma unroll 1
        for (int s = 0; s < 3; ++s) {
            if (IN(pb + PH_MRG0 + s)) { PB();
                const int koff = s == 0 ? 0 : (s == 1 ? 512 : 768), ks = s == 0 ? 512 : 256;
                pg8::Gemm g{s == 2 ? (const bf16*)(F.ws + WS_POOLO) : (const bf16*)(F.ws + WS_MIX) + koff, (const bf16*)(F.ws + WS_WBR) + (size_t)l * 1024 * 1024 + (size_t)1024 * koff, ks, s == 2 ? 256 : 1024, ks};
                TileOrder S; S.init(l == 0 ? 68 : 64, 4, F.G, (int)blockIdx.x, l);
                EpiMerge E{(bf16*)(F.ws + WS_MG), (const bf16*)(F.ws + WS_PROJ), PC_GATE + s * 1024, s == 0};
                pg8::gemm_phase<EpiMerge, TileOrder, true, true>(F.lds, g, S, E);
            }
            if (s < 2) { if (IN(pb + PH_MRG0 + s)) { PB(); VM_WAIT(); __syncthreads(); } } else SEAM(pb + PH_MRG2);
        }
        if (IN(pb + PH_OUT)) { PB();
            pg8::Gemm g{(const bf16*)(F.ws + WS_MG), (const bf16*)(F.ws + WS_WOUT) + (size_t)l * 1024 * 1024, 1024, 1024, 1024};
            TileOrder S; S.init(l == 0 ? 68 : 64, 4, F.G, (int)blockIdx.x, l);
            EpiResid E{(float*)(F.ws + WS_H), modl, 2};
            pg8::gemm_phase<EpiResid, TileOrder, true, true>(F.lds, g, S, E);
        } SEAM(pb + PH_OUT);
#ifdef DENSE_F8
        PH_BEGIN(pb + PH_N2) norm_mod_phase(F, args, l, 1, l == 1, l == 1, l == 0); PH_END(pb + PH_N2)
#else
        PH_BEGIN(pb + PH_N2) norm_mod_phase(F, args, l, 1, l == 1, l == 1); PH_END(pb + PH_N2)
#endif
        if (l == 0) {
#ifdef DENSE_F8
            PH_BEGIN(PH_FUP)
                pg8::Gemm g{(const bf16*)(F.ws + WS_U), (const bf16*)(F.ws + WS_W13), 512, 512, 512, E8(F8_ACT_L2), E8(F8_W13_L2)};
                TileOrder S; S.init(68, 2 * FFD / 256, F.G, (int)blockIdx.x, 0);
                EpiSwiglu8 E{F.ws + WS_HID, FFD};
                pg8::gemm_phase8<EpiSwiglu8, TileOrder, true, true>(F.lds, g, S, E);
            PH_END(PH_FUP)
            if (IN(PH_FDN)) { PB();
                pg8::Gemm g{(const bf16*)(F.ws + WS_HID), (const bf16*)(F.ws + WS_W2), FFD / 2, FFD / 2, FFD / 2, E8(F8_ACT_L2), E8(F8_W2_L2)};
                TileOrder S; S.init(68, 4, F.G, (int)blockIdx.x, 0);
                EpiResid E{(float*)(F.ws + WS_H), modl, 5};
                pg8::gemm_phase8<EpiResid, TileOrder, true, true>(F.lds, g, S, E);
            } SEAM(PH_FDN);
#else
            PH_BEGIN(PH_FUP)
                pg8::Gemm g{(const bf16*)(F.ws + WS_U), (const bf16*)(F.ws + WS_W13), 1024, 1024, 1024};
                TileOrder S; S.init(68, 2 * FFD / 256, F.G, (int)blockIdx.x, 0);
                EpiSwiglu E{(bf16*)(F.ws + WS_HID), FFD};
                pg8::gemm_phase<EpiSwiglu, TileOrder, true, true>(F.lds, g, S, E);
            PH_END(PH_FUP)
            if (IN(PH_FDN)) { PB();
                pg8::Gemm g{(const bf16*)(F.ws + WS_HID), (const bf16*)(F.ws + WS_W2), FFD, FFD, FFD};
                TileOrder S; S.init(68, 4, F.G, (int)blockIdx.x, 0);
                EpiResid E{(float*)(F.ws + WS_H), modl, 5};
                pg8::gemm_phase<EpiResid, TileOrder, true, true>(F.lds, g, S, E);
            } SEAM(PH_FDN);
#endif
        }
    }
    PH_BEGIN(PH_GATH) moe_gather(F); PH_END(PH_GATH)
#pragma unroll 1
    for (int hh = 0; hh < 1; ++hh) {
        const int p0 = PH_CV0 + 3 * hh;
        PH_BEGIN(p0 + 1)
            pg8::Gemm g{(const bf16*)(F.ws + WS_XG), (const bf16*)(F.ws + WS_W13M), 512, 512, 512, E8(F8_ACT_L2), E8(F8_W13_L2)};
            MoeOrder S; S.init(F.ctl + CW_ECNT, 2 * FFE / 256, F.G, F.vcu);
            EpiSwiglu8 E{F.ws + WS_HIDM, FFE};
            pg8::gemm_phase8<EpiSwiglu8, MoeOrder, true, true>(F.lds, g, S, E);
        PH_END(p0 + 1)
        if (IN(p0 + 2)) { PB();
            pg8::Gemm g{(const bf16*)(F.ws + WS_HIDM), (const bf16*)(F.ws + WS_W2M), FFE / 2, FFE / 2, FFE / 2, E8(F8_ACT_L2), E8(F8_W2_L2)};
            MoeOrder S; S.init(F.ctl + CW_ECNT, 4, F.G, F.vcu);
            EpiY E{(bf16*)(F.ws + WS_Y), 1};
            pg8::gemm_phase8<EpiY, MoeOrder, true, true>(F.lds, g, S, E);
        } SEAM(p0 + 2);
    }
    PH_BEGIN(PH_FIN) final_phase(F, args); } }
#ifdef DBG_STOP
    if (lo == 100) {
        const int gw = F.vcu * NWAVES + F.wave, NGW = F.G * NWAVES;
        for (int tk = gw; tk < NB * SEQ; tk += NGW) { const int b = tk / SEQ, t = tk - b * SEQ; const size_t R = (size_t)b * RPB + CTXL + t;
#if DBG_SRC == 0
            const f32x4* s = (const f32x4*)((const float*)(args.ws + WS_H) + R * DM) + F.lane; f32x4* d = (f32x4*)(args.out + (size_t)tk * DM) + F.lane;
            for (int q = 0; q < 4; ++q) d[64 * q] = s[64 * q];
#elif DBG_SRC == 2
            MoeOrder mo; mo.init((gu32*)args.ws + CW_ECNT, 1, 1, 0); const v4u rt = ((const v4u*)(args.ws + WS_ROUTE))[2 * tk];
            const size_t rr = (size_t)mo.tile_off((int)rt.x) * 256 + rt.z; (void)R;
            const bf16* s = (const bf16*)(args.ws + DBG_OFF) + rr * DBG_LD + DBG_COL; float* d = args.out + (size_t)tk * DM;
            for (int q = 0; q < 16; ++q) d[F.lane + 64 * q] = bf2f(s[F.lane + 64 * q]);
#else
#ifdef DBG_MOD
            const bf16* s = (const bf16*)(args.ws + DBG_OFF) + (R % DBG_MOD) * DBG_LD + DBG_COL; float* d = args.out + (size_t)tk * DM;
#else
            const bf16* s = (const bf16*)(args.ws + DBG_OFF) + R * DBG_LD + DBG_COL; float* d = args.out + (size_t)tk * DM;
#endif
            for (int q = 0; q < 16; ++q) { float v = bf2f(s[F.lane + 64 * q]); d[F.lane + 64 * q] = (v == v && fabsf(v) < 1e30f) ? v : DBG_NANVAL; }
#endif
        }
    }
#endif
#undef IN
#undef SEAM
}

extern "C" void kernel_launch(void* const* d_in, const int* in_sizes, int n_in, void* d_out, int out_size, void* d_ws, size_t ws_size, hipStream_t stream) {
    static int grid = 0;
    if (grid == 0) {
        if (n_in != 27 || in_sizes[0] != NB * SEQ * DM || out_size != NB * SEQ * DM || ws_size < WS_END) {
            fprintf(stderr, "kernel_launch: shape / workspace mismatch (n_in %d, in0 %d, out %d, ws %zu, need %zu); nothing launched\n", n_in, n_in > 0 ? in_sizes[0] : -1, out_size, ws_size, (size_t)WS_END); grid = -1; return; }
        int dev = 0, cus = 0, per_cu = 0;
        if (hipGetDevice(&dev) != hipSuccess || hipDeviceGetAttribute(&cus, hipDeviceAttributeMultiprocessorCount, dev) != hipSuccess) { grid = -1; return; }
        if (hipFuncSetAttribute((const void*)mk_fwd, hipFuncAttributeMaxDynamicSharedMemorySize, LDS_BYTES) != hipSuccess) { fprintf(stderr, "kernel_launch: hipFuncSetAttribute failed\n"); grid = -1; return; }
        if (hipOccupancyMaxActiveBlocksPerMultiprocessor(&per_cu, (const void*)mk_fwd, NTHR, LDS_BYTES) != hipSuccess || per_cu < 1)
            fprintf(stderr, "kernel_launch: note: occupancy query reports %d workgroups per CU\n", per_cu);
        (void)hipGetLastError();
        grid = cus;
    }
    if (grid < 0) return;
    if (hipMemsetAsync((char*)d_ws + WS_CTL, 0, CTL_ZERO_BYTES, stream) != hipSuccess) return;
    Args a{};
    for (int i = 0; i < 27; ++i) a.in[i] = (const float*)d_in[i];
    a.out = (float*)d_out; a.ws = (unsigned char*)d_ws;
    constexpr int NL = MK_N_LAUNCHES;
#ifdef DBG_STOP
    constexpr int NLL = DBG_STOP + 2;
#else
    constexpr int NLL = NL;
#endif
    for (int li = 0; li < NLL; ++li) {
#ifdef DBG_SKIP_LO
        if (li >= DBG_SKIP_LO && li <= DBG_SKIP_HI) continue;
#endif
        a.ph_lo = (NL == 1) ? 0 : li; a.ph_hi = (NL == 1) ? PH_COUNT : li + 1;
#ifdef DBG_STOP
        a.ph_lo = li; a.ph_hi = li + 1;
        if (li == NLL - 1) { a.ph_lo = 100; a.ph_hi = 101; }
#endif
        hipLaunchKernelGGL(mk_fwd, dim3(grid), dim3(NTHR), LDS_BYTES, stream, a);
        const hipError_t le = hipPeekAtLastError();
        if (le != hipSuccess) { fprintf(stderr, "kernel_launch: launch %d failed: %s\n", li, hipGetErrorName(le)); break; }
    }
}
```

```cpp
#include <hip/hip_runtime.h>
#include <cstdio>
#include <cstdint>
#include <cmath>

namespace pg8 {
#define PG8_LAS __attribute__((address_space(3)))
typedef unsigned short bf16_t;
typedef short bf16x8 __attribute__((ext_vector_type(8)));
typedef float f32x4 __attribute__((ext_vector_type(4)));
typedef unsigned u32x4 __attribute__((ext_vector_type(4)));
typedef unsigned u32x2 __attribute__((ext_vector_type(2)));
constexpr int BM = 256, BK = 64, HALF = 128, HTB = HALF * BK * 2  , STAGE_BYTES = 8 * HTB;

__host__ __device__ __forceinline__ int lds_byte(int r, int c) { const int st = (r >> 4) * 2 + (c >> 5), rr = r & 15, cc = c & 31, ob = rr * 64 + cc * 2; return st * 1024 + (ob ^ (((ob >> 9) & 1) << 5)); }
__host__ __device__ __forceinline__ void stage_rc(int b, int& R, int& C) { const int st = b / 1024, sb = b % 1024, swz = sb ^ (((sb >> 9) & 1) << 5); R = (st >> 1) * 16 + swz / 64; C = (st & 1) * 32 + (swz % 64) / 2; }
__host__ __device__ __forceinline__ int perm32(int rho) { const int n = rho >> 4, i = rho & 15; return 8 * (i >> 2) + 4 * n + (i & 3); }

struct Unit { int pm, pn, pb; };
struct Gemm { const bf16_t* A; const bf16_t* Bt; int K, lda, ldb, sA, sB; };

__device__ __forceinline__ unsigned cvt_pk_bf16(float lo, float hi) { unsigned r; asm volatile("v_cvt_pk_bf16_f32 %0, %1, %2" : "=v"(r) : "v"(lo), "v"(hi)); return r; }
template <class Epi, class Sched, bool ALIGN_EPI = false, bool SP2 = false>
__device__ __forceinline__ void gemm_phase(PG8_LAS unsigned char* lds, const Gemm g, const Sched& S, const Epi& E) {
    int tid = threadIdx.x; asm volatile("" : "+v"(tid)); const int wid = __builtin_amdgcn_readfirstlane(tid >> 6), lane = tid & 63, wr = wid >> 2, wc = wid & 3, fr = lane & 15, fq = lane >> 4;
    const int K = g.K, nt = K / BK;
    unsigned voffA[2], voffB[2];
#pragma unroll
    for (int i = 0; i < 2; ++i) { int R, C; stage_rc(tid * 16 + i * 8192, R, C); const int Rb = Epi::PERM ? ((R & ~31) + perm32(R & 31)) : R;
        voffA[i] = (unsigned)(R * g.lda + C) * 2u; voffB[i] = (unsigned)(Rb * g.ldb + C) * 2u; }
    const size_t kstep = (size_t)(BK * 2);
    const size_t hstepA = (size_t)HALF * g.lda * 2, hstepB = (size_t)HALF * g.ldb * 2;
    const size_t tstepA = 2 * hstepA, tstepB = 2 * hstepB;
    const unsigned ldsw = (unsigned)wid * 1024u;
    const int aoff = lds_byte(wr * 64 + fr, fq * 8), boff = lds_byte(wc * 32 + fr, fq * 8);
#define PG8_SA(b, h) (((b) * 2 + (h)) * HTB)
#define PG8_SB(b, h) ((4 + (b) * 2 + (h)) * HTB)
#define PG8_STAGE(bufoff, gbase, voff) do { _Pragma("unroll") for (int _i = 0; _i < 2; ++_i) \
        __builtin_amdgcn_global_load_lds((const unsigned*)((const char*)(gbase) + (voff)[_i]), (PG8_LAS unsigned*)(lds + (bufoff) + ldsw + _i * 8192), 16, 0, 0); } while (0)
#define PG8_LDA(dst, b, h) do { _Pragma("unroll") for (int m = 0; m < 4; ++m) _Pragma("unroll") for (int k = 0; k < 2; ++k) dst[m][k] = *(const PG8_LAS bf16x8*)(lds + PG8_SA(b, h) + aoff + m * 2048 + k * 1024); } while (0)
#define PG8_LDB(dst, b, h) do { _Pragma("unroll") for (int n = 0; n < 2; ++n) _Pragma("unroll") for (int k = 0; k < 2; ++k) dst[n][k] = *(const PG8_LAS bf16x8*)(lds + PG8_SB(b, h) + boff + n * 2048 + k * 1024); } while (0)
#define PG8_MMA(ai, bj, At, Bt) do { __builtin_amdgcn_s_setprio(1); _Pragma("unroll") for (int m = 0; m < 4; ++m) _Pragma("unroll") for (int n = 0; n < 2; ++n) _Pragma("unroll") for (int k = 0; k < 2; ++k) \
        acc[ai][bj][m][n] = __builtin_amdgcn_mfma_f32_16x16x32_bf16(Bt[n][k], At[m][k], acc[ai][bj][m][n], 0, 0, 0); __builtin_amdgcn_s_setprio(0); } while (0)
#define PG8_WAIT_V(n) asm volatile("s_waitcnt vmcnt(" #n ")" ::: "memory")
#define PG8_WAIT_L(n) asm volatile("s_waitcnt lgkmcnt(" #n ")" ::: "memory")
#define PG8_BAR __builtin_amdgcn_s_barrier()
#define PG8_SCHED __builtin_amdgcn_sched_barrier(0)
    Unit cur, nxt; int ui = 0;
    if (!S.next(0, cur)) return;
    f32x4 acc[2][2][4][2];
#pragma unroll
    for (int a = 0; a < 2; ++a)
#pragma unroll
        for (int b = 0; b < 2; ++b)
#pragma unroll
            for (int m = 0; m < 4; ++m)
#pragma unroll
                for (int n = 0; n < 2; ++n) acc[a][b][m][n] = (f32x4){0.f, 0.f, 0.f, 0.f};
    bf16x8 At[4][2], B0[2][2], B1[2][2];
    const char* cA = (const char*)g.A + (size_t)cur.pm * tstepA; const char* cB = (const char*)g.Bt + (size_t)cur.pb * tstepB;
    S.a_ready(cur);
    if constexpr (SP2) {
        PG8_STAGE(PG8_SB(0, 0), cB, voffB); PG8_STAGE(PG8_SB(0, 1), cB + hstepB, voffB); PG8_STAGE(PG8_SA(0, 0), cA, voffA); PG8_STAGE(PG8_SA(0, 1), cA + hstepA, voffA);
        if (wr == 1) PG8_BAR;
        PG8_WAIT_V(2); PG8_BAR;
        PG8_STAGE(PG8_SB(1, 0), cB + kstep, voffB); PG8_STAGE(PG8_SA(1, 0), cA + kstep, voffA); PG8_STAGE(PG8_SB(1, 1), cB + hstepB + kstep, voffB);
        PG8_WAIT_V(6); PG8_BAR;
    } else {
        PG8_STAGE(PG8_SB(0, 0), cB, voffB); PG8_STAGE(PG8_SA(0, 0), cA, voffA); PG8_STAGE(PG8_SB(0, 1), cB + hstepB, voffB); PG8_STAGE(PG8_SA(0, 1), cA + hstepA, voffA);
        if (wr == 1) PG8_BAR;
        PG8_WAIT_V(4); PG8_BAR;
        PG8_STAGE(PG8_SB(1, 0), cB + kstep, voffB); PG8_STAGE(PG8_SA(1, 0), cA + kstep, voffA); PG8_STAGE(PG8_SB(1, 1), cB + hstepB + kstep, voffB);
        PG8_WAIT_V(6); PG8_BAR;
    }
    for (;;) {
        const bool has_next = S.next(ui + 1, nxt);
        const char* nA = has_next ? (const char*)g.A + (size_t)nxt.pm * tstepA : cA; const char* nB = has_next ? (const char*)g.Bt + (size_t)nxt.pb * tstepB : cB;
        for (int t = 0; t < nt; t += 2) {
            const bool last = (t == nt - 2);
            const char* a1 = cA + (size_t)(t + 1) * kstep;
            const char* a2 = last ? nA : cA + (size_t)(t + 2) * kstep; const char* b2 = last ? nB : cB + (size_t)(t + 2) * kstep;
            const char* a3 = a2 + kstep; const char* b3 = b2 + kstep;
            if (last && has_next) S.a_ready(nxt);
            if constexpr (SP2) {
            PG8_LDB(B0, 0, 0); PG8_LDB(B1, 0, 1); PG8_SCHED; PG8_LDA(At, 0, 0); PG8_STAGE(PG8_SA(1, 1), a1 + hstepA, voffA);
            PG8_WAIT_V(8); PG8_WAIT_L(0); PG8_BAR; PG8_MMA(0, 0, At, B0); PG8_MMA(0, 1, At, B1); PG8_BAR; PG8_SCHED;
            PG8_LDA(At, 0, 1); PG8_STAGE(PG8_SB(0, 0), b2, voffB); PG8_STAGE(PG8_SB(0, 1), b2 + hstepB, voffB); PG8_STAGE(PG8_SA(0, 0), a2, voffA);
            PG8_WAIT_V(8); PG8_WAIT_L(0); PG8_BAR; PG8_MMA(1, 0, At, B0); PG8_MMA(1, 1, At, B1); PG8_BAR; PG8_SCHED;
            PG8_LDB(B0, 1, 0); PG8_LDB(B1, 1, 1); PG8_SCHED; PG8_LDA(At, 1, 0); PG8_STAGE(PG8_SA(0, 1), a2 + hstepA, voffA);
            PG8_WAIT_V(8); PG8_WAIT_L(0); PG8_BAR; PG8_MMA(0, 0, At, B0); PG8_MMA(0, 1, At, B1); PG8_BAR; PG8_SCHED;
            PG8_LDA(At, 1, 1); PG8_STAGE(PG8_SB(1, 0), b3, voffB); PG8_STAGE(PG8_SB(1, 1), b3 + hstepB, voffB); PG8_STAGE(PG8_SA(1, 0), a3, voffA);
            PG8_WAIT_V(8); PG8_WAIT_L(0); PG8_BAR; PG8_MMA(1, 0, At, B0); PG8_MMA(1, 1, At, B1); PG8_BAR; PG8_SCHED;
            } else {
            PG8_LDB(B0, 0, 0); PG8_SCHED; PG8_LDA(At, 0, 0); PG8_STAGE(PG8_SA(1, 1), a1 + hstepA, voffA);
            PG8_WAIT_L(8); PG8_BAR; PG8_WAIT_L(0); PG8_MMA(0, 0, At, B0); PG8_BAR; PG8_SCHED;
            PG8_LDB(B1, 0, 1); PG8_STAGE(PG8_SB(0, 0), b2, voffB);
            PG8_BAR; PG8_WAIT_L(0); PG8_MMA(0, 1, At, B1); PG8_BAR;
            PG8_LDA(At, 0, 1); PG8_STAGE(PG8_SA(0, 0), a2, voffA);
            PG8_BAR; PG8_WAIT_L(0); PG8_MMA(1, 0, At, B0); PG8_BAR; PG8_SCHED;
            PG8_STAGE(PG8_SB(0, 1), b2 + hstepB, voffB);
            PG8_WAIT_V(6); PG8_BAR; PG8_MMA(1, 1, At, B1); PG8_BAR;
            PG8_LDB(B0, 1, 0); PG8_SCHED; PG8_LDA(At, 1, 0); PG8_STAGE(PG8_SA(0, 1), a2 + hstepA, voffA);
            PG8_WAIT_L(8); PG8_BAR; PG8_WAIT_L(0); PG8_MMA(0, 0, At, B0); PG8_BAR; PG8_SCHED;
            PG8_LDB(B1, 1, 1); PG8_STAGE(PG8_SB(1, 0), b3, voffB);
            PG8_BAR; PG8_WAIT_L(0); PG8_MMA(0, 1, At, B1); PG8_BAR;
            PG8_LDA(At, 1, 1); PG8_STAGE(PG8_SA(1, 0), a3, voffA);
            PG8_BAR; PG8_WAIT_L(0); PG8_MMA(1, 0, At, B0); PG8_BAR; PG8_SCHED;
            PG8_STAGE(PG8_SB(1, 1), b3 + hstepB, voffB);
            PG8_WAIT_V(6); PG8_BAR; PG8_MMA(1, 1, At, B1); PG8_BAR;
            }
        }
        if constexpr (ALIGN_EPI) { if (wr == 0) PG8_BAR; }
        if constexpr (!Epi::AFTER_DRAIN) { E(acc, cur, wr, wc, fr, fq); S.done(cur); }
        if (!has_next) break;
#pragma unroll
        for (int a = 0; a < 2; ++a)
#pragma unroll
            for (int b = 0; b < 2; ++b)
#pragma unroll
                for (int m = 0; m < 4; ++m)
#pragma unroll
                    for (int n = 0; n < 2; ++n) acc[a][b][m][n] = (f32x4){0.f, 0.f, 0.f, 0.f};
        cur = nxt; cA = nA; cB = nB; ++ui;
        if constexpr (ALIGN_EPI) { if (wr == 1) PG8_BAR; }
    }
    PG8_WAIT_V(0);
    if constexpr (!ALIGN_EPI) { if (wr == 0) PG8_BAR; }
    PG8_BAR;
    if constexpr (Epi::AFTER_DRAIN) { E.fused(acc, cur, wr, wc, fr, fq, lds, wid, lane); S.done(cur); }
#undef PG8_SA
#undef PG8_SB
#undef PG8_STAGE
#undef PG8_LDA
#undef PG8_LDB
#undef PG8_MMA
#undef PG8_WAIT_V
#undef PG8_WAIT_L
#undef PG8_BAR
#undef PG8_SCHED
}
template <class Epi, class Sched, bool ALIGN_EPI = false, bool SP2 = false>
__device__ __forceinline__ void gemm_phase8(PG8_LAS unsigned char* lds, const Gemm g, const Sched& S, const Epi& E) {
    int tid = threadIdx.x; asm volatile("" : "+v"(tid)); const int wid = __builtin_amdgcn_readfirstlane(tid >> 6), lane = tid & 63, wr = wid >> 2, wc = wid & 3, fr = lane & 15, fq = lane >> 4;
    const int K = g.K, nt = K / BK;
    unsigned voffA[2], voffB[2];
#pragma unroll
    for (int i = 0; i < 2; ++i) { int R, C; stage_rc(tid * 16 + i * 8192, R, C); const int Rb = Epi::PERM ? ((R & ~31) + perm32(R & 31)) : R;
        voffA[i] = (unsigned)(R * g.lda + C) * 2u; voffB[i] = (unsigned)(Rb * g.ldb + C) * 2u; }
    const size_t kstep = (size_t)(BK * 2);
    const size_t hstepA = (size_t)HALF * g.lda * 2, hstepB = (size_t)HALF * g.ldb * 2;
    const size_t tstepA = 2 * hstepA, tstepB = 2 * hstepB;
    const unsigned ldsw = (unsigned)wid * 1024u;
    const int c8 = (fq >> 1) * 32 + (fq & 1) * 16;
    const int aoff0 = lds_byte(wr * 64 + fr, c8), aoff1 = lds_byte(wr * 64 + fr, c8 + 8), boff0 = lds_byte(wc * 32 + fr, c8), boff1 = lds_byte(wc * 32 + fr, c8 + 8);
#define PG8_SA(b, h) (((b) * 2 + (h)) * HTB)
#define PG8_SB(b, h) ((4 + (b) * 2 + (h)) * HTB)
#define PG8_STAGE(bufoff, gbase, voff) do { _Pragma("unroll") for (int _i = 0; _i < 2; ++_i) \
        __builtin_amdgcn_global_load_lds((const unsigned*)((const char*)(gbase) + (voff)[_i]), (PG8_LAS unsigned*)(lds + (bufoff) + ldsw + _i * 8192), 16, 0, 0); } while (0)
#define PG8_LDA(dst, b, h) do { _Pragma("unroll") for (int m = 0; m < 4; ++m) { const u32x4 lo_ = *(const PG8_LAS u32x4*)(lds + PG8_SA(b, h) + aoff0 + m * 2048), hi_ = *(const PG8_LAS u32x4*)(lds + PG8_SA(b, h) + aoff1 + m * 2048); \
        dst[m] = (i32x8){(int)lo_.x, (int)lo_.y, (int)lo_.z, (int)lo_.w, (int)hi_.x, (int)hi_.y, (int)hi_.z, (int)hi_.w}; } } while (0)
#define PG8_LDB(dst, b, h) do { _Pragma("unroll") for (int n = 0; n < 2; ++n) { const u32x4 lo_ = *(const PG8_LAS u32x4*)(lds + PG8_SB(b, h) + boff0 + n * 2048), hi_ = *(const PG8_LAS u32x4*)(lds + PG8_SB(b, h) + boff1 + n * 2048); \
        dst[n] = (i32x8){(int)lo_.x, (int)lo_.y, (int)lo_.z, (int)lo_.w, (int)hi_.x, (int)hi_.y, (int)hi_.z, (int)hi_.w}; } } while (0)
#define PG8_MMA(ai, bj, At, Bt) do { __builtin_amdgcn_s_setprio(1); _Pragma("unroll") for (int m = 0; m < 4; ++m) _Pragma("unroll") for (int n = 0; n < 2; ++n) \
        asm volatile("v_mfma_scale_f32_16x16x128_f8f6f4 %0, %1, %2, %0, %3, %4 op_sel_hi:[0,0,0]" : "+v"(acc[ai][bj][m][n]) : "v"(Bt[n]), "v"(At[m]), "v"(vsB), "v"(vsA)); __builtin_amdgcn_s_setprio(0); } while (0)
#define PG8_WAIT_V(n) asm volatile("s_waitcnt vmcnt(" #n ")" ::: "memory")
#define PG8_WAIT_L(n) asm volatile("s_waitcnt lgkmcnt(" #n ")" ::: "memory")
#define PG8_BAR __builtin_amdgcn_s_barrier()
#define PG8_SCHED __builtin_amdgcn_sched_barrier(0)
    Unit cur, nxt; int ui = 0;
    if (!S.next(0, cur)) return;
    f32x4 acc[2][2][4][2];
#pragma unroll
    for (int a = 0; a < 2; ++a)
#pragma unroll
        for (int b = 0; b < 2; ++b)
#pragma unroll
            for (int m = 0; m < 4; ++m)
#pragma unroll
                for (int n = 0; n < 2; ++n) acc[a][b][m][n] = (f32x4){0.f, 0.f, 0.f, 0.f};
    typedef int i32x8 __attribute__((ext_vector_type(8)));
    i32x8 At[4], B0[2], B1[2];
    int vsA = g.sA, vsB = g.sB; asm volatile("" : "+v"(vsA), "+v"(vsB));
    const char* cA = (const char*)g.A + (size_t)cur.pm * tstepA; const char* cB = (const char*)g.Bt + (size_t)cur.pb * tstepB;
    S.a_ready(cur);
    if constexpr (SP2) {
        PG8_STAGE(PG8_SB(0, 0), cB, voffB); PG8_STAGE(PG8_SB(0, 1), cB + hstepB, voffB); PG8_STAGE(PG8_SA(0, 0), cA, voffA); PG8_STAGE(PG8_SA(0, 1), cA + hstepA, voffA);
        if (wr == 1) PG8_BAR;
        PG8_WAIT_V(2); PG8_BAR;
        PG8_STAGE(PG8_SB(1, 0), cB + kstep, voffB); PG8_STAGE(PG8_SA(1, 0), cA + kstep, voffA); PG8_STAGE(PG8_SB(1, 1), cB + hstepB + kstep, voffB);
        PG8_WAIT_V(6); PG8_BAR;
    } else {
        PG8_STAGE(PG8_SB(0, 0), cB, voffB); PG8_STAGE(PG8_SA(0, 0), cA, voffA); PG8_STAGE(PG8_SB(0, 1), cB + hstepB, voffB); PG8_STAGE(PG8_SA(0, 1), cA + hstepA, voffA);
        if (wr == 1) PG8_BAR;
        PG8_WAIT_V(4); PG8_BAR;
        PG8_STAGE(PG8_SB(1, 0), cB + kstep, voffB); PG8_STAGE(PG8_SA(1, 0), cA + kstep, voffA); PG8_STAGE(PG8_SB(1, 1), cB + hstepB + kstep, voffB);
        PG8_WAIT_V(6); PG8_BAR;
    }
    for (;;) {
        const bool has_next = S.next(ui + 1, nxt);
        const char* nA = has_next ? (const char*)g.A + (size_t)nxt.pm * tstepA : cA; const char* nB = has_next ? (const char*)g.Bt + (size_t)nxt.pb * tstepB : cB;
        for (int t = 0; t < nt; t += 2) {
            const bool last = (t == nt - 2);
            const char* a1 = cA + (size_t)(t + 1) * kstep;
            const char* a2 = last ? nA : cA + (size_t)(t + 2) * kstep; const char* b2 = last ? nB : cB + (size_t)(t + 2) * kstep;
            const char* a3 = a2 + kstep; const char* b3 = b2 + kstep;
            if (last && has_next) S.a_ready(nxt);
            if constexpr (SP2) {
            PG8_LDB(B0, 0, 0); PG8_LDB(B1, 0, 1); PG8_SCHED; PG8_LDA(At, 0, 0); PG8_STAGE(PG8_SA(1, 1), a1 + hstepA, voffA);
            PG8_WAIT_V(8); PG8_WAIT_L(0); PG8_BAR; PG8_MMA(0, 0, At, B0); PG8_MMA(0, 1, At, B1); PG8_BAR; PG8_SCHED;
            PG8_LDA(At, 0, 1); PG8_STAGE(PG8_SB(0, 0), b2, voffB); PG8_STAGE(PG8_SB(0, 1), b2 + hstepB, voffB); PG8_STAGE(PG8_SA(0, 0), a2, voffA);
            PG8_WAIT_V(8); PG8_WAIT_L(0); PG8_BAR; PG8_MMA(1, 0, At, B0); PG8_MMA(1, 1, At, B1); PG8_BAR; PG8_SCHED;
            PG8_LDB(B0, 1, 0); PG8_LDB(B1, 1, 1); PG8_SCHED; PG8_LDA(At, 1, 0); PG8_STAGE(PG8_SA(0, 1), a2 + hstepA, voffA);
            PG8_WAIT_V(8); PG8_WAIT_L(0); PG8_BAR; PG8_MMA(0, 0, At, B0); PG8_MMA(0, 1, At, B1); PG8_BAR; PG8_SCHED;
            PG8_LDA(At, 1, 1); PG8_STAGE(PG8_SB(1, 0), b3, voffB); PG8_STAGE(PG8_SB(1, 1), b3 + hstepB, voffB); PG8_STAGE(PG8_SA(1, 0), a3, voffA);
            PG8_WAIT_V(8); PG8_WAIT_L(0); PG8_BAR; PG8_MMA(1, 0, At, B0); PG8_MMA(1, 1, At, B1); PG8_BAR; PG8_SCHED;
            } else {
            PG8_LDB(B0, 0, 0); PG8_SCHED; PG8_LDA(At, 0, 0); PG8_STAGE(PG8_SA(1, 1), a1 + hstepA, voffA);
            PG8_WAIT_L(8); PG8_BAR; PG8_WAIT_L(0); PG8_MMA(0, 0, At, B0); PG8_BAR; PG8_SCHED;
            PG8_LDB(B1, 0, 1); PG8_STAGE(PG8_SB(0, 0), b2, voffB);
            PG8_BAR; PG8_WAIT_L(0); PG8_MMA(0, 1, At, B1); PG8_BAR;
            PG8_LDA(At, 0, 1); PG8_STAGE(PG8_SA(0, 0), a2, voffA);
            PG8_BAR; PG8_WAIT_L(0); PG8_MMA(1, 0, At, B0); PG8_BAR; PG8_SCHED;
            PG8_STAGE(PG8_SB(0, 1), b2 + hstepB, voffB);
            PG8_WAIT_V(6); PG8_BAR; PG8_MMA(1, 1, At, B1); PG8_BAR;
            PG8_LDB(B0, 1, 0); PG8_SCHED; PG8_LDA(At, 1, 0); PG8_STAGE(PG8_SA(0, 1), a2 + hstepA, voffA);
            PG8_WAIT_L(8); PG8_BAR; PG8_WAIT_L(0); PG8_MMA(0, 0, At, B0); PG8_BAR; PG8_SCHED;
            PG8_LDB(B1, 1, 1); PG8_STAGE(PG8_SB(1, 0), b3, voffB);
            PG8_BAR; PG8_WAIT_L(0); PG8_MMA(0, 1, At, B1); PG8_BAR;
            PG8_LDA(At, 1, 1); PG8_STAGE(PG8_SA(1, 0), a3, voffA);
            PG8_BAR; PG8_WAIT_L(0); PG8_MMA(1, 0, At, B0); PG8_BAR; PG8_SCHED;
            PG8_STAGE(PG8_SB(1, 1), b3 + hstepB, voffB);
            PG8_WAIT_V(6); PG8_BAR; PG8_MMA(1, 1, At, B1); PG8_BAR;
            }
        }
        if constexpr (ALIGN_EPI) { if (wr == 0) PG8_BAR; }
        asm volatile("s_nop 15\n\ts_nop 15" ::: "memory");
        if constexpr (!Epi::AFTER_DRAIN) { E(acc, cur, wr, wc, fr, fq); S.done(cur); }
        if (!has_next) break;
#pragma unroll
        for (int a = 0; a < 2; ++a)
#pragma unroll
            for (int b = 0; b < 2; ++b)
#pragma unroll
                for (int m = 0; m < 4; ++m)
#pragma unroll
                    for (int n = 0; n < 2; ++n) acc[a][b][m][n] = (f32x4){0.f, 0.f, 0.f, 0.f};
        cur = nxt; cA = nA; cB = nB; ++ui;
        if constexpr (ALIGN_EPI) { if (wr == 1) PG8_BAR; }
    }
    PG8_WAIT_V(0);
    if constexpr (!ALIGN_EPI) { if (wr == 0) PG8_BAR; }
    PG8_BAR;
    if constexpr (Epi::AFTER_DRAIN) { E.fused(acc, cur, wr, wc, fr, fq, lds, wid, lane); S.done(cur); }
#undef PG8_SA
#undef PG8_SB
#undef PG8_STAGE
#undef PG8_LDA
#undef PG8_LDB
#undef PG8_MMA
#undef PG8_WAIT_V
#undef PG8_WAIT_L
#undef PG8_BAR
#undef PG8_SCHED
}
}

namespace attn {
using bf16x8 = __attribute__((ext_vector_type(8))) short;
using s16x4  = __attribute__((ext_vector_type(4))) short;
using f32x16 = __attribute__((ext_vector_type(16))) float;
using u32x4  = __attribute__((ext_vector_type(4))) unsigned;
constexpr int DV = 128, DK = 64, NW = 8, QBLK = 32, KVBLK = 64;
constexpr float SCALE = 0.125f;
constexpr float THR = 4.f;
constexpr size_t SHM_V = KVBLK * DV * 2, SHM_K = KVBLK * DK * 2, SHM_ATTN = 2 * SHM_V + 2 * SHM_K + NW * 64 * 4;
#define AKSWZ(row, colB) ((row) * 128 + ((colB) ^ ((((row) >> 1) & 7) << 4)))
#define ASBAR() __builtin_amdgcn_sched_barrier(0)
__device__ __forceinline__ int crow(int r, int hi) { return (r & 3) + 8 * (r >> 2) + 4 * hi; }
__device__ __forceinline__ unsigned cvtpk(float lo, float hi) { unsigned r; asm volatile("v_cvt_pk_bf16_f32 %0, %1, %2" : "=v"(r) : "v"(lo), "v"(hi)); return r; }

__device__ __forceinline__ void partialSM(f32x16& p0, f32x16& p1, float& m_reg, float& mn, float& alpha) {
  constexpr float C = SCALE * 1.4426950408889634f;
  float pmax = p0[0];
#pragma unroll
  for (int r = 1; r < 16; ++r) pmax = fmaxf(pmax, p0[r]);
#pragma unroll
  for (int r = 0; r < 16; ++r) pmax = fmaxf(pmax, p1[r]);
  { auto rr = __builtin_amdgcn_permlane32_swap(__float_as_uint(pmax), __float_as_uint(pmax), false, false);
    pmax = fmaxf(__uint_as_float(rr[0]), __uint_as_float(rr[1])); }
  if (__builtin_expect(__all(pmax - m_reg <= THR / SCALE), 1)) { mn = m_reg; alpha = 1.f; }
  else { mn = fmaxf(m_reg, pmax); alpha = __builtin_amdgcn_exp2f((m_reg - mn) * C); m_reg = mn; }
  const float mnC = -mn * C;
#pragma unroll
  for (int r = 0; r < 16; ++r) p0[r] = fmaf(p0[r], C, mnC);
#pragma unroll
  for (int r = 0; r < 16; ++r) p1[r] = fmaf(p1[r], C, mnC);
#pragma unroll
  for (int r = 0; r < 16; ++r) p0[r] = __builtin_amdgcn_exp2f(p0[r]);
}
__device__ __forceinline__ void finishSM(f32x16& p0, f32x16& p1, float alpha, float& l_reg, bf16x8& pa0, bf16x8& pa1, bf16x8& pa2, bf16x8& pa3) {
#pragma unroll
  for (int r = 0; r < 16; ++r) p1[r] = __builtin_amdgcn_exp2f(p1[r]);
  float ps = 0;
#pragma unroll
  for (int r = 0; r < 16; ++r) ps += p0[r];
#pragma unroll
  for (int r = 0; r < 16; ++r) ps += p1[r];
  { auto rr = __builtin_amdgcn_permlane32_swap(__float_as_uint(ps), __float_as_uint(ps), false, false);
    ps = __uint_as_float(rr[0]) + __uint_as_float(rr[1]); }
  l_reg = l_reg * alpha + ps;
#define APK4(P, BASE, OUT) do { unsigned a0 = cvtpk(P[BASE + 0], P[BASE + 1]), a1 = cvtpk(P[BASE + 2], P[BASE + 3]);   \
    unsigned b0 = cvtpk(P[BASE + 4], P[BASE + 5]), b1 = cvtpk(P[BASE + 6], P[BASE + 7]);                              \
    auto r0 = __builtin_amdgcn_permlane32_swap(a0, b0, false, false); auto r1 = __builtin_amdgcn_permlane32_swap(a1, b1, false, false); \
    u32x4 w = {r0[0], r1[0], r0[1], r1[1]}; OUT = *reinterpret_cast<bf16x8*>(&w); } while (0)
  APK4(p0, 0, pa0); APK4(p0, 8, pa1); APK4(p1, 0, pa2); APK4(p1, 8, pa3);
#undef APK4
}
__device__ __forceinline__ void qkt(f32x16& p0, f32x16& p1, const char* Ks, const bf16x8* qr, int r32, int hi) {
  p0 = f32x16{}; p1 = f32x16{};
#pragma unroll
  for (int d0 = 0; d0 < 4; ++d0) { const int cb = (d0 * 16 + hi * 8) * 2;
    bf16x8 b0 = *reinterpret_cast<const bf16x8*>(Ks + AKSWZ(r32, cb));
    bf16x8 b1 = *reinterpret_cast<const bf16x8*>(Ks + AKSWZ(32 + r32, cb));
    p0 = __builtin_amdgcn_mfma_f32_32x32x16_bf16(b0, qr[d0], p0, 0, 0, 0);
    p1 = __builtin_amdgcn_mfma_f32_32x32x16_bf16(b1, qr[d0], p1, 0, 0, 0); }
}
__device__ __forceinline__ int v_st(int k, int c) { const int kk = (k & ~0xC) | ((k & 4) << 1) | ((k & 8) >> 1); return ((kk >> 3) * 4 + (c >> 5)) * 512 + ((kk & 7) * 32 + (c & 31)) * 2; }
__device__ __forceinline__ int v_rd_base(int lane) { return ((lane & 3) << 3) | (((lane >> 2) & 3) << 6) | (((lane >> 4) & 1) << 5) | (((lane >> 5) & 1) << 8); }
constexpr int v_rd_off(int d0, int ks, int half) { return d0 * 512 + ks * 4096 + half * 2048; }
template <int OFF> __device__ __forceinline__ s16x4 tr_read(int vb) {
  s16x4 r; asm volatile("ds_read_b64_tr_b16 %0, %1 offset:%2" : "=&v"(r) : "v"(vb), "i"(OFF) : "memory"); return r;
}
template <int D0> __device__ __forceinline__ void pv_one(f32x16& od, int vb, bf16x8 pa0, bf16x8 pa1, bf16x8 pa2, bf16x8 pa3) {
  const s16x4 l0 = tr_read<v_rd_off(D0, 0, 0)>(vb), h0 = tr_read<v_rd_off(D0, 0, 1)>(vb), l1 = tr_read<v_rd_off(D0, 1, 0)>(vb), h1 = tr_read<v_rd_off(D0, 1, 1)>(vb);
  const s16x4 l2 = tr_read<v_rd_off(D0, 2, 0)>(vb), h2 = tr_read<v_rd_off(D0, 2, 1)>(vb), l3 = tr_read<v_rd_off(D0, 3, 0)>(vb), h3 = tr_read<v_rd_off(D0, 3, 1)>(vb);
  asm volatile("s_waitcnt lgkmcnt(0)" ::: "memory"); ASBAR();
#define APK(L, H) (bf16x8){L[0], L[1], L[2], L[3], H[0], H[1], H[2], H[3]}
  od = __builtin_amdgcn_mfma_f32_32x32x16_bf16(pa0, APK(l0, h0), od, 0, 0, 0);
  od = __builtin_amdgcn_mfma_f32_32x32x16_bf16(pa1, APK(l1, h1), od, 0, 0, 0);
  od = __builtin_amdgcn_mfma_f32_32x32x16_bf16(pa2, APK(l2, h2), od, 0, 0, 0);
  od = __builtin_amdgcn_mfma_f32_32x32x16_bf16(pa3, APK(l3, h3), od, 0, 0, 0);
#undef APK
}
__device__ __forceinline__ void pv_d0(f32x16* o, int vb, bf16x8 pa0, bf16x8 pa1, bf16x8 pa2, bf16x8 pa3) {
  pv_one<0>(o[0], vb, pa0, pa1, pa2, pa3); pv_one<1>(o[1], vb, pa0, pa1, pa2, pa3); pv_one<2>(o[2], vb, pa0, pa1, pa2, pa3); pv_one<3>(o[3], vb, pa0, pa1, pa2, pa3);
}
template <int LDQ, int LDO>
__device__ __forceinline__ void attn_unit(const unsigned short* __restrict__ Qb, const unsigned short* __restrict__ Kh, const unsigned short* __restrict__ Vh,
                                          unsigned short* __restrict__ Ob, int seq, char* lds) {
  int tid = threadIdx.x; asm volatile("" : "+v"(tid)); const int wid = tid >> 6, lane = tid & 63, r32 = lane & 31, hi = lane >> 5;
  char* V_lds = lds; char* K_lds = lds + 2 * SHM_V;
  float* ws = (float*)(lds + 2 * SHM_V + 2 * SHM_K) + wid * 64; float* li_l = ws; float* al_l = ws + 32;
  float m_reg = -1e30f, l_reg = 0; f32x16 o[4] = {}; bf16x8 qr[4];
  const unsigned short* Qw = Qb + (long)(wid * QBLK + r32) * LDQ + hi * 8;
#pragma unroll
  for (int d0 = 0; d0 < 4; ++d0) qr[d0] = *reinterpret_cast<const bf16x8*>(Qw + d0 * 16);
  const int sr = tid >> 4, sc = (tid & 15) * 8, vst0 = v_st(sr, sc), vst1 = v_st(32 + sr, sc);
  const int kr = tid >> 3, kc = (tid & 7) * 8, kst = AKSWZ(kr, kc * 2);
  const int vb0 = (int)(uintptr_t)V_lds + v_rd_base(lane);
  bf16x8 sv0[2], sv1[2], sk0[2];
#define ASLOAD(i, k0) do { sv0[i] = *reinterpret_cast<const bf16x8*>(&Vh[(long)((k0) + sr) * LDQ + sc]); sv1[i] = *reinterpret_cast<const bf16x8*>(&Vh[(long)((k0) + 32 + sr) * LDQ + sc]); \
    sk0[i] = *reinterpret_cast<const bf16x8*>(&Kh[(long)((k0) + kr) * LDQ + kc]); } while (0)
#define ASWRITE(b, i) do { *(bf16x8*)(V_lds + (b) * SHM_V + vst0) = sv0[i]; *(bf16x8*)(V_lds + (b) * SHM_V + vst1) = sv1[i]; \
    *(bf16x8*)(K_lds + (b) * SHM_K + kst) = sk0[i]; } while (0)
#define ASWAIT() asm volatile("s_waitcnt vmcnt(3)" ::: "memory")
#define ARESC(a) do { if (__any((a) < 1.f)) { if (hi == 0) al_l[r32] = (a); asm volatile("s_waitcnt lgkmcnt(0)" ::: "memory"); \
    _Pragma("unroll") for (int d = 0; d < 4; ++d) _Pragma("unroll") for (int r = 0; r < 16; ++r) o[d][r] *= al_l[crow(r, hi)]; } } while (0)
  f32x16 pA0, pA1, pB0, pB1; float mnA, mnB, alA, alB; bf16x8 pa0, pa1, pa2, pa3; const int NT = seq / KVBLK;
  ASLOAD(0, 0); asm volatile("s_waitcnt vmcnt(0)" ::: "memory"); ASWRITE(0, 0); __syncthreads();
  qkt(pA0, pA1, K_lds, qr, r32, hi); partialSM(pA0, pA1, m_reg, mnA, alA);
  ASLOAD(1, KVBLK); if (2 < NT) ASLOAD(0, 2 * KVBLK);
  if (2 < NT) ASWAIT(); else asm volatile("s_waitcnt vmcnt(0)" ::: "memory");
  ASWRITE(1, 1); __syncthreads();
  for (int j = 1; j + 1 < NT; j += 2) {
    ASBAR(); qkt(pB0, pB1, K_lds + SHM_K, qr, r32, hi);
    finishSM(pA0, pA1, alA, l_reg, pa0, pa1, pa2, pa3); ASBAR();
    ASLOAD(1, (j + 2) * KVBLK); ASBAR();
    pv_d0(o, vb0, pa0, pa1, pa2, pa3); partialSM(pB0, pB1, m_reg, mnB, alB);
    __syncthreads(); ASWAIT(); ASWRITE(0, 0);
    ARESC(alB); __syncthreads();
    ASBAR(); qkt(pA0, pA1, K_lds, qr, r32, hi);
    finishSM(pB0, pB1, alB, l_reg, pa0, pa1, pa2, pa3); ASBAR();
    if (j + 3 < NT) ASLOAD(0, (j + 3) * KVBLK); ASBAR();
    pv_d0(o, vb0 + (int)SHM_V, pa0, pa1, pa2, pa3); partialSM(pA0, pA1, m_reg, mnA, alA);
    __syncthreads(); if (j + 3 < NT) ASWAIT(); else asm volatile("s_waitcnt vmcnt(0)" ::: "memory");
    ASWRITE(1, 1);
    ARESC(alA); __syncthreads();
  }
  ASBAR(); qkt(pB0, pB1, K_lds + SHM_K, qr, r32, hi);
  finishSM(pA0, pA1, alA, l_reg, pa0, pa1, pa2, pa3); ASBAR();
  pv_d0(o, vb0, pa0, pa1, pa2, pa3); partialSM(pB0, pB1, m_reg, mnB, alB);
  __syncthreads(); ARESC(alB);
  finishSM(pB0, pB1, alB, l_reg, pa0, pa1, pa2, pa3); ASBAR();
  pv_d0(o, vb0 + (int)SHM_V, pa0, pa1, pa2, pa3);
  if (hi == 0) li_l[r32] = l_reg; asm volatile("s_waitcnt lgkmcnt(0)" ::: "memory");
  float rli[16];
#pragma unroll
  for (int r = 0; r < 16; ++r) rli[r] = __builtin_amdgcn_rcpf(li_l[crow(r, hi)]);
  unsigned short* Ow = Ob + (long)(wid * QBLK) * LDO;
#pragma unroll
  for (int r = 0; r < 16; ++r) { const int orow = crow(r, hi);
#pragma unroll
    for (int d0 = 0; d0 < 4; ++d0) { const float v = o[d0][r] * rli[r]; Ow[(long)orow * LDO + d0 * 32 + r32] = (unsigned short)(cvtpk(v, v) & 0xffffu); } }
  __syncthreads();
#undef ASLOAD
#undef ASWRITE
#undef ASWAIT
#undef ARESC
}
}

constexpr int NWAVES = 8, NTHR = NWAVES * 64;
constexpr int DM = 1024, NB = 4, SEQ = 4096, CTXL = 256, RPB = CTXL + SEQ  , MROWS = NB * RPB  ;
constexpr int INW = 5904, NPROJ = 6144, PLD = 5888;
constexpr int FFD = 2816, FFE = 3584, NEXP = 8, FFEH = FFE / 2;
constexpr int NCHUNK = RPB / 64;
constexpr float EPSN = 1e-6f;
constexpr int PC_AQ = 0, PC_AK = 512, PC_AV = 1024, PC_DQ = 1536, PC_DK = 1792, PC_DV = 2048, PC_DZ = 2304, PC_POOL = 2560, PC_GATE = 2816, PC_AB = 5888;

constexpr size_t MiB = 1u << 20;
constexpr size_t WS_CTL = 0, CTL_ZERO_BYTES = 2 * MiB;
constexpr size_t WS_MOD = 1 * MiB;
constexpr size_t WS_ROPE = 2 * MiB;
constexpr size_t WS_LAM = 2 * MiB + 65536;
constexpr size_t WS_ROUTE = 3 * MiB;
constexpr size_t WS_GB = 4 * MiB;
constexpr int NPB = 2816;
constexpr size_t WS_WIN = 8 * MiB;
constexpr size_t WS_WG8 = 20 * MiB;
constexpr size_t WS_WAB = 26 * MiB;
constexpr size_t WS_U8 = 484 * MiB;
constexpr size_t WS_WBR = 32 * MiB;
constexpr size_t WS_WOUT = 36 * MiB;
constexpr size_t WS_W13 = 40 * MiB;
constexpr size_t WS_W2 = 51 * MiB;
constexpr size_t WS_H = 58 * MiB;
constexpr size_t WS_U = 126 * MiB;
constexpr size_t WS_ATTO = WS_U;
constexpr size_t WS_MIX = WS_U;
constexpr size_t WS_PROJ = 160 * MiB;
constexpr size_t WS_POOLO = 356 * MiB;
constexpr size_t WS_W2M = 365 * MiB;
constexpr size_t WS_DNP = 398 * MiB;
constexpr size_t WS_MG = WS_DNP;
constexpr size_t WS_DNG = 466 * MiB;
constexpr size_t WS_DNO = 467 * MiB;
constexpr size_t WS_W13M = 484 * MiB;
constexpr size_t WS_HID = WS_PROJ;
constexpr int MOE_MAXT = 136;
constexpr size_t WS_HIDM = 160 * MiB;
constexpr size_t WS_XG = 279 * MiB;
constexpr size_t WS_Y = 279 * MiB;
constexpr size_t WS_END = 540 * MiB;
static_assert(WS_HIDM + (size_t)MOE_MAXT * 256 * FFE <= WS_XG && WS_Y + (size_t)MOE_MAXT * 256 * 1024 * 2 <= WS_POOLO && WS_DNO + (size_t)2 * MROWS * 256 * 2 <= WS_W13M && WS_W13M + (size_t)8 * 2 * FFE * 1024 <= WS_END, "ws map");
static_assert(WS_WIN + (size_t)2 * NPB * 1024 * 2 <= WS_WG8 && WS_WG8 + (size_t)2 * 3072 * 1024 <= WS_WAB && WS_WAB + 2 * 65536 <= WS_WBR && WS_W13 + (size_t)2 * FFD * 1024 * 2 <= WS_W2 && WS_W2 + (size_t)1024 * FFD * 2 <= WS_H, "ws map (weights)");
static_assert(WS_H + (size_t)MROWS * 1024 * 4 <= WS_U && WS_U + (size_t)MROWS * 1024 * 2 <= WS_PROJ && WS_PROJ + (size_t)MROWS * PLD * 2 <= WS_POOLO && WS_POOLO + (size_t)MROWS * 256 * 2 <= WS_W2M && WS_W2M + (size_t)8 * 1024 * FFE <= WS_DNP, "ws map (acts)");
static_assert(WS_DNP + (size_t)NB * NCHUNK * 4 * 2 * 32768 <= WS_DNG, "ws map (dn)");
constexpr int CW_TMO = 0, CW_CODE = 1;
constexpr int CW_BAR = 4096;
constexpr int CW_ECNT = 16384;

constexpr int RING_BYTES = 155648;
constexpr int MISC_OFF = RING_BYTES;
constexpr int LDS_BYTES = RING_BYTES + 1024;

enum { PH_PRO = 0, PH_L0 = 1, PH_N1 = 0, PH_PROJ = 1, PH_ATT = 2, PH_SCAN = 3, PH_MIXB = 4, PH_MRG0 = 5, PH_MRG1 = 6, PH_MRG2 = 7, PH_OUT = 8, PH_N2 = 9, PH_LAYER = 10,
       PH_FUP = 11, PH_FDN = 12, PH_L1 = 13, PH_GATH = 23, PH_CV0 = 24, PH_UP0 = 25, PH_DN0 = 26, PH_CV1 = 27, PH_UP1 = 28, PH_DN1 = 29, PH_FIN = 30, PH_COUNT = 31 };

#define GAS __attribute__((address_space(1)))
#define LAS __attribute__((address_space(3)))
typedef unsigned short bf16;
typedef unsigned v4u __attribute__((ext_vector_type(4)));
typedef unsigned v2u __attribute__((ext_vector_type(2)));
typedef float f32x4 __attribute__((ext_vector_type(4)));
typedef GAS unsigned gu32;
#define RLX_AGENT __ATOMIC_RELAXED, __HIP_MEMORY_SCOPE_AGENT
#define LDS_WAIT() asm volatile("s_waitcnt lgkmcnt(0)" ::: "memory")
#define VM_WAIT() asm volatile("s_waitcnt vmcnt(0)" ::: "memory")
__device__ __forceinline__ unsigned f2bf(float f) { unsigned u = __builtin_bit_cast(unsigned, f); return (u + 0x7fffu + ((u >> 16) & 1u)) >> 16; }
typedef float f32x2_c __attribute__((ext_vector_type(2))); typedef __bf16 bf16x2_c __attribute__((ext_vector_type(2)));
__device__ __forceinline__ unsigned cvtpk_c(float lo, float hi) { f32x2_c v = {lo, hi}; bf16x2_c b = __builtin_convertvector(v, bf16x2_c); return __builtin_bit_cast(unsigned, b); }
__device__ __forceinline__ unsigned pk2(float lo, float hi) { return cvtpk_c(lo, hi); }
__device__ __forceinline__ unsigned cvt4_fp8(float a, float b, float c, float d) {
    a = fminf(fmaxf(a, -448.f), 448.f); b = fminf(fmaxf(b, -448.f), 448.f); c = fminf(fmaxf(c, -448.f), 448.f); d = fminf(fmaxf(d, -448.f), 448.f);
    int r = 0; r = __builtin_amdgcn_cvt_pk_fp8_f32(a, b, r, false); r = __builtin_amdgcn_cvt_pk_fp8_f32(c, d, r, true); return (unsigned)r; }
constexpr int E8(int log2scale) { return (127 - log2scale) * 0x01010101; }
constexpr int F8_ACT_L2 = 3, F8_W13_L2 = 5, F8_W2_L2 = 6;
__device__ __forceinline__ float bf_lo(unsigned w) { return __builtin_bit_cast(float, w << 16); }
__device__ __forceinline__ float bf_hi(unsigned w) { return __builtin_bit_cast(float, w & 0xffff0000u); }
__device__ __forceinline__ float bf2f(bf16 v) { return __builtin_bit_cast(float, (unsigned)v << 16); }
__device__ __forceinline__ float sigmoidf_(float x) { return 1.f / (1.f + __expf(-x)); }
__device__ __forceinline__ float siluf_(float x) { return x / (1.f + __expf(-x)); }
__device__ __forceinline__ float wave_sum(float v) {
#pragma unroll
    for (int o = 1; o < 64; o <<= 1) v += __shfl_xor(v, o);
    return v;
}
#define XB_TMO      128
#define XB_XCNT(j)  (256  + 64 * (j))
#define XB_XSUB(j)  (1280 + 64 * (j))
#define XB_XGEN(j)  (2304 + 64 * (j))
#define XB_TOP      3328
#define XB_TOPGEN   3392
#define XCD_BAR_WORDS 3456
#define XB_SPIN_CAP (1u << 18)

__device__ __forceinline__ unsigned xb_ld(unsigned* p)              { return __hip_atomic_load(p, __ATOMIC_RELAXED, __HIP_MEMORY_SCOPE_AGENT); }
__device__ __forceinline__ unsigned xb_add(unsigned* p, unsigned v) { return __hip_atomic_fetch_add(p, v, __ATOMIC_RELAXED, __HIP_MEMORY_SCOPE_AGENT); }
__device__ __forceinline__ unsigned xb_xcc_id() { return (unsigned)__builtin_amdgcn_s_getreg((3 << 11) | 20) & 0xFu; }
#define XB_SPIN(cond, bar) do { unsigned _sp = 0; while (cond) { __builtin_amdgcn_s_sleep(1); \
    if ((++_sp & 255u) == 0u) { if (xb_ld(&(bar)[XB_TMO])) break; if (_sp > XB_SPIN_CAP) { atomicAdd(&(bar)[XB_TMO], 1u); break; } } } } while (0)

struct XcdBarrier {
    unsigned* bar; unsigned x;
    volatile LAS unsigned* st;
};

__device__ __forceinline__ XcdBarrier xcd_barrier_post(unsigned* bar, volatile LAS unsigned* st) {
    XcdBarrier b; b.bar = bar; b.x = xb_xcc_id(); b.st = st;
    if (threadIdx.x == 0) (void)xb_add(&bar[XB_XCNT(b.x)], 1u);
    return b;
}
__device__ __forceinline__ void xcd_barrier_complete(unsigned* bar, unsigned x, unsigned& nloc, unsigned& nx) {
    const unsigned G = gridDim.x * gridDim.y * gridDim.z;
    unsigned sum, cnt, mine, sp = 0u;
    for (;;) {
        sum = 0u; cnt = 0u; mine = 0u;
#pragma unroll
        for (unsigned j = 0; j < 16; ++j) { const unsigned c = xb_ld(&bar[XB_XCNT(j)]); sum += c; cnt += (c > 0u) ? 1u : 0u; mine = (j == x) ? c : mine; }
        if (sum == G) break;
        __builtin_amdgcn_s_sleep(1);
        if ((++sp & 255u) == 0u) { if (xb_ld(&bar[XB_TMO])) break; if (sp > XB_SPIN_CAP) { atomicAdd(&bar[XB_TMO], 1u); break; } }
    }
    nloc = mine > 0u ? mine : 1u; nx = cnt > 0u ? cnt : 1u;
}

__device__ __forceinline__ void xcd_barrier(const XcdBarrier& b) {
    asm volatile("s_waitcnt vmcnt(0)" ::: "memory");
    __syncthreads();
    if (threadIdx.x == 0) {
        unsigned* bar = b.bar;
        __builtin_amdgcn_s_waitcnt(0);
        unsigned nloc = b.st[0], nx = b.st[1];
        if (nloc == 0u) { xcd_barrier_complete(bar, b.x, nloc, nx); b.st[0] = nloc; b.st[1] = nx; }
        const unsigned old = xb_add(&bar[XB_XSUB(b.x)], 1u);
        const unsigned gen = old / nloc;
        if (old + 1u == (gen + 1u) * nloc) {
            __builtin_amdgcn_fence(__ATOMIC_RELEASE, "agent");
            asm volatile("s_waitcnt vmcnt(0)" ::: "memory");
            const unsigned og = xb_add(&bar[XB_TOP], 1u);
            const unsigned tg = og / nx;
            if (og + 1u == (tg + 1u) * nx) xb_add(&bar[XB_TOPGEN], 1u);
            else XB_SPIN(xb_ld(&bar[XB_TOPGEN]) == tg, bar);
            __builtin_amdgcn_fence(__ATOMIC_ACQUIRE, "agent");
            xb_add(&bar[XB_XGEN(b.x)], 1u);
            asm volatile("s_waitcnt vmcnt(0)" ::: "memory");
        } else {
            XB_SPIN(xb_ld(&bar[XB_XGEN(b.x)]) == gen, bar);
            __builtin_amdgcn_fence(__ATOMIC_ACQUIRE, "agent");
            asm volatile("s_waitcnt vmcnt(0)" ::: "memory");
        }
    }
    __syncthreads();
}

struct Frame {
    LAS unsigned char* lds;
    volatile LAS unsigned* MISC;
    gu32* ctl;
    int tid, lane, wave, vcu, G, zz;
    unsigned char* ws;
    float* out;
};
struct Args { const float* in[27]; float* out; unsigned char* ws; int ph_lo, ph_hi, bar_li, pad; };

struct TileOrder {
    int nM, nN, nwg, G, c, skip;
    __device__ __forceinline__ void init(int nM_, int nN_, int G_, int c_, int skip_) { nM = nM_; nN = nN_; nwg = nM * nN; G = G_; c = c_; skip = skip_; }
    __device__ __forceinline__ bool next(int i, pg8::Unit& u) const {
        const long L = (long)i * G + c; if (L >= nwg) return false;
        int wgid = (int)L; { const int q = nwg / 8, r = nwg % 8, xcd = wgid % 8, off = wgid / 8; wgid = (xcd < r ? xcd * (q + 1) : r * (q + 1) + (xcd - r) * q) + off; }
        const int nig = 8 * nN, gid = wgid / nig, fm = gid * 8, gsz = (nM - fm) < 8 ? (nM - fm) : 8;
        int pm = fm + ((wgid % nig) % gsz); const int pn = (wgid % nig) / gsz;
        if (skip) pm = (pm >> 4) * 17 + 1 + (pm & 15);
        u.pm = pm; u.pn = pn; u.pb = pn; return true;
    }
    __device__ __forceinline__ void a_ready(const pg8::Unit&) const {}
    __device__ __forceinline__ void done(const pg8::Unit&) const {}
};
struct MoeOrder {
    int t1, t2, t3, t4, t5, t6, t7, t8, nN, G, c;
    __device__ __forceinline__ void init(const gu32* cnt, int nN_, int G_, int c_) {
        int t = 0;
        t += ((int)__hip_atomic_load(cnt + 0 * 64, RLX_AGENT) + 255) >> 8; t1 = t; t += ((int)__hip_atomic_load(cnt + 1 * 64, RLX_AGENT) + 255) >> 8; t2 = t;
        t += ((int)__hip_atomic_load(cnt + 2 * 64, RLX_AGENT) + 255) >> 8; t3 = t; t += ((int)__hip_atomic_load(cnt + 3 * 64, RLX_AGENT) + 255) >> 8; t4 = t;
        t += ((int)__hip_atomic_load(cnt + 4 * 64, RLX_AGENT) + 255) >> 8; t5 = t; t += ((int)__hip_atomic_load(cnt + 5 * 64, RLX_AGENT) + 255) >> 8; t6 = t;
        t += ((int)__hip_atomic_load(cnt + 6 * 64, RLX_AGENT) + 255) >> 8; t7 = t; t += ((int)__hip_atomic_load(cnt + 7 * 64, RLX_AGENT) + 255) >> 8; t8 = t;
        nN = nN_; G = G_; c = c_;
    }
    __device__ __forceinline__ int tile_off(int e) const { return e == 0 ? 0 : e == 1 ? t1 : e == 2 ? t2 : e == 3 ? t3 : e == 4 ? t4 : e == 5 ? t5 : e == 6 ? t6 : t7; }
    __device__ __forceinline__ bool next(int i, pg8::Unit& u) const {
        const long L = (long)i * G + c; if (L >= (long)t8 * nN) return false;
        const int pm = (int)(L / nN), pn = (int)(L % nN);
        const int e = (pm >= t1) + (pm >= t2) + (pm >= t3) + (pm >= t4) + (pm >= t5) + (pm >= t6) + (pm >= t7);
        u.pm = pm; u.pn = pn; u.pb = e * nN + pn; return true;
    }
    __device__ __forceinline__ void a_ready(const pg8::Unit&) const {}
    __device__ __forceinline__ void done(const pg8::Unit&) const {}
};

#define EPI_LOOP(...) _Pragma("unroll") for (int ai = 0; ai < 2; ++ai) _Pragma("unroll") for (int m = 0; m < 4; ++m) { const int row = u.pm * 256 + ai * 128 + wr * 64 + m * 16 + fr; \
    _Pragma("unroll") for (int bj = 0; bj < 2; ++bj) { const int col = bj * 128 + wc * 32 + 4 * fq; f32x4 v0 = acc[ai][bj][m][0], v1 = acc[ai][bj][m][1]; __VA_ARGS__ } if (m & 1) asm volatile("" ::: "memory"); }
#define EPI_LOOP8(...) _Pragma("unroll") for (int ai = 0; ai < 2; ++ai) _Pragma("unroll") for (int m = 0; m < 4; ++m) { const int row = u.pm * 256 + ai * 128 + wr * 64 + m * 16 + fr; \
    _Pragma("unroll") for (int bj = 0; bj < 2; ++bj) { const int col = bj * 128 + wc * 32 + 8 * fq; f32x4 v0 = acc[ai][bj][m][0], v1 = acc[ai][bj][m][1]; __VA_ARGS__ } if (m & 1) asm volatile("" ::: "memory"); }
__device__ __forceinline__ v4u pack8(f32x4 a, f32x4 b) { v4u w; w.x = pg8::cvt_pk_bf16(a[0], a[1]); w.y = pg8::cvt_pk_bf16(a[2], a[3]); w.z = pg8::cvt_pk_bf16(b[0], b[1]); w.w = pg8::cvt_pk_bf16(b[2], b[3]); return w; }
__device__ __forceinline__ v2u pack4(f32x4 v) { v2u w; w.x = pg8::cvt_pk_bf16(v[0], v[1]); w.y = pg8::cvt_pk_bf16(v[2], v[3]); return w; }
__device__ __forceinline__ f32x4 unpack4(v2u w) { return (f32x4){bf_lo(w.x), bf_hi(w.x), bf_lo(w.y), bf_hi(w.y)}; }

struct EpiProj {
    static constexpr bool PERM = false, AFTER_DRAIN = false;
    bf16* P; const float* rope;
    __device__ __forceinline__ void operator()(const pg8::f32x4 (&acc)[2][2][4][2], const pg8::Unit& u, int wr, int wc, int fr, int fq) const {
        const int pn = u.pn;
        if (pn < 4) {
            EPI_LOOP({ const int j = row % RPB;
                if (j >= CTXL) { const int t = j - CTXL; const int pos = (wc & 1) ? (t & 63) : (t >> 6);
                    const f32x4 cs0 = *(const f32x4*)(rope + (pos * 16 + 4 * fq) * 2), cs1 = *(const f32x4*)(rope + (pos * 16 + 4 * fq) * 2 + 4);
                    const float c0 = cs0[0], s0 = cs0[1], c1 = cs0[2], s1 = cs0[3], c2 = cs1[0], s2 = cs1[1], c3 = cs1[2], s3 = cs1[3];
                    const f32x4 a = v0, b = v1;
                    v0[0] = a[0] * c0 - b[0] * s0; v1[0] = b[0] * c0 + a[0] * s0; v0[1] = a[1] * c1 - b[1] * s1; v1[1] = b[1] * c1 + a[1] * s1;
                    v0[2] = a[2] * c2 - b[2] * s2; v1[2] = b[2] * c2 + a[2] * s2; v0[3] = a[3] * c3 - b[3] * s3; v1[3] = b[3] * c3 + a[3] * s3; }
                bf16* o = P + (size_t)row * PLD + pn * 256 + col; *(v2u*)o = pack4(v0); *(v2u*)(o + 16) = pack4(v1); })
        } else {
            EPI_LOOP8({ *(v4u*)(P + (size_t)row * PLD + pn * 256 + col) = pack8(v0, v1); })
        }
    }
};
struct EpiGate {
    static constexpr bool PERM = false, AFTER_DRAIN = false;
    bf16* P;
    __device__ __forceinline__ void operator()(const pg8::f32x4 (&acc)[2][2][4][2], const pg8::Unit& u, int wr, int wc, int fr, int fq) const {
        EPI_LOOP8({ for (int q = 0; q < 4; ++q) { v0[q] = sigmoidf_(v0[q]); v1[q] = sigmoidf_(v1[q]); }
            *(v4u*)(P + (size_t)row * PLD + PC_GATE + u.pn * 256 + col) = pack8(v0, v1); })
    }
};
struct EpiMerge {
    static constexpr bool PERM = false, AFTER_DRAIN = false;
    bf16* MG; const bf16* P; int gcol0; int first;
    __device__ __forceinline__ void operator()(const pg8::f32x4 (&acc)[2][2][4][2], const pg8::Unit& u, int wr, int wc, int fr, int fq) const {
        EPI_LOOP8({ const int c = u.pn * 256 + col; const v4u gw = *(const v4u*)(P + (size_t)row * PLD + gcol0 + c); bf16* o = MG + (size_t)row * DM + c;
            f32x4 r0 = unpack4((v2u){gw.x, gw.y}) * v0, r1 = unpack4((v2u){gw.z, gw.w}) * v1;
            if (!first) { unsigned long long w0 = __hip_atomic_load((unsigned long long*)o, RLX_AGENT), w1 = __hip_atomic_load((unsigned long long*)(o + 4), RLX_AGENT);
                r0 += unpack4((v2u){(unsigned)w0, (unsigned)(w0 >> 32)}); r1 += unpack4((v2u){(unsigned)w1, (unsigned)(w1 >> 32)}); }
            *(v4u*)o = pack8(r0, r1); })
    }
};
struct EpiResid {
    static constexpr bool PERM = false, AFTER_DRAIN = false;
    float* H; const float* modl; int gidx;
    __device__ __forceinline__ void operator()(const pg8::f32x4 (&acc)[2][2][4][2], const pg8::Unit& u, int wr, int wc, int fr, int fq) const {
        EPI_LOOP8({ const int c = u.pn * 256 + col; const int b = row / RPB, j = row - b * RPB; const int mr = j < CTXL ? 4 : b;
            const float* gp = modl + mr * 6144 + gidx * 1024 + c; float* hp = H + (size_t)row * DM + c;
            const f32x4 g0 = *(const f32x4*)gp, g1 = *(const f32x4*)(gp + 4);
            *(f32x4*)hp = *(const f32x4*)hp + g0 * v0; *(f32x4*)(hp + 4) = *(const f32x4*)(hp + 4) + g1 * v1; })
    }
};
struct EpiSwiglu {
    static constexpr bool PERM = false, AFTER_DRAIN = false;
    bf16* HID; int ldh;
    __device__ __forceinline__ void operator()(const pg8::f32x4 (&acc)[2][2][4][2], const pg8::Unit& u, int wr, int wc, int fr, int fq) const {
#pragma unroll
        for (int ai = 0; ai < 2; ++ai)
#pragma unroll
            for (int m = 0; m < 4; ++m) { const int row = u.pm * 256 + ai * 128 + wr * 64 + m * 16 + fr; f32x4 r0, r1;
#pragma unroll
                for (int q = 0; q < 4; ++q) { r0[q] = siluf_(acc[ai][0][m][0][q]) * acc[ai][0][m][1][q]; r1[q] = siluf_(acc[ai][1][m][0][q]) * acc[ai][1][m][1][q]; }
                *(v4u*)(HID + (size_t)row * ldh + u.pn * 128 + wc * 32 + 8 * fq) = pack8(r0, r1);
                if (m & 1) asm volatile("" ::: "memory"); }
    }
};
struct EpiSwiglu8 {
    static constexpr bool PERM = false, AFTER_DRAIN = false;
    unsigned char* HID; int ldh;
    __device__ __forceinline__ void operator()(const pg8::f32x4 (&acc)[2][2][4][2], const pg8::Unit& u, int wr, int wc, int fr, int fq) const {
        const float s8 = (float)(1 << F8_ACT_L2);
#pragma unroll
        for (int ai = 0; ai < 2; ++ai)
#pragma unroll
            for (int m = 0; m < 4; ++m) { const int row = u.pm * 256 + ai * 128 + wr * 64 + m * 16 + fr; f32x4 r0, r1;
#pragma unroll
                for (int q = 0; q < 4; ++q) { r0[q] = siluf_(acc[ai][0][m][0][q]) * acc[ai][0][m][1][q] * s8; r1[q] = siluf_(acc[ai][1][m][0][q]) * acc[ai][1][m][1][q] * s8; }
                v2u o; o.x = cvt4_fp8(r0[0], r0[1], r0[2], r0[3]); o.y = cvt4_fp8(r1[0], r1[1], r1[2], r1[3]);
                *(v2u*)(HID + (size_t)row * ldh + u.pn * 128 + wc * 32 + 8 * fq) = o;
                if (m & 1) asm volatile("" ::: "memory"); }
    }
};
struct EpiY {
    static constexpr bool PERM = false, AFTER_DRAIN = false;
    bf16* Y; int first;
    __device__ __forceinline__ void operator()(const pg8::f32x4 (&acc)[2][2][4][2], const pg8::Unit& u, int wr, int wc, int fr, int fq) const {
        EPI_LOOP8({ (void)first; *(v4u*)(Y + (size_t)row * DM + u.pn * 256 + col) = pack8(v0, v1); })
    }
};

__device__ __forceinline__ int iperm32(int c) { return ((c >> 2) & 1) * 16 + (c >> 3) * 4 + (c & 3); }
template <int MAP> __device__ __forceinline__ int map_col(int c) {
    if (MAP == 0) return c;
    if (MAP == 1) { if (c >= 2560 && (c < 2576 || c >= 2832)) return -1;
        const int d = c < 2560 ? c : PC_POOL + (c - 2576);
        return d < 1024 ? d : (d & ~31) + iperm32(d & 31); }
    if (MAP == 4) return (c & ~31) + iperm32(c & 31);
    { const int x = c & 31; return (c >> 7) * 256 + ((x >> 2) & 1) * 128 + ((c >> 5) & 3) * 32 + (MAP == 3 ? 16 : 0) + 4 * (x >> 3) + (x & 3); }
}
template <int MAP> __device__ __forceinline__ void tr_item(const float* W, int ldw, int N, bf16* WT, int ldd, int item, LAS float* scr, int lane) {
    const int nblk = (N + 31) / 32, kb = item / nblk, nb = item % nblk, k0 = 64 * kb, n0 = 32 * nb;
    const int cl = n0 + (lane & 31);
    float tv[32];
#pragma unroll
    for (int i = 0; i < 32; ++i) { const int kk = 2 * i + (lane >> 5); tv[i] = cl < N ? W[(size_t)(k0 + kk) * ldw + cl] : 0.f; }
#pragma unroll
    for (int i = 0; i < 32; ++i) { const int kk = 2 * i + (lane >> 5); scr[kk * 33 + (lane & 31)] = tv[i]; }
    LDS_WAIT(); asm volatile("" ::: "memory");
    const int c = lane & 7;
#pragma unroll
    for (int j = 0; j < 4; ++j) { const int n = (lane >> 3) + 8 * j; const LAS float* s = scr + (8 * c) * 33 + n;
        const int dr = n0 + n < N ? map_col<MAP>(n0 + n) : -1;
        if (dr >= 0) { v4u o; o.x = pk2(s[0 * 33], s[1 * 33]); o.y = pk2(s[2 * 33], s[3 * 33]); o.z = pk2(s[4 * 33], s[5 * 33]); o.w = pk2(s[6 * 33], s[7 * 33]);
            *(GAS v4u*)(WT + (size_t)dr * ldd + k0 + 8 * c) = o; } }
    LDS_WAIT(); asm volatile("" ::: "memory");
}
template <int MAP> __device__ __forceinline__ void tr_item8(const float* W, int ldw, int N, unsigned char* WT, int ldd, int item, LAS float* scr, int lane, float scale) {
    const int nblk = (N + 31) / 32, kb = item / nblk, nb = item % nblk, k0 = 64 * kb, n0 = 32 * nb;
    const int cl = n0 + (lane & 31);
    float tv[32];
#pragma unroll
    for (int i = 0; i < 32; ++i) { const int kk = 2 * i + (lane >> 5); tv[i] = cl < N ? W[(size_t)(k0 + kk) * ldw + cl] : 0.f; }
#pragma unroll
    for (int i = 0; i < 32; ++i) { const int kk = 2 * i + (lane >> 5); scr[kk * 33 + (lane & 31)] = tv[i]; }
    LDS_WAIT(); asm volatile("" ::: "memory");
    const int c = lane & 7;
#pragma unroll
    for (int j = 0; j < 4; ++j) { const int n = (lane >> 3) + 8 * j; const LAS float* s = scr + (8 * c) * 33 + n;
        if (n0 + n < N) { v2u o; o.x = cvt4_fp8(s[0 * 33] * scale, s[1 * 33] * scale, s[2 * 33] * scale, s[3 * 33] * scale); o.y = cvt4_fp8(s[4 * 33] * scale, s[5 * 33] * scale, s[6 * 33] * scale, s[7 * 33] * scale);
            *(GAS v2u*)(WT + (size_t)map_col<MAP>(n0 + n) * ldd + k0 + 8 * c) = o; } }
    LDS_WAIT(); asm volatile("" ::: "memory");
}
#define TR_RUN(MAP, W, ldw, K, N, WT, ldd) { const int cnt_ = ((K) / 64) * (((N) + 31) / 32); if (r < cnt_) { tr_item<MAP>(W, ldw, N, WT, ldd, r, scr, F.lane); continue; } r -= cnt_; }

constexpr int LW_ITEMS = 16 * 185 + 8 * 32 + 4 * 32 + 4 * 32 + 16 * 32 + 16 * 96 + 64;
__device__ __forceinline__ void conv_layer_weights(Frame& F, const Args& A, int l, int rank, int nranks) {
    LAS float* scr = (LAS float*)(F.lds + F.wave * 16384);
    bf16* WIN = (bf16*)(F.ws + WS_WIN); bf16* WBR = (bf16*)(F.ws + WS_WBR); bf16* WOUT = (bf16*)(F.ws + WS_WOUT);
    const float* win = A.in[F.zz + 8] + (size_t)l * 1024 * INW; const float* wbr = A.in[F.zz + 17] + (size_t)l * 1024 * 1024; const float* wo = A.in[F.zz + 18] + (size_t)l * 1024 * 1024;
    bf16* dbr = WBR + (size_t)l * 1024 * 1024;
    for (int it = rank; it < LW_ITEMS; it += nranks) {
        int r = it;
        { const int cnt_ = 16 * 185; if (r < cnt_) { tr_item<1>(win, INW, INW, WIN + (size_t)l * NPB * 1024, 1024, r, scr, F.lane); continue; } r -= cnt_; }
        { const int cnt_ = 8 * 32; if (r < cnt_) { tr_item<4>(wbr, 1024, 1024, dbr, 512, r, scr, F.lane); continue; } r -= cnt_; }
        { const int cnt_ = 4 * 32; if (r < cnt_) { tr_item<4>(wbr + 512 * 1024, 1024, 1024, dbr + 1024 * 512, 256, r, scr, F.lane); continue; } r -= cnt_; }
        { const int cnt_ = 4 * 32; if (r < cnt_) { tr_item<4>(wbr + 768 * 1024, 1024, 1024, dbr + 1024 * 768, 256, r, scr, F.lane); continue; } r -= cnt_; }
        { const int cnt_ = 16 * 32; if (r < cnt_) { tr_item<4>(wo, 1024, 1024, WOUT + (size_t)l * 1024 * 1024, 1024, r, scr, F.lane); continue; } r -= cnt_; }
        { const int cnt_ = 16 * 96; if (r < cnt_) { tr_item8<4>(win + 2832, INW, 3072, F.ws + WS_WG8 + (size_t)l * 3072 * 1024, 1024, r, scr, F.lane, (float)(1 << F8_W13_L2)); continue; } r -= cnt_; }
        { bf16* wab = (bf16*)(F.ws + WS_WAB) + (size_t)l * 16384;
          for (int e = F.lane; e < 256; e += 64) { const int k = r * 16 + (e >> 4), c = e & 15; wab[c * 1024 + k] = (bf16)f2bf(win[(size_t)k * INW + 2560 + c]); } }
    }
}
__device__ __forceinline__ void p0_prologue(Frame& F, const Args& A) {
    LAS float* scr = (LAS float*)(F.lds + F.wave * 16384);
    const int gw = F.vcu * NWAVES + F.wave, NGW = F.G * NWAVES;
    bf16* W13 = (bf16*)(F.ws + WS_W13); bf16* W2 = (bf16*)(F.ws + WS_W2);
    conv_layer_weights(F, A, 0, gw, NGW);
    constexpr int TOTAL = 16 * 88 * 2 + 44 * 32;
    for (int it = gw; it < TOTAL; it += NGW) {
        int r = it;
#ifdef DENSE_F8
        { const int cnt_ = 16 * 88; if (r < cnt_) { tr_item8<2>(A.in[F.zz + 19], FFD, FFD, (unsigned char*)W13, 1024, r, scr, F.lane, (float)(1 << F8_W13_L2)); continue; } r -= cnt_; }
        { const int cnt_ = 16 * 88; if (r < cnt_) { tr_item8<3>(A.in[F.zz + 20], FFD, FFD, (unsigned char*)W13, 1024, r, scr, F.lane, (float)(1 << F8_W13_L2)); continue; } r -= cnt_; }
        tr_item8<4>(A.in[F.zz + 21], 1024, 1024, (unsigned char*)W2, FFD, r, scr, F.lane, (float)(1 << F8_W2_L2));
#else
        { const int cnt_ = 16 * 88; if (r < cnt_) { tr_item<2>(A.in[F.zz + 19], FFD, FFD, W13, 1024, r, scr, F.lane); continue; } r -= cnt_; }
        { const int cnt_ = 16 * 88; if (r < cnt_) { tr_item<3>(A.in[F.zz + 20], FFD, FFD, W13, 1024, r, scr, F.lane); continue; } r -= cnt_; }
        tr_item<4>(A.in[F.zz + 21], 1024, 1024, W2, FFD, r, scr, F.lane);
#endif
    }
    if (F.vcu == 0 && F.tid < 8) __hip_atomic_store(F.ctl + CW_ECNT + 64 * F.tid, 0u, RLX_AGENT);
    float* H = (float*)(F.ws + WS_H);
    for (int R = gw; R < MROWS; R += NGW) { const int b = R / RPB, j = R - b * RPB;
        const float* src = j < CTXL ? A.in[F.zz + 2] + ((size_t)b * CTXL + j) * DM : A.in[F.zz + 0] + ((size_t)b * SEQ + (j - CTXL)) * DM;
        const GAS f32x4* s4 = (const GAS f32x4*)src + F.lane; GAS f32x4* d4 = (GAS f32x4*)(H + (size_t)R * DM) + F.lane;
#pragma unroll
        for (int q = 0; q < 4; ++q) d4[64 * q] = s4[64 * q]; }
    if (F.vcu == 0) {
        float* rope = (float*)(F.ws + WS_ROPE);
        for (int e = F.tid; e < 1024; e += NTHR) { const int pos = e >> 4, i = e & 15; const float inv = powf(10000.f, -(float)i / 16.f); const float a = (float)pos * inv;
            rope[2 * e] = cosf(a); rope[2 * e + 1] = sinf(a); }
        if (F.tid < 2) { const int l = F.tid; const float* lp = A.in[F.zz + 9] + l * 256; float s1 = 0.f, s2 = 0.f;
            for (int i = 0; i < 64; ++i) { s1 += lp[i] * lp[64 + i]; s2 += lp[128 + i] * lp[192 + i]; }
            const float li = 0.8f - 0.6f * expf(-0.3f * (float)l);
            ((float*)(F.ws + WS_LAM))[l] = expf(s1) - expf(s2) + li; }
    }
    __syncthreads();
    float* MOD = (float*)(F.ws + WS_MOD);
    LAS float* red = (LAS float*)F.lds;
    for (int task = F.vcu; task < 2 * 96; task += F.G) {
        const int l = task / 96, cc = task % 96;
        const float* aw = A.in[F.zz + 4] + (size_t)l * 1024 * 6144 + cc * 64 + F.lane;
        const float* c0 = A.in[F.zz + 1]; const float* cx = A.in[F.zz + 3];
        float a0 = 0.f, a1 = 0.f, a2 = 0.f, a3 = 0.f, a4 = 0.f;
#pragma unroll 8
        for (int i = 0; i < 128; ++i) { const int k = F.wave * 128 + i; const float w = aw[(size_t)k * 6144];
            a0 += siluf_(c0[k]) * w; a1 += siluf_(c0[1024 + k]) * w; a2 += siluf_(c0[2048 + k]) * w; a3 += siluf_(c0[3072 + k]) * w; a4 += siluf_(cx[k]) * w; }
        LAS float* rw = red + F.wave * 320 + F.lane;
        rw[0] = a0; rw[64] = a1; rw[128] = a2; rw[192] = a3; rw[256] = a4;
        __syncthreads();
        if (F.tid < 320) { float s = 0.f;
#pragma unroll
            for (int w = 0; w < 8; ++w) s += red[w * 320 + F.tid];
            const int rr = F.tid >> 6, jj = cc * 64 + (F.tid & 63);
            MOD[(l * 5 + rr) * 6144 + jj] = s + A.in[F.zz + 5][l * 6144 + jj]; }
        __syncthreads();
    }
}

__device__ __forceinline__ void moe_convert(Frame& F, const Args& A, int rank, int nranks) {
    LAS float* scr = (LAS float*)(F.lds + F.wave * 16384);
    const int gw = rank, NGW = nranks;
    unsigned char* W13M = F.ws + WS_W13M; unsigned char* W2M = F.ws + WS_W2M;
    constexpr int I13 = 16 * 112, I2 = 56 * 32, PER_E = 2 * I13 + I2;
    for (int it = gw; it < 8 * PER_E; it += NGW) {
        const int e = it / PER_E; int r = it - e * PER_E;
        if (r < I13) { tr_item8<2>(A.in[F.zz + 23] + (size_t)e * 1024 * FFE, FFE, FFE, W13M + (size_t)e * 2 * FFE * 1024, 1024, r, scr, F.lane, (float)(1 << F8_W13_L2)); continue; } r -= I13;
        if (r < I13) { tr_item8<3>(A.in[F.zz + 24] + (size_t)e * 1024 * FFE, FFE, FFE, W13M + (size_t)e * 2 * FFE * 1024, 1024, r, scr, F.lane, (float)(1 << F8_W13_L2)); continue; } r -= I13;
        tr_item8<4>(A.in[F.zz + 25] + (size_t)e * FFE * 1024, 1024, 1024, W2M + (size_t)e * 1024 * FFE, FFE, r, scr, F.lane, (float)(1 << F8_W2_L2));
    }
}

__device__ __forceinline__ void norm_mod_phase(Frame& F, const Args& A, int l, int which, bool latent_only, bool route, bool out8 = false) {
    const int gw = F.vcu * NWAVES + F.wave, NGW = F.G * NWAVES;
    const float* H = (const float*)(F.ws + WS_H); bf16* U = (bf16*)(F.ws + WS_U); const float* MOD = (const float*)(F.ws + WS_MOD) + l * 5 * 6144;
    const float* g = (which ? A.in[F.zz + 7] : A.in[F.zz + 6]) + l * 1024;
    for (int R = gw; R < MROWS; R += NGW) {
        const int b = R / RPB, j = R - b * RPB; const bool isctx = j < CTXL; if (latent_only && isctx) continue;
        const float* mod = MOD + (isctx ? 4 : b) * 6144; const float* shift = mod + (which ? 3 : 0) * 1024; const float* scale = mod + (which ? 4 : 1) * 1024;
        const GAS f32x4* xr = (const GAS f32x4*)(H + (size_t)R * DM) + F.lane;
        f32x4 v[4]; float ss = 0.f;
#pragma unroll
        for (int q = 0; q < 4; ++q) { v[q] = xr[64 * q]; ss += (v[q].x * v[q].x + v[q].y * v[q].y) + (v[q].z * v[q].z + v[q].w * v[q].w); }
        const float rstd = 1.f / sqrtf(wave_sum(ss) * (1.f / DM) + EPSN);
        GAS v2u* o8 = (GAS v2u*)(U + (size_t)R * DM) + F.lane;
#pragma unroll
        for (int q = 0; q < 4; ++q) { const int c = 4 * F.lane + 256 * q; const f32x4 gg = *(const f32x4*)(g + c), sh = *(const f32x4*)(shift + c), sc = *(const f32x4*)(scale + c);
            v[q] = (v[q] * rstd) * gg * (sc + 1.f) + sh;
            if (out8) { const float s8 = (float)(1 << F8_ACT_L2); ((GAS unsigned*)((unsigned char*)U + (size_t)R * DM))[F.lane + 64 * q] = cvt4_fp8(v[q].x * s8, v[q].y * s8, v[q].z * s8, v[q].w * s8); }
            else { v2u w; w.x = pk2(v[q].x, v[q].y); w.y = pk2(v[q].z, v[q].w); o8[64 * q] = w; } }
        if (which == 0) {
            const float s8 = (float)(1 << F8_ACT_L2);
#pragma unroll
            for (int q = 0; q < 4; ++q) ((GAS unsigned*)(F.ws + WS_U8 + (size_t)R * DM))[F.lane + 64 * q] = cvt4_fp8(v[q].x * s8, v[q].y * s8, v[q].z * s8, v[q].w * s8);
        }
        if (route) {
            const float* rw = A.in[F.zz + 22];
            float lg[8] = {0, 0, 0, 0, 0, 0, 0, 0};
#pragma unroll
            for (int q = 0; q < 4; ++q)
#pragma unroll
                for (int i = 0; i < 4; ++i) { const int k = 4 * F.lane + 256 * q + i; const f32x4 w0 = *(const f32x4*)(rw + k * 8), w1 = *(const f32x4*)(rw + k * 8 + 4); const float x = v[q][i];
                    lg[0] += x * w0[0]; lg[1] += x * w0[1]; lg[2] += x * w0[2]; lg[3] += x * w0[3]; lg[4] += x * w1[0]; lg[5] += x * w1[1]; lg[6] += x * w1[2]; lg[7] += x * w1[3]; }
#pragma unroll
            for (int e = 0; e < 8; ++e) lg[e] = wave_sum(lg[e]);
            if (F.lane == 0) {
                int e0 = 0; float v0 = lg[0];
#pragma unroll
                for (int e = 1; e < 8; ++e) if (lg[e] > v0) { v0 = lg[e]; e0 = e; }
                int e1 = -1; float v1 = -3.0e38f;
#pragma unroll
                for (int e = 0; e < 8; ++e) if (e != e0 && lg[e] > v1) { v1 = lg[e]; e1 = e; }
                const float ex = __expf(v1 - v0); const float w0 = 1.f / (1.f + ex), w1 = ex / (1.f + ex);
                gu32* cnt = F.ctl + CW_ECNT;
#ifdef DBG_DETPOS
                const unsigned p0 = 0, p1 = 0; (void)cnt;
#else
                const unsigned p0 = __hip_atomic_fetch_add(cnt + 64 * e0, 1u, RLX_AGENT), p1 = __hip_atomic_fetch_add(cnt + 64 * e1, 1u, RLX_AGENT);
#endif
                const int tk = b * SEQ + (j - CTXL);
                v4u* rt = (v4u*)(F.ws + WS_ROUTE) + 2 * tk;
                rt[0] = (v4u){(unsigned)e0, (unsigned)e1, p0, p1}; rt[1] = (v4u){__float_as_uint(w0), __float_as_uint(w1), 0u, 0u};
            }
        }
    }
}

__device__ __forceinline__ void norm2_route_phase(Frame& F, const Args& A) {
    const int l = 1;
    const float* H = (const float*)(F.ws + WS_H); bf16* U = (bf16*)(F.ws + WS_U); const float* MOD = (const float*)(F.ws + WS_MOD) + l * 5 * 6144;
    const float* g = A.in[F.zz + 7] + l * 1024; const float* rw = A.in[F.zz + 22];
    LAS unsigned* wcnt = (LAS unsigned*)F.lds;
    LAS unsigned* gbase = wcnt + 64;
    const int lane = F.lane, wv = F.wave;
    for (int blk = F.vcu; blk < NB * SEQ / 64; blk += F.G) {
        int me0 = 0, me1 = 0; float mw0 = 0.f, mw1 = 0.f;
#pragma unroll 1
        for (int i = 0; i < 8; ++i) {
            const int tk = blk * 64 + wv * 8 + i, b = tk / SEQ, t = tk - b * SEQ; const size_t R = (size_t)b * RPB + CTXL + t;
            const float* mod = MOD + b * 6144; const float* shift = mod + 3 * 1024; const float* scale = mod + 4 * 1024;
            const GAS f32x4* xr = (const GAS f32x4*)(H + R * DM) + lane;
            f32x4 v[4]; float ss = 0.f;
#pragma unroll
            for (int q = 0; q < 4; ++q) { v[q] = xr[64 * q]; ss += (v[q].x * v[q].x + v[q].y * v[q].y) + (v[q].z * v[q].z + v[q].w * v[q].w); }
            const float rstd = 1.f / sqrtf(wave_sum(ss) * (1.f / DM) + EPSN);
            GAS v2u* o8 = (GAS v2u*)(U + R * DM) + lane;
            float lg[8] = {0, 0, 0, 0, 0, 0, 0, 0};
#pragma unroll
            for (int q = 0; q < 4; ++q) { const int c = 4 * lane + 256 * q; const f32x4 gg = *(const f32x4*)(g + c), sh = *(const f32x4*)(shift + c), sc = *(const f32x4*)(scale + c);
                v[q] = (v[q] * rstd) * gg * (sc + 1.f) + sh; v2u w; w.x = pk2(v[q].x, v[q].y); w.y = pk2(v[q].z, v[q].w); o8[64 * q] = w;
#pragma unroll
                for (int j = 0; j < 4; ++j) { const int k = c + j; const f32x4 w0 = *(const f32x4*)(rw + k * 8), w1 = *(const f32x4*)(rw + k * 8 + 4); const float x = v[q][j];
                    lg[0] += x * w0[0]; lg[1] += x * w0[1]; lg[2] += x * w0[2]; lg[3] += x * w0[3]; lg[4] += x * w1[0]; lg[5] += x * w1[1]; lg[6] += x * w1[2]; lg[7] += x * w1[3]; } }
#pragma unroll
            for (int e = 0; e < 8; ++e) lg[e] = wave_sum(lg[e]);
            int e0 = 0; float v0 = lg[0];
#pragma unroll
            for (int e = 1; e < 8; ++e) if (lg[e] > v0) { v0 = lg[e]; e0 = e; }
            int e1 = -1; float v1 = -3.0e38f;
#pragma unroll
            for (int e = 0; e < 8; ++e) if (e != e0 && lg[e] > v1) { v1 = lg[e]; e1 = e; }
            const float ex = __expf(v1 - v0);
            if (lane == i) { me0 = e0; me1 = e1; mw0 = 1.f / (1.f + ex); mw1 = ex / (1.f + ex); }
        }
        const bool act = lane < 8; const unsigned long long below = (1ull << lane) - 1ull;
        unsigned r0 = 0, r1 = 0, mycnt = 0;
#pragma unroll
        for (int e = 0; e < 8; ++e) { const unsigned long long m0 = __ballot(act && me0 == e), m1 = __ballot(act && me1 == e);
            const unsigned bel = (unsigned)__popcll((m0 | m1) & below);
            if (me0 == e) r0 = bel; if (me1 == e) r1 = bel;
            if (lane == e) mycnt = (unsigned)__popcll(m0) + (unsigned)__popcll(m1); }
        if (act) wcnt[wv * 8 + lane] = mycnt;
        __syncthreads();
        if (F.tid < 8) { unsigned tot = 0;
#pragma unroll
            for (int w = 0; w < 8; ++w) tot += wcnt[w * 8 + F.tid];
            gbase[F.tid] = __hip_atomic_fetch_add(F.ctl + CW_ECNT + 64 * F.tid, tot, RLX_AGENT); }
        __syncthreads();
        if (act) { unsigned b0 = gbase[me0], b1 = gbase[me1];
            for (int w = 0; w < wv; ++w) { b0 += wcnt[w * 8 + me0]; b1 += wcnt[w * 8 + me1]; }
            const int tk = blk * 64 + wv * 8 + lane;
            v4u* rt = (v4u*)(F.ws + WS_ROUTE) + 2 * tk;
            rt[0] = (v4u){(unsigned)me0, (unsigned)me1, b0 + r0, b1 + r1}; rt[1] = (v4u){__float_as_uint(mw0), __float_as_uint(mw1), 0u, 0u}; }
        __syncthreads();
    }
}

__device__ __forceinline__ void ab_tiles(Frame& F, const Args& A, int l) {
    typedef short ab_s16x8 __attribute__((ext_vector_type(8)));
    const int gw = F.vcu * NWAVES + F.wave, NGW = F.G * NWAVES, r = F.lane & 15, q = F.lane >> 4;
    const bf16* U = (const bf16*)(F.ws + WS_U); const bf16* wab = (const bf16*)(F.ws + WS_WAB) + (size_t)l * 16384 + r * 1024 + 8 * q;
    const float alog = A.in[F.zz + 12][l * 8 + (r & 7)], dtb = A.in[F.zz + 13][l * 8 + (r & 7)];
    for (int t = gw; t < MROWS / 16; t += NGW) {
        const bf16* up = U + (size_t)(t * 16 + r) * DM + 8 * q; f32x4 acc = {0.f, 0.f, 0.f, 0.f};
#pragma unroll 8
        for (int ks = 0; ks < 32; ++ks) acc = __builtin_amdgcn_mfma_f32_16x16x32_bf16(*(const ab_s16x8*)(up + 32 * ks), *(const ab_s16x8*)(wab + 32 * ks), acc, 0, 0, 0);
        f32x4 o;
#pragma unroll
        for (int g = 0; g < 4; ++g) { const float x = acc[g];
            if (r < 8) { const float z = x + dtb; const float ez = __expf(z); const float sp = z > 15.f ? z : (ez < 0.03f ? ez * (1.f - ez * (0.5f - ez * (1.f / 3.f))) : __logf(1.f + ez)); o[g] = -__expf(alog) * sp; }
            else o[g] = sigmoidf_(x); }
        float* gb = (float*)(F.ws + WS_GB) + (size_t)(t * 16 + 4 * q) * 16 + r;
        gb[0] = o[0]; gb[16] = o[1]; gb[32] = o[2]; gb[48] = o[3];
    }
}

__device__ __forceinline__ void moe_gather2(Frame& F) {
    const int gw = F.vcu * NWAVES + F.wave, NGW = F.G * NWAVES;
    MoeOrder mo; mo.init(F.ctl + CW_ECNT, 1, 1, 0);
    const bf16* U = (const bf16*)(F.ws + WS_U); unsigned char* XG = F.ws + WS_XG; const float sc = (float)(1 << F8_ACT_L2);
    for (int tk = gw; tk < NB * SEQ; tk += NGW) {
        const int b = tk / SEQ, t = tk - b * SEQ; const size_t R = (size_t)b * RPB + CTXL + t;
        const v4u rt = ((const v4u*)(F.ws + WS_ROUTE))[2 * tk];
        const size_t r0 = (size_t)mo.tile_off((int)rt.x) * 256 + rt.z, r1 = (size_t)mo.tile_off((int)rt.y) * 256 + rt.w;
        const GAS v4u* s = (const GAS v4u*)(U + R * DM) + 2 * F.lane; const v4u a = s[0], c = s[1];
        v4u o; o.x = cvt4_fp8(bf_lo(a.x) * sc, bf_hi(a.x) * sc, bf_lo(a.y) * sc, bf_hi(a.y) * sc); o.y = cvt4_fp8(bf_lo(a.z) * sc, bf_hi(a.z) * sc, bf_lo(a.w) * sc, bf_hi(a.w) * sc);
        o.z = cvt4_fp8(bf_lo(c.x) * sc, bf_hi(c.x) * sc, bf_lo(c.y) * sc, bf_hi(c.y) * sc); o.w = cvt4_fp8(bf_lo(c.z) * sc, bf_hi(c.z) * sc, bf_lo(c.w) * sc, bf_hi(c.w) * sc);
        *((GAS v4u*)(XG + r0 * DM) + F.lane) = o; *((GAS v4u*)(XG + r1 * DM) + F.lane) = o;
    }
}
__device__ __forceinline__ void moe_gather(Frame& F) {
    moe_gather2(F);
}
__device__ __forceinline__ void final_phase(Frame& F, const Args& A) {
    const int gw = F.vcu * NWAVES + F.wave, NGW = F.G * NWAVES;
    MoeOrder mo; mo.init(F.ctl + CW_ECNT, 1, 1, 0);
    const float* H = (const float*)(F.ws + WS_H); const bf16* Y = (const bf16*)(F.ws + WS_Y); const float* MOD = (const float*)(F.ws + WS_MOD) + 1 * 5 * 6144;
    for (int tk = gw; tk < NB * SEQ; tk += NGW) {
        const int b = tk / SEQ, t = tk - b * SEQ; const size_t R = (size_t)b * RPB + CTXL + t;
        const v4u rt = ((const v4u*)(F.ws + WS_ROUTE))[2 * tk], rw = ((const v4u*)(F.ws + WS_ROUTE))[2 * tk + 1];
        const size_t r0 = (size_t)mo.tile_off((int)rt.x) * 256 + rt.z, r1 = (size_t)mo.tile_off((int)rt.y) * 256 + rt.w;
        const float w0 = __uint_as_float(rw.x), w1 = __uint_as_float(rw.y);
        const float* gate = MOD + b * 6144 + 5 * 1024;
        f32x4 v[4]; float ss = 0.f;
#pragma unroll
        for (int q = 0; q < 4; ++q) { const int c = 4 * F.lane + 256 * q;
            const f32x4 h = *(const f32x4*)(H + R * DM + c), gg = *(const f32x4*)(gate + c);
            const f32x4 y0 = unpack4(*(const v2u*)(Y + r0 * DM + c)), y1 = unpack4(*(const v2u*)(Y + r1 * DM + c));
            v[q] = h + gg * (y0 * w0 + y1 * w1); ss += (v[q].x * v[q].x + v[q].y * v[q].y) + (v[q].z * v[q].z + v[q].w * v[q].w); }
        const float rstd = 1.f / sqrtf(wave_sum(ss) * (1.f / DM) + EPSN);
#pragma unroll
        for (int q = 0; q < 4; ++q) { const int c = 4 * F.lane + 256 * q; *(f32x4*)(F.out + (size_t)tk * DM + c) = v[q] * rstd * *(const f32x4*)(A.in[F.zz + 26] + c); }
    }
}

constexpr int DP = 65;
typedef short dn_bf16x8 __attribute__((ext_vector_type(8)));
__device__ __forceinline__ f32x4 mm_tile(const LAS float* Am, int a_sm, int a_sk, const LAS float* Bm, int b_sk, int b_sn, int m0, int n0, int lane) {
    const int r = lane & 15, q = lane >> 4; f32x4 acc = {0.f, 0.f, 0.f, 0.f};
#pragma unroll
    for (int ks = 0; ks < 2; ++ks) {
        const LAS float* ap = Am + (m0 + r) * a_sm + (32 * ks + 8 * q) * a_sk; const LAS float* bp = Bm + (32 * ks + 8 * q) * b_sk + (n0 + r) * b_sn;
        v4u a, b;
        a.x = pk2(ap[0], ap[a_sk]); a.y = pk2(ap[2 * a_sk], ap[3 * a_sk]); a.z = pk2(ap[4 * a_sk], ap[5 * a_sk]); a.w = pk2(ap[6 * a_sk], ap[7 * a_sk]);
        b.x = pk2(bp[0], bp[b_sk]); b.y = pk2(bp[2 * b_sk], bp[3 * b_sk]); b.z = pk2(bp[4 * b_sk], bp[5 * b_sk]); b.w = pk2(bp[6 * b_sk], bp[7 * b_sk]);
        acc = __builtin_amdgcn_mfma_f32_16x16x32_bf16(__builtin_bit_cast(dn_bf16x8, a), __builtin_bit_cast(dn_bf16x8, b), acc, 0, 0, 0);
    }
    return acc;
}

constexpr int RS = 72;
constexpr int IMG = 64 * RS * 2;
typedef short dn_s16x4 __attribute__((ext_vector_type(4)));
__device__ __forceinline__ f32x4 mm_img(const LAS bf16* Ai, const LAS bf16* Bi, int m0, int n0, int r, int q) {
    f32x4 acc = {0.f, 0.f, 0.f, 0.f};
    const LAS bf16* ap = Ai + (m0 + r) * RS + 8 * q; const LAS bf16* bp = Bi + (n0 + r) * RS + 8 * q;
    acc = __builtin_amdgcn_mfma_f32_16x16x32_bf16(*(const LAS dn_bf16x8*)ap, *(const LAS dn_bf16x8*)bp, acc, 0, 0, 0);
    acc = __builtin_amdgcn_mfma_f32_16x16x32_bf16(*(const LAS dn_bf16x8*)(ap + 32), *(const LAS dn_bf16x8*)(bp + 32), acc, 0, 0, 0);
    return acc;
}
template <int D> __device__ __forceinline__ void dn_diag_inv(LAS float* Dg, int ln) {
    const int blk = ln >> 4, r = ln & 15;
    LAS float* Ab = Dg + blk * 256;
    float t[16];
#pragma unroll
    for (int c = 0; c < 16; ++c) t[c] = (c == r) ? 1.f : 0.f;
#pragma unroll
    for (int c = 14; c >= 0; --c) { float s = 0.f;
#pragma unroll
        for (int j = c + 1; j < 16; ++j) { const float a = D == 0 ? Ab[j * 16 + c] : Ab[(15 - j) * 16 + (15 - c)]; s -= t[j] * a; }
        t[c] = (c < r) ? s : t[c]; }
    asm volatile("s_waitcnt lgkmcnt(0)" ::: "memory");
#pragma unroll
    for (int c = 0; c < 16; ++c) { if (D == 0) Ab[r * 16 + c] = t[c]; else Ab[(15 - r) * 16 + (15 - c)] = t[c]; }
}
template <int D> __device__ __forceinline__ void dn_solve_tiles(const LAS bf16* Ad, const LAS float* Dg, const LAS bf16* VT, const LAS bf16* KT, LAS bf16* UT, LAS bf16* WT,
                                                               const LAS float* Bd, const LAS float* Gd, int w4, int ln) {
    const int r = ln & 15, q = ln >> 4;
#pragma unroll 1
    for (int i = 0; i < 2; ++i) { const int nt = w4 * 2 + i; const bool isw = nt >= 4; const int c0 = (nt & 3) * 16 + r;
        const LAS bf16* src = (isw ? KT : VT) + c0 * RS; LAS bf16* dst = (isw ? WT : UT) + c0 * RS;
        f32x4 acc[4]; dn_s16x4 xb[4];
#pragma unroll
        for (int bi = 0; bi < 4; ++bi) { const v2u x = *(const LAS v2u*)(src + 16 * bi + 4 * q); const f32x4 xv = {bf_lo(x.x), bf_hi(x.x), bf_lo(x.y), bf_hi(x.y)};
#pragma unroll
            for (int g = 0; g < 4; ++g) { const int t = 16 * bi + 4 * q + g; const float sc = isw ? Bd[t] * __expf(Gd[t]) : Bd[t]; acc[bi][g] = xv[g] * sc; } }
#pragma unroll
        for (int st = 0; st < 4; ++st) { const int bi = D == 0 ? st : 3 - st;
#pragma unroll
            for (int s2 = 0; s2 < st; ++s2) { const int bj = D == 0 ? s2 : 3 - s2;
                v2u a = *(const LAS v2u*)(Ad + (16 * bi + r) * RS + 16 * bj + 4 * q); a.x ^= 0x80008000u; a.y ^= 0x80008000u;
                acc[bi] = __builtin_amdgcn_mfma_f32_16x16x16bf16_1k(__builtin_bit_cast(dn_s16x4, a), xb[bj], acc[bi], 0, 0, 0); }
            { const LAS float* tp = Dg + bi * 256 + r * 16 + 4 * q; v2u a; a.x = cvtpk_c(tp[0], tp[1]); a.y = cvtpk_c(tp[2], tp[3]);
              v2u xr; xr.x = cvtpk_c(acc[bi][0], acc[bi][1]); xr.y = cvtpk_c(acc[bi][2], acc[bi][3]);
              acc[bi] = __builtin_amdgcn_mfma_f32_16x16x16bf16_1k(__builtin_bit_cast(dn_s16x4, a), __builtin_bit_cast(dn_s16x4, xr), (f32x4){0.f, 0.f, 0.f, 0.f}, 0, 0, 0);
              v2u xo; xo.x = cvtpk_c(acc[bi][0], acc[bi][1]); xo.y = cvtpk_c(acc[bi][2], acc[bi][3]); xb[bi] = __builtin_bit_cast(dn_s16x4, xo);
              *(LAS v2u*)(dst + 16 * bi + 4 * q) = xo; }
        }
    }
}
__device__ __forceinline__ void dn_pre_unit(Frame& F, const Args& A, int l, int b, int n, int h) {
    LAS bf16* KcB = (LAS bf16*)(F.lds + 0 * IMG); LAS bf16* QcB = (LAS bf16*)(F.lds + 1 * IMG); LAS bf16* KT = (LAS bf16*)(F.lds + 2 * IMG); LAS bf16* VT = (LAS bf16*)(F.lds + 3 * IMG);
#define DIMG(d, k) ((LAS bf16*)(F.lds + (4 + 5 * (d) + (k)) * IMG))
    LAS float* Gs = (LAS float*)(F.lds + 14 * IMG);
    LAS float* Bs = Gs + 128;
    LAS float* Dg = Gs + 256;
    const bf16* P = (const bf16*)(F.ws + WS_PROJ); const float* GB = (const float*)(F.ws + WS_GB);
    int tid = threadIdx.x; asm volatile("" : "+v"(tid));
    const int wv = tid >> 6, ln = tid & 63, r = ln & 15, q = ln >> 4;
    const int row0 = b * RPB + n * 64; const int seq_lo = (n < 4) ? b * RPB : b * RPB + CTXL, seq_hi = (n < 4) ? b * RPB + CTXL : (b + 1) * RPB;
    {
        const int t = tid >> 3, cg = tid & 7;
        const float* cw = A.in[F.zz + 11] + (size_t)l * 5 * 768;
#pragma unroll
        for (int p = 0; p < 3; ++p) {
            const int ch = p * 256 + h * 64 + cg * 8;
            float acc[8] = {0, 0, 0, 0, 0, 0, 0, 0};
#pragma unroll
            for (int tap = 0; tap < 5; ++tap) { const int rr = row0 + t + tap - 2;
                if (rr >= seq_lo && rr < seq_hi) { const v4u x = *(const v4u*)(P + (size_t)rr * PLD + PC_DQ + ch);
                    const f32x4 w0 = *(const f32x4*)(cw + tap * 768 + ch), w1 = *(const f32x4*)(cw + tap * 768 + ch + 4);
                    acc[0] += bf_lo(x.x) * w0[0]; acc[1] += bf_hi(x.x) * w0[1]; acc[2] += bf_lo(x.y) * w0[2]; acc[3] += bf_hi(x.y) * w0[3];
                    acc[4] += bf_lo(x.z) * w1[0]; acc[5] += bf_hi(x.z) * w1[1]; acc[6] += bf_lo(x.w) * w1[2]; acc[7] += bf_hi(x.w) * w1[3]; } }
            float ss = 0.f;
#pragma unroll
            for (int i = 0; i < 8; ++i) { acc[i] = siluf_(acc[i]); ss += acc[i] * acc[i]; }
            float sc = 1.f;
            if (p < 2) { ss += __shfl_xor(ss, 1); ss += __shfl_xor(ss, 2); ss += __shfl_xor(ss, 4); sc = (1.f / sqrtf(ss + EPSN)) * (p == 0 ? 0.125f : 1.f); }
            v4u o; o.x = cvtpk_c(acc[0] * sc, acc[1] * sc); o.y = cvtpk_c(acc[2] * sc, acc[3] * sc); o.z = cvtpk_c(acc[4] * sc, acc[5] * sc); o.w = cvtpk_c(acc[6] * sc, acc[7] * sc);
            if (p == 0) *(LAS v4u*)(QcB + t * RS + cg * 8) = o;
            else { if (p == 1) *(LAS v4u*)(KcB + t * RS + cg * 8) = o;
                LAS bf16* tp = (p == 1 ? KT : VT) + (cg * 8) * RS + t;
                tp[0 * RS] = (bf16)(o.x & 0xffffu); tp[1 * RS] = (bf16)(o.x >> 16); tp[2 * RS] = (bf16)(o.y & 0xffffu); tp[3 * RS] = (bf16)(o.y >> 16);
                tp[4 * RS] = (bf16)(o.z & 0xffffu); tp[5 * RS] = (bf16)(o.z >> 16); tp[6 * RS] = (bf16)(o.w & 0xffffu); tp[7 * RS] = (bf16)(o.w >> 16); }
        }
        if (wv < 2) { const int d = wv; const float* gb = GB + (size_t)(row0 + ln) * 16; const float g = gb[d * 4 + h]; Bs[d * 64 + ln] = gb[8 + d * 4 + h];
            float pf = g;
#pragma unroll
            for (int o = 1; o < 64; o <<= 1) { const float v = __shfl_up(pf, o); if (ln >= o) pf += v; }
            const float tot = __shfl(pf, 63);
            Gs[d * 64 + ln] = d == 0 ? pf : tot - pf + g; }
    }
    __syncthreads();
    {
#pragma unroll
        for (int i = 0; i < 2; ++i) { const int tile = wv * 2 + i, m0 = (tile >> 2) * 16, n0 = (tile & 3) * 16;
            const f32x4 kk = mm_img(KcB, KcB, m0, n0, r, q), qk = mm_img(QcB, KcB, m0, n0, r, q);
            const int s = n0 + r; const float g0s = Gs[s], g1s = Gs[64 + s];
#pragma unroll
            for (int g = 0; g < 4; ++g) { const int t = m0 + 4 * q + g; const float e0 = __expf(Gs[t] - g0s), e1 = __expf(Gs[64 + t] - g1s);
                const float a0 = (s < t) ? Bs[t] * kk[g] * e0 : 0.f, a1 = (s > t) ? Bs[64 + t] * kk[g] * e1 : 0.f;
                DIMG(0, 0)[t * RS + s] = (bf16)f2bf(a0); DIMG(1, 0)[t * RS + s] = (bf16)f2bf(a1);
                DIMG(0, 1)[t * RS + s] = (bf16)f2bf((s <= t) ? qk[g] * e0 : 0.f); DIMG(1, 1)[t * RS + s] = (bf16)f2bf((s >= t) ? qk[g] * e1 : 0.f);
                if (m0 == n0) { Dg[(m0 >> 4) * 256 + (t & 15) * 16 + r] = a0; Dg[1024 + (m0 >> 4) * 256 + (t & 15) * 16 + r] = a1; } } }
        { const int c = tid >> 3, t0 = (tid & 7) * 8; const v4u kx = *(const LAS v4u*)(KT + c * RS + t0); const float gl0 = Gs[63], gl1 = Gs[64];
          const float kf[8] = {bf_lo(kx.x), bf_hi(kx.x), bf_lo(kx.y), bf_hi(kx.y), bf_lo(kx.z), bf_hi(kx.z), bf_lo(kx.w), bf_hi(kx.w)};
          float s0[8], s1[8];
#pragma unroll
          for (int j = 0; j < 8; ++j) { s0[j] = kf[j] * __expf(gl0 - Gs[t0 + j]); s1[j] = kf[j] * __expf(gl1 - Gs[64 + t0 + j]); }
          v4u o0, o1; o0.x = cvtpk_c(s0[0], s0[1]); o0.y = cvtpk_c(s0[2], s0[3]); o0.z = cvtpk_c(s0[4], s0[5]); o0.w = cvtpk_c(s0[6], s0[7]);
          o1.x = cvtpk_c(s1[0], s1[1]); o1.y = cvtpk_c(s1[2], s1[3]); o1.z = cvtpk_c(s1[4], s1[5]); o1.w = cvtpk_c(s1[6], s1[7]);
          *(LAS v4u*)(DIMG(0, 4) + c * RS + t0) = o0; *(LAS v4u*)(DIMG(1, 4) + c * RS + t0) = o1; }
    }
    __syncthreads();
    if (wv == 0) dn_diag_inv<0>(Dg, ln); else if (wv == 4) dn_diag_inv<1>(Dg + 1024, ln);
    __syncthreads();
    if (wv < 4) dn_solve_tiles<0>(DIMG(0, 0), Dg, VT, KT, DIMG(0, 3), DIMG(0, 2), Bs, Gs, wv & 3, ln);
    else dn_solve_tiles<1>(DIMG(1, 0), Dg + 1024, VT, KT, DIMG(1, 3), DIMG(1, 2), Bs + 64, Gs + 64, wv & 3, ln);
    __syncthreads();
    {
        const int d = wv >> 2, mt = wv & 3;
        const LAS bf16* Aq = DIMG(d, 1); const LAS bf16* WT = DIMG(d, 2); const LAS bf16* UT = DIMG(d, 3); const LAS bf16* KsT = DIMG(d, 4); const LAS float* Gd = Gs + d * 64;
        const float glast = d == 0 ? Gd[63] : Gd[0];
        const size_t prob = (((size_t)b * NCHUNK + n) * 4 + h) * 2 + d;
        unsigned char* out = F.ws + WS_DNP + prob * 32768;
        if (ln == 0 && mt == 0) ((float*)(F.ws + WS_DNG))[prob] = __expf(glast);
        const float gq = __expf(Gd[16 * mt + r]);
#pragma unroll
        for (int ks = 0; ks < 2; ++ks) {
            const f32x4 y0 = mm_img(WT, Aq, 32 * ks, 16 * mt, r, q), y1 = mm_img(WT, Aq, 32 * ks + 16, 16 * mt, r, q);
            const LAS bf16* qp = QcB + (16 * mt + r) * RS + 32 * ks + 4 * q; const v2u qa = *(const LAS v2u*)qp, qb = *(const LAS v2u*)(qp + 16);
            v4u o; o.x = cvtpk_c(gq * bf_lo(qa.x) - y0[0], gq * bf_hi(qa.x) - y0[1]); o.y = cvtpk_c(gq * bf_lo(qa.y) - y0[2], gq * bf_hi(qa.y) - y0[3]);
            o.z = cvtpk_c(gq * bf_lo(qb.x) - y1[0], gq * bf_hi(qb.x) - y1[1]); o.w = cvtpk_c(gq * bf_lo(qb.y) - y1[2], gq * bf_hi(qb.y) - y1[3]);
            *(v4u*)(out + (mt * 2 + ks) * 1024 + ln * 16) = o;
            const f32x4 c0 = mm_img(WT, KsT, 32 * ks, 16 * mt, r, q), c1 = mm_img(WT, KsT, 32 * ks + 16, 16 * mt, r, q);
            v4u oc; oc.x = cvtpk_c(-c0[0], -c0[1]); oc.y = cvtpk_c(-c0[2], -c0[3]); oc.z = cvtpk_c(-c1[0], -c1[1]); oc.w = cvtpk_c(-c1[2], -c1[3]);
            *(v4u*)(out + 8192 + (mt * 2 + ks) * 1024 + ln * 16) = oc; }
#pragma unroll
        for (int nt = 0; nt < 4; ++nt) { const f32x4 rr = mm_img(Aq, UT, 16 * mt, 16 * nt, r, q), bb = mm_img(KsT, UT, 16 * mt, 16 * nt, r, q);
            v2u o; o.x = cvtpk_c(rr[0], rr[1]); o.y = cvtpk_c(rr[2], rr[3]); *(v2u*)(out + 16384 + (mt * 4 + nt) * 512 + ln * 8) = o;
            v2u ob; ob.x = cvtpk_c(bb[0], bb[1]); ob.y = cvtpk_c(bb[2], bb[3]); *(v2u*)(out + 24576 + (mt * 4 + nt) * 512 + ln * 8) = ob; }
    }
    __syncthreads();
#ifdef DBG_DN
    { unsigned char* out = F.ws + WS_DNP + ((((size_t)b * NCHUNK + n) * 4 + h) * 2) * 32768;
      if (DBG_DN < 14) { const LAS bf16* im = (const LAS bf16*)(F.lds + DBG_DN * IMG);
          for (int e = tid; e < 4096; e += NTHR) ((bf16*)out)[e] = im[(e >> 6) * RS + (e & 63)]; }
      else { for (int e = tid; e < 2304; e += NTHR) ((bf16*)out)[e] = (bf16)f2bf(Gs[e]); for (int e = 2304 + tid; e < 4096; e += NTHR) ((bf16*)out)[e] = 0; } }
    __syncthreads();
#endif
#undef DIMG
}

__device__ __forceinline__ void pool_unit(Frame& F, const Args& A, int l, int blk, int g) {
    LAS float* Uw = (LAS float*)F.lds;
    LAS float* Mm = Uw + 80 * DP;
    LAS float* PW = Mm + 64 * DP;
    const bf16* P = (const bf16*)(F.ws + WS_PROJ); bf16* PO = (bf16*)(F.ws + WS_POOLO);
    int tid = threadIdx.x; asm volatile("" : "+v"(tid));
    const int row0 = blk * 64, b = row0 / RPB, j0 = row0 - b * RPB; const bool isctx = j0 < CTXL;
    const int seq_lo = isctx ? b * RPB : b * RPB + CTXL, L = isctx ? CTXL : SEQ; const int pos0 = row0 - seq_lo;
    for (int idx = tid; idx < 640; idx += NTHR) { const int rr = idx >> 3, c8 = (idx & 7) * 8; const int pos = pos0 - 8 + rr;
        float v[8] = {0, 0, 0, 0, 0, 0, 0, 0};
        if (pos >= 0 && pos < L) { const v4u x = *(const v4u*)(P + (size_t)(seq_lo + pos) * PLD + PC_POOL + g * 64 + c8);
            v[0] = bf_lo(x.x); v[1] = bf_hi(x.x); v[2] = bf_lo(x.y); v[3] = bf_hi(x.y); v[4] = bf_lo(x.z); v[5] = bf_hi(x.z); v[6] = bf_lo(x.w); v[7] = bf_hi(x.w); }
#pragma unroll
        for (int i = 0; i < 8; ++i) Uw[rr * DP + c8 + i] = v[i]; }
    { const float* pw = A.in[F.zz + 15] + ((size_t)l * 4 + g) * 4096;
#pragma unroll
      for (int k = 0; k < 8; ++k) { const int e = tid + 512 * k; PW[(e >> 6) * DP + (e & 63)] = pw[e]; } }
    __syncthreads();
    const int win = 2 << g;
#pragma unroll 1
    for (int k = 0; k < 8; ++k) { const int e = tid + 512 * k, t = e >> 6, i = e & 63; const int pos = pos0 + t;
        int lo = pos - win / 2, hi = lo + win; lo = lo < 0 ? 0 : lo; hi = hi > L ? L : hi;
        float s = 0.f;
#pragma unroll 4
        for (int p = lo; p < hi; ++p) s += Uw[(p - pos0 + 8) * DP + i];
        Mm[t * DP + i] = s / (float)(hi - lo) - Uw[(t + 8) * DP + i]; }
    __syncthreads();
    const float* psc = A.in[F.zz + 16] + l * 256 + g * 64;
    { const int wv = tid >> 6, ln = tid & 63, r = ln & 15, q = ln >> 4;
#pragma unroll
      for (int i = 0; i < 2; ++i) { const int tile = wv * 2 + i, m0 = (tile >> 2) * 16, n0 = (tile & 3) * 16;
          const f32x4 y = mm_tile(Mm, DP, 1, PW, DP, 1, m0, n0, ln); const float sc = psc[n0 + r];
#pragma unroll
          for (int gg = 0; gg < 4; ++gg) PO[(size_t)(row0 + m0 + 4 * q + gg) * 256 + g * 64 + n0 + r] = (bf16)f2bf(y[gg] * sc); } }
    __syncthreads();
}

constexpr int SC_SLOT = 32768, SC_NSLOT = 4, SC_ST = SC_SLOT * SC_NSLOT, SC_GL = SC_ST + 2 * 8192;
__device__ __forceinline__ void dn_scan_item(Frame& F, int item) {
    typedef short s16x8v __attribute__((ext_vector_type(8)));
    const int d = item & 1, h = (item >> 1) & 3, b = item >> 3;
    int tid = threadIdx.x; asm volatile("" : "+v"(tid));
    const int wv = __builtin_amdgcn_readfirstlane(tid >> 6), ln = tid & 63, r = ln & 15, q = ln >> 4;
    LAS unsigned char* L = F.lds;
    LAS float* glv = (LAS float*)(L + SC_GL);
    const unsigned char* dnp = F.ws + WS_DNP;
#define SC_N(st) (d == 0 ? (st) : ((st) < 4 ? 3 - (st) : 71 - (st)))
#define SC_PROB(st) ((((size_t)b * NCHUNK + SC_N(st)) * 4 + h) * 2 + d)
    if (tid < NCHUNK) glv[tid] = ((const float*)(F.ws + WS_DNG))[SC_PROB(tid)];
    for (int e = tid; e < 2 * 8192 / 16; e += NTHR) ((LAS v4u*)(L + SC_ST))[e] = (v4u){0u, 0u, 0u, 0u};
    asm volatile("s_waitcnt vmcnt(0) lgkmcnt(0)" ::: "memory"); __builtin_amdgcn_s_barrier();
#define SC_DMA(st, slot) do { const unsigned char* src_ = dnp + SC_PROB(st) * 32768 + wv * 8192 + ln * 16; \
        _Pragma("unroll") for (int i_ = 0; i_ < 8; ++i_) __builtin_amdgcn_global_load_lds((const unsigned*)(src_ + i_ * 1024), (LAS unsigned*)(L + (slot) * SC_SLOT + wv * 8192 + i_ * 1024), 16, 0, 0); } while (0)
    if (wv < 4) { SC_DMA(0, 0); SC_DMA(1, 1); SC_DMA(2, 2); }
    f32x4 s0 = {0.f, 0.f, 0.f, 0.f}, s1 = s0, s2 = s0, s3 = s0;
    bf16* DNO = (bf16*)(F.ws + WS_DNO) + (size_t)d * MROWS * 256;
#pragma unroll 1
    for (int st = 0; st < NCHUNK; ++st) {
        if (wv < 4) asm volatile("s_waitcnt vmcnt(16)" ::: "memory");
        asm volatile("s_waitcnt lgkmcnt(0)" ::: "memory"); __builtin_amdgcn_s_barrier();
        if (wv < 4) { const int nx = st + 3 < NCHUNK ? st + 3 : NCHUNK - 1; SC_DMA(nx, (st + 3) & 3); }
        const LAS unsigned char* slot = L + (st & 3) * SC_SLOT;
        const LAS unsigned char* stc = L + SC_ST + (st & 1) * 8192; LAS unsigned char* stn = L + SC_ST + ((st + 1) & 1) * 8192;
        const int nt = wv & 3;
        const s16x8v bf0 = *(const LAS s16x8v*)(stc + (nt * 2 + 0) * 1024 + ln * 16), bf1 = *(const LAS s16x8v*)(stc + (nt * 2 + 1) * 1024 + ln * 16);
        if (wv < 4) {
            const float gl = glv[st];
            const LAS unsigned char* cf = slot + 8192; const LAS unsigned char* bi = slot + 24576;
#define SC_ST_TILE(S, mt) do { const v2u bw_ = *(const LAS v2u*)(bi + ((mt) * 4 + nt) * 512 + ln * 8); \
            f32x4 a_ = {gl * S[0] + bf_lo(bw_.x), gl * S[1] + bf_hi(bw_.x), gl * S[2] + bf_lo(bw_.y), gl * S[3] + bf_hi(bw_.y)}; \
            a_ = __builtin_amdgcn_mfma_f32_16x16x32_bf16(*(const LAS s16x8v*)(cf + ((mt) * 2 + 0) * 1024 + ln * 16), bf0, a_, 0, 0, 0); \
            a_ = __builtin_amdgcn_mfma_f32_16x16x32_bf16(*(const LAS s16x8v*)(cf + ((mt) * 2 + 1) * 1024 + ln * 16), bf1, a_, 0, 0, 0); S = a_; } while (0)
            SC_ST_TILE(s0, 0); SC_ST_TILE(s1, 1); SC_ST_TILE(s2, 2); SC_ST_TILE(s3, 3);
#undef SC_ST_TILE
            v4u w0, w1; w0.x = pk2(s0[0], s0[1]); w0.y = pk2(s0[2], s0[3]); w0.z = pk2(s1[0], s1[1]); w0.w = pk2(s1[2], s1[3]);
            w1.x = pk2(s2[0], s2[1]); w1.y = pk2(s2[2], s2[3]); w1.z = pk2(s3[0], s3[1]); w1.w = pk2(s3[2], s3[3]);
            *(LAS v4u*)(stn + (nt * 2 + 0) * 1024 + ln * 16) = w0; *(LAS v4u*)(stn + (nt * 2 + 1) * 1024 + ln * 16) = w1;
        } else {
            const LAS unsigned char* pf = slot; const LAS unsigned char* ri = slot + 16384;
            const int n = SC_N(st);
            bf16* orow = DNO + (size_t)(b * RPB + n * 64 + 4 * q) * 256 + h * 64 + nt * 16 + r;
#pragma unroll
            for (int mt = 0; mt < 4; ++mt) { const v2u rw_ = *(const LAS v2u*)(ri + (mt * 4 + nt) * 512 + ln * 8);
                f32x4 a_ = {bf_lo(rw_.x), bf_hi(rw_.x), bf_lo(rw_.y), bf_hi(rw_.y)};
                a_ = __builtin_amdgcn_mfma_f32_16x16x32_bf16(*(const LAS s16x8v*)(pf + (mt * 2 + 0) * 1024 + ln * 16), bf0, a_, 0, 0, 0);
                a_ = __builtin_amdgcn_mfma_f32_16x16x32_bf16(*(const LAS s16x8v*)(pf + (mt * 2 + 1) * 1024 + ln * 16), bf1, a_, 0, 0, 0);
#pragma unroll
                for (int g = 0; g < 4; ++g) orow[(size_t)(16 * mt + g) * 256] = (bf16)f2bf(a_[g]); }
        }
    }
    asm volatile("s_waitcnt vmcnt(0) lgkmcnt(0)" ::: "memory"); __builtin_amdgcn_s_barrier();
#undef SC_DMA
#undef SC_N
#undef SC_PROB
}

__device__ __forceinline__ void mix_build(Frame& F, const Args& A, int l) {
    int lane = threadIdx.x & 63; asm volatile("" : "+v"(lane)); const int gw = F.vcu * NWAVES + F.wave, NGW = F.G * NWAVES;
    const bf16* ATTO = (const bf16*)(F.ws + WS_ATTO); const bf16* P = (const bf16*)(F.ws + WS_PROJ); const bf16* DNO = (const bf16*)(F.ws + WS_DNO); bf16* MIX = (bf16*)(F.ws + WS_MIX);
    const float lam = ((const float*)(F.ws + WS_LAM))[l]; const float li = 0.8f - 0.6f * expf(-0.3f * (float)l);
    const float* sg = A.in[F.zz + 10] + l * 128; const float* ng = A.in[F.zz + 14] + l * 64;
    for (int R = gw; R < MROWS; R += NGW) {
        const int j = R % RPB; if (l == 1 && j < CTXL) continue;
        { const int hh = lane >> 4, e0 = (lane & 15) * 8;
          const v4u a = *(const v4u*)(ATTO + (size_t)R * DM + (hh * 2) * 128 + e0), c = *(const v4u*)(ATTO + (size_t)R * DM + (hh * 2 + 1) * 128 + e0);
          float x[8] = {bf_lo(a.x) - lam * bf_lo(c.x), bf_hi(a.x) - lam * bf_hi(c.x), bf_lo(a.y) - lam * bf_lo(c.y), bf_hi(a.y) - lam * bf_hi(c.y),
                        bf_lo(a.z) - lam * bf_lo(c.z), bf_hi(a.z) - lam * bf_hi(c.z), bf_lo(a.w) - lam * bf_lo(c.w), bf_hi(a.w) - lam * bf_hi(c.w)};
          float ss = 0.f;
#pragma unroll
          for (int i = 0; i < 8; ++i) ss += x[i] * x[i];
          ss += __shfl_xor(ss, 1); ss += __shfl_xor(ss, 2); ss += __shfl_xor(ss, 4); ss += __shfl_xor(ss, 8);
          const float sc = (1.f / sqrtf(ss * (1.f / 128.f) + EPSN)) * (1.f - li);
          const f32x4 g0 = *(const f32x4*)(sg + e0), g1 = *(const f32x4*)(sg + e0 + 4);
          v4u o; o.x = pk2(x[0] * sc * g0[0], x[1] * sc * g0[1]); o.y = pk2(x[2] * sc * g0[2], x[3] * sc * g0[3]); o.z = pk2(x[4] * sc * g1[0], x[5] * sc * g1[1]); o.w = pk2(x[6] * sc * g1[2], x[7] * sc * g1[3]);
          *(v4u*)(MIX + (size_t)R * DM + hh * 128 + e0) = o; }
        { const int c0 = lane * 4;
          const v2u a = *(const v2u*)(DNO + (size_t)R * 256 + c0), c = *(const v2u*)(DNO + ((size_t)MROWS + R) * 256 + c0), z = *(const v2u*)(P + (size_t)R * PLD + PC_DZ + c0);
          float x[4] = {bf_lo(a.x) + bf_lo(c.x), bf_hi(a.x) + bf_hi(c.x), bf_lo(a.y) + bf_lo(c.y), bf_hi(a.y) + bf_hi(c.y)};
          float ss = x[0] * x[0] + x[1] * x[1] + x[2] * x[2] + x[3] * x[3];
          ss += __shfl_xor(ss, 1); ss += __shfl_xor(ss, 2); ss += __shfl_xor(ss, 4); ss += __shfl_xor(ss, 8);
          const float sc = 1.f / sqrtf(ss * (1.f / 64.f) + EPSN);
          const f32x4 gg = *(const f32x4*)(ng + (c0 & 63));
          v2u o; o.x = pk2(x[0] * sc * gg[0] * siluf_(bf_lo(z.x)), x[1] * sc * gg[1] * siluf_(bf_hi(z.x))); o.y = pk2(x[2] * sc * gg[2] * siluf_(bf_lo(z.y)), x[3] * sc * gg[3] * siluf_(bf_hi(z.y)));
          *(v2u*)(MIX + (size_t)R * DM + 512 + c0) = o; }
    }
}

#ifndef MK_N_LAUNCHES
#define MK_N_LAUNCHES 1
#endif
__global__ void __launch_bounds__(NTHR, 2) mk_fwd(Args args) {
    extern __shared__ __attribute__((aligned(16))) unsigned char lds[];
    Frame F;
    F.lds = (LAS unsigned char*)lds;
    F.MISC = (volatile LAS unsigned*)(F.lds + MISC_OFF);
    F.tid = threadIdx.x; F.lane = F.tid & 63; F.wave = __builtin_amdgcn_readfirstlane(F.tid >> 6);
    F.G = gridDim.x; { const int bx = blockIdx.x; F.vcu = (F.G % 8 == 0) ? (bx % 8) * (F.G / 8) + bx / 8 : bx; }
    F.ws = args.ws; F.out = args.out; F.zz = 0;
    F.ctl = (gu32*)(args.ws + WS_CTL);
    for (int u = F.tid; u < (LDS_BYTES - MISC_OFF) / 4; u += NTHR) ((LAS unsigned*)(F.lds + MISC_OFF))[u] = 0u;
    __syncthreads();
    const int lo = args.ph_lo, hi = args.ph_hi;
    const bool use_bar = (hi - lo) > 1;
    XcdBarrier bar; bar.bar = ((unsigned*)(F.ctl + CW_BAR) + args.bar_li * XCD_BAR_WORDS); bar.x = 0; bar.st = nullptr;
    if (use_bar) bar = xcd_barrier_post(((unsigned*)(F.ctl + CW_BAR) + args.bar_li * XCD_BAR_WORDS), F.MISC + 8);
#ifndef EN_MASK
#define EN_MASK 0xFFFFFFFFu
#endif
#define IN(k) (((EN_MASK >> ((k) > 12 ? (k) - 12 : (k))) & 1u) && lo <= (k) && (k) < hi)
#define PB() do { int z_ = 0; asm volatile("" : "+s"(z_)); F.ws = args.ws + z_; F.ctl = (gu32*)(args.ws + z_); F.zz = z_; int t_ = threadIdx.x; asm volatile("" : "+v"(t_)); F.tid = t_; F.lane = t_ & 63; F.wave = __builtin_amdgcn_readfirstlane(t_ >> 6); } while (0)
#ifdef DBG_DUP
#define NREP(k) ((((k) > 12 && (k) < 23) ? (k) - 12 : (k)) == DBG_DUP ? 2 : 1)
#else
#define NREP(k) 1
#endif
#define SEAMX() do { XcdBarrier bl_ = bar; { int z_ = 0; unsigned x_ = bar.x; asm volatile("" : "+s"(z_), "+s"(x_)); bl_.bar = (unsigned*)(args.ws + WS_CTL) + CW_BAR + args.bar_li * XCD_BAR_WORDS + z_; bl_.x = x_; } xcd_barrier(bl_); } while (0)
#define PH_BEGIN(k) if (IN(k)) { for (int rep_ = 0; rep_ < NREP(k); ++rep_) { if (rep_) SEAMX(); PB();
#define PH_END(k) } } SEAM(k);
#define SEAM(k) do { if (IN(k) && IN((k) + 1)) { XcdBarrier bl_ = bar; { int z_ = 0; unsigned x_ = bar.x; asm volatile("" : "+s"(z_), "+s"(x_)); bl_.bar = (unsigned*)(args.ws + WS_CTL) + CW_BAR + args.bar_li * XCD_BAR_WORDS + z_; bl_.x = x_; } xcd_barrier(bl_); } } while (0)
    char* ldsg = (char*)lds;

    PH_BEGIN(PH_PRO) p0_prologue(F, args); PH_END(PH_PRO)

#pragma unroll 1
    for (int l = 0; l < 2; ++l) {
        const int pb = 1 + 12 * l;
        const float* modl = (const float*)(F.ws + WS_MOD) + l * 5 * 6144;
        PH_BEGIN(pb + PH_N1) norm_mod_phase(F, args, l, 0, false, false); PH_END(pb + PH_N1)
        PH_BEGIN(pb + PH_PROJ)
            { pg8::Gemm g{(const bf16*)(F.ws + WS_U), (const bf16*)(F.ws + WS_WIN) + (size_t)l * NPB * 1024, 1024, 1024, 1024, 0, 0};
              TileOrder S; S.init(MROWS / 256, NPB / 256, F.G, (int)blockIdx.x, 0);
              EpiProj E{(bf16*)(F.ws + WS_PROJ), (const float*)(F.ws + WS_ROPE)};
              pg8::gemm_phase<EpiProj, TileOrder, true, true>(F.lds, g, S, E); }
            { pg8::Gemm g{(const bf16*)(F.ws + WS_U8), (const bf16*)(F.ws + WS_WG8 + (size_t)l * 3072 * 1024), 512, 512, 512, E8(F8_ACT_L2), E8(F8_W13_L2)};
              TileOrder S; S.init(MROWS / 256, 12, F.G, (int)blockIdx.x, 0);
              EpiGate E{(bf16*)(F.ws + WS_PROJ)};
              pg8::gemm_phase8<EpiGate, TileOrder, true, true>(F.lds, g, S, E); }
            ab_tiles(F, args, l);
        PH_END(pb + PH_PROJ)
        PH_BEGIN(pb + PH_ATT)
            const bf16* P = (const bf16*)(F.ws + WS_PROJ); bf16* AO = (bf16*)(F.ws + WS_ATTO);
            const int nunits = 512 + (l == 0 ? 32 : 0);
#ifndef DIS_ATTN
#ifdef DBG_DUP
            for (int r2_ = 0; r2_ < (DBG_DUP == 31 ? 2 : 1); ++r2_)
#endif
#pragma unroll 1
            for (int u = F.vcu; u < nunits; u += F.G) {
                int b, hm, qrow, seq;
                if (u < 512) { b = u >> 7; hm = (u >> 4) & 7; qrow = CTXL + (u & 15) * 256; seq = RPB; }
                else { const int v = u - 512; b = v >> 3; hm = v & 7; qrow = 0; seq = CTXL; }
                const size_t r0 = (size_t)b * RPB;
                attn::attn_unit<PLD, DM>(P + (r0 + qrow) * PLD + PC_AQ + hm * 64, P + r0 * PLD + PC_AK + hm * 64, P + r0 * PLD + PC_AV + (hm >> 1) * 128,
                                           AO + (r0 + qrow) * DM + hm * 128, seq, ldsg);
            }
#endif
#ifndef DIS_DNPRE
#ifdef DBG_DUP
            for (int r2_ = 0; r2_ < (DBG_DUP == 32 ? 2 : 1); ++r2_)
#endif
#pragma unroll 1
            for (int u = F.vcu; u < NB * NCHUNK * 4; u += F.G) { const int h = u & 3, n = (u >> 2) % NCHUNK, b = (u >> 2) / NCHUNK; dn_pre_unit(F, args, l, b, n, h); }
#endif
        PH_END(pb + PH_ATT)
        PH_BEGIN(pb + PH_SCAN)
#pragma unroll 1
            for (int it = F.vcu; it < 32; it += F.G) dn_scan_item(F, it);
            { const bool many = F.G > 32; const int rk = many ? F.vcu - 32 : F.vcu, nr = many ? F.G - 32 : F.G;
              if (rk >= 0) {
#pragma unroll 1
                for (int u = rk; u < (MROWS / 64) * 4; u += nr) pool_unit(F, args, l, u >> 2, u & 3);
                if (l == 0) conv_layer_weights(F, args, 1, rk * NWAVES + F.wave, nr * NWAVES);
                else moe_convert(F, args, rk * NWAVES + F.wave, nr * NWAVES); } }
        PH_END(pb + PH_SCAN)
        PH_BEGIN(pb + PH_MIXB) mix_build(F, args, l); PH_END(pb + PH_MIXB)
#pragma unroll 1
        for (int s = 0; s < 3; ++s) {
            if (IN(pb + PH_MRG0 + s)) { PB();
                const int koff = s == 0 ? 0 : (s == 1 ? 512 : 768), ks = s == 0 ? 512 : 256;
                pg8::Gemm g{s == 2 ? (const bf16*)(F.ws + WS_POOLO) : (const bf16*)(F.ws + WS_MIX) + koff, (const bf16*)(F.ws + WS_WBR) + (size_t)l * 1024 * 1024 + (size_t)1024 * koff, ks, s == 2 ? 256 : 1024, ks};
                TileOrder S; S.init(l == 0 ? 68 : 64, 4, F.G, (int)blockIdx.x, l);
                EpiMerge E{(bf16*)(F.ws + WS_MG), (const bf16*)(F.ws + WS_PROJ), PC_GATE + s * 1024, s == 0};
                pg8::gemm_phase<EpiMerge, TileOrder, true, true>(F.lds, g, S, E);
            }
            if (s < 2) { if (IN(pb + PH_MRG0 + s)) { PB(); VM_WAIT(); __syncthreads(); } } else SEAM(pb + PH_MRG2);
        }
        if (IN(pb + PH_OUT)) { PB();
            pg8::Gemm g{(const bf16*)(F.ws + WS_MG), (const bf16*)(F.ws + WS_WOUT) + (size_t)l * 1024 * 1024, 1024, 1024, 1024};
            TileOrder S; S.init(l == 0 ? 68 : 64, 4, F.G, (int)blockIdx.x, l);
            EpiResid E{(float*)(F.ws + WS_H), modl, 2};
            pg8::gemm_phase<EpiResid, TileOrder, true, true>(F.lds, g, S, E);
        } SEAM(pb + PH_OUT);
#ifdef DENSE_F8
        PH_BEGIN(pb + PH_N2) norm_mod_phase(F, args, l, 1, l == 1, l == 1, l == 0); PH_END(pb + PH_N2)
#else
        PH_BEGIN(pb + PH_N2) if (l == 0) norm_mod_phase(F, args, 0, 1, false, false); else norm2_route_phase(F, args); PH_END(pb + PH_N2)
#endif
        if (l == 0) {
#ifdef DENSE_F8
            PH_BEGIN(PH_FUP)
                pg8::Gemm g{(const bf16*)(F.ws + WS_U), (const bf16*)(F.ws + WS_W13), 512, 512, 512, E8(F8_ACT_L2), E8(F8_W13_L2)};
                TileOrder S; S.init(68, 2 * FFD / 256, F.G, (int)blockIdx.x, 0);
                EpiSwiglu8 E{F.ws + WS_HID, FFD};
                pg8::gemm_phase8<EpiSwiglu8, TileOrder, true, true>(F.lds, g, S, E);
            PH_END(PH_FUP)
            if (IN(PH_FDN)) { PB();
                pg8::Gemm g{(const bf16*)(F.ws + WS_HID), (const bf16*)(F.ws + WS_W2), FFD / 2, FFD / 2, FFD / 2, E8(F8_ACT_L2), E8(F8_W2_L2)};
                TileOrder S; S.init(68, 4, F.G, (int)blockIdx.x, 0);
                EpiResid E{(float*)(F.ws + WS_H), modl, 5};
                pg8::gemm_phase8<EpiResid, TileOrder, true, true>(F.lds, g, S, E);
            } SEAM(PH_FDN);
#else
            PH_BEGIN(PH_FUP)
                pg8::Gemm g{(const bf16*)(F.ws + WS_U), (const bf16*)(F.ws + WS_W13), 1024, 1024, 1024};
                TileOrder S; S.init(68, 2 * FFD / 256, F.G, (int)blockIdx.x, 0);
                EpiSwiglu E{(bf16*)(F.ws + WS_HID), FFD};
                pg8::gemm_phase<EpiSwiglu, TileOrder, true, true>(F.lds, g, S, E);
            PH_END(PH_FUP)
            if (IN(PH_FDN)) { PB();
                pg8::Gemm g{(const bf16*)(F.ws + WS_HID), (const bf16*)(F.ws + WS_W2), FFD, FFD, FFD};
                TileOrder S; S.init(68, 4, F.G, (int)blockIdx.x, 0);
                EpiResid E{(float*)(F.ws + WS_H), modl, 5};
                pg8::gemm_phase<EpiResid, TileOrder, true, true>(F.lds, g, S, E);
            } SEAM(PH_FDN);
#endif
        }
    }
    PH_BEGIN(PH_GATH) moe_gather(F); PH_END(PH_GATH)
#pragma unroll 1
    for (int hh = 0; hh < 1; ++hh) {
        const int p0 = PH_CV0 + 3 * hh;
        PH_BEGIN(p0 + 1)
            pg8::Gemm g{(const bf16*)(F.ws + WS_XG), (const bf16*)(F.ws + WS_W13M), 512, 512, 512, E8(F8_ACT_L2), E8(F8_W13_L2)};
            MoeOrder S; S.init(F.ctl + CW_ECNT, 2 * FFE / 256, F.G, F.vcu);
            EpiSwiglu8 E{F.ws + WS_HIDM, FFE};
            pg8::gemm_phase8<EpiSwiglu8, MoeOrder, true, true>(F.lds, g, S, E);
        PH_END(p0 + 1)
        if (IN(p0 + 2)) { PB();
            pg8::Gemm g{(const bf16*)(F.ws + WS_HIDM), (const bf16*)(F.ws + WS_W2M), FFE / 2, FFE / 2, FFE / 2, E8(F8_ACT_L2), E8(F8_W2_L2)};
            MoeOrder S; S.init(F.ctl + CW_ECNT, 4, F.G, F.vcu);
            EpiY E{(bf16*)(F.ws + WS_Y), 1};
            pg8::gemm_phase8<EpiY, MoeOrder, true, true>(F.lds, g, S, E);
        } SEAM(p0 + 2);
    }
    PH_BEGIN(PH_FIN) final_phase(F, args); } }
#ifdef DBG_STOP
    if (lo == 100) {
        const int gw = F.vcu * NWAVES + F.wave, NGW = F.G * NWAVES;
        for (int tk = gw; tk < NB * SEQ; tk += NGW) { const int b = tk / SEQ, t = tk - b * SEQ; const size_t R = (size_t)b * RPB + CTXL + t;
#if DBG_SRC == 0
            const f32x4* s = (const f32x4*)((const float*)(args.ws + WS_H) + R * DM) + F.lane; f32x4* d = (f32x4*)(args.out + (size_t)tk * DM) + F.lane;
            for (int q = 0; q < 4; ++q) d[64 * q] = s[64 * q];
#elif DBG_SRC == 2
            MoeOrder mo; mo.init((gu32*)args.ws + CW_ECNT, 1, 1, 0); const v4u rt = ((const v4u*)(args.ws + WS_ROUTE))[2 * tk];
            const size_t rr = (size_t)mo.tile_off((int)rt.x) * 256 + rt.z; (void)R;
            const bf16* s = (const bf16*)(args.ws + DBG_OFF) + rr * DBG_LD + DBG_COL; float* d = args.out + (size_t)tk * DM;
            for (int q = 0; q < 16; ++q) d[F.lane + 64 * q] = bf2f(s[F.lane + 64 * q]);
#else
#ifdef DBG_MOD
            const bf16* s = (const bf16*)(args.ws + DBG_OFF) + (R % DBG_MOD) * DBG_LD + DBG_COL; float* d = args.out + (size_t)tk * DM;
#else
            const bf16* s = (const bf16*)(args.ws + DBG_OFF) + R * DBG_LD + DBG_COL; float* d = args.out + (size_t)tk * DM;
#endif
            for (int q = 0; q < 16; ++q) { float v = bf2f(s[F.lane + 64 * q]); d[F.lane + 64 * q] = (v == v && fabsf(v) < 1e30f) ? v : DBG_NANVAL; }
#endif
        }
    }
#endif
#undef IN
#undef SEAM
}

extern "C" void kernel_launch(void* const* d_in, const int* in_sizes, int n_in, void* d_out, int out_size, void* d_ws, size_t ws_size, hipStream_t stream) {
    static int grid = 0;
    if (grid == 0) {
        if (n_in != 27 || in_sizes[0] != NB * SEQ * DM || out_size != NB * SEQ * DM || ws_size < WS_END) {
            fprintf(stderr, "kernel_launch: shape / workspace mismatch (n_in %d, in0 %d, out %d, ws %zu, need %zu); nothing launched\n", n_in, n_in > 0 ? in_sizes[0] : -1, out_size, ws_size, (size_t)WS_END); grid = -1; return; }
        int dev = 0, cus = 0, per_cu = 0;
        if (hipGetDevice(&dev) != hipSuccess || hipDeviceGetAttribute(&cus, hipDeviceAttributeMultiprocessorCount, dev) != hipSuccess) { grid = -1; return; }
        if (hipFuncSetAttribute((const void*)mk_fwd, hipFuncAttributeMaxDynamicSharedMemorySize, LDS_BYTES) != hipSuccess) { fprintf(stderr, "kernel_launch: hipFuncSetAttribute failed\n"); grid = -1; return; }
        if (hipOccupancyMaxActiveBlocksPerMultiprocessor(&per_cu, (const void*)mk_fwd, NTHR, LDS_BYTES) != hipSuccess || per_cu < 1)
            fprintf(stderr, "kernel_launch: note: occupancy query reports %d workgroups per CU\n", per_cu);
        (void)hipGetLastError();
        grid = cus;
    }
    if (grid < 0) return;
    if (hipMemsetAsync((char*)d_ws + WS_CTL, 0, CTL_ZERO_BYTES, stream) != hipSuccess) return;
    Args a{};
    for (int i = 0; i < 27; ++i) a.in[i] = (const float*)d_in[i];
    a.out = (float*)d_out; a.ws = (unsigned char*)d_ws;
    constexpr int NL = MK_N_LAUNCHES;
#ifdef DBG_STOP
    constexpr int NLL = DBG_STOP + 2;
#else
    constexpr int NLL = NL;
#endif
#ifdef DBG_PREFIX
    for (int li = 0; li < 2; ++li) { a.ph_lo = 0; a.ph_hi = li == 0 ? DBG_PREFIX + 1 : PH_COUNT; a.bar_li = li;
        hipLaunchKernelGGL(mk_fwd, dim3(grid), dim3(NTHR), LDS_BYTES, stream, a); }
    return;
#endif
    for (int li = 0; li < NLL; ++li) {
#ifdef DBG_SKIP_LO
        if (li >= DBG_SKIP_LO && li <= DBG_SKIP_HI) continue;
#endif
        a.ph_lo = (NL == 1) ? 0 : li; a.ph_hi = (NL == 1) ? PH_COUNT : li + 1;
#ifdef DBG_STOP
        a.ph_lo = li; a.ph_hi = li + 1;
        if (li == NLL - 1) { a.ph_lo = 100; a.ph_hi = 101; }
#endif
        hipLaunchKernelGGL(mk_fwd, dim3(grid), dim3(NTHR), LDS_BYTES, stream, a);
        const hipError_t le = hipPeekAtLastError();
        if (le != hipSuccess) { fprintf(stderr, "kernel_launch: launch %d failed: %s\n", li, hipGetErrorName(le)); break; }
    }
}
```

```cpp
#include <hip/hip_runtime.h>
#include <cstdio>
#include <cstdint>
#include <cmath>

namespace pg8 {
#define PG8_LAS __attribute__((address_space(3)))
typedef unsigned short bf16_t;
typedef short bf16x8 __attribute__((ext_vector_type(8)));
typedef float f32x4 __attribute__((ext_vector_type(4)));
typedef unsigned u32x4 __attribute__((ext_vector_type(4)));
typedef unsigned u32x2 __attribute__((ext_vector_type(2)));
constexpr int BM = 256, BK = 64, HALF = 128, HTB = HALF * BK * 2  , STAGE_BYTES = 8 * HTB;

__host__ __device__ __forceinline__ int lds_byte(int r, int c) { const int st = (r >> 4) * 2 + (c >> 5), rr = r & 15, cc = c & 31, ob = rr * 64 + cc * 2; return st * 1024 + (ob ^ (((ob >> 9) & 1) << 5)); }
__host__ __device__ __forceinline__ void stage_rc(int b, int& R, int& C) { const int st = b / 1024, sb = b % 1024, swz = sb ^ (((sb >> 9) & 1) << 5); R = (st >> 1) * 16 + swz / 64; C = (st & 1) * 32 + (swz % 64) / 2; }
__host__ __device__ __forceinline__ int perm32(int rho) { const int n = rho >> 4, i = rho & 15; return 8 * (i >> 2) + 4 * n + (i & 3); }

__device__ __forceinline__ int lane_id_asm() { int l; asm volatile("v_mbcnt_lo_u32_b32 %0, -1, 0\n\tv_mbcnt_hi_u32_b32 %0, -1, %0" : "=v"(l)); return l; }
__device__ __forceinline__ int tid_from(int wid) { return (wid << 6) | lane_id_asm(); }
struct Unit { int pm, pn, pb, ko, aux; };
struct Gemm { const bf16_t* A; const bf16_t* Bt; int K, lda, ldb, sA, sB, wid; };

__device__ __forceinline__ unsigned cvt_pk_bf16(float lo, float hi) { unsigned r; asm volatile("v_cvt_pk_bf16_f32 %0, %1, %2" : "=v"(r) : "v"(lo), "v"(hi)); return r; }
template <class Epi, class Sched, bool ALIGN_EPI = false, bool SP2 = false>
__device__ __forceinline__ void gemm_phase(PG8_LAS unsigned char* lds, const Gemm g, const Sched& S, const Epi& E) {
    const int wid = g.wid; const int tid = tid_from(wid), lane = tid & 63, wr = wid >> 2, wc = wid & 3, fr = lane & 15, fq = lane >> 4;
    const int K = g.K, nt = K / BK;
    unsigned voffA[2], voffB[2];
#pragma unroll
    for (int i = 0; i < 2; ++i) { int R, C; stage_rc(tid * 16 + i * 8192, R, C); const int Rb = Epi::PERM ? ((R & ~31) + perm32(R & 31)) : R;
        voffA[i] = (unsigned)(R * g.lda + C) * 2u; voffB[i] = (unsigned)(Rb * g.ldb + C) * 2u; }
    const size_t kstep = (size_t)(BK * 2);
    const size_t hstepA = (size_t)HALF * g.lda * 2, hstepB = (size_t)HALF * g.ldb * 2;
    const size_t tstepA = 2 * hstepA, tstepB = 2 * hstepB;
    const unsigned ldsw = (unsigned)wid * 1024u;
    const int aoff = lds_byte(wr * 64 + fr, fq * 8), boff = lds_byte(wc * 32 + fr, fq * 8);
#define PG8_SA(b, h) (((b) * 2 + (h)) * HTB)
#define PG8_SB(b, h) ((4 + (b) * 2 + (h)) * HTB)
#define PG8_STAGE(bufoff, gbase, voff) do { _Pragma("unroll") for (int _i = 0; _i < 2; ++_i) \
        __builtin_amdgcn_global_load_lds((const unsigned*)((const char*)(gbase) + (voff)[_i]), (PG8_LAS unsigned*)(lds + (bufoff) + ldsw + _i * 8192), 16, 0, 0); } while (0)
#define PG8_LDA(dst, b, h) do { _Pragma("unroll") for (int m = 0; m < 4; ++m) _Pragma("unroll") for (int k = 0; k < 2; ++k) dst[m][k] = *(const PG8_LAS bf16x8*)(lds + PG8_SA(b, h) + aoff + m * 2048 + k * 1024); } while (0)
#define PG8_LDB(dst, b, h) do { _Pragma("unroll") for (int n = 0; n < 2; ++n) _Pragma("unroll") for (int k = 0; k < 2; ++k) dst[n][k] = *(const PG8_LAS bf16x8*)(lds + PG8_SB(b, h) + boff + n * 2048 + k * 1024); } while (0)
#define PG8_MMA(ai, bj, At, Bt) do { __builtin_amdgcn_s_setprio(1); _Pragma("unroll") for (int m = 0; m < 4; ++m) _Pragma("unroll") for (int n = 0; n < 2; ++n) _Pragma("unroll") for (int k = 0; k < 2; ++k) \
        acc[ai][bj][m][n] = __builtin_amdgcn_mfma_f32_16x16x32_bf16(Bt[n][k], At[m][k], acc[ai][bj][m][n], 0, 0, 0); __builtin_amdgcn_s_setprio(0); } while (0)
#define PG8_WAIT_V(n) asm volatile("s_waitcnt vmcnt(" #n ")" ::: "memory")
#define PG8_WAIT_L(n) asm volatile("s_waitcnt lgkmcnt(" #n ")" ::: "memory")
#define PG8_BAR __builtin_amdgcn_s_barrier()
#define PG8_SCHED __builtin_amdgcn_sched_barrier(0)
    Unit cur, nxt; int ui = 0;
    if (!S.next(0, cur)) return;
    f32x4 acc[2][2][4][2];
#pragma unroll
    for (int a = 0; a < 2; ++a)
#pragma unroll
        for (int b = 0; b < 2; ++b)
#pragma unroll
            for (int m = 0; m < 4; ++m)
#pragma unroll
                for (int n = 0; n < 2; ++n) acc[a][b][m][n] = (f32x4){0.f, 0.f, 0.f, 0.f};
    bf16x8 At[4][2], B0[2][2], B1[2][2];
    const char* cA = (const char*)g.A + (size_t)cur.pm * tstepA + cur.ko; const char* cB = (const char*)g.Bt + (size_t)cur.pb * tstepB + cur.ko;
    S.a_ready(cur);
    if constexpr (SP2) {
        PG8_STAGE(PG8_SB(0, 0), cB, voffB); PG8_STAGE(PG8_SB(0, 1), cB + hstepB, voffB); PG8_STAGE(PG8_SA(0, 0), cA, voffA); PG8_STAGE(PG8_SA(0, 1), cA + hstepA, voffA);
        if (wr == 1) PG8_BAR;
        PG8_WAIT_V(2); PG8_BAR;
        PG8_STAGE(PG8_SB(1, 0), cB + kstep, voffB); PG8_STAGE(PG8_SA(1, 0), cA + kstep, voffA); PG8_STAGE(PG8_SB(1, 1), cB + hstepB + kstep, voffB);
        PG8_WAIT_V(6); PG8_BAR;
    } else {
        PG8_STAGE(PG8_SB(0, 0), cB, voffB); PG8_STAGE(PG8_SA(0, 0), cA, voffA); PG8_STAGE(PG8_SB(0, 1), cB + hstepB, voffB); PG8_STAGE(PG8_SA(0, 1), cA + hstepA, voffA);
        if (wr == 1) PG8_BAR;
        PG8_WAIT_V(4); PG8_BAR;
        PG8_STAGE(PG8_SB(1, 0), cB + kstep, voffB); PG8_STAGE(PG8_SA(1, 0), cA + kstep, voffA); PG8_STAGE(PG8_SB(1, 1), cB + hstepB + kstep, voffB);
        PG8_WAIT_V(6); PG8_BAR;
    }
    for (;;) {
        const bool has_next = S.next(ui + 1, nxt);
        const char* nA = has_next ? (const char*)g.A + (size_t)nxt.pm * tstepA + nxt.ko : cA; const char* nB = has_next ? (const char*)g.Bt + (size_t)nxt.pb * tstepB + nxt.ko : cB;
        for (int t = 0; t < nt; t += 2) {
            if constexpr (Epi::KHOOK) { if (t == 8 || t == 12) E.khook(acc, cur, t, wr, wc, fr, fq); }
            const bool last = (t == nt - 2);
            const char* a1 = cA + (size_t)(t + 1) * kstep;
            const char* a2 = last ? nA : cA + (size_t)(t + 2) * kstep; const char* b2 = last ? nB : cB + (size_t)(t + 2) * kstep;
            const char* a3 = a2 + kstep; const char* b3 = b2 + kstep;
            if (last && has_next) S.a_ready(nxt);
            if constexpr (SP2) {
            PG8_LDB(B0, 0, 0); PG8_LDB(B1, 0, 1); PG8_SCHED; PG8_LDA(At, 0, 0); PG8_STAGE(PG8_SA(1, 1), a1 + hstepA, voffA);
            PG8_WAIT_V(8); PG8_WAIT_L(0); PG8_BAR; PG8_MMA(0, 0, At, B0); PG8_MMA(0, 1, At, B1); PG8_BAR; PG8_SCHED;
            PG8_LDA(At, 0, 1); PG8_STAGE(PG8_SB(0, 0), b2, voffB); PG8_STAGE(PG8_SB(0, 1), b2 + hstepB, voffB); PG8_STAGE(PG8_SA(0, 0), a2, voffA);
            PG8_WAIT_V(8); PG8_WAIT_L(0); PG8_BAR; PG8_MMA(1, 0, At, B0); PG8_MMA(1, 1, At, B1); PG8_BAR; PG8_SCHED;
            PG8_LDB(B0, 1, 0); PG8_LDB(B1, 1, 1); PG8_SCHED; PG8_LDA(At, 1, 0); PG8_STAGE(PG8_SA(0, 1), a2 + hstepA, voffA);
            PG8_WAIT_V(8); PG8_WAIT_L(0); PG8_BAR; PG8_MMA(0, 0, At, B0); PG8_MMA(0, 1, At, B1); PG8_BAR; PG8_SCHED;
            PG8_LDA(At, 1, 1); PG8_STAGE(PG8_SB(1, 0), b3, voffB); PG8_STAGE(PG8_SB(1, 1), b3 + hstepB, voffB); PG8_STAGE(PG8_SA(1, 0), a3, voffA);
            PG8_WAIT_V(8); PG8_WAIT_L(0); PG8_BAR; PG8_MMA(1, 0, At, B0); PG8_MMA(1, 1, At, B1); PG8_BAR; PG8_SCHED;
            } else {
            PG8_LDB(B0, 0, 0); PG8_SCHED; PG8_LDA(At, 0, 0); PG8_STAGE(PG8_SA(1, 1), a1 + hstepA, voffA);
            PG8_WAIT_L(8); PG8_BAR; PG8_WAIT_L(0); PG8_MMA(0, 0, At, B0); PG8_BAR; PG8_SCHED;
            PG8_LDB(B1, 0, 1); PG8_STAGE(PG8_SB(0, 0), b2, voffB);
            PG8_BAR; PG8_WAIT_L(0); PG8_MMA(0, 1, At, B1); PG8_BAR;
            PG8_LDA(At, 0, 1); PG8_STAGE(PG8_SA(0, 0), a2, voffA);
            PG8_BAR; PG8_WAIT_L(0); PG8_MMA(1, 0, At, B0); PG8_BAR; PG8_SCHED;
            PG8_STAGE(PG8_SB(0, 1), b2 + hstepB, voffB);
            PG8_WAIT_V(6); PG8_BAR; PG8_MMA(1, 1, At, B1); PG8_BAR;
            PG8_LDB(B0, 1, 0); PG8_SCHED; PG8_LDA(At, 1, 0); PG8_STAGE(PG8_SA(0, 1), a2 + hstepA, voffA);
            PG8_WAIT_L(8); PG8_BAR; PG8_WAIT_L(0); PG8_MMA(0, 0, At, B0); PG8_BAR; PG8_SCHED;
            PG8_LDB(B1, 1, 1); PG8_STAGE(PG8_SB(1, 0), b3, voffB);
            PG8_BAR; PG8_WAIT_L(0); PG8_MMA(0, 1, At, B1); PG8_BAR;
            PG8_LDA(At, 1, 1); PG8_STAGE(PG8_SA(1, 0), a3, voffA);
            PG8_BAR; PG8_WAIT_L(0); PG8_MMA(1, 0, At, B0); PG8_BAR; PG8_SCHED;
            PG8_STAGE(PG8_SB(1, 1), b3 + hstepB, voffB);
            PG8_WAIT_V(6); PG8_BAR; PG8_MMA(1, 1, At, B1); PG8_BAR;
            }
        }
        if constexpr (ALIGN_EPI) { if (wr == 0) PG8_BAR; }
        if constexpr (!Epi::AFTER_DRAIN) { E(acc, cur, wr, wc, fr, fq); S.done(cur); }
        if (!has_next) break;
#pragma unroll
        for (int a = 0; a < 2; ++a)
#pragma unroll
            for (int b = 0; b < 2; ++b)
#pragma unroll
                for (int m = 0; m < 4; ++m)
#pragma unroll
                    for (int n = 0; n < 2; ++n) acc[a][b][m][n] = (f32x4){0.f, 0.f, 0.f, 0.f};
        cur = nxt; cA = nA; cB = nB; ++ui;
        if constexpr (ALIGN_EPI) { if (wr == 1) PG8_BAR; }
    }
    PG8_WAIT_V(0);
    if constexpr (!ALIGN_EPI) { if (wr == 0) PG8_BAR; }
    PG8_BAR;
    if constexpr (Epi::AFTER_DRAIN) { E.fused(acc, cur, wr, wc, fr, fq, lds, wid, lane); S.done(cur); }
#undef PG8_SA
#undef PG8_SB
#undef PG8_STAGE
#undef PG8_LDA
#undef PG8_LDB
#undef PG8_MMA
#undef PG8_WAIT_V
#undef PG8_WAIT_L
#undef PG8_BAR
#undef PG8_SCHED
}
template <class Epi, class Sched, bool ALIGN_EPI = false, bool SP2 = false>
__device__ __forceinline__ void gemm_phase8(PG8_LAS unsigned char* lds, const Gemm g, const Sched& S, const Epi& E) {
    const int wid = g.wid; const int tid = tid_from(wid), lane = tid & 63, wr = wid >> 2, wc = wid & 3, fr = lane & 15, fq = lane >> 4;
    const int K = g.K, nt = K / BK;
    unsigned voffA[2], voffB[2];
#pragma unroll
    for (int i = 0; i < 2; ++i) { int R, C; stage_rc(tid * 16 + i * 8192, R, C); const int Rb = Epi::PERM ? ((R & ~31) + perm32(R & 31)) : R;
        voffA[i] = (unsigned)(R * g.lda + C) * 2u; voffB[i] = (unsigned)(Rb * g.ldb + C) * 2u; }
    const size_t kstep = (size_t)(BK * 2);
    const size_t hstepA = (size_t)HALF * g.lda * 2, hstepB = (size_t)HALF * g.ldb * 2;
    const size_t tstepA = 2 * hstepA, tstepB = 2 * hstepB;
    const unsigned ldsw = (unsigned)wid * 1024u;
    const int c8 = (fq >> 1) * 32 + (fq & 1) * 16;
    const int aoff0 = lds_byte(wr * 64 + fr, c8), aoff1 = lds_byte(wr * 64 + fr, c8 + 8), boff0 = lds_byte(wc * 32 + fr, c8), boff1 = lds_byte(wc * 32 + fr, c8 + 8);
#define PG8_SA(b, h) (((b) * 2 + (h)) * HTB)
#define PG8_SB(b, h) ((4 + (b) * 2 + (h)) * HTB)
#define PG8_STAGE(bufoff, gbase, voff) do { _Pragma("unroll") for (int _i = 0; _i < 2; ++_i) \
        __builtin_amdgcn_global_load_lds((const unsigned*)((const char*)(gbase) + (voff)[_i]), (PG8_LAS unsigned*)(lds + (bufoff) + ldsw + _i * 8192), 16, 0, 0); } while (0)
#define PG8_LDA(dst, b, h) do { _Pragma("unroll") for (int m = 0; m < 4; ++m) { const u32x4 lo_ = *(const PG8_LAS u32x4*)(lds + PG8_SA(b, h) + aoff0 + m * 2048), hi_ = *(const PG8_LAS u32x4*)(lds + PG8_SA(b, h) + aoff1 + m * 2048); \
        dst[m] = (i32x8){(int)lo_.x, (int)lo_.y, (int)lo_.z, (int)lo_.w, (int)hi_.x, (int)hi_.y, (int)hi_.z, (int)hi_.w}; } } while (0)
#define PG8_LDB(dst, b, h) do { _Pragma("unroll") for (int n = 0; n < 2; ++n) { const u32x4 lo_ = *(const PG8_LAS u32x4*)(lds + PG8_SB(b, h) + boff0 + n * 2048), hi_ = *(const PG8_LAS u32x4*)(lds + PG8_SB(b, h) + boff1 + n * 2048); \
        dst[n] = (i32x8){(int)lo_.x, (int)lo_.y, (int)lo_.z, (int)lo_.w, (int)hi_.x, (int)hi_.y, (int)hi_.z, (int)hi_.w}; } } while (0)
#define PG8_MMA(ai, bj, At, Bt) do { __builtin_amdgcn_s_setprio(1); _Pragma("unroll") for (int m = 0; m < 4; ++m) _Pragma("unroll") for (int n = 0; n < 2; ++n) \
        asm volatile("v_mfma_scale_f32_16x16x128_f8f6f4 %0, %1, %2, %0, %3, %4 op_sel_hi:[0,0,0]" : "+v"(acc[ai][bj][m][n]) : "v"(Bt[n]), "v"(At[m]), "v"(vsB), "v"(vsA)); __builtin_amdgcn_s_setprio(0); } while (0)
#define PG8_WAIT_V(n) asm volatile("s_waitcnt vmcnt(" #n ")" ::: "memory")
#define PG8_WAIT_L(n) asm volatile("s_waitcnt lgkmcnt(" #n ")" ::: "memory")
#define PG8_BAR __builtin_amdgcn_s_barrier()
#define PG8_SCHED __builtin_amdgcn_sched_barrier(0)
    Unit cur, nxt; int ui = 0;
    if (!S.next(0, cur)) return;
    f32x4 acc[2][2][4][2];
#pragma unroll
    for (int a = 0; a < 2; ++a)
#pragma unroll
        for (int b = 0; b < 2; ++b)
#pragma unroll
            for (int m = 0; m < 4; ++m)
#pragma unroll
                for (int n = 0; n < 2; ++n) acc[a][b][m][n] = (f32x4){0.f, 0.f, 0.f, 0.f};
    typedef int i32x8 __attribute__((ext_vector_type(8)));
    i32x8 At[4], B0[2], B1[2];
    int vsA = g.sA, vsB = g.sB; asm volatile("" : "+v"(vsA), "+v"(vsB));
    const char* cA = (const char*)g.A + (size_t)cur.pm * tstepA + cur.ko; const char* cB = (const char*)g.Bt + (size_t)cur.pb * tstepB + cur.ko;
    S.a_ready(cur);
    if constexpr (SP2) {
        PG8_STAGE(PG8_SB(0, 0), cB, voffB); PG8_STAGE(PG8_SB(0, 1), cB + hstepB, voffB); PG8_STAGE(PG8_SA(0, 0), cA, voffA); PG8_STAGE(PG8_SA(0, 1), cA + hstepA, voffA);
        if (wr == 1) PG8_BAR;
        PG8_WAIT_V(2); PG8_BAR;
        PG8_STAGE(PG8_SB(1, 0), cB + kstep, voffB); PG8_STAGE(PG8_SA(1, 0), cA + kstep, voffA); PG8_STAGE(PG8_SB(1, 1), cB + hstepB + kstep, voffB);
        PG8_WAIT_V(6); PG8_BAR;
    } else {
        PG8_STAGE(PG8_SB(0, 0), cB, voffB); PG8_STAGE(PG8_SA(0, 0), cA, voffA); PG8_STAGE(PG8_SB(0, 1), cB + hstepB, voffB); PG8_STAGE(PG8_SA(0, 1), cA + hstepA, voffA);
        if (wr == 1) PG8_BAR;
        PG8_WAIT_V(4); PG8_BAR;
        PG8_STAGE(PG8_SB(1, 0), cB + kstep, voffB); PG8_STAGE(PG8_SA(1, 0), cA + kstep, voffA); PG8_STAGE(PG8_SB(1, 1), cB + hstepB + kstep, voffB);
        PG8_WAIT_V(6); PG8_BAR;
    }
    for (;;) {
        const bool has_next = S.next(ui + 1, nxt);
        const char* nA = has_next ? (const char*)g.A + (size_t)nxt.pm * tstepA + nxt.ko : cA; const char* nB = has_next ? (const char*)g.Bt + (size_t)nxt.pb * tstepB + nxt.ko : cB;
        for (int t = 0; t < nt; t += 2) {
            const bool last = (t == nt - 2);
            const char* a1 = cA + (size_t)(t + 1) * kstep;
            const char* a2 = last ? nA : cA + (size_t)(t + 2) * kstep; const char* b2 = last ? nB : cB + (size_t)(t + 2) * kstep;
            const char* a3 = a2 + kstep; const char* b3 = b2 + kstep;
            if (last && has_next) S.a_ready(nxt);
            if constexpr (SP2) {
            PG8_LDB(B0, 0, 0); PG8_LDB(B1, 0, 1); PG8_SCHED; PG8_LDA(At, 0, 0); PG8_STAGE(PG8_SA(1, 1), a1 + hstepA, voffA);
            PG8_WAIT_V(8); PG8_WAIT_L(0); PG8_BAR; PG8_MMA(0, 0, At, B0); PG8_MMA(0, 1, At, B1); PG8_BAR; PG8_SCHED;
            PG8_LDA(At, 0, 1); PG8_STAGE(PG8_SB(0, 0), b2, voffB); PG8_STAGE(PG8_SB(0, 1), b2 + hstepB, voffB); PG8_STAGE(PG8_SA(0, 0), a2, voffA);
            PG8_WAIT_V(8); PG8_WAIT_L(0); PG8_BAR; PG8_MMA(1, 0, At, B0); PG8_MMA(1, 1, At, B1); PG8_BAR; PG8_SCHED;
            PG8_LDB(B0, 1, 0); PG8_LDB(B1, 1, 1); PG8_SCHED; PG8_LDA(At, 1, 0); PG8_STAGE(PG8_SA(0, 1), a2 + hstepA, voffA);
            PG8_WAIT_V(8); PG8_WAIT_L(0); PG8_BAR; PG8_MMA(0, 0, At, B0); PG8_MMA(0, 1, At, B1); PG8_BAR; PG8_SCHED;
            PG8_LDA(At, 1, 1); PG8_STAGE(PG8_SB(1, 0), b3, voffB); PG8_STAGE(PG8_SB(1, 1), b3 + hstepB, voffB); PG8_STAGE(PG8_SA(1, 0), a3, voffA);
            PG8_WAIT_V(8); PG8_WAIT_L(0); PG8_BAR; PG8_MMA(1, 0, At, B0); PG8_MMA(1, 1, At, B1); PG8_BAR; PG8_SCHED;
            } else {
            PG8_LDB(B0, 0, 0); PG8_SCHED; PG8_LDA(At, 0, 0); PG8_STAGE(PG8_SA(1, 1), a1 + hstepA, voffA);
            PG8_WAIT_L(8); PG8_BAR; PG8_WAIT_L(0); PG8_MMA(0, 0, At, B0); PG8_BAR; PG8_SCHED;
            PG8_LDB(B1, 0, 1); PG8_STAGE(PG8_SB(0, 0), b2, voffB);
            PG8_BAR; PG8_WAIT_L(0); PG8_MMA(0, 1, At, B1); PG8_BAR;
            PG8_LDA(At, 0, 1); PG8_STAGE(PG8_SA(0, 0), a2, voffA);
            PG8_BAR; PG8_WAIT_L(0); PG8_MMA(1, 0, At, B0); PG8_BAR; PG8_SCHED;
            PG8_STAGE(PG8_SB(0, 1), b2 + hstepB, voffB);
            PG8_WAIT_V(6); PG8_BAR; PG8_MMA(1, 1, At, B1); PG8_BAR;
            PG8_LDB(B0, 1, 0); PG8_SCHED; PG8_LDA(At, 1, 0); PG8_STAGE(PG8_SA(0, 1), a2 + hstepA, voffA);
            PG8_WAIT_L(8); PG8_BAR; PG8_WAIT_L(0); PG8_MMA(0, 0, At, B0); PG8_BAR; PG8_SCHED;
            PG8_LDB(B1, 1, 1); PG8_STAGE(PG8_SB(1, 0), b3, voffB);
            PG8_BAR; PG8_WAIT_L(0); PG8_MMA(0, 1, At, B1); PG8_BAR;
            PG8_LDA(At, 1, 1); PG8_STAGE(PG8_SA(1, 0), a3, voffA);
            PG8_BAR; PG8_WAIT_L(0); PG8_MMA(1, 0, At, B0); PG8_BAR; PG8_SCHED;
            PG8_STAGE(PG8_SB(1, 1), b3 + hstepB, voffB);
            PG8_WAIT_V(6); PG8_BAR; PG8_MMA(1, 1, At, B1); PG8_BAR;
            }
        }
        if constexpr (ALIGN_EPI) { if (wr == 0) PG8_BAR; }
        asm volatile("s_nop 15\n\ts_nop 15" ::: "memory");
        if constexpr (!Epi::AFTER_DRAIN) { E(acc, cur, wr, wc, fr, fq); S.done(cur); }
        if (!has_next) break;
#pragma unroll
        for (int a = 0; a < 2; ++a)
#pragma unroll
            for (int b = 0; b < 2; ++b)
#pragma unroll
                for (int m = 0; m < 4; ++m)
#pragma unroll
                    for (int n = 0; n < 2; ++n) acc[a][b][m][n] = (f32x4){0.f, 0.f, 0.f, 0.f};
        cur = nxt; cA = nA; cB = nB; ++ui;
        if constexpr (ALIGN_EPI) { if (wr == 1) PG8_BAR; }
    }
    PG8_WAIT_V(0);
    if constexpr (!ALIGN_EPI) { if (wr == 0) PG8_BAR; }
    PG8_BAR;
    if constexpr (Epi::AFTER_DRAIN) { E.fused(acc, cur, wr, wc, fr, fq, lds, wid, lane); S.done(cur); }
#undef PG8_SA
#undef PG8_SB
#undef PG8_STAGE
#undef PG8_LDA
#undef PG8_LDB
#undef PG8_MMA
#undef PG8_WAIT_V
#undef PG8_WAIT_L
#undef PG8_BAR
#undef PG8_SCHED
}
}

namespace attn {
using bf16x8 = __attribute__((ext_vector_type(8))) short;
using s16x4  = __attribute__((ext_vector_type(4))) short;
using f32x16 = __attribute__((ext_vector_type(16))) float;
using u32x4  = __attribute__((ext_vector_type(4))) unsigned;
constexpr int DV = 128, DK = 64, NW = 8, QBLK = 32, KVBLK = 64;
constexpr float SCALE = 0.125f;
constexpr float THR = 4.f;
constexpr size_t SHM_V = KVBLK * DV * 2, SHM_K = KVBLK * DK * 2, SHM_ATTN = 2 * SHM_V + 2 * SHM_K + NW * 64 * 4;
#define AKSWZ(row, colB) ((row) * 128 + ((colB) ^ ((((row) >> 1) & 7) << 4)))
#define ASBAR() __builtin_amdgcn_sched_barrier(0)
__device__ __forceinline__ int crow(int r, int hi) { return (r & 3) + 8 * (r >> 2) + 4 * hi; }
__device__ __forceinline__ unsigned cvtpk(float lo, float hi) { unsigned r; asm volatile("v_cvt_pk_bf16_f32 %0, %1, %2" : "=v"(r) : "v"(lo), "v"(hi)); return r; }

__device__ __forceinline__ void partialSM(f32x16& p0, f32x16& p1, float& m_reg, float& mn, float& alpha) {
  constexpr float C = SCALE * 1.4426950408889634f;
  float pmax = p0[0];
#pragma unroll
  for (int r = 1; r < 16; ++r) pmax = fmaxf(pmax, p0[r]);
#pragma unroll
  for (int r = 0; r < 16; ++r) pmax = fmaxf(pmax, p1[r]);
  { auto rr = __builtin_amdgcn_permlane32_swap(__float_as_uint(pmax), __float_as_uint(pmax), false, false);
    pmax = fmaxf(__uint_as_float(rr[0]), __uint_as_float(rr[1])); }
  if (__builtin_expect(__all(pmax - m_reg <= THR / SCALE), 1)) { mn = m_reg; alpha = 1.f; }
  else { mn = fmaxf(m_reg, pmax); alpha = __builtin_amdgcn_exp2f((m_reg - mn) * C); m_reg = mn; }
  const float mnC = -mn * C;
#pragma unroll
  for (int r = 0; r < 16; ++r) p0[r] = fmaf(p0[r], C, mnC);
#pragma unroll
  for (int r = 0; r < 16; ++r) p1[r] = fmaf(p1[r], C, mnC);
#pragma unroll
  for (int r = 0; r < 16; ++r) p0[r] = __builtin_amdgcn_exp2f(p0[r]);
}
__device__ __forceinline__ void finishSM(f32x16& p0, f32x16& p1, float alpha, float& l_reg, bf16x8& pa0, bf16x8& pa1, bf16x8& pa2, bf16x8& pa3) {
#pragma unroll
  for (int r = 0; r < 16; ++r) p1[r] = __builtin_amdgcn_exp2f(p1[r]);
  float ps = 0;
#pragma unroll
  for (int r = 0; r < 16; ++r) ps += p0[r];
#pragma unroll
  for (int r = 0; r < 16; ++r) ps += p1[r];
  { auto rr = __builtin_amdgcn_permlane32_swap(__float_as_uint(ps), __float_as_uint(ps), false, false);
    ps = __uint_as_float(rr[0]) + __uint_as_float(rr[1]); }
  l_reg = l_reg * alpha + ps;
#define APK4(P, BASE, OUT) do { unsigned a0 = cvtpk(P[BASE + 0], P[BASE + 1]), a1 = cvtpk(P[BASE + 2], P[BASE + 3]);   \
    unsigned b0 = cvtpk(P[BASE + 4], P[BASE + 5]), b1 = cvtpk(P[BASE + 6], P[BASE + 7]);                              \
    auto r0 = __builtin_amdgcn_permlane32_swap(a0, b0, false, false); auto r1 = __builtin_amdgcn_permlane32_swap(a1, b1, false, false); \
    u32x4 w = {r0[0], r1[0], r0[1], r1[1]}; OUT = *reinterpret_cast<bf16x8*>(&w); } while (0)
  APK4(p0, 0, pa0); APK4(p0, 8, pa1); APK4(p1, 0, pa2); APK4(p1, 8, pa3);
#undef APK4
}
__device__ __forceinline__ void qkt(f32x16& p0, f32x16& p1, const char* Ks, const bf16x8* qr, int r32, int hi) {
  p0 = f32x16{}; p1 = f32x16{};
#pragma unroll
  for (int d0 = 0; d0 < 4; ++d0) { const int cb = (d0 * 16 + hi * 8) * 2;
    bf16x8 b0 = *reinterpret_cast<const bf16x8*>(Ks + AKSWZ(r32, cb));
    bf16x8 b1 = *reinterpret_cast<const bf16x8*>(Ks + AKSWZ(32 + r32, cb));
    p0 = __builtin_amdgcn_mfma_f32_32x32x16_bf16(b0, qr[d0], p0, 0, 0, 0);
    p1 = __builtin_amdgcn_mfma_f32_32x32x16_bf16(b1, qr[d0], p1, 0, 0, 0); }
}
__device__ __forceinline__ int v_st(int k, int c) { const int kk = (k & ~0xC) | ((k & 4) << 1) | ((k & 8) >> 1); return ((kk >> 3) * 4 + (c >> 5)) * 512 + ((kk & 7) * 32 + (c & 31)) * 2; }
__device__ __forceinline__ int v_rd_base(int lane) { return ((lane & 3) << 3) | (((lane >> 2) & 3) << 6) | (((lane >> 4) & 1) << 5) | (((lane >> 5) & 1) << 8); }
constexpr int v_rd_off(int d0, int ks, int half) { return d0 * 512 + ks * 4096 + half * 2048; }
template <int OFF> __device__ __forceinline__ s16x4 tr_read(int vb) {
  s16x4 r; asm volatile("ds_read_b64_tr_b16 %0, %1 offset:%2" : "=&v"(r) : "v"(vb), "i"(OFF) : "memory"); return r;
}
template <int D0> __device__ __forceinline__ void pv_one(f32x16& od, int vb, bf16x8 pa0, bf16x8 pa1, bf16x8 pa2, bf16x8 pa3) {
  const s16x4 l0 = tr_read<v_rd_off(D0, 0, 0)>(vb), h0 = tr_read<v_rd_off(D0, 0, 1)>(vb), l1 = tr_read<v_rd_off(D0, 1, 0)>(vb), h1 = tr_read<v_rd_off(D0, 1, 1)>(vb);
  const s16x4 l2 = tr_read<v_rd_off(D0, 2, 0)>(vb), h2 = tr_read<v_rd_off(D0, 2, 1)>(vb), l3 = tr_read<v_rd_off(D0, 3, 0)>(vb), h3 = tr_read<v_rd_off(D0, 3, 1)>(vb);
  asm volatile("s_waitcnt lgkmcnt(0)" ::: "memory"); ASBAR();
#define APK(L, H) (bf16x8){L[0], L[1], L[2], L[3], H[0], H[1], H[2], H[3]}
  od = __builtin_amdgcn_mfma_f32_32x32x16_bf16(pa0, APK(l0, h0), od, 0, 0, 0);
  od = __builtin_amdgcn_mfma_f32_32x32x16_bf16(pa1, APK(l1, h1), od, 0, 0, 0);
  od = __builtin_amdgcn_mfma_f32_32x32x16_bf16(pa2, APK(l2, h2), od, 0, 0, 0);
  od = __builtin_amdgcn_mfma_f32_32x32x16_bf16(pa3, APK(l3, h3), od, 0, 0, 0);
#undef APK
}
__device__ __forceinline__ void pv_d0(f32x16* o, int vb, bf16x8 pa0, bf16x8 pa1, bf16x8 pa2, bf16x8 pa3) {
  pv_one<0>(o[0], vb, pa0, pa1, pa2, pa3); pv_one<1>(o[1], vb, pa0, pa1, pa2, pa3); pv_one<2>(o[2], vb, pa0, pa1, pa2, pa3); pv_one<3>(o[3], vb, pa0, pa1, pa2, pa3);
}
template <int LDQ, int LDO>
__device__ __forceinline__ void attn_unit(const unsigned short* __restrict__ Qb, const unsigned short* __restrict__ Kh, const unsigned short* __restrict__ Vh,
                                          unsigned short* __restrict__ Ob, int seq, char* lds, int wid) {
  const int tid = pg8::tid_from(wid), lane = tid & 63, r32 = lane & 31, hi = lane >> 5;
  char* V_lds = lds; char* K_lds = lds + 2 * SHM_V;
  float* ws = (float*)(lds + 2 * SHM_V + 2 * SHM_K) + wid * 64; float* li_l = ws; float* al_l = ws + 32;
  float m_reg = -1e30f, l_reg = 0; f32x16 o[4] = {}; bf16x8 qr[4];
  const unsigned short* Qw = Qb + (long)(wid * QBLK + r32) * LDQ + hi * 8;
#pragma unroll
  for (int d0 = 0; d0 < 4; ++d0) qr[d0] = *reinterpret_cast<const bf16x8*>(Qw + d0 * 16);
  const int sr = tid >> 4, sc = (tid & 15) * 8, vst0 = v_st(sr, sc), vst1 = v_st(32 + sr, sc);
  const int kr = tid >> 3, kc = (tid & 7) * 8, kst = AKSWZ(kr, kc * 2);
  const int vb0 = (int)(uintptr_t)V_lds + v_rd_base(lane);
  bf16x8 sv0[2], sv1[2], sk0[2];
#define ASLOAD(i, k0) do { sv0[i] = *reinterpret_cast<const bf16x8*>(&Vh[(long)((k0) + sr) * LDQ + sc]); sv1[i] = *reinterpret_cast<const bf16x8*>(&Vh[(long)((k0) + 32 + sr) * LDQ + sc]); \
    sk0[i] = *reinterpret_cast<const bf16x8*>(&Kh[(long)((k0) + kr) * LDQ + kc]); } while (0)
#define ASWRITE(b, i) do { *(bf16x8*)(V_lds + (b) * SHM_V + vst0) = sv0[i]; *(bf16x8*)(V_lds + (b) * SHM_V + vst1) = sv1[i]; \
    *(bf16x8*)(K_lds + (b) * SHM_K + kst) = sk0[i]; } while (0)
#define ASWAIT() asm volatile("s_waitcnt vmcnt(3)" ::: "memory")
#define ARESC(a) do { if (__any((a) < 1.f)) { if (hi == 0) al_l[r32] = (a); asm volatile("s_waitcnt lgkmcnt(0)" ::: "memory"); \
    _Pragma("unroll") for (int d = 0; d < 4; ++d) _Pragma("unroll") for (int r = 0; r < 16; ++r) o[d][r] *= al_l[crow(r, hi)]; } } while (0)
  f32x16 pA0, pA1, pB0, pB1; float mnA, mnB, alA, alB; bf16x8 pa0, pa1, pa2, pa3; const int NT = seq / KVBLK;
  ASLOAD(0, 0); asm volatile("s_waitcnt vmcnt(0)" ::: "memory"); ASWRITE(0, 0); __syncthreads();
  qkt(pA0, pA1, K_lds, qr, r32, hi); partialSM(pA0, pA1, m_reg, mnA, alA);
  ASLOAD(1, KVBLK); if (2 < NT) ASLOAD(0, 2 * KVBLK);
  if (2 < NT) ASWAIT(); else asm volatile("s_waitcnt vmcnt(0)" ::: "memory");
  ASWRITE(1, 1); __syncthreads();
  for (int j = 1; j + 1 < NT; j += 2) {
    ASBAR(); qkt(pB0, pB1, K_lds + SHM_K, qr, r32, hi);
    finishSM(pA0, pA1, alA, l_reg, pa0, pa1, pa2, pa3); ASBAR();
    ASLOAD(1, (j + 2) * KVBLK); ASBAR();
    pv_d0(o, vb0, pa0, pa1, pa2, pa3); partialSM(pB0, pB1, m_reg, mnB, alB);
    __syncthreads(); ASWAIT(); ASWRITE(0, 0);
    ARESC(alB); __syncthreads();
    ASBAR(); qkt(pA0, pA1, K_lds, qr, r32, hi);
    finishSM(pB0, pB1, alB, l_reg, pa0, pa1, pa2, pa3); ASBAR();
    if (j + 3 < NT) ASLOAD(0, (j + 3) * KVBLK); ASBAR();
    pv_d0(o, vb0 + (int)SHM_V, pa0, pa1, pa2, pa3); partialSM(pA0, pA1, m_reg, mnA, alA);
    __syncthreads(); if (j + 3 < NT) ASWAIT(); else asm volatile("s_waitcnt vmcnt(0)" ::: "memory");
    ASWRITE(1, 1);
    ARESC(alA); __syncthreads();
  }
  ASBAR(); qkt(pB0, pB1, K_lds + SHM_K, qr, r32, hi);
  finishSM(pA0, pA1, alA, l_reg, pa0, pa1, pa2, pa3); ASBAR();
  pv_d0(o, vb0, pa0, pa1, pa2, pa3); partialSM(pB0, pB1, m_reg, mnB, alB);
  __syncthreads(); ARESC(alB);
  finishSM(pB0, pB1, alB, l_reg, pa0, pa1, pa2, pa3); ASBAR();
  pv_d0(o, vb0 + (int)SHM_V, pa0, pa1, pa2, pa3);
  if (hi == 0) li_l[r32] = l_reg; asm volatile("s_waitcnt lgkmcnt(0)" ::: "memory");
  float rli[16];
#pragma unroll
  for (int r = 0; r < 16; ++r) rli[r] = __builtin_amdgcn_rcpf(li_l[crow(r, hi)]);
  unsigned short* Ow = Ob + (long)(wid * QBLK) * LDO;
#pragma unroll
  for (int r = 0; r < 16; ++r) { const int orow = crow(r, hi);
#pragma unroll
    for (int d0 = 0; d0 < 4; ++d0) { const float v = o[d0][r] * rli[r]; Ow[(long)orow * LDO + d0 * 32 + r32] = (unsigned short)(cvtpk(v, v) & 0xffffu); } }
  __syncthreads();
#undef ASLOAD
#undef ASWRITE
#undef ASWAIT
#undef ARESC
}
}

constexpr int NWAVES = 8, NTHR = NWAVES * 64;
constexpr int DM = 1024, NB = 4, SEQ = 4096, CTXL = 256, RPB = CTXL + SEQ  , MROWS = NB * RPB  ;
constexpr int INW = 5904, NPROJ = 6144, PLD = 5888;
constexpr int FFD = 2816, FFE = 3584, NEXP = 8, FFEH = FFE / 2;
constexpr int NCHUNK = RPB / 64;
constexpr float EPSN = 1e-6f;
constexpr int PC_AQ = 0, PC_AK = 512, PC_AV = 1024, PC_DQ = 1536, PC_DK = 1792, PC_DV = 2048, PC_DZ = 2304, PC_POOL = 2560, PC_GATE = 2816, PC_AB = 5888;

constexpr size_t MiB = 1u << 20;
constexpr size_t WS_CTL = 0, CTL_ZERO_BYTES = 2 * MiB;
constexpr size_t WS_MOD = 1 * MiB;
constexpr size_t WS_ROPE = 2 * MiB;
constexpr size_t WS_LAM = 2 * MiB + 65536;
constexpr size_t WS_ROUTE = 3 * MiB;
constexpr size_t WS_GB = 4 * MiB;
constexpr int NPB = 2816;
constexpr size_t WS_WIN = 8 * MiB;
constexpr size_t WS_WG8 = 20 * MiB;
constexpr size_t WS_WAB = 26 * MiB;
constexpr size_t WS_U8 = 484 * MiB;
constexpr size_t WS_WBR = 32 * MiB;
constexpr size_t WS_WOUT = 36 * MiB;
constexpr size_t WS_W13 = 40 * MiB;
constexpr size_t WS_W2 = 51 * MiB;
constexpr size_t WS_H = 58 * MiB;
constexpr size_t WS_U = 126 * MiB;
constexpr size_t WS_ATTO = WS_U;
constexpr size_t WS_MIX = WS_U;
constexpr size_t WS_PROJ = 160 * MiB;
constexpr size_t WS_POOLO = 356 * MiB;
constexpr size_t WS_W2M = 365 * MiB;
constexpr size_t WS_DNP = 398 * MiB;
constexpr size_t WS_MG = WS_DNP;
constexpr size_t WS_DNG = 466 * MiB;
constexpr size_t WS_DNO = 467 * MiB;
constexpr size_t WS_W13M = 484 * MiB;
constexpr size_t WS_SLAB = 256 * MiB;
constexpr size_t WS_HID = WS_PROJ;
constexpr int MOE_MAXT = 136;
constexpr size_t WS_HIDM = 160 * MiB;
constexpr size_t WS_XG = 279 * MiB;
constexpr size_t WS_Y = 279 * MiB;
constexpr size_t WS_END = 540 * MiB;
static_assert(WS_HIDM + (size_t)MOE_MAXT * 256 * FFE <= WS_XG && WS_Y + (size_t)MOE_MAXT * 256 * 1024 * 2 <= WS_POOLO && WS_DNO + (size_t)2 * MROWS * 256 * 2 <= WS_W13M && WS_W13M + (size_t)8 * 2 * FFE * 1024 <= WS_END, "ws map");
static_assert(WS_WIN + (size_t)2 * NPB * 1024 * 2 <= WS_WG8 && WS_WG8 + (size_t)2 * 3072 * 1024 <= WS_WAB && WS_WAB + 2 * 65536 <= WS_WBR && WS_W13 + (size_t)2 * FFD * 1024 * 2 <= WS_W2 && WS_W2 + (size_t)1024 * FFD * 2 <= WS_H, "ws map (weights)");
static_assert(WS_H + (size_t)MROWS * 1024 * 4 <= WS_U && WS_U + (size_t)MROWS * 1024 * 2 <= WS_PROJ && WS_PROJ + (size_t)MROWS * PLD * 2 <= WS_POOLO && WS_POOLO + (size_t)MROWS * 256 * 2 <= WS_W2M && WS_W2M + (size_t)8 * 1024 * FFE <= WS_DNP, "ws map (acts)");
static_assert(WS_DNP + (size_t)NB * NCHUNK * 4 * 2 * 32768 <= WS_DNG, "ws map (dn)");
constexpr int CW_TMO = 0, CW_CODE = 1;
constexpr int CW_BAR = 4096;
constexpr int CW_ECNT = 16384;

constexpr int RING_BYTES = 155648;
constexpr int MISC_OFF = RING_BYTES;
constexpr int LDS_BYTES = RING_BYTES + 1024;

enum { PH_PRO = 0, PH_L0 = 1, PH_N1 = 0, PH_PROJ = 1, PH_ATT = 2, PH_SCAN = 3, PH_MIXB = 4, PH_MRG0 = 5, PH_MRG1 = 6, PH_MRG2 = 7, PH_OUT = 8, PH_N2 = 9, PH_LAYER = 10,
       PH_FUP = 11, PH_FDN = 12, PH_L1 = 13, PH_GATH = 23, PH_CV0 = 24, PH_UP0 = 25, PH_DN0 = 26, PH_CV1 = 27, PH_UP1 = 28, PH_DN1 = 29, PH_FIN = 30, PH_COUNT = 31 };

#define GAS __attribute__((address_space(1)))
#define LAS __attribute__((address_space(3)))
typedef unsigned short bf16;
typedef unsigned v4u __attribute__((ext_vector_type(4)));
typedef unsigned v2u __attribute__((ext_vector_type(2)));
typedef float f32x4 __attribute__((ext_vector_type(4)));
typedef GAS unsigned gu32;
#define RLX_AGENT __ATOMIC_RELAXED, __HIP_MEMORY_SCOPE_AGENT
#define LDS_WAIT() asm volatile("s_waitcnt lgkmcnt(0)" ::: "memory")
#define VM_WAIT() asm volatile("s_waitcnt vmcnt(0)" ::: "memory")
__device__ __forceinline__ unsigned f2bf(float f) { unsigned u = __builtin_bit_cast(unsigned, f); return (u + 0x7fffu + ((u >> 16) & 1u)) >> 16; }
typedef float f32x2_c __attribute__((ext_vector_type(2))); typedef __bf16 bf16x2_c __attribute__((ext_vector_type(2)));
__device__ __forceinline__ unsigned cvtpk_c(float lo, float hi) { f32x2_c v = {lo, hi}; bf16x2_c b = __builtin_convertvector(v, bf16x2_c); return __builtin_bit_cast(unsigned, b); }
__device__ __forceinline__ unsigned pk2(float lo, float hi) { return cvtpk_c(lo, hi); }
__device__ __forceinline__ unsigned cvt4_fp8(float a, float b, float c, float d) {
    a = fminf(fmaxf(a, -448.f), 448.f); b = fminf(fmaxf(b, -448.f), 448.f); c = fminf(fmaxf(c, -448.f), 448.f); d = fminf(fmaxf(d, -448.f), 448.f);
    int r = 0; r = __builtin_amdgcn_cvt_pk_fp8_f32(a, b, r, false); r = __builtin_amdgcn_cvt_pk_fp8_f32(c, d, r, true); return (unsigned)r; }
constexpr int E8(int log2scale) { return (127 - log2scale) * 0x01010101; }
constexpr int F8_ACT_L2 = 3, F8_W13_L2 = 5, F8_W2_L2 = 6;
__device__ __forceinline__ float bf_lo(unsigned w) { return __builtin_bit_cast(float, w << 16); }
__device__ __forceinline__ float bf_hi(unsigned w) { return __builtin_bit_cast(float, w & 0xffff0000u); }
__device__ __forceinline__ float bf2f(bf16 v) { return __builtin_bit_cast(float, (unsigned)v << 16); }
__device__ __forceinline__ float sigmoidf_(float x) { return 1.f / (1.f + __expf(-x)); }
__device__ __forceinline__ float siluf_(float x) { return x / (1.f + __expf(-x)); }
__device__ __forceinline__ float dpp_add_(float v, const int ctrl_sel) {
    int r;
    if (ctrl_sel == 0) r = __builtin_amdgcn_update_dpp(0, __builtin_bit_cast(int, v), 0xB1, 0xF, 0xF, false);
    else if (ctrl_sel == 1) r = __builtin_amdgcn_update_dpp(0, __builtin_bit_cast(int, v), 0x4E, 0xF, 0xF, false);
    else if (ctrl_sel == 2) r = __builtin_amdgcn_update_dpp(0, __builtin_bit_cast(int, v), 0x141, 0xF, 0xF, false);
    else r = __builtin_amdgcn_update_dpp(0, __builtin_bit_cast(int, v), 0x140, 0xF, 0xF, false);
    return v + __builtin_bit_cast(float, r);
}
__device__ __forceinline__ float grp8_sum(float v) { v = dpp_add_(v, 0); v = dpp_add_(v, 1); v = dpp_add_(v, 2); return v; }
__device__ __forceinline__ float grp16_sum(float v) { v = grp8_sum(v); v = dpp_add_(v, 3); return v; }
__device__ __forceinline__ float wave_sum(float v) {
    v = grp16_sum(v);
    { auto rr = __builtin_amdgcn_permlane16_swap(__float_as_uint(v), __float_as_uint(v), false, false); v = __uint_as_float(rr[0]) + __uint_as_float(rr[1]); }
    { auto rr = __builtin_amdgcn_permlane32_swap(__float_as_uint(v), __float_as_uint(v), false, false); v = __uint_as_float(rr[0]) + __uint_as_float(rr[1]); }
    return v;
}
__device__ __forceinline__ int lane_id_() { return pg8::lane_id_asm(); }
__device__ __forceinline__ float lane_get(float v, int src) { return __builtin_bit_cast(float, __builtin_amdgcn_ds_bpermute(src << 2, __builtin_bit_cast(int, v))); }
#define XB_TMO      128
#define XB_XCNT(j)  (256  + 64 * (j))
#define XB_XSUB(j)  (1280 + 64 * (j))
#define XB_XGEN(j)  (2304 + 64 * (j))
#define XB_TOP      3328
#define XB_TOPGEN   3392
#define XCD_BAR_WORDS 3456
#define XB_SPIN_CAP (1u << 18)

__device__ __forceinline__ unsigned xb_ld(unsigned* p)              { return __hip_atomic_load(p, __ATOMIC_RELAXED, __HIP_MEMORY_SCOPE_AGENT); }
__device__ __forceinline__ unsigned xb_add(unsigned* p, unsigned v) { return __hip_atomic_fetch_add(p, v, __ATOMIC_RELAXED, __HIP_MEMORY_SCOPE_AGENT); }
__device__ __forceinline__ unsigned xb_xcc_id() { return (unsigned)__builtin_amdgcn_s_getreg((3 << 11) | 20) & 0xFu; }
#define XB_SPIN(cond, bar) do { unsigned _sp = 0; while (cond) { __builtin_amdgcn_s_sleep(1); \
    if ((++_sp & 255u) == 0u) { if (xb_ld(&(bar)[XB_TMO])) break; if (_sp > XB_SPIN_CAP) { atomicAdd(&(bar)[XB_TMO], 1u); break; } } } } while (0)

struct XcdBarrier {
    unsigned* bar; unsigned x; unsigned wid;
    volatile LAS unsigned* st;
};

__device__ __forceinline__ XcdBarrier xcd_barrier_post(unsigned* bar, volatile LAS unsigned* st, unsigned wid) {
    XcdBarrier b; b.bar = bar; b.x = xb_xcc_id(); b.st = st; b.wid = wid;
    if (wid == 0 && pg8::lane_id_asm() == 0) (void)xb_add(&bar[XB_XCNT(b.x)], 1u);
    return b;
}
__device__ __forceinline__ void xcd_barrier_complete(unsigned* bar, unsigned x, unsigned& nloc, unsigned& nx) {
    const unsigned G = gridDim.x * gridDim.y * gridDim.z;
    unsigned sum, cnt, mine, sp = 0u;
    for (;;) {
        sum = 0u; cnt = 0u; mine = 0u;
#pragma unroll
        for (unsigned j = 0; j < 16; ++j) { const unsigned c = xb_ld(&bar[XB_XCNT(j)]); sum += c; cnt += (c > 0u) ? 1u : 0u; mine = (j == x) ? c : mine; }
        if (sum == G) break;
        __builtin_amdgcn_s_sleep(1);
        if ((++sp & 255u) == 0u) { if (xb_ld(&bar[XB_TMO])) break; if (sp > XB_SPIN_CAP) { atomicAdd(&bar[XB_TMO], 1u); break; } }
    }
    nloc = mine > 0u ? mine : 1u; nx = cnt > 0u ? cnt : 1u;
}

__device__ __forceinline__ void xcd_barrier(const XcdBarrier& b) {
    asm volatile("s_waitcnt vmcnt(0)" ::: "memory");
    __syncthreads();
    if (b.wid == 0 && pg8::lane_id_asm() == 0) {
        unsigned* bar = b.bar;
        __builtin_amdgcn_s_waitcnt(0);
        unsigned nloc = b.st[0], nx = b.st[1];
        if (nloc == 0u) { xcd_barrier_complete(bar, b.x, nloc, nx); b.st[0] = nloc; b.st[1] = nx; }
        const unsigned old = xb_add(&bar[XB_XSUB(b.x)], 1u);
        const unsigned gen = old / nloc;
        if (old + 1u == (gen + 1u) * nloc) {
            __builtin_amdgcn_fence(__ATOMIC_RELEASE, "agent");
            asm volatile("s_waitcnt vmcnt(0)" ::: "memory");
            const unsigned og = xb_add(&bar[XB_TOP], 1u);
            const unsigned tg = og / nx;
            if (og + 1u == (tg + 1u) * nx) xb_add(&bar[XB_TOPGEN], 1u);
            else XB_SPIN(xb_ld(&bar[XB_TOPGEN]) == tg, bar);
            __builtin_amdgcn_fence(__ATOMIC_ACQUIRE, "agent");
            xb_add(&bar[XB_XGEN(b.x)], 1u);
            asm volatile("s_waitcnt vmcnt(0)" ::: "memory");
        } else {
            XB_SPIN(xb_ld(&bar[XB_XGEN(b.x)]) == gen, bar);
            __builtin_amdgcn_fence(__ATOMIC_ACQUIRE, "agent");
            asm volatile("s_waitcnt vmcnt(0)" ::: "memory");
        }
    }
    __syncthreads();
}

struct Frame {
    LAS unsigned char* lds;
    volatile LAS unsigned* MISC;
    gu32* ctl;
    int tid, lane, wave, vcu, G, zz, bx, wid_s;
    unsigned char* ws;
    float* out;
};
struct Args { const float* in[27]; float* out; unsigned char* ws; int ph_lo, ph_hi, bar_li, pad; };

struct TileOrder {
    int nM, nN, nwg, G, c, skip;
    __device__ __forceinline__ void init(int nM_, int nN_, int G_, int c_, int skip_) { nM = nM_; nN = nN_; nwg = nM * nN; G = G_; c = c_; skip = skip_; }
    __device__ __forceinline__ bool next(int i, pg8::Unit& u) const {
        const long L = (long)i * G + c; if (L >= nwg) return false;
        int wgid = (int)L; { const int q = nwg / 8, r = nwg % 8, xcd = wgid % 8, off = wgid / 8; wgid = (xcd < r ? xcd * (q + 1) : r * (q + 1) + (xcd - r) * q) + off; }
        const int nig = 8 * nN, gid = wgid / nig, fm = gid * 8, gsz = (nM - fm) < 8 ? (nM - fm) : 8;
        int pm = fm + ((wgid % nig) % gsz); const int pn = (wgid % nig) / gsz;
        if (skip) pm = (pm >> 4) * 17 + 1 + (pm & 15);
        u.pm = pm; u.pn = pn; u.pb = pn; u.ko = 0; u.aux = 0; return true;
    }
    __device__ __forceinline__ void a_ready(const pg8::Unit&) const {}
    __device__ __forceinline__ void done(const pg8::Unit&) const {}
};
struct MoeOrder {
    int t1, t2, t3, t4, t5, t6, t7, t8, nN, G, c;
    __device__ __forceinline__ void init(const gu32* cnt, int nN_, int G_, int c_) {
        int t = 0;
        t += ((int)__hip_atomic_load(cnt + 0 * 64, RLX_AGENT) + 255) >> 8; t1 = t; t += ((int)__hip_atomic_load(cnt + 1 * 64, RLX_AGENT) + 255) >> 8; t2 = t;
        t += ((int)__hip_atomic_load(cnt + 2 * 64, RLX_AGENT) + 255) >> 8; t3 = t; t += ((int)__hip_atomic_load(cnt + 3 * 64, RLX_AGENT) + 255) >> 8; t4 = t;
        t += ((int)__hip_atomic_load(cnt + 4 * 64, RLX_AGENT) + 255) >> 8; t5 = t; t += ((int)__hip_atomic_load(cnt + 5 * 64, RLX_AGENT) + 255) >> 8; t6 = t;
        t += ((int)__hip_atomic_load(cnt + 6 * 64, RLX_AGENT) + 255) >> 8; t7 = t; t += ((int)__hip_atomic_load(cnt + 7 * 64, RLX_AGENT) + 255) >> 8; t8 = t;
        nN = nN_; G = G_; c = c_;
    }
    __device__ __forceinline__ int tile_off(int e) const { return e == 0 ? 0 : e == 1 ? t1 : e == 2 ? t2 : e == 3 ? t3 : e == 4 ? t4 : e == 5 ? t5 : e == 6 ? t6 : t7; }
    __device__ __forceinline__ bool next(int i, pg8::Unit& u) const {
        const long L = (long)i * G + c; if (L >= (long)t8 * nN) return false;
        const int pm = (int)(L / nN), pn = (int)(L % nN);
        const int e = (pm >= t1) + (pm >= t2) + (pm >= t3) + (pm >= t4) + (pm >= t5) + (pm >= t6) + (pm >= t7);
        u.pm = pm; u.pn = pn; u.pb = e * nN + pn; u.ko = 0; u.aux = 0; return true;
    }
    __device__ __forceinline__ void a_ready(const pg8::Unit&) const {}
    __device__ __forceinline__ void done(const pg8::Unit&) const {}
};

struct CtxSplitOrder {
    int S, kpb, G, c;
    __device__ __forceinline__ void init(int S_, int kp_bytes, int G_, int c_) { S = S_; kpb = kp_bytes; G = G_; c = c_; }
    __device__ __forceinline__ bool next(int i, pg8::Unit& u) const {
        const int L = i * G + c; if (L >= 16 * S) return false;
        const int ks = L % S, pn = (L / S) & 3, ct = L / (4 * S);
        u.pm = ct * 17; u.pn = pn; u.pb = pn; u.ko = ks * kpb; u.aux = ks; return true;
    }
    __device__ __forceinline__ void a_ready(const pg8::Unit&) const {}
    __device__ __forceinline__ void done(const pg8::Unit&) const {}
};
#define EPI_LOOP(...) _Pragma("unroll") for (int ai = 0; ai < 2; ++ai) _Pragma("unroll") for (int m = 0; m < 4; ++m) { const int row = u.pm * 256 + ai * 128 + wr * 64 + m * 16 + fr; \
    _Pragma("unroll") for (int bj = 0; bj < 2; ++bj) { const int col = bj * 128 + wc * 32 + 4 * fq; f32x4 v0 = acc[ai][bj][m][0], v1 = acc[ai][bj][m][1]; __VA_ARGS__ } if (m & 1) asm volatile("" ::: "memory"); }
#define EPI_LOOP8(...) _Pragma("unroll") for (int ai = 0; ai < 2; ++ai) _Pragma("unroll") for (int m = 0; m < 4; ++m) { const int row = u.pm * 256 + ai * 128 + wr * 64 + m * 16 + fr; \
    _Pragma("unroll") for (int bj = 0; bj < 2; ++bj) { const int col = bj * 128 + wc * 32 + 8 * fq; f32x4 v0 = acc[ai][bj][m][0], v1 = acc[ai][bj][m][1]; __VA_ARGS__ } if (m & 1) asm volatile("" ::: "memory"); }
__device__ __forceinline__ v4u pack8(f32x4 a, f32x4 b) { v4u w; w.x = pg8::cvt_pk_bf16(a[0], a[1]); w.y = pg8::cvt_pk_bf16(a[2], a[3]); w.z = pg8::cvt_pk_bf16(b[0], b[1]); w.w = pg8::cvt_pk_bf16(b[2], b[3]); return w; }
__device__ __forceinline__ v2u pack4(f32x4 v) { v2u w; w.x = pg8::cvt_pk_bf16(v[0], v[1]); w.y = pg8::cvt_pk_bf16(v[2], v[3]); return w; }
__device__ __forceinline__ f32x4 unpack4(v2u w) { return (f32x4){bf_lo(w.x), bf_hi(w.x), bf_lo(w.y), bf_hi(w.y)}; }

struct EpiProj {
    static constexpr bool PERM = false, AFTER_DRAIN = false, KHOOK = false;
    bf16* P; const float* rope;
    __device__ __forceinline__ void operator()(const pg8::f32x4 (&acc)[2][2][4][2], const pg8::Unit& u, int wr, int wc, int fr, int fq) const {
        asm volatile("" : "+v"(fr), "+v"(fq));
        const int pn = u.pn;
        if (pn < 4) {
            EPI_LOOP({ const int j = row % RPB;
                if (j >= CTXL) { const int t = j - CTXL; const int pos = (wc & 1) ? (t & 63) : (t >> 6);
                    const f32x4 cs0 = *(const f32x4*)(rope + (pos * 16 + 4 * fq) * 2), cs1 = *(const f32x4*)(rope + (pos * 16 + 4 * fq) * 2 + 4);
                    const float c0 = cs0[0], s0 = cs0[1], c1 = cs0[2], s1 = cs0[3], c2 = cs1[0], s2 = cs1[1], c3 = cs1[2], s3 = cs1[3];
                    const f32x4 a = v0, b = v1;
                    v0[0] = a[0] * c0 - b[0] * s0; v1[0] = b[0] * c0 + a[0] * s0; v0[1] = a[1] * c1 - b[1] * s1; v1[1] = b[1] * c1 + a[1] * s1;
                    v0[2] = a[2] * c2 - b[2] * s2; v1[2] = b[2] * c2 + a[2] * s2; v0[3] = a[3] * c3 - b[3] * s3; v1[3] = b[3] * c3 + a[3] * s3; }
                bf16* o = P + (size_t)row * PLD + pn * 256 + col; *(v2u*)o = pack4(v0); *(v2u*)(o + 16) = pack4(v1); })
        } else {
            EPI_LOOP8({ *(v4u*)(P + (size_t)row * PLD + pn * 256 + col) = pack8(v0, v1); })
        }
    }
};
struct EpiGate {
    static constexpr bool PERM = false, AFTER_DRAIN = false, KHOOK = false;
    bf16* P;
    __device__ __forceinline__ void operator()(const pg8::f32x4 (&acc)[2][2][4][2], const pg8::Unit& u, int wr, int wc, int fr, int fq) const {
        asm volatile("" : "+v"(fr), "+v"(fq));
        EPI_LOOP8({ for (int q = 0; q < 4; ++q) { v0[q] = sigmoidf_(v0[q]); v1[q] = sigmoidf_(v1[q]); }
            *(v4u*)(P + (size_t)row * PLD + PC_GATE + u.pn * 256 + col) = pack8(v0, v1); })
    }
};
struct EpiMergeF {
    static constexpr bool PERM = false, AFTER_DRAIN = false, KHOOK = true;
    bf16* MG; const bf16* P;
    __device__ __forceinline__ void khook(pg8::f32x4 (&acc)[2][2][4][2], const pg8::Unit& u, int t, int wr, int wc, int fr, int fq) const {
        asm volatile("" : "+v"(fr), "+v"(fq));
        const int gnum = PC_GATE + (t == 8 ? 0 : 1024), gden = gnum + 1024;
#pragma unroll
        for (int ai = 0; ai < 2; ++ai)
#pragma unroll
            for (int m = 0; m < 4; ++m) { const int row = u.pm * 256 + ai * 128 + wr * 64 + m * 16 + fr;
#pragma unroll
                for (int bj = 0; bj < 2; ++bj) { const int c = u.pn * 256 + bj * 128 + wc * 32 + 8 * fq; const bf16* gp = P + (size_t)row * PLD + c;
                    const v4u a = *(const v4u*)(gp + gnum), b = *(const v4u*)(gp + gden);
                    const f32x4 n0 = unpack4((v2u){a.x, a.y}), n1 = unpack4((v2u){a.z, a.w}), d0 = unpack4((v2u){b.x, b.y}), d1 = unpack4((v2u){b.z, b.w});
#pragma unroll
                    for (int q = 0; q < 4; ++q) { acc[ai][bj][m][0][q] *= n0[q] * __builtin_amdgcn_rcpf(fmaxf(d0[q], 1e-20f)); acc[ai][bj][m][1][q] *= n1[q] * __builtin_amdgcn_rcpf(fmaxf(d1[q], 1e-20f)); } }
                if (m & 1) asm volatile("" ::: "memory"); }
    }
    __device__ __forceinline__ void operator()(const pg8::f32x4 (&acc)[2][2][4][2], const pg8::Unit& u, int wr, int wc, int fr, int fq) const {
        asm volatile("" : "+v"(fr), "+v"(fq));
        EPI_LOOP8({ const int c = u.pn * 256 + col; const v4u gw = *(const v4u*)(P + (size_t)row * PLD + PC_GATE + 2048 + c);
            *(v4u*)(MG + (size_t)row * DM + c) = pack8(unpack4((v2u){gw.x, gw.y}) * v0, unpack4((v2u){gw.z, gw.w}) * v1); })
    }
};
struct EpiResid {
    static constexpr bool PERM = false, AFTER_DRAIN = false, KHOOK = false;
    float* H; const float* modl; int gidx;
    __device__ __forceinline__ void operator()(const pg8::f32x4 (&acc)[2][2][4][2], const pg8::Unit& u, int wr, int wc, int fr, int fq) const {
        asm volatile("" : "+v"(fr), "+v"(fq));
        EPI_LOOP8({ const int c = u.pn * 256 + col; const int b = row / RPB, j = row - b * RPB; const int mr = j < CTXL ? 4 : b;
            const float* gp = modl + mr * 6144 + gidx * 1024 + c; float* hp = H + (size_t)row * DM + c;
            const f32x4 g0 = *(const f32x4*)gp, g1 = *(const f32x4*)(gp + 4);
            *(f32x4*)hp = *(const f32x4*)hp + g0 * v0; *(f32x4*)(hp + 4) = *(const f32x4*)(hp + 4) + g1 * v1; })
    }
};
struct EpiSlab {
    static constexpr bool PERM = false, AFTER_DRAIN = false, KHOOK = false;
    float* SL; const float* modl; int gidx;
    __device__ __forceinline__ void operator()(const pg8::f32x4 (&acc)[2][2][4][2], const pg8::Unit& u, int wr, int wc, int fr, int fq) const {
        asm volatile("" : "+v"(fr), "+v"(fq));
        const float* gate = modl + 4 * 6144 + gidx * 1024; float* sl = SL + ((size_t)u.aux * 1024 + (u.pm / 17) * 256) * 1024;
#pragma unroll
        for (int ai = 0; ai < 2; ++ai)
#pragma unroll
            for (int m = 0; m < 4; ++m) { const int lr = ai * 128 + wr * 64 + m * 16 + fr;
#pragma unroll
                for (int bj = 0; bj < 2; ++bj) { const int c = u.pn * 256 + bj * 128 + wc * 32 + 8 * fq; const f32x4 g0 = *(const f32x4*)(gate + c), g1 = *(const f32x4*)(gate + c + 4);
                    float* o = sl + (size_t)lr * 1024 + c; *(f32x4*)o = g0 * acc[ai][bj][m][0]; *(f32x4*)(o + 4) = g1 * acc[ai][bj][m][1]; } }
    }
};
struct EpiSwiglu {
    static constexpr bool PERM = false, AFTER_DRAIN = false, KHOOK = false;
    bf16* HID; int ldh;
    __device__ __forceinline__ void operator()(const pg8::f32x4 (&acc)[2][2][4][2], const pg8::Unit& u, int wr, int wc, int fr, int fq) const {
        asm volatile("" : "+v"(fr), "+v"(fq));
#pragma unroll
        for (int ai = 0; ai < 2; ++ai)
#pragma unroll
            for (int m = 0; m < 4; ++m) { const int row = u.pm * 256 + ai * 128 + wr * 64 + m * 16 + fr; f32x4 r0, r1;
#pragma unroll
                for (int q = 0; q < 4; ++q) { r0[q] = siluf_(acc[ai][0][m][0][q]) * acc[ai][0][m][1][q]; r1[q] = siluf_(acc[ai][1][m][0][q]) * acc[ai][1][m][1][q]; }
                *(v4u*)(HID + (size_t)row * ldh + u.pn * 128 + wc * 32 + 8 * fq) = pack8(r0, r1);
                if (m & 1) asm volatile("" ::: "memory"); }
    }
};
struct EpiSwiglu8 {
    static constexpr bool PERM = false, AFTER_DRAIN = false, KHOOK = false;
    unsigned char* HID; int ldh;
    __device__ __forceinline__ void operator()(const pg8::f32x4 (&acc)[2][2][4][2], const pg8::Unit& u, int wr, int wc, int fr, int fq) const {
        asm volatile("" : "+v"(fr), "+v"(fq));
        const float s8 = (float)(1 << F8_ACT_L2);
#pragma unroll
        for (int ai = 0; ai < 2; ++ai)
#pragma unroll
            for (int m = 0; m < 4; ++m) { const int row = u.pm * 256 + ai * 128 + wr * 64 + m * 16 + fr; f32x4 r0, r1;
#pragma unroll
                for (int q = 0; q < 4; ++q) { r0[q] = siluf_(acc[ai][0][m][0][q]) * acc[ai][0][m][1][q] * s8; r1[q] = siluf_(acc[ai][1][m][0][q]) * acc[ai][1][m][1][q] * s8; }
                v2u o; o.x = cvt4_fp8(r0[0], r0[1], r0[2], r0[3]); o.y = cvt4_fp8(r1[0], r1[1], r1[2], r1[3]);
                *(v2u*)(HID + (size_t)row * ldh + u.pn * 128 + wc * 32 + 8 * fq) = o;
                if (m & 1) asm volatile("" ::: "memory"); }
    }
};
struct EpiY {
    static constexpr bool PERM = false, AFTER_DRAIN = false, KHOOK = false;
    bf16* Y; int first;
    __device__ __forceinline__ void operator()(const pg8::f32x4 (&acc)[2][2][4][2], const pg8::Unit& u, int wr, int wc, int fr, int fq) const {
        asm volatile("" : "+v"(fr), "+v"(fq));
        EPI_LOOP8({ (void)first; *(v4u*)(Y + (size_t)row * DM + u.pn * 256 + col) = pack8(v0, v1); })
    }
};

__device__ __forceinline__ int iperm32(int c) { return ((c >> 2) & 1) * 16 + (c >> 3) * 4 + (c & 3); }
template <int MAP> __device__ __forceinline__ int map_col(int c) {
    if (MAP == 0) return c;
    if (MAP == 1) { if (c >= 2560 && (c < 2576 || c >= 2832)) return -1;
        const int d = c < 2560 ? c : PC_POOL + (c - 2576);
        return d < 1024 ? d : (d & ~31) + iperm32(d & 31); }
    if (MAP == 4) return (c & ~31) + iperm32(c & 31);
    { const int x = c & 31; return (c >> 7) * 256 + ((x >> 2) & 1) * 128 + ((c >> 5) & 3) * 32 + (MAP == 3 ? 16 : 0) + 4 * (x >> 3) + (x & 3); }
}
template <int MAP> __device__ __forceinline__ void tr_item(const float* W, int ldw, int N, bf16* WT, int ldd, int item, LAS float* scr, int lane) {
    const int nblk = (N + 31) / 32, kb = item / nblk, nb = item % nblk, k0 = 64 * kb, n0 = 32 * nb;
    const int cl = n0 + (lane & 31);
    float tv[32];
#pragma unroll
    for (int i = 0; i < 32; ++i) { const int kk = 2 * i + (lane >> 5); tv[i] = cl < N ? W[(size_t)(k0 + kk) * ldw + cl] : 0.f; }
#pragma unroll
    for (int i = 0; i < 32; ++i) { const int kk = 2 * i + (lane >> 5); scr[kk * 33 + (lane & 31)] = tv[i]; }
    LDS_WAIT(); asm volatile("" ::: "memory");
    const int c = lane & 7;
#pragma unroll
    for (int j = 0; j < 4; ++j) { const int n = (lane >> 3) + 8 * j; const LAS float* s = scr + (8 * c) * 33 + n;
        const int dr = n0 + n < N ? map_col<MAP>(n0 + n) : -1;
        if (dr >= 0) { v4u o; o.x = pk2(s[0 * 33], s[1 * 33]); o.y = pk2(s[2 * 33], s[3 * 33]); o.z = pk2(s[4 * 33], s[5 * 33]); o.w = pk2(s[6 * 33], s[7 * 33]);
            *(GAS v4u*)(WT + (size_t)dr * ldd + k0 + 8 * c) = o; } }
    LDS_WAIT(); asm volatile("" ::: "memory");
}
template <int MAP> __device__ __forceinline__ void tr_item8(const float* W, int ldw, int N, unsigned char* WT, int ldd, int item, LAS float* scr, int lane, float scale) {
    const int nblk = (N + 31) / 32, kb = item / nblk, nb = item % nblk, k0 = 64 * kb, n0 = 32 * nb;
    const int cl = n0 + (lane & 31);
    float tv[32];
#pragma unroll
    for (int i = 0; i < 32; ++i) { const int kk = 2 * i + (lane >> 5); tv[i] = cl < N ? W[(size_t)(k0 + kk) * ldw + cl] : 0.f; }
#pragma unroll
    for (int i = 0; i < 32; ++i) { const int kk = 2 * i + (lane >> 5); scr[kk * 33 + (lane & 31)] = tv[i]; }
    LDS_WAIT(); asm volatile("" ::: "memory");
    const int c = lane & 7;
#pragma unroll
    for (int j = 0; j < 4; ++j) { const int n = (lane >> 3) + 8 * j; const LAS float* s = scr + (8 * c) * 33 + n;
        if (n0 + n < N) { v2u o; o.x = cvt4_fp8(s[0 * 33] * scale, s[1 * 33] * scale, s[2 * 33] * scale, s[3 * 33] * scale); o.y = cvt4_fp8(s[4 * 33] * scale, s[5 * 33] * scale, s[6 * 33] * scale, s[7 * 33] * scale);
            *(GAS v2u*)(WT + (size_t)map_col<MAP>(n0 + n) * ldd + k0 + 8 * c) = o; } }
    LDS_WAIT(); asm volatile("" ::: "memory");
}
#define TR_RUN(MAP, W, ldw, K, N, WT, ldd) { const int cnt_ = ((K) / 64) * (((N) + 31) / 32); if (r < cnt_) { tr_item<MAP>(W, ldw, N, WT, ldd, r, scr, F.lane); continue; } r -= cnt_; }

constexpr int LW_ITEMS = 16 * 185 + 8 * 32 + 4 * 32 + 4 * 32 + 16 * 32 + 16 * 96 + 64;
__device__ __forceinline__ void conv_layer_weights(Frame& F, const Args& A, int l, int rank, int nranks) {
    LAS float* scr = (LAS float*)(F.lds + F.wave * 16384);
    bf16* WIN = (bf16*)(F.ws + WS_WIN); bf16* WBR = (bf16*)(F.ws + WS_WBR); bf16* WOUT = (bf16*)(F.ws + WS_WOUT);
    const float* win = A.in[F.zz + 8] + (size_t)l * 1024 * INW; const float* wbr = A.in[F.zz + 17] + (size_t)l * 1024 * 1024; const float* wo = A.in[F.zz + 18] + (size_t)l * 1024 * 1024;
    bf16* dbr = WBR + (size_t)l * 1024 * 1024;
    for (int it = rank; it < LW_ITEMS; it += nranks) {
        int r = it;
        { const int cnt_ = 16 * 185; if (r < cnt_) { tr_item<1>(win, INW, INW, WIN + (size_t)l * NPB * 1024, 1024, r, scr, F.lane); continue; } r -= cnt_; }
        { const int cnt_ = 8 * 32; if (r < cnt_) { tr_item<4>(wbr, 1024, 1024, dbr, 1024, r, scr, F.lane); continue; } r -= cnt_; }
        { const int cnt_ = 4 * 32; if (r < cnt_) { tr_item<4>(wbr + 512 * 1024, 1024, 1024, dbr + 512, 1024, r, scr, F.lane); continue; } r -= cnt_; }
        { const int cnt_ = 4 * 32; if (r < cnt_) { tr_item<4>(wbr + 768 * 1024, 1024, 1024, dbr + 768, 1024, r, scr, F.lane); continue; } r -= cnt_; }
        { const int cnt_ = 16 * 32; if (r < cnt_) { tr_item<4>(wo, 1024, 1024, WOUT + (size_t)l * 1024 * 1024, 1024, r, scr, F.lane); continue; } r -= cnt_; }
        { const int cnt_ = 16 * 96; if (r < cnt_) { tr_item8<4>(win + 2832, INW, 3072, F.ws + WS_WG8 + (size_t)l * 3072 * 1024, 1024, r, scr, F.lane, (float)(1 << F8_W13_L2)); continue; } r -= cnt_; }
        { bf16* wab = (bf16*)(F.ws + WS_WAB) + (size_t)l * 16384;
          for (int e = F.lane; e < 256; e += 64) { const int k = r * 16 + (e >> 4), c = e & 15; wab[c * 1024 + k] = (bf16)f2bf(win[(size_t)k * INW + 2560 + c]); } }
    }
}
__device__ __forceinline__ void p0_prologue(Frame& F, const Args& A) {
    LAS float* scr = (LAS float*)(F.lds + F.wave * 16384);
    const int gw = F.vcu * NWAVES + F.wave, NGW = F.G * NWAVES;
    bf16* W13 = (bf16*)(F.ws + WS_W13); bf16* W2 = (bf16*)(F.ws + WS_W2);
    conv_layer_weights(F, A, 0, gw, NGW);
    constexpr int TOTAL = 16 * 88 * 2 + 44 * 32;
    for (int it = gw; it < TOTAL; it += NGW) {
        int r = it;
#ifdef DENSE_F8
        { const int cnt_ = 16 * 88; if (r < cnt_) { tr_item8<2>(A.in[F.zz + 19], FFD, FFD, (unsigned char*)W13, 1024, r, scr, F.lane, (float)(1 << F8_W13_L2)); continue; } r -= cnt_; }
        { const int cnt_ = 16 * 88; if (r < cnt_) { tr_item8<3>(A.in[F.zz + 20], FFD, FFD, (unsigned char*)W13, 1024, r, scr, F.lane, (float)(1 << F8_W13_L2)); continue; } r -= cnt_; }
        tr_item8<4>(A.in[F.zz + 21], 1024, 1024, (unsigned char*)W2, FFD, r, scr, F.lane, (float)(1 << F8_W2_L2));
#else
        { const int cnt_ = 16 * 88; if (r < cnt_) { tr_item<2>(A.in[F.zz + 19], FFD, FFD, W13, 1024, r, scr, F.lane); continue; } r -= cnt_; }
        { const int cnt_ = 16 * 88; if (r < cnt_) { tr_item<3>(A.in[F.zz + 20], FFD, FFD, W13, 1024, r, scr, F.lane); continue; } r -= cnt_; }
        tr_item<4>(A.in[F.zz + 21], 1024, 1024, W2, FFD, r, scr, F.lane);
#endif
    }
    if (F.vcu == 0 && F.tid < 8) __hip_atomic_store(F.ctl + CW_ECNT + 64 * F.tid, 0u, RLX_AGENT);
    float* H = (float*)(F.ws + WS_H);
    for (int R = gw; R < MROWS; R += NGW) { const int b = R / RPB, j = R - b * RPB;
        const float* src = j < CTXL ? A.in[F.zz + 2] + ((size_t)b * CTXL + j) * DM : A.in[F.zz + 0] + ((size_t)b * SEQ + (j - CTXL)) * DM;
        const GAS f32x4* s4 = (const GAS f32x4*)src + F.lane; GAS f32x4* d4 = (GAS f32x4*)(H + (size_t)R * DM) + F.lane;
#pragma unroll
        for (int q = 0; q < 4; ++q) d4[64 * q] = s4[64 * q]; }
    if (F.vcu == 0) {
        float* rope = (float*)(F.ws + WS_ROPE);
        for (int e = F.tid; e < 1024; e += NTHR) { const int pos = e >> 4, i = e & 15; const float inv = powf(10000.f, -(float)i / 16.f); const float a = (float)pos * inv;
            rope[2 * e] = cosf(a); rope[2 * e + 1] = sinf(a); }
        if (F.tid < 2) { const int l = F.tid; const float* lp = A.in[F.zz + 9] + l * 256; float s1 = 0.f, s2 = 0.f;
            for (int i = 0; i < 64; ++i) { s1 += lp[i] * lp[64 + i]; s2 += lp[128 + i] * lp[192 + i]; }
            const float li = 0.8f - 0.6f * expf(-0.3f * (float)l);
            ((float*)(F.ws + WS_LAM))[l] = expf(s1) - expf(s2) + li; }
    }
    __syncthreads();
    float* MOD = (float*)(F.ws + WS_MOD);
    LAS float* red = (LAS float*)F.lds;
    for (int task = F.vcu; task < 2 * 96; task += F.G) {
        const int l = task / 96, cc = task % 96;
        const float* aw = A.in[F.zz + 4] + (size_t)l * 1024 * 6144 + cc * 64 + F.lane;
        const float* c0 = A.in[F.zz + 1]; const float* cx = A.in[F.zz + 3];
        float a0 = 0.f, a1 = 0.f, a2 = 0.f, a3 = 0.f, a4 = 0.f;
#pragma unroll 8
        for (int i = 0; i < 128; ++i) { const int k = F.wave * 128 + i; const float w = aw[(size_t)k * 6144];
            a0 += siluf_(c0[k]) * w; a1 += siluf_(c0[1024 + k]) * w; a2 += siluf_(c0[2048 + k]) * w; a3 += siluf_(c0[3072 + k]) * w; a4 += siluf_(cx[k]) * w; }
        LAS float* rw = red + F.wave * 320 + F.lane;
        rw[0] = a0; rw[64] = a1; rw[128] = a2; rw[192] = a3; rw[256] = a4;
        __syncthreads();
        if (F.tid < 320) { float s = 0.f;
#pragma unroll
            for (int w = 0; w < 8; ++w) s += red[w * 320 + F.tid];
            const int rr = F.tid >> 6, jj = cc * 64 + (F.tid & 63);
            MOD[(l * 5 + rr) * 6144 + jj] = s + A.in[F.zz + 5][l * 6144 + jj]; }
        __syncthreads();
    }
}

__device__ __forceinline__ void moe_convert(Frame& F, const Args& A, int rank, int nranks) {
    LAS float* scr = (LAS float*)(F.lds + F.wave * 16384);
    const int gw = rank, NGW = nranks;
    unsigned char* W13M = F.ws + WS_W13M; unsigned char* W2M = F.ws + WS_W2M;
    constexpr int I13 = 16 * 112, I2 = 56 * 32, PER_E = 2 * I13 + I2;
    for (int it = gw; it < 8 * PER_E; it += NGW) {
        const int e = it / PER_E; int r = it - e * PER_E;
        if (r < I13) { tr_item8<2>(A.in[F.zz + 23] + (size_t)e * 1024 * FFE, FFE, FFE, W13M + (size_t)e * 2 * FFE * 1024, 1024, r, scr, F.lane, (float)(1 << F8_W13_L2)); continue; } r -= I13;
        if (r < I13) { tr_item8<3>(A.in[F.zz + 24] + (size_t)e * 1024 * FFE, FFE, FFE, W13M + (size_t)e * 2 * FFE * 1024, 1024, r, scr, F.lane, (float)(1 << F8_W13_L2)); continue; } r -= I13;
        tr_item8<4>(A.in[F.zz + 25] + (size_t)e * FFE * 1024, 1024, 1024, W2M + (size_t)e * 1024 * FFE, FFE, r, scr, F.lane, (float)(1 << F8_W2_L2));
    }
}

__device__ __forceinline__ void norm_mod_phase(Frame& F, const Args& A, int l, int which, bool latent_only, bool route, bool out8 = false, int nslab = 0) {
    (void)latent_only; (void)route;
    const int gw = F.vcu * NWAVES + F.wave, NGW = F.G * NWAVES;
    const float* H = (const float*)(F.ws + WS_H); bf16* U = (bf16*)(F.ws + WS_U); const float* MOD = (const float*)(F.ws + WS_MOD) + l * 5 * 6144;
    const float* g = (which ? A.in[F.zz + 7] : A.in[F.zz + 6]) + l * 1024;
    f32x4 nv[4];
    if (gw < MROWS) { const GAS f32x4* xr = (const GAS f32x4*)(H + (size_t)gw * DM) + F.lane;
#pragma unroll
        for (int q = 0; q < 4; ++q) nv[q] = xr[64 * q]; }
#pragma unroll 1
    for (int R = gw; R < MROWS; R += NGW) {
        const int b = R / RPB, j = R - b * RPB; const bool isctx = j < CTXL;
        const float* mod = MOD + (isctx ? 4 : b) * 6144; const float* shift = mod + (which ? 3 : 0) * 1024; const float* scale = mod + (which ? 4 : 1) * 1024;
        f32x4 v[4]; float ss = 0.f;
#pragma unroll
        for (int q = 0; q < 4; ++q) v[q] = nv[q];
        if (R + NGW < MROWS) { const GAS f32x4* xr = (const GAS f32x4*)(H + (size_t)(R + NGW) * DM) + F.lane;
#pragma unroll
            for (int q = 0; q < 4; ++q) nv[q] = xr[64 * q]; }
        if (nslab > 0 && isctx) {
            const GAS f32x4* sp = (const GAS f32x4*)((const float*)(F.ws + WS_SLAB) + (size_t)(b * 256 + j) * 1024) + F.lane;
#pragma unroll
            for (int q = 0; q < 4; ++q) { f32x4 t[11];
#pragma unroll
                for (int s = 0; s < 11; ++s) t[s] = s < nslab ? sp[(size_t)s * 262144 + 64 * q] : (f32x4){0.f, 0.f, 0.f, 0.f};
#pragma unroll
                for (int s = 0; s < 11; ++s) v[q] += t[s]; }
            GAS f32x4* hw = (GAS f32x4*)(F.ws + WS_H + (size_t)R * DM * 4) + F.lane;
#pragma unroll
            for (int q = 0; q < 4; ++q) hw[64 * q] = v[q]; }
#pragma unroll
        for (int q = 0; q < 4; ++q) ss += (v[q].x * v[q].x + v[q].y * v[q].y) + (v[q].z * v[q].z + v[q].w * v[q].w);
        const float rstd = 1.f / sqrtf(wave_sum(ss) * (1.f / DM) + EPSN);
        GAS v2u* o8 = (GAS v2u*)(U + (size_t)R * DM) + F.lane;
#pragma unroll
        for (int q = 0; q < 4; ++q) { const int c = 4 * F.lane + 256 * q; const f32x4 gg = *(const f32x4*)(g + c), sh = *(const f32x4*)(shift + c), sc = *(const f32x4*)(scale + c);
            v[q] = (v[q] * rstd) * gg * (sc + 1.f) + sh;
            if (out8) { const float s8 = (float)(1 << F8_ACT_L2); ((GAS unsigned*)((unsigned char*)U + (size_t)R * DM))[F.lane + 64 * q] = cvt4_fp8(v[q].x * s8, v[q].y * s8, v[q].z * s8, v[q].w * s8); }
            else { v2u w; w.x = pk2(v[q].x, v[q].y); w.y = pk2(v[q].z, v[q].w); o8[64 * q] = w; } }
        if (which == 0) {
            const float s8 = (float)(1 << F8_ACT_L2);
#pragma unroll
            for (int q = 0; q < 4; ++q) ((GAS unsigned*)(F.ws + WS_U8 + (size_t)R * DM))[F.lane + 64 * q] = cvt4_fp8(v[q].x * s8, v[q].y * s8, v[q].z * s8, v[q].w * s8);
        }
    }
}
__device__ __forceinline__ void norm2_route_phase(Frame& F, const Args& A) {
    const int l = 1;
    const float* H = (const float*)(F.ws + WS_H); bf16* U = (bf16*)(F.ws + WS_U); const float* MOD = (const float*)(F.ws + WS_MOD) + l * 5 * 6144;
    const float* g = A.in[F.zz + 7] + l * 1024; const float* rw = A.in[F.zz + 22];
    LAS unsigned* wcnt = (LAS unsigned*)F.lds;
    LAS unsigned* gbase = wcnt + 64;
    const int lane = F.lane, wv = F.wave;
    for (int blk = F.vcu; blk < NB * SEQ / 64; blk += F.G) {
        int me0 = 0, me1 = 0; float mw0 = 0.f, mw1 = 0.f;
        f32x4 nv[4];
        { const int tk = blk * 64 + wv * 8, b = tk / SEQ, t = tk - b * SEQ; const GAS f32x4* xr = (const GAS f32x4*)(H + ((size_t)b * RPB + CTXL + t) * DM) + lane;
#pragma unroll
          for (int q = 0; q < 4; ++q) nv[q] = xr[64 * q]; }
#pragma unroll 1
        for (int i = 0; i < 8; ++i) {
            const int tk = blk * 64 + wv * 8 + i, b = tk / SEQ, t = tk - b * SEQ; const size_t R = (size_t)b * RPB + CTXL + t;
            const float* mod = MOD + b * 6144; const float* shift = mod + 3 * 1024; const float* scale = mod + 4 * 1024;
            f32x4 v[4]; float ss = 0.f;
#pragma unroll
            for (int q = 0; q < 4; ++q) { v[q] = nv[q]; ss += (v[q].x * v[q].x + v[q].y * v[q].y) + (v[q].z * v[q].z + v[q].w * v[q].w); }
            if (i < 7) { const GAS f32x4* xr = (const GAS f32x4*)(H + (R + 1) * DM) + lane;
#pragma unroll
                for (int q = 0; q < 4; ++q) nv[q] = xr[64 * q]; }
            const float rstd = 1.f / sqrtf(wave_sum(ss) * (1.f / DM) + EPSN);
            GAS v2u* o8 = (GAS v2u*)(U + R * DM) + lane;
            float lg[8] = {0, 0, 0, 0, 0, 0, 0, 0};
#pragma unroll
            for (int q = 0; q < 4; ++q) { const int c = 4 * lane + 256 * q; const f32x4 gg = *(const f32x4*)(g + c), sh = *(const f32x4*)(shift + c), sc = *(const f32x4*)(scale + c);
                v[q] = (v[q] * rstd) * gg * (sc + 1.f) + sh; v2u w; w.x = pk2(v[q].x, v[q].y); w.y = pk2(v[q].z, v[q].w); o8[64 * q] = w;
#pragma unroll
                for (int j = 0; j < 4; ++j) { const int k = c + j; const f32x4 w0 = *(const f32x4*)(rw + k * 8), w1 = *(const f32x4*)(rw + k * 8 + 4); const float x = v[q][j];
                    lg[0] += x * w0[0]; lg[1] += x * w0[1]; lg[2] += x * w0[2]; lg[3] += x * w0[3]; lg[4] += x * w1[0]; lg[5] += x * w1[1]; lg[6] += x * w1[2]; lg[7] += x * w1[3]; } }
#pragma unroll
            for (int e = 0; e < 8; ++e) lg[e] = wave_sum(lg[e]);
            int e0 = 0; float v0 = lg[0];
#pragma unroll
            for (int e = 1; e < 8; ++e) if (lg[e] > v0) { v0 = lg[e]; e0 = e; }
            int e1 = -1; float v1 = -3.0e38f;
#pragma unroll
            for (int e = 0; e < 8; ++e) if (e != e0 && lg[e] > v1) { v1 = lg[e]; e1 = e; }
            const float ex = __expf(v1 - v0);
            if (lane == i) { me0 = e0; me1 = e1; mw0 = 1.f / (1.f + ex); mw1 = ex / (1.f + ex); }
        }
        const bool act = lane < 8; const unsigned long long below = (1ull << lane) - 1ull;
        unsigned r0 = 0, r1 = 0, mycnt = 0;
#pragma unroll
        for (int e = 0; e < 8; ++e) { const unsigned long long m0 = __ballot(act && me0 == e), m1 = __ballot(act && me1 == e);
            const unsigned bel = (unsigned)__popcll((m0 | m1) & below);
            if (me0 == e) r0 = bel; if (me1 == e) r1 = bel;
            if (lane == e) mycnt = (unsigned)__popcll(m0) + (unsigned)__popcll(m1); }
        if (act) wcnt[wv * 8 + lane] = mycnt;
        __syncthreads();
        if (F.tid < 8) { unsigned tot = 0;
#pragma unroll
            for (int w = 0; w < 8; ++w) tot += wcnt[w * 8 + F.tid];
            gbase[F.tid] = __hip_atomic_fetch_add(F.ctl + CW_ECNT + 64 * F.tid, tot, RLX_AGENT); }
        __syncthreads();
        if (act) { unsigned b0 = gbase[me0], b1 = gbase[me1];
            for (int w = 0; w < wv; ++w) { b0 += wcnt[w * 8 + me0]; b1 += wcnt[w * 8 + me1]; }
            const int tk = blk * 64 + wv * 8 + lane;
            v4u* rt = (v4u*)(F.ws + WS_ROUTE) + 2 * tk;
            rt[0] = (v4u){(unsigned)me0, (unsigned)me1, b0 + r0, b1 + r1}; rt[1] = (v4u){__float_as_uint(mw0), __float_as_uint(mw1), 0u, 0u}; }
        __syncthreads();
    }
}

__device__ __forceinline__ void ab_tiles(Frame& F, const Args& A, int l) {
    typedef short ab_s16x8 __attribute__((ext_vector_type(8)));
    const int gw = F.vcu * NWAVES + F.wave, NGW = F.G * NWAVES, r = F.lane & 15, q = F.lane >> 4;
    const bf16* U = (const bf16*)(F.ws + WS_U); const bf16* wab = (const bf16*)(F.ws + WS_WAB) + (size_t)l * 16384 + r * 1024 + 8 * q;
    const float alog = A.in[F.zz + 12][l * 8 + (r & 7)], dtb = A.in[F.zz + 13][l * 8 + (r & 7)];
    for (int t = gw; t < MROWS / 16; t += NGW) {
        const bf16* up = U + (size_t)(t * 16 + r) * DM + 8 * q; f32x4 acc = {0.f, 0.f, 0.f, 0.f};
#pragma unroll 8
        for (int ks = 0; ks < 32; ++ks) acc = __builtin_amdgcn_mfma_f32_16x16x32_bf16(*(const ab_s16x8*)(up + 32 * ks), *(const ab_s16x8*)(wab + 32 * ks), acc, 0, 0, 0);
        f32x4 o;
#pragma unroll
        for (int g = 0; g < 4; ++g) { const float x = acc[g];
            if (r < 8) { const float z = x + dtb; const float ez = __expf(z); const float sp = z > 15.f ? z : (ez < 0.03f ? ez * (1.f - ez * (0.5f - ez * (1.f / 3.f))) : __logf(1.f + ez)); o[g] = -__expf(alog) * sp; }
            else o[g] = sigmoidf_(x); }
        float* gb = (float*)(F.ws + WS_GB) + (size_t)(t * 16 + 4 * q) * 16 + r;
        gb[0] = o[0]; gb[16] = o[1]; gb[32] = o[2]; gb[48] = o[3];
    }
}

__device__ __forceinline__ void moe_gather2(Frame& F) {
    const int gw = F.vcu * NWAVES + F.wave, NGW = F.G * NWAVES;
    MoeOrder mo; mo.init(F.ctl + CW_ECNT, 1, 1, 0);
    const bf16* U = (const bf16*)(F.ws + WS_U); unsigned char* XG = F.ws + WS_XG; const float sc = (float)(1 << F8_ACT_L2);
    for (int tk = gw; tk < NB * SEQ; tk += NGW) {
        const int b = tk / SEQ, t = tk - b * SEQ; const size_t R = (size_t)b * RPB + CTXL + t;
        const v4u rt = ((const v4u*)(F.ws + WS_ROUTE))[2 * tk];
        const size_t r0 = (size_t)mo.tile_off((int)rt.x) * 256 + rt.z, r1 = (size_t)mo.tile_off((int)rt.y) * 256 + rt.w;
        const GAS v4u* s = (const GAS v4u*)(U + R * DM) + 2 * F.lane; const v4u a = s[0], c = s[1];
        v4u o; o.x = cvt4_fp8(bf_lo(a.x) * sc, bf_hi(a.x) * sc, bf_lo(a.y) * sc, bf_hi(a.y) * sc); o.y = cvt4_fp8(bf_lo(a.z) * sc, bf_hi(a.z) * sc, bf_lo(a.w) * sc, bf_hi(a.w) * sc);
        o.z = cvt4_fp8(bf_lo(c.x) * sc, bf_hi(c.x) * sc, bf_lo(c.y) * sc, bf_hi(c.y) * sc); o.w = cvt4_fp8(bf_lo(c.z) * sc, bf_hi(c.z) * sc, bf_lo(c.w) * sc, bf_hi(c.w) * sc);
        *((GAS v4u*)(XG + r0 * DM) + F.lane) = o; *((GAS v4u*)(XG + r1 * DM) + F.lane) = o;
    }
}
__device__ __forceinline__ void moe_gather(Frame& F) {
    moe_gather2(F);
}
__device__ __forceinline__ void final_phase(Frame& F, const Args& A) {
    const int gw = F.vcu * NWAVES + F.wave, NGW = F.G * NWAVES;
    MoeOrder mo; mo.init(F.ctl + CW_ECNT, 1, 1, 0);
    const float* H = (const float*)(F.ws + WS_H); const bf16* Y = (const bf16*)(F.ws + WS_Y); const float* MOD = (const float*)(F.ws + WS_MOD) + 1 * 5 * 6144;
    for (int tk = gw; tk < NB * SEQ; tk += NGW) {
        const int b = tk / SEQ, t = tk - b * SEQ; const size_t R = (size_t)b * RPB + CTXL + t;
        const v4u rt = ((const v4u*)(F.ws + WS_ROUTE))[2 * tk], rw = ((const v4u*)(F.ws + WS_ROUTE))[2 * tk + 1];
        const size_t r0 = (size_t)mo.tile_off((int)rt.x) * 256 + rt.z, r1 = (size_t)mo.tile_off((int)rt.y) * 256 + rt.w;
        const float w0 = __uint_as_float(rw.x), w1 = __uint_as_float(rw.y);
        const float* gate = MOD + b * 6144 + 5 * 1024;
        f32x4 v[4]; float ss = 0.f;
#pragma unroll
        for (int q = 0; q < 4; ++q) { const int c = 4 * F.lane + 256 * q;
            const f32x4 h = *(const f32x4*)(H + R * DM + c), gg = *(const f32x4*)(gate + c);
            const f32x4 y0 = unpack4(*(const v2u*)(Y + r0 * DM + c)), y1 = unpack4(*(const v2u*)(Y + r1 * DM + c));
            v[q] = h + gg * (y0 * w0 + y1 * w1); ss += (v[q].x * v[q].x + v[q].y * v[q].y) + (v[q].z * v[q].z + v[q].w * v[q].w); }
        const float rstd = 1.f / sqrtf(wave_sum(ss) * (1.f / DM) + EPSN);
#pragma unroll
        for (int q = 0; q < 4; ++q) { const int c = 4 * F.lane + 256 * q; *(f32x4*)(F.out + (size_t)tk * DM + c) = v[q] * rstd * *(const f32x4*)(A.in[F.zz + 26] + c); }
    }
}

constexpr int DP = 65;
typedef short dn_bf16x8 __attribute__((ext_vector_type(8)));
__device__ __forceinline__ f32x4 mm_tile(const LAS float* Am, int a_sm, int a_sk, const LAS float* Bm, int b_sk, int b_sn, int m0, int n0, int lane) {
    const int r = lane & 15, q = lane >> 4; f32x4 acc = {0.f, 0.f, 0.f, 0.f};
#pragma unroll
    for (int ks = 0; ks < 2; ++ks) {
        const LAS float* ap = Am + (m0 + r) * a_sm + (32 * ks + 8 * q) * a_sk; const LAS float* bp = Bm + (32 * ks + 8 * q) * b_sk + (n0 + r) * b_sn;
        v4u a, b;
        a.x = pk2(ap[0], ap[a_sk]); a.y = pk2(ap[2 * a_sk], ap[3 * a_sk]); a.z = pk2(ap[4 * a_sk], ap[5 * a_sk]); a.w = pk2(ap[6 * a_sk], ap[7 * a_sk]);
        b.x = pk2(bp[0], bp[b_sk]); b.y = pk2(bp[2 * b_sk], bp[3 * b_sk]); b.z = pk2(bp[4 * b_sk], bp[5 * b_sk]); b.w = pk2(bp[6 * b_sk], bp[7 * b_sk]);
        acc = __builtin_amdgcn_mfma_f32_16x16x32_bf16(__builtin_bit_cast(dn_bf16x8, a), __builtin_bit_cast(dn_bf16x8, b), acc, 0, 0, 0);
    }
    return acc;
}

constexpr int RS = 72;
constexpr int IMG = 64 * RS * 2;
typedef short dn_s16x4 __attribute__((ext_vector_type(4)));
__device__ __forceinline__ f32x4 mm_img(const LAS bf16* Ai, const LAS bf16* Bi, int m0, int n0, int r, int q) {
    f32x4 acc = {0.f, 0.f, 0.f, 0.f};
    const LAS bf16* ap = Ai + (m0 + r) * RS + 8 * q; const LAS bf16* bp = Bi + (n0 + r) * RS + 8 * q;
    acc = __builtin_amdgcn_mfma_f32_16x16x32_bf16(*(const LAS dn_bf16x8*)ap, *(const LAS dn_bf16x8*)bp, acc, 0, 0, 0);
    acc = __builtin_amdgcn_mfma_f32_16x16x32_bf16(*(const LAS dn_bf16x8*)(ap + 32), *(const LAS dn_bf16x8*)(bp + 32), acc, 0, 0, 0);
    return acc;
}
template <int D> __device__ __forceinline__ void dn_diag_inv(LAS float* Dg, int ln) {
    const int blk = ln >> 4, r = ln & 15;
    LAS float* Ab = Dg + blk * 256;
    float t[16];
#pragma unroll
    for (int c = 0; c < 16; ++c) t[c] = (c == r) ? 1.f : 0.f;
#pragma unroll
    for (int c = 14; c >= 0; --c) { float s = 0.f;
#pragma unroll
        for (int j = c + 1; j < 16; ++j) { const float a = D == 0 ? Ab[j * 16 + c] : Ab[(15 - j) * 16 + (15 - c)]; s -= t[j] * a; }
        t[c] = (c < r) ? s : t[c]; }
    asm volatile("s_waitcnt lgkmcnt(0)" ::: "memory");
#pragma unroll
    for (int c = 0; c < 16; ++c) { if (D == 0) Ab[r * 16 + c] = t[c]; else Ab[(15 - r) * 16 + (15 - c)] = t[c]; }
}
template <int D> __device__ __forceinline__ void dn_solve_tiles(const LAS bf16* Ad, const LAS float* Dg, const LAS bf16* VT, const LAS bf16* KT, LAS bf16* UT, LAS bf16* WT,
                                                               const LAS float* Bd, const LAS float* Gd, int w4, int ln) {
    const int r = ln & 15, q = ln >> 4;
#pragma unroll 1
    for (int i = 0; i < 2; ++i) { const int nt = w4 * 2 + i; const bool isw = nt >= 4; const int c0 = (nt & 3) * 16 + r;
        const LAS bf16* src = (isw ? KT : VT) + c0 * RS; LAS bf16* dst = (isw ? WT : UT) + c0 * RS;
        f32x4 acc[4]; dn_s16x4 xb[4];
#pragma unroll
        for (int bi = 0; bi < 4; ++bi) { const v2u x = *(const LAS v2u*)(src + 16 * bi + 4 * q); const f32x4 xv = {bf_lo(x.x), bf_hi(x.x), bf_lo(x.y), bf_hi(x.y)};
#pragma unroll
            for (int g = 0; g < 4; ++g) { const int t = 16 * bi + 4 * q + g; const float sc = isw ? Bd[t] * __expf(Gd[t]) : Bd[t]; acc[bi][g] = xv[g] * sc; } }
#pragma unroll
        for (int st = 0; st < 4; ++st) { const int bi = D == 0 ? st : 3 - st;
#pragma unroll
            for (int s2 = 0; s2 < st; ++s2) { const int bj = D == 0 ? s2 : 3 - s2;
                v2u a = *(const LAS v2u*)(Ad + (16 * bi + r) * RS + 16 * bj + 4 * q); a.x ^= 0x80008000u; a.y ^= 0x80008000u;
                acc[bi] = __builtin_amdgcn_mfma_f32_16x16x16bf16_1k(__builtin_bit_cast(dn_s16x4, a), xb[bj], acc[bi], 0, 0, 0); }
            { const LAS float* tp = Dg + bi * 256 + r * 16 + 4 * q; v2u a; a.x = cvtpk_c(tp[0], tp[1]); a.y = cvtpk_c(tp[2], tp[3]);
              v2u xr; xr.x = cvtpk_c(acc[bi][0], acc[bi][1]); xr.y = cvtpk_c(acc[bi][2], acc[bi][3]);
              acc[bi] = __builtin_amdgcn_mfma_f32_16x16x16bf16_1k(__builtin_bit_cast(dn_s16x4, a), __builtin_bit_cast(dn_s16x4, xr), (f32x4){0.f, 0.f, 0.f, 0.f}, 0, 0, 0);
              v2u xo; xo.x = cvtpk_c(acc[bi][0], acc[bi][1]); xo.y = cvtpk_c(acc[bi][2], acc[bi][3]); xb[bi] = __builtin_bit_cast(dn_s16x4, xo);
              *(LAS v2u*)(dst + 16 * bi + 4 * q) = xo; }
        }
    }
}
__device__ __forceinline__ void dn_pre_unit(Frame& F, const Args& A, int l, int b, int n, int h) {
    LAS bf16* KcB = (LAS bf16*)(F.lds + 0 * IMG); LAS bf16* QcB = (LAS bf16*)(F.lds + 1 * IMG); LAS bf16* KT = (LAS bf16*)(F.lds + 2 * IMG); LAS bf16* VT = (LAS bf16*)(F.lds + 3 * IMG);
#define DIMG(d, k) ((LAS bf16*)(F.lds + (4 + 5 * (d) + (k)) * IMG))
    LAS float* Gs = (LAS float*)(F.lds + 14 * IMG);
    LAS float* Bs = Gs + 128;
    LAS float* Dg = Gs + 256;
    const bf16* P = (const bf16*)(F.ws + WS_PROJ); const float* GB = (const float*)(F.ws + WS_GB);
    const int tid = pg8::tid_from(F.wid_s);
    const int wv = tid >> 6, ln = tid & 63, r = ln & 15, q = ln >> 4;
    const int row0 = b * RPB + n * 64; const int seq_lo = (n < 4) ? b * RPB : b * RPB + CTXL, seq_hi = (n < 4) ? b * RPB + CTXL : (b + 1) * RPB;
    {
        const int t = tid >> 3, cg = tid & 7;
        const float* cw = A.in[F.zz + 11] + (size_t)l * 5 * 768;
#pragma unroll
        for (int p = 0; p < 3; ++p) {
            const int ch = p * 256 + h * 64 + cg * 8;
            float acc[8] = {0, 0, 0, 0, 0, 0, 0, 0};
#pragma unroll
            for (int tap = 0; tap < 5; ++tap) { const int rr = row0 + t + tap - 2;
                if (rr >= seq_lo && rr < seq_hi) { const v4u x = *(const v4u*)(P + (size_t)rr * PLD + PC_DQ + ch);
                    const f32x4 w0 = *(const f32x4*)(cw + tap * 768 + ch), w1 = *(const f32x4*)(cw + tap * 768 + ch + 4);
                    acc[0] += bf_lo(x.x) * w0[0]; acc[1] += bf_hi(x.x) * w0[1]; acc[2] += bf_lo(x.y) * w0[2]; acc[3] += bf_hi(x.y) * w0[3];
                    acc[4] += bf_lo(x.z) * w1[0]; acc[5] += bf_hi(x.z) * w1[1]; acc[6] += bf_lo(x.w) * w1[2]; acc[7] += bf_hi(x.w) * w1[3]; } }
            float ss = 0.f;
#pragma unroll
            for (int i = 0; i < 8; ++i) { acc[i] = siluf_(acc[i]); ss += acc[i] * acc[i]; }
            float sc = 1.f;
            if (p < 2) { ss = grp8_sum(ss); sc = (1.f / sqrtf(ss + EPSN)) * (p == 0 ? 0.125f : 1.f); }
            v4u o; o.x = cvtpk_c(acc[0] * sc, acc[1] * sc); o.y = cvtpk_c(acc[2] * sc, acc[3] * sc); o.z = cvtpk_c(acc[4] * sc, acc[5] * sc); o.w = cvtpk_c(acc[6] * sc, acc[7] * sc);
            if (p == 0) *(LAS v4u*)(QcB + t * RS + cg * 8) = o;
            else { if (p == 1) *(LAS v4u*)(KcB + t * RS + cg * 8) = o;
                LAS bf16* tp = (p == 1 ? KT : VT) + (cg * 8) * RS + t;
                tp[0 * RS] = (bf16)(o.x & 0xffffu); tp[1 * RS] = (bf16)(o.x >> 16); tp[2 * RS] = (bf16)(o.y & 0xffffu); tp[3 * RS] = (bf16)(o.y >> 16);
                tp[4 * RS] = (bf16)(o.z & 0xffffu); tp[5 * RS] = (bf16)(o.z >> 16); tp[6 * RS] = (bf16)(o.w & 0xffffu); tp[7 * RS] = (bf16)(o.w >> 16); }
        }
        if (wv < 2) { const int d = wv; const float* gb = GB + (size_t)(row0 + ln) * 16; const float g = gb[d * 4 + h]; Bs[d * 64 + ln] = gb[8 + d * 4 + h];
            float pf = g;
            { const int lid = lane_id_();
#pragma unroll
              for (int o = 1; o < 64; o <<= 1) { const float v = lane_get(pf, lid >= o ? lid - o : lid); if (lid >= o) pf += v; }
            }
            const float tot = lane_get(pf, 63);
            Gs[d * 64 + ln] = d == 0 ? pf : tot - pf + g; }
    }
    __syncthreads();
    {
#pragma unroll
        for (int i = 0; i < 2; ++i) { const int tile = wv * 2 + i, m0 = (tile >> 2) * 16, n0 = (tile & 3) * 16;
            const f32x4 kk = mm_img(KcB, KcB, m0, n0, r, q), qk = mm_img(QcB, KcB, m0, n0, r, q);
            const int s = n0 + r; const float g0s = Gs[s], g1s = Gs[64 + s];
#pragma unroll
            for (int g = 0; g < 4; ++g) { const int t = m0 + 4 * q + g; const float e0 = __expf(Gs[t] - g0s), e1 = __expf(Gs[64 + t] - g1s);
                const float a0 = (s < t) ? Bs[t] * kk[g] * e0 : 0.f, a1 = (s > t) ? Bs[64 + t] * kk[g] * e1 : 0.f;
                DIMG(0, 0)[t * RS + s] = (bf16)f2bf(a0); DIMG(1, 0)[t * RS + s] = (bf16)f2bf(a1);
                DIMG(0, 1)[t * RS + s] = (bf16)f2bf((s <= t) ? qk[g] * e0 : 0.f); DIMG(1, 1)[t * RS + s] = (bf16)f2bf((s >= t) ? qk[g] * e1 : 0.f);
                if (m0 == n0) { Dg[(m0 >> 4) * 256 + (t & 15) * 16 + r] = a0; Dg[1024 + (m0 >> 4) * 256 + (t & 15) * 16 + r] = a1; } } }
        { const int c = tid >> 3, t0 = (tid & 7) * 8; const v4u kx = *(const LAS v4u*)(KT + c * RS + t0); const float gl0 = Gs[63], gl1 = Gs[64];
          const float kf[8] = {bf_lo(kx.x), bf_hi(kx.x), bf_lo(kx.y), bf_hi(kx.y), bf_lo(kx.z), bf_hi(kx.z), bf_lo(kx.w), bf_hi(kx.w)};
          float s0[8], s1[8];
#pragma unroll
          for (int j = 0; j < 8; ++j) { s0[j] = kf[j] * __expf(gl0 - Gs[t0 + j]); s1[j] = kf[j] * __expf(gl1 - Gs[64 + t0 + j]); }
          v4u o0, o1; o0.x = cvtpk_c(s0[0], s0[1]); o0.y = cvtpk_c(s0[2], s0[3]); o0.z = cvtpk_c(s0[4], s0[5]); o0.w = cvtpk_c(s0[6], s0[7]);
          o1.x = cvtpk_c(s1[0], s1[1]); o1.y = cvtpk_c(s1[2], s1[3]); o1.z = cvtpk_c(s1[4], s1[5]); o1.w = cvtpk_c(s1[6], s1[7]);
          *(LAS v4u*)(DIMG(0, 4) + c * RS + t0) = o0; *(LAS v4u*)(DIMG(1, 4) + c * RS + t0) = o1; }
    }
    __syncthreads();
    if (wv == 0) dn_diag_inv<0>(Dg, ln); else if (wv == 4) dn_diag_inv<1>(Dg + 1024, ln);
    __syncthreads();
    if (wv < 4) dn_solve_tiles<0>(DIMG(0, 0), Dg, VT, KT, DIMG(0, 3), DIMG(0, 2), Bs, Gs, wv & 3, ln);
    else dn_solve_tiles<1>(DIMG(1, 0), Dg + 1024, VT, KT, DIMG(1, 3), DIMG(1, 2), Bs + 64, Gs + 64, wv & 3, ln);
    __syncthreads();
    {
        const int d = wv >> 2, mt = wv & 3;
        const LAS bf16* Aq = DIMG(d, 1); const LAS bf16* WT = DIMG(d, 2); const LAS bf16* UT = DIMG(d, 3); const LAS bf16* KsT = DIMG(d, 4); const LAS float* Gd = Gs + d * 64;
        const float glast = d == 0 ? Gd[63] : Gd[0];
        const size_t prob = (((size_t)b * NCHUNK + n) * 4 + h) * 2 + d;
        unsigned char* out = F.ws + WS_DNP + prob * 32768;
        if (ln == 0 && mt == 0) ((float*)(F.ws + WS_DNG))[prob] = __expf(glast);
        const float gq = __expf(Gd[16 * mt + r]);
#pragma unroll
        for (int ks = 0; ks < 2; ++ks) {
            const f32x4 y0 = mm_img(WT, Aq, 32 * ks, 16 * mt, r, q), y1 = mm_img(WT, Aq, 32 * ks + 16, 16 * mt, r, q);
            const LAS bf16* qp = QcB + (16 * mt + r) * RS + 32 * ks + 4 * q; const v2u qa = *(const LAS v2u*)qp, qb = *(const LAS v2u*)(qp + 16);
            v4u o; o.x = cvtpk_c(gq * bf_lo(qa.x) - y0[0], gq * bf_hi(qa.x) - y0[1]); o.y = cvtpk_c(gq * bf_lo(qa.y) - y0[2], gq * bf_hi(qa.y) - y0[3]);
            o.z = cvtpk_c(gq * bf_lo(qb.x) - y1[0], gq * bf_hi(qb.x) - y1[1]); o.w = cvtpk_c(gq * bf_lo(qb.y) - y1[2], gq * bf_hi(qb.y) - y1[3]);
            *(v4u*)(out + (mt * 2 + ks) * 1024 + ln * 16) = o;
            const f32x4 c0 = mm_img(WT, KsT, 32 * ks, 16 * mt, r, q), c1 = mm_img(WT, KsT, 32 * ks + 16, 16 * mt, r, q);
            v4u oc; oc.x = cvtpk_c(-c0[0], -c0[1]); oc.y = cvtpk_c(-c0[2], -c0[3]); oc.z = cvtpk_c(-c1[0], -c1[1]); oc.w = cvtpk_c(-c1[2], -c1[3]);
            *(v4u*)(out + 8192 + (mt * 2 + ks) * 1024 + ln * 16) = oc; }
#pragma unroll
        for (int nt = 0; nt < 4; ++nt) { const f32x4 rr = mm_img(Aq, UT, 16 * mt, 16 * nt, r, q), bb = mm_img(KsT, UT, 16 * mt, 16 * nt, r, q);
            v2u o; o.x = cvtpk_c(rr[0], rr[1]); o.y = cvtpk_c(rr[2], rr[3]); *(v2u*)(out + 16384 + (mt * 4 + nt) * 512 + ln * 8) = o;
            v2u ob; ob.x = cvtpk_c(bb[0], bb[1]); ob.y = cvtpk_c(bb[2], bb[3]); *(v2u*)(out + 24576 + (mt * 4 + nt) * 512 + ln * 8) = ob; }
    }
    __syncthreads();
#ifdef DBG_DN
    { unsigned char* out = F.ws + WS_DNP + ((((size_t)b * NCHUNK + n) * 4 + h) * 2) * 32768;
      if (DBG_DN < 14) { const LAS bf16* im = (const LAS bf16*)(F.lds + DBG_DN * IMG);
          for (int e = tid; e < 4096; e += NTHR) ((bf16*)out)[e] = im[(e >> 6) * RS + (e & 63)]; }
      else { for (int e = tid; e < 2304; e += NTHR) ((bf16*)out)[e] = (bf16)f2bf(Gs[e]); for (int e = 2304 + tid; e < 4096; e += NTHR) ((bf16*)out)[e] = 0; } }
    __syncthreads();
#endif
#undef DIMG
}

__device__ __forceinline__ void pool_unit(Frame& F, const Args& A, int l, int blk, int g) {
    LAS float* Uw = (LAS float*)F.lds;
    LAS float* Mm = Uw + 80 * DP;
    LAS float* PW = Mm + 64 * DP;
    const bf16* P = (const bf16*)(F.ws + WS_PROJ); bf16* PO = (bf16*)(F.ws + WS_POOLO);
    const int tid = pg8::tid_from(F.wid_s);
    const int row0 = blk * 64, b = row0 / RPB, j0 = row0 - b * RPB; const bool isctx = j0 < CTXL;
    const int seq_lo = isctx ? b * RPB : b * RPB + CTXL, L = isctx ? CTXL : SEQ; const int pos0 = row0 - seq_lo;
    for (int idx = tid; idx < 640; idx += NTHR) { const int rr = idx >> 3, c8 = (idx & 7) * 8; const int pos = pos0 - 8 + rr;
        float v[8] = {0, 0, 0, 0, 0, 0, 0, 0};
        if (pos >= 0 && pos < L) { const v4u x = *(const v4u*)(P + (size_t)(seq_lo + pos) * PLD + PC_POOL + g * 64 + c8);
            v[0] = bf_lo(x.x); v[1] = bf_hi(x.x); v[2] = bf_lo(x.y); v[3] = bf_hi(x.y); v[4] = bf_lo(x.z); v[5] = bf_hi(x.z); v[6] = bf_lo(x.w); v[7] = bf_hi(x.w); }
#pragma unroll
        for (int i = 0; i < 8; ++i) Uw[rr * DP + c8 + i] = v[i]; }
    { const float* pw = A.in[F.zz + 15] + ((size_t)l * 4 + g) * 4096;
#pragma unroll
      for (int k = 0; k < 8; ++k) { const int e = tid + 512 * k; PW[(e >> 6) * DP + (e & 63)] = pw[e]; } }
    __syncthreads();
    const int win = 2 << g;
#pragma unroll 1
    for (int k = 0; k < 8; ++k) { const int e = tid + 512 * k, t = e >> 6, i = e & 63; const int pos = pos0 + t;
        int lo = pos - win / 2, hi = lo + win; lo = lo < 0 ? 0 : lo; hi = hi > L ? L : hi;
        float s = 0.f;
#pragma unroll 4
        for (int p = lo; p < hi; ++p) s += Uw[(p - pos0 + 8) * DP + i];
        Mm[t * DP + i] = s / (float)(hi - lo) - Uw[(t + 8) * DP + i]; }
    __syncthreads();
    const float* psc = A.in[F.zz + 16] + l * 256 + g * 64;
    { const int wv = tid >> 6, ln = tid & 63, r = ln & 15, q = ln >> 4;
#pragma unroll
      for (int i = 0; i < 2; ++i) { const int tile = wv * 2 + i, m0 = (tile >> 2) * 16, n0 = (tile & 3) * 16;
          const f32x4 y = mm_tile(Mm, DP, 1, PW, DP, 1, m0, n0, ln); const float sc = psc[n0 + r];
#pragma unroll
          for (int gg = 0; gg < 4; ++gg) PO[(size_t)(row0 + m0 + 4 * q + gg) * 256 + g * 64 + n0 + r] = (bf16)f2bf(y[gg] * sc); } }
    __syncthreads();
}

constexpr int SC_SLOT = 32768, SC_NSLOT = 4, SC_ST = SC_SLOT * SC_NSLOT, SC_GL = SC_ST + 2 * 8192;
__device__ __forceinline__ void dn_scan_item(Frame& F, int item) {
    typedef short s16x8v __attribute__((ext_vector_type(8)));
    const int d = item & 1, h = (item >> 1) & 3, b = item >> 3;
    const int tid = pg8::tid_from(F.wid_s);
    const int wv = __builtin_amdgcn_readfirstlane(tid >> 6), ln = tid & 63, r = ln & 15, q = ln >> 4;
    LAS unsigned char* L = F.lds;
    LAS float* glv = (LAS float*)(L + SC_GL);
    const unsigned char* dnp = F.ws + WS_DNP;
#define SC_N(st) (d == 0 ? (st) : ((st) < 4 ? 3 - (st) : 71 - (st)))
#define SC_PROB(st) ((((size_t)b * NCHUNK + SC_N(st)) * 4 + h) * 2 + d)
    if (tid < NCHUNK) glv[tid] = ((const float*)(F.ws + WS_DNG))[SC_PROB(tid)];
    for (int e = tid; e < 2 * 8192 / 16; e += NTHR) ((LAS v4u*)(L + SC_ST))[e] = (v4u){0u, 0u, 0u, 0u};
    asm volatile("s_waitcnt vmcnt(0) lgkmcnt(0)" ::: "memory"); __builtin_amdgcn_s_barrier();
#define SC_DMA(st, slot) do { const unsigned char* src_ = dnp + SC_PROB(st) * 32768 + wv * 8192 + ln * 16; \
        _Pragma("unroll") for (int i_ = 0; i_ < 8; ++i_) __builtin_amdgcn_global_load_lds((const unsigned*)(src_ + i_ * 1024), (LAS unsigned*)(L + (slot) * SC_SLOT + wv * 8192 + i_ * 1024), 16, 0, 0); } while (0)
    if (wv < 4) { SC_DMA(0, 0); SC_DMA(1, 1); SC_DMA(2, 2); }
    f32x4 s0 = {0.f, 0.f, 0.f, 0.f}, s1 = s0, s2 = s0, s3 = s0;
    bf16* DNO = (bf16*)(F.ws + WS_DNO) + (size_t)d * MROWS * 256;
#pragma unroll 1
    for (int st = 0; st < NCHUNK; ++st) {
        if (wv < 4) asm volatile("s_waitcnt vmcnt(16)" ::: "memory");
        asm volatile("s_waitcnt lgkmcnt(0)" ::: "memory"); __builtin_amdgcn_s_barrier();
        if (wv < 4) { const int nx = st + 3 < NCHUNK ? st + 3 : NCHUNK - 1; SC_DMA(nx, (st + 3) & 3); }
        const LAS unsigned char* slot = L + (st & 3) * SC_SLOT;
        const LAS unsigned char* stc = L + SC_ST + (st & 1) * 8192; LAS unsigned char* stn = L + SC_ST + ((st + 1) & 1) * 8192;
        const int nt = wv & 3;
        const s16x8v bf0 = *(const LAS s16x8v*)(stc + (nt * 2 + 0) * 1024 + ln * 16), bf1 = *(const LAS s16x8v*)(stc + (nt * 2 + 1) * 1024 + ln * 16);
        if (wv < 4) {
            const float gl = glv[st];
            const LAS unsigned char* cf = slot + 8192; const LAS unsigned char* bi = slot + 24576;
#define SC_ST_TILE(S, mt) do { const v2u bw_ = *(const LAS v2u*)(bi + ((mt) * 4 + nt) * 512 + ln * 8); \
            f32x4 a_ = {gl * S[0] + bf_lo(bw_.x), gl * S[1] + bf_hi(bw_.x), gl * S[2] + bf_lo(bw_.y), gl * S[3] + bf_hi(bw_.y)}; \
            a_ = __builtin_amdgcn_mfma_f32_16x16x32_bf16(*(const LAS s16x8v*)(cf + ((mt) * 2 + 0) * 1024 + ln * 16), bf0, a_, 0, 0, 0); \
            a_ = __builtin_amdgcn_mfma_f32_16x16x32_bf16(*(const LAS s16x8v*)(cf + ((mt) * 2 + 1) * 1024 + ln * 16), bf1, a_, 0, 0, 0); S = a_; } while (0)
            SC_ST_TILE(s0, 0); SC_ST_TILE(s1, 1); SC_ST_TILE(s2, 2); SC_ST_TILE(s3, 3);
#undef SC_ST_TILE
            v4u w0, w1; w0.x = pk2(s0[0], s0[1]); w0.y = pk2(s0[2], s0[3]); w0.z = pk2(s1[0], s1[1]); w0.w = pk2(s1[2], s1[3]);
            w1.x = pk2(s2[0], s2[1]); w1.y = pk2(s2[2], s2[3]); w1.z = pk2(s3[0], s3[1]); w1.w = pk2(s3[2], s3[3]);
            *(LAS v4u*)(stn + (nt * 2 + 0) * 1024 + ln * 16) = w0; *(LAS v4u*)(stn + (nt * 2 + 1) * 1024 + ln * 16) = w1;
        } else {
            const LAS unsigned char* pf = slot; const LAS unsigned char* ri = slot + 16384;
            const int n = SC_N(st);
            bf16* orow = DNO + (size_t)(b * RPB + n * 64 + 4 * q) * 256 + h * 64 + nt * 16 + r;
#pragma unroll
            for (int mt = 0; mt < 4; ++mt) { const v2u rw_ = *(const LAS v2u*)(ri + (mt * 4 + nt) * 512 + ln * 8);
                f32x4 a_ = {bf_lo(rw_.x), bf_hi(rw_.x), bf_lo(rw_.y), bf_hi(rw_.y)};
                a_ = __builtin_amdgcn_mfma_f32_16x16x32_bf16(*(const LAS s16x8v*)(pf + (mt * 2 + 0) * 1024 + ln * 16), bf0, a_, 0, 0, 0);
                a_ = __builtin_amdgcn_mfma_f32_16x16x32_bf16(*(const LAS s16x8v*)(pf + (mt * 2 + 1) * 1024 + ln * 16), bf1, a_, 0, 0, 0);
#pragma unroll
                for (int g = 0; g < 4; ++g) orow[(size_t)(16 * mt + g) * 256] = (bf16)f2bf(a_[g]); }
        }
    }
    asm volatile("s_waitcnt vmcnt(0) lgkmcnt(0)" ::: "memory"); __builtin_amdgcn_s_barrier();
#undef SC_DMA
#undef SC_N
#undef SC_PROB
}

__device__ __forceinline__ void mix_build(Frame& F, const Args& A, int l) {
    const int lane = pg8::lane_id_asm(); const int gw = F.vcu * NWAVES + F.wave, NGW = F.G * NWAVES;
    const bf16* ATTO = (const bf16*)(F.ws + WS_ATTO); const bf16* P = (const bf16*)(F.ws + WS_PROJ); const bf16* DNO = (const bf16*)(F.ws + WS_DNO); bf16* MIX = (bf16*)(F.ws + WS_MIX);
    const float lam = ((const float*)(F.ws + WS_LAM))[l]; const float li = 0.8f - 0.6f * expf(-0.3f * (float)l);
    const float* sg = A.in[F.zz + 10] + l * 128; const float* ng = A.in[F.zz + 14] + l * 64;
    for (int R = gw; R < MROWS; R += NGW) {
        const int j = R % RPB; if (l == 1 && j < CTXL) continue;
        { const int hh = lane >> 4, e0 = (lane & 15) * 8;
          const v4u a = *(const v4u*)(ATTO + (size_t)R * DM + (hh * 2) * 128 + e0), c = *(const v4u*)(ATTO + (size_t)R * DM + (hh * 2 + 1) * 128 + e0);
          float x[8] = {bf_lo(a.x) - lam * bf_lo(c.x), bf_hi(a.x) - lam * bf_hi(c.x), bf_lo(a.y) - lam * bf_lo(c.y), bf_hi(a.y) - lam * bf_hi(c.y),
                        bf_lo(a.z) - lam * bf_lo(c.z), bf_hi(a.z) - lam * bf_hi(c.z), bf_lo(a.w) - lam * bf_lo(c.w), bf_hi(a.w) - lam * bf_hi(c.w)};
          float ss = 0.f;
#pragma unroll
          for (int i = 0; i < 8; ++i) ss += x[i] * x[i];
          ss = grp16_sum(ss);
          const float sc = (1.f / sqrtf(ss * (1.f / 128.f) + EPSN)) * (1.f - li);
          const f32x4 g0 = *(const f32x4*)(sg + e0), g1 = *(const f32x4*)(sg + e0 + 4);
          v4u o; o.x = pk2(x[0] * sc * g0[0], x[1] * sc * g0[1]); o.y = pk2(x[2] * sc * g0[2], x[3] * sc * g0[3]); o.z = pk2(x[4] * sc * g1[0], x[5] * sc * g1[1]); o.w = pk2(x[6] * sc * g1[2], x[7] * sc * g1[3]);
          *(v4u*)(MIX + (size_t)R * DM + hh * 128 + e0) = o; }
        { const int c0 = lane * 4;
          const v2u a = *(const v2u*)(DNO + (size_t)R * 256 + c0), c = *(const v2u*)(DNO + ((size_t)MROWS + R) * 256 + c0), z = *(const v2u*)(P + (size_t)R * PLD + PC_DZ + c0);
          float x[4] = {bf_lo(a.x) + bf_lo(c.x), bf_hi(a.x) + bf_hi(c.x), bf_lo(a.y) + bf_lo(c.y), bf_hi(a.y) + bf_hi(c.y)};
          float ss = x[0] * x[0] + x[1] * x[1] + x[2] * x[2] + x[3] * x[3];
          ss = grp16_sum(ss);
          const float sc = 1.f / sqrtf(ss * (1.f / 64.f) + EPSN);
          const f32x4 gg = *(const f32x4*)(ng + (c0 & 63));
          v2u o; o.x = pk2(x[0] * sc * gg[0] * siluf_(bf_lo(z.x)), x[1] * sc * gg[1] * siluf_(bf_hi(z.x))); o.y = pk2(x[2] * sc * gg[2] * siluf_(bf_lo(z.y)), x[3] * sc * gg[3] * siluf_(bf_hi(z.y)));
          *(v2u*)(MIX + (size_t)R * DM + 512 + c0) = o; }
        { const v2u pz = *(const v2u*)((const bf16*)(F.ws + WS_POOLO) + (size_t)R * 256 + lane * 4); *(v2u*)(MIX + (size_t)R * DM + 768 + lane * 4) = pz; }
    }
}

#ifndef MK_N_LAUNCHES
#define MK_N_LAUNCHES 1
#endif
__device__ __forceinline__ bool in_phase(int k, int lo, int hi) { asm volatile("" : "+s"(lo), "+s"(hi)); return lo <= k && k < hi; }
__global__ void __launch_bounds__(NTHR, 2) mk_fwd(Args args) {
    extern __shared__ __attribute__((aligned(16))) unsigned char lds[];
    Frame F;
    F.lds = (LAS unsigned char*)lds;
    F.MISC = (volatile LAS unsigned*)(F.lds + MISC_OFF);
    F.wid_s = __builtin_amdgcn_readfirstlane((int)(threadIdx.x >> 6));
    F.tid = pg8::tid_from(F.wid_s); F.lane = F.tid & 63; F.wave = F.wid_s;
    F.G = gridDim.x; { const int bx = blockIdx.x; F.bx = bx; F.vcu = (F.G % 8 == 0) ? (bx % 8) * (F.G / 8) + bx / 8 : bx; }
    F.ws = args.ws; F.out = args.out; F.zz = 0;
    F.ctl = (gu32*)(args.ws + WS_CTL);
    for (int u = F.tid; u < (LDS_BYTES - MISC_OFF) / 4; u += NTHR) ((LAS unsigned*)(F.lds + MISC_OFF))[u] = 0u;
    __syncthreads();
    const int lo = args.ph_lo, hi = args.ph_hi;
    const bool use_bar = (hi - lo) > 1;
    XcdBarrier bar; bar.bar = ((unsigned*)(F.ctl + CW_BAR) + args.bar_li * XCD_BAR_WORDS); bar.x = 0; bar.st = nullptr; bar.wid = (unsigned)F.wid_s;
    if (use_bar) bar = xcd_barrier_post(((unsigned*)(F.ctl + CW_BAR) + args.bar_li * XCD_BAR_WORDS), F.MISC + 8, (unsigned)F.wid_s);
#ifndef EN_MASK
#define EN_MASK 0xFFFFFFFFu
#endif
#define IN(k) (((EN_MASK >> ((k) > 12 ? (k) - 12 : (k))) & 1u) && in_phase((k), lo, hi))
#define PB() do { GAS unsigned char* w_ = (GAS unsigned char*)args.ws; LAS unsigned char* l_ = (LAS unsigned char*)lds; int z_ = 0; asm volatile("" : "+s"(w_), "+s"(l_), "+s"(z_)); F.ws = (unsigned char*)w_; F.ctl = (gu32*)w_; F.lds = l_; F.zz = z_; { int bx_ = blockIdx.x; asm volatile("" : "+s"(bx_)); F.bx = bx_; F.vcu = (F.G % 8 == 0) ? (bx_ % 8) * (F.G / 8) + bx_ / 8 : bx_; } const int t_ = pg8::tid_from(F.wid_s); F.tid = t_; F.lane = t_ & 63; F.wave = F.wid_s; } while (0)
#ifdef DBG_DUP
#define NREP(k) ((((k) > 12 && (k) < 23) ? (k) - 12 : (k)) == DBG_DUP ? 2 : 1)
#else
#define NREP(k) 1
#endif
#define SEAMX() do { XcdBarrier bl_ = bar; { GAS unsigned* b_ = (GAS unsigned*)(args.ws + WS_CTL) + CW_BAR + args.bar_li * XCD_BAR_WORDS; unsigned x_ = bar.x; asm volatile("" : "+s"(b_), "+s"(x_)); bl_.bar = (unsigned*)b_; bl_.x = x_; } xcd_barrier(bl_); } while (0)
#define PH_BEGIN(k) if (IN(k)) { for (int rep_ = 0; rep_ < NREP(k); ++rep_) { if (rep_) SEAMX(); PB();
#define PH_END(k) } } SEAM(k);
#define SEAM(k) do { if (IN(k) && IN((k) + 1)) { XcdBarrier bl_ = bar; { GAS unsigned* b_ = (GAS unsigned*)(args.ws + WS_CTL) + CW_BAR + args.bar_li * XCD_BAR_WORDS; unsigned x_ = bar.x; asm volatile("" : "+s"(b_), "+s"(x_)); bl_.bar = (unsigned*)b_; bl_.x = x_; } xcd_barrier(bl_); } } while (0)
    char* ldsg = (char*)lds;

    PH_BEGIN(PH_PRO) p0_prologue(F, args); PH_END(PH_PRO)

#pragma unroll 1
    for (int l = 0; l < 2; ++l) {
        const int pb = 1 + 12 * l;
        const float* modl = (const float*)(F.ws + WS_MOD) + l * 5 * 6144;
        PH_BEGIN(pb + PH_N1) norm_mod_phase(F, args, l, 0, false, false, false, l == 1 ? 11 : 0); PH_END(pb + PH_N1)
        PH_BEGIN(pb + PH_PROJ)
            { pg8::Gemm g{(const bf16*)(F.ws + WS_U), (const bf16*)(F.ws + WS_WIN) + (size_t)l * NPB * 1024, 1024, 1024, 1024, 0, 0, F.wid_s};
              TileOrder S; S.init(MROWS / 256, NPB / 256, F.G, F.bx, 0);
              EpiProj E{(bf16*)(F.ws + WS_PROJ), (const float*)(F.ws + WS_ROPE)};
              pg8::gemm_phase<EpiProj, TileOrder, true, true>(F.lds, g, S, E); }
            { pg8::Gemm g{(const bf16*)(F.ws + WS_U8), (const bf16*)(F.ws + WS_WG8 + (size_t)l * 3072 * 1024), 512, 512, 512, E8(F8_ACT_L2), E8(F8_W13_L2), F.wid_s};
              TileOrder S; S.init(MROWS / 256, 12, F.G, F.bx, 0);
              EpiGate E{(bf16*)(F.ws + WS_PROJ)};
              pg8::gemm_phase8<EpiGate, TileOrder, true, true>(F.lds, g, S, E); }
            ab_tiles(F, args, l);
        PH_END(pb + PH_PROJ)
        PH_BEGIN(pb + PH_ATT)
            const bf16* P = (const bf16*)(F.ws + WS_PROJ); bf16* AO = (bf16*)(F.ws + WS_ATTO);
            const int nunits = 512 + (l == 0 ? 32 : 0);
#ifndef DIS_ATTN
#ifdef DBG_DUP
            for (int r2_ = 0; r2_ < (DBG_DUP == 31 ? 2 : 1); ++r2_)
#endif
#pragma unroll 1
            for (int u = F.vcu; u < nunits; u += F.G) {
                int b, hm, qrow, seq;
                if (u < 512) { b = u >> 7; hm = (u >> 4) & 7; qrow = CTXL + (u & 15) * 256; seq = RPB; }
                else { const int v = u - 512; b = v >> 3; hm = v & 7; qrow = 0; seq = CTXL; }
                const size_t r0 = (size_t)b * RPB;
                attn::attn_unit<PLD, DM>(P + (r0 + qrow) * PLD + PC_AQ + hm * 64, P + r0 * PLD + PC_AK + hm * 64, P + r0 * PLD + PC_AV + (hm >> 1) * 128,
                                           AO + (r0 + qrow) * DM + hm * 128, seq, (char*)F.lds, F.wid_s);
            }
#endif
#ifndef DIS_DNPRE
#ifdef DBG_DUP
            for (int r2_ = 0; r2_ < (DBG_DUP == 32 ? 2 : 1); ++r2_)
#endif
#pragma unroll 1
            for (int u = F.vcu; u < NB * NCHUNK * 4; u += F.G) { const int h = u & 3, n = (u >> 2) % NCHUNK, b = (u >> 2) / NCHUNK; dn_pre_unit(F, args, l, b, n, h); }
#endif
        PH_END(pb + PH_ATT)
        PH_BEGIN(pb + PH_SCAN)
#pragma unroll 1
            for (int it = F.vcu; it < 32; it += F.G) dn_scan_item(F, it);
            { const bool many = F.G > 32; const int rk = many ? F.vcu - 32 : F.vcu, nr = many ? F.G - 32 : F.G;
              if (rk >= 0) {
#pragma unroll 1
                for (int u = rk; u < (MROWS / 64) * 4; u += nr) pool_unit(F, args, l, u >> 2, u & 3);
                if (l == 0) conv_layer_weights(F, args, 1, rk * NWAVES + F.wave, nr * NWAVES);
                else moe_convert(F, args, rk * NWAVES + F.wave, nr * NWAVES); } }
        PH_END(pb + PH_SCAN)
        PH_BEGIN(pb + PH_MIXB) mix_build(F, args, l); PH_END(pb + PH_MIXB)
        if (IN(pb + PH_MRG0)) { PB();
            pg8::Gemm g{(const bf16*)(F.ws + WS_MIX), (const bf16*)(F.ws + WS_WBR) + (size_t)l * 1024 * 1024, 1024, 1024, 1024, 0, 0, F.wid_s};
            TileOrder S; S.init(l == 0 ? 68 : 64, 4, F.G, F.bx, l);
            EpiMergeF E{(bf16*)(F.ws + WS_MG), (const bf16*)(F.ws + WS_PROJ)};
            pg8::gemm_phase<EpiMergeF, TileOrder, true, true>(F.lds, g, S, E);
        } SEAM(pb + PH_MRG2);
        if (IN(pb + PH_OUT)) { PB();
            { pg8::Gemm g{(const bf16*)(F.ws + WS_MG), (const bf16*)(F.ws + WS_WOUT) + (size_t)l * 1024 * 1024, 1024, 1024, 1024, 0, 0, F.wid_s};
              TileOrder S; S.init(64, 4, F.G, F.bx, 1);
              EpiResid E{(float*)(F.ws + WS_H), modl, 2};
              pg8::gemm_phase<EpiResid, TileOrder, true, true>(F.lds, g, S, E); }
            if (l == 0) {
              pg8::Gemm g{(const bf16*)(F.ws + WS_MG), (const bf16*)(F.ws + WS_WOUT), 256, 1024, 1024, 0, 0, F.wid_s};
              CtxSplitOrder S; S.init(4, 512, F.G, F.bx);
              EpiSlab E{(float*)(F.ws + WS_SLAB), modl, 2};
              pg8::gemm_phase<EpiSlab, CtxSplitOrder, true, true>(F.lds, g, S, E); }
        } SEAM(pb + PH_OUT);
#ifdef DENSE_F8
        PH_BEGIN(pb + PH_N2) norm_mod_phase(F, args, l, 1, l == 1, l == 1, l == 0); PH_END(pb + PH_N2)
#else
        PH_BEGIN(pb + PH_N2) if (l == 0) norm_mod_phase(F, args, 0, 1, false, false, false, 4); else norm2_route_phase(F, args); PH_END(pb + PH_N2)
#endif
        if (l == 0) {
#ifdef DENSE_F8
            PH_BEGIN(PH_FUP)
                pg8::Gemm g{(const bf16*)(F.ws + WS_U), (const bf16*)(F.ws + WS_W13), 512, 512, 512, E8(F8_ACT_L2), E8(F8_W13_L2), F.wid_s};
                TileOrder S; S.init(68, 2 * FFD / 256, F.G, F.bx, 0);
                EpiSwiglu8 E{F.ws + WS_HID, FFD};
                pg8::gemm_phase8<EpiSwiglu8, TileOrder, true, true>(F.lds, g, S, E);
            PH_END(PH_FUP)
            if (IN(PH_FDN)) { PB();
                pg8::Gemm g{(const bf16*)(F.ws + WS_HID), (const bf16*)(F.ws + WS_W2), FFD / 2, FFD / 2, FFD / 2, E8(F8_ACT_L2), E8(F8_W2_L2), F.wid_s};
                TileOrder S; S.init(68, 4, F.G, F.bx, 0);
                EpiResid E{(float*)(F.ws + WS_H), modl, 5};
                pg8::gemm_phase8<EpiResid, TileOrder, true, true>(F.lds, g, S, E);
            } SEAM(PH_FDN);
#else
            PH_BEGIN(PH_FUP)
                pg8::Gemm g{(const bf16*)(F.ws + WS_U), (const bf16*)(F.ws + WS_W13), 1024, 1024, 1024, 0, 0, F.wid_s};
                TileOrder S; S.init(68, 2 * FFD / 256, F.G, F.bx, 0);
                EpiSwiglu E{(bf16*)(F.ws + WS_HID), FFD};
                pg8::gemm_phase<EpiSwiglu, TileOrder, true, true>(F.lds, g, S, E);
            PH_END(PH_FUP)
            if (IN(PH_FDN)) { PB();
                { pg8::Gemm g{(const bf16*)(F.ws + WS_HID), (const bf16*)(F.ws + WS_W2), FFD, FFD, FFD, 0, 0, F.wid_s};
                  TileOrder S; S.init(64, 4, F.G, F.bx, 1);
                  EpiResid E{(float*)(F.ws + WS_H), modl, 5};
                  pg8::gemm_phase<EpiResid, TileOrder, true, true>(F.lds, g, S, E); }
                { pg8::Gemm g{(const bf16*)(F.ws + WS_HID), (const bf16*)(F.ws + WS_W2), 256, FFD, FFD, 0, 0, F.wid_s};
                  CtxSplitOrder S; S.init(11, 512, F.G, F.bx);
                  EpiSlab E{(float*)(F.ws + WS_SLAB), modl, 5};
                  pg8::gemm_phase<EpiSlab, CtxSplitOrder, true, true>(F.lds, g, S, E); }
            } SEAM(PH_FDN);
#endif
        }
    }
    PH_BEGIN(PH_GATH) moe_gather(F); PH_END(PH_GATH)
#pragma unroll 1
    for (int hh = 0; hh < 1; ++hh) {
        const int p0 = PH_CV0 + 3 * hh;
        PH_BEGIN(p0 + 1)
            pg8::Gemm g{(const bf16*)(F.ws + WS_XG), (const bf16*)(F.ws + WS_W13M), 512, 512, 512, E8(F8_ACT_L2), E8(F8_W13_L2), F.wid_s};
            MoeOrder S; S.init(F.ctl + CW_ECNT, 2 * FFE / 256, F.G, F.vcu);
            EpiSwiglu8 E{F.ws + WS_HIDM, FFE};
            pg8::gemm_phase8<EpiSwiglu8, MoeOrder, true, true>(F.lds, g, S, E);
        PH_END(p0 + 1)
        if (IN(p0 + 2)) { PB();
            pg8::Gemm g{(const bf16*)(F.ws + WS_HIDM), (const bf16*)(F.ws + WS_W2M), FFE / 2, FFE / 2, FFE / 2, E8(F8_ACT_L2), E8(F8_W2_L2), F.wid_s};
            MoeOrder S; S.init(F.ctl + CW_ECNT, 4, F.G, F.vcu);
            EpiY E{(bf16*)(F.ws + WS_Y), 1};
            pg8::gemm_phase8<EpiY, MoeOrder, true, true>(F.lds, g, S, E);
        } SEAM(p0 + 2);
    }
    PH_BEGIN(PH_FIN) final_phase(F, args); } }
#ifdef DBG_STOP
    if (lo == 100) {
        const int gw = F.vcu * NWAVES + F.wave, NGW = F.G * NWAVES;
        for (int tk = gw; tk < NB * SEQ; tk += NGW) { const int b = tk / SEQ, t = tk - b * SEQ; const size_t R = (size_t)b * RPB + CTXL + t;
#if DBG_SRC == 0
            const f32x4* s = (const f32x4*)((const float*)(args.ws + WS_H) + R * DM) + F.lane; f32x4* d = (f32x4*)(args.out + (size_t)tk * DM) + F.lane;
            for (int q = 0; q < 4; ++q) d[64 * q] = s[64 * q];
#elif DBG_SRC == 2
            MoeOrder mo; mo.init((gu32*)args.ws + CW_ECNT, 1, 1, 0); const v4u rt = ((const v4u*)(args.ws + WS_ROUTE))[2 * tk];
            const size_t rr = (size_t)mo.tile_off((int)rt.x) * 256 + rt.z; (void)R;
            const bf16* s = (const bf16*)(args.ws + DBG_OFF) + rr * DBG_LD + DBG_COL; float* d = args.out + (size_t)tk * DM;
            for (int q = 0; q < 16; ++q) d[F.lane + 64 * q] = bf2f(s[F.lane + 64 * q]);
#else
#ifdef DBG_MOD
            const bf16* s = (const bf16*)(args.ws + DBG_OFF) + (R % DBG_MOD) * DBG_LD + DBG_COL; float* d = args.out + (size_t)tk * DM;
#else
            const bf16* s = (const bf16*)(args.ws + DBG_OFF) + R * DBG_LD + DBG_COL; float* d = args.out + (size_t)tk * DM;
#endif
            for (int q = 0; q < 16; ++q) { float v = bf2f(s[F.lane + 64 * q]); d[F.lane + 64 * q] = (v == v && fabsf(v) < 1e30f) ? v : DBG_NANVAL; }
#endif
        }
    }
#endif
#undef IN
#undef SEAM
}

extern "C" void kernel_launch(void* const* d_in, const int* in_sizes, int n_in, void* d_out, int out_size, void* d_ws, size_t ws_size, hipStream_t stream) {
    static int grid = 0;
    if (grid == 0) {
        if (n_in != 27 || in_sizes[0] != NB * SEQ * DM || out_size != NB * SEQ * DM || ws_size < WS_END) {
            fprintf(stderr, "kernel_launch: shape / workspace mismatch (n_in %d, in0 %d, out %d, ws %zu, need %zu); nothing launched\n", n_in, n_in > 0 ? in_sizes[0] : -1, out_size, ws_size, (size_t)WS_END); grid = -1; return; }
        int dev = 0, cus = 0, per_cu = 0;
        if (hipGetDevice(&dev) != hipSuccess || hipDeviceGetAttribute(&cus, hipDeviceAttributeMultiprocessorCount, dev) != hipSuccess) { grid = -1; return; }
        if (hipFuncSetAttribute((const void*)mk_fwd, hipFuncAttributeMaxDynamicSharedMemorySize, LDS_BYTES) != hipSuccess) { fprintf(stderr, "kernel_launch: hipFuncSetAttribute failed\n"); grid = -1; return; }
        if (hipOccupancyMaxActiveBlocksPerMultiprocessor(&per_cu, (const void*)mk_fwd, NTHR, LDS_BYTES) != hipSuccess || per_cu < 1)
            fprintf(stderr, "kernel_launch: note: occupancy query reports %d workgroups per CU\n", per_cu);
        (void)hipGetLastError();
        grid = cus;
    }
    if (grid < 0) return;
    if (hipMemsetAsync((char*)d_ws + WS_CTL, 0, CTL_ZERO_BYTES, stream) != hipSuccess) return;
    Args a{};
    for (int i = 0; i < 27; ++i) a.in[i] = (const float*)d_in[i];
    a.out = (float*)d_out; a.ws = (unsigned char*)d_ws;
    constexpr int NL = MK_N_LAUNCHES;
#ifdef DBG_STOP
    constexpr int NLL = DBG_STOP + 2;
#else
    constexpr int NLL = NL;
#endif
#ifdef DBG_PREFIX
    for (int li = 0; li < 2; ++li) { a.ph_lo = 0; a.ph_hi = li == 0 ? DBG_PREFIX + 1 : PH_COUNT; a.bar_li = li;
        hipLaunchKernelGGL(mk_fwd, dim3(grid), dim3(NTHR), LDS_BYTES, stream, a); }
    return;
#endif
    for (int li = 0; li < NLL; ++li) {
#ifdef DBG_SKIP_LO
        if (li >= DBG_SKIP_LO && li <= DBG_SKIP_HI) continue;
#endif
        a.ph_lo = (NL == 1) ? 0 : li; a.ph_hi = (NL == 1) ? PH_COUNT : li + 1;
#ifdef DBG_STOP
        a.ph_lo = li; a.ph_hi = li + 1;
        if (li == NLL - 1) { a.ph_lo = 100; a.ph_hi = 101; }
#endif
        hipLaunchKernelGGL(mk_fwd, dim3(grid), dim3(NTHR), LDS_BYTES, stream, a);
        const hipError_t le = hipPeekAtLastError();
        if (le != hipSuccess) { fprintf(stderr, "kernel_launch: launch %d failed: %s\n", li, hipGetErrorName(le)); break; }
    }
}
```

```cpp
#include <hip/hip_runtime.h>
#include <cstdio>
#include <cstdint>
#include <cmath>

namespace pg8 {
#define PG8_LAS __attribute__((address_space(3)))
typedef unsigned short bf16_t;
typedef short bf16x8 __attribute__((ext_vector_type(8)));
typedef float f32x4 __attribute__((ext_vector_type(4)));
typedef unsigned u32x4 __attribute__((ext_vector_type(4)));
typedef unsigned u32x2 __attribute__((ext_vector_type(2)));
constexpr int BM = 256, BK = 64, HALF = 128, HTB = HALF * BK * 2  , STAGE_BYTES = 8 * HTB;

__host__ __device__ __forceinline__ int lds_byte(int r, int c) { const int st = (r >> 4) * 2 + (c >> 5), rr = r & 15, cc = c & 31, ob = rr * 64 + cc * 2; return st * 1024 + (ob ^ (((ob >> 9) & 1) << 5)); }
__host__ __device__ __forceinline__ void stage_rc(int b, int& R, int& C) { const int st = b / 1024, sb = b % 1024, swz = sb ^ (((sb >> 9) & 1) << 5); R = (st >> 1) * 16 + swz / 64; C = (st & 1) * 32 + (swz % 64) / 2; }
__host__ __device__ __forceinline__ int perm32(int rho) { const int n = rho >> 4, i = rho & 15; return 8 * (i >> 2) + 4 * n + (i & 3); }

__device__ __forceinline__ int lane_id_asm() { int l; asm volatile("v_mbcnt_lo_u32_b32 %0, -1, 0\n\tv_mbcnt_hi_u32_b32 %0, -1, %0" : "=v"(l)); return l; }
__device__ __forceinline__ int tid_from(int wid) { return (wid << 6) | lane_id_asm(); }
struct Unit { int pm, pn, pb, ko, aux; };
struct Gemm { const bf16_t* A; const bf16_t* Bt; int K, lda, ldb, sA, sB, wid; };

__device__ __forceinline__ unsigned cvt_pk_bf16(float lo, float hi) { unsigned r; asm volatile("v_cvt_pk_bf16_f32 %0, %1, %2" : "=v"(r) : "v"(lo), "v"(hi)); return r; }
template <class Epi, class Sched, bool ALIGN_EPI = false, bool SP2 = false>
__device__ __forceinline__ void gemm_phase(PG8_LAS unsigned char* lds, const Gemm g, const Sched& S, const Epi& E) {
    const int wid = g.wid; const int tid = tid_from(wid), lane = tid & 63, wr = wid >> 2, wc = wid & 3, fr = lane & 15, fq = lane >> 4;
    const int K = g.K, nt = K / BK;
    unsigned voffA[2], voffB[2];
#pragma unroll
    for (int i = 0; i < 2; ++i) { int R, C; stage_rc(tid * 16 + i * 8192, R, C); const int Rb = Epi::PERM ? ((R & ~31) + perm32(R & 31)) : R;
        voffA[i] = (unsigned)(R * g.lda + C) * 2u; voffB[i] = (unsigned)(Rb * g.ldb + C) * 2u; }
    const size_t kstep = (size_t)(BK * 2);
    const size_t hstepA = (size_t)HALF * g.lda * 2, hstepB = (size_t)HALF * g.ldb * 2;
    const size_t tstepA = 2 * hstepA, tstepB = 2 * hstepB;
    const unsigned ldsw = (unsigned)wid * 1024u;
    const int aoff = lds_byte(wr * 64 + fr, fq * 8), boff = lds_byte(wc * 32 + fr, fq * 8);
#define PG8_SA(b, h) (((b) * 2 + (h)) * HTB)
#define PG8_SB(b, h) ((4 + (b) * 2 + (h)) * HTB)
#define PG8_STAGE(bufoff, gbase, voff) do { _Pragma("unroll") for (int _i = 0; _i < 2; ++_i) \
        __builtin_amdgcn_global_load_lds((const unsigned*)((const char*)(gbase) + (voff)[_i]), (PG8_LAS unsigned*)(lds + (bufoff) + ldsw + _i * 8192), 16, 0, 0); } while (0)
#define PG8_LDA(dst, b, h) do { _Pragma("unroll") for (int m = 0; m < 4; ++m) _Pragma("unroll") for (int k = 0; k < 2; ++k) dst[m][k] = *(const PG8_LAS bf16x8*)(lds + PG8_SA(b, h) + aoff + m * 2048 + k * 1024); } while (0)
#define PG8_LDB(dst, b, h) do { _Pragma("unroll") for (int n = 0; n < 2; ++n) _Pragma("unroll") for (int k = 0; k < 2; ++k) dst[n][k] = *(const PG8_LAS bf16x8*)(lds + PG8_SB(b, h) + boff + n * 2048 + k * 1024); } while (0)
#define PG8_MMA(ai, bj, At, Bt) do { __builtin_amdgcn_s_setprio(1); _Pragma("unroll") for (int m = 0; m < 4; ++m) _Pragma("unroll") for (int n = 0; n < 2; ++n) _Pragma("unroll") for (int k = 0; k < 2; ++k) \
        acc[ai][bj][m][n] = __builtin_amdgcn_mfma_f32_16x16x32_bf16(Bt[n][k], At[m][k], acc[ai][bj][m][n], 0, 0, 0); __builtin_amdgcn_s_setprio(0); } while (0)
#define PG8_WAIT_V(n) asm volatile("s_waitcnt vmcnt(" #n ")" ::: "memory")
#define PG8_WAIT_L(n) asm volatile("s_waitcnt lgkmcnt(" #n ")" ::: "memory")
#define PG8_BAR __builtin_amdgcn_s_barrier()
#define PG8_SCHED __builtin_amdgcn_sched_barrier(0)
    Unit cur, nxt; int ui = 0;
    if (!S.next(0, cur)) return;
    f32x4 acc[2][2][4][2];
#pragma unroll
    for (int a = 0; a < 2; ++a)
#pragma unroll
        for (int b = 0; b < 2; ++b)
#pragma unroll
            for (int m = 0; m < 4; ++m)
#pragma unroll
                for (int n = 0; n < 2; ++n) acc[a][b][m][n] = (f32x4){0.f, 0.f, 0.f, 0.f};
    bf16x8 At[4][2], B0[2][2], B1[2][2];
    const char* cA = (const char*)g.A + (size_t)cur.pm * tstepA + cur.ko; const char* cB = (const char*)g.Bt + (size_t)cur.pb * tstepB + cur.ko;
    S.a_ready(cur);
    if constexpr (SP2) {
        PG8_STAGE(PG8_SB(0, 0), cB, voffB); PG8_STAGE(PG8_SB(0, 1), cB + hstepB, voffB); PG8_STAGE(PG8_SA(0, 0), cA, voffA); PG8_STAGE(PG8_SA(0, 1), cA + hstepA, voffA);
        if (wr == 1) PG8_BAR;
        PG8_WAIT_V(2); PG8_BAR;
        PG8_STAGE(PG8_SB(1, 0), cB + kstep, voffB); PG8_STAGE(PG8_SA(1, 0), cA + kstep, voffA); PG8_STAGE(PG8_SB(1, 1), cB + hstepB + kstep, voffB);
        PG8_WAIT_V(6); PG8_BAR;
    } else {
        PG8_STAGE(PG8_SB(0, 0), cB, voffB); PG8_STAGE(PG8_SA(0, 0), cA, voffA); PG8_STAGE(PG8_SB(0, 1), cB + hstepB, voffB); PG8_STAGE(PG8_SA(0, 1), cA + hstepA, voffA);
        if (wr == 1) PG8_BAR;
        PG8_WAIT_V(4); PG8_BAR;
        PG8_STAGE(PG8_SB(1, 0), cB + kstep, voffB); PG8_STAGE(PG8_SA(1, 0), cA + kstep, voffA); PG8_STAGE(PG8_SB(1, 1), cB + hstepB + kstep, voffB);
        PG8_WAIT_V(6); PG8_BAR;
    }
    for (;;) {
        const bool has_next = S.next(ui + 1, nxt);
        const char* nA = has_next ? (const char*)g.A + (size_t)nxt.pm * tstepA + nxt.ko : cA; const char* nB = has_next ? (const char*)g.Bt + (size_t)nxt.pb * tstepB + nxt.ko : cB;
        for (int t = 0; t < nt; t += 2) {
            if constexpr (Epi::KHOOK) { if (t == 8 || t == 12) E.khook(acc, cur, t, wr, wc, fr, fq); }
            const bool last = (t == nt - 2);
            const char* a1 = cA + (size_t)(t + 1) * kstep;
            const char* a2 = last ? nA : cA + (size_t)(t + 2) * kstep; const char* b2 = last ? nB : cB + (size_t)(t + 2) * kstep;
            const char* a3 = a2 + kstep; const char* b3 = b2 + kstep;
            if (last && has_next) S.a_ready(nxt);
            if constexpr (SP2) {
            PG8_LDB(B0, 0, 0); PG8_LDB(B1, 0, 1); PG8_SCHED; PG8_LDA(At, 0, 0); PG8_STAGE(PG8_SA(1, 1), a1 + hstepA, voffA);
            PG8_WAIT_V(8); PG8_WAIT_L(0); PG8_BAR; PG8_MMA(0, 0, At, B0); PG8_MMA(0, 1, At, B1); PG8_BAR; PG8_SCHED;
            PG8_LDA(At, 0, 1); PG8_STAGE(PG8_SB(0, 0), b2, voffB); PG8_STAGE(PG8_SB(0, 1), b2 + hstepB, voffB); PG8_STAGE(PG8_SA(0, 0), a2, voffA);
            PG8_WAIT_V(8); PG8_WAIT_L(0); PG8_BAR; PG8_MMA(1, 0, At, B0); PG8_MMA(1, 1, At, B1); PG8_BAR; PG8_SCHED;
            PG8_LDB(B0, 1, 0); PG8_LDB(B1, 1, 1); PG8_SCHED; PG8_LDA(At, 1, 0); PG8_STAGE(PG8_SA(0, 1), a2 + hstepA, voffA);
            PG8_WAIT_V(8); PG8_WAIT_L(0); PG8_BAR; PG8_MMA(0, 0, At, B0); PG8_MMA(0, 1, At, B1); PG8_BAR; PG8_SCHED;
            PG8_LDA(At, 1, 1); PG8_STAGE(PG8_SB(1, 0), b3, voffB); PG8_STAGE(PG8_SB(1, 1), b3 + hstepB, voffB); PG8_STAGE(PG8_SA(1, 0), a3, voffA);
            PG8_WAIT_V(8); PG8_WAIT_L(0); PG8_BAR; PG8_MMA(1, 0, At, B0); PG8_MMA(1, 1, At, B1); PG8_BAR; PG8_SCHED;
            } else {
            PG8_LDB(B0, 0, 0); PG8_SCHED; PG8_LDA(At, 0, 0); PG8_STAGE(PG8_SA(1, 1), a1 + hstepA, voffA);
            PG8_WAIT_L(8); PG8_BAR; PG8_WAIT_L(0); PG8_MMA(0, 0, At, B0); PG8_BAR; PG8_SCHED;
            PG8_LDB(B1, 0, 1); PG8_STAGE(PG8_SB(0, 0), b2, voffB);
            PG8_BAR; PG8_WAIT_L(0); PG8_MMA(0, 1, At, B1); PG8_BAR;
            PG8_LDA(At, 0, 1); PG8_STAGE(PG8_SA(0, 0), a2, voffA);
            PG8_BAR; PG8_WAIT_L(0); PG8_MMA(1, 0, At, B0); PG8_BAR; PG8_SCHED;
            PG8_STAGE(PG8_SB(0, 1), b2 + hstepB, voffB);
            PG8_WAIT_V(6); PG8_BAR; PG8_MMA(1, 1, At, B1); PG8_BAR;
            PG8_LDB(B0, 1, 0); PG8_SCHED; PG8_LDA(At, 1, 0); PG8_STAGE(PG8_SA(0, 1), a2 + hstepA, voffA);
            PG8_WAIT_L(8); PG8_BAR; PG8_WAIT_L(0); PG8_MMA(0, 0, At, B0); PG8_BAR; PG8_SCHED;
            PG8_LDB(B1, 1, 1); PG8_STAGE(PG8_SB(1, 0), b3, voffB);
            PG8_BAR; PG8_WAIT_L(0); PG8_MMA(0, 1, At, B1); PG8_BAR;
            PG8_LDA(At, 1, 1); PG8_STAGE(PG8_SA(1, 0), a3, voffA);
            PG8_BAR; PG8_WAIT_L(0); PG8_MMA(1, 0, At, B0); PG8_BAR; PG8_SCHED;
            PG8_STAGE(PG8_SB(1, 1), b3 + hstepB, voffB);
            PG8_WAIT_V(6); PG8_BAR; PG8_MMA(1, 1, At, B1); PG8_BAR;
            }
        }
        if constexpr (ALIGN_EPI) { if (wr == 0) PG8_BAR; }
        if constexpr (!Epi::AFTER_DRAIN) { E(acc, cur, wr, wc, fr, fq); S.done(cur); }
        if (!has_next) break;
#pragma unroll
        for (int a = 0; a < 2; ++a)
#pragma unroll
            for (int b = 0; b < 2; ++b)
#pragma unroll
                for (int m = 0; m < 4; ++m)
#pragma unroll
                    for (int n = 0; n < 2; ++n) acc[a][b][m][n] = (f32x4){0.f, 0.f, 0.f, 0.f};
        cur = nxt; cA = nA; cB = nB; ++ui;
        if constexpr (ALIGN_EPI) { if (wr == 1) PG8_BAR; }
    }
    PG8_WAIT_V(0);
    if constexpr (!ALIGN_EPI) { if (wr == 0) PG8_BAR; }
    PG8_BAR;
    if constexpr (Epi::AFTER_DRAIN) { E.fused(acc, cur, wr, wc, fr, fq, lds, wid, lane); S.done(cur); }
#undef PG8_SA
#undef PG8_SB
#undef PG8_STAGE
#undef PG8_LDA
#undef PG8_LDB
#undef PG8_MMA
#undef PG8_WAIT_V
#undef PG8_WAIT_L
#undef PG8_BAR
#undef PG8_SCHED
}
template <class Epi, class Sched, bool ALIGN_EPI = false, bool SP2 = false>
__device__ __forceinline__ void gemm_phase8(PG8_LAS unsigned char* lds, const Gemm g, const Sched& S, const Epi& E) {
    const int wid = g.wid; const int tid = tid_from(wid), lane = tid & 63, wr = wid >> 2, wc = wid & 3, fr = lane & 15, fq = lane >> 4;
    const int K = g.K, nt = K / BK;
    unsigned voffA[2], voffB[2];
#pragma unroll
    for (int i = 0; i < 2; ++i) { int R, C; stage_rc(tid * 16 + i * 8192, R, C); const int Rb = Epi::PERM ? ((R & ~31) + perm32(R & 31)) : R;
        voffA[i] = (unsigned)(R * g.lda + C) * 2u; voffB[i] = (unsigned)(Rb * g.ldb + C) * 2u; }
    const size_t kstep = (size_t)(BK * 2);
    const size_t hstepA = (size_t)HALF * g.lda * 2, hstepB = (size_t)HALF * g.ldb * 2;
    const size_t tstepA = 2 * hstepA, tstepB = 2 * hstepB;
    const unsigned ldsw = (unsigned)wid * 1024u;
    const int c8 = (fq >> 1) * 32 + (fq & 1) * 16;
    const int aoff0 = lds_byte(wr * 64 + fr, c8), aoff1 = lds_byte(wr * 64 + fr, c8 + 8), boff0 = lds_byte(wc * 32 + fr, c8), boff1 = lds_byte(wc * 32 + fr, c8 + 8);
#define PG8_SA(b, h) (((b) * 2 + (h)) * HTB)
#define PG8_SB(b, h) ((4 + (b) * 2 + (h)) * HTB)
#define PG8_STAGE(bufoff, gbase, voff) do { _Pragma("unroll") for (int _i = 0; _i < 2; ++_i) \
        __builtin_amdgcn_global_load_lds((const unsigned*)((const char*)(gbase) + (voff)[_i]), (PG8_LAS unsigned*)(lds + (bufoff) + ldsw + _i * 8192), 16, 0, 0); } while (0)
#define PG8_LDA(dst, b, h) do { _Pragma("unroll") for (int m = 0; m < 4; ++m) { const u32x4 lo_ = *(const PG8_LAS u32x4*)(lds + PG8_SA(b, h) + aoff0 + m * 2048), hi_ = *(const PG8_LAS u32x4*)(lds + PG8_SA(b, h) + aoff1 + m * 2048); \
        dst[m] = (i32x8){(int)lo_.x, (int)lo_.y, (int)lo_.z, (int)lo_.w, (int)hi_.x, (int)hi_.y, (int)hi_.z, (int)hi_.w}; } } while (0)
#define PG8_LDB(dst, b, h) do { _Pragma("unroll") for (int n = 0; n < 2; ++n) { const u32x4 lo_ = *(const PG8_LAS u32x4*)(lds + PG8_SB(b, h) + boff0 + n * 2048), hi_ = *(const PG8_LAS u32x4*)(lds + PG8_SB(b, h) + boff1 + n * 2048); \
        dst[n] = (i32x8){(int)lo_.x, (int)lo_.y, (int)lo_.z, (int)lo_.w, (int)hi_.x, (int)hi_.y, (int)hi_.z, (int)hi_.w}; } } while (0)
#define PG8_MMA(ai, bj, At, Bt) do { __builtin_amdgcn_s_setprio(1); _Pragma("unroll") for (int m = 0; m < 4; ++m) _Pragma("unroll") for (int n = 0; n < 2; ++n) \
        asm volatile("v_mfma_scale_f32_16x16x128_f8f6f4 %0, %1, %2, %0, %3, %4 op_sel_hi:[0,0,0]" : "+v"(acc[ai][bj][m][n]) : "v"(Bt[n]), "v"(At[m]), "v"(vsB), "v"(vsA)); __builtin_amdgcn_s_setprio(0); } while (0)
#define PG8_WAIT_V(n) asm volatile("s_waitcnt vmcnt(" #n ")" ::: "memory")
#define PG8_WAIT_L(n) asm volatile("s_waitcnt lgkmcnt(" #n ")" ::: "memory")
#define PG8_BAR __builtin_amdgcn_s_barrier()
#define PG8_SCHED __builtin_amdgcn_sched_barrier(0)
    Unit cur, nxt; int ui = 0;
    if (!S.next(0, cur)) return;
    f32x4 acc[2][2][4][2];
#pragma unroll
    for (int a = 0; a < 2; ++a)
#pragma unroll
        for (int b = 0; b < 2; ++b)
#pragma unroll
            for (int m = 0; m < 4; ++m)
#pragma unroll
                for (int n = 0; n < 2; ++n) acc[a][b][m][n] = (f32x4){0.f, 0.f, 0.f, 0.f};
    typedef int i32x8 __attribute__((ext_vector_type(8)));
    i32x8 At[4], B0[2], B1[2];
    int vsA = g.sA, vsB = g.sB; asm volatile("" : "+v"(vsA), "+v"(vsB));
    const char* cA = (const char*)g.A + (size_t)cur.pm * tstepA + cur.ko; const char* cB = (const char*)g.Bt + (size_t)cur.pb * tstepB + cur.ko;
    S.a_ready(cur);
    if constexpr (SP2) {
        PG8_STAGE(PG8_SB(0, 0), cB, voffB); PG8_STAGE(PG8_SB(0, 1), cB + hstepB, voffB); PG8_STAGE(PG8_SA(0, 0), cA, voffA); PG8_STAGE(PG8_SA(0, 1), cA + hstepA, voffA);
        if (wr == 1) PG8_BAR;
        PG8_WAIT_V(2); PG8_BAR;
        PG8_STAGE(PG8_SB(1, 0), cB + kstep, voffB); PG8_STAGE(PG8_SA(1, 0), cA + kstep, voffA); PG8_STAGE(PG8_SB(1, 1), cB + hstepB + kstep, voffB);
        PG8_WAIT_V(6); PG8_BAR;
    } else {
        PG8_STAGE(PG8_SB(0, 0), cB, voffB); PG8_STAGE(PG8_SA(0, 0), cA, voffA); PG8_STAGE(PG8_SB(0, 1), cB + hstepB, voffB); PG8_STAGE(PG8_SA(0, 1), cA + hstepA, voffA);
        if (wr == 1) PG8_BAR;
        PG8_WAIT_V(4); PG8_BAR;
        PG8_STAGE(PG8_SB(1, 0), cB + kstep, voffB); PG8_STAGE(PG8_SA(1, 0), cA + kstep, voffA); PG8_STAGE(PG8_SB(1, 1), cB + hstepB + kstep, voffB);
        PG8_WAIT_V(6); PG8_BAR;
    }
    for (;;) {
        const bool has_next = S.next(ui + 1, nxt);
        const char* nA = has_next ? (const char*)g.A + (size_t)nxt.pm * tstepA + nxt.ko : cA; const char* nB = has_next ? (const char*)g.Bt + (size_t)nxt.pb * tstepB + nxt.ko : cB;
        for (int t = 0; t < nt; t += 2) {
            const bool last = (t == nt - 2);
            const char* a1 = cA + (size_t)(t + 1) * kstep;
            const char* a2 = last ? nA : cA + (size_t)(t + 2) * kstep; const char* b2 = last ? nB : cB + (size_t)(t + 2) * kstep;
            const char* a3 = a2 + kstep; const char* b3 = b2 + kstep;
            if (last && has_next) S.a_ready(nxt);
            if constexpr (SP2) {
            PG8_LDB(B0, 0, 0); PG8_LDB(B1, 0, 1); PG8_SCHED; PG8_LDA(At, 0, 0); PG8_STAGE(PG8_SA(1, 1), a1 + hstepA, voffA);
            PG8_WAIT_V(8); PG8_WAIT_L(0); PG8_BAR; PG8_MMA(0, 0, At, B0); PG8_MMA(0, 1, At, B1); PG8_BAR; PG8_SCHED;
            PG8_LDA(At, 0, 1); PG8_STAGE(PG8_SB(0, 0), b2, voffB); PG8_STAGE(PG8_SB(0, 1), b2 + hstepB, voffB); PG8_STAGE(PG8_SA(0, 0), a2, voffA);
            PG8_WAIT_V(8); PG8_WAIT_L(0); PG8_BAR; PG8_MMA(1, 0, At, B0); PG8_MMA(1, 1, At, B1); PG8_BAR; PG8_SCHED;
            PG8_LDB(B0, 1, 0); PG8_LDB(B1, 1, 1); PG8_SCHED; PG8_LDA(At, 1, 0); PG8_STAGE(PG8_SA(0, 1), a2 + hstepA, voffA);
            PG8_WAIT_V(8); PG8_WAIT_L(0); PG8_BAR; PG8_MMA(0, 0, At, B0); PG8_MMA(0, 1, At, B1); PG8_BAR; PG8_SCHED;
            PG8_LDA(At, 1, 1); PG8_STAGE(PG8_SB(1, 0), b3, voffB); PG8_STAGE(PG8_SB(1, 1), b3 + hstepB, voffB); PG8_STAGE(PG8_SA(1, 0), a3, voffA);
            PG8_WAIT_V(8); PG8_WAIT_L(0); PG8_BAR; PG8_MMA(1, 0, At, B0); PG8_MMA(1, 1, At, B1); PG8_BAR; PG8_SCHED;
            } else {
            PG8_LDB(B0, 0, 0); PG8_SCHED; PG8_LDA(At, 0, 0); PG8_STAGE(PG8_SA(1, 1), a1 + hstepA, voffA);
            PG8_WAIT_L(8); PG8_BAR; PG8_WAIT_L(0); PG8_MMA(0, 0, At, B0); PG8_BAR; PG8_SCHED;
            PG8_LDB(B1, 0, 1); PG8_STAGE(PG8_SB(0, 0), b2, voffB);
            PG8_BAR; PG8_WAIT_L(0); PG8_MMA(0, 1, At, B1); PG8_BAR;
            PG8_LDA(At, 0, 1); PG8_STAGE(PG8_SA(0, 0), a2, voffA);
            PG8_BAR; PG8_WAIT_L(0); PG8_MMA(1, 0, At, B0); PG8_BAR; PG8_SCHED;
            PG8_STAGE(PG8_SB(0, 1), b2 + hstepB, voffB);
            PG8_WAIT_V(6); PG8_BAR; PG8_MMA(1, 1, At, B1); PG8_BAR;
            PG8_LDB(B0, 1, 0); PG8_SCHED; PG8_LDA(At, 1, 0); PG8_STAGE(PG8_SA(0, 1), a2 + hstepA, voffA);
            PG8_WAIT_L(8); PG8_BAR; PG8_WAIT_L(0); PG8_MMA(0, 0, At, B0); PG8_BAR; PG8_SCHED;
            PG8_LDB(B1, 1, 1); PG8_STAGE(PG8_SB(1, 0), b3, voffB);
            PG8_BAR; PG8_WAIT_L(0); PG8_MMA(0, 1, At, B1); PG8_BAR;
            PG8_LDA(At, 1, 1); PG8_STAGE(PG8_SA(1, 0), a3, voffA);
            PG8_BAR; PG8_WAIT_L(0); PG8_MMA(1, 0, At, B0); PG8_BAR; PG8_SCHED;
            PG8_STAGE(PG8_SB(1, 1), b3 + hstepB, voffB);
            PG8_WAIT_V(6); PG8_BAR; PG8_MMA(1, 1, At, B1); PG8_BAR;
            }
        }
        if constexpr (ALIGN_EPI) { if (wr == 0) PG8_BAR; }
        asm volatile("s_nop 15\n\ts_nop 15" ::: "memory");
        if constexpr (!Epi::AFTER_DRAIN) { E(acc, cur, wr, wc, fr, fq); S.done(cur); }
        if (!has_next) break;
#pragma unroll
        for (int a = 0; a < 2; ++a)
#pragma unroll
            for (int b = 0; b < 2; ++b)
#pragma unroll
                for (int m = 0; m < 4; ++m)
#pragma unroll
                    for (int n = 0; n < 2; ++n) acc[a][b][m][n] = (f32x4){0.f, 0.f, 0.f, 0.f};
        cur = nxt; cA = nA; cB = nB; ++ui;
        if constexpr (ALIGN_EPI) { if (wr == 1) PG8_BAR; }
    }
    PG8_WAIT_V(0);
    if constexpr (!ALIGN_EPI) { if (wr == 0) PG8_BAR; }
    PG8_BAR;
    if constexpr (Epi::AFTER_DRAIN) { E.fused(acc, cur, wr, wc, fr, fq, lds, wid, lane); S.done(cur); }
#undef PG8_SA
#undef PG8_SB
#undef PG8_STAGE
#undef PG8_LDA
#undef PG8_LDB
#undef PG8_MMA
#undef PG8_WAIT_V
#undef PG8_WAIT_L
#undef PG8_BAR
#undef PG8_SCHED
}
}

namespace attn {
using bf16x8 = __attribute__((ext_vector_type(8))) short;
using s16x4  = __attribute__((ext_vector_type(4))) short;
using f32x16 = __attribute__((ext_vector_type(16))) float;
using u32x4  = __attribute__((ext_vector_type(4))) unsigned;
constexpr int DV = 128, DK = 64, NW = 8, QBLK = 32, KVBLK = 64;
constexpr float SCALE = 0.125f;
constexpr float THR = 4.f;
constexpr size_t SHM_V = KVBLK * DV * 2, SHM_K = KVBLK * DK * 2, SHM_ATTN = 2 * SHM_V + 2 * SHM_K + NW * 64 * 4;
#define AKSWZ(row, colB) ((row) * 128 + ((colB) ^ ((((row) >> 1) & 7) << 4)))
#define ASBAR() __builtin_amdgcn_sched_barrier(0)
__device__ __forceinline__ int crow(int r, int hi) { return (r & 3) + 8 * (r >> 2) + 4 * hi; }
__device__ __forceinline__ unsigned cvtpk(float lo, float hi) { unsigned r; asm volatile("v_cvt_pk_bf16_f32 %0, %1, %2" : "=v"(r) : "v"(lo), "v"(hi)); return r; }

__device__ __forceinline__ void partialSM(f32x16& p0, f32x16& p1, float& m_reg, float& mn, float& alpha) {
  constexpr float C = SCALE * 1.4426950408889634f;
  float pmax = p0[0];
#pragma unroll
  for (int r = 1; r < 16; ++r) pmax = fmaxf(pmax, p0[r]);
#pragma unroll
  for (int r = 0; r < 16; ++r) pmax = fmaxf(pmax, p1[r]);
  { auto rr = __builtin_amdgcn_permlane32_swap(__float_as_uint(pmax), __float_as_uint(pmax), false, false);
    pmax = fmaxf(__uint_as_float(rr[0]), __uint_as_float(rr[1])); }
  if (__builtin_expect(__all(pmax - m_reg <= THR / SCALE), 1)) { mn = m_reg; alpha = 1.f; }
  else { mn = fmaxf(m_reg, pmax); alpha = __builtin_amdgcn_exp2f((m_reg - mn) * C); m_reg = mn; }
  const float mnC = -mn * C;
#pragma unroll
  for (int r = 0; r < 16; ++r) p0[r] = fmaf(p0[r], C, mnC);
#pragma unroll
  for (int r = 0; r < 16; ++r) p1[r] = fmaf(p1[r], C, mnC);
#pragma unroll
  for (int r = 0; r < 16; ++r) p0[r] = __builtin_amdgcn_exp2f(p0[r]);
}
__device__ __forceinline__ void finishSM(f32x16& p0, f32x16& p1, float alpha, float& l_reg, bf16x8& pa0, bf16x8& pa1, bf16x8& pa2, bf16x8& pa3) {
#pragma unroll
  for (int r = 0; r < 16; ++r) p1[r] = __builtin_amdgcn_exp2f(p1[r]);
  float ps = 0;
#pragma unroll
  for (int r = 0; r < 16; ++r) ps += p0[r];
#pragma unroll
  for (int r = 0; r < 16; ++r) ps += p1[r];
  { auto rr = __builtin_amdgcn_permlane32_swap(__float_as_uint(ps), __float_as_uint(ps), false, false);
    ps = __uint_as_float(rr[0]) + __uint_as_float(rr[1]); }
  l_reg = l_reg * alpha + ps;
#define APK4(P, BASE, OUT) do { unsigned a0 = cvtpk(P[BASE + 0], P[BASE + 1]), a1 = cvtpk(P[BASE + 2], P[BASE + 3]);   \
    unsigned b0 = cvtpk(P[BASE + 4], P[BASE + 5]), b1 = cvtpk(P[BASE + 6], P[BASE + 7]);                              \
    auto r0 = __builtin_amdgcn_permlane32_swap(a0, b0, false, false); auto r1 = __builtin_amdgcn_permlane32_swap(a1, b1, false, false); \
    u32x4 w = {r0[0], r1[0], r0[1], r1[1]}; OUT = *reinterpret_cast<bf16x8*>(&w); } while (0)
  APK4(p0, 0, pa0); APK4(p0, 8, pa1); APK4(p1, 0, pa2); APK4(p1, 8, pa3);
#undef APK4
}
__device__ __forceinline__ void qkt(f32x16& p0, f32x16& p1, const char* Ks, const bf16x8* qr, int r32, int hi) {
  p0 = f32x16{}; p1 = f32x16{};
#pragma unroll
  for (int d0 = 0; d0 < 4; ++d0) { const int cb = (d0 * 16 + hi * 8) * 2;
    bf16x8 b0 = *reinterpret_cast<const bf16x8*>(Ks + AKSWZ(r32, cb));
    bf16x8 b1 = *reinterpret_cast<const bf16x8*>(Ks + AKSWZ(32 + r32, cb));
    p0 = __builtin_amdgcn_mfma_f32_32x32x16_bf16(b0, qr[d0], p0, 0, 0, 0);
    p1 = __builtin_amdgcn_mfma_f32_32x32x16_bf16(b1, qr[d0], p1, 0, 0, 0); }
}
__device__ __forceinline__ int v_st(int k, int c) { const int kk = (k & ~0xC) | ((k & 4) << 1) | ((k & 8) >> 1); return ((kk >> 3) * 4 + (c >> 5)) * 512 + ((kk & 7) * 32 + (c & 31)) * 2; }
__device__ __forceinline__ int v_rd_base(int lane) { return ((lane & 3) << 3) | (((lane >> 2) & 3) << 6) | (((lane >> 4) & 1) << 5) | (((lane >> 5) & 1) << 8); }
constexpr int v_rd_off(int d0, int ks, int half) { return d0 * 512 + ks * 4096 + half * 2048; }
template <int OFF> __device__ __forceinline__ s16x4 tr_read(int vb) {
  s16x4 r; asm volatile("ds_read_b64_tr_b16 %0, %1 offset:%2" : "=&v"(r) : "v"(vb), "i"(OFF) : "memory"); return r;
}
template <int D0> __device__ __forceinline__ void pv_one(f32x16& od, int vb, bf16x8 pa0, bf16x8 pa1, bf16x8 pa2, bf16x8 pa3) {
  const s16x4 l0 = tr_read<v_rd_off(D0, 0, 0)>(vb), h0 = tr_read<v_rd_off(D0, 0, 1)>(vb), l1 = tr_read<v_rd_off(D0, 1, 0)>(vb), h1 = tr_read<v_rd_off(D0, 1, 1)>(vb);
  const s16x4 l2 = tr_read<v_rd_off(D0, 2, 0)>(vb), h2 = tr_read<v_rd_off(D0, 2, 1)>(vb), l3 = tr_read<v_rd_off(D0, 3, 0)>(vb), h3 = tr_read<v_rd_off(D0, 3, 1)>(vb);
  asm volatile("s_waitcnt lgkmcnt(0)" ::: "memory"); ASBAR();
#define APK(L, H) (bf16x8){L[0], L[1], L[2], L[3], H[0], H[1], H[2], H[3]}
  od = __builtin_amdgcn_mfma_f32_32x32x16_bf16(pa0, APK(l0, h0), od, 0, 0, 0);
  od = __builtin_amdgcn_mfma_f32_32x32x16_bf16(pa1, APK(l1, h1), od, 0, 0, 0);
  od = __builtin_amdgcn_mfma_f32_32x32x16_bf16(pa2, APK(l2, h2), od, 0, 0, 0);
  od = __builtin_amdgcn_mfma_f32_32x32x16_bf16(pa3, APK(l3, h3), od, 0, 0, 0);
#undef APK
}
__device__ __forceinline__ void pv_d0(f32x16* o, int vb, bf16x8 pa0, bf16x8 pa1, bf16x8 pa2, bf16x8 pa3) {
  pv_one<0>(o[0], vb, pa0, pa1, pa2, pa3); pv_one<1>(o[1], vb, pa0, pa1, pa2, pa3); pv_one<2>(o[2], vb, pa0, pa1, pa2, pa3); pv_one<3>(o[3], vb, pa0, pa1, pa2, pa3);
}
template <int LDQ, int LDO>
__device__ __forceinline__ void attn_unit(const unsigned short* __restrict__ Qb, const unsigned short* __restrict__ Kh, const unsigned short* __restrict__ Vh,
                                          unsigned short* __restrict__ Ob, int seq, char* lds, int wid) {
  const int tid = pg8::tid_from(wid), lane = tid & 63, r32 = lane & 31, hi = lane >> 5;
  char* V_lds = lds; char* K_lds = lds + 2 * SHM_V;
  float* ws = (float*)(lds + 2 * SHM_V + 2 * SHM_K) + wid * 64; float* li_l = ws; float* al_l = ws + 32;
  float m_reg = -1e30f, l_reg = 0; f32x16 o[4] = {}; bf16x8 qr[4];
  const unsigned short* Qw = Qb + (long)(wid * QBLK + r32) * LDQ + hi * 8;
#pragma unroll
  for (int d0 = 0; d0 < 4; ++d0) qr[d0] = *reinterpret_cast<const bf16x8*>(Qw + d0 * 16);
  const int sr = tid >> 4, sc = (tid & 15) * 8, vst0 = v_st(sr, sc), vst1 = v_st(32 + sr, sc);
  const int kr = tid >> 3, kc = (tid & 7) * 8, kst = AKSWZ(kr, kc * 2);
  const int vb0 = (int)(uintptr_t)V_lds + v_rd_base(lane);
  bf16x8 sv0[2], sv1[2], sk0[2];
#define ASLOAD(i, k0) do { sv0[i] = *reinterpret_cast<const bf16x8*>(&Vh[(long)((k0) + sr) * LDQ + sc]); sv1[i] = *reinterpret_cast<const bf16x8*>(&Vh[(long)((k0) + 32 + sr) * LDQ + sc]); \
    sk0[i] = *reinterpret_cast<const bf16x8*>(&Kh[(long)((k0) + kr) * LDQ + kc]); } while (0)
#define ASWRITE(b, i) do { *(bf16x8*)(V_lds + (b) * SHM_V + vst0) = sv0[i]; *(bf16x8*)(V_lds + (b) * SHM_V + vst1) = sv1[i]; \
    *(bf16x8*)(K_lds + (b) * SHM_K + kst) = sk0[i]; } while (0)
#define ASWAIT() asm volatile("s_waitcnt vmcnt(3)" ::: "memory")
#define ARESC(a) do { if (__any((a) < 1.f)) { if (hi == 0) al_l[r32] = (a); asm volatile("s_waitcnt lgkmcnt(0)" ::: "memory"); \
    _Pragma("unroll") for (int d = 0; d < 4; ++d) _Pragma("unroll") for (int r = 0; r < 16; ++r) o[d][r] *= al_l[crow(r, hi)]; } } while (0)
  f32x16 pA0, pA1, pB0, pB1; float mnA, mnB, alA, alB; bf16x8 pa0, pa1, pa2, pa3; const int NT = seq / KVBLK;
  ASLOAD(0, 0); asm volatile("s_waitcnt vmcnt(0)" ::: "memory"); ASWRITE(0, 0); __syncthreads();
  qkt(pA0, pA1, K_lds, qr, r32, hi); partialSM(pA0, pA1, m_reg, mnA, alA);
  ASLOAD(1, KVBLK); if (2 < NT) ASLOAD(0, 2 * KVBLK);
  if (2 < NT) ASWAIT(); else asm volatile("s_waitcnt vmcnt(0)" ::: "memory");
  ASWRITE(1, 1); __syncthreads();
  for (int j = 1; j + 1 < NT; j += 2) {
    ASBAR(); qkt(pB0, pB1, K_lds + SHM_K, qr, r32, hi);
    finishSM(pA0, pA1, alA, l_reg, pa0, pa1, pa2, pa3); ASBAR();
    ASLOAD(1, (j + 2) * KVBLK); ASBAR();
    pv_d0(o, vb0, pa0, pa1, pa2, pa3); partialSM(pB0, pB1, m_reg, mnB, alB);
    __syncthreads(); ASWAIT(); ASWRITE(0, 0);
    ARESC(alB); __syncthreads();
    ASBAR(); qkt(pA0, pA1, K_lds, qr, r32, hi);
    finishSM(pB0, pB1, alB, l_reg, pa0, pa1, pa2, pa3); ASBAR();
    if (j + 3 < NT) ASLOAD(0, (j + 3) * KVBLK); ASBAR();
    pv_d0(o, vb0 + (int)SHM_V, pa0, pa1, pa2, pa3); partialSM(pA0, pA1, m_reg, mnA, alA);
    __syncthreads(); if (j + 3 < NT) ASWAIT(); else asm volatile("s_waitcnt vmcnt(0)" ::: "memory");
    ASWRITE(1, 1);
    ARESC(alA); __syncthreads();
  }
  ASBAR(); qkt(pB0, pB1, K_lds + SHM_K, qr, r32, hi);
  finishSM(pA0, pA1, alA, l_reg, pa0, pa1, pa2, pa3); ASBAR();
  pv_d0(o, vb0, pa0, pa1, pa2, pa3); partialSM(pB0, pB1, m_reg, mnB, alB);
  __syncthreads(); ARESC(alB);
  finishSM(pB0, pB1, alB, l_reg, pa0, pa1, pa2, pa3); ASBAR();
  pv_d0(o, vb0 + (int)SHM_V, pa0, pa1, pa2, pa3);
  if (hi == 0) li_l[r32] = l_reg; asm volatile("s_waitcnt lgkmcnt(0)" ::: "memory");
  float rli[16];
#pragma unroll
  for (int r = 0; r < 16; ++r) rli[r] = __builtin_amdgcn_rcpf(li_l[crow(r, hi)]);
  unsigned short* Ow = Ob + (long)(wid * QBLK) * LDO;
#pragma unroll
  for (int r = 0; r < 16; ++r) { const int orow = crow(r, hi);
#pragma unroll
    for (int d0 = 0; d0 < 4; ++d0) { const float v = o[d0][r] * rli[r]; Ow[(long)orow * LDO + d0 * 32 + r32] = (unsigned short)(cvtpk(v, v) & 0xffffu); } }
  __syncthreads();
#undef ASLOAD
#undef ASWRITE
#undef ASWAIT
#undef ARESC
}
}

constexpr int NWAVES = 8, NTHR = NWAVES * 64;
constexpr int DM = 1024, NB = 4, SEQ = 4096, CTXL = 256, RPB = CTXL + SEQ  , MROWS = NB * RPB  ;
constexpr int INW = 5904, NPROJ = 6144, PLD = 5888;
constexpr int FFD = 2816, FFE = 3584, NEXP = 8, FFEH = FFE / 2;
constexpr int NCHUNK = RPB / 64;
constexpr float EPSN = 1e-6f;
constexpr int PC_AQ = 0, PC_AK = 512, PC_AV = 1024, PC_DQ = 1536, PC_DK = 1792, PC_DV = 2048, PC_DZ = 2304, PC_POOL = 2560, PC_GATE = 2816, PC_AB = 5888;

constexpr size_t MiB = 1u << 20;
constexpr size_t WS_CTL = 0, CTL_ZERO_BYTES = 2 * MiB;
constexpr size_t WS_MOD = 1 * MiB;
constexpr size_t WS_ROPE = 2 * MiB;
constexpr size_t WS_LAM = 2 * MiB + 65536;
constexpr size_t WS_ROUTE = 3 * MiB;
constexpr size_t WS_GB = 4 * MiB;
constexpr int NPB = 2816;
constexpr size_t WS_WIN = 8 * MiB;
constexpr size_t WS_WG8 = 20 * MiB;
constexpr size_t WS_WAB = 26 * MiB;
constexpr size_t WS_U8 = 484 * MiB;
constexpr size_t WS_WBR = 32 * MiB;
constexpr size_t WS_WOUT = 36 * MiB;
constexpr size_t WS_W13 = 40 * MiB;
constexpr size_t WS_W2 = 51 * MiB;
constexpr size_t WS_H = 58 * MiB;
constexpr size_t WS_U = 126 * MiB;
constexpr size_t WS_ATTO = WS_U;
constexpr size_t WS_MIX = WS_U;
constexpr size_t WS_PROJ = 160 * MiB;
constexpr size_t WS_POOLO = 356 * MiB;
constexpr size_t WS_W2M = 365 * MiB;
constexpr size_t WS_DNP = 398 * MiB;
constexpr size_t WS_MG = WS_DNP;
constexpr size_t WS_DNG = 466 * MiB;
constexpr size_t WS_DNO = 467 * MiB;
constexpr size_t WS_W13M = 484 * MiB;
constexpr size_t WS_SLAB = 256 * MiB;
constexpr size_t WS_HID = WS_PROJ;
constexpr int MOE_MAXT = 136;
constexpr size_t WS_HIDM = 160 * MiB;
constexpr size_t WS_XG = 279 * MiB;
constexpr size_t WS_Y = 279 * MiB;
constexpr size_t WS_END = 540 * MiB;
static_assert(WS_HIDM + (size_t)MOE_MAXT * 256 * FFE <= WS_XG && WS_Y + (size_t)MOE_MAXT * 256 * 1024 * 2 <= WS_POOLO && WS_DNO + (size_t)2 * MROWS * 256 * 2 <= WS_W13M && WS_W13M + (size_t)8 * 2 * FFE * 1024 <= WS_END, "ws map");
static_assert(WS_WIN + (size_t)2 * NPB * 1024 * 2 <= WS_WG8 && WS_WG8 + (size_t)2 * 3072 * 1024 <= WS_WAB && WS_WAB + 2 * 65536 <= WS_WBR && WS_W13 + (size_t)2 * FFD * 1024 * 2 <= WS_W2 && WS_W2 + (size_t)1024 * FFD * 2 <= WS_H, "ws map (weights)");
static_assert(WS_H + (size_t)MROWS * 1024 * 4 <= WS_U && WS_U + (size_t)MROWS * 1024 * 2 <= WS_PROJ && WS_PROJ + (size_t)MROWS * PLD * 2 <= WS_POOLO && WS_POOLO + (size_t)MROWS * 256 * 2 <= WS_W2M && WS_W2M + (size_t)8 * 1024 * FFE <= WS_DNP, "ws map (acts)");
static_assert(WS_DNP + (size_t)NB * NCHUNK * 4 * 2 * 32768 <= WS_DNG, "ws map (dn)");
constexpr int CW_TMO = 0, CW_CODE = 1;
constexpr int CW_BAR = 4096;
constexpr int CW_ECNT = 16384;

constexpr int RING_BYTES = 155648;
constexpr int MISC_OFF = RING_BYTES;
constexpr int LDS_BYTES = RING_BYTES + 1024;

enum { PH_PRO = 0, PH_L0 = 1, PH_N1 = 0, PH_PROJ = 1, PH_ATT = 2, PH_SCAN = 3, PH_MIXB = 4, PH_MRG0 = 5, PH_MRG1 = 6, PH_MRG2 = 7, PH_OUT = 8, PH_N2 = 9, PH_LAYER = 10,
       PH_FUP = 11, PH_FDN = 12, PH_L1 = 13, PH_GATH = 23, PH_CV0 = 24, PH_UP0 = 25, PH_DN0 = 26, PH_CV1 = 27, PH_UP1 = 28, PH_DN1 = 29, PH_FIN = 30, PH_COUNT = 31 };

#define GAS __attribute__((address_space(1)))
#define LAS __attribute__((address_space(3)))
typedef unsigned short bf16;
typedef unsigned v4u __attribute__((ext_vector_type(4)));
typedef unsigned v2u __attribute__((ext_vector_type(2)));
typedef float f32x4 __attribute__((ext_vector_type(4)));
typedef GAS unsigned gu32;
#define RLX_AGENT __ATOMIC_RELAXED, __HIP_MEMORY_SCOPE_AGENT
#define LDS_WAIT() asm volatile("s_waitcnt lgkmcnt(0)" ::: "memory")
#define VM_WAIT() asm volatile("s_waitcnt vmcnt(0)" ::: "memory")
__device__ __forceinline__ unsigned f2bf(float f) { unsigned u = __builtin_bit_cast(unsigned, f); return (u + 0x7fffu + ((u >> 16) & 1u)) >> 16; }
typedef float f32x2_c __attribute__((ext_vector_type(2))); typedef __bf16 bf16x2_c __attribute__((ext_vector_type(2)));
__device__ __forceinline__ unsigned cvtpk_c(float lo, float hi) { f32x2_c v = {lo, hi}; bf16x2_c b = __builtin_convertvector(v, bf16x2_c); return __builtin_bit_cast(unsigned, b); }
__device__ __forceinline__ unsigned pk2(float lo, float hi) { return cvtpk_c(lo, hi); }
__device__ __forceinline__ unsigned cvt4_fp8(float a, float b, float c, float d) {
    a = fminf(fmaxf(a, -448.f), 448.f); b = fminf(fmaxf(b, -448.f), 448.f); c = fminf(fmaxf(c, -448.f), 448.f); d = fminf(fmaxf(d, -448.f), 448.f);
    int r = 0; r = __builtin_amdgcn_cvt_pk_fp8_f32(a, b, r, false); r = __builtin_amdgcn_cvt_pk_fp8_f32(c, d, r, true); return (unsigned)r; }
constexpr int E8(int log2scale) { return (127 - log2scale) * 0x01010101; }
constexpr int F8_ACT_L2 = 3, F8_W13_L2 = 5, F8_W2_L2 = 6;
__device__ __forceinline__ float bf_lo(unsigned w) { return __builtin_bit_cast(float, w << 16); }
__device__ __forceinline__ float bf_hi(unsigned w) { return __builtin_bit_cast(float, w & 0xffff0000u); }
__device__ __forceinline__ float bf2f(bf16 v) { return __builtin_bit_cast(float, (unsigned)v << 16); }
__device__ __forceinline__ float sigmoidf_(float x) { return 1.f / (1.f + __expf(-x)); }
__device__ __forceinline__ float siluf_(float x) { return x / (1.f + __expf(-x)); }
__device__ __forceinline__ float dpp_add_(float v, const int ctrl_sel) {
    int r;
    if (ctrl_sel == 0) r = __builtin_amdgcn_update_dpp(0, __builtin_bit_cast(int, v), 0xB1, 0xF, 0xF, false);
    else if (ctrl_sel == 1) r = __builtin_amdgcn_update_dpp(0, __builtin_bit_cast(int, v), 0x4E, 0xF, 0xF, false);
    else if (ctrl_sel == 2) r = __builtin_amdgcn_update_dpp(0, __builtin_bit_cast(int, v), 0x141, 0xF, 0xF, false);
    else r = __builtin_amdgcn_update_dpp(0, __builtin_bit_cast(int, v), 0x140, 0xF, 0xF, false);
    return v + __builtin_bit_cast(float, r);
}
__device__ __forceinline__ float grp8_sum(float v) { v = dpp_add_(v, 0); v = dpp_add_(v, 1); v = dpp_add_(v, 2); return v; }
__device__ __forceinline__ float grp16_sum(float v) { v = grp8_sum(v); v = dpp_add_(v, 3); return v; }
__device__ __forceinline__ float wave_sum(float v) {
    v = grp16_sum(v);
    { auto rr = __builtin_amdgcn_permlane16_swap(__float_as_uint(v), __float_as_uint(v), false, false); v = __uint_as_float(rr[0]) + __uint_as_float(rr[1]); }
    { auto rr = __builtin_amdgcn_permlane32_swap(__float_as_uint(v), __float_as_uint(v), false, false); v = __uint_as_float(rr[0]) + __uint_as_float(rr[1]); }
    return v;
}
__device__ __forceinline__ int lane_id_() { return pg8::lane_id_asm(); }
__device__ __forceinline__ float lane_get(float v, int src) { return __builtin_bit_cast(float, __builtin_amdgcn_ds_bpermute(src << 2, __builtin_bit_cast(int, v))); }
#define XB_TMO      128
#define XB_XCNT(j)  (256  + 64 * (j))
#define XB_XSUB(j)  (1280 + 64 * (j))
#define XB_XGEN(j)  (2304 + 64 * (j))
#define XB_TOP      3328
#define XB_TOPGEN   3392
#define XCD_BAR_WORDS 3456
#define XB_SPIN_CAP (1u << 18)

__device__ __forceinline__ unsigned xb_ld(unsigned* p)              { return __hip_atomic_load(p, __ATOMIC_RELAXED, __HIP_MEMORY_SCOPE_AGENT); }
__device__ __forceinline__ unsigned xb_add(unsigned* p, unsigned v) { return __hip_atomic_fetch_add(p, v, __ATOMIC_RELAXED, __HIP_MEMORY_SCOPE_AGENT); }
__device__ __forceinline__ unsigned xb_xcc_id() { return (unsigned)__builtin_amdgcn_s_getreg((3 << 11) | 20) & 0xFu; }
#define XB_SPIN(cond, bar) do { unsigned _sp = 0; while (cond) { __builtin_amdgcn_s_sleep(1); \
    if ((++_sp & 255u) == 0u) { if (xb_ld(&(bar)[XB_TMO])) break; if (_sp > XB_SPIN_CAP) { atomicAdd(&(bar)[XB_TMO], 1u); break; } } } } while (0)

struct XcdBarrier {
    unsigned* bar; unsigned x; unsigned wid;
    volatile LAS unsigned* st;
};

__device__ __forceinline__ XcdBarrier xcd_barrier_post(unsigned* bar, volatile LAS unsigned* st, unsigned wid) {
    XcdBarrier b; b.bar = bar; b.x = xb_xcc_id(); b.st = st; b.wid = wid;
    if (wid == 0 && pg8::lane_id_asm() == 0) (void)xb_add(&bar[XB_XCNT(b.x)], 1u);
    return b;
}
__device__ __forceinline__ void xcd_barrier_complete(unsigned* bar, unsigned x, unsigned& nloc, unsigned& nx) {
    const unsigned G = gridDim.x * gridDim.y * gridDim.z;
    unsigned sum, cnt, mine, sp = 0u;
    for (;;) {
        sum = 0u; cnt = 0u; mine = 0u;
#pragma unroll
        for (unsigned j = 0; j < 16; ++j) { const unsigned c = xb_ld(&bar[XB_XCNT(j)]); sum += c; cnt += (c > 0u) ? 1u : 0u; mine = (j == x) ? c : mine; }
        if (sum == G) break;
        __builtin_amdgcn_s_sleep(1);
        if ((++sp & 255u) == 0u) { if (xb_ld(&bar[XB_TMO])) break; if (sp > XB_SPIN_CAP) { atomicAdd(&bar[XB_TMO], 1u); break; } }
    }
    nloc = mine > 0u ? mine : 1u; nx = cnt > 0u ? cnt : 1u;
}

__device__ __forceinline__ void xcd_barrier(const XcdBarrier& b) {
    asm volatile("s_waitcnt vmcnt(0)" ::: "memory");
    __syncthreads();
    if (b.wid == 0 && pg8::lane_id_asm() == 0) {
        unsigned* bar = b.bar;
        __builtin_amdgcn_s_waitcnt(0);
        unsigned nloc = b.st[0], nx = b.st[1];
        if (nloc == 0u) { xcd_barrier_complete(bar, b.x, nloc, nx); b.st[0] = nloc; b.st[1] = nx; }
        const unsigned old = xb_add(&bar[XB_XSUB(b.x)], 1u);
        const unsigned gen = old / nloc;
        if (old + 1u == (gen + 1u) * nloc) {
            __builtin_amdgcn_fence(__ATOMIC_RELEASE, "agent");
            asm volatile("s_waitcnt vmcnt(0)" ::: "memory");
            const unsigned og = xb_add(&bar[XB_TOP], 1u);
            const unsigned tg = og / nx;
            if (og + 1u == (tg + 1u) * nx) xb_add(&bar[XB_TOPGEN], 1u);
            else XB_SPIN(xb_ld(&bar[XB_TOPGEN]) == tg, bar);
            __builtin_amdgcn_fence(__ATOMIC_ACQUIRE, "agent");
            xb_add(&bar[XB_XGEN(b.x)], 1u);
            asm volatile("s_waitcnt vmcnt(0)" ::: "memory");
        } else {
            XB_SPIN(xb_ld(&bar[XB_XGEN(b.x)]) == gen, bar);
            __builtin_amdgcn_fence(__ATOMIC_ACQUIRE, "agent");
            asm volatile("s_waitcnt vmcnt(0)" ::: "memory");
        }
    }
    __syncthreads();
}

struct Frame {
    LAS unsigned char* lds;
    volatile LAS unsigned* MISC;
    gu32* ctl;
    int tid, lane, wave, vcu, G, zz, bx, wid_s;
    unsigned char* ws;
    float* out;
};
struct Args { const float* in[27]; float* out; unsigned char* ws; int ph_lo, ph_hi, bar_li, pad; };

struct TileOrder {
    int nM, nN, nwg, G, c, skip;
    __device__ __forceinline__ void init(int nM_, int nN_, int G_, int c_, int skip_) { nM = nM_; nN = nN_; nwg = nM * nN; G = G_; c = c_; skip = skip_; }
    __device__ __forceinline__ bool next(int i, pg8::Unit& u) const {
        const long L = (long)i * G + c; if (L >= nwg) return false;
        int wgid = (int)L; { const int q = nwg / 8, r = nwg % 8, xcd = wgid % 8, off = wgid / 8; wgid = (xcd < r ? xcd * (q + 1) : r * (q + 1) + (xcd - r) * q) + off; }
        const int nig = 8 * nN, gid = wgid / nig, fm = gid * 8, gsz = (nM - fm) < 8 ? (nM - fm) : 8;
        int pm = fm + ((wgid % nig) % gsz); const int pn = (wgid % nig) / gsz;
        if (skip) pm = (pm >> 4) * 17 + 1 + (pm & 15);
        u.pm = pm; u.pn = pn; u.pb = pn; u.ko = 0; u.aux = 0; return true;
    }
    __device__ __forceinline__ void a_ready(const pg8::Unit&) const {}
    __device__ __forceinline__ void done(const pg8::Unit&) const {}
};
struct MoeOrder {
    int t1, t2, t3, t4, t5, t6, t7, t8, nN, G, c;
    __device__ __forceinline__ void init(const gu32* cnt, int nN_, int G_, int c_) {
        int t = 0;
        t += ((int)__hip_atomic_load(cnt + 0 * 64, RLX_AGENT) + 255) >> 8; t1 = t; t += ((int)__hip_atomic_load(cnt + 1 * 64, RLX_AGENT) + 255) >> 8; t2 = t;
        t += ((int)__hip_atomic_load(cnt + 2 * 64, RLX_AGENT) + 255) >> 8; t3 = t; t += ((int)__hip_atomic_load(cnt + 3 * 64, RLX_AGENT) + 255) >> 8; t4 = t;
        t += ((int)__hip_atomic_load(cnt + 4 * 64, RLX_AGENT) + 255) >> 8; t5 = t; t += ((int)__hip_atomic_load(cnt + 5 * 64, RLX_AGENT) + 255) >> 8; t6 = t;
        t += ((int)__hip_atomic_load(cnt + 6 * 64, RLX_AGENT) + 255) >> 8; t7 = t; t += ((int)__hip_atomic_load(cnt + 7 * 64, RLX_AGENT) + 255) >> 8; t8 = t;
        nN = nN_; G = G_; c = c_;
    }
    __device__ __forceinline__ int tile_off(int e) const { return e == 0 ? 0 : e == 1 ? t1 : e == 2 ? t2 : e == 3 ? t3 : e == 4 ? t4 : e == 5 ? t5 : e == 6 ? t6 : t7; }
    __device__ __forceinline__ bool next(int i, pg8::Unit& u) const {
        const long L = (long)i * G + c; if (L >= (long)t8 * nN) return false;
        const int pm = (int)(L / nN), pn = (int)(L % nN);
        const int e = (pm >= t1) + (pm >= t2) + (pm >= t3) + (pm >= t4) + (pm >= t5) + (pm >= t6) + (pm >= t7);
        u.pm = pm; u.pn = pn; u.pb = e * nN + pn; u.ko = 0; u.aux = 0; return true;
    }
    __device__ __forceinline__ void a_ready(const pg8::Unit&) const {}
    __device__ __forceinline__ void done(const pg8::Unit&) const {}
};

struct CtxSplitOrder {
    int S, kpb, G, c;
    __device__ __forceinline__ void init(int S_, int kp_bytes, int G_, int c_) { S = S_; kpb = kp_bytes; G = G_; c = c_; }
    __device__ __forceinline__ bool next(int i, pg8::Unit& u) const {
        const int L = i * G + c; if (L >= 16 * S) return false;
        const int ks = L % S, pn = (L / S) & 3, ct = L / (4 * S);
        u.pm = ct * 17; u.pn = pn; u.pb = pn; u.ko = ks * kpb; u.aux = ks; return true;
    }
    __device__ __forceinline__ void a_ready(const pg8::Unit&) const {}
    __device__ __forceinline__ void done(const pg8::Unit&) const {}
};
#define EPI_LOOP(...) _Pragma("unroll") for (int ai = 0; ai < 2; ++ai) _Pragma("unroll") for (int m = 0; m < 4; ++m) { const int row = u.pm * 256 + ai * 128 + wr * 64 + m * 16 + fr; \
    _Pragma("unroll") for (int bj = 0; bj < 2; ++bj) { const int col = bj * 128 + wc * 32 + 4 * fq; f32x4 v0 = acc[ai][bj][m][0], v1 = acc[ai][bj][m][1]; __VA_ARGS__ } if (m & 1) asm volatile("" ::: "memory"); }
#define EPI_LOOP8(...) _Pragma("unroll") for (int ai = 0; ai < 2; ++ai) _Pragma("unroll") for (int m = 0; m < 4; ++m) { const int row = u.pm * 256 + ai * 128 + wr * 64 + m * 16 + fr; \
    _Pragma("unroll") for (int bj = 0; bj < 2; ++bj) { const int col = bj * 128 + wc * 32 + 8 * fq; f32x4 v0 = acc[ai][bj][m][0], v1 = acc[ai][bj][m][1]; __VA_ARGS__ } if (m & 1) asm volatile("" ::: "memory"); }
__device__ __forceinline__ v4u pack8(f32x4 a, f32x4 b) { v4u w; w.x = pg8::cvt_pk_bf16(a[0], a[1]); w.y = pg8::cvt_pk_bf16(a[2], a[3]); w.z = pg8::cvt_pk_bf16(b[0], b[1]); w.w = pg8::cvt_pk_bf16(b[2], b[3]); return w; }
__device__ __forceinline__ v2u pack4(f32x4 v) { v2u w; w.x = pg8::cvt_pk_bf16(v[0], v[1]); w.y = pg8::cvt_pk_bf16(v[2], v[3]); return w; }
__device__ __forceinline__ f32x4 unpack4(v2u w) { return (f32x4){bf_lo(w.x), bf_hi(w.x), bf_lo(w.y), bf_hi(w.y)}; }

struct EpiProj {
    static constexpr bool PERM = false, AFTER_DRAIN = false, KHOOK = false;
    bf16* P; const float* rope;
    __device__ __forceinline__ void operator()(const pg8::f32x4 (&acc)[2][2][4][2], const pg8::Unit& u, int wr, int wc, int fr, int fq) const {
        asm volatile("" : "+v"(fr), "+v"(fq));
        const int pn = u.pn;
        if (pn < 4) {
            EPI_LOOP({ const int j = row % RPB;
                if (j >= CTXL) { const int t = j - CTXL; const int pos = (wc & 1) ? (t & 63) : (t >> 6);
                    const f32x4 cs0 = *(const f32x4*)(rope + (pos * 16 + 4 * fq) * 2), cs1 = *(const f32x4*)(rope + (pos * 16 + 4 * fq) * 2 + 4);
                    const float c0 = cs0[0], s0 = cs0[1], c1 = cs0[2], s1 = cs0[3], c2 = cs1[0], s2 = cs1[1], c3 = cs1[2], s3 = cs1[3];
                    const f32x4 a = v0, b = v1;
                    v0[0] = a[0] * c0 - b[0] * s0; v1[0] = b[0] * c0 + a[0] * s0; v0[1] = a[1] * c1 - b[1] * s1; v1[1] = b[1] * c1 + a[1] * s1;
                    v0[2] = a[2] * c2 - b[2] * s2; v1[2] = b[2] * c2 + a[2] * s2; v0[3] = a[3] * c3 - b[3] * s3; v1[3] = b[3] * c3 + a[3] * s3; }
                bf16* o = P + (size_t)row * PLD + pn * 256 + col; *(v2u*)o = pack4(v0); *(v2u*)(o + 16) = pack4(v1); })
        } else {
            EPI_LOOP8({ *(v4u*)(P + (size_t)row * PLD + pn * 256 + col) = pack8(v0, v1); })
        }
    }
};
struct EpiGate {
    static constexpr bool PERM = false, AFTER_DRAIN = false, KHOOK = false;
    bf16* P;
    __device__ __forceinline__ void operator()(const pg8::f32x4 (&acc)[2][2][4][2], const pg8::Unit& u, int wr, int wc, int fr, int fq) const {
        asm volatile("" : "+v"(fr), "+v"(fq));
        EPI_LOOP8({ for (int q = 0; q < 4; ++q) { v0[q] = sigmoidf_(v0[q]); v1[q] = sigmoidf_(v1[q]); }
            *(v4u*)(P + (size_t)row * PLD + PC_GATE + u.pn * 256 + col) = pack8(v0, v1); })
    }
};
struct EpiMergeF {
    static constexpr bool PERM = false, AFTER_DRAIN = false, KHOOK = true;
    bf16* MG; const bf16* P;
    __device__ __forceinline__ void khook(pg8::f32x4 (&acc)[2][2][4][2], const pg8::Unit& u, int t, int wr, int wc, int fr, int fq) const {
        asm volatile("" : "+v"(fr), "+v"(fq));
        const int gnum = PC_GATE + (t == 8 ? 0 : 1024), gden = gnum + 1024;
#pragma unroll
        for (int ai = 0; ai < 2; ++ai)
#pragma unroll
            for (int m = 0; m < 4; ++m) { const int row = u.pm * 256 + ai * 128 + wr * 64 + m * 16 + fr;
#pragma unroll
                for (int bj = 0; bj < 2; ++bj) { const int c = u.pn * 256 + bj * 128 + wc * 32 + 8 * fq; const bf16* gp = P + (size_t)row * PLD + c;
                    const v4u a = *(const v4u*)(gp + gnum), b = *(const v4u*)(gp + gden);
                    const f32x4 n0 = unpack4((v2u){a.x, a.y}), n1 = unpack4((v2u){a.z, a.w}), d0 = unpack4((v2u){b.x, b.y}), d1 = unpack4((v2u){b.z, b.w});
#pragma unroll
                    for (int q = 0; q < 4; ++q) { acc[ai][bj][m][0][q] *= n0[q] * __builtin_amdgcn_rcpf(fmaxf(d0[q], 1e-20f)); acc[ai][bj][m][1][q] *= n1[q] * __builtin_amdgcn_rcpf(fmaxf(d1[q], 1e-20f)); } }
                if (m & 1) asm volatile("" ::: "memory"); }
    }
    __device__ __forceinline__ void operator()(const pg8::f32x4 (&acc)[2][2][4][2], const pg8::Unit& u, int wr, int wc, int fr, int fq) const {
        asm volatile("" : "+v"(fr), "+v"(fq));
        EPI_LOOP8({ const int c = u.pn * 256 + col; const v4u gw = *(const v4u*)(P + (size_t)row * PLD + PC_GATE + 2048 + c);
            *(v4u*)(MG + (size_t)row * DM + c) = pack8(unpack4((v2u){gw.x, gw.y}) * v0, unpack4((v2u){gw.z, gw.w}) * v1); })
    }
};
struct EpiResid {
    static constexpr bool PERM = false, AFTER_DRAIN = false, KHOOK = false;
    float* H; const float* modl; int gidx; const float* xin;
    __device__ __forceinline__ void operator()(const pg8::f32x4 (&acc)[2][2][4][2], const pg8::Unit& u, int wr, int wc, int fr, int fq) const {
        asm volatile("" : "+v"(fr), "+v"(fq));
        EPI_LOOP8({ const int c = u.pn * 256 + col; const int b = row / RPB, j = row - b * RPB; const int mr = j < CTXL ? 4 : b;
            const float* gp = modl + mr * 6144 + gidx * 1024 + c; float* hp = H + (size_t)row * DM + c;
            const float* sp = xin ? xin + ((size_t)b * SEQ + (j - CTXL)) * DM + c : hp;
            const f32x4 g0 = *(const f32x4*)gp, g1 = *(const f32x4*)(gp + 4);
            *(f32x4*)hp = *(const f32x4*)sp + g0 * v0; *(f32x4*)(hp + 4) = *(const f32x4*)(sp + 4) + g1 * v1; })
    }
};
struct EpiSlab {
    static constexpr bool PERM = false, AFTER_DRAIN = false, KHOOK = false;
    float* SL; const float* modl; int gidx;
    __device__ __forceinline__ void operator()(const pg8::f32x4 (&acc)[2][2][4][2], const pg8::Unit& u, int wr, int wc, int fr, int fq) const {
        asm volatile("" : "+v"(fr), "+v"(fq));
        const float* gate = modl + 4 * 6144 + gidx * 1024; float* sl = SL + ((size_t)u.aux * 1024 + (u.pm / 17) * 256) * 1024;
#pragma unroll
        for (int ai = 0; ai < 2; ++ai)
#pragma unroll
            for (int m = 0; m < 4; ++m) { const int lr = ai * 128 + wr * 64 + m * 16 + fr;
#pragma unroll
                for (int bj = 0; bj < 2; ++bj) { const int c = u.pn * 256 + bj * 128 + wc * 32 + 8 * fq; const f32x4 g0 = *(const f32x4*)(gate + c), g1 = *(const f32x4*)(gate + c + 4);
                    float* o = sl + (size_t)lr * 1024 + c; *(f32x4*)o = g0 * acc[ai][bj][m][0]; *(f32x4*)(o + 4) = g1 * acc[ai][bj][m][1]; } }
    }
};
struct EpiSwiglu {
    static constexpr bool PERM = false, AFTER_DRAIN = false, KHOOK = false;
    bf16* HID; int ldh;
    __device__ __forceinline__ void operator()(const pg8::f32x4 (&acc)[2][2][4][2], const pg8::Unit& u, int wr, int wc, int fr, int fq) const {
        asm volatile("" : "+v"(fr), "+v"(fq));
#pragma unroll
        for (int ai = 0; ai < 2; ++ai)
#pragma unroll
            for (int m = 0; m < 4; ++m) { const int row = u.pm * 256 + ai * 128 + wr * 64 + m * 16 + fr; f32x4 r0, r1;
#pragma unroll
                for (int q = 0; q < 4; ++q) { r0[q] = siluf_(acc[ai][0][m][0][q]) * acc[ai][0][m][1][q]; r1[q] = siluf_(acc[ai][1][m][0][q]) * acc[ai][1][m][1][q]; }
                *(v4u*)(HID + (size_t)row * ldh + u.pn * 128 + wc * 32 + 8 * fq) = pack8(r0, r1);
                if (m & 1) asm volatile("" ::: "memory"); }
    }
};
struct EpiSwiglu8 {
    static constexpr bool PERM = false, AFTER_DRAIN = false, KHOOK = false;
    unsigned char* HID; int ldh;
    __device__ __forceinline__ void operator()(const pg8::f32x4 (&acc)[2][2][4][2], const pg8::Unit& u, int wr, int wc, int fr, int fq) const {
        asm volatile("" : "+v"(fr), "+v"(fq));
        const float s8 = (float)(1 << F8_ACT_L2);
#pragma unroll
        for (int ai = 0; ai < 2; ++ai)
#pragma unroll
            for (int m = 0; m < 4; ++m) { const int row = u.pm * 256 + ai * 128 + wr * 64 + m * 16 + fr; f32x4 r0, r1;
#pragma unroll
                for (int q = 0; q < 4; ++q) { r0[q] = siluf_(acc[ai][0][m][0][q]) * acc[ai][0][m][1][q] * s8; r1[q] = siluf_(acc[ai][1][m][0][q]) * acc[ai][1][m][1][q] * s8; }
                v2u o; o.x = cvt4_fp8(r0[0], r0[1], r0[2], r0[3]); o.y = cvt4_fp8(r1[0], r1[1], r1[2], r1[3]);
                *(v2u*)(HID + (size_t)row * ldh + u.pn * 128 + wc * 32 + 8 * fq) = o;
                if (m & 1) asm volatile("" ::: "memory"); }
    }
};
struct EpiY {
    static constexpr bool PERM = false, AFTER_DRAIN = false, KHOOK = false;
    bf16* Y; int first;
    __device__ __forceinline__ void operator()(const pg8::f32x4 (&acc)[2][2][4][2], const pg8::Unit& u, int wr, int wc, int fr, int fq) const {
        asm volatile("" : "+v"(fr), "+v"(fq));
        EPI_LOOP8({ (void)first; *(v4u*)(Y + (size_t)row * DM + u.pn * 256 + col) = pack8(v0, v1); })
    }
};

__device__ __forceinline__ int iperm32(int c) { return ((c >> 2) & 1) * 16 + (c >> 3) * 4 + (c & 3); }
template <int MAP> __device__ __forceinline__ int map_col(int c) {
    if (MAP == 0) return c;
    if (MAP == 1) { if (c >= 2560 && (c < 2576 || c >= 2832)) return -1;
        const int d = c < 2560 ? c : PC_POOL + (c - 2576);
        return d < 1024 ? d : (d & ~31) + iperm32(d & 31); }
    if (MAP == 4) return (c & ~31) + iperm32(c & 31);
    { const int x = c & 31; return (c >> 7) * 256 + ((x >> 2) & 1) * 128 + ((c >> 5) & 3) * 32 + (MAP == 3 ? 16 : 0) + 4 * (x >> 3) + (x & 3); }
}
template <int MAP> __device__ __forceinline__ void tr_item(const float* W, int ldw, int N, bf16* WT, int ldd, int item, LAS float* scr, int lane) {
    const int nblk = (N + 31) / 32, kb = item / nblk, nb = item % nblk, k0 = 64 * kb, n0 = 32 * nb;
    const int cl = n0 + (lane & 31);
    float tv[32];
#pragma unroll
    for (int i = 0; i < 32; ++i) { const int kk = 2 * i + (lane >> 5); tv[i] = cl < N ? W[(size_t)(k0 + kk) * ldw + cl] : 0.f; }
#pragma unroll
    for (int i = 0; i < 32; ++i) { const int kk = 2 * i + (lane >> 5); scr[kk * 33 + (lane & 31)] = tv[i]; }
    LDS_WAIT(); asm volatile("" ::: "memory");
    const int c = lane & 7;
#pragma unroll
    for (int j = 0; j < 4; ++j) { const int n = (lane >> 3) + 8 * j; const LAS float* s = scr + (8 * c) * 33 + n;
        const int dr = n0 + n < N ? map_col<MAP>(n0 + n) : -1;
        if (dr >= 0) { v4u o; o.x = pk2(s[0 * 33], s[1 * 33]); o.y = pk2(s[2 * 33], s[3 * 33]); o.z = pk2(s[4 * 33], s[5 * 33]); o.w = pk2(s[6 * 33], s[7 * 33]);
            *(GAS v4u*)(WT + (size_t)dr * ldd + k0 + 8 * c) = o; } }
    LDS_WAIT(); asm volatile("" ::: "memory");
}
template <int MAP> __device__ __forceinline__ void tr_item8(const float* W, int ldw, int N, unsigned char* WT, int ldd, int item, LAS float* scr, int lane, float scale) {
    const int nblk = (N + 31) / 32, kb = item / nblk, nb = item % nblk, k0 = 64 * kb, n0 = 32 * nb;
    const int cl = n0 + (lane & 31);
    float tv[32];
#pragma unroll
    for (int i = 0; i < 32; ++i) { const int kk = 2 * i + (lane >> 5); tv[i] = cl < N ? W[(size_t)(k0 + kk) * ldw + cl] : 0.f; }
#pragma unroll
    for (int i = 0; i < 32; ++i) { const int kk = 2 * i + (lane >> 5); scr[kk * 33 + (lane & 31)] = tv[i]; }
    LDS_WAIT(); asm volatile("" ::: "memory");
    const int c = lane & 7;
#pragma unroll
    for (int j = 0; j < 4; ++j) { const int n = (lane >> 3) + 8 * j; const LAS float* s = scr + (8 * c) * 33 + n;
        if (n0 + n < N) { v2u o; o.x = cvt4_fp8(s[0 * 33] * scale, s[1 * 33] * scale, s[2 * 33] * scale, s[3 * 33] * scale); o.y = cvt4_fp8(s[4 * 33] * scale, s[5 * 33] * scale, s[6 * 33] * scale, s[7 * 33] * scale);
            *(GAS v2u*)(WT + (size_t)map_col<MAP>(n0 + n) * ldd + k0 + 8 * c) = o; } }
    LDS_WAIT(); asm volatile("" ::: "memory");
}
#define TR_RUN(MAP, W, ldw, K, N, WT, ldd) { const int cnt_ = ((K) / 64) * (((N) + 31) / 32); if (r < cnt_) { tr_item<MAP>(W, ldw, N, WT, ldd, r, scr, F.lane); continue; } r -= cnt_; }

constexpr int LW_ITEMS = 16 * 185 + 8 * 32 + 4 * 32 + 4 * 32 + 16 * 32 + 16 * 96 + 64;
__device__ __forceinline__ void conv_layer_weights(Frame& F, const Args& A, int l, int rank, int nranks) {
    LAS float* scr = (LAS float*)(F.lds + F.wave * 16384);
    bf16* WIN = (bf16*)(F.ws + WS_WIN); bf16* WBR = (bf16*)(F.ws + WS_WBR); bf16* WOUT = (bf16*)(F.ws + WS_WOUT);
    const float* win = A.in[F.zz + 8] + (size_t)l * 1024 * INW; const float* wbr = A.in[F.zz + 17] + (size_t)l * 1024 * 1024; const float* wo = A.in[F.zz + 18] + (size_t)l * 1024 * 1024;
    bf16* dbr = WBR + (size_t)l * 1024 * 1024;
    for (int it = rank; it < LW_ITEMS; it += nranks) {
        int r = it;
        { const int cnt_ = 16 * 185; if (r < cnt_) { tr_item<1>(win, INW, INW, WIN + (size_t)l * NPB * 1024, 1024, r, scr, F.lane); continue; } r -= cnt_; }
        { const int cnt_ = 8 * 32; if (r < cnt_) { tr_item<4>(wbr, 1024, 1024, dbr, 1024, r, scr, F.lane); continue; } r -= cnt_; }
        { const int cnt_ = 4 * 32; if (r < cnt_) { tr_item<4>(wbr + 512 * 1024, 1024, 1024, dbr + 512, 1024, r, scr, F.lane); continue; } r -= cnt_; }
        { const int cnt_ = 4 * 32; if (r < cnt_) { tr_item<4>(wbr + 768 * 1024, 1024, 1024, dbr + 768, 1024, r, scr, F.lane); continue; } r -= cnt_; }
        { const int cnt_ = 16 * 32; if (r < cnt_) { tr_item<4>(wo, 1024, 1024, WOUT + (size_t)l * 1024 * 1024, 1024, r, scr, F.lane); continue; } r -= cnt_; }
        { const int cnt_ = 16 * 96; if (r < cnt_) { tr_item8<4>(win + 2832, INW, 3072, F.ws + WS_WG8 + (size_t)l * 3072 * 1024, 1024, r, scr, F.lane, (float)(1 << F8_W13_L2)); continue; } r -= cnt_; }
        { bf16* wab = (bf16*)(F.ws + WS_WAB) + (size_t)l * 16384;
          for (int e = F.lane; e < 256; e += 64) { const int k = r * 16 + (e >> 4), c = e & 15; wab[c * 1024 + k] = (bf16)f2bf(win[(size_t)k * INW + 2560 + c]); } }
    }
}
__device__ __forceinline__ void p0_prologue(Frame& F, const Args& A) {
    LAS float* scr = (LAS float*)(F.lds + F.wave * 16384);
    const int gw = F.vcu * NWAVES + F.wave, NGW = F.G * NWAVES;
    bf16* W13 = (bf16*)(F.ws + WS_W13); bf16* W2 = (bf16*)(F.ws + WS_W2);
    conv_layer_weights(F, A, 0, gw, NGW);
    constexpr int TOTAL = 16 * 88 * 2 + 44 * 32;
    for (int it = gw; it < TOTAL; it += NGW) {
        int r = it;
#ifdef DENSE_F8
        { const int cnt_ = 16 * 88; if (r < cnt_) { tr_item8<2>(A.in[F.zz + 19], FFD, FFD, (unsigned char*)W13, 1024, r, scr, F.lane, (float)(1 << F8_W13_L2)); continue; } r -= cnt_; }
        { const int cnt_ = 16 * 88; if (r < cnt_) { tr_item8<3>(A.in[F.zz + 20], FFD, FFD, (unsigned char*)W13, 1024, r, scr, F.lane, (float)(1 << F8_W13_L2)); continue; } r -= cnt_; }
        tr_item8<4>(A.in[F.zz + 21], 1024, 1024, (unsigned char*)W2, FFD, r, scr, F.lane, (float)(1 << F8_W2_L2));
#else
        { const int cnt_ = 16 * 88; if (r < cnt_) { tr_item<2>(A.in[F.zz + 19], FFD, FFD, W13, 1024, r, scr, F.lane); continue; } r -= cnt_; }
        { const int cnt_ = 16 * 88; if (r < cnt_) { tr_item<3>(A.in[F.zz + 20], FFD, FFD, W13, 1024, r, scr, F.lane); continue; } r -= cnt_; }
        tr_item<4>(A.in[F.zz + 21], 1024, 1024, W2, FFD, r, scr, F.lane);
#endif
    }
    if (F.vcu == 0 && F.tid < 8) __hip_atomic_store(F.ctl + CW_ECNT + 64 * F.tid, 0u, RLX_AGENT);
    if (F.vcu == 0) {
        float* rope = (float*)(F.ws + WS_ROPE);
        for (int e = F.tid; e < 1024; e += NTHR) { const int pos = e >> 4, i = e & 15; const float inv = powf(10000.f, -(float)i / 16.f); const float a = (float)pos * inv;
            rope[2 * e] = cosf(a); rope[2 * e + 1] = sinf(a); }
        if (F.tid < 2) { const int l = F.tid; const float* lp = A.in[F.zz + 9] + l * 256; float s1 = 0.f, s2 = 0.f;
            for (int i = 0; i < 64; ++i) { s1 += lp[i] * lp[64 + i]; s2 += lp[128 + i] * lp[192 + i]; }
            const float li = 0.8f - 0.6f * expf(-0.3f * (float)l);
            ((float*)(F.ws + WS_LAM))[l] = expf(s1) - expf(s2) + li; }
    }
    __syncthreads();
    float* MOD = (float*)(F.ws + WS_MOD);
    LAS float* red = (LAS float*)F.lds;
    for (int task = F.vcu; task < 2 * 96; task += F.G) {
        const int l = task / 96, cc = task % 96;
        const float* aw = A.in[F.zz + 4] + (size_t)l * 1024 * 6144 + cc * 64 + F.lane;
        const float* c0 = A.in[F.zz + 1]; const float* cx = A.in[F.zz + 3];
        float a0 = 0.f, a1 = 0.f, a2 = 0.f, a3 = 0.f, a4 = 0.f;
#pragma unroll 8
        for (int i = 0; i < 128; ++i) { const int k = F.wave * 128 + i; const float w = aw[(size_t)k * 6144];
            a0 += siluf_(c0[k]) * w; a1 += siluf_(c0[1024 + k]) * w; a2 += siluf_(c0[2048 + k]) * w; a3 += siluf_(c0[3072 + k]) * w; a4 += siluf_(cx[k]) * w; }
        LAS float* rw = red + F.wave * 320 + F.lane;
        rw[0] = a0; rw[64] = a1; rw[128] = a2; rw[192] = a3; rw[256] = a4;
        __syncthreads();
        if (F.tid < 320) { float s = 0.f;
#pragma unroll
            for (int w = 0; w < 8; ++w) s += red[w * 320 + F.tid];
            const int rr = F.tid >> 6, jj = cc * 64 + (F.tid & 63);
            MOD[(l * 5 + rr) * 6144 + jj] = s + A.in[F.zz + 5][l * 6144 + jj]; }
        __syncthreads();
    }
}

__device__ __forceinline__ void moe_convert(Frame& F, const Args& A, int rank, int nranks) {
    LAS float* scr = (LAS float*)(F.lds + F.wave * 16384);
    const int gw = rank, NGW = nranks;
    unsigned char* W13M = F.ws + WS_W13M; unsigned char* W2M = F.ws + WS_W2M;
    constexpr int I13 = 16 * 112, I2 = 56 * 32, PER_E = 2 * I13 + I2;
    for (int it = gw; it < 8 * PER_E; it += NGW) {
        const int e = it / PER_E; int r = it - e * PER_E;
        if (r < I13) { tr_item8<2>(A.in[F.zz + 23] + (size_t)e * 1024 * FFE, FFE, FFE, W13M + (size_t)e * 2 * FFE * 1024, 1024, r, scr, F.lane, (float)(1 << F8_W13_L2)); continue; } r -= I13;
        if (r < I13) { tr_item8<3>(A.in[F.zz + 24] + (size_t)e * 1024 * FFE, FFE, FFE, W13M + (size_t)e * 2 * FFE * 1024, 1024, r, scr, F.lane, (float)(1 << F8_W13_L2)); continue; } r -= I13;
        tr_item8<4>(A.in[F.zz + 25] + (size_t)e * FFE * 1024, 1024, 1024, W2M + (size_t)e * 1024 * FFE, FFE, r, scr, F.lane, (float)(1 << F8_W2_L2));
    }
}

__device__ __forceinline__ void norm_mod_phase(Frame& F, const Args& A, int l, int which, bool latent_only, bool route, bool out8 = false, int nslab = 0, int srcmode = 0) {
    (void)latent_only; (void)route;
    const int gw = F.vcu * NWAVES + F.wave, NGW = F.G * NWAVES;
    const float* H = (const float*)(F.ws + WS_H); bf16* U = (bf16*)(F.ws + WS_U); const float* MOD = (const float*)(F.ws + WS_MOD) + l * 5 * 6144;
    const float* g = (which ? A.in[F.zz + 7] : A.in[F.zz + 6]) + l * 1024;
    const float* xin = A.in[F.zz + 0]; const float* cin = A.in[F.zz + 2];
#define NM_SRC(R_) ({ const int b_ = (R_) / RPB, j_ = (R_) - b_ * RPB; const float* p_ = (srcmode == 1 || (srcmode == 2 && j_ < CTXL)) ? (j_ < CTXL ? cin + ((size_t)b_ * CTXL + j_) * DM : xin + ((size_t)b_ * SEQ + (j_ - CTXL)) * DM) : H + (size_t)(R_) * DM; p_; })
    f32x4 nv[4];
    if (gw < MROWS) { const GAS f32x4* xr = (const GAS f32x4*)NM_SRC(gw) + F.lane;
#pragma unroll
        for (int q = 0; q < 4; ++q) nv[q] = xr[64 * q]; }
#pragma unroll 1
    for (int R = gw; R < MROWS; R += NGW) {
        const int b = R / RPB, j = R - b * RPB; const bool isctx = j < CTXL;
        const float* mod = MOD + (isctx ? 4 : b) * 6144; const float* shift = mod + (which ? 3 : 0) * 1024; const float* scale = mod + (which ? 4 : 1) * 1024;
        f32x4 v[4]; float ss = 0.f;
#pragma unroll
        for (int q = 0; q < 4; ++q) v[q] = nv[q];
        if (R + NGW < MROWS) { const GAS f32x4* xr = (const GAS f32x4*)NM_SRC(R + NGW) + F.lane;
#pragma unroll
            for (int q = 0; q < 4; ++q) nv[q] = xr[64 * q]; }
        if (nslab > 0 && isctx) {
            const GAS f32x4* sp = (const GAS f32x4*)((const float*)(F.ws + WS_SLAB) + (size_t)(b * 256 + j) * 1024) + F.lane;
#pragma unroll
            for (int q = 0; q < 4; ++q) { f32x4 t[11];
#pragma unroll
                for (int s = 0; s < 11; ++s) t[s] = s < nslab ? sp[(size_t)s * 262144 + 64 * q] : (f32x4){0.f, 0.f, 0.f, 0.f};
#pragma unroll
                for (int s = 0; s < 11; ++s) v[q] += t[s]; }
            GAS f32x4* hw = (GAS f32x4*)(F.ws + WS_H + (size_t)R * DM * 4) + F.lane;
#pragma unroll
            for (int q = 0; q < 4; ++q) hw[64 * q] = v[q]; }
#pragma unroll
        for (int q = 0; q < 4; ++q) ss += (v[q].x * v[q].x + v[q].y * v[q].y) + (v[q].z * v[q].z + v[q].w * v[q].w);
        const float rstd = 1.f / sqrtf(wave_sum(ss) * (1.f / DM) + EPSN);
        GAS v2u* o8 = (GAS v2u*)(U + (size_t)R * DM) + F.lane;
#pragma unroll
        for (int q = 0; q < 4; ++q) { const int c = 4 * F.lane + 256 * q; const f32x4 gg = *(const f32x4*)(g + c), sh = *(const f32x4*)(shift + c), sc = *(const f32x4*)(scale + c);
            v[q] = (v[q] * rstd) * gg * (sc + 1.f) + sh;
            if (out8) { const float s8 = (float)(1 << F8_ACT_L2); ((GAS unsigned*)((unsigned char*)U + (size_t)R * DM))[F.lane + 64 * q] = cvt4_fp8(v[q].x * s8, v[q].y * s8, v[q].z * s8, v[q].w * s8); }
            else { v2u w; w.x = pk2(v[q].x, v[q].y); w.y = pk2(v[q].z, v[q].w); o8[64 * q] = w; } }
        if (which == 0) {
            const float s8 = (float)(1 << F8_ACT_L2);
#pragma unroll
            for (int q = 0; q < 4; ++q) ((GAS unsigned*)(F.ws + WS_U8 + (size_t)R * DM))[F.lane + 64 * q] = cvt4_fp8(v[q].x * s8, v[q].y * s8, v[q].z * s8, v[q].w * s8);
        }
    }
}
__device__ __forceinline__ void norm2_route_phase(Frame& F, const Args& A) {
    const int l = 1;
    const float* H = (const float*)(F.ws + WS_H); bf16* U = (bf16*)(F.ws + WS_U); const float* MOD = (const float*)(F.ws + WS_MOD) + l * 5 * 6144;
    const float* g = A.in[F.zz + 7] + l * 1024; const float* rw = A.in[F.zz + 22];
    LAS unsigned* wcnt = (LAS unsigned*)F.lds;
    LAS unsigned* gbase = wcnt + 64;
    const int lane = F.lane, wv = F.wave;
    for (int blk = F.vcu; blk < NB * SEQ / 64; blk += F.G) {
        int me0 = 0, me1 = 0; float mw0 = 0.f, mw1 = 0.f;
        f32x4 nv[4];
        { const int tk = blk * 64 + wv * 8, b = tk / SEQ, t = tk - b * SEQ; const GAS f32x4* xr = (const GAS f32x4*)(H + ((size_t)b * RPB + CTXL + t) * DM) + lane;
#pragma unroll
          for (int q = 0; q < 4; ++q) nv[q] = xr[64 * q]; }
#pragma unroll 1
        for (int i = 0; i < 8; ++i) {
            const int tk = blk * 64 + wv * 8 + i, b = tk / SEQ, t = tk - b * SEQ; const size_t R = (size_t)b * RPB + CTXL + t;
            const float* mod = MOD + b * 6144; const float* shift = mod + 3 * 1024; const float* scale = mod + 4 * 1024;
            f32x4 v[4]; float ss = 0.f;
#pragma unroll
            for (int q = 0; q < 4; ++q) { v[q] = nv[q]; ss += (v[q].x * v[q].x + v[q].y * v[q].y) + (v[q].z * v[q].z + v[q].w * v[q].w); }
            if (i < 7) { const GAS f32x4* xr = (const GAS f32x4*)(H + (R + 1) * DM) + lane;
#pragma unroll
                for (int q = 0; q < 4; ++q) nv[q] = xr[64 * q]; }
            const float rstd = 1.f / sqrtf(wave_sum(ss) * (1.f / DM) + EPSN);
            GAS v2u* o8 = (GAS v2u*)(U + R * DM) + lane;
            float lg[8] = {0, 0, 0, 0, 0, 0, 0, 0};
#pragma unroll
            for (int q = 0; q < 4; ++q) { const int c = 4 * lane + 256 * q; const f32x4 gg = *(const f32x4*)(g + c), sh = *(const f32x4*)(shift + c), sc = *(const f32x4*)(scale + c);
                v[q] = (v[q] * rstd) * gg * (sc + 1.f) + sh; v2u w; w.x = pk2(v[q].x, v[q].y); w.y = pk2(v[q].z, v[q].w); o8[64 * q] = w;
#pragma unroll
                for (int j = 0; j < 4; ++j) { const int k = c + j; const f32x4 w0 = *(const f32x4*)(rw + k * 8), w1 = *(const f32x4*)(rw + k * 8 + 4); const float x = v[q][j];
                    lg[0] += x * w0[0]; lg[1] += x * w0[1]; lg[2] += x * w0[2]; lg[3] += x * w0[3]; lg[4] += x * w1[0]; lg[5] += x * w1[1]; lg[6] += x * w1[2]; lg[7] += x * w1[3]; } }
#pragma unroll
            for (int e = 0; e < 8; ++e) lg[e] = wave_sum(lg[e]);
            int e0 = 0; float v0 = lg[0];
#pragma unroll
            for (int e = 1; e < 8; ++e) if (lg[e] > v0) { v0 = lg[e]; e0 = e; }
            int e1 = -1; float v1 = -3.0e38f;
#pragma unroll
            for (int e = 0; e < 8; ++e) if (e != e0 && lg[e] > v1) { v1 = lg[e]; e1 = e; }
            const float ex = __expf(v1 - v0);
            if (lane == i) { me0 = e0; me1 = e1; mw0 = 1.f / (1.f + ex); mw1 = ex / (1.f + ex); }
        }
        const bool act = lane < 8; const unsigned long long below = (1ull << lane) - 1ull;
        unsigned r0 = 0, r1 = 0, mycnt = 0;
#pragma unroll
        for (int e = 0; e < 8; ++e) { const unsigned long long m0 = __ballot(act && me0 == e), m1 = __ballot(act && me1 == e);
            const unsigned bel = (unsigned)__popcll((m0 | m1) & below);
            if (me0 == e) r0 = bel; if (me1 == e) r1 = bel;
            if (lane == e) mycnt = (unsigned)__popcll(m0) + (unsigned)__popcll(m1); }
        if (act) wcnt[wv * 8 + lane] = mycnt;
        __syncthreads();
        if (F.tid < 8) { unsigned tot = 0;
#pragma unroll
            for (int w = 0; w < 8; ++w) tot += wcnt[w * 8 + F.tid];
            gbase[F.tid] = __hip_atomic_fetch_add(F.ctl + CW_ECNT + 64 * F.tid, tot, RLX_AGENT); }
        __syncthreads();
        if (act) { unsigned b0 = gbase[me0], b1 = gbase[me1];
            for (int w = 0; w < wv; ++w) { b0 += wcnt[w * 8 + me0]; b1 += wcnt[w * 8 + me1]; }
            const int tk = blk * 64 + wv * 8 + lane;
            v4u* rt = (v4u*)(F.ws + WS_ROUTE) + 2 * tk;
            rt[0] = (v4u){(unsigned)me0, (unsigned)me1, b0 + r0, b1 + r1}; rt[1] = (v4u){__float_as_uint(mw0), __float_as_uint(mw1), 0u, 0u}; }
        __syncthreads();
    }
}

__device__ __forceinline__ void ab_tiles(Frame& F, const Args& A, int l) {
    typedef short ab_s16x8 __attribute__((ext_vector_type(8)));
    const int gw = F.vcu * NWAVES + F.wave, NGW = F.G * NWAVES, r = F.lane & 15, q = F.lane >> 4;
    const bf16* U = (const bf16*)(F.ws + WS_U); const bf16* wab = (const bf16*)(F.ws + WS_WAB) + (size_t)l * 16384 + r * 1024 + 8 * q;
    const float alog = A.in[F.zz + 12][l * 8 + (r & 7)], dtb = A.in[F.zz + 13][l * 8 + (r & 7)];
    for (int t = gw; t < MROWS / 16; t += NGW) {
        const bf16* up = U + (size_t)(t * 16 + r) * DM + 8 * q; f32x4 acc = {0.f, 0.f, 0.f, 0.f};
#pragma unroll 8
        for (int ks = 0; ks < 32; ++ks) acc = __builtin_amdgcn_mfma_f32_16x16x32_bf16(*(const ab_s16x8*)(up + 32 * ks), *(const ab_s16x8*)(wab + 32 * ks), acc, 0, 0, 0);
        f32x4 o;
#pragma unroll
        for (int g = 0; g < 4; ++g) { const float x = acc[g];
            if (r < 8) { const float z = x + dtb; const float ez = __expf(z); const float sp = z > 15.f ? z : (ez < 0.03f ? ez * (1.f - ez * (0.5f - ez * (1.f / 3.f))) : __logf(1.f + ez)); o[g] = -__expf(alog) * sp; }
            else o[g] = sigmoidf_(x); }
        float* gb = (float*)(F.ws + WS_GB) + (size_t)(t * 16 + 4 * q) * 16 + r;
        gb[0] = o[0]; gb[16] = o[1]; gb[32] = o[2]; gb[48] = o[3];
    }
}

__device__ __forceinline__ void moe_gather2(Frame& F) {
    const int gw = F.vcu * NWAVES + F.wave, NGW = F.G * NWAVES;
    MoeOrder mo; mo.init(F.ctl + CW_ECNT, 1, 1, 0);
    const bf16* U = (const bf16*)(F.ws + WS_U); unsigned char* XG = F.ws + WS_XG; const float sc = (float)(1 << F8_ACT_L2);
    for (int tk = gw; tk < NB * SEQ; tk += NGW) {
        const int b = tk / SEQ, t = tk - b * SEQ; const size_t R = (size_t)b * RPB + CTXL + t;
        const v4u rt = ((const v4u*)(F.ws + WS_ROUTE))[2 * tk];
        const size_t r0 = (size_t)mo.tile_off((int)rt.x) * 256 + rt.z, r1 = (size_t)mo.tile_off((int)rt.y) * 256 + rt.w;
        const GAS v4u* s = (const GAS v4u*)(U + R * DM) + 2 * F.lane; const v4u a = s[0], c = s[1];
        v4u o; o.x = cvt4_fp8(bf_lo(a.x) * sc, bf_hi(a.x) * sc, bf_lo(a.y) * sc, bf_hi(a.y) * sc); o.y = cvt4_fp8(bf_lo(a.z) * sc, bf_hi(a.z) * sc, bf_lo(a.w) * sc, bf_hi(a.w) * sc);
        o.z = cvt4_fp8(bf_lo(c.x) * sc, bf_hi(c.x) * sc, bf_lo(c.y) * sc, bf_hi(c.y) * sc); o.w = cvt4_fp8(bf_lo(c.z) * sc, bf_hi(c.z) * sc, bf_lo(c.w) * sc, bf_hi(c.w) * sc);
        *((GAS v4u*)(XG + r0 * DM) + F.lane) = o; *((GAS v4u*)(XG + r1 * DM) + F.lane) = o;
    }
}
__device__ __forceinline__ void moe_gather(Frame& F) {
    moe_gather2(F);
}
__device__ __forceinline__ void final_phase(Frame& F, const Args& A) {
    const int gw = F.vcu * NWAVES + F.wave, NGW = F.G * NWAVES;
    MoeOrder mo; mo.init(F.ctl + CW_ECNT, 1, 1, 0);
    const float* H = (const float*)(F.ws + WS_H); const bf16* Y = (const bf16*)(F.ws + WS_Y); const float* MOD = (const float*)(F.ws + WS_MOD) + 1 * 5 * 6144;
    for (int tk = gw; tk < NB * SEQ; tk += NGW) {
        const int b = tk / SEQ, t = tk - b * SEQ; const size_t R = (size_t)b * RPB + CTXL + t;
        const v4u rt = ((const v4u*)(F.ws + WS_ROUTE))[2 * tk], rw = ((const v4u*)(F.ws + WS_ROUTE))[2 * tk + 1];
        const size_t r0 = (size_t)mo.tile_off((int)rt.x) * 256 + rt.z, r1 = (size_t)mo.tile_off((int)rt.y) * 256 + rt.w;
        const float w0 = __uint_as_float(rw.x), w1 = __uint_as_float(rw.y);
        const float* gate = MOD + b * 6144 + 5 * 1024;
        f32x4 v[4]; float ss = 0.f;
#pragma unroll
        for (int q = 0; q < 4; ++q) { const int c = 4 * F.lane + 256 * q;
            const f32x4 h = *(const f32x4*)(H + R * DM + c), gg = *(const f32x4*)(gate + c);
            const f32x4 y0 = unpack4(*(const v2u*)(Y + r0 * DM + c)), y1 = unpack4(*(const v2u*)(Y + r1 * DM + c));
            v[q] = h + gg * (y0 * w0 + y1 * w1); ss += (v[q].x * v[q].x + v[q].y * v[q].y) + (v[q].z * v[q].z + v[q].w * v[q].w); }
        const float rstd = 1.f / sqrtf(wave_sum(ss) * (1.f / DM) + EPSN);
#pragma unroll
        for (int q = 0; q < 4; ++q) { const int c = 4 * F.lane + 256 * q; *(f32x4*)(F.out + (size_t)tk * DM + c) = v[q] * rstd * *(const f32x4*)(A.in[F.zz + 26] + c); }
    }
}

constexpr int DP = 65;
typedef short dn_bf16x8 __attribute__((ext_vector_type(8)));
__device__ __forceinline__ f32x4 mm_tile(const LAS float* Am, int a_sm, int a_sk, const LAS float* Bm, int b_sk, int b_sn, int m0, int n0, int lane) {
    const int r = lane & 15, q = lane >> 4; f32x4 acc = {0.f, 0.f, 0.f, 0.f};
#pragma unroll
    for (int ks = 0; ks < 2; ++ks) {
        const LAS float* ap = Am + (m0 + r) * a_sm + (32 * ks + 8 * q) * a_sk; const LAS float* bp = Bm + (32 * ks + 8 * q) * b_sk + (n0 + r) * b_sn;
        v4u a, b;
        a.x = pk2(ap[0], ap[a_sk]); a.y = pk2(ap[2 * a_sk], ap[3 * a_sk]); a.z = pk2(ap[4 * a_sk], ap[5 * a_sk]); a.w = pk2(ap[6 * a_sk], ap[7 * a_sk]);
        b.x = pk2(bp[0], bp[b_sk]); b.y = pk2(bp[2 * b_sk], bp[3 * b_sk]); b.z = pk2(bp[4 * b_sk], bp[5 * b_sk]); b.w = pk2(bp[6 * b_sk], bp[7 * b_sk]);
        acc = __builtin_amdgcn_mfma_f32_16x16x32_bf16(__builtin_bit_cast(dn_bf16x8, a), __builtin_bit_cast(dn_bf16x8, b), acc, 0, 0, 0);
    }
    return acc;
}

constexpr int RS = 72;
constexpr int IMG = 64 * RS * 2;
typedef short dn_s16x4 __attribute__((ext_vector_type(4)));
__device__ __forceinline__ f32x4 mm_img(const LAS bf16* Ai, const LAS bf16* Bi, int m0, int n0, int r, int q) {
    f32x4 acc = {0.f, 0.f, 0.f, 0.f};
    const LAS bf16* ap = Ai + (m0 + r) * RS + 8 * q; const LAS bf16* bp = Bi + (n0 + r) * RS + 8 * q;
    acc = __builtin_amdgcn_mfma_f32_16x16x32_bf16(*(const LAS dn_bf16x8*)ap, *(const LAS dn_bf16x8*)bp, acc, 0, 0, 0);
    acc = __builtin_amdgcn_mfma_f32_16x16x32_bf16(*(const LAS dn_bf16x8*)(ap + 32), *(const LAS dn_bf16x8*)(bp + 32), acc, 0, 0, 0);
    return acc;
}
template <int D> __device__ __forceinline__ void dn_diag_inv(LAS float* Dg, int ln) {
    const int blk = ln >> 4, r = ln & 15;
    LAS float* Ab = Dg + blk * 256;
    float t[16];
#pragma unroll
    for (int c = 0; c < 16; ++c) t[c] = (c == r) ? 1.f : 0.f;
#pragma unroll
    for (int c = 14; c >= 0; --c) { float s = 0.f;
#pragma unroll
        for (int j = c + 1; j < 16; ++j) { const float a = D == 0 ? Ab[j * 16 + c] : Ab[(15 - j) * 16 + (15 - c)]; s -= t[j] * a; }
        t[c] = (c < r) ? s : t[c]; }
    asm volatile("s_waitcnt lgkmcnt(0)" ::: "memory");
#pragma unroll
    for (int c = 0; c < 16; ++c) { if (D == 0) Ab[r * 16 + c] = t[c]; else Ab[(15 - r) * 16 + (15 - c)] = t[c]; }
}
template <int D> __device__ __forceinline__ void dn_solve_tiles(const LAS bf16* Ad, const LAS float* Dg, const LAS bf16* VT, const LAS bf16* KT, LAS bf16* UT, LAS bf16* WT,
                                                               const LAS float* Bd, const LAS float* Gd, int w4, int ln) {
    const int r = ln & 15, q = ln >> 4;
#pragma unroll 1
    for (int i = 0; i < 2; ++i) { const int nt = w4 * 2 + i; const bool isw = nt >= 4; const int c0 = (nt & 3) * 16 + r;
        const LAS bf16* src = (isw ? KT : VT) + c0 * RS; LAS bf16* dst = (isw ? WT : UT) + c0 * RS;
        f32x4 acc[4]; dn_s16x4 xb[4];
#pragma unroll
        for (int bi = 0; bi < 4; ++bi) { const v2u x = *(const LAS v2u*)(src + 16 * bi + 4 * q); const f32x4 xv = {bf_lo(x.x), bf_hi(x.x), bf_lo(x.y), bf_hi(x.y)};
#pragma unroll
            for (int g = 0; g < 4; ++g) { const int t = 16 * bi + 4 * q + g; const float sc = isw ? Bd[t] * __expf(Gd[t]) : Bd[t]; acc[bi][g] = xv[g] * sc; } }
#pragma unroll
        for (int st = 0; st < 4; ++st) { const int bi = D == 0 ? st : 3 - st;
#pragma unroll
            for (int s2 = 0; s2 < st; ++s2) { const int bj = D == 0 ? s2 : 3 - s2;
                v2u a = *(const LAS v2u*)(Ad + (16 * bi + r) * RS + 16 * bj + 4 * q); a.x ^= 0x80008000u; a.y ^= 0x80008000u;
                acc[bi] = __builtin_amdgcn_mfma_f32_16x16x16bf16_1k(__builtin_bit_cast(dn_s16x4, a), xb[bj], acc[bi], 0, 0, 0); }
            { const LAS float* tp = Dg + bi * 256 + r * 16 + 4 * q; v2u a; a.x = cvtpk_c(tp[0], tp[1]); a.y = cvtpk_c(tp[2], tp[3]);
              v2u xr; xr.x = cvtpk_c(acc[bi][0], acc[bi][1]); xr.y = cvtpk_c(acc[bi][2], acc[bi][3]);
              acc[bi] = __builtin_amdgcn_mfma_f32_16x16x16bf16_1k(__builtin_bit_cast(dn_s16x4, a), __builtin_bit_cast(dn_s16x4, xr), (f32x4){0.f, 0.f, 0.f, 0.f}, 0, 0, 0);
              v2u xo; xo.x = cvtpk_c(acc[bi][0], acc[bi][1]); xo.y = cvtpk_c(acc[bi][2], acc[bi][3]); xb[bi] = __builtin_bit_cast(dn_s16x4, xo);
              *(LAS v2u*)(dst + 16 * bi + 4 * q) = xo; }
        }
    }
}
__device__ __forceinline__ void dn_pre_unit(Frame& F, const Args& A, int l, int b, int n, int h) {
    LAS bf16* KcB = (LAS bf16*)(F.lds + 0 * IMG); LAS bf16* QcB = (LAS bf16*)(F.lds + 1 * IMG); LAS bf16* KT = (LAS bf16*)(F.lds + 2 * IMG); LAS bf16* VT = (LAS bf16*)(F.lds + 3 * IMG);
#define DIMG(d, k) ((LAS bf16*)(F.lds + (4 + 5 * (d) + (k)) * IMG))
    LAS float* Gs = (LAS float*)(F.lds + 14 * IMG);
    LAS float* Bs = Gs + 128;
    LAS float* Dg = Gs + 256;
    const bf16* P = (const bf16*)(F.ws + WS_PROJ); const float* GB = (const float*)(F.ws + WS_GB);
    const int tid = pg8::tid_from(F.wid_s);
    const int wv = tid >> 6, ln = tid & 63, r = ln & 15, q = ln >> 4;
    const int row0 = b * RPB + n * 64; const int seq_lo = (n < 4) ? b * RPB : b * RPB + CTXL, seq_hi = (n < 4) ? b * RPB + CTXL : (b + 1) * RPB;
    {
        const int t = tid >> 3, cg = tid & 7;
        const float* cw = A.in[F.zz + 11] + (size_t)l * 5 * 768;
#pragma unroll
        for (int p = 0; p < 3; ++p) {
            const int ch = p * 256 + h * 64 + cg * 8;
            float acc[8] = {0, 0, 0, 0, 0, 0, 0, 0};
#pragma unroll
            for (int tap = 0; tap < 5; ++tap) { const int rr = row0 + t + tap - 2;
                if (rr >= seq_lo && rr < seq_hi) { const v4u x = *(const v4u*)(P + (size_t)rr * PLD + PC_DQ + ch);
                    const f32x4 w0 = *(const f32x4*)(cw + tap * 768 + ch), w1 = *(const f32x4*)(cw + tap * 768 + ch + 4);
                    acc[0] += bf_lo(x.x) * w0[0]; acc[1] += bf_hi(x.x) * w0[1]; acc[2] += bf_lo(x.y) * w0[2]; acc[3] += bf_hi(x.y) * w0[3];
                    acc[4] += bf_lo(x.z) * w1[0]; acc[5] += bf_hi(x.z) * w1[1]; acc[6] += bf_lo(x.w) * w1[2]; acc[7] += bf_hi(x.w) * w1[3]; } }
            float ss = 0.f;
#pragma unroll
            for (int i = 0; i < 8; ++i) { acc[i] = siluf_(acc[i]); ss += acc[i] * acc[i]; }
            float sc = 1.f;
            if (p < 2) { ss = grp8_sum(ss); sc = (1.f / sqrtf(ss + EPSN)) * (p == 0 ? 0.125f : 1.f); }
            v4u o; o.x = cvtpk_c(acc[0] * sc, acc[1] * sc); o.y = cvtpk_c(acc[2] * sc, acc[3] * sc); o.z = cvtpk_c(acc[4] * sc, acc[5] * sc); o.w = cvtpk_c(acc[6] * sc, acc[7] * sc);
            if (p == 0) *(LAS v4u*)(QcB + t * RS + cg * 8) = o;
            else { if (p == 1) *(LAS v4u*)(KcB + t * RS + cg * 8) = o;
                LAS bf16* tp = (p == 1 ? KT : VT) + (cg * 8) * RS + t;
                tp[0 * RS] = (bf16)(o.x & 0xffffu); tp[1 * RS] = (bf16)(o.x >> 16); tp[2 * RS] = (bf16)(o.y & 0xffffu); tp[3 * RS] = (bf16)(o.y >> 16);
                tp[4 * RS] = (bf16)(o.z & 0xffffu); tp[5 * RS] = (bf16)(o.z >> 16); tp[6 * RS] = (bf16)(o.w & 0xffffu); tp[7 * RS] = (bf16)(o.w >> 16); }
        }
        if (wv < 2) { const int d = wv; const float* gb = GB + (size_t)(row0 + ln) * 16; const float g = gb[d * 4 + h]; Bs[d * 64 + ln] = gb[8 + d * 4 + h];
            float pf = g;
            { const int lid = lane_id_();
#pragma unroll
              for (int o = 1; o < 64; o <<= 1) { const float v = lane_get(pf, lid >= o ? lid - o : lid); if (lid >= o) pf += v; }
            }
            const float tot = lane_get(pf, 63);
            Gs[d * 64 + ln] = d == 0 ? pf : tot - pf + g; }
    }
    __syncthreads();
    {
#pragma unroll
        for (int i = 0; i < 2; ++i) { const int tile = wv * 2 + i, m0 = (tile >> 2) * 16, n0 = (tile & 3) * 16;
            const f32x4 kk = mm_img(KcB, KcB, m0, n0, r, q), qk = mm_img(QcB, KcB, m0, n0, r, q);
            const int s = n0 + r; const float g0s = Gs[s], g1s = Gs[64 + s];
#pragma unroll
            for (int g = 0; g < 4; ++g) { const int t = m0 + 4 * q + g; const float e0 = __expf(Gs[t] - g0s), e1 = __expf(Gs[64 + t] - g1s);
                const float a0 = (s < t) ? Bs[t] * kk[g] * e0 : 0.f, a1 = (s > t) ? Bs[64 + t] * kk[g] * e1 : 0.f;
                DIMG(0, 0)[t * RS + s] = (bf16)f2bf(a0); DIMG(1, 0)[t * RS + s] = (bf16)f2bf(a1);
                DIMG(0, 1)[t * RS + s] = (bf16)f2bf((s <= t) ? qk[g] * e0 : 0.f); DIMG(1, 1)[t * RS + s] = (bf16)f2bf((s >= t) ? qk[g] * e1 : 0.f);
                if (m0 == n0) { Dg[(m0 >> 4) * 256 + (t & 15) * 16 + r] = a0; Dg[1024 + (m0 >> 4) * 256 + (t & 15) * 16 + r] = a1; } } }
        { const int c = tid >> 3, t0 = (tid & 7) * 8; const v4u kx = *(const LAS v4u*)(KT + c * RS + t0); const float gl0 = Gs[63], gl1 = Gs[64];
          const float kf[8] = {bf_lo(kx.x), bf_hi(kx.x), bf_lo(kx.y), bf_hi(kx.y), bf_lo(kx.z), bf_hi(kx.z), bf_lo(kx.w), bf_hi(kx.w)};
          float s0[8], s1[8];
#pragma unroll
          for (int j = 0; j < 8; ++j) { s0[j] = kf[j] * __expf(gl0 - Gs[t0 + j]); s1[j] = kf[j] * __expf(gl1 - Gs[64 + t0 + j]); }
          v4u o0, o1; o0.x = cvtpk_c(s0[0], s0[1]); o0.y = cvtpk_c(s0[2], s0[3]); o0.z = cvtpk_c(s0[4], s0[5]); o0.w = cvtpk_c(s0[6], s0[7]);
          o1.x = cvtpk_c(s1[0], s1[1]); o1.y = cvtpk_c(s1[2], s1[3]); o1.z = cvtpk_c(s1[4], s1[5]); o1.w = cvtpk_c(s1[6], s1[7]);
          *(LAS v4u*)(DIMG(0, 4) + c * RS + t0) = o0; *(LAS v4u*)(DIMG(1, 4) + c * RS + t0) = o1; }
    }
    __syncthreads();
    if (wv == 0) dn_diag_inv<0>(Dg, ln); else if (wv == 4) dn_diag_inv<1>(Dg + 1024, ln);
    __syncthreads();
    if (wv < 4) dn_solve_tiles<0>(DIMG(0, 0), Dg, VT, KT, DIMG(0, 3), DIMG(0, 2), Bs, Gs, wv & 3, ln);
    else dn_solve_tiles<1>(DIMG(1, 0), Dg + 1024, VT, KT, DIMG(1, 3), DIMG(1, 2), Bs + 64, Gs + 64, wv & 3, ln);
    __syncthreads();
    {
        const int d = wv >> 2, mt = wv & 3;
        const LAS bf16* Aq = DIMG(d, 1); const LAS bf16* WT = DIMG(d, 2); const LAS bf16* UT = DIMG(d, 3); const LAS bf16* KsT = DIMG(d, 4); const LAS float* Gd = Gs + d * 64;
        const float glast = d == 0 ? Gd[63] : Gd[0];
        const size_t prob = (((size_t)b * NCHUNK + n) * 4 + h) * 2 + d;
        unsigned char* out = F.ws + WS_DNP + prob * 32768;
        if (ln == 0 && mt == 0) ((float*)(F.ws + WS_DNG))[prob] = __expf(glast);
        const float gq = __expf(Gd[16 * mt + r]);
#pragma unroll
        for (int ks = 0; ks < 2; ++ks) {
            const f32x4 y0 = mm_img(WT, Aq, 32 * ks, 16 * mt, r, q), y1 = mm_img(WT, Aq, 32 * ks + 16, 16 * mt, r, q);
            const LAS bf16* qp = QcB + (16 * mt + r) * RS + 32 * ks + 4 * q; const v2u qa = *(const LAS v2u*)qp, qb = *(const LAS v2u*)(qp + 16);
            v4u o; o.x = cvtpk_c(gq * bf_lo(qa.x) - y0[0], gq * bf_hi(qa.x) - y0[1]); o.y = cvtpk_c(gq * bf_lo(qa.y) - y0[2], gq * bf_hi(qa.y) - y0[3]);
            o.z = cvtpk_c(gq * bf_lo(qb.x) - y1[0], gq * bf_hi(qb.x) - y1[1]); o.w = cvtpk_c(gq * bf_lo(qb.y) - y1[2], gq * bf_hi(qb.y) - y1[3]);
            *(v4u*)(out + (mt * 2 + ks) * 1024 + ln * 16) = o;
            const f32x4 c0 = mm_img(WT, KsT, 32 * ks, 16 * mt, r, q), c1 = mm_img(WT, KsT, 32 * ks + 16, 16 * mt, r, q);
            v4u oc; oc.x = cvtpk_c(-c0[0], -c0[1]); oc.y = cvtpk_c(-c0[2], -c0[3]); oc.z = cvtpk_c(-c1[0], -c1[1]); oc.w = cvtpk_c(-c1[2], -c1[3]);
            *(v4u*)(out + 8192 + (mt * 2 + ks) * 1024 + ln * 16) = oc; }
#pragma unroll
        for (int nt = 0; nt < 4; ++nt) { const f32x4 rr = mm_img(Aq, UT, 16 * mt, 16 * nt, r, q), bb = mm_img(KsT, UT, 16 * mt, 16 * nt, r, q);
            v2u o; o.x = cvtpk_c(rr[0], rr[1]); o.y = cvtpk_c(rr[2], rr[3]); *(v2u*)(out + 16384 + (mt * 4 + nt) * 512 + ln * 8) = o;
            v2u ob; ob.x = cvtpk_c(bb[0], bb[1]); ob.y = cvtpk_c(bb[2], bb[3]); *(v2u*)(out + 24576 + (mt * 4 + nt) * 512 + ln * 8) = ob; }
    }
    __syncthreads();
#ifdef DBG_DN
    { unsigned char* out = F.ws + WS_DNP + ((((size_t)b * NCHUNK + n) * 4 + h) * 2) * 32768;
      if (DBG_DN < 14) { const LAS bf16* im = (const LAS bf16*)(F.lds + DBG_DN * IMG);
          for (int e = tid; e < 4096; e += NTHR) ((bf16*)out)[e] = im[(e >> 6) * RS + (e & 63)]; }
      else { for (int e = tid; e < 2304; e += NTHR) ((bf16*)out)[e] = (bf16)f2bf(Gs[e]); for (int e = 2304 + tid; e < 4096; e += NTHR) ((bf16*)out)[e] = 0; } }
    __syncthreads();
#endif
#undef DIMG
}

__device__ __forceinline__ void pool_unit(Frame& F, const Args& A, int l, int blk, int g) {
    LAS float* Uw = (LAS float*)F.lds;
    LAS float* Mm = Uw + 80 * DP;
    LAS float* PW = Mm + 64 * DP;
    const bf16* P = (const bf16*)(F.ws + WS_PROJ); bf16* PO = (bf16*)(F.ws + WS_POOLO);
    const int tid = pg8::tid_from(F.wid_s);
    const int row0 = blk * 64, b = row0 / RPB, j0 = row0 - b * RPB; const bool isctx = j0 < CTXL;
    const int seq_lo = isctx ? b * RPB : b * RPB + CTXL, L = isctx ? CTXL : SEQ; const int pos0 = row0 - seq_lo;
    for (int idx = tid; idx < 640; idx += NTHR) { const int rr = idx >> 3, c8 = (idx & 7) * 8; const int pos = pos0 - 8 + rr;
        float v[8] = {0, 0, 0, 0, 0, 0, 0, 0};
        if (pos >= 0 && pos < L) { const v4u x = *(const v4u*)(P + (size_t)(seq_lo + pos) * PLD + PC_POOL + g * 64 + c8);
            v[0] = bf_lo(x.x); v[1] = bf_hi(x.x); v[2] = bf_lo(x.y); v[3] = bf_hi(x.y); v[4] = bf_lo(x.z); v[5] = bf_hi(x.z); v[6] = bf_lo(x.w); v[7] = bf_hi(x.w); }
#pragma unroll
        for (int i = 0; i < 8; ++i) Uw[rr * DP + c8 + i] = v[i]; }
    { const float* pw = A.in[F.zz + 15] + ((size_t)l * 4 + g) * 4096;
#pragma unroll
      for (int k = 0; k < 8; ++k) { const int e = tid + 512 * k; PW[(e >> 6) * DP + (e & 63)] = pw[e]; } }
    __syncthreads();
    const int win = 2 << g;
#pragma unroll 1
    for (int k = 0; k < 8; ++k) { const int e = tid + 512 * k, t = e >> 6, i = e & 63; const int pos = pos0 + t;
        int lo = pos - win / 2, hi = lo + win; lo = lo < 0 ? 0 : lo; hi = hi > L ? L : hi;
        float s = 0.f;
#pragma unroll 4
        for (int p = lo; p < hi; ++p) s += Uw[(p - pos0 + 8) * DP + i];
        Mm[t * DP + i] = s / (float)(hi - lo) - Uw[(t + 8) * DP + i]; }
    __syncthreads();
    const float* psc = A.in[F.zz + 16] + l * 256 + g * 64;
    { const int wv = tid >> 6, ln = tid & 63, r = ln & 15, q = ln >> 4;
#pragma unroll
      for (int i = 0; i < 2; ++i) { const int tile = wv * 2 + i, m0 = (tile >> 2) * 16, n0 = (tile & 3) * 16;
          const f32x4 y = mm_tile(Mm, DP, 1, PW, DP, 1, m0, n0, ln); const float sc = psc[n0 + r];
#pragma unroll
          for (int gg = 0; gg < 4; ++gg) PO[(size_t)(row0 + m0 + 4 * q + gg) * 256 + g * 64 + n0 + r] = (bf16)f2bf(y[gg] * sc); } }
    __syncthreads();
}

constexpr int SC_SLOT = 32768, SC_NSLOT = 4, SC_ST = SC_SLOT * SC_NSLOT, SC_GL = SC_ST + 2 * 8192;
__device__ __forceinline__ void dn_scan_item(Frame& F, int item) {
    typedef short s16x8v __attribute__((ext_vector_type(8)));
    const int d = item & 1, h = (item >> 1) & 3, b = item >> 3;
    const int tid = pg8::tid_from(F.wid_s);
    const int wv = __builtin_amdgcn_readfirstlane(tid >> 6), ln = tid & 63, r = ln & 15, q = ln >> 4;
    LAS unsigned char* L = F.lds;
    LAS float* glv = (LAS float*)(L + SC_GL);
    const unsigned char* dnp = F.ws + WS_DNP;
#define SC_N(st) (d == 0 ? (st) : ((st) < 4 ? 3 - (st) : 71 - (st)))
#define SC_PROB(st) ((((size_t)b * NCHUNK + SC_N(st)) * 4 + h) * 2 + d)
    if (tid < NCHUNK) glv[tid] = ((const float*)(F.ws + WS_DNG))[SC_PROB(tid)];
    for (int e = tid; e < 2 * 8192 / 16; e += NTHR) ((LAS v4u*)(L + SC_ST))[e] = (v4u){0u, 0u, 0u, 0u};
    asm volatile("s_waitcnt vmcnt(0) lgkmcnt(0)" ::: "memory"); __builtin_amdgcn_s_barrier();
#define SC_DMA(st, slot) do { const unsigned char* src_ = dnp + SC_PROB(st) * 32768 + wv * 8192 + ln * 16; \
        _Pragma("unroll") for (int i_ = 0; i_ < 8; ++i_) __builtin_amdgcn_global_load_lds((const unsigned*)(src_ + i_ * 1024), (LAS unsigned*)(L + (slot) * SC_SLOT + wv * 8192 + i_ * 1024), 16, 0, 0); } while (0)
    if (wv < 4) { SC_DMA(0, 0); SC_DMA(1, 1); SC_DMA(2, 2); }
    f32x4 s0 = {0.f, 0.f, 0.f, 0.f}, s1 = s0, s2 = s0, s3 = s0;
    bf16* DNO = (bf16*)(F.ws + WS_DNO) + (size_t)d * MROWS * 256;
#pragma unroll 1
    for (int st = 0; st < NCHUNK; ++st) {
        if (wv < 4) asm volatile("s_waitcnt vmcnt(16)" ::: "memory");
        asm volatile("s_waitcnt lgkmcnt(0)" ::: "memory"); __builtin_amdgcn_s_barrier();
        if (wv < 4) { const int nx = st + 3 < NCHUNK ? st + 3 : NCHUNK - 1; SC_DMA(nx, (st + 3) & 3); }
        const LAS unsigned char* slot = L + (st & 3) * SC_SLOT;
        const LAS unsigned char* stc = L + SC_ST + (st & 1) * 8192; LAS unsigned char* stn = L + SC_ST + ((st + 1) & 1) * 8192;
        const int nt = wv & 3;
        const s16x8v bf0 = *(const LAS s16x8v*)(stc + (nt * 2 + 0) * 1024 + ln * 16), bf1 = *(const LAS s16x8v*)(stc + (nt * 2 + 1) * 1024 + ln * 16);
        if (wv < 4) {
            const float gl = glv[st];
            const LAS unsigned char* cf = slot + 8192; const LAS unsigned char* bi = slot + 24576;
#define SC_ST_TILE(S, mt) do { const v2u bw_ = *(const LAS v2u*)(bi + ((mt) * 4 + nt) * 512 + ln * 8); \
            f32x4 a_ = {gl * S[0] + bf_lo(bw_.x), gl * S[1] + bf_hi(bw_.x), gl * S[2] + bf_lo(bw_.y), gl * S[3] + bf_hi(bw_.y)}; \
            a_ = __builtin_amdgcn_mfma_f32_16x16x32_bf16(*(const LAS s16x8v*)(cf + ((mt) * 2 + 0) * 1024 + ln * 16), bf0, a_, 0, 0, 0); \
            a_ = __builtin_amdgcn_mfma_f32_16x16x32_bf16(*(const LAS s16x8v*)(cf + ((mt) * 2 + 1) * 1024 + ln * 16), bf1, a_, 0, 0, 0); S = a_; } while (0)
            SC_ST_TILE(s0, 0); SC_ST_TILE(s1, 1); SC_ST_TILE(s2, 2); SC_ST_TILE(s3, 3);
#undef SC_ST_TILE
            v4u w0, w1; w0.x = pk2(s0[0], s0[1]); w0.y = pk2(s0[2], s0[3]); w0.z = pk2(s1[0], s1[1]); w0.w = pk2(s1[2], s1[3]);
            w1.x = pk2(s2[0], s2[1]); w1.y = pk2(s2[2], s2[3]); w1.z = pk2(s3[0], s3[1]); w1.w = pk2(s3[2], s3[3]);
            *(LAS v4u*)(stn + (nt * 2 + 0) * 1024 + ln * 16) = w0; *(LAS v4u*)(stn + (nt * 2 + 1) * 1024 + ln * 16) = w1;
        } else {
            const LAS unsigned char* pf = slot; const LAS unsigned char* ri = slot + 16384;
            const int n = SC_N(st);
            bf16* orow = DNO + (size_t)(b * RPB + n * 64 + 4 * q) * 256 + h * 64 + nt * 16 + r;
#pragma unroll
            for (int mt = 0; mt < 4; ++mt) { const v2u rw_ = *(const LAS v2u*)(ri + (mt * 4 + nt) * 512 + ln * 8);
                f32x4 a_ = {bf_lo(rw_.x), bf_hi(rw_.x), bf_lo(rw_.y), bf_hi(rw_.y)};
                a_ = __builtin_amdgcn_mfma_f32_16x16x32_bf16(*(const LAS s16x8v*)(pf + (mt * 2 + 0) * 1024 + ln * 16), bf0, a_, 0, 0, 0);
                a_ = __builtin_amdgcn_mfma_f32_16x16x32_bf16(*(const LAS s16x8v*)(pf + (mt * 2 + 1) * 1024 + ln * 16), bf1, a_, 0, 0, 0);
#pragma unroll
                for (int g = 0; g < 4; ++g) orow[(size_t)(16 * mt + g) * 256] = (bf16)f2bf(a_[g]); }
        }
    }
    asm volatile("s_waitcnt vmcnt(0) lgkmcnt(0)" ::: "memory"); __builtin_amdgcn_s_barrier();
#undef SC_DMA
#undef SC_N
#undef SC_PROB
}

__device__ __forceinline__ void mix_build(Frame& F, const Args& A, int l) {
    const int lane = pg8::lane_id_asm(); const int gw = F.vcu * NWAVES + F.wave, NGW = F.G * NWAVES;
    const bf16* ATTO = (const bf16*)(F.ws + WS_ATTO); const bf16* P = (const bf16*)(F.ws + WS_PROJ); const bf16* DNO = (const bf16*)(F.ws + WS_DNO); bf16* MIX = (bf16*)(F.ws + WS_MIX);
    const float lam = ((const float*)(F.ws + WS_LAM))[l]; const float li = 0.8f - 0.6f * expf(-0.3f * (float)l);
    const float* sg = A.in[F.zz + 10] + l * 128; const float* ng = A.in[F.zz + 14] + l * 64;
    for (int R = gw; R < MROWS; R += NGW) {
        const int j = R % RPB; if (l == 1 && j < CTXL) continue;
        { const int hh = lane >> 4, e0 = (lane & 15) * 8;
          const v4u a = *(const v4u*)(ATTO + (size_t)R * DM + (hh * 2) * 128 + e0), c = *(const v4u*)(ATTO + (size_t)R * DM + (hh * 2 + 1) * 128 + e0);
          float x[8] = {bf_lo(a.x) - lam * bf_lo(c.x), bf_hi(a.x) - lam * bf_hi(c.x), bf_lo(a.y) - lam * bf_lo(c.y), bf_hi(a.y) - lam * bf_hi(c.y),
                        bf_lo(a.z) - lam * bf_lo(c.z), bf_hi(a.z) - lam * bf_hi(c.z), bf_lo(a.w) - lam * bf_lo(c.w), bf_hi(a.w) - lam * bf_hi(c.w)};
          float ss = 0.f;
#pragma unroll
          for (int i = 0; i < 8; ++i) ss += x[i] * x[i];
          ss = grp16_sum(ss);
          const float sc = (1.f / sqrtf(ss * (1.f / 128.f) + EPSN)) * (1.f - li);
          const f32x4 g0 = *(const f32x4*)(sg + e0), g1 = *(const f32x4*)(sg + e0 + 4);
          v4u o; o.x = pk2(x[0] * sc * g0[0], x[1] * sc * g0[1]); o.y = pk2(x[2] * sc * g0[2], x[3] * sc * g0[3]); o.z = pk2(x[4] * sc * g1[0], x[5] * sc * g1[1]); o.w = pk2(x[6] * sc * g1[2], x[7] * sc * g1[3]);
          *(v4u*)(MIX + (size_t)R * DM + hh * 128 + e0) = o; }
        { const int c0 = lane * 4;
          const v2u a = *(const v2u*)(DNO + (size_t)R * 256 + c0), c = *(const v2u*)(DNO + ((size_t)MROWS + R) * 256 + c0), z = *(const v2u*)(P + (size_t)R * PLD + PC_DZ + c0);
          float x[4] = {bf_lo(a.x) + bf_lo(c.x), bf_hi(a.x) + bf_hi(c.x), bf_lo(a.y) + bf_lo(c.y), bf_hi(a.y) + bf_hi(c.y)};
          float ss = x[0] * x[0] + x[1] * x[1] + x[2] * x[2] + x[3] * x[3];
          ss = grp16_sum(ss);
          const float sc = 1.f / sqrtf(ss * (1.f / 64.f) + EPSN);
          const f32x4 gg = *(const f32x4*)(ng + (c0 & 63));
          v2u o; o.x = pk2(x[0] * sc * gg[0] * siluf_(bf_lo(z.x)), x[1] * sc * gg[1] * siluf_(bf_hi(z.x))); o.y = pk2(x[2] * sc * gg[2] * siluf_(bf_lo(z.y)), x[3] * sc * gg[3] * siluf_(bf_hi(z.y)));
          *(v2u*)(MIX + (size_t)R * DM + 512 + c0) = o; }
        { const v2u pz = *(const v2u*)((const bf16*)(F.ws + WS_POOLO) + (size_t)R * 256 + lane * 4); *(v2u*)(MIX + (size_t)R * DM + 768 + lane * 4) = pz; }
    }
}

#ifndef MK_N_LAUNCHES
#define MK_N_LAUNCHES 1
#endif
__device__ __forceinline__ bool in_phase(int k, int lo, int hi) { asm volatile("" : "+s"(lo), "+s"(hi)); return lo <= k && k < hi; }
__global__ void __launch_bounds__(NTHR, 2) mk_fwd(Args args) {
    extern __shared__ __attribute__((aligned(16))) unsigned char lds[];
    Frame F;
    F.lds = (LAS unsigned char*)lds;
    F.MISC = (volatile LAS unsigned*)(F.lds + MISC_OFF);
    F.wid_s = __builtin_amdgcn_readfirstlane((int)(threadIdx.x >> 6));
    F.tid = pg8::tid_from(F.wid_s); F.lane = F.tid & 63; F.wave = F.wid_s;
    F.G = gridDim.x; { const int bx = blockIdx.x; F.bx = bx; F.vcu = (F.G % 8 == 0) ? (bx % 8) * (F.G / 8) + bx / 8 : bx; }
    F.ws = args.ws; F.out = args.out; F.zz = 0;
    F.ctl = (gu32*)(args.ws + WS_CTL);
    for (int u = F.tid; u < (LDS_BYTES - MISC_OFF) / 4; u += NTHR) ((LAS unsigned*)(F.lds + MISC_OFF))[u] = 0u;
    __syncthreads();
    const int lo = args.ph_lo, hi = args.ph_hi;
    const bool use_bar = (hi - lo) > 1;
    XcdBarrier bar; bar.bar = ((unsigned*)(F.ctl + CW_BAR) + args.bar_li * XCD_BAR_WORDS); bar.x = 0; bar.st = nullptr; bar.wid = (unsigned)F.wid_s;
    if (use_bar) bar = xcd_barrier_post(((unsigned*)(F.ctl + CW_BAR) + args.bar_li * XCD_BAR_WORDS), F.MISC + 8, (unsigned)F.wid_s);
#ifndef EN_MASK
#define EN_MASK 0xFFFFFFFFu
#endif
#define IN(k) (((EN_MASK >> ((k) > 12 ? (k) - 12 : (k))) & 1u) && in_phase((k), lo, hi))
#define PB() do { GAS unsigned char* w_ = (GAS unsigned char*)args.ws; LAS unsigned char* l_ = (LAS unsigned char*)lds; int z_ = 0; asm volatile("" : "+s"(w_), "+s"(l_), "+s"(z_)); F.ws = (unsigned char*)w_; F.ctl = (gu32*)w_; F.lds = l_; F.zz = z_; { int bx_ = blockIdx.x; asm volatile("" : "+s"(bx_)); F.bx = bx_; F.vcu = (F.G % 8 == 0) ? (bx_ % 8) * (F.G / 8) + bx_ / 8 : bx_; } const int t_ = pg8::tid_from(F.wid_s); F.tid = t_; F.lane = t_ & 63; F.wave = F.wid_s; } while (0)
#ifdef DBG_DUP
#define NREP(k) ((((k) > 12 && (k) < 23) ? (k) - 12 : (k)) == DBG_DUP ? 2 : 1)
#else
#define NREP(k) 1
#endif
#define SEAMX() do { XcdBarrier bl_ = bar; { GAS unsigned* b_ = (GAS unsigned*)(args.ws + WS_CTL) + CW_BAR + args.bar_li * XCD_BAR_WORDS; unsigned x_ = bar.x; asm volatile("" : "+s"(b_), "+s"(x_)); bl_.bar = (unsigned*)b_; bl_.x = x_; } xcd_barrier(bl_); } while (0)
#define PH_BEGIN(k) if (IN(k)) { for (int rep_ = 0; rep_ < NREP(k); ++rep_) { if (rep_) SEAMX(); PB();
#define PH_END(k) } } SEAM(k);
#define SEAM(k) do { if (IN(k) && IN((k) + 1)) { XcdBarrier bl_ = bar; { GAS unsigned* b_ = (GAS unsigned*)(args.ws + WS_CTL) + CW_BAR + args.bar_li * XCD_BAR_WORDS; unsigned x_ = bar.x; asm volatile("" : "+s"(b_), "+s"(x_)); bl_.bar = (unsigned*)b_; bl_.x = x_; } xcd_barrier(bl_); } } while (0)
    char* ldsg = (char*)lds;

    PH_BEGIN(PH_PRO) p0_prologue(F, args); PH_END(PH_PRO)

#pragma unroll 1
    for (int l = 0; l < 2; ++l) {
        const int pb = 1 + 12 * l;
        const float* modl = (const float*)(F.ws + WS_MOD) + l * 5 * 6144;
        PH_BEGIN(pb + PH_N1) norm_mod_phase(F, args, l, 0, false, false, false, l == 1 ? 11 : 0, l == 0 ? 1 : 0); PH_END(pb + PH_N1)
        PH_BEGIN(pb + PH_PROJ)
            { pg8::Gemm g{(const bf16*)(F.ws + WS_U), (const bf16*)(F.ws + WS_WIN) + (size_t)l * NPB * 1024, 1024, 1024, 1024, 0, 0, F.wid_s};
              TileOrder S; S.init(MROWS / 256, NPB / 256, F.G, F.bx, 0);
              EpiProj E{(bf16*)(F.ws + WS_PROJ), (const float*)(F.ws + WS_ROPE)};
              pg8::gemm_phase<EpiProj, TileOrder, true, true>(F.lds, g, S, E); }
            { pg8::Gemm g{(const bf16*)(F.ws + WS_U8), (const bf16*)(F.ws + WS_WG8 + (size_t)l * 3072 * 1024), 512, 512, 512, E8(F8_ACT_L2), E8(F8_W13_L2), F.wid_s};
              TileOrder S; S.init(MROWS / 256, 12, F.G, F.bx, 0);
              EpiGate E{(bf16*)(F.ws + WS_PROJ)};
              pg8::gemm_phase8<EpiGate, TileOrder, true, true>(F.lds, g, S, E); }
            ab_tiles(F, args, l);
        PH_END(pb + PH_PROJ)
        PH_BEGIN(pb + PH_ATT)
            const bf16* P = (const bf16*)(F.ws + WS_PROJ); bf16* AO = (bf16*)(F.ws + WS_ATTO);
            const int nunits = 512 + (l == 0 ? 32 : 0);
#ifndef DIS_ATTN
#ifdef DBG_DUP
            for (int r2_ = 0; r2_ < (DBG_DUP == 31 ? 2 : 1); ++r2_)
#endif
#pragma unroll 1
            for (int u = F.vcu; u < nunits; u += F.G) {
                int b, hm, qrow, seq;
                if (u < 512) { b = u >> 7; hm = (u >> 4) & 7; qrow = CTXL + (u & 15) * 256; seq = RPB; }
                else { const int v = u - 512; b = v >> 3; hm = v & 7; qrow = 0; seq = CTXL; }
                const size_t r0 = (size_t)b * RPB;
                attn::attn_unit<PLD, DM>(P + (r0 + qrow) * PLD + PC_AQ + hm * 64, P + r0 * PLD + PC_AK + hm * 64, P + r0 * PLD + PC_AV + (hm >> 1) * 128,
                                           AO + (r0 + qrow) * DM + hm * 128, seq, (char*)F.lds, F.wid_s);
            }
#endif
#ifndef DIS_DNPRE
#ifdef DBG_DUP
            for (int r2_ = 0; r2_ < (DBG_DUP == 32 ? 2 : 1); ++r2_)
#endif
#pragma unroll 1
            for (int u = F.vcu; u < NB * NCHUNK * 4; u += F.G) { const int h = u & 3, n = (u >> 2) % NCHUNK, b = (u >> 2) / NCHUNK; dn_pre_unit(F, args, l, b, n, h); }
#endif
        PH_END(pb + PH_ATT)
        PH_BEGIN(pb + PH_SCAN)
#pragma unroll 1
            for (int it = F.vcu; it < 32; it += F.G) dn_scan_item(F, it);
            { const bool many = F.G > 32; const int rk = many ? F.vcu - 32 : F.vcu, nr = many ? F.G - 32 : F.G;
              if (rk >= 0) {
#pragma unroll 1
                for (int u = rk; u < (MROWS / 64) * 4; u += nr) pool_unit(F, args, l, u >> 2, u & 3);
                if (l == 0) conv_layer_weights(F, args, 1, rk * NWAVES + F.wave, nr * NWAVES);
                else moe_convert(F, args, rk * NWAVES + F.wave, nr * NWAVES); } }
        PH_END(pb + PH_SCAN)
        PH_BEGIN(pb + PH_MIXB) mix_build(F, args, l); PH_END(pb + PH_MIXB)
        if (IN(pb + PH_MRG0)) { PB();
            pg8::Gemm g{(const bf16*)(F.ws + WS_MIX), (const bf16*)(F.ws + WS_WBR) + (size_t)l * 1024 * 1024, 1024, 1024, 1024, 0, 0, F.wid_s};
            TileOrder S; S.init(l == 0 ? 68 : 64, 4, F.G, F.bx, l);
            EpiMergeF E{(bf16*)(F.ws + WS_MG), (const bf16*)(F.ws + WS_PROJ)};
            pg8::gemm_phase<EpiMergeF, TileOrder, true, true>(F.lds, g, S, E);
        } SEAM(pb + PH_MRG2);
        if (IN(pb + PH_OUT)) { PB();
            { pg8::Gemm g{(const bf16*)(F.ws + WS_MG), (const bf16*)(F.ws + WS_WOUT) + (size_t)l * 1024 * 1024, 1024, 1024, 1024, 0, 0, F.wid_s};
              TileOrder S; S.init(64, 4, F.G, F.bx, 1);
              EpiResid E{(float*)(F.ws + WS_H), modl, 2, l == 0 ? args.in[F.zz + 0] : nullptr};
              pg8::gemm_phase<EpiResid, TileOrder, true, true>(F.lds, g, S, E); }
            if (l == 0) {
              pg8::Gemm g{(const bf16*)(F.ws + WS_MG), (const bf16*)(F.ws + WS_WOUT), 256, 1024, 1024, 0, 0, F.wid_s};
              CtxSplitOrder S; S.init(4, 512, F.G, F.bx);
              EpiSlab E{(float*)(F.ws + WS_SLAB), modl, 2};
              pg8::gemm_phase<EpiSlab, CtxSplitOrder, true, true>(F.lds, g, S, E); }
        } SEAM(pb + PH_OUT);
#ifdef DENSE_F8
        PH_BEGIN(pb + PH_N2) norm_mod_phase(F, args, l, 1, l == 1, l == 1, l == 0); PH_END(pb + PH_N2)
#else
        PH_BEGIN(pb + PH_N2) if (l == 0) norm_mod_phase(F, args, 0, 1, false, false, false, 4, 2); else norm2_route_phase(F, args); PH_END(pb + PH_N2)
#endif
        if (l == 0) {
#ifdef DENSE_F8
            PH_BEGIN(PH_FUP)
                pg8::Gemm g{(const bf16*)(F.ws + WS_U), (const bf16*)(F.ws + WS_W13), 512, 512, 512, E8(F8_ACT_L2), E8(F8_W13_L2), F.wid_s};
                TileOrder S; S.init(68, 2 * FFD / 256, F.G, F.bx, 0);
                EpiSwiglu8 E{F.ws + WS_HID, FFD};
                pg8::gemm_phase8<EpiSwiglu8, TileOrder, true, true>(F.lds, g, S, E);
            PH_END(PH_FUP)
            if (IN(PH_FDN)) { PB();
                pg8::Gemm g{(const bf16*)(F.ws + WS_HID), (const bf16*)(F.ws + WS_W2), FFD / 2, FFD / 2, FFD / 2, E8(F8_ACT_L2), E8(F8_W2_L2), F.wid_s};
                TileOrder S; S.init(68, 4, F.G, F.bx, 0);
                EpiResid E{(float*)(F.ws + WS_H), modl, 5, nullptr};
                pg8::gemm_phase8<EpiResid, TileOrder, true, true>(F.lds, g, S, E);
            } SEAM(PH_FDN);
#else
            PH_BEGIN(PH_FUP)
                pg8::Gemm g{(const bf16*)(F.ws + WS_U), (const bf16*)(F.ws + WS_W13), 1024, 1024, 1024, 0, 0, F.wid_s};
                TileOrder S; S.init(68, 2 * FFD / 256, F.G, F.bx, 0);
                EpiSwiglu E{(bf16*)(F.ws + WS_HID), FFD};
                pg8::gemm_phase<EpiSwiglu, TileOrder, true, true>(F.lds, g, S, E);
            PH_END(PH_FUP)
            if (IN(PH_FDN)) { PB();
                { pg8::Gemm g{(const bf16*)(F.ws + WS_HID), (const bf16*)(F.ws + WS_W2), FFD, FFD, FFD, 0, 0, F.wid_s};
                  TileOrder S; S.init(64, 4, F.G, F.bx, 1);
                  EpiResid E{(float*)(F.ws + WS_H), modl, 5, nullptr};
                  pg8::gemm_phase<EpiResid, TileOrder, true, true>(F.lds, g, S, E); }
                { pg8::Gemm g{(const bf16*)(F.ws + WS_HID), (const bf16*)(F.ws + WS_W2), 256, FFD, FFD, 0, 0, F.wid_s};
                  CtxSplitOrder S; S.init(11, 512, F.G, F.bx);
                  EpiSlab E{(float*)(F.ws + WS_SLAB), modl, 5};
                  pg8::gemm_phase<EpiSlab, CtxSplitOrder, true, true>(F.lds, g, S, E); }
            } SEAM(PH_FDN);
#endif
        }
    }
    PH_BEGIN(PH_GATH) moe_gather(F); PH_END(PH_GATH)
#pragma unroll 1
    for (int hh = 0; hh < 1; ++hh) {
        const int p0 = PH_CV0 + 3 * hh;
        PH_BEGIN(p0 + 1)
            pg8::Gemm g{(const bf16*)(F.ws + WS_XG), (const bf16*)(F.ws + WS_W13M), 512, 512, 512, E8(F8_ACT_L2), E8(F8_W13_L2), F.wid_s};
            MoeOrder S; S.init(F.ctl + CW_ECNT, 2 * FFE / 256, F.G, F.vcu);
            EpiSwiglu8 E{F.ws + WS_HIDM, FFE};
            pg8::gemm_phase8<EpiSwiglu8, MoeOrder, true, true>(F.lds, g, S, E);
        PH_END(p0 + 1)
        if (IN(p0 + 2)) { PB();
            pg8::Gemm g{(const bf16*)(F.ws + WS_HIDM), (const bf16*)(F.ws + WS_W2M), FFE / 2, FFE / 2, FFE / 2, E8(F8_ACT_L2), E8(F8_W2_L2), F.wid_s};
            MoeOrder S; S.init(F.ctl + CW_ECNT, 4, F.G, F.vcu);
            EpiY E{(bf16*)(F.ws + WS_Y), 1};
            pg8::gemm_phase8<EpiY, MoeOrder, true, true>(F.lds, g, S, E);
        } SEAM(p0 + 2);
    }
    PH_BEGIN(PH_FIN) final_phase(F, args); } }
#ifdef DBG_STOP
    if (lo == 100) {
        const int gw = F.vcu * NWAVES + F.wave, NGW = F.G * NWAVES;
        for (int tk = gw; tk < NB * SEQ; tk += NGW) { const int b = tk / SEQ, t = tk - b * SEQ; const size_t R = (size_t)b * RPB + CTXL + t;
#if DBG_SRC == 0
            const f32x4* s = (const f32x4*)((const float*)(args.ws + WS_H) + R * DM) + F.lane; f32x4* d = (f32x4*)(args.out + (size_t)tk * DM) + F.lane;
            for (int q = 0; q < 4; ++q) d[64 * q] = s[64 * q];
#elif DBG_SRC == 2
            MoeOrder mo; mo.init((gu32*)args.ws + CW_ECNT, 1, 1, 0); const v4u rt = ((const v4u*)(args.ws + WS_ROUTE))[2 * tk];
            const size_t rr = (size_t)mo.tile_off((int)rt.x) * 256 + rt.z; (void)R;
            const bf16* s = (const bf16*)(args.ws + DBG_OFF) + rr * DBG_LD + DBG_COL; float* d = args.out + (size_t)tk * DM;
            for (int q = 0; q < 16; ++q) d[F.lane + 64 * q] = bf2f(s[F.lane + 64 * q]);
#else
#ifdef DBG_MOD
            const bf16* s = (const bf16*)(args.ws + DBG_OFF) + (R % DBG_MOD) * DBG_LD + DBG_COL; float* d = args.out + (size_t)tk * DM;
#else
            const bf16* s = (const bf16*)(args.ws + DBG_OFF) + R * DBG_LD + DBG_COL; float* d = args.out + (size_t)tk * DM;
#endif
            for (int q = 0; q < 16; ++q) { float v = bf2f(s[F.lane + 64 * q]); d[F.lane + 64 * q] = (v == v && fabsf(v) < 1e30f) ? v : DBG_NANVAL; }
#endif
        }
    }
#endif
#undef IN
#undef SEAM
}

extern "C" void kernel_launch(void* const* d_in, const int* in_sizes, int n_in, void* d_out, int out_size, void* d_ws, size_t ws_size, hipStream_t stream) {
    static int grid = 0;
    if (grid == 0) {
        if (n_in != 27 || in_sizes[0] != NB * SEQ * DM || out_size != NB * SEQ * DM || ws_size < WS_END) {
            fprintf(stderr, "kernel_launch: shape / workspace mismatch (n_in %d, in0 %d, out %d, ws %zu, need %zu); nothing launched\n", n_in, n_in > 0 ? in_sizes[0] : -1, out_size, ws_size, (size_t)WS_END); grid = -1; return; }
        int dev = 0, cus = 0, per_cu = 0;
        if (hipGetDevice(&dev) != hipSuccess || hipDeviceGetAttribute(&cus, hipDeviceAttributeMultiprocessorCount, dev) != hipSuccess) { grid = -1; return; }
        if (hipFuncSetAttribute((const void*)mk_fwd, hipFuncAttributeMaxDynamicSharedMemorySize, LDS_BYTES) != hipSuccess) { fprintf(stderr, "kernel_launch: hipFuncSetAttribute failed\n"); grid = -1; return; }
        if (hipOccupancyMaxActiveBlocksPerMultiprocessor(&per_cu, (const void*)mk_fwd, NTHR, LDS_BYTES) != hipSuccess || per_cu < 1)
            fprintf(stderr, "kernel_launch: note: occupancy query reports %d workgroups per CU\n", per_cu);
        (void)hipGetLastError();
        grid = cus;
    }
    if (grid < 0) return;
    if (hipMemsetAsync((char*)d_ws + WS_CTL, 0, CTL_ZERO_BYTES, stream) != hipSuccess) return;
    Args a{};
    for (int i = 0; i < 27; ++i) a.in[i] = (const float*)d_in[i];
    a.out = (float*)d_out; a.ws = (unsigned char*)d_ws;
    constexpr int NL = MK_N_LAUNCHES;
#ifdef DBG_STOP
    constexpr int NLL = DBG_STOP + 2;
#else
    constexpr int NLL = NL;
#endif
#ifdef DBG_PREFIX
    for (int li = 0; li < 2; ++li) { a.ph_lo = 0; a.ph_hi = li == 0 ? DBG_PREFIX + 1 : PH_COUNT; a.bar_li = li;
        hipLaunchKernelGGL(mk_fwd, dim3(grid), dim3(NTHR), LDS_BYTES, stream, a); }
    return;
#endif
    for (int li = 0; li < NLL; ++li) {
#ifdef DBG_SKIP_LO
        if (li >= DBG_SKIP_LO && li <= DBG_SKIP_HI) continue;
#endif
        a.ph_lo = (NL == 1) ? 0 : li; a.ph_hi = (NL == 1) ? PH_COUNT : li + 1;
#ifdef DBG_STOP
        a.ph_lo = li; a.ph_hi = li + 1;
        if (li == NLL - 1) { a.ph_lo = 100; a.ph_hi = 101; }
#endif
        hipLaunchKernelGGL(mk_fwd, dim3(grid), dim3(NTHR), LDS_BYTES, stream, a);
        const hipError_t le = hipPeekAtLastError();
        if (le != hipSuccess) { fprintf(stderr, "kernel_launch: launch %d failed: %s\n", li, hipGetErrorName(le)); break; }
    }
}
```

```cpp
#include <hip/hip_runtime.h>
#include <cstdio>
#include <cstdint>
#include <cmath>

namespace pg8 {
#define PG8_LAS __attribute__((address_space(3)))
typedef unsigned short bf16_t;
typedef short bf16x8 __attribute__((ext_vector_type(8)));
typedef float f32x4 __attribute__((ext_vector_type(4)));
typedef unsigned u32x4 __attribute__((ext_vector_type(4)));
typedef unsigned u32x2 __attribute__((ext_vector_type(2)));
constexpr int BM = 256, BK = 64, HALF = 128, HTB = HALF * BK * 2  , STAGE_BYTES = 8 * HTB;

__host__ __device__ __forceinline__ int lds_byte(int r, int c) { const int st = (r >> 4) * 2 + (c >> 5), rr = r & 15, cc = c & 31, ob = rr * 64 + cc * 2; return st * 1024 + (ob ^ (((ob >> 9) & 1) << 5)); }
__host__ __device__ __forceinline__ void stage_rc(int b, int& R, int& C) { const int st = b / 1024, sb = b % 1024, swz = sb ^ (((sb >> 9) & 1) << 5); R = (st >> 1) * 16 + swz / 64; C = (st & 1) * 32 + (swz % 64) / 2; }
__host__ __device__ __forceinline__ int perm32(int rho) { const int n = rho >> 4, i = rho & 15; return 8 * (i >> 2) + 4 * n + (i & 3); }

__device__ __forceinline__ int lane_id_asm() { int l; asm volatile("v_mbcnt_lo_u32_b32 %0, -1, 0\n\tv_mbcnt_hi_u32_b32 %0, -1, %0" : "=v"(l)); return l; }
__device__ __forceinline__ int tid_from(int wid) { return (wid << 6) | lane_id_asm(); }
struct Unit { int pm, pn, pb, ko, aux; };
struct Gemm { const bf16_t* A; const bf16_t* Bt; int K, lda, ldb, sA, sB, wid; };

__device__ __forceinline__ unsigned cvt_pk_bf16(float lo, float hi) { unsigned r; asm volatile("v_cvt_pk_bf16_f32 %0, %1, %2" : "=v"(r) : "v"(lo), "v"(hi)); return r; }
template <class Epi, class Sched, bool ALIGN_EPI = false, bool SP2 = false>
__device__ __forceinline__ void gemm_phase(PG8_LAS unsigned char* lds, const Gemm g, const Sched& S, const Epi& E) {
    const int wid = g.wid; const int tid = tid_from(wid), lane = tid & 63, wr = wid >> 2, wc = wid & 3, fr = lane & 15, fq = lane >> 4;
    const int K = g.K, nt = K / BK;
    unsigned voffA[2], voffB[2];
#pragma unroll
    for (int i = 0; i < 2; ++i) { int R, C; stage_rc(tid * 16 + i * 8192, R, C); const int Rb = Epi::PERM ? ((R & ~31) + perm32(R & 31)) : R;
        voffA[i] = (unsigned)(R * g.lda + C) * 2u; voffB[i] = (unsigned)(Rb * g.ldb + C) * 2u; }
    const size_t kstep = (size_t)(BK * 2);
    const size_t hstepA = (size_t)HALF * g.lda * 2, hstepB = (size_t)HALF * g.ldb * 2;
    const size_t tstepA = 2 * hstepA, tstepB = 2 * hstepB;
    const unsigned ldsw = (unsigned)wid * 1024u;
    const int aoff = lds_byte(wr * 64 + fr, fq * 8), boff = lds_byte(wc * 32 + fr, fq * 8);
#define PG8_SA(b, h) (((b) * 2 + (h)) * HTB)
#define PG8_SB(b, h) ((4 + (b) * 2 + (h)) * HTB)
#define PG8_STAGE(bufoff, gbase, voff) do { _Pragma("unroll") for (int _i = 0; _i < 2; ++_i) \
        __builtin_amdgcn_global_load_lds((const unsigned*)((const char*)(gbase) + (voff)[_i]), (PG8_LAS unsigned*)(lds + (bufoff) + ldsw + _i * 8192), 16, 0, 0); } while (0)
#define PG8_LDA(dst, b, h) do { _Pragma("unroll") for (int m = 0; m < 4; ++m) _Pragma("unroll") for (int k = 0; k < 2; ++k) dst[m][k] = *(const PG8_LAS bf16x8*)(lds + PG8_SA(b, h) + aoff + m * 2048 + k * 1024); } while (0)
#define PG8_LDB(dst, b, h) do { _Pragma("unroll") for (int n = 0; n < 2; ++n) _Pragma("unroll") for (int k = 0; k < 2; ++k) dst[n][k] = *(const PG8_LAS bf16x8*)(lds + PG8_SB(b, h) + boff + n * 2048 + k * 1024); } while (0)
#define PG8_MMA(ai, bj, At, Bt) do { __builtin_amdgcn_s_setprio(1); _Pragma("unroll") for (int m = 0; m < 4; ++m) _Pragma("unroll") for (int n = 0; n < 2; ++n) _Pragma("unroll") for (int k = 0; k < 2; ++k) \
        acc[ai][bj][m][n] = __builtin_amdgcn_mfma_f32_16x16x32_bf16(Bt[n][k], At[m][k], acc[ai][bj][m][n], 0, 0, 0); __builtin_amdgcn_s_setprio(0); } while (0)
#define PG8_WAIT_V(n) asm volatile("s_waitcnt vmcnt(" #n ")" ::: "memory")
#define PG8_WAIT_L(n) asm volatile("s_waitcnt lgkmcnt(" #n ")" ::: "memory")
#define PG8_BAR __builtin_amdgcn_s_barrier()
#define PG8_SCHED __builtin_amdgcn_sched_barrier(0)
    Unit cur, nxt; int ui = 0;
    if (!S.next(0, cur)) return;
    f32x4 acc[2][2][4][2];
#pragma unroll
    for (int a = 0; a < 2; ++a)
#pragma unroll
        for (int b = 0; b < 2; ++b)
#pragma unroll
            for (int m = 0; m < 4; ++m)
#pragma unroll
                for (int n = 0; n < 2; ++n) acc[a][b][m][n] = (f32x4){0.f, 0.f, 0.f, 0.f};
    bf16x8 At[4][2], B0[2][2], B1[2][2];
    const char* cA = (const char*)g.A + (size_t)cur.pm * tstepA + cur.ko; const char* cB = (const char*)g.Bt + (size_t)cur.pb * tstepB + cur.ko;
    S.a_ready(cur);
    if constexpr (SP2) {
        PG8_STAGE(PG8_SB(0, 0), cB, voffB); PG8_STAGE(PG8_SB(0, 1), cB + hstepB, voffB); PG8_STAGE(PG8_SA(0, 0), cA, voffA); PG8_STAGE(PG8_SA(0, 1), cA + hstepA, voffA);
        if (wr == 1) PG8_BAR;
        PG8_WAIT_V(2); PG8_BAR;
        PG8_STAGE(PG8_SB(1, 0), cB + kstep, voffB); PG8_STAGE(PG8_SA(1, 0), cA + kstep, voffA); PG8_STAGE(PG8_SB(1, 1), cB + hstepB + kstep, voffB);
        PG8_WAIT_V(6); PG8_BAR;
    } else {
        PG8_STAGE(PG8_SB(0, 0), cB, voffB); PG8_STAGE(PG8_SA(0, 0), cA, voffA); PG8_STAGE(PG8_SB(0, 1), cB + hstepB, voffB); PG8_STAGE(PG8_SA(0, 1), cA + hstepA, voffA);
        if (wr == 1) PG8_BAR;
        PG8_WAIT_V(4); PG8_BAR;
        PG8_STAGE(PG8_SB(1, 0), cB + kstep, voffB); PG8_STAGE(PG8_SA(1, 0), cA + kstep, voffA); PG8_STAGE(PG8_SB(1, 1), cB + hstepB + kstep, voffB);
        PG8_WAIT_V(6); PG8_BAR;
    }
    for (;;) {
        const bool has_next = S.next(ui + 1, nxt);
        const char* nA = has_next ? (const char*)g.A + (size_t)nxt.pm * tstepA + nxt.ko : cA; const char* nB = has_next ? (const char*)g.Bt + (size_t)nxt.pb * tstepB + nxt.ko : cB;
        for (int t = 0; t < nt; t += 2) {
            if constexpr (Epi::KHOOK) { if (t == 8 || t == 12) E.khook(acc, cur, t, wr, wc, fr, fq); }
            const bool last = (t == nt - 2);
            const char* a1 = cA + (size_t)(t + 1) * kstep;
            const char* a2 = last ? nA : cA + (size_t)(t + 2) * kstep; const char* b2 = last ? nB : cB + (size_t)(t + 2) * kstep;
            const char* a3 = a2 + kstep; const char* b3 = b2 + kstep;
            if (last && has_next) S.a_ready(nxt);
            if constexpr (SP2) {
            PG8_LDB(B0, 0, 0); PG8_LDB(B1, 0, 1); PG8_SCHED; PG8_LDA(At, 0, 0); PG8_STAGE(PG8_SA(1, 1), a1 + hstepA, voffA);
            PG8_WAIT_V(8); PG8_WAIT_L(0); PG8_BAR; PG8_MMA(0, 0, At, B0); PG8_MMA(0, 1, At, B1); PG8_BAR; PG8_SCHED;
            PG8_LDA(At, 0, 1); PG8_STAGE(PG8_SB(0, 0), b2, voffB); PG8_STAGE(PG8_SB(0, 1), b2 + hstepB, voffB); PG8_STAGE(PG8_SA(0, 0), a2, voffA);
            PG8_WAIT_V(8); PG8_WAIT_L(0); PG8_BAR; PG8_MMA(1, 0, At, B0); PG8_MMA(1, 1, At, B1); PG8_BAR; PG8_SCHED;
            PG8_LDB(B0, 1, 0); PG8_LDB(B1, 1, 1); PG8_SCHED; PG8_LDA(At, 1, 0); PG8_STAGE(PG8_SA(0, 1), a2 + hstepA, voffA);
            PG8_WAIT_V(8); PG8_WAIT_L(0); PG8_BAR; PG8_MMA(0, 0, At, B0); PG8_MMA(0, 1, At, B1); PG8_BAR; PG8_SCHED;
            PG8_LDA(At, 1, 1); PG8_STAGE(PG8_SB(1, 0), b3, voffB); PG8_STAGE(PG8_SB(1, 1), b3 + hstepB, voffB); PG8_STAGE(PG8_SA(1, 0), a3, voffA);
            PG8_WAIT_V(8); PG8_WAIT_L(0); PG8_BAR; PG8_MMA(1, 0, At, B0); PG8_MMA(1, 1, At, B1); PG8_BAR; PG8_SCHED;
            } else {
            PG8_LDB(B0, 0, 0); PG8_SCHED; PG8_LDA(At, 0, 0); PG8_STAGE(PG8_SA(1, 1), a1 + hstepA, voffA);
            PG8_WAIT_L(8); PG8_BAR; PG8_WAIT_L(0); PG8_MMA(0, 0, At, B0); PG8_BAR; PG8_SCHED;
            PG8_LDB(B1, 0, 1); PG8_STAGE(PG8_SB(0, 0), b2, voffB);
            PG8_BAR; PG8_WAIT_L(0); PG8_MMA(0, 1, At, B1); PG8_BAR;
            PG8_LDA(At, 0, 1); PG8_STAGE(PG8_SA(0, 0), a2, voffA);
            PG8_BAR; PG8_WAIT_L(0); PG8_MMA(1, 0, At, B0); PG8_BAR; PG8_SCHED;
            PG8_STAGE(PG8_SB(0, 1), b2 + hstepB, voffB);
            PG8_WAIT_V(6); PG8_BAR; PG8_MMA(1, 1, At, B1); PG8_BAR;
            PG8_LDB(B0, 1, 0); PG8_SCHED; PG8_LDA(At, 1, 0); PG8_STAGE(PG8_SA(0, 1), a2 + hstepA, voffA);
            PG8_WAIT_L(8); PG8_BAR; PG8_WAIT_L(0); PG8_MMA(0, 0, At, B0); PG8_BAR; PG8_SCHED;
            PG8_LDB(B1, 1, 1); PG8_STAGE(PG8_SB(1, 0), b3, voffB);
            PG8_BAR; PG8_WAIT_L(0); PG8_MMA(0, 1, At, B1); PG8_BAR;
            PG8_LDA(At, 1, 1); PG8_STAGE(PG8_SA(1, 0), a3, voffA);
            PG8_BAR; PG8_WAIT_L(0); PG8_MMA(1, 0, At, B0); PG8_BAR; PG8_SCHED;
            PG8_STAGE(PG8_SB(1, 1), b3 + hstepB, voffB);
            PG8_WAIT_V(6); PG8_BAR; PG8_MMA(1, 1, At, B1); PG8_BAR;
            }
        }
        if constexpr (ALIGN_EPI) { if (wr == 0) PG8_BAR; }
        if constexpr (!Epi::AFTER_DRAIN) { E(acc, cur, wr, wc, fr, fq); S.done(cur); }
        if (!has_next) break;
#pragma unroll
        for (int a = 0; a < 2; ++a)
#pragma unroll
            for (int b = 0; b < 2; ++b)
#pragma unroll
                for (int m = 0; m < 4; ++m)
#pragma unroll
                    for (int n = 0; n < 2; ++n) acc[a][b][m][n] = (f32x4){0.f, 0.f, 0.f, 0.f};
        cur = nxt; cA = nA; cB = nB; ++ui;
        if constexpr (ALIGN_EPI) { if (wr == 1) PG8_BAR; }
    }
    PG8_WAIT_V(0);
    if constexpr (!ALIGN_EPI) { if (wr == 0) PG8_BAR; }
    PG8_BAR;
    if constexpr (Epi::AFTER_DRAIN) { E.fused(acc, cur, wr, wc, fr, fq, lds, wid, lane); S.done(cur); }
#undef PG8_SA
#undef PG8_SB
#undef PG8_STAGE
#undef PG8_LDA
#undef PG8_LDB
#undef PG8_MMA
#undef PG8_WAIT_V
#undef PG8_WAIT_L
#undef PG8_BAR
#undef PG8_SCHED
}
template <class Epi, class Sched, bool ALIGN_EPI = false, bool SP2 = false>
__device__ __forceinline__ void gemm_phase8(PG8_LAS unsigned char* lds, const Gemm g, const Sched& S, const Epi& E) {
    const int wid = g.wid; const int tid = tid_from(wid), lane = tid & 63, wr = wid >> 2, wc = wid & 3, fr = lane & 15, fq = lane >> 4;
    const int K = g.K, nt = K / BK;
    unsigned voffA[2], voffB[2];
#pragma unroll
    for (int i = 0; i < 2; ++i) { int R, C; stage_rc(tid * 16 + i * 8192, R, C); const int Rb = Epi::PERM ? ((R & ~31) + perm32(R & 31)) : R;
        voffA[i] = (unsigned)(R * g.lda + C) * 2u; voffB[i] = (unsigned)(Rb * g.ldb + C) * 2u; }
    const size_t kstep = (size_t)(BK * 2);
    const size_t hstepA = (size_t)HALF * g.lda * 2, hstepB = (size_t)HALF * g.ldb * 2;
    const size_t tstepA = 2 * hstepA, tstepB = 2 * hstepB;
    const unsigned ldsw = (unsigned)wid * 1024u;
    const int c8 = (fq >> 1) * 32 + (fq & 1) * 16;
    const int aoff0 = lds_byte(wr * 64 + fr, c8), aoff1 = lds_byte(wr * 64 + fr, c8 + 8), boff0 = lds_byte(wc * 32 + fr, c8), boff1 = lds_byte(wc * 32 + fr, c8 + 8);
#define PG8_SA(b, h) (((b) * 2 + (h)) * HTB)
#define PG8_SB(b, h) ((4 + (b) * 2 + (h)) * HTB)
#define PG8_STAGE(bufoff, gbase, voff) do { _Pragma("unroll") for (int _i = 0; _i < 2; ++_i) \
        __builtin_amdgcn_global_load_lds((const unsigned*)((const char*)(gbase) + (voff)[_i]), (PG8_LAS unsigned*)(lds + (bufoff) + ldsw + _i * 8192), 16, 0, 0); } while (0)
#define PG8_LDA(dst, b, h) do { _Pragma("unroll") for (int m = 0; m < 4; ++m) { const u32x4 lo_ = *(const PG8_LAS u32x4*)(lds + PG8_SA(b, h) + aoff0 + m * 2048), hi_ = *(const PG8_LAS u32x4*)(lds + PG8_SA(b, h) + aoff1 + m * 2048); \
        dst[m] = (i32x8){(int)lo_.x, (int)lo_.y, (int)lo_.z, (int)lo_.w, (int)hi_.x, (int)hi_.y, (int)hi_.z, (int)hi_.w}; } } while (0)
#define PG8_LDB(dst, b, h) do { _Pragma("unroll") for (int n = 0; n < 2; ++n) { const u32x4 lo_ = *(const PG8_LAS u32x4*)(lds + PG8_SB(b, h) + boff0 + n * 2048), hi_ = *(const PG8_LAS u32x4*)(lds + PG8_SB(b, h) + boff1 + n * 2048); \
        dst[n] = (i32x8){(int)lo_.x, (int)lo_.y, (int)lo_.z, (int)lo_.w, (int)hi_.x, (int)hi_.y, (int)hi_.z, (int)hi_.w}; } } while (0)
#define PG8_MMA(ai, bj, At, Bt) do { __builtin_amdgcn_s_setprio(1); _Pragma("unroll") for (int m = 0; m < 4; ++m) _Pragma("unroll") for (int n = 0; n < 2; ++n) \
        asm volatile("v_mfma_scale_f32_16x16x128_f8f6f4 %0, %1, %2, %0, %3, %4 op_sel_hi:[0,0,0]" : "+v"(acc[ai][bj][m][n]) : "v"(Bt[n]), "v"(At[m]), "v"(vsB), "v"(vsA)); __builtin_amdgcn_s_setprio(0); } while (0)
#define PG8_WAIT_V(n) asm volatile("s_waitcnt vmcnt(" #n ")" ::: "memory")
#define PG8_WAIT_L(n) asm volatile("s_waitcnt lgkmcnt(" #n ")" ::: "memory")
#define PG8_BAR __builtin_amdgcn_s_barrier()
#define PG8_SCHED __builtin_amdgcn_sched_barrier(0)
    Unit cur, nxt; int ui = 0;
    if (!S.next(0, cur)) return;
    f32x4 acc[2][2][4][2];
#pragma unroll
    for (int a = 0; a < 2; ++a)
#pragma unroll
        for (int b = 0; b < 2; ++b)
#pragma unroll
            for (int m = 0; m < 4; ++m)
#pragma unroll
                for (int n = 0; n < 2; ++n) acc[a][b][m][n] = (f32x4){0.f, 0.f, 0.f, 0.f};
    typedef int i32x8 __attribute__((ext_vector_type(8)));
    i32x8 At[4], B0[2], B1[2];
    int vsA = g.sA, vsB = g.sB; asm volatile("" : "+v"(vsA), "+v"(vsB));
    const char* cA = (const char*)g.A + (size_t)cur.pm * tstepA + cur.ko; const char* cB = (const char*)g.Bt + (size_t)cur.pb * tstepB + cur.ko;
    S.a_ready(cur);
    if constexpr (SP2) {
        PG8_STAGE(PG8_SB(0, 0), cB, voffB); PG8_STAGE(PG8_SB(0, 1), cB + hstepB, voffB); PG8_STAGE(PG8_SA(0, 0), cA, voffA); PG8_STAGE(PG8_SA(0, 1), cA + hstepA, voffA);
        if (wr == 1) PG8_BAR;
        PG8_WAIT_V(2); PG8_BAR;
        PG8_STAGE(PG8_SB(1, 0), cB + kstep, voffB); PG8_STAGE(PG8_SA(1, 0), cA + kstep, voffA); PG8_STAGE(PG8_SB(1, 1), cB + hstepB + kstep, voffB);
        PG8_WAIT_V(6); PG8_BAR;
    } else {
        PG8_STAGE(PG8_SB(0, 0), cB, voffB); PG8_STAGE(PG8_SA(0, 0), cA, voffA); PG8_STAGE(PG8_SB(0, 1), cB + hstepB, voffB); PG8_STAGE(PG8_SA(0, 1), cA + hstepA, voffA);
        if (wr == 1) PG8_BAR;
        PG8_WAIT_V(4); PG8_BAR;
        PG8_STAGE(PG8_SB(1, 0), cB + kstep, voffB); PG8_STAGE(PG8_SA(1, 0), cA + kstep, voffA); PG8_STAGE(PG8_SB(1, 1), cB + hstepB + kstep, voffB);
        PG8_WAIT_V(6); PG8_BAR;
    }
    for (;;) {
        const bool has_next = S.next(ui + 1, nxt);
        const char* nA = has_next ? (const char*)g.A + (size_t)nxt.pm * tstepA + nxt.ko : cA; const char* nB = has_next ? (const char*)g.Bt + (size_t)nxt.pb * tstepB + nxt.ko : cB;
        for (int t = 0; t < nt; t += 2) {
            const bool last = (t == nt - 2);
            const char* a1 = cA + (size_t)(t + 1) * kstep;
            const char* a2 = last ? nA : cA + (size_t)(t + 2) * kstep; const char* b2 = last ? nB : cB + (size_t)(t + 2) * kstep;
            const char* a3 = a2 + kstep; const char* b3 = b2 + kstep;
            if (last && has_next) S.a_ready(nxt);
            if constexpr (SP2) {
            PG8_LDB(B0, 0, 0); PG8_LDB(B1, 0, 1); PG8_SCHED; PG8_LDA(At, 0, 0); PG8_STAGE(PG8_SA(1, 1), a1 + hstepA, voffA);
            PG8_WAIT_V(8); PG8_WAIT_L(0); PG8_BAR; PG8_MMA(0, 0, At, B0); PG8_MMA(0, 1, At, B1); PG8_BAR; PG8_SCHED;
            PG8_LDA(At, 0, 1); PG8_STAGE(PG8_SB(0, 0), b2, voffB); PG8_STAGE(PG8_SB(0, 1), b2 + hstepB, voffB); PG8_STAGE(PG8_SA(0, 0), a2, voffA);
            PG8_WAIT_V(8); PG8_WAIT_L(0); PG8_BAR; PG8_MMA(1, 0, At, B0); PG8_MMA(1, 1, At, B1); PG8_BAR; PG8_SCHED;
            PG8_LDB(B0, 1, 0); PG8_LDB(B1, 1, 1); PG8_SCHED; PG8_LDA(At, 1, 0); PG8_STAGE(PG8_SA(0, 1), a2 + hstepA, voffA);
            PG8_WAIT_V(8); PG8_WAIT_L(0); PG8_BAR; PG8_MMA(0, 0, At, B0); PG8_MMA(0, 1, At, B1); PG8_BAR; PG8_SCHED;
            PG8_LDA(At, 1, 1); PG8_STAGE(PG8_SB(1, 0), b3, voffB); PG8_STAGE(PG8_SB(1, 1), b3 + hstepB, voffB); PG8_STAGE(PG8_SA(1, 0), a3, voffA);
            PG8_WAIT_V(8); PG8_WAIT_L(0); PG8_BAR; PG8_MMA(1, 0, At, B0); PG8_MMA(1, 1, At, B1); PG8_BAR; PG8_SCHED;
            } else {
            PG8_LDB(B0, 0, 0); PG8_SCHED; PG8_LDA(At, 0, 0); PG8_STAGE(PG8_SA(1, 1), a1 + hstepA, voffA);
            PG8_WAIT_L(8); PG8_BAR; PG8_WAIT_L(0); PG8_MMA(0, 0, At, B0); PG8_BAR; PG8_SCHED;
            PG8_LDB(B1, 0, 1); PG8_STAGE(PG8_SB(0, 0), b2, voffB);
            PG8_BAR; PG8_WAIT_L(0); PG8_MMA(0, 1, At, B1); PG8_BAR;
            PG8_LDA(At, 0, 1); PG8_STAGE(PG8_SA(0, 0), a2, voffA);
            PG8_BAR; PG8_WAIT_L(0); PG8_MMA(1, 0, At, B0); PG8_BAR; PG8_SCHED;
            PG8_STAGE(PG8_SB(0, 1), b2 + hstepB, voffB);
            PG8_WAIT_V(6); PG8_BAR; PG8_MMA(1, 1, At, B1); PG8_BAR;
            PG8_LDB(B0, 1, 0); PG8_SCHED; PG8_LDA(At, 1, 0); PG8_STAGE(PG8_SA(0, 1), a2 + hstepA, voffA);
            PG8_WAIT_L(8); PG8_BAR; PG8_WAIT_L(0); PG8_MMA(0, 0, At, B0); PG8_BAR; PG8_SCHED;
            PG8_LDB(B1, 1, 1); PG8_STAGE(PG8_SB(1, 0), b3, voffB);
            PG8_BAR; PG8_WAIT_L(0); PG8_MMA(0, 1, At, B1); PG8_BAR;
            PG8_LDA(At, 1, 1); PG8_STAGE(PG8_SA(1, 0), a3, voffA);
            PG8_BAR; PG8_WAIT_L(0); PG8_MMA(1, 0, At, B0); PG8_BAR; PG8_SCHED;
            PG8_STAGE(PG8_SB(1, 1), b3 + hstepB, voffB);
            PG8_WAIT_V(6); PG8_BAR; PG8_MMA(1, 1, At, B1); PG8_BAR;
            }
        }
        if constexpr (ALIGN_EPI) { if (wr == 0) PG8_BAR; }
        asm volatile("s_nop 15\n\ts_nop 15" ::: "memory");
        if constexpr (!Epi::AFTER_DRAIN) { E(acc, cur, wr, wc, fr, fq); S.done(cur); }
        if (!has_next) break;
#pragma unroll
        for (int a = 0; a < 2; ++a)
#pragma unroll
            for (int b = 0; b < 2; ++b)
#pragma unroll
                for (int m = 0; m < 4; ++m)
#pragma unroll
                    for (int n = 0; n < 2; ++n) acc[a][b][m][n] = (f32x4){0.f, 0.f, 0.f, 0.f};
        cur = nxt; cA = nA; cB = nB; ++ui;
        if constexpr (ALIGN_EPI) { if (wr == 1) PG8_BAR; }
    }
    PG8_WAIT_V(0);
    if constexpr (!ALIGN_EPI) { if (wr == 0) PG8_BAR; }
    PG8_BAR;
    if constexpr (Epi::AFTER_DRAIN) { E.fused(acc, cur, wr, wc, fr, fq, lds, wid, lane); S.done(cur); }
#undef PG8_SA
#undef PG8_SB
#undef PG8_STAGE
#undef PG8_LDA
#undef PG8_LDB
#undef PG8_MMA
#undef PG8_WAIT_V
#undef PG8_WAIT_L
#undef PG8_BAR
#undef PG8_SCHED
}
}

namespace attn {
using bf16x8 = __attribute__((ext_vector_type(8))) short;
using s16x4  = __attribute__((ext_vector_type(4))) short;
using f32x16 = __attribute__((ext_vector_type(16))) float;
using u32x4  = __attribute__((ext_vector_type(4))) unsigned;
constexpr int DV = 128, DK = 64, NW = 8, QBLK = 32, KVBLK = 64;
constexpr float SCALE = 0.125f;
constexpr float THR2 = 6.f;
constexpr float QSCALE = SCALE * 1.4426950408889634f;
#define AKSWZ(row, colB) ((row) * 128 + ((colB) ^ ((((row) >> 1) & 7) << 4)))
#define ASBAR() __builtin_amdgcn_sched_barrier(0)
__device__ __forceinline__ int crow(int r, int hi) { return (r & 3) + 8 * (r >> 2) + 4 * hi; }
__device__ __forceinline__ unsigned cvtpk(float lo, float hi) { unsigned r; asm volatile("v_cvt_pk_bf16_f32 %0, %1, %2" : "=v"(r) : "v"(lo), "v"(hi)); return r; }

__device__ __forceinline__ float rowmax32(const f32x16& p0, const f32x16& p1) {
  float pmax = p0[0];
#pragma unroll
  for (int r = 1; r < 16; ++r) pmax = fmaxf(pmax, p0[r]);
#pragma unroll
  for (int r = 0; r < 16; ++r) pmax = fmaxf(pmax, p1[r]);
  auto rr = __builtin_amdgcn_permlane32_swap(__float_as_uint(pmax), __float_as_uint(pmax), false, false);
  return fmaxf(__uint_as_float(rr[0]), __uint_as_float(rr[1]));
}
__device__ __forceinline__ void firstSM(f32x16& p0, f32x16& p1, float& m_reg, f32x16& negm) {
  const float d = rowmax32(p0, p1); m_reg = d;
#pragma unroll
  for (int r = 0; r < 16; ++r) { p0[r] = __builtin_amdgcn_exp2f(p0[r] - d); p1[r] = __builtin_amdgcn_exp2f(p1[r] - d); }
#pragma unroll
  for (int r = 0; r < 16; ++r) negm[r] = -m_reg;
  asm volatile("" : "+v"(negm));
}
__device__ __forceinline__ void moveRef(f32x16& p0, f32x16& p1, float pmax, float& m_reg, f32x16& negm, float& alpha) {
  const float d = fmaxf(pmax, 0.f); alpha = __builtin_amdgcn_exp2f(-d); m_reg += d;
#pragma unroll
  for (int r = 0; r < 16; ++r) { p0[r] -= d; p1[r] -= d; }
#pragma unroll
  for (int r = 0; r < 16; ++r) negm[r] = -m_reg;
  asm volatile("" : "+v"(negm));
}
__device__ __forceinline__ void finishSM(f32x16& p0, f32x16& p1, float alpha, float& l_reg, bf16x8& pa0, bf16x8& pa1, bf16x8& pa2, bf16x8& pa3) {
  float ps = 0;
#pragma unroll
  for (int r = 0; r < 16; ++r) ps += p0[r];
#pragma unroll
  for (int r = 0; r < 16; ++r) ps += p1[r];
  { auto rr = __builtin_amdgcn_permlane32_swap(__float_as_uint(ps), __float_as_uint(ps), false, false);
    ps = __uint_as_float(rr[0]) + __uint_as_float(rr[1]); }
  l_reg = l_reg * alpha + ps;
#define APK4(P, BASE, OUT) do { unsigned a0 = cvtpk(P[BASE + 0], P[BASE + 1]), a1 = cvtpk(P[BASE + 2], P[BASE + 3]);   \
    unsigned b0 = cvtpk(P[BASE + 4], P[BASE + 5]), b1 = cvtpk(P[BASE + 6], P[BASE + 7]);                              \
    auto r0 = __builtin_amdgcn_permlane32_swap(a0, b0, false, false); auto r1 = __builtin_amdgcn_permlane32_swap(a1, b1, false, false); \
    u32x4 w = {r0[0], r1[0], r0[1], r1[1]}; OUT = *reinterpret_cast<bf16x8*>(&w); } while (0)
  APK4(p0, 0, pa0); APK4(p0, 8, pa1); APK4(p1, 0, pa2); APK4(p1, 8, pa3);
#undef APK4
}
__device__ __forceinline__ void qkt(f32x16& p0, f32x16& p1, const char* Ks, const bf16x8* qr, const f32x16& negm, int r32, int hi) {
#pragma unroll
  for (int d0 = 0; d0 < 4; ++d0) { const int cb = (d0 * 16 + hi * 8) * 2;
    bf16x8 b0 = *reinterpret_cast<const bf16x8*>(Ks + AKSWZ(r32, cb));
    bf16x8 b1 = *reinterpret_cast<const bf16x8*>(Ks + AKSWZ(32 + r32, cb));
    if (d0 == 0) { p0 = __builtin_amdgcn_mfma_f32_32x32x16_bf16(b0, qr[0], negm, 0, 0, 0); p1 = __builtin_amdgcn_mfma_f32_32x32x16_bf16(b1, qr[0], negm, 0, 0, 0); }
    else { p0 = __builtin_amdgcn_mfma_f32_32x32x16_bf16(b0, qr[d0], p0, 0, 0, 0); p1 = __builtin_amdgcn_mfma_f32_32x32x16_bf16(b1, qr[d0], p1, 0, 0, 0); } }
}
__device__ __forceinline__ int v_st(int k, int c) { const int kk = (k & ~0xC) | ((k & 4) << 1) | ((k & 8) >> 1); return ((kk >> 3) * 4 + (c >> 5)) * 512 + ((kk & 7) * 32 + (c & 31)) * 2; }
__device__ __forceinline__ int v_rd_base(int lane) { return ((lane & 3) << 3) | (((lane >> 2) & 3) << 6) | (((lane >> 4) & 1) << 5) | (((lane >> 5) & 1) << 8); }
constexpr int v_rd_off(int d0, int ks, int half) { return d0 * 512 + ks * 4096 + half * 2048; }
template <int OFF> __device__ __forceinline__ s16x4 tr_read(int vb) {
  s16x4 r; asm volatile("ds_read_b64_tr_b16 %0, %1 offset:%2" : "=&v"(r) : "v"(vb), "i"(OFF) : "memory"); return r;
}
template <int D0> __device__ __forceinline__ void pv_one(f32x16& od, int vb, bf16x8 pa0, bf16x8 pa1, bf16x8 pa2, bf16x8 pa3) {
  const s16x4 l0 = tr_read<v_rd_off(D0, 0, 0)>(vb), h0 = tr_read<v_rd_off(D0, 0, 1)>(vb), l1 = tr_read<v_rd_off(D0, 1, 0)>(vb), h1 = tr_read<v_rd_off(D0, 1, 1)>(vb);
  const s16x4 l2 = tr_read<v_rd_off(D0, 2, 0)>(vb), h2 = tr_read<v_rd_off(D0, 2, 1)>(vb), l3 = tr_read<v_rd_off(D0, 3, 0)>(vb), h3 = tr_read<v_rd_off(D0, 3, 1)>(vb);
  asm volatile("s_waitcnt lgkmcnt(0)" ::: "memory"); ASBAR();
#define APK(L, H) (bf16x8){L[0], L[1], L[2], L[3], H[0], H[1], H[2], H[3]}
  od = __builtin_amdgcn_mfma_f32_32x32x16_bf16(pa0, APK(l0, h0), od, 0, 0, 0);
  od = __builtin_amdgcn_mfma_f32_32x32x16_bf16(pa1, APK(l1, h1), od, 0, 0, 0);
  od = __builtin_amdgcn_mfma_f32_32x32x16_bf16(pa2, APK(l2, h2), od, 0, 0, 0);
  od = __builtin_amdgcn_mfma_f32_32x32x16_bf16(pa3, APK(l3, h3), od, 0, 0, 0);
#undef APK
}
__device__ __forceinline__ void pv_d0(f32x16* o, int vb, bf16x8 pa0, bf16x8 pa1, bf16x8 pa2, bf16x8 pa3) {
  pv_one<0>(o[0], vb, pa0, pa1, pa2, pa3); pv_one<1>(o[1], vb, pa0, pa1, pa2, pa3); pv_one<2>(o[2], vb, pa0, pa1, pa2, pa3); pv_one<3>(o[3], vb, pa0, pa1, pa2, pa3);
}
constexpr int SLOT_K = 8192, SLOT_V = 16384, RING_V = 3 * SLOT_K, WS_OFF = 3 * SLOT_K + 3 * SLOT_V;
constexpr size_t SHM_ATTN = WS_OFF + NW * 64 * 4;
#define AWAIT_BAR(N) asm volatile("s_waitcnt vmcnt(" #N ") lgkmcnt(0)\n\ts_barrier" ::: "memory")
template <int LDQ, int LDO>
__device__ __forceinline__ void attn_unit(const unsigned short* __restrict__ Qb, const unsigned short* __restrict__ Kh, const unsigned short* __restrict__ Vh,
                                          unsigned short* __restrict__ Ob, int seq, PG8_LAS unsigned char* ldsl, int wid) {
  char* lds = (char*)ldsl;
  const int tid = pg8::tid_from(wid), lane = tid & 63, r32 = lane & 31, hi = lane >> 5;
  char* K_lds = lds;
  float* ws = (float*)(lds + WS_OFF) + wid * 64; float* li_l = ws; float* al_l = ws + 32;
  float m_reg = 0.f, l_reg = 0; f32x16 o[4] = {}; bf16x8 qr[4]; f32x16 negm = f32x16{}; asm volatile("" : "+v"(negm));
  const unsigned short* Qw = Qb + (long)(wid * QBLK + r32) * LDQ + hi * 8;
#pragma unroll
  for (int d0 = 0; d0 < 4; ++d0) qr[d0] = *reinterpret_cast<const bf16x8*>(Qw + d0 * 16);
  const int krow = tid >> 3; const unsigned koff = (unsigned)(krow * LDQ * 2 + (((tid & 7) ^ ((krow >> 1) & 7)) << 4));
  unsigned voff[2];
#pragma unroll
  for (int i = 0; i < 2; ++i) { const int L = tid + 512 * i, sub = L >> 5, within = (L & 31) * 16, kk = (sub >> 2) * 8 + (within >> 6);
    const int k = (kk & ~0xC) | ((kk & 4) << 1) | ((kk & 8) >> 1), c = (sub & 3) * 32 + ((within & 63) >> 4) * 8; voff[i] = (unsigned)(k * LDQ * 2 + c * 2); }
  const int NT = seq / KVBLK; const unsigned ldsw = (unsigned)wid * 1024u;
#define ADMA_K(tile, slot) do { const int tl_ = (tile) < NT ? (tile) : NT - 1; const char* g_ = (const char*)Kh + (size_t)tl_ * (KVBLK * LDQ * 2); \
    __builtin_amdgcn_global_load_lds((const unsigned*)(g_ + koff), (PG8_LAS unsigned*)(ldsl + (slot) * SLOT_K + ldsw), 16, 0, 0); } while (0)
#define ADMA_V(tile, slot) do { const int tl_ = (tile) < NT ? (tile) : NT - 1; const char* g_ = (const char*)Vh + (size_t)tl_ * (KVBLK * LDQ * 2); \
    __builtin_amdgcn_global_load_lds((const unsigned*)(g_ + voff[0]), (PG8_LAS unsigned*)(ldsl + RING_V + (slot) * SLOT_V + ldsw), 16, 0, 0); \
    __builtin_amdgcn_global_load_lds((const unsigned*)(g_ + voff[1]), (PG8_LAS unsigned*)(ldsl + RING_V + (slot) * SLOT_V + 8192 + ldsw), 16, 0, 0); } while (0)
  const int vb0 = (int)(uintptr_t)(lds + RING_V) + v_rd_base(lane);
#define ARESC(a) do { if (__any((a) < 1.f)) { if (hi == 0) al_l[r32] = (a); asm volatile("s_waitcnt lgkmcnt(0)" ::: "memory"); \
    _Pragma("unroll") for (int d = 0; d < 4; ++d) _Pragma("unroll") for (int r = 0; r < 16; ++r) o[d][r] *= al_l[crow(r, hi)]; } } while (0)
#define AROT() do { const int t_ = s0; s0 = s1; s1 = s2; s2 = t_; } while (0)
  f32x16 pA0, pA1, pB0, pB1; float alA, alB; bf16x8 pa0, pa1, pa2, pa3;
  int s0 = 0, s1 = 1, s2 = 2;
#define TRR(F, D0, VB) do { F[0] = tr_read<v_rd_off(D0, 0, 0)>(VB); F[1] = tr_read<v_rd_off(D0, 0, 1)>(VB); F[2] = tr_read<v_rd_off(D0, 1, 0)>(VB); F[3] = tr_read<v_rd_off(D0, 1, 1)>(VB); \
    F[4] = tr_read<v_rd_off(D0, 2, 0)>(VB); F[5] = tr_read<v_rd_off(D0, 2, 1)>(VB); F[6] = tr_read<v_rd_off(D0, 3, 0)>(VB); F[7] = tr_read<v_rd_off(D0, 3, 1)>(VB); } while (0)
#define APK(L, H) (bf16x8){L[0], L[1], L[2], L[3], H[0], H[1], H[2], H[3]}
#define PVM(F, D0) do { o[D0] = __builtin_amdgcn_mfma_f32_32x32x16_bf16(pa0, APK(F[0], F[1]), o[D0], 0, 0, 0); o[D0] = __builtin_amdgcn_mfma_f32_32x32x16_bf16(pa1, APK(F[2], F[3]), o[D0], 0, 0, 0); \
    o[D0] = __builtin_amdgcn_mfma_f32_32x32x16_bf16(pa2, APK(F[4], F[5]), o[D0], 0, 0, 0); o[D0] = __builtin_amdgcn_mfma_f32_32x32x16_bf16(pa3, APK(F[6], F[7]), o[D0], 0, 0, 0); } while (0)
#define LWAIT() asm volatile("s_waitcnt lgkmcnt(0)" ::: "memory")
#define EXPS(P, A, B) do { _Pragma("unroll") for (int r_ = (A); r_ < (B); ++r_) P[r_] = __builtin_amdgcn_exp2f(P[r_]); } while (0)
#define PVSM(VB, P0, P1, AL) do { const int vb_ = (VB); s16x4 fa[8], fb[8]; float pm_; \
    TRR(fa, 0, vb_); LWAIT(); ASBAR(); \
    PVM(fa, 0); TRR(fb, 1, vb_); pm_ = rowmax32(P0, P1); \
    if (__builtin_expect(__all(pm_ <= THR2), 1)) { AL = 1.f; } else { moveRef(P0, P1, pm_, m_reg, negm, AL); } \
    LWAIT(); ASBAR(); \
    PVM(fb, 1); TRR(fa, 2, vb_); EXPS(P0, 0, 11); asm volatile("" : "+v"(P0)); \
    LWAIT(); ASBAR(); \
    PVM(fa, 2); TRR(fb, 3, vb_); EXPS(P0, 11, 16); EXPS(P1, 0, 6); asm volatile("" : "+v"(P0), "+v"(P1)); \
    LWAIT(); ASBAR(); \
    PVM(fb, 3); EXPS(P1, 6, 16); asm volatile("" : "+v"(P1)); ASBAR(); } while (0)
  ADMA_K(0, 0); ADMA_V(0, 0); ADMA_K(1, 1); ADMA_V(1, 1); ADMA_K(2, 2);
  AWAIT_BAR(4);
  qkt(pA0, pA1, K_lds, qr, negm, r32, hi); firstSM(pA0, pA1, m_reg, negm); alA = 1.f;
#pragma unroll 1
  for (int t = 0; t + 2 < NT; t += 2) {
    AWAIT_BAR(3); ADMA_K(t + 3, s0); ADMA_V(t + 2, s2);
    ASBAR(); qkt(pB0, pB1, K_lds + s1 * SLOT_K, qr, negm, r32, hi);
    finishSM(pA0, pA1, alA, l_reg, pa0, pa1, pa2, pa3); ASBAR();
    PVSM(vb0 + s0 * SLOT_V, pB0, pB1, alB);
    ARESC(alB); AROT();
    AWAIT_BAR(3); ADMA_K(t + 4, s0); ADMA_V(t + 3, s2);
    ASBAR(); qkt(pA0, pA1, K_lds + s1 * SLOT_K, qr, negm, r32, hi);
    finishSM(pB0, pB1, alB, l_reg, pa0, pa1, pa2, pa3); ASBAR();
    PVSM(vb0 + s0 * SLOT_V, pA0, pA1, alA);
    ARESC(alA); AROT();
  }
  AWAIT_BAR(3);
  ASBAR(); qkt(pB0, pB1, K_lds + s1 * SLOT_K, qr, negm, r32, hi);
  finishSM(pA0, pA1, alA, l_reg, pa0, pa1, pa2, pa3); ASBAR();
  PVSM(vb0 + s0 * SLOT_V, pB0, pB1, alB);
  ARESC(alB); AROT();
  AWAIT_BAR(0);
  finishSM(pB0, pB1, alB, l_reg, pa0, pa1, pa2, pa3); ASBAR();
  pv_d0(o, vb0 + s0 * SLOT_V, pa0, pa1, pa2, pa3);
  if (hi == 0) li_l[r32] = l_reg; asm volatile("s_waitcnt lgkmcnt(0)" ::: "memory");
  float rli[16];
#pragma unroll
  for (int r = 0; r < 16; ++r) rli[r] = __builtin_amdgcn_rcpf(li_l[crow(r, hi)]);
  unsigned short* Ow = Ob + (long)(wid * QBLK) * LDO;
#pragma unroll
  for (int r = 0; r < 16; ++r) { const int orow = crow(r, hi);
#pragma unroll
    for (int d0 = 0; d0 < 4; ++d0) { const float v = o[d0][r] * rli[r]; Ow[(long)orow * LDO + d0 * 32 + r32] = (unsigned short)(cvtpk(v, v) & 0xffffu); } }
  __syncthreads();
#undef ADMA_K
#undef TRR
#undef APK
#undef PVM
#undef LWAIT
#undef EXPS
#undef PVSM
#undef ADMA_V
#undef ARESC
#undef AROT
}
}

constexpr int NWAVES = 8, NTHR = NWAVES * 64;
constexpr int DM = 1024, NB = 4, SEQ = 4096, CTXL = 256, RPB = CTXL + SEQ  , MROWS = NB * RPB  ;
constexpr int INW = 5904, NPROJ = 6144, PLD = 5888;
constexpr int FFD = 2816, FFE = 3584, NEXP = 8, FFEH = FFE / 2;
constexpr int NCHUNK = RPB / 64;
constexpr float EPSN = 1e-6f;
constexpr int PC_AQ = 0, PC_AK = 512, PC_AV = 1024, PC_DQ = 1536, PC_DK = 1792, PC_DV = 2048, PC_DZ = 2304, PC_POOL = 2560, PC_GATE = 2816, PC_AB = 5888;

constexpr size_t MiB = 1u << 20;
constexpr size_t WS_CTL = 0, CTL_ZERO_BYTES = 2 * MiB;
constexpr size_t WS_MOD = 1 * MiB;
constexpr size_t WS_ROPE = 2 * MiB;
constexpr size_t WS_LAM = 2 * MiB + 65536;
constexpr size_t WS_ROUTE = 3 * MiB;
constexpr size_t WS_GB = 4 * MiB;
constexpr int NPB = 2816;
constexpr size_t WS_WIN = 8 * MiB;
constexpr size_t WS_WG8 = 20 * MiB;
constexpr size_t WS_WAB = 26 * MiB;
constexpr size_t WS_U8 = 484 * MiB;
constexpr size_t WS_WBR = 32 * MiB;
constexpr size_t WS_WOUT = 36 * MiB;
constexpr size_t WS_W13 = 40 * MiB;
constexpr size_t WS_W2 = 51 * MiB;
constexpr size_t WS_H = 58 * MiB;
constexpr size_t WS_U = 126 * MiB;
constexpr size_t WS_ATTO = WS_U;
constexpr size_t WS_MIX = WS_U;
constexpr size_t WS_PROJ = 160 * MiB;
constexpr size_t WS_POOLO = 356 * MiB;
constexpr size_t WS_W2M = 365 * MiB;
constexpr size_t WS_DNP = 398 * MiB;
constexpr size_t WS_MG = WS_DNP;
constexpr size_t WS_DNG = 466 * MiB;
constexpr size_t WS_DNO = 467 * MiB;
constexpr size_t WS_W13M = 484 * MiB;
constexpr size_t WS_SLAB = 256 * MiB;
constexpr size_t WS_HID = WS_PROJ;
constexpr int MOE_MAXT = 136;
constexpr size_t WS_HIDM = 160 * MiB;
constexpr size_t WS_XG = 279 * MiB;
constexpr size_t WS_Y = 279 * MiB;
constexpr size_t WS_END = 540 * MiB;
static_assert(WS_HIDM + (size_t)MOE_MAXT * 256 * FFE <= WS_XG && WS_Y + (size_t)MOE_MAXT * 256 * 1024 * 2 <= WS_POOLO && WS_DNO + (size_t)2 * MROWS * 256 * 2 <= WS_W13M && WS_W13M + (size_t)8 * 2 * FFE * 1024 <= WS_END, "ws map");
static_assert(WS_WIN + (size_t)2 * NPB * 1024 * 2 <= WS_WG8 && WS_WG8 + (size_t)2 * 3072 * 1024 <= WS_WAB && WS_WAB + 2 * 65536 <= WS_WBR && WS_W13 + (size_t)2 * FFD * 1024 * 2 <= WS_W2 && WS_W2 + (size_t)1024 * FFD * 2 <= WS_H, "ws map (weights)");
static_assert(WS_H + (size_t)MROWS * 1024 * 4 <= WS_U && WS_U + (size_t)MROWS * 1024 * 2 <= WS_PROJ && WS_PROJ + (size_t)MROWS * PLD * 2 <= WS_POOLO && WS_POOLO + (size_t)MROWS * 256 * 2 <= WS_W2M && WS_W2M + (size_t)8 * 1024 * FFE <= WS_DNP, "ws map (acts)");
static_assert(WS_DNP + (size_t)NB * NCHUNK * 4 * 2 * 32768 <= WS_DNG, "ws map (dn)");
constexpr int CW_TMO = 0, CW_CODE = 1;
constexpr int CW_BAR = 4096;
constexpr int CW_ECNT = 16384;

constexpr int RING_BYTES = 155648;
constexpr int MISC_OFF = RING_BYTES;
constexpr int LDS_BYTES = RING_BYTES + 1024;

enum { PH_PRO = 0, PH_L0 = 1, PH_N1 = 0, PH_PROJ = 1, PH_ATT = 2, PH_SCAN = 3, PH_MIXB = 4, PH_MRG0 = 5, PH_MRG1 = 6, PH_MRG2 = 7, PH_OUT = 8, PH_N2 = 9, PH_LAYER = 10,
       PH_FUP = 11, PH_FDN = 12, PH_L1 = 13, PH_GATH = 23, PH_CV0 = 24, PH_UP0 = 25, PH_DN0 = 26, PH_CV1 = 27, PH_UP1 = 28, PH_DN1 = 29, PH_FIN = 30, PH_COUNT = 31 };

#define GAS __attribute__((address_space(1)))
#define LAS __attribute__((address_space(3)))
typedef unsigned short bf16;
typedef unsigned v4u __attribute__((ext_vector_type(4)));
typedef unsigned v2u __attribute__((ext_vector_type(2)));
typedef float f32x4 __attribute__((ext_vector_type(4)));
typedef GAS unsigned gu32;
#define RLX_AGENT __ATOMIC_RELAXED, __HIP_MEMORY_SCOPE_AGENT
#define LDS_WAIT() asm volatile("s_waitcnt lgkmcnt(0)" ::: "memory")
#define VM_WAIT() asm volatile("s_waitcnt vmcnt(0)" ::: "memory")
__device__ __forceinline__ unsigned f2bf(float f) { unsigned u = __builtin_bit_cast(unsigned, f); return (u + 0x7fffu + ((u >> 16) & 1u)) >> 16; }
typedef float f32x2_c __attribute__((ext_vector_type(2))); typedef __bf16 bf16x2_c __attribute__((ext_vector_type(2)));
__device__ __forceinline__ unsigned cvtpk_c(float lo, float hi) { f32x2_c v = {lo, hi}; bf16x2_c b = __builtin_convertvector(v, bf16x2_c); return __builtin_bit_cast(unsigned, b); }
__device__ __forceinline__ unsigned pk2(float lo, float hi) { return cvtpk_c(lo, hi); }
__device__ __forceinline__ unsigned cvt4_fp8(float a, float b, float c, float d) {
    a = fminf(fmaxf(a, -448.f), 448.f); b = fminf(fmaxf(b, -448.f), 448.f); c = fminf(fmaxf(c, -448.f), 448.f); d = fminf(fmaxf(d, -448.f), 448.f);
    int r = 0; r = __builtin_amdgcn_cvt_pk_fp8_f32(a, b, r, false); r = __builtin_amdgcn_cvt_pk_fp8_f32(c, d, r, true); return (unsigned)r; }
constexpr int E8(int log2scale) { return (127 - log2scale) * 0x01010101; }
constexpr int F8_ACT_L2 = 3, F8_W13_L2 = 5, F8_W2_L2 = 6;
__device__ __forceinline__ float bf_lo(unsigned w) { return __builtin_bit_cast(float, w << 16); }
__device__ __forceinline__ float bf_hi(unsigned w) { return __builtin_bit_cast(float, w & 0xffff0000u); }
__device__ __forceinline__ float bf2f(bf16 v) { return __builtin_bit_cast(float, (unsigned)v << 16); }
__device__ __forceinline__ float sigmoidf_(float x) { return 1.f / (1.f + __expf(-x)); }
__device__ __forceinline__ float siluf_(float x) { return x / (1.f + __expf(-x)); }
__device__ __forceinline__ float dpp_add_(float v, const int ctrl_sel) {
    int r;
    if (ctrl_sel == 0) r = __builtin_amdgcn_update_dpp(0, __builtin_bit_cast(int, v), 0xB1, 0xF, 0xF, false);
    else if (ctrl_sel == 1) r = __builtin_amdgcn_update_dpp(0, __builtin_bit_cast(int, v), 0x4E, 0xF, 0xF, false);
    else if (ctrl_sel == 2) r = __builtin_amdgcn_update_dpp(0, __builtin_bit_cast(int, v), 0x141, 0xF, 0xF, false);
    else r = __builtin_amdgcn_update_dpp(0, __builtin_bit_cast(int, v), 0x140, 0xF, 0xF, false);
    return v + __builtin_bit_cast(float, r);
}
__device__ __forceinline__ float grp8_sum(float v) { v = dpp_add_(v, 0); v = dpp_add_(v, 1); v = dpp_add_(v, 2); return v; }
__device__ __forceinline__ float grp16_sum(float v) { v = grp8_sum(v); v = dpp_add_(v, 3); return v; }
__device__ __forceinline__ float wave_sum(float v) {
    v = grp16_sum(v);
    { auto rr = __builtin_amdgcn_permlane16_swap(__float_as_uint(v), __float_as_uint(v), false, false); v = __uint_as_float(rr[0]) + __uint_as_float(rr[1]); }
    { auto rr = __builtin_amdgcn_permlane32_swap(__float_as_uint(v), __float_as_uint(v), false, false); v = __uint_as_float(rr[0]) + __uint_as_float(rr[1]); }
    return v;
}
__device__ __forceinline__ int lane_id_() { return pg8::lane_id_asm(); }
__device__ __forceinline__ float lane_get(float v, int src) { return __builtin_bit_cast(float, __builtin_amdgcn_ds_bpermute(src << 2, __builtin_bit_cast(int, v))); }
#define XB_TMO      128
#define XB_XCNT(j)  (256  + 64 * (j))
#define XB_XSUB(j)  (1280 + 64 * (j))
#define XB_XGEN(j)  (2304 + 64 * (j))
#define XB_TOP      3328
#define XB_TOPGEN   3392
#define XCD_BAR_WORDS 3456
#define XB_SPIN_CAP (1u << 18)

__device__ __forceinline__ unsigned xb_ld(unsigned* p)              { return __hip_atomic_load(p, __ATOMIC_RELAXED, __HIP_MEMORY_SCOPE_AGENT); }
__device__ __forceinline__ unsigned xb_add(unsigned* p, unsigned v) { return __hip_atomic_fetch_add(p, v, __ATOMIC_RELAXED, __HIP_MEMORY_SCOPE_AGENT); }
__device__ __forceinline__ unsigned xb_xcc_id() { return (unsigned)__builtin_amdgcn_s_getreg((3 << 11) | 20) & 0xFu; }
#define XB_SPIN(cond, bar) do { unsigned _sp = 0; while (cond) { __builtin_amdgcn_s_sleep(1); \
    if ((++_sp & 255u) == 0u) { if (xb_ld(&(bar)[XB_TMO])) break; if (_sp > XB_SPIN_CAP) { atomicAdd(&(bar)[XB_TMO], 1u); break; } } } } while (0)

struct XcdBarrier {
    unsigned* bar; unsigned x; unsigned wid;
    volatile LAS unsigned* st;
};

__device__ __forceinline__ XcdBarrier xcd_barrier_post(unsigned* bar, volatile LAS unsigned* st, unsigned wid) {
    XcdBarrier b; b.bar = bar; b.x = xb_xcc_id(); b.st = st; b.wid = wid;
    if (wid == 0 && pg8::lane_id_asm() == 0) (void)xb_add(&bar[XB_XCNT(b.x)], 1u);
    return b;
}
__device__ __forceinline__ void xcd_barrier_complete(unsigned* bar, unsigned x, unsigned& nloc, unsigned& nx) {
    const unsigned G = gridDim.x * gridDim.y * gridDim.z;
    unsigned sum, cnt, mine, sp = 0u;
    for (;;) {
        sum = 0u; cnt = 0u; mine = 0u;
#pragma unroll
        for (unsigned j = 0; j < 16; ++j) { const unsigned c = xb_ld(&bar[XB_XCNT(j)]); sum += c; cnt += (c > 0u) ? 1u : 0u; mine = (j == x) ? c : mine; }
        if (sum == G) break;
        __builtin_amdgcn_s_sleep(1);
        if ((++sp & 255u) == 0u) { if (xb_ld(&bar[XB_TMO])) break; if (sp > XB_SPIN_CAP) { atomicAdd(&bar[XB_TMO], 1u); break; } }
    }
    nloc = mine > 0u ? mine : 1u; nx = cnt > 0u ? cnt : 1u;
}

__device__ __forceinline__ void xcd_barrier(const XcdBarrier& b) {
    asm volatile("s_waitcnt vmcnt(0)" ::: "memory");
    __syncthreads();
    if (b.wid == 0 && pg8::lane_id_asm() == 0) {
        unsigned* bar = b.bar;
        __builtin_amdgcn_s_waitcnt(0);
        unsigned nloc = b.st[0], nx = b.st[1];
        if (nloc == 0u) { xcd_barrier_complete(bar, b.x, nloc, nx); b.st[0] = nloc; b.st[1] = nx; }
        const unsigned old = xb_add(&bar[XB_XSUB(b.x)], 1u);
        const unsigned gen = old / nloc;
        if (old + 1u == (gen + 1u) * nloc) {
            __builtin_amdgcn_fence(__ATOMIC_RELEASE, "agent");
            asm volatile("s_waitcnt vmcnt(0)" ::: "memory");
            const unsigned og = xb_add(&bar[XB_TOP], 1u);
            const unsigned tg = og / nx;
            if (og + 1u == (tg + 1u) * nx) xb_add(&bar[XB_TOPGEN], 1u);
            else XB_SPIN(xb_ld(&bar[XB_TOPGEN]) == tg, bar);
            __builtin_amdgcn_fence(__ATOMIC_ACQUIRE, "agent");
            xb_add(&bar[XB_XGEN(b.x)], 1u);
            asm volatile("s_waitcnt vmcnt(0)" ::: "memory");
        } else {
            XB_SPIN(xb_ld(&bar[XB_XGEN(b.x)]) == gen, bar);
            __builtin_amdgcn_fence(__ATOMIC_ACQUIRE, "agent");
            asm volatile("s_waitcnt vmcnt(0)" ::: "memory");
        }
    }
    __syncthreads();
}

struct Frame {
    LAS unsigned char* lds;
    volatile LAS unsigned* MISC;
    gu32* ctl;
    int tid, lane, wave, vcu, G, zz, bx, wid_s;
    unsigned char* ws;
    float* out;
};
struct Args { const float* in[27]; float* out; unsigned char* ws; int ph_lo, ph_hi, bar_li, pad; };

struct TileOrder {
    int nM, nN, nwg, G, c, skip;
    __device__ __forceinline__ void init(int nM_, int nN_, int G_, int c_, int skip_) { nM = nM_; nN = nN_; nwg = nM * nN; G = G_; c = c_; skip = skip_; }
    __device__ __forceinline__ bool next(int i, pg8::Unit& u) const {
        const long L = (long)i * G + c; if (L >= nwg) return false;
        int wgid = (int)L; { const int q = nwg / 8, r = nwg % 8, xcd = wgid % 8, off = wgid / 8; wgid = (xcd < r ? xcd * (q + 1) : r * (q + 1) + (xcd - r) * q) + off; }
        const int nig = 8 * nN, gid = wgid / nig, fm = gid * 8, gsz = (nM - fm) < 8 ? (nM - fm) : 8;
        int pm = fm + ((wgid % nig) % gsz); const int pn = (wgid % nig) / gsz;
        if (skip) pm = (pm >> 4) * 17 + 1 + (pm & 15);
        u.pm = pm; u.pn = pn; u.pb = pn; u.ko = 0; u.aux = 0; return true;
    }
    __device__ __forceinline__ void a_ready(const pg8::Unit&) const {}
    __device__ __forceinline__ void done(const pg8::Unit&) const {}
};
struct MoeOrder {
    int t1, t2, t3, t4, t5, t6, t7, t8, nN, G, c;
    __device__ __forceinline__ void init(const gu32* cnt, int nN_, int G_, int c_) {
        int t = 0;
        t += ((int)__hip_atomic_load(cnt + 0 * 64, RLX_AGENT) + 255) >> 8; t1 = t; t += ((int)__hip_atomic_load(cnt + 1 * 64, RLX_AGENT) + 255) >> 8; t2 = t;
        t += ((int)__hip_atomic_load(cnt + 2 * 64, RLX_AGENT) + 255) >> 8; t3 = t; t += ((int)__hip_atomic_load(cnt + 3 * 64, RLX_AGENT) + 255) >> 8; t4 = t;
        t += ((int)__hip_atomic_load(cnt + 4 * 64, RLX_AGENT) + 255) >> 8; t5 = t; t += ((int)__hip_atomic_load(cnt + 5 * 64, RLX_AGENT) + 255) >> 8; t6 = t;
        t += ((int)__hip_atomic_load(cnt + 6 * 64, RLX_AGENT) + 255) >> 8; t7 = t; t += ((int)__hip_atomic_load(cnt + 7 * 64, RLX_AGENT) + 255) >> 8; t8 = t;
        nN = nN_; G = G_; c = c_;
    }
    __device__ __forceinline__ int tile_off(int e) const { return e == 0 ? 0 : e == 1 ? t1 : e == 2 ? t2 : e == 3 ? t3 : e == 4 ? t4 : e == 5 ? t5 : e == 6 ? t6 : t7; }
    __device__ __forceinline__ bool next(int i, pg8::Unit& u) const {
        const long L = (long)i * G + c; if (L >= (long)t8 * nN) return false;
        const int pm = (int)(L / nN), pn = (int)(L % nN);
        const int e = (pm >= t1) + (pm >= t2) + (pm >= t3) + (pm >= t4) + (pm >= t5) + (pm >= t6) + (pm >= t7);
        u.pm = pm; u.pn = pn; u.pb = e * nN + pn; u.ko = 0; u.aux = 0; return true;
    }
    __device__ __forceinline__ void a_ready(const pg8::Unit&) const {}
    __device__ __forceinline__ void done(const pg8::Unit&) const {}
};

struct CtxSplitOrder {
    int S, kpb, G, c;
    __device__ __forceinline__ void init(int S_, int kp_bytes, int G_, int c_) { S = S_; kpb = kp_bytes; G = G_; c = c_; }
    __device__ __forceinline__ bool next(int i, pg8::Unit& u) const {
        const int L = i * G + c; if (L >= 16 * S) return false;
        const int ks = L % S, pn = (L / S) & 3, ct = L / (4 * S);
        u.pm = ct * 17; u.pn = pn; u.pb = pn; u.ko = ks * kpb; u.aux = ks; return true;
    }
    __device__ __forceinline__ void a_ready(const pg8::Unit&) const {}
    __device__ __forceinline__ void done(const pg8::Unit&) const {}
};
#define EPI_LOOP(...) _Pragma("unroll") for (int ai = 0; ai < 2; ++ai) _Pragma("unroll") for (int m = 0; m < 4; ++m) { const int row = u.pm * 256 + ai * 128 + wr * 64 + m * 16 + fr; \
    _Pragma("unroll") for (int bj = 0; bj < 2; ++bj) { const int col = bj * 128 + wc * 32 + 4 * fq; f32x4 v0 = acc[ai][bj][m][0], v1 = acc[ai][bj][m][1]; __VA_ARGS__ } if (m & 1) asm volatile("" ::: "memory"); }
#define EPI_LOOP8(...) _Pragma("unroll") for (int ai = 0; ai < 2; ++ai) _Pragma("unroll") for (int m = 0; m < 4; ++m) { const int row = u.pm * 256 + ai * 128 + wr * 64 + m * 16 + fr; \
    _Pragma("unroll") for (int bj = 0; bj < 2; ++bj) { const int col = bj * 128 + wc * 32 + 8 * fq; f32x4 v0 = acc[ai][bj][m][0], v1 = acc[ai][bj][m][1]; __VA_ARGS__ } if (m & 1) asm volatile("" ::: "memory"); }
__device__ __forceinline__ v4u pack8(f32x4 a, f32x4 b) { v4u w; w.x = pg8::cvt_pk_bf16(a[0], a[1]); w.y = pg8::cvt_pk_bf16(a[2], a[3]); w.z = pg8::cvt_pk_bf16(b[0], b[1]); w.w = pg8::cvt_pk_bf16(b[2], b[3]); return w; }
__device__ __forceinline__ v2u pack4(f32x4 v) { v2u w; w.x = pg8::cvt_pk_bf16(v[0], v[1]); w.y = pg8::cvt_pk_bf16(v[2], v[3]); return w; }
__device__ __forceinline__ f32x4 unpack4(v2u w) { return (f32x4){bf_lo(w.x), bf_hi(w.x), bf_lo(w.y), bf_hi(w.y)}; }

struct EpiProj {
    static constexpr bool PERM = false, AFTER_DRAIN = false, KHOOK = false;
    bf16* P; const float* rope;
    __device__ __forceinline__ void operator()(const pg8::f32x4 (&acc)[2][2][4][2], const pg8::Unit& u, int wr, int wc, int fr, int fq) const {
        asm volatile("" : "+v"(fr), "+v"(fq));
        const int pn = u.pn;
        if (pn < 4) {
            EPI_LOOP({ const int j = row % RPB;
                if (j >= CTXL) { const int t = j - CTXL; const int pos = (wc & 1) ? (t & 63) : (t >> 6);
                    const f32x4 cs0 = *(const f32x4*)(rope + (pos * 16 + 4 * fq) * 2), cs1 = *(const f32x4*)(rope + (pos * 16 + 4 * fq) * 2 + 4);
                    const float c0 = cs0[0], s0 = cs0[1], c1 = cs0[2], s1 = cs0[3], c2 = cs1[0], s2 = cs1[1], c3 = cs1[2], s3 = cs1[3];
                    const f32x4 a = v0, b = v1;
                    v0[0] = a[0] * c0 - b[0] * s0; v1[0] = b[0] * c0 + a[0] * s0; v0[1] = a[1] * c1 - b[1] * s1; v1[1] = b[1] * c1 + a[1] * s1;
                    v0[2] = a[2] * c2 - b[2] * s2; v1[2] = b[2] * c2 + a[2] * s2; v0[3] = a[3] * c3 - b[3] * s3; v1[3] = b[3] * c3 + a[3] * s3; }
                if (pn < 2) { v0 *= attn::QSCALE; v1 *= attn::QSCALE; }
                bf16* o = P + (size_t)row * PLD + pn * 256 + col; *(v2u*)o = pack4(v0); *(v2u*)(o + 16) = pack4(v1); })
        } else {
            EPI_LOOP8({ *(v4u*)(P + (size_t)row * PLD + pn * 256 + col) = pack8(v0, v1); })
        }
    }
};
struct EpiGate {
    static constexpr bool PERM = false, AFTER_DRAIN = false, KHOOK = false;
    bf16* P;
    __device__ __forceinline__ void operator()(const pg8::f32x4 (&acc)[2][2][4][2], const pg8::Unit& u, int wr, int wc, int fr, int fq) const {
        asm volatile("" : "+v"(fr), "+v"(fq));
        EPI_LOOP8({ for (int q = 0; q < 4; ++q) { v0[q] = sigmoidf_(v0[q]); v1[q] = sigmoidf_(v1[q]); }
            *(v4u*)(P + (size_t)row * PLD + PC_GATE + u.pn * 256 + col) = pack8(v0, v1); })
    }
};
struct EpiMergeF {
    static constexpr bool PERM = false, AFTER_DRAIN = false, KHOOK = true;
    bf16* MG; const bf16* P;
    __device__ __forceinline__ void khook(pg8::f32x4 (&acc)[2][2][4][2], const pg8::Unit& u, int t, int wr, int wc, int fr, int fq) const {
        asm volatile("" : "+v"(fr), "+v"(fq));
        const int gnum = PC_GATE + (t == 8 ? 0 : 1024), gden = gnum + 1024;
#pragma unroll
        for (int ai = 0; ai < 2; ++ai)
#pragma unroll
            for (int m = 0; m < 4; ++m) { const int row = u.pm * 256 + ai * 128 + wr * 64 + m * 16 + fr;
#pragma unroll
                for (int bj = 0; bj < 2; ++bj) { const int c = u.pn * 256 + bj * 128 + wc * 32 + 8 * fq; const bf16* gp = P + (size_t)row * PLD + c;
                    const v4u a = *(const v4u*)(gp + gnum), b = *(const v4u*)(gp + gden);
                    const f32x4 n0 = unpack4((v2u){a.x, a.y}), n1 = unpack4((v2u){a.z, a.w}), d0 = unpack4((v2u){b.x, b.y}), d1 = unpack4((v2u){b.z, b.w});
#pragma unroll
                    for (int q = 0; q < 4; ++q) { acc[ai][bj][m][0][q] *= n0[q] * __builtin_amdgcn_rcpf(fmaxf(d0[q], 1e-20f)); acc[ai][bj][m][1][q] *= n1[q] * __builtin_amdgcn_rcpf(fmaxf(d1[q], 1e-20f)); } }
                if (m & 1) asm volatile("" ::: "memory"); }
    }
    __device__ __forceinline__ void operator()(const pg8::f32x4 (&acc)[2][2][4][2], const pg8::Unit& u, int wr, int wc, int fr, int fq) const {
        asm volatile("" : "+v"(fr), "+v"(fq));
        EPI_LOOP8({ const int c = u.pn * 256 + col; const v4u gw = *(const v4u*)(P + (size_t)row * PLD + PC_GATE + 2048 + c);
            *(v4u*)(MG + (size_t)row * DM + c) = pack8(unpack4((v2u){gw.x, gw.y}) * v0, unpack4((v2u){gw.z, gw.w}) * v1); })
    }
};
struct EpiResid {
    static constexpr bool PERM = false, AFTER_DRAIN = false, KHOOK = false;
    float* H; const float* modl; int gidx; const float* xin;
    __device__ __forceinline__ void operator()(const pg8::f32x4 (&acc)[2][2][4][2], const pg8::Unit& u, int wr, int wc, int fr, int fq) const {
        asm volatile("" : "+v"(fr), "+v"(fq));
        EPI_LOOP8({ const int c = u.pn * 256 + col; const int b = row / RPB, j = row - b * RPB; const int mr = j < CTXL ? 4 : b;
            const float* gp = modl + mr * 6144 + gidx * 1024 + c; float* hp = H + (size_t)row * DM + c;
            const float* sp = xin ? xin + ((size_t)b * SEQ + (j - CTXL)) * DM + c : hp;
            const f32x4 g0 = *(const f32x4*)gp, g1 = *(const f32x4*)(gp + 4);
            *(f32x4*)hp = *(const f32x4*)sp + g0 * v0; *(f32x4*)(hp + 4) = *(const f32x4*)(sp + 4) + g1 * v1; })
    }
};
struct EpiSlab {
    static constexpr bool PERM = false, AFTER_DRAIN = false, KHOOK = false;
    float* SL; const float* modl; int gidx;
    __device__ __forceinline__ void operator()(const pg8::f32x4 (&acc)[2][2][4][2], const pg8::Unit& u, int wr, int wc, int fr, int fq) const {
        asm volatile("" : "+v"(fr), "+v"(fq));
        const float* gate = modl + 4 * 6144 + gidx * 1024; float* sl = SL + ((size_t)u.aux * 1024 + (u.pm / 17) * 256) * 1024;
#pragma unroll
        for (int ai = 0; ai < 2; ++ai)
#pragma unroll
            for (int m = 0; m < 4; ++m) { const int lr = ai * 128 + wr * 64 + m * 16 + fr;
#pragma unroll
                for (int bj = 0; bj < 2; ++bj) { const int c = u.pn * 256 + bj * 128 + wc * 32 + 8 * fq; const f32x4 g0 = *(const f32x4*)(gate + c), g1 = *(const f32x4*)(gate + c + 4);
                    float* o = sl + (size_t)lr * 1024 + c; *(f32x4*)o = g0 * acc[ai][bj][m][0]; *(f32x4*)(o + 4) = g1 * acc[ai][bj][m][1]; } }
    }
};
struct EpiSwiglu {
    static constexpr bool PERM = false, AFTER_DRAIN = false, KHOOK = false;
    bf16* HID; int ldh;
    __device__ __forceinline__ void operator()(const pg8::f32x4 (&acc)[2][2][4][2], const pg8::Unit& u, int wr, int wc, int fr, int fq) const {
        asm volatile("" : "+v"(fr), "+v"(fq));
#pragma unroll
        for (int ai = 0; ai < 2; ++ai)
#pragma unroll
            for (int m = 0; m < 4; ++m) { const int row = u.pm * 256 + ai * 128 + wr * 64 + m * 16 + fr; f32x4 r0, r1;
#pragma unroll
                for (int q = 0; q < 4; ++q) { r0[q] = siluf_(acc[ai][0][m][0][q]) * acc[ai][0][m][1][q]; r1[q] = siluf_(acc[ai][1][m][0][q]) * acc[ai][1][m][1][q]; }
                *(v4u*)(HID + (size_t)row * ldh + u.pn * 128 + wc * 32 + 8 * fq) = pack8(r0, r1);
                if (m & 1) asm volatile("" ::: "memory"); }
    }
};
struct EpiSwiglu8 {
    static constexpr bool PERM = false, AFTER_DRAIN = false, KHOOK = false;
    unsigned char* HID; int ldh;
    __device__ __forceinline__ void operator()(const pg8::f32x4 (&acc)[2][2][4][2], const pg8::Unit& u, int wr, int wc, int fr, int fq) const {
        asm volatile("" : "+v"(fr), "+v"(fq));
        const float s8 = (float)(1 << F8_ACT_L2);
#pragma unroll
        for (int ai = 0; ai < 2; ++ai)
#pragma unroll
            for (int m = 0; m < 4; ++m) { const int row = u.pm * 256 + ai * 128 + wr * 64 + m * 16 + fr; f32x4 r0, r1;
#pragma unroll
                for (int q = 0; q < 4; ++q) { r0[q] = siluf_(acc[ai][0][m][0][q]) * acc[ai][0][m][1][q] * s8; r1[q] = siluf_(acc[ai][1][m][0][q]) * acc[ai][1][m][1][q] * s8; }
                v2u o; o.x = cvt4_fp8(r0[0], r0[1], r0[2], r0[3]); o.y = cvt4_fp8(r1[0], r1[1], r1[2], r1[3]);
                *(v2u*)(HID + (size_t)row * ldh + u.pn * 128 + wc * 32 + 8 * fq) = o;
                if (m & 1) asm volatile("" ::: "memory"); }
    }
};
struct EpiY {
    static constexpr bool PERM = false, AFTER_DRAIN = false, KHOOK = false;
    bf16* Y; int first;
    __device__ __forceinline__ void operator()(const pg8::f32x4 (&acc)[2][2][4][2], const pg8::Unit& u, int wr, int wc, int fr, int fq) const {
        asm volatile("" : "+v"(fr), "+v"(fq));
        EPI_LOOP8({ (void)first; *(v4u*)(Y + (size_t)row * DM + u.pn * 256 + col) = pack8(v0, v1); })
    }
};

__device__ __forceinline__ int iperm32(int c) { return ((c >> 2) & 1) * 16 + (c >> 3) * 4 + (c & 3); }
template <int MAP> __device__ __forceinline__ int map_col(int c) {
    if (MAP == 0) return c;
    if (MAP == 1) { if (c >= 2560 && (c < 2576 || c >= 2832)) return -1;
        const int d = c < 2560 ? c : PC_POOL + (c - 2576);
        return d < 1024 ? d : (d & ~31) + iperm32(d & 31); }
    if (MAP == 4) return (c & ~31) + iperm32(c & 31);
    { const int x = c & 31; return (c >> 7) * 256 + ((x >> 2) & 1) * 128 + ((c >> 5) & 3) * 32 + (MAP == 3 ? 16 : 0) + 4 * (x >> 3) + (x & 3); }
}
template <int MAP> __device__ __forceinline__ void tr_item(const float* W, int ldw, int N, bf16* WT, int ldd, int item, LAS float* scr, int lane) {
    const int nblk = (N + 31) / 32, kb = item / nblk, nb = item % nblk, k0 = 64 * kb, n0 = 32 * nb;
    const int cl = n0 + (lane & 31);
    float tv[32];
#pragma unroll
    for (int i = 0; i < 32; ++i) { const int kk = 2 * i + (lane >> 5); tv[i] = cl < N ? W[(size_t)(k0 + kk) * ldw + cl] : 0.f; }
#pragma unroll
    for (int i = 0; i < 32; ++i) { const int kk = 2 * i + (lane >> 5); scr[kk * 33 + (lane & 31)] = tv[i]; }
    LDS_WAIT(); asm volatile("" ::: "memory");
    const int c = lane & 7;
#pragma unroll
    for (int j = 0; j < 4; ++j) { const int n = (lane >> 3) + 8 * j; const LAS float* s = scr + (8 * c) * 33 + n;
        const int dr = n0 + n < N ? map_col<MAP>(n0 + n) : -1;
        if (dr >= 0) { v4u o; o.x = pk2(s[0 * 33], s[1 * 33]); o.y = pk2(s[2 * 33], s[3 * 33]); o.z = pk2(s[4 * 33], s[5 * 33]); o.w = pk2(s[6 * 33], s[7 * 33]);
            *(GAS v4u*)(WT + (size_t)dr * ldd + k0 + 8 * c) = o; } }
    LDS_WAIT(); asm volatile("" ::: "memory");
}
template <int MAP> __device__ __forceinline__ void tr_item8(const float* W, int ldw, int N, unsigned char* WT, int ldd, int item, LAS float* scr, int lane, float scale) {
    const int nblk = (N + 31) / 32, kb = item / nblk, nb = item % nblk, k0 = 64 * kb, n0 = 32 * nb;
    const int cl = n0 + (lane & 31);
    float tv[32];
#pragma unroll
    for (int i = 0; i < 32; ++i) { const int kk = 2 * i + (lane >> 5); tv[i] = cl < N ? W[(size_t)(k0 + kk) * ldw + cl] : 0.f; }
#pragma unroll
    for (int i = 0; i < 32; ++i) { const int kk = 2 * i + (lane >> 5); scr[kk * 33 + (lane & 31)] = tv[i]; }
    LDS_WAIT(); asm volatile("" ::: "memory");
    const int c = lane & 7;
#pragma unroll
    for (int j = 0; j < 4; ++j) { const int n = (lane >> 3) + 8 * j; const LAS float* s = scr + (8 * c) * 33 + n;
        if (n0 + n < N) { v2u o; o.x = cvt4_fp8(s[0 * 33] * scale, s[1 * 33] * scale, s[2 * 33] * scale, s[3 * 33] * scale); o.y = cvt4_fp8(s[4 * 33] * scale, s[5 * 33] * scale, s[6 * 33] * scale, s[7 * 33] * scale);
            *(GAS v2u*)(WT + (size_t)map_col<MAP>(n0 + n) * ldd + k0 + 8 * c) = o; } }
    LDS_WAIT(); asm volatile("" ::: "memory");
}
#define TR_RUN(MAP, W, ldw, K, N, WT, ldd) { const int cnt_ = ((K) / 64) * (((N) + 31) / 32); if (r < cnt_) { tr_item<MAP>(W, ldw, N, WT, ldd, r, scr, F.lane); continue; } r -= cnt_; }

constexpr int LW_ITEMS = 16 * 185 + 8 * 32 + 4 * 32 + 4 * 32 + 16 * 32 + 16 * 96 + 64;
__device__ __forceinline__ void conv_layer_weights(Frame& F, const Args& A, int l, int rank, int nranks) {
    LAS float* scr = (LAS float*)(F.lds + F.wave * 16384);
    bf16* WIN = (bf16*)(F.ws + WS_WIN); bf16* WBR = (bf16*)(F.ws + WS_WBR); bf16* WOUT = (bf16*)(F.ws + WS_WOUT);
    const float* win = A.in[F.zz + 8] + (size_t)l * 1024 * INW; const float* wbr = A.in[F.zz + 17] + (size_t)l * 1024 * 1024; const float* wo = A.in[F.zz + 18] + (size_t)l * 1024 * 1024;
    bf16* dbr = WBR + (size_t)l * 1024 * 1024;
    for (int it = rank; it < LW_ITEMS; it += nranks) {
        int r = it;
        { const int cnt_ = 16 * 185; if (r < cnt_) { tr_item<1>(win, INW, INW, WIN + (size_t)l * NPB * 1024, 1024, r, scr, F.lane); continue; } r -= cnt_; }
        { const int cnt_ = 8 * 32; if (r < cnt_) { tr_item<4>(wbr, 1024, 1024, dbr, 1024, r, scr, F.lane); continue; } r -= cnt_; }
        { const int cnt_ = 4 * 32; if (r < cnt_) { tr_item<4>(wbr + 512 * 1024, 1024, 1024, dbr + 512, 1024, r, scr, F.lane); continue; } r -= cnt_; }
        { const int cnt_ = 4 * 32; if (r < cnt_) { tr_item<4>(wbr + 768 * 1024, 1024, 1024, dbr + 768, 1024, r, scr, F.lane); continue; } r -= cnt_; }
        { const int cnt_ = 16 * 32; if (r < cnt_) { tr_item<4>(wo, 1024, 1024, WOUT + (size_t)l * 1024 * 1024, 1024, r, scr, F.lane); continue; } r -= cnt_; }
        { const int cnt_ = 16 * 96; if (r < cnt_) { tr_item8<4>(win + 2832, INW, 3072, F.ws + WS_WG8 + (size_t)l * 3072 * 1024, 1024, r, scr, F.lane, (float)(1 << F8_W13_L2)); continue; } r -= cnt_; }
        { bf16* wab = (bf16*)(F.ws + WS_WAB) + (size_t)l * 16384;
          for (int e = F.lane; e < 256; e += 64) { const int k = r * 16 + (e >> 4), c = e & 15; wab[c * 1024 + k] = (bf16)f2bf(win[(size_t)k * INW + 2560 + c]); } }
    }
}
__device__ __forceinline__ void p0_prologue(Frame& F, const Args& A) {
    LAS float* scr = (LAS float*)(F.lds + F.wave * 16384);
    const int gw = F.vcu * NWAVES + F.wave, NGW = F.G * NWAVES;
    bf16* W13 = (bf16*)(F.ws + WS_W13); bf16* W2 = (bf16*)(F.ws + WS_W2);
    conv_layer_weights(F, A, 0, gw, NGW);
    constexpr int TOTAL = 16 * 88 * 2 + 44 * 32;
    for (int it = gw; it < TOTAL; it += NGW) {
        int r = it;
#ifdef DENSE_F8
        { const int cnt_ = 16 * 88; if (r < cnt_) { tr_item8<2>(A.in[F.zz + 19], FFD, FFD, (unsigned char*)W13, 1024, r, scr, F.lane, (float)(1 << F8_W13_L2)); continue; } r -= cnt_; }
        { const int cnt_ = 16 * 88; if (r < cnt_) { tr_item8<3>(A.in[F.zz + 20], FFD, FFD, (unsigned char*)W13, 1024, r, scr, F.lane, (float)(1 << F8_W13_L2)); continue; } r -= cnt_; }
        tr_item8<4>(A.in[F.zz + 21], 1024, 1024, (unsigned char*)W2, FFD, r, scr, F.lane, (float)(1 << F8_W2_L2));
#else
        { const int cnt_ = 16 * 88; if (r < cnt_) { tr_item<2>(A.in[F.zz + 19], FFD, FFD, W13, 1024, r, scr, F.lane); continue; } r -= cnt_; }
        { const int cnt_ = 16 * 88; if (r < cnt_) { tr_item<3>(A.in[F.zz + 20], FFD, FFD, W13, 1024, r, scr, F.lane); continue; } r -= cnt_; }
        tr_item<4>(A.in[F.zz + 21], 1024, 1024, W2, FFD, r, scr, F.lane);
#endif
    }
    if (F.vcu == 0 && F.tid < 8) __hip_atomic_store(F.ctl + CW_ECNT + 64 * F.tid, 0u, RLX_AGENT);
    if (F.vcu == 0) {
        float* rope = (float*)(F.ws + WS_ROPE);
        for (int e = F.tid; e < 1024; e += NTHR) { const int pos = e >> 4, i = e & 15; const float inv = powf(10000.f, -(float)i / 16.f); const float a = (float)pos * inv;
            rope[2 * e] = cosf(a); rope[2 * e + 1] = sinf(a); }
        if (F.tid < 2) { const int l = F.tid; const float* lp = A.in[F.zz + 9] + l * 256; float s1 = 0.f, s2 = 0.f;
            for (int i = 0; i < 64; ++i) { s1 += lp[i] * lp[64 + i]; s2 += lp[128 + i] * lp[192 + i]; }
            const float li = 0.8f - 0.6f * expf(-0.3f * (float)l);
            ((float*)(F.ws + WS_LAM))[l] = expf(s1) - expf(s2) + li; }
    }
    __syncthreads();
    float* MOD = (float*)(F.ws + WS_MOD);
    LAS float* red = (LAS float*)F.lds;
    for (int task = F.vcu; task < 2 * 96; task += F.G) {
        const int l = task / 96, cc = task % 96;
        const float* aw = A.in[F.zz + 4] + (size_t)l * 1024 * 6144 + cc * 64 + F.lane;
        const float* c0 = A.in[F.zz + 1]; const float* cx = A.in[F.zz + 3];
        float a0 = 0.f, a1 = 0.f, a2 = 0.f, a3 = 0.f, a4 = 0.f;
#pragma unroll 8
        for (int i = 0; i < 128; ++i) { const int k = F.wave * 128 + i; const float w = aw[(size_t)k * 6144];
            a0 += siluf_(c0[k]) * w; a1 += siluf_(c0[1024 + k]) * w; a2 += siluf_(c0[2048 + k]) * w; a3 += siluf_(c0[3072 + k]) * w; a4 += siluf_(cx[k]) * w; }
        LAS float* rw = red + F.wave * 320 + F.lane;
        rw[0] = a0; rw[64] = a1; rw[128] = a2; rw[192] = a3; rw[256] = a4;
        __syncthreads();
        if (F.tid < 320) { float s = 0.f;
#pragma unroll
            for (int w = 0; w < 8; ++w) s += red[w * 320 + F.tid];
            const int rr = F.tid >> 6, jj = cc * 64 + (F.tid & 63);
            MOD[(l * 5 + rr) * 6144 + jj] = s + A.in[F.zz + 5][l * 6144 + jj]; }
        __syncthreads();
    }
}

__device__ __forceinline__ void moe_convert(Frame& F, const Args& A, int rank, int nranks) {
    LAS float* scr = (LAS float*)(F.lds + F.wave * 16384);
    const int gw = rank, NGW = nranks;
    unsigned char* W13M = F.ws + WS_W13M; unsigned char* W2M = F.ws + WS_W2M;
    constexpr int I13 = 16 * 112, I2 = 56 * 32, PER_E = 2 * I13 + I2;
    for (int it = gw; it < 8 * PER_E; it += NGW) {
        const int e = it / PER_E; int r = it - e * PER_E;
        if (r < I13) { tr_item8<2>(A.in[F.zz + 23] + (size_t)e * 1024 * FFE, FFE, FFE, W13M + (size_t)e * 2 * FFE * 1024, 1024, r, scr, F.lane, (float)(1 << F8_W13_L2)); continue; } r -= I13;
        if (r < I13) { tr_item8<3>(A.in[F.zz + 24] + (size_t)e * 1024 * FFE, FFE, FFE, W13M + (size_t)e * 2 * FFE * 1024, 1024, r, scr, F.lane, (float)(1 << F8_W13_L2)); continue; } r -= I13;
        tr_item8<4>(A.in[F.zz + 25] + (size_t)e * FFE * 1024, 1024, 1024, W2M + (size_t)e * 1024 * FFE, FFE, r, scr, F.lane, (float)(1 << F8_W2_L2));
    }
}

__device__ __forceinline__ void norm_mod_phase(Frame& F, const Args& A, int l, int which, bool latent_only, bool route, bool out8 = false, int nslab = 0, int srcmode = 0) {
    (void)latent_only; (void)route;
    const int gw = F.vcu * NWAVES + F.wave, NGW = F.G * NWAVES;
    const float* H = (const float*)(F.ws + WS_H); bf16* U = (bf16*)(F.ws + WS_U); const float* MOD = (const float*)(F.ws + WS_MOD) + l * 5 * 6144;
    const float* g = (which ? A.in[F.zz + 7] : A.in[F.zz + 6]) + l * 1024;
    const float* xin = A.in[F.zz + 0]; const float* cin = A.in[F.zz + 2];
#define NM_SRC(R_) ({ const int b_ = (R_) / RPB, j_ = (R_) - b_ * RPB; const float* p_ = (srcmode == 1 || (srcmode == 2 && j_ < CTXL)) ? (j_ < CTXL ? cin + ((size_t)b_ * CTXL + j_) * DM : xin + ((size_t)b_ * SEQ + (j_ - CTXL)) * DM) : H + (size_t)(R_) * DM; p_; })
    f32x4 nv[4];
    if (gw < MROWS) { const GAS f32x4* xr = (const GAS f32x4*)NM_SRC(gw) + F.lane;
#pragma unroll
        for (int q = 0; q < 4; ++q) nv[q] = xr[64 * q]; }
#pragma unroll 1
    for (int R = gw; R < MROWS; R += NGW) {
        const int b = R / RPB, j = R - b * RPB; const bool isctx = j < CTXL;
        const float* mod = MOD + (isctx ? 4 : b) * 6144; const float* shift = mod + (which ? 3 : 0) * 1024; const float* scale = mod + (which ? 4 : 1) * 1024;
        f32x4 v[4]; float ss = 0.f;
#pragma unroll
        for (int q = 0; q < 4; ++q) v[q] = nv[q];
        if (R + NGW < MROWS) { const GAS f32x4* xr = (const GAS f32x4*)NM_SRC(R + NGW) + F.lane;
#pragma unroll
            for (int q = 0; q < 4; ++q) nv[q] = xr[64 * q]; }
        if (nslab > 0 && isctx) {
            const GAS f32x4* sp = (const GAS f32x4*)((const float*)(F.ws + WS_SLAB) + (size_t)(b * 256 + j) * 1024) + F.lane;
#pragma unroll
            for (int q = 0; q < 4; ++q) { f32x4 t[11];
#pragma unroll
                for (int s = 0; s < 11; ++s) t[s] = s < nslab ? sp[(size_t)s * 262144 + 64 * q] : (f32x4){0.f, 0.f, 0.f, 0.f};
#pragma unroll
                for (int s = 0; s < 11; ++s) v[q] += t[s]; }
            GAS f32x4* hw = (GAS f32x4*)(F.ws + WS_H + (size_t)R * DM * 4) + F.lane;
#pragma unroll
            for (int q = 0; q < 4; ++q) hw[64 * q] = v[q]; }
#pragma unroll
        for (int q = 0; q < 4; ++q) ss += (v[q].x * v[q].x + v[q].y * v[q].y) + (v[q].z * v[q].z + v[q].w * v[q].w);
        const float rstd = 1.f / sqrtf(wave_sum(ss) * (1.f / DM) + EPSN);
        GAS v2u* o8 = (GAS v2u*)(U + (size_t)R * DM) + F.lane;
#pragma unroll
        for (int q = 0; q < 4; ++q) { const int c = 4 * F.lane + 256 * q; const f32x4 gg = *(const f32x4*)(g + c), sh = *(const f32x4*)(shift + c), sc = *(const f32x4*)(scale + c);
            v[q] = (v[q] * rstd) * gg * (sc + 1.f) + sh;
            if (out8) { const float s8 = (float)(1 << F8_ACT_L2); ((GAS unsigned*)((unsigned char*)U + (size_t)R * DM))[F.lane + 64 * q] = cvt4_fp8(v[q].x * s8, v[q].y * s8, v[q].z * s8, v[q].w * s8); }
            else { v2u w; w.x = pk2(v[q].x, v[q].y); w.y = pk2(v[q].z, v[q].w); o8[64 * q] = w; } }
        if (which == 0) {
            const float s8 = (float)(1 << F8_ACT_L2);
#pragma unroll
            for (int q = 0; q < 4; ++q) ((GAS unsigned*)(F.ws + WS_U8 + (size_t)R * DM))[F.lane + 64 * q] = cvt4_fp8(v[q].x * s8, v[q].y * s8, v[q].z * s8, v[q].w * s8);
        }
    }
}
__device__ __forceinline__ void norm2_route_phase(Frame& F, const Args& A) {
    const int l = 1;
    const float* H = (const float*)(F.ws + WS_H); bf16* U = (bf16*)(F.ws + WS_U); const float* MOD = (const float*)(F.ws + WS_MOD) + l * 5 * 6144;
    const float* g = A.in[F.zz + 7] + l * 1024; const float* rw = A.in[F.zz + 22];
    LAS unsigned* wcnt = (LAS unsigned*)F.lds;
    LAS unsigned* gbase = wcnt + 64;
    const int lane = F.lane, wv = F.wave;
    for (int blk = F.vcu; blk < NB * SEQ / 64; blk += F.G) {
        int me0 = 0, me1 = 0; float mw0 = 0.f, mw1 = 0.f;
        f32x4 nv[4];
        { const int tk = blk * 64 + wv * 8, b = tk / SEQ, t = tk - b * SEQ; const GAS f32x4* xr = (const GAS f32x4*)(H + ((size_t)b * RPB + CTXL + t) * DM) + lane;
#pragma unroll
          for (int q = 0; q < 4; ++q) nv[q] = xr[64 * q]; }
#pragma unroll 1
        for (int i = 0; i < 8; ++i) {
            const int tk = blk * 64 + wv * 8 + i, b = tk / SEQ, t = tk - b * SEQ; const size_t R = (size_t)b * RPB + CTXL + t;
            const float* mod = MOD + b * 6144; const float* shift = mod + 3 * 1024; const float* scale = mod + 4 * 1024;
            f32x4 v[4]; float ss = 0.f;
#pragma unroll
            for (int q = 0; q < 4; ++q) { v[q] = nv[q]; ss += (v[q].x * v[q].x + v[q].y * v[q].y) + (v[q].z * v[q].z + v[q].w * v[q].w); }
            if (i < 7) { const GAS f32x4* xr = (const GAS f32x4*)(H + (R + 1) * DM) + lane;
#pragma unroll
                for (int q = 0; q < 4; ++q) nv[q] = xr[64 * q]; }
            const float rstd = 1.f / sqrtf(wave_sum(ss) * (1.f / DM) + EPSN);
            GAS v2u* o8 = (GAS v2u*)(U + R * DM) + lane;
            float lg[8] = {0, 0, 0, 0, 0, 0, 0, 0};
#pragma unroll
            for (int q = 0; q < 4; ++q) { const int c = 4 * lane + 256 * q; const f32x4 gg = *(const f32x4*)(g + c), sh = *(const f32x4*)(shift + c), sc = *(const f32x4*)(scale + c);
                v[q] = (v[q] * rstd) * gg * (sc + 1.f) + sh; v2u w; w.x = pk2(v[q].x, v[q].y); w.y = pk2(v[q].z, v[q].w); o8[64 * q] = w;
#pragma unroll
                for (int j = 0; j < 4; ++j) { const int k = c + j; const f32x4 w0 = *(const f32x4*)(rw + k * 8), w1 = *(const f32x4*)(rw + k * 8 + 4); const float x = v[q][j];
                    lg[0] += x * w0[0]; lg[1] += x * w0[1]; lg[2] += x * w0[2]; lg[3] += x * w0[3]; lg[4] += x * w1[0]; lg[5] += x * w1[1]; lg[6] += x * w1[2]; lg[7] += x * w1[3]; } }
#pragma unroll
            for (int e = 0; e < 8; ++e) lg[e] = wave_sum(lg[e]);
            int e0 = 0; float v0 = lg[0];
#pragma unroll
            for (int e = 1; e < 8; ++e) if (lg[e] > v0) { v0 = lg[e]; e0 = e; }
            int e1 = -1; float v1 = -3.0e38f;
#pragma unroll
            for (int e = 0; e < 8; ++e) if (e != e0 && lg[e] > v1) { v1 = lg[e]; e1 = e; }
            const float ex = __expf(v1 - v0);
            if (lane == i) { me0 = e0; me1 = e1; mw0 = 1.f / (1.f + ex); mw1 = ex / (1.f + ex); }
        }
        const bool act = lane < 8; const unsigned long long below = (1ull << lane) - 1ull;
        unsigned r0 = 0, r1 = 0, mycnt = 0;
#pragma unroll
        for (int e = 0; e < 8; ++e) { const unsigned long long m0 = __ballot(act && me0 == e), m1 = __ballot(act && me1 == e);
            const unsigned bel = (unsigned)__popcll((m0 | m1) & below);
            if (me0 == e) r0 = bel; if (me1 == e) r1 = bel;
            if (lane == e) mycnt = (unsigned)__popcll(m0) + (unsigned)__popcll(m1); }
        if (act) wcnt[wv * 8 + lane] = mycnt;
        __syncthreads();
        if (F.tid < 8) { unsigned tot = 0;
#pragma unroll
            for (int w = 0; w < 8; ++w) tot += wcnt[w * 8 + F.tid];
            gbase[F.tid] = __hip_atomic_fetch_add(F.ctl + CW_ECNT + 64 * F.tid, tot, RLX_AGENT); }
        __syncthreads();
        if (act) { unsigned b0 = gbase[me0], b1 = gbase[me1];
            for (int w = 0; w < wv; ++w) { b0 += wcnt[w * 8 + me0]; b1 += wcnt[w * 8 + me1]; }
            const int tk = blk * 64 + wv * 8 + lane;
            v4u* rt = (v4u*)(F.ws + WS_ROUTE) + 2 * tk;
            rt[0] = (v4u){(unsigned)me0, (unsigned)me1, b0 + r0, b1 + r1}; rt[1] = (v4u){__float_as_uint(mw0), __float_as_uint(mw1), 0u, 0u}; }
        __syncthreads();
    }
}

__device__ __forceinline__ void ab_tiles(Frame& F, const Args& A, int l) {
    typedef short ab_s16x8 __attribute__((ext_vector_type(8)));
    const int gw = F.vcu * NWAVES + F.wave, NGW = F.G * NWAVES, r = F.lane & 15, q = F.lane >> 4;
    const bf16* U = (const bf16*)(F.ws + WS_U); const bf16* wab = (const bf16*)(F.ws + WS_WAB) + (size_t)l * 16384 + r * 1024 + 8 * q;
    const float alog = A.in[F.zz + 12][l * 8 + (r & 7)], dtb = A.in[F.zz + 13][l * 8 + (r & 7)];
    for (int t = gw; t < MROWS / 16; t += NGW) {
        const bf16* up = U + (size_t)(t * 16 + r) * DM + 8 * q; f32x4 acc = {0.f, 0.f, 0.f, 0.f};
#pragma unroll 8
        for (int ks = 0; ks < 32; ++ks) acc = __builtin_amdgcn_mfma_f32_16x16x32_bf16(*(const ab_s16x8*)(up + 32 * ks), *(const ab_s16x8*)(wab + 32 * ks), acc, 0, 0, 0);
        f32x4 o;
#pragma unroll
        for (int g = 0; g < 4; ++g) { const float x = acc[g];
            if (r < 8) { const float z = x + dtb; const float ez = __expf(z); const float sp = z > 15.f ? z : (ez < 0.03f ? ez * (1.f - ez * (0.5f - ez * (1.f / 3.f))) : __logf(1.f + ez)); o[g] = -__expf(alog) * sp; }
            else o[g] = sigmoidf_(x); }
        float* gb = (float*)(F.ws + WS_GB) + (size_t)(t * 16 + 4 * q) * 16 + r;
        gb[0] = o[0]; gb[16] = o[1]; gb[32] = o[2]; gb[48] = o[3];
    }
}

__device__ __forceinline__ void moe_gather2(Frame& F) {
    const int gw = F.vcu * NWAVES + F.wave, NGW = F.G * NWAVES;
    MoeOrder mo; mo.init(F.ctl + CW_ECNT, 1, 1, 0);
    const bf16* U = (const bf16*)(F.ws + WS_U); unsigned char* XG = F.ws + WS_XG; const float sc = (float)(1 << F8_ACT_L2);
    for (int tk = gw; tk < NB * SEQ; tk += NGW) {
        const int b = tk / SEQ, t = tk - b * SEQ; const size_t R = (size_t)b * RPB + CTXL + t;
        const v4u rt = ((const v4u*)(F.ws + WS_ROUTE))[2 * tk];
        const size_t r0 = (size_t)mo.tile_off((int)rt.x) * 256 + rt.z, r1 = (size_t)mo.tile_off((int)rt.y) * 256 + rt.w;
        const GAS v4u* s = (const GAS v4u*)(U + R * DM) + 2 * F.lane; const v4u a = s[0], c = s[1];
        v4u o; o.x = cvt4_fp8(bf_lo(a.x) * sc, bf_hi(a.x) * sc, bf_lo(a.y) * sc, bf_hi(a.y) * sc); o.y = cvt4_fp8(bf_lo(a.z) * sc, bf_hi(a.z) * sc, bf_lo(a.w) * sc, bf_hi(a.w) * sc);
        o.z = cvt4_fp8(bf_lo(c.x) * sc, bf_hi(c.x) * sc, bf_lo(c.y) * sc, bf_hi(c.y) * sc); o.w = cvt4_fp8(bf_lo(c.z) * sc, bf_hi(c.z) * sc, bf_lo(c.w) * sc, bf_hi(c.w) * sc);
        *((GAS v4u*)(XG + r0 * DM) + F.lane) = o; *((GAS v4u*)(XG + r1 * DM) + F.lane) = o;
    }
}
__device__ __forceinline__ void moe_gather(Frame& F) {
    moe_gather2(F);
}
__device__ __forceinline__ void final_phase(Frame& F, const Args& A) {
    const int gw = F.vcu * NWAVES + F.wave, NGW = F.G * NWAVES;
    MoeOrder mo; mo.init(F.ctl + CW_ECNT, 1, 1, 0);
    const float* H = (const float*)(F.ws + WS_H); const bf16* Y = (const bf16*)(F.ws + WS_Y); const float* MOD = (const float*)(F.ws + WS_MOD) + 1 * 5 * 6144;
    for (int tk = gw; tk < NB * SEQ; tk += NGW) {
        const int b = tk / SEQ, t = tk - b * SEQ; const size_t R = (size_t)b * RPB + CTXL + t;
        const v4u rt = ((const v4u*)(F.ws + WS_ROUTE))[2 * tk], rw = ((const v4u*)(F.ws + WS_ROUTE))[2 * tk + 1];
        const size_t r0 = (size_t)mo.tile_off((int)rt.x) * 256 + rt.z, r1 = (size_t)mo.tile_off((int)rt.y) * 256 + rt.w;
        const float w0 = __uint_as_float(rw.x), w1 = __uint_as_float(rw.y);
        const float* gate = MOD + b * 6144 + 5 * 1024;
        f32x4 v[4]; float ss = 0.f;
#pragma unroll
        for (int q = 0; q < 4; ++q) { const int c = 4 * F.lane + 256 * q;
            const f32x4 h = *(const f32x4*)(H + R * DM + c), gg = *(const f32x4*)(gate + c);
            const f32x4 y0 = unpack4(*(const v2u*)(Y + r0 * DM + c)), y1 = unpack4(*(const v2u*)(Y + r1 * DM + c));
            v[q] = h + gg * (y0 * w0 + y1 * w1); ss += (v[q].x * v[q].x + v[q].y * v[q].y) + (v[q].z * v[q].z + v[q].w * v[q].w); }
        const float rstd = 1.f / sqrtf(wave_sum(ss) * (1.f / DM) + EPSN);
#pragma unroll
        for (int q = 0; q < 4; ++q) { const int c = 4 * F.lane + 256 * q; *(f32x4*)(F.out + (size_t)tk * DM + c) = v[q] * rstd * *(const f32x4*)(A.in[F.zz + 26] + c); }
    }
}

constexpr int DP = 65;
typedef short dn_bf16x8 __attribute__((ext_vector_type(8)));
__device__ __forceinline__ f32x4 mm_tile(const LAS float* Am, int a_sm, int a_sk, const LAS float* Bm, int b_sk, int b_sn, int m0, int n0, int lane) {
    const int r = lane & 15, q = lane >> 4; f32x4 acc = {0.f, 0.f, 0.f, 0.f};
#pragma unroll
    for (int ks = 0; ks < 2; ++ks) {
        const LAS float* ap = Am + (m0 + r) * a_sm + (32 * ks + 8 * q) * a_sk; const LAS float* bp = Bm + (32 * ks + 8 * q) * b_sk + (n0 + r) * b_sn;
        v4u a, b;
        a.x = pk2(ap[0], ap[a_sk]); a.y = pk2(ap[2 * a_sk], ap[3 * a_sk]); a.z = pk2(ap[4 * a_sk], ap[5 * a_sk]); a.w = pk2(ap[6 * a_sk], ap[7 * a_sk]);
        b.x = pk2(bp[0], bp[b_sk]); b.y = pk2(bp[2 * b_sk], bp[3 * b_sk]); b.z = pk2(bp[4 * b_sk], bp[5 * b_sk]); b.w = pk2(bp[6 * b_sk], bp[7 * b_sk]);
        acc = __builtin_amdgcn_mfma_f32_16x16x32_bf16(__builtin_bit_cast(dn_bf16x8, a), __builtin_bit_cast(dn_bf16x8, b), acc, 0, 0, 0);
    }
    return acc;
}

constexpr int RS = 72;
constexpr int IMG = 64 * RS * 2;
typedef short dn_s16x4 __attribute__((ext_vector_type(4)));
__device__ __forceinline__ f32x4 mm_img(const LAS bf16* Ai, const LAS bf16* Bi, int m0, int n0, int r, int q) {
    f32x4 acc = {0.f, 0.f, 0.f, 0.f};
    const LAS bf16* ap = Ai + (m0 + r) * RS + 8 * q; const LAS bf16* bp = Bi + (n0 + r) * RS + 8 * q;
    acc = __builtin_amdgcn_mfma_f32_16x16x32_bf16(*(const LAS dn_bf16x8*)ap, *(const LAS dn_bf16x8*)bp, acc, 0, 0, 0);
    acc = __builtin_amdgcn_mfma_f32_16x16x32_bf16(*(const LAS dn_bf16x8*)(ap + 32), *(const LAS dn_bf16x8*)(bp + 32), acc, 0, 0, 0);
    return acc;
}
template <int D> __device__ __forceinline__ void dn_diag_inv(LAS float* Dg, int ln) {
    const int blk = ln >> 4, r = ln & 15;
    LAS float* Ab = Dg + blk * 256;
    float t[16];
#pragma unroll
    for (int c = 0; c < 16; ++c) t[c] = (c == r) ? 1.f : 0.f;
#pragma unroll
    for (int c = 14; c >= 0; --c) { float s = 0.f;
#pragma unroll
        for (int j = c + 1; j < 16; ++j) { const float a = D == 0 ? Ab[j * 16 + c] : Ab[(15 - j) * 16 + (15 - c)]; s -= t[j] * a; }
        t[c] = (c < r) ? s : t[c]; }
    asm volatile("s_waitcnt lgkmcnt(0)" ::: "memory");
#pragma unroll
    for (int c = 0; c < 16; ++c) { if (D == 0) Ab[r * 16 + c] = t[c]; else Ab[(15 - r) * 16 + (15 - c)] = t[c]; }
}
template <int D> __device__ __forceinline__ void dn_solve_tiles(const LAS bf16* Ad, const LAS float* Dg, const LAS bf16* VT, const LAS bf16* KT, LAS bf16* UT, LAS bf16* WT,
                                                               const LAS float* Bd, const LAS float* Gd, int w4, int ln) {
    const int r = ln & 15, q = ln >> 4;
#pragma unroll 1
    for (int i = 0; i < 2; ++i) { const int nt = w4 * 2 + i; const bool isw = nt >= 4; const int c0 = (nt & 3) * 16 + r;
        const LAS bf16* src = (isw ? KT : VT) + c0 * RS; LAS bf16* dst = (isw ? WT : UT) + c0 * RS;
        f32x4 acc[4]; dn_s16x4 xb[4];
#pragma unroll
        for (int bi = 0; bi < 4; ++bi) { const v2u x = *(const LAS v2u*)(src + 16 * bi + 4 * q); const f32x4 xv = {bf_lo(x.x), bf_hi(x.x), bf_lo(x.y), bf_hi(x.y)};
#pragma unroll
            for (int g = 0; g < 4; ++g) { const int t = 16 * bi + 4 * q + g; const float sc = isw ? Bd[t] * __expf(Gd[t]) : Bd[t]; acc[bi][g] = xv[g] * sc; } }
#pragma unroll
        for (int st = 0; st < 4; ++st) { const int bi = D == 0 ? st : 3 - st;
#pragma unroll
            for (int s2 = 0; s2 < st; ++s2) { const int bj = D == 0 ? s2 : 3 - s2;
                v2u a = *(const LAS v2u*)(Ad + (16 * bi + r) * RS + 16 * bj + 4 * q); a.x ^= 0x80008000u; a.y ^= 0x80008000u;
                acc[bi] = __builtin_amdgcn_mfma_f32_16x16x16bf16_1k(__builtin_bit_cast(dn_s16x4, a), xb[bj], acc[bi], 0, 0, 0); }
            { const LAS float* tp = Dg + bi * 256 + r * 16 + 4 * q; v2u a; a.x = cvtpk_c(tp[0], tp[1]); a.y = cvtpk_c(tp[2], tp[3]);
              v2u xr; xr.x = cvtpk_c(acc[bi][0], acc[bi][1]); xr.y = cvtpk_c(acc[bi][2], acc[bi][3]);
              acc[bi] = __builtin_amdgcn_mfma_f32_16x16x16bf16_1k(__builtin_bit_cast(dn_s16x4, a), __builtin_bit_cast(dn_s16x4, xr), (f32x4){0.f, 0.f, 0.f, 0.f}, 0, 0, 0);
              v2u xo; xo.x = cvtpk_c(acc[bi][0], acc[bi][1]); xo.y = cvtpk_c(acc[bi][2], acc[bi][3]); xb[bi] = __builtin_bit_cast(dn_s16x4, xo);
              *(LAS v2u*)(dst + 16 * bi + 4 * q) = xo; }
        }
    }
}
__device__ __forceinline__ void dn_pre_unit(Frame& F, const Args& A, int l, int b, int n, int h) {
    LAS bf16* KcB = (LAS bf16*)(F.lds + 0 * IMG); LAS bf16* QcB = (LAS bf16*)(F.lds + 1 * IMG); LAS bf16* KT = (LAS bf16*)(F.lds + 2 * IMG); LAS bf16* VT = (LAS bf16*)(F.lds + 3 * IMG);
#define DIMG(d, k) ((LAS bf16*)(F.lds + (4 + 5 * (d) + (k)) * IMG))
    LAS float* Gs = (LAS float*)(F.lds + 14 * IMG);
    LAS float* Bs = Gs + 128;
    LAS float* Dg = Gs + 256;
    const bf16* P = (const bf16*)(F.ws + WS_PROJ); const float* GB = (const float*)(F.ws + WS_GB);
    const int tid = pg8::tid_from(F.wid_s);
    const int wv = tid >> 6, ln = tid & 63, r = ln & 15, q = ln >> 4;
    const int row0 = b * RPB + n * 64; const int seq_lo = (n < 4) ? b * RPB : b * RPB + CTXL, seq_hi = (n < 4) ? b * RPB + CTXL : (b + 1) * RPB;
    {
        const int t = tid >> 3, cg = tid & 7;
        const float* cw = A.in[F.zz + 11] + (size_t)l * 5 * 768;
#pragma unroll
        for (int p = 0; p < 3; ++p) {
            const int ch = p * 256 + h * 64 + cg * 8;
            float acc[8] = {0, 0, 0, 0, 0, 0, 0, 0};
#pragma unroll
            for (int tap = 0; tap < 5; ++tap) { const int rr = row0 + t + tap - 2;
                if (rr >= seq_lo && rr < seq_hi) { const v4u x = *(const v4u*)(P + (size_t)rr * PLD + PC_DQ + ch);
                    const f32x4 w0 = *(const f32x4*)(cw + tap * 768 + ch), w1 = *(const f32x4*)(cw + tap * 768 + ch + 4);
                    acc[0] += bf_lo(x.x) * w0[0]; acc[1] += bf_hi(x.x) * w0[1]; acc[2] += bf_lo(x.y) * w0[2]; acc[3] += bf_hi(x.y) * w0[3];
                    acc[4] += bf_lo(x.z) * w1[0]; acc[5] += bf_hi(x.z) * w1[1]; acc[6] += bf_lo(x.w) * w1[2]; acc[7] += bf_hi(x.w) * w1[3]; } }
            float ss = 0.f;
#pragma unroll
            for (int i = 0; i < 8; ++i) { acc[i] = siluf_(acc[i]); ss += acc[i] * acc[i]; }
            float sc = 1.f;
            if (p < 2) { ss = grp8_sum(ss); sc = (1.f / sqrtf(ss + EPSN)) * (p == 0 ? 0.125f : 1.f); }
            v4u o; o.x = cvtpk_c(acc[0] * sc, acc[1] * sc); o.y = cvtpk_c(acc[2] * sc, acc[3] * sc); o.z = cvtpk_c(acc[4] * sc, acc[5] * sc); o.w = cvtpk_c(acc[6] * sc, acc[7] * sc);
            if (p == 0) *(LAS v4u*)(QcB + t * RS + cg * 8) = o;
            else { if (p == 1) *(LAS v4u*)(KcB + t * RS + cg * 8) = o;
                LAS bf16* tp = (p == 1 ? KT : VT) + (cg * 8) * RS + t;
                tp[0 * RS] = (bf16)(o.x & 0xffffu); tp[1 * RS] = (bf16)(o.x >> 16); tp[2 * RS] = (bf16)(o.y & 0xffffu); tp[3 * RS] = (bf16)(o.y >> 16);
                tp[4 * RS] = (bf16)(o.z & 0xffffu); tp[5 * RS] = (bf16)(o.z >> 16); tp[6 * RS] = (bf16)(o.w & 0xffffu); tp[7 * RS] = (bf16)(o.w >> 16); }
        }
        if (wv < 2) { const int d = wv; const float* gb = GB + (size_t)(row0 + ln) * 16; const float g = gb[d * 4 + h]; Bs[d * 64 + ln] = gb[8 + d * 4 + h];
            float pf = g;
            { const int lid = lane_id_();
#pragma unroll
              for (int o = 1; o < 64; o <<= 1) { const float v = lane_get(pf, lid >= o ? lid - o : lid); if (lid >= o) pf += v; }
            }
            const float tot = lane_get(pf, 63);
            Gs[d * 64 + ln] = d == 0 ? pf : tot - pf + g; }
    }
    __syncthreads();
    {
#pragma unroll
        for (int i = 0; i < 2; ++i) { const int tile = wv * 2 + i, m0 = (tile >> 2) * 16, n0 = (tile & 3) * 16;
            const f32x4 kk = mm_img(KcB, KcB, m0, n0, r, q), qk = mm_img(QcB, KcB, m0, n0, r, q);
            const int s = n0 + r; const float g0s = Gs[s], g1s = Gs[64 + s];
#pragma unroll
            for (int g = 0; g < 4; ++g) { const int t = m0 + 4 * q + g; const float e0 = __expf(Gs[t] - g0s), e1 = __expf(Gs[64 + t] - g1s);
                const float a0 = (s < t) ? Bs[t] * kk[g] * e0 : 0.f, a1 = (s > t) ? Bs[64 + t] * kk[g] * e1 : 0.f;
                DIMG(0, 0)[t * RS + s] = (bf16)f2bf(a0); DIMG(1, 0)[t * RS + s] = (bf16)f2bf(a1);
                DIMG(0, 1)[t * RS + s] = (bf16)f2bf((s <= t) ? qk[g] * e0 : 0.f); DIMG(1, 1)[t * RS + s] = (bf16)f2bf((s >= t) ? qk[g] * e1 : 0.f);
                if (m0 == n0) { Dg[(m0 >> 4) * 256 + (t & 15) * 16 + r] = a0; Dg[1024 + (m0 >> 4) * 256 + (t & 15) * 16 + r] = a1; } } }
        { const int c = tid >> 3, t0 = (tid & 7) * 8; const v4u kx = *(const LAS v4u*)(KT + c * RS + t0); const float gl0 = Gs[63], gl1 = Gs[64];
          const float kf[8] = {bf_lo(kx.x), bf_hi(kx.x), bf_lo(kx.y), bf_hi(kx.y), bf_lo(kx.z), bf_hi(kx.z), bf_lo(kx.w), bf_hi(kx.w)};
          float s0[8], s1[8];
#pragma unroll
          for (int j = 0; j < 8; ++j) { s0[j] = kf[j] * __expf(gl0 - Gs[t0 + j]); s1[j] = kf[j] * __expf(gl1 - Gs[64 + t0 + j]); }
          v4u o0, o1; o0.x = cvtpk_c(s0[0], s0[1]); o0.y = cvtpk_c(s0[2], s0[3]); o0.z = cvtpk_c(s0[4], s0[5]); o0.w = cvtpk_c(s0[6], s0[7]);
          o1.x = cvtpk_c(s1[0], s1[1]); o1.y = cvtpk_c(s1[2], s1[3]); o1.z = cvtpk_c(s1[4], s1[5]); o1.w = cvtpk_c(s1[6], s1[7]);
          *(LAS v4u*)(DIMG(0, 4) + c * RS + t0) = o0; *(LAS v4u*)(DIMG(1, 4) + c * RS + t0) = o1; }
    }
    __syncthreads();
    if (wv == 0) dn_diag_inv<0>(Dg, ln); else if (wv == 4) dn_diag_inv<1>(Dg + 1024, ln);
    __syncthreads();
    if (wv < 4) dn_solve_tiles<0>(DIMG(0, 0), Dg, VT, KT, DIMG(0, 3), DIMG(0, 2), Bs, Gs, wv & 3, ln);
    else dn_solve_tiles<1>(DIMG(1, 0), Dg + 1024, VT, KT, DIMG(1, 3), DIMG(1, 2), Bs + 64, Gs + 64, wv & 3, ln);
    __syncthreads();
    {
        const int d = wv >> 2, mt = wv & 3;
        const LAS bf16* Aq = DIMG(d, 1); const LAS bf16* WT = DIMG(d, 2); const LAS bf16* UT = DIMG(d, 3); const LAS bf16* KsT = DIMG(d, 4); const LAS float* Gd = Gs + d * 64;
        const float glast = d == 0 ? Gd[63] : Gd[0];
        const size_t prob = (((size_t)b * NCHUNK + n) * 4 + h) * 2 + d;
        unsigned char* out = F.ws + WS_DNP + prob * 32768;
        if (ln == 0 && mt == 0) ((float*)(F.ws + WS_DNG))[prob] = __expf(glast);
        const float gq = __expf(Gd[16 * mt + r]);
#pragma unroll
        for (int ks = 0; ks < 2; ++ks) {
            const f32x4 y0 = mm_img(WT, Aq, 32 * ks, 16 * mt, r, q), y1 = mm_img(WT, Aq, 32 * ks + 16, 16 * mt, r, q);
            const LAS bf16* qp = QcB + (16 * mt + r) * RS + 32 * ks + 4 * q; const v2u qa = *(const LAS v2u*)qp, qb = *(const LAS v2u*)(qp + 16);
            v4u o; o.x = cvtpk_c(gq * bf_lo(qa.x) - y0[0], gq * bf_hi(qa.x) - y0[1]); o.y = cvtpk_c(gq * bf_lo(qa.y) - y0[2], gq * bf_hi(qa.y) - y0[3]);
            o.z = cvtpk_c(gq * bf_lo(qb.x) - y1[0], gq * bf_hi(qb.x) - y1[1]); o.w = cvtpk_c(gq * bf_lo(qb.y) - y1[2], gq * bf_hi(qb.y) - y1[3]);
            *(v4u*)(out + (mt * 2 + ks) * 1024 + ln * 16) = o;
            const f32x4 c0 = mm_img(WT, KsT, 32 * ks, 16 * mt, r, q), c1 = mm_img(WT, KsT, 32 * ks + 16, 16 * mt, r, q);
            v4u oc; oc.x = cvtpk_c(-c0[0], -c0[1]); oc.y = cvtpk_c(-c0[2], -c0[3]); oc.z = cvtpk_c(-c1[0], -c1[1]); oc.w = cvtpk_c(-c1[2], -c1[3]);
            *(v4u*)(out + 8192 + (mt * 2 + ks) * 1024 + ln * 16) = oc; }
#pragma unroll
        for (int nt = 0; nt < 4; ++nt) { const f32x4 rr = mm_img(Aq, UT, 16 * mt, 16 * nt, r, q), bb = mm_img(KsT, UT, 16 * mt, 16 * nt, r, q);
            v2u o; o.x = cvtpk_c(rr[0], rr[1]); o.y = cvtpk_c(rr[2], rr[3]); *(v2u*)(out + 16384 + (mt * 4 + nt) * 512 + ln * 8) = o;
            v2u ob; ob.x = cvtpk_c(bb[0], bb[1]); ob.y = cvtpk_c(bb[2], bb[3]); *(v2u*)(out + 24576 + (mt * 4 + nt) * 512 + ln * 8) = ob; }
    }
    __syncthreads();
#ifdef DBG_DN
    { unsigned char* out = F.ws + WS_DNP + ((((size_t)b * NCHUNK + n) * 4 + h) * 2) * 32768;
      if (DBG_DN < 14) { const LAS bf16* im = (const LAS bf16*)(F.lds + DBG_DN * IMG);
          for (int e = tid; e < 4096; e += NTHR) ((bf16*)out)[e] = im[(e >> 6) * RS + (e & 63)]; }
      else { for (int e = tid; e < 2304; e += NTHR) ((bf16*)out)[e] = (bf16)f2bf(Gs[e]); for (int e = 2304 + tid; e < 4096; e += NTHR) ((bf16*)out)[e] = 0; } }
    __syncthreads();
#endif
#undef DIMG
}

__device__ __forceinline__ void pool_unit(Frame& F, const Args& A, int l, int blk, int g) {
    LAS float* Uw = (LAS float*)F.lds;
    LAS float* Mm = Uw + 80 * DP;
    LAS float* PW = Mm + 64 * DP;
    const bf16* P = (const bf16*)(F.ws + WS_PROJ); bf16* PO = (bf16*)(F.ws + WS_POOLO);
    const int tid = pg8::tid_from(F.wid_s);
    const int row0 = blk * 64, b = row0 / RPB, j0 = row0 - b * RPB; const bool isctx = j0 < CTXL;
    const int seq_lo = isctx ? b * RPB : b * RPB + CTXL, L = isctx ? CTXL : SEQ; const int pos0 = row0 - seq_lo;
    for (int idx = tid; idx < 640; idx += NTHR) { const int rr = idx >> 3, c8 = (idx & 7) * 8; const int pos = pos0 - 8 + rr;
        float v[8] = {0, 0, 0, 0, 0, 0, 0, 0};
        if (pos >= 0 && pos < L) { const v4u x = *(const v4u*)(P + (size_t)(seq_lo + pos) * PLD + PC_POOL + g * 64 + c8);
            v[0] = bf_lo(x.x); v[1] = bf_hi(x.x); v[2] = bf_lo(x.y); v[3] = bf_hi(x.y); v[4] = bf_lo(x.z); v[5] = bf_hi(x.z); v[6] = bf_lo(x.w); v[7] = bf_hi(x.w); }
#pragma unroll
        for (int i = 0; i < 8; ++i) Uw[rr * DP + c8 + i] = v[i]; }
    { const float* pw = A.in[F.zz + 15] + ((size_t)l * 4 + g) * 4096;
#pragma unroll
      for (int k = 0; k < 8; ++k) { const int e = tid + 512 * k; PW[(e >> 6) * DP + (e & 63)] = pw[e]; } }
    __syncthreads();
    const int win = 2 << g;
#pragma unroll 1
    for (int k = 0; k < 8; ++k) { const int e = tid + 512 * k, t = e >> 6, i = e & 63; const int pos = pos0 + t;
        int lo = pos - win / 2, hi = lo + win; lo = lo < 0 ? 0 : lo; hi = hi > L ? L : hi;
        float s = 0.f;
#pragma unroll 4
        for (int p = lo; p < hi; ++p) s += Uw[(p - pos0 + 8) * DP + i];
        Mm[t * DP + i] = s / (float)(hi - lo) - Uw[(t + 8) * DP + i]; }
    __syncthreads();
    const float* psc = A.in[F.zz + 16] + l * 256 + g * 64;
    { const int wv = tid >> 6, ln = tid & 63, r = ln & 15, q = ln >> 4;
#pragma unroll
      for (int i = 0; i < 2; ++i) { const int tile = wv * 2 + i, m0 = (tile >> 2) * 16, n0 = (tile & 3) * 16;
          const f32x4 y = mm_tile(Mm, DP, 1, PW, DP, 1, m0, n0, ln); const float sc = psc[n0 + r];
#pragma unroll
          for (int gg = 0; gg < 4; ++gg) PO[(size_t)(row0 + m0 + 4 * q + gg) * 256 + g * 64 + n0 + r] = (bf16)f2bf(y[gg] * sc); } }
    __syncthreads();
}

constexpr int SC_SLOT = 32768, SC_NSLOT = 4, SC_ST = SC_SLOT * SC_NSLOT, SC_GL = SC_ST + 2 * 8192;
__device__ __forceinline__ void dn_scan_item(Frame& F, int item) {
    typedef short s16x8v __attribute__((ext_vector_type(8)));
    const int d = item & 1, h = (item >> 1) & 3, b = item >> 3;
    const int tid = pg8::tid_from(F.wid_s);
    const int wv = __builtin_amdgcn_readfirstlane(tid >> 6), ln = tid & 63, r = ln & 15, q = ln >> 4;
    LAS unsigned char* L = F.lds;
    LAS float* glv = (LAS float*)(L + SC_GL);
    const unsigned char* dnp = F.ws + WS_DNP;
#define SC_N(st) (d == 0 ? (st) : ((st) < 4 ? 3 - (st) : 71 - (st)))
#define SC_PROB(st) ((((size_t)b * NCHUNK + SC_N(st)) * 4 + h) * 2 + d)
    if (tid < NCHUNK) glv[tid] = ((const float*)(F.ws + WS_DNG))[SC_PROB(tid)];
    for (int e = tid; e < 2 * 8192 / 16; e += NTHR) ((LAS v4u*)(L + SC_ST))[e] = (v4u){0u, 0u, 0u, 0u};
    asm volatile("s_waitcnt vmcnt(0) lgkmcnt(0)" ::: "memory"); __builtin_amdgcn_s_barrier();
#define SC_DMA(st, slot) do { const unsigned char* src_ = dnp + SC_PROB(st) * 32768 + wv * 8192 + ln * 16; \
        _Pragma("unroll") for (int i_ = 0; i_ < 8; ++i_) __builtin_amdgcn_global_load_lds((const unsigned*)(src_ + i_ * 1024), (LAS unsigned*)(L + (slot) * SC_SLOT + wv * 8192 + i_ * 1024), 16, 0, 0); } while (0)
    if (wv < 4) { SC_DMA(0, 0); SC_DMA(1, 1); SC_DMA(2, 2); }
    f32x4 s0 = {0.f, 0.f, 0.f, 0.f}, s1 = s0, s2 = s0, s3 = s0;
    bf16* DNO = (bf16*)(F.ws + WS_DNO) + (size_t)d * MROWS * 256;
#pragma unroll 1
    for (int st = 0; st < NCHUNK; ++st) {
        if (wv < 4) asm volatile("s_waitcnt vmcnt(16)" ::: "memory");
        asm volatile("s_waitcnt lgkmcnt(0)" ::: "memory"); __builtin_amdgcn_s_barrier();
        if (wv < 4) { const int nx = st + 3 < NCHUNK ? st + 3 : NCHUNK - 1; SC_DMA(nx, (st + 3) & 3); }
        const LAS unsigned char* slot = L + (st & 3) * SC_SLOT;
        const LAS unsigned char* stc = L + SC_ST + (st & 1) * 8192; LAS unsigned char* stn = L + SC_ST + ((st + 1) & 1) * 8192;
        const int nt = wv & 3;
        const s16x8v bf0 = *(const LAS s16x8v*)(stc + (nt * 2 + 0) * 1024 + ln * 16), bf1 = *(const LAS s16x8v*)(stc + (nt * 2 + 1) * 1024 + ln * 16);
        if (wv < 4) {
            const float gl = glv[st];
            const LAS unsigned char* cf = slot + 8192; const LAS unsigned char* bi = slot + 24576;
#define SC_ST_TILE(S, mt) do { const v2u bw_ = *(const LAS v2u*)(bi + ((mt) * 4 + nt) * 512 + ln * 8); \
            f32x4 a_ = {gl * S[0] + bf_lo(bw_.x), gl * S[1] + bf_hi(bw_.x), gl * S[2] + bf_lo(bw_.y), gl * S[3] + bf_hi(bw_.y)}; \
            a_ = __builtin_amdgcn_mfma_f32_16x16x32_bf16(*(const LAS s16x8v*)(cf + ((mt) * 2 + 0) * 1024 + ln * 16), bf0, a_, 0, 0, 0); \
            a_ = __builtin_amdgcn_mfma_f32_16x16x32_bf16(*(const LAS s16x8v*)(cf + ((mt) * 2 + 1) * 1024 + ln * 16), bf1, a_, 0, 0, 0); S = a_; } while (0)
            SC_ST_TILE(s0, 0); SC_ST_TILE(s1, 1); SC_ST_TILE(s2, 2); SC_ST_TILE(s3, 3);
#undef SC_ST_TILE
            v4u w0, w1; w0.x = pk2(s0[0], s0[1]); w0.y = pk2(s0[2], s0[3]); w0.z = pk2(s1[0], s1[1]); w0.w = pk2(s1[2], s1[3]);
            w1.x = pk2(s2[0], s2[1]); w1.y = pk2(s2[2], s2[3]); w1.z = pk2(s3[0], s3[1]); w1.w = pk2(s3[2], s3[3]);
            *(LAS v4u*)(stn + (nt * 2 + 0) * 1024 + ln * 16) = w0; *(LAS v4u*)(stn + (nt * 2 + 1) * 1024 + ln * 16) = w1;
        } else {
            const LAS unsigned char* pf = slot; const LAS unsigned char* ri = slot + 16384;
            const int n = SC_N(st);
            bf16* orow = DNO + (size_t)(b * RPB + n * 64 + 4 * q) * 256 + h * 64 + nt * 16 + r;
#pragma unroll
            for (int mt = 0; mt < 4; ++mt) { const v2u rw_ = *(const LAS v2u*)(ri + (mt * 4 + nt) * 512 + ln * 8);
                f32x4 a_ = {bf_lo(rw_.x), bf_hi(rw_.x), bf_lo(rw_.y), bf_hi(rw_.y)};
                a_ = __builtin_amdgcn_mfma_f32_16x16x32_bf16(*(const LAS s16x8v*)(pf + (mt * 2 + 0) * 1024 + ln * 16), bf0, a_, 0, 0, 0);
                a_ = __builtin_amdgcn_mfma_f32_16x16x32_bf16(*(const LAS s16x8v*)(pf + (mt * 2 + 1) * 1024 + ln * 16), bf1, a_, 0, 0, 0);
#pragma unroll
                for (int g = 0; g < 4; ++g) orow[(size_t)(16 * mt + g) * 256] = (bf16)f2bf(a_[g]); }
        }
    }
    asm volatile("s_waitcnt vmcnt(0) lgkmcnt(0)" ::: "memory"); __builtin_amdgcn_s_barrier();
#undef SC_DMA
#undef SC_N
#undef SC_PROB
}

__device__ __forceinline__ void mix_build(Frame& F, const Args& A, int l) {
    const int lane = pg8::lane_id_asm(); const int gw = F.vcu * NWAVES + F.wave, NGW = F.G * NWAVES;
    const bf16* ATTO = (const bf16*)(F.ws + WS_ATTO); const bf16* P = (const bf16*)(F.ws + WS_PROJ); const bf16* DNO = (const bf16*)(F.ws + WS_DNO); bf16* MIX = (bf16*)(F.ws + WS_MIX);
    const float lam = ((const float*)(F.ws + WS_LAM))[l]; const float li = 0.8f - 0.6f * expf(-0.3f * (float)l);
    const float* sg = A.in[F.zz + 10] + l * 128; const float* ng = A.in[F.zz + 14] + l * 64;
    for (int R = gw; R < MROWS; R += NGW) {
        const int j = R % RPB; if (l == 1 && j < CTXL) continue;
        { const int hh = lane >> 4, e0 = (lane & 15) * 8;
          const v4u a = *(const v4u*)(ATTO + (size_t)R * DM + (hh * 2) * 128 + e0), c = *(const v4u*)(ATTO + (size_t)R * DM + (hh * 2 + 1) * 128 + e0);
          float x[8] = {bf_lo(a.x) - lam * bf_lo(c.x), bf_hi(a.x) - lam * bf_hi(c.x), bf_lo(a.y) - lam * bf_lo(c.y), bf_hi(a.y) - lam * bf_hi(c.y),
                        bf_lo(a.z) - lam * bf_lo(c.z), bf_hi(a.z) - lam * bf_hi(c.z), bf_lo(a.w) - lam * bf_lo(c.w), bf_hi(a.w) - lam * bf_hi(c.w)};
          float ss = 0.f;
#pragma unroll
          for (int i = 0; i < 8; ++i) ss += x[i] * x[i];
          ss = grp16_sum(ss);
          const float sc = (1.f / sqrtf(ss * (1.f / 128.f) + EPSN)) * (1.f - li);
          const f32x4 g0 = *(const f32x4*)(sg + e0), g1 = *(const f32x4*)(sg + e0 + 4);
          v4u o; o.x = pk2(x[0] * sc * g0[0], x[1] * sc * g0[1]); o.y = pk2(x[2] * sc * g0[2], x[3] * sc * g0[3]); o.z = pk2(x[4] * sc * g1[0], x[5] * sc * g1[1]); o.w = pk2(x[6] * sc * g1[2], x[7] * sc * g1[3]);
          *(v4u*)(MIX + (size_t)R * DM + hh * 128 + e0) = o; }
        { const int c0 = lane * 4;
          const v2u a = *(const v2u*)(DNO + (size_t)R * 256 + c0), c = *(const v2u*)(DNO + ((size_t)MROWS + R) * 256 + c0), z = *(const v2u*)(P + (size_t)R * PLD + PC_DZ + c0);
          float x[4] = {bf_lo(a.x) + bf_lo(c.x), bf_hi(a.x) + bf_hi(c.x), bf_lo(a.y) + bf_lo(c.y), bf_hi(a.y) + bf_hi(c.y)};
          float ss = x[0] * x[0] + x[1] * x[1] + x[2] * x[2] + x[3] * x[3];
          ss = grp16_sum(ss);
          const float sc = 1.f / sqrtf(ss * (1.f / 64.f) + EPSN);
          const f32x4 gg = *(const f32x4*)(ng + (c0 & 63));
          v2u o; o.x = pk2(x[0] * sc * gg[0] * siluf_(bf_lo(z.x)), x[1] * sc * gg[1] * siluf_(bf_hi(z.x))); o.y = pk2(x[2] * sc * gg[2] * siluf_(bf_lo(z.y)), x[3] * sc * gg[3] * siluf_(bf_hi(z.y)));
          *(v2u*)(MIX + (size_t)R * DM + 512 + c0) = o; }
        { const v2u pz = *(const v2u*)((const bf16*)(F.ws + WS_POOLO) + (size_t)R * 256 + lane * 4); *(v2u*)(MIX + (size_t)R * DM + 768 + lane * 4) = pz; }
    }
}

#ifndef MK_N_LAUNCHES
#define MK_N_LAUNCHES 1
#endif
__device__ __forceinline__ bool in_phase(int k, int lo, int hi) { asm volatile("" : "+s"(lo), "+s"(hi)); return lo <= k && k < hi; }
__global__ void __launch_bounds__(NTHR, 2) mk_fwd(Args args) {
    extern __shared__ __attribute__((aligned(16))) unsigned char lds[];
    Frame F;
    F.lds = (LAS unsigned char*)lds;
    F.MISC = (volatile LAS unsigned*)(F.lds + MISC_OFF);
    F.wid_s = __builtin_amdgcn_readfirstlane((int)(threadIdx.x >> 6));
    F.tid = pg8::tid_from(F.wid_s); F.lane = F.tid & 63; F.wave = F.wid_s;
    F.G = gridDim.x; { const int bx = blockIdx.x; F.bx = bx; F.vcu = (F.G % 8 == 0) ? (bx % 8) * (F.G / 8) + bx / 8 : bx; }
    F.ws = args.ws; F.out = args.out; F.zz = 0;
    F.ctl = (gu32*)(args.ws + WS_CTL);
    for (int u = F.tid; u < (LDS_BYTES - MISC_OFF) / 4; u += NTHR) ((LAS unsigned*)(F.lds + MISC_OFF))[u] = 0u;
    __syncthreads();
    const int lo = args.ph_lo, hi = args.ph_hi;
    const bool use_bar = (hi - lo) > 1;
    XcdBarrier bar; bar.bar = ((unsigned*)(F.ctl + CW_BAR) + args.bar_li * XCD_BAR_WORDS); bar.x = 0; bar.st = nullptr; bar.wid = (unsigned)F.wid_s;
    if (use_bar) bar = xcd_barrier_post(((unsigned*)(F.ctl + CW_BAR) + args.bar_li * XCD_BAR_WORDS), F.MISC + 8, (unsigned)F.wid_s);
#ifndef EN_MASK
#define EN_MASK 0xFFFFFFFFu
#endif
#define IN(k) (((EN_MASK >> ((k) > 12 ? (k) - 12 : (k))) & 1u) && in_phase((k), lo, hi))
#define PB() do { GAS unsigned char* w_ = (GAS unsigned char*)args.ws; LAS unsigned char* l_ = (LAS unsigned char*)lds; int z_ = 0; asm volatile("" : "+s"(w_), "+s"(l_), "+s"(z_)); F.ws = (unsigned char*)w_; F.ctl = (gu32*)w_; F.lds = l_; F.zz = z_; { int bx_ = blockIdx.x; asm volatile("" : "+s"(bx_)); F.bx = bx_; F.vcu = (F.G % 8 == 0) ? (bx_ % 8) * (F.G / 8) + bx_ / 8 : bx_; } const int t_ = pg8::tid_from(F.wid_s); F.tid = t_; F.lane = t_ & 63; F.wave = F.wid_s; } while (0)
#ifdef DBG_DUP
#define NREP(k) ((((k) > 12 && (k) < 23) ? (k) - 12 : (k)) == DBG_DUP ? 2 : 1)
#else
#define NREP(k) 1
#endif
#define SEAMX() do { XcdBarrier bl_ = bar; { GAS unsigned* b_ = (GAS unsigned*)(args.ws + WS_CTL) + CW_BAR + args.bar_li * XCD_BAR_WORDS; unsigned x_ = bar.x; asm volatile("" : "+s"(b_), "+s"(x_)); bl_.bar = (unsigned*)b_; bl_.x = x_; } xcd_barrier(bl_); } while (0)
#define PH_BEGIN(k) if (IN(k)) { for (int rep_ = 0; rep_ < NREP(k); ++rep_) { if (rep_) SEAMX(); PB();
#define PH_END(k) } } SEAM(k);
#define SEAM(k) do { if (IN(k) && IN((k) + 1)) { XcdBarrier bl_ = bar; { GAS unsigned* b_ = (GAS unsigned*)(args.ws + WS_CTL) + CW_BAR + args.bar_li * XCD_BAR_WORDS; unsigned x_ = bar.x; asm volatile("" : "+s"(b_), "+s"(x_)); bl_.bar = (unsigned*)b_; bl_.x = x_; } xcd_barrier(bl_); } } while (0)
    char* ldsg = (char*)lds;

    PH_BEGIN(PH_PRO) p0_prologue(F, args); PH_END(PH_PRO)

#pragma unroll 1
    for (int l = 0; l < 2; ++l) {
        const int pb = 1 + 12 * l;
        const float* modl = (const float*)(F.ws + WS_MOD) + l * 5 * 6144;
        PH_BEGIN(pb + PH_N1) norm_mod_phase(F, args, l, 0, false, false, false, l == 1 ? 11 : 0, l == 0 ? 1 : 0); PH_END(pb + PH_N1)
        PH_BEGIN(pb + PH_PROJ)
            { pg8::Gemm g{(const bf16*)(F.ws + WS_U), (const bf16*)(F.ws + WS_WIN) + (size_t)l * NPB * 1024, 1024, 1024, 1024, 0, 0, F.wid_s};
              TileOrder S; S.init(MROWS / 256, NPB / 256, F.G, F.bx, 0);
              EpiProj E{(bf16*)(F.ws + WS_PROJ), (const float*)(F.ws + WS_ROPE)};
              pg8::gemm_phase<EpiProj, TileOrder, true, true>(F.lds, g, S, E); }
            { pg8::Gemm g{(const bf16*)(F.ws + WS_U8), (const bf16*)(F.ws + WS_WG8 + (size_t)l * 3072 * 1024), 512, 512, 512, E8(F8_ACT_L2), E8(F8_W13_L2), F.wid_s};
              TileOrder S; S.init(MROWS / 256, 12, F.G, F.bx, 0);
              EpiGate E{(bf16*)(F.ws + WS_PROJ)};
              pg8::gemm_phase8<EpiGate, TileOrder, true, true>(F.lds, g, S, E); }
            ab_tiles(F, args, l);
        PH_END(pb + PH_PROJ)
        PH_BEGIN(pb + PH_ATT)
            const bf16* P = (const bf16*)(F.ws + WS_PROJ); bf16* AO = (bf16*)(F.ws + WS_ATTO);
            const int nunits = 512 + (l == 0 ? 32 : 0);
#ifndef DIS_ATTN
#ifdef DBG_DUP
            for (int r2_ = 0; r2_ < (DBG_DUP == 31 ? 2 : 1); ++r2_)
#endif
#pragma unroll 1
            for (int u = F.vcu; u < nunits; u += F.G) {
                int b, hm, qrow, seq;
                if (u < 512) { b = u >> 7; hm = (u >> 4) & 7; qrow = CTXL + (u & 15) * 256; seq = RPB; }
                else { const int v = u - 512; b = v >> 3; hm = v & 7; qrow = 0; seq = CTXL; }
                const size_t r0 = (size_t)b * RPB;
                attn::attn_unit<PLD, DM>(P + (r0 + qrow) * PLD + PC_AQ + hm * 64, P + r0 * PLD + PC_AK + hm * 64, P + r0 * PLD + PC_AV + (hm >> 1) * 128,
                                           AO + (r0 + qrow) * DM + hm * 128, seq, F.lds, F.wid_s);
            }
#endif
#ifndef DIS_DNPRE
#ifdef DBG_DUP
            for (int r2_ = 0; r2_ < (DBG_DUP == 32 ? 2 : 1); ++r2_)
#endif
#pragma unroll 1
            for (int u = F.vcu; u < NB * NCHUNK * 4; u += F.G) { const int h = u & 3, n = (u >> 2) % NCHUNK, b = (u >> 2) / NCHUNK; dn_pre_unit(F, args, l, b, n, h); }
#endif
        PH_END(pb + PH_ATT)
        PH_BEGIN(pb + PH_SCAN)
#pragma unroll 1
            for (int it = F.vcu; it < 32; it += F.G) dn_scan_item(F, it);
            { const bool many = F.G > 32; const int rk = many ? F.vcu - 32 : F.vcu, nr = many ? F.G - 32 : F.G;
              if (rk >= 0) {
#pragma unroll 1
                for (int u = rk; u < (MROWS / 64) * 4; u += nr) pool_unit(F, args, l, u >> 2, u & 3);
                if (l == 0) conv_layer_weights(F, args, 1, rk * NWAVES + F.wave, nr * NWAVES);
                else moe_convert(F, args, rk * NWAVES + F.wave, nr * NWAVES); } }
        PH_END(pb + PH_SCAN)
        PH_BEGIN(pb + PH_MIXB) mix_build(F, args, l); PH_END(pb + PH_MIXB)
        if (IN(pb + PH_MRG0)) { PB();
            pg8::Gemm g{(const bf16*)(F.ws + WS_MIX), (const bf16*)(F.ws + WS_WBR) + (size_t)l * 1024 * 1024, 1024, 1024, 1024, 0, 0, F.wid_s};
            TileOrder S; S.init(l == 0 ? 68 : 64, 4, F.G, F.bx, l);
            EpiMergeF E{(bf16*)(F.ws + WS_MG), (const bf16*)(F.ws + WS_PROJ)};
            pg8::gemm_phase<EpiMergeF, TileOrder, true, true>(F.lds, g, S, E);
        } SEAM(pb + PH_MRG2);
        if (IN(pb + PH_OUT)) { PB();
            { pg8::Gemm g{(const bf16*)(F.ws + WS_MG), (const bf16*)(F.ws + WS_WOUT) + (size_t)l * 1024 * 1024, 1024, 1024, 1024, 0, 0, F.wid_s};
              TileOrder S; S.init(64, 4, F.G, F.bx, 1);
              EpiResid E{(float*)(F.ws + WS_H), modl, 2, l == 0 ? args.in[F.zz + 0] : nullptr};
              pg8::gemm_phase<EpiResid, TileOrder, true, true>(F.lds, g, S, E); }
            if (l == 0) {
              pg8::Gemm g{(const bf16*)(F.ws + WS_MG), (const bf16*)(F.ws + WS_WOUT), 256, 1024, 1024, 0, 0, F.wid_s};
              CtxSplitOrder S; S.init(4, 512, F.G, F.bx);
              EpiSlab E{(float*)(F.ws + WS_SLAB), modl, 2};
              pg8::gemm_phase<EpiSlab, CtxSplitOrder, true, true>(F.lds, g, S, E); }
        } SEAM(pb + PH_OUT);
#ifdef DENSE_F8
        PH_BEGIN(pb + PH_N2) norm_mod_phase(F, args, l, 1, l == 1, l == 1, l == 0); PH_END(pb + PH_N2)
#else
        PH_BEGIN(pb + PH_N2) if (l == 0) norm_mod_phase(F, args, 0, 1, false, false, false, 4, 2); else norm2_route_phase(F, args); PH_END(pb + PH_N2)
#endif
        if (l == 0) {
#ifdef DENSE_F8
            PH_BEGIN(PH_FUP)
                pg8::Gemm g{(const bf16*)(F.ws + WS_U), (const bf16*)(F.ws + WS_W13), 512, 512, 512, E8(F8_ACT_L2), E8(F8_W13_L2), F.wid_s};
                TileOrder S; S.init(68, 2 * FFD / 256, F.G, F.bx, 0);
                EpiSwiglu8 E{F.ws + WS_HID, FFD};
                pg8::gemm_phase8<EpiSwiglu8, TileOrder, true, true>(F.lds, g, S, E);
            PH_END(PH_FUP)
            if (IN(PH_FDN)) { PB();
                pg8::Gemm g{(const bf16*)(F.ws + WS_HID), (const bf16*)(F.ws + WS_W2), FFD / 2, FFD / 2, FFD / 2, E8(F8_ACT_L2), E8(F8_W2_L2), F.wid_s};
                TileOrder S; S.init(68, 4, F.G, F.bx, 0);
                EpiResid E{(float*)(F.ws + WS_H), modl, 5, nullptr};
                pg8::gemm_phase8<EpiResid, TileOrder, true, true>(F.lds, g, S, E);
            } SEAM(PH_FDN);
#else
            PH_BEGIN(PH_FUP)
                pg8::Gemm g{(const bf16*)(F.ws + WS_U), (const bf16*)(F.ws + WS_W13), 1024, 1024, 1024, 0, 0, F.wid_s};
                TileOrder S; S.init(68, 2 * FFD / 256, F.G, F.bx, 0);
                EpiSwiglu E{(bf16*)(F.ws + WS_HID), FFD};
                pg8::gemm_phase<EpiSwiglu, TileOrder, true, true>(F.lds, g, S, E);
            PH_END(PH_FUP)
            if (IN(PH_FDN)) { PB();
                { pg8::Gemm g{(const bf16*)(F.ws + WS_HID), (const bf16*)(F.ws + WS_W2), FFD, FFD, FFD, 0, 0, F.wid_s};
                  TileOrder S; S.init(64, 4, F.G, F.bx, 1);
                  EpiResid E{(float*)(F.ws + WS_H), modl, 5, nullptr};
                  pg8::gemm_phase<EpiResid, TileOrder, true, true>(F.lds, g, S, E); }
                { pg8::Gemm g{(const bf16*)(F.ws + WS_HID), (const bf16*)(F.ws + WS_W2), 256, FFD, FFD, 0, 0, F.wid_s};
                  CtxSplitOrder S; S.init(11, 512, F.G, F.bx);
                  EpiSlab E{(float*)(F.ws + WS_SLAB), modl, 5};
                  pg8::gemm_phase<EpiSlab, CtxSplitOrder, true, true>(F.lds, g, S, E); }
            } SEAM(PH_FDN);
#endif
        }
    }
    PH_BEGIN(PH_GATH) moe_gather(F); PH_END(PH_GATH)
#pragma unroll 1
    for (int hh = 0; hh < 1; ++hh) {
        const int p0 = PH_CV0 + 3 * hh;
        PH_BEGIN(p0 + 1)
            pg8::Gemm g{(const bf16*)(F.ws + WS_XG), (const bf16*)(F.ws + WS_W13M), 512, 512, 512, E8(F8_ACT_L2), E8(F8_W13_L2), F.wid_s};
            MoeOrder S; S.init(F.ctl + CW_ECNT, 2 * FFE / 256, F.G, F.vcu);
            EpiSwiglu8 E{F.ws + WS_HIDM, FFE};
            pg8::gemm_phase8<EpiSwiglu8, MoeOrder, true, true>(F.lds, g, S, E);
        PH_END(p0 + 1)
        if (IN(p0 + 2)) { PB();
            pg8::Gemm g{(const bf16*)(F.ws + WS_HIDM), (const bf16*)(F.ws + WS_W2M), FFE / 2, FFE / 2, FFE / 2, E8(F8_ACT_L2), E8(F8_W2_L2), F.wid_s};
            MoeOrder S; S.init(F.ctl + CW_ECNT, 4, F.G, F.vcu);
            EpiY E{(bf16*)(F.ws + WS_Y), 1};
            pg8::gemm_phase8<EpiY, MoeOrder, true, true>(F.lds, g, S, E);
        } SEAM(p0 + 2);
    }
    PH_BEGIN(PH_FIN) final_phase(F, args); } }
#ifdef DBG_STOP
    if (lo == 100) {
        const int gw = F.vcu * NWAVES + F.wave, NGW = F.G * NWAVES;
        for (int tk = gw; tk < NB * SEQ; tk += NGW) { const int b = tk / SEQ, t = tk - b * SEQ; const size_t R = (size_t)b * RPB + CTXL + t;
#if DBG_SRC == 0
            const f32x4* s = (const f32x4*)((const float*)(args.ws + WS_H) + R * DM) + F.lane; f32x4* d = (f32x4*)(args.out + (size_t)tk * DM) + F.lane;
            for (int q = 0; q < 4; ++q) d[64 * q] = s[64 * q];
#elif DBG_SRC == 2
            MoeOrder mo; mo.init((gu32*)args.ws + CW_ECNT, 1, 1, 0); const v4u rt = ((const v4u*)(args.ws + WS_ROUTE))[2 * tk];
            const size_t rr = (size_t)mo.tile_off((int)rt.x) * 256 + rt.z; (void)R;
            const bf16* s = (const bf16*)(args.ws + DBG_OFF) + rr * DBG_LD + DBG_COL; float* d = args.out + (size_t)tk * DM;
            for (int q = 0; q < 16; ++q) d[F.lane + 64 * q] = bf2f(s[F.lane + 64 * q]);
#else
#ifdef DBG_MOD
            const bf16* s = (const bf16*)(args.ws + DBG_OFF) + (R % DBG_MOD) * DBG_LD + DBG_COL; float* d = args.out + (size_t)tk * DM;
#else
            const bf16* s = (const bf16*)(args.ws + DBG_OFF) + R * DBG_LD + DBG_COL; float* d = args.out + (size_t)tk * DM;
#endif
            for (int q = 0; q < 16; ++q) { float v = bf2f(s[F.lane + 64 * q]); d[F.lane + 64 * q] = (v == v && fabsf(v) < 1e30f) ? v : DBG_NANVAL; }
#endif
        }
    }
#endif
#undef IN
#undef SEAM
}

extern "C" void kernel_launch(void* const* d_in, const int* in_sizes, int n_in, void* d_out, int out_size, void* d_ws, size_t ws_size, hipStream_t stream) {
    static int grid = 0;
    if (grid == 0) {
        if (n_in != 27 || in_sizes[0] != NB * SEQ * DM || out_size != NB * SEQ * DM || ws_size < WS_END) {
            fprintf(stderr, "kernel_launch: shape / workspace mismatch (n_in %d, in0 %d, out %d, ws %zu, need %zu); nothing launched\n", n_in, n_in > 0 ? in_sizes[0] : -1, out_size, ws_size, (size_t)WS_END); grid = -1; return; }
        int dev = 0, cus = 0, per_cu = 0;
        if (hipGetDevice(&dev) != hipSuccess || hipDeviceGetAttribute(&cus, hipDeviceAttributeMultiprocessorCount, dev) != hipSuccess) { grid = -1; return; }
        if (hipFuncSetAttribute((const void*)mk_fwd, hipFuncAttributeMaxDynamicSharedMemorySize, LDS_BYTES) != hipSuccess) { fprintf(stderr, "kernel_launch: hipFuncSetAttribute failed\n"); grid = -1; return; }
        if (hipOccupancyMaxActiveBlocksPerMultiprocessor(&per_cu, (const void*)mk_fwd, NTHR, LDS_BYTES) != hipSuccess || per_cu < 1)
            fprintf(stderr, "kernel_launch: note: occupancy query reports %d workgroups per CU\n", per_cu);
        (void)hipGetLastError();
        grid = cus;
    }
    if (grid < 0) return;
    if (hipMemsetAsync((char*)d_ws + WS_CTL, 0, CTL_ZERO_BYTES, stream) != hipSuccess) return;
    Args a{};
    for (int i = 0; i < 27; ++i) a.in[i] = (const float*)d_in[i];
    a.out = (float*)d_out; a.ws = (unsigned char*)d_ws;
    constexpr int NL = MK_N_LAUNCHES;
#ifdef DBG_STOP
    constexpr int NLL = DBG_STOP + 2;
#else
    constexpr int NLL = NL;
#endif
#ifdef DBG_PREFIX
    for (int li = 0; li < 2; ++li) { a.ph_lo = 0; a.ph_hi = li == 0 ? DBG_PREFIX + 1 : PH_COUNT; a.bar_li = li;
        hipLaunchKernelGGL(mk_fwd, dim3(grid), dim3(NTHR), LDS_BYTES, stream, a); }
    return;
#endif
    for (int li = 0; li < NLL; ++li) {
#ifdef DBG_SKIP_LO
        if (li >= DBG_SKIP_LO && li <= DBG_SKIP_HI) continue;
#endif
        a.ph_lo = (NL == 1) ? 0 : li; a.ph_hi = (NL == 1) ? PH_COUNT : li + 1;
#ifdef DBG_STOP
        a.ph_lo = li; a.ph_hi = li + 1;
        if (li == NLL - 1) { a.ph_lo = 100; a.ph_hi = 101; }
#endif
        hipLaunchKernelGGL(mk_fwd, dim3(grid), dim3(NTHR), LDS_BYTES, stream, a);
        const hipError_t le = hipPeekAtLastError();
        if (le != hipSuccess) { fprintf(stderr, "kernel_launch: launch %d failed: %s\n", li, hipGetErrorName(le)); break; }
    }
}
```

```cpp
#include <hip/hip_runtime.h>
#include <cstdio>
#include <cstdint>
#include <cmath>

namespace pg8 {
#define PG8_LAS __attribute__((address_space(3)))
typedef unsigned short bf16_t;
typedef short bf16x8 __attribute__((ext_vector_type(8)));
typedef float f32x4 __attribute__((ext_vector_type(4)));
typedef unsigned u32x4 __attribute__((ext_vector_type(4)));
typedef unsigned u32x2 __attribute__((ext_vector_type(2)));
constexpr int BM = 256, BK = 64, HALF = 128, HTB = HALF * BK * 2  , STAGE_BYTES = 8 * HTB;

__host__ __device__ __forceinline__ int lds_byte(int r, int c) { const int st = (r >> 4) * 2 + (c >> 5), rr = r & 15, cc = c & 31, ob = rr * 64 + cc * 2; return st * 1024 + (ob ^ (((ob >> 9) & 1) << 5)); }
__host__ __device__ __forceinline__ void stage_rc(int b, int& R, int& C) { const int st = b / 1024, sb = b % 1024, swz = sb ^ (((sb >> 9) & 1) << 5); R = (st >> 1) * 16 + swz / 64; C = (st & 1) * 32 + (swz % 64) / 2; }
__host__ __device__ __forceinline__ int perm32(int rho) { const int n = rho >> 4, i = rho & 15; return 8 * (i >> 2) + 4 * n + (i & 3); }

__device__ __forceinline__ int lane_id_asm() { int l; asm volatile("v_mbcnt_lo_u32_b32 %0, -1, 0\n\tv_mbcnt_hi_u32_b32 %0, -1, %0" : "=v"(l)); return l; }
__device__ __forceinline__ int tid_from(int wid) { return (wid << 6) | lane_id_asm(); }
struct Unit { int pm, pn, pb, ko, aux; };
struct Gemm { const bf16_t* A; const bf16_t* Bt; int K, lda, ldb, sA, sB, wid; };

__device__ __forceinline__ unsigned cvt_pk_bf16(float lo, float hi) { unsigned r; asm volatile("v_cvt_pk_bf16_f32 %0, %1, %2" : "=v"(r) : "v"(lo), "v"(hi)); return r; }
template <class Epi, class Sched, bool ALIGN_EPI = false, bool SP2 = false>
__device__ __forceinline__ void gemm_phase(PG8_LAS unsigned char* lds, const Gemm g, const Sched& S, const Epi& E) {
    const int wid = g.wid; const int tid = tid_from(wid), lane = tid & 63, wr = wid >> 2, wc = wid & 3, fr = lane & 15, fq = lane >> 4;
    const int K = g.K, nt = K / BK;
    unsigned voffA[2], voffB[2];
#pragma unroll
    for (int i = 0; i < 2; ++i) { int R, C; stage_rc(tid * 16 + i * 8192, R, C); const int Rb = Epi::PERM ? ((R & ~31) + perm32(R & 31)) : R;
        voffA[i] = (unsigned)(R * g.lda + C) * 2u; voffB[i] = (unsigned)(Rb * g.ldb + C) * 2u; }
    const size_t kstep = (size_t)(BK * 2);
    const size_t hstepA = (size_t)HALF * g.lda * 2, hstepB = (size_t)HALF * g.ldb * 2;
    const size_t tstepA = 2 * hstepA, tstepB = 2 * hstepB;
    const unsigned ldsw = (unsigned)wid * 1024u;
    const int aoff = lds_byte(wr * 64 + fr, fq * 8), boff = lds_byte(wc * 32 + fr, fq * 8);
#define PG8_SA(b, h) (((b) * 2 + (h)) * HTB)
#define PG8_SB(b, h) ((4 + (b) * 2 + (h)) * HTB)
#define PG8_STAGE(bufoff, gbase, voff) do { _Pragma("unroll") for (int _i = 0; _i < 2; ++_i) \
        __builtin_amdgcn_global_load_lds((const unsigned*)((const char*)(gbase) + (voff)[_i]), (PG8_LAS unsigned*)(lds + (bufoff) + ldsw + _i * 8192), 16, 0, 0); } while (0)
#define PG8_LDA(dst, b, h) do { _Pragma("unroll") for (int m = 0; m < 4; ++m) _Pragma("unroll") for (int k = 0; k < 2; ++k) dst[m][k] = *(const PG8_LAS bf16x8*)(lds + PG8_SA(b, h) + aoff + m * 2048 + k * 1024); } while (0)
#define PG8_LDB(dst, b, h) do { _Pragma("unroll") for (int n = 0; n < 2; ++n) _Pragma("unroll") for (int k = 0; k < 2; ++k) dst[n][k] = *(const PG8_LAS bf16x8*)(lds + PG8_SB(b, h) + boff + n * 2048 + k * 1024); } while (0)
#define PG8_MMA(ai, bj, At, Bt) do { __builtin_amdgcn_s_setprio(1); _Pragma("unroll") for (int m = 0; m < 4; ++m) _Pragma("unroll") for (int n = 0; n < 2; ++n) _Pragma("unroll") for (int k = 0; k < 2; ++k) \
        acc[ai][bj][m][n] = __builtin_amdgcn_mfma_f32_16x16x32_bf16(Bt[n][k], At[m][k], acc[ai][bj][m][n], 0, 0, 0); __builtin_amdgcn_s_setprio(0); } while (0)
#define PG8_WAIT_V(n) asm volatile("s_waitcnt vmcnt(" #n ")" ::: "memory")
#define PG8_WAIT_L(n) asm volatile("s_waitcnt lgkmcnt(" #n ")" ::: "memory")
#define PG8_BAR __builtin_amdgcn_s_barrier()
#define PG8_SCHED __builtin_amdgcn_sched_barrier(0)
    Unit cur, nxt; int ui = 0;
    if (!S.next(0, cur)) return;
    f32x4 acc[2][2][4][2];
#pragma unroll
    for (int a = 0; a < 2; ++a)
#pragma unroll
        for (int b = 0; b < 2; ++b)
#pragma unroll
            for (int m = 0; m < 4; ++m)
#pragma unroll
                for (int n = 0; n < 2; ++n) acc[a][b][m][n] = (f32x4){0.f, 0.f, 0.f, 0.f};
    bf16x8 At[4][2], B0[2][2], B1[2][2];
    const char* cA = (const char*)g.A + (size_t)cur.pm * tstepA + cur.ko; const char* cB = (const char*)g.Bt + (size_t)cur.pb * tstepB + cur.ko;
    S.a_ready(cur);
    if constexpr (SP2) {
        PG8_STAGE(PG8_SB(0, 0), cB, voffB); PG8_STAGE(PG8_SB(0, 1), cB + hstepB, voffB); PG8_STAGE(PG8_SA(0, 0), cA, voffA); PG8_STAGE(PG8_SA(0, 1), cA + hstepA, voffA);
        if (wr == 1) PG8_BAR;
        PG8_WAIT_V(2); PG8_BAR;
        PG8_STAGE(PG8_SB(1, 0), cB + kstep, voffB); PG8_STAGE(PG8_SA(1, 0), cA + kstep, voffA); PG8_STAGE(PG8_SB(1, 1), cB + hstepB + kstep, voffB);
        PG8_WAIT_V(6); PG8_BAR;
    } else {
        PG8_STAGE(PG8_SB(0, 0), cB, voffB); PG8_STAGE(PG8_SA(0, 0), cA, voffA); PG8_STAGE(PG8_SB(0, 1), cB + hstepB, voffB); PG8_STAGE(PG8_SA(0, 1), cA + hstepA, voffA);
        if (wr == 1) PG8_BAR;
        PG8_WAIT_V(4); PG8_BAR;
        PG8_STAGE(PG8_SB(1, 0), cB + kstep, voffB); PG8_STAGE(PG8_SA(1, 0), cA + kstep, voffA); PG8_STAGE(PG8_SB(1, 1), cB + hstepB + kstep, voffB);
        PG8_WAIT_V(6); PG8_BAR;
    }
    for (;;) {
        const bool has_next = S.next(ui + 1, nxt);
        const char* nA = has_next ? (const char*)g.A + (size_t)nxt.pm * tstepA + nxt.ko : cA; const char* nB = has_next ? (const char*)g.Bt + (size_t)nxt.pb * tstepB + nxt.ko : cB;
        for (int t = 0; t < nt; t += 2) {
            if constexpr (Epi::KHOOK) { if (t == 8 || t == 12) E.khook(acc, cur, t, wr, wc, fr, fq); }
            const bool last = (t == nt - 2);
            const char* a1 = cA + (size_t)(t + 1) * kstep;
            const char* a2 = last ? nA : cA + (size_t)(t + 2) * kstep; const char* b2 = last ? nB : cB + (size_t)(t + 2) * kstep;
            const char* a3 = a2 + kstep; const char* b3 = b2 + kstep;
            if (last && has_next) S.a_ready(nxt);
            if constexpr (SP2) {
            PG8_LDB(B0, 0, 0); PG8_LDB(B1, 0, 1); PG8_SCHED; PG8_LDA(At, 0, 0); PG8_STAGE(PG8_SA(1, 1), a1 + hstepA, voffA);
            PG8_WAIT_V(8); PG8_WAIT_L(0); PG8_BAR; PG8_MMA(0, 0, At, B0); PG8_MMA(0, 1, At, B1); PG8_BAR; PG8_SCHED;
            PG8_LDA(At, 0, 1); PG8_STAGE(PG8_SB(0, 0), b2, voffB); PG8_STAGE(PG8_SB(0, 1), b2 + hstepB, voffB); PG8_STAGE(PG8_SA(0, 0), a2, voffA);
            PG8_WAIT_V(8); PG8_WAIT_L(0); PG8_BAR; PG8_MMA(1, 0, At, B0); PG8_MMA(1, 1, At, B1); PG8_BAR; PG8_SCHED;
            PG8_LDB(B0, 1, 0); PG8_LDB(B1, 1, 1); PG8_SCHED; PG8_LDA(At, 1, 0); PG8_STAGE(PG8_SA(0, 1), a2 + hstepA, voffA);
            PG8_WAIT_V(8); PG8_WAIT_L(0); PG8_BAR; PG8_MMA(0, 0, At, B0); PG8_MMA(0, 1, At, B1); PG8_BAR; PG8_SCHED;
            PG8_LDA(At, 1, 1); PG8_STAGE(PG8_SB(1, 0), b3, voffB); PG8_STAGE(PG8_SB(1, 1), b3 + hstepB, voffB); PG8_STAGE(PG8_SA(1, 0), a3, voffA);
            PG8_WAIT_V(8); PG8_WAIT_L(0); PG8_BAR; PG8_MMA(1, 0, At, B0); PG8_MMA(1, 1, At, B1); PG8_BAR; PG8_SCHED;
            } else {
            PG8_LDB(B0, 0, 0); PG8_SCHED; PG8_LDA(At, 0, 0); PG8_STAGE(PG8_SA(1, 1), a1 + hstepA, voffA);
            PG8_WAIT_L(8); PG8_BAR; PG8_WAIT_L(0); PG8_MMA(0, 0, At, B0); PG8_BAR; PG8_SCHED;
            PG8_LDB(B1, 0, 1); PG8_STAGE(PG8_SB(0, 0), b2, voffB);
            PG8_BAR; PG8_WAIT_L(0); PG8_MMA(0, 1, At, B1); PG8_BAR;
            PG8_LDA(At, 0, 1); PG8_STAGE(PG8_SA(0, 0), a2, voffA);
            PG8_BAR; PG8_WAIT_L(0); PG8_MMA(1, 0, At, B0); PG8_BAR; PG8_SCHED;
            PG8_STAGE(PG8_SB(0, 1), b2 + hstepB, voffB);
            PG8_WAIT_V(6); PG8_BAR; PG8_MMA(1, 1, At, B1); PG8_BAR;
            PG8_LDB(B0, 1, 0); PG8_SCHED; PG8_LDA(At, 1, 0); PG8_STAGE(PG8_SA(0, 1), a2 + hstepA, voffA);
            PG8_WAIT_L(8); PG8_BAR; PG8_WAIT_L(0); PG8_MMA(0, 0, At, B0); PG8_BAR; PG8_SCHED;
            PG8_LDB(B1, 1, 1); PG8_STAGE(PG8_SB(1, 0), b3, voffB);
            PG8_BAR; PG8_WAIT_L(0); PG8_MMA(0, 1, At, B1); PG8_BAR;
            PG8_LDA(At, 1, 1); PG8_STAGE(PG8_SA(1, 0), a3, voffA);
            PG8_BAR; PG8_WAIT_L(0); PG8_MMA(1, 0, At, B0); PG8_BAR; PG8_SCHED;
            PG8_STAGE(PG8_SB(1, 1), b3 + hstepB, voffB);
            PG8_WAIT_V(6); PG8_BAR; PG8_MMA(1, 1, At, B1); PG8_BAR;
            }
        }
        if constexpr (ALIGN_EPI) { if (wr == 0) PG8_BAR; }
        if constexpr (!Epi::AFTER_DRAIN) { E(acc, cur, wr, wc, fr, fq); S.done(cur); }
        if (!has_next) break;
#pragma unroll
        for (int a = 0; a < 2; ++a)
#pragma unroll
            for (int b = 0; b < 2; ++b)
#pragma unroll
                for (int m = 0; m < 4; ++m)
#pragma unroll
                    for (int n = 0; n < 2; ++n) acc[a][b][m][n] = (f32x4){0.f, 0.f, 0.f, 0.f};
        cur = nxt; cA = nA; cB = nB; ++ui;
        if constexpr (ALIGN_EPI) { if (wr == 1) PG8_BAR; }
    }
    PG8_WAIT_V(0);
    if constexpr (!ALIGN_EPI) { if (wr == 0) PG8_BAR; }
    PG8_BAR;
    if constexpr (Epi::AFTER_DRAIN) { E.fused(acc, cur, wr, wc, fr, fq, lds, wid, lane); S.done(cur); }
#undef PG8_SA
#undef PG8_SB
#undef PG8_STAGE
#undef PG8_LDA
#undef PG8_LDB
#undef PG8_MMA
#undef PG8_WAIT_V
#undef PG8_WAIT_L
#undef PG8_BAR
#undef PG8_SCHED
}
template <class Epi, class Sched, bool ALIGN_EPI = false, bool SP2 = false>
__device__ __forceinline__ void gemm_phase8(PG8_LAS unsigned char* lds, const Gemm g, const Sched& S, const Epi& E) {
    const int wid = g.wid; const int tid = tid_from(wid), lane = tid & 63, wr = wid >> 2, wc = wid & 3, fr = lane & 15, fq = lane >> 4;
    const int K = g.K, nt = K / BK;
    unsigned voffA[2], voffB[2];
#pragma unroll
    for (int i = 0; i < 2; ++i) { int R, C; stage_rc(tid * 16 + i * 8192, R, C); const int Rb = Epi::PERM ? ((R & ~31) + perm32(R & 31)) : R;
        voffA[i] = (unsigned)(R * g.lda + C) * 2u; voffB[i] = (unsigned)(Rb * g.ldb + C) * 2u; }
    const size_t kstep = (size_t)(BK * 2);
    const size_t hstepA = (size_t)HALF * g.lda * 2, hstepB = (size_t)HALF * g.ldb * 2;
    const size_t tstepA = 2 * hstepA, tstepB = 2 * hstepB;
    const unsigned ldsw = (unsigned)wid * 1024u;
    const int c8 = (fq >> 1) * 32 + (fq & 1) * 16;
    const int aoff0 = lds_byte(wr * 64 + fr, c8), aoff1 = lds_byte(wr * 64 + fr, c8 + 8), boff0 = lds_byte(wc * 32 + fr, c8), boff1 = lds_byte(wc * 32 + fr, c8 + 8);
#define PG8_SA(b, h) (((b) * 2 + (h)) * HTB)
#define PG8_SB(b, h) ((4 + (b) * 2 + (h)) * HTB)
#define PG8_STAGE(bufoff, gbase, voff) do { _Pragma("unroll") for (int _i = 0; _i < 2; ++_i) \
        __builtin_amdgcn_global_load_lds((const unsigned*)((const char*)(gbase) + (voff)[_i]), (PG8_LAS unsigned*)(lds + (bufoff) + ldsw + _i * 8192), 16, 0, 0); } while (0)
#define PG8_LDA(dst, b, h) do { _Pragma("unroll") for (int m = 0; m < 4; ++m) { const u32x4 lo_ = *(const PG8_LAS u32x4*)(lds + PG8_SA(b, h) + aoff0 + m * 2048), hi_ = *(const PG8_LAS u32x4*)(lds + PG8_SA(b, h) + aoff1 + m * 2048); \
        dst[m] = (i32x8){(int)lo_.x, (int)lo_.y, (int)lo_.z, (int)lo_.w, (int)hi_.x, (int)hi_.y, (int)hi_.z, (int)hi_.w}; } } while (0)
#define PG8_LDB(dst, b, h) do { _Pragma("unroll") for (int n = 0; n < 2; ++n) { const u32x4 lo_ = *(const PG8_LAS u32x4*)(lds + PG8_SB(b, h) + boff0 + n * 2048), hi_ = *(const PG8_LAS u32x4*)(lds + PG8_SB(b, h) + boff1 + n * 2048); \
        dst[n] = (i32x8){(int)lo_.x, (int)lo_.y, (int)lo_.z, (int)lo_.w, (int)hi_.x, (int)hi_.y, (int)hi_.z, (int)hi_.w}; } } while (0)
#define PG8_MMA(ai, bj, At, Bt) do { __builtin_amdgcn_s_setprio(1); _Pragma("unroll") for (int m = 0; m < 4; ++m) _Pragma("unroll") for (int n = 0; n < 2; ++n) \
        asm volatile("v_mfma_scale_f32_16x16x128_f8f6f4 %0, %1, %2, %0, %3, %4 op_sel_hi:[0,0,0]" : "+v"(acc[ai][bj][m][n]) : "v"(Bt[n]), "v"(At[m]), "v"(vsB), "v"(vsA)); __builtin_amdgcn_s_setprio(0); } while (0)
#define PG8_WAIT_V(n) asm volatile("s_waitcnt vmcnt(" #n ")" ::: "memory")
#define PG8_WAIT_L(n) asm volatile("s_waitcnt lgkmcnt(" #n ")" ::: "memory")
#define PG8_BAR __builtin_amdgcn_s_barrier()
#define PG8_SCHED __builtin_amdgcn_sched_barrier(0)
    Unit cur, nxt; int ui = 0;
    if (!S.next(0, cur)) return;
    f32x4 acc[2][2][4][2];
#pragma unroll
    for (int a = 0; a < 2; ++a)
#pragma unroll
        for (int b = 0; b < 2; ++b)
#pragma unroll
            for (int m = 0; m < 4; ++m)
#pragma unroll
                for (int n = 0; n < 2; ++n) acc[a][b][m][n] = (f32x4){0.f, 0.f, 0.f, 0.f};
    typedef int i32x8 __attribute__((ext_vector_type(8)));
    i32x8 At[4], B0[2], B1[2];
    int vsA = g.sA, vsB = g.sB; asm volatile("" : "+v"(vsA), "+v"(vsB));
    const char* cA = (const char*)g.A + (size_t)cur.pm * tstepA + cur.ko; const char* cB = (const char*)g.Bt + (size_t)cur.pb * tstepB + cur.ko;
    S.a_ready(cur);
    if constexpr (SP2) {
        PG8_STAGE(PG8_SB(0, 0), cB, voffB); PG8_STAGE(PG8_SB(0, 1), cB + hstepB, voffB); PG8_STAGE(PG8_SA(0, 0), cA, voffA); PG8_STAGE(PG8_SA(0, 1), cA + hstepA, voffA);
        if (wr == 1) PG8_BAR;
        PG8_WAIT_V(2); PG8_BAR;
        PG8_STAGE(PG8_SB(1, 0), cB + kstep, voffB); PG8_STAGE(PG8_SA(1, 0), cA + kstep, voffA); PG8_STAGE(PG8_SB(1, 1), cB + hstepB + kstep, voffB);
        PG8_WAIT_V(6); PG8_BAR;
    } else {
        PG8_STAGE(PG8_SB(0, 0), cB, voffB); PG8_STAGE(PG8_SA(0, 0), cA, voffA); PG8_STAGE(PG8_SB(0, 1), cB + hstepB, voffB); PG8_STAGE(PG8_SA(0, 1), cA + hstepA, voffA);
        if (wr == 1) PG8_BAR;
        PG8_WAIT_V(4); PG8_BAR;
        PG8_STAGE(PG8_SB(1, 0), cB + kstep, voffB); PG8_STAGE(PG8_SA(1, 0), cA + kstep, voffA); PG8_STAGE(PG8_SB(1, 1), cB + hstepB + kstep, voffB);
        PG8_WAIT_V(6); PG8_BAR;
    }
    for (;;) {
        const bool has_next = S.next(ui + 1, nxt);
        const char* nA = has_next ? (const char*)g.A + (size_t)nxt.pm * tstepA + nxt.ko : cA; const char* nB = has_next ? (const char*)g.Bt + (size_t)nxt.pb * tstepB + nxt.ko : cB;
        for (int t = 0; t < nt; t += 2) {
            const bool last = (t == nt - 2);
            const char* a1 = cA + (size_t)(t + 1) * kstep;
            const char* a2 = last ? nA : cA + (size_t)(t + 2) * kstep; const char* b2 = last ? nB : cB + (size_t)(t + 2) * kstep;
            const char* a3 = a2 + kstep; const char* b3 = b2 + kstep;
            if (last && has_next) S.a_ready(nxt);
            if constexpr (SP2) {
            PG8_LDB(B0, 0, 0); PG8_LDB(B1, 0, 1); PG8_SCHED; PG8_LDA(At, 0, 0); PG8_STAGE(PG8_SA(1, 1), a1 + hstepA, voffA);
            PG8_WAIT_V(8); PG8_WAIT_L(0); PG8_BAR; PG8_MMA(0, 0, At, B0); PG8_MMA(0, 1, At, B1); PG8_BAR; PG8_SCHED;
            PG8_LDA(At, 0, 1); PG8_STAGE(PG8_SB(0, 0), b2, voffB); PG8_STAGE(PG8_SB(0, 1), b2 + hstepB, voffB); PG8_STAGE(PG8_SA(0, 0), a2, voffA);
            PG8_WAIT_V(8); PG8_WAIT_L(0); PG8_BAR; PG8_MMA(1, 0, At, B0); PG8_MMA(1, 1, At, B1); PG8_BAR; PG8_SCHED;
            PG8_LDB(B0, 1, 0); PG8_LDB(B1, 1, 1); PG8_SCHED; PG8_LDA(At, 1, 0); PG8_STAGE(PG8_SA(0, 1), a2 + hstepA, voffA);
            PG8_WAIT_V(8); PG8_WAIT_L(0); PG8_BAR; PG8_MMA(0, 0, At, B0); PG8_MMA(0, 1, At, B1); PG8_BAR; PG8_SCHED;
            PG8_LDA(At, 1, 1); PG8_STAGE(PG8_SB(1, 0), b3, voffB); PG8_STAGE(PG8_SB(1, 1), b3 + hstepB, voffB); PG8_STAGE(PG8_SA(1, 0), a3, voffA);
            PG8_WAIT_V(8); PG8_WAIT_L(0); PG8_BAR; PG8_MMA(1, 0, At, B0); PG8_MMA(1, 1, At, B1); PG8_BAR; PG8_SCHED;
            } else {
            PG8_LDB(B0, 0, 0); PG8_SCHED; PG8_LDA(At, 0, 0); PG8_STAGE(PG8_SA(1, 1), a1 + hstepA, voffA);
            PG8_WAIT_L(8); PG8_BAR; PG8_WAIT_L(0); PG8_MMA(0, 0, At, B0); PG8_BAR; PG8_SCHED;
            PG8_LDB(B1, 0, 1); PG8_STAGE(PG8_SB(0, 0), b2, voffB);
            PG8_BAR; PG8_WAIT_L(0); PG8_MMA(0, 1, At, B1); PG8_BAR;
            PG8_LDA(At, 0, 1); PG8_STAGE(PG8_SA(0, 0), a2, voffA);
            PG8_BAR; PG8_WAIT_L(0); PG8_MMA(1, 0, At, B0); PG8_BAR; PG8_SCHED;
            PG8_STAGE(PG8_SB(0, 1), b2 + hstepB, voffB);
            PG8_WAIT_V(6); PG8_BAR; PG8_MMA(1, 1, At, B1); PG8_BAR;
            PG8_LDB(B0, 1, 0); PG8_SCHED; PG8_LDA(At, 1, 0); PG8_STAGE(PG8_SA(0, 1), a2 + hstepA, voffA);
            PG8_WAIT_L(8); PG8_BAR; PG8_WAIT_L(0); PG8_MMA(0, 0, At, B0); PG8_BAR; PG8_SCHED;
            PG8_LDB(B1, 1, 1); PG8_STAGE(PG8_SB(1, 0), b3, voffB);
            PG8_BAR; PG8_WAIT_L(0); PG8_MMA(0, 1, At, B1); PG8_BAR;
            PG8_LDA(At, 1, 1); PG8_STAGE(PG8_SA(1, 0), a3, voffA);
            PG8_BAR; PG8_WAIT_L(0); PG8_MMA(1, 0, At, B0); PG8_BAR; PG8_SCHED;
            PG8_STAGE(PG8_SB(1, 1), b3 + hstepB, voffB);
            PG8_WAIT_V(6); PG8_BAR; PG8_MMA(1, 1, At, B1); PG8_BAR;
            }
        }
        if constexpr (ALIGN_EPI) { if (wr == 0) PG8_BAR; }
        asm volatile("s_nop 15\n\ts_nop 15" ::: "memory");
        if constexpr (!Epi::AFTER_DRAIN) { E(acc, cur, wr, wc, fr, fq); S.done(cur); }
        if (!has_next) break;
#pragma unroll
        for (int a = 0; a < 2; ++a)
#pragma unroll
            for (int b = 0; b < 2; ++b)
#pragma unroll
                for (int m = 0; m < 4; ++m)
#pragma unroll
                    for (int n = 0; n < 2; ++n) acc[a][b][m][n] = (f32x4){0.f, 0.f, 0.f, 0.f};
        cur = nxt; cA = nA; cB = nB; ++ui;
        if constexpr (ALIGN_EPI) { if (wr == 1) PG8_BAR; }
    }
    PG8_WAIT_V(0);
    if constexpr (!ALIGN_EPI) { if (wr == 0) PG8_BAR; }
    PG8_BAR;
    if constexpr (Epi::AFTER_DRAIN) { E.fused(acc, cur, wr, wc, fr, fq, lds, wid, lane); S.done(cur); }
#undef PG8_SA
#undef PG8_SB
#undef PG8_STAGE
#undef PG8_LDA
#undef PG8_LDB
#undef PG8_MMA
#undef PG8_WAIT_V
#undef PG8_WAIT_L
#undef PG8_BAR
#undef PG8_SCHED
}
}

namespace attn {
using bf16x8 = __attribute__((ext_vector_type(8))) short;
using s16x4  = __attribute__((ext_vector_type(4))) short;
using f32x16 = __attribute__((ext_vector_type(16))) float;
using u32x4  = __attribute__((ext_vector_type(4))) unsigned;
constexpr int DV = 128, DK = 64, NW = 8, QBLK = 32, KVBLK = 64;
constexpr float SCALE = 0.125f;
constexpr float THR2 = 6.f;
constexpr float QSCALE = SCALE * 1.4426950408889634f;
#define AKSWZ(row, colB) ((row) * 128 + ((colB) ^ ((((row) >> 1) & 7) << 4)))
#define ASBAR() __builtin_amdgcn_sched_barrier(0)
__device__ __forceinline__ int crow(int r, int hi) { return (r & 3) + 8 * (r >> 2) + 4 * hi; }
__device__ __forceinline__ unsigned cvtpk(float lo, float hi) { unsigned r; asm volatile("v_cvt_pk_bf16_f32 %0, %1, %2" : "=v"(r) : "v"(lo), "v"(hi)); return r; }

__device__ __forceinline__ float rowmax32(const f32x16& p0, const f32x16& p1) {
  float pmax = p0[0];
#pragma unroll
  for (int r = 1; r < 16; ++r) pmax = fmaxf(pmax, p0[r]);
#pragma unroll
  for (int r = 0; r < 16; ++r) pmax = fmaxf(pmax, p1[r]);
  auto rr = __builtin_amdgcn_permlane32_swap(__float_as_uint(pmax), __float_as_uint(pmax), false, false);
  return fmaxf(__uint_as_float(rr[0]), __uint_as_float(rr[1]));
}
__device__ __forceinline__ void firstSM(f32x16& p0, f32x16& p1, float& m_reg, f32x16& negm) {
  const float d = rowmax32(p0, p1); m_reg = d;
#pragma unroll
  for (int r = 0; r < 16; ++r) { p0[r] = __builtin_amdgcn_exp2f(p0[r] - d); p1[r] = __builtin_amdgcn_exp2f(p1[r] - d); }
#pragma unroll
  for (int r = 0; r < 16; ++r) negm[r] = -m_reg;
  asm volatile("" : "+v"(negm));
}
__device__ __forceinline__ void moveRef(f32x16& p0, f32x16& p1, float pmax, float& m_reg, f32x16& negm, float& alpha) {
  const float d = fmaxf(pmax, 0.f); alpha = __builtin_amdgcn_exp2f(-d); m_reg += d;
#pragma unroll
  for (int r = 0; r < 16; ++r) { p0[r] -= d; p1[r] -= d; }
#pragma unroll
  for (int r = 0; r < 16; ++r) negm[r] = -m_reg;
  asm volatile("" : "+v"(negm));
}
__device__ __forceinline__ void finishSM(f32x16& p0, f32x16& p1, float alpha, float& l_reg, bf16x8& pa0, bf16x8& pa1, bf16x8& pa2, bf16x8& pa3) {
  float ps = 0;
#pragma unroll
  for (int r = 0; r < 16; ++r) ps += p0[r];
#pragma unroll
  for (int r = 0; r < 16; ++r) ps += p1[r];
  { auto rr = __builtin_amdgcn_permlane32_swap(__float_as_uint(ps), __float_as_uint(ps), false, false);
    ps = __uint_as_float(rr[0]) + __uint_as_float(rr[1]); }
  l_reg = l_reg * alpha + ps;
#define APK4(P, BASE, OUT) do { u32x4 w = {cvtpk(P[BASE + 0], P[BASE + 1]), cvtpk(P[BASE + 2], P[BASE + 3]), cvtpk(P[BASE + 4], P[BASE + 5]), cvtpk(P[BASE + 6], P[BASE + 7])}; \
    OUT = *reinterpret_cast<bf16x8*>(&w); } while (0)
  APK4(p0, 0, pa0); APK4(p0, 8, pa1); APK4(p1, 0, pa2); APK4(p1, 8, pa3);
#undef APK4
}
__device__ __forceinline__ void qkt(f32x16& p0, f32x16& p1, const char* Ks, const bf16x8* qr, const f32x16& negm, int r32, int hi) {
#pragma unroll
  for (int d0 = 0; d0 < 4; ++d0) { const int cb = (d0 * 16 + hi * 8) * 2;
    bf16x8 b0 = *reinterpret_cast<const bf16x8*>(Ks + AKSWZ(r32, cb));
    bf16x8 b1 = *reinterpret_cast<const bf16x8*>(Ks + AKSWZ(32 + r32, cb));
    if (d0 == 0) { p0 = __builtin_amdgcn_mfma_f32_32x32x16_bf16(b0, qr[0], negm, 0, 0, 0); p1 = __builtin_amdgcn_mfma_f32_32x32x16_bf16(b1, qr[0], negm, 0, 0, 0); }
    else { p0 = __builtin_amdgcn_mfma_f32_32x32x16_bf16(b0, qr[d0], p0, 0, 0, 0); p1 = __builtin_amdgcn_mfma_f32_32x32x16_bf16(b1, qr[d0], p1, 0, 0, 0); } }
}
__device__ __forceinline__ int v_st(int k, int c) { const int kk = (k & ~0xC) | ((k & 4) << 1) | ((k & 8) >> 1); return ((kk >> 3) * 4 + (c >> 5)) * 512 + ((kk & 7) * 32 + (c & 31)) * 2; }
__device__ __forceinline__ int v_rd_base(int lane) { return ((lane & 3) << 3) | (((lane >> 2) & 3) << 6) | (((lane >> 4) & 1) << 5) | (((lane >> 5) & 1) << 11); }
constexpr int v_rd_off(int d0, int ks, int half) { return d0 * 512 + ks * 4096 + half * 256; }
template <int OFF> __device__ __forceinline__ s16x4 tr_read(int vb) {
  s16x4 r; asm volatile("ds_read_b64_tr_b16 %0, %1 offset:%2" : "=&v"(r) : "v"(vb), "i"(OFF) : "memory"); return r;
}
template <int D0> __device__ __forceinline__ void pv_one(f32x16& od, int vb, bf16x8 pa0, bf16x8 pa1, bf16x8 pa2, bf16x8 pa3) {
  const s16x4 l0 = tr_read<v_rd_off(D0, 0, 0)>(vb), h0 = tr_read<v_rd_off(D0, 0, 1)>(vb), l1 = tr_read<v_rd_off(D0, 1, 0)>(vb), h1 = tr_read<v_rd_off(D0, 1, 1)>(vb);
  const s16x4 l2 = tr_read<v_rd_off(D0, 2, 0)>(vb), h2 = tr_read<v_rd_off(D0, 2, 1)>(vb), l3 = tr_read<v_rd_off(D0, 3, 0)>(vb), h3 = tr_read<v_rd_off(D0, 3, 1)>(vb);
  asm volatile("s_waitcnt lgkmcnt(0)" ::: "memory"); ASBAR();
#define APK(L, H) (bf16x8){L[0], L[1], L[2], L[3], H[0], H[1], H[2], H[3]}
  od = __builtin_amdgcn_mfma_f32_32x32x16_bf16(pa0, APK(l0, h0), od, 0, 0, 0);
  od = __builtin_amdgcn_mfma_f32_32x32x16_bf16(pa1, APK(l1, h1), od, 0, 0, 0);
  od = __builtin_amdgcn_mfma_f32_32x32x16_bf16(pa2, APK(l2, h2), od, 0, 0, 0);
  od = __builtin_amdgcn_mfma_f32_32x32x16_bf16(pa3, APK(l3, h3), od, 0, 0, 0);
#undef APK
}
__device__ __forceinline__ void pv_d0(f32x16* o, int vb, bf16x8 pa0, bf16x8 pa1, bf16x8 pa2, bf16x8 pa3) {
  pv_one<0>(o[0], vb, pa0, pa1, pa2, pa3); pv_one<1>(o[1], vb, pa0, pa1, pa2, pa3); pv_one<2>(o[2], vb, pa0, pa1, pa2, pa3); pv_one<3>(o[3], vb, pa0, pa1, pa2, pa3);
}
constexpr int SLOT_K = 8192, SLOT_V = 16384, RING_V = 3 * SLOT_K, WS_OFF = 3 * SLOT_K + 3 * SLOT_V;
constexpr size_t SHM_ATTN = WS_OFF + NW * 64 * 4;
#define AWAIT_BAR(N) asm volatile("s_waitcnt vmcnt(" #N ") lgkmcnt(0)\n\ts_barrier" ::: "memory")
template <int LDQ, int LDO>
__device__ __forceinline__ void attn_unit(const unsigned short* __restrict__ Qb, const unsigned short* __restrict__ Kh, const unsigned short* __restrict__ Vh,
                                          unsigned short* __restrict__ Ob, int seq, PG8_LAS unsigned char* ldsl, int wid) {
  char* lds = (char*)ldsl;
  const int tid = pg8::tid_from(wid), lane = tid & 63, r32 = lane & 31, hi = lane >> 5;
  char* K_lds = lds;
  float* ws = (float*)(lds + WS_OFF) + wid * 64; float* li_l = ws; float* al_l = ws + 32;
  float m_reg = 0.f, l_reg = 0; f32x16 o[4] = {}; bf16x8 qr[4]; f32x16 negm = f32x16{}; asm volatile("" : "+v"(negm));
  const unsigned short* Qw = Qb + (long)(wid * QBLK + r32) * LDQ + hi * 8;
#pragma unroll
  for (int d0 = 0; d0 < 4; ++d0) qr[d0] = *reinterpret_cast<const bf16x8*>(Qw + d0 * 16);
  const int krow = tid >> 3; const unsigned koff = (unsigned)(krow * LDQ * 2 + (((tid & 7) ^ ((krow >> 1) & 7)) << 4));
  unsigned voff[2];
#pragma unroll
  for (int i = 0; i < 2; ++i) { const int L = tid + 512 * i, sub = L >> 5, within = (L & 31) * 16, kk = (sub >> 2) * 8 + (within >> 6);
    const int k = (kk & ~0xC) | ((kk & 4) << 1) | ((kk & 8) >> 1), c = (sub & 3) * 32 + ((within & 63) >> 4) * 8; voff[i] = (unsigned)(k * LDQ * 2 + c * 2); }
  const int NT = seq / KVBLK; const unsigned ldsw = (unsigned)wid * 1024u;
#define ADMA_K(tile, slot) do { const int tl_ = (tile) < NT ? (tile) : NT - 1; const char* g_ = (const char*)Kh + (size_t)tl_ * (KVBLK * LDQ * 2); \
    __builtin_amdgcn_global_load_lds((const unsigned*)(g_ + koff), (PG8_LAS unsigned*)(ldsl + (slot) * SLOT_K + ldsw), 16, 0, 0); } while (0)
#define ADMA_V(tile, slot) do { const int tl_ = (tile) < NT ? (tile) : NT - 1; const char* g_ = (const char*)Vh + (size_t)tl_ * (KVBLK * LDQ * 2); \
    __builtin_amdgcn_global_load_lds((const unsigned*)(g_ + voff[0]), (PG8_LAS unsigned*)(ldsl + RING_V + (slot) * SLOT_V + ldsw), 16, 0, 0); \
    __builtin_amdgcn_global_load_lds((const unsigned*)(g_ + voff[1]), (PG8_LAS unsigned*)(ldsl + RING_V + (slot) * SLOT_V + 8192 + ldsw), 16, 0, 0); } while (0)
  const int vb0 = (int)(uintptr_t)(lds + RING_V) + v_rd_base(lane);
#define ARESC(a) do { if (__any((a) < 1.f)) { if (hi == 0) al_l[r32] = (a); asm volatile("s_waitcnt lgkmcnt(0)" ::: "memory"); \
    _Pragma("unroll") for (int d = 0; d < 4; ++d) _Pragma("unroll") for (int r = 0; r < 16; ++r) o[d][r] *= al_l[crow(r, hi)]; } } while (0)
#define AROT() do { const int t_ = s0; s0 = s1; s1 = s2; s2 = t_; } while (0)
  f32x16 pA0, pA1, pB0, pB1; float alA, alB; bf16x8 pa0, pa1, pa2, pa3;
  int s0 = 0, s1 = 1, s2 = 2;
#define TRR(F, D0, VB) do { F[0] = tr_read<v_rd_off(D0, 0, 0)>(VB); F[1] = tr_read<v_rd_off(D0, 0, 1)>(VB); F[2] = tr_read<v_rd_off(D0, 1, 0)>(VB); F[3] = tr_read<v_rd_off(D0, 1, 1)>(VB); \
    F[4] = tr_read<v_rd_off(D0, 2, 0)>(VB); F[5] = tr_read<v_rd_off(D0, 2, 1)>(VB); F[6] = tr_read<v_rd_off(D0, 3, 0)>(VB); F[7] = tr_read<v_rd_off(D0, 3, 1)>(VB); } while (0)
#define APK(L, H) (bf16x8){L[0], L[1], L[2], L[3], H[0], H[1], H[2], H[3]}
#define PVM(F, D0) do { o[D0] = __builtin_amdgcn_mfma_f32_32x32x16_bf16(pa0, APK(F[0], F[1]), o[D0], 0, 0, 0); o[D0] = __builtin_amdgcn_mfma_f32_32x32x16_bf16(pa1, APK(F[2], F[3]), o[D0], 0, 0, 0); \
    o[D0] = __builtin_amdgcn_mfma_f32_32x32x16_bf16(pa2, APK(F[4], F[5]), o[D0], 0, 0, 0); o[D0] = __builtin_amdgcn_mfma_f32_32x32x16_bf16(pa3, APK(F[6], F[7]), o[D0], 0, 0, 0); } while (0)
#define LWAIT() asm volatile("s_waitcnt lgkmcnt(0)" ::: "memory")
#define EXPS(P, A, B) do { _Pragma("unroll") for (int r_ = (A); r_ < (B); ++r_) P[r_] = __builtin_amdgcn_exp2f(P[r_]); } while (0)
#define TR1(F, I, D0, VB) do { F[2 * (I)] = tr_read<v_rd_off(D0, I, 0)>(VB); F[2 * (I) + 1] = tr_read<v_rd_off(D0, I, 1)>(VB); } while (0)
#define MF(a, b, c) __builtin_amdgcn_mfma_f32_32x32x16_bf16(a, b, c, 0, 0, 0)
#define PVG(F, D0, FN, DN, PX, PY, A0, A1, A2, A3, A4, B0, B1, B2, B3, B4) do { \
    o[D0] = MF(pa0, APK(F[0], F[1]), o[D0]); TR1(FN, 0, DN, vb_); EXPS(PX, A0, A1); EXPS(PY, B0, B1); asm volatile("" : "+v"(PX), "+v"(PY)); ASBAR(); \
    o[D0] = MF(pa1, APK(F[2], F[3]), o[D0]); TR1(FN, 1, DN, vb_); EXPS(PX, A1, A2); EXPS(PY, B1, B2); asm volatile("" : "+v"(PX), "+v"(PY)); ASBAR(); \
    o[D0] = MF(pa2, APK(F[4], F[5]), o[D0]); TR1(FN, 2, DN, vb_); EXPS(PX, A2, A3); EXPS(PY, B2, B3); asm volatile("" : "+v"(PX), "+v"(PY)); ASBAR(); \
    o[D0] = MF(pa3, APK(F[6], F[7]), o[D0]); TR1(FN, 3, DN, vb_); EXPS(PX, A3, A4); EXPS(PY, B3, B4); asm volatile("" : "+v"(PX), "+v"(PY)); ASBAR(); } while (0)
#define PVSM(VB, P0, P1, AL) do { const int vb_ = (VB); s16x4 fa[8], fb[8]; float pm_; \
    TRR(fa, 0, vb_); LWAIT(); ASBAR(); \
    PVM(fa, 0); TRR(fb, 1, vb_); pm_ = rowmax32(P0, P1); \
    if (__builtin_expect(__all(pm_ <= THR2), 1)) { AL = 1.f; } else { moveRef(P0, P1, pm_, m_reg, negm, AL); } \
    LWAIT(); ASBAR(); \
    PVG(fb, 1, fa, 2, P0, P1, 0, 3, 6, 9, 11, 0, 0, 0, 0, 0); LWAIT(); ASBAR(); \
    PVG(fa, 2, fb, 3, P0, P1, 11, 14, 16, 16, 16, 0, 0, 1, 4, 6); LWAIT(); ASBAR(); \
    o[3] = MF(pa0, APK(fb[0], fb[1]), o[3]); EXPS(P1, 6, 9); asm volatile("" : "+v"(P1)); ASBAR(); \
    o[3] = MF(pa1, APK(fb[2], fb[3]), o[3]); EXPS(P1, 9, 12); asm volatile("" : "+v"(P1)); ASBAR(); \
    o[3] = MF(pa2, APK(fb[4], fb[5]), o[3]); EXPS(P1, 12, 14); asm volatile("" : "+v"(P1)); ASBAR(); \
    o[3] = MF(pa3, APK(fb[6], fb[7]), o[3]); EXPS(P1, 14, 16); asm volatile("" : "+v"(P1)); ASBAR(); } while (0)
  ADMA_K(0, 0); ADMA_V(0, 0); ADMA_K(1, 1); ADMA_V(1, 1); ADMA_K(2, 2);
  AWAIT_BAR(4);
  qkt(pA0, pA1, K_lds, qr, negm, r32, hi); firstSM(pA0, pA1, m_reg, negm); alA = 1.f;
#pragma unroll 1
  for (int t = 0; t + 2 < NT; t += 2) {
    AWAIT_BAR(3); ADMA_K(t + 3, s0); ADMA_V(t + 2, s2);
    ASBAR(); qkt(pB0, pB1, K_lds + s1 * SLOT_K, qr, negm, r32, hi);
    finishSM(pA0, pA1, alA, l_reg, pa0, pa1, pa2, pa3); ASBAR();
    PVSM(vb0 + s0 * SLOT_V, pB0, pB1, alB);
    ARESC(alB); AROT();
    AWAIT_BAR(3); ADMA_K(t + 4, s0); ADMA_V(t + 3, s2);
    ASBAR(); qkt(pA0, pA1, K_lds + s1 * SLOT_K, qr, negm, r32, hi);
    finishSM(pB0, pB1, alB, l_reg, pa0, pa1, pa2, pa3); ASBAR();
    PVSM(vb0 + s0 * SLOT_V, pA0, pA1, alA);
    ARESC(alA); AROT();
  }
  AWAIT_BAR(3);
  ASBAR(); qkt(pB0, pB1, K_lds + s1 * SLOT_K, qr, negm, r32, hi);
  finishSM(pA0, pA1, alA, l_reg, pa0, pa1, pa2, pa3); ASBAR();
  PVSM(vb0 + s0 * SLOT_V, pB0, pB1, alB);
  ARESC(alB); AROT();
  AWAIT_BAR(0);
  finishSM(pB0, pB1, alB, l_reg, pa0, pa1, pa2, pa3); ASBAR();
  pv_d0(o, vb0 + s0 * SLOT_V, pa0, pa1, pa2, pa3);
  if (hi == 0) li_l[r32] = l_reg; asm volatile("s_waitcnt lgkmcnt(0)" ::: "memory");
  float rli[16];
#pragma unroll
  for (int r = 0; r < 16; ++r) rli[r] = __builtin_amdgcn_rcpf(li_l[crow(r, hi)]);
  unsigned short* Ow = Ob + (long)(wid * QBLK) * LDO;
#pragma unroll
  for (int r = 0; r < 16; ++r) { const int orow = crow(r, hi);
#pragma unroll
    for (int d0 = 0; d0 < 4; ++d0) { const float v = o[d0][r] * rli[r]; Ow[(long)orow * LDO + d0 * 32 + r32] = (unsigned short)(cvtpk(v, v) & 0xffffu); } }
  __syncthreads();
#undef ADMA_K
#undef TR1
#undef MF
#undef PVG
#undef TRR
#undef APK
#undef PVM
#undef LWAIT
#undef EXPS
#undef PVSM
#undef ADMA_V
#undef ARESC
#undef AROT
}
}

constexpr int NWAVES = 8, NTHR = NWAVES * 64;
constexpr int DM = 1024, NB = 4, SEQ = 4096, CTXL = 256, RPB = CTXL + SEQ  , MROWS = NB * RPB  ;
constexpr int INW = 5904, NPROJ = 6144, PLD = 5888;
constexpr int FFD = 2816, FFE = 3584, NEXP = 8, FFEH = FFE / 2;
constexpr int NCHUNK = RPB / 64;
constexpr float EPSN = 1e-6f;
constexpr int PC_AQ = 0, PC_AK = 512, PC_AV = 1024, PC_DQ = 1536, PC_DK = 1792, PC_DV = 2048, PC_DZ = 2304, PC_POOL = 2560, PC_GATE = 2816, PC_AB = 5888;

constexpr size_t MiB = 1u << 20;
constexpr size_t WS_CTL = 0, CTL_ZERO_BYTES = 2 * MiB;
constexpr size_t WS_MOD = 1 * MiB;
constexpr size_t WS_ROPE = 2 * MiB;
constexpr size_t WS_LAM = 2 * MiB + 65536;
constexpr size_t WS_ROUTE = 3 * MiB;
constexpr size_t WS_GB = 4 * MiB;
constexpr int NPB = 2816;
constexpr size_t WS_WIN = 8 * MiB;
constexpr size_t WS_WG8 = 20 * MiB;
constexpr size_t WS_WAB = 26 * MiB;
constexpr size_t WS_U8 = 484 * MiB;
constexpr size_t WS_WBR = 32 * MiB;
constexpr size_t WS_WOUT = 36 * MiB;
constexpr size_t WS_W13 = 40 * MiB;
constexpr size_t WS_W2 = 51 * MiB;
constexpr size_t WS_H = 58 * MiB;
constexpr size_t WS_U = 126 * MiB;
constexpr size_t WS_ATTO = WS_U;
constexpr size_t WS_MIX = WS_U;
constexpr size_t WS_PROJ = 160 * MiB;
constexpr size_t WS_POOLO = 356 * MiB;
constexpr size_t WS_W2M = 365 * MiB;
constexpr size_t WS_DNP = 398 * MiB;
constexpr size_t WS_MG = WS_DNP;
constexpr size_t WS_DNG = 466 * MiB;
constexpr size_t WS_DNO = 467 * MiB;
constexpr size_t WS_W13M = 484 * MiB;
constexpr size_t WS_SLAB = 256 * MiB;
constexpr size_t WS_HID = WS_PROJ;
constexpr int MOE_MAXT = 136;
constexpr size_t WS_HIDM = 160 * MiB;
constexpr size_t WS_XG = 279 * MiB;
constexpr size_t WS_Y = 279 * MiB;
constexpr size_t WS_END = 540 * MiB;
static_assert(WS_HIDM + (size_t)MOE_MAXT * 256 * FFE <= WS_XG && WS_Y + (size_t)MOE_MAXT * 256 * 1024 * 2 <= WS_POOLO && WS_DNO + (size_t)2 * MROWS * 256 * 2 <= WS_W13M && WS_W13M + (size_t)8 * 2 * FFE * 1024 <= WS_END, "ws map");
static_assert(WS_WIN + (size_t)2 * NPB * 1024 * 2 <= WS_WG8 && WS_WG8 + (size_t)2 * 3072 * 1024 <= WS_WAB && WS_WAB + 2 * 65536 <= WS_WBR && WS_W13 + (size_t)2 * FFD * 1024 * 2 <= WS_W2 && WS_W2 + (size_t)1024 * FFD * 2 <= WS_H, "ws map (weights)");
static_assert(WS_H + (size_t)MROWS * 1024 * 4 <= WS_U && WS_U + (size_t)MROWS * 1024 * 2 <= WS_PROJ && WS_PROJ + (size_t)MROWS * PLD * 2 <= WS_POOLO && WS_POOLO + (size_t)MROWS * 256 * 2 <= WS_W2M && WS_W2M + (size_t)8 * 1024 * FFE <= WS_DNP, "ws map (acts)");
static_assert(WS_DNP + (size_t)NB * NCHUNK * 4 * 2 * 32768 <= WS_DNG, "ws map (dn)");
constexpr int CW_TMO = 0, CW_CODE = 1;
constexpr int CW_BAR = 4096;
constexpr int CW_ECNT = 16384;

constexpr int RING_BYTES = 155648;
constexpr int MISC_OFF = RING_BYTES;
constexpr int LDS_BYTES = RING_BYTES + 1024;

enum { PH_PRO = 0, PH_L0 = 1, PH_N1 = 0, PH_PROJ = 1, PH_ATT = 2, PH_SCAN = 3, PH_MIXB = 4, PH_MRG0 = 5, PH_MRG1 = 6, PH_MRG2 = 7, PH_OUT = 8, PH_N2 = 9, PH_LAYER = 10,
       PH_FUP = 11, PH_FDN = 12, PH_L1 = 13, PH_GATH = 23, PH_CV0 = 24, PH_UP0 = 25, PH_DN0 = 26, PH_CV1 = 27, PH_UP1 = 28, PH_DN1 = 29, PH_FIN = 30, PH_COUNT = 31 };

#define GAS __attribute__((address_space(1)))
#define LAS __attribute__((address_space(3)))
typedef unsigned short bf16;
typedef unsigned v4u __attribute__((ext_vector_type(4)));
typedef unsigned v2u __attribute__((ext_vector_type(2)));
typedef float f32x4 __attribute__((ext_vector_type(4)));
typedef GAS unsigned gu32;
#define RLX_AGENT __ATOMIC_RELAXED, __HIP_MEMORY_SCOPE_AGENT
#define LDS_WAIT() asm volatile("s_waitcnt lgkmcnt(0)" ::: "memory")
#define VM_WAIT() asm volatile("s_waitcnt vmcnt(0)" ::: "memory")
__device__ __forceinline__ unsigned f2bf(float f) { unsigned u = __builtin_bit_cast(unsigned, f); return (u + 0x7fffu + ((u >> 16) & 1u)) >> 16; }
typedef float f32x2_c __attribute__((ext_vector_type(2))); typedef __bf16 bf16x2_c __attribute__((ext_vector_type(2)));
__device__ __forceinline__ unsigned cvtpk_c(float lo, float hi) { f32x2_c v = {lo, hi}; bf16x2_c b = __builtin_convertvector(v, bf16x2_c); return __builtin_bit_cast(unsigned, b); }
__device__ __forceinline__ unsigned pk2(float lo, float hi) { return cvtpk_c(lo, hi); }
__device__ __forceinline__ unsigned cvt4_fp8(float a, float b, float c, float d) {
    a = fminf(fmaxf(a, -448.f), 448.f); b = fminf(fmaxf(b, -448.f), 448.f); c = fminf(fmaxf(c, -448.f), 448.f); d = fminf(fmaxf(d, -448.f), 448.f);
    int r = 0; r = __builtin_amdgcn_cvt_pk_fp8_f32(a, b, r, false); r = __builtin_amdgcn_cvt_pk_fp8_f32(c, d, r, true); return (unsigned)r; }
constexpr int E8(int log2scale) { return (127 - log2scale) * 0x01010101; }
constexpr int F8_ACT_L2 = 3, F8_W13_L2 = 5, F8_W2_L2 = 6;
__device__ __forceinline__ float bf_lo(unsigned w) { return __builtin_bit_cast(float, w << 16); }
__device__ __forceinline__ float bf_hi(unsigned w) { return __builtin_bit_cast(float, w & 0xffff0000u); }
__device__ __forceinline__ float bf2f(bf16 v) { return __builtin_bit_cast(float, (unsigned)v << 16); }
__device__ __forceinline__ float sigmoidf_(float x) { return 1.f / (1.f + __expf(-x)); }
__device__ __forceinline__ float siluf_(float x) { return x / (1.f + __expf(-x)); }
__device__ __forceinline__ float dpp_add_(float v, const int ctrl_sel) {
    int r;
    if (ctrl_sel == 0) r = __builtin_amdgcn_update_dpp(0, __builtin_bit_cast(int, v), 0xB1, 0xF, 0xF, false);
    else if (ctrl_sel == 1) r = __builtin_amdgcn_update_dpp(0, __builtin_bit_cast(int, v), 0x4E, 0xF, 0xF, false);
    else if (ctrl_sel == 2) r = __builtin_amdgcn_update_dpp(0, __builtin_bit_cast(int, v), 0x141, 0xF, 0xF, false);
    else r = __builtin_amdgcn_update_dpp(0, __builtin_bit_cast(int, v), 0x140, 0xF, 0xF, false);
    return v + __builtin_bit_cast(float, r);
}
__device__ __forceinline__ float grp8_sum(float v) { v = dpp_add_(v, 0); v = dpp_add_(v, 1); v = dpp_add_(v, 2); return v; }
__device__ __forceinline__ float grp16_sum(float v) { v = grp8_sum(v); v = dpp_add_(v, 3); return v; }
__device__ __forceinline__ float wave_sum(float v) {
    v = grp16_sum(v);
    { auto rr = __builtin_amdgcn_permlane16_swap(__float_as_uint(v), __float_as_uint(v), false, false); v = __uint_as_float(rr[0]) + __uint_as_float(rr[1]); }
    { auto rr = __builtin_amdgcn_permlane32_swap(__float_as_uint(v), __float_as_uint(v), false, false); v = __uint_as_float(rr[0]) + __uint_as_float(rr[1]); }
    return v;
}
__device__ __forceinline__ int lane_id_() { return pg8::lane_id_asm(); }
__device__ __forceinline__ float lane_get(float v, int src) { return __builtin_bit_cast(float, __builtin_amdgcn_ds_bpermute(src << 2, __builtin_bit_cast(int, v))); }
#define XB_TMO      128
#define XB_XCNT(j)  (256  + 64 * (j))
#define XB_XSUB(j)  (1280 + 64 * (j))
#define XB_XGEN(j)  (2304 + 64 * (j))
#define XB_TOP      3328
#define XB_TOPGEN   3392
#define XCD_BAR_WORDS 3456
#define XB_SPIN_CAP (1u << 18)

__device__ __forceinline__ unsigned xb_ld(unsigned* p)              { return __hip_atomic_load(p, __ATOMIC_RELAXED, __HIP_MEMORY_SCOPE_AGENT); }
__device__ __forceinline__ unsigned xb_add(unsigned* p, unsigned v) { return __hip_atomic_fetch_add(p, v, __ATOMIC_RELAXED, __HIP_MEMORY_SCOPE_AGENT); }
__device__ __forceinline__ unsigned xb_xcc_id() { return (unsigned)__builtin_amdgcn_s_getreg((3 << 11) | 20) & 0xFu; }
#define XB_SPIN(cond, bar) do { unsigned _sp = 0; while (cond) { __builtin_amdgcn_s_sleep(1); \
    if ((++_sp & 255u) == 0u) { if (xb_ld(&(bar)[XB_TMO])) break; if (_sp > XB_SPIN_CAP) { atomicAdd(&(bar)[XB_TMO], 1u); break; } } } } while (0)

struct XcdBarrier {
    unsigned* bar; unsigned x; unsigned wid;
    volatile LAS unsigned* st;
};

__device__ __forceinline__ XcdBarrier xcd_barrier_post(unsigned* bar, volatile LAS unsigned* st, unsigned wid) {
    XcdBarrier b; b.bar = bar; b.x = xb_xcc_id(); b.st = st; b.wid = wid;
    if (wid == 0 && pg8::lane_id_asm() == 0) (void)xb_add(&bar[XB_XCNT(b.x)], 1u);
    return b;
}
__device__ __forceinline__ void xcd_barrier_complete(unsigned* bar, unsigned x, unsigned& nloc, unsigned& nx) {
    const unsigned G = gridDim.x * gridDim.y * gridDim.z;
    unsigned sum, cnt, mine, sp = 0u;
    for (;;) {
        sum = 0u; cnt = 0u; mine = 0u;
#pragma unroll
        for (unsigned j = 0; j < 16; ++j) { const unsigned c = xb_ld(&bar[XB_XCNT(j)]); sum += c; cnt += (c > 0u) ? 1u : 0u; mine = (j == x) ? c : mine; }
        if (sum == G) break;
        __builtin_amdgcn_s_sleep(1);
        if ((++sp & 255u) == 0u) { if (xb_ld(&bar[XB_TMO])) break; if (sp > XB_SPIN_CAP) { atomicAdd(&bar[XB_TMO], 1u); break; } }
    }
    nloc = mine > 0u ? mine : 1u; nx = cnt > 0u ? cnt : 1u;
}

__device__ __forceinline__ void xcd_barrier(const XcdBarrier& b) {
    asm volatile("s_waitcnt vmcnt(0)" ::: "memory");
    __syncthreads();
    if (b.wid == 0 && pg8::lane_id_asm() == 0) {
        unsigned* bar = b.bar;
        __builtin_amdgcn_s_waitcnt(0);
        unsigned nloc = b.st[0], nx = b.st[1];
        if (nloc == 0u) { xcd_barrier_complete(bar, b.x, nloc, nx); b.st[0] = nloc; b.st[1] = nx; }
        const unsigned old = xb_add(&bar[XB_XSUB(b.x)], 1u);
        const unsigned gen = old / nloc;
        if (old + 1u == (gen + 1u) * nloc) {
            __builtin_amdgcn_fence(__ATOMIC_RELEASE, "agent");
            asm volatile("s_waitcnt vmcnt(0)" ::: "memory");
            const unsigned og = xb_add(&bar[XB_TOP], 1u);
            const unsigned tg = og / nx;
            if (og + 1u == (tg + 1u) * nx) xb_add(&bar[XB_TOPGEN], 1u);
            else XB_SPIN(xb_ld(&bar[XB_TOPGEN]) == tg, bar);
            __builtin_amdgcn_fence(__ATOMIC_ACQUIRE, "agent");
            xb_add(&bar[XB_XGEN(b.x)], 1u);
            asm volatile("s_waitcnt vmcnt(0)" ::: "memory");
        } else {
            XB_SPIN(xb_ld(&bar[XB_XGEN(b.x)]) == gen, bar);
            __builtin_amdgcn_fence(__ATOMIC_ACQUIRE, "agent");
            asm volatile("s_waitcnt vmcnt(0)" ::: "memory");
        }
    }
    __syncthreads();
}

struct Frame {
    LAS unsigned char* lds;
    volatile LAS unsigned* MISC;
    gu32* ctl;
    int tid, lane, wave, vcu, G, zz, bx, wid_s;
    unsigned char* ws;
    float* out;
};
struct Args { const float* in[27]; float* out; unsigned char* ws; int ph_lo, ph_hi, bar_li, pad; };

struct TileOrder {
    int nM, nN, nwg, G, c, skip;
    __device__ __forceinline__ void init(int nM_, int nN_, int G_, int c_, int skip_) { nM = nM_; nN = nN_; nwg = nM * nN; G = G_; c = c_; skip = skip_; }
    __device__ __forceinline__ bool next(int i, pg8::Unit& u) const {
        const long L = (long)i * G + c; if (L >= nwg) return false;
        int wgid = (int)L; { const int q = nwg / 8, r = nwg % 8, xcd = wgid % 8, off = wgid / 8; wgid = (xcd < r ? xcd * (q + 1) : r * (q + 1) + (xcd - r) * q) + off; }
        const int nig = 8 * nN, gid = wgid / nig, fm = gid * 8, gsz = (nM - fm) < 8 ? (nM - fm) : 8;
        int pm = fm + ((wgid % nig) % gsz); const int pn = (wgid % nig) / gsz;
        if (skip) pm = (pm >> 4) * 17 + 1 + (pm & 15);
        u.pm = pm; u.pn = pn; u.pb = pn; u.ko = 0; u.aux = 0; return true;
    }
    __device__ __forceinline__ void a_ready(const pg8::Unit&) const {}
    __device__ __forceinline__ void done(const pg8::Unit&) const {}
};
struct MoeOrder {
    int t1, t2, t3, t4, t5, t6, t7, t8, nN, G, c;
    __device__ __forceinline__ void init(const gu32* cnt, int nN_, int G_, int c_) {
        int t = 0;
        t += ((int)__hip_atomic_load(cnt + 0 * 64, RLX_AGENT) + 255) >> 8; t1 = t; t += ((int)__hip_atomic_load(cnt + 1 * 64, RLX_AGENT) + 255) >> 8; t2 = t;
        t += ((int)__hip_atomic_load(cnt + 2 * 64, RLX_AGENT) + 255) >> 8; t3 = t; t += ((int)__hip_atomic_load(cnt + 3 * 64, RLX_AGENT) + 255) >> 8; t4 = t;
        t += ((int)__hip_atomic_load(cnt + 4 * 64, RLX_AGENT) + 255) >> 8; t5 = t; t += ((int)__hip_atomic_load(cnt + 5 * 64, RLX_AGENT) + 255) >> 8; t6 = t;
        t += ((int)__hip_atomic_load(cnt + 6 * 64, RLX_AGENT) + 255) >> 8; t7 = t; t += ((int)__hip_atomic_load(cnt + 7 * 64, RLX_AGENT) + 255) >> 8; t8 = t;
        nN = nN_; G = G_; c = c_;
    }
    __device__ __forceinline__ int tile_off(int e) const { return e == 0 ? 0 : e == 1 ? t1 : e == 2 ? t2 : e == 3 ? t3 : e == 4 ? t4 : e == 5 ? t5 : e == 6 ? t6 : t7; }
    __device__ __forceinline__ bool next(int i, pg8::Unit& u) const {
        const long L = (long)i * G + c; if (L >= (long)t8 * nN) return false;
        const int pm = (int)(L / nN), pn = (int)(L % nN);
        const int e = (pm >= t1) + (pm >= t2) + (pm >= t3) + (pm >= t4) + (pm >= t5) + (pm >= t6) + (pm >= t7);
        u.pm = pm; u.pn = pn; u.pb = e * nN + pn; u.ko = 0; u.aux = 0; return true;
    }
    __device__ __forceinline__ void a_ready(const pg8::Unit&) const {}
    __device__ __forceinline__ void done(const pg8::Unit&) const {}
};

struct CtxSplitOrder {
    int S, kpb, G, c;
    __device__ __forceinline__ void init(int S_, int kp_bytes, int G_, int c_) { S = S_; kpb = kp_bytes; G = G_; c = c_; }
    __device__ __forceinline__ bool next(int i, pg8::Unit& u) const {
        const int L = i * G + c; if (L >= 16 * S) return false;
        const int ks = L % S, pn = (L / S) & 3, ct = L / (4 * S);
        u.pm = ct * 17; u.pn = pn; u.pb = pn; u.ko = ks * kpb; u.aux = ks; return true;
    }
    __device__ __forceinline__ void a_ready(const pg8::Unit&) const {}
    __device__ __forceinline__ void done(const pg8::Unit&) const {}
};
#define EPI_LOOP(...) _Pragma("unroll") for (int ai = 0; ai < 2; ++ai) _Pragma("unroll") for (int m = 0; m < 4; ++m) { const int row = u.pm * 256 + ai * 128 + wr * 64 + m * 16 + fr; \
    _Pragma("unroll") for (int bj = 0; bj < 2; ++bj) { const int col = bj * 128 + wc * 32 + 4 * fq; f32x4 v0 = acc[ai][bj][m][0], v1 = acc[ai][bj][m][1]; __VA_ARGS__ } if (m & 1) asm volatile("" ::: "memory"); }
#define EPI_LOOP8(...) _Pragma("unroll") for (int ai = 0; ai < 2; ++ai) _Pragma("unroll") for (int m = 0; m < 4; ++m) { const int row = u.pm * 256 + ai * 128 + wr * 64 + m * 16 + fr; \
    _Pragma("unroll") for (int bj = 0; bj < 2; ++bj) { const int col = bj * 128 + wc * 32 + 8 * fq; f32x4 v0 = acc[ai][bj][m][0], v1 = acc[ai][bj][m][1]; __VA_ARGS__ } if (m & 1) asm volatile("" ::: "memory"); }
__device__ __forceinline__ v4u pack8(f32x4 a, f32x4 b) { v4u w; w.x = pg8::cvt_pk_bf16(a[0], a[1]); w.y = pg8::cvt_pk_bf16(a[2], a[3]); w.z = pg8::cvt_pk_bf16(b[0], b[1]); w.w = pg8::cvt_pk_bf16(b[2], b[3]); return w; }
__device__ __forceinline__ v2u pack4(f32x4 v) { v2u w; w.x = pg8::cvt_pk_bf16(v[0], v[1]); w.y = pg8::cvt_pk_bf16(v[2], v[3]); return w; }
__device__ __forceinline__ f32x4 unpack4(v2u w) { return (f32x4){bf_lo(w.x), bf_hi(w.x), bf_lo(w.y), bf_hi(w.y)}; }

struct EpiProj {
    static constexpr bool PERM = false, AFTER_DRAIN = false, KHOOK = false;
    bf16* P; const float* rope;
    __device__ __forceinline__ void operator()(const pg8::f32x4 (&acc)[2][2][4][2], const pg8::Unit& u, int wr, int wc, int fr, int fq) const {
        asm volatile("" : "+v"(fr), "+v"(fq));
        const int pn = u.pn;
        if (pn < 4) {
            EPI_LOOP({ const int j = row % RPB;
                if (j >= CTXL) { const int t = j - CTXL; const int pos = (wc & 1) ? (t & 63) : (t >> 6);
                    const f32x4 cs0 = *(const f32x4*)(rope + (pos * 16 + 4 * fq) * 2), cs1 = *(const f32x4*)(rope + (pos * 16 + 4 * fq) * 2 + 4);
                    const float c0 = cs0[0], s0 = cs0[1], c1 = cs0[2], s1 = cs0[3], c2 = cs1[0], s2 = cs1[1], c3 = cs1[2], s3 = cs1[3];
                    const f32x4 a = v0, b = v1;
                    v0[0] = a[0] * c0 - b[0] * s0; v1[0] = b[0] * c0 + a[0] * s0; v0[1] = a[1] * c1 - b[1] * s1; v1[1] = b[1] * c1 + a[1] * s1;
                    v0[2] = a[2] * c2 - b[2] * s2; v1[2] = b[2] * c2 + a[2] * s2; v0[3] = a[3] * c3 - b[3] * s3; v1[3] = b[3] * c3 + a[3] * s3; }
                if (pn < 2) { v0 *= attn::QSCALE; v1 *= attn::QSCALE; }
                bf16* o = P + (size_t)row * PLD + pn * 256 + col; *(v2u*)o = pack4(v0); *(v2u*)(o + 16) = pack4(v1); })
        } else {
            EPI_LOOP8({ *(v4u*)(P + (size_t)row * PLD + pn * 256 + col) = pack8(v0, v1); })
        }
    }
};
struct EpiGate {
    static constexpr bool PERM = false, AFTER_DRAIN = false, KHOOK = false;
    bf16* P;
    __device__ __forceinline__ void operator()(const pg8::f32x4 (&acc)[2][2][4][2], const pg8::Unit& u, int wr, int wc, int fr, int fq) const {
        asm volatile("" : "+v"(fr), "+v"(fq));
        EPI_LOOP8({ for (int q = 0; q < 4; ++q) { v0[q] = sigmoidf_(v0[q]); v1[q] = sigmoidf_(v1[q]); }
            *(v4u*)(P + (size_t)row * PLD + PC_GATE + u.pn * 256 + col) = pack8(v0, v1); })
    }
};
struct EpiMergeF {
    static constexpr bool PERM = false, AFTER_DRAIN = false, KHOOK = true;
    bf16* MG; const bf16* P;
    __device__ __forceinline__ void khook(pg8::f32x4 (&acc)[2][2][4][2], const pg8::Unit& u, int t, int wr, int wc, int fr, int fq) const {
        asm volatile("" : "+v"(fr), "+v"(fq));
        const int gnum = PC_GATE + (t == 8 ? 0 : 1024), gden = gnum + 1024;
#pragma unroll
        for (int ai = 0; ai < 2; ++ai)
#pragma unroll
            for (int m = 0; m < 4; ++m) { const int row = u.pm * 256 + ai * 128 + wr * 64 + m * 16 + fr;
#pragma unroll
                for (int bj = 0; bj < 2; ++bj) { const int c = u.pn * 256 + bj * 128 + wc * 32 + 8 * fq; const bf16* gp = P + (size_t)row * PLD + c;
                    const v4u a = *(const v4u*)(gp + gnum), b = *(const v4u*)(gp + gden);
                    const f32x4 n0 = unpack4((v2u){a.x, a.y}), n1 = unpack4((v2u){a.z, a.w}), d0 = unpack4((v2u){b.x, b.y}), d1 = unpack4((v2u){b.z, b.w});
#pragma unroll
                    for (int q = 0; q < 4; ++q) { acc[ai][bj][m][0][q] *= n0[q] * __builtin_amdgcn_rcpf(fmaxf(d0[q], 1e-20f)); acc[ai][bj][m][1][q] *= n1[q] * __builtin_amdgcn_rcpf(fmaxf(d1[q], 1e-20f)); } }
                if (m & 1) asm volatile("" ::: "memory"); }
    }
    __device__ __forceinline__ void operator()(const pg8::f32x4 (&acc)[2][2][4][2], const pg8::Unit& u, int wr, int wc, int fr, int fq) const {
        asm volatile("" : "+v"(fr), "+v"(fq));
        EPI_LOOP8({ const int c = u.pn * 256 + col; const v4u gw = *(const v4u*)(P + (size_t)row * PLD + PC_GATE + 2048 + c);
            *(v4u*)(MG + (size_t)row * DM + c) = pack8(unpack4((v2u){gw.x, gw.y}) * v0, unpack4((v2u){gw.z, gw.w}) * v1); })
    }
};
struct EpiResid {
    static constexpr bool PERM = false, AFTER_DRAIN = false, KHOOK = false;
    float* H; const float* modl; int gidx; const float* xin;
    __device__ __forceinline__ void operator()(const pg8::f32x4 (&acc)[2][2][4][2], const pg8::Unit& u, int wr, int wc, int fr, int fq) const {
        asm volatile("" : "+v"(fr), "+v"(fq));
        EPI_LOOP8({ const int c = u.pn * 256 + col; const int b = row / RPB, j = row - b * RPB; const int mr = j < CTXL ? 4 : b;
            const float* gp = modl + mr * 6144 + gidx * 1024 + c; float* hp = H + (size_t)row * DM + c;
            const float* sp = xin ? xin + ((size_t)b * SEQ + (j - CTXL)) * DM + c : hp;
            const f32x4 g0 = *(const f32x4*)gp, g1 = *(const f32x4*)(gp + 4);
            *(f32x4*)hp = *(const f32x4*)sp + g0 * v0; *(f32x4*)(hp + 4) = *(const f32x4*)(sp + 4) + g1 * v1; })
    }
};
struct EpiSlab {
    static constexpr bool PERM = false, AFTER_DRAIN = false, KHOOK = false;
    float* SL; const float* modl; int gidx;
    __device__ __forceinline__ void operator()(const pg8::f32x4 (&acc)[2][2][4][2], const pg8::Unit& u, int wr, int wc, int fr, int fq) const {
        asm volatile("" : "+v"(fr), "+v"(fq));
        const float* gate = modl + 4 * 6144 + gidx * 1024; float* sl = SL + ((size_t)u.aux * 1024 + (u.pm / 17) * 256) * 1024;
#pragma unroll
        for (int ai = 0; ai < 2; ++ai)
#pragma unroll
            for (int m = 0; m < 4; ++m) { const int lr = ai * 128 + wr * 64 + m * 16 + fr;
#pragma unroll
                for (int bj = 0; bj < 2; ++bj) { const int c = u.pn * 256 + bj * 128 + wc * 32 + 8 * fq; const f32x4 g0 = *(const f32x4*)(gate + c), g1 = *(const f32x4*)(gate + c + 4);
                    float* o = sl + (size_t)lr * 1024 + c; *(f32x4*)o = g0 * acc[ai][bj][m][0]; *(f32x4*)(o + 4) = g1 * acc[ai][bj][m][1]; } }
    }
};
struct EpiSwiglu {
    static constexpr bool PERM = false, AFTER_DRAIN = false, KHOOK = false;
    bf16* HID; int ldh;
    __device__ __forceinline__ void operator()(const pg8::f32x4 (&acc)[2][2][4][2], const pg8::Unit& u, int wr, int wc, int fr, int fq) const {
        asm volatile("" : "+v"(fr), "+v"(fq));
#pragma unroll
        for (int ai = 0; ai < 2; ++ai)
#pragma unroll
            for (int m = 0; m < 4; ++m) { const int row = u.pm * 256 + ai * 128 + wr * 64 + m * 16 + fr; f32x4 r0, r1;
#pragma unroll
                for (int q = 0; q < 4; ++q) { r0[q] = siluf_(acc[ai][0][m][0][q]) * acc[ai][0][m][1][q]; r1[q] = siluf_(acc[ai][1][m][0][q]) * acc[ai][1][m][1][q]; }
                *(v4u*)(HID + (size_t)row * ldh + u.pn * 128 + wc * 32 + 8 * fq) = pack8(r0, r1);
                if (m & 1) asm volatile("" ::: "memory"); }
    }
};
struct EpiSwiglu8 {
    static constexpr bool PERM = false, AFTER_DRAIN = false, KHOOK = false;
    unsigned char* HID; int ldh;
    __device__ __forceinline__ void operator()(const pg8::f32x4 (&acc)[2][2][4][2], const pg8::Unit& u, int wr, int wc, int fr, int fq) const {
        asm volatile("" : "+v"(fr), "+v"(fq));
        const float s8 = (float)(1 << F8_ACT_L2);
#pragma unroll
        for (int ai = 0; ai < 2; ++ai)
#pragma unroll
            for (int m = 0; m < 4; ++m) { const int row = u.pm * 256 + ai * 128 + wr * 64 + m * 16 + fr; f32x4 r0, r1;
#pragma unroll
                for (int q = 0; q < 4; ++q) { r0[q] = siluf_(acc[ai][0][m][0][q]) * acc[ai][0][m][1][q] * s8; r1[q] = siluf_(acc[ai][1][m][0][q]) * acc[ai][1][m][1][q] * s8; }
                v2u o; o.x = cvt4_fp8(r0[0], r0[1], r0[2], r0[3]); o.y = cvt4_fp8(r1[0], r1[1], r1[2], r1[3]);
                *(v2u*)(HID + (size_t)row * ldh + u.pn * 128 + wc * 32 + 8 * fq) = o;
                if (m & 1) asm volatile("" ::: "memory"); }
    }
};
struct EpiY {
    static constexpr bool PERM = false, AFTER_DRAIN = false, KHOOK = false;
    bf16* Y; int first;
    __device__ __forceinline__ void operator()(const pg8::f32x4 (&acc)[2][2][4][2], const pg8::Unit& u, int wr, int wc, int fr, int fq) const {
        asm volatile("" : "+v"(fr), "+v"(fq));
        EPI_LOOP8({ (void)first; *(v4u*)(Y + (size_t)row * DM + u.pn * 256 + col) = pack8(v0, v1); })
    }
};

__device__ __forceinline__ int iperm32(int c) { return ((c >> 2) & 1) * 16 + (c >> 3) * 4 + (c & 3); }
template <int MAP> __device__ __forceinline__ int map_col(int c) {
    if (MAP == 0) return c;
    if (MAP == 1) { if (c >= 2560 && (c < 2576 || c >= 2832)) return -1;
        const int d = c < 2560 ? c : PC_POOL + (c - 2576);
        return d < 1024 ? d : (d & ~31) + iperm32(d & 31); }
    if (MAP == 4) return (c & ~31) + iperm32(c & 31);
    { const int x = c & 31; return (c >> 7) * 256 + ((x >> 2) & 1) * 128 + ((c >> 5) & 3) * 32 + (MAP == 3 ? 16 : 0) + 4 * (x >> 3) + (x & 3); }
}
template <int MAP> __device__ __forceinline__ void tr_item(const float* W, int ldw, int N, bf16* WT, int ldd, int item, LAS float* scr, int lane) {
    const int nblk = (N + 31) / 32, kb = item / nblk, nb = item % nblk, k0 = 64 * kb, n0 = 32 * nb;
    const int cl = n0 + (lane & 31);
    float tv[32];
#pragma unroll
    for (int i = 0; i < 32; ++i) { const int kk = 2 * i + (lane >> 5); tv[i] = cl < N ? W[(size_t)(k0 + kk) * ldw + cl] : 0.f; }
#pragma unroll
    for (int i = 0; i < 32; ++i) { const int kk = 2 * i + (lane >> 5); scr[kk * 33 + (lane & 31)] = tv[i]; }
    LDS_WAIT(); asm volatile("" ::: "memory");
    const int c = lane & 7;
#pragma unroll
    for (int j = 0; j < 4; ++j) { const int n = (lane >> 3) + 8 * j; const LAS float* s = scr + (8 * c) * 33 + n;
        const int dr = n0 + n < N ? map_col<MAP>(n0 + n) : -1;
        if (dr >= 0) { v4u o; o.x = pk2(s[0 * 33], s[1 * 33]); o.y = pk2(s[2 * 33], s[3 * 33]); o.z = pk2(s[4 * 33], s[5 * 33]); o.w = pk2(s[6 * 33], s[7 * 33]);
            *(GAS v4u*)(WT + (size_t)dr * ldd + k0 + 8 * c) = o; } }
    LDS_WAIT(); asm volatile("" ::: "memory");
}
template <int MAP> __device__ __forceinline__ void tr_item8(const float* W, int ldw, int N, unsigned char* WT, int ldd, int item, LAS float* scr, int lane, float scale) {
    const int nblk = (N + 31) / 32, kb = item / nblk, nb = item % nblk, k0 = 64 * kb, n0 = 32 * nb;
    const int cl = n0 + (lane & 31);
    float tv[32];
#pragma unroll
    for (int i = 0; i < 32; ++i) { const int kk = 2 * i + (lane >> 5); tv[i] = cl < N ? W[(size_t)(k0 + kk) * ldw + cl] : 0.f; }
#pragma unroll
    for (int i = 0; i < 32; ++i) { const int kk = 2 * i + (lane >> 5); scr[kk * 33 + (lane & 31)] = tv[i]; }
    LDS_WAIT(); asm volatile("" ::: "memory");
    const int c = lane & 7;
#pragma unroll
    for (int j = 0; j < 4; ++j) { const int n = (lane >> 3) + 8 * j; const LAS float* s = scr + (8 * c) * 33 + n;
        if (n0 + n < N) { v2u o; o.x = cvt4_fp8(s[0 * 33] * scale, s[1 * 33] * scale, s[2 * 33] * scale, s[3 * 33] * scale); o.y = cvt4_fp8(s[4 * 33] * scale, s[5 * 33] * scale, s[6 * 33] * scale, s[7 * 33] * scale);
            *(GAS v2u*)(WT + (size_t)map_col<MAP>(n0 + n) * ldd + k0 + 8 * c) = o; } }
    LDS_WAIT(); asm volatile("" ::: "memory");
}
#define TR_RUN(MAP, W, ldw, K, N, WT, ldd) { const int cnt_ = ((K) / 64) * (((N) + 31) / 32); if (r < cnt_) { tr_item<MAP>(W, ldw, N, WT, ldd, r, scr, F.lane); continue; } r -= cnt_; }

constexpr int LW_ITEMS = 16 * 185 + 8 * 32 + 4 * 32 + 4 * 32 + 16 * 32 + 16 * 96 + 64;
__device__ __forceinline__ void conv_layer_weights(Frame& F, const Args& A, int l, int rank, int nranks) {
    LAS float* scr = (LAS float*)(F.lds + F.wave * 16384);
    bf16* WIN = (bf16*)(F.ws + WS_WIN); bf16* WBR = (bf16*)(F.ws + WS_WBR); bf16* WOUT = (bf16*)(F.ws + WS_WOUT);
    const float* win = A.in[F.zz + 8] + (size_t)l * 1024 * INW; const float* wbr = A.in[F.zz + 17] + (size_t)l * 1024 * 1024; const float* wo = A.in[F.zz + 18] + (size_t)l * 1024 * 1024;
    bf16* dbr = WBR + (size_t)l * 1024 * 1024;
    for (int it = rank; it < LW_ITEMS; it += nranks) {
        int r = it;
        { const int cnt_ = 16 * 185; if (r < cnt_) { tr_item<1>(win, INW, INW, WIN + (size_t)l * NPB * 1024, 1024, r, scr, F.lane); continue; } r -= cnt_; }
        { const int cnt_ = 8 * 32; if (r < cnt_) { tr_item<4>(wbr, 1024, 1024, dbr, 1024, r, scr, F.lane); continue; } r -= cnt_; }
        { const int cnt_ = 4 * 32; if (r < cnt_) { tr_item<4>(wbr + 512 * 1024, 1024, 1024, dbr + 512, 1024, r, scr, F.lane); continue; } r -= cnt_; }
        { const int cnt_ = 4 * 32; if (r < cnt_) { tr_item<4>(wbr + 768 * 1024, 1024, 1024, dbr + 768, 1024, r, scr, F.lane); continue; } r -= cnt_; }
        { const int cnt_ = 16 * 32; if (r < cnt_) { tr_item<4>(wo, 1024, 1024, WOUT + (size_t)l * 1024 * 1024, 1024, r, scr, F.lane); continue; } r -= cnt_; }
        { const int cnt_ = 16 * 96; if (r < cnt_) { tr_item8<4>(win + 2832, INW, 3072, F.ws + WS_WG8 + (size_t)l * 3072 * 1024, 1024, r, scr, F.lane, (float)(1 << F8_W13_L2)); continue; } r -= cnt_; }
        { bf16* wab = (bf16*)(F.ws + WS_WAB) + (size_t)l * 16384;
          for (int e = F.lane; e < 256; e += 64) { const int k = r * 16 + (e >> 4), c = e & 15; wab[c * 1024 + k] = (bf16)f2bf(win[(size_t)k * INW + 2560 + c]); } }
    }
}
__device__ __forceinline__ void p0_prologue(Frame& F, const Args& A) {
    LAS float* scr = (LAS float*)(F.lds + F.wave * 16384);
    const int gw = F.vcu * NWAVES + F.wave, NGW = F.G * NWAVES;
    bf16* W13 = (bf16*)(F.ws + WS_W13); bf16* W2 = (bf16*)(F.ws + WS_W2);
    conv_layer_weights(F, A, 0, gw, NGW);
    constexpr int TOTAL = 16 * 88 * 2 + 44 * 32;
    for (int it = gw; it < TOTAL; it += NGW) {
        int r = it;
#ifdef DENSE_F8
        { const int cnt_ = 16 * 88; if (r < cnt_) { tr_item8<2>(A.in[F.zz + 19], FFD, FFD, (unsigned char*)W13, 1024, r, scr, F.lane, (float)(1 << F8_W13_L2)); continue; } r -= cnt_; }
        { const int cnt_ = 16 * 88; if (r < cnt_) { tr_item8<3>(A.in[F.zz + 20], FFD, FFD, (unsigned char*)W13, 1024, r, scr, F.lane, (float)(1 << F8_W13_L2)); continue; } r -= cnt_; }
        tr_item8<4>(A.in[F.zz + 21], 1024, 1024, (unsigned char*)W2, FFD, r, scr, F.lane, (float)(1 << F8_W2_L2));
#else
        { const int cnt_ = 16 * 88; if (r < cnt_) { tr_item<2>(A.in[F.zz + 19], FFD, FFD, W13, 1024, r, scr, F.lane); continue; } r -= cnt_; }
        { const int cnt_ = 16 * 88; if (r < cnt_) { tr_item<3>(A.in[F.zz + 20], FFD, FFD, W13, 1024, r, scr, F.lane); continue; } r -= cnt_; }
        tr_item<4>(A.in[F.zz + 21], 1024, 1024, W2, FFD, r, scr, F.lane);
#endif
    }
    if (F.vcu == 0 && F.tid < 8) __hip_atomic_store(F.ctl + CW_ECNT + 64 * F.tid, 0u, RLX_AGENT);
    if (F.vcu == 0) {
        float* rope = (float*)(F.ws + WS_ROPE);
        for (int e = F.tid; e < 1024; e += NTHR) { const int pos = e >> 4, i = e & 15; const float inv = powf(10000.f, -(float)i / 16.f); const float a = (float)pos * inv;
            rope[2 * e] = cosf(a); rope[2 * e + 1] = sinf(a); }
        if (F.tid < 2) { const int l = F.tid; const float* lp = A.in[F.zz + 9] + l * 256; float s1 = 0.f, s2 = 0.f;
            for (int i = 0; i < 64; ++i) { s1 += lp[i] * lp[64 + i]; s2 += lp[128 + i] * lp[192 + i]; }
            const float li = 0.8f - 0.6f * expf(-0.3f * (float)l);
            ((float*)(F.ws + WS_LAM))[l] = expf(s1) - expf(s2) + li; }
    }
    __syncthreads();
    float* MOD = (float*)(F.ws + WS_MOD);
    LAS float* red = (LAS float*)F.lds;
    for (int task = F.vcu; task < 2 * 96; task += F.G) {
        const int l = task / 96, cc = task % 96;
        const float* aw = A.in[F.zz + 4] + (size_t)l * 1024 * 6144 + cc * 64 + F.lane;
        const float* c0 = A.in[F.zz + 1]; const float* cx = A.in[F.zz + 3];
        float a0 = 0.f, a1 = 0.f, a2 = 0.f, a3 = 0.f, a4 = 0.f;
#pragma unroll 8
        for (int i = 0; i < 128; ++i) { const int k = F.wave * 128 + i; const float w = aw[(size_t)k * 6144];
            a0 += siluf_(c0[k]) * w; a1 += siluf_(c0[1024 + k]) * w; a2 += siluf_(c0[2048 + k]) * w; a3 += siluf_(c0[3072 + k]) * w; a4 += siluf_(cx[k]) * w; }
        LAS float* rw = red + F.wave * 320 + F.lane;
        rw[0] = a0; rw[64] = a1; rw[128] = a2; rw[192] = a3; rw[256] = a4;
        __syncthreads();
        if (F.tid < 320) { float s = 0.f;
#pragma unroll
            for (int w = 0; w < 8; ++w) s += red[w * 320 + F.tid];
            const int rr = F.tid >> 6, jj = cc * 64 + (F.tid & 63);
            MOD[(l * 5 + rr) * 6144 + jj] = s + A.in[F.zz + 5][l * 6144 + jj]; }
        __syncthreads();
    }
}

template <int PART>
__device__ __forceinline__ void moe_convert(Frame& F, const Args& A, int rank, int nranks) {
    LAS float* scr = (LAS float*)(F.lds + F.wave * 16384);
    const int gw = rank, NGW = nranks;
    unsigned char* W13M = F.ws + WS_W13M; unsigned char* W2M = F.ws + WS_W2M;
    constexpr int I13 = 16 * 112, I2 = 56 * 32;
    if (PART == 0) {
        for (int it = gw; it < 8 * I2; it += NGW) { const int e = it / I2, r = it - e * I2;
            tr_item8<4>(A.in[F.zz + 25] + (size_t)e * FFE * 1024, 1024, 1024, W2M + (size_t)e * 1024 * FFE, FFE, r, scr, F.lane, (float)(1 << F8_W2_L2)); }
    } else {
        for (int it = gw; it < 16 * I13; it += NGW) { const int e = it / (2 * I13); int r = it - e * 2 * I13;
            if (r < I13) { tr_item8<2>(A.in[F.zz + 23] + (size_t)e * 1024 * FFE, FFE, FFE, W13M + (size_t)e * 2 * FFE * 1024, 1024, r, scr, F.lane, (float)(1 << F8_W13_L2)); continue; } r -= I13;
            tr_item8<3>(A.in[F.zz + 24] + (size_t)e * 1024 * FFE, FFE, FFE, W13M + (size_t)e * 2 * FFE * 1024, 1024, r, scr, F.lane, (float)(1 << F8_W13_L2)); }
    }
}

__device__ __forceinline__ void norm_mod_phase(Frame& F, const Args& A, int l, int which, bool latent_only, bool route, bool out8 = false, int nslab = 0, int srcmode = 0) {
    (void)latent_only; (void)route;
    const int gw = F.vcu * NWAVES + F.wave, NGW = F.G * NWAVES;
    const float* H = (const float*)(F.ws + WS_H); bf16* U = (bf16*)(F.ws + WS_U); const float* MOD = (const float*)(F.ws + WS_MOD) + l * 5 * 6144;
    const float* g = (which ? A.in[F.zz + 7] : A.in[F.zz + 6]) + l * 1024;
    const float* xin = A.in[F.zz + 0]; const float* cin = A.in[F.zz + 2];
#define NM_SRC(R_) ({ const int b_ = (R_) / RPB, j_ = (R_) - b_ * RPB; const float* p_ = (srcmode == 1 || (srcmode == 2 && j_ < CTXL)) ? (j_ < CTXL ? cin + ((size_t)b_ * CTXL + j_) * DM : xin + ((size_t)b_ * SEQ + (j_ - CTXL)) * DM) : H + (size_t)(R_) * DM; p_; })
    f32x4 nv[4];
    if (gw < MROWS) { const GAS f32x4* xr = (const GAS f32x4*)NM_SRC(gw) + F.lane;
#pragma unroll
        for (int q = 0; q < 4; ++q) nv[q] = xr[64 * q]; }
#pragma unroll 1
    for (int R = gw; R < MROWS; R += NGW) {
        const int b = R / RPB, j = R - b * RPB; const bool isctx = j < CTXL;
        const float* mod = MOD + (isctx ? 4 : b) * 6144; const float* shift = mod + (which ? 3 : 0) * 1024; const float* scale = mod + (which ? 4 : 1) * 1024;
        f32x4 v[4]; float ss = 0.f;
#pragma unroll
        for (int q = 0; q < 4; ++q) v[q] = nv[q];
        if (R + NGW < MROWS) { const GAS f32x4* xr = (const GAS f32x4*)NM_SRC(R + NGW) + F.lane;
#pragma unroll
            for (int q = 0; q < 4; ++q) nv[q] = xr[64 * q]; }
        if (nslab > 0 && isctx) {
            const GAS f32x4* sp = (const GAS f32x4*)((const float*)(F.ws + WS_SLAB) + (size_t)(b * 256 + j) * 1024) + F.lane;
#pragma unroll
            for (int q = 0; q < 4; ++q) { f32x4 t[11];
#pragma unroll
                for (int s = 0; s < 11; ++s) t[s] = s < nslab ? sp[(size_t)s * 262144 + 64 * q] : (f32x4){0.f, 0.f, 0.f, 0.f};
#pragma unroll
                for (int s = 0; s < 11; ++s) v[q] += t[s]; }
            GAS f32x4* hw = (GAS f32x4*)(F.ws + WS_H + (size_t)R * DM * 4) + F.lane;
#pragma unroll
            for (int q = 0; q < 4; ++q) hw[64 * q] = v[q]; }
#pragma unroll
        for (int q = 0; q < 4; ++q) ss += (v[q].x * v[q].x + v[q].y * v[q].y) + (v[q].z * v[q].z + v[q].w * v[q].w);
        const float rstd = 1.f / sqrtf(wave_sum(ss) * (1.f / DM) + EPSN);
        GAS v2u* o8 = (GAS v2u*)(U + (size_t)R * DM) + F.lane;
#pragma unroll
        for (int q = 0; q < 4; ++q) { const int c = 4 * F.lane + 256 * q; const f32x4 gg = *(const f32x4*)(g + c), sh = *(const f32x4*)(shift + c), sc = *(const f32x4*)(scale + c);
            v[q] = (v[q] * rstd) * gg * (sc + 1.f) + sh;
            if (out8) { const float s8 = (float)(1 << F8_ACT_L2); ((GAS unsigned*)((unsigned char*)U + (size_t)R * DM))[F.lane + 64 * q] = cvt4_fp8(v[q].x * s8, v[q].y * s8, v[q].z * s8, v[q].w * s8); }
            else { v2u w; w.x = pk2(v[q].x, v[q].y); w.y = pk2(v[q].z, v[q].w); o8[64 * q] = w; } }
        if (which == 0) {
            const float s8 = (float)(1 << F8_ACT_L2);
#pragma unroll
            for (int q = 0; q < 4; ++q) ((GAS unsigned*)(F.ws + WS_U8 + (size_t)R * DM))[F.lane + 64 * q] = cvt4_fp8(v[q].x * s8, v[q].y * s8, v[q].z * s8, v[q].w * s8);
        }
    }
}
__device__ __forceinline__ void norm2_route_phase(Frame& F, const Args& A) {
    const int l = 1;
    const float* H = (const float*)(F.ws + WS_H); bf16* U = (bf16*)(F.ws + WS_U); const float* MOD = (const float*)(F.ws + WS_MOD) + l * 5 * 6144;
    const float* g = A.in[F.zz + 7] + l * 1024; const float* rw = A.in[F.zz + 22];
    LAS unsigned* wcnt = (LAS unsigned*)F.lds;
    LAS unsigned* gbase = wcnt + 64;
    const int lane = F.lane, wv = F.wave;
    for (int blk = F.vcu; blk < NB * SEQ / 64; blk += F.G) {
        int me0 = 0, me1 = 0; float mw0 = 0.f, mw1 = 0.f;
        f32x4 nv[4];
        { const int tk = blk * 64 + wv * 8, b = tk / SEQ, t = tk - b * SEQ; const GAS f32x4* xr = (const GAS f32x4*)(H + ((size_t)b * RPB + CTXL + t) * DM) + lane;
#pragma unroll
          for (int q = 0; q < 4; ++q) nv[q] = xr[64 * q]; }
#pragma unroll 1
        for (int i = 0; i < 8; ++i) {
            const int tk = blk * 64 + wv * 8 + i, b = tk / SEQ, t = tk - b * SEQ; const size_t R = (size_t)b * RPB + CTXL + t;
            const float* mod = MOD + b * 6144; const float* shift = mod + 3 * 1024; const float* scale = mod + 4 * 1024;
            f32x4 v[4]; float ss = 0.f;
#pragma unroll
            for (int q = 0; q < 4; ++q) { v[q] = nv[q]; ss += (v[q].x * v[q].x + v[q].y * v[q].y) + (v[q].z * v[q].z + v[q].w * v[q].w); }
            if (i < 7) { const GAS f32x4* xr = (const GAS f32x4*)(H + (R + 1) * DM) + lane;
#pragma unroll
                for (int q = 0; q < 4; ++q) nv[q] = xr[64 * q]; }
            const float rstd = 1.f / sqrtf(wave_sum(ss) * (1.f / DM) + EPSN);
            GAS v2u* o8 = (GAS v2u*)(U + R * DM) + lane;
            float lg[8] = {0, 0, 0, 0, 0, 0, 0, 0};
#pragma unroll
            for (int q = 0; q < 4; ++q) { const int c = 4 * lane + 256 * q; const f32x4 gg = *(const f32x4*)(g + c), sh = *(const f32x4*)(shift + c), sc = *(const f32x4*)(scale + c);
                v[q] = (v[q] * rstd) * gg * (sc + 1.f) + sh; v2u w; w.x = pk2(v[q].x, v[q].y); w.y = pk2(v[q].z, v[q].w); o8[64 * q] = w;
#pragma unroll
                for (int j = 0; j < 4; ++j) { const int k = c + j; const f32x4 w0 = *(const f32x4*)(rw + k * 8), w1 = *(const f32x4*)(rw + k * 8 + 4); const float x = v[q][j];
                    lg[0] += x * w0[0]; lg[1] += x * w0[1]; lg[2] += x * w0[2]; lg[3] += x * w0[3]; lg[4] += x * w1[0]; lg[5] += x * w1[1]; lg[6] += x * w1[2]; lg[7] += x * w1[3]; } }
#pragma unroll
            for (int e = 0; e < 8; ++e) lg[e] = wave_sum(lg[e]);
            int e0 = 0; float v0 = lg[0];
#pragma unroll
            for (int e = 1; e < 8; ++e) if (lg[e] > v0) { v0 = lg[e]; e0 = e; }
            int e1 = -1; float v1 = -3.0e38f;
#pragma unroll
            for (int e = 0; e < 8; ++e) if (e != e0 && lg[e] > v1) { v1 = lg[e]; e1 = e; }
            const float ex = __expf(v1 - v0);
            if (lane == i) { me0 = e0; me1 = e1; mw0 = 1.f / (1.f + ex); mw1 = ex / (1.f + ex); }
        }
        const bool act = lane < 8; const unsigned long long below = (1ull << lane) - 1ull;
        unsigned r0 = 0, r1 = 0, mycnt = 0;
#pragma unroll
        for (int e = 0; e < 8; ++e) { const unsigned long long m0 = __ballot(act && me0 == e), m1 = __ballot(act && me1 == e);
            const unsigned bel = (unsigned)__popcll((m0 | m1) & below);
            if (me0 == e) r0 = bel; if (me1 == e) r1 = bel;
            if (lane == e) mycnt = (unsigned)__popcll(m0) + (unsigned)__popcll(m1); }
        if (act) wcnt[wv * 8 + lane] = mycnt;
        __syncthreads();
        if (F.tid < 8) { unsigned tot = 0;
#pragma unroll
            for (int w = 0; w < 8; ++w) tot += wcnt[w * 8 + F.tid];
            gbase[F.tid] = __hip_atomic_fetch_add(F.ctl + CW_ECNT + 64 * F.tid, tot, RLX_AGENT); }
        __syncthreads();
        if (act) { unsigned b0 = gbase[me0], b1 = gbase[me1];
            for (int w = 0; w < wv; ++w) { b0 += wcnt[w * 8 + me0]; b1 += wcnt[w * 8 + me1]; }
            const int tk = blk * 64 + wv * 8 + lane;
            v4u* rt = (v4u*)(F.ws + WS_ROUTE) + 2 * tk;
            rt[0] = (v4u){(unsigned)me0, (unsigned)me1, b0 + r0, b1 + r1}; rt[1] = (v4u){__float_as_uint(mw0), __float_as_uint(mw1), 0u, 0u}; }
        __syncthreads();
    }
}

__device__ __forceinline__ void ab_tiles(Frame& F, const Args& A, int l) {
    typedef short ab_s16x8 __attribute__((ext_vector_type(8)));
    const int gw = F.vcu * NWAVES + F.wave, NGW = F.G * NWAVES, r = F.lane & 15, q = F.lane >> 4;
    const bf16* U = (const bf16*)(F.ws + WS_U); const bf16* wab = (const bf16*)(F.ws + WS_WAB) + (size_t)l * 16384 + r * 1024 + 8 * q;
    const float alog = A.in[F.zz + 12][l * 8 + (r & 7)], dtb = A.in[F.zz + 13][l * 8 + (r & 7)];
    for (int t = gw; t < MROWS / 16; t += NGW) {
        const bf16* up = U + (size_t)(t * 16 + r) * DM + 8 * q; f32x4 acc = {0.f, 0.f, 0.f, 0.f};
#pragma unroll 8
        for (int ks = 0; ks < 32; ++ks) acc = __builtin_amdgcn_mfma_f32_16x16x32_bf16(*(const ab_s16x8*)(up + 32 * ks), *(const ab_s16x8*)(wab + 32 * ks), acc, 0, 0, 0);
        f32x4 o;
#pragma unroll
        for (int g = 0; g < 4; ++g) { const float x = acc[g];
            if (r < 8) { const float z = x + dtb; const float ez = __expf(z); const float sp = z > 15.f ? z : (ez < 0.03f ? ez * (1.f - ez * (0.5f - ez * (1.f / 3.f))) : __logf(1.f + ez)); o[g] = -__expf(alog) * sp; }
            else o[g] = sigmoidf_(x); }
        float* gb = (float*)(F.ws + WS_GB) + (size_t)(t * 16 + 4 * q) * 16 + r;
        gb[0] = o[0]; gb[16] = o[1]; gb[32] = o[2]; gb[48] = o[3];
    }
}

__device__ __forceinline__ void moe_gather2(Frame& F) {
    const int gw = F.vcu * NWAVES + F.wave, NGW = F.G * NWAVES;
    MoeOrder mo; mo.init(F.ctl + CW_ECNT, 1, 1, 0);
    const bf16* U = (const bf16*)(F.ws + WS_U); unsigned char* XG = F.ws + WS_XG; const float sc = (float)(1 << F8_ACT_L2);
    for (int tk = gw; tk < NB * SEQ; tk += NGW) {
        const int b = tk / SEQ, t = tk - b * SEQ; const size_t R = (size_t)b * RPB + CTXL + t;
        const v4u rt = ((const v4u*)(F.ws + WS_ROUTE))[2 * tk];
        const size_t r0 = (size_t)mo.tile_off((int)rt.x) * 256 + rt.z, r1 = (size_t)mo.tile_off((int)rt.y) * 256 + rt.w;
        const GAS v4u* s = (const GAS v4u*)(U + R * DM) + 2 * F.lane; const v4u a = s[0], c = s[1];
        v4u o; o.x = cvt4_fp8(bf_lo(a.x) * sc, bf_hi(a.x) * sc, bf_lo(a.y) * sc, bf_hi(a.y) * sc); o.y = cvt4_fp8(bf_lo(a.z) * sc, bf_hi(a.z) * sc, bf_lo(a.w) * sc, bf_hi(a.w) * sc);
        o.z = cvt4_fp8(bf_lo(c.x) * sc, bf_hi(c.x) * sc, bf_lo(c.y) * sc, bf_hi(c.y) * sc); o.w = cvt4_fp8(bf_lo(c.z) * sc, bf_hi(c.z) * sc, bf_lo(c.w) * sc, bf_hi(c.w) * sc);
        *((GAS v4u*)(XG + r0 * DM) + F.lane) = o; *((GAS v4u*)(XG + r1 * DM) + F.lane) = o;
    }
}
__device__ __forceinline__ void moe_gather(Frame& F) {
    moe_gather2(F);
}
__device__ __forceinline__ void final_phase(Frame& F, const Args& A) {
    const int gw = F.vcu * NWAVES + F.wave, NGW = F.G * NWAVES;
    MoeOrder mo; mo.init(F.ctl + CW_ECNT, 1, 1, 0);
    const float* H = (const float*)(F.ws + WS_H); const bf16* Y = (const bf16*)(F.ws + WS_Y); const float* MOD = (const float*)(F.ws + WS_MOD) + 1 * 5 * 6144;
    for (int tk = gw; tk < NB * SEQ; tk += NGW) {
        const int b = tk / SEQ, t = tk - b * SEQ; const size_t R = (size_t)b * RPB + CTXL + t;
        const v4u rt = ((const v4u*)(F.ws + WS_ROUTE))[2 * tk], rw = ((const v4u*)(F.ws + WS_ROUTE))[2 * tk + 1];
        const size_t r0 = (size_t)mo.tile_off((int)rt.x) * 256 + rt.z, r1 = (size_t)mo.tile_off((int)rt.y) * 256 + rt.w;
        const float w0 = __uint_as_float(rw.x), w1 = __uint_as_float(rw.y);
        const float* gate = MOD + b * 6144 + 5 * 1024;
        f32x4 v[4]; float ss = 0.f;
#pragma unroll
        for (int q = 0; q < 4; ++q) { const int c = 4 * F.lane + 256 * q;
            const f32x4 h = *(const f32x4*)(H + R * DM + c), gg = *(const f32x4*)(gate + c);
            const f32x4 y0 = unpack4(*(const v2u*)(Y + r0 * DM + c)), y1 = unpack4(*(const v2u*)(Y + r1 * DM + c));
            v[q] = h + gg * (y0 * w0 + y1 * w1); ss += (v[q].x * v[q].x + v[q].y * v[q].y) + (v[q].z * v[q].z + v[q].w * v[q].w); }
        const float rstd = 1.f / sqrtf(wave_sum(ss) * (1.f / DM) + EPSN);
#pragma unroll
        for (int q = 0; q < 4; ++q) { const int c = 4 * F.lane + 256 * q; *(f32x4*)(F.out + (size_t)tk * DM + c) = v[q] * rstd * *(const f32x4*)(A.in[F.zz + 26] + c); }
    }
}

constexpr int DP = 65;
typedef short dn_bf16x8 __attribute__((ext_vector_type(8)));
__device__ __forceinline__ f32x4 mm_tile(const LAS float* Am, int a_sm, int a_sk, const LAS float* Bm, int b_sk, int b_sn, int m0, int n0, int lane) {
    const int r = lane & 15, q = lane >> 4; f32x4 acc = {0.f, 0.f, 0.f, 0.f};
#pragma unroll
    for (int ks = 0; ks < 2; ++ks) {
        const LAS float* ap = Am + (m0 + r) * a_sm + (32 * ks + 8 * q) * a_sk; const LAS float* bp = Bm + (32 * ks + 8 * q) * b_sk + (n0 + r) * b_sn;
        v4u a, b;
        a.x = pk2(ap[0], ap[a_sk]); a.y = pk2(ap[2 * a_sk], ap[3 * a_sk]); a.z = pk2(ap[4 * a_sk], ap[5 * a_sk]); a.w = pk2(ap[6 * a_sk], ap[7 * a_sk]);
        b.x = pk2(bp[0], bp[b_sk]); b.y = pk2(bp[2 * b_sk], bp[3 * b_sk]); b.z = pk2(bp[4 * b_sk], bp[5 * b_sk]); b.w = pk2(bp[6 * b_sk], bp[7 * b_sk]);
        acc = __builtin_amdgcn_mfma_f32_16x16x32_bf16(__builtin_bit_cast(dn_bf16x8, a), __builtin_bit_cast(dn_bf16x8, b), acc, 0, 0, 0);
    }
    return acc;
}

constexpr int RS = 72;
constexpr int IMG = 64 * RS * 2;
typedef short dn_s16x4 __attribute__((ext_vector_type(4)));
__device__ __forceinline__ f32x4 mm_img(const LAS bf16* Ai, const LAS bf16* Bi, int m0, int n0, int r, int q) {
    f32x4 acc = {0.f, 0.f, 0.f, 0.f};
    const LAS bf16* ap = Ai + (m0 + r) * RS + 8 * q; const LAS bf16* bp = Bi + (n0 + r) * RS + 8 * q;
    acc = __builtin_amdgcn_mfma_f32_16x16x32_bf16(*(const LAS dn_bf16x8*)ap, *(const LAS dn_bf16x8*)bp, acc, 0, 0, 0);
    acc = __builtin_amdgcn_mfma_f32_16x16x32_bf16(*(const LAS dn_bf16x8*)(ap + 32), *(const LAS dn_bf16x8*)(bp + 32), acc, 0, 0, 0);
    return acc;
}
template <int D> __device__ __forceinline__ void dn_diag_inv(LAS float* Dg, int ln) {
    const int blk = ln >> 4, r = ln & 15;
    LAS float* Ab = Dg + blk * 256;
    float t[16];
#pragma unroll
    for (int c = 0; c < 16; ++c) t[c] = (c == r) ? 1.f : 0.f;
#pragma unroll
    for (int c = 14; c >= 0; --c) { float s = 0.f;
#pragma unroll
        for (int j = c + 1; j < 16; ++j) { const float a = D == 0 ? Ab[j * 16 + c] : Ab[(15 - j) * 16 + (15 - c)]; s -= t[j] * a; }
        t[c] = (c < r) ? s : t[c]; }
    asm volatile("s_waitcnt lgkmcnt(0)" ::: "memory");
#pragma unroll
    for (int c = 0; c < 16; ++c) { if (D == 0) Ab[r * 16 + c] = t[c]; else Ab[(15 - r) * 16 + (15 - c)] = t[c]; }
}
template <int D> __device__ __forceinline__ void dn_solve_tiles(const LAS bf16* Ad, const LAS float* Dg, const LAS bf16* VT, const LAS bf16* KT, LAS bf16* UT, LAS bf16* WT,
                                                               const LAS float* Bd, const LAS float* Gd, int w4, int ln) {
    const int r = ln & 15, q = ln >> 4;
#pragma unroll 1
    for (int i = 0; i < 2; ++i) { const int nt = w4 * 2 + i; const bool isw = nt >= 4; const int c0 = (nt & 3) * 16 + r;
        const LAS bf16* src = (isw ? KT : VT) + c0 * RS; LAS bf16* dst = (isw ? WT : UT) + c0 * RS;
        f32x4 acc[4]; dn_s16x4 xb[4];
#pragma unroll
        for (int bi = 0; bi < 4; ++bi) { const v2u x = *(const LAS v2u*)(src + 16 * bi + 4 * q); const f32x4 xv = {bf_lo(x.x), bf_hi(x.x), bf_lo(x.y), bf_hi(x.y)};
#pragma unroll
            for (int g = 0; g < 4; ++g) { const int t = 16 * bi + 4 * q + g; const float sc = isw ? Bd[t] * __expf(Gd[t]) : Bd[t]; acc[bi][g] = xv[g] * sc; } }
#pragma unroll
        for (int st = 0; st < 4; ++st) { const int bi = D == 0 ? st : 3 - st;
#pragma unroll
            for (int s2 = 0; s2 < st; ++s2) { const int bj = D == 0 ? s2 : 3 - s2;
                v2u a = *(const LAS v2u*)(Ad + (16 * bi + r) * RS + 16 * bj + 4 * q); a.x ^= 0x80008000u; a.y ^= 0x80008000u;
                acc[bi] = __builtin_amdgcn_mfma_f32_16x16x16bf16_1k(__builtin_bit_cast(dn_s16x4, a), xb[bj], acc[bi], 0, 0, 0); }
            { const LAS float* tp = Dg + bi * 256 + r * 16 + 4 * q; v2u a; a.x = cvtpk_c(tp[0], tp[1]); a.y = cvtpk_c(tp[2], tp[3]);
              v2u xr; xr.x = cvtpk_c(acc[bi][0], acc[bi][1]); xr.y = cvtpk_c(acc[bi][2], acc[bi][3]);
              acc[bi] = __builtin_amdgcn_mfma_f32_16x16x16bf16_1k(__builtin_bit_cast(dn_s16x4, a), __builtin_bit_cast(dn_s16x4, xr), (f32x4){0.f, 0.f, 0.f, 0.f}, 0, 0, 0);
              v2u xo; xo.x = cvtpk_c(acc[bi][0], acc[bi][1]); xo.y = cvtpk_c(acc[bi][2], acc[bi][3]); xb[bi] = __builtin_bit_cast(dn_s16x4, xo);
              *(LAS v2u*)(dst + 16 * bi + 4 * q) = xo; }
        }
    }
}
__device__ __forceinline__ void dn_pre_unit(Frame& F, const Args& A, int l, int b, int n, int h) {
    LAS bf16* KcB = (LAS bf16*)(F.lds + 0 * IMG); LAS bf16* QcB = (LAS bf16*)(F.lds + 1 * IMG); LAS bf16* KT = (LAS bf16*)(F.lds + 2 * IMG); LAS bf16* VT = (LAS bf16*)(F.lds + 3 * IMG);
#define DIMG(d, k) ((LAS bf16*)(F.lds + (4 + 5 * (d) + (k)) * IMG))
    LAS float* Gs = (LAS float*)(F.lds + 14 * IMG);
    LAS float* Bs = Gs + 128;
    LAS float* Dg = Gs + 256;
    const bf16* P = (const bf16*)(F.ws + WS_PROJ); const float* GB = (const float*)(F.ws + WS_GB);
    const int tid = pg8::tid_from(F.wid_s);
    const int wv = tid >> 6, ln = tid & 63, r = ln & 15, q = ln >> 4;
    const int row0 = b * RPB + n * 64; const int seq_lo = (n < 4) ? b * RPB : b * RPB + CTXL, seq_hi = (n < 4) ? b * RPB + CTXL : (b + 1) * RPB;
    {
        const int t = tid >> 3, cg = tid & 7;
        const float* cw = A.in[F.zz + 11] + (size_t)l * 5 * 768;
#pragma unroll
        for (int p = 0; p < 3; ++p) {
            const int ch = p * 256 + h * 64 + cg * 8;
            float acc[8] = {0, 0, 0, 0, 0, 0, 0, 0};
#pragma unroll
            for (int tap = 0; tap < 5; ++tap) { const int rr = row0 + t + tap - 2;
                if (rr >= seq_lo && rr < seq_hi) { const v4u x = *(const v4u*)(P + (size_t)rr * PLD + PC_DQ + ch);
                    const f32x4 w0 = *(const f32x4*)(cw + tap * 768 + ch), w1 = *(const f32x4*)(cw + tap * 768 + ch + 4);
                    acc[0] += bf_lo(x.x) * w0[0]; acc[1] += bf_hi(x.x) * w0[1]; acc[2] += bf_lo(x.y) * w0[2]; acc[3] += bf_hi(x.y) * w0[3];
                    acc[4] += bf_lo(x.z) * w1[0]; acc[5] += bf_hi(x.z) * w1[1]; acc[6] += bf_lo(x.w) * w1[2]; acc[7] += bf_hi(x.w) * w1[3]; } }
            float ss = 0.f;
#pragma unroll
            for (int i = 0; i < 8; ++i) { acc[i] = siluf_(acc[i]); ss += acc[i] * acc[i]; }
            float sc = 1.f;
            if (p < 2) { ss = grp8_sum(ss); sc = (1.f / sqrtf(ss + EPSN)) * (p == 0 ? 0.125f : 1.f); }
            v4u o; o.x = cvtpk_c(acc[0] * sc, acc[1] * sc); o.y = cvtpk_c(acc[2] * sc, acc[3] * sc); o.z = cvtpk_c(acc[4] * sc, acc[5] * sc); o.w = cvtpk_c(acc[6] * sc, acc[7] * sc);
            if (p == 0) *(LAS v4u*)(QcB + t * RS + cg * 8) = o;
            else { if (p == 1) *(LAS v4u*)(KcB + t * RS + cg * 8) = o;
                LAS bf16* tp = (p == 1 ? KT : VT) + (cg * 8) * RS + t;
                tp[0 * RS] = (bf16)(o.x & 0xffffu); tp[1 * RS] = (bf16)(o.x >> 16); tp[2 * RS] = (bf16)(o.y & 0xffffu); tp[3 * RS] = (bf16)(o.y >> 16);
                tp[4 * RS] = (bf16)(o.z & 0xffffu); tp[5 * RS] = (bf16)(o.z >> 16); tp[6 * RS] = (bf16)(o.w & 0xffffu); tp[7 * RS] = (bf16)(o.w >> 16); }
        }
        if (wv < 2) { const int d = wv; const float* gb = GB + (size_t)(row0 + ln) * 16; const float g = gb[d * 4 + h]; Bs[d * 64 + ln] = gb[8 + d * 4 + h];
            float pf = g;
            { const int lid = lane_id_();
#pragma unroll
              for (int o = 1; o < 64; o <<= 1) { const float v = lane_get(pf, lid >= o ? lid - o : lid); if (lid >= o) pf += v; }
            }
            const float tot = lane_get(pf, 63);
            Gs[d * 64 + ln] = d == 0 ? pf : tot - pf + g; }
    }
    __syncthreads();
    {
#pragma unroll
        for (int i = 0; i < 2; ++i) { const int tile = wv * 2 + i, m0 = (tile >> 2) * 16, n0 = (tile & 3) * 16;
            const f32x4 kk = mm_img(KcB, KcB, m0, n0, r, q), qk = mm_img(QcB, KcB, m0, n0, r, q);
            const int s = n0 + r; const float g0s = Gs[s], g1s = Gs[64 + s];
#pragma unroll
            for (int g = 0; g < 4; ++g) { const int t = m0 + 4 * q + g; const float e0 = __expf(Gs[t] - g0s), e1 = __expf(Gs[64 + t] - g1s);
                const float a0 = (s < t) ? Bs[t] * kk[g] * e0 : 0.f, a1 = (s > t) ? Bs[64 + t] * kk[g] * e1 : 0.f;
                DIMG(0, 0)[t * RS + s] = (bf16)f2bf(a0); DIMG(1, 0)[t * RS + s] = (bf16)f2bf(a1);
                DIMG(0, 1)[t * RS + s] = (bf16)f2bf((s <= t) ? qk[g] * e0 : 0.f); DIMG(1, 1)[t * RS + s] = (bf16)f2bf((s >= t) ? qk[g] * e1 : 0.f);
                if (m0 == n0) { Dg[(m0 >> 4) * 256 + (t & 15) * 16 + r] = a0; Dg[1024 + (m0 >> 4) * 256 + (t & 15) * 16 + r] = a1; } } }
        { const int c = tid >> 3, t0 = (tid & 7) * 8; const v4u kx = *(const LAS v4u*)(KT + c * RS + t0); const float gl0 = Gs[63], gl1 = Gs[64];
          const float kf[8] = {bf_lo(kx.x), bf_hi(kx.x), bf_lo(kx.y), bf_hi(kx.y), bf_lo(kx.z), bf_hi(kx.z), bf_lo(kx.w), bf_hi(kx.w)};
          float s0[8], s1[8];
#pragma unroll
          for (int j = 0; j < 8; ++j) { s0[j] = kf[j] * __expf(gl0 - Gs[t0 + j]); s1[j] = kf[j] * __expf(gl1 - Gs[64 + t0 + j]); }
          v4u o0, o1; o0.x = cvtpk_c(s0[0], s0[1]); o0.y = cvtpk_c(s0[2], s0[3]); o0.z = cvtpk_c(s0[4], s0[5]); o0.w = cvtpk_c(s0[6], s0[7]);
          o1.x = cvtpk_c(s1[0], s1[1]); o1.y = cvtpk_c(s1[2], s1[3]); o1.z = cvtpk_c(s1[4], s1[5]); o1.w = cvtpk_c(s1[6], s1[7]);
          *(LAS v4u*)(DIMG(0, 4) + c * RS + t0) = o0; *(LAS v4u*)(DIMG(1, 4) + c * RS + t0) = o1; }
    }
    __syncthreads();
    if (wv == 0) dn_diag_inv<0>(Dg, ln); else if (wv == 4) dn_diag_inv<1>(Dg + 1024, ln);
    __syncthreads();
    if (wv < 4) dn_solve_tiles<0>(DIMG(0, 0), Dg, VT, KT, DIMG(0, 3), DIMG(0, 2), Bs, Gs, wv & 3, ln);
    else dn_solve_tiles<1>(DIMG(1, 0), Dg + 1024, VT, KT, DIMG(1, 3), DIMG(1, 2), Bs + 64, Gs + 64, wv & 3, ln);
    __syncthreads();
    {
        const int d = wv >> 2, mt = wv & 3;
        const LAS bf16* Aq = DIMG(d, 1); const LAS bf16* WT = DIMG(d, 2); const LAS bf16* UT = DIMG(d, 3); const LAS bf16* KsT = DIMG(d, 4); const LAS float* Gd = Gs + d * 64;
        const float glast = d == 0 ? Gd[63] : Gd[0];
        const size_t prob = (((size_t)b * NCHUNK + n) * 4 + h) * 2 + d;
        unsigned char* out = F.ws + WS_DNP + prob * 32768;
        if (ln == 0 && mt == 0) ((float*)(F.ws + WS_DNG))[prob] = __expf(glast);
        const float gq = __expf(Gd[16 * mt + r]);
#pragma unroll
        for (int ks = 0; ks < 2; ++ks) {
            const f32x4 y0 = mm_img(WT, Aq, 32 * ks, 16 * mt, r, q), y1 = mm_img(WT, Aq, 32 * ks + 16, 16 * mt, r, q);
            const LAS bf16* qp = QcB + (16 * mt + r) * RS + 32 * ks + 4 * q; const v2u qa = *(const LAS v2u*)qp, qb = *(const LAS v2u*)(qp + 16);
            v4u o; o.x = cvtpk_c(gq * bf_lo(qa.x) - y0[0], gq * bf_hi(qa.x) - y0[1]); o.y = cvtpk_c(gq * bf_lo(qa.y) - y0[2], gq * bf_hi(qa.y) - y0[3]);
            o.z = cvtpk_c(gq * bf_lo(qb.x) - y1[0], gq * bf_hi(qb.x) - y1[1]); o.w = cvtpk_c(gq * bf_lo(qb.y) - y1[2], gq * bf_hi(qb.y) - y1[3]);
            *(v4u*)(out + (mt * 2 + ks) * 1024 + ln * 16) = o;
            const f32x4 c0 = mm_img(WT, KsT, 32 * ks, 16 * mt, r, q), c1 = mm_img(WT, KsT, 32 * ks + 16, 16 * mt, r, q);
            v4u oc; oc.x = cvtpk_c(-c0[0], -c0[1]); oc.y = cvtpk_c(-c0[2], -c0[3]); oc.z = cvtpk_c(-c1[0], -c1[1]); oc.w = cvtpk_c(-c1[2], -c1[3]);
            *(v4u*)(out + 8192 + (mt * 2 + ks) * 1024 + ln * 16) = oc; }
#pragma unroll
        for (int nt = 0; nt < 4; ++nt) { const f32x4 rr = mm_img(Aq, UT, 16 * mt, 16 * nt, r, q), bb = mm_img(KsT, UT, 16 * mt, 16 * nt, r, q);
            v2u o; o.x = cvtpk_c(rr[0], rr[1]); o.y = cvtpk_c(rr[2], rr[3]); *(v2u*)(out + 16384 + (mt * 4 + nt) * 512 + ln * 8) = o;
            v2u ob; ob.x = cvtpk_c(bb[0], bb[1]); ob.y = cvtpk_c(bb[2], bb[3]); *(v2u*)(out + 24576 + (mt * 4 + nt) * 512 + ln * 8) = ob; }
    }
    __syncthreads();
#ifdef DBG_DN
    { unsigned char* out = F.ws + WS_DNP + ((((size_t)b * NCHUNK + n) * 4 + h) * 2) * 32768;
      if (DBG_DN < 14) { const LAS bf16* im = (const LAS bf16*)(F.lds + DBG_DN * IMG);
          for (int e = tid; e < 4096; e += NTHR) ((bf16*)out)[e] = im[(e >> 6) * RS + (e & 63)]; }
      else { for (int e = tid; e < 2304; e += NTHR) ((bf16*)out)[e] = (bf16)f2bf(Gs[e]); for (int e = 2304 + tid; e < 4096; e += NTHR) ((bf16*)out)[e] = 0; } }
    __syncthreads();
#endif
#undef DIMG
}

__device__ __forceinline__ void pool_unit(Frame& F, const Args& A, int l, int blk, int g) {
    LAS float* Uw = (LAS float*)F.lds;
    LAS float* Mm = Uw + 80 * DP;
    LAS float* PW = Mm + 64 * DP;
    const bf16* P = (const bf16*)(F.ws + WS_PROJ); bf16* PO = (bf16*)(F.ws + WS_POOLO);
    const int tid = pg8::tid_from(F.wid_s);
    const int row0 = blk * 64, b = row0 / RPB, j0 = row0 - b * RPB; const bool isctx = j0 < CTXL;
    const int seq_lo = isctx ? b * RPB : b * RPB + CTXL, L = isctx ? CTXL : SEQ; const int pos0 = row0 - seq_lo;
    for (int idx = tid; idx < 640; idx += NTHR) { const int rr = idx >> 3, c8 = (idx & 7) * 8; const int pos = pos0 - 8 + rr;
        float v[8] = {0, 0, 0, 0, 0, 0, 0, 0};
        if (pos >= 0 && pos < L) { const v4u x = *(const v4u*)(P + (size_t)(seq_lo + pos) * PLD + PC_POOL + g * 64 + c8);
            v[0] = bf_lo(x.x); v[1] = bf_hi(x.x); v[2] = bf_lo(x.y); v[3] = bf_hi(x.y); v[4] = bf_lo(x.z); v[5] = bf_hi(x.z); v[6] = bf_lo(x.w); v[7] = bf_hi(x.w); }
#pragma unroll
        for (int i = 0; i < 8; ++i) Uw[rr * DP + c8 + i] = v[i]; }
    { const float* pw = A.in[F.zz + 15] + ((size_t)l * 4 + g) * 4096;
#pragma unroll
      for (int k = 0; k < 8; ++k) { const int e = tid + 512 * k; PW[(e >> 6) * DP + (e & 63)] = pw[e]; } }
    __syncthreads();
    const int win = 2 << g;
#pragma unroll 1
    for (int k = 0; k < 8; ++k) { const int e = tid + 512 * k, t = e >> 6, i = e & 63; const int pos = pos0 + t;
        int lo = pos - win / 2, hi = lo + win; lo = lo < 0 ? 0 : lo; hi = hi > L ? L : hi;
        float s = 0.f;
#pragma unroll 4
        for (int p = lo; p < hi; ++p) s += Uw[(p - pos0 + 8) * DP + i];
        Mm[t * DP + i] = s / (float)(hi - lo) - Uw[(t + 8) * DP + i]; }
    __syncthreads();
    const float* psc = A.in[F.zz + 16] + l * 256 + g * 64;
    { const int wv = tid >> 6, ln = tid & 63, r = ln & 15, q = ln >> 4;
#pragma unroll
      for (int i = 0; i < 2; ++i) { const int tile = wv * 2 + i, m0 = (tile >> 2) * 16, n0 = (tile & 3) * 16;
          const f32x4 y = mm_tile(Mm, DP, 1, PW, DP, 1, m0, n0, ln); const float sc = psc[n0 + r];
#pragma unroll
          for (int gg = 0; gg < 4; ++gg) PO[(size_t)(row0 + m0 + 4 * q + gg) * 256 + g * 64 + n0 + r] = (bf16)f2bf(y[gg] * sc); } }
    __syncthreads();
}

constexpr int SC_SLOT = 32768, SC_NSLOT = 4, SC_ST = SC_SLOT * SC_NSLOT, SC_GL = SC_ST + 2 * 8192;
__device__ __forceinline__ void dn_scan_item(Frame& F, int item) {
    typedef short s16x8v __attribute__((ext_vector_type(8)));
    const int d = item & 1, h = (item >> 1) & 3, b = item >> 3;
    const int tid = pg8::tid_from(F.wid_s);
    const int wv = __builtin_amdgcn_readfirstlane(tid >> 6), ln = tid & 63, r = ln & 15, q = ln >> 4;
    LAS unsigned char* L = F.lds;
    LAS float* glv = (LAS float*)(L + SC_GL);
    const unsigned char* dnp = F.ws + WS_DNP;
#define SC_N(st) (d == 0 ? (st) : ((st) < 4 ? 3 - (st) : 71 - (st)))
#define SC_PROB(st) ((((size_t)b * NCHUNK + SC_N(st)) * 4 + h) * 2 + d)
    if (tid < NCHUNK) glv[tid] = ((const float*)(F.ws + WS_DNG))[SC_PROB(tid)];
    for (int e = tid; e < 2 * 8192 / 16; e += NTHR) ((LAS v4u*)(L + SC_ST))[e] = (v4u){0u, 0u, 0u, 0u};
    asm volatile("s_waitcnt vmcnt(0) lgkmcnt(0)" ::: "memory"); __builtin_amdgcn_s_barrier();
#define SC_DMA(st, slot) do { const unsigned char* src_ = dnp + SC_PROB(st) * 32768 + wv * 8192 + ln * 16; \
        _Pragma("unroll") for (int i_ = 0; i_ < 8; ++i_) __builtin_amdgcn_global_load_lds((const unsigned*)(src_ + i_ * 1024), (LAS unsigned*)(L + (slot) * SC_SLOT + wv * 8192 + i_ * 1024), 16, 0, 0); } while (0)
    if (wv < 4) { SC_DMA(0, 0); SC_DMA(1, 1); SC_DMA(2, 2); }
    f32x4 s0 = {0.f, 0.f, 0.f, 0.f}, s1 = s0, s2 = s0, s3 = s0;
    bf16* DNO = (bf16*)(F.ws + WS_DNO) + (size_t)d * MROWS * 256;
#pragma unroll 1
    for (int st = 0; st < NCHUNK; ++st) {
        if (wv < 4) asm volatile("s_waitcnt vmcnt(16)" ::: "memory");
        asm volatile("s_waitcnt lgkmcnt(0)" ::: "memory"); __builtin_amdgcn_s_barrier();
        if (wv < 4) { const int nx = st + 3 < NCHUNK ? st + 3 : NCHUNK - 1; SC_DMA(nx, (st + 3) & 3); }
        const LAS unsigned char* slot = L + (st & 3) * SC_SLOT;
        const LAS unsigned char* stc = L + SC_ST + (st & 1) * 8192; LAS unsigned char* stn = L + SC_ST + ((st + 1) & 1) * 8192;
        const int nt = wv & 3;
        const s16x8v bf0 = *(const LAS s16x8v*)(stc + (nt * 2 + 0) * 1024 + ln * 16), bf1 = *(const LAS s16x8v*)(stc + (nt * 2 + 1) * 1024 + ln * 16);
        if (wv < 4) {
            const float gl = glv[st];
            const LAS unsigned char* cf = slot + 8192; const LAS unsigned char* bi = slot + 24576;
#define SC_ST_TILE(S, mt) do { const v2u bw_ = *(const LAS v2u*)(bi + ((mt) * 4 + nt) * 512 + ln * 8); \
            f32x4 a_ = {gl * S[0] + bf_lo(bw_.x), gl * S[1] + bf_hi(bw_.x), gl * S[2] + bf_lo(bw_.y), gl * S[3] + bf_hi(bw_.y)}; \
            a_ = __builtin_amdgcn_mfma_f32_16x16x32_bf16(*(const LAS s16x8v*)(cf + ((mt) * 2 + 0) * 1024 + ln * 16), bf0, a_, 0, 0, 0); \
            a_ = __builtin_amdgcn_mfma_f32_16x16x32_bf16(*(const LAS s16x8v*)(cf + ((mt) * 2 + 1) * 1024 + ln * 16), bf1, a_, 0, 0, 0); S = a_; } while (0)
            SC_ST_TILE(s0, 0); SC_ST_TILE(s1, 1); SC_ST_TILE(s2, 2); SC_ST_TILE(s3, 3);
#undef SC_ST_TILE
            v4u w0, w1; w0.x = pk2(s0[0], s0[1]); w0.y = pk2(s0[2], s0[3]); w0.z = pk2(s1[0], s1[1]); w0.w = pk2(s1[2], s1[3]);
            w1.x = pk2(s2[0], s2[1]); w1.y = pk2(s2[2], s2[3]); w1.z = pk2(s3[0], s3[1]); w1.w = pk2(s3[2], s3[3]);
            *(LAS v4u*)(stn + (nt * 2 + 0) * 1024 + ln * 16) = w0; *(LAS v4u*)(stn + (nt * 2 + 1) * 1024 + ln * 16) = w1;
        } else {
            const LAS unsigned char* pf = slot; const LAS unsigned char* ri = slot + 16384;
            const int n = SC_N(st);
            bf16* orow = DNO + (size_t)(b * RPB + n * 64 + 4 * q) * 256 + h * 64 + nt * 16 + r;
#pragma unroll
            for (int mt = 0; mt < 4; ++mt) { const v2u rw_ = *(const LAS v2u*)(ri + (mt * 4 + nt) * 512 + ln * 8);
                f32x4 a_ = {bf_lo(rw_.x), bf_hi(rw_.x), bf_lo(rw_.y), bf_hi(rw_.y)};
                a_ = __builtin_amdgcn_mfma_f32_16x16x32_bf16(*(const LAS s16x8v*)(pf + (mt * 2 + 0) * 1024 + ln * 16), bf0, a_, 0, 0, 0);
                a_ = __builtin_amdgcn_mfma_f32_16x16x32_bf16(*(const LAS s16x8v*)(pf + (mt * 2 + 1) * 1024 + ln * 16), bf1, a_, 0, 0, 0);
#pragma unroll
                for (int g = 0; g < 4; ++g) orow[(size_t)(16 * mt + g) * 256] = (bf16)f2bf(a_[g]); }
        }
    }
    asm volatile("s_waitcnt vmcnt(0) lgkmcnt(0)" ::: "memory"); __builtin_amdgcn_s_barrier();
#undef SC_DMA
#undef SC_N
#undef SC_PROB
}

__device__ __forceinline__ void mix_build(Frame& F, const Args& A, int l) {
    const int lane = pg8::lane_id_asm(); const int gw = F.vcu * NWAVES + F.wave, NGW = F.G * NWAVES;
    const bf16* ATTO = (const bf16*)(F.ws + WS_ATTO); const bf16* P = (const bf16*)(F.ws + WS_PROJ); const bf16* DNO = (const bf16*)(F.ws + WS_DNO); bf16* MIX = (bf16*)(F.ws + WS_MIX);
    const float lam = ((const float*)(F.ws + WS_LAM))[l]; const float li = 0.8f - 0.6f * expf(-0.3f * (float)l);
    const float* sg = A.in[F.zz + 10] + l * 128; const float* ng = A.in[F.zz + 14] + l * 64;
    for (int R = gw; R < MROWS; R += NGW) {
        const int j = R % RPB; if (l == 1 && j < CTXL) continue;
        { const int hh = lane >> 4, e0 = (lane & 15) * 8;
          const v4u a = *(const v4u*)(ATTO + (size_t)R * DM + (hh * 2) * 128 + e0), c = *(const v4u*)(ATTO + (size_t)R * DM + (hh * 2 + 1) * 128 + e0);
          float x[8] = {bf_lo(a.x) - lam * bf_lo(c.x), bf_hi(a.x) - lam * bf_hi(c.x), bf_lo(a.y) - lam * bf_lo(c.y), bf_hi(a.y) - lam * bf_hi(c.y),
                        bf_lo(a.z) - lam * bf_lo(c.z), bf_hi(a.z) - lam * bf_hi(c.z), bf_lo(a.w) - lam * bf_lo(c.w), bf_hi(a.w) - lam * bf_hi(c.w)};
          float ss = 0.f;
#pragma unroll
          for (int i = 0; i < 8; ++i) ss += x[i] * x[i];
          ss = grp16_sum(ss);
          const float sc = (1.f / sqrtf(ss * (1.f / 128.f) + EPSN)) * (1.f - li);
          const f32x4 g0 = *(const f32x4*)(sg + e0), g1 = *(const f32x4*)(sg + e0 + 4);
          v4u o; o.x = pk2(x[0] * sc * g0[0], x[1] * sc * g0[1]); o.y = pk2(x[2] * sc * g0[2], x[3] * sc * g0[3]); o.z = pk2(x[4] * sc * g1[0], x[5] * sc * g1[1]); o.w = pk2(x[6] * sc * g1[2], x[7] * sc * g1[3]);
          *(v4u*)(MIX + (size_t)R * DM + hh * 128 + e0) = o; }
        { const int c0 = lane * 4;
          const v2u a = *(const v2u*)(DNO + (size_t)R * 256 + c0), c = *(const v2u*)(DNO + ((size_t)MROWS + R) * 256 + c0), z = *(const v2u*)(P + (size_t)R * PLD + PC_DZ + c0);
          float x[4] = {bf_lo(a.x) + bf_lo(c.x), bf_hi(a.x) + bf_hi(c.x), bf_lo(a.y) + bf_lo(c.y), bf_hi(a.y) + bf_hi(c.y)};
          float ss = x[0] * x[0] + x[1] * x[1] + x[2] * x[2] + x[3] * x[3];
          ss = grp16_sum(ss);
          const float sc = 1.f / sqrtf(ss * (1.f / 64.f) + EPSN);
          const f32x4 gg = *(const f32x4*)(ng + (c0 & 63));
          v2u o; o.x = pk2(x[0] * sc * gg[0] * siluf_(bf_lo(z.x)), x[1] * sc * gg[1] * siluf_(bf_hi(z.x))); o.y = pk2(x[2] * sc * gg[2] * siluf_(bf_lo(z.y)), x[3] * sc * gg[3] * siluf_(bf_hi(z.y)));
          *(v2u*)(MIX + (size_t)R * DM + 512 + c0) = o; }
        { const v2u pz = *(const v2u*)((const bf16*)(F.ws + WS_POOLO) + (size_t)R * 256 + lane * 4); *(v2u*)(MIX + (size_t)R * DM + 768 + lane * 4) = pz; }
    }
}

#ifndef MK_N_LAUNCHES
#define MK_N_LAUNCHES 1
#endif
__device__ __forceinline__ bool in_phase(int k, int lo, int hi) { asm volatile("" : "+s"(lo), "+s"(hi)); return lo <= k && k < hi; }
__global__ void __launch_bounds__(NTHR, 2) mk_fwd(Args args) {
    extern __shared__ __attribute__((aligned(16))) unsigned char lds[];
    Frame F;
    F.lds = (LAS unsigned char*)lds;
    F.MISC = (volatile LAS unsigned*)(F.lds + MISC_OFF);
    F.wid_s = __builtin_amdgcn_readfirstlane((int)(threadIdx.x >> 6));
    F.tid = pg8::tid_from(F.wid_s); F.lane = F.tid & 63; F.wave = F.wid_s;
    F.G = gridDim.x; { const int bx = blockIdx.x; F.bx = bx; F.vcu = (F.G % 8 == 0) ? (bx % 8) * (F.G / 8) + bx / 8 : bx; }
    F.ws = args.ws; F.out = args.out; F.zz = 0;
    F.ctl = (gu32*)(args.ws + WS_CTL);
    for (int u = F.tid; u < (LDS_BYTES - MISC_OFF) / 4; u += NTHR) ((LAS unsigned*)(F.lds + MISC_OFF))[u] = 0u;
    __syncthreads();
    const int lo = args.ph_lo, hi = args.ph_hi;
    const bool use_bar = (hi - lo) > 1;
    XcdBarrier bar; bar.bar = ((unsigned*)(F.ctl + CW_BAR) + args.bar_li * XCD_BAR_WORDS); bar.x = 0; bar.st = nullptr; bar.wid = (unsigned)F.wid_s;
    if (use_bar) bar = xcd_barrier_post(((unsigned*)(F.ctl + CW_BAR) + args.bar_li * XCD_BAR_WORDS), F.MISC + 8, (unsigned)F.wid_s);
#ifndef EN_MASK
#define EN_MASK 0xFFFFFFFFu
#endif
#define IN(k) (((EN_MASK >> ((k) > 12 ? (k) - 12 : (k))) & 1u) && in_phase((k), lo, hi))
#define PB() do { GAS unsigned char* w_ = (GAS unsigned char*)args.ws; LAS unsigned char* l_ = (LAS unsigned char*)lds; int z_ = 0; asm volatile("" : "+s"(w_), "+s"(l_), "+s"(z_)); F.ws = (unsigned char*)w_; F.ctl = (gu32*)w_; F.lds = l_; F.zz = z_; { int bx_ = blockIdx.x; asm volatile("" : "+s"(bx_)); F.bx = bx_; F.vcu = (F.G % 8 == 0) ? (bx_ % 8) * (F.G / 8) + bx_ / 8 : bx_; } const int t_ = pg8::tid_from(F.wid_s); F.tid = t_; F.lane = t_ & 63; F.wave = F.wid_s; } while (0)
#ifdef DBG_DUP
#define NREP(k) ((((k) > 12 && (k) < 23) ? (k) - 12 : (k)) == DBG_DUP ? 2 : 1)
#else
#define NREP(k) 1
#endif
#define SEAMX() do { XcdBarrier bl_ = bar; { GAS unsigned* b_ = (GAS unsigned*)(args.ws + WS_CTL) + CW_BAR + args.bar_li * XCD_BAR_WORDS; unsigned x_ = bar.x; asm volatile("" : "+s"(b_), "+s"(x_)); bl_.bar = (unsigned*)b_; bl_.x = x_; } xcd_barrier(bl_); } while (0)
#define PH_BEGIN(k) if (IN(k)) { for (int rep_ = 0; rep_ < NREP(k); ++rep_) { if (rep_) SEAMX(); PB();
#define PH_END(k) } } SEAM(k);
#define SEAM(k) do { if (IN(k) && IN((k) + 1)) { XcdBarrier bl_ = bar; { GAS unsigned* b_ = (GAS unsigned*)(args.ws + WS_CTL) + CW_BAR + args.bar_li * XCD_BAR_WORDS; unsigned x_ = bar.x; asm volatile("" : "+s"(b_), "+s"(x_)); bl_.bar = (unsigned*)b_; bl_.x = x_; } xcd_barrier(bl_); } } while (0)
    char* ldsg = (char*)lds;

    PH_BEGIN(PH_PRO) p0_prologue(F, args); PH_END(PH_PRO)

#pragma unroll 1
    for (int l = 0; l < 2; ++l) {
        const int pb = 1 + 12 * l;
        const float* modl = (const float*)(F.ws + WS_MOD) + l * 5 * 6144;
        PH_BEGIN(pb + PH_N1) norm_mod_phase(F, args, l, 0, false, false, false, l == 1 ? 11 : 0, l == 0 ? 1 : 0); PH_END(pb + PH_N1)
        PH_BEGIN(pb + PH_PROJ)
            { pg8::Gemm g{(const bf16*)(F.ws + WS_U), (const bf16*)(F.ws + WS_WIN) + (size_t)l * NPB * 1024, 1024, 1024, 1024, 0, 0, F.wid_s};
              TileOrder S; S.init(MROWS / 256, NPB / 256, F.G, F.bx, 0);
              EpiProj E{(bf16*)(F.ws + WS_PROJ), (const float*)(F.ws + WS_ROPE)};
              pg8::gemm_phase<EpiProj, TileOrder, true, true>(F.lds, g, S, E); }
            { pg8::Gemm g{(const bf16*)(F.ws + WS_U8), (const bf16*)(F.ws + WS_WG8 + (size_t)l * 3072 * 1024), 512, 512, 512, E8(F8_ACT_L2), E8(F8_W13_L2), F.wid_s};
              TileOrder S; S.init(MROWS / 256, 12, F.G, F.bx, 0);
              EpiGate E{(bf16*)(F.ws + WS_PROJ)};
              pg8::gemm_phase8<EpiGate, TileOrder, true, true>(F.lds, g, S, E); }
            ab_tiles(F, args, l);
        PH_END(pb + PH_PROJ)
        PH_BEGIN(pb + PH_ATT)
            const bf16* P = (const bf16*)(F.ws + WS_PROJ); bf16* AO = (bf16*)(F.ws + WS_ATTO);
            const int nunits = 512 + (l == 0 ? 32 : 0);
#ifndef DIS_ATTN
#ifdef DBG_DUP
            for (int r2_ = 0; r2_ < (DBG_DUP == 31 ? 2 : 1); ++r2_)
#endif
#pragma unroll 1
            for (int u = F.vcu; u < nunits; u += F.G) {
                int b, hm, qrow, seq;
                if (u < 512) { b = u >> 7; hm = (u >> 4) & 7; qrow = CTXL + (u & 15) * 256; seq = RPB; }
                else { const int v = u - 512; b = v >> 3; hm = v & 7; qrow = 0; seq = CTXL; }
                const size_t r0 = (size_t)b * RPB;
                attn::attn_unit<PLD, DM>(P + (r0 + qrow) * PLD + PC_AQ + hm * 64, P + r0 * PLD + PC_AK + hm * 64, P + r0 * PLD + PC_AV + (hm >> 1) * 128,
                                           AO + (r0 + qrow) * DM + hm * 128, seq, F.lds, F.wid_s);
            }
#endif
#ifndef DIS_DNPRE
#ifdef DBG_DUP
            for (int r2_ = 0; r2_ < (DBG_DUP == 32 ? 2 : 1); ++r2_)
#endif
#pragma unroll 1
            for (int u = F.vcu; u < NB * NCHUNK * 4; u += F.G) { const int h = u & 3, n = (u >> 2) % NCHUNK, b = (u >> 2) / NCHUNK; dn_pre_unit(F, args, l, b, n, h); }
#endif
        PH_END(pb + PH_ATT)
        PH_BEGIN(pb + PH_SCAN)
#pragma unroll 1
            for (int it = F.vcu; it < 32; it += F.G) dn_scan_item(F, it);
            { const bool many = F.G > 32; const int rk = many ? F.vcu - 32 : F.vcu, nr = many ? F.G - 32 : F.G;
              if (rk >= 0) {
#pragma unroll 1
                for (int u = rk; u < (MROWS / 64) * 4; u += nr) pool_unit(F, args, l, u >> 2, u & 3);
                if (l == 0) { conv_layer_weights(F, args, 1, rk * NWAVES + F.wave, nr * NWAVES); moe_convert<0>(F, args, rk * NWAVES + F.wave, nr * NWAVES); }
                else moe_convert<1>(F, args, rk * NWAVES + F.wave, nr * NWAVES); } }
        PH_END(pb + PH_SCAN)
        PH_BEGIN(pb + PH_MIXB) mix_build(F, args, l); PH_END(pb + PH_MIXB)
        if (IN(pb + PH_MRG0)) { PB();
            pg8::Gemm g{(const bf16*)(F.ws + WS_MIX), (const bf16*)(F.ws + WS_WBR) + (size_t)l * 1024 * 1024, 1024, 1024, 1024, 0, 0, F.wid_s};
            TileOrder S; S.init(l == 0 ? 68 : 64, 4, F.G, F.bx, l);
            EpiMergeF E{(bf16*)(F.ws + WS_MG), (const bf16*)(F.ws + WS_PROJ)};
            pg8::gemm_phase<EpiMergeF, TileOrder, true, true>(F.lds, g, S, E);
        } SEAM(pb + PH_MRG2);
        if (IN(pb + PH_OUT)) { PB();
            { pg8::Gemm g{(const bf16*)(F.ws + WS_MG), (const bf16*)(F.ws + WS_WOUT) + (size_t)l * 1024 * 1024, 1024, 1024, 1024, 0, 0, F.wid_s};
              TileOrder S; S.init(64, 4, F.G, F.bx, 1);
              EpiResid E{(float*)(F.ws + WS_H), modl, 2, l == 0 ? args.in[F.zz + 0] : nullptr};
              pg8::gemm_phase<EpiResid, TileOrder, true, true>(F.lds, g, S, E); }
            if (l == 0) {
              pg8::Gemm g{(const bf16*)(F.ws + WS_MG), (const bf16*)(F.ws + WS_WOUT), 256, 1024, 1024, 0, 0, F.wid_s};
              CtxSplitOrder S; S.init(4, 512, F.G, F.bx);
              EpiSlab E{(float*)(F.ws + WS_SLAB), modl, 2};
              pg8::gemm_phase<EpiSlab, CtxSplitOrder, true, true>(F.lds, g, S, E); }
        } SEAM(pb + PH_OUT);
#ifdef DENSE_F8
        PH_BEGIN(pb + PH_N2) norm_mod_phase(F, args, l, 1, l == 1, l == 1, l == 0); PH_END(pb + PH_N2)
#else
        PH_BEGIN(pb + PH_N2) if (l == 0) norm_mod_phase(F, args, 0, 1, false, false, false, 4, 2); else norm2_route_phase(F, args); PH_END(pb + PH_N2)
#endif
        if (l == 0) {
#ifdef DENSE_F8
            PH_BEGIN(PH_FUP)
                pg8::Gemm g{(const bf16*)(F.ws + WS_U), (const bf16*)(F.ws + WS_W13), 512, 512, 512, E8(F8_ACT_L2), E8(F8_W13_L2), F.wid_s};
                TileOrder S; S.init(68, 2 * FFD / 256, F.G, F.bx, 0);
                EpiSwiglu8 E{F.ws + WS_HID, FFD};
                pg8::gemm_phase8<EpiSwiglu8, TileOrder, true, true>(F.lds, g, S, E);
            PH_END(PH_FUP)
            if (IN(PH_FDN)) { PB();
                pg8::Gemm g{(const bf16*)(F.ws + WS_HID), (const bf16*)(F.ws + WS_W2), FFD / 2, FFD / 2, FFD / 2, E8(F8_ACT_L2), E8(F8_W2_L2), F.wid_s};
                TileOrder S; S.init(68, 4, F.G, F.bx, 0);
                EpiResid E{(float*)(F.ws + WS_H), modl, 5, nullptr};
                pg8::gemm_phase8<EpiResid, TileOrder, true, true>(F.lds, g, S, E);
            } SEAM(PH_FDN);
#else
            PH_BEGIN(PH_FUP)
                pg8::Gemm g{(const bf16*)(F.ws + WS_U), (const bf16*)(F.ws + WS_W13), 1024, 1024, 1024, 0, 0, F.wid_s};
                TileOrder S; S.init(68, 2 * FFD / 256, F.G, F.bx, 0);
                EpiSwiglu E{(bf16*)(F.ws + WS_HID), FFD};
                pg8::gemm_phase<EpiSwiglu, TileOrder, true, true>(F.lds, g, S, E);
            PH_END(PH_FUP)
            if (IN(PH_FDN)) { PB();
                { pg8::Gemm g{(const bf16*)(F.ws + WS_HID), (const bf16*)(F.ws + WS_W2), FFD, FFD, FFD, 0, 0, F.wid_s};
                  TileOrder S; S.init(64, 4, F.G, F.bx, 1);
                  EpiResid E{(float*)(F.ws + WS_H), modl, 5, nullptr};
                  pg8::gemm_phase<EpiResid, TileOrder, true, true>(F.lds, g, S, E); }
                { pg8::Gemm g{(const bf16*)(F.ws + WS_HID), (const bf16*)(F.ws + WS_W2), 256, FFD, FFD, 0, 0, F.wid_s};
                  CtxSplitOrder S; S.init(11, 512, F.G, F.bx);
                  EpiSlab E{(float*)(F.ws + WS_SLAB), modl, 5};
                  pg8::gemm_phase<EpiSlab, CtxSplitOrder, true, true>(F.lds, g, S, E); }
            } SEAM(PH_FDN);
#endif
        }
    }
    PH_BEGIN(PH_GATH) moe_gather(F); PH_END(PH_GATH)
#pragma unroll 1
    for (int hh = 0; hh < 1; ++hh) {
        const int p0 = PH_CV0 + 3 * hh;
        PH_BEGIN(p0 + 1)
            pg8::Gemm g{(const bf16*)(F.ws + WS_XG), (const bf16*)(F.ws + WS_W13M), 512, 512, 512, E8(F8_ACT_L2), E8(F8_W13_L2), F.wid_s};
            MoeOrder S; S.init(F.ctl + CW_ECNT, 2 * FFE / 256, F.G, F.vcu);
            EpiSwiglu8 E{F.ws + WS_HIDM, FFE};
            pg8::gemm_phase8<EpiSwiglu8, MoeOrder, true, true>(F.lds, g, S, E);
        PH_END(p0 + 1)
        if (IN(p0 + 2)) { PB();
            pg8::Gemm g{(const bf16*)(F.ws + WS_HIDM), (const bf16*)(F.ws + WS_W2M), FFE / 2, FFE / 2, FFE / 2, E8(F8_ACT_L2), E8(F8_W2_L2), F.wid_s};
            MoeOrder S; S.init(F.ctl + CW_ECNT, 4, F.G, F.vcu);
            EpiY E{(bf16*)(F.ws + WS_Y), 1};
            pg8::gemm_phase8<EpiY, MoeOrder, true, true>(F.lds, g, S, E);
        } SEAM(p0 + 2);
    }
    PH_BEGIN(PH_FIN) final_phase(F, args); } }
#ifdef DBG_STOP
    if (lo == 100) {
        const int gw = F.vcu * NWAVES + F.wave, NGW = F.G * NWAVES;
        for (int tk = gw; tk < NB * SEQ; tk += NGW) { const int b = tk / SEQ, t = tk - b * SEQ; const size_t R = (size_t)b * RPB + CTXL + t;
#if DBG_SRC == 0
            const f32x4* s = (const f32x4*)((const float*)(args.ws + WS_H) + R * DM) + F.lane; f32x4* d = (f32x4*)(args.out + (size_t)tk * DM) + F.lane;
            for (int q = 0; q < 4; ++q) d[64 * q] = s[64 * q];
#elif DBG_SRC == 2
            MoeOrder mo; mo.init((gu32*)args.ws + CW_ECNT, 1, 1, 0); const v4u rt = ((const v4u*)(args.ws + WS_ROUTE))[2 * tk];
            const size_t rr = (size_t)mo.tile_off((int)rt.x) * 256 + rt.z; (void)R;
            const bf16* s = (const bf16*)(args.ws + DBG_OFF) + rr * DBG_LD + DBG_COL; float* d = args.out + (size_t)tk * DM;
            for (int q = 0; q < 16; ++q) d[F.lane + 64 * q] = bf2f(s[F.lane + 64 * q]);
#else
#ifdef DBG_MOD
            const bf16* s = (const bf16*)(args.ws + DBG_OFF) + (R % DBG_MOD) * DBG_LD + DBG_COL; float* d = args.out + (size_t)tk * DM;
#else
            const bf16* s = (const bf16*)(args.ws + DBG_OFF) + R * DBG_LD + DBG_COL; float* d = args.out + (size_t)tk * DM;
#endif
            for (int q = 0; q < 16; ++q) { float v = bf2f(s[F.lane + 64 * q]); d[F.lane + 64 * q] = (v == v && fabsf(v) < 1e30f) ? v : DBG_NANVAL; }
#endif
        }
    }
#endif
#undef IN
#undef SEAM
}

extern "C" void kernel_launch(void* const* d_in, const int* in_sizes, int n_in, void* d_out, int out_size, void* d_ws, size_t ws_size, hipStream_t stream) {
    static int grid = 0;
    if (grid == 0) {
        if (n_in != 27 || in_sizes[0] != NB * SEQ * DM || out_size != NB * SEQ * DM || ws_size < WS_END) {
            fprintf(stderr, "kernel_launch: shape / workspace mismatch (n_in %d, in0 %d, out %d, ws %zu, need %zu); nothing launched\n", n_in, n_in > 0 ? in_sizes[0] : -1, out_size, ws_size, (size_t)WS_END); grid = -1; return; }
        int dev = 0, cus = 0, per_cu = 0;
        if (hipGetDevice(&dev) != hipSuccess || hipDeviceGetAttribute(&cus, hipDeviceAttributeMultiprocessorCount, dev) != hipSuccess) { grid = -1; return; }
        if (hipFuncSetAttribute((const void*)mk_fwd, hipFuncAttributeMaxDynamicSharedMemorySize, LDS_BYTES) != hipSuccess) { fprintf(stderr, "kernel_launch: hipFuncSetAttribute failed\n"); grid = -1; return; }
        if (hipOccupancyMaxActiveBlocksPerMultiprocessor(&per_cu, (const void*)mk_fwd, NTHR, LDS_BYTES) != hipSuccess || per_cu < 1)
            fprintf(stderr, "kernel_launch: note: occupancy query reports %d workgroups per CU\n", per_cu);
        (void)hipGetLastError();
        grid = cus;
    }
    if (grid < 0) return;
    if (hipMemsetAsync((char*)d_ws + WS_CTL, 0, CTL_ZERO_BYTES, stream) != hipSuccess) return;
    Args a{};
    for (int i = 0; i < 27; ++i) a.in[i] = (const float*)d_in[i];
    a.out = (float*)d_out; a.ws = (unsigned char*)d_ws;
    constexpr int NL = MK_N_LAUNCHES;
#ifdef DBG_STOP
    constexpr int NLL = DBG_STOP + 2;
#else
    constexpr int NLL = NL;
#endif
#ifdef DBG_PREFIX
    for (int li = 0; li < 2; ++li) { a.ph_lo = 0; a.ph_hi = li == 0 ? DBG_PREFIX + 1 : PH_COUNT; a.bar_li = li;
        hipLaunchKernelGGL(mk_fwd, dim3(grid), dim3(NTHR), LDS_BYTES, stream, a); }
    return;
#endif
    for (int li = 0; li < NLL; ++li) {
#ifdef DBG_SKIP_LO
        if (li >= DBG_SKIP_LO && li <= DBG_SKIP_HI) continue;
#endif
        a.ph_lo = (NL == 1) ? 0 : li; a.ph_hi = (NL == 1) ? PH_COUNT : li + 1;
#ifdef DBG_STOP
        a.ph_lo = li; a.ph_hi = li + 1;
        if (li == NLL - 1) { a.ph_lo = 100; a.ph_hi = 101; }
#endif
        hipLaunchKernelGGL(mk_fwd, dim3(grid), dim3(NTHR), LDS_BYTES, stream, a);
        const hipError_t le = hipPeekAtLastError();
        if (le != hipSuccess) { fprintf(stderr, "kernel_launch: launch %d failed: %s\n", li, hipGetErrorName(le)); break; }
    }
}
```

```cpp
#include <hip/hip_runtime.h>
#include <cstdio>
#include <cstdint>
#include <cmath>

namespace pg8 {
#define PG8_LAS __attribute__((address_space(3)))
typedef unsigned short bf16_t;
typedef short bf16x8 __attribute__((ext_vector_type(8)));
typedef float f32x4 __attribute__((ext_vector_type(4)));
typedef unsigned u32x4 __attribute__((ext_vector_type(4)));
typedef unsigned u32x2 __attribute__((ext_vector_type(2)));
constexpr int BM = 256, BK = 64, HALF = 128, HTB = HALF * BK * 2  , STAGE_BYTES = 8 * HTB;

__host__ __device__ __forceinline__ int lds_byte(int r, int c) { const int st = (r >> 4) * 2 + (c >> 5), rr = r & 15, cc = c & 31, ob = rr * 64 + cc * 2; return st * 1024 + (ob ^ (((ob >> 9) & 1) << 5)); }
__host__ __device__ __forceinline__ void stage_rc(int b, int& R, int& C) { const int st = b / 1024, sb = b % 1024, swz = sb ^ (((sb >> 9) & 1) << 5); R = (st >> 1) * 16 + swz / 64; C = (st & 1) * 32 + (swz % 64) / 2; }
__host__ __device__ __forceinline__ int perm32(int rho) { const int n = rho >> 4, i = rho & 15; return 8 * (i >> 2) + 4 * n + (i & 3); }

__device__ __forceinline__ int lane_id_asm() { int l; asm volatile("v_mbcnt_lo_u32_b32 %0, -1, 0\n\tv_mbcnt_hi_u32_b32 %0, -1, %0" : "=v"(l)); return l; }
__device__ __forceinline__ int tid_from(int wid) { return (wid << 6) | lane_id_asm(); }
struct Unit { int pm, pn, pb, ko, aux; };
struct Gemm { const bf16_t* A; const bf16_t* Bt; int K, lda, ldb, sA, sB, wid; };

__device__ __forceinline__ unsigned cvt_pk_bf16(float lo, float hi) { unsigned r; asm volatile("v_cvt_pk_bf16_f32 %0, %1, %2" : "=v"(r) : "v"(lo), "v"(hi)); return r; }
template <class Epi, class Sched, bool ALIGN_EPI = false, bool SP2 = false>
__device__ __forceinline__ void gemm_phase(PG8_LAS unsigned char* lds, const Gemm g, const Sched& S, const Epi& E) {
    const int wid = g.wid; const int tid = tid_from(wid), lane = tid & 63, wr = wid >> 2, wc = wid & 3, fr = lane & 15, fq = lane >> 4;
    const int K = g.K, nt = K / BK;
    unsigned voffA[2], voffB[2];
#pragma unroll
    for (int i = 0; i < 2; ++i) { int R, C; stage_rc(tid * 16 + i * 8192, R, C); const int Rb = Epi::PERM ? ((R & ~31) + perm32(R & 31)) : R;
        voffA[i] = (unsigned)(R * g.lda + C) * 2u; voffB[i] = (unsigned)(Rb * g.ldb + C) * 2u; }
    const size_t kstep = (size_t)(BK * 2);
    const size_t hstepA = (size_t)HALF * g.lda * 2, hstepB = (size_t)HALF * g.ldb * 2;
    const size_t tstepA = 2 * hstepA, tstepB = 2 * hstepB;
    const unsigned ldsw = (unsigned)wid * 1024u;
    const int aoff = lds_byte(wr * 64 + fr, fq * 8), boff = lds_byte(wc * 32 + fr, fq * 8);
#define PG8_SA(b, h) (((b) * 2 + (h)) * HTB)
#define PG8_SB(b, h) ((4 + (b) * 2 + (h)) * HTB)
#define PG8_STAGE(bufoff, gbase, voff) do { _Pragma("unroll") for (int _i = 0; _i < 2; ++_i) \
        __builtin_amdgcn_global_load_lds((const unsigned*)((const char*)(gbase) + (voff)[_i]), (PG8_LAS unsigned*)(lds + (bufoff) + ldsw + _i * 8192), 16, 0, 0); } while (0)
#define PG8_LDA(dst, b, h) do { _Pragma("unroll") for (int m = 0; m < 4; ++m) _Pragma("unroll") for (int k = 0; k < 2; ++k) dst[m][k] = *(const PG8_LAS bf16x8*)(lds + PG8_SA(b, h) + aoff + m * 2048 + k * 1024); } while (0)
#define PG8_LDB(dst, b, h) do { _Pragma("unroll") for (int n = 0; n < 2; ++n) _Pragma("unroll") for (int k = 0; k < 2; ++k) dst[n][k] = *(const PG8_LAS bf16x8*)(lds + PG8_SB(b, h) + boff + n * 2048 + k * 1024); } while (0)
#define PG8_MMA(ai, bj, At, Bt) do { __builtin_amdgcn_s_setprio(1); _Pragma("unroll") for (int m = 0; m < 4; ++m) _Pragma("unroll") for (int n = 0; n < 2; ++n) _Pragma("unroll") for (int k = 0; k < 2; ++k) \
        acc[ai][bj][m][n] = __builtin_amdgcn_mfma_f32_16x16x32_bf16(Bt[n][k], At[m][k], acc[ai][bj][m][n], 0, 0, 0); __builtin_amdgcn_s_setprio(0); } while (0)
#define PG8_WAIT_V(n) asm volatile("s_waitcnt vmcnt(" #n ")" ::: "memory")
#define PG8_WAIT_L(n) asm volatile("s_waitcnt lgkmcnt(" #n ")" ::: "memory")
#define PG8_BAR __builtin_amdgcn_s_barrier()
#define PG8_SCHED __builtin_amdgcn_sched_barrier(0)
    Unit cur, nxt; int ui = 0;
    if (!S.next(0, cur)) return;
    f32x4 acc[2][2][4][2];
#pragma unroll
    for (int a = 0; a < 2; ++a)
#pragma unroll
        for (int b = 0; b < 2; ++b)
#pragma unroll
            for (int m = 0; m < 4; ++m)
#pragma unroll
                for (int n = 0; n < 2; ++n) acc[a][b][m][n] = (f32x4){0.f, 0.f, 0.f, 0.f};
    bf16x8 At[4][2], B0[2][2], B1[2][2];
    const char* cA = (const char*)g.A + (size_t)cur.pm * tstepA + cur.ko; const char* cB = (const char*)g.Bt + (size_t)cur.pb * tstepB + cur.ko;
    S.a_ready(cur);
    if constexpr (SP2) {
        PG8_STAGE(PG8_SB(0, 0), cB, voffB); PG8_STAGE(PG8_SB(0, 1), cB + hstepB, voffB); PG8_STAGE(PG8_SA(0, 0), cA, voffA); PG8_STAGE(PG8_SA(0, 1), cA + hstepA, voffA);
        if (wr == 1) PG8_BAR;
        PG8_WAIT_V(2); PG8_BAR;
        PG8_STAGE(PG8_SB(1, 0), cB + kstep, voffB); PG8_STAGE(PG8_SA(1, 0), cA + kstep, voffA); PG8_STAGE(PG8_SB(1, 1), cB + hstepB + kstep, voffB);
        PG8_WAIT_V(6); PG8_BAR;
    } else {
        PG8_STAGE(PG8_SB(0, 0), cB, voffB); PG8_STAGE(PG8_SA(0, 0), cA, voffA); PG8_STAGE(PG8_SB(0, 1), cB + hstepB, voffB); PG8_STAGE(PG8_SA(0, 1), cA + hstepA, voffA);
        if (wr == 1) PG8_BAR;
        PG8_WAIT_V(4); PG8_BAR;
        PG8_STAGE(PG8_SB(1, 0), cB + kstep, voffB); PG8_STAGE(PG8_SA(1, 0), cA + kstep, voffA); PG8_STAGE(PG8_SB(1, 1), cB + hstepB + kstep, voffB);
        PG8_WAIT_V(6); PG8_BAR;
    }
    for (;;) {
        const bool has_next = S.next(ui + 1, nxt);
        const char* nA = has_next ? (const char*)g.A + (size_t)nxt.pm * tstepA + nxt.ko : cA; const char* nB = has_next ? (const char*)g.Bt + (size_t)nxt.pb * tstepB + nxt.ko : cB;
        for (int t = 0; t < nt; t += 2) {
            if constexpr (Epi::KHOOK) { if (t == 8 || t == 12) E.khook(acc, cur, t, wr, wc, fr, fq); }
            const bool last = (t == nt - 2);
            const char* a1 = cA + (size_t)(t + 1) * kstep;
            const char* a2 = last ? nA : cA + (size_t)(t + 2) * kstep; const char* b2 = last ? nB : cB + (size_t)(t + 2) * kstep;
            const char* a3 = a2 + kstep; const char* b3 = b2 + kstep;
            if (last && has_next) S.a_ready(nxt);
            if constexpr (SP2) {
            PG8_LDB(B0, 0, 0); PG8_LDB(B1, 0, 1); PG8_SCHED; PG8_LDA(At, 0, 0); PG8_STAGE(PG8_SA(1, 1), a1 + hstepA, voffA);
            PG8_WAIT_V(8); PG8_WAIT_L(0); PG8_BAR; PG8_MMA(0, 0, At, B0); PG8_MMA(0, 1, At, B1); PG8_BAR; PG8_SCHED;
            PG8_LDA(At, 0, 1); PG8_STAGE(PG8_SB(0, 0), b2, voffB); PG8_STAGE(PG8_SB(0, 1), b2 + hstepB, voffB); PG8_STAGE(PG8_SA(0, 0), a2, voffA);
            PG8_WAIT_V(8); PG8_WAIT_L(0); PG8_BAR; PG8_MMA(1, 0, At, B0); PG8_MMA(1, 1, At, B1); PG8_BAR; PG8_SCHED;
            PG8_LDB(B0, 1, 0); PG8_LDB(B1, 1, 1); PG8_SCHED; PG8_LDA(At, 1, 0); PG8_STAGE(PG8_SA(0, 1), a2 + hstepA, voffA);
            PG8_WAIT_V(8); PG8_WAIT_L(0); PG8_BAR; PG8_MMA(0, 0, At, B0); PG8_MMA(0, 1, At, B1); PG8_BAR; PG8_SCHED;
            PG8_LDA(At, 1, 1); PG8_STAGE(PG8_SB(1, 0), b3, voffB); PG8_STAGE(PG8_SB(1, 1), b3 + hstepB, voffB); PG8_STAGE(PG8_SA(1, 0), a3, voffA);
            PG8_WAIT_V(8); PG8_WAIT_L(0); PG8_BAR; PG8_MMA(1, 0, At, B0); PG8_MMA(1, 1, At, B1); PG8_BAR; PG8_SCHED;
            } else {
            PG8_LDB(B0, 0, 0); PG8_SCHED; PG8_LDA(At, 0, 0); PG8_STAGE(PG8_SA(1, 1), a1 + hstepA, voffA);
            PG8_WAIT_L(8); PG8_BAR; PG8_WAIT_L(0); PG8_MMA(0, 0, At, B0); PG8_BAR; PG8_SCHED;
            PG8_LDB(B1, 0, 1); PG8_STAGE(PG8_SB(0, 0), b2, voffB);
            PG8_BAR; PG8_WAIT_L(0); PG8_MMA(0, 1, At, B1); PG8_BAR;
            PG8_LDA(At, 0, 1); PG8_STAGE(PG8_SA(0, 0), a2, voffA);
            PG8_BAR; PG8_WAIT_L(0); PG8_MMA(1, 0, At, B0); PG8_BAR; PG8_SCHED;
            PG8_STAGE(PG8_SB(0, 1), b2 + hstepB, voffB);
            PG8_WAIT_V(6); PG8_BAR; PG8_MMA(1, 1, At, B1); PG8_BAR;
            PG8_LDB(B0, 1, 0); PG8_SCHED; PG8_LDA(At, 1, 0); PG8_STAGE(PG8_SA(0, 1), a2 + hstepA, voffA);
            PG8_WAIT_L(8); PG8_BAR; PG8_WAIT_L(0); PG8_MMA(0, 0, At, B0); PG8_BAR; PG8_SCHED;
            PG8_LDB(B1, 1, 1); PG8_STAGE(PG8_SB(1, 0), b3, voffB);
            PG8_BAR; PG8_WAIT_L(0); PG8_MMA(0, 1, At, B1); PG8_BAR;
            PG8_LDA(At, 1, 1); PG8_STAGE(PG8_SA(1, 0), a3, voffA);
            PG8_BAR; PG8_WAIT_L(0); PG8_MMA(1, 0, At, B0); PG8_BAR; PG8_SCHED;
            PG8_STAGE(PG8_SB(1, 1), b3 + hstepB, voffB);
            PG8_WAIT_V(6); PG8_BAR; PG8_MMA(1, 1, At, B1); PG8_BAR;
            }
        }
        if constexpr (ALIGN_EPI) { if (wr == 0) PG8_BAR; }
        if constexpr (!Epi::AFTER_DRAIN) { E(acc, cur, wr, wc, fr, fq); S.done(cur); }
        if (!has_next) break;
#pragma unroll
        for (int a = 0; a < 2; ++a)
#pragma unroll
            for (int b = 0; b < 2; ++b)
#pragma unroll
                for (int m = 0; m < 4; ++m)
#pragma unroll
                    for (int n = 0; n < 2; ++n) acc[a][b][m][n] = (f32x4){0.f, 0.f, 0.f, 0.f};
        cur = nxt; cA = nA; cB = nB; ++ui;
        if constexpr (ALIGN_EPI) { if (wr == 1) PG8_BAR; }
    }
    PG8_WAIT_V(0);
    if constexpr (!ALIGN_EPI) { if (wr == 0) PG8_BAR; }
    PG8_BAR;
    if constexpr (Epi::AFTER_DRAIN) { E.fused(acc, cur, wr, wc, fr, fq, lds, wid, lane); S.done(cur); }
#undef PG8_SA
#undef PG8_SB
#undef PG8_STAGE
#undef PG8_LDA
#undef PG8_LDB
#undef PG8_MMA
#undef PG8_WAIT_V
#undef PG8_WAIT_L
#undef PG8_BAR
#undef PG8_SCHED
}
template <class Epi, class Sched, bool ALIGN_EPI = false, bool SP2 = false>
__device__ __forceinline__ void gemm_phase8(PG8_LAS unsigned char* lds, const Gemm g, const Sched& S, const Epi& E) {
    const int wid = g.wid; const int tid = tid_from(wid), lane = tid & 63, wr = wid >> 2, wc = wid & 3, fr = lane & 15, fq = lane >> 4;
    const int K = g.K, nt = K / BK;
    unsigned voffA[2], voffB[2];
#pragma unroll
    for (int i = 0; i < 2; ++i) { int R, C; stage_rc(tid * 16 + i * 8192, R, C); const int Rb = Epi::PERM ? ((R & ~31) + perm32(R & 31)) : R;
        voffA[i] = (unsigned)(R * g.lda + C) * 2u; voffB[i] = (unsigned)(Rb * g.ldb + C) * 2u; }
    const size_t kstep = (size_t)(BK * 2);
    const size_t hstepA = (size_t)HALF * g.lda * 2, hstepB = (size_t)HALF * g.ldb * 2;
    const size_t tstepA = 2 * hstepA, tstepB = 2 * hstepB;
    const unsigned ldsw = (unsigned)wid * 1024u;
    const int c8 = (fq >> 1) * 32 + (fq & 1) * 16;
    const int aoff0 = lds_byte(wr * 64 + fr, c8), aoff1 = lds_byte(wr * 64 + fr, c8 + 8), boff0 = lds_byte(wc * 32 + fr, c8), boff1 = lds_byte(wc * 32 + fr, c8 + 8);
#define PG8_SA(b, h) (((b) * 2 + (h)) * HTB)
#define PG8_SB(b, h) ((4 + (b) * 2 + (h)) * HTB)
#define PG8_STAGE(bufoff, gbase, voff) do { _Pragma("unroll") for (int _i = 0; _i < 2; ++_i) \
        __builtin_amdgcn_global_load_lds((const unsigned*)((const char*)(gbase) + (voff)[_i]), (PG8_LAS unsigned*)(lds + (bufoff) + ldsw + _i * 8192), 16, 0, 0); } while (0)
#define PG8_LDA(dst, b, h) do { _Pragma("unroll") for (int m = 0; m < 4; ++m) { const u32x4 lo_ = *(const PG8_LAS u32x4*)(lds + PG8_SA(b, h) + aoff0 + m * 2048), hi_ = *(const PG8_LAS u32x4*)(lds + PG8_SA(b, h) + aoff1 + m * 2048); \
        dst[m] = (i32x8){(int)lo_.x, (int)lo_.y, (int)lo_.z, (int)lo_.w, (int)hi_.x, (int)hi_.y, (int)hi_.z, (int)hi_.w}; } } while (0)
#define PG8_LDB(dst, b, h) do { _Pragma("unroll") for (int n = 0; n < 2; ++n) { const u32x4 lo_ = *(const PG8_LAS u32x4*)(lds + PG8_SB(b, h) + boff0 + n * 2048), hi_ = *(const PG8_LAS u32x4*)(lds + PG8_SB(b, h) + boff1 + n * 2048); \
        dst[n] = (i32x8){(int)lo_.x, (int)lo_.y, (int)lo_.z, (int)lo_.w, (int)hi_.x, (int)hi_.y, (int)hi_.z, (int)hi_.w}; } } while (0)
#define PG8_MMA(ai, bj, At, Bt) do { __builtin_amdgcn_s_setprio(1); _Pragma("unroll") for (int m = 0; m < 4; ++m) _Pragma("unroll") for (int n = 0; n < 2; ++n) \
        asm volatile("v_mfma_scale_f32_16x16x128_f8f6f4 %0, %1, %2, %0, %3, %4 op_sel_hi:[0,0,0]" : "+v"(acc[ai][bj][m][n]) : "v"(Bt[n]), "v"(At[m]), "v"(vsB), "v"(vsA)); __builtin_amdgcn_s_setprio(0); } while (0)
#define PG8_WAIT_V(n) asm volatile("s_waitcnt vmcnt(" #n ")" ::: "memory")
#define PG8_WAIT_L(n) asm volatile("s_waitcnt lgkmcnt(" #n ")" ::: "memory")
#define PG8_BAR __builtin_amdgcn_s_barrier()
#define PG8_SCHED __builtin_amdgcn_sched_barrier(0)
    Unit cur, nxt; int ui = 0;
    if (!S.next(0, cur)) return;
    f32x4 acc[2][2][4][2];
#pragma unroll
    for (int a = 0; a < 2; ++a)
#pragma unroll
        for (int b = 0; b < 2; ++b)
#pragma unroll
            for (int m = 0; m < 4; ++m)
#pragma unroll
                for (int n = 0; n < 2; ++n) acc[a][b][m][n] = (f32x4){0.f, 0.f, 0.f, 0.f};
    typedef int i32x8 __attribute__((ext_vector_type(8)));
    i32x8 At[4], B0[2], B1[2];
    int vsA = g.sA, vsB = g.sB; asm volatile("" : "+v"(vsA), "+v"(vsB));
    const char* cA = (const char*)g.A + (size_t)cur.pm * tstepA + cur.ko; const char* cB = (const char*)g.Bt + (size_t)cur.pb * tstepB + cur.ko;
    S.a_ready(cur);
    if constexpr (SP2) {
        PG8_STAGE(PG8_SB(0, 0), cB, voffB); PG8_STAGE(PG8_SB(0, 1), cB + hstepB, voffB); PG8_STAGE(PG8_SA(0, 0), cA, voffA); PG8_STAGE(PG8_SA(0, 1), cA + hstepA, voffA);
        if (wr == 1) PG8_BAR;
        PG8_WAIT_V(2); PG8_BAR;
        PG8_STAGE(PG8_SB(1, 0), cB + kstep, voffB); PG8_STAGE(PG8_SA(1, 0), cA + kstep, voffA); PG8_STAGE(PG8_SB(1, 1), cB + hstepB + kstep, voffB);
        PG8_WAIT_V(6); PG8_BAR;
    } else {
        PG8_STAGE(PG8_SB(0, 0), cB, voffB); PG8_STAGE(PG8_SA(0, 0), cA, voffA); PG8_STAGE(PG8_SB(0, 1), cB + hstepB, voffB); PG8_STAGE(PG8_SA(0, 1), cA + hstepA, voffA);
        if (wr == 1) PG8_BAR;
        PG8_WAIT_V(4); PG8_BAR;
        PG8_STAGE(PG8_SB(1, 0), cB + kstep, voffB); PG8_STAGE(PG8_SA(1, 0), cA + kstep, voffA); PG8_STAGE(PG8_SB(1, 1), cB + hstepB + kstep, voffB);
        PG8_WAIT_V(6); PG8_BAR;
    }
    for (;;) {
        const bool has_next = S.next(ui + 1, nxt);
        const char* nA = has_next ? (const char*)g.A + (size_t)nxt.pm * tstepA + nxt.ko : cA; const char* nB = has_next ? (const char*)g.Bt + (size_t)nxt.pb * tstepB + nxt.ko : cB;
        for (int t = 0; t < nt; t += 2) {
            const bool last = (t == nt - 2);
            const char* a1 = cA + (size_t)(t + 1) * kstep;
            const char* a2 = last ? nA : cA + (size_t)(t + 2) * kstep; const char* b2 = last ? nB : cB + (size_t)(t + 2) * kstep;
            const char* a3 = a2 + kstep; const char* b3 = b2 + kstep;
            if (last && has_next) S.a_ready(nxt);
            if constexpr (SP2) {
            PG8_LDB(B0, 0, 0); PG8_LDB(B1, 0, 1); PG8_SCHED; PG8_LDA(At, 0, 0); PG8_STAGE(PG8_SA(1, 1), a1 + hstepA, voffA);
            PG8_WAIT_V(8); PG8_WAIT_L(0); PG8_BAR; PG8_MMA(0, 0, At, B0); PG8_MMA(0, 1, At, B1); PG8_BAR; PG8_SCHED;
            PG8_LDA(At, 0, 1); PG8_STAGE(PG8_SB(0, 0), b2, voffB); PG8_STAGE(PG8_SB(0, 1), b2 + hstepB, voffB); PG8_STAGE(PG8_SA(0, 0), a2, voffA);
            PG8_WAIT_V(8); PG8_WAIT_L(0); PG8_BAR; PG8_MMA(1, 0, At, B0); PG8_MMA(1, 1, At, B1); PG8_BAR; PG8_SCHED;
            PG8_LDB(B0, 1, 0); PG8_LDB(B1, 1, 1); PG8_SCHED; PG8_LDA(At, 1, 0); PG8_STAGE(PG8_SA(0, 1), a2 + hstepA, voffA);
            PG8_WAIT_V(8); PG8_WAIT_L(0); PG8_BAR; PG8_MMA(0, 0, At, B0); PG8_MMA(0, 1, At, B1); PG8_BAR; PG8_SCHED;
            PG8_LDA(At, 1, 1); PG8_STAGE(PG8_SB(1, 0), b3, voffB); PG8_STAGE(PG8_SB(1, 1), b3 + hstepB, voffB); PG8_STAGE(PG8_SA(1, 0), a3, voffA);
            PG8_WAIT_V(8); PG8_WAIT_L(0); PG8_BAR; PG8_MMA(1, 0, At, B0); PG8_MMA(1, 1, At, B1); PG8_BAR; PG8_SCHED;
            } else {
            PG8_LDB(B0, 0, 0); PG8_SCHED; PG8_LDA(At, 0, 0); PG8_STAGE(PG8_SA(1, 1), a1 + hstepA, voffA);
            PG8_WAIT_L(8); PG8_BAR; PG8_WAIT_L(0); PG8_MMA(0, 0, At, B0); PG8_BAR; PG8_SCHED;
            PG8_LDB(B1, 0, 1); PG8_STAGE(PG8_SB(0, 0), b2, voffB);
            PG8_BAR; PG8_WAIT_L(0); PG8_MMA(0, 1, At, B1); PG8_BAR;
            PG8_LDA(At, 0, 1); PG8_STAGE(PG8_SA(0, 0), a2, voffA);
            PG8_BAR; PG8_WAIT_L(0); PG8_MMA(1, 0, At, B0); PG8_BAR; PG8_SCHED;
            PG8_STAGE(PG8_SB(0, 1), b2 + hstepB, voffB);
            PG8_WAIT_V(6); PG8_BAR; PG8_MMA(1, 1, At, B1); PG8_BAR;
            PG8_LDB(B0, 1, 0); PG8_SCHED; PG8_LDA(At, 1, 0); PG8_STAGE(PG8_SA(0, 1), a2 + hstepA, voffA);
            PG8_WAIT_L(8); PG8_BAR; PG8_WAIT_L(0); PG8_MMA(0, 0, At, B0); PG8_BAR; PG8_SCHED;
            PG8_LDB(B1, 1, 1); PG8_STAGE(PG8_SB(1, 0), b3, voffB);
            PG8_BAR; PG8_WAIT_L(0); PG8_MMA(0, 1, At, B1); PG8_BAR;
            PG8_LDA(At, 1, 1); PG8_STAGE(PG8_SA(1, 0), a3, voffA);
            PG8_BAR; PG8_WAIT_L(0); PG8_MMA(1, 0, At, B0); PG8_BAR; PG8_SCHED;
            PG8_STAGE(PG8_SB(1, 1), b3 + hstepB, voffB);
            PG8_WAIT_V(6); PG8_BAR; PG8_MMA(1, 1, At, B1); PG8_BAR;
            }
        }
        if constexpr (ALIGN_EPI) { if (wr == 0) PG8_BAR; }
        __builtin_amdgcn_sched_barrier(0); asm volatile("s_nop 15\n\ts_nop 15" ::: "memory"); __builtin_amdgcn_sched_barrier(0);
        if constexpr (!Epi::AFTER_DRAIN) { E(acc, cur, wr, wc, fr, fq); S.done(cur); }
        if (!has_next) break;
#pragma unroll
        for (int a = 0; a < 2; ++a)
#pragma unroll
            for (int b = 0; b < 2; ++b)
#pragma unroll
                for (int m = 0; m < 4; ++m)
#pragma unroll
                    for (int n = 0; n < 2; ++n) acc[a][b][m][n] = (f32x4){0.f, 0.f, 0.f, 0.f};
        cur = nxt; cA = nA; cB = nB; ++ui;
        if constexpr (ALIGN_EPI) { if (wr == 1) PG8_BAR; }
    }
    PG8_WAIT_V(0);
    if constexpr (!ALIGN_EPI) { if (wr == 0) PG8_BAR; }
    PG8_BAR;
    if constexpr (Epi::AFTER_DRAIN) { E.fused(acc, cur, wr, wc, fr, fq, lds, wid, lane); S.done(cur); }
#undef PG8_SA
#undef PG8_SB
#undef PG8_STAGE
#undef PG8_LDA
#undef PG8_LDB
#undef PG8_MMA
#undef PG8_WAIT_V
#undef PG8_WAIT_L
#undef PG8_BAR
#undef PG8_SCHED
}
}

namespace attn {
using bf16x8 = __attribute__((ext_vector_type(8))) short;
using s16x4  = __attribute__((ext_vector_type(4))) short;
using f32x16 = __attribute__((ext_vector_type(16))) float;
using u32x4  = __attribute__((ext_vector_type(4))) unsigned;
constexpr int DV = 128, DK = 64, NW = 8, QBLK = 32, KVBLK = 64;
constexpr float SCALE = 0.125f;
constexpr float THR2 = 6.f;
constexpr float QSCALE = SCALE * 1.4426950408889634f;
#define AKSWZ(row, colB) ((row) * 128 + ((colB) ^ ((((row) >> 1) & 7) << 4)))
#define ASBAR() __builtin_amdgcn_sched_barrier(0)
__device__ __forceinline__ int crow(int r, int hi) { return (r & 3) + 8 * (r >> 2) + 4 * hi; }
__device__ __forceinline__ unsigned cvtpk(float lo, float hi) { unsigned r; asm volatile("v_cvt_pk_bf16_f32 %0, %1, %2" : "=v"(r) : "v"(lo), "v"(hi)); return r; }

__device__ __forceinline__ float rowmax32p(const f32x16& p0, const f32x16& p1) {
  float ma = p0[0], mb = p1[0];
#pragma unroll
  for (int r = 1; r < 16; ++r) { ma = fmaxf(ma, p0[r]); mb = fmaxf(mb, p1[r]); }
  return fmaxf(ma, mb);
}
__device__ __forceinline__ float halfmax(float pmax) {
  auto rr = __builtin_amdgcn_permlane32_swap(__float_as_uint(pmax), __float_as_uint(pmax), false, false);
  return fmaxf(__uint_as_float(rr[0]), __uint_as_float(rr[1]));
}
__device__ __forceinline__ void firstSM(f32x16& p0, f32x16& p1, float& m_reg, f32x16& negm) {
  const float d = halfmax(rowmax32p(p0, p1)); m_reg = d;
#pragma unroll
  for (int r = 0; r < 16; ++r) { p0[r] = __builtin_amdgcn_exp2f(p0[r] - d); p1[r] = __builtin_amdgcn_exp2f(p1[r] - d); }
#pragma unroll
  for (int r = 0; r < 16; ++r) negm[r] = -m_reg;
  asm volatile("" : "+v"(negm));
}
__device__ __forceinline__ void moveRef(f32x16& p0, f32x16& p1, float pmax, float& m_reg, f32x16& negm, float& alpha) {
  const float d = fmaxf(pmax, 0.f); alpha = __builtin_amdgcn_exp2f(-d); m_reg += d;
#pragma unroll
  for (int r = 0; r < 16; ++r) { p0[r] -= d; p1[r] -= d; }
#pragma unroll
  for (int r = 0; r < 16; ++r) negm[r] = -m_reg;
  asm volatile("" : "+v"(negm));
}
__device__ __forceinline__ void finishSM(f32x16& p0, f32x16& p1, float alpha, float& l_reg, bf16x8& pa0, bf16x8& pa1, bf16x8& pa2, bf16x8& pa3) {
  float s0 = p0[0], s1 = p0[1], s2 = p1[0], s3 = p1[1];
#pragma unroll
  for (int r = 2; r < 16; r += 2) { s0 += p0[r]; s1 += p0[r + 1]; s2 += p1[r]; s3 += p1[r + 1]; }
  const float ps = (s0 + s1) + (s2 + s3);
  l_reg = l_reg * alpha + ps; asm volatile("" : "+v"(l_reg));
#define APK4(P, BASE, OUT) do { u32x4 w = {cvtpk(P[BASE + 0], P[BASE + 1]), cvtpk(P[BASE + 2], P[BASE + 3]), cvtpk(P[BASE + 4], P[BASE + 5]), cvtpk(P[BASE + 6], P[BASE + 7])}; \
    OUT = *reinterpret_cast<bf16x8*>(&w); } while (0)
  APK4(p0, 0, pa0); APK4(p0, 8, pa1); APK4(p1, 0, pa2); APK4(p1, 8, pa3);
#undef APK4
}
__device__ __forceinline__ void qkt(f32x16& p0, f32x16& p1, const char* Ks, const bf16x8* qr, const f32x16& negm, int r32, int hi) {
#pragma unroll
  for (int d0 = 0; d0 < 4; ++d0) { const int cb = (d0 * 16 + hi * 8) * 2;
    bf16x8 b0 = *reinterpret_cast<const bf16x8*>(Ks + AKSWZ(r32, cb));
    bf16x8 b1 = *reinterpret_cast<const bf16x8*>(Ks + AKSWZ(32 + r32, cb));
    if (d0 == 0) { p0 = __builtin_amdgcn_mfma_f32_32x32x16_bf16(b0, qr[0], negm, 0, 0, 0); p1 = __builtin_amdgcn_mfma_f32_32x32x16_bf16(b1, qr[0], negm, 0, 0, 0); }
    else { p0 = __builtin_amdgcn_mfma_f32_32x32x16_bf16(b0, qr[d0], p0, 0, 0, 0); p1 = __builtin_amdgcn_mfma_f32_32x32x16_bf16(b1, qr[d0], p1, 0, 0, 0); } }
}
__device__ __forceinline__ int v_st(int k, int c) { const int kk = (k & ~0xC) | ((k & 4) << 1) | ((k & 8) >> 1); return ((kk >> 3) * 4 + (c >> 5)) * 512 + ((kk & 7) * 32 + (c & 31)) * 2; }
__device__ __forceinline__ int v_rd_base(int lane) { return ((lane & 3) << 3) | (((lane >> 2) & 3) << 6) | (((lane >> 4) & 1) << 5) | (((lane >> 5) & 1) << 11); }
constexpr int v_rd_off(int d0, int ks, int half) { return d0 * 512 + ks * 4096 + half * 256; }
template <int OFF> __device__ __forceinline__ s16x4 tr_read(int vb) {
  s16x4 r; asm volatile("ds_read_b64_tr_b16 %0, %1 offset:%2" : "=&v"(r) : "v"(vb), "i"(OFF) : "memory"); return r;
}
template <int D0> __device__ __forceinline__ void pv_one(f32x16& od, int vb, bf16x8 pa0, bf16x8 pa1, bf16x8 pa2, bf16x8 pa3) {
  const s16x4 l0 = tr_read<v_rd_off(D0, 0, 0)>(vb), h0 = tr_read<v_rd_off(D0, 0, 1)>(vb), l1 = tr_read<v_rd_off(D0, 1, 0)>(vb), h1 = tr_read<v_rd_off(D0, 1, 1)>(vb);
  const s16x4 l2 = tr_read<v_rd_off(D0, 2, 0)>(vb), h2 = tr_read<v_rd_off(D0, 2, 1)>(vb), l3 = tr_read<v_rd_off(D0, 3, 0)>(vb), h3 = tr_read<v_rd_off(D0, 3, 1)>(vb);
  asm volatile("s_waitcnt lgkmcnt(0)" ::: "memory"); ASBAR();
#define APK(L, H) (bf16x8){L[0], L[1], L[2], L[3], H[0], H[1], H[2], H[3]}
  od = __builtin_amdgcn_mfma_f32_32x32x16_bf16(pa0, APK(l0, h0), od, 0, 0, 0);
  od = __builtin_amdgcn_mfma_f32_32x32x16_bf16(pa1, APK(l1, h1), od, 0, 0, 0);
  od = __builtin_amdgcn_mfma_f32_32x32x16_bf16(pa2, APK(l2, h2), od, 0, 0, 0);
  od = __builtin_amdgcn_mfma_f32_32x32x16_bf16(pa3, APK(l3, h3), od, 0, 0, 0);
#undef APK
}
__device__ __forceinline__ void pv_d0(f32x16* o, int vb, bf16x8 pa0, bf16x8 pa1, bf16x8 pa2, bf16x8 pa3) {
  pv_one<0>(o[0], vb, pa0, pa1, pa2, pa3); pv_one<1>(o[1], vb, pa0, pa1, pa2, pa3); pv_one<2>(o[2], vb, pa0, pa1, pa2, pa3); pv_one<3>(o[3], vb, pa0, pa1, pa2, pa3);
}
constexpr int SLOT_K = 8192, SLOT_V = 16384, RING_V = 3 * SLOT_K, WS_OFF = 3 * SLOT_K + 3 * SLOT_V;
constexpr size_t SHM_ATTN = WS_OFF + NW * 64 * 4;
#define AWAIT_BAR(N) asm volatile("s_waitcnt vmcnt(" #N ") lgkmcnt(0)\n\ts_barrier" ::: "memory")
template <int LDQ, int LDO>
__device__ __forceinline__ void attn_unit(const unsigned short* __restrict__ Qb, const unsigned short* __restrict__ Kh, const unsigned short* __restrict__ Vh,
                                          unsigned short* __restrict__ Ob, int seq, PG8_LAS unsigned char* ldsl, int wid) {
  char* lds = (char*)ldsl;
  const int tid = pg8::tid_from(wid), lane = tid & 63, r32 = lane & 31, hi = lane >> 5;
  char* K_lds = lds;
  float* ws = (float*)(lds + WS_OFF) + wid * 64; float* li_l = ws; float* al_l = ws + 32;
  float m_reg = 0.f, l_reg = 0; f32x16 o[4] = {}; bf16x8 qr[4]; f32x16 negm = f32x16{}; asm volatile("" : "+v"(negm));
  const unsigned short* Qw = Qb + (long)(wid * QBLK + r32) * LDQ + hi * 8;
#pragma unroll
  for (int d0 = 0; d0 < 4; ++d0) qr[d0] = *reinterpret_cast<const bf16x8*>(Qw + d0 * 16);
  const int krow = tid >> 3; const unsigned koff = (unsigned)(krow * LDQ * 2 + (((tid & 7) ^ ((krow >> 1) & 7)) << 4));
  unsigned voff[2];
#pragma unroll
  for (int i = 0; i < 2; ++i) { const int L = tid + 512 * i, sub = L >> 5, within = (L & 31) * 16, kk = (sub >> 2) * 8 + (within >> 6);
    const int k = (kk & ~0xC) | ((kk & 4) << 1) | ((kk & 8) >> 1), c = (sub & 3) * 32 + ((within & 63) >> 4) * 8; voff[i] = (unsigned)(k * LDQ * 2 + c * 2); }
  const int NT = seq / KVBLK; const unsigned ldsw = (unsigned)wid * 1024u;
#define ADMA_K(tile, slot) do { const int tl_ = (tile) < NT ? (tile) : NT - 1; const char* g_ = (const char*)Kh + (size_t)tl_ * (KVBLK * LDQ * 2); \
    __builtin_amdgcn_global_load_lds((const unsigned*)(g_ + koff), (PG8_LAS unsigned*)(ldsl + (slot) * SLOT_K + ldsw), 16, 0, 0); } while (0)
#define ADMA_V(tile, slot) do { const int tl_ = (tile) < NT ? (tile) : NT - 1; const char* g_ = (const char*)Vh + (size_t)tl_ * (KVBLK * LDQ * 2); \
    __builtin_amdgcn_global_load_lds((const unsigned*)(g_ + voff[0]), (PG8_LAS unsigned*)(ldsl + RING_V + (slot) * SLOT_V + ldsw), 16, 0, 0); \
    __builtin_amdgcn_global_load_lds((const unsigned*)(g_ + voff[1]), (PG8_LAS unsigned*)(ldsl + RING_V + (slot) * SLOT_V + 8192 + ldsw), 16, 0, 0); } while (0)
  const int vb0 = (int)(uintptr_t)(lds + RING_V) + v_rd_base(lane);
#define ARESC(a) do { if (__any((a) < 1.f)) { if (hi == 0) al_l[r32] = (a); asm volatile("s_waitcnt lgkmcnt(0)" ::: "memory"); \
    _Pragma("unroll") for (int d = 0; d < 4; ++d) _Pragma("unroll") for (int r = 0; r < 16; ++r) o[d][r] *= al_l[crow(r, hi)]; } } while (0)
#define AROT() do { const int t_ = s0; s0 = s1; s1 = s2; s2 = t_; } while (0)
  f32x16 pA0, pA1, pB0, pB1; float alA, alB; bf16x8 pa0, pa1, pa2, pa3;
  int s0 = 0, s1 = 1, s2 = 2;
#define TRR(F, D0, VB) do { F[0] = tr_read<v_rd_off(D0, 0, 0)>(VB); F[1] = tr_read<v_rd_off(D0, 0, 1)>(VB); F[2] = tr_read<v_rd_off(D0, 1, 0)>(VB); F[3] = tr_read<v_rd_off(D0, 1, 1)>(VB); \
    F[4] = tr_read<v_rd_off(D0, 2, 0)>(VB); F[5] = tr_read<v_rd_off(D0, 2, 1)>(VB); F[6] = tr_read<v_rd_off(D0, 3, 0)>(VB); F[7] = tr_read<v_rd_off(D0, 3, 1)>(VB); } while (0)
#define APK(L, H) (bf16x8){L[0], L[1], L[2], L[3], H[0], H[1], H[2], H[3]}
#define PVM(F, D0) do { o[D0] = __builtin_amdgcn_mfma_f32_32x32x16_bf16(pa0, APK(F[0], F[1]), o[D0], 0, 0, 0); o[D0] = __builtin_amdgcn_mfma_f32_32x32x16_bf16(pa1, APK(F[2], F[3]), o[D0], 0, 0, 0); \
    o[D0] = __builtin_amdgcn_mfma_f32_32x32x16_bf16(pa2, APK(F[4], F[5]), o[D0], 0, 0, 0); o[D0] = __builtin_amdgcn_mfma_f32_32x32x16_bf16(pa3, APK(F[6], F[7]), o[D0], 0, 0, 0); } while (0)
#define LWAIT() asm volatile("s_waitcnt lgkmcnt(0)" ::: "memory")
#define EXPS(P, A, B) do { _Pragma("unroll") for (int r_ = (A); r_ < (B); ++r_) P[r_] = __builtin_amdgcn_exp2f(P[r_]); } while (0)
#define TR1(F, I, D0, VB) do { F[2 * (I)] = tr_read<v_rd_off(D0, I, 0)>(VB); F[2 * (I) + 1] = tr_read<v_rd_off(D0, I, 1)>(VB); } while (0)
#define MF(a, b, c) __builtin_amdgcn_mfma_f32_32x32x16_bf16(a, b, c, 0, 0, 0)
#define PVG(F, D0, FN, DN, PX, PY, A0, A1, A2, A3, A4, B0, B1, B2, B3, B4) do { \
    o[D0] = MF(pa0, APK(F[0], F[1]), o[D0]); TR1(FN, 0, DN, vb_); EXPS(PX, A0, A1); EXPS(PY, B0, B1); asm volatile("" : "+v"(PX), "+v"(PY)); ASBAR(); \
    o[D0] = MF(pa1, APK(F[2], F[3]), o[D0]); TR1(FN, 1, DN, vb_); EXPS(PX, A1, A2); EXPS(PY, B1, B2); asm volatile("" : "+v"(PX), "+v"(PY)); ASBAR(); \
    o[D0] = MF(pa2, APK(F[4], F[5]), o[D0]); TR1(FN, 2, DN, vb_); EXPS(PX, A2, A3); EXPS(PY, B2, B3); asm volatile("" : "+v"(PX), "+v"(PY)); ASBAR(); \
    o[D0] = MF(pa3, APK(F[6], F[7]), o[D0]); TR1(FN, 3, DN, vb_); EXPS(PX, A3, A4); EXPS(PY, B3, B4); asm volatile("" : "+v"(PX), "+v"(PY)); ASBAR(); } while (0)
#define PVSM(VB, P0, P1, AL) do { const int vb_ = (VB); s16x4 fa[8], fb[8]; float pm_; \
    TRR(fa, 0, vb_); LWAIT(); ASBAR(); \
    PVM(fa, 0); TRR(fb, 1, vb_); pm_ = rowmax32p(P0, P1); \
    if (__builtin_expect(__all(pm_ <= THR2), 1)) { AL = 1.f; } else { moveRef(P0, P1, halfmax(pm_), m_reg, negm, AL); } \
    LWAIT(); ASBAR(); \
    PVG(fb, 1, fa, 2, P0, P1, 0, 3, 6, 9, 11, 0, 0, 0, 0, 0); LWAIT(); ASBAR(); \
    PVG(fa, 2, fb, 3, P0, P1, 11, 14, 16, 16, 16, 0, 0, 1, 4, 6); LWAIT(); ASBAR(); \
    o[3] = MF(pa0, APK(fb[0], fb[1]), o[3]); EXPS(P1, 6, 9); asm volatile("" : "+v"(P1)); ASBAR(); \
    o[3] = MF(pa1, APK(fb[2], fb[3]), o[3]); EXPS(P1, 9, 12); asm volatile("" : "+v"(P1)); ASBAR(); \
    o[3] = MF(pa2, APK(fb[4], fb[5]), o[3]); EXPS(P1, 12, 14); asm volatile("" : "+v"(P1)); ASBAR(); \
    o[3] = MF(pa3, APK(fb[6], fb[7]), o[3]); EXPS(P1, 14, 16); asm volatile("" : "+v"(P1)); ASBAR(); } while (0)
  ADMA_K(0, 0); ADMA_V(0, 0); ADMA_K(1, 1); ADMA_V(1, 1); ADMA_K(2, 2);
  AWAIT_BAR(4);
  qkt(pA0, pA1, K_lds, qr, negm, r32, hi); firstSM(pA0, pA1, m_reg, negm); alA = 1.f;
#pragma unroll 1
  for (int t = 0; t + 2 < NT; t += 2) {
    AWAIT_BAR(3); ADMA_K(t + 3, s0); ADMA_V(t + 2, s2);
    ASBAR(); qkt(pB0, pB1, K_lds + s1 * SLOT_K, qr, negm, r32, hi);
    finishSM(pA0, pA1, alA, l_reg, pa0, pa1, pa2, pa3); ASBAR();
    PVSM(vb0 + s0 * SLOT_V, pB0, pB1, alB);
    ARESC(alB); AROT();
    AWAIT_BAR(3); ADMA_K(t + 4, s0); ADMA_V(t + 3, s2);
    ASBAR(); qkt(pA0, pA1, K_lds + s1 * SLOT_K, qr, negm, r32, hi);
    finishSM(pB0, pB1, alB, l_reg, pa0, pa1, pa2, pa3); ASBAR();
    PVSM(vb0 + s0 * SLOT_V, pA0, pA1, alA);
    ARESC(alA); AROT();
  }
  AWAIT_BAR(3);
  ASBAR(); qkt(pB0, pB1, K_lds + s1 * SLOT_K, qr, negm, r32, hi);
  finishSM(pA0, pA1, alA, l_reg, pa0, pa1, pa2, pa3); ASBAR();
  PVSM(vb0 + s0 * SLOT_V, pB0, pB1, alB);
  ARESC(alB); AROT();
  AWAIT_BAR(0);
  finishSM(pB0, pB1, alB, l_reg, pa0, pa1, pa2, pa3); ASBAR();
  pv_d0(o, vb0 + s0 * SLOT_V, pa0, pa1, pa2, pa3);
  { auto rr = __builtin_amdgcn_permlane32_swap(__float_as_uint(l_reg), __float_as_uint(l_reg), false, false); l_reg = __uint_as_float(rr[0]) + __uint_as_float(rr[1]); }
  if (hi == 0) li_l[r32] = l_reg; asm volatile("s_waitcnt lgkmcnt(0)" ::: "memory");
  float rli[16];
#pragma unroll
  for (int r = 0; r < 16; ++r) rli[r] = __builtin_amdgcn_rcpf(li_l[crow(r, hi)]);
  unsigned short* Ow = Ob + (long)(wid * QBLK) * LDO;
#pragma unroll
  for (int r = 0; r < 16; ++r) { const int orow = crow(r, hi);
#pragma unroll
    for (int d0 = 0; d0 < 4; ++d0) { const float v = o[d0][r] * rli[r]; Ow[(long)orow * LDO + d0 * 32 + r32] = (unsigned short)(cvtpk(v, v) & 0xffffu); } }
  __syncthreads();
#undef ADMA_K
#undef TR1
#undef MF
#undef PVG
#undef TRR
#undef APK
#undef PVM
#undef LWAIT
#undef EXPS
#undef PVSM
#undef ADMA_V
#undef ARESC
#undef AROT
}
}

constexpr int NWAVES = 8, NTHR = NWAVES * 64;
constexpr int DM = 1024, NB = 4, SEQ = 4096, CTXL = 256, RPB = CTXL + SEQ  , MROWS = NB * RPB  ;
constexpr int INW = 5904, NPROJ = 6144, PLD = 5888;
constexpr int FFD = 2816, FFE = 3584, NEXP = 8, FFEH = FFE / 2;
constexpr int NCHUNK = RPB / 64;
constexpr float EPSN = 1e-6f;
constexpr int PC_AQ = 0, PC_AK = 512, PC_AV = 1024, PC_DQ = 1536, PC_DK = 1792, PC_DV = 2048, PC_DZ = 2304, PC_POOL = 2560, PC_GATE = 2816, PC_AB = 5888;

constexpr size_t MiB = 1u << 20;
constexpr size_t WS_CTL = 0, CTL_ZERO_BYTES = 2 * MiB;
constexpr size_t WS_MOD = 1 * MiB;
constexpr size_t WS_ROPE = 2 * MiB;
constexpr size_t WS_LAM = 2 * MiB + 65536;
constexpr size_t WS_ROUTE = 3 * MiB;
constexpr size_t WS_GB = 4 * MiB;
constexpr int NPB = 2816;
constexpr size_t WS_WIN = 8 * MiB;
constexpr size_t WS_WG8 = 20 * MiB;
constexpr size_t WS_WAB = 26 * MiB;
constexpr size_t WS_U8 = 484 * MiB;
constexpr size_t WS_WBR = 32 * MiB;
constexpr size_t WS_WOUT = 36 * MiB;
constexpr size_t WS_W13 = 40 * MiB;
constexpr size_t WS_W2 = 51 * MiB;
constexpr size_t WS_H = 58 * MiB;
constexpr size_t WS_U = 126 * MiB;
constexpr size_t WS_ATTO = WS_U;
constexpr size_t WS_MIX = WS_U;
constexpr size_t WS_PROJ = 160 * MiB;
constexpr size_t WS_POOLO = 356 * MiB;
constexpr size_t WS_W2M = 365 * MiB;
constexpr size_t WS_DNP = 398 * MiB;
constexpr size_t WS_MG = WS_DNP;
constexpr size_t WS_DNG = 466 * MiB;
constexpr size_t WS_DNO = 467 * MiB;
constexpr size_t WS_W13M = 484 * MiB;
constexpr size_t WS_SLAB = 256 * MiB;
constexpr size_t WS_HID = WS_PROJ;
constexpr int MOE_MAXT = 136;
constexpr size_t WS_HIDM = 160 * MiB;
constexpr size_t WS_XG = 279 * MiB;
constexpr size_t WS_Y = 279 * MiB;
constexpr size_t WS_END = 540 * MiB;
static_assert(WS_HIDM + (size_t)MOE_MAXT * 256 * FFE <= WS_XG && WS_Y + (size_t)MOE_MAXT * 256 * 1024 * 2 <= WS_POOLO && WS_DNO + (size_t)2 * MROWS * 256 * 2 <= WS_W13M && WS_W13M + (size_t)8 * 2 * FFE * 1024 <= WS_END, "ws map");
static_assert(WS_WIN + (size_t)2 * NPB * 1024 * 2 <= WS_WG8 && WS_WG8 + (size_t)2 * 3072 * 1024 <= WS_WAB && WS_WAB + 2 * 65536 <= WS_WBR && WS_W13 + (size_t)2 * FFD * 1024 * 2 <= WS_W2 && WS_W2 + (size_t)1024 * FFD * 2 <= WS_H, "ws map (weights)");
static_assert(WS_H + (size_t)MROWS * 1024 * 4 <= WS_U && WS_U + (size_t)MROWS * 1024 * 2 <= WS_PROJ && WS_PROJ + (size_t)MROWS * PLD * 2 <= WS_POOLO && WS_POOLO + (size_t)MROWS * 256 * 2 <= WS_W2M && WS_W2M + (size_t)8 * 1024 * FFE <= WS_DNP, "ws map (acts)");
static_assert(WS_DNP + (size_t)NB * NCHUNK * 4 * 2 * 32768 <= WS_DNG, "ws map (dn)");
constexpr int CW_TMO = 0, CW_CODE = 1;
constexpr int CW_BAR = 4096;
constexpr int CW_ECNT = 16384;

constexpr int RING_BYTES = 155648;
constexpr int MISC_OFF = RING_BYTES;
constexpr int LDS_BYTES = RING_BYTES + 1024;

enum { PH_PRO = 0, PH_L0 = 1, PH_N1 = 0, PH_PROJ = 1, PH_ATT = 2, PH_SCAN = 3, PH_MIXB = 4, PH_MRG0 = 5, PH_MRG1 = 6, PH_MRG2 = 7, PH_OUT = 8, PH_N2 = 9, PH_LAYER = 10,
       PH_FUP = 11, PH_FDN = 12, PH_L1 = 13, PH_GATH = 23, PH_CV0 = 24, PH_UP0 = 25, PH_DN0 = 26, PH_CV1 = 27, PH_UP1 = 28, PH_DN1 = 29, PH_FIN = 30, PH_COUNT = 31 };

#define GAS __attribute__((address_space(1)))
#define LAS __attribute__((address_space(3)))
typedef unsigned short bf16;
typedef unsigned v4u __attribute__((ext_vector_type(4)));
typedef unsigned v2u __attribute__((ext_vector_type(2)));
typedef float f32x4 __attribute__((ext_vector_type(4)));
typedef GAS unsigned gu32;
#define RLX_AGENT __ATOMIC_RELAXED, __HIP_MEMORY_SCOPE_AGENT
#define LDS_WAIT() asm volatile("s_waitcnt lgkmcnt(0)" ::: "memory")
#define VM_WAIT() asm volatile("s_waitcnt vmcnt(0)" ::: "memory")
__device__ __forceinline__ unsigned f2bf(float f) { unsigned u = __builtin_bit_cast(unsigned, f); return (u + 0x7fffu + ((u >> 16) & 1u)) >> 16; }
typedef float f32x2_c __attribute__((ext_vector_type(2))); typedef __bf16 bf16x2_c __attribute__((ext_vector_type(2)));
__device__ __forceinline__ unsigned cvtpk_c(float lo, float hi) { f32x2_c v = {lo, hi}; bf16x2_c b = __builtin_convertvector(v, bf16x2_c); return __builtin_bit_cast(unsigned, b); }
__device__ __forceinline__ unsigned pk2(float lo, float hi) { return cvtpk_c(lo, hi); }
__device__ __forceinline__ unsigned cvt4_fp8(float a, float b, float c, float d) {
    a = fminf(fmaxf(a, -448.f), 448.f); b = fminf(fmaxf(b, -448.f), 448.f); c = fminf(fmaxf(c, -448.f), 448.f); d = fminf(fmaxf(d, -448.f), 448.f);
    int r = 0; r = __builtin_amdgcn_cvt_pk_fp8_f32(a, b, r, false); r = __builtin_amdgcn_cvt_pk_fp8_f32(c, d, r, true); return (unsigned)r; }
constexpr int E8(int log2scale) { return (127 - log2scale) * 0x01010101; }
constexpr int F8_ACT_L2 = 3, F8_W13_L2 = 5, F8_W2_L2 = 6;
__device__ __forceinline__ float bf_lo(unsigned w) { return __builtin_bit_cast(float, w << 16); }
__device__ __forceinline__ float bf_hi(unsigned w) { return __builtin_bit_cast(float, w & 0xffff0000u); }
__device__ __forceinline__ float bf2f(bf16 v) { return __builtin_bit_cast(float, (unsigned)v << 16); }
__device__ __forceinline__ float sigmoidq_(float x) { return __builtin_amdgcn_rcpf(1.f + __builtin_amdgcn_exp2f(x * -1.4426950408889634f)); }
__device__ __forceinline__ float sigmoidf_(float x) { return sigmoidq_(x); }
__device__ __forceinline__ float siluq_(float x) { return x * __builtin_amdgcn_rcpf(1.f + __builtin_amdgcn_exp2f(x * -1.4426950408889634f)); }
__device__ __forceinline__ float siluf_(float x) { return siluq_(x); }
__device__ __forceinline__ float dpp_add_(float v, const int ctrl_sel) {
    int r;
    if (ctrl_sel == 0) r = __builtin_amdgcn_update_dpp(0, __builtin_bit_cast(int, v), 0xB1, 0xF, 0xF, false);
    else if (ctrl_sel == 1) r = __builtin_amdgcn_update_dpp(0, __builtin_bit_cast(int, v), 0x4E, 0xF, 0xF, false);
    else if (ctrl_sel == 2) r = __builtin_amdgcn_update_dpp(0, __builtin_bit_cast(int, v), 0x141, 0xF, 0xF, false);
    else r = __builtin_amdgcn_update_dpp(0, __builtin_bit_cast(int, v), 0x140, 0xF, 0xF, false);
    return v + __builtin_bit_cast(float, r);
}
__device__ __forceinline__ float grp8_sum(float v) { v = dpp_add_(v, 0); v = dpp_add_(v, 1); v = dpp_add_(v, 2); return v; }
__device__ __forceinline__ float grp16_sum(float v) { v = grp8_sum(v); v = dpp_add_(v, 3); return v; }
__device__ __forceinline__ float wave_sum(float v) {
    v = grp16_sum(v);
    { auto rr = __builtin_amdgcn_permlane16_swap(__float_as_uint(v), __float_as_uint(v), false, false); v = __uint_as_float(rr[0]) + __uint_as_float(rr[1]); }
    { auto rr = __builtin_amdgcn_permlane32_swap(__float_as_uint(v), __float_as_uint(v), false, false); v = __uint_as_float(rr[0]) + __uint_as_float(rr[1]); }
    return v;
}
__device__ __forceinline__ int lane_id_() { return pg8::lane_id_asm(); }
__device__ __forceinline__ float lane_get(float v, int src) { return __builtin_bit_cast(float, __builtin_amdgcn_ds_bpermute(src << 2, __builtin_bit_cast(int, v))); }
#define XB_TMO      128
#define XB_XCNT(j)  (256  + 64 * (j))
#define XB_XSUB(j)  (1280 + 64 * (j))
#define XB_XGEN(j)  (2304 + 64 * (j))
#define XB_TOP      3328
#define XB_TOPGEN   3392
#define XCD_BAR_WORDS 3456
#define XB_SPIN_CAP (1u << 18)

__device__ __forceinline__ unsigned xb_ld(unsigned* p)              { return __hip_atomic_load(p, __ATOMIC_RELAXED, __HIP_MEMORY_SCOPE_AGENT); }
__device__ __forceinline__ unsigned xb_add(unsigned* p, unsigned v) { return __hip_atomic_fetch_add(p, v, __ATOMIC_RELAXED, __HIP_MEMORY_SCOPE_AGENT); }
__device__ __forceinline__ unsigned xb_xcc_id() { return (unsigned)__builtin_amdgcn_s_getreg((3 << 11) | 20) & 0xFu; }
#define XB_SPIN(cond, bar) do { unsigned _sp = 0; while (cond) { __builtin_amdgcn_s_sleep(1); \
    if ((++_sp & 255u) == 0u) { if (xb_ld(&(bar)[XB_TMO])) break; if (_sp > XB_SPIN_CAP) { atomicAdd(&(bar)[XB_TMO], 1u); break; } } } } while (0)

struct XcdBarrier {
    unsigned* bar; unsigned x; unsigned wid;
    volatile LAS unsigned* st;
};

__device__ __forceinline__ XcdBarrier xcd_barrier_post(unsigned* bar, volatile LAS unsigned* st, unsigned wid) {
    XcdBarrier b; b.bar = bar; b.x = xb_xcc_id(); b.st = st; b.wid = wid;
    if (wid == 0 && pg8::lane_id_asm() == 0) (void)xb_add(&bar[XB_XCNT(b.x)], 1u);
    return b;
}
__device__ __forceinline__ void xcd_barrier_complete(unsigned* bar, unsigned x, unsigned& nloc, unsigned& nx) {
    const unsigned G = gridDim.x * gridDim.y * gridDim.z;
    unsigned sum, cnt, mine, sp = 0u;
    for (;;) {
        sum = 0u; cnt = 0u; mine = 0u;
#pragma unroll
        for (unsigned j = 0; j < 16; ++j) { const unsigned c = xb_ld(&bar[XB_XCNT(j)]); sum += c; cnt += (c > 0u) ? 1u : 0u; mine = (j == x) ? c : mine; }
        if (sum == G) break;
        __builtin_amdgcn_s_sleep(1);
        if ((++sp & 255u) == 0u) { if (xb_ld(&bar[XB_TMO])) break; if (sp > XB_SPIN_CAP) { atomicAdd(&bar[XB_TMO], 1u); break; } }
    }
    nloc = mine > 0u ? mine : 1u; nx = cnt > 0u ? cnt : 1u;
}

__device__ __forceinline__ void xcd_barrier(const XcdBarrier& b) {
    asm volatile("s_waitcnt vmcnt(0)" ::: "memory");
    __syncthreads();
    if (b.wid == 0 && pg8::lane_id_asm() == 0) {
        unsigned* bar = b.bar;
        __builtin_amdgcn_s_waitcnt(0);
        unsigned nloc = b.st[0], nx = b.st[1];
        if (nloc == 0u) { xcd_barrier_complete(bar, b.x, nloc, nx); b.st[0] = nloc; b.st[1] = nx; }
        const unsigned old = xb_add(&bar[XB_XSUB(b.x)], 1u);
        const unsigned gen = old / nloc;
        if (old + 1u == (gen + 1u) * nloc) {
            __builtin_amdgcn_fence(__ATOMIC_RELEASE, "agent");
            asm volatile("s_waitcnt vmcnt(0)" ::: "memory");
            const unsigned og = xb_add(&bar[XB_TOP], 1u);
            const unsigned tg = og / nx;
            if (og + 1u == (tg + 1u) * nx) xb_add(&bar[XB_TOPGEN], 1u);
            else XB_SPIN(xb_ld(&bar[XB_TOPGEN]) == tg, bar);
            __builtin_amdgcn_fence(__ATOMIC_ACQUIRE, "agent");
            xb_add(&bar[XB_XGEN(b.x)], 1u);
            asm volatile("s_waitcnt vmcnt(0)" ::: "memory");
        } else {
            XB_SPIN(xb_ld(&bar[XB_XGEN(b.x)]) == gen, bar);
            __builtin_amdgcn_fence(__ATOMIC_ACQUIRE, "agent");
            asm volatile("s_waitcnt vmcnt(0)" ::: "memory");
        }
    }
    __syncthreads();
}
#ifndef SIGG
#define SIGG sigmoidq_
#endif
#ifndef SIL8
#define SIL8 siluq_
#endif
#ifndef SILD
#define SILD siluq_
#endif

struct Frame {
    LAS unsigned char* lds;
    volatile LAS unsigned* MISC;
    gu32* ctl;
    int tid, lane, wave, vcu, G, zz, bx, wid_s;
    unsigned char* ws;
    float* out;
};
struct Args { const float* in[27]; float* out; unsigned char* ws; int ph_lo, ph_hi, bar_li, pad; };

struct TileOrder {
    int nM, nN, nwg, G, c, skip;
    __device__ __forceinline__ void init(int nM_, int nN_, int G_, int c_, int skip_) { nM = nM_; nN = nN_; nwg = nM * nN; G = G_; c = c_; skip = skip_; }
    __device__ __forceinline__ bool next(int i, pg8::Unit& u) const {
        const long L = (long)i * G + c; if (L >= nwg) return false;
        int wgid = (int)L; { const int q = nwg / 8, r = nwg % 8, xcd = wgid % 8, off = wgid / 8; wgid = (xcd < r ? xcd * (q + 1) : r * (q + 1) + (xcd - r) * q) + off; }
        const int nig = 8 * nN, gid = wgid / nig, fm = gid * 8, gsz = (nM - fm) < 8 ? (nM - fm) : 8;
        int pm = fm + ((wgid % nig) % gsz); const int pn = (wgid % nig) / gsz;
        if (skip) pm = (pm >> 4) * 17 + 1 + (pm & 15);
        u.pm = pm; u.pn = pn; u.pb = pn; u.ko = 0; u.aux = 0; return true;
    }
    __device__ __forceinline__ void a_ready(const pg8::Unit&) const {}
    __device__ __forceinline__ void done(const pg8::Unit&) const {}
};
struct MoeOrder {
    int t1, t2, t3, t4, t5, t6, t7, t8, nN, G, c;
    __device__ __forceinline__ void init(const gu32* cnt, int nN_, int G_, int c_) {
        int t = 0;
        t += ((int)__hip_atomic_load(cnt + 0 * 64, RLX_AGENT) + 255) >> 8; t1 = t; t += ((int)__hip_atomic_load(cnt + 1 * 64, RLX_AGENT) + 255) >> 8; t2 = t;
        t += ((int)__hip_atomic_load(cnt + 2 * 64, RLX_AGENT) + 255) >> 8; t3 = t; t += ((int)__hip_atomic_load(cnt + 3 * 64, RLX_AGENT) + 255) >> 8; t4 = t;
        t += ((int)__hip_atomic_load(cnt + 4 * 64, RLX_AGENT) + 255) >> 8; t5 = t; t += ((int)__hip_atomic_load(cnt + 5 * 64, RLX_AGENT) + 255) >> 8; t6 = t;
        t += ((int)__hip_atomic_load(cnt + 6 * 64, RLX_AGENT) + 255) >> 8; t7 = t; t += ((int)__hip_atomic_load(cnt + 7 * 64, RLX_AGENT) + 255) >> 8; t8 = t;
        nN = nN_; G = G_; c = c_;
    }
    __device__ __forceinline__ int tile_off(int e) const { return e == 0 ? 0 : e == 1 ? t1 : e == 2 ? t2 : e == 3 ? t3 : e == 4 ? t4 : e == 5 ? t5 : e == 6 ? t6 : t7; }
    __device__ __forceinline__ bool next(int i, pg8::Unit& u) const {
        const long L = (long)i * G + c; if (L >= (long)t8 * nN) return false;
        const int pm = (int)(L / nN), pn = (int)(L % nN);
        const int e = (pm >= t1) + (pm >= t2) + (pm >= t3) + (pm >= t4) + (pm >= t5) + (pm >= t6) + (pm >= t7);
        u.pm = pm; u.pn = pn; u.pb = e * nN + pn; u.ko = 0; u.aux = 0; return true;
    }
    __device__ __forceinline__ void a_ready(const pg8::Unit&) const {}
    __device__ __forceinline__ void done(const pg8::Unit&) const {}
};

struct CtxSplitOrder {
    int S, kpb, G, c;
    __device__ __forceinline__ void init(int S_, int kp_bytes, int G_, int c_) { S = S_; kpb = kp_bytes; G = G_; c = c_; }
    __device__ __forceinline__ bool next(int i, pg8::Unit& u) const {
        const int L = i * G + c; if (L >= 16 * S) return false;
        const int ks = L % S, pn = (L / S) & 3, ct = L / (4 * S);
        u.pm = ct * 17; u.pn = pn; u.pb = pn; u.ko = ks * kpb; u.aux = ks; return true;
    }
    __device__ __forceinline__ void a_ready(const pg8::Unit&) const {}
    __device__ __forceinline__ void done(const pg8::Unit&) const {}
};
#define EPI_LOOP(...) _Pragma("unroll") for (int ai = 0; ai < 2; ++ai) _Pragma("unroll") for (int m = 0; m < 4; ++m) { const int row = u.pm * 256 + ai * 128 + wr * 64 + m * 16 + fr; \
    _Pragma("unroll") for (int bj = 0; bj < 2; ++bj) { const int col = bj * 128 + wc * 32 + 4 * fq; f32x4 v0 = acc[ai][bj][m][0], v1 = acc[ai][bj][m][1]; __VA_ARGS__ } if (m & 1) asm volatile("" ::: "memory"); }
#define EPI_LOOP8(...) _Pragma("unroll") for (int ai = 0; ai < 2; ++ai) _Pragma("unroll") for (int m = 0; m < 4; ++m) { const int row = u.pm * 256 + ai * 128 + wr * 64 + m * 16 + fr; \
    _Pragma("unroll") for (int bj = 0; bj < 2; ++bj) { const int col = bj * 128 + wc * 32 + 8 * fq; f32x4 v0 = acc[ai][bj][m][0], v1 = acc[ai][bj][m][1]; __VA_ARGS__ } if (m & 1) asm volatile("" ::: "memory"); }
__device__ __forceinline__ v4u pack8(f32x4 a, f32x4 b) { v4u w; w.x = cvtpk_c(a[0], a[1]); w.y = cvtpk_c(a[2], a[3]); w.z = cvtpk_c(b[0], b[1]); w.w = cvtpk_c(b[2], b[3]); return w; }
__device__ __forceinline__ v2u pack4(f32x4 v) { v2u w; w.x = cvtpk_c(v[0], v[1]); w.y = cvtpk_c(v[2], v[3]); return w; }
__device__ __forceinline__ f32x4 unpack4(v2u w) { return (f32x4){bf_lo(w.x), bf_hi(w.x), bf_lo(w.y), bf_hi(w.y)}; }

struct EpiProj {
    static constexpr bool PERM = false, AFTER_DRAIN = false, KHOOK = false;
    bf16* P; const float* rope;
    __device__ __forceinline__ void operator()(const pg8::f32x4 (&acc)[2][2][4][2], const pg8::Unit& u, int wr, int wc, int fr, int fq) const {
        asm volatile("" : "+v"(fr), "+v"(fq));
        const int pn = u.pn;
        if (pn < 4) {
            EPI_LOOP({ const int j = row % RPB;
                if (j >= CTXL) { const int t = j - CTXL; const int pos = (wc & 1) ? (t & 63) : (t >> 6);
                    const f32x4 cs0 = *(const f32x4*)(rope + (pos * 16 + 4 * fq) * 2), cs1 = *(const f32x4*)(rope + (pos * 16 + 4 * fq) * 2 + 4);
                    const float c0 = cs0[0], s0 = cs0[1], c1 = cs0[2], s1 = cs0[3], c2 = cs1[0], s2 = cs1[1], c3 = cs1[2], s3 = cs1[3];
                    const f32x4 a = v0, b = v1;
                    v0[0] = a[0] * c0 - b[0] * s0; v1[0] = b[0] * c0 + a[0] * s0; v0[1] = a[1] * c1 - b[1] * s1; v1[1] = b[1] * c1 + a[1] * s1;
                    v0[2] = a[2] * c2 - b[2] * s2; v1[2] = b[2] * c2 + a[2] * s2; v0[3] = a[3] * c3 - b[3] * s3; v1[3] = b[3] * c3 + a[3] * s3; }
                if (pn < 2) { v0 *= attn::QSCALE; v1 *= attn::QSCALE; }
                bf16* o = P + (size_t)row * PLD + pn * 256 + col; *(v2u*)o = pack4(v0); *(v2u*)(o + 16) = pack4(v1); })
        } else {
            EPI_LOOP8({ *(v4u*)(P + (size_t)row * PLD + pn * 256 + col) = pack8(v0, v1); })
        }
    }
};
struct EpiGate {
    static constexpr bool PERM = false, AFTER_DRAIN = false, KHOOK = false;
    bf16* P;
    __device__ __forceinline__ void operator()(const pg8::f32x4 (&acc)[2][2][4][2], const pg8::Unit& u, int wr, int wc, int fr, int fq) const {
        asm volatile("" : "+v"(fr), "+v"(fq));
        EPI_LOOP8({ for (int q = 0; q < 4; ++q) { v0[q] = SIGG(v0[q]); v1[q] = SIGG(v1[q]); }
            *(v4u*)(P + (size_t)row * PLD + PC_GATE + u.pn * 256 + col) = pack8(v0, v1); })
    }
};
struct EpiMergeF {
    static constexpr bool PERM = false, AFTER_DRAIN = false, KHOOK = true;
    bf16* MG; const bf16* P;
    __device__ __forceinline__ void khook(pg8::f32x4 (&acc)[2][2][4][2], const pg8::Unit& u, int t, int wr, int wc, int fr, int fq) const {
        asm volatile("" : "+v"(fr), "+v"(fq));
        const int gnum = PC_GATE + (t == 8 ? 0 : 1024), gden = gnum + 1024;
#pragma unroll
        for (int ai = 0; ai < 2; ++ai)
#pragma unroll
            for (int m = 0; m < 4; ++m) { const int row = u.pm * 256 + ai * 128 + wr * 64 + m * 16 + fr;
#pragma unroll
                for (int bj = 0; bj < 2; ++bj) { const int c = u.pn * 256 + bj * 128 + wc * 32 + 8 * fq; const bf16* gp = P + (size_t)row * PLD + c;
                    const v4u a = *(const v4u*)(gp + gnum), b = *(const v4u*)(gp + gden);
                    const f32x4 n0 = unpack4((v2u){a.x, a.y}), n1 = unpack4((v2u){a.z, a.w}), d0 = unpack4((v2u){b.x, b.y}), d1 = unpack4((v2u){b.z, b.w});
#pragma unroll
                    for (int q = 0; q < 4; ++q) { acc[ai][bj][m][0][q] *= n0[q] * __builtin_amdgcn_rcpf(fmaxf(d0[q], 1e-20f)); acc[ai][bj][m][1][q] *= n1[q] * __builtin_amdgcn_rcpf(fmaxf(d1[q], 1e-20f)); } }
                if (m & 1) asm volatile("" ::: "memory"); }
    }
    __device__ __forceinline__ void operator()(const pg8::f32x4 (&acc)[2][2][4][2], const pg8::Unit& u, int wr, int wc, int fr, int fq) const {
        asm volatile("" : "+v"(fr), "+v"(fq));
        EPI_LOOP8({ const int c = u.pn * 256 + col; const v4u gw = *(const v4u*)(P + (size_t)row * PLD + PC_GATE + 2048 + c);
            *(v4u*)(MG + (size_t)row * DM + c) = pack8(unpack4((v2u){gw.x, gw.y}) * v0, unpack4((v2u){gw.z, gw.w}) * v1); })
    }
};
struct EpiResid {
    static constexpr bool PERM = false, AFTER_DRAIN = false, KHOOK = false;
    float* H; const float* modl; int gidx; const float* xin;
    __device__ __forceinline__ void operator()(const pg8::f32x4 (&acc)[2][2][4][2], const pg8::Unit& u, int wr, int wc, int fr, int fq) const {
        asm volatile("" : "+v"(fr), "+v"(fq));
        EPI_LOOP8({ const int c = u.pn * 256 + col; const int b = row / RPB, j = row - b * RPB; const int mr = j < CTXL ? 4 : b;
            const float* gp = modl + mr * 6144 + gidx * 1024 + c; float* hp = H + (size_t)row * DM + c;
            const float* sp = xin ? xin + ((size_t)b * SEQ + (j - CTXL)) * DM + c : hp;
            const f32x4 g0 = *(const f32x4*)gp, g1 = *(const f32x4*)(gp + 4);
            *(f32x4*)hp = *(const f32x4*)sp + g0 * v0; *(f32x4*)(hp + 4) = *(const f32x4*)(sp + 4) + g1 * v1; })
    }
};
struct EpiSlab {
    static constexpr bool PERM = false, AFTER_DRAIN = false, KHOOK = false;
    float* SL; const float* modl; int gidx;
    __device__ __forceinline__ void operator()(const pg8::f32x4 (&acc)[2][2][4][2], const pg8::Unit& u, int wr, int wc, int fr, int fq) const {
        asm volatile("" : "+v"(fr), "+v"(fq));
        const float* gate = modl + 4 * 6144 + gidx * 1024; float* sl = SL + ((size_t)u.aux * 1024 + (u.pm / 17) * 256) * 1024;
#pragma unroll
        for (int ai = 0; ai < 2; ++ai)
#pragma unroll
            for (int m = 0; m < 4; ++m) { const int lr = ai * 128 + wr * 64 + m * 16 + fr;
#pragma unroll
                for (int bj = 0; bj < 2; ++bj) { const int c = u.pn * 256 + bj * 128 + wc * 32 + 8 * fq; const f32x4 g0 = *(const f32x4*)(gate + c), g1 = *(const f32x4*)(gate + c + 4);
                    float* o = sl + (size_t)lr * 1024 + c; *(f32x4*)o = g0 * acc[ai][bj][m][0]; *(f32x4*)(o + 4) = g1 * acc[ai][bj][m][1]; } }
    }
};
struct EpiSwiglu {
    static constexpr bool PERM = false, AFTER_DRAIN = false, KHOOK = false;
    bf16* HID; int ldh;
    __device__ __forceinline__ void operator()(const pg8::f32x4 (&acc)[2][2][4][2], const pg8::Unit& u, int wr, int wc, int fr, int fq) const {
        asm volatile("" : "+v"(fr), "+v"(fq));
#pragma unroll
        for (int ai = 0; ai < 2; ++ai)
#pragma unroll
            for (int m = 0; m < 4; ++m) { const int row = u.pm * 256 + ai * 128 + wr * 64 + m * 16 + fr; f32x4 r0, r1;
#pragma unroll
                for (int q = 0; q < 4; ++q) { r0[q] = SILD(acc[ai][0][m][0][q]) * acc[ai][0][m][1][q]; r1[q] = SILD(acc[ai][1][m][0][q]) * acc[ai][1][m][1][q]; }
                *(v4u*)(HID + (size_t)row * ldh + u.pn * 128 + wc * 32 + 8 * fq) = pack8(r0, r1);
                if (m & 1) asm volatile("" ::: "memory"); }
    }
};
struct EpiSwiglu8 {
    static constexpr bool PERM = false, AFTER_DRAIN = false, KHOOK = false;
    unsigned char* HID; int ldh;
    __device__ __forceinline__ void operator()(const pg8::f32x4 (&acc)[2][2][4][2], const pg8::Unit& u, int wr, int wc, int fr, int fq) const {
        asm volatile("" : "+v"(fr), "+v"(fq));
        const float s8 = (float)(1 << F8_ACT_L2);
#pragma unroll
        for (int ai = 0; ai < 2; ++ai)
#pragma unroll
            for (int m = 0; m < 4; ++m) { const int row = u.pm * 256 + ai * 128 + wr * 64 + m * 16 + fr; f32x4 r0, r1;
#pragma unroll
                for (int q = 0; q < 4; ++q) { r0[q] = SIL8(acc[ai][0][m][0][q]) * acc[ai][0][m][1][q] * s8; r1[q] = SIL8(acc[ai][1][m][0][q]) * acc[ai][1][m][1][q] * s8; }
                v2u o; o.x = cvt4_fp8(r0[0], r0[1], r0[2], r0[3]); o.y = cvt4_fp8(r1[0], r1[1], r1[2], r1[3]);
                *(v2u*)(HID + (size_t)row * ldh + u.pn * 128 + wc * 32 + 8 * fq) = o;
                if (m & 1) asm volatile("" ::: "memory"); }
    }
};
struct EpiY {
    static constexpr bool PERM = false, AFTER_DRAIN = false, KHOOK = false;
    bf16* Y; int first;
    __device__ __forceinline__ void operator()(const pg8::f32x4 (&acc)[2][2][4][2], const pg8::Unit& u, int wr, int wc, int fr, int fq) const {
        asm volatile("" : "+v"(fr), "+v"(fq));
        EPI_LOOP8({ (void)first; *(v4u*)(Y + (size_t)row * DM + u.pn * 256 + col) = pack8(v0, v1); })
    }
};

__device__ __forceinline__ int iperm32(int c) { return ((c >> 2) & 1) * 16 + (c >> 3) * 4 + (c & 3); }
template <int MAP> __device__ __forceinline__ int map_col(int c) {
    if (MAP == 0) return c;
    if (MAP == 1) { if (c >= 2560 && (c < 2576 || c >= 2832)) return -1;
        const int d = c < 2560 ? c : PC_POOL + (c - 2576);
        return d < 1024 ? d : (d & ~31) + iperm32(d & 31); }
    if (MAP == 4) return (c & ~31) + iperm32(c & 31);
    { const int x = c & 31; return (c >> 7) * 256 + ((x >> 2) & 1) * 128 + ((c >> 5) & 3) * 32 + (MAP == 3 ? 16 : 0) + 4 * (x >> 3) + (x & 3); }
}
template <int MAP> __device__ __forceinline__ void tr_item(const float* W, int ldw, int N, bf16* WT, int ldd, int item, LAS float* scr, int lane) {
    const int nblk = (N + 31) / 32, kb = item / nblk, nb = item % nblk, k0 = 64 * kb, n0 = 32 * nb;
    const int cl = n0 + (lane & 31);
    float tv[32];
#pragma unroll
    for (int i = 0; i < 32; ++i) { const int kk = 2 * i + (lane >> 5); tv[i] = cl < N ? W[(size_t)(k0 + kk) * ldw + cl] : 0.f; }
#pragma unroll
    for (int i = 0; i < 32; ++i) { const int kk = 2 * i + (lane >> 5); scr[kk * 33 + (lane & 31)] = tv[i]; }
    LDS_WAIT(); asm volatile("" ::: "memory");
    const int c = lane & 7;
#pragma unroll
    for (int j = 0; j < 4; ++j) { const int n = (lane >> 3) + 8 * j; const LAS float* s = scr + (8 * c) * 33 + n;
        const int dr = n0 + n < N ? map_col<MAP>(n0 + n) : -1;
        if (dr >= 0) { v4u o; o.x = pk2(s[0 * 33], s[1 * 33]); o.y = pk2(s[2 * 33], s[3 * 33]); o.z = pk2(s[4 * 33], s[5 * 33]); o.w = pk2(s[6 * 33], s[7 * 33]);
            *(GAS v4u*)(WT + (size_t)dr * ldd + k0 + 8 * c) = o; } }
    LDS_WAIT(); asm volatile("" ::: "memory");
}
template <int MAP> __device__ __forceinline__ void tr_item8(const float* W, int ldw, int N, unsigned char* WT, int ldd, int item, LAS float* scr, int lane, float scale) {
    const int nblk = (N + 31) / 32, kb = item / nblk, nb = item % nblk, k0 = 64 * kb, n0 = 32 * nb;
    const int cl = n0 + (lane & 31);
    float tv[32];
#pragma unroll
    for (int i = 0; i < 32; ++i) { const int kk = 2 * i + (lane >> 5); tv[i] = cl < N ? W[(size_t)(k0 + kk) * ldw + cl] : 0.f; }
#pragma unroll
    for (int i = 0; i < 32; ++i) { const int kk = 2 * i + (lane >> 5); scr[kk * 33 + (lane & 31)] = tv[i]; }
    LDS_WAIT(); asm volatile("" ::: "memory");
    const int c = lane & 7;
#pragma unroll
    for (int j = 0; j < 4; ++j) { const int n = (lane >> 3) + 8 * j; const LAS float* s = scr + (8 * c) * 33 + n;
        if (n0 + n < N) { v2u o; o.x = cvt4_fp8(s[0 * 33] * scale, s[1 * 33] * scale, s[2 * 33] * scale, s[3 * 33] * scale); o.y = cvt4_fp8(s[4 * 33] * scale, s[5 * 33] * scale, s[6 * 33] * scale, s[7 * 33] * scale);
            *(GAS v2u*)(WT + (size_t)map_col<MAP>(n0 + n) * ldd + k0 + 8 * c) = o; } }
    LDS_WAIT(); asm volatile("" ::: "memory");
}
#define TR_RUN(MAP, W, ldw, K, N, WT, ldd) { const int cnt_ = ((K) / 64) * (((N) + 31) / 32); if (r < cnt_) { tr_item<MAP>(W, ldw, N, WT, ldd, r, scr, F.lane); continue; } r -= cnt_; }

constexpr int LW_ITEMS = 16 * 185 + 8 * 32 + 4 * 32 + 4 * 32 + 16 * 32 + 16 * 96 + 64;
__device__ __forceinline__ void conv_layer_weights(Frame& F, const Args& A, int l, int rank, int nranks) {
    LAS float* scr = (LAS float*)(F.lds + F.wave * 16384);
    bf16* WIN = (bf16*)(F.ws + WS_WIN); bf16* WBR = (bf16*)(F.ws + WS_WBR); bf16* WOUT = (bf16*)(F.ws + WS_WOUT);
    const float* win = A.in[F.zz + 8] + (size_t)l * 1024 * INW; const float* wbr = A.in[F.zz + 17] + (size_t)l * 1024 * 1024; const float* wo = A.in[F.zz + 18] + (size_t)l * 1024 * 1024;
    bf16* dbr = WBR + (size_t)l * 1024 * 1024;
    for (int it = rank; it < LW_ITEMS; it += nranks) {
        int r = it;
        { const int cnt_ = 16 * 185; if (r < cnt_) { tr_item<1>(win, INW, INW, WIN + (size_t)l * NPB * 1024, 1024, r, scr, F.lane); continue; } r -= cnt_; }
        { const int cnt_ = 8 * 32; if (r < cnt_) { tr_item<4>(wbr, 1024, 1024, dbr, 1024, r, scr, F.lane); continue; } r -= cnt_; }
        { const int cnt_ = 4 * 32; if (r < cnt_) { tr_item<4>(wbr + 512 * 1024, 1024, 1024, dbr + 512, 1024, r, scr, F.lane); continue; } r -= cnt_; }
        { const int cnt_ = 4 * 32; if (r < cnt_) { tr_item<4>(wbr + 768 * 1024, 1024, 1024, dbr + 768, 1024, r, scr, F.lane); continue; } r -= cnt_; }
        { const int cnt_ = 16 * 32; if (r < cnt_) { tr_item<4>(wo, 1024, 1024, WOUT + (size_t)l * 1024 * 1024, 1024, r, scr, F.lane); continue; } r -= cnt_; }
        { const int cnt_ = 16 * 96; if (r < cnt_) { tr_item8<4>(win + 2832, INW, 3072, F.ws + WS_WG8 + (size_t)l * 3072 * 1024, 1024, r, scr, F.lane, (float)(1 << F8_W13_L2)); continue; } r -= cnt_; }
        { bf16* wab = (bf16*)(F.ws + WS_WAB) + (size_t)l * 16384;
          for (int e = F.lane; e < 256; e += 64) { const int k = r * 16 + (e >> 4), c = e & 15; wab[c * 1024 + k] = (bf16)f2bf(win[(size_t)k * INW + 2560 + c]); } }
    }
}
__device__ __forceinline__ void p0_prologue(Frame& F, const Args& A) {
    LAS float* scr = (LAS float*)(F.lds + F.wave * 16384);
    const int gw = F.vcu * NWAVES + F.wave, NGW = F.G * NWAVES;
    bf16* W13 = (bf16*)(F.ws + WS_W13); bf16* W2 = (bf16*)(F.ws + WS_W2);
    conv_layer_weights(F, A, 0, gw, NGW);
    constexpr int TOTAL = 16 * 88 * 2 + 44 * 32;
    for (int it = gw; it < TOTAL; it += NGW) {
        int r = it;
#ifdef DENSE_F8
        { const int cnt_ = 16 * 88; if (r < cnt_) { tr_item8<2>(A.in[F.zz + 19], FFD, FFD, (unsigned char*)W13, 1024, r, scr, F.lane, (float)(1 << F8_W13_L2)); continue; } r -= cnt_; }
        { const int cnt_ = 16 * 88; if (r < cnt_) { tr_item8<3>(A.in[F.zz + 20], FFD, FFD, (unsigned char*)W13, 1024, r, scr, F.lane, (float)(1 << F8_W13_L2)); continue; } r -= cnt_; }
        tr_item8<4>(A.in[F.zz + 21], 1024, 1024, (unsigned char*)W2, FFD, r, scr, F.lane, (float)(1 << F8_W2_L2));
#else
        { const int cnt_ = 16 * 88; if (r < cnt_) { tr_item<2>(A.in[F.zz + 19], FFD, FFD, W13, 1024, r, scr, F.lane); continue; } r -= cnt_; }
        { const int cnt_ = 16 * 88; if (r < cnt_) { tr_item<3>(A.in[F.zz + 20], FFD, FFD, W13, 1024, r, scr, F.lane); continue; } r -= cnt_; }
        tr_item<4>(A.in[F.zz + 21], 1024, 1024, W2, FFD, r, scr, F.lane);
#endif
    }
    if (F.vcu == 0 && F.tid < 8) __hip_atomic_store(F.ctl + CW_ECNT + 64 * F.tid, 0u, RLX_AGENT);
    if (F.vcu == 0) {
        float* rope = (float*)(F.ws + WS_ROPE);
        for (int e = F.tid; e < 1024; e += NTHR) { const int pos = e >> 4, i = e & 15; const float inv = powf(10000.f, -(float)i / 16.f); const float a = (float)pos * inv;
            rope[2 * e] = cosf(a); rope[2 * e + 1] = sinf(a); }
        if (F.tid < 2) { const int l = F.tid; const float* lp = A.in[F.zz + 9] + l * 256; float s1 = 0.f, s2 = 0.f;
            for (int i = 0; i < 64; ++i) { s1 += lp[i] * lp[64 + i]; s2 += lp[128 + i] * lp[192 + i]; }
            const float li = 0.8f - 0.6f * expf(-0.3f * (float)l);
            ((float*)(F.ws + WS_LAM))[l] = expf(s1) - expf(s2) + li; }
    }
    __syncthreads();
    float* MOD = (float*)(F.ws + WS_MOD);
    LAS float* red = (LAS float*)F.lds;
    for (int task = F.vcu; task < 2 * 96; task += F.G) {
        const int l = task / 96, cc = task % 96;
        const float* aw = A.in[F.zz + 4] + (size_t)l * 1024 * 6144 + cc * 64 + F.lane;
        const float* c0 = A.in[F.zz + 1]; const float* cx = A.in[F.zz + 3];
        float a0 = 0.f, a1 = 0.f, a2 = 0.f, a3 = 0.f, a4 = 0.f;
#pragma unroll 8
        for (int i = 0; i < 128; ++i) { const int k = F.wave * 128 + i; const float w = aw[(size_t)k * 6144];
            a0 += siluf_(c0[k]) * w; a1 += siluf_(c0[1024 + k]) * w; a2 += siluf_(c0[2048 + k]) * w; a3 += siluf_(c0[3072 + k]) * w; a4 += siluf_(cx[k]) * w; }
        LAS float* rw = red + F.wave * 320 + F.lane;
        rw[0] = a0; rw[64] = a1; rw[128] = a2; rw[192] = a3; rw[256] = a4;
        __syncthreads();
        if (F.tid < 320) { float s = 0.f;
#pragma unroll
            for (int w = 0; w < 8; ++w) s += red[w * 320 + F.tid];
            const int rr = F.tid >> 6, jj = cc * 64 + (F.tid & 63);
            MOD[(l * 5 + rr) * 6144 + jj] = s + A.in[F.zz + 5][l * 6144 + jj]; }
        __syncthreads();
    }
}

template <int PART>
__device__ __forceinline__ void moe_convert(Frame& F, const Args& A, int rank, int nranks) {
    LAS float* scr = (LAS float*)(F.lds + F.wave * 16384);
    const int gw = rank, NGW = nranks;
    unsigned char* W13M = F.ws + WS_W13M; unsigned char* W2M = F.ws + WS_W2M;
    constexpr int I13 = 16 * 112, I2 = 56 * 32;
    if (PART == 0) {
        for (int it = gw; it < 8 * I2; it += NGW) { const int e = it / I2, r = it - e * I2;
            tr_item8<4>(A.in[F.zz + 25] + (size_t)e * FFE * 1024, 1024, 1024, W2M + (size_t)e * 1024 * FFE, FFE, r, scr, F.lane, (float)(1 << F8_W2_L2)); }
    } else {
        for (int it = gw; it < 16 * I13; it += NGW) { const int e = it / (2 * I13); int r = it - e * 2 * I13;
            if (r < I13) { tr_item8<2>(A.in[F.zz + 23] + (size_t)e * 1024 * FFE, FFE, FFE, W13M + (size_t)e * 2 * FFE * 1024, 1024, r, scr, F.lane, (float)(1 << F8_W13_L2)); continue; } r -= I13;
            tr_item8<3>(A.in[F.zz + 24] + (size_t)e * 1024 * FFE, FFE, FFE, W13M + (size_t)e * 2 * FFE * 1024, 1024, r, scr, F.lane, (float)(1 << F8_W13_L2)); }
    }
}

__device__ __forceinline__ void norm_mod_phase(Frame& F, const Args& A, int l, int which, bool latent_only, bool route, bool out8 = false, int nslab = 0, int srcmode = 0) {
    (void)latent_only; (void)route;
    const int gw = F.vcu * NWAVES + F.wave, NGW = F.G * NWAVES;
    const float* H = (const float*)(F.ws + WS_H); bf16* U = (bf16*)(F.ws + WS_U); const float* MOD = (const float*)(F.ws + WS_MOD) + l * 5 * 6144;
    const float* g = (which ? A.in[F.zz + 7] : A.in[F.zz + 6]) + l * 1024;
    const float* xin = A.in[F.zz + 0]; const float* cin = A.in[F.zz + 2];
#define NM_SRC(R_) ({ const int b_ = (R_) / RPB, j_ = (R_) - b_ * RPB; const float* p_ = (srcmode == 1 || (srcmode == 2 && j_ < CTXL)) ? (j_ < CTXL ? cin + ((size_t)b_ * CTXL + j_) * DM : xin + ((size_t)b_ * SEQ + (j_ - CTXL)) * DM) : H + (size_t)(R_) * DM; p_; })
    f32x4 nv[4];
    if (gw < MROWS) { const GAS f32x4* xr = (const GAS f32x4*)NM_SRC(gw) + F.lane;
#pragma unroll
        for (int q = 0; q < 4; ++q) nv[q] = xr[64 * q]; }
#pragma unroll 1
    for (int R = gw; R < MROWS; R += NGW) {
        const int b = R / RPB, j = R - b * RPB; const bool isctx = j < CTXL;
        const float* mod = MOD + (isctx ? 4 : b) * 6144; const float* shift = mod + (which ? 3 : 0) * 1024; const float* scale = mod + (which ? 4 : 1) * 1024;
        f32x4 v[4]; float ss = 0.f;
#pragma unroll
        for (int q = 0; q < 4; ++q) v[q] = nv[q];
        if (R + NGW < MROWS) { const GAS f32x4* xr = (const GAS f32x4*)NM_SRC(R + NGW) + F.lane;
#pragma unroll
            for (int q = 0; q < 4; ++q) nv[q] = xr[64 * q]; }
        if (nslab > 0 && isctx) {
            const GAS f32x4* sp = (const GAS f32x4*)((const float*)(F.ws + WS_SLAB) + (size_t)(b * 256 + j) * 1024) + F.lane;
#pragma unroll
            for (int q = 0; q < 4; ++q) { f32x4 t[11];
#pragma unroll
                for (int s = 0; s < 11; ++s) t[s] = s < nslab ? sp[(size_t)s * 262144 + 64 * q] : (f32x4){0.f, 0.f, 0.f, 0.f};
#pragma unroll
                for (int s = 0; s < 11; ++s) v[q] += t[s]; }
            GAS f32x4* hw = (GAS f32x4*)(F.ws + WS_H + (size_t)R * DM * 4) + F.lane;
#pragma unroll
            for (int q = 0; q < 4; ++q) hw[64 * q] = v[q]; }
#pragma unroll
        for (int q = 0; q < 4; ++q) ss += (v[q].x * v[q].x + v[q].y * v[q].y) + (v[q].z * v[q].z + v[q].w * v[q].w);
        const float rstd = 1.f / sqrtf(wave_sum(ss) * (1.f / DM) + EPSN);
        GAS v2u* o8 = (GAS v2u*)(U + (size_t)R * DM) + F.lane;
#pragma unroll
        for (int q = 0; q < 4; ++q) { const int c = 4 * F.lane + 256 * q; const f32x4 gg = *(const f32x4*)(g + c), sh = *(const f32x4*)(shift + c), sc = *(const f32x4*)(scale + c);
            v[q] = (v[q] * rstd) * gg * (sc + 1.f) + sh;
            if (out8) { const float s8 = (float)(1 << F8_ACT_L2); ((GAS unsigned*)((unsigned char*)U + (size_t)R * DM))[F.lane + 64 * q] = cvt4_fp8(v[q].x * s8, v[q].y * s8, v[q].z * s8, v[q].w * s8); }
            else { v2u w; w.x = pk2(v[q].x, v[q].y); w.y = pk2(v[q].z, v[q].w); o8[64 * q] = w; } }
        if (which == 0) {
            const float s8 = (float)(1 << F8_ACT_L2);
#pragma unroll
            for (int q = 0; q < 4; ++q) ((GAS unsigned*)(F.ws + WS_U8 + (size_t)R * DM))[F.lane + 64 * q] = cvt4_fp8(v[q].x * s8, v[q].y * s8, v[q].z * s8, v[q].w * s8);
        }
    }
}
__device__ __forceinline__ void norm2_route_phase(Frame& F, const Args& A) {
    const int l = 1;
    const float* H = (const float*)(F.ws + WS_H); bf16* U = (bf16*)(F.ws + WS_U); const float* MOD = (const float*)(F.ws + WS_MOD) + l * 5 * 6144;
    const float* g = A.in[F.zz + 7] + l * 1024; const float* rw = A.in[F.zz + 22];
    LAS unsigned* wcnt = (LAS unsigned*)F.lds;
    LAS unsigned* gbase = wcnt + 64;
    const int lane = F.lane, wv = F.wave;
    for (int blk = F.vcu; blk < NB * SEQ / 64; blk += F.G) {
        int me0 = 0, me1 = 0; float mw0 = 0.f, mw1 = 0.f;
        f32x4 nv[4];
        { const int tk = blk * 64 + wv * 8, b = tk / SEQ, t = tk - b * SEQ; const GAS f32x4* xr = (const GAS f32x4*)(H + ((size_t)b * RPB + CTXL + t) * DM) + lane;
#pragma unroll
          for (int q = 0; q < 4; ++q) nv[q] = xr[64 * q]; }
#pragma unroll 1
        for (int i = 0; i < 8; ++i) {
            const int tk = blk * 64 + wv * 8 + i, b = tk / SEQ, t = tk - b * SEQ; const size_t R = (size_t)b * RPB + CTXL + t;
            const float* mod = MOD + b * 6144; const float* shift = mod + 3 * 1024; const float* scale = mod + 4 * 1024;
            f32x4 v[4]; float ss = 0.f;
#pragma unroll
            for (int q = 0; q < 4; ++q) { v[q] = nv[q]; ss += (v[q].x * v[q].x + v[q].y * v[q].y) + (v[q].z * v[q].z + v[q].w * v[q].w); }
            if (i < 7) { const GAS f32x4* xr = (const GAS f32x4*)(H + (R + 1) * DM) + lane;
#pragma unroll
                for (int q = 0; q < 4; ++q) nv[q] = xr[64 * q]; }
            const float rstd = 1.f / sqrtf(wave_sum(ss) * (1.f / DM) + EPSN);
            GAS v2u* o8 = (GAS v2u*)(U + R * DM) + lane;
            float lg[8] = {0, 0, 0, 0, 0, 0, 0, 0};
#pragma unroll
            for (int q = 0; q < 4; ++q) { const int c = 4 * lane + 256 * q; const f32x4 gg = *(const f32x4*)(g + c), sh = *(const f32x4*)(shift + c), sc = *(const f32x4*)(scale + c);
                v[q] = (v[q] * rstd) * gg * (sc + 1.f) + sh; v2u w; w.x = pk2(v[q].x, v[q].y); w.y = pk2(v[q].z, v[q].w); o8[64 * q] = w;
#pragma unroll
                for (int j = 0; j < 4; ++j) { const int k = c + j; const f32x4 w0 = *(const f32x4*)(rw + k * 8), w1 = *(const f32x4*)(rw + k * 8 + 4); const float x = v[q][j];
                    lg[0] += x * w0[0]; lg[1] += x * w0[1]; lg[2] += x * w0[2]; lg[3] += x * w0[3]; lg[4] += x * w1[0]; lg[5] += x * w1[1]; lg[6] += x * w1[2]; lg[7] += x * w1[3]; } }
#pragma unroll
            for (int e = 0; e < 8; ++e) lg[e] = wave_sum(lg[e]);
            int e0 = 0; float v0 = lg[0];
#pragma unroll
            for (int e = 1; e < 8; ++e) if (lg[e] > v0) { v0 = lg[e]; e0 = e; }
            int e1 = -1; float v1 = -3.0e38f;
#pragma unroll
            for (int e = 0; e < 8; ++e) if (e != e0 && lg[e] > v1) { v1 = lg[e]; e1 = e; }
            const float ex = __expf(v1 - v0);
            if (lane == i) { me0 = e0; me1 = e1; mw0 = 1.f / (1.f + ex); mw1 = ex / (1.f + ex); }
        }
        const bool act = lane < 8; const unsigned long long below = (1ull << lane) - 1ull;
        unsigned r0 = 0, r1 = 0, mycnt = 0;
#pragma unroll
        for (int e = 0; e < 8; ++e) { const unsigned long long m0 = __ballot(act && me0 == e), m1 = __ballot(act && me1 == e);
            const unsigned bel = (unsigned)__popcll((m0 | m1) & below);
            if (me0 == e) r0 = bel; if (me1 == e) r1 = bel;
            if (lane == e) mycnt = (unsigned)__popcll(m0) + (unsigned)__popcll(m1); }
        if (act) wcnt[wv * 8 + lane] = mycnt;
        __syncthreads();
        if (F.tid < 8) { unsigned tot = 0;
#pragma unroll
            for (int w = 0; w < 8; ++w) tot += wcnt[w * 8 + F.tid];
            gbase[F.tid] = __hip_atomic_fetch_add(F.ctl + CW_ECNT + 64 * F.tid, tot, RLX_AGENT); }
        __syncthreads();
        if (act) { unsigned b0 = gbase[me0], b1 = gbase[me1];
            for (int w = 0; w < wv; ++w) { b0 += wcnt[w * 8 + me0]; b1 += wcnt[w * 8 + me1]; }
            const int tk = blk * 64 + wv * 8 + lane;
            v4u* rt = (v4u*)(F.ws + WS_ROUTE) + 2 * tk;
            rt[0] = (v4u){(unsigned)me0, (unsigned)me1, b0 + r0, b1 + r1}; rt[1] = (v4u){__float_as_uint(mw0), __float_as_uint(mw1), 0u, 0u}; }
        __syncthreads();
    }
}

__device__ __forceinline__ void ab_tiles(Frame& F, const Args& A, int l) {
    typedef short ab_s16x8 __attribute__((ext_vector_type(8)));
    const int gw = F.vcu * NWAVES + F.wave, NGW = F.G * NWAVES, r = F.lane & 15, q = F.lane >> 4;
    const bf16* U = (const bf16*)(F.ws + WS_U); const bf16* wab = (const bf16*)(F.ws + WS_WAB) + (size_t)l * 16384 + r * 1024 + 8 * q;
    const float alog = A.in[F.zz + 12][l * 8 + (r & 7)], dtb = A.in[F.zz + 13][l * 8 + (r & 7)];
    for (int t = gw; t < MROWS / 16; t += NGW) {
        const bf16* up = U + (size_t)(t * 16 + r) * DM + 8 * q; f32x4 acc = {0.f, 0.f, 0.f, 0.f};
#pragma unroll 8
        for (int ks = 0; ks < 32; ++ks) acc = __builtin_amdgcn_mfma_f32_16x16x32_bf16(*(const ab_s16x8*)(up + 32 * ks), *(const ab_s16x8*)(wab + 32 * ks), acc, 0, 0, 0);
        f32x4 o;
#pragma unroll
        for (int g = 0; g < 4; ++g) { const float x = acc[g];
            if (r < 8) { const float z = x + dtb; const float ez = __expf(z); const float sp = z > 15.f ? z : (ez < 0.03f ? ez * (1.f - ez * (0.5f - ez * (1.f / 3.f))) : __logf(1.f + ez)); o[g] = -__expf(alog) * sp; }
            else o[g] = sigmoidf_(x); }
        float* gb = (float*)(F.ws + WS_GB) + (size_t)(t * 16 + 4 * q) * 16 + r;
        gb[0] = o[0]; gb[16] = o[1]; gb[32] = o[2]; gb[48] = o[3];
    }
}

__device__ __forceinline__ void moe_gather2(Frame& F) {
    const int gw = F.vcu * NWAVES + F.wave, NGW = F.G * NWAVES;
    MoeOrder mo; mo.init(F.ctl + CW_ECNT, 1, 1, 0);
    const bf16* U = (const bf16*)(F.ws + WS_U); unsigned char* XG = F.ws + WS_XG; const float sc = (float)(1 << F8_ACT_L2);
    for (int tk = gw; tk < NB * SEQ; tk += NGW) {
        const int b = tk / SEQ, t = tk - b * SEQ; const size_t R = (size_t)b * RPB + CTXL + t;
        const v4u rt = ((const v4u*)(F.ws + WS_ROUTE))[2 * tk];
        const size_t r0 = (size_t)mo.tile_off((int)rt.x) * 256 + rt.z, r1 = (size_t)mo.tile_off((int)rt.y) * 256 + rt.w;
        const GAS v4u* s = (const GAS v4u*)(U + R * DM) + 2 * F.lane; const v4u a = s[0], c = s[1];
        v4u o; o.x = cvt4_fp8(bf_lo(a.x) * sc, bf_hi(a.x) * sc, bf_lo(a.y) * sc, bf_hi(a.y) * sc); o.y = cvt4_fp8(bf_lo(a.z) * sc, bf_hi(a.z) * sc, bf_lo(a.w) * sc, bf_hi(a.w) * sc);
        o.z = cvt4_fp8(bf_lo(c.x) * sc, bf_hi(c.x) * sc, bf_lo(c.y) * sc, bf_hi(c.y) * sc); o.w = cvt4_fp8(bf_lo(c.z) * sc, bf_hi(c.z) * sc, bf_lo(c.w) * sc, bf_hi(c.w) * sc);
        *((GAS v4u*)(XG + r0 * DM) + F.lane) = o; *((GAS v4u*)(XG + r1 * DM) + F.lane) = o;
    }
}
__device__ __forceinline__ void moe_gather(Frame& F) {
    moe_gather2(F);
}
__device__ __forceinline__ void final_phase(Frame& F, const Args& A) {
    const int gw = F.vcu * NWAVES + F.wave, NGW = F.G * NWAVES;
    MoeOrder mo; mo.init(F.ctl + CW_ECNT, 1, 1, 0);
    const float* H = (const float*)(F.ws + WS_H); const bf16* Y = (const bf16*)(F.ws + WS_Y); const float* MOD = (const float*)(F.ws + WS_MOD) + 1 * 5 * 6144;
    for (int tk = gw; tk < NB * SEQ; tk += NGW) {
        const int b = tk / SEQ, t = tk - b * SEQ; const size_t R = (size_t)b * RPB + CTXL + t;
        const v4u rt = ((const v4u*)(F.ws + WS_ROUTE))[2 * tk], rw = ((const v4u*)(F.ws + WS_ROUTE))[2 * tk + 1];
        const size_t r0 = (size_t)mo.tile_off((int)rt.x) * 256 + rt.z, r1 = (size_t)mo.tile_off((int)rt.y) * 256 + rt.w;
        const float w0 = __uint_as_float(rw.x), w1 = __uint_as_float(rw.y);
        const float* gate = MOD + b * 6144 + 5 * 1024;
        f32x4 v[4]; float ss = 0.f;
#pragma unroll
        for (int q = 0; q < 4; ++q) { const int c = 4 * F.lane + 256 * q;
            const f32x4 h = *(const f32x4*)(H + R * DM + c), gg = *(const f32x4*)(gate + c);
            const f32x4 y0 = unpack4(*(const v2u*)(Y + r0 * DM + c)), y1 = unpack4(*(const v2u*)(Y + r1 * DM + c));
            v[q] = h + gg * (y0 * w0 + y1 * w1); ss += (v[q].x * v[q].x + v[q].y * v[q].y) + (v[q].z * v[q].z + v[q].w * v[q].w); }
        const float rstd = 1.f / sqrtf(wave_sum(ss) * (1.f / DM) + EPSN);
#pragma unroll
        for (int q = 0; q < 4; ++q) { const int c = 4 * F.lane + 256 * q; *(f32x4*)(F.out + (size_t)tk * DM + c) = v[q] * rstd * *(const f32x4*)(A.in[F.zz + 26] + c); }
    }
}

constexpr int DP = 65;
typedef short dn_bf16x8 __attribute__((ext_vector_type(8)));
__device__ __forceinline__ f32x4 mm_tile(const LAS float* Am, int a_sm, int a_sk, const LAS float* Bm, int b_sk, int b_sn, int m0, int n0, int lane) {
    const int r = lane & 15, q = lane >> 4; f32x4 acc = {0.f, 0.f, 0.f, 0.f};
#pragma unroll
    for (int ks = 0; ks < 2; ++ks) {
        const LAS float* ap = Am + (m0 + r) * a_sm + (32 * ks + 8 * q) * a_sk; const LAS float* bp = Bm + (32 * ks + 8 * q) * b_sk + (n0 + r) * b_sn;
        v4u a, b;
        a.x = pk2(ap[0], ap[a_sk]); a.y = pk2(ap[2 * a_sk], ap[3 * a_sk]); a.z = pk2(ap[4 * a_sk], ap[5 * a_sk]); a.w = pk2(ap[6 * a_sk], ap[7 * a_sk]);
        b.x = pk2(bp[0], bp[b_sk]); b.y = pk2(bp[2 * b_sk], bp[3 * b_sk]); b.z = pk2(bp[4 * b_sk], bp[5 * b_sk]); b.w = pk2(bp[6 * b_sk], bp[7 * b_sk]);
        acc = __builtin_amdgcn_mfma_f32_16x16x32_bf16(__builtin_bit_cast(dn_bf16x8, a), __builtin_bit_cast(dn_bf16x8, b), acc, 0, 0, 0);
    }
    return acc;
}

constexpr int RS = 72;
constexpr int IMG = 64 * RS * 2;
typedef short dn_s16x4 __attribute__((ext_vector_type(4)));
__device__ __forceinline__ f32x4 mm_img(const LAS bf16* Ai, const LAS bf16* Bi, int m0, int n0, int r, int q) {
    f32x4 acc = {0.f, 0.f, 0.f, 0.f};
    const LAS bf16* ap = Ai + (m0 + r) * RS + 8 * q; const LAS bf16* bp = Bi + (n0 + r) * RS + 8 * q;
    acc = __builtin_amdgcn_mfma_f32_16x16x32_bf16(*(const LAS dn_bf16x8*)ap, *(const LAS dn_bf16x8*)bp, acc, 0, 0, 0);
    acc = __builtin_amdgcn_mfma_f32_16x16x32_bf16(*(const LAS dn_bf16x8*)(ap + 32), *(const LAS dn_bf16x8*)(bp + 32), acc, 0, 0, 0);
    return acc;
}
template <int D> __device__ __forceinline__ void dn_diag_inv(LAS float* Dg, int ln) {
    const int blk = ln >> 4, r = ln & 15;
    LAS float* Ab = Dg + blk * 256;
    float t[16];
#pragma unroll
    for (int c = 0; c < 16; ++c) t[c] = (c == r) ? 1.f : 0.f;
#pragma unroll
    for (int c = 14; c >= 0; --c) { float s = 0.f;
#pragma unroll
        for (int j = c + 1; j < 16; ++j) { const float a = D == 0 ? Ab[j * 16 + c] : Ab[(15 - j) * 16 + (15 - c)]; s -= t[j] * a; }
        t[c] = (c < r) ? s : t[c]; }
    asm volatile("s_waitcnt lgkmcnt(0)" ::: "memory");
#pragma unroll
    for (int c = 0; c < 16; ++c) { if (D == 0) Ab[r * 16 + c] = t[c]; else Ab[(15 - r) * 16 + (15 - c)] = t[c]; }
}
template <int D> __device__ __forceinline__ void dn_solve_tiles(const LAS bf16* Ad, const LAS float* Dg, const LAS bf16* VT, const LAS bf16* KT, LAS bf16* UT, LAS bf16* WT,
                                                               const LAS float* Bd, const LAS float* Gd, int w4, int ln) {
    const int r = ln & 15, q = ln >> 4;
#pragma unroll 1
    for (int i = 0; i < 2; ++i) { const int nt = w4 * 2 + i; const bool isw = nt >= 4; const int c0 = (nt & 3) * 16 + r;
        const LAS bf16* src = (isw ? KT : VT) + c0 * RS; LAS bf16* dst = (isw ? WT : UT) + c0 * RS;
        f32x4 acc[4]; dn_s16x4 xb[4];
#pragma unroll
        for (int bi = 0; bi < 4; ++bi) { const v2u x = *(const LAS v2u*)(src + 16 * bi + 4 * q); const f32x4 xv = {bf_lo(x.x), bf_hi(x.x), bf_lo(x.y), bf_hi(x.y)};
#pragma unroll
            for (int g = 0; g < 4; ++g) { const int t = 16 * bi + 4 * q + g; const float sc = isw ? Bd[t] * __expf(Gd[t]) : Bd[t]; acc[bi][g] = xv[g] * sc; } }
#pragma unroll
        for (int st = 0; st < 4; ++st) { const int bi = D == 0 ? st : 3 - st;
#pragma unroll
            for (int s2 = 0; s2 < st; ++s2) { const int bj = D == 0 ? s2 : 3 - s2;
                v2u a = *(const LAS v2u*)(Ad + (16 * bi + r) * RS + 16 * bj + 4 * q); a.x ^= 0x80008000u; a.y ^= 0x80008000u;
                acc[bi] = __builtin_amdgcn_mfma_f32_16x16x16bf16_1k(__builtin_bit_cast(dn_s16x4, a), xb[bj], acc[bi], 0, 0, 0); }
            { const LAS float* tp = Dg + bi * 256 + r * 16 + 4 * q; v2u a; a.x = cvtpk_c(tp[0], tp[1]); a.y = cvtpk_c(tp[2], tp[3]);
              v2u xr; xr.x = cvtpk_c(acc[bi][0], acc[bi][1]); xr.y = cvtpk_c(acc[bi][2], acc[bi][3]);
              acc[bi] = __builtin_amdgcn_mfma_f32_16x16x16bf16_1k(__builtin_bit_cast(dn_s16x4, a), __builtin_bit_cast(dn_s16x4, xr), (f32x4){0.f, 0.f, 0.f, 0.f}, 0, 0, 0);
              v2u xo; xo.x = cvtpk_c(acc[bi][0], acc[bi][1]); xo.y = cvtpk_c(acc[bi][2], acc[bi][3]); xb[bi] = __builtin_bit_cast(dn_s16x4, xo);
              *(LAS v2u*)(dst + 16 * bi + 4 * q) = xo; }
        }
    }
}
__device__ __forceinline__ void dn_pre_unit(Frame& F, const Args& A, int l, int b, int n, int h) {
    LAS bf16* KcB = (LAS bf16*)(F.lds + 0 * IMG); LAS bf16* QcB = (LAS bf16*)(F.lds + 1 * IMG); LAS bf16* KT = (LAS bf16*)(F.lds + 2 * IMG); LAS bf16* VT = (LAS bf16*)(F.lds + 3 * IMG);
#define DIMG(d, k) ((LAS bf16*)(F.lds + (4 + 5 * (d) + (k)) * IMG))
    LAS float* Gs = (LAS float*)(F.lds + 14 * IMG);
    LAS float* Bs = Gs + 128;
    LAS float* Dg = Gs + 256;
    const bf16* P = (const bf16*)(F.ws + WS_PROJ); const float* GB = (const float*)(F.ws + WS_GB);
    const int tid = pg8::tid_from(F.wid_s);
    const int wv = tid >> 6, ln = tid & 63, r = ln & 15, q = ln >> 4;
    const int row0 = b * RPB + n * 64; const int seq_lo = (n < 4) ? b * RPB : b * RPB + CTXL, seq_hi = (n < 4) ? b * RPB + CTXL : (b + 1) * RPB;
    {
        const int t = tid >> 3, cg = tid & 7;
        const float* cw = A.in[F.zz + 11] + (size_t)l * 5 * 768;
#pragma unroll
        for (int p = 0; p < 3; ++p) {
            const int ch = p * 256 + h * 64 + cg * 8;
            float acc[8] = {0, 0, 0, 0, 0, 0, 0, 0};
#pragma unroll
            for (int tap = 0; tap < 5; ++tap) { const int rr = row0 + t + tap - 2;
                if (rr >= seq_lo && rr < seq_hi) { const v4u x = *(const v4u*)(P + (size_t)rr * PLD + PC_DQ + ch);
                    const f32x4 w0 = *(const f32x4*)(cw + tap * 768 + ch), w1 = *(const f32x4*)(cw + tap * 768 + ch + 4);
                    acc[0] += bf_lo(x.x) * w0[0]; acc[1] += bf_hi(x.x) * w0[1]; acc[2] += bf_lo(x.y) * w0[2]; acc[3] += bf_hi(x.y) * w0[3];
                    acc[4] += bf_lo(x.z) * w1[0]; acc[5] += bf_hi(x.z) * w1[1]; acc[6] += bf_lo(x.w) * w1[2]; acc[7] += bf_hi(x.w) * w1[3]; } }
            float ss = 0.f;
#pragma unroll
            for (int i = 0; i < 8; ++i) { acc[i] = siluf_(acc[i]); ss += acc[i] * acc[i]; }
            float sc = 1.f;
            if (p < 2) { ss = grp8_sum(ss); sc = (1.f / sqrtf(ss + EPSN)) * (p == 0 ? 0.125f : 1.f); }
            v4u o; o.x = cvtpk_c(acc[0] * sc, acc[1] * sc); o.y = cvtpk_c(acc[2] * sc, acc[3] * sc); o.z = cvtpk_c(acc[4] * sc, acc[5] * sc); o.w = cvtpk_c(acc[6] * sc, acc[7] * sc);
            if (p == 0) *(LAS v4u*)(QcB + t * RS + cg * 8) = o;
            else { if (p == 1) *(LAS v4u*)(KcB + t * RS + cg * 8) = o;
                LAS bf16* tp = (p == 1 ? KT : VT) + (cg * 8) * RS + t;
                tp[0 * RS] = (bf16)(o.x & 0xffffu); tp[1 * RS] = (bf16)(o.x >> 16); tp[2 * RS] = (bf16)(o.y & 0xffffu); tp[3 * RS] = (bf16)(o.y >> 16);
                tp[4 * RS] = (bf16)(o.z & 0xffffu); tp[5 * RS] = (bf16)(o.z >> 16); tp[6 * RS] = (bf16)(o.w & 0xffffu); tp[7 * RS] = (bf16)(o.w >> 16); }
        }
        if (wv < 2) { const int d = wv; const float* gb = GB + (size_t)(row0 + ln) * 16; const float g = gb[d * 4 + h]; Bs[d * 64 + ln] = gb[8 + d * 4 + h];
            float pf = g;
            { const int lid = lane_id_();
#pragma unroll
              for (int o = 1; o < 64; o <<= 1) { const float v = lane_get(pf, lid >= o ? lid - o : lid); if (lid >= o) pf += v; }
            }
            const float tot = lane_get(pf, 63);
            Gs[d * 64 + ln] = d == 0 ? pf : tot - pf + g; }
    }
    __syncthreads();
    {
#pragma unroll
        for (int i = 0; i < 2; ++i) { const int tile = wv * 2 + i, m0 = (tile >> 2) * 16, n0 = (tile & 3) * 16;
            const f32x4 kk = mm_img(KcB, KcB, m0, n0, r, q), qk = mm_img(QcB, KcB, m0, n0, r, q);
            const int s = n0 + r; const float g0s = Gs[s], g1s = Gs[64 + s];
#pragma unroll
            for (int g = 0; g < 4; ++g) { const int t = m0 + 4 * q + g; const float e0 = __expf(Gs[t] - g0s), e1 = __expf(Gs[64 + t] - g1s);
                const float a0 = (s < t) ? Bs[t] * kk[g] * e0 : 0.f, a1 = (s > t) ? Bs[64 + t] * kk[g] * e1 : 0.f;
                DIMG(0, 0)[t * RS + s] = (bf16)f2bf(a0); DIMG(1, 0)[t * RS + s] = (bf16)f2bf(a1);
                DIMG(0, 1)[t * RS + s] = (bf16)f2bf((s <= t) ? qk[g] * e0 : 0.f); DIMG(1, 1)[t * RS + s] = (bf16)f2bf((s >= t) ? qk[g] * e1 : 0.f);
                if (m0 == n0) { Dg[(m0 >> 4) * 256 + (t & 15) * 16 + r] = a0; Dg[1024 + (m0 >> 4) * 256 + (t & 15) * 16 + r] = a1; } } }
        { const int c = tid >> 3, t0 = (tid & 7) * 8; const v4u kx = *(const LAS v4u*)(KT + c * RS + t0); const float gl0 = Gs[63], gl1 = Gs[64];
          const float kf[8] = {bf_lo(kx.x), bf_hi(kx.x), bf_lo(kx.y), bf_hi(kx.y), bf_lo(kx.z), bf_hi(kx.z), bf_lo(kx.w), bf_hi(kx.w)};
          float s0[8], s1[8];
#pragma unroll
          for (int j = 0; j < 8; ++j) { s0[j] = kf[j] * __expf(gl0 - Gs[t0 + j]); s1[j] = kf[j] * __expf(gl1 - Gs[64 + t0 + j]); }
          v4u o0, o1; o0.x = cvtpk_c(s0[0], s0[1]); o0.y = cvtpk_c(s0[2], s0[3]); o0.z = cvtpk_c(s0[4], s0[5]); o0.w = cvtpk_c(s0[6], s0[7]);
          o1.x = cvtpk_c(s1[0], s1[1]); o1.y = cvtpk_c(s1[2], s1[3]); o1.z = cvtpk_c(s1[4], s1[5]); o1.w = cvtpk_c(s1[6], s1[7]);
          *(LAS v4u*)(DIMG(0, 4) + c * RS + t0) = o0; *(LAS v4u*)(DIMG(1, 4) + c * RS + t0) = o1; }
    }
    __syncthreads();
    if (wv == 0) dn_diag_inv<0>(Dg, ln); else if (wv == 4) dn_diag_inv<1>(Dg + 1024, ln);
    __syncthreads();
    if (wv < 4) dn_solve_tiles<0>(DIMG(0, 0), Dg, VT, KT, DIMG(0, 3), DIMG(0, 2), Bs, Gs, wv & 3, ln);
    else dn_solve_tiles<1>(DIMG(1, 0), Dg + 1024, VT, KT, DIMG(1, 3), DIMG(1, 2), Bs + 64, Gs + 64, wv & 3, ln);
    __syncthreads();
    {
        const int d = wv >> 2, mt = wv & 3;
        const LAS bf16* Aq = DIMG(d, 1); const LAS bf16* WT = DIMG(d, 2); const LAS bf16* UT = DIMG(d, 3); const LAS bf16* KsT = DIMG(d, 4); const LAS float* Gd = Gs + d * 64;
        const float glast = d == 0 ? Gd[63] : Gd[0];
        const size_t prob = (((size_t)b * NCHUNK + n) * 4 + h) * 2 + d;
        unsigned char* out = F.ws + WS_DNP + prob * 32768;
        if (ln == 0 && mt == 0) ((float*)(F.ws + WS_DNG))[prob] = __expf(glast);
        const float gq = __expf(Gd[16 * mt + r]);
#pragma unroll
        for (int ks = 0; ks < 2; ++ks) {
            const f32x4 y0 = mm_img(WT, Aq, 32 * ks, 16 * mt, r, q), y1 = mm_img(WT, Aq, 32 * ks + 16, 16 * mt, r, q);
            const LAS bf16* qp = QcB + (16 * mt + r) * RS + 32 * ks + 4 * q; const v2u qa = *(const LAS v2u*)qp, qb = *(const LAS v2u*)(qp + 16);
            v4u o; o.x = cvtpk_c(gq * bf_lo(qa.x) - y0[0], gq * bf_hi(qa.x) - y0[1]); o.y = cvtpk_c(gq * bf_lo(qa.y) - y0[2], gq * bf_hi(qa.y) - y0[3]);
            o.z = cvtpk_c(gq * bf_lo(qb.x) - y1[0], gq * bf_hi(qb.x) - y1[1]); o.w = cvtpk_c(gq * bf_lo(qb.y) - y1[2], gq * bf_hi(qb.y) - y1[3]);
            *(v4u*)(out + (mt * 2 + ks) * 1024 + ln * 16) = o;
            const f32x4 c0 = mm_img(WT, KsT, 32 * ks, 16 * mt, r, q), c1 = mm_img(WT, KsT, 32 * ks + 16, 16 * mt, r, q);
            v4u oc; oc.x = cvtpk_c(-c0[0], -c0[1]); oc.y = cvtpk_c(-c0[2], -c0[3]); oc.z = cvtpk_c(-c1[0], -c1[1]); oc.w = cvtpk_c(-c1[2], -c1[3]);
            *(v4u*)(out + 8192 + (mt * 2 + ks) * 1024 + ln * 16) = oc; }
#pragma unroll
        for (int nt = 0; nt < 4; ++nt) { const f32x4 rr = mm_img(Aq, UT, 16 * mt, 16 * nt, r, q), bb = mm_img(KsT, UT, 16 * mt, 16 * nt, r, q);
            v2u o; o.x = cvtpk_c(rr[0], rr[1]); o.y = cvtpk_c(rr[2], rr[3]); *(v2u*)(out + 16384 + (mt * 4 + nt) * 512 + ln * 8) = o;
            v2u ob; ob.x = cvtpk_c(bb[0], bb[1]); ob.y = cvtpk_c(bb[2], bb[3]); *(v2u*)(out + 24576 + (mt * 4 + nt) * 512 + ln * 8) = ob; }
    }
    __syncthreads();
#ifdef DBG_DN
    { unsigned char* out = F.ws + WS_DNP + ((((size_t)b * NCHUNK + n) * 4 + h) * 2) * 32768;
      if (DBG_DN < 14) { const LAS bf16* im = (const LAS bf16*)(F.lds + DBG_DN * IMG);
          for (int e = tid; e < 4096; e += NTHR) ((bf16*)out)[e] = im[(e >> 6) * RS + (e & 63)]; }
      else { for (int e = tid; e < 2304; e += NTHR) ((bf16*)out)[e] = (bf16)f2bf(Gs[e]); for (int e = 2304 + tid; e < 4096; e += NTHR) ((bf16*)out)[e] = 0; } }
    __syncthreads();
#endif
#undef DIMG
}

__device__ __forceinline__ void pool_unit(Frame& F, const Args& A, int l, int blk, int g) {
    LAS float* Uw = (LAS float*)F.lds;
    LAS float* Mm = Uw + 80 * DP;
    LAS float* PW = Mm + 64 * DP;
    const bf16* P = (const bf16*)(F.ws + WS_PROJ); bf16* PO = (bf16*)(F.ws + WS_POOLO);
    const int tid = pg8::tid_from(F.wid_s);
    const int row0 = blk * 64, b = row0 / RPB, j0 = row0 - b * RPB; const bool isctx = j0 < CTXL;
    const int seq_lo = isctx ? b * RPB : b * RPB + CTXL, L = isctx ? CTXL : SEQ; const int pos0 = row0 - seq_lo;
    for (int idx = tid; idx < 640; idx += NTHR) { const int rr = idx >> 3, c8 = (idx & 7) * 8; const int pos = pos0 - 8 + rr;
        float v[8] = {0, 0, 0, 0, 0, 0, 0, 0};
        if (pos >= 0 && pos < L) { const v4u x = *(const v4u*)(P + (size_t)(seq_lo + pos) * PLD + PC_POOL + g * 64 + c8);
            v[0] = bf_lo(x.x); v[1] = bf_hi(x.x); v[2] = bf_lo(x.y); v[3] = bf_hi(x.y); v[4] = bf_lo(x.z); v[5] = bf_hi(x.z); v[6] = bf_lo(x.w); v[7] = bf_hi(x.w); }
#pragma unroll
        for (int i = 0; i < 8; ++i) Uw[rr * DP + c8 + i] = v[i]; }
    { const float* pw = A.in[F.zz + 15] + ((size_t)l * 4 + g) * 4096;
#pragma unroll
      for (int k = 0; k < 8; ++k) { const int e = tid + 512 * k; PW[(e >> 6) * DP + (e & 63)] = pw[e]; } }
    __syncthreads();
    const int win = 2 << g;
#pragma unroll 1
    for (int k = 0; k < 8; ++k) { const int e = tid + 512 * k, t = e >> 6, i = e & 63; const int pos = pos0 + t;
        int lo = pos - win / 2, hi = lo + win; lo = lo < 0 ? 0 : lo; hi = hi > L ? L : hi;
        float s = 0.f;
#pragma unroll 4
        for (int p = lo; p < hi; ++p) s += Uw[(p - pos0 + 8) * DP + i];
        Mm[t * DP + i] = s / (float)(hi - lo) - Uw[(t + 8) * DP + i]; }
    __syncthreads();
    const float* psc = A.in[F.zz + 16] + l * 256 + g * 64;
    { const int wv = tid >> 6, ln = tid & 63, r = ln & 15, q = ln >> 4;
#pragma unroll
      for (int i = 0; i < 2; ++i) { const int tile = wv * 2 + i, m0 = (tile >> 2) * 16, n0 = (tile & 3) * 16;
          const f32x4 y = mm_tile(Mm, DP, 1, PW, DP, 1, m0, n0, ln); const float sc = psc[n0 + r];
#pragma unroll
          for (int gg = 0; gg < 4; ++gg) PO[(size_t)(row0 + m0 + 4 * q + gg) * 256 + g * 64 + n0 + r] = (bf16)f2bf(y[gg] * sc); } }
    __syncthreads();
}

constexpr int SC_SLOT = 32768, SC_NSLOT = 4, SC_ST = SC_SLOT * SC_NSLOT, SC_GL = SC_ST + 2 * 8192;
__device__ __forceinline__ void dn_scan_item(Frame& F, int item) {
    typedef short s16x8v __attribute__((ext_vector_type(8)));
    const int d = item & 1, h = (item >> 1) & 3, b = item >> 3;
    const int tid = pg8::tid_from(F.wid_s);
    const int wv = __builtin_amdgcn_readfirstlane(tid >> 6), ln = tid & 63, r = ln & 15, q = ln >> 4;
    LAS unsigned char* L = F.lds;
    LAS float* glv = (LAS float*)(L + SC_GL);
    const unsigned char* dnp = F.ws + WS_DNP;
#define SC_N(st) (d == 0 ? (st) : ((st) < 4 ? 3 - (st) : 71 - (st)))
#define SC_PROB(st) ((((size_t)b * NCHUNK + SC_N(st)) * 4 + h) * 2 + d)
    if (tid < NCHUNK) glv[tid] = ((const float*)(F.ws + WS_DNG))[SC_PROB(tid)];
    for (int e = tid; e < 2 * 8192 / 16; e += NTHR) ((LAS v4u*)(L + SC_ST))[e] = (v4u){0u, 0u, 0u, 0u};
    asm volatile("s_waitcnt vmcnt(0) lgkmcnt(0)" ::: "memory"); __builtin_amdgcn_s_barrier();
#define SC_DMA(st, slot) do { const unsigned char* src_ = dnp + SC_PROB(st) * 32768 + wv * 8192 + ln * 16; \
        _Pragma("unroll") for (int i_ = 0; i_ < 8; ++i_) __builtin_amdgcn_global_load_lds((const unsigned*)(src_ + i_ * 1024), (LAS unsigned*)(L + (slot) * SC_SLOT + wv * 8192 + i_ * 1024), 16, 0, 0); } while (0)
    if (wv < 4) { SC_DMA(0, 0); SC_DMA(1, 1); SC_DMA(2, 2); }
    f32x4 s0 = {0.f, 0.f, 0.f, 0.f}, s1 = s0, s2 = s0, s3 = s0;
    bf16* DNO = (bf16*)(F.ws + WS_DNO) + (size_t)d * MROWS * 256;
#pragma unroll 1
    for (int st = 0; st < NCHUNK; ++st) {
        if (wv < 4) asm volatile("s_waitcnt vmcnt(16)" ::: "memory");
        asm volatile("s_waitcnt lgkmcnt(0)" ::: "memory"); __builtin_amdgcn_s_barrier();
        if (wv < 4) { const int nx = st + 3 < NCHUNK ? st + 3 : NCHUNK - 1; SC_DMA(nx, (st + 3) & 3); }
        const LAS unsigned char* slot = L + (st & 3) * SC_SLOT;
        const LAS unsigned char* stc = L + SC_ST + (st & 1) * 8192; LAS unsigned char* stn = L + SC_ST + ((st + 1) & 1) * 8192;
        const int nt = wv & 3;
        const s16x8v bf0 = *(const LAS s16x8v*)(stc + (nt * 2 + 0) * 1024 + ln * 16), bf1 = *(const LAS s16x8v*)(stc + (nt * 2 + 1) * 1024 + ln * 16);
        if (wv < 4) {
            const float gl = glv[st];
            const LAS unsigned char* cf = slot + 8192; const LAS unsigned char* bi = slot + 24576;
#define SC_ST_TILE(S, mt) do { const v2u bw_ = *(const LAS v2u*)(bi + ((mt) * 4 + nt) * 512 + ln * 8); \
            f32x4 a_ = {gl * S[0] + bf_lo(bw_.x), gl * S[1] + bf_hi(bw_.x), gl * S[2] + bf_lo(bw_.y), gl * S[3] + bf_hi(bw_.y)}; \
            a_ = __builtin_amdgcn_mfma_f32_16x16x32_bf16(*(const LAS s16x8v*)(cf + ((mt) * 2 + 0) * 1024 + ln * 16), bf0, a_, 0, 0, 0); \
            a_ = __builtin_amdgcn_mfma_f32_16x16x32_bf16(*(const LAS s16x8v*)(cf + ((mt) * 2 + 1) * 1024 + ln * 16), bf1, a_, 0, 0, 0); S = a_; } while (0)
            SC_ST_TILE(s0, 0); SC_ST_TILE(s1, 1); SC_ST_TILE(s2, 2); SC_ST_TILE(s3, 3);
#undef SC_ST_TILE
            v4u w0, w1; w0.x = pk2(s0[0], s0[1]); w0.y = pk2(s0[2], s0[3]); w0.z = pk2(s1[0], s1[1]); w0.w = pk2(s1[2], s1[3]);
            w1.x = pk2(s2[0], s2[1]); w1.y = pk2(s2[2], s2[3]); w1.z = pk2(s3[0], s3[1]); w1.w = pk2(s3[2], s3[3]);
            *(LAS v4u*)(stn + (nt * 2 + 0) * 1024 + ln * 16) = w0; *(LAS v4u*)(stn + (nt * 2 + 1) * 1024 + ln * 16) = w1;
        } else {
            const LAS unsigned char* pf = slot; const LAS unsigned char* ri = slot + 16384;
            const int n = SC_N(st);
            bf16* orow = DNO + (size_t)(b * RPB + n * 64 + 4 * q) * 256 + h * 64 + nt * 16 + r;
#pragma unroll
            for (int mt = 0; mt < 4; ++mt) { const v2u rw_ = *(const LAS v2u*)(ri + (mt * 4 + nt) * 512 + ln * 8);
                f32x4 a_ = {bf_lo(rw_.x), bf_hi(rw_.x), bf_lo(rw_.y), bf_hi(rw_.y)};
                a_ = __builtin_amdgcn_mfma_f32_16x16x32_bf16(*(const LAS s16x8v*)(pf + (mt * 2 + 0) * 1024 + ln * 16), bf0, a_, 0, 0, 0);
                a_ = __builtin_amdgcn_mfma_f32_16x16x32_bf16(*(const LAS s16x8v*)(pf + (mt * 2 + 1) * 1024 + ln * 16), bf1, a_, 0, 0, 0);
#pragma unroll
                for (int g = 0; g < 4; ++g) orow[(size_t)(16 * mt + g) * 256] = (bf16)f2bf(a_[g]); }
        }
    }
    asm volatile("s_waitcnt vmcnt(0) lgkmcnt(0)" ::: "memory"); __builtin_amdgcn_s_barrier();
#undef SC_DMA
#undef SC_N
#undef SC_PROB
}

__device__ __forceinline__ void mix_build(Frame& F, const Args& A, int l) {
    const int lane = pg8::lane_id_asm(); const int gw = F.vcu * NWAVES + F.wave, NGW = F.G * NWAVES;
    const bf16* ATTO = (const bf16*)(F.ws + WS_ATTO); const bf16* P = (const bf16*)(F.ws + WS_PROJ); const bf16* DNO = (const bf16*)(F.ws + WS_DNO); bf16* MIX = (bf16*)(F.ws + WS_MIX);
    const float lam = ((const float*)(F.ws + WS_LAM))[l]; const float li = 0.8f - 0.6f * expf(-0.3f * (float)l);
    const float* sg = A.in[F.zz + 10] + l * 128; const float* ng = A.in[F.zz + 14] + l * 64;
    for (int R = gw; R < MROWS; R += NGW) {
        const int j = R % RPB; if (l == 1 && j < CTXL) continue;
        { const int hh = lane >> 4, e0 = (lane & 15) * 8;
          const v4u a = *(const v4u*)(ATTO + (size_t)R * DM + (hh * 2) * 128 + e0), c = *(const v4u*)(ATTO + (size_t)R * DM + (hh * 2 + 1) * 128 + e0);
          float x[8] = {bf_lo(a.x) - lam * bf_lo(c.x), bf_hi(a.x) - lam * bf_hi(c.x), bf_lo(a.y) - lam * bf_lo(c.y), bf_hi(a.y) - lam * bf_hi(c.y),
                        bf_lo(a.z) - lam * bf_lo(c.z), bf_hi(a.z) - lam * bf_hi(c.z), bf_lo(a.w) - lam * bf_lo(c.w), bf_hi(a.w) - lam * bf_hi(c.w)};
          float ss = 0.f;
#pragma unroll
          for (int i = 0; i < 8; ++i) ss += x[i] * x[i];
          ss = grp16_sum(ss);
          const float sc = (1.f / sqrtf(ss * (1.f / 128.f) + EPSN)) * (1.f - li);
          const f32x4 g0 = *(const f32x4*)(sg + e0), g1 = *(const f32x4*)(sg + e0 + 4);
          v4u o; o.x = pk2(x[0] * sc * g0[0], x[1] * sc * g0[1]); o.y = pk2(x[2] * sc * g0[2], x[3] * sc * g0[3]); o.z = pk2(x[4] * sc * g1[0], x[5] * sc * g1[1]); o.w = pk2(x[6] * sc * g1[2], x[7] * sc * g1[3]);
          *(v4u*)(MIX + (size_t)R * DM + hh * 128 + e0) = o; }
        { const int c0 = lane * 4;
          const v2u a = *(const v2u*)(DNO + (size_t)R * 256 + c0), c = *(const v2u*)(DNO + ((size_t)MROWS + R) * 256 + c0), z = *(const v2u*)(P + (size_t)R * PLD + PC_DZ + c0);
          float x[4] = {bf_lo(a.x) + bf_lo(c.x), bf_hi(a.x) + bf_hi(c.x), bf_lo(a.y) + bf_lo(c.y), bf_hi(a.y) + bf_hi(c.y)};
          float ss = x[0] * x[0] + x[1] * x[1] + x[2] * x[2] + x[3] * x[3];
          ss = grp16_sum(ss);
          const float sc = 1.f / sqrtf(ss * (1.f / 64.f) + EPSN);
          const f32x4 gg = *(const f32x4*)(ng + (c0 & 63));
          v2u o; o.x = pk2(x[0] * sc * gg[0] * siluf_(bf_lo(z.x)), x[1] * sc * gg[1] * siluf_(bf_hi(z.x))); o.y = pk2(x[2] * sc * gg[2] * siluf_(bf_lo(z.y)), x[3] * sc * gg[3] * siluf_(bf_hi(z.y)));
          *(v2u*)(MIX + (size_t)R * DM + 512 + c0) = o; }
        { const v2u pz = *(const v2u*)((const bf16*)(F.ws + WS_POOLO) + (size_t)R * 256 + lane * 4); *(v2u*)(MIX + (size_t)R * DM + 768 + lane * 4) = pz; }
    }
}

#ifndef MK_N_LAUNCHES
#define MK_N_LAUNCHES 1
#endif
__device__ __forceinline__ bool in_phase(int k, int lo, int hi) { asm volatile("" : "+s"(lo), "+s"(hi)); return lo <= k && k < hi; }
__global__ void __launch_bounds__(NTHR, 2) mk_fwd(Args args) {
    extern __shared__ __attribute__((aligned(16))) unsigned char lds[];
    Frame F;
    F.lds = (LAS unsigned char*)lds;
    F.MISC = (volatile LAS unsigned*)(F.lds + MISC_OFF);
    F.wid_s = __builtin_amdgcn_readfirstlane((int)(threadIdx.x >> 6));
    F.tid = pg8::tid_from(F.wid_s); F.lane = F.tid & 63; F.wave = F.wid_s;
    F.G = gridDim.x; { const int bx = blockIdx.x; F.bx = bx; F.vcu = (F.G % 8 == 0) ? (bx % 8) * (F.G / 8) + bx / 8 : bx; }
    F.ws = args.ws; F.out = args.out; F.zz = 0;
    F.ctl = (gu32*)(args.ws + WS_CTL);
    for (int u = F.tid; u < (LDS_BYTES - MISC_OFF) / 4; u += NTHR) ((LAS unsigned*)(F.lds + MISC_OFF))[u] = 0u;
    __syncthreads();
    const int lo = args.ph_lo, hi = args.ph_hi;
    const bool use_bar = (hi - lo) > 1;
    XcdBarrier bar; bar.bar = ((unsigned*)(F.ctl + CW_BAR) + args.bar_li * XCD_BAR_WORDS); bar.x = 0; bar.st = nullptr; bar.wid = (unsigned)F.wid_s;
    if (use_bar) bar = xcd_barrier_post(((unsigned*)(F.ctl + CW_BAR) + args.bar_li * XCD_BAR_WORDS), F.MISC + 8, (unsigned)F.wid_s);
#ifndef EN_MASK
#define EN_MASK 0xFFFFFFFFu
#endif
#define IN(k) (((EN_MASK >> ((k) > 12 ? (k) - 12 : (k))) & 1u) && in_phase((k), lo, hi))
#define PB() do { GAS unsigned char* w_ = (GAS unsigned char*)args.ws; LAS unsigned char* l_ = (LAS unsigned char*)lds; int z_ = 0; asm volatile("" : "+s"(w_), "+s"(l_), "+s"(z_)); F.ws = (unsigned char*)w_; F.ctl = (gu32*)w_; F.lds = l_; F.zz = z_; { int bx_ = blockIdx.x; asm volatile("" : "+s"(bx_)); F.bx = bx_; F.vcu = (F.G % 8 == 0) ? (bx_ % 8) * (F.G / 8) + bx_ / 8 : bx_; } const int t_ = pg8::tid_from(F.wid_s); F.tid = t_; F.lane = t_ & 63; F.wave = F.wid_s; } while (0)
#ifdef DBG_DUP
#define NREP(k) ((((k) > 12 && (k) < 23) ? (k) - 12 : (k)) == DBG_DUP ? 2 : 1)
#else
#define NREP(k) 1
#endif
#define SEAMX() do { XcdBarrier bl_ = bar; { GAS unsigned* b_ = (GAS unsigned*)(args.ws + WS_CTL) + CW_BAR + args.bar_li * XCD_BAR_WORDS; unsigned x_ = bar.x; asm volatile("" : "+s"(b_), "+s"(x_)); bl_.bar = (unsigned*)b_; bl_.x = x_; } xcd_barrier(bl_); } while (0)
#define PH_BEGIN(k) if (IN(k)) { for (int rep_ = 0; rep_ < NREP(k); ++rep_) { if (rep_) SEAMX(); PB();
#define PH_END(k) } } SEAM(k);
#define SEAM(k) do { if (IN(k) && IN((k) + 1)) { XcdBarrier bl_ = bar; { GAS unsigned* b_ = (GAS unsigned*)(args.ws + WS_CTL) + CW_BAR + args.bar_li * XCD_BAR_WORDS; unsigned x_ = bar.x; asm volatile("" : "+s"(b_), "+s"(x_)); bl_.bar = (unsigned*)b_; bl_.x = x_; } xcd_barrier(bl_); } } while (0)
    char* ldsg = (char*)lds;

    PH_BEGIN(PH_PRO) p0_prologue(F, args); PH_END(PH_PRO)

#pragma unroll 1
    for (int l = 0; l < 2; ++l) {
        const int pb = 1 + 12 * l;
        const float* modl = (const float*)(F.ws + WS_MOD) + l * 5 * 6144;
        PH_BEGIN(pb + PH_N1) norm_mod_phase(F, args, l, 0, false, false, false, l == 1 ? 11 : 0, l == 0 ? 1 : 0); PH_END(pb + PH_N1)
        PH_BEGIN(pb + PH_PROJ)
            { pg8::Gemm g{(const bf16*)(F.ws + WS_U), (const bf16*)(F.ws + WS_WIN) + (size_t)l * NPB * 1024, 1024, 1024, 1024, 0, 0, F.wid_s};
              TileOrder S; S.init(MROWS / 256, NPB / 256, F.G, F.bx, 0);
              EpiProj E{(bf16*)(F.ws + WS_PROJ), (const float*)(F.ws + WS_ROPE)};
              pg8::gemm_phase<EpiProj, TileOrder, true, true>(F.lds, g, S, E); }
            { pg8::Gemm g{(const bf16*)(F.ws + WS_U8), (const bf16*)(F.ws + WS_WG8 + (size_t)l * 3072 * 1024), 512, 512, 512, E8(F8_ACT_L2), E8(F8_W13_L2), F.wid_s};
              TileOrder S; S.init(MROWS / 256, 12, F.G, F.bx, 0);
              EpiGate E{(bf16*)(F.ws + WS_PROJ)};
              pg8::gemm_phase8<EpiGate, TileOrder, true, true>(F.lds, g, S, E); }
            ab_tiles(F, args, l);
        PH_END(pb + PH_PROJ)
        PH_BEGIN(pb + PH_ATT)
            const bf16* P = (const bf16*)(F.ws + WS_PROJ); bf16* AO = (bf16*)(F.ws + WS_ATTO);
            const int nunits = 512 + (l == 0 ? 32 : 0);
#ifndef DIS_ATTN
#ifdef DBG_DUP
            for (int r2_ = 0; r2_ < (DBG_DUP == 31 ? 2 : 1); ++r2_)
#endif
#pragma unroll 1
            for (int u = F.vcu; u < nunits; u += F.G) {
                int b, hm, qrow, seq;
                if (u < 512) { b = u >> 7; hm = (u >> 4) & 7; qrow = CTXL + (u & 15) * 256; seq = RPB; }
                else { const int v = u - 512; b = v >> 3; hm = v & 7; qrow = 0; seq = CTXL; }
                const size_t r0 = (size_t)b * RPB;
                attn::attn_unit<PLD, DM>(P + (r0 + qrow) * PLD + PC_AQ + hm * 64, P + r0 * PLD + PC_AK + hm * 64, P + r0 * PLD + PC_AV + (hm >> 1) * 128,
                                           AO + (r0 + qrow) * DM + hm * 128, seq, F.lds, F.wid_s);
            }
#endif
#ifndef DIS_DNPRE
#ifdef DBG_DUP
            for (int r2_ = 0; r2_ < (DBG_DUP == 32 ? 2 : 1); ++r2_)
#endif
#pragma unroll 1
            for (int u = F.vcu; u < NB * NCHUNK * 4; u += F.G) { const int h = u & 3, n = (u >> 2) % NCHUNK, b = (u >> 2) / NCHUNK; dn_pre_unit(F, args, l, b, n, h); }
#endif
        PH_END(pb + PH_ATT)
        PH_BEGIN(pb + PH_SCAN)
#pragma unroll 1
            for (int it = F.vcu; it < 32; it += F.G) dn_scan_item(F, it);
            { const bool many = F.G > 32; const int rk = many ? F.vcu - 32 : F.vcu, nr = many ? F.G - 32 : F.G;
              if (rk >= 0) {
#pragma unroll 1
                for (int u = rk; u < (MROWS / 64) * 4; u += nr) pool_unit(F, args, l, u >> 2, u & 3);
                if (l == 0) { conv_layer_weights(F, args, 1, rk * NWAVES + F.wave, nr * NWAVES); moe_convert<0>(F, args, rk * NWAVES + F.wave, nr * NWAVES); }
                else moe_convert<1>(F, args, rk * NWAVES + F.wave, nr * NWAVES); } }
        PH_END(pb + PH_SCAN)
        PH_BEGIN(pb + PH_MIXB) mix_build(F, args, l); PH_END(pb + PH_MIXB)
        if (IN(pb + PH_MRG0)) { PB();
            pg8::Gemm g{(const bf16*)(F.ws + WS_MIX), (const bf16*)(F.ws + WS_WBR) + (size_t)l * 1024 * 1024, 1024, 1024, 1024, 0, 0, F.wid_s};
            TileOrder S; S.init(l == 0 ? 68 : 64, 4, F.G, F.bx, l);
            EpiMergeF E{(bf16*)(F.ws + WS_MG), (const bf16*)(F.ws + WS_PROJ)};
            pg8::gemm_phase<EpiMergeF, TileOrder, true, true>(F.lds, g, S, E);
        } SEAM(pb + PH_MRG2);
        if (IN(pb + PH_OUT)) { PB();
            { pg8::Gemm g{(const bf16*)(F.ws + WS_MG), (const bf16*)(F.ws + WS_WOUT) + (size_t)l * 1024 * 1024, 1024, 1024, 1024, 0, 0, F.wid_s};
              TileOrder S; S.init(64, 4, F.G, F.bx, 1);
              EpiResid E{(float*)(F.ws + WS_H), modl, 2, l == 0 ? args.in[F.zz + 0] : nullptr};
              pg8::gemm_phase<EpiResid, TileOrder, true, true>(F.lds, g, S, E); }
            if (l == 0) {
              pg8::Gemm g{(const bf16*)(F.ws + WS_MG), (const bf16*)(F.ws + WS_WOUT), 256, 1024, 1024, 0, 0, F.wid_s};
              CtxSplitOrder S; S.init(4, 512, F.G, F.bx);
              EpiSlab E{(float*)(F.ws + WS_SLAB), modl, 2};
              pg8::gemm_phase<EpiSlab, CtxSplitOrder, true, true>(F.lds, g, S, E); }
        } SEAM(pb + PH_OUT);
#ifdef DENSE_F8
        PH_BEGIN(pb + PH_N2) norm_mod_phase(F, args, l, 1, l == 1, l == 1, l == 0); PH_END(pb + PH_N2)
#else
        PH_BEGIN(pb + PH_N2) if (l == 0) norm_mod_phase(F, args, 0, 1, false, false, false, 4, 2); else norm2_route_phase(F, args); PH_END(pb + PH_N2)
#endif
        if (l == 0) {
#ifdef DENSE_F8
            PH_BEGIN(PH_FUP)
                pg8::Gemm g{(const bf16*)(F.ws + WS_U), (const bf16*)(F.ws + WS_W13), 512, 512, 512, E8(F8_ACT_L2), E8(F8_W13_L2), F.wid_s};
                TileOrder S; S.init(68, 2 * FFD / 256, F.G, F.bx, 0);
                EpiSwiglu8 E{F.ws + WS_HID, FFD};
                pg8::gemm_phase8<EpiSwiglu8, TileOrder, true, true>(F.lds, g, S, E);
            PH_END(PH_FUP)
            if (IN(PH_FDN)) { PB();
                pg8::Gemm g{(const bf16*)(F.ws + WS_HID), (const bf16*)(F.ws + WS_W2), FFD / 2, FFD / 2, FFD / 2, E8(F8_ACT_L2), E8(F8_W2_L2), F.wid_s};
                TileOrder S; S.init(68, 4, F.G, F.bx, 0);
                EpiResid E{(float*)(F.ws + WS_H), modl, 5, nullptr};
                pg8::gemm_phase8<EpiResid, TileOrder, true, true>(F.lds, g, S, E);
            } SEAM(PH_FDN);
#else
            PH_BEGIN(PH_FUP)
                pg8::Gemm g{(const bf16*)(F.ws + WS_U), (const bf16*)(F.ws + WS_W13), 1024, 1024, 1024, 0, 0, F.wid_s};
                TileOrder S; S.init(68, 2 * FFD / 256, F.G, F.bx, 0);
                EpiSwiglu E{(bf16*)(F.ws + WS_HID), FFD};
                pg8::gemm_phase<EpiSwiglu, TileOrder, true, true>(F.lds, g, S, E);
            PH_END(PH_FUP)
            if (IN(PH_FDN)) { PB();
                { pg8::Gemm g{(const bf16*)(F.ws + WS_HID), (const bf16*)(F.ws + WS_W2), FFD, FFD, FFD, 0, 0, F.wid_s};
                  TileOrder S; S.init(64, 4, F.G, F.bx, 1);
                  EpiResid E{(float*)(F.ws + WS_H), modl, 5, nullptr};
                  pg8::gemm_phase<EpiResid, TileOrder, true, true>(F.lds, g, S, E); }
                { pg8::Gemm g{(const bf16*)(F.ws + WS_HID), (const bf16*)(F.ws + WS_W2), 256, FFD, FFD, 0, 0, F.wid_s};
                  CtxSplitOrder S; S.init(11, 512, F.G, F.bx);
                  EpiSlab E{(float*)(F.ws + WS_SLAB), modl, 5};
                  pg8::gemm_phase<EpiSlab, CtxSplitOrder, true, true>(F.lds, g, S, E); }
            } SEAM(PH_FDN);
#endif
        }
    }
    PH_BEGIN(PH_GATH) moe_gather(F); PH_END(PH_GATH)
#pragma unroll 1
    for (int hh = 0; hh < 1; ++hh) {
        const int p0 = PH_CV0 + 3 * hh;
        PH_BEGIN(p0 + 1)
            pg8::Gemm g{(const bf16*)(F.ws + WS_XG), (const bf16*)(F.ws + WS_W13M), 512, 512, 512, E8(F8_ACT_L2), E8(F8_W13_L2), F.wid_s};
            MoeOrder S; S.init(F.ctl + CW_ECNT, 2 * FFE / 256, F.G, F.vcu);
            EpiSwiglu8 E{F.ws + WS_HIDM, FFE};
            pg8::gemm_phase8<EpiSwiglu8, MoeOrder, true, true>(F.lds, g, S, E);
        PH_END(p0 + 1)
        if (IN(p0 + 2)) { PB();
            pg8::Gemm g{(const bf16*)(F.ws + WS_HIDM), (const bf16*)(F.ws + WS_W2M), FFE / 2, FFE / 2, FFE / 2, E8(F8_ACT_L2), E8(F8_W2_L2), F.wid_s};
            MoeOrder S; S.init(F.ctl + CW_ECNT, 4, F.G, F.vcu);
            EpiY E{(bf16*)(F.ws + WS_Y), 1};
            pg8::gemm_phase8<EpiY, MoeOrder, true, true>(F.lds, g, S, E);
        } SEAM(p0 + 2);
    }
    PH_BEGIN(PH_FIN) final_phase(F, args); } }
#ifdef DBG_STOP
    if (lo == 100) {
        const int gw = F.vcu * NWAVES + F.wave, NGW = F.G * NWAVES;
        for (int tk = gw; tk < NB * SEQ; tk += NGW) { const int b = tk / SEQ, t = tk - b * SEQ; const size_t R = (size_t)b * RPB + CTXL + t;
#if DBG_SRC == 0
            const f32x4* s = (const f32x4*)((const float*)(args.ws + WS_H) + R * DM) + F.lane; f32x4* d = (f32x4*)(args.out + (size_t)tk * DM) + F.lane;
            for (int q = 0; q < 4; ++q) d[64 * q] = s[64 * q];
#elif DBG_SRC == 2
            MoeOrder mo; mo.init((gu32*)args.ws + CW_ECNT, 1, 1, 0); const v4u rt = ((const v4u*)(args.ws + WS_ROUTE))[2 * tk];
            const size_t rr = (size_t)mo.tile_off((int)rt.x) * 256 + rt.z; (void)R;
            const bf16* s = (const bf16*)(args.ws + DBG_OFF) + rr * DBG_LD + DBG_COL; float* d = args.out + (size_t)tk * DM;
            for (int q = 0; q < 16; ++q) d[F.lane + 64 * q] = bf2f(s[F.lane + 64 * q]);
#else
#ifdef DBG_MOD
            const bf16* s = (const bf16*)(args.ws + DBG_OFF) + (R % DBG_MOD) * DBG_LD + DBG_COL; float* d = args.out + (size_t)tk * DM;
#else
            const bf16* s = (const bf16*)(args.ws + DBG_OFF) + R * DBG_LD + DBG_COL; float* d = args.out + (size_t)tk * DM;
#endif
            for (int q = 0; q < 16; ++q) { float v = bf2f(s[F.lane + 64 * q]); d[F.lane + 64 * q] = (v == v && fabsf(v) < 1e30f) ? v : DBG_NANVAL; }
#endif
        }
    }
#endif
#undef IN
#undef SEAM
}

extern "C" void kernel_launch(void* const* d_in, const int* in_sizes, int n_in, void* d_out, int out_size, void* d_ws, size_t ws_size, hipStream_t stream) {
    static int grid = 0;
    if (grid == 0) {
        if (n_in != 27 || in_sizes[0] != NB * SEQ * DM || out_size != NB * SEQ * DM || ws_size < WS_END) {
            fprintf(stderr, "kernel_launch: shape / workspace mismatch (n_in %d, in0 %d, out %d, ws %zu, need %zu); nothing launched\n", n_in, n_in > 0 ? in_sizes[0] : -1, out_size, ws_size, (size_t)WS_END); grid = -1; return; }
        int dev = 0, cus = 0, per_cu = 0;
        if (hipGetDevice(&dev) != hipSuccess || hipDeviceGetAttribute(&cus, hipDeviceAttributeMultiprocessorCount, dev) != hipSuccess) { grid = -1; return; }
        if (hipFuncSetAttribute((const void*)mk_fwd, hipFuncAttributeMaxDynamicSharedMemorySize, LDS_BYTES) != hipSuccess) { fprintf(stderr, "kernel_launch: hipFuncSetAttribute failed\n"); grid = -1; return; }
        if (hipOccupancyMaxActiveBlocksPerMultiprocessor(&per_cu, (const void*)mk_fwd, NTHR, LDS_BYTES) != hipSuccess || per_cu < 1)
            fprintf(stderr, "kernel_launch: note: occupancy query reports %d workgroups per CU\n", per_cu);
        (void)hipGetLastError();
        grid = cus;
    }
    if (grid < 0) return;
    if (hipMemsetAsync((char*)d_ws + WS_CTL, 0, CTL_ZERO_BYTES, stream) != hipSuccess) return;
    Args a{};
    for (int i = 0; i < 27; ++i) a.in[i] = (const float*)d_in[i];
    a.out = (float*)d_out; a.ws = (unsigned char*)d_ws;
    constexpr int NL = MK_N_LAUNCHES;
#ifdef DBG_STOP
    constexpr int NLL = DBG_STOP + 2;
#else
    constexpr int NLL = NL;
#endif
#ifdef DBG_PREFIX
    for (int li = 0; li < 2; ++li) { a.ph_lo = 0; a.ph_hi = li == 0 ? DBG_PREFIX + 1 : PH_COUNT; a.bar_li = li;
        hipLaunchKernelGGL(mk_fwd, dim3(grid), dim3(NTHR), LDS_BYTES, stream, a); }
    return;
#endif
    for (int li = 0; li < NLL; ++li) {
#ifdef DBG_SKIP_LO
        if (li >= DBG_SKIP_LO && li <= DBG_SKIP_HI) continue;
#endif
        a.ph_lo = (NL == 1) ? 0 : li; a.ph_hi = (NL == 1) ? PH_COUNT : li + 1;
#ifdef DBG_STOP
        a.ph_lo = li; a.ph_hi = li + 1;
        if (li == NLL - 1) { a.ph_lo = 100; a.ph_hi = 101; }
#endif
        hipLaunchKernelGGL(mk_fwd, dim3(grid), dim3(NTHR), LDS_BYTES, stream, a);
        const hipError_t le = hipPeekAtLastError();
        if (le != hipSuccess) { fprintf(stderr, "kernel_launch: launch %d failed: %s\n", li, hipGetErrorName(le)); break; }
    }
}
```
